# Optimizing an MI355X kernel written in HIP

```python
import math
import jax, jax.numpy as jnp
from jax import lax
import numpy as np

D_MODEL = 1024
BATCH = 8
SEQ = 8192
DEPTH = 1

N_MEM = 256
EPS = 1e-6

SSD_D_INNER = D_MODEL
SSD_HEAD_DIM = 64
SSD_HEADS = SSD_D_INNER // SSD_HEAD_DIM
SSD_GROUPS = 4
SSD_HEADS_PER_GROUP = SSD_HEADS // SSD_GROUPS
SSD_STATE = 128
SSD_CONV = 4
SSD_CHUNK = 128
SSD_CONV_DIM = SSD_D_INNER + 2 * SSD_GROUPS * SSD_STATE

DIL_PAIRS = ((128, 1), (512, 4), (2048, 16))
DIL_HEADS_PER_GROUP = 4
DIL_HEAD_DIM = 64
DIL_HEADS = len(DIL_PAIRS) * DIL_HEADS_PER_GROUP
DIL_WIDTH = DIL_HEADS * DIL_HEAD_DIM
DIL_OUT_WIDTH = DIL_HEADS_PER_GROUP * DIL_HEAD_DIM

MEM_HEADS = 4
MEM_HEAD_DIM = 192
MEM_WIDTH = MEM_HEADS * MEM_HEAD_DIM

ROPE_THETA = 500000.0
ROPE_FRACTION = 4

PEER_HEADS = 8
PEER_N_KEYS = 128
PEER_EXPERTS = PEER_N_KEYS * PEER_N_KEYS
PEER_QUERY_DIM = 256
PEER_TOPK = 16
PEER_BLOCK = 64

N_BRANCHES = 3

OFF_Z = 0
OFF_XBC = OFF_Z + SSD_D_INNER
OFF_DT = OFF_XBC + SSD_CONV_DIM
OFF_DQ = OFF_DT + SSD_HEADS
OFF_DK = OFF_DQ + DIL_WIDTH
OFF_DV = OFF_DK + DIL_WIDTH
OFF_MQ = OFF_DV + DIL_WIDTH
OFF_GATE = OFF_MQ + MEM_WIDTH
IN_PROJ_WIDTH = OFF_GATE + N_BRANCHES * D_MODEL

kernel_name = 'hybrid_ssd_dilated_memory_peer_block'

F32 = jnp.float32


def _rms_norm(t, w):
    tf = t.astype(F32)
    tf = tf * lax.rsqrt(jnp.mean(tf * tf, axis=-1, keepdims=True) + EPS)
    return (tf * w.astype(F32)).astype(t.dtype)


def _partial_rope(t, positions):
    hd = t.shape[-1]
    rot = hd // ROPE_FRACTION
    half = rot // 2
    inv = jnp.exp(-math.log(ROPE_THETA) * (2.0 / rot) * jnp.arange(half, dtype=F32))
    ang = positions.astype(F32)[..., None] * inv
    cos = jnp.cos(ang)[:, :, None, :]
    sin = jnp.sin(ang)[:, :, None, :]
    tf = t.astype(F32)
    t1 = tf[..., :half]
    t2 = tf[..., half:rot]
    out = jnp.concatenate([t1 * cos - t2 * sin, t2 * cos + t1 * sin, tf[..., rot:]], axis=-1)
    return out.astype(t.dtype)


def _causal_depthwise_conv(t, w, bias):
    c = t.shape[-1]
    y = lax.conv_general_dilated(
        t, w[:, None, :].astype(t.dtype), window_strides=(1,),
        padding=[(w.shape[0] - 1, 0)],
        dimension_numbers=('NWC', 'WIO', 'NWC'),
        feature_group_count=c)
    return y + bias.astype(t.dtype)


def _ssd_chunked(xh, dt, a, bmat, cmat):
    b, s, g, r, p = xh.shape
    n = bmat.shape[-1]
    nc = s // SSD_CHUNK
    x_dt = xh.astype(F32) * dt[..., None]
    da = dt * a

    def chunks(t):
        return jnp.moveaxis(t.reshape(b, nc, SSD_CHUNK, *t.shape[2:]), 1, 0)

    tril = jnp.tril(jnp.ones((SSD_CHUNK, SSD_CHUNK), dtype=bool))
    strict = jnp.tril(jnp.ones((SSD_CHUNK, SSD_CHUNK), dtype=bool), k=-1)

    def step(state, inp):
        xc, dac, bc, cc = inp
        dat = jnp.moveaxis(dac, 1, -1)
        acum = jnp.cumsum(dat, axis=-1)
        seg = jnp.cumsum(jnp.where(strict, dat[..., :, None], 0.0), axis=-2)
        lmat = jnp.exp(jnp.where(tril, seg, -jnp.inf))
        cb = jnp.einsum('bsgn,btgn->bgst', cc, bc)
        y_diag = jnp.einsum('bgst,bgrst,btgrp->bsgrp', cb, lmat, xc)
        y_off = jnp.einsum('bsgn,bgrpn,bgrs->bsgrp', cc, state, jnp.exp(acum))
        decay = jnp.exp(acum[..., -1:] - acum)
        new_state = (state * jnp.exp(acum[..., -1])[..., None, None]
                     + jnp.einsum('btgn,bgrt,btgrp->bgrpn', bc, decay, xc))
        return new_state, y_diag + y_off

    state0 = jnp.zeros((b, g, r, p, n), F32)
    _, ys = lax.scan(step, state0, (chunks(x_dt), chunks(da),
                                    chunks(bmat.astype(F32)), chunks(cmat.astype(F32))))
    return jnp.moveaxis(ys, 0, 1).reshape(b, s, g, r, p)


def _dilated_group_attention(q, k, v, dilation, n_back):
    b, s, h, hd = q.shape
    m = s // dilation
    blk = n_back
    nb = -(-m // blk)
    mp = nb * blk

    def to_sub(t):
        t = t.reshape(b, m, dilation, h, hd)
        t = jnp.pad(t, ((0, 0), (0, mp - m), (0, 0), (0, 0), (0, 0)))
        return t.reshape(b, nb, blk, dilation, h, hd)

    def with_prev(t):
        prev = jnp.pad(t[:, :-1], ((0, 0), (1, 0), (0, 0), (0, 0), (0, 0), (0, 0)))
        return jnp.concatenate([prev, t], axis=2)

    qs = to_sub(q)
    kk = with_prev(to_sub(k))
    vv = with_prev(to_sub(v))
    scores = jnp.einsum('bnqrhd,bnkrhd->bnrhqk', qs, kk).astype(F32) * (hd ** -0.5)
    qi = jnp.arange(blk)[:, None]
    ki = jnp.arange(2 * blk)[None, :]
    dist = qi + blk - ki
    band = (dist >= 0) & (dist <= n_back)
    valid = band[None] & ((jnp.arange(nb)[:, None, None] > 0) | (ki >= blk)[None])
    scores = jnp.where(valid[None, :, None, None], scores, -jnp.inf)
    lse = jax.nn.logsumexp(scores, axis=-1)
    probs = jnp.exp(scores - lse[..., None]).astype(v.dtype)
    out = jnp.einsum('bnrhqk,bnkrhd->bnqrhd', probs, vv)
    out = out.reshape(b, mp, dilation, h, hd)[:, :m].reshape(b, s, h, hd)
    lse = lse.transpose(0, 1, 4, 2, 3).reshape(b, mp, dilation, h)[:, :m].reshape(b, s, h)
    return out, lse


def _peer(hn, w_query, sub_keys, expert_down, expert_up):
    b, s, d = hn.shape
    q = (hn @ w_query).reshape(b, s, PEER_HEADS, 2, PEER_QUERY_DIM // 2)
    sc = jnp.einsum('bshcd,hckd->bshck', q, sub_keys).astype(F32)
    v1, i1 = lax.top_k(sc[..., 0, :], PEER_TOPK)
    v2, i2 = lax.top_k(sc[..., 1, :], PEER_TOPK)
    cand = (v1[..., :, None] + v2[..., None, :]).reshape(b, s, PEER_HEADS, PEER_TOPK * PEER_TOPK)
    cidx = (i1[..., :, None] * PEER_N_KEYS + i2[..., None, :]).reshape(b, s, PEER_HEADS, PEER_TOPK * PEER_TOPK)
    top, pos = lax.top_k(cand, PEER_TOPK)
    idx = jnp.take_along_axis(cidx, pos, axis=-1)
    gate = jax.nn.softmax(top, axis=-1)
    nblk = s // PEER_BLOCK

    def blockify(t):
        return jnp.moveaxis(t.reshape(b, nblk, PEER_BLOCK, *t.shape[2:]), 1, 0)

    def one_block(args):
        hb, ib, gb = args
        u = expert_down[ib]
        act = jax.nn.gelu(jnp.einsum('bld,blhkd->blhk', hb, u), approximate=False)
        coef = (gb * act.astype(F32)).astype(hb.dtype)
        vv = expert_up[ib]
        return jnp.einsum('blhk,blhkd->bld', coef, vv)

    out = lax.map(one_block, (blockify(hn), blockify(idx), blockify(gate)))
    return jnp.moveaxis(out, 0, 1).reshape(b, s, d)


def setup_inputs(seed: int = 0) -> dict:
    key = jax.random.key(seed)
    ks = jax.random.split(key, 32)
    L = DEPTH

    def nrm(k, shape, scale):
        return jax.random.normal(k, shape, F32) * scale

    def gain(k, shape):
        return 1.0 + 0.05 * jax.random.normal(k, shape, F32)

    x = nrm(ks[0], (BATCH, SEQ, D_MODEL), 1.0)
    mem = nrm(ks[1], (BATCH, N_MEM, D_MODEL), 1.0)
    offset = jax.random.randint(ks[2], (BATCH, 1), 0, 4096, dtype=jnp.int32)
    positions = jnp.arange(SEQ, dtype=jnp.int32)[None, :] + offset
    norm_mix_w = gain(ks[3], (L, D_MODEL))
    w_in = nrm(ks[4], (L, D_MODEL, IN_PROJ_WIDTH), D_MODEL ** -0.5)
    ssd_conv_w = nrm(ks[5], (L, SSD_CONV, SSD_CONV_DIM), SSD_CONV ** -0.5)
    ssd_conv_b = nrm(ks[6], (L, SSD_CONV_DIM), 0.02)
    dt0 = jnp.exp(jax.random.uniform(ks[7], (L, SSD_HEADS), F32, math.log(1e-3), math.log(1e-1)))
    ssd_dt_bias = dt0 + jnp.log(-jnp.expm1(-dt0))
    ssd_a_log = jnp.log(jax.random.uniform(ks[8], (L, SSD_HEADS), F32, 1.0, 16.0))
    ssd_d = gain(ks[9], (L, SSD_HEADS))
    ssd_norm_w = gain(ks[10], (L, SSD_D_INNER))
    dil_q_norm_w = gain(ks[11], (L, DIL_HEAD_DIM))
    dil_k_norm_w = gain(ks[12], (L, DIL_HEAD_DIM))
    mem_norm_w = gain(ks[13], (L, D_MODEL))
    w_mem_kv = nrm(ks[14], (L, D_MODEL, 2 * MEM_WIDTH), D_MODEL ** -0.5)
    mem_q_norm_w = gain(ks[15], (L, MEM_HEAD_DIM))
    mem_k_norm_w = gain(ks[16], (L, MEM_HEAD_DIM))
    w_ssd_br = nrm(ks[17], (L, SSD_D_INNER, D_MODEL), SSD_D_INNER ** -0.5)
    w_dil_br = nrm(ks[18], (L, DIL_OUT_WIDTH, D_MODEL), DIL_OUT_WIDTH ** -0.5)
    w_mem_br = nrm(ks[19], (L, MEM_WIDTH, D_MODEL), MEM_WIDTH ** -0.5)
    w_out = nrm(ks[20], (L, D_MODEL, D_MODEL), D_MODEL ** -0.5)
    norm_ffn_w = gain(ks[21], (L, D_MODEL))
    peer_w_query = nrm(ks[22], (L, D_MODEL, PEER_HEADS * PEER_QUERY_DIM), D_MODEL ** -0.5)
    peer_sub_keys = nrm(ks[23], (L, PEER_HEADS, 2, PEER_N_KEYS, PEER_QUERY_DIM // 2),
                        (PEER_QUERY_DIM // 2) ** -0.5)
    peer_down = nrm(ks[24], (L, PEER_EXPERTS, D_MODEL), D_MODEL ** -0.5)
    peer_up = nrm(ks[25], (L, PEER_EXPERTS, D_MODEL), PEER_HEADS ** -0.5)
    return {
        'x': x, 'mem': mem, 'positions': positions,
        'norm_mix_w': norm_mix_w, 'w_in': w_in,
        'ssd_conv_w': ssd_conv_w, 'ssd_conv_b': ssd_conv_b, 'ssd_dt_bias': ssd_dt_bias,
        'ssd_a_log': ssd_a_log, 'ssd_d': ssd_d, 'ssd_norm_w': ssd_norm_w,
        'dil_q_norm_w': dil_q_norm_w, 'dil_k_norm_w': dil_k_norm_w,
        'mem_norm_w': mem_norm_w, 'w_mem_kv': w_mem_kv,
        'mem_q_norm_w': mem_q_norm_w, 'mem_k_norm_w': mem_k_norm_w,
        'w_ssd_br': w_ssd_br, 'w_dil_br': w_dil_br, 'w_mem_br': w_mem_br, 'w_out': w_out,
        'norm_ffn_w': norm_ffn_w, 'peer_w_query': peer_w_query, 'peer_sub_keys': peer_sub_keys,
        'peer_down': peer_down, 'peer_up': peer_up,
    }


def reference(x, mem, positions, norm_mix_w, w_in, ssd_conv_w, ssd_conv_b, ssd_dt_bias,
              ssd_a_log, ssd_d, ssd_norm_w, dil_q_norm_w, dil_k_norm_w, mem_norm_w, w_mem_kv,
              mem_q_norm_w, mem_k_norm_w, w_ssd_br, w_dil_br, w_mem_br, w_out, norm_ffn_w,
              peer_w_query, peer_sub_keys, peer_down, peer_up):
    b, s, _ = x.shape
    n_mem = mem.shape[1]
    h = x
    for layer in range(DEPTH):
        u = _rms_norm(h, norm_mix_w[layer])
        proj = u @ w_in[layer]
        z = proj[..., OFF_Z:OFF_XBC]
        xbc = proj[..., OFF_XBC:OFF_DT]
        dt_raw = proj[..., OFF_DT:OFF_DQ]
        dq = proj[..., OFF_DQ:OFF_DK].reshape(b, s, DIL_HEADS, DIL_HEAD_DIM)
        dk = proj[..., OFF_DK:OFF_DV].reshape(b, s, DIL_HEADS, DIL_HEAD_DIM)
        dv = proj[..., OFF_DV:OFF_MQ].reshape(b, s, DIL_HEADS, DIL_HEAD_DIM)
        mq = proj[..., OFF_MQ:OFF_GATE].reshape(b, s, MEM_HEADS, MEM_HEAD_DIM)
        gates = jax.nn.sigmoid(proj[..., OFF_GATE:].astype(F32)).reshape(b, s, N_BRANCHES, D_MODEL)

        xbc = jax.nn.silu(_causal_depthwise_conv(xbc, ssd_conv_w[layer], ssd_conv_b[layer]))
        gn = SSD_GROUPS * SSD_STATE
        xs = xbc[..., :SSD_D_INNER].reshape(b, s, SSD_GROUPS, SSD_HEADS_PER_GROUP, SSD_HEAD_DIM)
        bm = xbc[..., SSD_D_INNER:SSD_D_INNER + gn].reshape(b, s, SSD_GROUPS, SSD_STATE)
        cm = xbc[..., SSD_D_INNER + gn:].reshape(b, s, SSD_GROUPS, SSD_STATE)
        dt = jax.nn.softplus(dt_raw.astype(F32) + ssd_dt_bias[layer].astype(F32))
        dt = dt.reshape(b, s, SSD_GROUPS, SSD_HEADS_PER_GROUP)
        a = -jnp.exp(ssd_a_log[layer].astype(F32)).reshape(SSD_GROUPS, SSD_HEADS_PER_GROUP)
        y = _ssd_chunked(xs, dt, a, bm, cm)
        y = y + ssd_d[layer].astype(F32).reshape(SSD_GROUPS, SSD_HEADS_PER_GROUP)[..., None] * xs.astype(F32)
        y = y.reshape(b, s, SSD_D_INNER) * jax.nn.silu(z.astype(F32))
        yg = y.reshape(b, s, SSD_GROUPS, SSD_D_INNER // SSD_GROUPS)
        yg = yg * lax.rsqrt(jnp.mean(yg * yg, axis=-1, keepdims=True) + EPS)
        y_ssd = (yg.reshape(b, s, SSD_D_INNER) * ssd_norm_w[layer].astype(F32)).astype(h.dtype)

        dq = _partial_rope(_rms_norm(dq, dil_q_norm_w[layer]), positions)
        dk = _partial_rope(_rms_norm(dk, dil_k_norm_w[layer]), positions)
        outs = []
        lses = []
        for gi, (window, dilation) in enumerate(DIL_PAIRS):
            sl = slice(gi * DIL_HEADS_PER_GROUP, (gi + 1) * DIL_HEADS_PER_GROUP)
            o, l = _dilated_group_attention(dq[:, :, sl], dk[:, :, sl], dv[:, :, sl],
                                            dilation, window // dilation)
            outs.append(o.astype(F32))
            lses.append(l)
        wts = jax.nn.softmax(jnp.stack(lses, axis=0), axis=0)
        y_dil = jnp.sum(wts[..., None] * jnp.stack(outs, axis=0), axis=0)
        y_dil = y_dil.reshape(b, s, DIL_OUT_WIDTH).astype(h.dtype)

        mkv = _rms_norm(mem, mem_norm_w[layer]) @ w_mem_kv[layer]
        mk = mkv[..., :MEM_WIDTH].reshape(b, n_mem, MEM_HEADS, MEM_HEAD_DIM)
        mv = mkv[..., MEM_WIDTH:].reshape(b, n_mem, MEM_HEADS, MEM_HEAD_DIM)
        mqn = _rms_norm(mq, mem_q_norm_w[layer])
        mk = _rms_norm(mk, mem_k_norm_w[layer])
        msc = jnp.einsum('bshd,bmhd->bhsm', mqn, mk).astype(F32) * (MEM_HEAD_DIM ** -0.5)
        mp = jax.nn.softmax(msc, axis=-1).astype(mv.dtype)
        y_mem = jnp.einsum('bhsm,bmhd->bshd', mp, mv).reshape(b, s, MEM_WIDTH)

        merged = (gates[:, :, 0] * (y_ssd @ w_ssd_br[layer]).astype(F32)
                  + gates[:, :, 1] * (y_dil @ w_dil_br[layer]).astype(F32)
                  + gates[:, :, 2] * (y_mem @ w_mem_br[layer]).astype(F32))
        h = h + merged.astype(h.dtype) @ w_out[layer]

        hn = _rms_norm(h, norm_ffn_w[layer])
        h = h + _peer(hn, peer_w_query[layer], peer_sub_keys[layer], peer_down[layer], peer_up[layer])
    return h
```

```cpp
#include <hip/hip_runtime.h>
#include <cstdio>
#include <cstdint>

#ifndef MK_N_LAUNCHES
#define MK_N_LAUNCHES 1
#endif

#define LAS __attribute__((address_space(3)))
#define GAS __attribute__((address_space(1)))
typedef unsigned short bf16;
typedef short bf16x8 __attribute__((ext_vector_type(8)));
typedef float f32x4 __attribute__((ext_vector_type(4)));
typedef float f32x2 __attribute__((ext_vector_type(2)));
typedef unsigned u32x4 __attribute__((ext_vector_type(4)));
typedef unsigned u32x2 __attribute__((ext_vector_type(2)));

constexpr int NB = 8, SEQ = 8192, DM = 1024, T = NB * SEQ;
constexpr int HB = 4, HT = HB * SEQ;
constexpr int NMEM = 256;
constexpr int NPROJ = 6144;
constexpr int PC_Z = 0, PC_X = 1024, PC_B = 2048, PC_C = 2560, PC_DQ = 3072, PC_DK = 3840, PC_DV = 4608, PC_MQ = 5376;
constexpr int W_IN_N = 9232, OFF_DT = 3072, OFF_AFTER_DT = 3088;
constexpr int NGATE = 3072;
constexpr int YC = 2048;
constexpr int PEER_H = 8, PEER_K = 16, PEER_NK = 128, PEER_Q = 2048;
constexpr float EPS = 1e-6f;

constexpr size_t MiB = 1u << 20;
constexpr size_t WS_CTL = 0, CTL_ZERO_BYTES = 65536;
constexpr size_t WS_WALLT = 1 * MiB;
constexpr size_t WS_WMKVT = 19 * MiB;
constexpr size_t WS_WCATT = 22 * MiB;
constexpr size_t WS_WOUTT = 26 * MiB;
constexpr size_t WS_WQT = 28 * MiB;
constexpr size_t WS_SUBK = 32 * MiB;
constexpr size_t WS_PD = 33 * MiB;
constexpr size_t WS_PU = 65 * MiB;
constexpr size_t WS_DT = 97 * MiB;
constexpr size_t WS_MEMN = 101 * MiB;
constexpr size_t WS_MKV = 105 * MiB;
constexpr size_t WS_ACT1 = 112 * MiB;
constexpr size_t WS_BIG = 240 * MiB;
constexpr size_t WS_END = 624 * MiB;

constexpr int RING_BYTES = 131072;
constexpr int LDSCTL_OFF = 143360;
constexpr int LDS_BYTES = 147456;
constexpr int NWAVES = 8, NTHR = 512;

__device__ __forceinline__ float bf2f(unsigned short b) { return __builtin_bit_cast(float, (unsigned)b << 16); }
__device__ __forceinline__ float bflo(unsigned w) { return __builtin_bit_cast(float, w << 16); }
__device__ __forceinline__ float bfhi(unsigned w) { return __builtin_bit_cast(float, w & 0xffff0000u); }
__device__ __forceinline__ unsigned f2bf(float f) { unsigned u = __builtin_bit_cast(unsigned, f); return (u + 0x7fffu + ((u >> 16) & 1u)) >> 16; }
__device__ __forceinline__ unsigned pk2(float lo, float hi) { return f2bf(lo) | (f2bf(hi) << 16); }
__device__ __forceinline__ float wave_sum(float v) {
#pragma unroll
    for (int o = 1; o < 64; o <<= 1) v += __shfl_xor(v, o);
    return v;
}
__device__ __forceinline__ float wave_max(float v) {
#pragma unroll
    for (int o = 1; o < 64; o <<= 1) v = fmaxf(v, __shfl_xor(v, o));
    return v;
}
__device__ __forceinline__ float sigmoidf_(float x) { return 1.0f / (1.0f + __expf(-x)); }
#define LDS_WAIT() asm volatile("s_waitcnt lgkmcnt(0)" ::: "memory")
#define VM_WAIT() asm volatile("s_waitcnt vmcnt(0)" ::: "memory")

#define XB_TMO      128
#define XB_XCNT(j)  (256  + 64 * (j))
#define XB_XSUB(j)  (1280 + 64 * (j))
#define XB_XGEN(j)  (2304 + 64 * (j))
#define XB_TOP      3328
#define XB_TOPGEN   3392
#define XCD_BAR_WORDS 3456
#define XB_SPIN_CAP (1u << 18)
__device__ __forceinline__ unsigned xb_ld(unsigned* p)              { return __hip_atomic_load(p, __ATOMIC_RELAXED, __HIP_MEMORY_SCOPE_AGENT); }
__device__ __forceinline__ unsigned xb_add(unsigned* p, unsigned v) { return __hip_atomic_fetch_add(p, v, __ATOMIC_RELAXED, __HIP_MEMORY_SCOPE_AGENT); }
__device__ __forceinline__ unsigned xb_xcc_id() { return (unsigned)__builtin_amdgcn_s_getreg((3 << 11) | 20) & 0xFu; }
#define XB_SPIN(cond, bar) do { unsigned _sp = 0; while (cond) { __builtin_amdgcn_s_sleep(1); \
    if ((++_sp & 255u) == 0u) { if (xb_ld(&(bar)[XB_TMO])) break; if (_sp > XB_SPIN_CAP) { atomicAdd(&(bar)[XB_TMO], 1u); break; } } } } while (0)
struct XcdBarrier { unsigned* bar; unsigned x; volatile LAS unsigned* st; };
__device__ __forceinline__ XcdBarrier xcd_barrier_post(unsigned* bar, volatile LAS unsigned* st) {
    XcdBarrier b; b.bar = bar; b.x = xb_xcc_id(); b.st = st;
    if (threadIdx.x == 0) (void)xb_add(&bar[XB_XCNT(b.x)], 1u);
    return b;
}
__device__ __forceinline__ void xcd_barrier_complete(unsigned* bar, unsigned x, unsigned& nloc, unsigned& nx) {
    const unsigned G = gridDim.x * gridDim.y * gridDim.z;
    unsigned sum, cnt, mine, sp = 0u;
    for (;;) {
        sum = 0u; cnt = 0u; mine = 0u;
#pragma unroll
        for (unsigned j = 0; j < 16; ++j) { const unsigned c = xb_ld(&bar[XB_XCNT(j)]); sum += c; cnt += (c > 0u) ? 1u : 0u; mine = (j == x) ? c : mine; }
        if (sum == G) break;
        __builtin_amdgcn_s_sleep(1);
        if ((++sp & 255u) == 0u) { if (xb_ld(&bar[XB_TMO])) break; if (sp > XB_SPIN_CAP) { atomicAdd(&bar[XB_TMO], 1u); break; } }
    }
    nloc = mine > 0u ? mine : 1u; nx = cnt > 0u ? cnt : 1u;
}
__device__ __forceinline__ void xcd_barrier(const XcdBarrier& b) {
    asm volatile("s_waitcnt vmcnt(0)" ::: "memory");
    __syncthreads();
    if (threadIdx.x == 0) {
        unsigned* bar = b.bar;
        __builtin_amdgcn_s_waitcnt(0);
        unsigned nloc = b.st[0], nx = b.st[1];
        if (nloc == 0u) { xcd_barrier_complete(bar, b.x, nloc, nx); b.st[0] = nloc; b.st[1] = nx; }
        const unsigned old = xb_add(&bar[XB_XSUB(b.x)], 1u);
        const unsigned gen = old / nloc;
        if (old + 1u == (gen + 1u) * nloc) {
            __builtin_amdgcn_fence(__ATOMIC_RELEASE, "agent");
            asm volatile("s_waitcnt vmcnt(0)" ::: "memory");
            const unsigned og = xb_add(&bar[XB_TOP], 1u);
            const unsigned tg = og / nx;
            if (og + 1u == (tg + 1u) * nx) xb_add(&bar[XB_TOPGEN], 1u);
            else XB_SPIN(xb_ld(&bar[XB_TOPGEN]) == tg, bar);
            __builtin_amdgcn_fence(__ATOMIC_ACQUIRE, "agent");
            xb_add(&bar[XB_XGEN(b.x)], 1u);
            asm volatile("s_waitcnt vmcnt(0)" ::: "memory");
        } else {
            XB_SPIN(xb_ld(&bar[XB_XGEN(b.x)]) == gen, bar);
            __builtin_amdgcn_fence(__ATOMIC_ACQUIRE, "agent");
            asm volatile("s_waitcnt vmcnt(0)" ::: "memory");
        }
    }
    __syncthreads();
}

namespace pg8 {
constexpr int BM = 256, BK = 64, HALF = 128, HTB = HALF * BK * 2, STAGE_BYTES = 8 * HTB, NXCD = 8, WGM = 8;
__host__ __device__ __forceinline__ int lds_byte(int r, int c) { const int st = (r >> 4) * 2 + (c >> 5), rr = r & 15, cc = c & 31, ob = rr * 64 + cc * 2; return st * 1024 + (ob ^ (((ob >> 9) & 1) << 5)); }
__host__ __device__ __forceinline__ void stage_rc(int b, int& R, int& C) { const int st = b / 1024, sb = b % 1024, swz = sb ^ (((sb >> 9) & 1) << 5); R = (st >> 1) * 16 + swz / 64; C = (st & 1) * 32 + (swz % 64) / 2; }
__host__ __device__ __forceinline__ int perm32(int rho) { const int n = rho >> 4, i = rho & 15; return 8 * (i >> 2) + 4 * n + (i & 3); }
struct Unit { int pm, pn; };
struct Gemm { const bf16* A; const bf16* Bt; int M, N, K, lda, ldb; };
struct StaticOrder {
    int nM, nN, nwg, G, c;
    __host__ __device__ void init(int M, int N, int G_, int c_) { nM = M / BM; nN = N / BM; nwg = nM * nN; G = G_; c = c_; }
    __host__ __device__ bool next(int i, Unit& u) const {
        const long L = (long)i * G + c; if (L >= nwg) return false;
        int wgid = (int)L; { const int q = nwg / NXCD, r = nwg % NXCD, xcd = wgid % NXCD, off = wgid / NXCD; wgid = (xcd < r ? xcd * (q + 1) : r * (q + 1) + (xcd - r) * q) + off; }
        const int nig = WGM * nN, gid = wgid / nig, fm = gid * WGM, gsz = (nM - fm) < WGM ? (nM - fm) : WGM;
        u.pm = fm + ((wgid % nig) % gsz); u.pn = (wgid % nig) / gsz; return true;
    }
    __device__ __forceinline__ void a_ready(const Unit&) const {}
    __device__ __forceinline__ void done(const Unit&) const {}
};
__device__ __forceinline__ unsigned cvt_pk_bf16(float lo, float hi) { unsigned r; asm volatile("v_cvt_pk_bf16_f32 %0, %1, %2" : "=v"(r) : "v"(lo), "v"(hi)); return r; }

template <int ACT> struct EpiBf16 {
    static constexpr bool PERM = true, AFTER_DRAIN = false;
    bf16* O; int ldc;
    __device__ __forceinline__ void operator()(const f32x4 (&acc)[2][2][4][2], const Unit& u, int wr, int wc, int fr, int fq) const {
        const int row0 = u.pm * BM + wr * 64 + fr; const int col0 = u.pn * BM + wc * 32 + 8 * fq;
#pragma unroll
        for (int ai = 0; ai < 2; ++ai)
#pragma unroll
            for (int m = 0; m < 4; ++m) { bf16* rowp = O + (size_t)(row0 + ai * HALF + m * 16) * ldc + col0;
#pragma unroll
                for (int bj = 0; bj < 2; ++bj) { f32x4 v0 = acc[ai][bj][m][0], v1 = acc[ai][bj][m][1];
                    if (ACT == 1) {
#pragma unroll
                        for (int j = 0; j < 4; ++j) { v0[j] = sigmoidf_(v0[j]); v1[j] = sigmoidf_(v1[j]); } }
                    u32x4 w; w.x = cvt_pk_bf16(v0[0], v0[1]); w.y = cvt_pk_bf16(v0[2], v0[3]); w.z = cvt_pk_bf16(v1[0], v1[1]); w.w = cvt_pk_bf16(v1[2], v1[3]);
                    *(u32x4*)(rowp + bj * HALF) = w; } }
    }
};
template <bool ACCUM> struct EpiBranch {
    static constexpr bool PERM = true, AFTER_DRAIN = false;
    bf16* O; int ldc; const bf16* Gt; int ldg; int gcol0;
    __device__ __forceinline__ void operator()(const f32x4 (&acc)[2][2][4][2], const Unit& u, int wr, int wc, int fr, int fq) const {
        const int row0 = u.pm * BM + wr * 64 + fr; const int col0 = u.pn * BM + wc * 32 + 8 * fq;
#pragma unroll
        for (int ai = 0; ai < 2; ++ai)
#pragma unroll
            for (int m = 0; m < 4; ++m) { const size_t r = (size_t)(row0 + ai * HALF + m * 16); bf16* rowp = O + r * ldc + col0; const bf16* gp = Gt + r * ldg + gcol0 + col0;
#pragma unroll
                for (int bj = 0; bj < 2; ++bj) { const f32x4 v0 = acc[ai][bj][m][0], v1 = acc[ai][bj][m][1];
                    const u32x4 g = *(const u32x4*)(gp + bj * HALF);
                    float o[8];
                    o[0] = v0[0] * bflo(g.x); o[1] = v0[1] * bfhi(g.x); o[2] = v0[2] * bflo(g.y); o[3] = v0[3] * bfhi(g.y);
                    o[4] = v1[0] * bflo(g.z); o[5] = v1[1] * bfhi(g.z); o[6] = v1[2] * bflo(g.w); o[7] = v1[3] * bfhi(g.w);
                    if (ACCUM) { const u32x4 p = *(const u32x4*)(rowp + bj * HALF);
                        o[0] += bflo(p.x); o[1] += bfhi(p.x); o[2] += bflo(p.y); o[3] += bfhi(p.y); o[4] += bflo(p.z); o[5] += bfhi(p.z); o[6] += bflo(p.w); o[7] += bfhi(p.w); }
                    u32x4 w; w.x = cvt_pk_bf16(o[0], o[1]); w.y = cvt_pk_bf16(o[2], o[3]); w.z = cvt_pk_bf16(o[4], o[5]); w.w = cvt_pk_bf16(o[6], o[7]);
                    *(u32x4*)(rowp + bj * HALF) = w; } }
    }
};
struct EpiResid {
    static constexpr bool PERM = false, AFTER_DRAIN = false;
    float* C; int ldc; const float* R;
    __device__ __forceinline__ void operator()(const f32x4 (&acc)[2][2][4][2], const Unit& u, int wr, int wc, int fr, int fq) const {
        const int row0 = u.pm * BM + wr * 64 + fr, col0 = u.pn * BM + wc * 32 + 4 * fq;
#pragma unroll
        for (int ai = 0; ai < 2; ++ai)
#pragma unroll
            for (int m = 0; m < 4; ++m) { const size_t off = (size_t)(row0 + ai * HALF + m * 16) * ldc + col0;
#pragma unroll
                for (int bj = 0; bj < 2; ++bj)
#pragma unroll
                    for (int n = 0; n < 2; ++n) { const f32x4 r = *(const f32x4*)(R + off + bj * HALF + n * 16); *(f32x4*)(C + off + bj * HALF + n * 16) = acc[ai][bj][m][n] + r; } }
    }
};

template <class Epi, class Sched>
__device__ __forceinline__ void gemm_phase(LAS unsigned char* lds, const Gemm g, const Sched& S, const Epi& E) {
    const int tid = threadIdx.x, wid = __builtin_amdgcn_readfirstlane(tid >> 6), lane = tid & 63, wr = wid >> 2, wc = wid & 3, fr = lane & 15, fq = lane >> 4;
    const int K = g.K, nt = K / BK;
    unsigned voffA[2], voffB[2];
#pragma unroll
    for (int i = 0; i < 2; ++i) { int R, C; stage_rc(tid * 16 + i * 8192, R, C); const int Rb = Epi::PERM ? ((R & ~31) + perm32(R & 31)) : R;
        voffA[i] = (unsigned)(R * g.lda + C) * 2u; voffB[i] = (unsigned)(Rb * g.ldb + C) * 2u; }
    const size_t kstep = (size_t)(BK * 2);
    const size_t hsA = (size_t)HALF * g.lda * 2, hsB = (size_t)HALF * g.ldb * 2;
    const size_t tsA = 2 * hsA, tsB = 2 * hsB;
    const unsigned ldsw = (unsigned)wid * 1024u;
    const int aoff = lds_byte(wr * 64 + fr, fq * 8), boff = lds_byte(wc * 32 + fr, fq * 8);
#define PG8_SA(b, h) (((b) * 2 + (h)) * HTB)
#define PG8_SB(b, h) ((4 + (b) * 2 + (h)) * HTB)
#define PG8_STAGE(bufoff, gbase, voff) do { _Pragma("unroll") for (int _i = 0; _i < 2; ++_i) \
        __builtin_amdgcn_global_load_lds((const unsigned*)((const char*)(gbase) + (voff)[_i]), (LAS unsigned*)(lds + (bufoff) + ldsw + _i * 8192), 16, 0, 0); } while (0)
#define PG8_LDA(dst, b, h) do { _Pragma("unroll") for (int m = 0; m < 4; ++m) _Pragma("unroll") for (int k = 0; k < 2; ++k) dst[m][k] = *(const LAS bf16x8*)(lds + PG8_SA(b, h) + aoff + m * 2048 + k * 1024); } while (0)
#define PG8_LDB(dst, b, h) do { _Pragma("unroll") for (int n = 0; n < 2; ++n) _Pragma("unroll") for (int k = 0; k < 2; ++k) dst[n][k] = *(const LAS bf16x8*)(lds + PG8_SB(b, h) + boff + n * 2048 + k * 1024); } while (0)
#define PG8_MMA(ai, bj, At, Bt) do { __builtin_amdgcn_s_setprio(1); _Pragma("unroll") for (int m = 0; m < 4; ++m) _Pragma("unroll") for (int n = 0; n < 2; ++n) _Pragma("unroll") for (int k = 0; k < 2; ++k) \
        acc[ai][bj][m][n] = __builtin_amdgcn_mfma_f32_16x16x32_bf16(Bt[n][k], At[m][k], acc[ai][bj][m][n], 0, 0, 0); __builtin_amdgcn_s_setprio(0); } while (0)
#define PG8_WAIT_V(n) asm volatile("s_waitcnt vmcnt(" #n ")" ::: "memory")
#define PG8_WAIT_L(n) asm volatile("s_waitcnt lgkmcnt(" #n ")" ::: "memory")
#define PG8_BAR __builtin_amdgcn_s_barrier()
#define PG8_SCHED __builtin_amdgcn_sched_barrier(0)
    Unit cur, nxt; int ui = 0;
    if (!S.next(0, cur)) return;
    f32x4 acc[2][2][4][2];
#pragma unroll
    for (int a = 0; a < 2; ++a)
#pragma unroll
        for (int b = 0; b < 2; ++b)
#pragma unroll
            for (int m = 0; m < 4; ++m)
#pragma unroll
                for (int n = 0; n < 2; ++n) acc[a][b][m][n] = (f32x4){0.f, 0.f, 0.f, 0.f};
    bf16x8 At[4][2], B0[2][2], B1[2][2];
    const char* cA = (const char*)g.A + (size_t)cur.pm * tsA; const char* cB = (const char*)g.Bt + (size_t)cur.pn * tsB;
    S.a_ready(cur);
    PG8_STAGE(PG8_SB(0, 0), cB, voffB); PG8_STAGE(PG8_SA(0, 0), cA, voffA); PG8_STAGE(PG8_SB(0, 1), cB + hsB, voffB); PG8_STAGE(PG8_SA(0, 1), cA + hsA, voffA);
    if (wr == 1) PG8_BAR;
    PG8_WAIT_V(4); PG8_BAR;
    PG8_STAGE(PG8_SB(1, 0), cB + kstep, voffB); PG8_STAGE(PG8_SA(1, 0), cA + kstep, voffA); PG8_STAGE(PG8_SB(1, 1), cB + hsB + kstep, voffB);
    PG8_WAIT_V(6); PG8_BAR;
    for (;;) {
        const bool has_next = S.next(ui + 1, nxt);
        const char* nA = has_next ? (const char*)g.A + (size_t)nxt.pm * tsA : cA; const char* nB = has_next ? (const char*)g.Bt + (size_t)nxt.pn * tsB : cB;
        for (int t = 0; t < nt; t += 2) {
            const bool last = (t == nt - 2);
            const char* a1 = cA + (size_t)(t + 1) * kstep;
            const char* a2 = last ? nA : cA + (size_t)(t + 2) * kstep; const char* b2 = last ? nB : cB + (size_t)(t + 2) * kstep;
            const char* a3 = a2 + kstep; const char* b3 = b2 + kstep;
            if (last && has_next) S.a_ready(nxt);
            PG8_LDB(B0, 0, 0); PG8_SCHED; PG8_LDA(At, 0, 0); PG8_STAGE(PG8_SA(1, 1), a1 + hsA, voffA);
            PG8_WAIT_L(8); PG8_BAR; PG8_WAIT_L(0); PG8_MMA(0, 0, At, B0); PG8_BAR; PG8_SCHED;
            PG8_LDB(B1, 0, 1); PG8_STAGE(PG8_SB(0, 0), b2, voffB);
            PG8_BAR; PG8_WAIT_L(0); PG8_MMA(0, 1, At, B1); PG8_BAR;
            PG8_LDA(At, 0, 1); PG8_STAGE(PG8_SA(0, 0), a2, voffA);
            PG8_BAR; PG8_WAIT_L(0); PG8_MMA(1, 0, At, B0); PG8_BAR; PG8_SCHED;
            PG8_STAGE(PG8_SB(0, 1), b2 + hsB, voffB);
            PG8_WAIT_V(6); PG8_BAR; PG8_MMA(1, 1, At, B1); PG8_BAR;
            PG8_LDB(B0, 1, 0); PG8_SCHED; PG8_LDA(At, 1, 0); PG8_STAGE(PG8_SA(0, 1), a2 + hsA, voffA);
            PG8_WAIT_L(8); PG8_BAR; PG8_WAIT_L(0); PG8_MMA(0, 0, At, B0); PG8_BAR; PG8_SCHED;
            PG8_LDB(B1, 1, 1); PG8_STAGE(PG8_SB(1, 0), b3, voffB);
            PG8_BAR; PG8_WAIT_L(0); PG8_MMA(0, 1, At, B1); PG8_BAR;
            PG8_LDA(At, 1, 1); PG8_STAGE(PG8_SA(1, 0), a3, voffA);
            PG8_BAR; PG8_WAIT_L(0); PG8_MMA(1, 0, At, B0); PG8_BAR; PG8_SCHED;
            PG8_STAGE(PG8_SB(1, 1), b3 + hsB, voffB);
            PG8_WAIT_V(6); PG8_BAR; PG8_MMA(1, 1, At, B1); PG8_BAR;
        }
        E(acc, cur, wr, wc, fr, fq); S.done(cur);
        if (!has_next) break;
#pragma unroll
        for (int a = 0; a < 2; ++a)
#pragma unroll
            for (int b = 0; b < 2; ++b)
#pragma unroll
                for (int m = 0; m < 4; ++m)
#pragma unroll
                    for (int n = 0; n < 2; ++n) acc[a][b][m][n] = (f32x4){0.f, 0.f, 0.f, 0.f};
        cur = nxt; cA = nA; cB = nB; ++ui;
    }
    PG8_WAIT_V(0);
    if (wr == 0) PG8_BAR;
    PG8_BAR;
#undef PG8_SA
#undef PG8_SB
#undef PG8_STAGE
#undef PG8_LDA
#undef PG8_LDB
#undef PG8_MMA
#undef PG8_WAIT_V
#undef PG8_WAIT_L
#undef PG8_BAR
#undef PG8_SCHED
}
}

struct Args {
    const float* in[26]; const int* positions; float* out; unsigned char* ws; int ph_lo, ph_hi; int pad0, pad1;
};
struct Frame {
    LAS unsigned char* lds;
    int tid, lane, wave, G, bid;
    const float* in[26]; const int* positions; float* out; unsigned char* ws;
};
enum { I_X = 0, I_MEM = 1, I_POS = 2, I_NMIXW = 3, I_WIN = 4, I_CONVW = 5, I_CONVB = 6, I_DTB = 7, I_ALOG = 8, I_SSDD = 9, I_SSDNW = 10, I_DQNW = 11, I_DKNW = 12, I_MEMNW = 13,
       I_WMKV = 14, I_MQNW = 15, I_MKNW = 16, I_WSSD = 17, I_WDIL = 18, I_WMEMBR = 19, I_WOUT = 20, I_NFFNW = 21, I_WQ = 22, I_SUBK = 23, I_PD = 24, I_PU = 25 };

__device__ __forceinline__ void p0_transpose_item(const float* W, int ldw, int src_col0, bf16* WT, int ldt, int dst_row0, int dst_col0, int nblk, LAS float* scr, int item, int lane) {
    const int kb = item / nblk, nb = item % nblk, k0 = 64 * kb, n0 = 32 * nb;
#pragma unroll 8
    for (int i = 0; i < 32; ++i) { const int kk = 2 * i + (lane >> 5); scr[kk * 33 + (lane & 31)] = W[(size_t)(k0 + kk) * ldw + src_col0 + n0 + (lane & 31)]; }
    LDS_WAIT(); asm volatile("" ::: "memory");
    const int c = lane & 7;
#pragma unroll
    for (int j = 0; j < 4; ++j) { const int n = (lane >> 3) + 8 * j; const LAS float* s = scr + (8 * c) * 33 + n;
        u32x4 o; o.x = pk2(s[0 * 33], s[1 * 33]); o.y = pk2(s[2 * 33], s[3 * 33]); o.z = pk2(s[4 * 33], s[5 * 33]); o.w = pk2(s[6 * 33], s[7 * 33]);
        *(u32x4*)(WT + (size_t)(dst_row0 + n0 + n) * ldt + dst_col0 + k0 + 8 * c) = o; }
    LDS_WAIT(); asm volatile("" ::: "memory");
}
__device__ __forceinline__ void rms_row_to_bf16(const float* xrow, const float* w, bf16* orow, int lane, f32x4 (&v)[4]) {
    const f32x4* xr = (const f32x4*)xrow + lane; const f32x4* wr = (const f32x4*)w + lane;
    float s = 0.f;
#pragma unroll
    for (int j = 0; j < 4; ++j) { v[j] = xr[64 * j]; s += (v[j].x * v[j].x + v[j].y * v[j].y) + (v[j].z * v[j].z + v[j].w * v[j].w); }
    const float rstd = 1.0f / sqrtf(wave_sum(s) * (1.f / DM) + EPS);
    unsigned long long* o8 = (unsigned long long*)orow + lane;
#pragma unroll
    for (int j = 0; j < 4; ++j) { const f32x4 ww = wr[64 * j]; v[j] = v[j] * rstd * ww;
        o8[64 * j] = (unsigned long long)pk2(v[j].x, v[j].y) | ((unsigned long long)pk2(v[j].z, v[j].w) << 32); }
}
__device__ __forceinline__ void cvt_f32_bf16_stream(const float* src, bf16* dst, size_t n, size_t gtid, size_t gthreads) {
    for (size_t i = gtid * 8; i < n; i += gthreads * 8) { const f32x4 a = *(const f32x4*)(src + i), b = *(const f32x4*)(src + i + 4);
        u32x4 o; o.x = pk2(a.x, a.y); o.y = pk2(a.z, a.w); o.z = pk2(b.x, b.y); o.w = pk2(b.z, b.w); *(u32x4*)(dst + i) = o; }
}
__device__ __forceinline__ void p0_prologue(Frame& F) {
    LAS float* scr = (LAS float*)(F.lds + F.wave * 8448);
    LAS float* wdt = (LAS float*)(F.lds + 8 * 8448);
    const int gw = F.bid * NWAVES + F.wave, NGW = F.G * NWAVES;
    unsigned char* ws = F.ws;
    for (int i = F.tid; i < 1024 * 16; i += NTHR) wdt[i] = F.in[I_WIN][(size_t)(i >> 4) * W_IN_N + OFF_DT + (i & 15)];
    __syncthreads();
    constexpr int IT_A = 16 * 96, IT_B = 16 * 192, IT_MKV = 16 * 48, IT_SSD = 16 * 32, IT_DIL = 4 * 32, IT_MBR = 12 * 32, IT_OUT = 16 * 32, IT_WQ = 16 * 64;
    constexpr int NITEMS = IT_A + IT_B + IT_MKV + IT_SSD + IT_DIL + IT_MBR + IT_OUT + IT_WQ;
    bf16* WallT = (bf16*)(ws + WS_WALLT);
    for (int it = gw; it < NITEMS; it += NGW) {
        int r = it;
        if (r < IT_A) { p0_transpose_item(F.in[I_WIN], W_IN_N, 0, WallT, DM, 0, 0, 96, scr, r, F.lane); continue; } r -= IT_A;
        if (r < IT_B) { p0_transpose_item(F.in[I_WIN], W_IN_N, OFF_AFTER_DT, WallT, DM, 3072, 0, 192, scr, r, F.lane); continue; } r -= IT_B;
        if (r < IT_MKV) { p0_transpose_item(F.in[I_WMKV], 1536, 0, (bf16*)(ws + WS_WMKVT), DM, 0, 0, 48, scr, r, F.lane); continue; } r -= IT_MKV;
        if (r < IT_SSD) { p0_transpose_item(F.in[I_WSSD], DM, 0, (bf16*)(ws + WS_WCATT), YC, 0, 0, 32, scr, r, F.lane); continue; } r -= IT_SSD;
        if (r < IT_DIL) { p0_transpose_item(F.in[I_WDIL], DM, 0, (bf16*)(ws + WS_WCATT), YC, 0, 1024, 32, scr, r, F.lane); continue; } r -= IT_DIL;
        if (r < IT_MBR) { p0_transpose_item(F.in[I_WMEMBR], DM, 0, (bf16*)(ws + WS_WCATT), YC, 0, 1280, 32, scr, r, F.lane); continue; } r -= IT_MBR;
        if (r < IT_OUT) { p0_transpose_item(F.in[I_WOUT], DM, 0, (bf16*)(ws + WS_WOUTT), DM, 0, 0, 32, scr, r, F.lane); continue; } r -= IT_OUT;
        p0_transpose_item(F.in[I_WQ], PEER_Q, 0, (bf16*)(ws + WS_WQT), DM, 0, 0, 64, scr, r, F.lane);
    }
    const size_t gtid = (size_t)F.bid * NTHR + F.tid, gth = (size_t)F.G * NTHR;
    cvt_f32_bf16_stream(F.in[I_SUBK], (bf16*)(ws + WS_SUBK), (size_t)8 * 2 * 128 * 128, gtid, gth);
    cvt_f32_bf16_stream(F.in[I_PD], (bf16*)(ws + WS_PD), (size_t)16384 * 1024, gtid, gth);
    cvt_f32_bf16_stream(F.in[I_PU], (bf16*)(ws + WS_PU), (size_t)16384 * 1024, gtid, gth);
    for (int m = gw; m < NB * NMEM; m += NGW) { f32x4 v[4]; rms_row_to_bf16(F.in[I_MEM] + (size_t)m * DM, F.in[I_MEMNW], (bf16*)(ws + WS_MEMN) + (size_t)m * DM, F.lane, v); }
    float* DTp = (float*)(ws + WS_DT);
    for (int m = gw; m < T; m += NGW) {
        f32x4 v[4]; rms_row_to_bf16(F.in[I_X] + (size_t)m * DM, F.in[I_NMIXW], (bf16*)(ws + WS_ACT1) + (size_t)m * DM, F.lane, v);
        float d[16];
#pragma unroll
        for (int j = 0; j < 16; ++j) d[j] = 0.f;
#pragma unroll
        for (int j = 0; j < 4; ++j)
#pragma unroll
            for (int e = 0; e < 4; ++e) { const int k = 4 * F.lane + 256 * j + e; const float uv = v[j][e];
#pragma unroll
                for (int q = 0; q < 4; ++q) { const f32x4 w4 = *(const LAS f32x4*)(wdt + k * 16 + 4 * q); d[4 * q + 0] += uv * w4.x; d[4 * q + 1] += uv * w4.y; d[4 * q + 2] += uv * w4.z; d[4 * q + 3] += uv * w4.w; }
                __builtin_amdgcn_sched_barrier(0); }
        float mine = 0.f;
#pragma unroll
        for (int j = 0; j < 16; ++j) { const float s = wave_sum(d[j]); mine = (F.lane == j) ? s : mine; }
        if (F.lane < 16) { const float xx = mine + F.in[I_DTB][F.lane]; DTp[(size_t)m * 16 + F.lane] = (xx > 20.f) ? xx : log1pf(__expf(xx)); }
    }
}

__device__ __forceinline__ void qkprep_phase(Frame& F, int half) {
    bf16* P = (bf16*)(F.ws + WS_BIG);
    const int gw = F.bid * NWAVES + F.wave, NGW = F.G * NWAVES, lane = F.lane;
    const float wq = F.in[I_DQNW][lane], wk = F.in[I_DKNW][lane];
    const float wmq0 = F.in[I_MQNW][lane], wmq1 = F.in[I_MQNW][lane + 64], wmq2 = F.in[I_MQNW][lane + 128];
    const float inv = __expf(-logf(500000.0f) * (2.0f / 16.0f) * (float)(lane & 7));
    for (int r = gw; r < HT; r += NGW) {
        const int tok = half * HT + r;
        const int pos = F.positions[tok];
        const double rev = (double)((float)pos * inv) * 0.15915494309189535;
        const float fr = (float)(rev - floor(rev));
        const float cs = __builtin_amdgcn_cosf(fr), sn = __builtin_amdgcn_sinf(fr);
        bf16* row = P + (size_t)r * NPROJ;
#pragma unroll 4
        for (int h = 0; h < 24; ++h) {
            bf16* p = row + PC_DQ + h * 64 + lane;
            float v = bf2f(*p);
            const float ss = wave_sum(v * v);
            v = v * (1.0f / sqrtf(ss * (1.f / 64.f) + EPS)) * (h < 12 ? wq : wk);
            const float other = __shfl_xor(v, 8);
            if (lane < 8) v = v * cs - other * sn; else if (lane < 16) v = v * cs + other * sn;
            *p = (bf16)f2bf(v);
        }
#pragma unroll
        for (int h = 0; h < 4; ++h) {
            bf16* p = row + PC_MQ + h * 192 + lane;
            float v0 = bf2f(p[0]), v1 = bf2f(p[64]), v2 = bf2f(p[128]);
            const float ss = wave_sum(v0 * v0 + v1 * v1 + v2 * v2);
            const float rs = 1.0f / sqrtf(ss * (1.f / 192.f) + EPS);
            p[0] = (bf16)f2bf(v0 * rs * wmq0); p[64] = (bf16)f2bf(v1 * rs * wmq1); p[128] = (bf16)f2bf(v2 * rs * wmq2);
        }
    }
    if (half == 0) {
        bf16* MK = (bf16*)(F.ws + WS_MKV);
        const float wk0 = F.in[I_MKNW][lane], wk1 = F.in[I_MKNW][lane + 64], wk2 = F.in[I_MKNW][lane + 128];
        for (int r = gw; r < NB * NMEM * 4; r += NGW) {
            bf16* p = MK + (size_t)(r >> 2) * 1536 + (r & 3) * 192 + lane;
            float v0 = bf2f(p[0]), v1 = bf2f(p[64]), v2 = bf2f(p[128]);
            const float ss = wave_sum(v0 * v0 + v1 * v1 + v2 * v2);
            const float rs = 1.0f / sqrtf(ss * (1.f / 192.f) + EPS);
            p[0] = (bf16)f2bf(v0 * rs * wk0); p[64] = (bf16)f2bf(v1 * rs * wk1); p[128] = (bf16)f2bf(v2 * rs * wk2);
        }
    }
}

__device__ __forceinline__ void ssd_naive_phase(Frame& F, int half) {
    const bf16* P = (const bf16*)(F.ws + WS_BIG);
    bf16* Y = (bf16*)F.out;
    const float* DTp = (const float*)(F.ws + WS_DT);
    LAS float* sx = (LAS float*)F.lds;
    LAS float* sB = sx + 64 * 16;
    LAS float* sC = sB + 64 * 128;
    LAS float* sdt = sC + 64 * 128;
    LAS float* sy = sdt + 64;
    const int tid = F.tid, pl = tid >> 5, ng = tid & 31;
    const float* cw = F.in[I_CONVW]; const float* cb = F.in[I_CONVB];
    for (int chain = F.bid; chain < HB * 16 * 4; chain += F.G) {
        const int bl = chain >> 6, head = (chain >> 2) & 15, pq = chain & 3, grp = head >> 2;
        const float A = -__expf(F.in[I_ALOG][head]), Dh = F.in[I_SSDD][head];
        const size_t row0 = (size_t)bl * SEQ;
        const size_t tok0 = (size_t)half * HT + row0;
        float h0 = 0.f, h1 = 0.f, h2 = 0.f, h3 = 0.f;
        for (int t0 = 0; t0 < SEQ; t0 += 64) {
            __syncthreads();
            for (int o = tid; o < 64 * 272; o += NTHR) {
                const int tt = o / 272, cc = o % 272;
                int pcol, ccol;
                if (cc < 16) { ccol = head * 64 + pq * 16 + cc; }
                else if (cc < 144) { ccol = 1024 + grp * 128 + (cc - 16); }
                else { ccol = 1536 + grp * 128 + (cc - 144); }
                pcol = PC_X + ccol;
                const int t = t0 + tt;
                float a = cb[ccol];
#pragma unroll
                for (int k = 0; k < 4; ++k) { const int ts = t - 3 + k; if (ts >= 0) a += cw[k * 2048 + ccol] * bf2f(P[(row0 + ts) * NPROJ + pcol]); }
                a = a * sigmoidf_(a);
                if (cc < 16) sx[tt * 16 + cc] = a; else if (cc < 144) sB[tt * 128 + cc - 16] = a; else sC[tt * 128 + cc - 144] = a;
            }
            if (tid < 64) sdt[tid] = DTp[(tok0 + t0 + tid) * 16 + head];
            __syncthreads();
            for (int tt = 0; tt < 64; ++tt) {
                const float dt = sdt[tt], xv = sx[tt * 16 + pl];
                const float dA = __expf(dt * A), xdt = xv * dt;
                const f32x4 b4 = *(const LAS f32x4*)(sB + tt * 128 + 4 * ng), c4 = *(const LAS f32x4*)(sC + tt * 128 + 4 * ng);
                h0 = h0 * dA + xdt * b4.x; h1 = h1 * dA + xdt * b4.y; h2 = h2 * dA + xdt * b4.z; h3 = h3 * dA + xdt * b4.w;
                float acc = (h0 * c4.x + h1 * c4.y) + (h2 * c4.z + h3 * c4.w);
                acc += __shfl_xor(acc, 1); acc += __shfl_xor(acc, 2); acc += __shfl_xor(acc, 4); acc += __shfl_xor(acc, 8); acc += __shfl_xor(acc, 16);
                if (ng == 0) sy[tt * 16 + pl] = acc + Dh * xv;
            }
            __syncthreads();
            for (int o = tid; o < 64 * 16; o += NTHR) { const int tt = o >> 4, cc = o & 15; Y[(tok0 + t0 + tt) * YC + head * 64 + pq * 16 + cc] = (bf16)f2bf(sy[o]); }
        }
    }
}

__device__ __forceinline__ void gatenorm_phase(Frame& F, int half) {
    const bf16* P = (const bf16*)(F.ws + WS_BIG);
    bf16* Y = (bf16*)F.out;
    const int gw = F.bid * NWAVES + F.wave, NGW = F.G * NWAVES, lane = F.lane;
    const float* nw = F.in[I_SSDNW];
    for (int r = gw; r < HT; r += NGW) {
        const size_t tok = (size_t)half * HT + r;
        bf16* yp = Y + tok * YC + lane * 16; const bf16* zp = P + (size_t)r * NPROJ + PC_Z + lane * 16;
        const u32x4 ya = *(const u32x4*)yp, yb = *(const u32x4*)(yp + 8), za = *(const u32x4*)zp, zb = *(const u32x4*)(zp + 8);
        float y[16], z[16];
        y[0] = bflo(ya.x); y[1] = bfhi(ya.x); y[2] = bflo(ya.y); y[3] = bfhi(ya.y); y[4] = bflo(ya.z); y[5] = bfhi(ya.z); y[6] = bflo(ya.w); y[7] = bfhi(ya.w);
        y[8] = bflo(yb.x); y[9] = bfhi(yb.x); y[10] = bflo(yb.y); y[11] = bfhi(yb.y); y[12] = bflo(yb.z); y[13] = bfhi(yb.z); y[14] = bflo(yb.w); y[15] = bfhi(yb.w);
        z[0] = bflo(za.x); z[1] = bfhi(za.x); z[2] = bflo(za.y); z[3] = bfhi(za.y); z[4] = bflo(za.z); z[5] = bfhi(za.z); z[6] = bflo(za.w); z[7] = bfhi(za.w);
        z[8] = bflo(zb.x); z[9] = bfhi(zb.x); z[10] = bflo(zb.y); z[11] = bfhi(zb.y); z[12] = bflo(zb.z); z[13] = bfhi(zb.z); z[14] = bflo(zb.w); z[15] = bfhi(zb.w);
        float ss = 0.f;
#pragma unroll
        for (int j = 0; j < 16; ++j) { y[j] = y[j] * z[j] * sigmoidf_(z[j]); ss += y[j] * y[j]; }
        ss += __shfl_xor(ss, 1); ss += __shfl_xor(ss, 2); ss += __shfl_xor(ss, 4); ss += __shfl_xor(ss, 8);
        const float rs = 1.0f / sqrtf(ss * (1.f / 256.f) + EPS);
        const f32x4* w4 = (const f32x4*)(nw + lane * 16);
        u32x4 oa, ob; f32x4 w;
        w = w4[0]; oa.x = pk2(y[0] * rs * w.x, y[1] * rs * w.y); oa.y = pk2(y[2] * rs * w.z, y[3] * rs * w.w);
        w = w4[1]; oa.z = pk2(y[4] * rs * w.x, y[5] * rs * w.y); oa.w = pk2(y[6] * rs * w.z, y[7] * rs * w.w);
        w = w4[2]; ob.x = pk2(y[8] * rs * w.x, y[9] * rs * w.y); ob.y = pk2(y[10] * rs * w.z, y[11] * rs * w.w);
        w = w4[3]; ob.z = pk2(y[12] * rs * w.x, y[13] * rs * w.y); ob.w = pk2(y[14] * rs * w.z, y[15] * rs * w.w);
        *(u32x4*)yp = oa; *(u32x4*)(yp + 8) = ob;
    }
}

__device__ __forceinline__ void dilattn_naive_phase(Frame& F, int half) {
    const bf16* P = (const bf16*)(F.ws + WS_BIG);
    bf16* Y = (bf16*)F.out;
    const int gw = F.bid * NWAVES + F.wave, NGW = F.G * NWAVES, lane = F.lane;
    for (int it = gw; it < HT * 4; it += NGW) {
        const int r = it >> 2, hh = it & 3;
        const int s = r & (SEQ - 1);
        const size_t rb = (size_t)(r - s);
        float M = -1e30f, L = 0.f, O = 0.f;
#pragma unroll 1
        for (int g = 0; g < 3; ++g) {
            const int head = 4 * g + hh, dil = (g == 0) ? 1 : (g == 1 ? 4 : 16);
            const bf16* qp = P + (size_t)r * NPROJ + PC_DQ + head * 64;
            u32x4 q[8];
#pragma unroll
            for (int j = 0; j < 8; ++j) q[j] = *(const u32x4*)(qp + 8 * j);
            float sc[3];
#pragma unroll
            for (int c = 0; c < 3; ++c) {
                const int j = lane + 64 * c; const int ps = s - j * dil;
                float a = -1e30f;
                if (j <= 128 && ps >= 0) {
                    const bf16* kp = P + (rb + ps) * NPROJ + PC_DK + head * 64;
                    a = 0.f;
#pragma unroll
                    for (int jj = 0; jj < 8; ++jj) { const u32x4 kk = *(const u32x4*)(kp + 8 * jj);
                        a += bflo(q[jj].x) * bflo(kk.x) + bfhi(q[jj].x) * bfhi(kk.x) + bflo(q[jj].y) * bflo(kk.y) + bfhi(q[jj].y) * bfhi(kk.y)
                           + bflo(q[jj].z) * bflo(kk.z) + bfhi(q[jj].z) * bfhi(kk.z) + bflo(q[jj].w) * bflo(kk.w) + bfhi(q[jj].w) * bfhi(kk.w); }
                    a *= 0.125f;
                }
                sc[c] = a;
            }
            const float m = wave_max(fmaxf(fmaxf(sc[0], sc[1]), sc[2]));
            float p0 = (sc[0] > -1e29f) ? __expf(sc[0] - m) : 0.f, p1 = (sc[1] > -1e29f) ? __expf(sc[1] - m) : 0.f, p2 = (sc[2] > -1e29f) ? __expf(sc[2] - m) : 0.f;
            const float l = wave_sum(p0 + p1 + p2);
            float o = 0.f;
            const int nk = min(128, s / dil) + 1;
            const bf16* vbase = P + PC_DV + head * 64 + lane;
            for (int j = 0; j < nk; ++j) {
                const float pj = __shfl(j < 64 ? p0 : (j < 128 ? p1 : p2), j & 63);
                o += pj * bf2f(vbase[(rb + s - j * dil) * NPROJ]);
            }
            const float Mn = fmaxf(M, m), f0 = __expf(M - Mn), f1 = __expf(m - Mn);
            O = O * f0 + o * f1; L = L * f0 + l * f1; M = Mn;
        }
        Y[((size_t)half * HT + r) * YC + 1024 + hh * 64 + lane] = (bf16)f2bf(O / L);
    }
}

__device__ __forceinline__ void memattn_naive_phase(Frame& F, int half) {
    const bf16* P = (const bf16*)(F.ws + WS_BIG);
    const bf16* MKV = (const bf16*)(F.ws + WS_MKV);
    bf16* Y = (bf16*)F.out;
    LAS float* sq = (LAS float*)(F.lds) + F.wave * 192;
    const int gw = F.bid * NWAVES + F.wave, NGW = F.G * NWAVES, lane = F.lane;
    for (int it = gw; it < HT * 4; it += NGW) {
        const int r = it >> 2, head = it & 3;
        const int b = half * HB + (r >> 13);
        const bf16* qp = P + (size_t)r * NPROJ + PC_MQ + head * 192;
        sq[lane] = bf2f(qp[lane]); sq[lane + 64] = bf2f(qp[lane + 64]); sq[lane + 128] = bf2f(qp[lane + 128]);
        LDS_WAIT(); __builtin_amdgcn_wave_barrier();
        float sc[4];
#pragma unroll
        for (int c = 0; c < 4; ++c) {
            const bf16* kp = MKV + (size_t)(b * NMEM + lane + 64 * c) * 1536 + head * 192;
            float a = 0.f;
#pragma unroll 4
            for (int jj = 0; jj < 24; ++jj) { const u32x4 kk = *(const u32x4*)(kp + 8 * jj); const f32x4 qa = *(const LAS f32x4*)(sq + 8 * jj), qb = *(const LAS f32x4*)(sq + 8 * jj + 4);
                a += qa.x * bflo(kk.x) + qa.y * bfhi(kk.x) + qa.z * bflo(kk.y) + qa.w * bfhi(kk.y) + qb.x * bflo(kk.z) + qb.y * bfhi(kk.z) + qb.z * bflo(kk.w) + qb.w * bfhi(kk.w); }
            sc[c] = a * 0.07216878364870323f;
        }
        const float m = wave_max(fmaxf(fmaxf(sc[0], sc[1]), fmaxf(sc[2], sc[3])));
        float p[4];
#pragma unroll
        for (int c = 0; c < 4; ++c) p[c] = __expf(sc[c] - m);
        const float l = wave_sum((p[0] + p[1]) + (p[2] + p[3]));
        float o0 = 0.f, o1 = 0.f, o2 = 0.f;
        const bf16* vb = MKV + (size_t)(b * NMEM) * 1536 + 768 + head * 192 + lane;
#pragma unroll
        for (int c = 0; c < 4; ++c)
#pragma unroll 8
            for (int j = 0; j < 64; ++j) { const float pj = __shfl(p[c], j); const bf16* vp = vb + (size_t)(j + 64 * c) * 1536;
                o0 += pj * bf2f(vp[0]); o1 += pj * bf2f(vp[64]); o2 += pj * bf2f(vp[128]); }
        const float il = 1.0f / l;
        bf16* yp = Y + ((size_t)half * HT + r) * YC + 1280 + head * 192 + lane;
        yp[0] = (bf16)f2bf(o0 * il); yp[64] = (bf16)f2bf(o1 * il); yp[128] = (bf16)f2bf(o2 * il);
        __builtin_amdgcn_wave_barrier();
    }
}

__device__ __forceinline__ void hn_phase(Frame& F) {
    const int gw = F.bid * NWAVES + F.wave, NGW = F.G * NWAVES;
    for (int m = gw; m < T; m += NGW) { f32x4 v[4]; rms_row_to_bf16(F.out + (size_t)m * DM, F.in[I_NFFNW], (bf16*)(F.ws + WS_ACT1) + (size_t)m * DM, F.lane, v); }
}

__device__ __forceinline__ float gelu_erf(float x) { return 0.5f * x * (1.0f + erff(x * 0.70710678118654752f)); }
__device__ __forceinline__ void peer_naive_phase(Frame& F) {
    const bf16* Q = (const bf16*)(F.ws + WS_BIG);
    const bf16* SK = (const bf16*)(F.ws + WS_SUBK);
    const bf16* PD = (const bf16*)(F.ws + WS_PD); const bf16* PU = (const bf16*)(F.ws + WS_PU);
    const bf16* HN = (const bf16*)(F.ws + WS_ACT1);
    LAS float* sq = (LAS float*)F.lds;
    LAS float* ssc = sq + 16 * 256;
    LAS float* stv = ssc + 16 * 256;
    LAS int* sti = (LAS int*)(stv + 16 * 32);
    LAS int* sidx = sti + 16 * 32;
    LAS float* sgate = (LAS float*)(sidx + 16 * 128);
    const int tid = F.tid, lane = F.lane, wave = F.wave;
    for (int tile = F.bid; tile < T / 16; tile += F.G) {
        const size_t tok0 = (size_t)tile * 16;
#pragma unroll 1
        for (int h = 0; h < PEER_H; ++h) {
            __syncthreads();
            for (int i = tid; i < 16 * 256; i += NTHR) sq[i] = bf2f(Q[(tok0 + (i >> 8)) * PEER_Q + h * 256 + (i & 255)]);
            __syncthreads();
            {
                const int c = tid >> 8, k = (tid >> 1) & 127, th = tid & 1;
                const bf16* kp = SK + ((size_t)(h * 2 + c) * 128 + k) * 128;
                float a[8];
#pragma unroll
                for (int j = 0; j < 8; ++j) a[j] = 0.f;
#pragma unroll 2
                for (int d8 = 0; d8 < 16; ++d8) { const u32x4 kk = *(const u32x4*)(kp + 8 * d8);
                    const float k0 = bflo(kk.x), k1 = bfhi(kk.x), k2 = bflo(kk.y), k3 = bfhi(kk.y), k4 = bflo(kk.z), k5 = bfhi(kk.z), k6 = bflo(kk.w), k7 = bfhi(kk.w);
#pragma unroll
                    for (int j = 0; j < 8; ++j) { const LAS float* qq = sq + (th * 8 + j) * 256 + c * 128 + 8 * d8; const f32x4 qa = *(const LAS f32x4*)qq, qb = *(const LAS f32x4*)(qq + 4);
                        a[j] += (qa.x * k0 + qa.y * k1) + (qa.z * k2 + qa.w * k3) + (qb.x * k4 + qb.y * k5) + (qb.z * k6 + qb.w * k7); } }
#pragma unroll
                for (int j = 0; j < 8; ++j) ssc[((th * 8 + j) * 2 + c) * 128 + k] = a[j];
            }
            __syncthreads();
#pragma unroll 1
            for (int li = 0; li < 4; ++li) {
                const int list = wave * 4 + li;
                float v0 = ssc[list * 128 + lane], v1 = ssc[list * 128 + 64 + lane];
#pragma unroll 1
                for (int rnk = 0; rnk < 16; ++rnk) {
                    float bv = fmaxf(v0, v1); int bi = (v0 >= v1) ? lane : lane + 64;
#pragma unroll
                    for (int o = 1; o < 64; o <<= 1) { const float ov = __shfl_xor(bv, o); const int oi = __shfl_xor(bi, o); if (ov > bv || (ov == bv && oi < bi)) { bv = ov; bi = oi; } }
                    if (bi == lane) v0 = -3.0e38f; if (bi == lane + 64) v1 = -3.0e38f;
                    if (lane == 0) { stv[list * 16 + rnk] = bv; sti[list * 16 + rnk] = bi; }
                }
            }
            __syncthreads();
#pragma unroll 1
            for (int li = 0; li < 2; ++li) {
                const int tk = wave * 2 + li;
                float cv[4]; int ci[4];
#pragma unroll
                for (int j = 0; j < 4; ++j) { const int id = lane + 64 * j, a = id >> 4, b = id & 15; cv[j] = stv[(tk * 2 + 0) * 16 + a] + stv[(tk * 2 + 1) * 16 + b]; ci[j] = id; }
                float myv = 0.f; int myi = 0;
#pragma unroll 1
                for (int rnk = 0; rnk < 16; ++rnk) {
                    float bv = cv[0]; int bi = ci[0];
#pragma unroll
                    for (int j = 1; j < 4; ++j) if (cv[j] > bv) { bv = cv[j]; bi = ci[j]; }
#pragma unroll
                    for (int o = 1; o < 64; o <<= 1) { const float ov = __shfl_xor(bv, o); const int oi = __shfl_xor(bi, o); if (ov > bv || (ov == bv && oi < bi)) { bv = ov; bi = oi; } }
#pragma unroll
                    for (int j = 0; j < 4; ++j) if (ci[j] == bi) cv[j] = -3.0e38f;
                    if (lane == rnk) { myv = bv; myi = bi; }
                }
                const float mx = __shfl(myv, 0);
                const float e = (lane < 16) ? __expf(myv - mx) : 0.f;
                const float den = wave_sum(e);
                if (lane < 16) { const int a = myi >> 4, b = myi & 15;
                    sidx[tk * 128 + h * 16 + lane] = sti[(tk * 2 + 0) * 16 + a] * 128 + sti[(tk * 2 + 1) * 16 + b];
                    sgate[tk * 128 + h * 16 + lane] = e / den; }
            }
        }
        __syncthreads();
#pragma unroll 1
        for (int li = 0; li < 2; ++li) {
            const int tk = wave * 2 + li; const size_t tok = tok0 + tk;
            float hv[16], oacc[16];
            { const u32x4 a = *(const u32x4*)(HN + tok * DM + 8 * lane), b = *(const u32x4*)(HN + tok * DM + 512 + 8 * lane);
              hv[0] = bflo(a.x); hv[1] = bfhi(a.x); hv[2] = bflo(a.y); hv[3] = bfhi(a.y); hv[4] = bflo(a.z); hv[5] = bfhi(a.z); hv[6] = bflo(a.w); hv[7] = bfhi(a.w);
              hv[8] = bflo(b.x); hv[9] = bfhi(b.x); hv[10] = bflo(b.y); hv[11] = bfhi(b.y); hv[12] = bflo(b.z); hv[13] = bfhi(b.z); hv[14] = bflo(b.w); hv[15] = bfhi(b.w); }
#pragma unroll
            for (int j = 0; j < 16; ++j) oacc[j] = 0.f;
#pragma unroll 1
            for (int e0 = 0; e0 < 128; e0 += 4) {
                u32x4 da[4], db[4], ua[4], ub[4]; float gt[4];
#pragma unroll
                for (int j = 0; j < 4; ++j) { const int id = sidx[tk * 128 + e0 + j]; gt[j] = sgate[tk * 128 + e0 + j];
                    const bf16* dp = PD + (size_t)id * DM + 8 * lane; const bf16* up = PU + (size_t)id * DM + 8 * lane;
                    da[j] = *(const u32x4*)dp; db[j] = *(const u32x4*)(dp + 512); ua[j] = *(const u32x4*)up; ub[j] = *(const u32x4*)(up + 512); }
#pragma unroll
                for (int j = 0; j < 4; ++j) {
                    float d = (hv[0] * bflo(da[j].x) + hv[1] * bfhi(da[j].x)) + (hv[2] * bflo(da[j].y) + hv[3] * bfhi(da[j].y)) + (hv[4] * bflo(da[j].z) + hv[5] * bfhi(da[j].z)) + (hv[6] * bflo(da[j].w) + hv[7] * bfhi(da[j].w))
                            + (hv[8] * bflo(db[j].x) + hv[9] * bfhi(db[j].x)) + (hv[10] * bflo(db[j].y) + hv[11] * bfhi(db[j].y)) + (hv[12] * bflo(db[j].z) + hv[13] * bfhi(db[j].z)) + (hv[14] * bflo(db[j].w) + hv[15] * bfhi(db[j].w));
                    d = wave_sum(d);
                    const float cf = gt[j] * gelu_erf(d);
                    oacc[0] += cf * bflo(ua[j].x); oacc[1] += cf * bfhi(ua[j].x); oacc[2] += cf * bflo(ua[j].y); oacc[3] += cf * bfhi(ua[j].y);
                    oacc[4] += cf * bflo(ua[j].z); oacc[5] += cf * bfhi(ua[j].z); oacc[6] += cf * bflo(ua[j].w); oacc[7] += cf * bfhi(ua[j].w);
                    oacc[8] += cf * bflo(ub[j].x); oacc[9] += cf * bfhi(ub[j].x); oacc[10] += cf * bflo(ub[j].y); oacc[11] += cf * bfhi(ub[j].y);
                    oacc[12] += cf * bflo(ub[j].z); oacc[13] += cf * bfhi(ub[j].z); oacc[14] += cf * bflo(ub[j].w); oacc[15] += cf * bfhi(ub[j].w);
                }
            }
            float* op = F.out + tok * DM + 8 * lane;
            f32x4 r0 = *(const f32x4*)op, r1 = *(const f32x4*)(op + 4), r2 = *(const f32x4*)(op + 512), r3 = *(const f32x4*)(op + 516);
            r0.x += oacc[0]; r0.y += oacc[1]; r0.z += oacc[2]; r0.w += oacc[3]; r1.x += oacc[4]; r1.y += oacc[5]; r1.z += oacc[6]; r1.w += oacc[7];
            r2.x += oacc[8]; r2.y += oacc[9]; r2.z += oacc[10]; r2.w += oacc[11]; r3.x += oacc[12]; r3.y += oacc[13]; r3.z += oacc[14]; r3.w += oacc[15];
            *(f32x4*)op = r0; *(f32x4*)(op + 4) = r1; *(f32x4*)(op + 512) = r2; *(f32x4*)(op + 516) = r3;
        }
    }
}

constexpr int N_PHASES = 13;
__global__ void __launch_bounds__(NTHR, 2) mega_fwd(Args args) {
    extern __shared__ __attribute__((aligned(16))) unsigned char lds_raw[];
    Frame F;
    F.lds = (LAS unsigned char*)lds_raw;
    F.tid = threadIdx.x; F.lane = F.tid & 63; F.wave = __builtin_amdgcn_readfirstlane(F.tid >> 6);
    F.G = gridDim.x; F.bid = blockIdx.x;
#pragma unroll
    for (int i = 0; i < 26; ++i) F.in[i] = args.in[i];
    F.positions = args.positions; F.out = args.out; F.ws = args.ws;
    unsigned char* ws = args.ws;
    volatile LAS unsigned* ctlw = (volatile LAS unsigned*)(F.lds + LDSCTL_OFF);
    if (F.tid < 64) ctlw[F.tid] = 0u;
    __syncthreads();
    const int lo = args.ph_lo, hi = args.ph_hi;
    XcdBarrier bar; bar.bar = (unsigned*)(ws + WS_CTL); bar.x = 0; bar.st = nullptr;
    if (hi - lo > 1) bar = xcd_barrier_post((unsigned*)(ws + WS_CTL), ctlw + 8);
#define IN(k) (lo <= (k) && (k) < hi)
#define SEAM(k) do { if (IN(k) && IN((k) + 1)) xcd_barrier(bar); } while (0)
    bf16* ACT1 = (bf16*)(ws + WS_ACT1); bf16* BIG = (bf16*)(ws + WS_BIG); bf16* WallT = (bf16*)(ws + WS_WALLT);

    if (IN(0)) { p0_prologue(F); __syncthreads(); }
    SEAM(0);
    if (IN(1)) {
        { pg8::Gemm g{(const bf16*)(ws + WS_MEMN), (const bf16*)(ws + WS_WMKVT), NB * NMEM, 1536, DM, DM, DM}; pg8::StaticOrder S; S.init(g.M, g.N, F.G, F.bid);
          pg8::EpiBf16<0> E{(bf16*)(ws + WS_MKV), 1536}; pg8::gemm_phase(F.lds, g, S, E); }
        { pg8::Gemm g{ACT1, WallT, HT, NPROJ, DM, DM, DM}; pg8::StaticOrder S; S.init(g.M, g.N, F.G, F.bid);
          pg8::EpiBf16<0> E{BIG, NPROJ}; pg8::gemm_phase(F.lds, g, S, E); }
    }
    SEAM(1);
    if (IN(2)) { qkprep_phase(F, 0); ssd_naive_phase(F, 0); }
    SEAM(2);
    if (IN(3)) { gatenorm_phase(F, 0); dilattn_naive_phase(F, 0); memattn_naive_phase(F, 0); }
    SEAM(3);
    if (IN(4)) { pg8::Gemm g{ACT1 + (size_t)HT * DM, WallT, HT, NPROJ, DM, DM, DM}; pg8::StaticOrder S; S.init(g.M, g.N, F.G, F.bid);
        pg8::EpiBf16<0> E{BIG, NPROJ}; pg8::gemm_phase(F.lds, g, S, E); }
    SEAM(4);
    if (IN(5)) { qkprep_phase(F, 1); ssd_naive_phase(F, 1); }
    SEAM(5);
    if (IN(6)) { gatenorm_phase(F, 1); dilattn_naive_phase(F, 1); memattn_naive_phase(F, 1); }
    SEAM(6);
    if (IN(7)) { pg8::Gemm g{ACT1, WallT + (size_t)NPROJ * DM, T, NGATE, DM, DM, DM}; pg8::StaticOrder S; S.init(g.M, g.N, F.G, F.bid);
        pg8::EpiBf16<1> E{BIG, NGATE}; pg8::gemm_phase(F.lds, g, S, E); }
    SEAM(7);
    if (IN(8)) {
        const bf16* Yc = (const bf16*)F.out; const bf16* Wc = (const bf16*)(ws + WS_WCATT);
        { pg8::Gemm g{Yc, Wc, T, DM, 1024, YC, YC}; pg8::StaticOrder S; S.init(g.M, g.N, F.G, F.bid); pg8::EpiBranch<false> E{ACT1, DM, BIG, NGATE, 0}; pg8::gemm_phase(F.lds, g, S, E); }
        { pg8::Gemm g{Yc + 1024, Wc + 1024, T, DM, 256, YC, YC}; pg8::StaticOrder S; S.init(g.M, g.N, F.G, F.bid); pg8::EpiBranch<true> E{ACT1, DM, BIG, NGATE, 1024}; pg8::gemm_phase(F.lds, g, S, E); }
        { pg8::Gemm g{Yc + 1280, Wc + 1280, T, DM, 768, YC, YC}; pg8::StaticOrder S; S.init(g.M, g.N, F.G, F.bid); pg8::EpiBranch<true> E{ACT1, DM, BIG, NGATE, 2048}; pg8::gemm_phase(F.lds, g, S, E); }
    }
    SEAM(8);
    if (IN(9)) { pg8::Gemm g{ACT1, (const bf16*)(ws + WS_WOUTT), T, DM, DM, DM, DM}; pg8::StaticOrder S; S.init(g.M, g.N, F.G, F.bid);
        pg8::EpiResid E{F.out, DM, F.in[I_X]}; pg8::gemm_phase(F.lds, g, S, E); }
    SEAM(9);
    if (IN(10)) hn_phase(F);
    SEAM(10);
    if (IN(11)) { pg8::Gemm g{ACT1, (const bf16*)(ws + WS_WQT), T, PEER_Q, DM, DM, DM}; pg8::StaticOrder S; S.init(g.M, g.N, F.G, F.bid);
        pg8::EpiBf16<0> E{BIG, PEER_Q}; pg8::gemm_phase(F.lds, g, S, E); }
    SEAM(11);
    if (IN(12)) peer_naive_phase(F);
#undef IN
#undef SEAM
}

extern "C" void kernel_launch(void* const* d_in, const int* in_sizes, int n_in, void* d_out, int out_size, void* d_ws, size_t ws_size, hipStream_t stream) {
    static int grid = 0;
    if (grid == 0) {
        if (n_in != 26 || out_size != T * DM || ws_size < WS_END) { fprintf(stderr, "kernel_launch: unexpected shapes (n_in %d, out %d, ws %zu)\n", n_in, out_size, ws_size); grid = -1; return; }
        int dev = 0, cus = 0;
        if (hipGetDevice(&dev) != hipSuccess || hipDeviceGetAttribute(&cus, hipDeviceAttributeMultiprocessorCount, dev) != hipSuccess) { grid = -1; return; }
        if (hipFuncSetAttribute((const void*)mega_fwd, hipFuncAttributeMaxDynamicSharedMemorySize, LDS_BYTES) != hipSuccess) { grid = -1; return; }
        int per_cu = 0;
        (void)hipOccupancyMaxActiveBlocksPerMultiprocessor(&per_cu, (const void*)mega_fwd, NTHR, LDS_BYTES);
        (void)hipGetLastError();
        grid = cus;
    }
    if (grid < 0) return;
    (void)hipMemsetAsync((char*)d_ws + WS_CTL, 0, CTL_ZERO_BYTES, stream);
    Args a{};
    for (int i = 0; i < 26; ++i) a.in[i] = (const float*)d_in[i];
    a.positions = (const int*)d_in[2]; a.out = (float*)d_out; a.ws = (unsigned char*)d_ws;
#if MK_N_LAUNCHES == 1
    a.ph_lo = 0; a.ph_hi = N_PHASES;
    hipLaunchKernelGGL(mega_fwd, dim3(grid), dim3(NTHR), LDS_BYTES, stream, a);
#else
    for (int p = 0; p < N_PHASES; ++p) { a.ph_lo = p; a.ph_hi = p + 1; hipLaunchKernelGGL(mega_fwd, dim3(grid), dim3(NTHR), LDS_BYTES, stream, a); }
#endif
}
```

```cpp
#include <hip/hip_runtime.h>
#include <cstdio>
#include <cstdint>

#ifndef MK_N_LAUNCHES
#define MK_N_LAUNCHES 1
#endif

#define LAS __attribute__((address_space(3)))
#define GAS __attribute__((address_space(1)))
typedef unsigned short bf16;
typedef short bf16x8 __attribute__((ext_vector_type(8)));
typedef float f32x4 __attribute__((ext_vector_type(4)));
typedef float f32x2 __attribute__((ext_vector_type(2)));
typedef unsigned u32x4 __attribute__((ext_vector_type(4)));
typedef unsigned u32x2 __attribute__((ext_vector_type(2)));

constexpr int NB = 8, SEQ = 8192, DM = 1024, T = NB * SEQ;
constexpr int HB = 4, HT = HB * SEQ;
constexpr int NMEM = 256;
constexpr int NPROJ = 6144;
constexpr int PC_Z = 0, PC_X = 1024, PC_B = 2048, PC_C = 2560, PC_DQ = 3072, PC_DK = 3840, PC_DV = 4608, PC_MQ = 5376;
constexpr int W_IN_N = 9232, OFF_DT = 3072, OFF_AFTER_DT = 3088;
constexpr int NGATE = 3072;
constexpr int YC = 2048;
constexpr int PEER_H = 8, PEER_K = 16, PEER_NK = 128, PEER_Q = 2048;
constexpr float EPS = 1e-6f;

constexpr size_t MiB = 1u << 20;
constexpr size_t WS_CTL = 0, CTL_ZERO_BYTES = 65536;
constexpr size_t WS_WALLT = 1 * MiB;
constexpr size_t WS_WMKVT = 19 * MiB;
constexpr size_t WS_WCATT = 22 * MiB;
constexpr size_t WS_WOUTT = 26 * MiB;
constexpr size_t WS_WQT = 28 * MiB;
constexpr size_t WS_SUBK = 32 * MiB;
constexpr size_t WS_PD = 33 * MiB;
constexpr size_t WS_PU = 65 * MiB;
constexpr size_t WS_DT = 97 * MiB;
constexpr size_t WS_MEMN = 101 * MiB;
constexpr size_t WS_MKV = 105 * MiB;
constexpr size_t WS_ACT1 = 112 * MiB;
constexpr size_t WS_BIG = 240 * MiB;
constexpr size_t WS_LSE = 624 * MiB;
constexpr size_t WS_MVT = 628 * MiB;
constexpr size_t WS_END = 632 * MiB;

constexpr int RING_BYTES = 131072;
constexpr int LDSCTL_OFF = 143360;
constexpr int LDS_BYTES = 147456;
constexpr int NWAVES = 8, NTHR = 512;

__device__ __forceinline__ float bf2f(unsigned short b) { return __builtin_bit_cast(float, (unsigned)b << 16); }
__device__ __forceinline__ float bflo(unsigned w) { return __builtin_bit_cast(float, w << 16); }
__device__ __forceinline__ float bfhi(unsigned w) { return __builtin_bit_cast(float, w & 0xffff0000u); }
__device__ __forceinline__ unsigned f2bf(float f) { unsigned u = __builtin_bit_cast(unsigned, f); return (u + 0x7fffu + ((u >> 16) & 1u)) >> 16; }
__device__ __forceinline__ unsigned pk2(float lo, float hi) { return f2bf(lo) | (f2bf(hi) << 16); }
typedef float f32x16 __attribute__((ext_vector_type(16)));
typedef short s16x4 __attribute__((ext_vector_type(4)));
typedef __bf16 bf2_t __attribute__((ext_vector_type(2)));
__device__ __forceinline__ unsigned pkbf(float a, float b) { const f32x2 v = {a, b}; return __builtin_bit_cast(unsigned, __builtin_convertvector(v, bf2_t)); }
#define MFMA32(a, b, c) __builtin_amdgcn_mfma_f32_32x32x16_bf16((a), (b), (c), 0, 0, 0)
__device__ __forceinline__ float wave_sum(float v) {
#pragma unroll
    for (int o = 1; o < 64; o <<= 1) v += __shfl_xor(v, o);
    return v;
}
__device__ __forceinline__ float wave_max(float v) {
#pragma unroll
    for (int o = 1; o < 64; o <<= 1) v = fmaxf(v, __shfl_xor(v, o));
    return v;
}
__device__ __forceinline__ float sigmoidf_(float x) { return 1.0f / (1.0f + __expf(-x)); }
#define LDS_WAIT() asm volatile("s_waitcnt lgkmcnt(0)" ::: "memory")
#define VM_WAIT() asm volatile("s_waitcnt vmcnt(0)" ::: "memory")

#define XB_TMO      128
#define XB_XCNT(j)  (256  + 64 * (j))
#define XB_XSUB(j)  (1280 + 64 * (j))
#define XB_XGEN(j)  (2304 + 64 * (j))
#define XB_TOP      3328
#define XB_TOPGEN   3392
#define XCD_BAR_WORDS 3456
#define XB_SPIN_CAP (1u << 18)
__device__ __forceinline__ unsigned xb_ld(unsigned* p)              { return __hip_atomic_load(p, __ATOMIC_RELAXED, __HIP_MEMORY_SCOPE_AGENT); }
__device__ __forceinline__ unsigned xb_add(unsigned* p, unsigned v) { return __hip_atomic_fetch_add(p, v, __ATOMIC_RELAXED, __HIP_MEMORY_SCOPE_AGENT); }
__device__ __forceinline__ unsigned xb_xcc_id() { return (unsigned)__builtin_amdgcn_s_getreg((3 << 11) | 20) & 0xFu; }
#define XB_SPIN(cond, bar) do { unsigned _sp = 0; while (cond) { __builtin_amdgcn_s_sleep(1); \
    if ((++_sp & 255u) == 0u) { if (xb_ld(&(bar)[XB_TMO])) break; if (_sp > XB_SPIN_CAP) { atomicAdd(&(bar)[XB_TMO], 1u); break; } } } } while (0)
struct XcdBarrier { unsigned* bar; unsigned x; volatile LAS unsigned* st; };
__device__ __forceinline__ XcdBarrier xcd_barrier_post(unsigned* bar, volatile LAS unsigned* st) {
    XcdBarrier b; b.bar = bar; b.x = xb_xcc_id(); b.st = st;
    if (threadIdx.x == 0) (void)xb_add(&bar[XB_XCNT(b.x)], 1u);
    return b;
}
__device__ __forceinline__ void xcd_barrier_complete(unsigned* bar, unsigned x, unsigned& nloc, unsigned& nx) {
    const unsigned G = gridDim.x * gridDim.y * gridDim.z;
    unsigned sum, cnt, mine, sp = 0u;
    for (;;) {
        sum = 0u; cnt = 0u; mine = 0u;
#pragma unroll
        for (unsigned j = 0; j < 16; ++j) { const unsigned c = xb_ld(&bar[XB_XCNT(j)]); sum += c; cnt += (c > 0u) ? 1u : 0u; mine = (j == x) ? c : mine; }
        if (sum == G) break;
        __builtin_amdgcn_s_sleep(1);
        if ((++sp & 255u) == 0u) { if (xb_ld(&bar[XB_TMO])) break; if (sp > XB_SPIN_CAP) { atomicAdd(&bar[XB_TMO], 1u); break; } }
    }
    nloc = mine > 0u ? mine : 1u; nx = cnt > 0u ? cnt : 1u;
}
__device__ __forceinline__ void xcd_barrier(const XcdBarrier& b) {
    asm volatile("s_waitcnt vmcnt(0)" ::: "memory");
    __syncthreads();
    if (threadIdx.x == 0) {
        unsigned* bar = b.bar;
        __builtin_amdgcn_s_waitcnt(0);
        unsigned nloc = b.st[0], nx = b.st[1];
        if (nloc == 0u) { xcd_barrier_complete(bar, b.x, nloc, nx); b.st[0] = nloc; b.st[1] = nx; }
        const unsigned old = xb_add(&bar[XB_XSUB(b.x)], 1u);
        const unsigned gen = old / nloc;
        if (old + 1u == (gen + 1u) * nloc) {
            __builtin_amdgcn_fence(__ATOMIC_RELEASE, "agent");
            asm volatile("s_waitcnt vmcnt(0)" ::: "memory");
            const unsigned og = xb_add(&bar[XB_TOP], 1u);
            const unsigned tg = og / nx;
            if (og + 1u == (tg + 1u) * nx) xb_add(&bar[XB_TOPGEN], 1u);
            else XB_SPIN(xb_ld(&bar[XB_TOPGEN]) == tg, bar);
            __builtin_amdgcn_fence(__ATOMIC_ACQUIRE, "agent");
            xb_add(&bar[XB_XGEN(b.x)], 1u);
            asm volatile("s_waitcnt vmcnt(0)" ::: "memory");
        } else {
            XB_SPIN(xb_ld(&bar[XB_XGEN(b.x)]) == gen, bar);
            __builtin_amdgcn_fence(__ATOMIC_ACQUIRE, "agent");
            asm volatile("s_waitcnt vmcnt(0)" ::: "memory");
        }
    }
    __syncthreads();
}

namespace pg8 {
constexpr int BM = 256, BK = 64, HALF = 128, HTB = HALF * BK * 2, STAGE_BYTES = 8 * HTB, NXCD = 8, WGM = 8;
__host__ __device__ __forceinline__ int lds_byte(int r, int c) { const int st = (r >> 4) * 2 + (c >> 5), rr = r & 15, cc = c & 31, ob = rr * 64 + cc * 2; return st * 1024 + (ob ^ (((ob >> 9) & 1) << 5)); }
__host__ __device__ __forceinline__ void stage_rc(int b, int& R, int& C) { const int st = b / 1024, sb = b % 1024, swz = sb ^ (((sb >> 9) & 1) << 5); R = (st >> 1) * 16 + swz / 64; C = (st & 1) * 32 + (swz % 64) / 2; }
__host__ __device__ __forceinline__ int perm32(int rho) { const int n = rho >> 4, i = rho & 15; return 8 * (i >> 2) + 4 * n + (i & 3); }
struct Unit { int pm, pn; };
struct Gemm { const bf16* A; const bf16* Bt; int M, N, K, lda, ldb; };
struct StaticOrder {
    int nM, nN, nwg, G, c;
    __host__ __device__ void init(int M, int N, int G_, int c_) { nM = M / BM; nN = N / BM; nwg = nM * nN; G = G_; c = c_; }
    __host__ __device__ bool next(int i, Unit& u) const {
        const long L = (long)i * G + c; if (L >= nwg) return false;
        int wgid = (int)L; { const int q = nwg / NXCD, r = nwg % NXCD, xcd = wgid % NXCD, off = wgid / NXCD; wgid = (xcd < r ? xcd * (q + 1) : r * (q + 1) + (xcd - r) * q) + off; }
        const int nig = WGM * nN, gid = wgid / nig, fm = gid * WGM, gsz = (nM - fm) < WGM ? (nM - fm) : WGM;
        u.pm = fm + ((wgid % nig) % gsz); u.pn = (wgid % nig) / gsz; return true;
    }
    __device__ __forceinline__ void a_ready(const Unit&) const {}
    __device__ __forceinline__ void done(const Unit&) const {}
};
__device__ __forceinline__ unsigned cvt_pk_bf16(float lo, float hi) { unsigned r; asm volatile("v_cvt_pk_bf16_f32 %0, %1, %2" : "=v"(r) : "v"(lo), "v"(hi)); return r; }

template <int ACT> struct EpiBf16 {
    static constexpr bool PERM = true, AFTER_DRAIN = false;
    bf16* O; int ldc;
    __device__ __forceinline__ void operator()(const f32x4 (&acc)[2][2][4][2], const Unit& u, int wr, int wc, int fr, int fq) const {
        const int row0 = u.pm * BM + wr * 64 + fr; const int col0 = u.pn * BM + wc * 32 + 8 * fq;
#pragma unroll
        for (int ai = 0; ai < 2; ++ai)
#pragma unroll
            for (int m = 0; m < 4; ++m) { bf16* rowp = O + (size_t)(row0 + ai * HALF + m * 16) * ldc + col0;
#pragma unroll
                for (int bj = 0; bj < 2; ++bj) { f32x4 v0 = acc[ai][bj][m][0], v1 = acc[ai][bj][m][1];
                    if (ACT == 1) {
#pragma unroll
                        for (int j = 0; j < 4; ++j) { v0[j] = sigmoidf_(v0[j]); v1[j] = sigmoidf_(v1[j]); } }
                    u32x4 w; w.x = cvt_pk_bf16(v0[0], v0[1]); w.y = cvt_pk_bf16(v0[2], v0[3]); w.z = cvt_pk_bf16(v1[0], v1[1]); w.w = cvt_pk_bf16(v1[2], v1[3]);
                    *(u32x4*)(rowp + bj * HALF) = w; } }
    }
};
template <bool ACCUM> struct EpiBranch {
    static constexpr bool PERM = true, AFTER_DRAIN = false;
    bf16* O; int ldc; const bf16* Gt; int ldg; int gcol0;
    __device__ __forceinline__ void operator()(const f32x4 (&acc)[2][2][4][2], const Unit& u, int wr, int wc, int fr, int fq) const {
        const int row0 = u.pm * BM + wr * 64 + fr; const int col0 = u.pn * BM + wc * 32 + 8 * fq;
#pragma unroll
        for (int ai = 0; ai < 2; ++ai)
#pragma unroll
            for (int m = 0; m < 4; ++m) { const size_t r = (size_t)(row0 + ai * HALF + m * 16); bf16* rowp = O + r * ldc + col0; const bf16* gp = Gt + r * ldg + gcol0 + col0;
#pragma unroll
                for (int bj = 0; bj < 2; ++bj) { const f32x4 v0 = acc[ai][bj][m][0], v1 = acc[ai][bj][m][1];
                    const u32x4 g = *(const u32x4*)(gp + bj * HALF);
                    float o[8];
                    o[0] = v0[0] * bflo(g.x); o[1] = v0[1] * bfhi(g.x); o[2] = v0[2] * bflo(g.y); o[3] = v0[3] * bfhi(g.y);
                    o[4] = v1[0] * bflo(g.z); o[5] = v1[1] * bfhi(g.z); o[6] = v1[2] * bflo(g.w); o[7] = v1[3] * bfhi(g.w);
                    if (ACCUM) { const u32x4 p = *(const u32x4*)(rowp + bj * HALF);
                        o[0] += bflo(p.x); o[1] += bfhi(p.x); o[2] += bflo(p.y); o[3] += bfhi(p.y); o[4] += bflo(p.z); o[5] += bfhi(p.z); o[6] += bflo(p.w); o[7] += bfhi(p.w); }
                    u32x4 w; w.x = cvt_pk_bf16(o[0], o[1]); w.y = cvt_pk_bf16(o[2], o[3]); w.z = cvt_pk_bf16(o[4], o[5]); w.w = cvt_pk_bf16(o[6], o[7]);
                    *(u32x4*)(rowp + bj * HALF) = w; } }
    }
};
struct EpiResid {
    static constexpr bool PERM = false, AFTER_DRAIN = false;
    float* C; int ldc; const float* R;
    __device__ __forceinline__ void operator()(const f32x4 (&acc)[2][2][4][2], const Unit& u, int wr, int wc, int fr, int fq) const {
        const int row0 = u.pm * BM + wr * 64 + fr, col0 = u.pn * BM + wc * 32 + 4 * fq;
#pragma unroll
        for (int ai = 0; ai < 2; ++ai)
#pragma unroll
            for (int m = 0; m < 4; ++m) { const size_t off = (size_t)(row0 + ai * HALF + m * 16) * ldc + col0;
#pragma unroll
                for (int bj = 0; bj < 2; ++bj)
#pragma unroll
                    for (int n = 0; n < 2; ++n) { const f32x4 r = *(const f32x4*)(R + off + bj * HALF + n * 16); *(f32x4*)(C + off + bj * HALF + n * 16) = acc[ai][bj][m][n] + r; } }
    }
};

template <class Epi, class Sched>
__device__ __forceinline__ void gemm_phase(LAS unsigned char* lds, const Gemm g, const Sched& S, const Epi& E) {
    const int tid = threadIdx.x, wid = __builtin_amdgcn_readfirstlane(tid >> 6), lane = tid & 63, wr = wid >> 2, wc = wid & 3, fr = lane & 15, fq = lane >> 4;
    const int K = g.K, nt = K / BK;
    unsigned voffA[2], voffB[2];
#pragma unroll
    for (int i = 0; i < 2; ++i) { int R, C; stage_rc(tid * 16 + i * 8192, R, C); const int Rb = Epi::PERM ? ((R & ~31) + perm32(R & 31)) : R;
        voffA[i] = (unsigned)(R * g.lda + C) * 2u; voffB[i] = (unsigned)(Rb * g.ldb + C) * 2u; }
    const size_t kstep = (size_t)(BK * 2);
    const size_t hsA = (size_t)HALF * g.lda * 2, hsB = (size_t)HALF * g.ldb * 2;
    const size_t tsA = 2 * hsA, tsB = 2 * hsB;
    const unsigned ldsw = (unsigned)wid * 1024u;
    const int aoff = lds_byte(wr * 64 + fr, fq * 8), boff = lds_byte(wc * 32 + fr, fq * 8);
#define PG8_SA(b, h) (((b) * 2 + (h)) * HTB)
#define PG8_SB(b, h) ((4 + (b) * 2 + (h)) * HTB)
#define PG8_STAGE(bufoff, gbase, voff) do { _Pragma("unroll") for (int _i = 0; _i < 2; ++_i) \
        __builtin_amdgcn_global_load_lds((const unsigned*)((const char*)(gbase) + (voff)[_i]), (LAS unsigned*)(lds + (bufoff) + ldsw + _i * 8192), 16, 0, 0); } while (0)
#define PG8_LDA(dst, b, h) do { _Pragma("unroll") for (int m = 0; m < 4; ++m) _Pragma("unroll") for (int k = 0; k < 2; ++k) dst[m][k] = *(const LAS bf16x8*)(lds + PG8_SA(b, h) + aoff + m * 2048 + k * 1024); } while (0)
#define PG8_LDB(dst, b, h) do { _Pragma("unroll") for (int n = 0; n < 2; ++n) _Pragma("unroll") for (int k = 0; k < 2; ++k) dst[n][k] = *(const LAS bf16x8*)(lds + PG8_SB(b, h) + boff + n * 2048 + k * 1024); } while (0)
#define PG8_MMA(ai, bj, At, Bt) do { __builtin_amdgcn_s_setprio(1); _Pragma("unroll") for (int m = 0; m < 4; ++m) _Pragma("unroll") for (int n = 0; n < 2; ++n) _Pragma("unroll") for (int k = 0; k < 2; ++k) \
        acc[ai][bj][m][n] = __builtin_amdgcn_mfma_f32_16x16x32_bf16(Bt[n][k], At[m][k], acc[ai][bj][m][n], 0, 0, 0); __builtin_amdgcn_s_setprio(0); } while (0)
#define PG8_WAIT_V(n) asm volatile("s_waitcnt vmcnt(" #n ")" ::: "memory")
#define PG8_WAIT_L(n) asm volatile("s_waitcnt lgkmcnt(" #n ")" ::: "memory")
#define PG8_BAR __builtin_amdgcn_s_barrier()
#define PG8_SCHED __builtin_amdgcn_sched_barrier(0)
    Unit cur, nxt; int ui = 0;
    if (!S.next(0, cur)) return;
    f32x4 acc[2][2][4][2];
#pragma unroll
    for (int a = 0; a < 2; ++a)
#pragma unroll
        for (int b = 0; b < 2; ++b)
#pragma unroll
            for (int m = 0; m < 4; ++m)
#pragma unroll
                for (int n = 0; n < 2; ++n) acc[a][b][m][n] = (f32x4){0.f, 0.f, 0.f, 0.f};
    bf16x8 At[4][2], B0[2][2], B1[2][2];
    const char* cA = (const char*)g.A + (size_t)cur.pm * tsA; const char* cB = (const char*)g.Bt + (size_t)cur.pn * tsB;
    S.a_ready(cur);
    PG8_STAGE(PG8_SB(0, 0), cB, voffB); PG8_STAGE(PG8_SA(0, 0), cA, voffA); PG8_STAGE(PG8_SB(0, 1), cB + hsB, voffB); PG8_STAGE(PG8_SA(0, 1), cA + hsA, voffA);
    if (wr == 1) PG8_BAR;
    PG8_WAIT_V(4); PG8_BAR;
    PG8_STAGE(PG8_SB(1, 0), cB + kstep, voffB); PG8_STAGE(PG8_SA(1, 0), cA + kstep, voffA); PG8_STAGE(PG8_SB(1, 1), cB + hsB + kstep, voffB);
    PG8_WAIT_V(6); PG8_BAR;
    for (;;) {
        const bool has_next = S.next(ui + 1, nxt);
        const char* nA = has_next ? (const char*)g.A + (size_t)nxt.pm * tsA : cA; const char* nB = has_next ? (const char*)g.Bt + (size_t)nxt.pn * tsB : cB;
        for (int t = 0; t < nt; t += 2) {
            const bool last = (t == nt - 2);
            const char* a1 = cA + (size_t)(t + 1) * kstep;
            const char* a2 = last ? nA : cA + (size_t)(t + 2) * kstep; const char* b2 = last ? nB : cB + (size_t)(t + 2) * kstep;
            const char* a3 = a2 + kstep; const char* b3 = b2 + kstep;
            if (last && has_next) S.a_ready(nxt);
            PG8_LDB(B0, 0, 0); PG8_SCHED; PG8_LDA(At, 0, 0); PG8_STAGE(PG8_SA(1, 1), a1 + hsA, voffA);
            PG8_WAIT_L(8); PG8_BAR; PG8_WAIT_L(0); PG8_MMA(0, 0, At, B0); PG8_BAR; PG8_SCHED;
            PG8_LDB(B1, 0, 1); PG8_STAGE(PG8_SB(0, 0), b2, voffB);
            PG8_BAR; PG8_WAIT_L(0); PG8_MMA(0, 1, At, B1); PG8_BAR;
            PG8_LDA(At, 0, 1); PG8_STAGE(PG8_SA(0, 0), a2, voffA);
            PG8_BAR; PG8_WAIT_L(0); PG8_MMA(1, 0, At, B0); PG8_BAR; PG8_SCHED;
            PG8_STAGE(PG8_SB(0, 1), b2 + hsB, voffB);
            PG8_WAIT_V(6); PG8_BAR; PG8_MMA(1, 1, At, B1); PG8_BAR;
            PG8_LDB(B0, 1, 0); PG8_SCHED; PG8_LDA(At, 1, 0); PG8_STAGE(PG8_SA(0, 1), a2 + hsA, voffA);
            PG8_WAIT_L(8); PG8_BAR; PG8_WAIT_L(0); PG8_MMA(0, 0, At, B0); PG8_BAR; PG8_SCHED;
            PG8_LDB(B1, 1, 1); PG8_STAGE(PG8_SB(1, 0), b3, voffB);
            PG8_BAR; PG8_WAIT_L(0); PG8_MMA(0, 1, At, B1); PG8_BAR;
            PG8_LDA(At, 1, 1); PG8_STAGE(PG8_SA(1, 0), a3, voffA);
            PG8_BAR; PG8_WAIT_L(0); PG8_MMA(1, 0, At, B0); PG8_BAR; PG8_SCHED;
            PG8_STAGE(PG8_SB(1, 1), b3 + hsB, voffB);
            PG8_WAIT_V(6); PG8_BAR; PG8_MMA(1, 1, At, B1); PG8_BAR;
        }
        E(acc, cur, wr, wc, fr, fq); S.done(cur);
        if (!has_next) break;
#pragma unroll
        for (int a = 0; a < 2; ++a)
#pragma unroll
            for (int b = 0; b < 2; ++b)
#pragma unroll
                for (int m = 0; m < 4; ++m)
#pragma unroll
                    for (int n = 0; n < 2; ++n) acc[a][b][m][n] = (f32x4){0.f, 0.f, 0.f, 0.f};
        cur = nxt; cA = nA; cB = nB; ++ui;
    }
    PG8_WAIT_V(0);
    if (wr == 0) PG8_BAR;
    PG8_BAR;
#undef PG8_SA
#undef PG8_SB
#undef PG8_STAGE
#undef PG8_LDA
#undef PG8_LDB
#undef PG8_MMA
#undef PG8_WAIT_V
#undef PG8_WAIT_L
#undef PG8_BAR
#undef PG8_SCHED
}
}

struct Args {
    const float* in[26]; const int* positions; float* out; unsigned char* ws; int ph_lo, ph_hi; int pad0, pad1;
};
struct Frame {
    LAS unsigned char* lds;
    int tid, lane, wave, G, bid;
    const float* in[26]; const int* positions; float* out; unsigned char* ws;
};
enum { I_X = 0, I_MEM = 1, I_POS = 2, I_NMIXW = 3, I_WIN = 4, I_CONVW = 5, I_CONVB = 6, I_DTB = 7, I_ALOG = 8, I_SSDD = 9, I_SSDNW = 10, I_DQNW = 11, I_DKNW = 12, I_MEMNW = 13,
       I_WMKV = 14, I_MQNW = 15, I_MKNW = 16, I_WSSD = 17, I_WDIL = 18, I_WMEMBR = 19, I_WOUT = 20, I_NFFNW = 21, I_WQ = 22, I_SUBK = 23, I_PD = 24, I_PU = 25 };

__device__ __forceinline__ void p0_transpose_item(const float* W, int ldw, int src_col0, bf16* WT, int ldt, int dst_row0, int dst_col0, int nblk, LAS float* scr, int item, int lane) {
    const int kb = item / nblk, nb = item % nblk, k0 = 64 * kb, n0 = 32 * nb;
#pragma unroll 8
    for (int i = 0; i < 32; ++i) { const int kk = 2 * i + (lane >> 5); scr[kk * 33 + (lane & 31)] = W[(size_t)(k0 + kk) * ldw + src_col0 + n0 + (lane & 31)]; }
    LDS_WAIT(); asm volatile("" ::: "memory");
    const int c = lane & 7;
#pragma unroll
    for (int j = 0; j < 4; ++j) { const int n = (lane >> 3) + 8 * j; const LAS float* s = scr + (8 * c) * 33 + n;
        u32x4 o; o.x = pk2(s[0 * 33], s[1 * 33]); o.y = pk2(s[2 * 33], s[3 * 33]); o.z = pk2(s[4 * 33], s[5 * 33]); o.w = pk2(s[6 * 33], s[7 * 33]);
        *(u32x4*)(WT + (size_t)(dst_row0 + n0 + n) * ldt + dst_col0 + k0 + 8 * c) = o; }
    LDS_WAIT(); asm volatile("" ::: "memory");
}
__device__ __forceinline__ void rms_row_to_bf16(const float* xrow, const float* w, bf16* orow, int lane, f32x4 (&v)[4]) {
    const f32x4* xr = (const f32x4*)xrow + lane; const f32x4* wr = (const f32x4*)w + lane;
    float s = 0.f;
#pragma unroll
    for (int j = 0; j < 4; ++j) { v[j] = xr[64 * j]; s += (v[j].x * v[j].x + v[j].y * v[j].y) + (v[j].z * v[j].z + v[j].w * v[j].w); }
    const float rstd = 1.0f / sqrtf(wave_sum(s) * (1.f / DM) + EPS);
    unsigned long long* o8 = (unsigned long long*)orow + lane;
#pragma unroll
    for (int j = 0; j < 4; ++j) { const f32x4 ww = wr[64 * j]; v[j] = v[j] * rstd * ww;
        o8[64 * j] = (unsigned long long)pk2(v[j].x, v[j].y) | ((unsigned long long)pk2(v[j].z, v[j].w) << 32); }
}
__device__ __forceinline__ void cvt_f32_bf16_stream(const float* src, bf16* dst, size_t n, size_t gtid, size_t gthreads) {
    for (size_t i = gtid * 8; i < n; i += gthreads * 8) { const f32x4 a = *(const f32x4*)(src + i), b = *(const f32x4*)(src + i + 4);
        u32x4 o; o.x = pk2(a.x, a.y); o.y = pk2(a.z, a.w); o.z = pk2(b.x, b.y); o.w = pk2(b.z, b.w); *(u32x4*)(dst + i) = o; }
}
__device__ __forceinline__ void p0_prologue(Frame& F) {
    LAS float* scr = (LAS float*)(F.lds + F.wave * 8448);
    LAS float* wdt = (LAS float*)(F.lds + 8 * 8448);
    const int gw = F.bid * NWAVES + F.wave, NGW = F.G * NWAVES;
    unsigned char* ws = F.ws;
    for (int i = F.tid; i < 1024 * 16; i += NTHR) wdt[i] = F.in[I_WIN][(size_t)(i >> 4) * W_IN_N + OFF_DT + (i & 15)];
    __syncthreads();
    constexpr int IT_A = 16 * 96, IT_B = 16 * 192, IT_MKV = 16 * 48, IT_SSD = 16 * 32, IT_DIL = 4 * 32, IT_MBR = 12 * 32, IT_OUT = 16 * 32, IT_WQ = 16 * 64;
    constexpr int NITEMS = IT_A + IT_B + IT_MKV + IT_SSD + IT_DIL + IT_MBR + IT_OUT + IT_WQ;
    bf16* WallT = (bf16*)(ws + WS_WALLT);
    for (int it = gw; it < NITEMS; it += NGW) {
        int r = it;
        if (r < IT_A) { p0_transpose_item(F.in[I_WIN], W_IN_N, 0, WallT, DM, 0, 0, 96, scr, r, F.lane); continue; } r -= IT_A;
        if (r < IT_B) { p0_transpose_item(F.in[I_WIN], W_IN_N, OFF_AFTER_DT, WallT, DM, 3072, 0, 192, scr, r, F.lane); continue; } r -= IT_B;
        if (r < IT_MKV) { p0_transpose_item(F.in[I_WMKV], 1536, 0, (bf16*)(ws + WS_WMKVT), DM, 0, 0, 48, scr, r, F.lane); continue; } r -= IT_MKV;
        if (r < IT_SSD) { p0_transpose_item(F.in[I_WSSD], DM, 0, (bf16*)(ws + WS_WCATT), YC, 0, 0, 32, scr, r, F.lane); continue; } r -= IT_SSD;
        if (r < IT_DIL) { p0_transpose_item(F.in[I_WDIL], DM, 0, (bf16*)(ws + WS_WCATT), YC, 0, 1024, 32, scr, r, F.lane); continue; } r -= IT_DIL;
        if (r < IT_MBR) { p0_transpose_item(F.in[I_WMEMBR], DM, 0, (bf16*)(ws + WS_WCATT), YC, 0, 1280, 32, scr, r, F.lane); continue; } r -= IT_MBR;
        if (r < IT_OUT) { p0_transpose_item(F.in[I_WOUT], DM, 0, (bf16*)(ws + WS_WOUTT), DM, 0, 0, 32, scr, r, F.lane); continue; } r -= IT_OUT;
        p0_transpose_item(F.in[I_WQ], PEER_Q, 0, (bf16*)(ws + WS_WQT), DM, 0, 0, 64, scr, r, F.lane);
    }
    const size_t gtid = (size_t)F.bid * NTHR + F.tid, gth = (size_t)F.G * NTHR;
    cvt_f32_bf16_stream(F.in[I_SUBK], (bf16*)(ws + WS_SUBK), (size_t)8 * 2 * 128 * 128, gtid, gth);
    cvt_f32_bf16_stream(F.in[I_PD], (bf16*)(ws + WS_PD), (size_t)16384 * 1024, gtid, gth);
    cvt_f32_bf16_stream(F.in[I_PU], (bf16*)(ws + WS_PU), (size_t)16384 * 1024, gtid, gth);
    for (int m = gw; m < NB * NMEM; m += NGW) { f32x4 v[4]; rms_row_to_bf16(F.in[I_MEM] + (size_t)m * DM, F.in[I_MEMNW], (bf16*)(ws + WS_MEMN) + (size_t)m * DM, F.lane, v); }
    float* DTp = (float*)(ws + WS_DT);
    for (int m = gw; m < T; m += NGW) {
        f32x4 v[4]; rms_row_to_bf16(F.in[I_X] + (size_t)m * DM, F.in[I_NMIXW], (bf16*)(ws + WS_ACT1) + (size_t)m * DM, F.lane, v);
        float d[16];
#pragma unroll
        for (int j = 0; j < 16; ++j) d[j] = 0.f;
#pragma unroll
        for (int j = 0; j < 4; ++j)
#pragma unroll
            for (int e = 0; e < 4; ++e) { const int k = 4 * F.lane + 256 * j + e; const float uv = v[j][e];
#pragma unroll
                for (int q = 0; q < 4; ++q) { const f32x4 w4 = *(const LAS f32x4*)(wdt + k * 16 + 4 * q); d[4 * q + 0] += uv * w4.x; d[4 * q + 1] += uv * w4.y; d[4 * q + 2] += uv * w4.z; d[4 * q + 3] += uv * w4.w; }
                __builtin_amdgcn_sched_barrier(0); }
        float mine = 0.f;
#pragma unroll
        for (int j = 0; j < 16; ++j) { const float s = wave_sum(d[j]); mine = (F.lane == j) ? s : mine; }
        if (F.lane < 16) { const float xx = mine + F.in[I_DTB][F.lane]; DTp[(size_t)m * 16 + F.lane] = (xx > 20.f) ? xx : log1pf(__expf(xx)); }
    }
}

__device__ __forceinline__ void qkprep_phase(Frame& F, int half) {
    bf16* P = (bf16*)(F.ws + WS_BIG);
    const int gw = F.bid * NWAVES + F.wave, NGW = F.G * NWAVES, lane = F.lane;
    const float wq = F.in[I_DQNW][lane], wk = F.in[I_DKNW][lane];
    const float wmq0 = F.in[I_MQNW][lane], wmq1 = F.in[I_MQNW][lane + 64], wmq2 = F.in[I_MQNW][lane + 128];
    const float inv = __expf(-logf(500000.0f) * (2.0f / 16.0f) * (float)(lane & 7));
    for (int r = gw; r < HT; r += NGW) {
        const int tok = half * HT + r;
        const int pos = F.positions[tok];
        const double rev = (double)((float)pos * inv) * 0.15915494309189535;
        const float fr = (float)(rev - floor(rev));
        const float cs = __builtin_amdgcn_cosf(fr), sn = __builtin_amdgcn_sinf(fr);
        bf16* row = P + (size_t)r * NPROJ;
#pragma unroll 4
        for (int h = 0; h < 24; ++h) {
            bf16* p = row + PC_DQ + h * 64 + lane;
            float v = bf2f(*p);
            const float ss = wave_sum(v * v);
            v = v * (1.0f / sqrtf(ss * (1.f / 64.f) + EPS)) * (h < 12 ? wq : wk);
            const float other = __shfl_xor(v, 8);
            if (lane < 8) v = v * cs - other * sn; else if (lane < 16) v = v * cs + other * sn;
            *p = (bf16)f2bf(v);
        }
#pragma unroll
        for (int h = 0; h < 4; ++h) {
            bf16* p = row + PC_MQ + h * 192 + lane;
            float v0 = bf2f(p[0]), v1 = bf2f(p[64]), v2 = bf2f(p[128]);
            const float ss = wave_sum(v0 * v0 + v1 * v1 + v2 * v2);
            const float rs = 1.0f / sqrtf(ss * (1.f / 192.f) + EPS);
            p[0] = (bf16)f2bf(v0 * rs * wmq0); p[64] = (bf16)f2bf(v1 * rs * wmq1); p[128] = (bf16)f2bf(v2 * rs * wmq2);
        }
    }
    if (half == 0) {
        bf16* MK = (bf16*)(F.ws + WS_MKV);
        const float wk0 = F.in[I_MKNW][lane], wk1 = F.in[I_MKNW][lane + 64], wk2 = F.in[I_MKNW][lane + 128];
        for (int r = gw; r < NB * NMEM * 4; r += NGW) {
            bf16* p = MK + (size_t)(r >> 2) * 1536 + (r & 3) * 192 + lane;
            float v0 = bf2f(p[0]), v1 = bf2f(p[64]), v2 = bf2f(p[128]);
            const float ss = wave_sum(v0 * v0 + v1 * v1 + v2 * v2);
            const float rs = 1.0f / sqrtf(ss * (1.f / 192.f) + EPS);
            p[0] = (bf16)f2bf(v0 * rs * wk0); p[64] = (bf16)f2bf(v1 * rs * wk1); p[128] = (bf16)f2bf(v2 * rs * wk2);
        }
    }
}

__device__ __forceinline__ void ssd_naive_phase(Frame& F, int half) {
    const bf16* P = (const bf16*)(F.ws + WS_BIG);
    bf16* Y = (bf16*)F.out;
    const float* DTp = (const float*)(F.ws + WS_DT);
    LAS float* sx = (LAS float*)F.lds;
    LAS float* sB = sx + 64 * 16;
    LAS float* sC = sB + 64 * 128;
    LAS float* sdt = sC + 64 * 128;
    LAS float* sy = sdt + 64;
    const int tid = F.tid, pl = tid >> 5, ng = tid & 31;
    const float* cw = F.in[I_CONVW]; const float* cb = F.in[I_CONVB];
    for (int chain = F.bid; chain < HB * 16 * 4; chain += F.G) {
        const int bl = chain >> 6, head = (chain >> 2) & 15, pq = chain & 3, grp = head >> 2;
        const float A = -__expf(F.in[I_ALOG][head]), Dh = F.in[I_SSDD][head];
        const size_t row0 = (size_t)bl * SEQ;
        const size_t tok0 = (size_t)half * HT + row0;
        float h0 = 0.f, h1 = 0.f, h2 = 0.f, h3 = 0.f;
        for (int t0 = 0; t0 < SEQ; t0 += 64) {
            __syncthreads();
            for (int o = tid; o < 64 * 272; o += NTHR) {
                const int tt = o / 272, cc = o % 272;
                int pcol, ccol;
                if (cc < 16) { ccol = head * 64 + pq * 16 + cc; }
                else if (cc < 144) { ccol = 1024 + grp * 128 + (cc - 16); }
                else { ccol = 1536 + grp * 128 + (cc - 144); }
                pcol = PC_X + ccol;
                const int t = t0 + tt;
                float a = cb[ccol];
#pragma unroll
                for (int k = 0; k < 4; ++k) { const int ts = t - 3 + k; if (ts >= 0) a += cw[k * 2048 + ccol] * bf2f(P[(row0 + ts) * NPROJ + pcol]); }
                a = a * sigmoidf_(a);
                if (cc < 16) sx[tt * 16 + cc] = a; else if (cc < 144) sB[tt * 128 + cc - 16] = a; else sC[tt * 128 + cc - 144] = a;
            }
            if (tid < 64) sdt[tid] = DTp[(tok0 + t0 + tid) * 16 + head];
            __syncthreads();
            for (int tt = 0; tt < 64; ++tt) {
                const float dt = sdt[tt], xv = sx[tt * 16 + pl];
                const float dA = __expf(dt * A), xdt = xv * dt;
                const f32x4 b4 = *(const LAS f32x4*)(sB + tt * 128 + 4 * ng), c4 = *(const LAS f32x4*)(sC + tt * 128 + 4 * ng);
                h0 = h0 * dA + xdt * b4.x; h1 = h1 * dA + xdt * b4.y; h2 = h2 * dA + xdt * b4.z; h3 = h3 * dA + xdt * b4.w;
                float acc = (h0 * c4.x + h1 * c4.y) + (h2 * c4.z + h3 * c4.w);
                acc += __shfl_xor(acc, 1); acc += __shfl_xor(acc, 2); acc += __shfl_xor(acc, 4); acc += __shfl_xor(acc, 8); acc += __shfl_xor(acc, 16);
                if (ng == 0) sy[tt * 16 + pl] = acc + Dh * xv;
            }
            __syncthreads();
            for (int o = tid; o < 64 * 16; o += NTHR) { const int tt = o >> 4, cc = o & 15; Y[(tok0 + t0 + tt) * YC + head * 64 + pq * 16 + cc] = (bf16)f2bf(sy[o]); }
        }
    }
}

__device__ __forceinline__ void gatenorm_phase(Frame& F, int half) {
    const bf16* P = (const bf16*)(F.ws + WS_BIG);
    bf16* Y = (bf16*)F.out;
    const int gw = F.bid * NWAVES + F.wave, NGW = F.G * NWAVES, lane = F.lane;
    const float* nw = F.in[I_SSDNW];
    for (int r = gw; r < HT; r += NGW) {
        const size_t tok = (size_t)half * HT + r;
        bf16* yp = Y + tok * YC + lane * 16; const bf16* zp = P + (size_t)r * NPROJ + PC_Z + lane * 16;
        const u32x4 ya = *(const u32x4*)yp, yb = *(const u32x4*)(yp + 8), za = *(const u32x4*)zp, zb = *(const u32x4*)(zp + 8);
        float y[16], z[16];
        y[0] = bflo(ya.x); y[1] = bfhi(ya.x); y[2] = bflo(ya.y); y[3] = bfhi(ya.y); y[4] = bflo(ya.z); y[5] = bfhi(ya.z); y[6] = bflo(ya.w); y[7] = bfhi(ya.w);
        y[8] = bflo(yb.x); y[9] = bfhi(yb.x); y[10] = bflo(yb.y); y[11] = bfhi(yb.y); y[12] = bflo(yb.z); y[13] = bfhi(yb.z); y[14] = bflo(yb.w); y[15] = bfhi(yb.w);
        z[0] = bflo(za.x); z[1] = bfhi(za.x); z[2] = bflo(za.y); z[3] = bfhi(za.y); z[4] = bflo(za.z); z[5] = bfhi(za.z); z[6] = bflo(za.w); z[7] = bfhi(za.w);
        z[8] = bflo(zb.x); z[9] = bfhi(zb.x); z[10] = bflo(zb.y); z[11] = bfhi(zb.y); z[12] = bflo(zb.z); z[13] = bfhi(zb.z); z[14] = bflo(zb.w); z[15] = bfhi(zb.w);
        float ss = 0.f;
#pragma unroll
        for (int j = 0; j < 16; ++j) { y[j] = y[j] * z[j] * sigmoidf_(z[j]); ss += y[j] * y[j]; }
        ss += __shfl_xor(ss, 1); ss += __shfl_xor(ss, 2); ss += __shfl_xor(ss, 4); ss += __shfl_xor(ss, 8);
        const float rs = 1.0f / sqrtf(ss * (1.f / 256.f) + EPS);
        const f32x4* w4 = (const f32x4*)(nw + lane * 16);
        u32x4 oa, ob; f32x4 w;
        w = w4[0]; oa.x = pk2(y[0] * rs * w.x, y[1] * rs * w.y); oa.y = pk2(y[2] * rs * w.z, y[3] * rs * w.w);
        w = w4[1]; oa.z = pk2(y[4] * rs * w.x, y[5] * rs * w.y); oa.w = pk2(y[6] * rs * w.z, y[7] * rs * w.w);
        w = w4[2]; ob.x = pk2(y[8] * rs * w.x, y[9] * rs * w.y); ob.y = pk2(y[10] * rs * w.z, y[11] * rs * w.w);
        w = w4[3]; ob.z = pk2(y[12] * rs * w.x, y[13] * rs * w.y); ob.w = pk2(y[14] * rs * w.z, y[15] * rs * w.w);
        *(u32x4*)yp = oa; *(u32x4*)(yp + 8) = ob;
    }
}

__device__ __forceinline__ void dilattn_naive_phase(Frame& F, int half) {
    const bf16* P = (const bf16*)(F.ws + WS_BIG);
    bf16* Y = (bf16*)F.out;
    const int gw = F.bid * NWAVES + F.wave, NGW = F.G * NWAVES, lane = F.lane;
    for (int it = gw; it < HT * 4; it += NGW) {
        const int r = it >> 2, hh = it & 3;
        const int s = r & (SEQ - 1);
        const size_t rb = (size_t)(r - s);
        float M = -1e30f, L = 0.f, O = 0.f;
#pragma unroll 1
        for (int g = 0; g < 3; ++g) {
            const int head = 4 * g + hh, dil = (g == 0) ? 1 : (g == 1 ? 4 : 16);
            const bf16* qp = P + (size_t)r * NPROJ + PC_DQ + head * 64;
            u32x4 q[8];
#pragma unroll
            for (int j = 0; j < 8; ++j) q[j] = *(const u32x4*)(qp + 8 * j);
            float sc[3];
#pragma unroll
            for (int c = 0; c < 3; ++c) {
                const int j = lane + 64 * c; const int ps = s - j * dil;
                float a = -1e30f;
                if (j <= 128 && ps >= 0) {
                    const bf16* kp = P + (rb + ps) * NPROJ + PC_DK + head * 64;
                    a = 0.f;
#pragma unroll
                    for (int jj = 0; jj < 8; ++jj) { const u32x4 kk = *(const u32x4*)(kp + 8 * jj);
                        a += bflo(q[jj].x) * bflo(kk.x) + bfhi(q[jj].x) * bfhi(kk.x) + bflo(q[jj].y) * bflo(kk.y) + bfhi(q[jj].y) * bfhi(kk.y)
                           + bflo(q[jj].z) * bflo(kk.z) + bfhi(q[jj].z) * bfhi(kk.z) + bflo(q[jj].w) * bflo(kk.w) + bfhi(q[jj].w) * bfhi(kk.w); }
                    a *= 0.125f;
                }
                sc[c] = a;
            }
            const float m = wave_max(fmaxf(fmaxf(sc[0], sc[1]), sc[2]));
            float p0 = (sc[0] > -1e29f) ? __expf(sc[0] - m) : 0.f, p1 = (sc[1] > -1e29f) ? __expf(sc[1] - m) : 0.f, p2 = (sc[2] > -1e29f) ? __expf(sc[2] - m) : 0.f;
            const float l = wave_sum(p0 + p1 + p2);
            float o = 0.f;
            const int nk = min(128, s / dil) + 1;
            const bf16* vbase = P + PC_DV + head * 64 + lane;
            for (int j = 0; j < nk; ++j) {
                const float pj = __shfl(j < 64 ? p0 : (j < 128 ? p1 : p2), j & 63);
                o += pj * bf2f(vbase[(rb + s - j * dil) * NPROJ]);
            }
            const float Mn = fmaxf(M, m), f0 = __expf(M - Mn), f1 = __expf(m - Mn);
            O = O * f0 + o * f1; L = L * f0 + l * f1; M = Mn;
        }
        Y[((size_t)half * HT + r) * YC + 1024 + hh * 64 + lane] = (bf16)f2bf(O / L);
    }
}

__device__ __forceinline__ void memattn_naive_phase(Frame& F, int half) {
    const bf16* P = (const bf16*)(F.ws + WS_BIG);
    const bf16* MKV = (const bf16*)(F.ws + WS_MKV);
    bf16* Y = (bf16*)F.out;
    LAS float* sq = (LAS float*)(F.lds) + F.wave * 192;
    const int gw = F.bid * NWAVES + F.wave, NGW = F.G * NWAVES, lane = F.lane;
    for (int it = gw; it < HT * 4; it += NGW) {
        const int r = it >> 2, head = it & 3;
        const int b = half * HB + (r >> 13);
        const bf16* qp = P + (size_t)r * NPROJ + PC_MQ + head * 192;
        sq[lane] = bf2f(qp[lane]); sq[lane + 64] = bf2f(qp[lane + 64]); sq[lane + 128] = bf2f(qp[lane + 128]);
        LDS_WAIT(); __builtin_amdgcn_wave_barrier();
        float sc[4];
#pragma unroll
        for (int c = 0; c < 4; ++c) {
            const bf16* kp = MKV + (size_t)(b * NMEM + lane + 64 * c) * 1536 + head * 192;
            float a = 0.f;
#pragma unroll 4
            for (int jj = 0; jj < 24; ++jj) { const u32x4 kk = *(const u32x4*)(kp + 8 * jj); const f32x4 qa = *(const LAS f32x4*)(sq + 8 * jj), qb = *(const LAS f32x4*)(sq + 8 * jj + 4);
                a += qa.x * bflo(kk.x) + qa.y * bfhi(kk.x) + qa.z * bflo(kk.y) + qa.w * bfhi(kk.y) + qb.x * bflo(kk.z) + qb.y * bfhi(kk.z) + qb.z * bflo(kk.w) + qb.w * bfhi(kk.w); }
            sc[c] = a * 0.07216878364870323f;
        }
        const float m = wave_max(fmaxf(fmaxf(sc[0], sc[1]), fmaxf(sc[2], sc[3])));
        float p[4];
#pragma unroll
        for (int c = 0; c < 4; ++c) p[c] = __expf(sc[c] - m);
        const float l = wave_sum((p[0] + p[1]) + (p[2] + p[3]));
        float o0 = 0.f, o1 = 0.f, o2 = 0.f;
        const bf16* vb = MKV + (size_t)(b * NMEM) * 1536 + 768 + head * 192 + lane;
#pragma unroll
        for (int c = 0; c < 4; ++c)
#pragma unroll 8
            for (int j = 0; j < 64; ++j) { const float pj = __shfl(p[c], j); const bf16* vp = vb + (size_t)(j + 64 * c) * 1536;
                o0 += pj * bf2f(vp[0]); o1 += pj * bf2f(vp[64]); o2 += pj * bf2f(vp[128]); }
        const float il = 1.0f / l;
        bf16* yp = Y + ((size_t)half * HT + r) * YC + 1280 + head * 192 + lane;
        yp[0] = (bf16)f2bf(o0 * il); yp[64] = (bf16)f2bf(o1 * il); yp[128] = (bf16)f2bf(o2 * il);
        __builtin_amdgcn_wave_barrier();
    }
}

__device__ __forceinline__ bf16x8 mk_bf16x8(u32x2 lo, u32x2 hi) { const u32x4 v = {lo.x, lo.y, hi.x, hi.y}; return __builtin_bit_cast(bf16x8, v); }

__device__ __forceinline__ void memattn_mfma_phase(Frame& F, int half) {
    const bf16* P = (const bf16*)(F.ws + WS_BIG);
    const bf16* MKV = (const bf16*)(F.ws + WS_MKV);
    const bf16* MVT = (const bf16*)(F.ws + WS_MVT);
    bf16* Y = (bf16*)F.out;
    LAS unsigned char* sm = F.lds;
    const int tid = F.tid, lane = F.lane, wave = F.wave, ql = lane & 31, h = lane >> 5;
    constexpr int KST = 400, VST = 528;
    for (int unit = F.bid; unit < HB * 4 * 32; unit += F.G) {
        const int bl = unit >> 7, head = (unit >> 5) & 3, qt = unit & 31, b = half * HB + bl;
        const int r = bl * SEQ + qt * 256 + wave * 32 + ql;
        __syncthreads();
        for (int c = tid; c < 256 * 24; c += NTHR) { const int row = c / 24, ch = c % 24;
            *(LAS u32x4*)(sm + row * KST + ch * 16) = *(const u32x4*)(MKV + (size_t)(b * NMEM + row) * 1536 + head * 192 + ch * 8); }
        bf16x8 qf[12];
        { const bf16* qp = P + (size_t)r * NPROJ + PC_MQ + head * 192 + 8 * h;
#pragma unroll
          for (int ks = 0; ks < 12; ++ks) qf[ks] = *(const bf16x8*)(qp + 16 * ks); }
        __syncthreads();
        f32x16 sacc[8];
#pragma unroll
        for (int mt = 0; mt < 8; ++mt) {
#pragma unroll
            for (int i = 0; i < 16; ++i) sacc[mt][i] = 0.f;
#pragma unroll
            for (int ks = 0; ks < 12; ++ks) { const bf16x8 kf = *(const LAS bf16x8*)(sm + (32 * mt + ql) * KST + 32 * ks + 16 * h); sacc[mt] = MFMA32(kf, qf[ks], sacc[mt]); }
        }
        float mx = -3.0e38f;
#pragma unroll
        for (int mt = 0; mt < 8; ++mt)
#pragma unroll
            for (int i = 0; i < 16; ++i) mx = fmaxf(mx, sacc[mt][i]);
        mx = fmaxf(mx, __shfl_xor(mx, 32));
        const float sc = 0.07216878364870323f * 1.4426950408889634f;
        float l = 0.f;
        bf16x8 pf[8][2];
#pragma unroll
        for (int mt = 0; mt < 8; ++mt) {
            float p[16];
#pragma unroll
            for (int i = 0; i < 16; ++i) { p[i] = __builtin_amdgcn_exp2f((sacc[mt][i] - mx) * sc); l += p[i]; }
#pragma unroll
            for (int s2 = 0; s2 < 2; ++s2) { const u32x4 w = {pkbf(p[8 * s2 + 0], p[8 * s2 + 1]), pkbf(p[8 * s2 + 2], p[8 * s2 + 3]), pkbf(p[8 * s2 + 4], p[8 * s2 + 5]), pkbf(p[8 * s2 + 6], p[8 * s2 + 7])};
                pf[mt][s2] = __builtin_bit_cast(bf16x8, w); }
        }
        l += __shfl_xor(l, 32);
        __syncthreads();
        for (int c = tid; c < 192 * 32; c += NTHR) { const int row = c >> 5, ch = c & 31;
            *(LAS u32x4*)(sm + row * VST + ch * 16) = *(const u32x4*)(MVT + (size_t)(head * 192 + row) * 2048 + b * NMEM + ch * 8); }
        __syncthreads();
        const float il = 1.0f / l;
        bf16* yp = Y + ((size_t)half * HT + r) * YC + 1280 + head * 192 + 4 * h;
#pragma unroll
        for (int dt = 0; dt < 6; ++dt) {
            f32x16 o;
#pragma unroll
            for (int i = 0; i < 16; ++i) o[i] = 0.f;
#pragma unroll
            for (int mt = 0; mt < 8; ++mt)
#pragma unroll
                for (int s2 = 0; s2 < 2; ++s2) { const LAS unsigned char* vp = sm + (32 * dt + ql) * VST + (32 * mt + 16 * s2 + 4 * h) * 2;
                    const bf16x8 vf = mk_bf16x8(*(const LAS u32x2*)vp, *(const LAS u32x2*)(vp + 16)); o = MFMA32(vf, pf[mt][s2], o); }
#pragma unroll
            for (int g = 0; g < 4; ++g) { const u32x2 w = {pkbf(o[4 * g] * il, o[4 * g + 1] * il), pkbf(o[4 * g + 2] * il, o[4 * g + 3] * il)}; *(u32x2*)(yp + 32 * dt + 8 * g) = w; }
        }
    }
}

__device__ __forceinline__ void dilattn_mfma_phase(Frame& F, int half) {
    bf16* P = (bf16*)(F.ws + WS_BIG);
    float* LSE = (float*)(F.ws + WS_LSE);
    LAS unsigned char* sK = F.lds; LAS unsigned char* sV = F.lds + 384 * 144;
    const int tid = F.tid, lane = F.lane, wave = F.wave, ql = lane & 31, h = lane >> 5;
    constexpr int RST = 144;
    for (int unit = F.bid; unit < HB * 12 * 32; unit += F.G) {
        const int bl = unit / 384, rem = unit % 384, head = rem >> 5, blk = rem & 31;
        const int g = head >> 2, dil = (g == 0) ? 1 : (g == 1 ? 4 : 16), bpr = 32 / dil;
        const int res = blk / bpr, q0 = (blk % bpr) * 256;
        const size_t rowb = (size_t)bl * SEQ;
        __syncthreads();
        for (int c = tid; c < 384 * 8; c += NTHR) { const int row = c >> 3, ch = c & 7; const int ks = q0 - 128 + row;
            u32x4 kv = {0u, 0u, 0u, 0u}, vv = {0u, 0u, 0u, 0u};
            if (ks >= 0) { const bf16* src = P + (rowb + (size_t)ks * dil + res) * NPROJ + head * 64 + ch * 8; kv = *(const u32x4*)(src + PC_DK); vv = *(const u32x4*)(src + PC_DV); }
            *(LAS u32x4*)(sK + row * RST + ch * 16) = kv; *(LAS u32x4*)(sV + row * RST + ch * 16) = vv; }
        const int qs = q0 + wave * 32 + ql;
        const size_t rq = rowb + (size_t)qs * dil + res;
        bf16* qp = P + rq * NPROJ + PC_DQ + head * 64;
        bf16x8 qf[4];
#pragma unroll
        for (int ks = 0; ks < 4; ++ks) qf[ks] = *(const bf16x8*)(qp + 16 * ks + 8 * h);
        __syncthreads();
        f32x16 sacc[5];
        const int kfirst = q0 + wave * 32 - 128;
#pragma unroll
        for (int i = 0; i < 5; ++i) {
#pragma unroll
            for (int e = 0; e < 16; ++e) sacc[i][e] = 0.f;
#pragma unroll
            for (int ks = 0; ks < 4; ++ks) { const bf16x8 kf = *(const LAS bf16x8*)(sK + (32 * wave + 32 * i + ql) * RST + 32 * ks + 16 * h); sacc[i] = MFMA32(kf, qf[ks], sacc[i]); }
        }
        float mx = -3.0e38f;
#pragma unroll
        for (int i = 0; i < 5; ++i)
#pragma unroll
            for (int e = 0; e < 16; ++e) { const int kj = 32 * i + (e & 3) + 8 * (e >> 2) + 4 * h; const bool ok = (kj >= ql) && (kj <= ql + 128) && (kfirst + kj >= 0);
                sacc[i][e] = ok ? sacc[i][e] : -3.0e38f; mx = fmaxf(mx, sacc[i][e]); }
        mx = fmaxf(mx, __shfl_xor(mx, 32));
        const float sc = 0.125f * 1.4426950408889634f;
        float l = 0.f;
        bf16x8 pf[5][2];
#pragma unroll
        for (int i = 0; i < 5; ++i) {
            float p[16];
#pragma unroll
            for (int e = 0; e < 16; ++e) { p[e] = (sacc[i][e] > -1.0e38f) ? __builtin_amdgcn_exp2f((sacc[i][e] - mx) * sc) : 0.f; l += p[e]; }
#pragma unroll
            for (int s2 = 0; s2 < 2; ++s2) { const u32x4 w = {pkbf(p[8 * s2 + 0], p[8 * s2 + 1]), pkbf(p[8 * s2 + 2], p[8 * s2 + 3]), pkbf(p[8 * s2 + 4], p[8 * s2 + 5]), pkbf(p[8 * s2 + 6], p[8 * s2 + 7])};
                pf[i][s2] = __builtin_bit_cast(bf16x8, w); }
        }
        l += __shfl_xor(l, 32);
        const float il = 1.0f / l;
        const int tq = (lane & 15) >> 2, tp = lane & 3, tblk = (lane >> 4) & 1;
        const unsigned vbase = (unsigned)(size_t)(sV) + (unsigned)((32 * wave + 4 * h + tq) * RST + (16 * tblk + 4 * tp) * 2);
#pragma unroll
        for (int dt = 0; dt < 2; ++dt) {
            f32x16 o;
#pragma unroll
            for (int e = 0; e < 16; ++e) o[e] = 0.f;
#pragma unroll
            for (int i = 0; i < 5; ++i) {
                s16x4 lo[2], hi[2];
#pragma unroll
                for (int s2 = 0; s2 < 2; ++s2) { const unsigned a = vbase + (unsigned)((32 * i + 16 * s2) * RST + 64 * dt);
                    asm volatile("ds_read_b64_tr_b16 %0, %1" : "=&v"(lo[s2]) : "v"(a) : "memory");
                    asm volatile("ds_read_b64_tr_b16 %0, %1 offset:1152" : "=&v"(hi[s2]) : "v"(a) : "memory"); }
                asm volatile("s_waitcnt lgkmcnt(0)" ::: "memory"); __builtin_amdgcn_sched_barrier(0);
#pragma unroll
                for (int s2 = 0; s2 < 2; ++s2) { const bf16x8 vf = {lo[s2][0], lo[s2][1], lo[s2][2], lo[s2][3], hi[s2][0], hi[s2][1], hi[s2][2], hi[s2][3]}; o = MFMA32(vf, pf[i][s2], o); }
            }
#pragma unroll
            for (int gq = 0; gq < 4; ++gq) { const u32x2 w = {pkbf(o[4 * gq] * il, o[4 * gq + 1] * il), pkbf(o[4 * gq + 2] * il, o[4 * gq + 3] * il)}; *(u32x2*)(qp + 32 * dt + 8 * gq + 4 * h) = w; }
        }
        if (h == 0) LSE[((size_t)half * HT + rq) * 12 + head] = mx * 0.125f + __logf(l);
    }
}

__device__ __forceinline__ void dilmerge_phase(Frame& F, int half) {
    const bf16* P = (const bf16*)(F.ws + WS_BIG);
    const float* LSE = (const float*)(F.ws + WS_LSE);
    bf16* Y = (bf16*)F.out;
    const size_t gtid = (size_t)F.bid * NTHR + F.tid, gth = (size_t)F.G * NTHR;
    for (size_t it = gtid; it < (size_t)HT * 32; it += gth) {
        const size_t r = it >> 5; const int hh = (int)(it >> 3) & 3, d0 = (int)(it & 7) * 8;
        const size_t tok = (size_t)half * HT + r;
        const float l0 = LSE[tok * 12 + hh], l1 = LSE[tok * 12 + 4 + hh], l2 = LSE[tok * 12 + 8 + hh];
        const float m = fmaxf(l0, fmaxf(l1, l2));
        float w0 = __expf(l0 - m), w1 = __expf(l1 - m), w2 = __expf(l2 - m); const float iw = 1.0f / (w0 + w1 + w2); w0 *= iw; w1 *= iw; w2 *= iw;
        const bf16* op = P + r * NPROJ + PC_DQ + hh * 64 + d0;
        const u32x4 a = *(const u32x4*)op, b = *(const u32x4*)(op + 256), c = *(const u32x4*)(op + 512);
        u32x4 o;
        o.x = pkbf(w0 * bflo(a.x) + w1 * bflo(b.x) + w2 * bflo(c.x), w0 * bfhi(a.x) + w1 * bfhi(b.x) + w2 * bfhi(c.x));
        o.y = pkbf(w0 * bflo(a.y) + w1 * bflo(b.y) + w2 * bflo(c.y), w0 * bfhi(a.y) + w1 * bfhi(b.y) + w2 * bfhi(c.y));
        o.z = pkbf(w0 * bflo(a.z) + w1 * bflo(b.z) + w2 * bflo(c.z), w0 * bfhi(a.z) + w1 * bfhi(b.z) + w2 * bfhi(c.z));
        o.w = pkbf(w0 * bflo(a.w) + w1 * bflo(b.w) + w2 * bflo(c.w), w0 * bfhi(a.w) + w1 * bfhi(b.w) + w2 * bfhi(c.w));
        *(u32x4*)(Y + tok * YC + 1024 + hh * 64 + d0) = o;
    }
}

__device__ __forceinline__ void hn_phase(Frame& F) {
    const int gw = F.bid * NWAVES + F.wave, NGW = F.G * NWAVES;
    for (int m = gw; m < T; m += NGW) { f32x4 v[4]; rms_row_to_bf16(F.out + (size_t)m * DM, F.in[I_NFFNW], (bf16*)(F.ws + WS_ACT1) + (size_t)m * DM, F.lane, v); }
}

__device__ __forceinline__ float gelu_erf(float x) { return 0.5f * x * (1.0f + erff(x * 0.70710678118654752f)); }
__device__ __forceinline__ void peer_naive_phase(Frame& F) {
    const bf16* Q = (const bf16*)(F.ws + WS_BIG);
    const bf16* SK = (const bf16*)(F.ws + WS_SUBK);
    const bf16* PD = (const bf16*)(F.ws + WS_PD); const bf16* PU = (const bf16*)(F.ws + WS_PU);
    const bf16* HN = (const bf16*)(F.ws + WS_ACT1);
    LAS float* sq = (LAS float*)F.lds;
    LAS float* ssc = sq + 16 * 256;
    LAS float* stv = ssc + 16 * 256;
    LAS int* sti = (LAS int*)(stv + 16 * 32);
    LAS int* sidx = sti + 16 * 32;
    LAS float* sgate = (LAS float*)(sidx + 16 * 128);
    const int tid = F.tid, lane = F.lane, wave = F.wave;
    for (int tile = F.bid; tile < T / 16; tile += F.G) {
        const size_t tok0 = (size_t)tile * 16;
#pragma unroll 1
        for (int h = 0; h < PEER_H; ++h) {
            __syncthreads();
            for (int i = tid; i < 16 * 256; i += NTHR) sq[i] = bf2f(Q[(tok0 + (i >> 8)) * PEER_Q + h * 256 + (i & 255)]);
            __syncthreads();
            {
                const int c = tid >> 8, k = (tid >> 1) & 127, th = tid & 1;
                const bf16* kp = SK + ((size_t)(h * 2 + c) * 128 + k) * 128;
                float a[8];
#pragma unroll
                for (int j = 0; j < 8; ++j) a[j] = 0.f;
#pragma unroll 2
                for (int d8 = 0; d8 < 16; ++d8) { const u32x4 kk = *(const u32x4*)(kp + 8 * d8);
                    const float k0 = bflo(kk.x), k1 = bfhi(kk.x), k2 = bflo(kk.y), k3 = bfhi(kk.y), k4 = bflo(kk.z), k5 = bfhi(kk.z), k6 = bflo(kk.w), k7 = bfhi(kk.w);
#pragma unroll
                    for (int j = 0; j < 8; ++j) { const LAS float* qq = sq + (th * 8 + j) * 256 + c * 128 + 8 * d8; const f32x4 qa = *(const LAS f32x4*)qq, qb = *(const LAS f32x4*)(qq + 4);
                        a[j] += (qa.x * k0 + qa.y * k1) + (qa.z * k2 + qa.w * k3) + (qb.x * k4 + qb.y * k5) + (qb.z * k6 + qb.w * k7); } }
#pragma unroll
                for (int j = 0; j < 8; ++j) ssc[((th * 8 + j) * 2 + c) * 128 + k] = a[j];
            }
            __syncthreads();
#pragma unroll 1
            for (int li = 0; li < 4; ++li) {
                const int list = wave * 4 + li;
                float v0 = ssc[list * 128 + lane], v1 = ssc[list * 128 + 64 + lane];
#pragma unroll 1
                for (int rnk = 0; rnk < 16; ++rnk) {
                    float bv = fmaxf(v0, v1); int bi = (v0 >= v1) ? lane : lane + 64;
#pragma unroll
                    for (int o = 1; o < 64; o <<= 1) { const float ov = __shfl_xor(bv, o); const int oi = __shfl_xor(bi, o); if (ov > bv || (ov == bv && oi < bi)) { bv = ov; bi = oi; } }
                    if (bi == lane) v0 = -3.0e38f; if (bi == lane + 64) v1 = -3.0e38f;
                    if (lane == 0) { stv[list * 16 + rnk] = bv; sti[list * 16 + rnk] = bi; }
                }
            }
            __syncthreads();
#pragma unroll 1
            for (int li = 0; li < 2; ++li) {
                const int tk = wave * 2 + li;
                float cv[4]; int ci[4];
#pragma unroll
                for (int j = 0; j < 4; ++j) { const int id = lane + 64 * j, a = id >> 4, b = id & 15; cv[j] = stv[(tk * 2 + 0) * 16 + a] + stv[(tk * 2 + 1) * 16 + b]; ci[j] = id; }
                float myv = 0.f; int myi = 0;
#pragma unroll 1
                for (int rnk = 0; rnk < 16; ++rnk) {
                    float bv = cv[0]; int bi = ci[0];
#pragma unroll
                    for (int j = 1; j < 4; ++j) if (cv[j] > bv) { bv = cv[j]; bi = ci[j]; }
#pragma unroll
                    for (int o = 1; o < 64; o <<= 1) { const float ov = __shfl_xor(bv, o); const int oi = __shfl_xor(bi, o); if (ov > bv || (ov == bv && oi < bi)) { bv = ov; bi = oi; } }
#pragma unroll
                    for (int j = 0; j < 4; ++j) if (ci[j] == bi) cv[j] = -3.0e38f;
                    if (lane == rnk) { myv = bv; myi = bi; }
                }
                const float mx = __shfl(myv, 0);
                const float e = (lane < 16) ? __expf(myv - mx) : 0.f;
                const float den = wave_sum(e);
                if (lane < 16) { const int a = myi >> 4, b = myi & 15;
                    sidx[tk * 128 + h * 16 + lane] = sti[(tk * 2 + 0) * 16 + a] * 128 + sti[(tk * 2 + 1) * 16 + b];
                    sgate[tk * 128 + h * 16 + lane] = e / den; }
            }
        }
        __syncthreads();
#pragma unroll 1
        for (int li = 0; li < 2; ++li) {
            const int tk = wave * 2 + li; const size_t tok = tok0 + tk;
            float hv[16], oacc[16];
            { const u32x4 a = *(const u32x4*)(HN + tok * DM + 8 * lane), b = *(const u32x4*)(HN + tok * DM + 512 + 8 * lane);
              hv[0] = bflo(a.x); hv[1] = bfhi(a.x); hv[2] = bflo(a.y); hv[3] = bfhi(a.y); hv[4] = bflo(a.z); hv[5] = bfhi(a.z); hv[6] = bflo(a.w); hv[7] = bfhi(a.w);
              hv[8] = bflo(b.x); hv[9] = bfhi(b.x); hv[10] = bflo(b.y); hv[11] = bfhi(b.y); hv[12] = bflo(b.z); hv[13] = bfhi(b.z); hv[14] = bflo(b.w); hv[15] = bfhi(b.w); }
#pragma unroll
            for (int j = 0; j < 16; ++j) oacc[j] = 0.f;
#pragma unroll 1
            for (int e0 = 0; e0 < 128; e0 += 4) {
                u32x4 da[4], db[4], ua[4], ub[4]; float gt[4];
#pragma unroll
                for (int j = 0; j < 4; ++j) { const int id = sidx[tk * 128 + e0 + j]; gt[j] = sgate[tk * 128 + e0 + j];
                    const bf16* dp = PD + (size_t)id * DM + 8 * lane; const bf16* up = PU + (size_t)id * DM + 8 * lane;
                    da[j] = *(const u32x4*)dp; db[j] = *(const u32x4*)(dp + 512); ua[j] = *(const u32x4*)up; ub[j] = *(const u32x4*)(up + 512); }
#pragma unroll
                for (int j = 0; j < 4; ++j) {
                    float d = (hv[0] * bflo(da[j].x) + hv[1] * bfhi(da[j].x)) + (hv[2] * bflo(da[j].y) + hv[3] * bfhi(da[j].y)) + (hv[4] * bflo(da[j].z) + hv[5] * bfhi(da[j].z)) + (hv[6] * bflo(da[j].w) + hv[7] * bfhi(da[j].w))
                            + (hv[8] * bflo(db[j].x) + hv[9] * bfhi(db[j].x)) + (hv[10] * bflo(db[j].y) + hv[11] * bfhi(db[j].y)) + (hv[12] * bflo(db[j].z) + hv[13] * bfhi(db[j].z)) + (hv[14] * bflo(db[j].w) + hv[15] * bfhi(db[j].w));
                    d = wave_sum(d);
                    const float cf = gt[j] * gelu_erf(d);
                    oacc[0] += cf * bflo(ua[j].x); oacc[1] += cf * bfhi(ua[j].x); oacc[2] += cf * bflo(ua[j].y); oacc[3] += cf * bfhi(ua[j].y);
                    oacc[4] += cf * bflo(ua[j].z); oacc[5] += cf * bfhi(ua[j].z); oacc[6] += cf * bflo(ua[j].w); oacc[7] += cf * bfhi(ua[j].w);
                    oacc[8] += cf * bflo(ub[j].x); oacc[9] += cf * bfhi(ub[j].x); oacc[10] += cf * bflo(ub[j].y); oacc[11] += cf * bfhi(ub[j].y);
                    oacc[12] += cf * bflo(ub[j].z); oacc[13] += cf * bfhi(ub[j].z); oacc[14] += cf * bflo(ub[j].w); oacc[15] += cf * bfhi(ub[j].w);
                }
            }
            float* op = F.out + tok * DM + 8 * lane;
            f32x4 r0 = *(const f32x4*)op, r1 = *(const f32x4*)(op + 4), r2 = *(const f32x4*)(op + 512), r3 = *(const f32x4*)(op + 516);
            r0.x += oacc[0]; r0.y += oacc[1]; r0.z += oacc[2]; r0.w += oacc[3]; r1.x += oacc[4]; r1.y += oacc[5]; r1.z += oacc[6]; r1.w += oacc[7];
            r2.x += oacc[8]; r2.y += oacc[9]; r2.z += oacc[10]; r2.w += oacc[11]; r3.x += oacc[12]; r3.y += oacc[13]; r3.z += oacc[14]; r3.w += oacc[15];
            *(f32x4*)op = r0; *(f32x4*)(op + 4) = r1; *(f32x4*)(op + 512) = r2; *(f32x4*)(op + 516) = r3;
        }
    }
}

constexpr int N_PHASES = 15;
__global__ void __launch_bounds__(NTHR, 2) mega_fwd(Args args) {
    extern __shared__ __attribute__((aligned(16))) unsigned char lds_raw[];
    Frame F;
    F.lds = (LAS unsigned char*)lds_raw;
    F.tid = threadIdx.x; F.lane = F.tid & 63; F.wave = __builtin_amdgcn_readfirstlane(F.tid >> 6);
    F.G = gridDim.x; F.bid = blockIdx.x;
#pragma unroll
    for (int i = 0; i < 26; ++i) F.in[i] = args.in[i];
    F.positions = args.positions; F.out = args.out; F.ws = args.ws;
    unsigned char* ws = args.ws;
    volatile LAS unsigned* ctlw = (volatile LAS unsigned*)(F.lds + LDSCTL_OFF);
    if (F.tid < 64) ctlw[F.tid] = 0u;
    __syncthreads();
    const int lo = args.ph_lo, hi = args.ph_hi;
    XcdBarrier bar; bar.bar = (unsigned*)(ws + WS_CTL); bar.x = 0; bar.st = nullptr;
    if (hi - lo > 1) bar = xcd_barrier_post((unsigned*)(ws + WS_CTL), ctlw + 8);
#define IN(k) (lo <= (k) && (k) < hi)
#define SEAM(k) do { if (IN(k) && IN((k) + 1)) xcd_barrier(bar); } while (0)
    bf16* ACT1 = (bf16*)(ws + WS_ACT1); bf16* BIG = (bf16*)(ws + WS_BIG); bf16* WallT = (bf16*)(ws + WS_WALLT);

    if (IN(0)) { p0_prologue(F); __syncthreads(); }
    SEAM(0);
    if (IN(1)) {
        { pg8::Gemm g{(const bf16*)(ws + WS_MEMN), (const bf16*)(ws + WS_WMKVT), NB * NMEM, 768, DM, DM, DM}; pg8::StaticOrder S; S.init(g.M, g.N, F.G, F.bid);
          pg8::EpiBf16<0> E{(bf16*)(ws + WS_MKV), 1536}; pg8::gemm_phase(F.lds, g, S, E); }
        { pg8::Gemm g{(const bf16*)(ws + WS_WMKVT) + (size_t)768 * DM, (const bf16*)(ws + WS_MEMN), 768, NB * NMEM, DM, DM, DM}; pg8::StaticOrder S; S.init(g.M, g.N, F.G, F.G - 1 - F.bid);
          pg8::EpiBf16<0> E{(bf16*)(ws + WS_MVT), NB * NMEM}; pg8::gemm_phase(F.lds, g, S, E); }
        { pg8::Gemm g{ACT1, WallT, HT, NPROJ, DM, DM, DM}; pg8::StaticOrder S; S.init(g.M, g.N, F.G, F.bid);
          pg8::EpiBf16<0> E{BIG, NPROJ}; pg8::gemm_phase(F.lds, g, S, E); }
    }
    SEAM(1);
    if (IN(2)) { qkprep_phase(F, 0); ssd_naive_phase(F, 0); }
    SEAM(2);
    if (IN(3)) { gatenorm_phase(F, 0); dilattn_mfma_phase(F, 0); memattn_mfma_phase(F, 0); }
    SEAM(3);
    if (IN(4)) dilmerge_phase(F, 0);
    SEAM(4);
    if (IN(5)) { pg8::Gemm g{ACT1 + (size_t)HT * DM, WallT, HT, NPROJ, DM, DM, DM}; pg8::StaticOrder S; S.init(g.M, g.N, F.G, F.bid);
        pg8::EpiBf16<0> E{BIG, NPROJ}; pg8::gemm_phase(F.lds, g, S, E); }
    SEAM(5);
    if (IN(6)) { qkprep_phase(F, 1); ssd_naive_phase(F, 1); }
    SEAM(6);
    if (IN(7)) { gatenorm_phase(F, 1); dilattn_mfma_phase(F, 1); memattn_mfma_phase(F, 1); }
    SEAM(7);
    if (IN(8)) dilmerge_phase(F, 1);
    SEAM(8);
    if (IN(9)) { pg8::Gemm g{ACT1, WallT + (size_t)NPROJ * DM, T, NGATE, DM, DM, DM}; pg8::StaticOrder S; S.init(g.M, g.N, F.G, F.bid);
        pg8::EpiBf16<1> E{BIG, NGATE}; pg8::gemm_phase(F.lds, g, S, E); }
    SEAM(9);
    if (IN(10)) {
        const bf16* Yc = (const bf16*)F.out; const bf16* Wc = (const bf16*)(ws + WS_WCATT);
        { pg8::Gemm g{Yc, Wc, T, DM, 1024, YC, YC}; pg8::StaticOrder S; S.init(g.M, g.N, F.G, F.bid); pg8::EpiBranch<false> E{ACT1, DM, BIG, NGATE, 0}; pg8::gemm_phase(F.lds, g, S, E); }
        { pg8::Gemm g{Yc + 1024, Wc + 1024, T, DM, 256, YC, YC}; pg8::StaticOrder S; S.init(g.M, g.N, F.G, F.bid); pg8::EpiBranch<true> E{ACT1, DM, BIG, NGATE, 1024}; pg8::gemm_phase(F.lds, g, S, E); }
        { pg8::Gemm g{Yc + 1280, Wc + 1280, T, DM, 768, YC, YC}; pg8::StaticOrder S; S.init(g.M, g.N, F.G, F.bid); pg8::EpiBranch<true> E{ACT1, DM, BIG, NGATE, 2048}; pg8::gemm_phase(F.lds, g, S, E); }
    }
    SEAM(10);
    if (IN(11)) { pg8::Gemm g{ACT1, (const bf16*)(ws + WS_WOUTT), T, DM, DM, DM, DM}; pg8::StaticOrder S; S.init(g.M, g.N, F.G, F.bid);
        pg8::EpiResid E{F.out, DM, F.in[I_X]}; pg8::gemm_phase(F.lds, g, S, E); }
    SEAM(11);
    if (IN(12)) hn_phase(F);
    SEAM(12);
    if (IN(13)) { pg8::Gemm g{ACT1, (const bf16*)(ws + WS_WQT), T, PEER_Q, DM, DM, DM}; pg8::StaticOrder S; S.init(g.M, g.N, F.G, F.bid);
        pg8::EpiBf16<0> E{BIG, PEER_Q}; pg8::gemm_phase(F.lds, g, S, E); }
    SEAM(13);
    if (IN(14)) peer_naive_phase(F);
#undef IN
#undef SEAM
}

extern "C" void kernel_launch(void* const* d_in, const int* in_sizes, int n_in, void* d_out, int out_size, void* d_ws, size_t ws_size, hipStream_t stream) {
    static int grid = 0;
    if (grid == 0) {
        if (n_in != 26 || out_size != T * DM || ws_size < WS_END) { fprintf(stderr, "kernel_launch: unexpected shapes (n_in %d, out %d, ws %zu)\n", n_in, out_size, ws_size); grid = -1; return; }
        int dev = 0, cus = 0;
        if (hipGetDevice(&dev) != hipSuccess || hipDeviceGetAttribute(&cus, hipDeviceAttributeMultiprocessorCount, dev) != hipSuccess) { grid = -1; return; }
        if (hipFuncSetAttribute((const void*)mega_fwd, hipFuncAttributeMaxDynamicSharedMemorySize, LDS_BYTES) != hipSuccess) { grid = -1; return; }
        int per_cu = 0;
        (void)hipOccupancyMaxActiveBlocksPerMultiprocessor(&per_cu, (const void*)mega_fwd, NTHR, LDS_BYTES);
        (void)hipGetLastError();
        grid = cus;
    }
    if (grid < 0) return;
    (void)hipMemsetAsync((char*)d_ws + WS_CTL, 0, CTL_ZERO_BYTES, stream);
    Args a{};
    for (int i = 0; i < 26; ++i) a.in[i] = (const float*)d_in[i];
    a.positions = (const int*)d_in[2]; a.out = (float*)d_out; a.ws = (unsigned char*)d_ws;
#if MK_N_LAUNCHES == 1
    a.ph_lo = 0; a.ph_hi = N_PHASES;
    hipLaunchKernelGGL(mega_fwd, dim3(grid), dim3(NTHR), LDS_BYTES, stream, a);
#else
    for (int p = 0; p < N_PHASES; ++p) { a.ph_lo = p; a.ph_hi = p + 1; hipLaunchKernelGGL(mega_fwd, dim3(grid), dim3(NTHR), LDS_BYTES, stream, a); }
#endif
}
```

```cpp
#include <hip/hip_runtime.h>
#include <cstdio>
#include <cstdint>

#ifndef MK_N_LAUNCHES
#define MK_N_LAUNCHES 1
#endif

#define LAS __attribute__((address_space(3)))
#define GAS __attribute__((address_space(1)))
typedef unsigned short bf16;
typedef short bf16x8 __attribute__((ext_vector_type(8)));
typedef float f32x4 __attribute__((ext_vector_type(4)));
typedef float f32x2 __attribute__((ext_vector_type(2)));
typedef unsigned u32x4 __attribute__((ext_vector_type(4)));
typedef unsigned u32x2 __attribute__((ext_vector_type(2)));

constexpr int NB = 8, SEQ = 8192, DM = 1024, T = NB * SEQ;
constexpr int HB = 4, HT = HB * SEQ;
constexpr int NMEM = 256;
constexpr int NPROJ = 6144;
constexpr int PC_Z = 0, PC_X = 1024, PC_B = 2048, PC_C = 2560, PC_DQ = 3072, PC_DK = 3840, PC_DV = 4608, PC_MQ = 5376;
constexpr int W_IN_N = 9232, OFF_DT = 3072, OFF_AFTER_DT = 3088;
constexpr int NGATE = 3072;
constexpr int YC = 2048;
constexpr int PEER_H = 8, PEER_K = 16, PEER_NK = 128, PEER_Q = 2048;
constexpr float EPS = 1e-6f;

constexpr size_t MiB = 1u << 20;
constexpr size_t WS_CTL = 0, CTL_ZERO_BYTES = 65536;
constexpr size_t WS_WALLT = 1 * MiB;
constexpr size_t WS_WMKVT = 19 * MiB;
constexpr size_t WS_WCATT = 22 * MiB;
constexpr size_t WS_WOUTT = 26 * MiB;
constexpr size_t WS_WQT = 28 * MiB;
constexpr size_t WS_SUBK = 32 * MiB;
constexpr size_t WS_PD = 33 * MiB;
constexpr size_t WS_PU = 65 * MiB;
constexpr size_t WS_DT = 97 * MiB;
constexpr size_t WS_MEMN = 101 * MiB;
constexpr size_t WS_MKV = 105 * MiB;
constexpr size_t WS_ACT1 = 112 * MiB;
constexpr size_t WS_BIG = 240 * MiB;
constexpr size_t WS_LSE = 624 * MiB;
constexpr size_t WS_MVT = 628 * MiB;
constexpr size_t WS_DEC = 631 * MiB;
constexpr size_t WS_SST = 632 * MiB;
constexpr size_t WS_SIN = 760 * MiB;
constexpr size_t WS_END = 824 * MiB;

constexpr int RING_BYTES = 131072;
constexpr int LDSCTL_OFF = 143360;
constexpr int LDS_BYTES = 147456;
constexpr int NWAVES = 8, NTHR = 512;

__device__ __forceinline__ float bf2f(unsigned short b) { return __builtin_bit_cast(float, (unsigned)b << 16); }
__device__ __forceinline__ float bflo(unsigned w) { return __builtin_bit_cast(float, w << 16); }
__device__ __forceinline__ float bfhi(unsigned w) { return __builtin_bit_cast(float, w & 0xffff0000u); }
__device__ __forceinline__ unsigned f2bf(float f) { unsigned u = __builtin_bit_cast(unsigned, f); return (u + 0x7fffu + ((u >> 16) & 1u)) >> 16; }
__device__ __forceinline__ unsigned pk2(float lo, float hi) { return f2bf(lo) | (f2bf(hi) << 16); }
typedef float f32x16 __attribute__((ext_vector_type(16)));
typedef short s16x4 __attribute__((ext_vector_type(4)));
typedef __bf16 bf2_t __attribute__((ext_vector_type(2)));
__device__ __forceinline__ unsigned pkbf(float a, float b) { const f32x2 v = {a, b}; return __builtin_bit_cast(unsigned, __builtin_convertvector(v, bf2_t)); }
#define MFMA32(a, b, c) __builtin_amdgcn_mfma_f32_32x32x16_bf16((a), (b), (c), 0, 0, 0)
__device__ __forceinline__ float wave_sum(float v) {
#pragma unroll
    for (int o = 1; o < 64; o <<= 1) v += __shfl_xor(v, o);
    return v;
}
__device__ __forceinline__ float wave_max(float v) {
#pragma unroll
    for (int o = 1; o < 64; o <<= 1) v = fmaxf(v, __shfl_xor(v, o));
    return v;
}
__device__ __forceinline__ float sigmoidf_(float x) { return 1.0f / (1.0f + __expf(-x)); }
#define LDS_WAIT() asm volatile("s_waitcnt lgkmcnt(0)" ::: "memory")
#define VM_WAIT() asm volatile("s_waitcnt vmcnt(0)" ::: "memory")

#define XB_TMO      128
#define XB_XCNT(j)  (256  + 64 * (j))
#define XB_XSUB(j)  (1280 + 64 * (j))
#define XB_XGEN(j)  (2304 + 64 * (j))
#define XB_TOP      3328
#define XB_TOPGEN   3392
#define XCD_BAR_WORDS 3456
#define XB_SPIN_CAP (1u << 18)
__device__ __forceinline__ unsigned xb_ld(unsigned* p)              { return __hip_atomic_load(p, __ATOMIC_RELAXED, __HIP_MEMORY_SCOPE_AGENT); }
__device__ __forceinline__ unsigned xb_add(unsigned* p, unsigned v) { return __hip_atomic_fetch_add(p, v, __ATOMIC_RELAXED, __HIP_MEMORY_SCOPE_AGENT); }
__device__ __forceinline__ unsigned xb_xcc_id() { return (unsigned)__builtin_amdgcn_s_getreg((3 << 11) | 20) & 0xFu; }
#define XB_SPIN(cond, bar) do { unsigned _sp = 0; while (cond) { __builtin_amdgcn_s_sleep(1); \
    if ((++_sp & 255u) == 0u) { if (xb_ld(&(bar)[XB_TMO])) break; if (_sp > XB_SPIN_CAP) { atomicAdd(&(bar)[XB_TMO], 1u); break; } } } } while (0)
struct XcdBarrier { unsigned* bar; unsigned x; volatile LAS unsigned* st; };
__device__ __forceinline__ XcdBarrier xcd_barrier_post(unsigned* bar, volatile LAS unsigned* st) {
    XcdBarrier b; b.bar = bar; b.x = xb_xcc_id(); b.st = st;
    if (threadIdx.x == 0) (void)xb_add(&bar[XB_XCNT(b.x)], 1u);
    return b;
}
__device__ __forceinline__ void xcd_barrier_complete(unsigned* bar, unsigned x, unsigned& nloc, unsigned& nx) {
    const unsigned G = gridDim.x * gridDim.y * gridDim.z;
    unsigned sum, cnt, mine, sp = 0u;
    for (;;) {
        sum = 0u; cnt = 0u; mine = 0u;
#pragma unroll
        for (unsigned j = 0; j < 16; ++j) { const unsigned c = xb_ld(&bar[XB_XCNT(j)]); sum += c; cnt += (c > 0u) ? 1u : 0u; mine = (j == x) ? c : mine; }
        if (sum == G) break;
        __builtin_amdgcn_s_sleep(1);
        if ((++sp & 255u) == 0u) { if (xb_ld(&bar[XB_TMO])) break; if (sp > XB_SPIN_CAP) { atomicAdd(&bar[XB_TMO], 1u); break; } }
    }
    nloc = mine > 0u ? mine : 1u; nx = cnt > 0u ? cnt : 1u;
}
__device__ __forceinline__ void xcd_barrier(const XcdBarrier& b) {
    asm volatile("s_waitcnt vmcnt(0)" ::: "memory");
    __syncthreads();
    if (threadIdx.x == 0) {
        unsigned* bar = b.bar;
        __builtin_amdgcn_s_waitcnt(0);
        unsigned nloc = b.st[0], nx = b.st[1];
        if (nloc == 0u) { xcd_barrier_complete(bar, b.x, nloc, nx); b.st[0] = nloc; b.st[1] = nx; }
        const unsigned old = xb_add(&bar[XB_XSUB(b.x)], 1u);
        const unsigned gen = old / nloc;
        if (old + 1u == (gen + 1u) * nloc) {
            __builtin_amdgcn_fence(__ATOMIC_RELEASE, "agent");
            asm volatile("s_waitcnt vmcnt(0)" ::: "memory");
            const unsigned og = xb_add(&bar[XB_TOP], 1u);
            const unsigned tg = og / nx;
            if (og + 1u == (tg + 1u) * nx) xb_add(&bar[XB_TOPGEN], 1u);
            else XB_SPIN(xb_ld(&bar[XB_TOPGEN]) == tg, bar);
            __builtin_amdgcn_fence(__ATOMIC_ACQUIRE, "agent");
            xb_add(&bar[XB_XGEN(b.x)], 1u);
            asm volatile("s_waitcnt vmcnt(0)" ::: "memory");
        } else {
            XB_SPIN(xb_ld(&bar[XB_XGEN(b.x)]) == gen, bar);
            __builtin_amdgcn_fence(__ATOMIC_ACQUIRE, "agent");
            asm volatile("s_waitcnt vmcnt(0)" ::: "memory");
        }
    }
    __syncthreads();
}

namespace pg8 {
constexpr int BM = 256, BK = 64, HALF = 128, HTB = HALF * BK * 2, STAGE_BYTES = 8 * HTB, NXCD = 8, WGM = 8;
__host__ __device__ __forceinline__ int lds_byte(int r, int c) { const int st = (r >> 4) * 2 + (c >> 5), rr = r & 15, cc = c & 31, ob = rr * 64 + cc * 2; return st * 1024 + (ob ^ (((ob >> 9) & 1) << 5)); }
__host__ __device__ __forceinline__ void stage_rc(int b, int& R, int& C) { const int st = b / 1024, sb = b % 1024, swz = sb ^ (((sb >> 9) & 1) << 5); R = (st >> 1) * 16 + swz / 64; C = (st & 1) * 32 + (swz % 64) / 2; }
__host__ __device__ __forceinline__ int perm32(int rho) { const int n = rho >> 4, i = rho & 15; return 8 * (i >> 2) + 4 * n + (i & 3); }
struct Unit { int pm, pn; };
struct Gemm { const bf16* A; const bf16* Bt; int M, N, K, lda, ldb; };
struct StaticOrder {
    int nM, nN, nwg, G, c;
    __host__ __device__ void init(int M, int N, int G_, int c_) { nM = M / BM; nN = N / BM; nwg = nM * nN; G = G_; c = c_; }
    __host__ __device__ bool next(int i, Unit& u) const {
        const long L = (long)i * G + c; if (L >= nwg) return false;
        int wgid = (int)L; { const int q = nwg / NXCD, r = nwg % NXCD, xcd = wgid % NXCD, off = wgid / NXCD; wgid = (xcd < r ? xcd * (q + 1) : r * (q + 1) + (xcd - r) * q) + off; }
        const int nig = WGM * nN, gid = wgid / nig, fm = gid * WGM, gsz = (nM - fm) < WGM ? (nM - fm) : WGM;
        u.pm = fm + ((wgid % nig) % gsz); u.pn = (wgid % nig) / gsz; return true;
    }
    __device__ __forceinline__ void a_ready(const Unit&) const {}
    __device__ __forceinline__ void done(const Unit&) const {}
};
__device__ __forceinline__ unsigned cvt_pk_bf16(float lo, float hi) { unsigned r; asm volatile("v_cvt_pk_bf16_f32 %0, %1, %2" : "=v"(r) : "v"(lo), "v"(hi)); return r; }

template <int ACT> struct EpiBf16 {
    static constexpr bool PERM = true, AFTER_DRAIN = false;
    bf16* O; int ldc;
    __device__ __forceinline__ void operator()(const f32x4 (&acc)[2][2][4][2], const Unit& u, int wr, int wc, int fr, int fq) const {
        const int row0 = u.pm * BM + wr * 64 + fr; const int col0 = u.pn * BM + wc * 32 + 8 * fq;
#pragma unroll
        for (int ai = 0; ai < 2; ++ai)
#pragma unroll
            for (int m = 0; m < 4; ++m) { bf16* rowp = O + (size_t)(row0 + ai * HALF + m * 16) * ldc + col0;
#pragma unroll
                for (int bj = 0; bj < 2; ++bj) { f32x4 v0 = acc[ai][bj][m][0], v1 = acc[ai][bj][m][1];
                    if (ACT == 1) {
#pragma unroll
                        for (int j = 0; j < 4; ++j) { v0[j] = sigmoidf_(v0[j]); v1[j] = sigmoidf_(v1[j]); } }
                    u32x4 w; w.x = cvt_pk_bf16(v0[0], v0[1]); w.y = cvt_pk_bf16(v0[2], v0[3]); w.z = cvt_pk_bf16(v1[0], v1[1]); w.w = cvt_pk_bf16(v1[2], v1[3]);
                    *(u32x4*)(rowp + bj * HALF) = w; } }
    }
};
template <bool ACCUM> struct EpiBranch {
    static constexpr bool PERM = true, AFTER_DRAIN = false;
    bf16* O; int ldc; const bf16* Gt; int ldg; int gcol0;
    __device__ __forceinline__ void operator()(const f32x4 (&acc)[2][2][4][2], const Unit& u, int wr, int wc, int fr, int fq) const {
        const int row0 = u.pm * BM + wr * 64 + fr; const int col0 = u.pn * BM + wc * 32 + 8 * fq;
#pragma unroll
        for (int ai = 0; ai < 2; ++ai)
#pragma unroll
            for (int m = 0; m < 4; ++m) { const size_t r = (size_t)(row0 + ai * HALF + m * 16); bf16* rowp = O + r * ldc + col0; const bf16* gp = Gt + r * ldg + gcol0 + col0;
#pragma unroll
                for (int bj = 0; bj < 2; ++bj) { const f32x4 v0 = acc[ai][bj][m][0], v1 = acc[ai][bj][m][1];
                    const u32x4 g = *(const u32x4*)(gp + bj * HALF);
                    float o[8];
                    o[0] = v0[0] * bflo(g.x); o[1] = v0[1] * bfhi(g.x); o[2] = v0[2] * bflo(g.y); o[3] = v0[3] * bfhi(g.y);
                    o[4] = v1[0] * bflo(g.z); o[5] = v1[1] * bfhi(g.z); o[6] = v1[2] * bflo(g.w); o[7] = v1[3] * bfhi(g.w);
                    if (ACCUM) { const u32x4 p = *(const u32x4*)(rowp + bj * HALF);
                        o[0] += bflo(p.x); o[1] += bfhi(p.x); o[2] += bflo(p.y); o[3] += bfhi(p.y); o[4] += bflo(p.z); o[5] += bfhi(p.z); o[6] += bflo(p.w); o[7] += bfhi(p.w); }
                    u32x4 w; w.x = cvt_pk_bf16(o[0], o[1]); w.y = cvt_pk_bf16(o[2], o[3]); w.z = cvt_pk_bf16(o[4], o[5]); w.w = cvt_pk_bf16(o[6], o[7]);
                    *(u32x4*)(rowp + bj * HALF) = w; } }
    }
};
struct EpiResid {
    static constexpr bool PERM = false, AFTER_DRAIN = false;
    float* C; int ldc; const float* R;
    __device__ __forceinline__ void operator()(const f32x4 (&acc)[2][2][4][2], const Unit& u, int wr, int wc, int fr, int fq) const {
        const int row0 = u.pm * BM + wr * 64 + fr, col0 = u.pn * BM + wc * 32 + 4 * fq;
#pragma unroll
        for (int ai = 0; ai < 2; ++ai)
#pragma unroll
            for (int m = 0; m < 4; ++m) { const size_t off = (size_t)(row0 + ai * HALF + m * 16) * ldc + col0;
#pragma unroll
                for (int bj = 0; bj < 2; ++bj)
#pragma unroll
                    for (int n = 0; n < 2; ++n) { const f32x4 r = *(const f32x4*)(R + off + bj * HALF + n * 16); *(f32x4*)(C + off + bj * HALF + n * 16) = acc[ai][bj][m][n] + r; } }
    }
};

template <class Epi, class Sched>
__device__ __forceinline__ void gemm_phase(LAS unsigned char* lds, const Gemm g, const Sched& S, const Epi& E) {
    const int tid = threadIdx.x, wid = __builtin_amdgcn_readfirstlane(tid >> 6), lane = tid & 63, wr = wid >> 2, wc = wid & 3, fr = lane & 15, fq = lane >> 4;
    const int K = g.K, nt = K / BK;
    unsigned voffA[2], voffB[2];
#pragma unroll
    for (int i = 0; i < 2; ++i) { int R, C; stage_rc(tid * 16 + i * 8192, R, C); const int Rb = Epi::PERM ? ((R & ~31) + perm32(R & 31)) : R;
        voffA[i] = (unsigned)(R * g.lda + C) * 2u; voffB[i] = (unsigned)(Rb * g.ldb + C) * 2u; }
    const size_t kstep = (size_t)(BK * 2);
    const size_t hsA = (size_t)HALF * g.lda * 2, hsB = (size_t)HALF * g.ldb * 2;
    const size_t tsA = 2 * hsA, tsB = 2 * hsB;
    const unsigned ldsw = (unsigned)wid * 1024u;
    const int aoff = lds_byte(wr * 64 + fr, fq * 8), boff = lds_byte(wc * 32 + fr, fq * 8);
#define PG8_SA(b, h) (((b) * 2 + (h)) * HTB)
#define PG8_SB(b, h) ((4 + (b) * 2 + (h)) * HTB)
#define PG8_STAGE(bufoff, gbase, voff) do { _Pragma("unroll") for (int _i = 0; _i < 2; ++_i) \
        __builtin_amdgcn_global_load_lds((const unsigned*)((const char*)(gbase) + (voff)[_i]), (LAS unsigned*)(lds + (bufoff) + ldsw + _i * 8192), 16, 0, 0); } while (0)
#define PG8_LDA(dst, b, h) do { _Pragma("unroll") for (int m = 0; m < 4; ++m) _Pragma("unroll") for (int k = 0; k < 2; ++k) dst[m][k] = *(const LAS bf16x8*)(lds + PG8_SA(b, h) + aoff + m * 2048 + k * 1024); } while (0)
#define PG8_LDB(dst, b, h) do { _Pragma("unroll") for (int n = 0; n < 2; ++n) _Pragma("unroll") for (int k = 0; k < 2; ++k) dst[n][k] = *(const LAS bf16x8*)(lds + PG8_SB(b, h) + boff + n * 2048 + k * 1024); } while (0)
#define PG8_MMA(ai, bj, At, Bt) do { __builtin_amdgcn_s_setprio(1); _Pragma("unroll") for (int m = 0; m < 4; ++m) _Pragma("unroll") for (int n = 0; n < 2; ++n) _Pragma("unroll") for (int k = 0; k < 2; ++k) \
        acc[ai][bj][m][n] = __builtin_amdgcn_mfma_f32_16x16x32_bf16(Bt[n][k], At[m][k], acc[ai][bj][m][n], 0, 0, 0); __builtin_amdgcn_s_setprio(0); } while (0)
#define PG8_WAIT_V(n) asm volatile("s_waitcnt vmcnt(" #n ")" ::: "memory")
#define PG8_WAIT_L(n) asm volatile("s_waitcnt lgkmcnt(" #n ")" ::: "memory")
#define PG8_BAR __builtin_amdgcn_s_barrier()
#define PG8_SCHED __builtin_amdgcn_sched_barrier(0)
    Unit cur, nxt; int ui = 0;
    if (!S.next(0, cur)) return;
    f32x4 acc[2][2][4][2];
#pragma unroll
    for (int a = 0; a < 2; ++a)
#pragma unroll
        for (int b = 0; b < 2; ++b)
#pragma unroll
            for (int m = 0; m < 4; ++m)
#pragma unroll
                for (int n = 0; n < 2; ++n) acc[a][b][m][n] = (f32x4){0.f, 0.f, 0.f, 0.f};
    bf16x8 At[4][2], B0[2][2], B1[2][2];
    const char* cA = (const char*)g.A + (size_t)cur.pm * tsA; const char* cB = (const char*)g.Bt + (size_t)cur.pn * tsB;
    S.a_ready(cur);
    PG8_STAGE(PG8_SB(0, 0), cB, voffB); PG8_STAGE(PG8_SA(0, 0), cA, voffA); PG8_STAGE(PG8_SB(0, 1), cB + hsB, voffB); PG8_STAGE(PG8_SA(0, 1), cA + hsA, voffA);
    if (wr == 1) PG8_BAR;
    PG8_WAIT_V(4); PG8_BAR;
    PG8_STAGE(PG8_SB(1, 0), cB + kstep, voffB); PG8_STAGE(PG8_SA(1, 0), cA + kstep, voffA); PG8_STAGE(PG8_SB(1, 1), cB + hsB + kstep, voffB);
    PG8_WAIT_V(6); PG8_BAR;
    for (;;) {
        const bool has_next = S.next(ui + 1, nxt);
        const char* nA = has_next ? (const char*)g.A + (size_t)nxt.pm * tsA : cA; const char* nB = has_next ? (const char*)g.Bt + (size_t)nxt.pn * tsB : cB;
        for (int t = 0; t < nt; t += 2) {
            const bool last = (t == nt - 2);
            const char* a1 = cA + (size_t)(t + 1) * kstep;
            const char* a2 = last ? nA : cA + (size_t)(t + 2) * kstep; const char* b2 = last ? nB : cB + (size_t)(t + 2) * kstep;
            const char* a3 = a2 + kstep; const char* b3 = b2 + kstep;
            if (last && has_next) S.a_ready(nxt);
            PG8_LDB(B0, 0, 0); PG8_SCHED; PG8_LDA(At, 0, 0); PG8_STAGE(PG8_SA(1, 1), a1 + hsA, voffA);
            PG8_WAIT_L(8); PG8_BAR; PG8_WAIT_L(0); PG8_MMA(0, 0, At, B0); PG8_BAR; PG8_SCHED;
            PG8_LDB(B1, 0, 1); PG8_STAGE(PG8_SB(0, 0), b2, voffB);
            PG8_BAR; PG8_WAIT_L(0); PG8_MMA(0, 1, At, B1); PG8_BAR;
            PG8_LDA(At, 0, 1); PG8_STAGE(PG8_SA(0, 0), a2, voffA);
            PG8_BAR; PG8_WAIT_L(0); PG8_MMA(1, 0, At, B0); PG8_BAR; PG8_SCHED;
            PG8_STAGE(PG8_SB(0, 1), b2 + hsB, voffB);
            PG8_WAIT_V(6); PG8_BAR; PG8_MMA(1, 1, At, B1); PG8_BAR;
            PG8_LDB(B0, 1, 0); PG8_SCHED; PG8_LDA(At, 1, 0); PG8_STAGE(PG8_SA(0, 1), a2 + hsA, voffA);
            PG8_WAIT_L(8); PG8_BAR; PG8_WAIT_L(0); PG8_MMA(0, 0, At, B0); PG8_BAR; PG8_SCHED;
            PG8_LDB(B1, 1, 1); PG8_STAGE(PG8_SB(1, 0), b3, voffB);
            PG8_BAR; PG8_WAIT_L(0); PG8_MMA(0, 1, At, B1); PG8_BAR;
            PG8_LDA(At, 1, 1); PG8_STAGE(PG8_SA(1, 0), a3, voffA);
            PG8_BAR; PG8_WAIT_L(0); PG8_MMA(1, 0, At, B0); PG8_BAR; PG8_SCHED;
            PG8_STAGE(PG8_SB(1, 1), b3 + hsB, voffB);
            PG8_WAIT_V(6); PG8_BAR; PG8_MMA(1, 1, At, B1); PG8_BAR;
        }
        E(acc, cur, wr, wc, fr, fq); S.done(cur);
        if (!has_next) break;
#pragma unroll
        for (int a = 0; a < 2; ++a)
#pragma unroll
            for (int b = 0; b < 2; ++b)
#pragma unroll
                for (int m = 0; m < 4; ++m)
#pragma unroll
                    for (int n = 0; n < 2; ++n) acc[a][b][m][n] = (f32x4){0.f, 0.f, 0.f, 0.f};
        cur = nxt; cA = nA; cB = nB; ++ui;
    }
    PG8_WAIT_V(0);
    if (wr == 0) PG8_BAR;
    PG8_BAR;
#undef PG8_SA
#undef PG8_SB
#undef PG8_STAGE
#undef PG8_LDA
#undef PG8_LDB
#undef PG8_MMA
#undef PG8_WAIT_V
#undef PG8_WAIT_L
#undef PG8_BAR
#undef PG8_SCHED
}
}

struct Args {
    const float* in[26]; const int* positions; float* out; unsigned char* ws; int ph_lo, ph_hi; int pad0, pad1;
};
struct Frame {
    LAS unsigned char* lds;
    int tid, lane, wave, G, bid;
    const float* in[26]; const int* positions; float* out; unsigned char* ws;
};
enum { I_X = 0, I_MEM = 1, I_POS = 2, I_NMIXW = 3, I_WIN = 4, I_CONVW = 5, I_CONVB = 6, I_DTB = 7, I_ALOG = 8, I_SSDD = 9, I_SSDNW = 10, I_DQNW = 11, I_DKNW = 12, I_MEMNW = 13,
       I_WMKV = 14, I_MQNW = 15, I_MKNW = 16, I_WSSD = 17, I_WDIL = 18, I_WMEMBR = 19, I_WOUT = 20, I_NFFNW = 21, I_WQ = 22, I_SUBK = 23, I_PD = 24, I_PU = 25 };

__device__ __forceinline__ void p0_transpose_item(const float* W, int ldw, int src_col0, bf16* WT, int ldt, int dst_row0, int dst_col0, int nblk, LAS float* scr, int item, int lane) {
    const int kb = item / nblk, nb = item % nblk, k0 = 64 * kb, n0 = 32 * nb;
#pragma unroll 8
    for (int i = 0; i < 32; ++i) { const int kk = 2 * i + (lane >> 5); scr[kk * 33 + (lane & 31)] = W[(size_t)(k0 + kk) * ldw + src_col0 + n0 + (lane & 31)]; }
    LDS_WAIT(); asm volatile("" ::: "memory");
    const int c = lane & 7;
#pragma unroll
    for (int j = 0; j < 4; ++j) { const int n = (lane >> 3) + 8 * j; const LAS float* s = scr + (8 * c) * 33 + n;
        u32x4 o; o.x = pk2(s[0 * 33], s[1 * 33]); o.y = pk2(s[2 * 33], s[3 * 33]); o.z = pk2(s[4 * 33], s[5 * 33]); o.w = pk2(s[6 * 33], s[7 * 33]);
        *(u32x4*)(WT + (size_t)(dst_row0 + n0 + n) * ldt + dst_col0 + k0 + 8 * c) = o; }
    LDS_WAIT(); asm volatile("" ::: "memory");
}
__device__ __forceinline__ void rms_row_to_bf16(const float* xrow, const float* w, bf16* orow, int lane, f32x4 (&v)[4]) {
    const f32x4* xr = (const f32x4*)xrow + lane; const f32x4* wr = (const f32x4*)w + lane;
    float s = 0.f;
#pragma unroll
    for (int j = 0; j < 4; ++j) { v[j] = xr[64 * j]; s += (v[j].x * v[j].x + v[j].y * v[j].y) + (v[j].z * v[j].z + v[j].w * v[j].w); }
    const float rstd = 1.0f / sqrtf(wave_sum(s) * (1.f / DM) + EPS);
    unsigned long long* o8 = (unsigned long long*)orow + lane;
#pragma unroll
    for (int j = 0; j < 4; ++j) { const f32x4 ww = wr[64 * j]; v[j] = v[j] * rstd * ww;
        o8[64 * j] = (unsigned long long)pk2(v[j].x, v[j].y) | ((unsigned long long)pk2(v[j].z, v[j].w) << 32); }
}
__device__ __forceinline__ void cvt_f32_bf16_stream(const float* src, bf16* dst, size_t n, size_t gtid, size_t gthreads) {
    for (size_t i = gtid * 8; i < n; i += gthreads * 8) { const f32x4 a = *(const f32x4*)(src + i), b = *(const f32x4*)(src + i + 4);
        u32x4 o; o.x = pk2(a.x, a.y); o.y = pk2(a.z, a.w); o.z = pk2(b.x, b.y); o.w = pk2(b.z, b.w); *(u32x4*)(dst + i) = o; }
}
__device__ __forceinline__ void p0_prologue(Frame& F) {
    LAS float* scr = (LAS float*)(F.lds + F.wave * 8448);
    LAS float* wdt = (LAS float*)(F.lds + 8 * 8448);
    const int gw = F.bid * NWAVES + F.wave, NGW = F.G * NWAVES;
    unsigned char* ws = F.ws;
    for (int i = F.tid; i < 1024 * 16; i += NTHR) wdt[i] = F.in[I_WIN][(size_t)(i >> 4) * W_IN_N + OFF_DT + (i & 15)];
    __syncthreads();
    constexpr int IT_A = 16 * 96, IT_B = 16 * 192, IT_MKV = 16 * 48, IT_SSD = 16 * 32, IT_DIL = 4 * 32, IT_MBR = 12 * 32, IT_OUT = 16 * 32, IT_WQ = 16 * 64;
    constexpr int NITEMS = IT_A + IT_B + IT_MKV + IT_SSD + IT_DIL + IT_MBR + IT_OUT + IT_WQ;
    bf16* WallT = (bf16*)(ws + WS_WALLT);
    for (int it = gw; it < NITEMS; it += NGW) {
        int r = it;
        if (r < IT_A) { p0_transpose_item(F.in[I_WIN], W_IN_N, 0, WallT, DM, 0, 0, 96, scr, r, F.lane); continue; } r -= IT_A;
        if (r < IT_B) { p0_transpose_item(F.in[I_WIN], W_IN_N, OFF_AFTER_DT, WallT, DM, 3072, 0, 192, scr, r, F.lane); continue; } r -= IT_B;
        if (r < IT_MKV) { p0_transpose_item(F.in[I_WMKV], 1536, 0, (bf16*)(ws + WS_WMKVT), DM, 0, 0, 48, scr, r, F.lane); continue; } r -= IT_MKV;
        if (r < IT_SSD) { p0_transpose_item(F.in[I_WSSD], DM, 0, (bf16*)(ws + WS_WCATT), YC, 0, 0, 32, scr, r, F.lane); continue; } r -= IT_SSD;
        if (r < IT_DIL) { p0_transpose_item(F.in[I_WDIL], DM, 0, (bf16*)(ws + WS_WCATT), YC, 0, 1024, 32, scr, r, F.lane); continue; } r -= IT_DIL;
        if (r < IT_MBR) { p0_transpose_item(F.in[I_WMEMBR], DM, 0, (bf16*)(ws + WS_WCATT), YC, 0, 1280, 32, scr, r, F.lane); continue; } r -= IT_MBR;
        if (r < IT_OUT) { p0_transpose_item(F.in[I_WOUT], DM, 0, (bf16*)(ws + WS_WOUTT), DM, 0, 0, 32, scr, r, F.lane); continue; } r -= IT_OUT;
        p0_transpose_item(F.in[I_WQ], PEER_Q, 0, (bf16*)(ws + WS_WQT), DM, 0, 0, 64, scr, r, F.lane);
    }
    const size_t gtid = (size_t)F.bid * NTHR + F.tid, gth = (size_t)F.G * NTHR;
    cvt_f32_bf16_stream(F.in[I_SUBK], (bf16*)(ws + WS_SUBK), (size_t)8 * 2 * 128 * 128, gtid, gth);
    cvt_f32_bf16_stream(F.in[I_PD], (bf16*)(ws + WS_PD), (size_t)16384 * 1024, gtid, gth);
    cvt_f32_bf16_stream(F.in[I_PU], (bf16*)(ws + WS_PU), (size_t)16384 * 1024, gtid, gth);
    for (int m = gw; m < NB * NMEM; m += NGW) { f32x4 v[4]; rms_row_to_bf16(F.in[I_MEM] + (size_t)m * DM, F.in[I_MEMNW], (bf16*)(ws + WS_MEMN) + (size_t)m * DM, F.lane, v); }
    float* DTp = (float*)(ws + WS_DT);
    for (int m = gw; m < T; m += NGW) {
        f32x4 v[4]; rms_row_to_bf16(F.in[I_X] + (size_t)m * DM, F.in[I_NMIXW], (bf16*)(ws + WS_ACT1) + (size_t)m * DM, F.lane, v);
        float d[16];
#pragma unroll
        for (int j = 0; j < 16; ++j) d[j] = 0.f;
#pragma unroll
        for (int j = 0; j < 4; ++j)
#pragma unroll
            for (int e = 0; e < 4; ++e) { const int k = 4 * F.lane + 256 * j + e; const float uv = v[j][e];
#pragma unroll
                for (int q = 0; q < 4; ++q) { const f32x4 w4 = *(const LAS f32x4*)(wdt + k * 16 + 4 * q); d[4 * q + 0] += uv * w4.x; d[4 * q + 1] += uv * w4.y; d[4 * q + 2] += uv * w4.z; d[4 * q + 3] += uv * w4.w; }
                __builtin_amdgcn_sched_barrier(0); }
        float mine = 0.f;
#pragma unroll
        for (int j = 0; j < 16; ++j) { const float s = wave_sum(d[j]); mine = (F.lane == j) ? s : mine; }
        if (F.lane < 16) { const float xx = mine + F.in[I_DTB][F.lane]; DTp[(size_t)m * 16 + F.lane] = (xx > 20.f) ? xx : log1pf(__expf(xx)); }
    }
}

__device__ __forceinline__ void qkprep_phase(Frame& F, int half) {
    bf16* P = (bf16*)(F.ws + WS_BIG);
    const int gw = F.bid * NWAVES + F.wave, NGW = F.G * NWAVES, lane = F.lane;
    const float wq = F.in[I_DQNW][lane], wk = F.in[I_DKNW][lane];
    const float wmq0 = F.in[I_MQNW][lane], wmq1 = F.in[I_MQNW][lane + 64], wmq2 = F.in[I_MQNW][lane + 128];
    const float inv = __expf(-logf(500000.0f) * (2.0f / 16.0f) * (float)(lane & 7));
    for (int r = gw; r < HT; r += NGW) {
        const int tok = half * HT + r;
        const int pos = F.positions[tok];
        const double rev = (double)((float)pos * inv) * 0.15915494309189535;
        const float fr = (float)(rev - floor(rev));
        const float cs = __builtin_amdgcn_cosf(fr), sn = __builtin_amdgcn_sinf(fr);
        bf16* row = P + (size_t)r * NPROJ;
#pragma unroll 4
        for (int h = 0; h < 24; ++h) {
            bf16* p = row + PC_DQ + h * 64 + lane;
            float v = bf2f(*p);
            const float ss = wave_sum(v * v);
            v = v * (1.0f / sqrtf(ss * (1.f / 64.f) + EPS)) * (h < 12 ? wq : wk);
            const float other = __shfl_xor(v, 8);
            if (lane < 8) v = v * cs - other * sn; else if (lane < 16) v = v * cs + other * sn;
            *p = (bf16)f2bf(v);
        }
#pragma unroll
        for (int h = 0; h < 4; ++h) {
            bf16* p = row + PC_MQ + h * 192 + lane;
            float v0 = bf2f(p[0]), v1 = bf2f(p[64]), v2 = bf2f(p[128]);
            const float ss = wave_sum(v0 * v0 + v1 * v1 + v2 * v2);
            const float rs = 1.0f / sqrtf(ss * (1.f / 192.f) + EPS);
            p[0] = (bf16)f2bf(v0 * rs * wmq0); p[64] = (bf16)f2bf(v1 * rs * wmq1); p[128] = (bf16)f2bf(v2 * rs * wmq2);
        }
    }
    if (half == 0) {
        bf16* MK = (bf16*)(F.ws + WS_MKV);
        const float wk0 = F.in[I_MKNW][lane], wk1 = F.in[I_MKNW][lane + 64], wk2 = F.in[I_MKNW][lane + 128];
        for (int r = gw; r < NB * NMEM * 4; r += NGW) {
            bf16* p = MK + (size_t)(r >> 2) * 1536 + (r & 3) * 192 + lane;
            float v0 = bf2f(p[0]), v1 = bf2f(p[64]), v2 = bf2f(p[128]);
            const float ss = wave_sum(v0 * v0 + v1 * v1 + v2 * v2);
            const float rs = 1.0f / sqrtf(ss * (1.f / 192.f) + EPS);
            p[0] = (bf16)f2bf(v0 * rs * wk0); p[64] = (bf16)f2bf(v1 * rs * wk1); p[128] = (bf16)f2bf(v2 * rs * wk2);
        }
    }
}

__device__ __forceinline__ void ssd_naive_phase(Frame& F, int half) {
    const bf16* P = (const bf16*)(F.ws + WS_BIG);
    bf16* Y = (bf16*)F.out;
    const float* DTp = (const float*)(F.ws + WS_DT);
    LAS float* sx = (LAS float*)F.lds;
    LAS float* sB = sx + 64 * 16;
    LAS float* sC = sB + 64 * 128;
    LAS float* sdt = sC + 64 * 128;
    LAS float* sy = sdt + 64;
    const int tid = F.tid, pl = tid >> 5, ng = tid & 31;
    const float* cw = F.in[I_CONVW]; const float* cb = F.in[I_CONVB];
    for (int chain = F.bid; chain < HB * 16 * 4; chain += F.G) {
        const int bl = chain >> 6, head = (chain >> 2) & 15, pq = chain & 3, grp = head >> 2;
        const float A = -__expf(F.in[I_ALOG][head]), Dh = F.in[I_SSDD][head];
        const size_t row0 = (size_t)bl * SEQ;
        const size_t tok0 = (size_t)half * HT + row0;
        float h0 = 0.f, h1 = 0.f, h2 = 0.f, h3 = 0.f;
        for (int t0 = 0; t0 < SEQ; t0 += 64) {
            __syncthreads();
            for (int o = tid; o < 64 * 272; o += NTHR) {
                const int tt = o / 272, cc = o % 272;
                int pcol, ccol;
                if (cc < 16) { ccol = head * 64 + pq * 16 + cc; }
                else if (cc < 144) { ccol = 1024 + grp * 128 + (cc - 16); }
                else { ccol = 1536 + grp * 128 + (cc - 144); }
                pcol = PC_X + ccol;
                const int t = t0 + tt;
                float a = cb[ccol];
#pragma unroll
                for (int k = 0; k < 4; ++k) { const int ts = t - 3 + k; if (ts >= 0) a += cw[k * 2048 + ccol] * bf2f(P[(row0 + ts) * NPROJ + pcol]); }
                a = a * sigmoidf_(a);
                if (cc < 16) sx[tt * 16 + cc] = a; else if (cc < 144) sB[tt * 128 + cc - 16] = a; else sC[tt * 128 + cc - 144] = a;
            }
            if (tid < 64) sdt[tid] = DTp[(tok0 + t0 + tid) * 16 + head];
            __syncthreads();
            for (int tt = 0; tt < 64; ++tt) {
                const float dt = sdt[tt], xv = sx[tt * 16 + pl];
                const float dA = __expf(dt * A), xdt = xv * dt;
                const f32x4 b4 = *(const LAS f32x4*)(sB + tt * 128 + 4 * ng), c4 = *(const LAS f32x4*)(sC + tt * 128 + 4 * ng);
                h0 = h0 * dA + xdt * b4.x; h1 = h1 * dA + xdt * b4.y; h2 = h2 * dA + xdt * b4.z; h3 = h3 * dA + xdt * b4.w;
                float acc = (h0 * c4.x + h1 * c4.y) + (h2 * c4.z + h3 * c4.w);
                acc += __shfl_xor(acc, 1); acc += __shfl_xor(acc, 2); acc += __shfl_xor(acc, 4); acc += __shfl_xor(acc, 8); acc += __shfl_xor(acc, 16);
                if (ng == 0) sy[tt * 16 + pl] = acc + Dh * xv;
            }
            __syncthreads();
            for (int o = tid; o < 64 * 16; o += NTHR) { const int tt = o >> 4, cc = o & 15; Y[(tok0 + t0 + tt) * YC + head * 64 + pq * 16 + cc] = (bf16)f2bf(sy[o]); }
        }
    }
}

__device__ __forceinline__ void gatenorm_phase(Frame& F, int half) {
    const bf16* P = (const bf16*)(F.ws + WS_BIG);
    bf16* Y = (bf16*)F.out;
    const int gw = F.bid * NWAVES + F.wave, NGW = F.G * NWAVES, lane = F.lane;
    const float* nw = F.in[I_SSDNW];
    for (int r = gw; r < HT; r += NGW) {
        const size_t tok = (size_t)half * HT + r;
        bf16* yp = Y + tok * YC + lane * 16; const bf16* zp = P + (size_t)r * NPROJ + PC_Z + lane * 16;
        const u32x4 ya = *(const u32x4*)yp, yb = *(const u32x4*)(yp + 8), za = *(const u32x4*)zp, zb = *(const u32x4*)(zp + 8);
        float y[16], z[16];
        y[0] = bflo(ya.x); y[1] = bfhi(ya.x); y[2] = bflo(ya.y); y[3] = bfhi(ya.y); y[4] = bflo(ya.z); y[5] = bfhi(ya.z); y[6] = bflo(ya.w); y[7] = bfhi(ya.w);
        y[8] = bflo(yb.x); y[9] = bfhi(yb.x); y[10] = bflo(yb.y); y[11] = bfhi(yb.y); y[12] = bflo(yb.z); y[13] = bfhi(yb.z); y[14] = bflo(yb.w); y[15] = bfhi(yb.w);
        z[0] = bflo(za.x); z[1] = bfhi(za.x); z[2] = bflo(za.y); z[3] = bfhi(za.y); z[4] = bflo(za.z); z[5] = bfhi(za.z); z[6] = bflo(za.w); z[7] = bfhi(za.w);
        z[8] = bflo(zb.x); z[9] = bfhi(zb.x); z[10] = bflo(zb.y); z[11] = bfhi(zb.y); z[12] = bflo(zb.z); z[13] = bfhi(zb.z); z[14] = bflo(zb.w); z[15] = bfhi(zb.w);
        float ss = 0.f;
#pragma unroll
        for (int j = 0; j < 16; ++j) { y[j] = y[j] * z[j] * sigmoidf_(z[j]); ss += y[j] * y[j]; }
        ss += __shfl_xor(ss, 1); ss += __shfl_xor(ss, 2); ss += __shfl_xor(ss, 4); ss += __shfl_xor(ss, 8);
        const float rs = 1.0f / sqrtf(ss * (1.f / 256.f) + EPS);
        const f32x4* w4 = (const f32x4*)(nw + lane * 16);
        u32x4 oa, ob; f32x4 w;
        w = w4[0]; oa.x = pk2(y[0] * rs * w.x, y[1] * rs * w.y); oa.y = pk2(y[2] * rs * w.z, y[3] * rs * w.w);
        w = w4[1]; oa.z = pk2(y[4] * rs * w.x, y[5] * rs * w.y); oa.w = pk2(y[6] * rs * w.z, y[7] * rs * w.w);
        w = w4[2]; ob.x = pk2(y[8] * rs * w.x, y[9] * rs * w.y); ob.y = pk2(y[10] * rs * w.z, y[11] * rs * w.w);
        w = w4[3]; ob.z = pk2(y[12] * rs * w.x, y[13] * rs * w.y); ob.w = pk2(y[14] * rs * w.z, y[15] * rs * w.w);
        *(u32x4*)yp = oa; *(u32x4*)(yp + 8) = ob;
    }
}

__device__ __forceinline__ void dilattn_naive_phase(Frame& F, int half) {
    const bf16* P = (const bf16*)(F.ws + WS_BIG);
    bf16* Y = (bf16*)F.out;
    const int gw = F.bid * NWAVES + F.wave, NGW = F.G * NWAVES, lane = F.lane;
    for (int it = gw; it < HT * 4; it += NGW) {
        const int r = it >> 2, hh = it & 3;
        const int s = r & (SEQ - 1);
        const size_t rb = (size_t)(r - s);
        float M = -1e30f, L = 0.f, O = 0.f;
#pragma unroll 1
        for (int g = 0; g < 3; ++g) {
            const int head = 4 * g + hh, dil = (g == 0) ? 1 : (g == 1 ? 4 : 16);
            const bf16* qp = P + (size_t)r * NPROJ + PC_DQ + head * 64;
            u32x4 q[8];
#pragma unroll
            for (int j = 0; j < 8; ++j) q[j] = *(const u32x4*)(qp + 8 * j);
            float sc[3];
#pragma unroll
            for (int c = 0; c < 3; ++c) {
                const int j = lane + 64 * c; const int ps = s - j * dil;
                float a = -1e30f;
                if (j <= 128 && ps >= 0) {
                    const bf16* kp = P + (rb + ps) * NPROJ + PC_DK + head * 64;
                    a = 0.f;
#pragma unroll
                    for (int jj = 0; jj < 8; ++jj) { const u32x4 kk = *(const u32x4*)(kp + 8 * jj);
                        a += bflo(q[jj].x) * bflo(kk.x) + bfhi(q[jj].x) * bfhi(kk.x) + bflo(q[jj].y) * bflo(kk.y) + bfhi(q[jj].y) * bfhi(kk.y)
                           + bflo(q[jj].z) * bflo(kk.z) + bfhi(q[jj].z) * bfhi(kk.z) + bflo(q[jj].w) * bflo(kk.w) + bfhi(q[jj].w) * bfhi(kk.w); }
                    a *= 0.125f;
                }
                sc[c] = a;
            }
            const float m = wave_max(fmaxf(fmaxf(sc[0], sc[1]), sc[2]));
            float p0 = (sc[0] > -1e29f) ? __expf(sc[0] - m) : 0.f, p1 = (sc[1] > -1e29f) ? __expf(sc[1] - m) : 0.f, p2 = (sc[2] > -1e29f) ? __expf(sc[2] - m) : 0.f;
            const float l = wave_sum(p0 + p1 + p2);
            float o = 0.f;
            const int nk = min(128, s / dil) + 1;
            const bf16* vbase = P + PC_DV + head * 64 + lane;
            for (int j = 0; j < nk; ++j) {
                const float pj = __shfl(j < 64 ? p0 : (j < 128 ? p1 : p2), j & 63);
                o += pj * bf2f(vbase[(rb + s - j * dil) * NPROJ]);
            }
            const float Mn = fmaxf(M, m), f0 = __expf(M - Mn), f1 = __expf(m - Mn);
            O = O * f0 + o * f1; L = L * f0 + l * f1; M = Mn;
        }
        Y[((size_t)half * HT + r) * YC + 1024 + hh * 64 + lane] = (bf16)f2bf(O / L);
    }
}

__device__ __forceinline__ void memattn_naive_phase(Frame& F, int half) {
    const bf16* P = (const bf16*)(F.ws + WS_BIG);
    const bf16* MKV = (const bf16*)(F.ws + WS_MKV);
    bf16* Y = (bf16*)F.out;
    LAS float* sq = (LAS float*)(F.lds) + F.wave * 192;
    const int gw = F.bid * NWAVES + F.wave, NGW = F.G * NWAVES, lane = F.lane;
    for (int it = gw; it < HT * 4; it += NGW) {
        const int r = it >> 2, head = it & 3;
        const int b = half * HB + (r >> 13);
        const bf16* qp = P + (size_t)r * NPROJ + PC_MQ + head * 192;
        sq[lane] = bf2f(qp[lane]); sq[lane + 64] = bf2f(qp[lane + 64]); sq[lane + 128] = bf2f(qp[lane + 128]);
        LDS_WAIT(); __builtin_amdgcn_wave_barrier();
        float sc[4];
#pragma unroll
        for (int c = 0; c < 4; ++c) {
            const bf16* kp = MKV + (size_t)(b * NMEM + lane + 64 * c) * 1536 + head * 192;
            float a = 0.f;
#pragma unroll 4
            for (int jj = 0; jj < 24; ++jj) { const u32x4 kk = *(const u32x4*)(kp + 8 * jj); const f32x4 qa = *(const LAS f32x4*)(sq + 8 * jj), qb = *(const LAS f32x4*)(sq + 8 * jj + 4);
                a += qa.x * bflo(kk.x) + qa.y * bfhi(kk.x) + qa.z * bflo(kk.y) + qa.w * bfhi(kk.y) + qb.x * bflo(kk.z) + qb.y * bfhi(kk.z) + qb.z * bflo(kk.w) + qb.w * bfhi(kk.w); }
            sc[c] = a * 0.07216878364870323f;
        }
        const float m = wave_max(fmaxf(fmaxf(sc[0], sc[1]), fmaxf(sc[2], sc[3])));
        float p[4];
#pragma unroll
        for (int c = 0; c < 4; ++c) p[c] = __expf(sc[c] - m);
        const float l = wave_sum((p[0] + p[1]) + (p[2] + p[3]));
        float o0 = 0.f, o1 = 0.f, o2 = 0.f;
        const bf16* vb = MKV + (size_t)(b * NMEM) * 1536 + 768 + head * 192 + lane;
#pragma unroll
        for (int c = 0; c < 4; ++c)
#pragma unroll 8
            for (int j = 0; j < 64; ++j) { const float pj = __shfl(p[c], j); const bf16* vp = vb + (size_t)(j + 64 * c) * 1536;
                o0 += pj * bf2f(vp[0]); o1 += pj * bf2f(vp[64]); o2 += pj * bf2f(vp[128]); }
        const float il = 1.0f / l;
        bf16* yp = Y + ((size_t)half * HT + r) * YC + 1280 + head * 192 + lane;
        yp[0] = (bf16)f2bf(o0 * il); yp[64] = (bf16)f2bf(o1 * il); yp[128] = (bf16)f2bf(o2 * il);
        __builtin_amdgcn_wave_barrier();
    }
}

constexpr int SC_ST = 272, SX_ST = 528;
__device__ __forceinline__ float bfsel(const u32x4& v, int j) { const unsigned w = v[j >> 1]; return (j & 1) ? bfhi(w) : bflo(w); }
__device__ __forceinline__ void conv_task(const bf16* P, size_t rowb, int t0, int pcol, const float* cw, const float* cb, int ccol, LAS unsigned char* dst, int stride, const LAS float* scale) {
    float w[4][8], bs[8];
#pragma unroll
    for (int k = 0; k < 4; ++k) { const f32x4 a = *(const f32x4*)(cw + k * 2048 + ccol), b = *(const f32x4*)(cw + k * 2048 + ccol + 4);
        w[k][0] = a.x; w[k][1] = a.y; w[k][2] = a.z; w[k][3] = a.w; w[k][4] = b.x; w[k][5] = b.y; w[k][6] = b.z; w[k][7] = b.w; }
    { const f32x4 a = *(const f32x4*)(cb + ccol), b = *(const f32x4*)(cb + ccol + 4); bs[0] = a.x; bs[1] = a.y; bs[2] = a.z; bs[3] = a.w; bs[4] = b.x; bs[5] = b.y; bs[6] = b.z; bs[7] = b.w; }
    const bf16* src = P + (rowb + t0) * NPROJ + pcol;
    u32x4 w0 = {0u, 0u, 0u, 0u}, w1 = w0, w2 = w0;
    if (t0 > 0) { w0 = *(const u32x4*)(src - 3 * (ptrdiff_t)NPROJ); w1 = *(const u32x4*)(src - 2 * (ptrdiff_t)NPROJ); w2 = *(const u32x4*)(src - (ptrdiff_t)NPROJ); }
#pragma unroll 4
    for (int i = 0; i < 16; ++i) {
        const u32x4 cur = *(const u32x4*)(src + (size_t)i * NPROJ);
        float o[8];
#pragma unroll
        for (int j = 0; j < 8; ++j) { float a = bs[j] + w[0][j] * bfsel(w0, j) + w[1][j] * bfsel(w1, j) + w[2][j] * bfsel(w2, j) + w[3][j] * bfsel(cur, j); o[j] = a * sigmoidf_(a); }
        if (scale) { const float sv = scale[i];
#pragma unroll
            for (int j = 0; j < 8; ++j) o[j] *= sv; }
        const u32x4 r = {pkbf(o[0], o[1]), pkbf(o[2], o[3]), pkbf(o[4], o[5]), pkbf(o[6], o[7])};
        *(LAS u32x4*)(dst + i * stride) = r;
        w0 = w1; w1 = w2; w2 = cur;
    }
}
__device__ __forceinline__ float ssd_scan(Frame& F, const float* DTp, size_t tok0, int g, LAS float* sAc, LAS float* sDt) {
    float total = 0.f;
    if (F.wave < 4) {
        const int head = 4 * g + F.wave, lane = F.lane;
        const float A = -__expf(F.in[I_ALOG][head]);
        const float d0 = DTp[(tok0 + 2 * lane) * 16 + head], d1 = DTp[(tok0 + 2 * lane + 1) * 16 + head];
        const float a0 = d0 * A, a1 = d1 * A;
        float sc = a0 + a1;
#pragma unroll
        for (int o = 1; o < 64; o <<= 1) { const float v = __shfl_up(sc, o); if (lane >= o) sc += v; }
        sAc[F.wave * 128 + 2 * lane] = sc - a1; sAc[F.wave * 128 + 2 * lane + 1] = sc;
        sDt[F.wave * 128 + 2 * lane] = d0; sDt[F.wave * 128 + 2 * lane + 1] = d1;
        total = __shfl(sc, 63);
    }
    return total;
}
__device__ __forceinline__ bf16x8 tr_pair(unsigned a_lo, unsigned a_hi) {
    s16x4 lo, hi;
    asm volatile("ds_read_b64_tr_b16 %0, %2\n\tds_read_b64_tr_b16 %1, %3\n\ts_waitcnt lgkmcnt(0)" : "=&v"(lo), "=&v"(hi) : "v"(a_lo), "v"(a_hi) : "memory");
    const bf16x8 r = {lo[0], lo[1], lo[2], lo[3], hi[0], hi[1], hi[2], hi[3]}; return r;
}

__device__ __forceinline__ void ssdC_phase(Frame& F, int half) {
    const bf16* P = (const bf16*)(F.ws + WS_BIG);
    const float* DTp = (const float*)(F.ws + WS_DT);
    float* SST = (float*)(F.ws + WS_SST); float* DEC = (float*)(F.ws + WS_DEC);
    LAS unsigned char* sX = F.lds; LAS unsigned char* sB = F.lds + 128 * SX_ST;
    LAS float* sAc = (LAS float*)(F.lds + 128 * SX_ST + 128 * SC_ST); LAS float* sDt = sAc + 512; LAS float* sW = sDt + 512;
    const int wave = F.wave;
    for (int unit = F.bid; unit < HB * 64 * 4; unit += F.G) {
        int tid = F.tid; asm volatile("" : "+v"(tid));
        const int lane = tid & 63, ql = lane & 31, h = lane >> 5, tq = (lane & 15) >> 2, tp = lane & 3, tblk = (lane >> 4) & 1;
        const int bl = unit >> 8, c = (unit >> 2) & 63, g = unit & 3;
        const size_t rowb = (size_t)bl * SEQ, tok0 = (size_t)half * HT + rowb + c * 128;
        __syncthreads();
        const float total = ssd_scan(F, DTp, tok0, g, sAc, sDt);
        if (wave < 4) { sW[wave * 128 + 2 * lane] = __expf(total - sAc[wave * 128 + 2 * lane]) * sDt[wave * 128 + 2 * lane];
            sW[wave * 128 + 2 * lane + 1] = __expf(total - sAc[wave * 128 + 2 * lane + 1]) * sDt[wave * 128 + 2 * lane + 1];
            if (lane == 0) DEC[((size_t)bl * 64 + c) * 16 + 4 * g + wave] = __expf(total); }
        __syncthreads();
        if (tid < 384) {
            int ch, strip, ccol, stride; LAS unsigned char* dst; const LAS float* scl = nullptr;
            if (tid < 256) { ch = tid & 31; strip = tid >> 5; ccol = g * 256 + 8 * ch; stride = SX_ST; dst = sX + (strip * 16) * SX_ST + ch * 16; scl = sW + (ch >> 3) * 128 + strip * 16; }
            else { const int u = tid - 256; ch = u & 15; strip = u >> 4; ccol = 1024 + g * 128 + 8 * ch; stride = SC_ST; dst = sB + (strip * 16) * SC_ST + ch * 16; }
            conv_task(P, rowb, c * 128 + strip * 16, PC_X + ccol, F.in[I_CONVW], F.in[I_CONVB], ccol, dst, stride, scl);
        }
        __syncthreads();
        const int r = wave >> 1, pt = wave & 1;
        f32x16 acc[4];
#pragma unroll
        for (int nt = 0; nt < 4; ++nt)
#pragma unroll
            for (int e = 0; e < 16; ++e) acc[nt][e] = 0.f;
        const unsigned xa = (unsigned)(size_t)sX + (unsigned)((8 * h + tq) * SX_ST + (r * 64 + 32 * pt + 16 * tblk + 4 * tp) * 2);
        const unsigned ba = (unsigned)(size_t)sB + (unsigned)((8 * h + tq) * SC_ST + (16 * tblk + 4 * tp) * 2);
#pragma unroll
        for (int ks = 0; ks < 8; ++ks) {
            const bf16x8 af = tr_pair(xa + ks * 16 * SX_ST, xa + ks * 16 * SX_ST + 4 * SX_ST);
            bf16x8 bfr[4];
#pragma unroll
            for (int nt = 0; nt < 4; ++nt) bfr[nt] = tr_pair(ba + ks * 16 * SC_ST + nt * 64, ba + ks * 16 * SC_ST + 4 * SC_ST + nt * 64);
            __builtin_amdgcn_sched_barrier(0);
#pragma unroll
            for (int nt = 0; nt < 4; ++nt) acc[nt] = MFMA32(af, bfr[nt], acc[nt]);
        }
        float* out = SST + (((size_t)bl * 64 + c) * 16 + 4 * g + r) * 8192;
#pragma unroll
        for (int nt = 0; nt < 4; ++nt)
#pragma unroll
            for (int e = 0; e < 16; ++e) out[(32 * pt + (e & 3) + 8 * (e >> 2) + 4 * h) * 128 + 32 * nt + ql] = acc[nt][e];
    }
}

__device__ __forceinline__ void ssdD_phase(Frame& F) {
    const float* SST = (const float*)(F.ws + WS_SST); const float* DEC = (const float*)(F.ws + WS_DEC);
    bf16* SIN = (bf16*)(F.ws + WS_SIN);
    const size_t gtid = (size_t)F.bid * NTHR + F.tid, gth = (size_t)F.G * NTHR;
    for (size_t it = gtid; it < (size_t)HB * 16 * 2048; it += gth) {
        const int bl = (int)(it >> 15), head = (int)(it >> 11) & 15, e4 = (int)(it & 2047) * 4;
        f32x4 st = {0.f, 0.f, 0.f, 0.f};
#pragma unroll 8
        for (int c = 0; c < 64; ++c) {
            const size_t idx = (((size_t)bl * 64 + c) * 16 + head);
            const u32x2 o = {pkbf(st.x, st.y), pkbf(st.z, st.w)};
            *(u32x2*)(SIN + idx * 8192 + e4) = o;
            const f32x4 sl = *(const f32x4*)(SST + idx * 8192 + e4); const float d = DEC[idx];
            st = st * d + sl;
        }
    }
}

__device__ __forceinline__ void ssdE_phase(Frame& F, int half) {
    const bf16* P = (const bf16*)(F.ws + WS_BIG);
    const float* DTp = (const float*)(F.ws + WS_DT);
    const bf16* SIN = (const bf16*)(F.ws + WS_SIN);
    bf16* Y = (bf16*)F.out;
    LAS unsigned char* sX = F.lds; LAS unsigned char* sB = F.lds + 128 * SX_ST; LAS unsigned char* sC = sB + 128 * SC_ST;
    LAS float* sAc = (LAS float*)(sC + 128 * SC_ST); LAS float* sDt = sAc + 512; LAS float* sSS = sDt + 512;
    const int wave = F.wave;
    const int st = wave & 3, hp = wave >> 2;
    for (int unit = F.bid; unit < HB * 64 * 4; unit += F.G) {
        int tid = F.tid; asm volatile("" : "+v"(tid));
        const int lane = tid & 63, ql = lane & 31, h = lane >> 5, tq = (lane & 15) >> 2, tp = lane & 3, tblk = (lane >> 4) & 1;
        const int bl = unit >> 8, c = (unit >> 2) & 63, g = unit & 3;
        const size_t rowb = (size_t)bl * SEQ, tok0 = (size_t)half * HT + rowb + c * 128;
        __syncthreads();
        (void)ssd_scan(F, DTp, tok0, g, sAc, sDt);
        if (tid < 128) sSS[tid] = 0.f;
        {
            int ch, strip, ccol, stride; LAS unsigned char* dst;
            if (tid < 256) { ch = tid & 31; strip = tid >> 5; ccol = g * 256 + 8 * ch; stride = SX_ST; dst = sX + (strip * 16) * SX_ST + ch * 16; }
            else if (tid < 384) { const int u = tid - 256; ch = u & 15; strip = u >> 4; ccol = 1024 + g * 128 + 8 * ch; stride = SC_ST; dst = sB + (strip * 16) * SC_ST + ch * 16; }
            else { const int u = tid - 384; ch = u & 15; strip = u >> 4; ccol = 1536 + g * 128 + 8 * ch; stride = SC_ST; dst = sC + (strip * 16) * SC_ST + ch * 16; }
            conv_task(P, rowb, c * 128 + strip * 16, PC_X + ccol, F.in[I_CONVW], F.in[I_CONVB], ccol, dst, stride, nullptr);
        }
        __syncthreads();
        const int s = 32 * st + ql;
        unsigned yk[2][2][8];
        float ssq = 0.f;
        const unsigned xa = (unsigned)(size_t)sX + (unsigned)((4 * h + tq) * SX_ST + (16 * tblk + 4 * tp) * 2);
#pragma unroll
        for (int hq = 0; hq < 2; ++hq) {
            const int r = 2 * hp + hq, head = 4 * g + r;
            const float acs = sAc[r * 128 + s];
            bf16x8 pf[4][2];
#pragma unroll
            for (int i = 0; i < 4; ++i) {
                f32x16 Xi;
#pragma unroll
                for (int e = 0; e < 16; ++e) Xi[e] = 0.f;
#pragma unroll
                for (int ks = 0; ks < 8; ++ks) { const bf16x8 bf_ = *(const LAS bf16x8*)(sB + (32 * i + ql) * SC_ST + 32 * ks + 16 * h);
                    const bf16x8 cf = *(const LAS bf16x8*)(sC + s * SC_ST + 32 * ks + 16 * h); Xi = MFMA32(bf_, cf, Xi); }
                float p[16];
#pragma unroll
                for (int q4 = 0; q4 < 4; ++q4) { const int t0 = 32 * i + 8 * q4 + 4 * h;
                    const f32x4 at = *(const LAS f32x4*)(sAc + r * 128 + t0), dt4 = *(const LAS f32x4*)(sDt + r * 128 + t0);
#pragma unroll
                    for (int e = 0; e < 4; ++e) { const int t = t0 + e; p[4 * q4 + e] = (t <= s) ? Xi[4 * q4 + e] * __expf(acs - at[e]) * dt4[e] : 0.f; } }
#pragma unroll
                for (int s2 = 0; s2 < 2; ++s2) { const u32x4 w = {pkbf(p[8 * s2 + 0], p[8 * s2 + 1]), pkbf(p[8 * s2 + 2], p[8 * s2 + 3]), pkbf(p[8 * s2 + 4], p[8 * s2 + 5]), pkbf(p[8 * s2 + 6], p[8 * s2 + 7])};
                    pf[i][s2] = __builtin_bit_cast(bf16x8, w); }
            }
            const bf16* stp = SIN + (((size_t)bl * 64 + c) * 16 + head) * 8192;
            const float eacs = __expf(acs), Dh = F.in[I_SSDD][head];
#pragma unroll
            for (int pt = 0; pt < 2; ++pt) {
                f32x16 yd, yo;
#pragma unroll
                for (int e = 0; e < 16; ++e) { yd[e] = 0.f; yo[e] = 0.f; }
#pragma unroll
                for (int i = 0; i < 4; ++i) {
#pragma unroll
                    for (int s2 = 0; s2 < 2; ++s2) { const unsigned a = xa + (unsigned)((32 * i + 16 * s2) * SX_ST + (r * 64 + 32 * pt) * 2);
                        const bf16x8 xf = tr_pair(a, a + 8 * SX_ST); __builtin_amdgcn_sched_barrier(0); yd = MFMA32(xf, pf[i][s2], yd); }
                }
#pragma unroll
                for (int ks = 0; ks < 8; ++ks) { const bf16x8 sf = *(const bf16x8*)(stp + (32 * pt + ql) * 128 + 16 * ks + 8 * h);
                    const bf16x8 cf = *(const LAS bf16x8*)(sC + s * SC_ST + 32 * ks + 16 * h); yo = MFMA32(sf, cf, yo); }
                const bf16* zp = P + (rowb + c * 128 + s) * NPROJ + PC_Z + g * 256 + r * 64 + 32 * pt + 4 * h;
#pragma unroll
                for (int q4 = 0; q4 < 4; ++q4) {
                    const u32x2 xv = *(const LAS u32x2*)(sX + s * SX_ST + (r * 64 + 32 * pt + 8 * q4 + 4 * h) * 2);
                    const u32x2 zv = *(const u32x2*)(zp + 8 * q4);
                    const float xs_[4] = {bflo(xv.x), bfhi(xv.x), bflo(xv.y), bfhi(xv.y)}, zs_[4] = {bflo(zv.x), bfhi(zv.x), bflo(zv.y), bfhi(zv.y)};
                    float yv[4];
#pragma unroll
                    for (int e = 0; e < 4; ++e) { float y = yd[4 * q4 + e] + eacs * yo[4 * q4 + e] + Dh * xs_[e]; y = y * zs_[e] * sigmoidf_(zs_[e]); yv[e] = y; ssq += y * y; }
                    yk[hq][pt][2 * q4] = pkbf(yv[0], yv[1]); yk[hq][pt][2 * q4 + 1] = pkbf(yv[2], yv[3]);
                }
            }
        }
        ssq += __shfl_xor(ssq, 32);
        if (h == 0) __hip_atomic_fetch_add(sSS + s, ssq, __ATOMIC_RELAXED, __HIP_MEMORY_SCOPE_WORKGROUP);
        __syncthreads();
        const float rs = 1.0f / sqrtf(sSS[s] * (1.f / 256.f) + EPS);
        bf16* yp = Y + (tok0 + s) * YC + g * 256 + 4 * h;
        const float* nw = F.in[I_SSDNW] + g * 256 + 4 * h;
#pragma unroll
        for (int hq = 0; hq < 2; ++hq)
#pragma unroll
            for (int pt = 0; pt < 2; ++pt)
#pragma unroll
                for (int q4 = 0; q4 < 4; ++q4) { const int cc = (2 * hp + hq) * 64 + 32 * pt + 8 * q4; const f32x4 w4 = *(const f32x4*)(nw + cc);
                    const unsigned ya = yk[hq][pt][2 * q4], yb = yk[hq][pt][2 * q4 + 1];
                    const u32x2 o = {pkbf(bflo(ya) * rs * w4.x, bfhi(ya) * rs * w4.y), pkbf(bflo(yb) * rs * w4.z, bfhi(yb) * rs * w4.w)};
                    *(u32x2*)(yp + cc) = o; }
    }
}

__device__ __forceinline__ bf16x8 mk_bf16x8(u32x2 lo, u32x2 hi) { const u32x4 v = {lo.x, lo.y, hi.x, hi.y}; return __builtin_bit_cast(bf16x8, v); }

__device__ __forceinline__ void memattn_mfma_phase(Frame& F, int half) {
    const bf16* P = (const bf16*)(F.ws + WS_BIG);
    const bf16* MKV = (const bf16*)(F.ws + WS_MKV);
    const bf16* MVT = (const bf16*)(F.ws + WS_MVT);
    bf16* Y = (bf16*)F.out;
    LAS unsigned char* sm = F.lds;
    const int tid = F.tid, lane = F.lane, wave = F.wave, ql = lane & 31, h = lane >> 5;
    constexpr int KST = 400, VST = 528;
    for (int unit = F.bid; unit < HB * 4 * 32; unit += F.G) {
        const int bl = unit >> 7, head = (unit >> 5) & 3, qt = unit & 31, b = half * HB + bl;
        const int r = bl * SEQ + qt * 256 + wave * 32 + ql;
        __syncthreads();
        for (int c = tid; c < 256 * 24; c += NTHR) { const int row = c / 24, ch = c % 24;
            *(LAS u32x4*)(sm + row * KST + ch * 16) = *(const u32x4*)(MKV + (size_t)(b * NMEM + row) * 1536 + head * 192 + ch * 8); }
        bf16x8 qf[12];
        { const bf16* qp = P + (size_t)r * NPROJ + PC_MQ + head * 192 + 8 * h;
#pragma unroll
          for (int ks = 0; ks < 12; ++ks) qf[ks] = *(const bf16x8*)(qp + 16 * ks); }
        __syncthreads();
        f32x16 sacc[8];
#pragma unroll
        for (int mt = 0; mt < 8; ++mt) {
#pragma unroll
            for (int i = 0; i < 16; ++i) sacc[mt][i] = 0.f;
#pragma unroll
            for (int ks = 0; ks < 12; ++ks) { const bf16x8 kf = *(const LAS bf16x8*)(sm + (32 * mt + ql) * KST + 32 * ks + 16 * h); sacc[mt] = MFMA32(kf, qf[ks], sacc[mt]); }
        }
        float mx = -3.0e38f;
#pragma unroll
        for (int mt = 0; mt < 8; ++mt)
#pragma unroll
            for (int i = 0; i < 16; ++i) mx = fmaxf(mx, sacc[mt][i]);
        mx = fmaxf(mx, __shfl_xor(mx, 32));
        const float sc = 0.07216878364870323f * 1.4426950408889634f;
        float l = 0.f;
        bf16x8 pf[8][2];
#pragma unroll
        for (int mt = 0; mt < 8; ++mt) {
            float p[16];
#pragma unroll
            for (int i = 0; i < 16; ++i) { p[i] = __builtin_amdgcn_exp2f((sacc[mt][i] - mx) * sc); l += p[i]; }
#pragma unroll
            for (int s2 = 0; s2 < 2; ++s2) { const u32x4 w = {pkbf(p[8 * s2 + 0], p[8 * s2 + 1]), pkbf(p[8 * s2 + 2], p[8 * s2 + 3]), pkbf(p[8 * s2 + 4], p[8 * s2 + 5]), pkbf(p[8 * s2 + 6], p[8 * s2 + 7])};
                pf[mt][s2] = __builtin_bit_cast(bf16x8, w); }
        }
        l += __shfl_xor(l, 32);
        __syncthreads();
        for (int c = tid; c < 192 * 32; c += NTHR) { const int row = c >> 5, ch = c & 31;
            *(LAS u32x4*)(sm + row * VST + ch * 16) = *(const u32x4*)(MVT + (size_t)(head * 192 + row) * 2048 + b * NMEM + ch * 8); }
        __syncthreads();
        const float il = 1.0f / l;
        bf16* yp = Y + ((size_t)half * HT + r) * YC + 1280 + head * 192 + 4 * h;
#pragma unroll
        for (int dt = 0; dt < 6; ++dt) {
            f32x16 o;
#pragma unroll
            for (int i = 0; i < 16; ++i) o[i] = 0.f;
#pragma unroll
            for (int mt = 0; mt < 8; ++mt)
#pragma unroll
                for (int s2 = 0; s2 < 2; ++s2) { const LAS unsigned char* vp = sm + (32 * dt + ql) * VST + (32 * mt + 16 * s2 + 4 * h) * 2;
                    const bf16x8 vf = mk_bf16x8(*(const LAS u32x2*)vp, *(const LAS u32x2*)(vp + 16)); o = MFMA32(vf, pf[mt][s2], o); }
#pragma unroll
            for (int g = 0; g < 4; ++g) { const u32x2 w = {pkbf(o[4 * g] * il, o[4 * g + 1] * il), pkbf(o[4 * g + 2] * il, o[4 * g + 3] * il)}; *(u32x2*)(yp + 32 * dt + 8 * g) = w; }
        }
    }
}

__device__ __forceinline__ void dilattn_mfma_phase(Frame& F, int half) {
    bf16* P = (bf16*)(F.ws + WS_BIG);
    float* LSE = (float*)(F.ws + WS_LSE);
    LAS unsigned char* sK = F.lds; LAS unsigned char* sV = F.lds + 384 * 144;
    const int tid = F.tid, lane = F.lane, wave = F.wave, ql = lane & 31, h = lane >> 5;
    constexpr int RST = 144;
    for (int unit = F.bid; unit < HB * 12 * 32; unit += F.G) {
        const int bl = unit / 384, rem = unit % 384, head = rem >> 5, blk = rem & 31;
        const int g = head >> 2, dil = (g == 0) ? 1 : (g == 1 ? 4 : 16), bpr = 32 / dil;
        const int res = blk / bpr, q0 = (blk % bpr) * 256;
        const size_t rowb = (size_t)bl * SEQ;
        __syncthreads();
        for (int c = tid; c < 384 * 8; c += NTHR) { const int row = c >> 3, ch = c & 7; const int ks = q0 - 128 + row;
            u32x4 kv = {0u, 0u, 0u, 0u}, vv = {0u, 0u, 0u, 0u};
            if (ks >= 0) { const bf16* src = P + (rowb + (size_t)ks * dil + res) * NPROJ + head * 64 + ch * 8; kv = *(const u32x4*)(src + PC_DK); vv = *(const u32x4*)(src + PC_DV); }
            *(LAS u32x4*)(sK + row * RST + ch * 16) = kv; *(LAS u32x4*)(sV + row * RST + ch * 16) = vv; }
        const int qs = q0 + wave * 32 + ql;
        const size_t rq = rowb + (size_t)qs * dil + res;
        bf16* qp = P + rq * NPROJ + PC_DQ + head * 64;
        bf16x8 qf[4];
#pragma unroll
        for (int ks = 0; ks < 4; ++ks) qf[ks] = *(const bf16x8*)(qp + 16 * ks + 8 * h);
        __syncthreads();
        f32x16 sacc[5];
        const int kfirst = q0 + wave * 32 - 128;
#pragma unroll
        for (int i = 0; i < 5; ++i) {
#pragma unroll
            for (int e = 0; e < 16; ++e) sacc[i][e] = 0.f;
#pragma unroll
            for (int ks = 0; ks < 4; ++ks) { const bf16x8 kf = *(const LAS bf16x8*)(sK + (32 * wave + 32 * i + ql) * RST + 32 * ks + 16 * h); sacc[i] = MFMA32(kf, qf[ks], sacc[i]); }
        }
        float mx = -3.0e38f;
#pragma unroll
        for (int i = 0; i < 5; ++i)
#pragma unroll
            for (int e = 0; e < 16; ++e) { const int kj = 32 * i + (e & 3) + 8 * (e >> 2) + 4 * h; const bool ok = (kj >= ql) && (kj <= ql + 128) && (kfirst + kj >= 0);
                sacc[i][e] = ok ? sacc[i][e] : -3.0e38f; mx = fmaxf(mx, sacc[i][e]); }
        mx = fmaxf(mx, __shfl_xor(mx, 32));
        const float sc = 0.125f * 1.4426950408889634f;
        float l = 0.f;
        bf16x8 pf[5][2];
#pragma unroll
        for (int i = 0; i < 5; ++i) {
            float p[16];
#pragma unroll
            for (int e = 0; e < 16; ++e) { p[e] = (sacc[i][e] > -1.0e38f) ? __builtin_amdgcn_exp2f((sacc[i][e] - mx) * sc) : 0.f; l += p[e]; }
#pragma unroll
            for (int s2 = 0; s2 < 2; ++s2) { const u32x4 w = {pkbf(p[8 * s2 + 0], p[8 * s2 + 1]), pkbf(p[8 * s2 + 2], p[8 * s2 + 3]), pkbf(p[8 * s2 + 4], p[8 * s2 + 5]), pkbf(p[8 * s2 + 6], p[8 * s2 + 7])};
                pf[i][s2] = __builtin_bit_cast(bf16x8, w); }
        }
        l += __shfl_xor(l, 32);
        const float il = 1.0f / l;
        const int tq = (lane & 15) >> 2, tp = lane & 3, tblk = (lane >> 4) & 1;
        const unsigned vbase = (unsigned)(size_t)(sV) + (unsigned)((32 * wave + 4 * h + tq) * RST + (16 * tblk + 4 * tp) * 2);
#pragma unroll
        for (int dt = 0; dt < 2; ++dt) {
            f32x16 o;
#pragma unroll
            for (int e = 0; e < 16; ++e) o[e] = 0.f;
#pragma unroll
            for (int i = 0; i < 5; ++i) {
                s16x4 lo[2], hi[2];
#pragma unroll
                for (int s2 = 0; s2 < 2; ++s2) { const unsigned a = vbase + (unsigned)((32 * i + 16 * s2) * RST + 64 * dt);
                    asm volatile("ds_read_b64_tr_b16 %0, %1" : "=&v"(lo[s2]) : "v"(a) : "memory");
                    asm volatile("ds_read_b64_tr_b16 %0, %1 offset:1152" : "=&v"(hi[s2]) : "v"(a) : "memory"); }
                asm volatile("s_waitcnt lgkmcnt(0)" ::: "memory"); __builtin_amdgcn_sched_barrier(0);
#pragma unroll
                for (int s2 = 0; s2 < 2; ++s2) { const bf16x8 vf = {lo[s2][0], lo[s2][1], lo[s2][2], lo[s2][3], hi[s2][0], hi[s2][1], hi[s2][2], hi[s2][3]}; o = MFMA32(vf, pf[i][s2], o); }
            }
#pragma unroll
            for (int gq = 0; gq < 4; ++gq) { const u32x2 w = {pkbf(o[4 * gq] * il, o[4 * gq + 1] * il), pkbf(o[4 * gq + 2] * il, o[4 * gq + 3] * il)}; *(u32x2*)(qp + 32 * dt + 8 * gq + 4 * h) = w; }
        }
        if (h == 0) LSE[((size_t)half * HT + rq) * 12 + head] = mx * 0.125f + __logf(l);
    }
}

__device__ __forceinline__ void dilmerge_phase(Frame& F, int half) {
    const bf16* P = (const bf16*)(F.ws + WS_BIG);
    const float* LSE = (const float*)(F.ws + WS_LSE);
    bf16* Y = (bf16*)F.out;
    const size_t gtid = (size_t)F.bid * NTHR + F.tid, gth = (size_t)F.G * NTHR;
    for (size_t it = gtid; it < (size_t)HT * 32; it += gth) {
        const size_t r = it >> 5; const int hh = (int)(it >> 3) & 3, d0 = (int)(it & 7) * 8;
        const size_t tok = (size_t)half * HT + r;
        const float l0 = LSE[tok * 12 + hh], l1 = LSE[tok * 12 + 4 + hh], l2 = LSE[tok * 12 + 8 + hh];
        const float m = fmaxf(l0, fmaxf(l1, l2));
        float w0 = __expf(l0 - m), w1 = __expf(l1 - m), w2 = __expf(l2 - m); const float iw = 1.0f / (w0 + w1 + w2); w0 *= iw; w1 *= iw; w2 *= iw;
        const bf16* op = P + r * NPROJ + PC_DQ + hh * 64 + d0;
        const u32x4 a = *(const u32x4*)op, b = *(const u32x4*)(op + 256), c = *(const u32x4*)(op + 512);
        u32x4 o;
        o.x = pkbf(w0 * bflo(a.x) + w1 * bflo(b.x) + w2 * bflo(c.x), w0 * bfhi(a.x) + w1 * bfhi(b.x) + w2 * bfhi(c.x));
        o.y = pkbf(w0 * bflo(a.y) + w1 * bflo(b.y) + w2 * bflo(c.y), w0 * bfhi(a.y) + w1 * bfhi(b.y) + w2 * bfhi(c.y));
        o.z = pkbf(w0 * bflo(a.z) + w1 * bflo(b.z) + w2 * bflo(c.z), w0 * bfhi(a.z) + w1 * bfhi(b.z) + w2 * bfhi(c.z));
        o.w = pkbf(w0 * bflo(a.w) + w1 * bflo(b.w) + w2 * bflo(c.w), w0 * bfhi(a.w) + w1 * bfhi(b.w) + w2 * bfhi(c.w));
        *(u32x4*)(Y + tok * YC + 1024 + hh * 64 + d0) = o;
    }
}

__device__ __forceinline__ void hn_phase(Frame& F) {
    const int gw = F.bid * NWAVES + F.wave, NGW = F.G * NWAVES;
    for (int m = gw; m < T; m += NGW) { f32x4 v[4]; rms_row_to_bf16(F.out + (size_t)m * DM, F.in[I_NFFNW], (bf16*)(F.ws + WS_ACT1) + (size_t)m * DM, F.lane, v); }
}

__device__ __forceinline__ float gelu_erf(float x) { return 0.5f * x * (1.0f + erff(x * 0.70710678118654752f)); }
__device__ __forceinline__ void peer_naive_phase(Frame& F) {
    const bf16* Q = (const bf16*)(F.ws + WS_BIG);
    const bf16* SK = (const bf16*)(F.ws + WS_SUBK);
    const bf16* PD = (const bf16*)(F.ws + WS_PD); const bf16* PU = (const bf16*)(F.ws + WS_PU);
    const bf16* HN = (const bf16*)(F.ws + WS_ACT1);
    LAS float* sq = (LAS float*)F.lds;
    LAS float* ssc = sq + 16 * 256;
    LAS float* stv = ssc + 16 * 256;
    LAS int* sti = (LAS int*)(stv + 16 * 32);
    LAS int* sidx = sti + 16 * 32;
    LAS float* sgate = (LAS float*)(sidx + 16 * 128);
    const int tid = F.tid, lane = F.lane, wave = F.wave;
    for (int tile = F.bid; tile < T / 16; tile += F.G) {
        const size_t tok0 = (size_t)tile * 16;
#pragma unroll 1
        for (int h = 0; h < PEER_H; ++h) {
            __syncthreads();
            for (int i = tid; i < 16 * 256; i += NTHR) sq[i] = bf2f(Q[(tok0 + (i >> 8)) * PEER_Q + h * 256 + (i & 255)]);
            __syncthreads();
            {
                const int c = tid >> 8, k = (tid >> 1) & 127, th = tid & 1;
                const bf16* kp = SK + ((size_t)(h * 2 + c) * 128 + k) * 128;
                float a[8];
#pragma unroll
                for (int j = 0; j < 8; ++j) a[j] = 0.f;
#pragma unroll 2
                for (int d8 = 0; d8 < 16; ++d8) { const u32x4 kk = *(const u32x4*)(kp + 8 * d8);
                    const float k0 = bflo(kk.x), k1 = bfhi(kk.x), k2 = bflo(kk.y), k3 = bfhi(kk.y), k4 = bflo(kk.z), k5 = bfhi(kk.z), k6 = bflo(kk.w), k7 = bfhi(kk.w);
#pragma unroll
                    for (int j = 0; j < 8; ++j) { const LAS float* qq = sq + (th * 8 + j) * 256 + c * 128 + 8 * d8; const f32x4 qa = *(const LAS f32x4*)qq, qb = *(const LAS f32x4*)(qq + 4);
                        a[j] += (qa.x * k0 + qa.y * k1) + (qa.z * k2 + qa.w * k3) + (qb.x * k4 + qb.y * k5) + (qb.z * k6 + qb.w * k7); } }
#pragma unroll
                for (int j = 0; j < 8; ++j) ssc[((th * 8 + j) * 2 + c) * 128 + k] = a[j];
            }
            __syncthreads();
#pragma unroll 1
            for (int li = 0; li < 4; ++li) {
                const int list = wave * 4 + li;
                float v0 = ssc[list * 128 + lane], v1 = ssc[list * 128 + 64 + lane];
#pragma unroll 1
                for (int rnk = 0; rnk < 16; ++rnk) {
                    float bv = fmaxf(v0, v1); int bi = (v0 >= v1) ? lane : lane + 64;
#pragma unroll
                    for (int o = 1; o < 64; o <<= 1) { const float ov = __shfl_xor(bv, o); const int oi = __shfl_xor(bi, o); if (ov > bv || (ov == bv && oi < bi)) { bv = ov; bi = oi; } }
                    if (bi == lane) v0 = -3.0e38f; if (bi == lane + 64) v1 = -3.0e38f;
                    if (lane == 0) { stv[list * 16 + rnk] = bv; sti[list * 16 + rnk] = bi; }
                }
            }
            __syncthreads();
#pragma unroll 1
            for (int li = 0; li < 2; ++li) {
                const int tk = wave * 2 + li;
                float cv[4]; int ci[4];
#pragma unroll
                for (int j = 0; j < 4; ++j) { const int id = lane + 64 * j, a = id >> 4, b = id & 15; cv[j] = stv[(tk * 2 + 0) * 16 + a] + stv[(tk * 2 + 1) * 16 + b]; ci[j] = id; }
                float myv = 0.f; int myi = 0;
#pragma unroll 1
                for (int rnk = 0; rnk < 16; ++rnk) {
                    float bv = cv[0]; int bi = ci[0];
#pragma unroll
                    for (int j = 1; j < 4; ++j) if (cv[j] > bv) { bv = cv[j]; bi = ci[j]; }
#pragma unroll
                    for (int o = 1; o < 64; o <<= 1) { const float ov = __shfl_xor(bv, o); const int oi = __shfl_xor(bi, o); if (ov > bv || (ov == bv && oi < bi)) { bv = ov; bi = oi; } }
#pragma unroll
                    for (int j = 0; j < 4; ++j) if (ci[j] == bi) cv[j] = -3.0e38f;
                    if (lane == rnk) { myv = bv; myi = bi; }
                }
                const float mx = __shfl(myv, 0);
                const float e = (lane < 16) ? __expf(myv - mx) : 0.f;
                const float den = wave_sum(e);
                if (lane < 16) { const int a = myi >> 4, b = myi & 15;
                    sidx[tk * 128 + h * 16 + lane] = sti[(tk * 2 + 0) * 16 + a] * 128 + sti[(tk * 2 + 1) * 16 + b];
                    sgate[tk * 128 + h * 16 + lane] = e / den; }
            }
        }
        __syncthreads();
#pragma unroll 1
        for (int li = 0; li < 2; ++li) {
            const int tk = wave * 2 + li; const size_t tok = tok0 + tk;
            float hv[16], oacc[16];
            { const u32x4 a = *(const u32x4*)(HN + tok * DM + 8 * lane), b = *(const u32x4*)(HN + tok * DM + 512 + 8 * lane);
              hv[0] = bflo(a.x); hv[1] = bfhi(a.x); hv[2] = bflo(a.y); hv[3] = bfhi(a.y); hv[4] = bflo(a.z); hv[5] = bfhi(a.z); hv[6] = bflo(a.w); hv[7] = bfhi(a.w);
              hv[8] = bflo(b.x); hv[9] = bfhi(b.x); hv[10] = bflo(b.y); hv[11] = bfhi(b.y); hv[12] = bflo(b.z); hv[13] = bfhi(b.z); hv[14] = bflo(b.w); hv[15] = bfhi(b.w); }
#pragma unroll
            for (int j = 0; j < 16; ++j) oacc[j] = 0.f;
#pragma unroll 1
            for (int e0 = 0; e0 < 128; e0 += 4) {
                u32x4 da[4], db[4], ua[4], ub[4]; float gt[4];
#pragma unroll
                for (int j = 0; j < 4; ++j) { const int id = sidx[tk * 128 + e0 + j]; gt[j] = sgate[tk * 128 + e0 + j];
                    const bf16* dp = PD + (size_t)id * DM + 8 * lane; const bf16* up = PU + (size_t)id * DM + 8 * lane;
                    da[j] = *(const u32x4*)dp; db[j] = *(const u32x4*)(dp + 512); ua[j] = *(const u32x4*)up; ub[j] = *(const u32x4*)(up + 512); }
#pragma unroll
                for (int j = 0; j < 4; ++j) {
                    float d = (hv[0] * bflo(da[j].x) + hv[1] * bfhi(da[j].x)) + (hv[2] * bflo(da[j].y) + hv[3] * bfhi(da[j].y)) + (hv[4] * bflo(da[j].z) + hv[5] * bfhi(da[j].z)) + (hv[6] * bflo(da[j].w) + hv[7] * bfhi(da[j].w))
                            + (hv[8] * bflo(db[j].x) + hv[9] * bfhi(db[j].x)) + (hv[10] * bflo(db[j].y) + hv[11] * bfhi(db[j].y)) + (hv[12] * bflo(db[j].z) + hv[13] * bfhi(db[j].z)) + (hv[14] * bflo(db[j].w) + hv[15] * bfhi(db[j].w));
                    d = wave_sum(d);
                    const float cf = gt[j] * gelu_erf(d);
                    oacc[0] += cf * bflo(ua[j].x); oacc[1] += cf * bfhi(ua[j].x); oacc[2] += cf * bflo(ua[j].y); oacc[3] += cf * bfhi(ua[j].y);
                    oacc[4] += cf * bflo(ua[j].z); oacc[5] += cf * bfhi(ua[j].z); oacc[6] += cf * bflo(ua[j].w); oacc[7] += cf * bfhi(ua[j].w);
                    oacc[8] += cf * bflo(ub[j].x); oacc[9] += cf * bfhi(ub[j].x); oacc[10] += cf * bflo(ub[j].y); oacc[11] += cf * bfhi(ub[j].y);
                    oacc[12] += cf * bflo(ub[j].z); oacc[13] += cf * bfhi(ub[j].z); oacc[14] += cf * bflo(ub[j].w); oacc[15] += cf * bfhi(ub[j].w);
                }
            }
            float* op = F.out + tok * DM + 8 * lane;
            f32x4 r0 = *(const f32x4*)op, r1 = *(const f32x4*)(op + 4), r2 = *(const f32x4*)(op + 512), r3 = *(const f32x4*)(op + 516);
            r0.x += oacc[0]; r0.y += oacc[1]; r0.z += oacc[2]; r0.w += oacc[3]; r1.x += oacc[4]; r1.y += oacc[5]; r1.z += oacc[6]; r1.w += oacc[7];
            r2.x += oacc[8]; r2.y += oacc[9]; r2.z += oacc[10]; r2.w += oacc[11]; r3.x += oacc[12]; r3.y += oacc[13]; r3.z += oacc[14]; r3.w += oacc[15];
            *(f32x4*)op = r0; *(f32x4*)(op + 4) = r1; *(f32x4*)(op + 512) = r2; *(f32x4*)(op + 516) = r3;
        }
    }
}

constexpr int N_PHASES = 15;
__global__ void __launch_bounds__(NTHR, 2) mega_fwd(Args args) {
    extern __shared__ __attribute__((aligned(16))) unsigned char lds_raw[];
    Frame F;
    F.lds = (LAS unsigned char*)lds_raw;
    F.tid = threadIdx.x; F.lane = F.tid & 63; F.wave = __builtin_amdgcn_readfirstlane(F.tid >> 6);
    F.G = gridDim.x; F.bid = blockIdx.x;
#pragma unroll
    for (int i = 0; i < 26; ++i) F.in[i] = args.in[i];
    F.positions = args.positions; F.out = args.out; F.ws = args.ws;
    unsigned char* ws = args.ws;
    volatile LAS unsigned* ctlw = (volatile LAS unsigned*)(F.lds + LDSCTL_OFF);
    if (F.tid < 64) ctlw[F.tid] = 0u;
    __syncthreads();
    const int lo = args.ph_lo, hi = args.ph_hi;
    XcdBarrier bar; bar.bar = (unsigned*)(ws + WS_CTL); bar.x = 0; bar.st = nullptr;
    if (hi - lo > 1) bar = xcd_barrier_post((unsigned*)(ws + WS_CTL), ctlw + 8);
#define IN(k) (lo <= (k) && (k) < hi)
#define SEAM(k) do { if (IN(k) && IN((k) + 1)) xcd_barrier(bar); } while (0)
    bf16* ACT1 = (bf16*)(ws + WS_ACT1); bf16* BIG = (bf16*)(ws + WS_BIG); bf16* WallT = (bf16*)(ws + WS_WALLT);

    if (IN(0)) { p0_prologue(F); __syncthreads(); }
    SEAM(0);
    if (IN(1)) {
        { pg8::Gemm g{(const bf16*)(ws + WS_MEMN), (const bf16*)(ws + WS_WMKVT), NB * NMEM, 768, DM, DM, DM}; pg8::StaticOrder S; S.init(g.M, g.N, F.G, F.bid);
          pg8::EpiBf16<0> E{(bf16*)(ws + WS_MKV), 1536}; pg8::gemm_phase(F.lds, g, S, E); }
        { pg8::Gemm g{(const bf16*)(ws + WS_WMKVT) + (size_t)768 * DM, (const bf16*)(ws + WS_MEMN), 768, NB * NMEM, DM, DM, DM}; pg8::StaticOrder S; S.init(g.M, g.N, F.G, F.G - 1 - F.bid);
          pg8::EpiBf16<0> E{(bf16*)(ws + WS_MVT), NB * NMEM}; pg8::gemm_phase(F.lds, g, S, E); }
        { pg8::Gemm g{ACT1, WallT, HT, NPROJ, DM, DM, DM}; pg8::StaticOrder S; S.init(g.M, g.N, F.G, F.bid);
          pg8::EpiBf16<0> E{BIG, NPROJ}; pg8::gemm_phase(F.lds, g, S, E); }
    }
    SEAM(1);
    if (IN(2)) { qkprep_phase(F, 0); ssdC_phase(F, 0); }
    SEAM(2);
    if (IN(3)) { ssdD_phase(F); dilattn_mfma_phase(F, 0); memattn_mfma_phase(F, 0); }
    SEAM(3);
    if (IN(4)) { ssdE_phase(F, 0); dilmerge_phase(F, 0); }
    SEAM(4);
    if (IN(5)) { pg8::Gemm g{ACT1 + (size_t)HT * DM, WallT, HT, NPROJ, DM, DM, DM}; pg8::StaticOrder S; S.init(g.M, g.N, F.G, F.bid);
        pg8::EpiBf16<0> E{BIG, NPROJ}; pg8::gemm_phase(F.lds, g, S, E); }
    SEAM(5);
    if (IN(6)) { qkprep_phase(F, 1); ssdC_phase(F, 1); }
    SEAM(6);
    if (IN(7)) { ssdD_phase(F); dilattn_mfma_phase(F, 1); memattn_mfma_phase(F, 1); }
    SEAM(7);
    if (IN(8)) { ssdE_phase(F, 1); dilmerge_phase(F, 1); }
    SEAM(8);
    if (IN(9)) { pg8::Gemm g{ACT1, WallT + (size_t)NPROJ * DM, T, NGATE, DM, DM, DM}; pg8::StaticOrder S; S.init(g.M, g.N, F.G, F.bid);
        pg8::EpiBf16<1> E{BIG, NGATE}; pg8::gemm_phase(F.lds, g, S, E); }
    SEAM(9);
    if (IN(10)) {
        const bf16* Yc = (const bf16*)F.out; const bf16* Wc = (const bf16*)(ws + WS_WCATT);
        { pg8::Gemm g{Yc, Wc, T, DM, 1024, YC, YC}; pg8::StaticOrder S; S.init(g.M, g.N, F.G, F.bid); pg8::EpiBranch<false> E{ACT1, DM, BIG, NGATE, 0}; pg8::gemm_phase(F.lds, g, S, E); }
        { pg8::Gemm g{Yc + 1024, Wc + 1024, T, DM, 256, YC, YC}; pg8::StaticOrder S; S.init(g.M, g.N, F.G, F.bid); pg8::EpiBranch<true> E{ACT1, DM, BIG, NGATE, 1024}; pg8::gemm_phase(F.lds, g, S, E); }
        { pg8::Gemm g{Yc + 1280, Wc + 1280, T, DM, 768, YC, YC}; pg8::StaticOrder S; S.init(g.M, g.N, F.G, F.bid); pg8::EpiBranch<true> E{ACT1, DM, BIG, NGATE, 2048}; pg8::gemm_phase(F.lds, g, S, E); }
    }
    SEAM(10);
    if (IN(11)) { pg8::Gemm g{ACT1, (const bf16*)(ws + WS_WOUTT), T, DM, DM, DM, DM}; pg8::StaticOrder S; S.init(g.M, g.N, F.G, F.bid);
        pg8::EpiResid E{F.out, DM, F.in[I_X]}; pg8::gemm_phase(F.lds, g, S, E); }
    SEAM(11);
    if (IN(12)) hn_phase(F);
    SEAM(12);
    if (IN(13)) { pg8::Gemm g{ACT1, (const bf16*)(ws + WS_WQT), T, PEER_Q, DM, DM, DM}; pg8::StaticOrder S; S.init(g.M, g.N, F.G, F.bid);
        pg8::EpiBf16<0> E{BIG, PEER_Q}; pg8::gemm_phase(F.lds, g, S, E); }
    SEAM(13);
    if (IN(14)) peer_naive_phase(F);
#undef IN
#undef SEAM
}

extern "C" void kernel_launch(void* const* d_in, const int* in_sizes, int n_in, void* d_out, int out_size, void* d_ws, size_t ws_size, hipStream_t stream) {
    static int grid = 0;
    if (grid == 0) {
        if (n_in != 26 || out_size != T * DM || ws_size < WS_END) { fprintf(stderr, "kernel_launch: unexpected shapes (n_in %d, out %d, ws %zu)\n", n_in, out_size, ws_size); grid = -1; return; }
        int dev = 0, cus = 0;
        if (hipGetDevice(&dev) != hipSuccess || hipDeviceGetAttribute(&cus, hipDeviceAttributeMultiprocessorCount, dev) != hipSuccess) { grid = -1; return; }
        if (hipFuncSetAttribute((const void*)mega_fwd, hipFuncAttributeMaxDynamicSharedMemorySize, LDS_BYTES) != hipSuccess) { grid = -1; return; }
        int per_cu = 0;
        (void)hipOccupancyMaxActiveBlocksPerMultiprocessor(&per_cu, (const void*)mega_fwd, NTHR, LDS_BYTES);
        (void)hipGetLastError();
        grid = cus;
    }
    if (grid < 0) return;
    (void)hipMemsetAsync((char*)d_ws + WS_CTL, 0, CTL_ZERO_BYTES, stream);
    Args a{};
    for (int i = 0; i < 26; ++i) a.in[i] = (const float*)d_in[i];
    a.positions = (const int*)d_in[2]; a.out = (float*)d_out; a.ws = (unsigned char*)d_ws;
#if MK_N_LAUNCHES == 1
    a.ph_lo = 0; a.ph_hi = N_PHASES;
    hipLaunchKernelGGL(mega_fwd, dim3(grid), dim3(NTHR), LDS_BYTES, stream, a);
#else
    for (int p = 0; p < N_PHASES; ++p) { a.ph_lo = p; a.ph_hi = p + 1; hipLaunchKernelGGL(mega_fwd, dim3(grid), dim3(NTHR), LDS_BYTES, stream, a); }
#endif
}
```

```cpp
#include <hip/hip_runtime.h>
#include <cstdio>
#include <cstdint>

#ifndef MK_N_LAUNCHES
#define MK_N_LAUNCHES 1
#endif

#define LAS __attribute__((address_space(3)))
#define GAS __attribute__((address_space(1)))
typedef unsigned short bf16;
typedef short bf16x8 __attribute__((ext_vector_type(8)));
typedef float f32x4 __attribute__((ext_vector_type(4)));
typedef float f32x2 __attribute__((ext_vector_type(2)));
typedef unsigned u32x4 __attribute__((ext_vector_type(4)));
typedef unsigned u32x2 __attribute__((ext_vector_type(2)));

constexpr int NB = 8, SEQ = 8192, DM = 1024, T = NB * SEQ;
constexpr int HB = 4, HT = HB * SEQ;
constexpr int NMEM = 256;
constexpr int NPROJ = 6144;
constexpr int PC_Z = 0, PC_X = 1024, PC_B = 2048, PC_C = 2560, PC_DQ = 3072, PC_DK = 3840, PC_DV = 4608, PC_MQ = 5376;
constexpr int W_IN_N = 9232, OFF_DT = 3072, OFF_AFTER_DT = 3088;
constexpr int NGATE = 3072;
constexpr int YC = 2048;
constexpr int PEER_H = 8, PEER_K = 16, PEER_NK = 128, PEER_Q = 2048;
constexpr float EPS = 1e-6f;

constexpr size_t MiB = 1u << 20;
constexpr size_t WS_CTL = 0, CTL_ZERO_BYTES = 65536;
constexpr size_t WS_WALLT = 1 * MiB;
constexpr size_t WS_WMKVT = 19 * MiB;
constexpr size_t WS_WCATT = 22 * MiB;
constexpr size_t WS_WOUTT = 26 * MiB;
constexpr size_t WS_WQT = 28 * MiB;
constexpr size_t WS_SUBK = 32 * MiB;
constexpr size_t WS_PD = 33 * MiB;
constexpr size_t WS_PU = 65 * MiB;
constexpr size_t WS_DT = 97 * MiB;
constexpr size_t WS_MEMN = 101 * MiB;
constexpr size_t WS_MKV = 105 * MiB;
constexpr size_t WS_ACT1 = 112 * MiB;
constexpr size_t WS_BIG = 240 * MiB;
constexpr size_t WS_LSE = 624 * MiB;
constexpr size_t WS_MVT = 628 * MiB;
constexpr size_t WS_DEC = 631 * MiB;
constexpr size_t WS_SST = 632 * MiB;
constexpr size_t WS_SIN = 760 * MiB;
constexpr size_t WS_END = 824 * MiB;

constexpr int RING_BYTES = 131072;
constexpr int LDSCTL_OFF = 143360;
constexpr int LDS_BYTES = 147456;
constexpr int NWAVES = 8, NTHR = 512;

__device__ __forceinline__ float bf2f(unsigned short b) { return __builtin_bit_cast(float, (unsigned)b << 16); }
__device__ __forceinline__ float bflo(unsigned w) { return __builtin_bit_cast(float, w << 16); }
__device__ __forceinline__ float bfhi(unsigned w) { return __builtin_bit_cast(float, w & 0xffff0000u); }
__device__ __forceinline__ unsigned f2bf(float f) { unsigned u = __builtin_bit_cast(unsigned, f); return (u + 0x7fffu + ((u >> 16) & 1u)) >> 16; }
__device__ __forceinline__ unsigned pk2(float lo, float hi) { return f2bf(lo) | (f2bf(hi) << 16); }
typedef float f32x16 __attribute__((ext_vector_type(16)));
typedef short s16x4 __attribute__((ext_vector_type(4)));
typedef __bf16 bf2_t __attribute__((ext_vector_type(2)));
__device__ __forceinline__ unsigned pkbf(float a, float b) { const f32x2 v = {a, b}; return __builtin_bit_cast(unsigned, __builtin_convertvector(v, bf2_t)); }
#define MFMA32(a, b, c) __builtin_amdgcn_mfma_f32_32x32x16_bf16((a), (b), (c), 0, 0, 0)
__device__ __forceinline__ float wave_sum(float v) {
#pragma unroll
    for (int o = 1; o < 64; o <<= 1) v += __shfl_xor(v, o);
    return v;
}
__device__ __forceinline__ float wave_max(float v) {
#pragma unroll
    for (int o = 1; o < 64; o <<= 1) v = fmaxf(v, __shfl_xor(v, o));
    return v;
}
__device__ __forceinline__ float sigmoidf_(float x) { return 1.0f / (1.0f + __expf(-x)); }
#define LDS_WAIT() asm volatile("s_waitcnt lgkmcnt(0)" ::: "memory")
#define VM_WAIT() asm volatile("s_waitcnt vmcnt(0)" ::: "memory")

#define XB_TMO      128
#define XB_XCNT(j)  (256  + 64 * (j))
#define XB_XSUB(j)  (1280 + 64 * (j))
#define XB_XGEN(j)  (2304 + 64 * (j))
#define XB_TOP      3328
#define XB_TOPGEN   3392
#define XCD_BAR_WORDS 3456
#define XB_SPIN_CAP (1u << 18)
__device__ __forceinline__ unsigned xb_ld(unsigned* p)              { return __hip_atomic_load(p, __ATOMIC_RELAXED, __HIP_MEMORY_SCOPE_AGENT); }
__device__ __forceinline__ unsigned xb_add(unsigned* p, unsigned v) { return __hip_atomic_fetch_add(p, v, __ATOMIC_RELAXED, __HIP_MEMORY_SCOPE_AGENT); }
__device__ __forceinline__ unsigned xb_xcc_id() { return (unsigned)__builtin_amdgcn_s_getreg((3 << 11) | 20) & 0xFu; }
#define XB_SPIN(cond, bar) do { unsigned _sp = 0; while (cond) { __builtin_amdgcn_s_sleep(1); \
    if ((++_sp & 255u) == 0u) { if (xb_ld(&(bar)[XB_TMO])) break; if (_sp > XB_SPIN_CAP) { atomicAdd(&(bar)[XB_TMO], 1u); break; } } } } while (0)
struct XcdBarrier { unsigned* bar; unsigned x; volatile LAS unsigned* st; };
__device__ __forceinline__ XcdBarrier xcd_barrier_post(unsigned* bar, volatile LAS unsigned* st) {
    XcdBarrier b; b.bar = bar; b.x = xb_xcc_id(); b.st = st;
    if (threadIdx.x == 0) (void)xb_add(&bar[XB_XCNT(b.x)], 1u);
    return b;
}
__device__ __forceinline__ void xcd_barrier_complete(unsigned* bar, unsigned x, unsigned& nloc, unsigned& nx) {
    const unsigned G = gridDim.x * gridDim.y * gridDim.z;
    unsigned sum, cnt, mine, sp = 0u;
    for (;;) {
        sum = 0u; cnt = 0u; mine = 0u;
#pragma unroll
        for (unsigned j = 0; j < 16; ++j) { const unsigned c = xb_ld(&bar[XB_XCNT(j)]); sum += c; cnt += (c > 0u) ? 1u : 0u; mine = (j == x) ? c : mine; }
        if (sum == G) break;
        __builtin_amdgcn_s_sleep(1);
        if ((++sp & 255u) == 0u) { if (xb_ld(&bar[XB_TMO])) break; if (sp > XB_SPIN_CAP) { atomicAdd(&bar[XB_TMO], 1u); break; } }
    }
    nloc = mine > 0u ? mine : 1u; nx = cnt > 0u ? cnt : 1u;
}
__device__ __forceinline__ void xcd_barrier(const XcdBarrier& b) {
    asm volatile("s_waitcnt vmcnt(0)" ::: "memory");
    __syncthreads();
    if (threadIdx.x == 0) {
        unsigned* bar = b.bar;
        __builtin_amdgcn_s_waitcnt(0);
        unsigned nloc = b.st[0], nx = b.st[1];
        if (nloc == 0u) { xcd_barrier_complete(bar, b.x, nloc, nx); b.st[0] = nloc; b.st[1] = nx; }
        const unsigned old = xb_add(&bar[XB_XSUB(b.x)], 1u);
        const unsigned gen = old / nloc;
        if (old + 1u == (gen + 1u) * nloc) {
            __builtin_amdgcn_fence(__ATOMIC_RELEASE, "agent");
            asm volatile("s_waitcnt vmcnt(0)" ::: "memory");
            const unsigned og = xb_add(&bar[XB_TOP], 1u);
            const unsigned tg = og / nx;
            if (og + 1u == (tg + 1u) * nx) xb_add(&bar[XB_TOPGEN], 1u);
            else XB_SPIN(xb_ld(&bar[XB_TOPGEN]) == tg, bar);
            __builtin_amdgcn_fence(__ATOMIC_ACQUIRE, "agent");
            xb_add(&bar[XB_XGEN(b.x)], 1u);
            asm volatile("s_waitcnt vmcnt(0)" ::: "memory");
        } else {
            XB_SPIN(xb_ld(&bar[XB_XGEN(b.x)]) == gen, bar);
            __builtin_amdgcn_fence(__ATOMIC_ACQUIRE, "agent");
            asm volatile("s_waitcnt vmcnt(0)" ::: "memory");
        }
    }
    __syncthreads();
}

namespace pg8 {
constexpr int BM = 256, BK = 64, HALF = 128, HTB = HALF * BK * 2, STAGE_BYTES = 8 * HTB, NXCD = 8, WGM = 8;
__host__ __device__ __forceinline__ int lds_byte(int r, int c) { const int st = (r >> 4) * 2 + (c >> 5), rr = r & 15, cc = c & 31, ob = rr * 64 + cc * 2; return st * 1024 + (ob ^ (((ob >> 9) & 1) << 5)); }
__host__ __device__ __forceinline__ void stage_rc(int b, int& R, int& C) { const int st = b / 1024, sb = b % 1024, swz = sb ^ (((sb >> 9) & 1) << 5); R = (st >> 1) * 16 + swz / 64; C = (st & 1) * 32 + (swz % 64) / 2; }
__host__ __device__ __forceinline__ int perm32(int rho) { const int n = rho >> 4, i = rho & 15; return 8 * (i >> 2) + 4 * n + (i & 3); }
struct Unit { int pm, pn; };
struct Gemm { const bf16* A; const bf16* Bt; int M, N, K, lda, ldb; };
struct StaticOrder {
    int nM, nN, nwg, G, c;
    __host__ __device__ void init(int M, int N, int G_, int c_) { nM = M / BM; nN = N / BM; nwg = nM * nN; G = G_; c = c_; }
    __host__ __device__ bool next(int i, Unit& u) const {
        const long L = (long)i * G + c; if (L >= nwg) return false;
        int wgid = (int)L; { const int q = nwg / NXCD, r = nwg % NXCD, xcd = wgid % NXCD, off = wgid / NXCD; wgid = (xcd < r ? xcd * (q + 1) : r * (q + 1) + (xcd - r) * q) + off; }
        const int nig = WGM * nN, gid = wgid / nig, fm = gid * WGM, gsz = (nM - fm) < WGM ? (nM - fm) : WGM;
        u.pm = fm + ((wgid % nig) % gsz); u.pn = (wgid % nig) / gsz; return true;
    }
    __device__ __forceinline__ void a_ready(const Unit&) const {}
    __device__ __forceinline__ void done(const Unit&) const {}
};
__device__ __forceinline__ unsigned cvt_pk_bf16(float lo, float hi) { unsigned r; asm volatile("v_cvt_pk_bf16_f32 %0, %1, %2" : "=v"(r) : "v"(lo), "v"(hi)); return r; }

template <int ACT> struct EpiBf16 {
    static constexpr bool PERM = true, AFTER_DRAIN = false;
    bf16* O; int ldc;
    __device__ __forceinline__ void operator()(const f32x4 (&acc)[2][2][4][2], const Unit& u, int wr, int wc, int fr, int fq) const {
        const int row0 = u.pm * BM + wr * 64 + fr; const int col0 = u.pn * BM + wc * 32 + 8 * fq;
#pragma unroll
        for (int ai = 0; ai < 2; ++ai)
#pragma unroll
            for (int m = 0; m < 4; ++m) { bf16* rowp = O + (size_t)(row0 + ai * HALF + m * 16) * ldc + col0;
#pragma unroll
                for (int bj = 0; bj < 2; ++bj) { f32x4 v0 = acc[ai][bj][m][0], v1 = acc[ai][bj][m][1];
                    if (ACT == 1) {
#pragma unroll
                        for (int j = 0; j < 4; ++j) { v0[j] = sigmoidf_(v0[j]); v1[j] = sigmoidf_(v1[j]); } }
                    u32x4 w; w.x = cvt_pk_bf16(v0[0], v0[1]); w.y = cvt_pk_bf16(v0[2], v0[3]); w.z = cvt_pk_bf16(v1[0], v1[1]); w.w = cvt_pk_bf16(v1[2], v1[3]);
                    *(u32x4*)(rowp + bj * HALF) = w; } }
    }
};
template <bool ACCUM> struct EpiBranch {
    static constexpr bool PERM = true, AFTER_DRAIN = false;
    bf16* O; int ldc; const bf16* Gt; int ldg; int gcol0;
    __device__ __forceinline__ void operator()(const f32x4 (&acc)[2][2][4][2], const Unit& u, int wr, int wc, int fr, int fq) const {
        const int row0 = u.pm * BM + wr * 64 + fr; const int col0 = u.pn * BM + wc * 32 + 8 * fq;
#pragma unroll
        for (int ai = 0; ai < 2; ++ai)
#pragma unroll
            for (int m = 0; m < 4; ++m) { const size_t r = (size_t)(row0 + ai * HALF + m * 16); bf16* rowp = O + r * ldc + col0; const bf16* gp = Gt + r * ldg + gcol0 + col0;
#pragma unroll
                for (int bj = 0; bj < 2; ++bj) { const f32x4 v0 = acc[ai][bj][m][0], v1 = acc[ai][bj][m][1];
                    const u32x4 g = *(const u32x4*)(gp + bj * HALF);
                    float o[8];
                    o[0] = v0[0] * bflo(g.x); o[1] = v0[1] * bfhi(g.x); o[2] = v0[2] * bflo(g.y); o[3] = v0[3] * bfhi(g.y);
                    o[4] = v1[0] * bflo(g.z); o[5] = v1[1] * bfhi(g.z); o[6] = v1[2] * bflo(g.w); o[7] = v1[3] * bfhi(g.w);
                    if (ACCUM) { const u32x4 p = *(const u32x4*)(rowp + bj * HALF);
                        o[0] += bflo(p.x); o[1] += bfhi(p.x); o[2] += bflo(p.y); o[3] += bfhi(p.y); o[4] += bflo(p.z); o[5] += bfhi(p.z); o[6] += bflo(p.w); o[7] += bfhi(p.w); }
                    u32x4 w; w.x = cvt_pk_bf16(o[0], o[1]); w.y = cvt_pk_bf16(o[2], o[3]); w.z = cvt_pk_bf16(o[4], o[5]); w.w = cvt_pk_bf16(o[6], o[7]);
                    *(u32x4*)(rowp + bj * HALF) = w; } }
    }
};
struct EpiResid {
    static constexpr bool PERM = false, AFTER_DRAIN = false;
    float* C; int ldc; const float* R;
    __device__ __forceinline__ void operator()(const f32x4 (&acc)[2][2][4][2], const Unit& u, int wr, int wc, int fr, int fq) const {
        const int row0 = u.pm * BM + wr * 64 + fr, col0 = u.pn * BM + wc * 32 + 4 * fq;
#pragma unroll
        for (int ai = 0; ai < 2; ++ai)
#pragma unroll
            for (int m = 0; m < 4; ++m) { const size_t off = (size_t)(row0 + ai * HALF + m * 16) * ldc + col0;
#pragma unroll
                for (int bj = 0; bj < 2; ++bj)
#pragma unroll
                    for (int n = 0; n < 2; ++n) { const f32x4 r = *(const f32x4*)(R + off + bj * HALF + n * 16); *(f32x4*)(C + off + bj * HALF + n * 16) = acc[ai][bj][m][n] + r; } }
    }
};

template <class Epi, class Sched>
__device__ __forceinline__ void gemm_phase(LAS unsigned char* lds, const Gemm g, const Sched& S, const Epi& E) {
    const int tid = threadIdx.x, wid = __builtin_amdgcn_readfirstlane(tid >> 6), lane = tid & 63, wr = wid >> 2, wc = wid & 3, fr = lane & 15, fq = lane >> 4;
    const int K = g.K, nt = K / BK;
    unsigned voffA[2], voffB[2];
#pragma unroll
    for (int i = 0; i < 2; ++i) { int R, C; stage_rc(tid * 16 + i * 8192, R, C); const int Rb = Epi::PERM ? ((R & ~31) + perm32(R & 31)) : R;
        voffA[i] = (unsigned)(R * g.lda + C) * 2u; voffB[i] = (unsigned)(Rb * g.ldb + C) * 2u; }
    const size_t kstep = (size_t)(BK * 2);
    const size_t hsA = (size_t)HALF * g.lda * 2, hsB = (size_t)HALF * g.ldb * 2;
    const size_t tsA = 2 * hsA, tsB = 2 * hsB;
    const unsigned ldsw = (unsigned)wid * 1024u;
    const int aoff = lds_byte(wr * 64 + fr, fq * 8), boff = lds_byte(wc * 32 + fr, fq * 8);
#define PG8_SA(b, h) (((b) * 2 + (h)) * HTB)
#define PG8_SB(b, h) ((4 + (b) * 2 + (h)) * HTB)
#define PG8_STAGE(bufoff, gbase, voff) do { _Pragma("unroll") for (int _i = 0; _i < 2; ++_i) \
        __builtin_amdgcn_global_load_lds((const unsigned*)((const char*)(gbase) + (voff)[_i]), (LAS unsigned*)(lds + (bufoff) + ldsw + _i * 8192), 16, 0, 0); } while (0)
#define PG8_LDA(dst, b, h) do { _Pragma("unroll") for (int m = 0; m < 4; ++m) _Pragma("unroll") for (int k = 0; k < 2; ++k) dst[m][k] = *(const LAS bf16x8*)(lds + PG8_SA(b, h) + aoff + m * 2048 + k * 1024); } while (0)
#define PG8_LDB(dst, b, h) do { _Pragma("unroll") for (int n = 0; n < 2; ++n) _Pragma("unroll") for (int k = 0; k < 2; ++k) dst[n][k] = *(const LAS bf16x8*)(lds + PG8_SB(b, h) + boff + n * 2048 + k * 1024); } while (0)
#define PG8_MMA(ai, bj, At, Bt) do { __builtin_amdgcn_s_setprio(1); _Pragma("unroll") for (int m = 0; m < 4; ++m) _Pragma("unroll") for (int n = 0; n < 2; ++n) _Pragma("unroll") for (int k = 0; k < 2; ++k) \
        acc[ai][bj][m][n] = __builtin_amdgcn_mfma_f32_16x16x32_bf16(Bt[n][k], At[m][k], acc[ai][bj][m][n], 0, 0, 0); __builtin_amdgcn_s_setprio(0); } while (0)
#define PG8_WAIT_V(n) asm volatile("s_waitcnt vmcnt(" #n ")" ::: "memory")
#define PG8_WAIT_L(n) asm volatile("s_waitcnt lgkmcnt(" #n ")" ::: "memory")
#define PG8_BAR __builtin_amdgcn_s_barrier()
#define PG8_SCHED __builtin_amdgcn_sched_barrier(0)
    Unit cur, nxt; int ui = 0;
    if (!S.next(0, cur)) return;
    f32x4 acc[2][2][4][2];
#pragma unroll
    for (int a = 0; a < 2; ++a)
#pragma unroll
        for (int b = 0; b < 2; ++b)
#pragma unroll
            for (int m = 0; m < 4; ++m)
#pragma unroll
                for (int n = 0; n < 2; ++n) acc[a][b][m][n] = (f32x4){0.f, 0.f, 0.f, 0.f};
    bf16x8 At[4][2], B0[2][2], B1[2][2];
    const char* cA = (const char*)g.A + (size_t)cur.pm * tsA; const char* cB = (const char*)g.Bt + (size_t)cur.pn * tsB;
    S.a_ready(cur);
    PG8_STAGE(PG8_SB(0, 0), cB, voffB); PG8_STAGE(PG8_SA(0, 0), cA, voffA); PG8_STAGE(PG8_SB(0, 1), cB + hsB, voffB); PG8_STAGE(PG8_SA(0, 1), cA + hsA, voffA);
    if (wr == 1) PG8_BAR;
    PG8_WAIT_V(4); PG8_BAR;
    PG8_STAGE(PG8_SB(1, 0), cB + kstep, voffB); PG8_STAGE(PG8_SA(1, 0), cA + kstep, voffA); PG8_STAGE(PG8_SB(1, 1), cB + hsB + kstep, voffB);
    PG8_WAIT_V(6); PG8_BAR;
    for (;;) {
        const bool has_next = S.next(ui + 1, nxt);
        const char* nA = has_next ? (const char*)g.A + (size_t)nxt.pm * tsA : cA; const char* nB = has_next ? (const char*)g.Bt + (size_t)nxt.pn * tsB : cB;
        for (int t = 0; t < nt; t += 2) {
            const bool last = (t == nt - 2);
            const char* a1 = cA + (size_t)(t + 1) * kstep;
            const char* a2 = last ? nA : cA + (size_t)(t + 2) * kstep; const char* b2 = last ? nB : cB + (size_t)(t + 2) * kstep;
            const char* a3 = a2 + kstep; const char* b3 = b2 + kstep;
            if (last && has_next) S.a_ready(nxt);
            PG8_LDB(B0, 0, 0); PG8_SCHED; PG8_LDA(At, 0, 0); PG8_STAGE(PG8_SA(1, 1), a1 + hsA, voffA);
            PG8_WAIT_L(8); PG8_BAR; PG8_WAIT_L(0); PG8_MMA(0, 0, At, B0); PG8_BAR; PG8_SCHED;
            PG8_LDB(B1, 0, 1); PG8_STAGE(PG8_SB(0, 0), b2, voffB);
            PG8_BAR; PG8_WAIT_L(0); PG8_MMA(0, 1, At, B1); PG8_BAR;
            PG8_LDA(At, 0, 1); PG8_STAGE(PG8_SA(0, 0), a2, voffA);
            PG8_BAR; PG8_WAIT_L(0); PG8_MMA(1, 0, At, B0); PG8_BAR; PG8_SCHED;
            PG8_STAGE(PG8_SB(0, 1), b2 + hsB, voffB);
            PG8_WAIT_V(6); PG8_BAR; PG8_MMA(1, 1, At, B1); PG8_BAR;
            PG8_LDB(B0, 1, 0); PG8_SCHED; PG8_LDA(At, 1, 0); PG8_STAGE(PG8_SA(0, 1), a2 + hsA, voffA);
            PG8_WAIT_L(8); PG8_BAR; PG8_WAIT_L(0); PG8_MMA(0, 0, At, B0); PG8_BAR; PG8_SCHED;
            PG8_LDB(B1, 1, 1); PG8_STAGE(PG8_SB(1, 0), b3, voffB);
            PG8_BAR; PG8_WAIT_L(0); PG8_MMA(0, 1, At, B1); PG8_BAR;
            PG8_LDA(At, 1, 1); PG8_STAGE(PG8_SA(1, 0), a3, voffA);
            PG8_BAR; PG8_WAIT_L(0); PG8_MMA(1, 0, At, B0); PG8_BAR; PG8_SCHED;
            PG8_STAGE(PG8_SB(1, 1), b3 + hsB, voffB);
            PG8_WAIT_V(6); PG8_BAR; PG8_MMA(1, 1, At, B1); PG8_BAR;
        }
        E(acc, cur, wr, wc, fr, fq); S.done(cur);
        if (!has_next) break;
#pragma unroll
        for (int a = 0; a < 2; ++a)
#pragma unroll
            for (int b = 0; b < 2; ++b)
#pragma unroll
                for (int m = 0; m < 4; ++m)
#pragma unroll
                    for (int n = 0; n < 2; ++n) acc[a][b][m][n] = (f32x4){0.f, 0.f, 0.f, 0.f};
        cur = nxt; cA = nA; cB = nB; ++ui;
    }
    PG8_WAIT_V(0);
    if (wr == 0) PG8_BAR;
    PG8_BAR;
#undef PG8_SA
#undef PG8_SB
#undef PG8_STAGE
#undef PG8_LDA
#undef PG8_LDB
#undef PG8_MMA
#undef PG8_WAIT_V
#undef PG8_WAIT_L
#undef PG8_BAR
#undef PG8_SCHED
}
}

struct Args {
    const float* in[26]; const int* positions; float* out; unsigned char* ws; int ph_lo, ph_hi; int pad0, pad1;
};
struct Frame {
    LAS unsigned char* lds;
    int tid, lane, wave, G, bid;
    const float* in[26]; const int* positions; float* out; unsigned char* ws;
};
enum { I_X = 0, I_MEM = 1, I_POS = 2, I_NMIXW = 3, I_WIN = 4, I_CONVW = 5, I_CONVB = 6, I_DTB = 7, I_ALOG = 8, I_SSDD = 9, I_SSDNW = 10, I_DQNW = 11, I_DKNW = 12, I_MEMNW = 13,
       I_WMKV = 14, I_MQNW = 15, I_MKNW = 16, I_WSSD = 17, I_WDIL = 18, I_WMEMBR = 19, I_WOUT = 20, I_NFFNW = 21, I_WQ = 22, I_SUBK = 23, I_PD = 24, I_PU = 25 };

__device__ __forceinline__ void p0_transpose_item(const float* W, int ldw, int src_col0, bf16* WT, int ldt, int dst_row0, int dst_col0, int nblk, LAS float* scr, int item, int lane) {
    const int kb = item / nblk, nb = item % nblk, k0 = 64 * kb, n0 = 32 * nb;
#pragma unroll 8
    for (int i = 0; i < 32; ++i) { const int kk = 2 * i + (lane >> 5); scr[kk * 33 + (lane & 31)] = W[(size_t)(k0 + kk) * ldw + src_col0 + n0 + (lane & 31)]; }
    LDS_WAIT(); asm volatile("" ::: "memory");
    const int c = lane & 7;
#pragma unroll
    for (int j = 0; j < 4; ++j) { const int n = (lane >> 3) + 8 * j; const LAS float* s = scr + (8 * c) * 33 + n;
        u32x4 o; o.x = pk2(s[0 * 33], s[1 * 33]); o.y = pk2(s[2 * 33], s[3 * 33]); o.z = pk2(s[4 * 33], s[5 * 33]); o.w = pk2(s[6 * 33], s[7 * 33]);
        *(u32x4*)(WT + (size_t)(dst_row0 + n0 + n) * ldt + dst_col0 + k0 + 8 * c) = o; }
    LDS_WAIT(); asm volatile("" ::: "memory");
}
__device__ __forceinline__ void rms_row_to_bf16(const float* xrow, const float* w, bf16* orow, int lane, f32x4 (&v)[4]) {
    const f32x4* xr = (const f32x4*)xrow + lane; const f32x4* wr = (const f32x4*)w + lane;
    float s = 0.f;
#pragma unroll
    for (int j = 0; j < 4; ++j) { v[j] = xr[64 * j]; s += (v[j].x * v[j].x + v[j].y * v[j].y) + (v[j].z * v[j].z + v[j].w * v[j].w); }
    const float rstd = 1.0f / sqrtf(wave_sum(s) * (1.f / DM) + EPS);
    unsigned long long* o8 = (unsigned long long*)orow + lane;
#pragma unroll
    for (int j = 0; j < 4; ++j) { const f32x4 ww = wr[64 * j]; v[j] = v[j] * rstd * ww;
        o8[64 * j] = (unsigned long long)pk2(v[j].x, v[j].y) | ((unsigned long long)pk2(v[j].z, v[j].w) << 32); }
}
__device__ __forceinline__ void cvt_f32_bf16_stream(const float* src, bf16* dst, size_t n, size_t gtid, size_t gthreads) {
    for (size_t i = gtid * 8; i < n; i += gthreads * 8) { const f32x4 a = *(const f32x4*)(src + i), b = *(const f32x4*)(src + i + 4);
        u32x4 o; o.x = pk2(a.x, a.y); o.y = pk2(a.z, a.w); o.z = pk2(b.x, b.y); o.w = pk2(b.z, b.w); *(u32x4*)(dst + i) = o; }
}
__device__ __forceinline__ void p0_prologue(Frame& F) {
    LAS float* scr = (LAS float*)(F.lds + F.wave * 8448);
    LAS float* wdt = (LAS float*)(F.lds + 8 * 8448);
    const int gw = F.bid * NWAVES + F.wave, NGW = F.G * NWAVES;
    unsigned char* ws = F.ws;
    for (int i = F.tid; i < 1024 * 16; i += NTHR) wdt[i] = F.in[I_WIN][(size_t)(i >> 4) * W_IN_N + OFF_DT + (i & 15)];
    __syncthreads();
    constexpr int IT_A = 16 * 96, IT_B = 16 * 192, IT_MKV = 16 * 48, IT_SSD = 16 * 32, IT_DIL = 4 * 32, IT_MBR = 12 * 32, IT_OUT = 16 * 32, IT_WQ = 16 * 64;
    constexpr int NITEMS = IT_A + IT_B + IT_MKV + IT_SSD + IT_DIL + IT_MBR + IT_OUT + IT_WQ;
    bf16* WallT = (bf16*)(ws + WS_WALLT);
    for (int it = gw; it < NITEMS; it += NGW) {
        int r = it;
        if (r < IT_A) { p0_transpose_item(F.in[I_WIN], W_IN_N, 0, WallT, DM, 0, 0, 96, scr, r, F.lane); continue; } r -= IT_A;
        if (r < IT_B) { p0_transpose_item(F.in[I_WIN], W_IN_N, OFF_AFTER_DT, WallT, DM, 3072, 0, 192, scr, r, F.lane); continue; } r -= IT_B;
        if (r < IT_MKV) { p0_transpose_item(F.in[I_WMKV], 1536, 0, (bf16*)(ws + WS_WMKVT), DM, 0, 0, 48, scr, r, F.lane); continue; } r -= IT_MKV;
        if (r < IT_SSD) { p0_transpose_item(F.in[I_WSSD], DM, 0, (bf16*)(ws + WS_WCATT), YC, 0, 0, 32, scr, r, F.lane); continue; } r -= IT_SSD;
        if (r < IT_DIL) { p0_transpose_item(F.in[I_WDIL], DM, 0, (bf16*)(ws + WS_WCATT), YC, 0, 1024, 32, scr, r, F.lane); continue; } r -= IT_DIL;
        if (r < IT_MBR) { p0_transpose_item(F.in[I_WMEMBR], DM, 0, (bf16*)(ws + WS_WCATT), YC, 0, 1280, 32, scr, r, F.lane); continue; } r -= IT_MBR;
        if (r < IT_OUT) { p0_transpose_item(F.in[I_WOUT], DM, 0, (bf16*)(ws + WS_WOUTT), DM, 0, 0, 32, scr, r, F.lane); continue; } r -= IT_OUT;
        p0_transpose_item(F.in[I_WQ], PEER_Q, 0, (bf16*)(ws + WS_WQT), DM, 0, 0, 64, scr, r, F.lane);
    }
    const size_t gtid = (size_t)F.bid * NTHR + F.tid, gth = (size_t)F.G * NTHR;
    cvt_f32_bf16_stream(F.in[I_SUBK], (bf16*)(ws + WS_SUBK), (size_t)8 * 2 * 128 * 128, gtid, gth);
    cvt_f32_bf16_stream(F.in[I_PD], (bf16*)(ws + WS_PD), (size_t)16384 * 1024, gtid, gth);
    cvt_f32_bf16_stream(F.in[I_PU], (bf16*)(ws + WS_PU), (size_t)16384 * 1024, gtid, gth);
    for (int m = gw; m < NB * NMEM; m += NGW) { f32x4 v[4]; rms_row_to_bf16(F.in[I_MEM] + (size_t)m * DM, F.in[I_MEMNW], (bf16*)(ws + WS_MEMN) + (size_t)m * DM, F.lane, v); }
    float* DTp = (float*)(ws + WS_DT);
    for (int m = gw; m < T; m += NGW) {
        f32x4 v[4]; rms_row_to_bf16(F.in[I_X] + (size_t)m * DM, F.in[I_NMIXW], (bf16*)(ws + WS_ACT1) + (size_t)m * DM, F.lane, v);
        float d[16];
#pragma unroll
        for (int j = 0; j < 16; ++j) d[j] = 0.f;
#pragma unroll
        for (int j = 0; j < 4; ++j)
#pragma unroll
            for (int e = 0; e < 4; ++e) { const int k = 4 * F.lane + 256 * j + e; const float uv = v[j][e];
#pragma unroll
                for (int q = 0; q < 4; ++q) { const f32x4 w4 = *(const LAS f32x4*)(wdt + k * 16 + 4 * q); d[4 * q + 0] += uv * w4.x; d[4 * q + 1] += uv * w4.y; d[4 * q + 2] += uv * w4.z; d[4 * q + 3] += uv * w4.w; }
                __builtin_amdgcn_sched_barrier(0); }
        float mine = 0.f;
#pragma unroll
        for (int j = 0; j < 16; ++j) { const float s = wave_sum(d[j]); mine = (F.lane == j) ? s : mine; }
        if (F.lane < 16) { const float xx = mine + F.in[I_DTB][F.lane]; DTp[(size_t)m * 16 + F.lane] = (xx > 20.f) ? xx : log1pf(__expf(xx)); }
    }
}

__device__ __forceinline__ void qkprep_phase(Frame& F, int half) {
    bf16* P = (bf16*)(F.ws + WS_BIG);
    const int gw = F.bid * NWAVES + F.wave, NGW = F.G * NWAVES, lane = F.lane;
    const float wq = F.in[I_DQNW][lane], wk = F.in[I_DKNW][lane];
    const float wmq0 = F.in[I_MQNW][lane], wmq1 = F.in[I_MQNW][lane + 64], wmq2 = F.in[I_MQNW][lane + 128];
    const float inv = __expf(-logf(500000.0f) * (2.0f / 16.0f) * (float)(lane & 7));
    for (int r = gw; r < HT; r += NGW) {
        const int tok = half * HT + r;
        const int pos = F.positions[tok];
        const double rev = (double)((float)pos * inv) * 0.15915494309189535;
        const float fr = (float)(rev - floor(rev));
        const float cs = __builtin_amdgcn_cosf(fr), sn = __builtin_amdgcn_sinf(fr);
        bf16* row = P + (size_t)r * NPROJ;
#pragma unroll 4
        for (int h = 0; h < 24; ++h) {
            bf16* p = row + PC_DQ + h * 64 + lane;
            float v = bf2f(*p);
            const float ss = wave_sum(v * v);
            v = v * (1.0f / sqrtf(ss * (1.f / 64.f) + EPS)) * (h < 12 ? wq : wk);
            const float other = __shfl_xor(v, 8);
            if (lane < 8) v = v * cs - other * sn; else if (lane < 16) v = v * cs + other * sn;
            *p = (bf16)f2bf(v);
        }
#pragma unroll
        for (int h = 0; h < 4; ++h) {
            bf16* p = row + PC_MQ + h * 192 + lane;
            float v0 = bf2f(p[0]), v1 = bf2f(p[64]), v2 = bf2f(p[128]);
            const float ss = wave_sum(v0 * v0 + v1 * v1 + v2 * v2);
            const float rs = 1.0f / sqrtf(ss * (1.f / 192.f) + EPS);
            p[0] = (bf16)f2bf(v0 * rs * wmq0); p[64] = (bf16)f2bf(v1 * rs * wmq1); p[128] = (bf16)f2bf(v2 * rs * wmq2);
        }
    }
    if (half == 0) {
        bf16* MK = (bf16*)(F.ws + WS_MKV);
        const float wk0 = F.in[I_MKNW][lane], wk1 = F.in[I_MKNW][lane + 64], wk2 = F.in[I_MKNW][lane + 128];
        for (int r = gw; r < NB * NMEM * 4; r += NGW) {
            bf16* p = MK + (size_t)(r >> 2) * 1536 + (r & 3) * 192 + lane;
            float v0 = bf2f(p[0]), v1 = bf2f(p[64]), v2 = bf2f(p[128]);
            const float ss = wave_sum(v0 * v0 + v1 * v1 + v2 * v2);
            const float rs = 1.0f / sqrtf(ss * (1.f / 192.f) + EPS);
            p[0] = (bf16)f2bf(v0 * rs * wk0); p[64] = (bf16)f2bf(v1 * rs * wk1); p[128] = (bf16)f2bf(v2 * rs * wk2);
        }
    }
}

__device__ __forceinline__ void ssd_naive_phase(Frame& F, int half) {
    const bf16* P = (const bf16*)(F.ws + WS_BIG);
    bf16* Y = (bf16*)F.out;
    const float* DTp = (const float*)(F.ws + WS_DT);
    LAS float* sx = (LAS float*)F.lds;
    LAS float* sB = sx + 64 * 16;
    LAS float* sC = sB + 64 * 128;
    LAS float* sdt = sC + 64 * 128;
    LAS float* sy = sdt + 64;
    const int tid = F.tid, pl = tid >> 5, ng = tid & 31;
    const float* cw = F.in[I_CONVW]; const float* cb = F.in[I_CONVB];
    for (int chain = F.bid; chain < HB * 16 * 4; chain += F.G) {
        const int bl = chain >> 6, head = (chain >> 2) & 15, pq = chain & 3, grp = head >> 2;
        const float A = -__expf(F.in[I_ALOG][head]), Dh = F.in[I_SSDD][head];
        const size_t row0 = (size_t)bl * SEQ;
        const size_t tok0 = (size_t)half * HT + row0;
        float h0 = 0.f, h1 = 0.f, h2 = 0.f, h3 = 0.f;
        for (int t0 = 0; t0 < SEQ; t0 += 64) {
            __syncthreads();
            for (int o = tid; o < 64 * 272; o += NTHR) {
                const int tt = o / 272, cc = o % 272;
                int pcol, ccol;
                if (cc < 16) { ccol = head * 64 + pq * 16 + cc; }
                else if (cc < 144) { ccol = 1024 + grp * 128 + (cc - 16); }
                else { ccol = 1536 + grp * 128 + (cc - 144); }
                pcol = PC_X + ccol;
                const int t = t0 + tt;
                float a = cb[ccol];
#pragma unroll
                for (int k = 0; k < 4; ++k) { const int ts = t - 3 + k; if (ts >= 0) a += cw[k * 2048 + ccol] * bf2f(P[(row0 + ts) * NPROJ + pcol]); }
                a = a * sigmoidf_(a);
                if (cc < 16) sx[tt * 16 + cc] = a; else if (cc < 144) sB[tt * 128 + cc - 16] = a; else sC[tt * 128 + cc - 144] = a;
            }
            if (tid < 64) sdt[tid] = DTp[(tok0 + t0 + tid) * 16 + head];
            __syncthreads();
            for (int tt = 0; tt < 64; ++tt) {
                const float dt = sdt[tt], xv = sx[tt * 16 + pl];
                const float dA = __expf(dt * A), xdt = xv * dt;
                const f32x4 b4 = *(const LAS f32x4*)(sB + tt * 128 + 4 * ng), c4 = *(const LAS f32x4*)(sC + tt * 128 + 4 * ng);
                h0 = h0 * dA + xdt * b4.x; h1 = h1 * dA + xdt * b4.y; h2 = h2 * dA + xdt * b4.z; h3 = h3 * dA + xdt * b4.w;
                float acc = (h0 * c4.x + h1 * c4.y) + (h2 * c4.z + h3 * c4.w);
                acc += __shfl_xor(acc, 1); acc += __shfl_xor(acc, 2); acc += __shfl_xor(acc, 4); acc += __shfl_xor(acc, 8); acc += __shfl_xor(acc, 16);
                if (ng == 0) sy[tt * 16 + pl] = acc + Dh * xv;
            }
            __syncthreads();
            for (int o = tid; o < 64 * 16; o += NTHR) { const int tt = o >> 4, cc = o & 15; Y[(tok0 + t0 + tt) * YC + head * 64 + pq * 16 + cc] = (bf16)f2bf(sy[o]); }
        }
    }
}

__device__ __forceinline__ void gatenorm_phase(Frame& F, int half) {
    const bf16* P = (const bf16*)(F.ws + WS_BIG);
    bf16* Y = (bf16*)F.out;
    const int gw = F.bid * NWAVES + F.wave, NGW = F.G * NWAVES, lane = F.lane;
    const float* nw = F.in[I_SSDNW];
    for (int r = gw; r < HT; r += NGW) {
        const size_t tok = (size_t)half * HT + r;
        bf16* yp = Y + tok * YC + lane * 16; const bf16* zp = P + (size_t)r * NPROJ + PC_Z + lane * 16;
        const u32x4 ya = *(const u32x4*)yp, yb = *(const u32x4*)(yp + 8), za = *(const u32x4*)zp, zb = *(const u32x4*)(zp + 8);
        float y[16], z[16];
        y[0] = bflo(ya.x); y[1] = bfhi(ya.x); y[2] = bflo(ya.y); y[3] = bfhi(ya.y); y[4] = bflo(ya.z); y[5] = bfhi(ya.z); y[6] = bflo(ya.w); y[7] = bfhi(ya.w);
        y[8] = bflo(yb.x); y[9] = bfhi(yb.x); y[10] = bflo(yb.y); y[11] = bfhi(yb.y); y[12] = bflo(yb.z); y[13] = bfhi(yb.z); y[14] = bflo(yb.w); y[15] = bfhi(yb.w);
        z[0] = bflo(za.x); z[1] = bfhi(za.x); z[2] = bflo(za.y); z[3] = bfhi(za.y); z[4] = bflo(za.z); z[5] = bfhi(za.z); z[6] = bflo(za.w); z[7] = bfhi(za.w);
        z[8] = bflo(zb.x); z[9] = bfhi(zb.x); z[10] = bflo(zb.y); z[11] = bfhi(zb.y); z[12] = bflo(zb.z); z[13] = bfhi(zb.z); z[14] = bflo(zb.w); z[15] = bfhi(zb.w);
        float ss = 0.f;
#pragma unroll
        for (int j = 0; j < 16; ++j) { y[j] = y[j] * z[j] * sigmoidf_(z[j]); ss += y[j] * y[j]; }
        ss += __shfl_xor(ss, 1); ss += __shfl_xor(ss, 2); ss += __shfl_xor(ss, 4); ss += __shfl_xor(ss, 8);
        const float rs = 1.0f / sqrtf(ss * (1.f / 256.f) + EPS);
        const f32x4* w4 = (const f32x4*)(nw + lane * 16);
        u32x4 oa, ob; f32x4 w;
        w = w4[0]; oa.x = pk2(y[0] * rs * w.x, y[1] * rs * w.y); oa.y = pk2(y[2] * rs * w.z, y[3] * rs * w.w);
        w = w4[1]; oa.z = pk2(y[4] * rs * w.x, y[5] * rs * w.y); oa.w = pk2(y[6] * rs * w.z, y[7] * rs * w.w);
        w = w4[2]; ob.x = pk2(y[8] * rs * w.x, y[9] * rs * w.y); ob.y = pk2(y[10] * rs * w.z, y[11] * rs * w.w);
        w = w4[3]; ob.z = pk2(y[12] * rs * w.x, y[13] * rs * w.y); ob.w = pk2(y[14] * rs * w.z, y[15] * rs * w.w);
        *(u32x4*)yp = oa; *(u32x4*)(yp + 8) = ob;
    }
}

__device__ __forceinline__ void dilattn_naive_phase(Frame& F, int half) {
    const bf16* P = (const bf16*)(F.ws + WS_BIG);
    bf16* Y = (bf16*)F.out;
    const int gw = F.bid * NWAVES + F.wave, NGW = F.G * NWAVES, lane = F.lane;
    for (int it = gw; it < HT * 4; it += NGW) {
        const int r = it >> 2, hh = it & 3;
        const int s = r & (SEQ - 1);
        const size_t rb = (size_t)(r - s);
        float M = -1e30f, L = 0.f, O = 0.f;
#pragma unroll 1
        for (int g = 0; g < 3; ++g) {
            const int head = 4 * g + hh, dil = (g == 0) ? 1 : (g == 1 ? 4 : 16);
            const bf16* qp = P + (size_t)r * NPROJ + PC_DQ + head * 64;
            u32x4 q[8];
#pragma unroll
            for (int j = 0; j < 8; ++j) q[j] = *(const u32x4*)(qp + 8 * j);
            float sc[3];
#pragma unroll
            for (int c = 0; c < 3; ++c) {
                const int j = lane + 64 * c; const int ps = s - j * dil;
                float a = -1e30f;
                if (j <= 128 && ps >= 0) {
                    const bf16* kp = P + (rb + ps) * NPROJ + PC_DK + head * 64;
                    a = 0.f;
#pragma unroll
                    for (int jj = 0; jj < 8; ++jj) { const u32x4 kk = *(const u32x4*)(kp + 8 * jj);
                        a += bflo(q[jj].x) * bflo(kk.x) + bfhi(q[jj].x) * bfhi(kk.x) + bflo(q[jj].y) * bflo(kk.y) + bfhi(q[jj].y) * bfhi(kk.y)
                           + bflo(q[jj].z) * bflo(kk.z) + bfhi(q[jj].z) * bfhi(kk.z) + bflo(q[jj].w) * bflo(kk.w) + bfhi(q[jj].w) * bfhi(kk.w); }
                    a *= 0.125f;
                }
                sc[c] = a;
            }
            const float m = wave_max(fmaxf(fmaxf(sc[0], sc[1]), sc[2]));
            float p0 = (sc[0] > -1e29f) ? __expf(sc[0] - m) : 0.f, p1 = (sc[1] > -1e29f) ? __expf(sc[1] - m) : 0.f, p2 = (sc[2] > -1e29f) ? __expf(sc[2] - m) : 0.f;
            const float l = wave_sum(p0 + p1 + p2);
            float o = 0.f;
            const int nk = min(128, s / dil) + 1;
            const bf16* vbase = P + PC_DV + head * 64 + lane;
            for (int j = 0; j < nk; ++j) {
                const float pj = __shfl(j < 64 ? p0 : (j < 128 ? p1 : p2), j & 63);
                o += pj * bf2f(vbase[(rb + s - j * dil) * NPROJ]);
            }
            const float Mn = fmaxf(M, m), f0 = __expf(M - Mn), f1 = __expf(m - Mn);
            O = O * f0 + o * f1; L = L * f0 + l * f1; M = Mn;
        }
        Y[((size_t)half * HT + r) * YC + 1024 + hh * 64 + lane] = (bf16)f2bf(O / L);
    }
}

__device__ __forceinline__ void memattn_naive_phase(Frame& F, int half) {
    const bf16* P = (const bf16*)(F.ws + WS_BIG);
    const bf16* MKV = (const bf16*)(F.ws + WS_MKV);
    bf16* Y = (bf16*)F.out;
    LAS float* sq = (LAS float*)(F.lds) + F.wave * 192;
    const int gw = F.bid * NWAVES + F.wave, NGW = F.G * NWAVES, lane = F.lane;
    for (int it = gw; it < HT * 4; it += NGW) {
        const int r = it >> 2, head = it & 3;
        const int b = half * HB + (r >> 13);
        const bf16* qp = P + (size_t)r * NPROJ + PC_MQ + head * 192;
        sq[lane] = bf2f(qp[lane]); sq[lane + 64] = bf2f(qp[lane + 64]); sq[lane + 128] = bf2f(qp[lane + 128]);
        LDS_WAIT(); __builtin_amdgcn_wave_barrier();
        float sc[4];
#pragma unroll
        for (int c = 0; c < 4; ++c) {
            const bf16* kp = MKV + (size_t)(b * NMEM + lane + 64 * c) * 1536 + head * 192;
            float a = 0.f;
#pragma unroll 4
            for (int jj = 0; jj < 24; ++jj) { const u32x4 kk = *(const u32x4*)(kp + 8 * jj); const f32x4 qa = *(const LAS f32x4*)(sq + 8 * jj), qb = *(const LAS f32x4*)(sq + 8 * jj + 4);
                a += qa.x * bflo(kk.x) + qa.y * bfhi(kk.x) + qa.z * bflo(kk.y) + qa.w * bfhi(kk.y) + qb.x * bflo(kk.z) + qb.y * bfhi(kk.z) + qb.z * bflo(kk.w) + qb.w * bfhi(kk.w); }
            sc[c] = a * 0.07216878364870323f;
        }
        const float m = wave_max(fmaxf(fmaxf(sc[0], sc[1]), fmaxf(sc[2], sc[3])));
        float p[4];
#pragma unroll
        for (int c = 0; c < 4; ++c) p[c] = __expf(sc[c] - m);
        const float l = wave_sum((p[0] + p[1]) + (p[2] + p[3]));
        float o0 = 0.f, o1 = 0.f, o2 = 0.f;
        const bf16* vb = MKV + (size_t)(b * NMEM) * 1536 + 768 + head * 192 + lane;
#pragma unroll
        for (int c = 0; c < 4; ++c)
#pragma unroll 8
            for (int j = 0; j < 64; ++j) { const float pj = __shfl(p[c], j); const bf16* vp = vb + (size_t)(j + 64 * c) * 1536;
                o0 += pj * bf2f(vp[0]); o1 += pj * bf2f(vp[64]); o2 += pj * bf2f(vp[128]); }
        const float il = 1.0f / l;
        bf16* yp = Y + ((size_t)half * HT + r) * YC + 1280 + head * 192 + lane;
        yp[0] = (bf16)f2bf(o0 * il); yp[64] = (bf16)f2bf(o1 * il); yp[128] = (bf16)f2bf(o2 * il);
        __builtin_amdgcn_wave_barrier();
    }
}

constexpr int SC_ST = 272, SX_ST = 528;
__device__ __forceinline__ float bfsel(const u32x4& v, int j) { const unsigned w = v[j >> 1]; return (j & 1) ? bfhi(w) : bflo(w); }
__device__ __forceinline__ void conv_task(const bf16* P, size_t rowb, int t0, int pcol, const float* cw, const float* cb, int ccol, LAS unsigned char* dst, int stride, const LAS float* scale) {
    float w[4][8], bs[8];
#pragma unroll
    for (int k = 0; k < 4; ++k) { const f32x4 a = *(const f32x4*)(cw + k * 2048 + ccol), b = *(const f32x4*)(cw + k * 2048 + ccol + 4);
        w[k][0] = a.x; w[k][1] = a.y; w[k][2] = a.z; w[k][3] = a.w; w[k][4] = b.x; w[k][5] = b.y; w[k][6] = b.z; w[k][7] = b.w; }
    { const f32x4 a = *(const f32x4*)(cb + ccol), b = *(const f32x4*)(cb + ccol + 4); bs[0] = a.x; bs[1] = a.y; bs[2] = a.z; bs[3] = a.w; bs[4] = b.x; bs[5] = b.y; bs[6] = b.z; bs[7] = b.w; }
    const bf16* src = P + (rowb + t0) * NPROJ + pcol;
    u32x4 w0 = {0u, 0u, 0u, 0u}, w1 = w0, w2 = w0;
    if (t0 > 0) { w0 = *(const u32x4*)(src - 3 * (ptrdiff_t)NPROJ); w1 = *(const u32x4*)(src - 2 * (ptrdiff_t)NPROJ); w2 = *(const u32x4*)(src - (ptrdiff_t)NPROJ); }
#pragma unroll 4
    for (int i = 0; i < 16; ++i) {
        const u32x4 cur = *(const u32x4*)(src + (size_t)i * NPROJ);
        float o[8];
#pragma unroll
        for (int j = 0; j < 8; ++j) { float a = bs[j] + w[0][j] * bfsel(w0, j) + w[1][j] * bfsel(w1, j) + w[2][j] * bfsel(w2, j) + w[3][j] * bfsel(cur, j); o[j] = a * sigmoidf_(a); }
        if (scale) { const float sv = scale[i];
#pragma unroll
            for (int j = 0; j < 8; ++j) o[j] *= sv; }
        const u32x4 r = {pkbf(o[0], o[1]), pkbf(o[2], o[3]), pkbf(o[4], o[5]), pkbf(o[6], o[7])};
        *(LAS u32x4*)(dst + i * stride) = r;
        w0 = w1; w1 = w2; w2 = cur;
    }
}
__device__ __forceinline__ float ssd_scan(Frame& F, const float* DTp, size_t tok0, int g, LAS float* sAc, LAS float* sDt) {
    float total = 0.f;
    if (F.wave < 4) {
        const int head = 4 * g + F.wave, lane = F.lane;
        const float A = -__expf(F.in[I_ALOG][head]);
        const float d0 = DTp[(tok0 + 2 * lane) * 16 + head], d1 = DTp[(tok0 + 2 * lane + 1) * 16 + head];
        const float a0 = d0 * A, a1 = d1 * A;
        float sc = a0 + a1;
#pragma unroll
        for (int o = 1; o < 64; o <<= 1) { const float v = __shfl_up(sc, o); if (lane >= o) sc += v; }
        sAc[F.wave * 128 + 2 * lane] = sc - a1; sAc[F.wave * 128 + 2 * lane + 1] = sc;
        sDt[F.wave * 128 + 2 * lane] = d0; sDt[F.wave * 128 + 2 * lane + 1] = d1;
        total = __shfl(sc, 63);
    }
    return total;
}
__device__ __forceinline__ bf16x8 tr_pair(unsigned a_lo, unsigned a_hi) {
    s16x4 lo, hi;
    asm volatile("ds_read_b64_tr_b16 %0, %2\n\tds_read_b64_tr_b16 %1, %3\n\ts_waitcnt lgkmcnt(0)" : "=&v"(lo), "=&v"(hi) : "v"(a_lo), "v"(a_hi) : "memory");
    const bf16x8 r = {lo[0], lo[1], lo[2], lo[3], hi[0], hi[1], hi[2], hi[3]}; return r;
}

__device__ __forceinline__ void ssdC_phase(Frame& F, int half) {
    const bf16* P = (const bf16*)(F.ws + WS_BIG);
    const float* DTp = (const float*)(F.ws + WS_DT);
    float* SST = (float*)(F.ws + WS_SST); float* DEC = (float*)(F.ws + WS_DEC);
    LAS unsigned char* sX = F.lds; LAS unsigned char* sB = F.lds + 128 * SX_ST;
    LAS float* sAc = (LAS float*)(F.lds + 128 * SX_ST + 128 * SC_ST); LAS float* sDt = sAc + 512; LAS float* sW = sDt + 512;
    const int wave = F.wave;
    for (int unit = F.bid; unit < HB * 64 * 4; unit += F.G) {
        int tid = F.tid; asm volatile("" : "+v"(tid));
        const int lane = tid & 63, ql = lane & 31, h = lane >> 5, tq = (lane & 15) >> 2, tp = lane & 3, tblk = (lane >> 4) & 1;
        const int bl = unit >> 8, c = (unit >> 2) & 63, g = unit & 3;
        const size_t rowb = (size_t)bl * SEQ, tok0 = (size_t)half * HT + rowb + c * 128;
        __syncthreads();
        const float total = ssd_scan(F, DTp, tok0, g, sAc, sDt);
        if (wave < 4) { sW[wave * 128 + 2 * lane] = __expf(total - sAc[wave * 128 + 2 * lane]) * sDt[wave * 128 + 2 * lane];
            sW[wave * 128 + 2 * lane + 1] = __expf(total - sAc[wave * 128 + 2 * lane + 1]) * sDt[wave * 128 + 2 * lane + 1];
            if (lane == 0) DEC[((size_t)bl * 64 + c) * 16 + 4 * g + wave] = __expf(total); }
        __syncthreads();
        if (tid < 384) {
            int ch, strip, ccol, stride; LAS unsigned char* dst; const LAS float* scl = nullptr;
            if (tid < 256) { ch = tid & 31; strip = tid >> 5; ccol = g * 256 + 8 * ch; stride = SX_ST; dst = sX + (strip * 16) * SX_ST + ch * 16; scl = sW + (ch >> 3) * 128 + strip * 16; }
            else { const int u = tid - 256; ch = u & 15; strip = u >> 4; ccol = 1024 + g * 128 + 8 * ch; stride = SC_ST; dst = sB + (strip * 16) * SC_ST + ch * 16; }
            conv_task(P, rowb, c * 128 + strip * 16, PC_X + ccol, F.in[I_CONVW], F.in[I_CONVB], ccol, dst, stride, scl);
        }
        __syncthreads();
        const int r = wave >> 1, pt = wave & 1;
        f32x16 acc[4];
#pragma unroll
        for (int nt = 0; nt < 4; ++nt)
#pragma unroll
            for (int e = 0; e < 16; ++e) acc[nt][e] = 0.f;
        const unsigned xa = (unsigned)(size_t)sX + (unsigned)((8 * h + tq) * SX_ST + (r * 64 + 32 * pt + 16 * tblk + 4 * tp) * 2);
        const unsigned ba = (unsigned)(size_t)sB + (unsigned)((8 * h + tq) * SC_ST + (16 * tblk + 4 * tp) * 2);
#pragma unroll
        for (int ks = 0; ks < 8; ++ks) {
            const bf16x8 af = tr_pair(xa + ks * 16 * SX_ST, xa + ks * 16 * SX_ST + 4 * SX_ST);
            bf16x8 bfr[4];
#pragma unroll
            for (int nt = 0; nt < 4; ++nt) bfr[nt] = tr_pair(ba + ks * 16 * SC_ST + nt * 64, ba + ks * 16 * SC_ST + 4 * SC_ST + nt * 64);
            __builtin_amdgcn_sched_barrier(0);
#pragma unroll
            for (int nt = 0; nt < 4; ++nt) acc[nt] = MFMA32(af, bfr[nt], acc[nt]);
        }
        float* out = SST + (((size_t)bl * 64 + c) * 16 + 4 * g + r) * 8192;
#pragma unroll
        for (int nt = 0; nt < 4; ++nt)
#pragma unroll
            for (int e = 0; e < 16; ++e) out[(32 * pt + (e & 3) + 8 * (e >> 2) + 4 * h) * 128 + 32 * nt + ql] = acc[nt][e];
    }
}

__device__ __forceinline__ void ssdD_phase(Frame& F) {
    const float* SST = (const float*)(F.ws + WS_SST); const float* DEC = (const float*)(F.ws + WS_DEC);
    bf16* SIN = (bf16*)(F.ws + WS_SIN);
    const size_t gtid = (size_t)F.bid * NTHR + F.tid, gth = (size_t)F.G * NTHR;
    for (size_t it = gtid; it < (size_t)HB * 16 * 2048; it += gth) {
        const int bl = (int)(it >> 15), head = (int)(it >> 11) & 15, e4 = (int)(it & 2047) * 4;
        f32x4 st = {0.f, 0.f, 0.f, 0.f};
#pragma unroll 8
        for (int c = 0; c < 64; ++c) {
            const size_t idx = (((size_t)bl * 64 + c) * 16 + head);
            const u32x2 o = {pkbf(st.x, st.y), pkbf(st.z, st.w)};
            *(u32x2*)(SIN + idx * 8192 + e4) = o;
            const f32x4 sl = *(const f32x4*)(SST + idx * 8192 + e4); const float d = DEC[idx];
            st = st * d + sl;
        }
    }
}

__device__ __forceinline__ void ssdE_phase(Frame& F, int half) {
    const bf16* P = (const bf16*)(F.ws + WS_BIG);
    const float* DTp = (const float*)(F.ws + WS_DT);
    const bf16* SIN = (const bf16*)(F.ws + WS_SIN);
    bf16* Y = (bf16*)F.out;
    LAS unsigned char* sX = F.lds; LAS unsigned char* sB = F.lds + 128 * SX_ST; LAS unsigned char* sC = sB + 128 * SC_ST;
    LAS float* sAc = (LAS float*)(sC + 128 * SC_ST); LAS float* sDt = sAc + 512; LAS float* sSS = sDt + 512;
    const int wave = F.wave;
    const int st = wave & 3, hp = wave >> 2;
    for (int unit = F.bid; unit < HB * 64 * 4; unit += F.G) {
        int tid = F.tid; asm volatile("" : "+v"(tid));
        const int lane = tid & 63, ql = lane & 31, h = lane >> 5, tq = (lane & 15) >> 2, tp = lane & 3, tblk = (lane >> 4) & 1;
        const int bl = unit >> 8, c = (unit >> 2) & 63, g = unit & 3;
        const size_t rowb = (size_t)bl * SEQ, tok0 = (size_t)half * HT + rowb + c * 128;
        __syncthreads();
        (void)ssd_scan(F, DTp, tok0, g, sAc, sDt);
        if (tid < 128) sSS[tid] = 0.f;
        {
            int ch, strip, ccol, stride; LAS unsigned char* dst;
            if (tid < 256) { ch = tid & 31; strip = tid >> 5; ccol = g * 256 + 8 * ch; stride = SX_ST; dst = sX + (strip * 16) * SX_ST + ch * 16; }
            else if (tid < 384) { const int u = tid - 256; ch = u & 15; strip = u >> 4; ccol = 1024 + g * 128 + 8 * ch; stride = SC_ST; dst = sB + (strip * 16) * SC_ST + ch * 16; }
            else { const int u = tid - 384; ch = u & 15; strip = u >> 4; ccol = 1536 + g * 128 + 8 * ch; stride = SC_ST; dst = sC + (strip * 16) * SC_ST + ch * 16; }
            conv_task(P, rowb, c * 128 + strip * 16, PC_X + ccol, F.in[I_CONVW], F.in[I_CONVB], ccol, dst, stride, nullptr);
        }
        __syncthreads();
        const int s = 32 * st + ql;
        unsigned yk[2][2][8];
        float ssq = 0.f;
        const unsigned xa = (unsigned)(size_t)sX + (unsigned)((4 * h + tq) * SX_ST + (16 * tblk + 4 * tp) * 2);
#pragma unroll
        for (int hq = 0; hq < 2; ++hq) {
            const int r = 2 * hp + hq, head = 4 * g + r;
            const float acs = sAc[r * 128 + s];
            bf16x8 pf[4][2];
#pragma unroll
            for (int i = 0; i < 4; ++i) {
                f32x16 Xi;
#pragma unroll
                for (int e = 0; e < 16; ++e) Xi[e] = 0.f;
#pragma unroll
                for (int ks = 0; ks < 8; ++ks) { const bf16x8 bf_ = *(const LAS bf16x8*)(sB + (32 * i + ql) * SC_ST + 32 * ks + 16 * h);
                    const bf16x8 cf = *(const LAS bf16x8*)(sC + s * SC_ST + 32 * ks + 16 * h); Xi = MFMA32(bf_, cf, Xi); }
                float p[16];
#pragma unroll
                for (int q4 = 0; q4 < 4; ++q4) { const int t0 = 32 * i + 8 * q4 + 4 * h;
                    const f32x4 at = *(const LAS f32x4*)(sAc + r * 128 + t0), dt4 = *(const LAS f32x4*)(sDt + r * 128 + t0);
#pragma unroll
                    for (int e = 0; e < 4; ++e) { const int t = t0 + e; p[4 * q4 + e] = (t <= s) ? Xi[4 * q4 + e] * __expf(acs - at[e]) * dt4[e] : 0.f; } }
#pragma unroll
                for (int s2 = 0; s2 < 2; ++s2) { const u32x4 w = {pkbf(p[8 * s2 + 0], p[8 * s2 + 1]), pkbf(p[8 * s2 + 2], p[8 * s2 + 3]), pkbf(p[8 * s2 + 4], p[8 * s2 + 5]), pkbf(p[8 * s2 + 6], p[8 * s2 + 7])};
                    pf[i][s2] = __builtin_bit_cast(bf16x8, w); }
            }
            const bf16* stp = SIN + (((size_t)bl * 64 + c) * 16 + head) * 8192;
            const float eacs = __expf(acs), Dh = F.in[I_SSDD][head];
#pragma unroll
            for (int pt = 0; pt < 2; ++pt) {
                f32x16 yd, yo;
#pragma unroll
                for (int e = 0; e < 16; ++e) { yd[e] = 0.f; yo[e] = 0.f; }
#pragma unroll
                for (int i = 0; i < 4; ++i) {
#pragma unroll
                    for (int s2 = 0; s2 < 2; ++s2) { const unsigned a = xa + (unsigned)((32 * i + 16 * s2) * SX_ST + (r * 64 + 32 * pt) * 2);
                        const bf16x8 xf = tr_pair(a, a + 8 * SX_ST); __builtin_amdgcn_sched_barrier(0); yd = MFMA32(xf, pf[i][s2], yd); }
                }
#pragma unroll
                for (int ks = 0; ks < 8; ++ks) { const bf16x8 sf = *(const bf16x8*)(stp + (32 * pt + ql) * 128 + 16 * ks + 8 * h);
                    const bf16x8 cf = *(const LAS bf16x8*)(sC + s * SC_ST + 32 * ks + 16 * h); yo = MFMA32(sf, cf, yo); }
                const bf16* zp = P + (rowb + c * 128 + s) * NPROJ + PC_Z + g * 256 + r * 64 + 32 * pt + 4 * h;
#pragma unroll
                for (int q4 = 0; q4 < 4; ++q4) {
                    const u32x2 xv = *(const LAS u32x2*)(sX + s * SX_ST + (r * 64 + 32 * pt + 8 * q4 + 4 * h) * 2);
                    const u32x2 zv = *(const u32x2*)(zp + 8 * q4);
                    const float xs_[4] = {bflo(xv.x), bfhi(xv.x), bflo(xv.y), bfhi(xv.y)}, zs_[4] = {bflo(zv.x), bfhi(zv.x), bflo(zv.y), bfhi(zv.y)};
                    float yv[4];
#pragma unroll
                    for (int e = 0; e < 4; ++e) { float y = yd[4 * q4 + e] + eacs * yo[4 * q4 + e] + Dh * xs_[e]; y = y * zs_[e] * sigmoidf_(zs_[e]); yv[e] = y; ssq += y * y; }
                    yk[hq][pt][2 * q4] = pkbf(yv[0], yv[1]); yk[hq][pt][2 * q4 + 1] = pkbf(yv[2], yv[3]);
                }
            }
        }
        ssq += __shfl_xor(ssq, 32);
        if (h == 0) __hip_atomic_fetch_add(sSS + s, ssq, __ATOMIC_RELAXED, __HIP_MEMORY_SCOPE_WORKGROUP);
        __syncthreads();
        const float rs = 1.0f / sqrtf(sSS[s] * (1.f / 256.f) + EPS);
        bf16* yp = Y + (tok0 + s) * YC + g * 256 + 4 * h;
        const float* nw = F.in[I_SSDNW] + g * 256 + 4 * h;
#pragma unroll
        for (int hq = 0; hq < 2; ++hq)
#pragma unroll
            for (int pt = 0; pt < 2; ++pt)
#pragma unroll
                for (int q4 = 0; q4 < 4; ++q4) { const int cc = (2 * hp + hq) * 64 + 32 * pt + 8 * q4; const f32x4 w4 = *(const f32x4*)(nw + cc);
                    const unsigned ya = yk[hq][pt][2 * q4], yb = yk[hq][pt][2 * q4 + 1];
                    const u32x2 o = {pkbf(bflo(ya) * rs * w4.x, bfhi(ya) * rs * w4.y), pkbf(bflo(yb) * rs * w4.z, bfhi(yb) * rs * w4.w)};
                    *(u32x2*)(yp + cc) = o; }
    }
}

__device__ __forceinline__ bf16x8 mk_bf16x8(u32x2 lo, u32x2 hi) { const u32x4 v = {lo.x, lo.y, hi.x, hi.y}; return __builtin_bit_cast(bf16x8, v); }

__device__ __forceinline__ void memattn_mfma_phase(Frame& F, int half) {
    const bf16* P = (const bf16*)(F.ws + WS_BIG);
    const bf16* MKV = (const bf16*)(F.ws + WS_MKV);
    const bf16* MVT = (const bf16*)(F.ws + WS_MVT);
    bf16* Y = (bf16*)F.out;
    LAS unsigned char* sm = F.lds;
    const int tid = F.tid, lane = F.lane, wave = F.wave, ql = lane & 31, h = lane >> 5;
    constexpr int KST = 400, VST = 528;
    for (int unit = F.bid; unit < HB * 4 * 32; unit += F.G) {
        const int bl = unit >> 7, head = (unit >> 5) & 3, qt = unit & 31, b = half * HB + bl;
        const int r = bl * SEQ + qt * 256 + wave * 32 + ql;
        __syncthreads();
        for (int c = tid; c < 256 * 24; c += NTHR) { const int row = c / 24, ch = c % 24;
            *(LAS u32x4*)(sm + row * KST + ch * 16) = *(const u32x4*)(MKV + (size_t)(b * NMEM + row) * 1536 + head * 192 + ch * 8); }
        bf16x8 qf[12];
        { const bf16* qp = P + (size_t)r * NPROJ + PC_MQ + head * 192 + 8 * h;
#pragma unroll
          for (int ks = 0; ks < 12; ++ks) qf[ks] = *(const bf16x8*)(qp + 16 * ks); }
        __syncthreads();
        f32x16 sacc[8];
#pragma unroll
        for (int mt = 0; mt < 8; ++mt) {
#pragma unroll
            for (int i = 0; i < 16; ++i) sacc[mt][i] = 0.f;
#pragma unroll
            for (int ks = 0; ks < 12; ++ks) { const bf16x8 kf = *(const LAS bf16x8*)(sm + (32 * mt + ql) * KST + 32 * ks + 16 * h); sacc[mt] = MFMA32(kf, qf[ks], sacc[mt]); }
        }
        float mx = -3.0e38f;
#pragma unroll
        for (int mt = 0; mt < 8; ++mt)
#pragma unroll
            for (int i = 0; i < 16; ++i) mx = fmaxf(mx, sacc[mt][i]);
        mx = fmaxf(mx, __shfl_xor(mx, 32));
        const float sc = 0.07216878364870323f * 1.4426950408889634f;
        float l = 0.f;
        bf16x8 pf[8][2];
#pragma unroll
        for (int mt = 0; mt < 8; ++mt) {
            float p[16];
#pragma unroll
            for (int i = 0; i < 16; ++i) { p[i] = __builtin_amdgcn_exp2f((sacc[mt][i] - mx) * sc); l += p[i]; }
#pragma unroll
            for (int s2 = 0; s2 < 2; ++s2) { const u32x4 w = {pkbf(p[8 * s2 + 0], p[8 * s2 + 1]), pkbf(p[8 * s2 + 2], p[8 * s2 + 3]), pkbf(p[8 * s2 + 4], p[8 * s2 + 5]), pkbf(p[8 * s2 + 6], p[8 * s2 + 7])};
                pf[mt][s2] = __builtin_bit_cast(bf16x8, w); }
        }
        l += __shfl_xor(l, 32);
        __syncthreads();
        for (int c = tid; c < 192 * 32; c += NTHR) { const int row = c >> 5, ch = c & 31;
            *(LAS u32x4*)(sm + row * VST + ch * 16) = *(const u32x4*)(MVT + (size_t)(head * 192 + row) * 2048 + b * NMEM + ch * 8); }
        __syncthreads();
        const float il = 1.0f / l;
        bf16* yp = Y + ((size_t)half * HT + r) * YC + 1280 + head * 192 + 4 * h;
#pragma unroll
        for (int dt = 0; dt < 6; ++dt) {
            f32x16 o;
#pragma unroll
            for (int i = 0; i < 16; ++i) o[i] = 0.f;
#pragma unroll
            for (int mt = 0; mt < 8; ++mt)
#pragma unroll
                for (int s2 = 0; s2 < 2; ++s2) { const LAS unsigned char* vp = sm + (32 * dt + ql) * VST + (32 * mt + 16 * s2 + 4 * h) * 2;
                    const bf16x8 vf = mk_bf16x8(*(const LAS u32x2*)vp, *(const LAS u32x2*)(vp + 16)); o = MFMA32(vf, pf[mt][s2], o); }
#pragma unroll
            for (int g = 0; g < 4; ++g) { const u32x2 w = {pkbf(o[4 * g] * il, o[4 * g + 1] * il), pkbf(o[4 * g + 2] * il, o[4 * g + 3] * il)}; *(u32x2*)(yp + 32 * dt + 8 * g) = w; }
        }
    }
}

__device__ __forceinline__ void dilattn_mfma_phase(Frame& F, int half) {
    bf16* P = (bf16*)(F.ws + WS_BIG);
    float* LSE = (float*)(F.ws + WS_LSE);
    LAS unsigned char* sK = F.lds; LAS unsigned char* sV = F.lds + 384 * 144;
    const int tid = F.tid, lane = F.lane, wave = F.wave, ql = lane & 31, h = lane >> 5;
    constexpr int RST = 144;
    for (int unit = F.bid; unit < HB * 12 * 32; unit += F.G) {
        const int bl = unit / 384, rem = unit % 384, head = rem >> 5, blk = rem & 31;
        const int g = head >> 2, dil = (g == 0) ? 1 : (g == 1 ? 4 : 16), bpr = 32 / dil;
        const int res = blk / bpr, q0 = (blk % bpr) * 256;
        const size_t rowb = (size_t)bl * SEQ;
        __syncthreads();
        for (int c = tid; c < 384 * 8; c += NTHR) { const int row = c >> 3, ch = c & 7; const int ks = q0 - 128 + row;
            u32x4 kv = {0u, 0u, 0u, 0u}, vv = {0u, 0u, 0u, 0u};
            if (ks >= 0) { const bf16* src = P + (rowb + (size_t)ks * dil + res) * NPROJ + head * 64 + ch * 8; kv = *(const u32x4*)(src + PC_DK); vv = *(const u32x4*)(src + PC_DV); }
            *(LAS u32x4*)(sK + row * RST + ch * 16) = kv; *(LAS u32x4*)(sV + row * RST + ch * 16) = vv; }
        const int qs = q0 + wave * 32 + ql;
        const size_t rq = rowb + (size_t)qs * dil + res;
        bf16* qp = P + rq * NPROJ + PC_DQ + head * 64;
        bf16x8 qf[4];
#pragma unroll
        for (int ks = 0; ks < 4; ++ks) qf[ks] = *(const bf16x8*)(qp + 16 * ks + 8 * h);
        __syncthreads();
        f32x16 sacc[5];
        const int kfirst = q0 + wave * 32 - 128;
#pragma unroll
        for (int i = 0; i < 5; ++i) {
#pragma unroll
            for (int e = 0; e < 16; ++e) sacc[i][e] = 0.f;
#pragma unroll
            for (int ks = 0; ks < 4; ++ks) { const bf16x8 kf = *(const LAS bf16x8*)(sK + (32 * wave + 32 * i + ql) * RST + 32 * ks + 16 * h); sacc[i] = MFMA32(kf, qf[ks], sacc[i]); }
        }
        float mx = -3.0e38f;
#pragma unroll
        for (int i = 0; i < 5; ++i)
#pragma unroll
            for (int e = 0; e < 16; ++e) { const int kj = 32 * i + (e & 3) + 8 * (e >> 2) + 4 * h; const bool ok = (kj >= ql) && (kj <= ql + 128) && (kfirst + kj >= 0);
                sacc[i][e] = ok ? sacc[i][e] : -3.0e38f; mx = fmaxf(mx, sacc[i][e]); }
        mx = fmaxf(mx, __shfl_xor(mx, 32));
        const float sc = 0.125f * 1.4426950408889634f;
        float l = 0.f;
        bf16x8 pf[5][2];
#pragma unroll
        for (int i = 0; i < 5; ++i) {
            float p[16];
#pragma unroll
            for (int e = 0; e < 16; ++e) { p[e] = (sacc[i][e] > -1.0e38f) ? __builtin_amdgcn_exp2f((sacc[i][e] - mx) * sc) : 0.f; l += p[e]; }
#pragma unroll
            for (int s2 = 0; s2 < 2; ++s2) { const u32x4 w = {pkbf(p[8 * s2 + 0], p[8 * s2 + 1]), pkbf(p[8 * s2 + 2], p[8 * s2 + 3]), pkbf(p[8 * s2 + 4], p[8 * s2 + 5]), pkbf(p[8 * s2 + 6], p[8 * s2 + 7])};
                pf[i][s2] = __builtin_bit_cast(bf16x8, w); }
        }
        l += __shfl_xor(l, 32);
        const float il = 1.0f / l;
        const int tq = (lane & 15) >> 2, tp = lane & 3, tblk = (lane >> 4) & 1;
        const unsigned vbase = (unsigned)(size_t)(sV) + (unsigned)((32 * wave + 4 * h + tq) * RST + (16 * tblk + 4 * tp) * 2);
#pragma unroll
        for (int dt = 0; dt < 2; ++dt) {
            f32x16 o;
#pragma unroll
            for (int e = 0; e < 16; ++e) o[e] = 0.f;
#pragma unroll
            for (int i = 0; i < 5; ++i) {
                s16x4 lo[2], hi[2];
#pragma unroll
                for (int s2 = 0; s2 < 2; ++s2) { const unsigned a = vbase + (unsigned)((32 * i + 16 * s2) * RST + 64 * dt);
                    asm volatile("ds_read_b64_tr_b16 %0, %1" : "=&v"(lo[s2]) : "v"(a) : "memory");
                    asm volatile("ds_read_b64_tr_b16 %0, %1 offset:1152" : "=&v"(hi[s2]) : "v"(a) : "memory"); }
                asm volatile("s_waitcnt lgkmcnt(0)" ::: "memory"); __builtin_amdgcn_sched_barrier(0);
#pragma unroll
                for (int s2 = 0; s2 < 2; ++s2) { const bf16x8 vf = {lo[s2][0], lo[s2][1], lo[s2][2], lo[s2][3], hi[s2][0], hi[s2][1], hi[s2][2], hi[s2][3]}; o = MFMA32(vf, pf[i][s2], o); }
            }
#pragma unroll
            for (int gq = 0; gq < 4; ++gq) { const u32x2 w = {pkbf(o[4 * gq] * il, o[4 * gq + 1] * il), pkbf(o[4 * gq + 2] * il, o[4 * gq + 3] * il)}; *(u32x2*)(qp + 32 * dt + 8 * gq + 4 * h) = w; }
        }
        if (h == 0) LSE[((size_t)half * HT + rq) * 12 + head] = mx * 0.125f + __logf(l);
    }
}

__device__ __forceinline__ void dilmerge_phase(Frame& F, int half) {
    const bf16* P = (const bf16*)(F.ws + WS_BIG);
    const float* LSE = (const float*)(F.ws + WS_LSE);
    bf16* Y = (bf16*)F.out;
    const size_t gtid = (size_t)F.bid * NTHR + F.tid, gth = (size_t)F.G * NTHR;
    for (size_t it = gtid; it < (size_t)HT * 32; it += gth) {
        const size_t r = it >> 5; const int hh = (int)(it >> 3) & 3, d0 = (int)(it & 7) * 8;
        const size_t tok = (size_t)half * HT + r;
        const float l0 = LSE[tok * 12 + hh], l1 = LSE[tok * 12 + 4 + hh], l2 = LSE[tok * 12 + 8 + hh];
        const float m = fmaxf(l0, fmaxf(l1, l2));
        float w0 = __expf(l0 - m), w1 = __expf(l1 - m), w2 = __expf(l2 - m); const float iw = 1.0f / (w0 + w1 + w2); w0 *= iw; w1 *= iw; w2 *= iw;
        const bf16* op = P + r * NPROJ + PC_DQ + hh * 64 + d0;
        const u32x4 a = *(const u32x4*)op, b = *(const u32x4*)(op + 256), c = *(const u32x4*)(op + 512);
        u32x4 o;
        o.x = pkbf(w0 * bflo(a.x) + w1 * bflo(b.x) + w2 * bflo(c.x), w0 * bfhi(a.x) + w1 * bfhi(b.x) + w2 * bfhi(c.x));
        o.y = pkbf(w0 * bflo(a.y) + w1 * bflo(b.y) + w2 * bflo(c.y), w0 * bfhi(a.y) + w1 * bfhi(b.y) + w2 * bfhi(c.y));
        o.z = pkbf(w0 * bflo(a.z) + w1 * bflo(b.z) + w2 * bflo(c.z), w0 * bfhi(a.z) + w1 * bfhi(b.z) + w2 * bfhi(c.z));
        o.w = pkbf(w0 * bflo(a.w) + w1 * bflo(b.w) + w2 * bflo(c.w), w0 * bfhi(a.w) + w1 * bfhi(b.w) + w2 * bfhi(c.w));
        *(u32x4*)(Y + tok * YC + 1024 + hh * 64 + d0) = o;
    }
}

__device__ __forceinline__ void hn_phase(Frame& F) {
    const int gw = F.bid * NWAVES + F.wave, NGW = F.G * NWAVES;
    for (int m = gw; m < T; m += NGW) { f32x4 v[4]; rms_row_to_bf16(F.out + (size_t)m * DM, F.in[I_NFFNW], (bf16*)(F.ws + WS_ACT1) + (size_t)m * DM, F.lane, v); }
}

__device__ __forceinline__ float gelu_erf(float x) { return 0.5f * x * (1.0f + erff(x * 0.70710678118654752f)); }
__device__ __forceinline__ void peer_naive_phase(Frame& F) {
    const bf16* Q = (const bf16*)(F.ws + WS_BIG);
    const bf16* SK = (const bf16*)(F.ws + WS_SUBK);
    const bf16* PD = (const bf16*)(F.ws + WS_PD); const bf16* PU = (const bf16*)(F.ws + WS_PU);
    const bf16* HN = (const bf16*)(F.ws + WS_ACT1);
    LAS float* sq = (LAS float*)F.lds;
    LAS float* ssc = sq + 16 * 256;
    LAS float* stv = ssc + 16 * 256;
    LAS int* sti = (LAS int*)(stv + 16 * 32);
    LAS int* sidx = sti + 16 * 32;
    LAS float* sgate = (LAS float*)(sidx + 16 * 128);
    const int tid = F.tid, lane = F.lane, wave = F.wave;
    for (int tile = F.bid; tile < T / 16; tile += F.G) {
        const size_t tok0 = (size_t)tile * 16;
#pragma unroll 1
        for (int h = 0; h < PEER_H; ++h) {
            __syncthreads();
            for (int i = tid; i < 16 * 256; i += NTHR) sq[i] = bf2f(Q[(tok0 + (i >> 8)) * PEER_Q + h * 256 + (i & 255)]);
            __syncthreads();
            {
                const int c = tid >> 8, k = (tid >> 1) & 127, th = tid & 1;
                const bf16* kp = SK + ((size_t)(h * 2 + c) * 128 + k) * 128;
                float a[8];
#pragma unroll
                for (int j = 0; j < 8; ++j) a[j] = 0.f;
#pragma unroll 2
                for (int d8 = 0; d8 < 16; ++d8) { const u32x4 kk = *(const u32x4*)(kp + 8 * d8);
                    const float k0 = bflo(kk.x), k1 = bfhi(kk.x), k2 = bflo(kk.y), k3 = bfhi(kk.y), k4 = bflo(kk.z), k5 = bfhi(kk.z), k6 = bflo(kk.w), k7 = bfhi(kk.w);
#pragma unroll
                    for (int j = 0; j < 8; ++j) { const LAS float* qq = sq + (th * 8 + j) * 256 + c * 128 + 8 * d8; const f32x4 qa = *(const LAS f32x4*)qq, qb = *(const LAS f32x4*)(qq + 4);
                        a[j] += (qa.x * k0 + qa.y * k1) + (qa.z * k2 + qa.w * k3) + (qb.x * k4 + qb.y * k5) + (qb.z * k6 + qb.w * k7); } }
#pragma unroll
                for (int j = 0; j < 8; ++j) ssc[((th * 8 + j) * 2 + c) * 128 + k] = a[j];
            }
            __syncthreads();
#pragma unroll 1
            for (int li = 0; li < 4; ++li) {
                const int list = wave * 4 + li;
                float v0 = ssc[list * 128 + lane], v1 = ssc[list * 128 + 64 + lane];
#pragma unroll 1
                for (int rnk = 0; rnk < 16; ++rnk) {
                    float bv = fmaxf(v0, v1); int bi = (v0 >= v1) ? lane : lane + 64;
#pragma unroll
                    for (int o = 1; o < 64; o <<= 1) { const float ov = __shfl_xor(bv, o); const int oi = __shfl_xor(bi, o); if (ov > bv || (ov == bv && oi < bi)) { bv = ov; bi = oi; } }
                    if (bi == lane) v0 = -3.0e38f; if (bi == lane + 64) v1 = -3.0e38f;
                    if (lane == 0) { stv[list * 16 + rnk] = bv; sti[list * 16 + rnk] = bi; }
                }
            }
            __syncthreads();
#pragma unroll 1
            for (int li = 0; li < 2; ++li) {
                const int tk = wave * 2 + li;
                float cv[4]; int ci[4];
#pragma unroll
                for (int j = 0; j < 4; ++j) { const int id = lane + 64 * j, a = id >> 4, b = id & 15; cv[j] = stv[(tk * 2 + 0) * 16 + a] + stv[(tk * 2 + 1) * 16 + b]; ci[j] = id; }
                float myv = 0.f; int myi = 0;
#pragma unroll 1
                for (int rnk = 0; rnk < 16; ++rnk) {
                    float bv = cv[0]; int bi = ci[0];
#pragma unroll
                    for (int j = 1; j < 4; ++j) if (cv[j] > bv) { bv = cv[j]; bi = ci[j]; }
#pragma unroll
                    for (int o = 1; o < 64; o <<= 1) { const float ov = __shfl_xor(bv, o); const int oi = __shfl_xor(bi, o); if (ov > bv || (ov == bv && oi < bi)) { bv = ov; bi = oi; } }
#pragma unroll
                    for (int j = 0; j < 4; ++j) if (ci[j] == bi) cv[j] = -3.0e38f;
                    if (lane == rnk) { myv = bv; myi = bi; }
                }
                const float mx = __shfl(myv, 0);
                const float e = (lane < 16) ? __expf(myv - mx) : 0.f;
                const float den = wave_sum(e);
                if (lane < 16) { const int a = myi >> 4, b = myi & 15;
                    sidx[tk * 128 + h * 16 + lane] = sti[(tk * 2 + 0) * 16 + a] * 128 + sti[(tk * 2 + 1) * 16 + b];
                    sgate[tk * 128 + h * 16 + lane] = e / den; }
            }
        }
        __syncthreads();
#pragma unroll 1
        for (int li = 0; li < 2; ++li) {
            const int tk = wave * 2 + li; const size_t tok = tok0 + tk;
            float hv[16], oacc[16];
            { const u32x4 a = *(const u32x4*)(HN + tok * DM + 8 * lane), b = *(const u32x4*)(HN + tok * DM + 512 + 8 * lane);
              hv[0] = bflo(a.x); hv[1] = bfhi(a.x); hv[2] = bflo(a.y); hv[3] = bfhi(a.y); hv[4] = bflo(a.z); hv[5] = bfhi(a.z); hv[6] = bflo(a.w); hv[7] = bfhi(a.w);
              hv[8] = bflo(b.x); hv[9] = bfhi(b.x); hv[10] = bflo(b.y); hv[11] = bfhi(b.y); hv[12] = bflo(b.z); hv[13] = bfhi(b.z); hv[14] = bflo(b.w); hv[15] = bfhi(b.w); }
#pragma unroll
            for (int j = 0; j < 16; ++j) oacc[j] = 0.f;
#pragma unroll 1
            for (int e0 = 0; e0 < 128; e0 += 4) {
                u32x4 da[4], db[4], ua[4], ub[4]; float gt[4];
#pragma unroll
                for (int j = 0; j < 4; ++j) { const int id = sidx[tk * 128 + e0 + j]; gt[j] = sgate[tk * 128 + e0 + j];
                    const bf16* dp = PD + (size_t)id * DM + 8 * lane; const bf16* up = PU + (size_t)id * DM + 8 * lane;
                    da[j] = *(const u32x4*)dp; db[j] = *(const u32x4*)(dp + 512); ua[j] = *(const u32x4*)up; ub[j] = *(const u32x4*)(up + 512); }
#pragma unroll
                for (int j = 0; j < 4; ++j) {
                    float d = (hv[0] * bflo(da[j].x) + hv[1] * bfhi(da[j].x)) + (hv[2] * bflo(da[j].y) + hv[3] * bfhi(da[j].y)) + (hv[4] * bflo(da[j].z) + hv[5] * bfhi(da[j].z)) + (hv[6] * bflo(da[j].w) + hv[7] * bfhi(da[j].w))
                            + (hv[8] * bflo(db[j].x) + hv[9] * bfhi(db[j].x)) + (hv[10] * bflo(db[j].y) + hv[11] * bfhi(db[j].y)) + (hv[12] * bflo(db[j].z) + hv[13] * bfhi(db[j].z)) + (hv[14] * bflo(db[j].w) + hv[15] * bfhi(db[j].w));
                    d = wave_sum(d);
                    const float cf = gt[j] * gelu_erf(d);
                    oacc[0] += cf * bflo(ua[j].x); oacc[1] += cf * bfhi(ua[j].x); oacc[2] += cf * bflo(ua[j].y); oacc[3] += cf * bfhi(ua[j].y);
                    oacc[4] += cf * bflo(ua[j].z); oacc[5] += cf * bfhi(ua[j].z); oacc[6] += cf * bflo(ua[j].w); oacc[7] += cf * bfhi(ua[j].w);
                    oacc[8] += cf * bflo(ub[j].x); oacc[9] += cf * bfhi(ub[j].x); oacc[10] += cf * bflo(ub[j].y); oacc[11] += cf * bfhi(ub[j].y);
                    oacc[12] += cf * bflo(ub[j].z); oacc[13] += cf * bfhi(ub[j].z); oacc[14] += cf * bflo(ub[j].w); oacc[15] += cf * bfhi(ub[j].w);
                }
            }
            float* op = F.out + tok * DM + 8 * lane;
            f32x4 r0 = *(const f32x4*)op, r1 = *(const f32x4*)(op + 4), r2 = *(const f32x4*)(op + 512), r3 = *(const f32x4*)(op + 516);
            r0.x += oacc[0]; r0.y += oacc[1]; r0.z += oacc[2]; r0.w += oacc[3]; r1.x += oacc[4]; r1.y += oacc[5]; r1.z += oacc[6]; r1.w += oacc[7];
            r2.x += oacc[8]; r2.y += oacc[9]; r2.z += oacc[10]; r2.w += oacc[11]; r3.x += oacc[12]; r3.y += oacc[13]; r3.z += oacc[14]; r3.w += oacc[15];
            *(f32x4*)op = r0; *(f32x4*)(op + 4) = r1; *(f32x4*)(op + 512) = r2; *(f32x4*)(op + 516) = r3;
        }
    }
}

__device__ __forceinline__ unsigned f2ord(float f) { const unsigned u = __builtin_bit_cast(unsigned, f); return u ^ ((unsigned)((int)u >> 31) | 0x80000000u); }
__device__ __forceinline__ float ord2f(unsigned k) { const unsigned m = (unsigned)((int)k >> 31); return __builtin_bit_cast(float, k ^ (0x80000000u | ~m)); }
#define CMPX(a, b) do { const unsigned _mx = max((a), (b)), _mn = min((a), (b)); (a) = _mx; (b) = _mn; } while (0)
__device__ __forceinline__ void bitonic_sort16_desc(unsigned (&v)[16]) {
#pragma unroll
    for (int k = 2; k <= 16; k <<= 1)
#pragma unroll
        for (int j = k >> 1; j > 0; j >>= 1)
#pragma unroll
            for (int i = 0; i < 16; ++i) { const int l = i ^ j; if (l > i) { if ((i & k) == 0) CMPX(v[i], v[l]); else CMPX(v[l], v[i]); } }
}
__device__ __forceinline__ void bitonic_merge16_desc(unsigned (&v)[16]) {
#pragma unroll
    for (int j = 8; j > 0; j >>= 1)
#pragma unroll
        for (int i = 0; i < 16; ++i) { const int l = i ^ j; if (l > i) CMPX(v[i], v[l]); }
}
__device__ __forceinline__ void top16_merge(unsigned (&a)[16], const unsigned (&b)[16]) {
#pragma unroll
    for (int i = 0; i < 16; ++i) a[i] = max(a[i], b[15 - i]);
    bitonic_merge16_desc(a);
}
constexpr int PK_ST = 272;
__device__ __forceinline__ void peer_topk_tile(Frame& F, size_t tok0, int* IDX, float* GATE) {
    const bf16* Q = (const bf16*)(F.ws + WS_BIG);
    const bf16* SK = (const bf16*)(F.ws + WS_SUBK);
    LAS unsigned char* sK = F.lds;
    int tid = F.tid; asm volatile("" : "+v"(tid));
    const int lane = tid & 63, wave = F.wave, ql = lane & 31, hh = lane >> 5;
    const size_t tok = tok0 + wave * 32 + ql;
    const bf16* qrow = Q + tok * PEER_Q + 8 * hh;
    __syncthreads();
#pragma unroll
    for (int j = 0; j < 4; ++j) { const int cidx = tid + 512 * j, row = cidx >> 4, ch = cidx & 15; *(LAS u32x4*)(sK + row * PK_ST + ch * 16) = *(const u32x4*)(SK + (size_t)row * 128 + ch * 8); }
    __syncthreads();
    unsigned k1[16];
#pragma unroll 1
    for (int hc = 0; hc < 16; ++hc) {
        LAS unsigned char* cur = sK + (hc & 1) * (128 * PK_ST); LAS unsigned char* nxt = sK + ((hc + 1) & 1) * (128 * PK_ST);
        u32x4 stg[4];
        const int hcn = (hc + 1) & 15;
#pragma unroll
        for (int j = 0; j < 4; ++j) { const int cidx = tid + 512 * j, row = cidx >> 4, ch = cidx & 15; stg[j] = *(const u32x4*)(SK + ((size_t)hcn * 128 + row) * 128 + ch * 8); }
        bf16x8 qf[8];
#pragma unroll
        for (int ks = 0; ks < 8; ++ks) qf[ks] = *(const bf16x8*)(qrow + hc * 128 + 16 * ks);
        unsigned pk[4][16];
#pragma unroll
        for (int mt = 0; mt < 4; ++mt) {
            f32x16 acc;
#pragma unroll
            for (int e = 0; e < 16; ++e) acc[e] = 0.f;
#pragma unroll
            for (int ks = 0; ks < 8; ++ks) { const bf16x8 kf = *(const LAS bf16x8*)(cur + (32 * mt + ql) * PK_ST + 32 * ks + 16 * hh); acc = MFMA32(kf, qf[ks], acc); }
#pragma unroll
            for (int e = 0; e < 16; ++e) pk[mt][e] = (f2ord(acc[e]) & 0xFFFFFF80u) | (unsigned)(32 * mt + (e & 3) + 8 * (e >> 2) + 4 * hh);
        }
#pragma unroll
        for (int j = 0; j < 4; ++j) { const int cidx = tid + 512 * j, row = cidx >> 4, ch = cidx & 15; *(LAS u32x4*)(nxt + row * PK_ST + ch * 16) = stg[j]; }
        __syncthreads();
#pragma unroll
        for (int mt = 0; mt < 4; ++mt) bitonic_sort16_desc(pk[mt]);
        top16_merge(pk[0], pk[1]); top16_merge(pk[2], pk[3]); top16_merge(pk[0], pk[2]);
        unsigned other[16];
#pragma unroll
        for (int i = 0; i < 16; ++i) other[i] = (unsigned)__shfl_xor((int)pk[0][i], 32);
        top16_merge(pk[0], other);
        if ((hc & 1) == 0) {
#pragma unroll
            for (int i = 0; i < 16; ++i) k1[i] = pk[0][i];
        } else {
            float f1[16], f2[16];
#pragma unroll
            for (int i = 0; i < 16; ++i) { f1[i] = ord2f(k1[i] & 0xFFFFFF80u); f2[i] = ord2f(pk[0][i] & 0xFFFFFF80u); }
            unsigned cd[4][16];
#pragma unroll
            for (int i = 0; i < 64; ++i) cd[i >> 4][i & 15] = 0u;
            int n = 0;
#pragma unroll
            for (int a = 0; a < 16; ++a)
#pragma unroll
                for (int b = 0; b < 16; ++b)
                    if ((a + 1) * (b + 1) <= 16) { cd[n >> 4][n & 15] = (f2ord(f1[a] + f2[b]) & 0xFFFFC000u) | ((k1[a] & 127u) << 7) | (pk[0][b] & 127u); ++n; }
#pragma unroll
            for (int g4 = 0; g4 < 4; ++g4) bitonic_sort16_desc(cd[g4]);
            top16_merge(cd[0], cd[1]); top16_merge(cd[2], cd[3]); top16_merge(cd[0], cd[2]);
            const float vmax = ord2f(cd[0][0] & 0xFFFFC000u);
            float ex[16], den = 0.f;
#pragma unroll
            for (int i = 0; i < 16; ++i) { ex[i] = __expf(ord2f(cd[0][i] & 0xFFFFC000u) - vmax); den += ex[i]; }
            const float iden = 1.0f / den;
            const int h = hc >> 1;
            if (hh == 0) { int* ip = IDX + tok * 128 + h * 16;
#pragma unroll
                for (int i = 0; i < 4; ++i) { const u32x4 w = {cd[0][4 * i] & 0x3FFFu, cd[0][4 * i + 1] & 0x3FFFu, cd[0][4 * i + 2] & 0x3FFFu, cd[0][4 * i + 3] & 0x3FFFu}; *(u32x4*)(ip + 4 * i) = w; } }
            else { float* gp = GATE + tok * 128 + h * 16;
#pragma unroll
                for (int i = 0; i < 4; ++i) { const f32x4 w = {ex[4 * i] * iden, ex[4 * i + 1] * iden, ex[4 * i + 2] * iden, ex[4 * i + 3] * iden}; *(f32x4*)(gp + 4 * i) = w; } }
        }
    }
}

typedef short bf2s __attribute__((ext_vector_type(2)));
__device__ __forceinline__ float dot2bf(unsigned a, unsigned b, float c) { return __builtin_amdgcn_fdot2_f32_bf16(__builtin_bit_cast(bf2s, a), __builtin_bit_cast(bf2s, b), c, false); }
__device__ __forceinline__ void peer_load8(u32x4 (&buf)[16], const bf16* tab, int idv, int li0, int lane) {
#pragma unroll
    for (int j = 0; j < 8; ++j) { const int id = __builtin_amdgcn_readlane(idv, li0 + j); const bf16* rp = tab + (size_t)id * DM + 8 * lane;
        buf[2 * j] = *(const u32x4*)rp; buf[2 * j + 1] = *(const u32x4*)(rp + 512); }
}
__device__ __forceinline__ void peer_gather_wave(Frame& F, size_t tokw, const int* IDX, const float* GATE) {
    const bf16* PD = (const bf16*)(F.ws + WS_PD); const bf16* PU = (const bf16*)(F.ws + WS_PU);
    const bf16* HN = (const bf16*)(F.ws + WS_ACT1);
    int lane = F.lane; asm volatile("" : "+v"(lane));
    const int myexp = ((lane >> 5) & 1) * 8 + ((lane >> 4) & 1) * 4 + ((lane >> 3) & 1) * 2 + ((lane >> 2) & 1);
    u32x4 bufA[16], bufB[16];
    int id0 = IDX[tokw * 128 + lane], id1 = IDX[tokw * 128 + 64 + lane];
    peer_load8(bufA, PD, id0, 0, lane);
#pragma unroll 1
    for (int t = 0; t < 32; ++t) {
        const size_t tok = tokw + t, tokn = tokw + (t < 31 ? t + 1 : t);
        const int idn0 = IDX[tokn * 128 + lane], idn1 = IDX[tokn * 128 + 64 + lane];
        const float g0 = GATE[tok * 128 + lane], g1 = GATE[tok * 128 + 64 + lane];
        const u32x4 ha = *(const u32x4*)(HN + tok * DM + 8 * lane), hb = *(const u32x4*)(HN + tok * DM + 512 + 8 * lane);
        float out[16];
#pragma unroll
        for (int j = 0; j < 16; ++j) out[j] = 0.f;
#pragma unroll 1
        for (int head = 0; head < 8; ++head) {
            const int idv = head < 4 ? id0 : id1; const float gv = head < 4 ? g0 : g1; const int lb = (head & 3) * 16;
            float da[16];
#define PEER_DOWN(buf, e0) _Pragma("unroll") for (int j = 0; j < 8; ++j) { const u32x4 ra = buf[2 * j], rb = buf[2 * j + 1]; float d = dot2bf(ha.x, ra.x, 0.f); d = dot2bf(ha.y, ra.y, d); d = dot2bf(ha.z, ra.z, d); d = dot2bf(ha.w, ra.w, d); \
                d = dot2bf(hb.x, rb.x, d); d = dot2bf(hb.y, rb.y, d); d = dot2bf(hb.z, rb.z, d); d = dot2bf(hb.w, rb.w, d); da[(e0) + j] = d; }
            peer_load8(bufB, PD, idv, lb + 8, lane);
            PEER_DOWN(bufA, 0)
            peer_load8(bufA, PU, idv, lb, lane);
            PEER_DOWN(bufB, 8)
            float r8[8], r4[4], r2[2], r1;
            { const bool up = (lane & 32) != 0;
#pragma unroll
              for (int k = 0; k < 8; ++k) { const float keep = up ? da[k + 8] : da[k], send = up ? da[k] : da[k + 8]; r8[k] = keep + __shfl_xor(send, 32); } }
            { const bool up = (lane & 16) != 0;
#pragma unroll
              for (int k = 0; k < 4; ++k) { const float keep = up ? r8[k + 4] : r8[k], send = up ? r8[k] : r8[k + 4]; r4[k] = keep + __shfl_xor(send, 16); } }
            { const bool up = (lane & 8) != 0;
#pragma unroll
              for (int k = 0; k < 2; ++k) { const float keep = up ? r4[k + 2] : r4[k], send = up ? r4[k] : r4[k + 2]; r2[k] = keep + __shfl_xor(send, 8); } }
            { const bool up = (lane & 4) != 0; const float keep = up ? r2[1] : r2[0], send = up ? r2[0] : r2[1]; r1 = keep + __shfl_xor(send, 4); }
            r1 += __shfl_xor(r1, 2); r1 += __shfl_xor(r1, 1);
            const float gate = __shfl(gv, lb + myexp);
            const float coef = gate * gelu_erf(r1);
#define PEER_LANE_OF(e) ((((e) >> 3) & 1) * 32 + (((e) >> 2) & 1) * 16 + (((e) >> 1) & 1) * 8 + ((e) & 1) * 4)
#define PEER_UP(buf, e0) _Pragma("unroll") for (int j = 0; j < 8; j += 2) { \
                const float c0 = __builtin_bit_cast(float, __builtin_amdgcn_readlane(__builtin_bit_cast(int, coef), PEER_LANE_OF((e0) + j))), c1 = __builtin_bit_cast(float, __builtin_amdgcn_readlane(__builtin_bit_cast(int, coef), PEER_LANE_OF((e0) + j + 1))); const unsigned cp = pkbf(c0, c1); \
                const u32x4 a0 = buf[2 * j], b0 = buf[2 * j + 1], a1 = buf[2 * j + 2], b1 = buf[2 * j + 3]; \
                out[0] = dot2bf(__builtin_amdgcn_perm(a1.x, a0.x, 0x05040100u), cp, out[0]); out[1] = dot2bf(__builtin_amdgcn_perm(a1.x, a0.x, 0x07060302u), cp, out[1]); \
                out[2] = dot2bf(__builtin_amdgcn_perm(a1.y, a0.y, 0x05040100u), cp, out[2]); out[3] = dot2bf(__builtin_amdgcn_perm(a1.y, a0.y, 0x07060302u), cp, out[3]); \
                out[4] = dot2bf(__builtin_amdgcn_perm(a1.z, a0.z, 0x05040100u), cp, out[4]); out[5] = dot2bf(__builtin_amdgcn_perm(a1.z, a0.z, 0x07060302u), cp, out[5]); \
                out[6] = dot2bf(__builtin_amdgcn_perm(a1.w, a0.w, 0x05040100u), cp, out[6]); out[7] = dot2bf(__builtin_amdgcn_perm(a1.w, a0.w, 0x07060302u), cp, out[7]); \
                out[8] = dot2bf(__builtin_amdgcn_perm(b1.x, b0.x, 0x05040100u), cp, out[8]); out[9] = dot2bf(__builtin_amdgcn_perm(b1.x, b0.x, 0x07060302u), cp, out[9]); \
                out[10] = dot2bf(__builtin_amdgcn_perm(b1.y, b0.y, 0x05040100u), cp, out[10]); out[11] = dot2bf(__builtin_amdgcn_perm(b1.y, b0.y, 0x07060302u), cp, out[11]); \
                out[12] = dot2bf(__builtin_amdgcn_perm(b1.z, b0.z, 0x05040100u), cp, out[12]); out[13] = dot2bf(__builtin_amdgcn_perm(b1.z, b0.z, 0x07060302u), cp, out[13]); \
                out[14] = dot2bf(__builtin_amdgcn_perm(b1.w, b0.w, 0x05040100u), cp, out[14]); out[15] = dot2bf(__builtin_amdgcn_perm(b1.w, b0.w, 0x07060302u), cp, out[15]); }
            peer_load8(bufB, PU, idv, lb + 8, lane);
            PEER_UP(bufA, 0)
            { const int idnx = head < 3 ? id0 : (head < 7 ? id1 : idn0); const int lbn = ((head + 1) & 3) * 16; peer_load8(bufA, PD, idnx, lbn, lane); }
            PEER_UP(bufB, 8)
        }
        float* op = F.out + tok * DM + 8 * lane;
        f32x4 r0 = *(const f32x4*)op, r1v = *(const f32x4*)(op + 4), r2v = *(const f32x4*)(op + 512), r3 = *(const f32x4*)(op + 516);
        r0.x += out[0]; r0.y += out[1]; r0.z += out[2]; r0.w += out[3]; r1v.x += out[4]; r1v.y += out[5]; r1v.z += out[6]; r1v.w += out[7];
        r2v.x += out[8]; r2v.y += out[9]; r2v.z += out[10]; r2v.w += out[11]; r3.x += out[12]; r3.y += out[13]; r3.z += out[14]; r3.w += out[15];
        *(f32x4*)op = r0; *(f32x4*)(op + 4) = r1v; *(f32x4*)(op + 512) = r2v; *(f32x4*)(op + 516) = r3;
        id0 = idn0; id1 = idn1;
    }
#undef PEER_DOWN
#undef PEER_UP
#undef PEER_LANE_OF
}
__device__ __forceinline__ void peer_phase(Frame& F) {
    int* IDX = (int*)(F.ws + WS_BIG + 256 * MiB); float* GATE = (float*)(F.ws + WS_BIG + 288 * MiB);
    for (int tile = F.bid; tile < T / 256; tile += F.G) {
        const size_t tok0 = (size_t)tile * 256;
        peer_topk_tile(F, tok0, IDX, GATE);
        VM_WAIT(); __syncthreads();
        peer_gather_wave(F, tok0 + F.wave * 32, IDX, GATE);
    }
}

constexpr int N_PHASES = 15;
__global__ void __launch_bounds__(NTHR, 2) mega_fwd(Args args) {
    extern __shared__ __attribute__((aligned(16))) unsigned char lds_raw[];
    Frame F;
    F.lds = (LAS unsigned char*)lds_raw;
    F.tid = threadIdx.x; F.lane = F.tid & 63; F.wave = __builtin_amdgcn_readfirstlane(F.tid >> 6);
    F.G = gridDim.x; F.bid = blockIdx.x;
#pragma unroll
    for (int i = 0; i < 26; ++i) F.in[i] = args.in[i];
    F.positions = args.positions; F.out = args.out; F.ws = args.ws;
    unsigned char* ws = args.ws;
    volatile LAS unsigned* ctlw = (volatile LAS unsigned*)(F.lds + LDSCTL_OFF);
    if (F.tid < 64) ctlw[F.tid] = 0u;
    __syncthreads();
    const int lo = args.ph_lo, hi = args.ph_hi;
    XcdBarrier bar; bar.bar = (unsigned*)(ws + WS_CTL); bar.x = 0; bar.st = nullptr;
    if (hi - lo > 1) bar = xcd_barrier_post((unsigned*)(ws + WS_CTL), ctlw + 8);
#define IN(k) (lo <= (k) && (k) < hi)
#define SEAM(k) do { if (IN(k) && IN((k) + 1)) xcd_barrier(bar); } while (0)
    bf16* ACT1 = (bf16*)(ws + WS_ACT1); bf16* BIG = (bf16*)(ws + WS_BIG); bf16* WallT = (bf16*)(ws + WS_WALLT);

    if (IN(0)) { p0_prologue(F); __syncthreads(); }
    SEAM(0);
    if (IN(1)) {
        { pg8::Gemm g{(const bf16*)(ws + WS_MEMN), (const bf16*)(ws + WS_WMKVT), NB * NMEM, 768, DM, DM, DM}; pg8::StaticOrder S; S.init(g.M, g.N, F.G, F.bid);
          pg8::EpiBf16<0> E{(bf16*)(ws + WS_MKV), 1536}; pg8::gemm_phase(F.lds, g, S, E); }
        { pg8::Gemm g{(const bf16*)(ws + WS_WMKVT) + (size_t)768 * DM, (const bf16*)(ws + WS_MEMN), 768, NB * NMEM, DM, DM, DM}; pg8::StaticOrder S; S.init(g.M, g.N, F.G, F.G - 1 - F.bid);
          pg8::EpiBf16<0> E{(bf16*)(ws + WS_MVT), NB * NMEM}; pg8::gemm_phase(F.lds, g, S, E); }
        { pg8::Gemm g{ACT1, WallT, HT, NPROJ, DM, DM, DM}; pg8::StaticOrder S; S.init(g.M, g.N, F.G, F.bid);
          pg8::EpiBf16<0> E{BIG, NPROJ}; pg8::gemm_phase(F.lds, g, S, E); }
    }
    SEAM(1);
    if (IN(2)) { qkprep_phase(F, 0); ssdC_phase(F, 0); }
    SEAM(2);
    if (IN(3)) { ssdD_phase(F); dilattn_mfma_phase(F, 0); memattn_mfma_phase(F, 0); }
    SEAM(3);
    if (IN(4)) { ssdE_phase(F, 0); dilmerge_phase(F, 0); }
    SEAM(4);
    if (IN(5)) { pg8::Gemm g{ACT1 + (size_t)HT * DM, WallT, HT, NPROJ, DM, DM, DM}; pg8::StaticOrder S; S.init(g.M, g.N, F.G, F.bid);
        pg8::EpiBf16<0> E{BIG, NPROJ}; pg8::gemm_phase(F.lds, g, S, E); }
    SEAM(5);
    if (IN(6)) { qkprep_phase(F, 1); ssdC_phase(F, 1); }
    SEAM(6);
    if (IN(7)) { ssdD_phase(F); dilattn_mfma_phase(F, 1); memattn_mfma_phase(F, 1); }
    SEAM(7);
    if (IN(8)) { ssdE_phase(F, 1); dilmerge_phase(F, 1); }
    SEAM(8);
    if (IN(9)) { pg8::Gemm g{ACT1, WallT + (size_t)NPROJ * DM, T, NGATE, DM, DM, DM}; pg8::StaticOrder S; S.init(g.M, g.N, F.G, F.bid);
        pg8::EpiBf16<1> E{BIG, NGATE}; pg8::gemm_phase(F.lds, g, S, E); }
    SEAM(9);
    if (IN(10)) {
        const bf16* Yc = (const bf16*)F.out; const bf16* Wc = (const bf16*)(ws + WS_WCATT);
        { pg8::Gemm g{Yc, Wc, T, DM, 1024, YC, YC}; pg8::StaticOrder S; S.init(g.M, g.N, F.G, F.bid); pg8::EpiBranch<false> E{ACT1, DM, BIG, NGATE, 0}; pg8::gemm_phase(F.lds, g, S, E); }
        { pg8::Gemm g{Yc + 1024, Wc + 1024, T, DM, 256, YC, YC}; pg8::StaticOrder S; S.init(g.M, g.N, F.G, F.bid); pg8::EpiBranch<true> E{ACT1, DM, BIG, NGATE, 1024}; pg8::gemm_phase(F.lds, g, S, E); }
        { pg8::Gemm g{Yc + 1280, Wc + 1280, T, DM, 768, YC, YC}; pg8::StaticOrder S; S.init(g.M, g.N, F.G, F.bid); pg8::EpiBranch<true> E{ACT1, DM, BIG, NGATE, 2048}; pg8::gemm_phase(F.lds, g, S, E); }
    }
    SEAM(10);
    if (IN(11)) { pg8::Gemm g{ACT1, (const bf16*)(ws + WS_WOUTT), T, DM, DM, DM, DM}; pg8::StaticOrder S; S.init(g.M, g.N, F.G, F.bid);
        pg8::EpiResid E{F.out, DM, F.in[I_X]}; pg8::gemm_phase(F.lds, g, S, E); }
    SEAM(11);
    if (IN(12)) hn_phase(F);
    SEAM(12);
    if (IN(13)) { pg8::Gemm g{ACT1, (const bf16*)(ws + WS_WQT), T, PEER_Q, DM, DM, DM}; pg8::StaticOrder S; S.init(g.M, g.N, F.G, F.bid);
        pg8::EpiBf16<0> E{BIG, PEER_Q}; pg8::gemm_phase(F.lds, g, S, E); }
    SEAM(13);
    if (IN(14)) peer_phase(F);
#undef IN
#undef SEAM
}

extern "C" void kernel_launch(void* const* d_in, const int* in_sizes, int n_in, void* d_out, int out_size, void* d_ws, size_t ws_size, hipStream_t stream) {
    static int grid = 0;
    if (grid == 0) {
        if (n_in != 26 || out_size != T * DM || ws_size < WS_END) { fprintf(stderr, "kernel_launch: unexpected shapes (n_in %d, out %d, ws %zu)\n", n_in, out_size, ws_size); grid = -1; return; }
        int dev = 0, cus = 0;
        if (hipGetDevice(&dev) != hipSuccess || hipDeviceGetAttribute(&cus, hipDeviceAttributeMultiprocessorCount, dev) != hipSuccess) { grid = -1; return; }
        if (hipFuncSetAttribute((const void*)mega_fwd, hipFuncAttributeMaxDynamicSharedMemorySize, LDS_BYTES) != hipSuccess) { grid = -1; return; }
        int per_cu = 0;
        (void)hipOccupancyMaxActiveBlocksPerMultiprocessor(&per_cu, (const void*)mega_fwd, NTHR, LDS_BYTES);
        (void)hipGetLastError();
        grid = cus;
    }
    if (grid < 0) return;
    (void)hipMemsetAsync((char*)d_ws + WS_CTL, 0, CTL_ZERO_BYTES, stream);
    Args a{};
    for (int i = 0; i < 26; ++i) a.in[i] = (const float*)d_in[i];
    a.positions = (const int*)d_in[2]; a.out = (float*)d_out; a.ws = (unsigned char*)d_ws;
#if MK_N_LAUNCHES == 1
    a.ph_lo = 0; a.ph_hi = N_PHASES;
    hipLaunchKernelGGL(mega_fwd, dim3(grid), dim3(NTHR), LDS_BYTES, stream, a);
#else
    for (int p = 0; p < N_PHASES; ++p) { a.ph_lo = p; a.ph_hi = p + 1; hipLaunchKernelGGL(mega_fwd, dim3(grid), dim3(NTHR), LDS_BYTES, stream, a); }
#endif
}
```

```cpp
#include <hip/hip_runtime.h>
#include <cstdio>
#include <cstdint>

#ifndef MK_N_LAUNCHES
#define MK_N_LAUNCHES 1
#endif

#define LAS __attribute__((address_space(3)))
#define GAS __attribute__((address_space(1)))
typedef unsigned short bf16;
typedef short bf16x8 __attribute__((ext_vector_type(8)));
typedef float f32x4 __attribute__((ext_vector_type(4)));
typedef float f32x2 __attribute__((ext_vector_type(2)));
typedef unsigned u32x4 __attribute__((ext_vector_type(4)));
typedef unsigned u32x2 __attribute__((ext_vector_type(2)));

constexpr int NB = 8, SEQ = 8192, DM = 1024, T = NB * SEQ;
constexpr int HB = 4, HT = HB * SEQ;
constexpr int NMEM = 256;
constexpr int NPROJ = 6144;
constexpr int PC_Z = 0, PC_X = 1024, PC_B = 2048, PC_C = 2560, PC_DQ = 3072, PC_DK = 3840, PC_DV = 4608, PC_MQ = 5376;
constexpr int W_IN_N = 9232, OFF_DT = 3072, OFF_AFTER_DT = 3088;
constexpr int NGATE = 3072;
constexpr int YC = 2048;
constexpr int PEER_H = 8, PEER_K = 16, PEER_NK = 128, PEER_Q = 2048;
constexpr float EPS = 1e-6f;

constexpr size_t MiB = 1u << 20;
constexpr size_t WS_CTL = 0, CTL_ZERO_BYTES = 65536;
constexpr size_t WS_WALLT = 1 * MiB;
constexpr size_t WS_WMKVT = 19 * MiB;
constexpr size_t WS_WCATT = 22 * MiB;
constexpr size_t WS_WOUTT = 26 * MiB;
constexpr size_t WS_WQT = 28 * MiB;
constexpr size_t WS_SUBK = 32 * MiB;
constexpr size_t WS_PD = 33 * MiB;
constexpr size_t WS_PU = 65 * MiB;
constexpr size_t WS_DT = 97 * MiB;
constexpr size_t WS_MEMN = 101 * MiB;
constexpr size_t WS_MKV = 105 * MiB;
constexpr size_t WS_ACT1 = 112 * MiB;
constexpr size_t WS_BIG = 240 * MiB;
constexpr size_t WS_LSE = 624 * MiB;
constexpr size_t WS_MVT = 628 * MiB;
constexpr size_t WS_DEC = 631 * MiB;
constexpr size_t WS_SST = 632 * MiB;
constexpr size_t WS_SIN = 760 * MiB;
constexpr size_t WS_END = 824 * MiB;

constexpr int RING_BYTES = 131072;
constexpr int LDSCTL_OFF = 143360;
constexpr int LDS_BYTES = 147456;
constexpr int NWAVES = 8, NTHR = 512;

__device__ __forceinline__ float bf2f(unsigned short b) { return __builtin_bit_cast(float, (unsigned)b << 16); }
__device__ __forceinline__ float bflo(unsigned w) { return __builtin_bit_cast(float, w << 16); }
__device__ __forceinline__ float bfhi(unsigned w) { return __builtin_bit_cast(float, w & 0xffff0000u); }
__device__ __forceinline__ unsigned f2bf(float f) { unsigned u = __builtin_bit_cast(unsigned, f); return (u + 0x7fffu + ((u >> 16) & 1u)) >> 16; }
__device__ __forceinline__ unsigned pk2(float lo, float hi) { return f2bf(lo) | (f2bf(hi) << 16); }
typedef float f32x16 __attribute__((ext_vector_type(16)));
typedef short s16x4 __attribute__((ext_vector_type(4)));
typedef __bf16 bf2_t __attribute__((ext_vector_type(2)));
__device__ __forceinline__ unsigned pkbf(float a, float b) { const f32x2 v = {a, b}; return __builtin_bit_cast(unsigned, __builtin_convertvector(v, bf2_t)); }
#define MFMA32(a, b, c) __builtin_amdgcn_mfma_f32_32x32x16_bf16((a), (b), (c), 0, 0, 0)
__device__ __forceinline__ float wave_sum(float v) {
#pragma unroll
    for (int o = 1; o < 64; o <<= 1) v += __shfl_xor(v, o);
    return v;
}
__device__ __forceinline__ float wave_max(float v) {
#pragma unroll
    for (int o = 1; o < 64; o <<= 1) v = fmaxf(v, __shfl_xor(v, o));
    return v;
}
__device__ __forceinline__ float sigmoidf_(float x) { return 1.0f / (1.0f + __expf(-x)); }
#define LDS_WAIT() asm volatile("s_waitcnt lgkmcnt(0)" ::: "memory")
#define VM_WAIT() asm volatile("s_waitcnt vmcnt(0)" ::: "memory")

#define XB_TMO      128
#define XB_XCNT(j)  (256  + 64 * (j))
#define XB_XSUB(j)  (1280 + 64 * (j))
#define XB_XGEN(j)  (2304 + 64 * (j))
#define XB_TOP      3328
#define XB_TOPGEN   3392
#define XCD_BAR_WORDS 3456
#define XB_SPIN_CAP (1u << 18)
__device__ __forceinline__ unsigned xb_ld(unsigned* p)              { return __hip_atomic_load(p, __ATOMIC_RELAXED, __HIP_MEMORY_SCOPE_AGENT); }
__device__ __forceinline__ unsigned xb_add(unsigned* p, unsigned v) { return __hip_atomic_fetch_add(p, v, __ATOMIC_RELAXED, __HIP_MEMORY_SCOPE_AGENT); }
__device__ __forceinline__ unsigned xb_xcc_id() { return (unsigned)__builtin_amdgcn_s_getreg((3 << 11) | 20) & 0xFu; }
#define XB_SPIN(cond, bar) do { unsigned _sp = 0; while (cond) { __builtin_amdgcn_s_sleep(1); \
    if ((++_sp & 255u) == 0u) { if (xb_ld(&(bar)[XB_TMO])) break; if (_sp > XB_SPIN_CAP) { atomicAdd(&(bar)[XB_TMO], 1u); break; } } } } while (0)
struct XcdBarrier { unsigned* bar; unsigned x; volatile LAS unsigned* st; };
__device__ __forceinline__ XcdBarrier xcd_barrier_post(unsigned* bar, volatile LAS unsigned* st) {
    XcdBarrier b; b.bar = bar; b.x = xb_xcc_id(); b.st = st;
    if (threadIdx.x == 0) (void)xb_add(&bar[XB_XCNT(b.x)], 1u);
    return b;
}
__device__ __forceinline__ void xcd_barrier_complete(unsigned* bar, unsigned x, unsigned& nloc, unsigned& nx) {
    const unsigned G = gridDim.x * gridDim.y * gridDim.z;
    unsigned sum, cnt, mine, sp = 0u;
    for (;;) {
        sum = 0u; cnt = 0u; mine = 0u;
#pragma unroll
        for (unsigned j = 0; j < 16; ++j) { const unsigned c = xb_ld(&bar[XB_XCNT(j)]); sum += c; cnt += (c > 0u) ? 1u : 0u; mine = (j == x) ? c : mine; }
        if (sum == G) break;
        __builtin_amdgcn_s_sleep(1);
        if ((++sp & 255u) == 0u) { if (xb_ld(&bar[XB_TMO])) break; if (sp > XB_SPIN_CAP) { atomicAdd(&bar[XB_TMO], 1u); break; } }
    }
    nloc = mine > 0u ? mine : 1u; nx = cnt > 0u ? cnt : 1u;
}
__device__ __forceinline__ void xcd_barrier(const XcdBarrier& b) {
    asm volatile("s_waitcnt vmcnt(0)" ::: "memory");
    __syncthreads();
    if (threadIdx.x == 0) {
        unsigned* bar = b.bar;
        __builtin_amdgcn_s_waitcnt(0);
        unsigned nloc = b.st[0], nx = b.st[1];
        if (nloc == 0u) { xcd_barrier_complete(bar, b.x, nloc, nx); b.st[0] = nloc; b.st[1] = nx; }
        const unsigned old = xb_add(&bar[XB_XSUB(b.x)], 1u);
        const unsigned gen = old / nloc;
        if (old + 1u == (gen + 1u) * nloc) {
            __builtin_amdgcn_fence(__ATOMIC_RELEASE, "agent");
            asm volatile("s_waitcnt vmcnt(0)" ::: "memory");
            const unsigned og = xb_add(&bar[XB_TOP], 1u);
            const unsigned tg = og / nx;
            if (og + 1u == (tg + 1u) * nx) xb_add(&bar[XB_TOPGEN], 1u);
            else XB_SPIN(xb_ld(&bar[XB_TOPGEN]) == tg, bar);
            __builtin_amdgcn_fence(__ATOMIC_ACQUIRE, "agent");
            xb_add(&bar[XB_XGEN(b.x)], 1u);
            asm volatile("s_waitcnt vmcnt(0)" ::: "memory");
        } else {
            XB_SPIN(xb_ld(&bar[XB_XGEN(b.x)]) == gen, bar);
            __builtin_amdgcn_fence(__ATOMIC_ACQUIRE, "agent");
            asm volatile("s_waitcnt vmcnt(0)" ::: "memory");
        }
    }
    __syncthreads();
}

namespace pg8 {
constexpr int BM = 256, BK = 64, HALF = 128, HTB = HALF * BK * 2, STAGE_BYTES = 8 * HTB, NXCD = 8, WGM = 8;
__host__ __device__ __forceinline__ int lds_byte(int r, int c) { const int st = (r >> 4) * 2 + (c >> 5), rr = r & 15, cc = c & 31, ob = rr * 64 + cc * 2; return st * 1024 + (ob ^ (((ob >> 9) & 1) << 5)); }
__host__ __device__ __forceinline__ void stage_rc(int b, int& R, int& C) { const int st = b / 1024, sb = b % 1024, swz = sb ^ (((sb >> 9) & 1) << 5); R = (st >> 1) * 16 + swz / 64; C = (st & 1) * 32 + (swz % 64) / 2; }
__host__ __device__ __forceinline__ int perm32(int rho) { const int n = rho >> 4, i = rho & 15; return 8 * (i >> 2) + 4 * n + (i & 3); }
struct Unit { int pm, pn; };
struct Gemm { const bf16* A; const bf16* Bt; int M, N, K, lda, ldb; };
struct StaticOrder {
    int nM, nN, nwg, G, c;
    __host__ __device__ void init(int M, int N, int G_, int c_) { nM = M / BM; nN = N / BM; nwg = nM * nN; G = G_; c = c_; }
    __host__ __device__ bool next(int i, Unit& u) const {
        const long L = (long)i * G + c; if (L >= nwg) return false;
        int wgid = (int)L; { const int q = nwg / NXCD, r = nwg % NXCD, xcd = wgid % NXCD, off = wgid / NXCD; wgid = (xcd < r ? xcd * (q + 1) : r * (q + 1) + (xcd - r) * q) + off; }
        const int nig = WGM * nN, gid = wgid / nig, fm = gid * WGM, gsz = (nM - fm) < WGM ? (nM - fm) : WGM;
        u.pm = fm + ((wgid % nig) % gsz); u.pn = (wgid % nig) / gsz; return true;
    }
    __device__ __forceinline__ void a_ready(const Unit&) const {}
    __device__ __forceinline__ void done(const Unit&) const {}
};
__device__ __forceinline__ unsigned cvt_pk_bf16(float lo, float hi) { unsigned r; asm volatile("v_cvt_pk_bf16_f32 %0, %1, %2" : "=v"(r) : "v"(lo), "v"(hi)); return r; }

template <int ACT> struct EpiBf16 {
    static constexpr bool PERM = true, AFTER_DRAIN = false;
    bf16* O; int ldc;
    __device__ __forceinline__ void operator()(const f32x4 (&acc)[2][2][4][2], const Unit& u, int wr, int wc, int fr, int fq) const {
        const int row0 = u.pm * BM + wr * 64 + fr; const int col0 = u.pn * BM + wc * 32 + 8 * fq;
#pragma unroll
        for (int ai = 0; ai < 2; ++ai)
#pragma unroll
            for (int m = 0; m < 4; ++m) { bf16* rowp = O + (size_t)(row0 + ai * HALF + m * 16) * ldc + col0;
#pragma unroll
                for (int bj = 0; bj < 2; ++bj) { f32x4 v0 = acc[ai][bj][m][0], v1 = acc[ai][bj][m][1];
                    if (ACT == 1) {
#pragma unroll
                        for (int j = 0; j < 4; ++j) { v0[j] = sigmoidf_(v0[j]); v1[j] = sigmoidf_(v1[j]); } }
                    u32x4 w; w.x = cvt_pk_bf16(v0[0], v0[1]); w.y = cvt_pk_bf16(v0[2], v0[3]); w.z = cvt_pk_bf16(v1[0], v1[1]); w.w = cvt_pk_bf16(v1[2], v1[3]);
                    *(u32x4*)(rowp + bj * HALF) = w; } }
    }
};
template <bool ACCUM> struct EpiBranch {
    static constexpr bool PERM = true, AFTER_DRAIN = false;
    bf16* O; int ldc; const bf16* Gt; int ldg; int gcol0;
    __device__ __forceinline__ void operator()(const f32x4 (&acc)[2][2][4][2], const Unit& u, int wr, int wc, int fr, int fq) const {
        const int row0 = u.pm * BM + wr * 64 + fr; const int col0 = u.pn * BM + wc * 32 + 8 * fq;
#pragma unroll
        for (int ai = 0; ai < 2; ++ai)
#pragma unroll
            for (int m = 0; m < 4; ++m) { const size_t r = (size_t)(row0 + ai * HALF + m * 16); bf16* rowp = O + r * ldc + col0; const bf16* gp = Gt + r * ldg + gcol0 + col0;
#pragma unroll
                for (int bj = 0; bj < 2; ++bj) { const f32x4 v0 = acc[ai][bj][m][0], v1 = acc[ai][bj][m][1];
                    const u32x4 g = *(const u32x4*)(gp + bj * HALF);
                    float o[8];
                    o[0] = v0[0] * bflo(g.x); o[1] = v0[1] * bfhi(g.x); o[2] = v0[2] * bflo(g.y); o[3] = v0[3] * bfhi(g.y);
                    o[4] = v1[0] * bflo(g.z); o[5] = v1[1] * bfhi(g.z); o[6] = v1[2] * bflo(g.w); o[7] = v1[3] * bfhi(g.w);
                    if (ACCUM) { const u32x4 p = *(const u32x4*)(rowp + bj * HALF);
                        o[0] += bflo(p.x); o[1] += bfhi(p.x); o[2] += bflo(p.y); o[3] += bfhi(p.y); o[4] += bflo(p.z); o[5] += bfhi(p.z); o[6] += bflo(p.w); o[7] += bfhi(p.w); }
                    u32x4 w; w.x = cvt_pk_bf16(o[0], o[1]); w.y = cvt_pk_bf16(o[2], o[3]); w.z = cvt_pk_bf16(o[4], o[5]); w.w = cvt_pk_bf16(o[6], o[7]);
                    *(u32x4*)(rowp + bj * HALF) = w; } }
    }
};
struct EpiResid {
    static constexpr bool PERM = false, AFTER_DRAIN = false;
    float* C; int ldc; const float* R;
    __device__ __forceinline__ void operator()(const f32x4 (&acc)[2][2][4][2], const Unit& u, int wr, int wc, int fr, int fq) const {
        const int row0 = u.pm * BM + wr * 64 + fr, col0 = u.pn * BM + wc * 32 + 4 * fq;
#pragma unroll
        for (int ai = 0; ai < 2; ++ai)
#pragma unroll
            for (int m = 0; m < 4; ++m) { const size_t off = (size_t)(row0 + ai * HALF + m * 16) * ldc + col0;
#pragma unroll
                for (int bj = 0; bj < 2; ++bj)
#pragma unroll
                    for (int n = 0; n < 2; ++n) { const f32x4 r = *(const f32x4*)(R + off + bj * HALF + n * 16); *(f32x4*)(C + off + bj * HALF + n * 16) = acc[ai][bj][m][n] + r; } }
    }
};

template <class Epi, class Sched>
__device__ __forceinline__ void gemm_phase(LAS unsigned char* lds, const Gemm g, const Sched& S, const Epi& E) {
    const int tid = threadIdx.x, wid = __builtin_amdgcn_readfirstlane(tid >> 6), lane = tid & 63, wr = wid >> 2, wc = wid & 3, fr = lane & 15, fq = lane >> 4;
    const int K = g.K, nt = K / BK;
    unsigned voffA[2], voffB[2];
#pragma unroll
    for (int i = 0; i < 2; ++i) { int R, C; stage_rc(tid * 16 + i * 8192, R, C); const int Rb = Epi::PERM ? ((R & ~31) + perm32(R & 31)) : R;
        voffA[i] = (unsigned)(R * g.lda + C) * 2u; voffB[i] = (unsigned)(Rb * g.ldb + C) * 2u; }
    const size_t kstep = (size_t)(BK * 2);
    const size_t hsA = (size_t)HALF * g.lda * 2, hsB = (size_t)HALF * g.ldb * 2;
    const size_t tsA = 2 * hsA, tsB = 2 * hsB;
    const unsigned ldsw = (unsigned)wid * 1024u;
    const int aoff = lds_byte(wr * 64 + fr, fq * 8), boff = lds_byte(wc * 32 + fr, fq * 8);
#define PG8_SA(b, h) (((b) * 2 + (h)) * HTB)
#define PG8_SB(b, h) ((4 + (b) * 2 + (h)) * HTB)
#define PG8_STAGE(bufoff, gbase, voff) do { _Pragma("unroll") for (int _i = 0; _i < 2; ++_i) \
        __builtin_amdgcn_global_load_lds((const unsigned*)((const char*)(gbase) + (voff)[_i]), (LAS unsigned*)(lds + (bufoff) + ldsw + _i * 8192), 16, 0, 0); } while (0)
#define PG8_LDA(dst, b, h) do { _Pragma("unroll") for (int m = 0; m < 4; ++m) _Pragma("unroll") for (int k = 0; k < 2; ++k) dst[m][k] = *(const LAS bf16x8*)(lds + PG8_SA(b, h) + aoff + m * 2048 + k * 1024); } while (0)
#define PG8_LDB(dst, b, h) do { _Pragma("unroll") for (int n = 0; n < 2; ++n) _Pragma("unroll") for (int k = 0; k < 2; ++k) dst[n][k] = *(const LAS bf16x8*)(lds + PG8_SB(b, h) + boff + n * 2048 + k * 1024); } while (0)
#define PG8_MMA(ai, bj, At, Bt) do { __builtin_amdgcn_s_setprio(1); _Pragma("unroll") for (int m = 0; m < 4; ++m) _Pragma("unroll") for (int n = 0; n < 2; ++n) _Pragma("unroll") for (int k = 0; k < 2; ++k) \
        acc[ai][bj][m][n] = __builtin_amdgcn_mfma_f32_16x16x32_bf16(Bt[n][k], At[m][k], acc[ai][bj][m][n], 0, 0, 0); __builtin_amdgcn_s_setprio(0); } while (0)
#define PG8_WAIT_V(n) asm volatile("s_waitcnt vmcnt(" #n ")" ::: "memory")
#define PG8_WAIT_L(n) asm volatile("s_waitcnt lgkmcnt(" #n ")" ::: "memory")
#define PG8_BAR __builtin_amdgcn_s_barrier()
#define PG8_SCHED __builtin_amdgcn_sched_barrier(0)
    Unit cur, nxt; int ui = 0;
    if (!S.next(0, cur)) return;
    f32x4 acc[2][2][4][2];
#pragma unroll
    for (int a = 0; a < 2; ++a)
#pragma unroll
        for (int b = 0; b < 2; ++b)
#pragma unroll
            for (int m = 0; m < 4; ++m)
#pragma unroll
                for (int n = 0; n < 2; ++n) acc[a][b][m][n] = (f32x4){0.f, 0.f, 0.f, 0.f};
    bf16x8 At[4][2], B0[2][2], B1[2][2];
    const char* cA = (const char*)g.A + (size_t)cur.pm * tsA; const char* cB = (const char*)g.Bt + (size_t)cur.pn * tsB;
    S.a_ready(cur);
    PG8_STAGE(PG8_SB(0, 0), cB, voffB); PG8_STAGE(PG8_SA(0, 0), cA, voffA); PG8_STAGE(PG8_SB(0, 1), cB + hsB, voffB); PG8_STAGE(PG8_SA(0, 1), cA + hsA, voffA);
    if (wr == 1) PG8_BAR;
    PG8_WAIT_V(4); PG8_BAR;
    PG8_STAGE(PG8_SB(1, 0), cB + kstep, voffB); PG8_STAGE(PG8_SA(1, 0), cA + kstep, voffA); PG8_STAGE(PG8_SB(1, 1), cB + hsB + kstep, voffB);
    PG8_WAIT_V(6); PG8_BAR;
    for (;;) {
        const bool has_next = S.next(ui + 1, nxt);
        const char* nA = has_next ? (const char*)g.A + (size_t)nxt.pm * tsA : cA; const char* nB = has_next ? (const char*)g.Bt + (size_t)nxt.pn * tsB : cB;
        for (int t = 0; t < nt; t += 2) {
            const bool last = (t == nt - 2);
            const char* a1 = cA + (size_t)(t + 1) * kstep;
            const char* a2 = last ? nA : cA + (size_t)(t + 2) * kstep; const char* b2 = last ? nB : cB + (size_t)(t + 2) * kstep;
            const char* a3 = a2 + kstep; const char* b3 = b2 + kstep;
            if (last && has_next) S.a_ready(nxt);
            PG8_LDB(B0, 0, 0); PG8_SCHED; PG8_LDA(At, 0, 0); PG8_STAGE(PG8_SA(1, 1), a1 + hsA, voffA);
            PG8_WAIT_L(8); PG8_BAR; PG8_WAIT_L(0); PG8_MMA(0, 0, At, B0); PG8_BAR; PG8_SCHED;
            PG8_LDB(B1, 0, 1); PG8_STAGE(PG8_SB(0, 0), b2, voffB);
            PG8_BAR; PG8_WAIT_L(0); PG8_MMA(0, 1, At, B1); PG8_BAR;
            PG8_LDA(At, 0, 1); PG8_STAGE(PG8_SA(0, 0), a2, voffA);
            PG8_BAR; PG8_WAIT_L(0); PG8_MMA(1, 0, At, B0); PG8_BAR; PG8_SCHED;
            PG8_STAGE(PG8_SB(0, 1), b2 + hsB, voffB);
            PG8_WAIT_V(6); PG8_BAR; PG8_MMA(1, 1, At, B1); PG8_BAR;
            PG8_LDB(B0, 1, 0); PG8_SCHED; PG8_LDA(At, 1, 0); PG8_STAGE(PG8_SA(0, 1), a2 + hsA, voffA);
            PG8_WAIT_L(8); PG8_BAR; PG8_WAIT_L(0); PG8_MMA(0, 0, At, B0); PG8_BAR; PG8_SCHED;
            PG8_LDB(B1, 1, 1); PG8_STAGE(PG8_SB(1, 0), b3, voffB);
            PG8_BAR; PG8_WAIT_L(0); PG8_MMA(0, 1, At, B1); PG8_BAR;
            PG8_LDA(At, 1, 1); PG8_STAGE(PG8_SA(1, 0), a3, voffA);
            PG8_BAR; PG8_WAIT_L(0); PG8_MMA(1, 0, At, B0); PG8_BAR; PG8_SCHED;
            PG8_STAGE(PG8_SB(1, 1), b3 + hsB, voffB);
            PG8_WAIT_V(6); PG8_BAR; PG8_MMA(1, 1, At, B1); PG8_BAR;
        }
        E(acc, cur, wr, wc, fr, fq); S.done(cur);
        if (!has_next) break;
#pragma unroll
        for (int a = 0; a < 2; ++a)
#pragma unroll
            for (int b = 0; b < 2; ++b)
#pragma unroll
                for (int m = 0; m < 4; ++m)
#pragma unroll
                    for (int n = 0; n < 2; ++n) acc[a][b][m][n] = (f32x4){0.f, 0.f, 0.f, 0.f};
        cur = nxt; cA = nA; cB = nB; ++ui;
    }
    PG8_WAIT_V(0);
    if (wr == 0) PG8_BAR;
    PG8_BAR;
#undef PG8_SA
#undef PG8_SB
#undef PG8_STAGE
#undef PG8_LDA
#undef PG8_LDB
#undef PG8_MMA
#undef PG8_WAIT_V
#undef PG8_WAIT_L
#undef PG8_BAR
#undef PG8_SCHED
}
}

struct Args {
    const float* in[26]; const int* positions; float* out; unsigned char* ws; int ph_lo, ph_hi; int pad0, pad1;
};
struct Frame {
    LAS unsigned char* lds;
    int tid, lane, wave, G, bid;
    const float* in[26]; const int* positions; float* out; unsigned char* ws;
};
enum { I_X = 0, I_MEM = 1, I_POS = 2, I_NMIXW = 3, I_WIN = 4, I_CONVW = 5, I_CONVB = 6, I_DTB = 7, I_ALOG = 8, I_SSDD = 9, I_SSDNW = 10, I_DQNW = 11, I_DKNW = 12, I_MEMNW = 13,
       I_WMKV = 14, I_MQNW = 15, I_MKNW = 16, I_WSSD = 17, I_WDIL = 18, I_WMEMBR = 19, I_WOUT = 20, I_NFFNW = 21, I_WQ = 22, I_SUBK = 23, I_PD = 24, I_PU = 25 };

__device__ __forceinline__ void p0_transpose_item(const float* W, int ldw, int src_col0, bf16* WT, int ldt, int dst_row0, int dst_col0, int nblk, LAS float* scr, int item, int lane) {
    const int kb = item / nblk, nb = item % nblk, k0 = 64 * kb, n0 = 32 * nb;
#pragma unroll 8
    for (int i = 0; i < 32; ++i) { const int kk = 2 * i + (lane >> 5); scr[kk * 33 + (lane & 31)] = W[(size_t)(k0 + kk) * ldw + src_col0 + n0 + (lane & 31)]; }
    LDS_WAIT(); asm volatile("" ::: "memory");
    const int c = lane & 7;
#pragma unroll
    for (int j = 0; j < 4; ++j) { const int n = (lane >> 3) + 8 * j; const LAS float* s = scr + (8 * c) * 33 + n;
        u32x4 o; o.x = pk2(s[0 * 33], s[1 * 33]); o.y = pk2(s[2 * 33], s[3 * 33]); o.z = pk2(s[4 * 33], s[5 * 33]); o.w = pk2(s[6 * 33], s[7 * 33]);
        *(u32x4*)(WT + (size_t)(dst_row0 + n0 + n) * ldt + dst_col0 + k0 + 8 * c) = o; }
    LDS_WAIT(); asm volatile("" ::: "memory");
}
__device__ __forceinline__ void rms_row_to_bf16(const float* xrow, const float* w, bf16* orow, int lane, f32x4 (&v)[4]) {
    const f32x4* xr = (const f32x4*)xrow + lane; const f32x4* wr = (const f32x4*)w + lane;
    float s = 0.f;
#pragma unroll
    for (int j = 0; j < 4; ++j) { v[j] = xr[64 * j]; s += (v[j].x * v[j].x + v[j].y * v[j].y) + (v[j].z * v[j].z + v[j].w * v[j].w); }
    const float rstd = 1.0f / sqrtf(wave_sum(s) * (1.f / DM) + EPS);
    unsigned long long* o8 = (unsigned long long*)orow + lane;
#pragma unroll
    for (int j = 0; j < 4; ++j) { const f32x4 ww = wr[64 * j]; v[j] = v[j] * rstd * ww;
        o8[64 * j] = (unsigned long long)pk2(v[j].x, v[j].y) | ((unsigned long long)pk2(v[j].z, v[j].w) << 32); }
}
__device__ __forceinline__ void cvt_f32_bf16_stream(const float* src, bf16* dst, size_t n, size_t gtid, size_t gthreads) {
    for (size_t i = gtid * 8; i < n; i += gthreads * 8) { const f32x4 a = *(const f32x4*)(src + i), b = *(const f32x4*)(src + i + 4);
        u32x4 o; o.x = pk2(a.x, a.y); o.y = pk2(a.z, a.w); o.z = pk2(b.x, b.y); o.w = pk2(b.z, b.w); *(u32x4*)(dst + i) = o; }
}
constexpr float PD_SCALE = 64.0f, PU_SCALE = 8.0f;
__device__ __forceinline__ unsigned pk4_fp8(f32x4 v, float sc) {
    const float a = fminf(fmaxf(v.x * sc, -448.f), 448.f), b = fminf(fmaxf(v.y * sc, -448.f), 448.f), c = fminf(fmaxf(v.z * sc, -448.f), 448.f), d = fminf(fmaxf(v.w * sc, -448.f), 448.f);
    unsigned p = __builtin_amdgcn_cvt_pk_fp8_f32(a, b, 0, false); return __builtin_amdgcn_cvt_pk_fp8_f32(c, d, p, true);
}
__device__ __forceinline__ void cvt_f32_fp8_stream(const float* src, unsigned char* dst, size_t n, float sc, size_t gtid, size_t gthreads) {
    for (size_t i = gtid * 16; i < n; i += gthreads * 16) { const f32x4 a = *(const f32x4*)(src + i), b = *(const f32x4*)(src + i + 4), c = *(const f32x4*)(src + i + 8), d = *(const f32x4*)(src + i + 12);
        const u32x4 o = {pk4_fp8(a, sc), pk4_fp8(b, sc), pk4_fp8(c, sc), pk4_fp8(d, sc)}; *(u32x4*)(dst + i) = o; }
}
__device__ __forceinline__ void p0_prologue(Frame& F) {
    LAS float* scr = (LAS float*)(F.lds + F.wave * 8448);
    LAS float* wdt = (LAS float*)(F.lds + 8 * 8448);
    const int gw = F.bid * NWAVES + F.wave, NGW = F.G * NWAVES;
    unsigned char* ws = F.ws;
    for (int i = F.tid; i < 1024 * 16; i += NTHR) wdt[i] = F.in[I_WIN][(size_t)(i >> 4) * W_IN_N + OFF_DT + (i & 15)];
    __syncthreads();
    constexpr int IT_A = 16 * 96, IT_B = 16 * 192, IT_MKV = 16 * 48, IT_SSD = 16 * 32, IT_DIL = 4 * 32, IT_MBR = 12 * 32, IT_OUT = 16 * 32, IT_WQ = 16 * 64;
    constexpr int NITEMS = IT_A + IT_B + IT_MKV + IT_SSD + IT_DIL + IT_MBR + IT_OUT + IT_WQ;
    bf16* WallT = (bf16*)(ws + WS_WALLT);
    for (int it = gw; it < NITEMS; it += NGW) {
        int r = it;
        if (r < IT_A) { p0_transpose_item(F.in[I_WIN], W_IN_N, 0, WallT, DM, 0, 0, 96, scr, r, F.lane); continue; } r -= IT_A;
        if (r < IT_B) { p0_transpose_item(F.in[I_WIN], W_IN_N, OFF_AFTER_DT, WallT, DM, 3072, 0, 192, scr, r, F.lane); continue; } r -= IT_B;
        if (r < IT_MKV) { p0_transpose_item(F.in[I_WMKV], 1536, 0, (bf16*)(ws + WS_WMKVT), DM, 0, 0, 48, scr, r, F.lane); continue; } r -= IT_MKV;
        if (r < IT_SSD) { p0_transpose_item(F.in[I_WSSD], DM, 0, (bf16*)(ws + WS_WCATT), YC, 0, 0, 32, scr, r, F.lane); continue; } r -= IT_SSD;
        if (r < IT_DIL) { p0_transpose_item(F.in[I_WDIL], DM, 0, (bf16*)(ws + WS_WCATT), YC, 0, 1024, 32, scr, r, F.lane); continue; } r -= IT_DIL;
        if (r < IT_MBR) { p0_transpose_item(F.in[I_WMEMBR], DM, 0, (bf16*)(ws + WS_WCATT), YC, 0, 1280, 32, scr, r, F.lane); continue; } r -= IT_MBR;
        if (r < IT_OUT) { p0_transpose_item(F.in[I_WOUT], DM, 0, (bf16*)(ws + WS_WOUTT), DM, 0, 0, 32, scr, r, F.lane); continue; } r -= IT_OUT;
        p0_transpose_item(F.in[I_WQ], PEER_Q, 0, (bf16*)(ws + WS_WQT), DM, 0, 0, 64, scr, r, F.lane);
    }
    const size_t gtid = (size_t)F.bid * NTHR + F.tid, gth = (size_t)F.G * NTHR;
    cvt_f32_bf16_stream(F.in[I_SUBK], (bf16*)(ws + WS_SUBK), (size_t)8 * 2 * 128 * 128, gtid, gth);
    cvt_f32_fp8_stream(F.in[I_PD], ws + WS_PD, (size_t)16384 * 1024, PD_SCALE, gtid, gth);
    cvt_f32_fp8_stream(F.in[I_PU], ws + WS_PU, (size_t)16384 * 1024, PU_SCALE, gtid, gth);
    for (int m = gw; m < NB * NMEM; m += NGW) { f32x4 v[4]; rms_row_to_bf16(F.in[I_MEM] + (size_t)m * DM, F.in[I_MEMNW], (bf16*)(ws + WS_MEMN) + (size_t)m * DM, F.lane, v); }
    float* DTp = (float*)(ws + WS_DT);
    for (int m = gw; m < T; m += NGW) {
        f32x4 v[4]; rms_row_to_bf16(F.in[I_X] + (size_t)m * DM, F.in[I_NMIXW], (bf16*)(ws + WS_ACT1) + (size_t)m * DM, F.lane, v);
        float d[16];
#pragma unroll
        for (int j = 0; j < 16; ++j) d[j] = 0.f;
#pragma unroll
        for (int j = 0; j < 4; ++j)
#pragma unroll
            for (int e = 0; e < 4; ++e) { const int k = 4 * F.lane + 256 * j + e; const float uv = v[j][e];
#pragma unroll
                for (int q = 0; q < 4; ++q) { const f32x4 w4 = *(const LAS f32x4*)(wdt + k * 16 + 4 * q); d[4 * q + 0] += uv * w4.x; d[4 * q + 1] += uv * w4.y; d[4 * q + 2] += uv * w4.z; d[4 * q + 3] += uv * w4.w; }
                __builtin_amdgcn_sched_barrier(0); }
        float mine = 0.f;
#pragma unroll
        for (int j = 0; j < 16; ++j) { const float s = wave_sum(d[j]); mine = (F.lane == j) ? s : mine; }
        if (F.lane < 16) { const float xx = mine + F.in[I_DTB][F.lane]; DTp[(size_t)m * 16 + F.lane] = (xx > 20.f) ? xx : log1pf(__expf(xx)); }
    }
}

__device__ __forceinline__ void qkprep_phase(Frame& F, int half) {
    bf16* P = (bf16*)(F.ws + WS_BIG);
    const int gw = F.bid * NWAVES + F.wave, NGW = F.G * NWAVES, lane = F.lane;
    const float wq = F.in[I_DQNW][lane], wk = F.in[I_DKNW][lane];
    const float wmq0 = F.in[I_MQNW][lane], wmq1 = F.in[I_MQNW][lane + 64], wmq2 = F.in[I_MQNW][lane + 128];
    const float inv = __expf(-logf(500000.0f) * (2.0f / 16.0f) * (float)(lane & 7));
    for (int r = gw; r < HT; r += NGW) {
        const int tok = half * HT + r;
        const int pos = F.positions[tok];
        const double rev = (double)((float)pos * inv) * 0.15915494309189535;
        const float fr = (float)(rev - floor(rev));
        const float cs = __builtin_amdgcn_cosf(fr), sn = __builtin_amdgcn_sinf(fr);
        bf16* row = P + (size_t)r * NPROJ;
#pragma unroll 4
        for (int h = 0; h < 24; ++h) {
            bf16* p = row + PC_DQ + h * 64 + lane;
            float v = bf2f(*p);
            const float ss = wave_sum(v * v);
            v = v * (1.0f / sqrtf(ss * (1.f / 64.f) + EPS)) * (h < 12 ? wq : wk);
            const float other = __shfl_xor(v, 8);
            if (lane < 8) v = v * cs - other * sn; else if (lane < 16) v = v * cs + other * sn;
            *p = (bf16)f2bf(v);
        }
#pragma unroll
        for (int h = 0; h < 4; ++h) {
            bf16* p = row + PC_MQ + h * 192 + lane;
            float v0 = bf2f(p[0]), v1 = bf2f(p[64]), v2 = bf2f(p[128]);
            const float ss = wave_sum(v0 * v0 + v1 * v1 + v2 * v2);
            const float rs = 1.0f / sqrtf(ss * (1.f / 192.f) + EPS);
            p[0] = (bf16)f2bf(v0 * rs * wmq0); p[64] = (bf16)f2bf(v1 * rs * wmq1); p[128] = (bf16)f2bf(v2 * rs * wmq2);
        }
    }
    if (half == 0) {
        bf16* MK = (bf16*)(F.ws + WS_MKV);
        const float wk0 = F.in[I_MKNW][lane], wk1 = F.in[I_MKNW][lane + 64], wk2 = F.in[I_MKNW][lane + 128];
        for (int r = gw; r < NB * NMEM * 4; r += NGW) {
            bf16* p = MK + (size_t)(r >> 2) * 1536 + (r & 3) * 192 + lane;
            float v0 = bf2f(p[0]), v1 = bf2f(p[64]), v2 = bf2f(p[128]);
            const float ss = wave_sum(v0 * v0 + v1 * v1 + v2 * v2);
            const float rs = 1.0f / sqrtf(ss * (1.f / 192.f) + EPS);
            p[0] = (bf16)f2bf(v0 * rs * wk0); p[64] = (bf16)f2bf(v1 * rs * wk1); p[128] = (bf16)f2bf(v2 * rs * wk2);
        }
    }
}


constexpr int SC_ST = 272, SX_ST = 528;
__device__ __forceinline__ float bfsel(const u32x4& v, int j) { const unsigned w = v[j >> 1]; return (j & 1) ? bfhi(w) : bflo(w); }
__device__ __forceinline__ void conv_task(const bf16* P, size_t rowb, int t0, int pcol, const float* cw, const float* cb, int ccol, LAS unsigned char* dst, int stride, const LAS float* scale) {
    float w[4][8], bs[8];
#pragma unroll
    for (int k = 0; k < 4; ++k) { const f32x4 a = *(const f32x4*)(cw + k * 2048 + ccol), b = *(const f32x4*)(cw + k * 2048 + ccol + 4);
        w[k][0] = a.x; w[k][1] = a.y; w[k][2] = a.z; w[k][3] = a.w; w[k][4] = b.x; w[k][5] = b.y; w[k][6] = b.z; w[k][7] = b.w; }
    { const f32x4 a = *(const f32x4*)(cb + ccol), b = *(const f32x4*)(cb + ccol + 4); bs[0] = a.x; bs[1] = a.y; bs[2] = a.z; bs[3] = a.w; bs[4] = b.x; bs[5] = b.y; bs[6] = b.z; bs[7] = b.w; }
    const bf16* src = P + (rowb + t0) * NPROJ + pcol;
    u32x4 w0 = {0u, 0u, 0u, 0u}, w1 = w0, w2 = w0;
    if (t0 > 0) { w0 = *(const u32x4*)(src - 3 * (ptrdiff_t)NPROJ); w1 = *(const u32x4*)(src - 2 * (ptrdiff_t)NPROJ); w2 = *(const u32x4*)(src - (ptrdiff_t)NPROJ); }
#pragma unroll 4
    for (int i = 0; i < 16; ++i) {
        const u32x4 cur = *(const u32x4*)(src + (size_t)i * NPROJ);
        float o[8];
#pragma unroll
        for (int j = 0; j < 8; ++j) { float a = bs[j] + w[0][j] * bfsel(w0, j) + w[1][j] * bfsel(w1, j) + w[2][j] * bfsel(w2, j) + w[3][j] * bfsel(cur, j); o[j] = a * sigmoidf_(a); }
        if (scale) { const float sv = scale[i];
#pragma unroll
            for (int j = 0; j < 8; ++j) o[j] *= sv; }
        const u32x4 r = {pkbf(o[0], o[1]), pkbf(o[2], o[3]), pkbf(o[4], o[5]), pkbf(o[6], o[7])};
        *(LAS u32x4*)(dst + i * stride) = r;
        w0 = w1; w1 = w2; w2 = cur;
    }
}
__device__ __forceinline__ float ssd_scan(Frame& F, const float* DTp, size_t tok0, int g, LAS float* sAc, LAS float* sDt) {
    float total = 0.f;
    if (F.wave < 4) {
        const int head = 4 * g + F.wave, lane = F.lane;
        const float A = -__expf(F.in[I_ALOG][head]);
        const float d0 = DTp[(tok0 + 2 * lane) * 16 + head], d1 = DTp[(tok0 + 2 * lane + 1) * 16 + head];
        const float a0 = d0 * A, a1 = d1 * A;
        float sc = a0 + a1;
#pragma unroll
        for (int o = 1; o < 64; o <<= 1) { const float v = __shfl_up(sc, o); if (lane >= o) sc += v; }
        sAc[F.wave * 128 + 2 * lane] = sc - a1; sAc[F.wave * 128 + 2 * lane + 1] = sc;
        sDt[F.wave * 128 + 2 * lane] = d0; sDt[F.wave * 128 + 2 * lane + 1] = d1;
        total = __shfl(sc, 63);
    }
    return total;
}
__device__ __forceinline__ bf16x8 tr_pair(unsigned a_lo, unsigned a_hi) {
    s16x4 lo, hi;
    asm volatile("ds_read_b64_tr_b16 %0, %2\n\tds_read_b64_tr_b16 %1, %3\n\ts_waitcnt lgkmcnt(0)" : "=&v"(lo), "=&v"(hi) : "v"(a_lo), "v"(a_hi) : "memory");
    const bf16x8 r = {lo[0], lo[1], lo[2], lo[3], hi[0], hi[1], hi[2], hi[3]}; return r;
}

__device__ __forceinline__ void ssdC_phase(Frame& F, int half) {
    const bf16* P = (const bf16*)(F.ws + WS_BIG);
    const float* DTp = (const float*)(F.ws + WS_DT);
    float* SST = (float*)(F.ws + WS_SST); float* DEC = (float*)(F.ws + WS_DEC);
    LAS unsigned char* sX = F.lds; LAS unsigned char* sB = F.lds + 128 * SX_ST;
    LAS float* sAc = (LAS float*)(F.lds + 128 * SX_ST + 128 * SC_ST); LAS float* sDt = sAc + 512; LAS float* sW = sDt + 512;
    const int wave = F.wave;
    for (int unit = F.bid; unit < HB * 64 * 4; unit += F.G) {
        int tid = F.tid; asm volatile("" : "+v"(tid));
        const int lane = tid & 63, ql = lane & 31, h = lane >> 5, tq = (lane & 15) >> 2, tp = lane & 3, tblk = (lane >> 4) & 1;
        const int bl = unit >> 8, c = (unit >> 2) & 63, g = unit & 3;
        const size_t rowb = (size_t)bl * SEQ, tok0 = (size_t)half * HT + rowb + c * 128;
        __syncthreads();
        const float total = ssd_scan(F, DTp, tok0, g, sAc, sDt);
        if (wave < 4) { sW[wave * 128 + 2 * lane] = __expf(total - sAc[wave * 128 + 2 * lane]) * sDt[wave * 128 + 2 * lane];
            sW[wave * 128 + 2 * lane + 1] = __expf(total - sAc[wave * 128 + 2 * lane + 1]) * sDt[wave * 128 + 2 * lane + 1];
            if (lane == 0) DEC[((size_t)bl * 64 + c) * 16 + 4 * g + wave] = __expf(total); }
        __syncthreads();
        if (tid < 384) {
            int ch, strip, ccol, stride; LAS unsigned char* dst; const LAS float* scl = nullptr;
            if (tid < 256) { ch = tid & 31; strip = tid >> 5; ccol = g * 256 + 8 * ch; stride = SX_ST; dst = sX + (strip * 16) * SX_ST + ch * 16; scl = sW + (ch >> 3) * 128 + strip * 16; }
            else { const int u = tid - 256; ch = u & 15; strip = u >> 4; ccol = 1024 + g * 128 + 8 * ch; stride = SC_ST; dst = sB + (strip * 16) * SC_ST + ch * 16; }
            conv_task(P, rowb, c * 128 + strip * 16, PC_X + ccol, F.in[I_CONVW], F.in[I_CONVB], ccol, dst, stride, scl);
        }
        __syncthreads();
        const int r = wave >> 1, pt = wave & 1;
        f32x16 acc[4];
#pragma unroll
        for (int nt = 0; nt < 4; ++nt)
#pragma unroll
            for (int e = 0; e < 16; ++e) acc[nt][e] = 0.f;
        const unsigned xa = (unsigned)(size_t)sX + (unsigned)((8 * h + tq) * SX_ST + (r * 64 + 32 * pt + 16 * tblk + 4 * tp) * 2);
        const unsigned ba = (unsigned)(size_t)sB + (unsigned)((8 * h + tq) * SC_ST + (16 * tblk + 4 * tp) * 2);
#pragma unroll
        for (int ks = 0; ks < 8; ++ks) {
            const bf16x8 af = tr_pair(xa + ks * 16 * SX_ST, xa + ks * 16 * SX_ST + 4 * SX_ST);
            bf16x8 bfr[4];
#pragma unroll
            for (int nt = 0; nt < 4; ++nt) bfr[nt] = tr_pair(ba + ks * 16 * SC_ST + nt * 64, ba + ks * 16 * SC_ST + 4 * SC_ST + nt * 64);
            __builtin_amdgcn_sched_barrier(0);
#pragma unroll
            for (int nt = 0; nt < 4; ++nt) acc[nt] = MFMA32(af, bfr[nt], acc[nt]);
        }
        float* out = SST + (((size_t)bl * 64 + c) * 16 + 4 * g + r) * 8192;
#pragma unroll
        for (int nt = 0; nt < 4; ++nt)
#pragma unroll
            for (int e = 0; e < 16; ++e) out[(32 * pt + (e & 3) + 8 * (e >> 2) + 4 * h) * 128 + 32 * nt + ql] = acc[nt][e];
    }
}

__device__ __forceinline__ void ssdD_phase(Frame& F) {
    const float* SST = (const float*)(F.ws + WS_SST); const float* DEC = (const float*)(F.ws + WS_DEC);
    bf16* SIN = (bf16*)(F.ws + WS_SIN);
    const size_t gtid = (size_t)F.bid * NTHR + F.tid, gth = (size_t)F.G * NTHR;
    for (size_t it = gtid; it < (size_t)HB * 16 * 2048; it += gth) {
        const int bl = (int)(it >> 15), head = (int)(it >> 11) & 15, e4 = (int)(it & 2047) * 4;
        f32x4 st = {0.f, 0.f, 0.f, 0.f};
#pragma unroll 8
        for (int c = 0; c < 64; ++c) {
            const size_t idx = (((size_t)bl * 64 + c) * 16 + head);
            const u32x2 o = {pkbf(st.x, st.y), pkbf(st.z, st.w)};
            *(u32x2*)(SIN + idx * 8192 + e4) = o;
            const f32x4 sl = *(const f32x4*)(SST + idx * 8192 + e4); const float d = DEC[idx];
            st = st * d + sl;
        }
    }
}

__device__ __forceinline__ void ssdE_phase(Frame& F, int half) {
    const bf16* P = (const bf16*)(F.ws + WS_BIG);
    const float* DTp = (const float*)(F.ws + WS_DT);
    const bf16* SIN = (const bf16*)(F.ws + WS_SIN);
    bf16* Y = (bf16*)F.out;
    LAS unsigned char* sX = F.lds; LAS unsigned char* sB = F.lds + 128 * SX_ST; LAS unsigned char* sC = sB + 128 * SC_ST;
    LAS float* sAc = (LAS float*)(sC + 128 * SC_ST); LAS float* sDt = sAc + 512; LAS float* sSS = sDt + 512;
    const int wave = F.wave;
    const int st = wave & 3, hp = wave >> 2;
    for (int unit = F.bid; unit < HB * 64 * 4; unit += F.G) {
        int tid = F.tid; asm volatile("" : "+v"(tid));
        const int lane = tid & 63, ql = lane & 31, h = lane >> 5, tq = (lane & 15) >> 2, tp = lane & 3, tblk = (lane >> 4) & 1;
        const int bl = unit >> 8, c = (unit >> 2) & 63, g = unit & 3;
        const size_t rowb = (size_t)bl * SEQ, tok0 = (size_t)half * HT + rowb + c * 128;
        __syncthreads();
        (void)ssd_scan(F, DTp, tok0, g, sAc, sDt);
        if (tid < 128) sSS[tid] = 0.f;
        {
            int ch, strip, ccol, stride; LAS unsigned char* dst;
            if (tid < 256) { ch = tid & 31; strip = tid >> 5; ccol = g * 256 + 8 * ch; stride = SX_ST; dst = sX + (strip * 16) * SX_ST + ch * 16; }
            else if (tid < 384) { const int u = tid - 256; ch = u & 15; strip = u >> 4; ccol = 1024 + g * 128 + 8 * ch; stride = SC_ST; dst = sB + (strip * 16) * SC_ST + ch * 16; }
            else { const int u = tid - 384; ch = u & 15; strip = u >> 4; ccol = 1536 + g * 128 + 8 * ch; stride = SC_ST; dst = sC + (strip * 16) * SC_ST + ch * 16; }
            conv_task(P, rowb, c * 128 + strip * 16, PC_X + ccol, F.in[I_CONVW], F.in[I_CONVB], ccol, dst, stride, nullptr);
        }
        __syncthreads();
        const int s = 32 * st + ql;
        unsigned yk[2][2][8];
        float ssq = 0.f;
        const unsigned xa = (unsigned)(size_t)sX + (unsigned)((4 * h + tq) * SX_ST + (16 * tblk + 4 * tp) * 2);
#pragma unroll
        for (int hq = 0; hq < 2; ++hq) {
            const int r = 2 * hp + hq, head = 4 * g + r;
            const float acs = sAc[r * 128 + s];
            bf16x8 pf[4][2];
#pragma unroll
            for (int i = 0; i < 4; ++i) {
                f32x16 Xi;
#pragma unroll
                for (int e = 0; e < 16; ++e) Xi[e] = 0.f;
#pragma unroll
                for (int ks = 0; ks < 8; ++ks) { const bf16x8 bf_ = *(const LAS bf16x8*)(sB + (32 * i + ql) * SC_ST + 32 * ks + 16 * h);
                    const bf16x8 cf = *(const LAS bf16x8*)(sC + s * SC_ST + 32 * ks + 16 * h); Xi = MFMA32(bf_, cf, Xi); }
                float p[16];
#pragma unroll
                for (int q4 = 0; q4 < 4; ++q4) { const int t0 = 32 * i + 8 * q4 + 4 * h;
                    const f32x4 at = *(const LAS f32x4*)(sAc + r * 128 + t0), dt4 = *(const LAS f32x4*)(sDt + r * 128 + t0);
#pragma unroll
                    for (int e = 0; e < 4; ++e) { const int t = t0 + e; p[4 * q4 + e] = (t <= s) ? Xi[4 * q4 + e] * __expf(acs - at[e]) * dt4[e] : 0.f; } }
#pragma unroll
                for (int s2 = 0; s2 < 2; ++s2) { const u32x4 w = {pkbf(p[8 * s2 + 0], p[8 * s2 + 1]), pkbf(p[8 * s2 + 2], p[8 * s2 + 3]), pkbf(p[8 * s2 + 4], p[8 * s2 + 5]), pkbf(p[8 * s2 + 6], p[8 * s2 + 7])};
                    pf[i][s2] = __builtin_bit_cast(bf16x8, w); }
            }
            const bf16* stp = SIN + (((size_t)bl * 64 + c) * 16 + head) * 8192;
            const float eacs = __expf(acs), Dh = F.in[I_SSDD][head];
#pragma unroll
            for (int pt = 0; pt < 2; ++pt) {
                f32x16 yd, yo;
#pragma unroll
                for (int e = 0; e < 16; ++e) { yd[e] = 0.f; yo[e] = 0.f; }
#pragma unroll
                for (int i = 0; i < 4; ++i) {
#pragma unroll
                    for (int s2 = 0; s2 < 2; ++s2) { const unsigned a = xa + (unsigned)((32 * i + 16 * s2) * SX_ST + (r * 64 + 32 * pt) * 2);
                        const bf16x8 xf = tr_pair(a, a + 8 * SX_ST); __builtin_amdgcn_sched_barrier(0); yd = MFMA32(xf, pf[i][s2], yd); }
                }
#pragma unroll
                for (int ks = 0; ks < 8; ++ks) { const bf16x8 sf = *(const bf16x8*)(stp + (32 * pt + ql) * 128 + 16 * ks + 8 * h);
                    const bf16x8 cf = *(const LAS bf16x8*)(sC + s * SC_ST + 32 * ks + 16 * h); yo = MFMA32(sf, cf, yo); }
                const bf16* zp = P + (rowb + c * 128 + s) * NPROJ + PC_Z + g * 256 + r * 64 + 32 * pt + 4 * h;
#pragma unroll
                for (int q4 = 0; q4 < 4; ++q4) {
                    const u32x2 xv = *(const LAS u32x2*)(sX + s * SX_ST + (r * 64 + 32 * pt + 8 * q4 + 4 * h) * 2);
                    const u32x2 zv = *(const u32x2*)(zp + 8 * q4);
                    const float xs_[4] = {bflo(xv.x), bfhi(xv.x), bflo(xv.y), bfhi(xv.y)}, zs_[4] = {bflo(zv.x), bfhi(zv.x), bflo(zv.y), bfhi(zv.y)};
                    float yv[4];
#pragma unroll
                    for (int e = 0; e < 4; ++e) { float y = yd[4 * q4 + e] + eacs * yo[4 * q4 + e] + Dh * xs_[e]; y = y * zs_[e] * sigmoidf_(zs_[e]); yv[e] = y; ssq += y * y; }
                    yk[hq][pt][2 * q4] = pkbf(yv[0], yv[1]); yk[hq][pt][2 * q4 + 1] = pkbf(yv[2], yv[3]);
                }
            }
        }
        ssq += __shfl_xor(ssq, 32);
        if (h == 0) __hip_atomic_fetch_add(sSS + s, ssq, __ATOMIC_RELAXED, __HIP_MEMORY_SCOPE_WORKGROUP);
        __syncthreads();
        const float rs = 1.0f / sqrtf(sSS[s] * (1.f / 256.f) + EPS);
        bf16* yp = Y + (tok0 + s) * YC + g * 256 + 4 * h;
        const float* nw = F.in[I_SSDNW] + g * 256 + 4 * h;
#pragma unroll
        for (int hq = 0; hq < 2; ++hq)
#pragma unroll
            for (int pt = 0; pt < 2; ++pt)
#pragma unroll
                for (int q4 = 0; q4 < 4; ++q4) { const int cc = (2 * hp + hq) * 64 + 32 * pt + 8 * q4; const f32x4 w4 = *(const f32x4*)(nw + cc);
                    const unsigned ya = yk[hq][pt][2 * q4], yb = yk[hq][pt][2 * q4 + 1];
                    const u32x2 o = {pkbf(bflo(ya) * rs * w4.x, bfhi(ya) * rs * w4.y), pkbf(bflo(yb) * rs * w4.z, bfhi(yb) * rs * w4.w)};
                    *(u32x2*)(yp + cc) = o; }
    }
}

__device__ __forceinline__ bf16x8 mk_bf16x8(u32x2 lo, u32x2 hi) { const u32x4 v = {lo.x, lo.y, hi.x, hi.y}; return __builtin_bit_cast(bf16x8, v); }

__device__ __forceinline__ void memattn_mfma_phase(Frame& F, int half) {
    const bf16* P = (const bf16*)(F.ws + WS_BIG);
    const bf16* MKV = (const bf16*)(F.ws + WS_MKV);
    const bf16* MVT = (const bf16*)(F.ws + WS_MVT);
    bf16* Y = (bf16*)F.out;
    LAS unsigned char* sm = F.lds;
    const int tid = F.tid, lane = F.lane, wave = F.wave, ql = lane & 31, h = lane >> 5;
    constexpr int KST = 400, VST = 528;
    for (int unit = F.bid; unit < HB * 4 * 32; unit += F.G) {
        const int bl = unit >> 7, head = (unit >> 5) & 3, qt = unit & 31, b = half * HB + bl;
        const int r = bl * SEQ + qt * 256 + wave * 32 + ql;
        __syncthreads();
        for (int c = tid; c < 256 * 24; c += NTHR) { const int row = c / 24, ch = c % 24;
            *(LAS u32x4*)(sm + row * KST + ch * 16) = *(const u32x4*)(MKV + (size_t)(b * NMEM + row) * 1536 + head * 192 + ch * 8); }
        bf16x8 qf[12];
        { const bf16* qp = P + (size_t)r * NPROJ + PC_MQ + head * 192 + 8 * h;
#pragma unroll
          for (int ks = 0; ks < 12; ++ks) qf[ks] = *(const bf16x8*)(qp + 16 * ks); }
        __syncthreads();
        f32x16 sacc[8];
#pragma unroll
        for (int mt = 0; mt < 8; ++mt) {
#pragma unroll
            for (int i = 0; i < 16; ++i) sacc[mt][i] = 0.f;
#pragma unroll
            for (int ks = 0; ks < 12; ++ks) { const bf16x8 kf = *(const LAS bf16x8*)(sm + (32 * mt + ql) * KST + 32 * ks + 16 * h); sacc[mt] = MFMA32(kf, qf[ks], sacc[mt]); }
        }
        float mx = -3.0e38f;
#pragma unroll
        for (int mt = 0; mt < 8; ++mt)
#pragma unroll
            for (int i = 0; i < 16; ++i) mx = fmaxf(mx, sacc[mt][i]);
        mx = fmaxf(mx, __shfl_xor(mx, 32));
        const float sc = 0.07216878364870323f * 1.4426950408889634f;
        float l = 0.f;
        bf16x8 pf[8][2];
#pragma unroll
        for (int mt = 0; mt < 8; ++mt) {
            float p[16];
#pragma unroll
            for (int i = 0; i < 16; ++i) { p[i] = __builtin_amdgcn_exp2f((sacc[mt][i] - mx) * sc); l += p[i]; }
#pragma unroll
            for (int s2 = 0; s2 < 2; ++s2) { const u32x4 w = {pkbf(p[8 * s2 + 0], p[8 * s2 + 1]), pkbf(p[8 * s2 + 2], p[8 * s2 + 3]), pkbf(p[8 * s2 + 4], p[8 * s2 + 5]), pkbf(p[8 * s2 + 6], p[8 * s2 + 7])};
                pf[mt][s2] = __builtin_bit_cast(bf16x8, w); }
        }
        l += __shfl_xor(l, 32);
        __syncthreads();
        for (int c = tid; c < 192 * 32; c += NTHR) { const int row = c >> 5, ch = c & 31;
            *(LAS u32x4*)(sm + row * VST + ch * 16) = *(const u32x4*)(MVT + (size_t)(head * 192 + row) * 2048 + b * NMEM + ch * 8); }
        __syncthreads();
        const float il = 1.0f / l;
        bf16* yp = Y + ((size_t)half * HT + r) * YC + 1280 + head * 192 + 4 * h;
#pragma unroll
        for (int dt = 0; dt < 6; ++dt) {
            f32x16 o;
#pragma unroll
            for (int i = 0; i < 16; ++i) o[i] = 0.f;
#pragma unroll
            for (int mt = 0; mt < 8; ++mt)
#pragma unroll
                for (int s2 = 0; s2 < 2; ++s2) { const LAS unsigned char* vp = sm + (32 * dt + ql) * VST + (32 * mt + 16 * s2 + 4 * h) * 2;
                    const bf16x8 vf = mk_bf16x8(*(const LAS u32x2*)vp, *(const LAS u32x2*)(vp + 16)); o = MFMA32(vf, pf[mt][s2], o); }
#pragma unroll
            for (int g = 0; g < 4; ++g) { const u32x2 w = {pkbf(o[4 * g] * il, o[4 * g + 1] * il), pkbf(o[4 * g + 2] * il, o[4 * g + 3] * il)}; *(u32x2*)(yp + 32 * dt + 8 * g) = w; }
        }
    }
}

__device__ __forceinline__ void dilattn_mfma_phase(Frame& F, int half) {
    bf16* P = (bf16*)(F.ws + WS_BIG);
    float* LSE = (float*)(F.ws + WS_LSE);
    LAS unsigned char* sK = F.lds; LAS unsigned char* sV = F.lds + 384 * 144;
    const int tid = F.tid, lane = F.lane, wave = F.wave, ql = lane & 31, h = lane >> 5;
    constexpr int RST = 144;
    for (int unit = F.bid; unit < HB * 12 * 32; unit += F.G) {
        const int bl = unit / 384, rem = unit % 384, head = rem >> 5, blk = rem & 31;
        const int g = head >> 2, dil = (g == 0) ? 1 : (g == 1 ? 4 : 16), bpr = 32 / dil;
        const int res = blk / bpr, q0 = (blk % bpr) * 256;
        const size_t rowb = (size_t)bl * SEQ;
        __syncthreads();
        for (int c = tid; c < 384 * 8; c += NTHR) { const int row = c >> 3, ch = c & 7; const int ks = q0 - 128 + row;
            u32x4 kv = {0u, 0u, 0u, 0u}, vv = {0u, 0u, 0u, 0u};
            if (ks >= 0) { const bf16* src = P + (rowb + (size_t)ks * dil + res) * NPROJ + head * 64 + ch * 8; kv = *(const u32x4*)(src + PC_DK); vv = *(const u32x4*)(src + PC_DV); }
            *(LAS u32x4*)(sK + row * RST + ch * 16) = kv; *(LAS u32x4*)(sV + row * RST + ch * 16) = vv; }
        const int qs = q0 + wave * 32 + ql;
        const size_t rq = rowb + (size_t)qs * dil + res;
        bf16* qp = P + rq * NPROJ + PC_DQ + head * 64;
        bf16x8 qf[4];
#pragma unroll
        for (int ks = 0; ks < 4; ++ks) qf[ks] = *(const bf16x8*)(qp + 16 * ks + 8 * h);
        __syncthreads();
        f32x16 sacc[5];
        const int kfirst = q0 + wave * 32 - 128;
#pragma unroll
        for (int i = 0; i < 5; ++i) {
#pragma unroll
            for (int e = 0; e < 16; ++e) sacc[i][e] = 0.f;
#pragma unroll
            for (int ks = 0; ks < 4; ++ks) { const bf16x8 kf = *(const LAS bf16x8*)(sK + (32 * wave + 32 * i + ql) * RST + 32 * ks + 16 * h); sacc[i] = MFMA32(kf, qf[ks], sacc[i]); }
        }
        float mx = -3.0e38f;
#pragma unroll
        for (int i = 0; i < 5; ++i)
#pragma unroll
            for (int e = 0; e < 16; ++e) { const int kj = 32 * i + (e & 3) + 8 * (e >> 2) + 4 * h; const bool ok = (kj >= ql) && (kj <= ql + 128) && (kfirst + kj >= 0);
                sacc[i][e] = ok ? sacc[i][e] : -3.0e38f; mx = fmaxf(mx, sacc[i][e]); }
        mx = fmaxf(mx, __shfl_xor(mx, 32));
        const float sc = 0.125f * 1.4426950408889634f;
        float l = 0.f;
        bf16x8 pf[5][2];
#pragma unroll
        for (int i = 0; i < 5; ++i) {
            float p[16];
#pragma unroll
            for (int e = 0; e < 16; ++e) { p[e] = (sacc[i][e] > -1.0e38f) ? __builtin_amdgcn_exp2f((sacc[i][e] - mx) * sc) : 0.f; l += p[e]; }
#pragma unroll
            for (int s2 = 0; s2 < 2; ++s2) { const u32x4 w = {pkbf(p[8 * s2 + 0], p[8 * s2 + 1]), pkbf(p[8 * s2 + 2], p[8 * s2 + 3]), pkbf(p[8 * s2 + 4], p[8 * s2 + 5]), pkbf(p[8 * s2 + 6], p[8 * s2 + 7])};
                pf[i][s2] = __builtin_bit_cast(bf16x8, w); }
        }
        l += __shfl_xor(l, 32);
        const float il = 1.0f / l;
        const int tq = (lane & 15) >> 2, tp = lane & 3, tblk = (lane >> 4) & 1;
        const unsigned vbase = (unsigned)(size_t)(sV) + (unsigned)((32 * wave + 4 * h + tq) * RST + (16 * tblk + 4 * tp) * 2);
#pragma unroll
        for (int dt = 0; dt < 2; ++dt) {
            f32x16 o;
#pragma unroll
            for (int e = 0; e < 16; ++e) o[e] = 0.f;
#pragma unroll
            for (int i = 0; i < 5; ++i) {
                s16x4 lo[2], hi[2];
#pragma unroll
                for (int s2 = 0; s2 < 2; ++s2) { const unsigned a = vbase + (unsigned)((32 * i + 16 * s2) * RST + 64 * dt);
                    asm volatile("ds_read_b64_tr_b16 %0, %1" : "=&v"(lo[s2]) : "v"(a) : "memory");
                    asm volatile("ds_read_b64_tr_b16 %0, %1 offset:1152" : "=&v"(hi[s2]) : "v"(a) : "memory"); }
                asm volatile("s_waitcnt lgkmcnt(0)" ::: "memory"); __builtin_amdgcn_sched_barrier(0);
#pragma unroll
                for (int s2 = 0; s2 < 2; ++s2) { const bf16x8 vf = {lo[s2][0], lo[s2][1], lo[s2][2], lo[s2][3], hi[s2][0], hi[s2][1], hi[s2][2], hi[s2][3]}; o = MFMA32(vf, pf[i][s2], o); }
            }
#pragma unroll
            for (int gq = 0; gq < 4; ++gq) { const u32x2 w = {pkbf(o[4 * gq] * il, o[4 * gq + 1] * il), pkbf(o[4 * gq + 2] * il, o[4 * gq + 3] * il)}; *(u32x2*)(qp + 32 * dt + 8 * gq + 4 * h) = w; }
        }
        if (h == 0) LSE[((size_t)half * HT + rq) * 12 + head] = mx * 0.125f + __logf(l);
    }
}

__device__ __forceinline__ void dilmerge_phase(Frame& F, int half) {
    const bf16* P = (const bf16*)(F.ws + WS_BIG);
    const float* LSE = (const float*)(F.ws + WS_LSE);
    bf16* Y = (bf16*)F.out;
    const size_t gtid = (size_t)F.bid * NTHR + F.tid, gth = (size_t)F.G * NTHR;
    for (size_t it = gtid; it < (size_t)HT * 32; it += gth) {
        const size_t r = it >> 5; const int hh = (int)(it >> 3) & 3, d0 = (int)(it & 7) * 8;
        const size_t tok = (size_t)half * HT + r;
        const float l0 = LSE[tok * 12 + hh], l1 = LSE[tok * 12 + 4 + hh], l2 = LSE[tok * 12 + 8 + hh];
        const float m = fmaxf(l0, fmaxf(l1, l2));
        float w0 = __expf(l0 - m), w1 = __expf(l1 - m), w2 = __expf(l2 - m); const float iw = 1.0f / (w0 + w1 + w2); w0 *= iw; w1 *= iw; w2 *= iw;
        const bf16* op = P + r * NPROJ + PC_DQ + hh * 64 + d0;
        const u32x4 a = *(const u32x4*)op, b = *(const u32x4*)(op + 256), c = *(const u32x4*)(op + 512);
        u32x4 o;
        o.x = pkbf(w0 * bflo(a.x) + w1 * bflo(b.x) + w2 * bflo(c.x), w0 * bfhi(a.x) + w1 * bfhi(b.x) + w2 * bfhi(c.x));
        o.y = pkbf(w0 * bflo(a.y) + w1 * bflo(b.y) + w2 * bflo(c.y), w0 * bfhi(a.y) + w1 * bfhi(b.y) + w2 * bfhi(c.y));
        o.z = pkbf(w0 * bflo(a.z) + w1 * bflo(b.z) + w2 * bflo(c.z), w0 * bfhi(a.z) + w1 * bfhi(b.z) + w2 * bfhi(c.z));
        o.w = pkbf(w0 * bflo(a.w) + w1 * bflo(b.w) + w2 * bflo(c.w), w0 * bfhi(a.w) + w1 * bfhi(b.w) + w2 * bfhi(c.w));
        *(u32x4*)(Y + tok * YC + 1024 + hh * 64 + d0) = o;
    }
}

__device__ __forceinline__ void hn_phase(Frame& F) {
    const int gw = F.bid * NWAVES + F.wave, NGW = F.G * NWAVES;
    for (int m = gw; m < T; m += NGW) { f32x4 v[4]; rms_row_to_bf16(F.out + (size_t)m * DM, F.in[I_NFFNW], (bf16*)(F.ws + WS_ACT1) + (size_t)m * DM, F.lane, v); }
}


__device__ __forceinline__ float gelu_erf(float x) { return 0.5f * x * (1.0f + erff(x * 0.70710678118654752f)); }
__device__ __forceinline__ unsigned f2ord(float f) { const unsigned u = __builtin_bit_cast(unsigned, f); return u ^ ((unsigned)((int)u >> 31) | 0x80000000u); }
__device__ __forceinline__ float ord2f(unsigned k) { const unsigned m = (unsigned)((int)k >> 31); return __builtin_bit_cast(float, k ^ (0x80000000u | ~m)); }
#define CMPX(a, b) do { const unsigned _mx = max((a), (b)), _mn = min((a), (b)); (a) = _mx; (b) = _mn; } while (0)
__device__ __forceinline__ void bitonic_sort16_desc(unsigned (&v)[16]) {
#pragma unroll
    for (int k = 2; k <= 16; k <<= 1)
#pragma unroll
        for (int j = k >> 1; j > 0; j >>= 1)
#pragma unroll
            for (int i = 0; i < 16; ++i) { const int l = i ^ j; if (l > i) { if ((i & k) == 0) CMPX(v[i], v[l]); else CMPX(v[l], v[i]); } }
}
__device__ __forceinline__ void bitonic_merge16_desc(unsigned (&v)[16]) {
#pragma unroll
    for (int j = 8; j > 0; j >>= 1)
#pragma unroll
        for (int i = 0; i < 16; ++i) { const int l = i ^ j; if (l > i) CMPX(v[i], v[l]); }
}
__device__ __forceinline__ void top16_merge(unsigned (&a)[16], const unsigned (&b)[16]) {
#pragma unroll
    for (int i = 0; i < 16; ++i) a[i] = max(a[i], b[15 - i]);
    bitonic_merge16_desc(a);
}
constexpr int PK_ST = 272;
__device__ __forceinline__ void peer_topk_tile(Frame& F, size_t tok0, int* IDX, float* GATE) {
    const bf16* Q = (const bf16*)(F.ws + WS_BIG);
    const bf16* SK = (const bf16*)(F.ws + WS_SUBK);
    LAS unsigned char* sK = F.lds;
    int tid = F.tid; asm volatile("" : "+v"(tid));
    const int lane = tid & 63, wave = F.wave, ql = lane & 31, hh = lane >> 5;
    const size_t tok = tok0 + wave * 32 + ql;
    const bf16* qrow = Q + tok * PEER_Q + 8 * hh;
    __syncthreads();
#pragma unroll
    for (int j = 0; j < 4; ++j) { const int cidx = tid + 512 * j, row = cidx >> 4, ch = cidx & 15; *(LAS u32x4*)(sK + row * PK_ST + ch * 16) = *(const u32x4*)(SK + (size_t)row * 128 + ch * 8); }
    __syncthreads();
    unsigned k1[16];
#pragma unroll 1
    for (int hc = 0; hc < 16; ++hc) {
        LAS unsigned char* cur = sK + (hc & 1) * (128 * PK_ST); LAS unsigned char* nxt = sK + ((hc + 1) & 1) * (128 * PK_ST);
        u32x4 stg[4];
        const int hcn = (hc + 1) & 15;
#pragma unroll
        for (int j = 0; j < 4; ++j) { const int cidx = tid + 512 * j, row = cidx >> 4, ch = cidx & 15; stg[j] = *(const u32x4*)(SK + ((size_t)hcn * 128 + row) * 128 + ch * 8); }
        bf16x8 qf[8];
#pragma unroll
        for (int ks = 0; ks < 8; ++ks) qf[ks] = *(const bf16x8*)(qrow + hc * 128 + 16 * ks);
        unsigned pk[4][16];
#pragma unroll
        for (int mt = 0; mt < 4; ++mt) {
            f32x16 acc;
#pragma unroll
            for (int e = 0; e < 16; ++e) acc[e] = 0.f;
#pragma unroll
            for (int ks = 0; ks < 8; ++ks) { const bf16x8 kf = *(const LAS bf16x8*)(cur + (32 * mt + ql) * PK_ST + 32 * ks + 16 * hh); acc = MFMA32(kf, qf[ks], acc); }
#pragma unroll
            for (int e = 0; e < 16; ++e) pk[mt][e] = (f2ord(acc[e]) & 0xFFFFFF80u) | (unsigned)(32 * mt + (e & 3) + 8 * (e >> 2) + 4 * hh);
        }
#pragma unroll
        for (int j = 0; j < 4; ++j) { const int cidx = tid + 512 * j, row = cidx >> 4, ch = cidx & 15; *(LAS u32x4*)(nxt + row * PK_ST + ch * 16) = stg[j]; }
        __syncthreads();
#pragma unroll
        for (int mt = 0; mt < 4; ++mt) bitonic_sort16_desc(pk[mt]);
        top16_merge(pk[0], pk[1]); top16_merge(pk[2], pk[3]); top16_merge(pk[0], pk[2]);
        unsigned other[16];
#pragma unroll
        for (int i = 0; i < 16; ++i) other[i] = (unsigned)__shfl_xor((int)pk[0][i], 32);
        top16_merge(pk[0], other);
        if ((hc & 1) == 0) {
#pragma unroll
            for (int i = 0; i < 16; ++i) k1[i] = pk[0][i];
        } else {
            float f1[16], f2[16];
#pragma unroll
            for (int i = 0; i < 16; ++i) { f1[i] = ord2f(k1[i] & 0xFFFFFF80u); f2[i] = ord2f(pk[0][i] & 0xFFFFFF80u); }
            unsigned cd[4][16];
#pragma unroll
            for (int i = 0; i < 64; ++i) cd[i >> 4][i & 15] = 0u;
            int n = 0;
#pragma unroll
            for (int a = 0; a < 16; ++a)
#pragma unroll
                for (int b = 0; b < 16; ++b)
                    if ((a + 1) * (b + 1) <= 16) { cd[n >> 4][n & 15] = (f2ord(f1[a] + f2[b]) & 0xFFFFC000u) | ((k1[a] & 127u) << 7) | (pk[0][b] & 127u); ++n; }
#pragma unroll
            for (int g4 = 0; g4 < 4; ++g4) bitonic_sort16_desc(cd[g4]);
            top16_merge(cd[0], cd[1]); top16_merge(cd[2], cd[3]); top16_merge(cd[0], cd[2]);
            const float vmax = ord2f(cd[0][0] & 0xFFFFC000u);
            float ex[16], den = 0.f;
#pragma unroll
            for (int i = 0; i < 16; ++i) { ex[i] = __expf(ord2f(cd[0][i] & 0xFFFFC000u) - vmax); den += ex[i]; }
            const float iden = 1.0f / den;
            const int h = hc >> 1;
            if (hh == 0) { int* ip = IDX + tok * 128 + h * 16;
#pragma unroll
                for (int i = 0; i < 4; ++i) { const u32x4 w = {cd[0][4 * i] & 0x3FFFu, cd[0][4 * i + 1] & 0x3FFFu, cd[0][4 * i + 2] & 0x3FFFu, cd[0][4 * i + 3] & 0x3FFFu}; *(u32x4*)(ip + 4 * i) = w; } }
            else { float* gp = GATE + tok * 128 + h * 16;
#pragma unroll
                for (int i = 0; i < 4; ++i) { const f32x4 w = {ex[4 * i] * iden, ex[4 * i + 1] * iden, ex[4 * i + 2] * iden, ex[4 * i + 3] * iden}; *(f32x4*)(gp + 4 * i) = w; } }
        }
    }
}

__device__ __forceinline__ void peer_load16(u32x4 (&buf)[16], const unsigned char* tab, int idv, int li0, int lane) {
#pragma unroll
    for (int j = 0; j < 16; ++j) { const int id = __builtin_amdgcn_readlane(idv, li0 + j); buf[j] = *(const u32x4*)(tab + (size_t)id * DM + 16 * lane); }
}
__device__ __forceinline__ void peer_gather_wave(Frame& F, size_t tokw, const int* IDX, const float* GATE) {
    const unsigned char* PD = F.ws + WS_PD; const unsigned char* PU = F.ws + WS_PU;
    const bf16* HN = (const bf16*)(F.ws + WS_ACT1);
    int lane = F.lane; asm volatile("" : "+v"(lane));
    const int myexp = ((lane >> 5) & 1) * 8 + ((lane >> 4) & 1) * 4 + ((lane >> 3) & 1) * 2 + ((lane >> 2) & 1);
    u32x4 bufA[16], bufB[16];
    int id0 = IDX[tokw * 128 + lane], id1 = IDX[tokw * 128 + 64 + lane];
    peer_load16(bufA, PD, id0, 0, lane);
#pragma unroll 1
    for (int t = 0; t < 32; ++t) {
        const size_t tok = tokw + t, tokn = tokw + (t < 31 ? t + 1 : t);
        const int idn0 = IDX[tokn * 128 + lane], idn1 = IDX[tokn * 128 + 64 + lane];
        const float g0 = GATE[tok * 128 + lane], g1 = GATE[tok * 128 + 64 + lane];
        f32x2 hv[8];
        { const u32x4 ha = *(const u32x4*)(HN + tok * DM + 16 * lane), hb = *(const u32x4*)(HN + tok * DM + 16 * lane + 8);
          hv[0] = (f32x2){bflo(ha.x), bfhi(ha.x)}; hv[1] = (f32x2){bflo(ha.y), bfhi(ha.y)}; hv[2] = (f32x2){bflo(ha.z), bfhi(ha.z)}; hv[3] = (f32x2){bflo(ha.w), bfhi(ha.w)};
          hv[4] = (f32x2){bflo(hb.x), bfhi(hb.x)}; hv[5] = (f32x2){bflo(hb.y), bfhi(hb.y)}; hv[6] = (f32x2){bflo(hb.z), bfhi(hb.z)}; hv[7] = (f32x2){bflo(hb.w), bfhi(hb.w)}; }
        f32x2 out[8];
#pragma unroll
        for (int j = 0; j < 8; ++j) out[j] = (f32x2){0.f, 0.f};
#pragma unroll 1
        for (int head = 0; head < 8; ++head) {
            const int idv = head < 4 ? id0 : id1; const float gv = head < 4 ? g0 : g1; const int lb = (head & 3) * 16;
            peer_load16(bufB, PU, idv, lb, lane);
            float da[16];
#pragma unroll
            for (int j = 0; j < 16; ++j) { const u32x4 r = bufA[j]; f32x2 a0 = {0.f, 0.f}, a1 = {0.f, 0.f};
                a0 = hv[0] * __builtin_amdgcn_cvt_pk_f32_fp8(r.x, false) + a0; a1 = hv[1] * __builtin_amdgcn_cvt_pk_f32_fp8(r.x, true) + a1;
                a0 = hv[2] * __builtin_amdgcn_cvt_pk_f32_fp8(r.y, false) + a0; a1 = hv[3] * __builtin_amdgcn_cvt_pk_f32_fp8(r.y, true) + a1;
                a0 = hv[4] * __builtin_amdgcn_cvt_pk_f32_fp8(r.z, false) + a0; a1 = hv[5] * __builtin_amdgcn_cvt_pk_f32_fp8(r.z, true) + a1;
                a0 = hv[6] * __builtin_amdgcn_cvt_pk_f32_fp8(r.w, false) + a0; a1 = hv[7] * __builtin_amdgcn_cvt_pk_f32_fp8(r.w, true) + a1;
                a0 += a1; da[j] = a0.x + a0.y; }
            float r8[8], r4[4], r2[2], r1;
            { const bool up = (lane & 32) != 0;
#pragma unroll
              for (int k = 0; k < 8; ++k) { const float keep = up ? da[k + 8] : da[k], send = up ? da[k] : da[k + 8]; r8[k] = keep + __shfl_xor(send, 32); } }
            { const bool up = (lane & 16) != 0;
#pragma unroll
              for (int k = 0; k < 4; ++k) { const float keep = up ? r8[k + 4] : r8[k], send = up ? r8[k] : r8[k + 4]; r4[k] = keep + __shfl_xor(send, 16); } }
            { const bool up = (lane & 8) != 0;
#pragma unroll
              for (int k = 0; k < 2; ++k) { const float keep = up ? r4[k + 2] : r4[k], send = up ? r4[k] : r4[k + 2]; r2[k] = keep + __shfl_xor(send, 8); } }
            { const bool up = (lane & 4) != 0; const float keep = up ? r2[1] : r2[0], send = up ? r2[0] : r2[1]; r1 = keep + __shfl_xor(send, 4); }
            r1 += __shfl_xor(r1, 2); r1 += __shfl_xor(r1, 1);
            const float gate = __shfl(gv, lb + myexp);
            const float coef = gate * gelu_erf(r1 * (1.0f / PD_SCALE)) * (1.0f / PU_SCALE);
            { const int idnx = head < 3 ? id0 : (head < 7 ? id1 : idn0); const int lbn = ((head + 1) & 3) * 16; peer_load16(bufA, PD, idnx, lbn, lane); }
#define PEER_LANE_OF(e) ((((e) >> 3) & 1) * 32 + (((e) >> 2) & 1) * 16 + (((e) >> 1) & 1) * 8 + ((e) & 1) * 4)
#pragma unroll
            for (int j = 0; j < 16; ++j) { const float c = __builtin_bit_cast(float, __builtin_amdgcn_readlane(__builtin_bit_cast(int, coef), PEER_LANE_OF(j))); const f32x2 c2 = {c, c}; const u32x4 r = bufB[j];
                out[0] = c2 * __builtin_amdgcn_cvt_pk_f32_fp8(r.x, false) + out[0]; out[1] = c2 * __builtin_amdgcn_cvt_pk_f32_fp8(r.x, true) + out[1];
                out[2] = c2 * __builtin_amdgcn_cvt_pk_f32_fp8(r.y, false) + out[2]; out[3] = c2 * __builtin_amdgcn_cvt_pk_f32_fp8(r.y, true) + out[3];
                out[4] = c2 * __builtin_amdgcn_cvt_pk_f32_fp8(r.z, false) + out[4]; out[5] = c2 * __builtin_amdgcn_cvt_pk_f32_fp8(r.z, true) + out[5];
                out[6] = c2 * __builtin_amdgcn_cvt_pk_f32_fp8(r.w, false) + out[6]; out[7] = c2 * __builtin_amdgcn_cvt_pk_f32_fp8(r.w, true) + out[7]; }
#undef PEER_LANE_OF
        }
        float* op = F.out + tok * DM + 16 * lane;
#pragma unroll
        for (int j = 0; j < 4; ++j) { f32x4 r = *(const f32x4*)(op + 4 * j); r.x += out[2 * j].x; r.y += out[2 * j].y; r.z += out[2 * j + 1].x; r.w += out[2 * j + 1].y; *(f32x4*)(op + 4 * j) = r; }
        id0 = idn0; id1 = idn1;
    }
}
__device__ __forceinline__ void peer_phase(Frame& F) {
    int* IDX = (int*)(F.ws + WS_BIG + 256 * MiB); float* GATE = (float*)(F.ws + WS_BIG + 288 * MiB);
    for (int tile = F.bid; tile < T / 256; tile += F.G) {
        const size_t tok0 = (size_t)tile * 256;
        peer_topk_tile(F, tok0, IDX, GATE);
        VM_WAIT(); __syncthreads();
        peer_gather_wave(F, tok0 + F.wave * 32, IDX, GATE);
    }
}

constexpr int N_PHASES = 15;
__global__ void __launch_bounds__(NTHR, 2) mega_fwd(Args args) {
    extern __shared__ __attribute__((aligned(16))) unsigned char lds_raw[];
    Frame F;
    F.lds = (LAS unsigned char*)lds_raw;
    F.tid = threadIdx.x; F.lane = F.tid & 63; F.wave = __builtin_amdgcn_readfirstlane(F.tid >> 6);
    F.G = gridDim.x; F.bid = blockIdx.x;
#pragma unroll
    for (int i = 0; i < 26; ++i) F.in[i] = args.in[i];
    F.positions = args.positions; F.out = args.out; F.ws = args.ws;
    unsigned char* ws = args.ws;
    volatile LAS unsigned* ctlw = (volatile LAS unsigned*)(F.lds + LDSCTL_OFF);
    if (F.tid < 64) ctlw[F.tid] = 0u;
    __syncthreads();
    const int lo = args.ph_lo, hi = args.ph_hi;
    XcdBarrier bar; bar.bar = (unsigned*)(ws + WS_CTL); bar.x = 0; bar.st = nullptr;
    if (hi - lo > 1) bar = xcd_barrier_post((unsigned*)(ws + WS_CTL), ctlw + 8);
#define IN(k) (lo <= (k) && (k) < hi)
#define SEAM(k) do { if (IN(k) && IN((k) + 1)) xcd_barrier(bar); } while (0)
    bf16* ACT1 = (bf16*)(ws + WS_ACT1); bf16* BIG = (bf16*)(ws + WS_BIG); bf16* WallT = (bf16*)(ws + WS_WALLT);

    if (IN(0)) { p0_prologue(F); __syncthreads(); }
    SEAM(0);
    if (IN(1)) {
        { pg8::Gemm g{(const bf16*)(ws + WS_MEMN), (const bf16*)(ws + WS_WMKVT), NB * NMEM, 768, DM, DM, DM}; pg8::StaticOrder S; S.init(g.M, g.N, F.G, F.bid);
          pg8::EpiBf16<0> E{(bf16*)(ws + WS_MKV), 1536}; pg8::gemm_phase(F.lds, g, S, E); }
        { pg8::Gemm g{(const bf16*)(ws + WS_WMKVT) + (size_t)768 * DM, (const bf16*)(ws + WS_MEMN), 768, NB * NMEM, DM, DM, DM}; pg8::StaticOrder S; S.init(g.M, g.N, F.G, F.G - 1 - F.bid);
          pg8::EpiBf16<0> E{(bf16*)(ws + WS_MVT), NB * NMEM}; pg8::gemm_phase(F.lds, g, S, E); }
        { pg8::Gemm g{ACT1, WallT, HT, NPROJ, DM, DM, DM}; pg8::StaticOrder S; S.init(g.M, g.N, F.G, F.bid);
          pg8::EpiBf16<0> E{BIG, NPROJ}; pg8::gemm_phase(F.lds, g, S, E); }
    }
    SEAM(1);
    if (IN(2)) { qkprep_phase(F, 0); ssdC_phase(F, 0); }
    SEAM(2);
    if (IN(3)) { ssdD_phase(F); dilattn_mfma_phase(F, 0); memattn_mfma_phase(F, 0); }
    SEAM(3);
    if (IN(4)) { ssdE_phase(F, 0); dilmerge_phase(F, 0); }
    SEAM(4);
    if (IN(5)) { pg8::Gemm g{ACT1 + (size_t)HT * DM, WallT, HT, NPROJ, DM, DM, DM}; pg8::StaticOrder S; S.init(g.M, g.N, F.G, F.bid);
        pg8::EpiBf16<0> E{BIG, NPROJ}; pg8::gemm_phase(F.lds, g, S, E); }
    SEAM(5);
    if (IN(6)) { qkprep_phase(F, 1); ssdC_phase(F, 1); }
    SEAM(6);
    if (IN(7)) { ssdD_phase(F); dilattn_mfma_phase(F, 1); memattn_mfma_phase(F, 1); }
    SEAM(7);
    if (IN(8)) { ssdE_phase(F, 1); dilmerge_phase(F, 1); }
    SEAM(8);
    if (IN(9)) { pg8::Gemm g{ACT1, WallT + (size_t)NPROJ * DM, T, NGATE, DM, DM, DM}; pg8::StaticOrder S; S.init(g.M, g.N, F.G, F.bid);
        pg8::EpiBf16<1> E{BIG, NGATE}; pg8::gemm_phase(F.lds, g, S, E); }
    SEAM(9);
    if (IN(10)) {
        const bf16* Yc = (const bf16*)F.out; const bf16* Wc = (const bf16*)(ws + WS_WCATT);
        { pg8::Gemm g{Yc, Wc, T, DM, 1024, YC, YC}; pg8::StaticOrder S; S.init(g.M, g.N, F.G, F.bid); pg8::EpiBranch<false> E{ACT1, DM, BIG, NGATE, 0}; pg8::gemm_phase(F.lds, g, S, E); }
        { pg8::Gemm g{Yc + 1024, Wc + 1024, T, DM, 256, YC, YC}; pg8::StaticOrder S; S.init(g.M, g.N, F.G, F.bid); pg8::EpiBranch<true> E{ACT1, DM, BIG, NGATE, 1024}; pg8::gemm_phase(F.lds, g, S, E); }
        { pg8::Gemm g{Yc + 1280, Wc + 1280, T, DM, 768, YC, YC}; pg8::StaticOrder S; S.init(g.M, g.N, F.G, F.bid); pg8::EpiBranch<true> E{ACT1, DM, BIG, NGATE, 2048}; pg8::gemm_phase(F.lds, g, S, E); }
    }
    SEAM(10);
    if (IN(11)) { pg8::Gemm g{ACT1, (const bf16*)(ws + WS_WOUTT), T, DM, DM, DM, DM}; pg8::StaticOrder S; S.init(g.M, g.N, F.G, F.bid);
        pg8::EpiResid E{F.out, DM, F.in[I_X]}; pg8::gemm_phase(F.lds, g, S, E); }
    SEAM(11);
    if (IN(12)) hn_phase(F);
    SEAM(12);
    if (IN(13)) { pg8::Gemm g{ACT1, (const bf16*)(ws + WS_WQT), T, PEER_Q, DM, DM, DM}; pg8::StaticOrder S; S.init(g.M, g.N, F.G, F.bid);
        pg8::EpiBf16<0> E{BIG, PEER_Q}; pg8::gemm_phase(F.lds, g, S, E); }
    SEAM(13);
    if (IN(14)) peer_phase(F);
#undef IN
#undef SEAM
}

extern "C" void kernel_launch(void* const* d_in, const int* in_sizes, int n_in, void* d_out, int out_size, void* d_ws, size_t ws_size, hipStream_t stream) {
    static int grid = 0;
    if (grid == 0) {
        if (n_in != 26 || out_size != T * DM || ws_size < WS_END) { fprintf(stderr, "kernel_launch: unexpected shapes (n_in %d, out %d, ws %zu)\n", n_in, out_size, ws_size); grid = -1; return; }
        int dev = 0, cus = 0;
        if (hipGetDevice(&dev) != hipSuccess || hipDeviceGetAttribute(&cus, hipDeviceAttributeMultiprocessorCount, dev) != hipSuccess) { grid = -1; return; }
        if (hipFuncSetAttribute((const void*)mega_fwd, hipFuncAttributeMaxDynamicSharedMemorySize, LDS_BYTES) != hipSuccess) { grid = -1; return; }
        int per_cu = 0;
        (void)hipOccupancyMaxActiveBlocksPerMultiprocessor(&per_cu, (const void*)mega_fwd, NTHR, LDS_BYTES);
        (void)hipGetLastError();
        grid = cus;
    }
    if (grid < 0) return;
    (void)hipMemsetAsync((char*)d_ws + WS_CTL, 0, CTL_ZERO_BYTES, stream);
    Args a{};
    for (int i = 0; i < 26; ++i) a.in[i] = (const float*)d_in[i];
    a.positions = (const int*)d_in[2]; a.out = (float*)d_out; a.ws = (unsigned char*)d_ws;
#if MK_N_LAUNCHES == 1
    a.ph_lo = 0; a.ph_hi = N_PHASES;
    hipLaunchKernelGGL(mega_fwd, dim3(grid), dim3(NTHR), LDS_BYTES, stream, a);
#else
    for (int p = 0; p < N_PHASES; ++p) { a.ph_lo = p; a.ph_hi = p + 1; hipLaunchKernelGGL(mega_fwd, dim3(grid), dim3(NTHR), LDS_BYTES, stream, a); }
#endif
}
```

```cpp
#include <hip/hip_runtime.h>
#include <cstdio>
#include <cstdint>

#ifndef MK_N_LAUNCHES
#define MK_N_LAUNCHES 1
#endif

#define LAS __attribute__((address_space(3)))
#define GAS __attribute__((address_space(1)))
typedef unsigned short bf16;
typedef short bf16x8 __attribute__((ext_vector_type(8)));
typedef float f32x4 __attribute__((ext_vector_type(4)));
typedef float f32x2 __attribute__((ext_vector_type(2)));
typedef unsigned u32x4 __attribute__((ext_vector_type(4)));
typedef unsigned u32x2 __attribute__((ext_vector_type(2)));

constexpr int NB = 8, SEQ = 8192, DM = 1024, T = NB * SEQ;
constexpr int HB = 4, HT = HB * SEQ;
constexpr int NMEM = 256;
constexpr int NPROJ = 6144;
constexpr int PC_Z = 0, PC_X = 1024, PC_B = 2048, PC_C = 2560, PC_DQ = 3072, PC_DK = 3840, PC_DV = 4608, PC_MQ = 5376;
constexpr int W_IN_N = 9232, OFF_DT = 3072, OFF_AFTER_DT = 3088;
constexpr int NGATE = 3072;
constexpr int YC = 2048;
constexpr int PEER_H = 8, PEER_K = 16, PEER_NK = 128, PEER_Q = 2048;
constexpr float EPS = 1e-6f;

constexpr size_t MiB = 1u << 20;
constexpr size_t WS_CTL = 0, CTL_ZERO_BYTES = 65536;
constexpr size_t WS_WALLT = 1 * MiB;
constexpr size_t WS_WMKVT = 19 * MiB;
constexpr size_t WS_WCATT = 22 * MiB;
constexpr size_t WS_WOUTT = 26 * MiB;
constexpr size_t WS_WQT = 28 * MiB;
constexpr size_t WS_SUBK = 32 * MiB;
constexpr size_t WS_PD = 33 * MiB;
constexpr size_t WS_PU = 65 * MiB;
constexpr size_t WS_DT = 97 * MiB;
constexpr size_t WS_MEMN = 101 * MiB;
constexpr size_t WS_MKV = 105 * MiB;
constexpr size_t WS_ACT1 = 112 * MiB;
constexpr size_t WS_BIG = 240 * MiB;
constexpr size_t WS_LSE = 624 * MiB;
constexpr size_t WS_MVT = 628 * MiB;
constexpr size_t WS_DEC = 631 * MiB;
constexpr size_t WS_SST = 632 * MiB;
constexpr size_t WS_SIN = 760 * MiB;
constexpr size_t WS_END = 824 * MiB;

constexpr int RING_BYTES = 131072;
constexpr int LDSCTL_OFF = 143360;
constexpr int LDS_BYTES = 147456;
constexpr int NWAVES = 8, NTHR = 512;

__device__ __forceinline__ float bf2f(unsigned short b) { return __builtin_bit_cast(float, (unsigned)b << 16); }
__device__ __forceinline__ float bflo(unsigned w) { return __builtin_bit_cast(float, w << 16); }
__device__ __forceinline__ float bfhi(unsigned w) { return __builtin_bit_cast(float, w & 0xffff0000u); }
__device__ __forceinline__ unsigned f2bf(float f) { unsigned u = __builtin_bit_cast(unsigned, f); return (u + 0x7fffu + ((u >> 16) & 1u)) >> 16; }
__device__ __forceinline__ unsigned pk2(float lo, float hi) { return f2bf(lo) | (f2bf(hi) << 16); }
typedef float f32x16 __attribute__((ext_vector_type(16)));
typedef short s16x4 __attribute__((ext_vector_type(4)));
typedef __bf16 bf2_t __attribute__((ext_vector_type(2)));
__device__ __forceinline__ unsigned pkbf(float a, float b) { const f32x2 v = {a, b}; return __builtin_bit_cast(unsigned, __builtin_convertvector(v, bf2_t)); }
#define MFMA32(a, b, c) __builtin_amdgcn_mfma_f32_32x32x16_bf16((a), (b), (c), 0, 0, 0)
__device__ __forceinline__ float wave_sum(float v) {
#pragma unroll
    for (int o = 1; o < 64; o <<= 1) v += __shfl_xor(v, o);
    return v;
}
__device__ __forceinline__ float wave_max(float v) {
#pragma unroll
    for (int o = 1; o < 64; o <<= 1) v = fmaxf(v, __shfl_xor(v, o));
    return v;
}
__device__ __forceinline__ float sigmoidf_(float x) { return 1.0f / (1.0f + __expf(-x)); }
#define LDS_WAIT() asm volatile("s_waitcnt lgkmcnt(0)" ::: "memory")
#define VM_WAIT() asm volatile("s_waitcnt vmcnt(0)" ::: "memory")

#define XB_TMO      128
#define XB_XCNT(j)  (256  + 64 * (j))
#define XB_XSUB(j)  (1280 + 64 * (j))
#define XB_XGEN(j)  (2304 + 64 * (j))
#define XB_TOP      3328
#define XB_TOPGEN   3392
#define XCD_BAR_WORDS 3456
#define XB_SPIN_CAP (1u << 18)
__device__ __forceinline__ unsigned xb_ld(unsigned* p)              { return __hip_atomic_load(p, __ATOMIC_RELAXED, __HIP_MEMORY_SCOPE_AGENT); }
__device__ __forceinline__ unsigned xb_add(unsigned* p, unsigned v) { return __hip_atomic_fetch_add(p, v, __ATOMIC_RELAXED, __HIP_MEMORY_SCOPE_AGENT); }
__device__ __forceinline__ unsigned xb_xcc_id() { return (unsigned)__builtin_amdgcn_s_getreg((3 << 11) | 20) & 0xFu; }
#define XB_SPIN(cond, bar) do { unsigned _sp = 0; while (cond) { __builtin_amdgcn_s_sleep(1); \
    if ((++_sp & 255u) == 0u) { if (xb_ld(&(bar)[XB_TMO])) break; if (_sp > XB_SPIN_CAP) { atomicAdd(&(bar)[XB_TMO], 1u); break; } } } } while (0)
struct XcdBarrier { unsigned* bar; unsigned x; volatile LAS unsigned* st; };
__device__ __forceinline__ XcdBarrier xcd_barrier_post(unsigned* bar, volatile LAS unsigned* st) {
    XcdBarrier b; b.bar = bar; b.x = xb_xcc_id(); b.st = st;
    if (threadIdx.x == 0) (void)xb_add(&bar[XB_XCNT(b.x)], 1u);
    return b;
}
__device__ __forceinline__ void xcd_barrier_complete(unsigned* bar, unsigned x, unsigned& nloc, unsigned& nx) {
    const unsigned G = gridDim.x * gridDim.y * gridDim.z;
    unsigned sum, cnt, mine, sp = 0u;
    for (;;) {
        sum = 0u; cnt = 0u; mine = 0u;
#pragma unroll
        for (unsigned j = 0; j < 16; ++j) { const unsigned c = xb_ld(&bar[XB_XCNT(j)]); sum += c; cnt += (c > 0u) ? 1u : 0u; mine = (j == x) ? c : mine; }
        if (sum == G) break;
        __builtin_amdgcn_s_sleep(1);
        if ((++sp & 255u) == 0u) { if (xb_ld(&bar[XB_TMO])) break; if (sp > XB_SPIN_CAP) { atomicAdd(&bar[XB_TMO], 1u); break; } }
    }
    nloc = mine > 0u ? mine : 1u; nx = cnt > 0u ? cnt : 1u;
}
__device__ __forceinline__ void xcd_barrier(const XcdBarrier& b) {
    asm volatile("s_waitcnt vmcnt(0)" ::: "memory");
    __syncthreads();
    if (threadIdx.x == 0) {
        unsigned* bar = b.bar;
        __builtin_amdgcn_s_waitcnt(0);
        unsigned nloc = b.st[0], nx = b.st[1];
        if (nloc == 0u) { xcd_barrier_complete(bar, b.x, nloc, nx); b.st[0] = nloc; b.st[1] = nx; }
        const unsigned old = xb_add(&bar[XB_XSUB(b.x)], 1u);
        const unsigned gen = old / nloc;
        if (old + 1u == (gen + 1u) * nloc) {
            __builtin_amdgcn_fence(__ATOMIC_RELEASE, "agent");
            asm volatile("s_waitcnt vmcnt(0)" ::: "memory");
            const unsigned og = xb_add(&bar[XB_TOP], 1u);
            const unsigned tg = og / nx;
            if (og + 1u == (tg + 1u) * nx) xb_add(&bar[XB_TOPGEN], 1u);
            else XB_SPIN(xb_ld(&bar[XB_TOPGEN]) == tg, bar);
            __builtin_amdgcn_fence(__ATOMIC_ACQUIRE, "agent");
            xb_add(&bar[XB_XGEN(b.x)], 1u);
            asm volatile("s_waitcnt vmcnt(0)" ::: "memory");
        } else {
            XB_SPIN(xb_ld(&bar[XB_XGEN(b.x)]) == gen, bar);
            __builtin_amdgcn_fence(__ATOMIC_ACQUIRE, "agent");
            asm volatile("s_waitcnt vmcnt(0)" ::: "memory");
        }
    }
    __syncthreads();
}

namespace pg8 {
constexpr int BM = 256, BK = 64, HALF = 128, HTB = HALF * BK * 2, STAGE_BYTES = 8 * HTB, NXCD = 8, WGM = 8;
__host__ __device__ __forceinline__ int lds_byte(int r, int c) { const int st = (r >> 4) * 2 + (c >> 5), rr = r & 15, cc = c & 31, ob = rr * 64 + cc * 2; return st * 1024 + (ob ^ (((ob >> 9) & 1) << 5)); }
__host__ __device__ __forceinline__ void stage_rc(int b, int& R, int& C) { const int st = b / 1024, sb = b % 1024, swz = sb ^ (((sb >> 9) & 1) << 5); R = (st >> 1) * 16 + swz / 64; C = (st & 1) * 32 + (swz % 64) / 2; }
__host__ __device__ __forceinline__ int perm32(int rho) { const int n = rho >> 4, i = rho & 15; return 8 * (i >> 2) + 4 * n + (i & 3); }
struct Unit { int pm, pn; };
struct Gemm { const bf16* A; const bf16* Bt; int M, N, K, lda, ldb; };
struct StaticOrder {
    int nM, nN, nwg, G, c;
    __host__ __device__ void init(int M, int N, int G_, int c_) { nM = M / BM; nN = N / BM; nwg = nM * nN; G = G_; c = c_; }
    __host__ __device__ bool next(int i, Unit& u) const {
        const long L = (long)i * G + c; if (L >= nwg) return false;
        int wgid = (int)L; { const int q = nwg / NXCD, r = nwg % NXCD, xcd = wgid % NXCD, off = wgid / NXCD; wgid = (xcd < r ? xcd * (q + 1) : r * (q + 1) + (xcd - r) * q) + off; }
        const int nig = WGM * nN, gid = wgid / nig, fm = gid * WGM, gsz = (nM - fm) < WGM ? (nM - fm) : WGM;
        u.pm = fm + ((wgid % nig) % gsz); u.pn = (wgid % nig) / gsz; return true;
    }
    __device__ __forceinline__ void a_ready(const Unit&) const {}
    __device__ __forceinline__ void done(const Unit&) const {}
};
__device__ __forceinline__ unsigned cvt_pk_bf16(float lo, float hi) { unsigned r; asm volatile("v_cvt_pk_bf16_f32 %0, %1, %2" : "=v"(r) : "v"(lo), "v"(hi)); return r; }

template <int ACT> struct EpiBf16 {
    static constexpr bool PERM = true, AFTER_DRAIN = false;
    bf16* O; int ldc;
    __device__ __forceinline__ void operator()(const f32x4 (&acc)[2][2][4][2], const Unit& u, int wr, int wc, int fr, int fq) const {
        const int row0 = u.pm * BM + wr * 64 + fr; const int col0 = u.pn * BM + wc * 32 + 8 * fq;
#pragma unroll
        for (int ai = 0; ai < 2; ++ai)
#pragma unroll
            for (int m = 0; m < 4; ++m) { bf16* rowp = O + (size_t)(row0 + ai * HALF + m * 16) * ldc + col0;
#pragma unroll
                for (int bj = 0; bj < 2; ++bj) { f32x4 v0 = acc[ai][bj][m][0], v1 = acc[ai][bj][m][1];
                    if (ACT == 1) {
#pragma unroll
                        for (int j = 0; j < 4; ++j) { v0[j] = sigmoidf_(v0[j]); v1[j] = sigmoidf_(v1[j]); } }
                    u32x4 w; w.x = cvt_pk_bf16(v0[0], v0[1]); w.y = cvt_pk_bf16(v0[2], v0[3]); w.z = cvt_pk_bf16(v1[0], v1[1]); w.w = cvt_pk_bf16(v1[2], v1[3]);
                    *(u32x4*)(rowp + bj * HALF) = w; } }
    }
};
template <bool ACCUM> struct EpiBranch {
    static constexpr bool PERM = true, AFTER_DRAIN = false;
    bf16* O; int ldc; const bf16* Gt; int ldg; int gcol0;
    __device__ __forceinline__ void operator()(const f32x4 (&acc)[2][2][4][2], const Unit& u, int wr, int wc, int fr, int fq) const {
        const int row0 = u.pm * BM + wr * 64 + fr; const int col0 = u.pn * BM + wc * 32 + 8 * fq;
#pragma unroll
        for (int ai = 0; ai < 2; ++ai)
#pragma unroll
            for (int m = 0; m < 4; ++m) { const size_t r = (size_t)(row0 + ai * HALF + m * 16); bf16* rowp = O + r * ldc + col0; const bf16* gp = Gt + r * ldg + gcol0 + col0;
#pragma unroll
                for (int bj = 0; bj < 2; ++bj) { const f32x4 v0 = acc[ai][bj][m][0], v1 = acc[ai][bj][m][1];
                    const u32x4 g = *(const u32x4*)(gp + bj * HALF);
                    float o[8];
                    o[0] = v0[0] * bflo(g.x); o[1] = v0[1] * bfhi(g.x); o[2] = v0[2] * bflo(g.y); o[3] = v0[3] * bfhi(g.y);
                    o[4] = v1[0] * bflo(g.z); o[5] = v1[1] * bfhi(g.z); o[6] = v1[2] * bflo(g.w); o[7] = v1[3] * bfhi(g.w);
                    if (ACCUM) { const u32x4 p = *(const u32x4*)(rowp + bj * HALF);
                        o[0] += bflo(p.x); o[1] += bfhi(p.x); o[2] += bflo(p.y); o[3] += bfhi(p.y); o[4] += bflo(p.z); o[5] += bfhi(p.z); o[6] += bflo(p.w); o[7] += bfhi(p.w); }
                    u32x4 w; w.x = cvt_pk_bf16(o[0], o[1]); w.y = cvt_pk_bf16(o[2], o[3]); w.z = cvt_pk_bf16(o[4], o[5]); w.w = cvt_pk_bf16(o[6], o[7]);
                    *(u32x4*)(rowp + bj * HALF) = w; } }
    }
};
struct EpiResid {
    static constexpr bool PERM = false, AFTER_DRAIN = false;
    float* C; int ldc; const float* R;
    __device__ __forceinline__ void operator()(const f32x4 (&acc)[2][2][4][2], const Unit& u, int wr, int wc, int fr, int fq) const {
        const int row0 = u.pm * BM + wr * 64 + fr, col0 = u.pn * BM + wc * 32 + 4 * fq;
#pragma unroll
        for (int ai = 0; ai < 2; ++ai)
#pragma unroll
            for (int m = 0; m < 4; ++m) { const size_t off = (size_t)(row0 + ai * HALF + m * 16) * ldc + col0;
#pragma unroll
                for (int bj = 0; bj < 2; ++bj)
#pragma unroll
                    for (int n = 0; n < 2; ++n) { const f32x4 r = *(const f32x4*)(R + off + bj * HALF + n * 16); *(f32x4*)(C + off + bj * HALF + n * 16) = acc[ai][bj][m][n] + r; } }
    }
};

template <class Epi, class Sched>
__device__ __forceinline__ void gemm_phase(LAS unsigned char* lds, const Gemm g, const Sched& S, const Epi& E) {
    const int tid = threadIdx.x, wid = __builtin_amdgcn_readfirstlane(tid >> 6), lane = tid & 63, wr = wid >> 2, wc = wid & 3, fr = lane & 15, fq = lane >> 4;
    const int K = g.K, nt = K / BK;
    unsigned voffA[2], voffB[2];
#pragma unroll
    for (int i = 0; i < 2; ++i) { int R, C; stage_rc(tid * 16 + i * 8192, R, C); const int Rb = Epi::PERM ? ((R & ~31) + perm32(R & 31)) : R;
        voffA[i] = (unsigned)(R * g.lda + C) * 2u; voffB[i] = (unsigned)(Rb * g.ldb + C) * 2u; }
    const size_t kstep = (size_t)(BK * 2);
    const size_t hsA = (size_t)HALF * g.lda * 2, hsB = (size_t)HALF * g.ldb * 2;
    const size_t tsA = 2 * hsA, tsB = 2 * hsB;
    const unsigned ldsw = (unsigned)wid * 1024u;
    const int aoff = lds_byte(wr * 64 + fr, fq * 8), boff = lds_byte(wc * 32 + fr, fq * 8);
#define PG8_SA(b, h) (((b) * 2 + (h)) * HTB)
#define PG8_SB(b, h) ((4 + (b) * 2 + (h)) * HTB)
#define PG8_STAGE(bufoff, gbase, voff) do { _Pragma("unroll") for (int _i = 0; _i < 2; ++_i) \
        __builtin_amdgcn_global_load_lds((const unsigned*)((const char*)(gbase) + (voff)[_i]), (LAS unsigned*)(lds + (bufoff) + ldsw + _i * 8192), 16, 0, 0); } while (0)
#define PG8_LDA(dst, b, h) do { _Pragma("unroll") for (int m = 0; m < 4; ++m) _Pragma("unroll") for (int k = 0; k < 2; ++k) dst[m][k] = *(const LAS bf16x8*)(lds + PG8_SA(b, h) + aoff + m * 2048 + k * 1024); } while (0)
#define PG8_LDB(dst, b, h) do { _Pragma("unroll") for (int n = 0; n < 2; ++n) _Pragma("unroll") for (int k = 0; k < 2; ++k) dst[n][k] = *(const LAS bf16x8*)(lds + PG8_SB(b, h) + boff + n * 2048 + k * 1024); } while (0)
#define PG8_MMA(ai, bj, At, Bt) do { __builtin_amdgcn_s_setprio(1); _Pragma("unroll") for (int m = 0; m < 4; ++m) _Pragma("unroll") for (int n = 0; n < 2; ++n) _Pragma("unroll") for (int k = 0; k < 2; ++k) \
        acc[ai][bj][m][n] = __builtin_amdgcn_mfma_f32_16x16x32_bf16(Bt[n][k], At[m][k], acc[ai][bj][m][n], 0, 0, 0); __builtin_amdgcn_s_setprio(0); } while (0)
#define PG8_WAIT_V(n) asm volatile("s_waitcnt vmcnt(" #n ")" ::: "memory")
#define PG8_WAIT_L(n) asm volatile("s_waitcnt lgkmcnt(" #n ")" ::: "memory")
#define PG8_BAR __builtin_amdgcn_s_barrier()
#define PG8_SCHED __builtin_amdgcn_sched_barrier(0)
    Unit cur, nxt; int ui = 0;
    if (!S.next(0, cur)) return;
    f32x4 acc[2][2][4][2];
#pragma unroll
    for (int a = 0; a < 2; ++a)
#pragma unroll
        for (int b = 0; b < 2; ++b)
#pragma unroll
            for (int m = 0; m < 4; ++m)
#pragma unroll
                for (int n = 0; n < 2; ++n) acc[a][b][m][n] = (f32x4){0.f, 0.f, 0.f, 0.f};
    bf16x8 At[4][2], B0[2][2], B1[2][2];
    const char* cA = (const char*)g.A + (size_t)cur.pm * tsA; const char* cB = (const char*)g.Bt + (size_t)cur.pn * tsB;
    S.a_ready(cur);
    PG8_STAGE(PG8_SB(0, 0), cB, voffB); PG8_STAGE(PG8_SA(0, 0), cA, voffA); PG8_STAGE(PG8_SB(0, 1), cB + hsB, voffB); PG8_STAGE(PG8_SA(0, 1), cA + hsA, voffA);
    if (wr == 1) PG8_BAR;
    PG8_WAIT_V(4); PG8_BAR;
    PG8_STAGE(PG8_SB(1, 0), cB + kstep, voffB); PG8_STAGE(PG8_SA(1, 0), cA + kstep, voffA); PG8_STAGE(PG8_SB(1, 1), cB + hsB + kstep, voffB);
    PG8_WAIT_V(6); PG8_BAR;
    for (;;) {
        const bool has_next = S.next(ui + 1, nxt);
        const char* nA = has_next ? (const char*)g.A + (size_t)nxt.pm * tsA : cA; const char* nB = has_next ? (const char*)g.Bt + (size_t)nxt.pn * tsB : cB;
        for (int t = 0; t < nt; t += 2) {
            const bool last = (t == nt - 2);
            const char* a1 = cA + (size_t)(t + 1) * kstep;
            const char* a2 = last ? nA : cA + (size_t)(t + 2) * kstep; const char* b2 = last ? nB : cB + (size_t)(t + 2) * kstep;
            const char* a3 = a2 + kstep; const char* b3 = b2 + kstep;
            if (last && has_next) S.a_ready(nxt);
            PG8_LDB(B0, 0, 0); PG8_SCHED; PG8_LDA(At, 0, 0); PG8_STAGE(PG8_SA(1, 1), a1 + hsA, voffA);
            PG8_WAIT_L(8); PG8_BAR; PG8_WAIT_L(0); PG8_MMA(0, 0, At, B0); PG8_BAR; PG8_SCHED;
            PG8_LDB(B1, 0, 1); PG8_STAGE(PG8_SB(0, 0), b2, voffB);
            PG8_BAR; PG8_WAIT_L(0); PG8_MMA(0, 1, At, B1); PG8_BAR;
            PG8_LDA(At, 0, 1); PG8_STAGE(PG8_SA(0, 0), a2, voffA);
            PG8_BAR; PG8_WAIT_L(0); PG8_MMA(1, 0, At, B0); PG8_BAR; PG8_SCHED;
            PG8_STAGE(PG8_SB(0, 1), b2 + hsB, voffB);
            PG8_WAIT_V(6); PG8_BAR; PG8_MMA(1, 1, At, B1); PG8_BAR;
            PG8_LDB(B0, 1, 0); PG8_SCHED; PG8_LDA(At, 1, 0); PG8_STAGE(PG8_SA(0, 1), a2 + hsA, voffA);
            PG8_WAIT_L(8); PG8_BAR; PG8_WAIT_L(0); PG8_MMA(0, 0, At, B0); PG8_BAR; PG8_SCHED;
            PG8_LDB(B1, 1, 1); PG8_STAGE(PG8_SB(1, 0), b3, voffB);
            PG8_BAR; PG8_WAIT_L(0); PG8_MMA(0, 1, At, B1); PG8_BAR;
            PG8_LDA(At, 1, 1); PG8_STAGE(PG8_SA(1, 0), a3, voffA);
            PG8_BAR; PG8_WAIT_L(0); PG8_MMA(1, 0, At, B0); PG8_BAR; PG8_SCHED;
            PG8_STAGE(PG8_SB(1, 1), b3 + hsB, voffB);
            PG8_WAIT_V(6); PG8_BAR; PG8_MMA(1, 1, At, B1); PG8_BAR;
        }
        E(acc, cur, wr, wc, fr, fq); S.done(cur);
        if (!has_next) break;
#pragma unroll
        for (int a = 0; a < 2; ++a)
#pragma unroll
            for (int b = 0; b < 2; ++b)
#pragma unroll
                for (int m = 0; m < 4; ++m)
#pragma unroll
                    for (int n = 0; n < 2; ++n) acc[a][b][m][n] = (f32x4){0.f, 0.f, 0.f, 0.f};
        cur = nxt; cA = nA; cB = nB; ++ui;
    }
    PG8_WAIT_V(0);
    if (wr == 0) PG8_BAR;
    PG8_BAR;
#undef PG8_SA
#undef PG8_SB
#undef PG8_STAGE
#undef PG8_LDA
#undef PG8_LDB
#undef PG8_MMA
#undef PG8_WAIT_V
#undef PG8_WAIT_L
#undef PG8_BAR
#undef PG8_SCHED
}
}

#ifndef PROBE
#define PROBE 0
#endif
struct Args {
    const float* in[26]; const int* positions; float* out; unsigned char* ws; int ph_lo, ph_hi; int pad0, pad1;
};
struct Frame {
    LAS unsigned char* lds;
    int tid, lane, wave, G, bid;
    const float* in[26]; const int* positions; float* out; unsigned char* ws;
};
enum { I_X = 0, I_MEM = 1, I_POS = 2, I_NMIXW = 3, I_WIN = 4, I_CONVW = 5, I_CONVB = 6, I_DTB = 7, I_ALOG = 8, I_SSDD = 9, I_SSDNW = 10, I_DQNW = 11, I_DKNW = 12, I_MEMNW = 13,
       I_WMKV = 14, I_MQNW = 15, I_MKNW = 16, I_WSSD = 17, I_WDIL = 18, I_WMEMBR = 19, I_WOUT = 20, I_NFFNW = 21, I_WQ = 22, I_SUBK = 23, I_PD = 24, I_PU = 25 };

__device__ __forceinline__ void p0_transpose_item(const float* W, int ldw, int src_col0, bf16* WT, int ldt, int dst_row0, int dst_col0, int nblk, LAS float* scr, int item, int lane) {
    const int kb = item / nblk, nb = item % nblk, k0 = 64 * kb, n0 = 32 * nb;
#pragma unroll 8
    for (int i = 0; i < 32; ++i) { const int kk = 2 * i + (lane >> 5); scr[kk * 33 + (lane & 31)] = W[(size_t)(k0 + kk) * ldw + src_col0 + n0 + (lane & 31)]; }
    LDS_WAIT(); asm volatile("" ::: "memory");
    const int c = lane & 7;
#pragma unroll
    for (int j = 0; j < 4; ++j) { const int n = (lane >> 3) + 8 * j; const LAS float* s = scr + (8 * c) * 33 + n;
        u32x4 o; o.x = pk2(s[0 * 33], s[1 * 33]); o.y = pk2(s[2 * 33], s[3 * 33]); o.z = pk2(s[4 * 33], s[5 * 33]); o.w = pk2(s[6 * 33], s[7 * 33]);
        *(u32x4*)(WT + (size_t)(dst_row0 + n0 + n) * ldt + dst_col0 + k0 + 8 * c) = o; }
    LDS_WAIT(); asm volatile("" ::: "memory");
}
__device__ __forceinline__ void rms_row_to_bf16(const float* xrow, const float* w, bf16* orow, int lane, f32x4 (&v)[4]) {
    const f32x4* xr = (const f32x4*)xrow + lane; const f32x4* wr = (const f32x4*)w + lane;
    float s = 0.f;
#pragma unroll
    for (int j = 0; j < 4; ++j) { v[j] = xr[64 * j]; s += (v[j].x * v[j].x + v[j].y * v[j].y) + (v[j].z * v[j].z + v[j].w * v[j].w); }
    const float rstd = 1.0f / sqrtf(wave_sum(s) * (1.f / DM) + EPS);
    unsigned long long* o8 = (unsigned long long*)orow + lane;
#pragma unroll
    for (int j = 0; j < 4; ++j) { const f32x4 ww = wr[64 * j]; v[j] = v[j] * rstd * ww;
        o8[64 * j] = (unsigned long long)pk2(v[j].x, v[j].y) | ((unsigned long long)pk2(v[j].z, v[j].w) << 32); }
}
__device__ __forceinline__ void cvt_f32_bf16_stream(const float* src, bf16* dst, size_t n, size_t gtid, size_t gthreads) {
    for (size_t i = gtid * 8; i < n; i += gthreads * 8) { const f32x4 a = *(const f32x4*)(src + i), b = *(const f32x4*)(src + i + 4);
        u32x4 o; o.x = pk2(a.x, a.y); o.y = pk2(a.z, a.w); o.z = pk2(b.x, b.y); o.w = pk2(b.z, b.w); *(u32x4*)(dst + i) = o; }
}
constexpr float PD_SCALE = 64.0f, PU_SCALE = 8.0f;
__device__ __forceinline__ unsigned pk4_fp8(f32x4 v, float sc) {
    const float a = fminf(fmaxf(v.x * sc, -448.f), 448.f), b = fminf(fmaxf(v.y * sc, -448.f), 448.f), c = fminf(fmaxf(v.z * sc, -448.f), 448.f), d = fminf(fmaxf(v.w * sc, -448.f), 448.f);
    unsigned p = __builtin_amdgcn_cvt_pk_fp8_f32(a, b, 0, false); return __builtin_amdgcn_cvt_pk_fp8_f32(c, d, p, true);
}
__device__ __forceinline__ void cvt_f32_fp8_sliced(const float* src, unsigned char* dst, float sc, size_t gtid, size_t gthreads) {
    for (size_t i = gtid * 16; i < (size_t)16384 * 1024; i += gthreads * 16) { const f32x4 a = *(const f32x4*)(src + i), b = *(const f32x4*)(src + i + 4), c = *(const f32x4*)(src + i + 8), d = *(const f32x4*)(src + i + 12);
        const size_t e = i >> 10, dd = i & 1023;
        const u32x4 o = {pk4_fp8(a, sc), pk4_fp8(b, sc), pk4_fp8(c, sc), pk4_fp8(d, sc)}; *(u32x4*)(dst + ((((dd >> 7) * 16384 + e) << 7) + (dd & 127))) = o; }
}
__device__ __forceinline__ void p0_prologue(Frame& F) {
    LAS float* scr = (LAS float*)(F.lds + F.wave * 8448);
    LAS float* wdt = (LAS float*)(F.lds + 8 * 8448);
    const int gw = F.bid * NWAVES + F.wave, NGW = F.G * NWAVES;
    unsigned char* ws = F.ws;
    for (int i = F.tid; i < 1024 * 16; i += NTHR) wdt[i] = F.in[I_WIN][(size_t)(i >> 4) * W_IN_N + OFF_DT + (i & 15)];
    __syncthreads();
    constexpr int IT_A = 16 * 96, IT_B = 16 * 192, IT_MKV = 16 * 48, IT_SSD = 16 * 32, IT_DIL = 4 * 32, IT_MBR = 12 * 32, IT_OUT = 16 * 32, IT_WQ = 16 * 64;
    constexpr int NITEMS = IT_A + IT_B + IT_MKV + IT_SSD + IT_DIL + IT_MBR + IT_OUT + IT_WQ;
    bf16* WallT = (bf16*)(ws + WS_WALLT);
    for (int it = gw; it < NITEMS; it += NGW) {
        int r = it;
        if (r < IT_A) { p0_transpose_item(F.in[I_WIN], W_IN_N, 0, WallT, DM, 0, 0, 96, scr, r, F.lane); continue; } r -= IT_A;
        if (r < IT_B) { p0_transpose_item(F.in[I_WIN], W_IN_N, OFF_AFTER_DT, WallT, DM, 3072, 0, 192, scr, r, F.lane); continue; } r -= IT_B;
        if (r < IT_MKV) { p0_transpose_item(F.in[I_WMKV], 1536, 0, (bf16*)(ws + WS_WMKVT), DM, 0, 0, 48, scr, r, F.lane); continue; } r -= IT_MKV;
        if (r < IT_SSD) { p0_transpose_item(F.in[I_WSSD], DM, 0, (bf16*)(ws + WS_WCATT), YC, 0, 0, 32, scr, r, F.lane); continue; } r -= IT_SSD;
        if (r < IT_DIL) { p0_transpose_item(F.in[I_WDIL], DM, 0, (bf16*)(ws + WS_WCATT), YC, 0, 1024, 32, scr, r, F.lane); continue; } r -= IT_DIL;
        if (r < IT_MBR) { p0_transpose_item(F.in[I_WMEMBR], DM, 0, (bf16*)(ws + WS_WCATT), YC, 0, 1280, 32, scr, r, F.lane); continue; } r -= IT_MBR;
        if (r < IT_OUT) { p0_transpose_item(F.in[I_WOUT], DM, 0, (bf16*)(ws + WS_WOUTT), DM, 0, 0, 32, scr, r, F.lane); continue; } r -= IT_OUT;
        p0_transpose_item(F.in[I_WQ], PEER_Q, 0, (bf16*)(ws + WS_WQT), DM, 0, 0, 64, scr, r, F.lane);
    }
    const size_t gtid = (size_t)F.bid * NTHR + F.tid, gth = (size_t)F.G * NTHR;
    cvt_f32_bf16_stream(F.in[I_SUBK], (bf16*)(ws + WS_SUBK), (size_t)8 * 2 * 128 * 128, gtid, gth);
    cvt_f32_fp8_sliced(F.in[I_PD], ws + WS_PD, PD_SCALE, gtid, gth);
    cvt_f32_fp8_sliced(F.in[I_PU], ws + WS_PU, PU_SCALE, gtid, gth);
    for (int m = gw; m < NB * NMEM; m += NGW) { f32x4 v[4]; rms_row_to_bf16(F.in[I_MEM] + (size_t)m * DM, F.in[I_MEMNW], (bf16*)(ws + WS_MEMN) + (size_t)m * DM, F.lane, v); }
    float* DTp = (float*)(ws + WS_DT);
    for (int m = gw; m < T; m += NGW) {
        f32x4 v[4]; rms_row_to_bf16(F.in[I_X] + (size_t)m * DM, F.in[I_NMIXW], (bf16*)(ws + WS_ACT1) + (size_t)m * DM, F.lane, v);
        float d[16];
#pragma unroll
        for (int j = 0; j < 16; ++j) d[j] = 0.f;
#pragma unroll
        for (int j = 0; j < 4; ++j)
#pragma unroll
            for (int e = 0; e < 4; ++e) { const int k = 4 * F.lane + 256 * j + e; const float uv = v[j][e];
#pragma unroll
                for (int q = 0; q < 4; ++q) { const f32x4 w4 = *(const LAS f32x4*)(wdt + k * 16 + 4 * q); d[4 * q + 0] += uv * w4.x; d[4 * q + 1] += uv * w4.y; d[4 * q + 2] += uv * w4.z; d[4 * q + 3] += uv * w4.w; }
                __builtin_amdgcn_sched_barrier(0); }
        float mine = 0.f;
#pragma unroll
        for (int j = 0; j < 16; ++j) { const float s = wave_sum(d[j]); mine = (F.lane == j) ? s : mine; }
        if (F.lane < 16) { const float xx = mine + F.in[I_DTB][F.lane]; DTp[(size_t)m * 16 + F.lane] = (xx > 20.f) ? xx : log1pf(__expf(xx)); }
    }
}

__device__ __forceinline__ void qkprep_phase(Frame& F, int half) {
    bf16* P = (bf16*)(F.ws + WS_BIG);
    const int gw = F.bid * NWAVES + F.wave, NGW = F.G * NWAVES, lane = F.lane;
    const float wq = F.in[I_DQNW][lane], wk = F.in[I_DKNW][lane];
    const float wmq0 = F.in[I_MQNW][lane], wmq1 = F.in[I_MQNW][lane + 64], wmq2 = F.in[I_MQNW][lane + 128];
    const float inv = __expf(-logf(500000.0f) * (2.0f / 16.0f) * (float)(lane & 7));
    for (int r = gw; r < HT; r += NGW) {
        const int tok = half * HT + r;
        const int pos = F.positions[tok];
        const double rev = (double)((float)pos * inv) * 0.15915494309189535;
        const float fr = (float)(rev - floor(rev));
        const float cs = __builtin_amdgcn_cosf(fr), sn = __builtin_amdgcn_sinf(fr);
        bf16* row = P + (size_t)r * NPROJ;
#pragma unroll 4
        for (int h = 0; h < 24; ++h) {
            bf16* p = row + PC_DQ + h * 64 + lane;
            float v = bf2f(*p);
            const float ss = wave_sum(v * v);
            v = v * (1.0f / sqrtf(ss * (1.f / 64.f) + EPS)) * (h < 12 ? wq : wk);
            const float other = __shfl_xor(v, 8);
            if (lane < 8) v = v * cs - other * sn; else if (lane < 16) v = v * cs + other * sn;
            *p = (bf16)f2bf(v);
        }
#pragma unroll
        for (int h = 0; h < 4; ++h) {
            bf16* p = row + PC_MQ + h * 192 + lane;
            float v0 = bf2f(p[0]), v1 = bf2f(p[64]), v2 = bf2f(p[128]);
            const float ss = wave_sum(v0 * v0 + v1 * v1 + v2 * v2);
            const float rs = 1.0f / sqrtf(ss * (1.f / 192.f) + EPS);
            p[0] = (bf16)f2bf(v0 * rs * wmq0); p[64] = (bf16)f2bf(v1 * rs * wmq1); p[128] = (bf16)f2bf(v2 * rs * wmq2);
        }
    }
    if (half == 0) {
        bf16* MK = (bf16*)(F.ws + WS_MKV);
        const float wk0 = F.in[I_MKNW][lane], wk1 = F.in[I_MKNW][lane + 64], wk2 = F.in[I_MKNW][lane + 128];
        for (int r = gw; r < NB * NMEM * 4; r += NGW) {
            bf16* p = MK + (size_t)(r >> 2) * 1536 + (r & 3) * 192 + lane;
            float v0 = bf2f(p[0]), v1 = bf2f(p[64]), v2 = bf2f(p[128]);
            const float ss = wave_sum(v0 * v0 + v1 * v1 + v2 * v2);
            const float rs = 1.0f / sqrtf(ss * (1.f / 192.f) + EPS);
            p[0] = (bf16)f2bf(v0 * rs * wk0); p[64] = (bf16)f2bf(v1 * rs * wk1); p[128] = (bf16)f2bf(v2 * rs * wk2);
        }
    }
}


constexpr int SC_ST = 272, SX_ST = 528;
__device__ __forceinline__ float bfsel(const u32x4& v, int j) { const unsigned w = v[j >> 1]; return (j & 1) ? bfhi(w) : bflo(w); }
__device__ __forceinline__ void conv_task(const bf16* P, size_t rowb, int t0, int pcol, const float* cw, const float* cb, int ccol, LAS unsigned char* dst, int stride, const LAS float* scale) {
    float w[4][8], bs[8];
#pragma unroll
    for (int k = 0; k < 4; ++k) { const f32x4 a = *(const f32x4*)(cw + k * 2048 + ccol), b = *(const f32x4*)(cw + k * 2048 + ccol + 4);
        w[k][0] = a.x; w[k][1] = a.y; w[k][2] = a.z; w[k][3] = a.w; w[k][4] = b.x; w[k][5] = b.y; w[k][6] = b.z; w[k][7] = b.w; }
    { const f32x4 a = *(const f32x4*)(cb + ccol), b = *(const f32x4*)(cb + ccol + 4); bs[0] = a.x; bs[1] = a.y; bs[2] = a.z; bs[3] = a.w; bs[4] = b.x; bs[5] = b.y; bs[6] = b.z; bs[7] = b.w; }
    const bf16* src = P + (rowb + t0) * NPROJ + pcol;
    u32x4 w0 = {0u, 0u, 0u, 0u}, w1 = w0, w2 = w0;
    if (t0 > 0) { w0 = *(const u32x4*)(src - 3 * (ptrdiff_t)NPROJ); w1 = *(const u32x4*)(src - 2 * (ptrdiff_t)NPROJ); w2 = *(const u32x4*)(src - (ptrdiff_t)NPROJ); }
#pragma unroll 4
    for (int i = 0; i < 16; ++i) {
        const u32x4 cur = *(const u32x4*)(src + (size_t)i * NPROJ);
        float o[8];
#pragma unroll
        for (int j = 0; j < 8; ++j) { float a = bs[j] + w[0][j] * bfsel(w0, j) + w[1][j] * bfsel(w1, j) + w[2][j] * bfsel(w2, j) + w[3][j] * bfsel(cur, j); o[j] = a * sigmoidf_(a); }
        if (scale) { const float sv = scale[i];
#pragma unroll
            for (int j = 0; j < 8; ++j) o[j] *= sv; }
        const u32x4 r = {pkbf(o[0], o[1]), pkbf(o[2], o[3]), pkbf(o[4], o[5]), pkbf(o[6], o[7])};
        *(LAS u32x4*)(dst + i * stride) = r;
        w0 = w1; w1 = w2; w2 = cur;
    }
}
__device__ __forceinline__ float ssd_scan(Frame& F, const float* DTp, size_t tok0, int g, LAS float* sAc, LAS float* sDt) {
    float total = 0.f;
    if (F.wave < 4) {
        const int head = 4 * g + F.wave, lane = F.lane;
        const float A = -__expf(F.in[I_ALOG][head]);
        const float d0 = DTp[(tok0 + 2 * lane) * 16 + head], d1 = DTp[(tok0 + 2 * lane + 1) * 16 + head];
        const float a0 = d0 * A, a1 = d1 * A;
        float sc = a0 + a1;
#pragma unroll
        for (int o = 1; o < 64; o <<= 1) { const float v = __shfl_up(sc, o); if (lane >= o) sc += v; }
        sAc[F.wave * 128 + 2 * lane] = sc - a1; sAc[F.wave * 128 + 2 * lane + 1] = sc;
        sDt[F.wave * 128 + 2 * lane] = d0; sDt[F.wave * 128 + 2 * lane + 1] = d1;
        total = __shfl(sc, 63);
    }
    return total;
}
__device__ __forceinline__ bf16x8 tr_pair(unsigned a_lo, unsigned a_hi) {
    s16x4 lo, hi;
    asm volatile("ds_read_b64_tr_b16 %0, %2\n\tds_read_b64_tr_b16 %1, %3\n\ts_waitcnt lgkmcnt(0)" : "=&v"(lo), "=&v"(hi) : "v"(a_lo), "v"(a_hi) : "memory");
    const bf16x8 r = {lo[0], lo[1], lo[2], lo[3], hi[0], hi[1], hi[2], hi[3]}; return r;
}

__device__ __forceinline__ void ssdC_phase(Frame& F, int half) {
    const bf16* P = (const bf16*)(F.ws + WS_BIG);
    const float* DTp = (const float*)(F.ws + WS_DT);
    float* SST = (float*)(F.ws + WS_SST); float* DEC = (float*)(F.ws + WS_DEC);
    LAS unsigned char* sX = F.lds; LAS unsigned char* sB = F.lds + 128 * SX_ST;
    LAS float* sAc = (LAS float*)(F.lds + 128 * SX_ST + 128 * SC_ST); LAS float* sDt = sAc + 512; LAS float* sW = sDt + 512;
    const int wave = F.wave;
    for (int unit = F.bid; unit < HB * 64 * 4; unit += F.G) {
        int tid = F.tid; asm volatile("" : "+v"(tid));
        const int lane = tid & 63, ql = lane & 31, h = lane >> 5, tq = (lane & 15) >> 2, tp = lane & 3, tblk = (lane >> 4) & 1;
        const int bl = unit >> 8, c = (unit >> 2) & 63, g = unit & 3;
        const size_t rowb = (size_t)bl * SEQ, tok0 = (size_t)half * HT + rowb + c * 128;
        __syncthreads();
        const float total = ssd_scan(F, DTp, tok0, g, sAc, sDt);
        if (wave < 4) { sW[wave * 128 + 2 * lane] = __expf(total - sAc[wave * 128 + 2 * lane]) * sDt[wave * 128 + 2 * lane];
            sW[wave * 128 + 2 * lane + 1] = __expf(total - sAc[wave * 128 + 2 * lane + 1]) * sDt[wave * 128 + 2 * lane + 1];
            if (lane == 0) DEC[((size_t)bl * 64 + c) * 16 + 4 * g + wave] = __expf(total); }
        __syncthreads();
        if (tid < 384) {
            int ch, strip, ccol, stride; LAS unsigned char* dst; const LAS float* scl = nullptr;
            if (tid < 256) { ch = tid & 31; strip = tid >> 5; ccol = g * 256 + 8 * ch; stride = SX_ST; dst = sX + (strip * 16) * SX_ST + ch * 16; scl = sW + (ch >> 3) * 128 + strip * 16; }
            else { const int u = tid - 256; ch = u & 15; strip = u >> 4; ccol = 1024 + g * 128 + 8 * ch; stride = SC_ST; dst = sB + (strip * 16) * SC_ST + ch * 16; }
            conv_task(P, rowb, c * 128 + strip * 16, PC_X + ccol, F.in[I_CONVW], F.in[I_CONVB], ccol, dst, stride, scl);
        }
        __syncthreads();
        const int r = wave >> 1, pt = wave & 1;
        f32x16 acc[4];
#pragma unroll
        for (int nt = 0; nt < 4; ++nt)
#pragma unroll
            for (int e = 0; e < 16; ++e) acc[nt][e] = 0.f;
        const unsigned xa = (unsigned)(size_t)sX + (unsigned)((8 * h + tq) * SX_ST + (r * 64 + 32 * pt + 16 * tblk + 4 * tp) * 2);
        const unsigned ba = (unsigned)(size_t)sB + (unsigned)((8 * h + tq) * SC_ST + (16 * tblk + 4 * tp) * 2);
#pragma unroll
        for (int ks = 0; ks < 8; ++ks) {
            const bf16x8 af = tr_pair(xa + ks * 16 * SX_ST, xa + ks * 16 * SX_ST + 4 * SX_ST);
            bf16x8 bfr[4];
#pragma unroll
            for (int nt = 0; nt < 4; ++nt) bfr[nt] = tr_pair(ba + ks * 16 * SC_ST + nt * 64, ba + ks * 16 * SC_ST + 4 * SC_ST + nt * 64);
            __builtin_amdgcn_sched_barrier(0);
#pragma unroll
            for (int nt = 0; nt < 4; ++nt) acc[nt] = MFMA32(af, bfr[nt], acc[nt]);
        }
        float* out = SST + (((size_t)bl * 64 + c) * 16 + 4 * g + r) * 8192;
#pragma unroll
        for (int nt = 0; nt < 4; ++nt)
#pragma unroll
            for (int e = 0; e < 16; ++e) out[(32 * pt + (e & 3) + 8 * (e >> 2) + 4 * h) * 128 + 32 * nt + ql] = acc[nt][e];
    }
}

__device__ __forceinline__ void ssdD_phase(Frame& F) {
    const float* SST = (const float*)(F.ws + WS_SST); const float* DEC = (const float*)(F.ws + WS_DEC);
    bf16* SIN = (bf16*)(F.ws + WS_SIN);
    const size_t gtid = (size_t)F.bid * NTHR + F.tid, gth = (size_t)F.G * NTHR;
    for (size_t it = gtid; it < (size_t)HB * 16 * 2048; it += gth) {
        const int bl = (int)(it >> 15), head = (int)(it >> 11) & 15, e4 = (int)(it & 2047) * 4;
        f32x4 st = {0.f, 0.f, 0.f, 0.f};
#pragma unroll 8
        for (int c = 0; c < 64; ++c) {
            const size_t idx = (((size_t)bl * 64 + c) * 16 + head);
            const u32x2 o = {pkbf(st.x, st.y), pkbf(st.z, st.w)};
            *(u32x2*)(SIN + idx * 8192 + e4) = o;
            const f32x4 sl = *(const f32x4*)(SST + idx * 8192 + e4); const float d = DEC[idx];
            st = st * d + sl;
        }
    }
}

__device__ __forceinline__ void ssdE_phase(Frame& F, int half) {
    const bf16* P = (const bf16*)(F.ws + WS_BIG);
    const float* DTp = (const float*)(F.ws + WS_DT);
    const bf16* SIN = (const bf16*)(F.ws + WS_SIN);
    bf16* Y = (bf16*)F.out;
    LAS unsigned char* sX = F.lds; LAS unsigned char* sB = F.lds + 128 * SX_ST; LAS unsigned char* sC = sB + 128 * SC_ST;
    LAS float* sAc = (LAS float*)(sC + 128 * SC_ST); LAS float* sDt = sAc + 512; LAS float* sSS = sDt + 512;
    const int wave = F.wave;
    const int st = wave & 3, hp = wave >> 2;
    for (int unit = F.bid; unit < HB * 64 * 4; unit += F.G) {
        int tid = F.tid; asm volatile("" : "+v"(tid));
        const int lane = tid & 63, ql = lane & 31, h = lane >> 5, tq = (lane & 15) >> 2, tp = lane & 3, tblk = (lane >> 4) & 1;
        const int bl = unit >> 8, c = (unit >> 2) & 63, g = unit & 3;
        const size_t rowb = (size_t)bl * SEQ, tok0 = (size_t)half * HT + rowb + c * 128;
        __syncthreads();
        (void)ssd_scan(F, DTp, tok0, g, sAc, sDt);
        if (tid < 128) sSS[tid] = 0.f;
        {
            int ch, strip, ccol, stride; LAS unsigned char* dst;
            if (tid < 256) { ch = tid & 31; strip = tid >> 5; ccol = g * 256 + 8 * ch; stride = SX_ST; dst = sX + (strip * 16) * SX_ST + ch * 16; }
            else if (tid < 384) { const int u = tid - 256; ch = u & 15; strip = u >> 4; ccol = 1024 + g * 128 + 8 * ch; stride = SC_ST; dst = sB + (strip * 16) * SC_ST + ch * 16; }
            else { const int u = tid - 384; ch = u & 15; strip = u >> 4; ccol = 1536 + g * 128 + 8 * ch; stride = SC_ST; dst = sC + (strip * 16) * SC_ST + ch * 16; }
            conv_task(P, rowb, c * 128 + strip * 16, PC_X + ccol, F.in[I_CONVW], F.in[I_CONVB], ccol, dst, stride, nullptr);
        }
        __syncthreads();
        const int s = 32 * st + ql;
        unsigned yk[2][2][8];
        float ssq = 0.f;
        const unsigned xa = (unsigned)(size_t)sX + (unsigned)((4 * h + tq) * SX_ST + (16 * tblk + 4 * tp) * 2);
#pragma unroll
        for (int hq = 0; hq < 2; ++hq) {
            const int r = 2 * hp + hq, head = 4 * g + r;
            const float acs = sAc[r * 128 + s];
            bf16x8 pf[4][2];
#pragma unroll
            for (int i = 0; i < 4; ++i) {
                f32x16 Xi;
#pragma unroll
                for (int e = 0; e < 16; ++e) Xi[e] = 0.f;
#pragma unroll
                for (int ks = 0; ks < 8; ++ks) { const bf16x8 bf_ = *(const LAS bf16x8*)(sB + (32 * i + ql) * SC_ST + 32 * ks + 16 * h);
                    const bf16x8 cf = *(const LAS bf16x8*)(sC + s * SC_ST + 32 * ks + 16 * h); Xi = MFMA32(bf_, cf, Xi); }
                float p[16];
#pragma unroll
                for (int q4 = 0; q4 < 4; ++q4) { const int t0 = 32 * i + 8 * q4 + 4 * h;
                    const f32x4 at = *(const LAS f32x4*)(sAc + r * 128 + t0), dt4 = *(const LAS f32x4*)(sDt + r * 128 + t0);
#pragma unroll
                    for (int e = 0; e < 4; ++e) { const int t = t0 + e; p[4 * q4 + e] = (t <= s) ? Xi[4 * q4 + e] * __expf(acs - at[e]) * dt4[e] : 0.f; } }
#pragma unroll
                for (int s2 = 0; s2 < 2; ++s2) { const u32x4 w = {pkbf(p[8 * s2 + 0], p[8 * s2 + 1]), pkbf(p[8 * s2 + 2], p[8 * s2 + 3]), pkbf(p[8 * s2 + 4], p[8 * s2 + 5]), pkbf(p[8 * s2 + 6], p[8 * s2 + 7])};
                    pf[i][s2] = __builtin_bit_cast(bf16x8, w); }
            }
            const bf16* stp = SIN + (((size_t)bl * 64 + c) * 16 + head) * 8192;
            const float eacs = __expf(acs), Dh = F.in[I_SSDD][head];
#pragma unroll
            for (int pt = 0; pt < 2; ++pt) {
                f32x16 yd, yo;
#pragma unroll
                for (int e = 0; e < 16; ++e) { yd[e] = 0.f; yo[e] = 0.f; }
#pragma unroll
                for (int i = 0; i < 4; ++i) {
#pragma unroll
                    for (int s2 = 0; s2 < 2; ++s2) { const unsigned a = xa + (unsigned)((32 * i + 16 * s2) * SX_ST + (r * 64 + 32 * pt) * 2);
                        const bf16x8 xf = tr_pair(a, a + 8 * SX_ST); __builtin_amdgcn_sched_barrier(0); yd = MFMA32(xf, pf[i][s2], yd); }
                }
#pragma unroll
                for (int ks = 0; ks < 8; ++ks) { const bf16x8 sf = *(const bf16x8*)(stp + (32 * pt + ql) * 128 + 16 * ks + 8 * h);
                    const bf16x8 cf = *(const LAS bf16x8*)(sC + s * SC_ST + 32 * ks + 16 * h); yo = MFMA32(sf, cf, yo); }
                const bf16* zp = P + (rowb + c * 128 + s) * NPROJ + PC_Z + g * 256 + r * 64 + 32 * pt + 4 * h;
#pragma unroll
                for (int q4 = 0; q4 < 4; ++q4) {
                    const u32x2 xv = *(const LAS u32x2*)(sX + s * SX_ST + (r * 64 + 32 * pt + 8 * q4 + 4 * h) * 2);
                    const u32x2 zv = *(const u32x2*)(zp + 8 * q4);
                    const float xs_[4] = {bflo(xv.x), bfhi(xv.x), bflo(xv.y), bfhi(xv.y)}, zs_[4] = {bflo(zv.x), bfhi(zv.x), bflo(zv.y), bfhi(zv.y)};
                    float yv[4];
#pragma unroll
                    for (int e = 0; e < 4; ++e) { float y = yd[4 * q4 + e] + eacs * yo[4 * q4 + e] + Dh * xs_[e]; y = y * zs_[e] * sigmoidf_(zs_[e]); yv[e] = y; ssq += y * y; }
                    yk[hq][pt][2 * q4] = pkbf(yv[0], yv[1]); yk[hq][pt][2 * q4 + 1] = pkbf(yv[2], yv[3]);
                }
            }
        }
        ssq += __shfl_xor(ssq, 32);
        if (h == 0) __hip_atomic_fetch_add(sSS + s, ssq, __ATOMIC_RELAXED, __HIP_MEMORY_SCOPE_WORKGROUP);
        __syncthreads();
        const float rs = 1.0f / sqrtf(sSS[s] * (1.f / 256.f) + EPS);
        bf16* yp = Y + (tok0 + s) * YC + g * 256 + 4 * h;
        const float* nw = F.in[I_SSDNW] + g * 256 + 4 * h;
#pragma unroll
        for (int hq = 0; hq < 2; ++hq)
#pragma unroll
            for (int pt = 0; pt < 2; ++pt)
#pragma unroll
                for (int q4 = 0; q4 < 4; ++q4) { const int cc = (2 * hp + hq) * 64 + 32 * pt + 8 * q4; const f32x4 w4 = *(const f32x4*)(nw + cc);
                    const unsigned ya = yk[hq][pt][2 * q4], yb = yk[hq][pt][2 * q4 + 1];
                    const u32x2 o = {pkbf(bflo(ya) * rs * w4.x, bfhi(ya) * rs * w4.y), pkbf(bflo(yb) * rs * w4.z, bfhi(yb) * rs * w4.w)};
                    *(u32x2*)(yp + cc) = o; }
    }
}

__device__ __forceinline__ bf16x8 mk_bf16x8(u32x2 lo, u32x2 hi) { const u32x4 v = {lo.x, lo.y, hi.x, hi.y}; return __builtin_bit_cast(bf16x8, v); }

__device__ __forceinline__ void memattn_mfma_phase(Frame& F, int half) {
    const bf16* P = (const bf16*)(F.ws + WS_BIG);
    const bf16* MKV = (const bf16*)(F.ws + WS_MKV);
    const bf16* MVT = (const bf16*)(F.ws + WS_MVT);
    bf16* Y = (bf16*)F.out;
    LAS unsigned char* sm = F.lds;
    const int tid = F.tid, lane = F.lane, wave = F.wave, ql = lane & 31, h = lane >> 5;
    constexpr int KST = 400, VST = 528;
    for (int unit = F.bid; unit < HB * 4 * 32; unit += F.G) {
        const int bl = unit >> 7, head = (unit >> 5) & 3, qt = unit & 31, b = half * HB + bl;
        const int r = bl * SEQ + qt * 256 + wave * 32 + ql;
        __syncthreads();
        for (int c = tid; c < 256 * 24; c += NTHR) { const int row = c / 24, ch = c % 24;
            *(LAS u32x4*)(sm + row * KST + ch * 16) = *(const u32x4*)(MKV + (size_t)(b * NMEM + row) * 1536 + head * 192 + ch * 8); }
        bf16x8 qf[12];
        { const bf16* qp = P + (size_t)r * NPROJ + PC_MQ + head * 192 + 8 * h;
#pragma unroll
          for (int ks = 0; ks < 12; ++ks) qf[ks] = *(const bf16x8*)(qp + 16 * ks); }
        __syncthreads();
        f32x16 sacc[8];
#pragma unroll
        for (int mt = 0; mt < 8; ++mt) {
#pragma unroll
            for (int i = 0; i < 16; ++i) sacc[mt][i] = 0.f;
#pragma unroll
            for (int ks = 0; ks < 12; ++ks) { const bf16x8 kf = *(const LAS bf16x8*)(sm + (32 * mt + ql) * KST + 32 * ks + 16 * h); sacc[mt] = MFMA32(kf, qf[ks], sacc[mt]); }
        }
        float mx = -3.0e38f;
#pragma unroll
        for (int mt = 0; mt < 8; ++mt)
#pragma unroll
            for (int i = 0; i < 16; ++i) mx = fmaxf(mx, sacc[mt][i]);
        mx = fmaxf(mx, __shfl_xor(mx, 32));
        const float sc = 0.07216878364870323f * 1.4426950408889634f;
        float l = 0.f;
        bf16x8 pf[8][2];
#pragma unroll
        for (int mt = 0; mt < 8; ++mt) {
            float p[16];
#pragma unroll
            for (int i = 0; i < 16; ++i) { p[i] = __builtin_amdgcn_exp2f((sacc[mt][i] - mx) * sc); l += p[i]; }
#pragma unroll
            for (int s2 = 0; s2 < 2; ++s2) { const u32x4 w = {pkbf(p[8 * s2 + 0], p[8 * s2 + 1]), pkbf(p[8 * s2 + 2], p[8 * s2 + 3]), pkbf(p[8 * s2 + 4], p[8 * s2 + 5]), pkbf(p[8 * s2 + 6], p[8 * s2 + 7])};
                pf[mt][s2] = __builtin_bit_cast(bf16x8, w); }
        }
        l += __shfl_xor(l, 32);
        __syncthreads();
        for (int c = tid; c < 192 * 32; c += NTHR) { const int row = c >> 5, ch = c & 31;
            *(LAS u32x4*)(sm + row * VST + ch * 16) = *(const u32x4*)(MVT + (size_t)(head * 192 + row) * 2048 + b * NMEM + ch * 8); }
        __syncthreads();
        const float il = 1.0f / l;
        bf16* yp = Y + ((size_t)half * HT + r) * YC + 1280 + head * 192 + 4 * h;
#pragma unroll
        for (int dt = 0; dt < 6; ++dt) {
            f32x16 o;
#pragma unroll
            for (int i = 0; i < 16; ++i) o[i] = 0.f;
#pragma unroll
            for (int mt = 0; mt < 8; ++mt)
#pragma unroll
                for (int s2 = 0; s2 < 2; ++s2) { const LAS unsigned char* vp = sm + (32 * dt + ql) * VST + (32 * mt + 16 * s2 + 4 * h) * 2;
                    const bf16x8 vf = mk_bf16x8(*(const LAS u32x2*)vp, *(const LAS u32x2*)(vp + 16)); o = MFMA32(vf, pf[mt][s2], o); }
#pragma unroll
            for (int g = 0; g < 4; ++g) { const u32x2 w = {pkbf(o[4 * g] * il, o[4 * g + 1] * il), pkbf(o[4 * g + 2] * il, o[4 * g + 3] * il)}; *(u32x2*)(yp + 32 * dt + 8 * g) = w; }
        }
    }
}

__device__ __forceinline__ void dilattn_mfma_phase(Frame& F, int half) {
    bf16* P = (bf16*)(F.ws + WS_BIG);
    float* LSE = (float*)(F.ws + WS_LSE);
    LAS unsigned char* sK = F.lds; LAS unsigned char* sV = F.lds + 384 * 144;
    const int tid = F.tid, lane = F.lane, wave = F.wave, ql = lane & 31, h = lane >> 5;
    constexpr int RST = 144;
    for (int unit = F.bid; unit < HB * 12 * 32; unit += F.G) {
        const int bl = unit / 384, rem = unit % 384, head = rem >> 5, blk = rem & 31;
        const int g = head >> 2, dil = (g == 0) ? 1 : (g == 1 ? 4 : 16), bpr = 32 / dil;
        const int res = blk / bpr, q0 = (blk % bpr) * 256;
        const size_t rowb = (size_t)bl * SEQ;
        __syncthreads();
        for (int c = tid; c < 384 * 8; c += NTHR) { const int row = c >> 3, ch = c & 7; const int ks = q0 - 128 + row;
            u32x4 kv = {0u, 0u, 0u, 0u}, vv = {0u, 0u, 0u, 0u};
            if (ks >= 0) { const bf16* src = P + (rowb + (size_t)ks * dil + res) * NPROJ + head * 64 + ch * 8; kv = *(const u32x4*)(src + PC_DK); vv = *(const u32x4*)(src + PC_DV); }
            *(LAS u32x4*)(sK + row * RST + ch * 16) = kv; *(LAS u32x4*)(sV + row * RST + ch * 16) = vv; }
        const int qs = q0 + wave * 32 + ql;
        const size_t rq = rowb + (size_t)qs * dil + res;
        bf16* qp = P + rq * NPROJ + PC_DQ + head * 64;
        bf16x8 qf[4];
#pragma unroll
        for (int ks = 0; ks < 4; ++ks) qf[ks] = *(const bf16x8*)(qp + 16 * ks + 8 * h);
        __syncthreads();
        f32x16 sacc[5];
        const int kfirst = q0 + wave * 32 - 128;
#pragma unroll
        for (int i = 0; i < 5; ++i) {
#pragma unroll
            for (int e = 0; e < 16; ++e) sacc[i][e] = 0.f;
#pragma unroll
            for (int ks = 0; ks < 4; ++ks) { const bf16x8 kf = *(const LAS bf16x8*)(sK + (32 * wave + 32 * i + ql) * RST + 32 * ks + 16 * h); sacc[i] = MFMA32(kf, qf[ks], sacc[i]); }
        }
        float mx = -3.0e38f;
#pragma unroll
        for (int i = 0; i < 5; ++i)
#pragma unroll
            for (int e = 0; e < 16; ++e) { const int kj = 32 * i + (e & 3) + 8 * (e >> 2) + 4 * h; const bool ok = (kj >= ql) && (kj <= ql + 128) && (kfirst + kj >= 0);
                sacc[i][e] = ok ? sacc[i][e] : -3.0e38f; mx = fmaxf(mx, sacc[i][e]); }
        mx = fmaxf(mx, __shfl_xor(mx, 32));
        const float sc = 0.125f * 1.4426950408889634f;
        float l = 0.f;
        bf16x8 pf[5][2];
#pragma unroll
        for (int i = 0; i < 5; ++i) {
            float p[16];
#pragma unroll
            for (int e = 0; e < 16; ++e) { p[e] = (sacc[i][e] > -1.0e38f) ? __builtin_amdgcn_exp2f((sacc[i][e] - mx) * sc) : 0.f; l += p[e]; }
#pragma unroll
            for (int s2 = 0; s2 < 2; ++s2) { const u32x4 w = {pkbf(p[8 * s2 + 0], p[8 * s2 + 1]), pkbf(p[8 * s2 + 2], p[8 * s2 + 3]), pkbf(p[8 * s2 + 4], p[8 * s2 + 5]), pkbf(p[8 * s2 + 6], p[8 * s2 + 7])};
                pf[i][s2] = __builtin_bit_cast(bf16x8, w); }
        }
        l += __shfl_xor(l, 32);
        const float il = 1.0f / l;
        const int tq = (lane & 15) >> 2, tp = lane & 3, tblk = (lane >> 4) & 1;
        const unsigned vbase = (unsigned)(size_t)(sV) + (unsigned)((32 * wave + 4 * h + tq) * RST + (16 * tblk + 4 * tp) * 2);
#pragma unroll
        for (int dt = 0; dt < 2; ++dt) {
            f32x16 o;
#pragma unroll
            for (int e = 0; e < 16; ++e) o[e] = 0.f;
#pragma unroll
            for (int i = 0; i < 5; ++i) {
                s16x4 lo[2], hi[2];
#pragma unroll
                for (int s2 = 0; s2 < 2; ++s2) { const unsigned a = vbase + (unsigned)((32 * i + 16 * s2) * RST + 64 * dt);
                    asm volatile("ds_read_b64_tr_b16 %0, %1" : "=&v"(lo[s2]) : "v"(a) : "memory");
                    asm volatile("ds_read_b64_tr_b16 %0, %1 offset:1152" : "=&v"(hi[s2]) : "v"(a) : "memory"); }
                asm volatile("s_waitcnt lgkmcnt(0)" ::: "memory"); __builtin_amdgcn_sched_barrier(0);
#pragma unroll
                for (int s2 = 0; s2 < 2; ++s2) { const bf16x8 vf = {lo[s2][0], lo[s2][1], lo[s2][2], lo[s2][3], hi[s2][0], hi[s2][1], hi[s2][2], hi[s2][3]}; o = MFMA32(vf, pf[i][s2], o); }
            }
#pragma unroll
            for (int gq = 0; gq < 4; ++gq) { const u32x2 w = {pkbf(o[4 * gq] * il, o[4 * gq + 1] * il), pkbf(o[4 * gq + 2] * il, o[4 * gq + 3] * il)}; *(u32x2*)(qp + 32 * dt + 8 * gq + 4 * h) = w; }
        }
        if (h == 0) LSE[((size_t)half * HT + rq) * 12 + head] = mx * 0.125f + __logf(l);
    }
}

__device__ __forceinline__ void dilmerge_phase(Frame& F, int half) {
    const bf16* P = (const bf16*)(F.ws + WS_BIG);
    const float* LSE = (const float*)(F.ws + WS_LSE);
    bf16* Y = (bf16*)F.out;
    const size_t gtid = (size_t)F.bid * NTHR + F.tid, gth = (size_t)F.G * NTHR;
    for (size_t it = gtid; it < (size_t)HT * 32; it += gth) {
        const size_t r = it >> 5; const int hh = (int)(it >> 3) & 3, d0 = (int)(it & 7) * 8;
        const size_t tok = (size_t)half * HT + r;
        const float l0 = LSE[tok * 12 + hh], l1 = LSE[tok * 12 + 4 + hh], l2 = LSE[tok * 12 + 8 + hh];
        const float m = fmaxf(l0, fmaxf(l1, l2));
        float w0 = __expf(l0 - m), w1 = __expf(l1 - m), w2 = __expf(l2 - m); const float iw = 1.0f / (w0 + w1 + w2); w0 *= iw; w1 *= iw; w2 *= iw;
        const bf16* op = P + r * NPROJ + PC_DQ + hh * 64 + d0;
        const u32x4 a = *(const u32x4*)op, b = *(const u32x4*)(op + 256), c = *(const u32x4*)(op + 512);
        u32x4 o;
        o.x = pkbf(w0 * bflo(a.x) + w1 * bflo(b.x) + w2 * bflo(c.x), w0 * bfhi(a.x) + w1 * bfhi(b.x) + w2 * bfhi(c.x));
        o.y = pkbf(w0 * bflo(a.y) + w1 * bflo(b.y) + w2 * bflo(c.y), w0 * bfhi(a.y) + w1 * bfhi(b.y) + w2 * bfhi(c.y));
        o.z = pkbf(w0 * bflo(a.z) + w1 * bflo(b.z) + w2 * bflo(c.z), w0 * bfhi(a.z) + w1 * bfhi(b.z) + w2 * bfhi(c.z));
        o.w = pkbf(w0 * bflo(a.w) + w1 * bflo(b.w) + w2 * bflo(c.w), w0 * bfhi(a.w) + w1 * bfhi(b.w) + w2 * bfhi(c.w));
        *(u32x4*)(Y + tok * YC + 1024 + hh * 64 + d0) = o;
    }
}

__device__ __forceinline__ void hn_phase(Frame& F) {
    const int gw = F.bid * NWAVES + F.wave, NGW = F.G * NWAVES;
    for (int m = gw; m < T; m += NGW) { f32x4 v[4]; rms_row_to_bf16(F.out + (size_t)m * DM, F.in[I_NFFNW], (bf16*)(F.ws + WS_ACT1) + (size_t)m * DM, F.lane, v); }
}


__device__ __forceinline__ float gelu_erf(float x) { return 0.5f * x * (1.0f + erff(x * 0.70710678118654752f)); }
__device__ __forceinline__ unsigned f2ord(float f) { const unsigned u = __builtin_bit_cast(unsigned, f); return u ^ ((unsigned)((int)u >> 31) | 0x80000000u); }
__device__ __forceinline__ float ord2f(unsigned k) { const unsigned m = (unsigned)((int)k >> 31); return __builtin_bit_cast(float, k ^ (0x80000000u | ~m)); }
#define CMPX(a, b) do { const unsigned _mx = max((a), (b)), _mn = min((a), (b)); (a) = _mx; (b) = _mn; } while (0)
__device__ __forceinline__ void bitonic_sort16_desc(unsigned (&v)[16]) {
#pragma unroll
    for (int k = 2; k <= 16; k <<= 1)
#pragma unroll
        for (int j = k >> 1; j > 0; j >>= 1)
#pragma unroll
            for (int i = 0; i < 16; ++i) { const int l = i ^ j; if (l > i) { if ((i & k) == 0) CMPX(v[i], v[l]); else CMPX(v[l], v[i]); } }
}
__device__ __forceinline__ void bitonic_merge16_desc(unsigned (&v)[16]) {
#pragma unroll
    for (int j = 8; j > 0; j >>= 1)
#pragma unroll
        for (int i = 0; i < 16; ++i) { const int l = i ^ j; if (l > i) CMPX(v[i], v[l]); }
}
__device__ __forceinline__ void top16_merge(unsigned (&a)[16], const unsigned (&b)[16]) {
#pragma unroll
    for (int i = 0; i < 16; ++i) a[i] = max(a[i], b[15 - i]);
    bitonic_merge16_desc(a);
}
constexpr int PK_ST = 272;
__device__ __forceinline__ void peer_topk_tile(Frame& F, size_t tok0, int* IDX, float* GATE) {
    const bf16* Q = (const bf16*)(F.ws + WS_BIG);
    const bf16* SK = (const bf16*)(F.ws + WS_SUBK);
    LAS unsigned char* sK = F.lds;
    int tid = F.tid; asm volatile("" : "+v"(tid));
    const int lane = tid & 63, wave = F.wave, ql = lane & 31, hh = lane >> 5;
    const size_t tok = tok0 + wave * 32 + ql;
    const bf16* qrow = Q + tok * PEER_Q + 8 * hh;
    __syncthreads();
#pragma unroll
    for (int j = 0; j < 4; ++j) { const int cidx = tid + 512 * j, row = cidx >> 4, ch = cidx & 15; *(LAS u32x4*)(sK + row * PK_ST + ch * 16) = *(const u32x4*)(SK + (size_t)row * 128 + ch * 8); }
    __syncthreads();
    unsigned k1[16];
#pragma unroll 1
    for (int hc = 0; hc < 16; ++hc) {
        LAS unsigned char* cur = sK + (hc & 1) * (128 * PK_ST); LAS unsigned char* nxt = sK + ((hc + 1) & 1) * (128 * PK_ST);
        u32x4 stg[4];
        const int hcn = (hc + 1) & 15;
#pragma unroll
        for (int j = 0; j < 4; ++j) { const int cidx = tid + 512 * j, row = cidx >> 4, ch = cidx & 15; stg[j] = *(const u32x4*)(SK + ((size_t)hcn * 128 + row) * 128 + ch * 8); }
        bf16x8 qf[8];
#pragma unroll
        for (int ks = 0; ks < 8; ++ks) qf[ks] = *(const bf16x8*)(qrow + hc * 128 + 16 * ks);
        unsigned pk[4][16];
#pragma unroll
        for (int mt = 0; mt < 4; ++mt) {
            f32x16 acc;
#pragma unroll
            for (int e = 0; e < 16; ++e) acc[e] = 0.f;
#pragma unroll
            for (int ks = 0; ks < 8; ++ks) { const bf16x8 kf = *(const LAS bf16x8*)(cur + (32 * mt + ql) * PK_ST + 32 * ks + 16 * hh); acc = MFMA32(kf, qf[ks], acc); }
#pragma unroll
            for (int e = 0; e < 16; ++e) pk[mt][e] = (f2ord(acc[e]) & 0xFFFFFF80u) | (unsigned)(32 * mt + (e & 3) + 8 * (e >> 2) + 4 * hh);
        }
#pragma unroll
        for (int j = 0; j < 4; ++j) { const int cidx = tid + 512 * j, row = cidx >> 4, ch = cidx & 15; *(LAS u32x4*)(nxt + row * PK_ST + ch * 16) = stg[j]; }
        __syncthreads();
#pragma unroll
        for (int mt = 0; mt < 4; ++mt) bitonic_sort16_desc(pk[mt]);
        top16_merge(pk[0], pk[1]); top16_merge(pk[2], pk[3]); top16_merge(pk[0], pk[2]);
        unsigned other[16];
#pragma unroll
        for (int i = 0; i < 16; ++i) other[i] = (unsigned)__shfl_xor((int)pk[0][i], 32);
        top16_merge(pk[0], other);
        if ((hc & 1) == 0) {
#pragma unroll
            for (int i = 0; i < 16; ++i) k1[i] = pk[0][i];
        } else {
            float f1[16], f2[16];
#pragma unroll
            for (int i = 0; i < 16; ++i) { f1[i] = ord2f(k1[i] & 0xFFFFFF80u); f2[i] = ord2f(pk[0][i] & 0xFFFFFF80u); }
            unsigned cd[4][16];
#pragma unroll
            for (int i = 0; i < 64; ++i) cd[i >> 4][i & 15] = 0u;
            int n = 0;
#pragma unroll
            for (int a = 0; a < 16; ++a)
#pragma unroll
                for (int b = 0; b < 16; ++b)
                    if ((a + 1) * (b + 1) <= 16) { cd[n >> 4][n & 15] = (f2ord(f1[a] + f2[b]) & 0xFFFFC000u) | ((k1[a] & 127u) << 7) | (pk[0][b] & 127u); ++n; }
#pragma unroll
            for (int g4 = 0; g4 < 4; ++g4) bitonic_sort16_desc(cd[g4]);
            top16_merge(cd[0], cd[1]); top16_merge(cd[2], cd[3]); top16_merge(cd[0], cd[2]);
            const float vmax = ord2f(cd[0][0] & 0xFFFFC000u);
            float ex[16], den = 0.f;
#pragma unroll
            for (int i = 0; i < 16; ++i) { ex[i] = __expf(ord2f(cd[0][i] & 0xFFFFC000u) - vmax); den += ex[i]; }
            const float iden = 1.0f / den;
            const int h = hc >> 1;
            if (hh == 0) { int* ip = IDX + tok * 128 + h * 16;
#pragma unroll
                for (int i = 0; i < 4; ++i) { const u32x4 w = {cd[0][4 * i] & 0x3FFFu, cd[0][4 * i + 1] & 0x3FFFu, cd[0][4 * i + 2] & 0x3FFFu, cd[0][4 * i + 3] & 0x3FFFu}; *(u32x4*)(ip + 4 * i) = w; } }
            else { float* gp = GATE + tok * 128 + h * 16;
#pragma unroll
                for (int i = 0; i < 4; ++i) { const f32x4 w = {ex[4 * i] * iden, ex[4 * i + 1] * iden, ex[4 * i + 2] * iden, ex[4 * i + 3] * iden}; *(f32x4*)(gp + 4 * i) = w; } }
        }
    }
}

constexpr size_t PEER_OFF_IDX = 256 * MiB, PEER_OFF_GATE = 288 * MiB, PEER_OFF_COEF = 320 * MiB;
struct PeerDeal { size_t tokw; int ntok; };
__device__ __forceinline__ void peer_item(int n, const PeerDeal& D, int wave, int& slice, size_t& tok) { slice = n >> 5; tok = D.tokw + (n & 31); }
__device__ __forceinline__ void peer_down_rows(u32x4 (&R)[16], const unsigned char* PD, int slice, int id0, int id1, int lane) {
    const unsigned char* base = PD + ((size_t)slice * 16384 << 7) + 16 * (lane & 7);
#pragma unroll
    for (int k = 0; k < 16; ++k) { const int id = __shfl(k < 8 ? id0 : id1, (8 * k + (lane >> 3)) & 63); R[k] = *(const u32x4*)(base + ((size_t)id << 7)); }
}
__device__ __forceinline__ void peer_down_park(const u32x4 (&R)[16], LAS unsigned char* sw, int lane) {
    const int e8 = lane >> 3, p = lane & 7;
#pragma unroll
    for (int k = 0; k < 16; ++k) { const int sl_ = 8 * k + e8; *(LAS u32x4*)(sw + sl_ * 128 + 16 * (p ^ ((sl_ >> 1) & 7))) = R[k]; }
}
__device__ __forceinline__ void peer_down_hn(u32x4 (&H)[4], const bf16* HN, int slice, size_t tok, int g) {
    const bf16* hp = HN + tok * DM + slice * 128 + 16 * g;
    H[0] = *(const u32x4*)hp; H[1] = *(const u32x4*)(hp + 8); H[2] = *(const u32x4*)(hp + 64); H[3] = *(const u32x4*)(hp + 72);
}
__device__ __forceinline__ void peer_down_compute(const LAS unsigned char* sw, const u32x4 (&H)[4], __amdgpu_buffer_rsrc_t prsrc, int slice, size_t tok, int lane) {
    const int g = lane >> 4, r = lane & 15;
    long bq[4];
#pragma unroll
    for (int h2 = 0; h2 < 2; ++h2) { const u32x4 x0 = H[2 * h2], x1 = H[2 * h2 + 1];
        unsigned p0 = __builtin_amdgcn_cvt_pk_fp8_f32(bflo(x0.x), bfhi(x0.x), 0, false); p0 = __builtin_amdgcn_cvt_pk_fp8_f32(bflo(x0.y), bfhi(x0.y), p0, true);
        unsigned p1 = __builtin_amdgcn_cvt_pk_fp8_f32(bflo(x0.z), bfhi(x0.z), 0, false); p1 = __builtin_amdgcn_cvt_pk_fp8_f32(bflo(x0.w), bfhi(x0.w), p1, true);
        unsigned p2 = __builtin_amdgcn_cvt_pk_fp8_f32(bflo(x1.x), bfhi(x1.x), 0, false); p2 = __builtin_amdgcn_cvt_pk_fp8_f32(bflo(x1.y), bfhi(x1.y), p2, true);
        unsigned p3 = __builtin_amdgcn_cvt_pk_fp8_f32(bflo(x1.z), bfhi(x1.z), 0, false); p3 = __builtin_amdgcn_cvt_pk_fp8_f32(bflo(x1.w), bfhi(x1.w), p3, true);
        bq[2 * h2] = (long)(((unsigned long long)p1 << 32) | p0); bq[2 * h2 + 1] = (long)(((unsigned long long)p3 << 32) | p2); }
    const unsigned off = ((lane & 15) == 0) ? (unsigned)((((size_t)slice * T + tok) * 128 + 4 * g) * 4) : 0xFFFFFF00u;
#pragma unroll
    for (int t8 = 0; t8 < 8; ++t8) { f32x4 acc = {0.f, 0.f, 0.f, 0.f}; const int sl_ = 16 * t8 + r; const LAS unsigned char* rp = sw + sl_ * 128; const int sx = (sl_ >> 1) & 7;
#pragma unroll
        for (int h2 = 0; h2 < 2; ++h2) { const u32x4 v = *(const LAS u32x4*)(rp + 16 * ((4 * h2 + g) ^ sx));
            acc = __builtin_amdgcn_mfma_f32_16x16x32_fp8_fp8((long)(((unsigned long long)v.y << 32) | v.x), bq[2 * h2], acc, 0, 0, 0);
            acc = __builtin_amdgcn_mfma_f32_16x16x32_fp8_fp8((long)(((unsigned long long)v.w << 32) | v.z), bq[2 * h2 + 1], acc, 0, 0, 0); }
        __builtin_amdgcn_raw_buffer_store_b128(__builtin_bit_cast(u32x4, acc), prsrc, off, 64 * t8, 0); }
}
__device__ __forceinline__ void peer_down_phase(Frame& F, const PeerDeal& D) {
    const unsigned char* PD = F.ws + WS_PD; const bf16* HN = (const bf16*)(F.ws + WS_ACT1);
    const int* IDX = (const int*)(F.ws + WS_BIG + PEER_OFF_IDX);
    const __amdgpu_buffer_rsrc_t prsrc = __builtin_amdgcn_make_buffer_rsrc((void*)(F.ws + WS_BIG), 0, 8 * T * 128 * 4, 0x00020000);
    int lane = F.lane; asm volatile("" : "+v"(lane));
    const int g = lane >> 4, wave = F.wave;
    LAS unsigned char* sw = F.lds + wave * 16384;
    const int ntok = D.ntok;
    int sl; size_t tk;
    u32x4 R[16], H0[4], H1[4]; int id0, id1;
    { int s1_; size_t t1_; peer_item(0, D, wave, sl, tk); peer_item(1, D, wave, s1_, t1_);
      const int a0 = IDX[tk * 128 + lane], a1 = IDX[tk * 128 + 64 + lane]; id0 = IDX[t1_ * 128 + lane]; id1 = IDX[t1_ * 128 + 64 + lane];
      __builtin_amdgcn_sched_barrier(0);
      peer_down_rows(R, PD, sl, a0, a1, lane); peer_down_hn(H0, HN, sl, tk, g);
      __builtin_amdgcn_sched_barrier(0); }
#pragma unroll 1
    for (int n = 0; n < ntok; n += 2) {
        int s0, s1, s2, s3; size_t t0, t1, t2, t3;
        peer_item(n, D, wave, s0, t0); peer_item(n + 1, D, wave, s1, t1); peer_item(n + 2 < ntok ? n + 2 : n, D, wave, s2, t2); peer_item(n + 3 < ntok ? n + 3 : n + 1, D, wave, s3, t3);
        peer_down_park(R, sw, lane);
        __builtin_amdgcn_sched_barrier(0);
        { const int j0 = IDX[t2 * 128 + lane], j1 = IDX[t2 * 128 + 64 + lane];
          peer_down_rows(R, PD, s1, id0, id1, lane); peer_down_hn(H1, HN, s1, t1, g); id0 = j0; id1 = j1; }
        __builtin_amdgcn_sched_barrier(0);
        peer_down_compute(sw, H0, prsrc, s0, t0, lane);
        __builtin_amdgcn_sched_barrier(0);
        peer_down_park(R, sw, lane);
        __builtin_amdgcn_sched_barrier(0);
        { const int j0 = IDX[t3 * 128 + lane], j1 = IDX[t3 * 128 + 64 + lane];
          peer_down_rows(R, PD, s2, id0, id1, lane); peer_down_hn(H0, HN, s2, t2, g); id0 = j0; id1 = j1; }
        __builtin_amdgcn_sched_barrier(0);
        peer_down_compute(sw, H1, prsrc, s1, t1, lane);
        __builtin_amdgcn_sched_barrier(0);
    }
}
__device__ __forceinline__ void peer_coef_wave(Frame& F, const PeerDeal& D) {
    const float* PART = (const float*)(F.ws + WS_BIG); const float* GATE = (const float*)(F.ws + WS_BIG + PEER_OFF_GATE); float* COEF = (float*)(F.ws + WS_BIG + PEER_OFF_COEF);
    for (int k = F.lane; k < 32 * 32; k += 64) {
        const size_t i = D.tokw * 128 + 4 * k;
        f32x4 sm = *(const f32x4*)(PART + i);
#pragma unroll
        for (int x = 1; x < 8; ++x) sm += *(const f32x4*)(PART + (size_t)x * T * 128 + i);
        const f32x4 gt = *(const f32x4*)(GATE + i);
        const f32x4 o = {gt.x * gelu_erf(sm.x * (1.0f / PD_SCALE)) * (1.0f / PU_SCALE), gt.y * gelu_erf(sm.y * (1.0f / PD_SCALE)) * (1.0f / PU_SCALE),
                         gt.z * gelu_erf(sm.z * (1.0f / PD_SCALE)) * (1.0f / PU_SCALE), gt.w * gelu_erf(sm.w * (1.0f / PD_SCALE)) * (1.0f / PU_SCALE)};
        *(f32x4*)(COEF + i) = o;
    }
}
__device__ __forceinline__ void peer_up_rows(u32x4 (&R)[16], const unsigned char* PU, int slice, int id0, int id1, int lane) {
    const unsigned char* base = PU + ((size_t)slice * 16384 << 7) + 16 * (lane & 3);
#pragma unroll
    for (int s8 = 0; s8 < 8; ++s8) { const int id = __shfl(s8 < 4 ? id0 : id1, (16 * s8 + (lane >> 2)) & 63); const unsigned char* rp = base + ((size_t)id << 7); R[2 * s8] = *(const u32x4*)rp; R[2 * s8 + 1] = *(const u32x4*)(rp + 64); }
}
__device__ __forceinline__ void peer_up_compute(const u32x4 (&R)[16], float c0, float c1, f32x2 h, float* out, int slice, size_t tok, int lane) {
    f32x2 acc[16];
#pragma unroll
    for (int k = 0; k < 16; ++k) acc[k] = (f32x2){0.f, 0.f};
#pragma unroll
    for (int s8 = 0; s8 < 8; ++s8) { const float c = __shfl(s8 < 4 ? c0 : c1, (16 * s8 + (lane >> 2)) & 63); f32x2 c2 = {c, c}; asm volatile("" : "+v"(c2));
#pragma unroll
        for (int hf = 0; hf < 2; ++hf) { const u32x4 r = R[2 * s8 + hf];
            acc[8 * hf + 0] = c2 * __builtin_amdgcn_cvt_pk_f32_fp8(r.x, false) + acc[8 * hf + 0]; acc[8 * hf + 1] = c2 * __builtin_amdgcn_cvt_pk_f32_fp8(r.x, true) + acc[8 * hf + 1];
            acc[8 * hf + 2] = c2 * __builtin_amdgcn_cvt_pk_f32_fp8(r.y, false) + acc[8 * hf + 2]; acc[8 * hf + 3] = c2 * __builtin_amdgcn_cvt_pk_f32_fp8(r.y, true) + acc[8 * hf + 3];
            acc[8 * hf + 4] = c2 * __builtin_amdgcn_cvt_pk_f32_fp8(r.z, false) + acc[8 * hf + 4]; acc[8 * hf + 5] = c2 * __builtin_amdgcn_cvt_pk_f32_fp8(r.z, true) + acc[8 * hf + 5];
            acc[8 * hf + 6] = c2 * __builtin_amdgcn_cvt_pk_f32_fp8(r.w, false) + acc[8 * hf + 6]; acc[8 * hf + 7] = c2 * __builtin_amdgcn_cvt_pk_f32_fp8(r.w, true) + acc[8 * hf + 7]; } }
    f32x2 r8[8], r4[4], r2[2], r1;
    { const bool up = (lane & 32) != 0;
#pragma unroll
      for (int k = 0; k < 8; ++k) { const f32x2 keep = up ? acc[k + 8] : acc[k], send = up ? acc[k] : acc[k + 8]; r8[k] = keep + (f32x2){__shfl_xor(send.x, 32), __shfl_xor(send.y, 32)}; } }
    { const bool up = (lane & 16) != 0;
#pragma unroll
      for (int k = 0; k < 4; ++k) { const f32x2 keep = up ? r8[k + 4] : r8[k], send = up ? r8[k] : r8[k + 4]; r4[k] = keep + (f32x2){__shfl_xor(send.x, 16), __shfl_xor(send.y, 16)}; } }
    { const bool up = (lane & 8) != 0;
#pragma unroll
      for (int k = 0; k < 2; ++k) { const f32x2 keep = up ? r4[k + 2] : r4[k], send = up ? r4[k] : r4[k + 2]; r2[k] = keep + (f32x2){__shfl_xor(send.x, 8), __shfl_xor(send.y, 8)}; } }
    { const bool up = (lane & 4) != 0; const f32x2 keep = up ? r2[1] : r2[0], send = up ? r2[0] : r2[1]; r1 = keep + (f32x2){__shfl_xor(send.x, 4), __shfl_xor(send.y, 4)}; }
    const int p = ((lane >> 5) & 1) * 8 + ((lane >> 4) & 1) * 4 + ((lane >> 3) & 1) * 2 + ((lane >> 2) & 1);
    *(f32x2*)(out + tok * DM + slice * 128 + 16 * (lane & 3) + 2 * (p & 7) + 64 * (p >> 3)) = h + r1;
}
__device__ __forceinline__ void peer_up_phase(Frame& F, const PeerDeal& D, float* outp) {
    const unsigned char* PU = F.ws + WS_PU;
    const int* IDX = (const int*)(F.ws + WS_BIG + PEER_OFF_IDX); const float* COEF = (const float*)(F.ws + WS_BIG + PEER_OFF_COEF);
    int lane = F.lane; asm volatile("" : "+v"(lane));
    const int wave = F.wave;
    const int ntok = D.ntok;
    const int p = ((lane >> 5) & 1) * 8 + ((lane >> 4) & 1) * 4 + ((lane >> 3) & 1) * 2 + ((lane >> 2) & 1);
    const int hoff = 16 * (lane & 3) + 2 * (p & 7) + 64 * (p >> 3);
    int sl; size_t tk;
    u32x4 R0[16], R1[16];
    float ca0, ca1, cb0, cb1; f32x2 ha, hb;
    int id0, id1, jd0, jd1;
    { int s1_; size_t t1_; peer_item(0, D, wave, sl, tk); peer_item(1, D, wave, s1_, t1_);
      jd0 = IDX[tk * 128 + lane]; jd1 = IDX[tk * 128 + 64 + lane]; id0 = IDX[t1_ * 128 + lane]; id1 = IDX[t1_ * 128 + 64 + lane];
      __builtin_amdgcn_sched_barrier(0);
      peer_up_rows(R0, PU, sl, jd0, jd1, lane);
      ca0 = COEF[tk * 128 + lane]; ca1 = COEF[tk * 128 + 64 + lane]; ha = *(const f32x2*)(F.out + tk * DM + sl * 128 + hoff);
      __builtin_amdgcn_sched_barrier(0); }
#pragma unroll 1
    for (int n = 0; n < ntok; n += 2) {
        int s0, s1, s2, s3; size_t t0, t1, t2, t3;
        peer_item(n, D, wave, s0, t0); peer_item(n + 1, D, wave, s1, t1);
        peer_item(n + 2 < ntok ? n + 2 : n, D, wave, s2, t2); peer_item(n + 3 < ntok ? n + 3 : n + 1, D, wave, s3, t3);
        jd0 = IDX[t2 * 128 + lane]; jd1 = IDX[t2 * 128 + 64 + lane];
        peer_up_rows(R1, PU, s1, id0, id1, lane);
        cb0 = COEF[t1 * 128 + lane]; cb1 = COEF[t1 * 128 + 64 + lane]; hb = *(const f32x2*)(F.out + t1 * DM + s1 * 128 + hoff);
        __builtin_amdgcn_sched_barrier(0);
        peer_up_compute(R0, ca0, ca1, ha, outp, s0, t0, lane);
        __builtin_amdgcn_sched_barrier(0);
        id0 = IDX[t3 * 128 + lane]; id1 = IDX[t3 * 128 + 64 + lane];
        peer_up_rows(R0, PU, s2, jd0, jd1, lane);
        ca0 = COEF[t2 * 128 + lane]; ca1 = COEF[t2 * 128 + 64 + lane]; ha = *(const f32x2*)(F.out + t2 * DM + s2 * 128 + hoff);
        __builtin_amdgcn_sched_barrier(0);
        peer_up_compute(R1, cb0, cb1, hb, outp, s1, t1, lane);
        __builtin_amdgcn_sched_barrier(0);
    }
}
__device__ __forceinline__ void peer_phase(Frame& F) {
    int* IDX = (int*)(F.ws + WS_BIG + PEER_OFF_IDX); float* GATE = (float*)(F.ws + WS_BIG + PEER_OFF_GATE);
    for (int tile = F.bid; tile < T / 256; tile += F.G) {
        peer_topk_tile(F, (size_t)tile * 256, IDX, GATE);
        VM_WAIT(); __syncthreads();
        PeerDeal D; D.tokw = (size_t)tile * 256 + F.wave * 32; D.ntok = 256;
        peer_down_phase(F, D);
        if (PROBE & 8) peer_down_phase(F, D);
        VM_WAIT(); __syncthreads();
        peer_coef_wave(F, D);
        VM_WAIT(); __syncthreads();
        if (PROBE & 16) peer_up_phase(F, D, (float*)(F.ws + WS_SST));
        peer_up_phase(F, D, F.out);
    }
}

constexpr int N_PHASES = 15;
__global__ void __launch_bounds__(NTHR, 2) mega_fwd(Args args) {
    extern __shared__ __attribute__((aligned(16))) unsigned char lds_raw[];
    Frame F;
    F.lds = (LAS unsigned char*)lds_raw;
    F.tid = threadIdx.x; F.lane = F.tid & 63; F.wave = __builtin_amdgcn_readfirstlane(F.tid >> 6);
    F.G = gridDim.x; F.bid = blockIdx.x;
#pragma unroll
    for (int i = 0; i < 26; ++i) F.in[i] = args.in[i];
    F.positions = args.positions; F.out = args.out; F.ws = args.ws;
    unsigned char* ws = args.ws;
    volatile LAS unsigned* ctlw = (volatile LAS unsigned*)(F.lds + LDSCTL_OFF);
    if (F.tid < 64) ctlw[F.tid] = 0u;
    __syncthreads();
    const int lo = args.ph_lo, hi = args.ph_hi;
    XcdBarrier bar; bar.bar = (unsigned*)(ws + WS_CTL); bar.x = 0; bar.st = nullptr;
    if (hi - lo > 1) bar = xcd_barrier_post((unsigned*)(ws + WS_CTL), ctlw + 8);
#define IN(k) (lo <= (k) && (k) < hi)
#define SEAM(k) do { if (IN(k) && IN((k) + 1)) xcd_barrier(bar); } while (0)
    bf16* ACT1 = (bf16*)(ws + WS_ACT1); bf16* BIG = (bf16*)(ws + WS_BIG); bf16* WallT = (bf16*)(ws + WS_WALLT);

    if (IN(0)) { p0_prologue(F); __syncthreads(); if (PROBE & 1) { p0_prologue(F); __syncthreads(); } }
    SEAM(0);
    if (IN(1)) { { {
        { pg8::Gemm g{(const bf16*)(ws + WS_MEMN), (const bf16*)(ws + WS_WMKVT), NB * NMEM, 768, DM, DM, DM}; pg8::StaticOrder S; S.init(g.M, g.N, F.G, F.bid);
          pg8::EpiBf16<0> E{(bf16*)(ws + WS_MKV), 1536}; pg8::gemm_phase(F.lds, g, S, E); }
        { pg8::Gemm g{(const bf16*)(ws + WS_WMKVT) + (size_t)768 * DM, (const bf16*)(ws + WS_MEMN), 768, NB * NMEM, DM, DM, DM}; pg8::StaticOrder S; S.init(g.M, g.N, F.G, F.G - 1 - F.bid);
          pg8::EpiBf16<0> E{(bf16*)(ws + WS_MVT), NB * NMEM}; pg8::gemm_phase(F.lds, g, S, E); }
        { pg8::Gemm g{ACT1, WallT, HT, NPROJ, DM, DM, DM}; pg8::StaticOrder S; S.init(g.M, g.N, F.G, F.bid);
          pg8::EpiBf16<0> E{BIG, NPROJ}; pg8::gemm_phase(F.lds, g, S, E); }
    } }
      if (PROBE & 2) { {
        { pg8::Gemm g{(const bf16*)(ws + WS_MEMN), (const bf16*)(ws + WS_WMKVT), NB * NMEM, 768, DM, DM, DM}; pg8::StaticOrder S; S.init(g.M, g.N, F.G, F.bid);
          pg8::EpiBf16<0> E{(bf16*)(ws + WS_MKV), 1536}; pg8::gemm_phase(F.lds, g, S, E); }
        { pg8::Gemm g{(const bf16*)(ws + WS_WMKVT) + (size_t)768 * DM, (const bf16*)(ws + WS_MEMN), 768, NB * NMEM, DM, DM, DM}; pg8::StaticOrder S; S.init(g.M, g.N, F.G, F.G - 1 - F.bid);
          pg8::EpiBf16<0> E{(bf16*)(ws + WS_MVT), NB * NMEM}; pg8::gemm_phase(F.lds, g, S, E); }
        { pg8::Gemm g{ACT1, WallT, HT, NPROJ, DM, DM, DM}; pg8::StaticOrder S; S.init(g.M, g.N, F.G, F.bid);
          pg8::EpiBf16<0> E{BIG, NPROJ}; pg8::gemm_phase(F.lds, g, S, E); }
    } } }
    SEAM(1);
    if (IN(2)) { qkprep_phase(F, 0); ssdC_phase(F, 0); if (PROBE & 4) ssdC_phase(F, 0); }
    SEAM(2);
    if (IN(3)) { ssdD_phase(F); dilattn_mfma_phase(F, 0); memattn_mfma_phase(F, 0); if (PROBE & 64) { ssdD_phase(F); memattn_mfma_phase(F, 0); } }
    SEAM(3);
    if (IN(4)) { ssdE_phase(F, 0); dilmerge_phase(F, 0); if (PROBE & 32) { ssdE_phase(F, 0); dilmerge_phase(F, 0); } }
    SEAM(4);
    if (IN(5)) { { { pg8::Gemm g{ACT1 + (size_t)HT * DM, WallT, HT, NPROJ, DM, DM, DM}; pg8::StaticOrder S; S.init(g.M, g.N, F.G, F.bid);
        pg8::EpiBf16<0> E{BIG, NPROJ}; pg8::gemm_phase(F.lds, g, S, E); } }
      if (PROBE & 2) { { pg8::Gemm g{ACT1 + (size_t)HT * DM, WallT, HT, NPROJ, DM, DM, DM}; pg8::StaticOrder S; S.init(g.M, g.N, F.G, F.bid);
        pg8::EpiBf16<0> E{BIG, NPROJ}; pg8::gemm_phase(F.lds, g, S, E); } } }
    SEAM(5);
    if (IN(6)) { qkprep_phase(F, 1); ssdC_phase(F, 1); if (PROBE & 4) ssdC_phase(F, 1); }
    SEAM(6);
    if (IN(7)) { ssdD_phase(F); dilattn_mfma_phase(F, 1); memattn_mfma_phase(F, 1); if (PROBE & 64) { ssdD_phase(F); memattn_mfma_phase(F, 1); } }
    SEAM(7);
    if (IN(8)) { ssdE_phase(F, 1); dilmerge_phase(F, 1); if (PROBE & 32) { ssdE_phase(F, 1); dilmerge_phase(F, 1); } }
    SEAM(8);
    if (IN(9)) { { { pg8::Gemm g{ACT1, WallT + (size_t)NPROJ * DM, T, NGATE, DM, DM, DM}; pg8::StaticOrder S; S.init(g.M, g.N, F.G, F.bid);
        pg8::EpiBf16<1> E{BIG, NGATE}; pg8::gemm_phase(F.lds, g, S, E); } }
      if (PROBE & 2) { { pg8::Gemm g{ACT1, WallT + (size_t)NPROJ * DM, T, NGATE, DM, DM, DM}; pg8::StaticOrder S; S.init(g.M, g.N, F.G, F.bid);
        pg8::EpiBf16<1> E{BIG, NGATE}; pg8::gemm_phase(F.lds, g, S, E); } } }
    SEAM(9);
    if (IN(10)) { { {
        const bf16* Yc = (const bf16*)F.out; const bf16* Wc = (const bf16*)(ws + WS_WCATT);
        { pg8::Gemm g{Yc, Wc, T, DM, 1024, YC, YC}; pg8::StaticOrder S; S.init(g.M, g.N, F.G, F.bid); pg8::EpiBranch<false> E{ACT1, DM, BIG, NGATE, 0}; pg8::gemm_phase(F.lds, g, S, E); }
        { pg8::Gemm g{Yc + 1024, Wc + 1024, T, DM, 256, YC, YC}; pg8::StaticOrder S; S.init(g.M, g.N, F.G, F.bid); pg8::EpiBranch<true> E{ACT1, DM, BIG, NGATE, 1024}; pg8::gemm_phase(F.lds, g, S, E); }
        { pg8::Gemm g{Yc + 1280, Wc + 1280, T, DM, 768, YC, YC}; pg8::StaticOrder S; S.init(g.M, g.N, F.G, F.bid); pg8::EpiBranch<true> E{ACT1, DM, BIG, NGATE, 2048}; pg8::gemm_phase(F.lds, g, S, E); }
    } }
      if (PROBE & 2) { {
        const bf16* Yc = (const bf16*)F.out; const bf16* Wc = (const bf16*)(ws + WS_WCATT);
        { pg8::Gemm g{Yc, Wc, T, DM, 1024, YC, YC}; pg8::StaticOrder S; S.init(g.M, g.N, F.G, F.bid); pg8::EpiBranch<false> E{ACT1, DM, BIG, NGATE, 0}; pg8::gemm_phase(F.lds, g, S, E); }
        { pg8::Gemm g{Yc + 1024, Wc + 1024, T, DM, 256, YC, YC}; pg8::StaticOrder S; S.init(g.M, g.N, F.G, F.bid); pg8::EpiBranch<true> E{ACT1, DM, BIG, NGATE, 1024}; pg8::gemm_phase(F.lds, g, S, E); }
        { pg8::Gemm g{Yc + 1280, Wc + 1280, T, DM, 768, YC, YC}; pg8::StaticOrder S; S.init(g.M, g.N, F.G, F.bid); pg8::EpiBranch<true> E{ACT1, DM, BIG, NGATE, 2048}; pg8::gemm_phase(F.lds, g, S, E); }
    } } }
    SEAM(10);
    if (IN(11)) { { { pg8::Gemm g{ACT1, (const bf16*)(ws + WS_WOUTT), T, DM, DM, DM, DM}; pg8::StaticOrder S; S.init(g.M, g.N, F.G, F.bid);
        pg8::EpiResid E{F.out, DM, F.in[I_X]}; pg8::gemm_phase(F.lds, g, S, E); } }
      if (PROBE & 2) { { pg8::Gemm g{ACT1, (const bf16*)(ws + WS_WOUTT), T, DM, DM, DM, DM}; pg8::StaticOrder S; S.init(g.M, g.N, F.G, F.bid);
        pg8::EpiResid E{F.out, DM, F.in[I_X]}; pg8::gemm_phase(F.lds, g, S, E); } } }
    SEAM(11);
    if (IN(12)) { { hn_phase(F); }
      if (PROBE & 2) { hn_phase(F); } }
    SEAM(12);
    if (IN(13)) { { { pg8::Gemm g{ACT1, (const bf16*)(ws + WS_WQT), T, PEER_Q, DM, DM, DM}; pg8::StaticOrder S; S.init(g.M, g.N, F.G, F.bid);
        pg8::EpiBf16<0> E{BIG, PEER_Q}; pg8::gemm_phase(F.lds, g, S, E); } }
      if (PROBE & 2) { { pg8::Gemm g{ACT1, (const bf16*)(ws + WS_WQT), T, PEER_Q, DM, DM, DM}; pg8::StaticOrder S; S.init(g.M, g.N, F.G, F.bid);
        pg8::EpiBf16<0> E{BIG, PEER_Q}; pg8::gemm_phase(F.lds, g, S, E); } } }
    SEAM(13);
    if (IN(14)) peer_phase(F);
#undef IN
#undef SEAM
}

extern "C" void kernel_launch(void* const* d_in, const int* in_sizes, int n_in, void* d_out, int out_size, void* d_ws, size_t ws_size, hipStream_t stream) {
    static int grid = 0;
    if (grid == 0) {
        if (n_in != 26 || out_size != T * DM || ws_size < WS_END) { fprintf(stderr, "kernel_launch: unexpected shapes (n_in %d, out %d, ws %zu)\n", n_in, out_size, ws_size); grid = -1; return; }
        int dev = 0, cus = 0;
        if (hipGetDevice(&dev) != hipSuccess || hipDeviceGetAttribute(&cus, hipDeviceAttributeMultiprocessorCount, dev) != hipSuccess) { grid = -1; return; }
        if (hipFuncSetAttribute((const void*)mega_fwd, hipFuncAttributeMaxDynamicSharedMemorySize, LDS_BYTES) != hipSuccess) { grid = -1; return; }
        int per_cu = 0;
        (void)hipOccupancyMaxActiveBlocksPerMultiprocessor(&per_cu, (const void*)mega_fwd, NTHR, LDS_BYTES);
        (void)hipGetLastError();
        grid = cus;
    }
    if (grid < 0) return;
    (void)hipMemsetAsync((char*)d_ws + WS_CTL, 0, CTL_ZERO_BYTES, stream);
    Args a{};
    for (int i = 0; i < 26; ++i) a.in[i] = (const float*)d_in[i];
    a.positions = (const int*)d_in[2]; a.out = (float*)d_out; a.ws = (unsigned char*)d_ws;
#if MK_N_LAUNCHES == 1
    a.ph_lo = 0; a.ph_hi = N_PHASES;
    hipLaunchKernelGGL(mega_fwd, dim3(grid), dim3(NTHR), LDS_BYTES, stream, a);
#else
    for (int p = 0; p < N_PHASES; ++p) { a.ph_lo = p; a.ph_hi = p + 1; hipLaunchKernelGGL(mega_fwd, dim3(grid), dim3(NTHR), LDS_BYTES, stream, a); }
#endif
}
```

```cpp
#include <hip/hip_runtime.h>
#include <cstdio>
#include <cstdint>

#ifndef MK_N_LAUNCHES
#define MK_N_LAUNCHES 1
#endif

#define LAS __attribute__((address_space(3)))
#define GAS __attribute__((address_space(1)))
typedef unsigned short bf16;
typedef short bf16x8 __attribute__((ext_vector_type(8)));
typedef float f32x4 __attribute__((ext_vector_type(4)));
typedef float f32x2 __attribute__((ext_vector_type(2)));
typedef unsigned u32x4 __attribute__((ext_vector_type(4)));
typedef unsigned u32x2 __attribute__((ext_vector_type(2)));

constexpr int NB = 8, SEQ = 8192, DM = 1024, T = NB * SEQ;
constexpr int HB = 4, HT = HB * SEQ;
constexpr int NMEM = 256;
constexpr int NPROJ = 6144;
constexpr int PC_Z = 0, PC_X = 1024, PC_B = 2048, PC_C = 2560, PC_DQ = 3072, PC_DK = 3840, PC_DV = 4608, PC_MQ = 5376;
constexpr int W_IN_N = 9232, OFF_DT = 3072, OFF_AFTER_DT = 3088;
constexpr int NGATE = 3072;
constexpr int YC = 2048;
constexpr int PEER_H = 8, PEER_K = 16, PEER_NK = 128, PEER_Q = 2048;
constexpr float EPS = 1e-6f;

constexpr size_t MiB = 1u << 20;
constexpr size_t WS_CTL = 0, CTL_ZERO_BYTES = 65536;
constexpr size_t WS_WALLT = 1 * MiB;
constexpr size_t WS_WMKVT = 19 * MiB;
constexpr size_t WS_WCATT = 22 * MiB;
constexpr size_t WS_WOUTT = 26 * MiB;
constexpr size_t WS_WQT = 28 * MiB;
constexpr size_t WS_SUBK = 32 * MiB;
constexpr size_t WS_PD = 33 * MiB;
constexpr size_t WS_PU = 65 * MiB;
constexpr size_t WS_DT = 97 * MiB;
constexpr size_t WS_MEMN = 101 * MiB;
constexpr size_t WS_MKV = 105 * MiB;
constexpr size_t WS_ACT1 = 112 * MiB;
constexpr size_t WS_BIG = 240 * MiB;
constexpr size_t WS_LSE = 624 * MiB;
constexpr size_t WS_MVT = 628 * MiB;
constexpr size_t WS_DEC = 631 * MiB;
constexpr size_t WS_SST = 632 * MiB;
constexpr size_t WS_SIN = 760 * MiB;
constexpr size_t WS_END = 824 * MiB;

constexpr int RING_BYTES = 131072;
constexpr int LDSCTL_OFF = 143360;
constexpr int LDS_BYTES = 147456;
constexpr int NWAVES = 8, NTHR = 512;

__device__ __forceinline__ float bf2f(unsigned short b) { return __builtin_bit_cast(float, (unsigned)b << 16); }
__device__ __forceinline__ float bflo(unsigned w) { return __builtin_bit_cast(float, w << 16); }
__device__ __forceinline__ float bfhi(unsigned w) { return __builtin_bit_cast(float, w & 0xffff0000u); }
__device__ __forceinline__ unsigned f2bf(float f) { unsigned u = __builtin_bit_cast(unsigned, f); return (u + 0x7fffu + ((u >> 16) & 1u)) >> 16; }
__device__ __forceinline__ unsigned pk2(float lo, float hi) { return f2bf(lo) | (f2bf(hi) << 16); }
typedef float f32x16 __attribute__((ext_vector_type(16)));
typedef short s16x4 __attribute__((ext_vector_type(4)));
typedef __bf16 bf2_t __attribute__((ext_vector_type(2)));
__device__ __forceinline__ unsigned pkbf(float a, float b) { const f32x2 v = {a, b}; return __builtin_bit_cast(unsigned, __builtin_convertvector(v, bf2_t)); }
#define MFMA32(a, b, c) __builtin_amdgcn_mfma_f32_32x32x16_bf16((a), (b), (c), 0, 0, 0)
__device__ __forceinline__ float wave_sum(float v) {
#pragma unroll
    for (int o = 1; o < 64; o <<= 1) v += __shfl_xor(v, o);
    return v;
}
__device__ __forceinline__ float wave_max(float v) {
#pragma unroll
    for (int o = 1; o < 64; o <<= 1) v = fmaxf(v, __shfl_xor(v, o));
    return v;
}
__device__ __forceinline__ float sigmoidf_(float x) { return 1.0f / (1.0f + __expf(-x)); }
#define LDS_WAIT() asm volatile("s_waitcnt lgkmcnt(0)" ::: "memory")
#define VM_WAIT() asm volatile("s_waitcnt vmcnt(0)" ::: "memory")

#define XB_TMO      128
#define XB_XCNT(j)  (256  + 64 * (j))
#define XB_XSUB(j)  (1280 + 64 * (j))
#define XB_XGEN(j)  (2304 + 64 * (j))
#define XB_TOP      3328
#define XB_TOPGEN   3392
#define XCD_BAR_WORDS 3456
#define XB_SPIN_CAP (1u << 18)
__device__ __forceinline__ unsigned xb_ld(unsigned* p)              { return __hip_atomic_load(p, __ATOMIC_RELAXED, __HIP_MEMORY_SCOPE_AGENT); }
__device__ __forceinline__ unsigned xb_add(unsigned* p, unsigned v) { return __hip_atomic_fetch_add(p, v, __ATOMIC_RELAXED, __HIP_MEMORY_SCOPE_AGENT); }
__device__ __forceinline__ unsigned xb_xcc_id() { return (unsigned)__builtin_amdgcn_s_getreg((3 << 11) | 20) & 0xFu; }
#define XB_SPIN(cond, bar) do { unsigned _sp = 0; while (cond) { __builtin_amdgcn_s_sleep(1); \
    if ((++_sp & 255u) == 0u) { if (xb_ld(&(bar)[XB_TMO])) break; if (_sp > XB_SPIN_CAP) { atomicAdd(&(bar)[XB_TMO], 1u); break; } } } } while (0)
struct XcdBarrier { unsigned* bar; unsigned x; volatile LAS unsigned* st; };
__device__ __forceinline__ XcdBarrier xcd_barrier_post(unsigned* bar, volatile LAS unsigned* st) {
    XcdBarrier b; b.bar = bar; b.x = xb_xcc_id(); b.st = st;
    if (threadIdx.x == 0) (void)xb_add(&bar[XB_XCNT(b.x)], 1u);
    return b;
}
__device__ __forceinline__ void xcd_barrier_complete(unsigned* bar, unsigned x, unsigned& nloc, unsigned& nx) {
    const unsigned G = gridDim.x * gridDim.y * gridDim.z;
    unsigned sum, cnt, mine, sp = 0u;
    for (;;) {
        sum = 0u; cnt = 0u; mine = 0u;
#pragma unroll
        for (unsigned j = 0; j < 16; ++j) { const unsigned c = xb_ld(&bar[XB_XCNT(j)]); sum += c; cnt += (c > 0u) ? 1u : 0u; mine = (j == x) ? c : mine; }
        if (sum == G) break;
        __builtin_amdgcn_s_sleep(1);
        if ((++sp & 255u) == 0u) { if (xb_ld(&bar[XB_TMO])) break; if (sp > XB_SPIN_CAP) { atomicAdd(&bar[XB_TMO], 1u); break; } }
    }
    nloc = mine > 0u ? mine : 1u; nx = cnt > 0u ? cnt : 1u;
}
__device__ __forceinline__ void xcd_barrier(const XcdBarrier& b) {
    asm volatile("s_waitcnt vmcnt(0)" ::: "memory");
    __syncthreads();
    if (threadIdx.x == 0) {
        unsigned* bar = b.bar;
        __builtin_amdgcn_s_waitcnt(0);
        unsigned nloc = b.st[0], nx = b.st[1];
        if (nloc == 0u) { xcd_barrier_complete(bar, b.x, nloc, nx); b.st[0] = nloc; b.st[1] = nx; }
        const unsigned old = xb_add(&bar[XB_XSUB(b.x)], 1u);
        const unsigned gen = old / nloc;
        if (old + 1u == (gen + 1u) * nloc) {
            __builtin_amdgcn_fence(__ATOMIC_RELEASE, "agent");
            asm volatile("s_waitcnt vmcnt(0)" ::: "memory");
            const unsigned og = xb_add(&bar[XB_TOP], 1u);
            const unsigned tg = og / nx;
            if (og + 1u == (tg + 1u) * nx) xb_add(&bar[XB_TOPGEN], 1u);
            else XB_SPIN(xb_ld(&bar[XB_TOPGEN]) == tg, bar);
            __builtin_amdgcn_fence(__ATOMIC_ACQUIRE, "agent");
            xb_add(&bar[XB_XGEN(b.x)], 1u);
            asm volatile("s_waitcnt vmcnt(0)" ::: "memory");
        } else {
            XB_SPIN(xb_ld(&bar[XB_XGEN(b.x)]) == gen, bar);
            __builtin_amdgcn_fence(__ATOMIC_ACQUIRE, "agent");
            asm volatile("s_waitcnt vmcnt(0)" ::: "memory");
        }
    }
    __syncthreads();
}

namespace pg8 {
constexpr int BM = 256, BK = 64, HALF = 128, HTB = HALF * BK * 2, STAGE_BYTES = 8 * HTB, NXCD = 8, WGM = 8;
__host__ __device__ __forceinline__ int lds_byte(int r, int c) { const int st = (r >> 4) * 2 + (c >> 5), rr = r & 15, cc = c & 31, ob = rr * 64 + cc * 2; return st * 1024 + (ob ^ (((ob >> 9) & 1) << 5)); }
__host__ __device__ __forceinline__ void stage_rc(int b, int& R, int& C) { const int st = b / 1024, sb = b % 1024, swz = sb ^ (((sb >> 9) & 1) << 5); R = (st >> 1) * 16 + swz / 64; C = (st & 1) * 32 + (swz % 64) / 2; }
__host__ __device__ __forceinline__ int perm32(int rho) { const int n = rho >> 4, i = rho & 15; return 8 * (i >> 2) + 4 * n + (i & 3); }
struct Unit { int pm, pn; };
struct Gemm { const bf16* A; const bf16* Bt; int M, N, K, lda, ldb; };
struct StaticOrder {
    int nM, nN, nwg, G, c;
    __host__ __device__ void init(int M, int N, int G_, int c_) { nM = M / BM; nN = N / BM; nwg = nM * nN; G = G_; c = c_; }
    __host__ __device__ bool next(int i, Unit& u) const {
        const long L = (long)i * G + c; if (L >= nwg) return false;
        int wgid = (int)L; { const int q = nwg / NXCD, r = nwg % NXCD, xcd = wgid % NXCD, off = wgid / NXCD; wgid = (xcd < r ? xcd * (q + 1) : r * (q + 1) + (xcd - r) * q) + off; }
        const int nig = WGM * nN, gid = wgid / nig, fm = gid * WGM, gsz = (nM - fm) < WGM ? (nM - fm) : WGM;
        u.pm = fm + ((wgid % nig) % gsz); u.pn = (wgid % nig) / gsz; return true;
    }
    __device__ __forceinline__ void a_ready(const Unit&) const {}
    __device__ __forceinline__ void done(const Unit&) const {}
};
__device__ __forceinline__ unsigned cvt_pk_bf16(float lo, float hi) { unsigned r; asm volatile("v_cvt_pk_bf16_f32 %0, %1, %2" : "=v"(r) : "v"(lo), "v"(hi)); return r; }

template <int ACT> struct EpiBf16 {
    static constexpr bool PERM = true, AFTER_DRAIN = false;
    bf16* O; int ldc;
    __device__ __forceinline__ void operator()(const f32x4 (&acc)[2][2][4][2], const Unit& u, int wr, int wc, int fr, int fq) const {
        const int row0 = u.pm * BM + wr * 64 + fr; const int col0 = u.pn * BM + wc * 32 + 8 * fq;
#pragma unroll
        for (int ai = 0; ai < 2; ++ai)
#pragma unroll
            for (int m = 0; m < 4; ++m) { bf16* rowp = O + (size_t)(row0 + ai * HALF + m * 16) * ldc + col0;
#pragma unroll
                for (int bj = 0; bj < 2; ++bj) { f32x4 v0 = acc[ai][bj][m][0], v1 = acc[ai][bj][m][1];
                    if (ACT == 1) {
#pragma unroll
                        for (int j = 0; j < 4; ++j) { v0[j] = sigmoidf_(v0[j]); v1[j] = sigmoidf_(v1[j]); } }
                    u32x4 w; w.x = cvt_pk_bf16(v0[0], v0[1]); w.y = cvt_pk_bf16(v0[2], v0[3]); w.z = cvt_pk_bf16(v1[0], v1[1]); w.w = cvt_pk_bf16(v1[2], v1[3]);
                    *(u32x4*)(rowp + bj * HALF) = w; } }
    }
};
template <bool ACCUM> struct EpiBranch {
    static constexpr bool PERM = true, AFTER_DRAIN = false;
    bf16* O; int ldc; const bf16* Gt; int ldg; int gcol0;
    __device__ __forceinline__ void operator()(const f32x4 (&acc)[2][2][4][2], const Unit& u, int wr, int wc, int fr, int fq) const {
        const int row0 = u.pm * BM + wr * 64 + fr; const int col0 = u.pn * BM + wc * 32 + 8 * fq;
#pragma unroll
        for (int ai = 0; ai < 2; ++ai)
#pragma unroll
            for (int m = 0; m < 4; ++m) { const size_t r = (size_t)(row0 + ai * HALF + m * 16); bf16* rowp = O + r * ldc + col0; const bf16* gp = Gt + r * ldg + gcol0 + col0;
#pragma unroll
                for (int bj = 0; bj < 2; ++bj) { const f32x4 v0 = acc[ai][bj][m][0], v1 = acc[ai][bj][m][1];
                    const u32x4 g = *(const u32x4*)(gp + bj * HALF);
                    float o[8];
                    o[0] = v0[0] * bflo(g.x); o[1] = v0[1] * bfhi(g.x); o[2] = v0[2] * bflo(g.y); o[3] = v0[3] * bfhi(g.y);
                    o[4] = v1[0] * bflo(g.z); o[5] = v1[1] * bfhi(g.z); o[6] = v1[2] * bflo(g.w); o[7] = v1[3] * bfhi(g.w);
                    if (ACCUM) { const u32x4 p = *(const u32x4*)(rowp + bj * HALF);
                        o[0] += bflo(p.x); o[1] += bfhi(p.x); o[2] += bflo(p.y); o[3] += bfhi(p.y); o[4] += bflo(p.z); o[5] += bfhi(p.z); o[6] += bflo(p.w); o[7] += bfhi(p.w); }
                    u32x4 w; w.x = cvt_pk_bf16(o[0], o[1]); w.y = cvt_pk_bf16(o[2], o[3]); w.z = cvt_pk_bf16(o[4], o[5]); w.w = cvt_pk_bf16(o[6], o[7]);
                    *(u32x4*)(rowp + bj * HALF) = w; } }
    }
};
struct EpiResid {
    static constexpr bool PERM = false, AFTER_DRAIN = false;
    float* C; int ldc; const float* R;
    __device__ __forceinline__ void operator()(const f32x4 (&acc)[2][2][4][2], const Unit& u, int wr, int wc, int fr, int fq) const {
        const int row0 = u.pm * BM + wr * 64 + fr, col0 = u.pn * BM + wc * 32 + 4 * fq;
#pragma unroll
        for (int ai = 0; ai < 2; ++ai)
#pragma unroll
            for (int m = 0; m < 4; ++m) { const size_t off = (size_t)(row0 + ai * HALF + m * 16) * ldc + col0;
#pragma unroll
                for (int bj = 0; bj < 2; ++bj)
#pragma unroll
                    for (int n = 0; n < 2; ++n) { const f32x4 r = *(const f32x4*)(R + off + bj * HALF + n * 16); *(f32x4*)(C + off + bj * HALF + n * 16) = acc[ai][bj][m][n] + r; } }
    }
};

template <class Epi, class Sched>
__device__ __forceinline__ void gemm_phase(LAS unsigned char* lds, const Gemm g, const Sched& S, const Epi& E) {
    const int tid = threadIdx.x, wid = __builtin_amdgcn_readfirstlane(tid >> 6), lane = tid & 63, wr = wid >> 2, wc = wid & 3, fr = lane & 15, fq = lane >> 4;
    const int K = g.K, nt = K / BK;
    unsigned voffA[2], voffB[2];
#pragma unroll
    for (int i = 0; i < 2; ++i) { int R, C; stage_rc(tid * 16 + i * 8192, R, C); const int Rb = Epi::PERM ? ((R & ~31) + perm32(R & 31)) : R;
        voffA[i] = (unsigned)(R * g.lda + C) * 2u; voffB[i] = (unsigned)(Rb * g.ldb + C) * 2u; }
    const size_t kstep = (size_t)(BK * 2);
    const size_t hsA = (size_t)HALF * g.lda * 2, hsB = (size_t)HALF * g.ldb * 2;
    const size_t tsA = 2 * hsA, tsB = 2 * hsB;
    const unsigned ldsw = (unsigned)wid * 1024u;
    const int aoff = lds_byte(wr * 64 + fr, fq * 8), boff = lds_byte(wc * 32 + fr, fq * 8);
#define PG8_SA(b, h) (((b) * 2 + (h)) * HTB)
#define PG8_SB(b, h) ((4 + (b) * 2 + (h)) * HTB)
#define PG8_STAGE(bufoff, gbase, voff) do { _Pragma("unroll") for (int _i = 0; _i < 2; ++_i) \
        __builtin_amdgcn_global_load_lds((const unsigned*)((const char*)(gbase) + (voff)[_i]), (LAS unsigned*)(lds + (bufoff) + ldsw + _i * 8192), 16, 0, 0); } while (0)
#define PG8_LDA(dst, b, h) do { _Pragma("unroll") for (int m = 0; m < 4; ++m) _Pragma("unroll") for (int k = 0; k < 2; ++k) dst[m][k] = *(const LAS bf16x8*)(lds + PG8_SA(b, h) + aoff + m * 2048 + k * 1024); } while (0)
#define PG8_LDB(dst, b, h) do { _Pragma("unroll") for (int n = 0; n < 2; ++n) _Pragma("unroll") for (int k = 0; k < 2; ++k) dst[n][k] = *(const LAS bf16x8*)(lds + PG8_SB(b, h) + boff + n * 2048 + k * 1024); } while (0)
#define PG8_MMA(ai, bj, At, Bt) do { __builtin_amdgcn_s_setprio(1); _Pragma("unroll") for (int m = 0; m < 4; ++m) _Pragma("unroll") for (int n = 0; n < 2; ++n) _Pragma("unroll") for (int k = 0; k < 2; ++k) \
        acc[ai][bj][m][n] = __builtin_amdgcn_mfma_f32_16x16x32_bf16(Bt[n][k], At[m][k], acc[ai][bj][m][n], 0, 0, 0); __builtin_amdgcn_s_setprio(0); } while (0)
#define PG8_WAIT_V(n) asm volatile("s_waitcnt vmcnt(" #n ")" ::: "memory")
#define PG8_WAIT_L(n) asm volatile("s_waitcnt lgkmcnt(" #n ")" ::: "memory")
#define PG8_BAR __builtin_amdgcn_s_barrier()
#define PG8_SCHED __builtin_amdgcn_sched_barrier(0)
    Unit cur, nxt; int ui = 0;
    if (!S.next(0, cur)) return;
    f32x4 acc[2][2][4][2];
#pragma unroll
    for (int a = 0; a < 2; ++a)
#pragma unroll
        for (int b = 0; b < 2; ++b)
#pragma unroll
            for (int m = 0; m < 4; ++m)
#pragma unroll
                for (int n = 0; n < 2; ++n) acc[a][b][m][n] = (f32x4){0.f, 0.f, 0.f, 0.f};
    bf16x8 At[4][2], B0[2][2], B1[2][2];
    const char* cA = (const char*)g.A + (size_t)cur.pm * tsA; const char* cB = (const char*)g.Bt + (size_t)cur.pn * tsB;
    S.a_ready(cur);
    PG8_STAGE(PG8_SB(0, 0), cB, voffB); PG8_STAGE(PG8_SA(0, 0), cA, voffA); PG8_STAGE(PG8_SB(0, 1), cB + hsB, voffB); PG8_STAGE(PG8_SA(0, 1), cA + hsA, voffA);
    if (wr == 1) PG8_BAR;
    PG8_WAIT_V(4); PG8_BAR;
    PG8_STAGE(PG8_SB(1, 0), cB + kstep, voffB); PG8_STAGE(PG8_SA(1, 0), cA + kstep, voffA); PG8_STAGE(PG8_SB(1, 1), cB + hsB + kstep, voffB);
    PG8_WAIT_V(6); PG8_BAR;
    for (;;) {
        const bool has_next = S.next(ui + 1, nxt);
        const char* nA = has_next ? (const char*)g.A + (size_t)nxt.pm * tsA : cA; const char* nB = has_next ? (const char*)g.Bt + (size_t)nxt.pn * tsB : cB;
        for (int t = 0; t < nt; t += 2) {
            const bool last = (t == nt - 2);
            const char* a1 = cA + (size_t)(t + 1) * kstep;
            const char* a2 = last ? nA : cA + (size_t)(t + 2) * kstep; const char* b2 = last ? nB : cB + (size_t)(t + 2) * kstep;
            const char* a3 = a2 + kstep; const char* b3 = b2 + kstep;
            if (last && has_next) S.a_ready(nxt);
            PG8_LDB(B0, 0, 0); PG8_SCHED; PG8_LDA(At, 0, 0); PG8_STAGE(PG8_SA(1, 1), a1 + hsA, voffA);
            PG8_WAIT_L(8); PG8_BAR; PG8_WAIT_L(0); PG8_MMA(0, 0, At, B0); PG8_BAR; PG8_SCHED;
            PG8_LDB(B1, 0, 1); PG8_STAGE(PG8_SB(0, 0), b2, voffB);
            PG8_BAR; PG8_WAIT_L(0); PG8_MMA(0, 1, At, B1); PG8_BAR;
            PG8_LDA(At, 0, 1); PG8_STAGE(PG8_SA(0, 0), a2, voffA);
            PG8_BAR; PG8_WAIT_L(0); PG8_MMA(1, 0, At, B0); PG8_BAR; PG8_SCHED;
            PG8_STAGE(PG8_SB(0, 1), b2 + hsB, voffB);
            PG8_WAIT_V(6); PG8_BAR; PG8_MMA(1, 1, At, B1); PG8_BAR;
            PG8_LDB(B0, 1, 0); PG8_SCHED; PG8_LDA(At, 1, 0); PG8_STAGE(PG8_SA(0, 1), a2 + hsA, voffA);
            PG8_WAIT_L(8); PG8_BAR; PG8_WAIT_L(0); PG8_MMA(0, 0, At, B0); PG8_BAR; PG8_SCHED;
            PG8_LDB(B1, 1, 1); PG8_STAGE(PG8_SB(1, 0), b3, voffB);
            PG8_BAR; PG8_WAIT_L(0); PG8_MMA(0, 1, At, B1); PG8_BAR;
            PG8_LDA(At, 1, 1); PG8_STAGE(PG8_SA(1, 0), a3, voffA);
            PG8_BAR; PG8_WAIT_L(0); PG8_MMA(1, 0, At, B0); PG8_BAR; PG8_SCHED;
            PG8_STAGE(PG8_SB(1, 1), b3 + hsB, voffB);
            PG8_WAIT_V(6); PG8_BAR; PG8_MMA(1, 1, At, B1); PG8_BAR;
        }
        E(acc, cur, wr, wc, fr, fq); S.done(cur);
        if (!has_next) break;
#pragma unroll
        for (int a = 0; a < 2; ++a)
#pragma unroll
            for (int b = 0; b < 2; ++b)
#pragma unroll
                for (int m = 0; m < 4; ++m)
#pragma unroll
                    for (int n = 0; n < 2; ++n) acc[a][b][m][n] = (f32x4){0.f, 0.f, 0.f, 0.f};
        cur = nxt; cA = nA; cB = nB; ++ui;
    }
    PG8_WAIT_V(0);
    if (wr == 0) PG8_BAR;
    PG8_BAR;
#undef PG8_SA
#undef PG8_SB
#undef PG8_STAGE
#undef PG8_LDA
#undef PG8_LDB
#undef PG8_MMA
#undef PG8_WAIT_V
#undef PG8_WAIT_L
#undef PG8_BAR
#undef PG8_SCHED
}
}

#ifndef PROBE
#define PROBE 0
#endif
struct Args {
    const float* in[26]; const int* positions; float* out; unsigned char* ws; int ph_lo, ph_hi; int pad0, pad1;
};
struct Frame {
    LAS unsigned char* lds;
    int tid, lane, wave, G, bid;
    const float* in[26]; const int* positions; float* out; unsigned char* ws;
};
enum { I_X = 0, I_MEM = 1, I_POS = 2, I_NMIXW = 3, I_WIN = 4, I_CONVW = 5, I_CONVB = 6, I_DTB = 7, I_ALOG = 8, I_SSDD = 9, I_SSDNW = 10, I_DQNW = 11, I_DKNW = 12, I_MEMNW = 13,
       I_WMKV = 14, I_MQNW = 15, I_MKNW = 16, I_WSSD = 17, I_WDIL = 18, I_WMEMBR = 19, I_WOUT = 20, I_NFFNW = 21, I_WQ = 22, I_SUBK = 23, I_PD = 24, I_PU = 25 };

__device__ __forceinline__ void p0_transpose_item(const float* W, int ldw, int src_col0, bf16* WT, int ldt, int dst_row0, int dst_col0, int nblk, LAS float* scr, int item, int lane) {
    const int kb = item / nblk, nb = item % nblk, k0 = 64 * kb, n0 = 32 * nb;
#pragma unroll 8
    for (int i = 0; i < 32; ++i) { const int kk = 2 * i + (lane >> 5); scr[kk * 33 + (lane & 31)] = W[(size_t)(k0 + kk) * ldw + src_col0 + n0 + (lane & 31)]; }
    LDS_WAIT(); asm volatile("" ::: "memory");
    const int c = lane & 7;
#pragma unroll
    for (int j = 0; j < 4; ++j) { const int n = (lane >> 3) + 8 * j; const LAS float* s = scr + (8 * c) * 33 + n;
        u32x4 o; o.x = pk2(s[0 * 33], s[1 * 33]); o.y = pk2(s[2 * 33], s[3 * 33]); o.z = pk2(s[4 * 33], s[5 * 33]); o.w = pk2(s[6 * 33], s[7 * 33]);
        *(u32x4*)(WT + (size_t)(dst_row0 + n0 + n) * ldt + dst_col0 + k0 + 8 * c) = o; }
    LDS_WAIT(); asm volatile("" ::: "memory");
}
__device__ __forceinline__ void rms_row_to_bf16(const float* xrow, const float* w, bf16* orow, int lane, f32x4 (&v)[4]) {
    const f32x4* xr = (const f32x4*)xrow + lane; const f32x4* wr = (const f32x4*)w + lane;
    float s = 0.f;
#pragma unroll
    for (int j = 0; j < 4; ++j) { v[j] = xr[64 * j]; s += (v[j].x * v[j].x + v[j].y * v[j].y) + (v[j].z * v[j].z + v[j].w * v[j].w); }
    const float rstd = 1.0f / sqrtf(wave_sum(s) * (1.f / DM) + EPS);
    unsigned long long* o8 = (unsigned long long*)orow + lane;
#pragma unroll
    for (int j = 0; j < 4; ++j) { const f32x4 ww = wr[64 * j]; v[j] = v[j] * rstd * ww;
        o8[64 * j] = (unsigned long long)pk2(v[j].x, v[j].y) | ((unsigned long long)pk2(v[j].z, v[j].w) << 32); }
}
__device__ __forceinline__ void cvt_f32_bf16_stream(const float* src, bf16* dst, size_t n, size_t gtid, size_t gthreads) {
    for (size_t i = gtid * 8; i < n; i += gthreads * 8) { const f32x4 a = *(const f32x4*)(src + i), b = *(const f32x4*)(src + i + 4);
        u32x4 o; o.x = pk2(a.x, a.y); o.y = pk2(a.z, a.w); o.z = pk2(b.x, b.y); o.w = pk2(b.z, b.w); *(u32x4*)(dst + i) = o; }
}
constexpr float PD_SCALE = 64.0f, PU_SCALE = 8.0f;
__device__ __forceinline__ unsigned pk4_fp8(f32x4 v, float sc) {
    const float a = fminf(fmaxf(v.x * sc, -448.f), 448.f), b = fminf(fmaxf(v.y * sc, -448.f), 448.f), c = fminf(fmaxf(v.z * sc, -448.f), 448.f), d = fminf(fmaxf(v.w * sc, -448.f), 448.f);
    unsigned p = __builtin_amdgcn_cvt_pk_fp8_f32(a, b, 0, false); return __builtin_amdgcn_cvt_pk_fp8_f32(c, d, p, true);
}
__device__ __forceinline__ void cvt_f32_fp8_sliced(const float* src, unsigned char* dst, float sc, size_t gtid, size_t gthreads) {
    for (size_t i = gtid * 16; i < (size_t)16384 * 1024; i += gthreads * 16) { const f32x4 a = *(const f32x4*)(src + i), b = *(const f32x4*)(src + i + 4), c = *(const f32x4*)(src + i + 8), d = *(const f32x4*)(src + i + 12);
        const size_t e = i >> 10, dd = i & 1023;
        const u32x4 o = {pk4_fp8(a, sc), pk4_fp8(b, sc), pk4_fp8(c, sc), pk4_fp8(d, sc)}; *(u32x4*)(dst + ((((dd >> 7) * 16384 + e) << 7) + (dd & 127))) = o; }
}
__device__ __forceinline__ void p0_prologue(Frame& F) {
    LAS float* scr = (LAS float*)(F.lds + F.wave * 8448);
    LAS float* wdt = (LAS float*)(F.lds + 8 * 8448);
    const int gw = F.bid * NWAVES + F.wave, NGW = F.G * NWAVES;
    unsigned char* ws = F.ws;
    for (int i = F.tid; i < 1024 * 16; i += NTHR) { const int k = i >> 4, c = i & 15, l = (k & 255) >> 2, e = k & 3, j = k >> 8, q = c >> 2;
        wdt[((((j * 4 + e) * 4 + q) * 64 + l) << 2) + (c & 3)] = F.in[I_WIN][(size_t)k * W_IN_N + OFF_DT + c]; }
    __syncthreads();
    constexpr int IT_A = 16 * 96, IT_B = 16 * 192, IT_MKV = 16 * 48, IT_SSD = 16 * 32, IT_DIL = 4 * 32, IT_MBR = 12 * 32, IT_OUT = 16 * 32, IT_WQ = 16 * 64;
    constexpr int NITEMS = IT_A + IT_B + IT_MKV + IT_SSD + IT_DIL + IT_MBR + IT_OUT + IT_WQ;
    bf16* WallT = (bf16*)(ws + WS_WALLT);
    for (int it = gw; it < NITEMS; it += NGW) {
        int r = it;
        if (r < IT_A) { p0_transpose_item(F.in[I_WIN], W_IN_N, 0, WallT, DM, 0, 0, 96, scr, r, F.lane); continue; } r -= IT_A;
        if (r < IT_B) { p0_transpose_item(F.in[I_WIN], W_IN_N, OFF_AFTER_DT, WallT, DM, 3072, 0, 192, scr, r, F.lane); continue; } r -= IT_B;
        if (r < IT_MKV) { p0_transpose_item(F.in[I_WMKV], 1536, 0, (bf16*)(ws + WS_WMKVT), DM, 0, 0, 48, scr, r, F.lane); continue; } r -= IT_MKV;
        if (r < IT_SSD) { p0_transpose_item(F.in[I_WSSD], DM, 0, (bf16*)(ws + WS_WCATT), YC, 0, 0, 32, scr, r, F.lane); continue; } r -= IT_SSD;
        if (r < IT_DIL) { p0_transpose_item(F.in[I_WDIL], DM, 0, (bf16*)(ws + WS_WCATT), YC, 0, 1024, 32, scr, r, F.lane); continue; } r -= IT_DIL;
        if (r < IT_MBR) { p0_transpose_item(F.in[I_WMEMBR], DM, 0, (bf16*)(ws + WS_WCATT), YC, 0, 1280, 32, scr, r, F.lane); continue; } r -= IT_MBR;
        if (r < IT_OUT) { p0_transpose_item(F.in[I_WOUT], DM, 0, (bf16*)(ws + WS_WOUTT), DM, 0, 0, 32, scr, r, F.lane); continue; } r -= IT_OUT;
        p0_transpose_item(F.in[I_WQ], PEER_Q, 0, (bf16*)(ws + WS_WQT), DM, 0, 0, 64, scr, r, F.lane);
    }
    const size_t gtid = (size_t)F.bid * NTHR + F.tid, gth = (size_t)F.G * NTHR;
    cvt_f32_bf16_stream(F.in[I_SUBK], (bf16*)(ws + WS_SUBK), (size_t)8 * 2 * 128 * 128, gtid, gth);
    cvt_f32_fp8_sliced(F.in[I_PD], ws + WS_PD, PD_SCALE, gtid, gth);
    cvt_f32_fp8_sliced(F.in[I_PU], ws + WS_PU, PU_SCALE, gtid, gth);
    for (int m = gw; m < NB * NMEM; m += NGW) { f32x4 v[4]; rms_row_to_bf16(F.in[I_MEM] + (size_t)m * DM, F.in[I_MEMNW], (bf16*)(ws + WS_MEMN) + (size_t)m * DM, F.lane, v); }
    float* DTp = (float*)(ws + WS_DT);
    const int lane = F.lane;
    const int myj = ((lane >> 5) & 1) * 8 + ((lane >> 4) & 1) * 4 + ((lane >> 3) & 1) * 2 + ((lane >> 2) & 1);
    const float dtb = F.in[I_DTB][myj];
    for (int m = 2 * gw; m < T; m += 2 * NGW) {
        f32x4 va[4], vb[4];
        rms_row_to_bf16(F.in[I_X] + (size_t)m * DM, F.in[I_NMIXW], (bf16*)(ws + WS_ACT1) + (size_t)m * DM, lane, va);
        rms_row_to_bf16(F.in[I_X] + (size_t)(m + 1) * DM, F.in[I_NMIXW], (bf16*)(ws + WS_ACT1) + (size_t)(m + 1) * DM, lane, vb);
        float da[16], db[16];
#pragma unroll
        for (int j = 0; j < 16; ++j) { da[j] = 0.f; db[j] = 0.f; }
#pragma unroll
        for (int j = 0; j < 4; ++j)
#pragma unroll
            for (int e = 0; e < 4; ++e) { const float ua = va[j][e], ub = vb[j][e];
#pragma unroll
                for (int q = 0; q < 4; ++q) { const f32x4 w4 = *(const LAS f32x4*)(wdt + ((((j * 4 + e) * 4 + q) * 64 + lane) << 2));
                    da[4 * q + 0] += ua * w4.x; da[4 * q + 1] += ua * w4.y; da[4 * q + 2] += ua * w4.z; da[4 * q + 3] += ua * w4.w;
                    db[4 * q + 0] += ub * w4.x; db[4 * q + 1] += ub * w4.y; db[4 * q + 2] += ub * w4.z; db[4 * q + 3] += ub * w4.w; }
                __builtin_amdgcn_sched_barrier(0); }
        float ra, rb;
        { float r8a[8], r8b[8], r4a[4], r4b[4], r2a[2], r2b[2];
          { const bool up = (lane & 32) != 0;
#pragma unroll
            for (int k = 0; k < 8; ++k) { r8a[k] = (up ? da[k + 8] : da[k]) + __shfl_xor(up ? da[k] : da[k + 8], 32); r8b[k] = (up ? db[k + 8] : db[k]) + __shfl_xor(up ? db[k] : db[k + 8], 32); } }
          { const bool up = (lane & 16) != 0;
#pragma unroll
            for (int k = 0; k < 4; ++k) { r4a[k] = (up ? r8a[k + 4] : r8a[k]) + __shfl_xor(up ? r8a[k] : r8a[k + 4], 16); r4b[k] = (up ? r8b[k + 4] : r8b[k]) + __shfl_xor(up ? r8b[k] : r8b[k + 4], 16); } }
          { const bool up = (lane & 8) != 0;
#pragma unroll
            for (int k = 0; k < 2; ++k) { r2a[k] = (up ? r4a[k + 2] : r4a[k]) + __shfl_xor(up ? r4a[k] : r4a[k + 2], 8); r2b[k] = (up ? r4b[k + 2] : r4b[k]) + __shfl_xor(up ? r4b[k] : r4b[k + 2], 8); } }
          { const bool up = (lane & 4) != 0; ra = (up ? r2a[1] : r2a[0]) + __shfl_xor(up ? r2a[0] : r2a[1], 4); rb = (up ? r2b[1] : r2b[0]) + __shfl_xor(up ? r2b[0] : r2b[1], 4); }
          ra += __shfl_xor(ra, 2); ra += __shfl_xor(ra, 1); rb += __shfl_xor(rb, 2); rb += __shfl_xor(rb, 1); }
        if ((lane & 3) == 0) { const float xa = ra + dtb, xb = rb + dtb;
            DTp[(size_t)m * 16 + myj] = (xa > 20.f) ? xa : log1pf(__expf(xa)); DTp[(size_t)(m + 1) * 16 + myj] = (xb > 20.f) ? xb : log1pf(__expf(xb)); }
    }
}

__device__ __forceinline__ void qkprep_phase(Frame& F, int half) {
    bf16* P = (bf16*)(F.ws + WS_BIG);
    const int gw = F.bid * NWAVES + F.wave, NGW = F.G * NWAVES, lane = F.lane;
    const float wq = F.in[I_DQNW][lane], wk = F.in[I_DKNW][lane];
    const float wmq0 = F.in[I_MQNW][lane], wmq1 = F.in[I_MQNW][lane + 64], wmq2 = F.in[I_MQNW][lane + 128];
    const float inv = __expf(-logf(500000.0f) * (2.0f / 16.0f) * (float)(lane & 7));
    for (int r = gw; r < HT; r += NGW) {
        const int tok = half * HT + r;
        const int pos = F.positions[tok];
        const double rev = (double)((float)pos * inv) * 0.15915494309189535;
        const float fr = (float)(rev - floor(rev));
        const float cs = __builtin_amdgcn_cosf(fr), sn = __builtin_amdgcn_sinf(fr);
        bf16* row = P + (size_t)r * NPROJ;
#pragma unroll 4
        for (int h = 0; h < 24; ++h) {
            bf16* p = row + PC_DQ + h * 64 + lane;
            float v = bf2f(*p);
            const float ss = wave_sum(v * v);
            v = v * (1.0f / sqrtf(ss * (1.f / 64.f) + EPS)) * (h < 12 ? wq : wk);
            const float other = __shfl_xor(v, 8);
            if (lane < 8) v = v * cs - other * sn; else if (lane < 16) v = v * cs + other * sn;
            *p = (bf16)f2bf(v);
        }
#pragma unroll
        for (int h = 0; h < 4; ++h) {
            bf16* p = row + PC_MQ + h * 192 + lane;
            float v0 = bf2f(p[0]), v1 = bf2f(p[64]), v2 = bf2f(p[128]);
            const float ss = wave_sum(v0 * v0 + v1 * v1 + v2 * v2);
            const float rs = 1.0f / sqrtf(ss * (1.f / 192.f) + EPS);
            p[0] = (bf16)f2bf(v0 * rs * wmq0); p[64] = (bf16)f2bf(v1 * rs * wmq1); p[128] = (bf16)f2bf(v2 * rs * wmq2);
        }
    }
    if (half == 0) {
        bf16* MK = (bf16*)(F.ws + WS_MKV);
        const float wk0 = F.in[I_MKNW][lane], wk1 = F.in[I_MKNW][lane + 64], wk2 = F.in[I_MKNW][lane + 128];
        for (int r = gw; r < NB * NMEM * 4; r += NGW) {
            bf16* p = MK + (size_t)(r >> 2) * 1536 + (r & 3) * 192 + lane;
            float v0 = bf2f(p[0]), v1 = bf2f(p[64]), v2 = bf2f(p[128]);
            const float ss = wave_sum(v0 * v0 + v1 * v1 + v2 * v2);
            const float rs = 1.0f / sqrtf(ss * (1.f / 192.f) + EPS);
            p[0] = (bf16)f2bf(v0 * rs * wk0); p[64] = (bf16)f2bf(v1 * rs * wk1); p[128] = (bf16)f2bf(v2 * rs * wk2);
        }
    }
}


constexpr int SC_ST = 272, SX_ST = 528;
__device__ __forceinline__ float bfsel(const u32x4& v, int j) { const unsigned w = v[j >> 1]; return (j & 1) ? bfhi(w) : bflo(w); }
__device__ __forceinline__ void conv_task(const bf16* P, size_t rowb, int t0, int pcol, const float* cw, const float* cb, int ccol, LAS unsigned char* dst, int stride, const LAS float* scale) {
    float w[4][8], bs[8];
#pragma unroll
    for (int k = 0; k < 4; ++k) { const f32x4 a = *(const f32x4*)(cw + k * 2048 + ccol), b = *(const f32x4*)(cw + k * 2048 + ccol + 4);
        w[k][0] = a.x; w[k][1] = a.y; w[k][2] = a.z; w[k][3] = a.w; w[k][4] = b.x; w[k][5] = b.y; w[k][6] = b.z; w[k][7] = b.w; }
    { const f32x4 a = *(const f32x4*)(cb + ccol), b = *(const f32x4*)(cb + ccol + 4); bs[0] = a.x; bs[1] = a.y; bs[2] = a.z; bs[3] = a.w; bs[4] = b.x; bs[5] = b.y; bs[6] = b.z; bs[7] = b.w; }
    const bf16* src = P + (rowb + t0) * NPROJ + pcol;
    u32x4 rw[19];
#pragma unroll
    for (int i = 0; i < 3; ++i) rw[i] = (u32x4){0u, 0u, 0u, 0u};
    if (t0 > 0) {
#pragma unroll
        for (int i = 0; i < 3; ++i) rw[i] = *(const u32x4*)(src + (ptrdiff_t)(i - 3) * NPROJ); }
#pragma unroll
    for (int i = 0; i < 16; ++i) rw[3 + i] = *(const u32x4*)(src + (size_t)i * NPROJ);
#pragma unroll
    for (int i = 0; i < 16; ++i) {
        float o[8];
#pragma unroll
        for (int j = 0; j < 8; ++j) { float a = bs[j] + w[0][j] * bfsel(rw[i], j) + w[1][j] * bfsel(rw[i + 1], j) + w[2][j] * bfsel(rw[i + 2], j) + w[3][j] * bfsel(rw[i + 3], j); o[j] = a * sigmoidf_(a); }
        if (scale) { const float sv = scale[i];
#pragma unroll
            for (int j = 0; j < 8; ++j) o[j] *= sv; }
        const u32x4 r = {pkbf(o[0], o[1]), pkbf(o[2], o[3]), pkbf(o[4], o[5]), pkbf(o[6], o[7])};
        *(LAS u32x4*)(dst + i * stride) = r;
    }
}
__device__ __forceinline__ float ssd_scan(Frame& F, const float* DTp, size_t tok0, int g, LAS float* sAc, LAS float* sDt) {
    float total = 0.f;
    if (F.wave < 4) {
        const int head = 4 * g + F.wave, lane = F.lane;
        const float A = -__expf(F.in[I_ALOG][head]);
        const float d0 = DTp[(tok0 + 2 * lane) * 16 + head], d1 = DTp[(tok0 + 2 * lane + 1) * 16 + head];
        const float a0 = d0 * A, a1 = d1 * A;
        float sc = a0 + a1;
#pragma unroll
        for (int o = 1; o < 64; o <<= 1) { const float v = __shfl_up(sc, o); if (lane >= o) sc += v; }
        sAc[F.wave * 128 + 2 * lane] = sc - a1; sAc[F.wave * 128 + 2 * lane + 1] = sc;
        sDt[F.wave * 128 + 2 * lane] = d0; sDt[F.wave * 128 + 2 * lane + 1] = d1;
        total = __shfl(sc, 63);
    }
    return total;
}
__device__ __forceinline__ bf16x8 tr_pair(unsigned a_lo, unsigned a_hi) {
    s16x4 lo, hi;
    asm volatile("ds_read_b64_tr_b16 %0, %2\n\tds_read_b64_tr_b16 %1, %3\n\ts_waitcnt lgkmcnt(0)" : "=&v"(lo), "=&v"(hi) : "v"(a_lo), "v"(a_hi) : "memory");
    const bf16x8 r = {lo[0], lo[1], lo[2], lo[3], hi[0], hi[1], hi[2], hi[3]}; return r;
}

__device__ __forceinline__ void ssdC_phase(Frame& F, int half) {
    const bf16* P = (const bf16*)(F.ws + WS_BIG);
    const float* DTp = (const float*)(F.ws + WS_DT);
    float* SST = (float*)(F.ws + WS_SST); float* DEC = (float*)(F.ws + WS_DEC);
    LAS unsigned char* sX = F.lds; LAS unsigned char* sB = F.lds + 128 * SX_ST;
    LAS float* sAc = (LAS float*)(F.lds + 128 * SX_ST + 128 * SC_ST); LAS float* sDt = sAc + 512; LAS float* sW = sDt + 512;
    const int wave = F.wave;
    for (int unit = F.bid; unit < HB * 64 * 4; unit += F.G) {
        int tid = F.tid; asm volatile("" : "+v"(tid));
        const int lane = tid & 63, ql = lane & 31, h = lane >> 5, tq = (lane & 15) >> 2, tp = lane & 3, tblk = (lane >> 4) & 1;
        const int bl = unit >> 8, c = (unit >> 2) & 63, g = unit & 3;
        const size_t rowb = (size_t)bl * SEQ, tok0 = (size_t)half * HT + rowb + c * 128;
        __syncthreads();
        const float total = ssd_scan(F, DTp, tok0, g, sAc, sDt);
        if (wave < 4) { sW[wave * 128 + 2 * lane] = __expf(total - sAc[wave * 128 + 2 * lane]) * sDt[wave * 128 + 2 * lane];
            sW[wave * 128 + 2 * lane + 1] = __expf(total - sAc[wave * 128 + 2 * lane + 1]) * sDt[wave * 128 + 2 * lane + 1];
            if (lane == 0) DEC[((size_t)bl * 64 + c) * 16 + 4 * g + wave] = __expf(total); }
        __syncthreads();
        if (tid < 384) {
            int ch, strip, ccol, stride; LAS unsigned char* dst; const LAS float* scl = nullptr;
            if (tid < 256) { ch = tid & 31; strip = tid >> 5; ccol = g * 256 + 8 * ch; stride = SX_ST; dst = sX + (strip * 16) * SX_ST + ch * 16; scl = sW + (ch >> 3) * 128 + strip * 16; }
            else { const int u = tid - 256; ch = u & 15; strip = u >> 4; ccol = 1024 + g * 128 + 8 * ch; stride = SC_ST; dst = sB + (strip * 16) * SC_ST + ch * 16; }
            conv_task(P, rowb, c * 128 + strip * 16, PC_X + ccol, F.in[I_CONVW], F.in[I_CONVB], ccol, dst, stride, scl);
        }
        __syncthreads();
        const int r = wave >> 1, pt = wave & 1;
        f32x16 acc[4];
#pragma unroll
        for (int nt = 0; nt < 4; ++nt)
#pragma unroll
            for (int e = 0; e < 16; ++e) acc[nt][e] = 0.f;
        const unsigned xa = (unsigned)(size_t)sX + (unsigned)((8 * h + tq) * SX_ST + (r * 64 + 32 * pt + 16 * tblk + 4 * tp) * 2);
        const unsigned ba = (unsigned)(size_t)sB + (unsigned)((8 * h + tq) * SC_ST + (16 * tblk + 4 * tp) * 2);
#pragma unroll
        for (int ks = 0; ks < 8; ++ks) {
            const bf16x8 af = tr_pair(xa + ks * 16 * SX_ST, xa + ks * 16 * SX_ST + 4 * SX_ST);
            bf16x8 bfr[4];
#pragma unroll
            for (int nt = 0; nt < 4; ++nt) bfr[nt] = tr_pair(ba + ks * 16 * SC_ST + nt * 64, ba + ks * 16 * SC_ST + 4 * SC_ST + nt * 64);
            __builtin_amdgcn_sched_barrier(0);
#pragma unroll
            for (int nt = 0; nt < 4; ++nt) acc[nt] = MFMA32(af, bfr[nt], acc[nt]);
        }
        float* out = SST + (((size_t)bl * 64 + c) * 16 + 4 * g + r) * 8192;
#pragma unroll
        for (int nt = 0; nt < 4; ++nt)
#pragma unroll
            for (int e = 0; e < 16; ++e) out[(32 * pt + (e & 3) + 8 * (e >> 2) + 4 * h) * 128 + 32 * nt + ql] = acc[nt][e];
    }
}

__device__ __forceinline__ void ssdD_phase(Frame& F) {
    const float* SST = (const float*)(F.ws + WS_SST); const float* DEC = (const float*)(F.ws + WS_DEC);
    bf16* SIN = (bf16*)(F.ws + WS_SIN);
    const size_t gtid = (size_t)F.bid * NTHR + F.tid, gth = (size_t)F.G * NTHR;
    for (size_t it = gtid; it < (size_t)HB * 16 * 2048; it += gth) {
        const int bl = (int)(it >> 15), head = (int)(it >> 11) & 15, e4 = (int)(it & 2047) * 4;
        f32x4 st = {0.f, 0.f, 0.f, 0.f};
#pragma unroll 8
        for (int c = 0; c < 64; ++c) {
            const size_t idx = (((size_t)bl * 64 + c) * 16 + head);
            const u32x2 o = {pkbf(st.x, st.y), pkbf(st.z, st.w)};
            *(u32x2*)(SIN + idx * 8192 + e4) = o;
            const f32x4 sl = *(const f32x4*)(SST + idx * 8192 + e4); const float d = DEC[idx];
            st = st * d + sl;
        }
    }
}

__device__ __forceinline__ void ssdE_phase(Frame& F, int half) {
    const bf16* P = (const bf16*)(F.ws + WS_BIG);
    const float* DTp = (const float*)(F.ws + WS_DT);
    const bf16* SIN = (const bf16*)(F.ws + WS_SIN);
    bf16* Y = (bf16*)F.out;
    LAS unsigned char* sX = F.lds; LAS unsigned char* sB = F.lds + 128 * SX_ST; LAS unsigned char* sC = sB + 128 * SC_ST;
    LAS float* sAc = (LAS float*)(sC + 128 * SC_ST); LAS float* sDt = sAc + 512; LAS float* sSS = sDt + 512;
    const int wave = F.wave;
    const int st = wave & 3, hp = wave >> 2;
    for (int unit = F.bid; unit < HB * 64 * 4; unit += F.G) {
        int tid = F.tid; asm volatile("" : "+v"(tid));
        const int lane = tid & 63, ql = lane & 31, h = lane >> 5, tq = (lane & 15) >> 2, tp = lane & 3, tblk = (lane >> 4) & 1;
        const int bl = unit >> 8, c = (unit >> 2) & 63, g = unit & 3;
        const size_t rowb = (size_t)bl * SEQ, tok0 = (size_t)half * HT + rowb + c * 128;
        __syncthreads();
        (void)ssd_scan(F, DTp, tok0, g, sAc, sDt);
        if (tid < 128) sSS[tid] = 0.f;
        {
            int ch, strip, ccol, stride; LAS unsigned char* dst;
            if (tid < 256) { ch = tid & 31; strip = tid >> 5; ccol = g * 256 + 8 * ch; stride = SX_ST; dst = sX + (strip * 16) * SX_ST + ch * 16; }
            else if (tid < 384) { const int u = tid - 256; ch = u & 15; strip = u >> 4; ccol = 1024 + g * 128 + 8 * ch; stride = SC_ST; dst = sB + (strip * 16) * SC_ST + ch * 16; }
            else { const int u = tid - 384; ch = u & 15; strip = u >> 4; ccol = 1536 + g * 128 + 8 * ch; stride = SC_ST; dst = sC + (strip * 16) * SC_ST + ch * 16; }
            conv_task(P, rowb, c * 128 + strip * 16, PC_X + ccol, F.in[I_CONVW], F.in[I_CONVB], ccol, dst, stride, nullptr);
        }
        __syncthreads();
        const int s = 32 * st + ql;
        unsigned yk[2][2][8];
        float ssq = 0.f;
        const unsigned xa = (unsigned)(size_t)sX + (unsigned)((4 * h + tq) * SX_ST + (16 * tblk + 4 * tp) * 2);
#pragma unroll
        for (int hq = 0; hq < 2; ++hq) {
            const int r = 2 * hp + hq, head = 4 * g + r;
            const float acs = sAc[r * 128 + s];
            const bf16* stp = SIN + (((size_t)bl * 64 + c) * 16 + head) * 8192 + ql * 128 + 8 * h;
            bf16x8 sfr[2][8];
#pragma unroll
            for (int pt = 0; pt < 2; ++pt)
#pragma unroll
                for (int ks = 0; ks < 8; ++ks) sfr[pt][ks] = *(const bf16x8*)(stp + pt * 4096 + 16 * ks);
            bf16x8 pf[4][2];
#pragma unroll
            for (int i = 0; i < 4; ++i) {
                f32x16 Xi;
#pragma unroll
                for (int e = 0; e < 16; ++e) Xi[e] = 0.f;
#pragma unroll
                for (int ks = 0; ks < 8; ++ks) { const bf16x8 bf_ = *(const LAS bf16x8*)(sB + (32 * i + ql) * SC_ST + 32 * ks + 16 * h);
                    const bf16x8 cf = *(const LAS bf16x8*)(sC + s * SC_ST + 32 * ks + 16 * h); Xi = MFMA32(bf_, cf, Xi); }
                float p[16];
#pragma unroll
                for (int q4 = 0; q4 < 4; ++q4) { const int t0 = 32 * i + 8 * q4 + 4 * h;
                    const f32x4 at = *(const LAS f32x4*)(sAc + r * 128 + t0), dt4 = *(const LAS f32x4*)(sDt + r * 128 + t0);
#pragma unroll
                    for (int e = 0; e < 4; ++e) { const int t = t0 + e; p[4 * q4 + e] = (t <= s) ? Xi[4 * q4 + e] * __expf(acs - at[e]) * dt4[e] : 0.f; } }
#pragma unroll
                for (int s2 = 0; s2 < 2; ++s2) { const u32x4 w = {pkbf(p[8 * s2 + 0], p[8 * s2 + 1]), pkbf(p[8 * s2 + 2], p[8 * s2 + 3]), pkbf(p[8 * s2 + 4], p[8 * s2 + 5]), pkbf(p[8 * s2 + 6], p[8 * s2 + 7])};
                    pf[i][s2] = __builtin_bit_cast(bf16x8, w); }
            }
            const float eacs = __expf(acs), Dh = F.in[I_SSDD][head];
#pragma unroll
            for (int pt = 0; pt < 2; ++pt) {
                f32x16 yd, yo;
#pragma unroll
                for (int e = 0; e < 16; ++e) { yd[e] = 0.f; yo[e] = 0.f; }
#pragma unroll
                for (int i = 0; i < 4; ++i) {
#pragma unroll
                    for (int s2 = 0; s2 < 2; ++s2) { const unsigned a = xa + (unsigned)((32 * i + 16 * s2) * SX_ST + (r * 64 + 32 * pt) * 2);
                        const bf16x8 xf = tr_pair(a, a + 8 * SX_ST); __builtin_amdgcn_sched_barrier(0); yd = MFMA32(xf, pf[i][s2], yd); }
                }
#pragma unroll
                for (int ks = 0; ks < 8; ++ks) { const bf16x8 cf = *(const LAS bf16x8*)(sC + s * SC_ST + 32 * ks + 16 * h); yo = MFMA32(sfr[pt][ks], cf, yo); }
                const bf16* zp = P + (rowb + c * 128 + s) * NPROJ + PC_Z + g * 256 + r * 64 + 32 * pt + 4 * h;
                u32x2 zv[4];
#pragma unroll
                for (int q4 = 0; q4 < 4; ++q4) zv[q4] = *(const u32x2*)(zp + 8 * q4);
#pragma unroll
                for (int q4 = 0; q4 < 4; ++q4) {
                    const u32x2 xv = *(const LAS u32x2*)(sX + s * SX_ST + (r * 64 + 32 * pt + 8 * q4 + 4 * h) * 2);
                    const u32x2 zq = zv[q4];
                    const float xs_[4] = {bflo(xv.x), bfhi(xv.x), bflo(xv.y), bfhi(xv.y)}, zs_[4] = {bflo(zq.x), bfhi(zq.x), bflo(zq.y), bfhi(zq.y)};
                    float yv[4];
#pragma unroll
                    for (int e = 0; e < 4; ++e) { float y = yd[4 * q4 + e] + eacs * yo[4 * q4 + e] + Dh * xs_[e]; y = y * zs_[e] * sigmoidf_(zs_[e]); yv[e] = y; ssq += y * y; }
                    yk[hq][pt][2 * q4] = pkbf(yv[0], yv[1]); yk[hq][pt][2 * q4 + 1] = pkbf(yv[2], yv[3]);
                }
            }
        }
        ssq += __shfl_xor(ssq, 32);
        if (h == 0) __hip_atomic_fetch_add(sSS + s, ssq, __ATOMIC_RELAXED, __HIP_MEMORY_SCOPE_WORKGROUP);
        __syncthreads();
        const float rs = 1.0f / sqrtf(sSS[s] * (1.f / 256.f) + EPS);
        bf16* yp = Y + (tok0 + s) * YC + g * 256 + 4 * h;
        const float* nw = F.in[I_SSDNW] + g * 256 + 4 * h;
#pragma unroll
        for (int hq = 0; hq < 2; ++hq)
#pragma unroll
            for (int pt = 0; pt < 2; ++pt)
#pragma unroll
                for (int q4 = 0; q4 < 4; ++q4) { const int cc = (2 * hp + hq) * 64 + 32 * pt + 8 * q4; const f32x4 w4 = *(const f32x4*)(nw + cc);
                    const unsigned ya = yk[hq][pt][2 * q4], yb = yk[hq][pt][2 * q4 + 1];
                    const u32x2 o = {pkbf(bflo(ya) * rs * w4.x, bfhi(ya) * rs * w4.y), pkbf(bflo(yb) * rs * w4.z, bfhi(yb) * rs * w4.w)};
                    *(u32x2*)(yp + cc) = o; }
    }
}

__device__ __forceinline__ bf16x8 mk_bf16x8(u32x2 lo, u32x2 hi) { const u32x4 v = {lo.x, lo.y, hi.x, hi.y}; return __builtin_bit_cast(bf16x8, v); }

__device__ __forceinline__ void memattn_mfma_phase(Frame& F, int half) {
    const bf16* P = (const bf16*)(F.ws + WS_BIG);
    const bf16* MKV = (const bf16*)(F.ws + WS_MKV);
    const bf16* MVT = (const bf16*)(F.ws + WS_MVT);
    bf16* Y = (bf16*)F.out;
    LAS unsigned char* sm = F.lds;
    const int tid = F.tid, lane = F.lane, wave = F.wave, ql = lane & 31, h = lane >> 5;
    constexpr int KST = 400, VST = 528;
    for (int unit = F.bid; unit < HB * 4 * 32; unit += F.G) {
        const int bl = unit >> 7, head = (unit >> 5) & 3, qt = unit & 31, b = half * HB + bl;
        const int r = bl * SEQ + qt * 256 + wave * 32 + ql;
        __syncthreads();
        for (int c = tid; c < 256 * 24; c += NTHR) { const int row = c / 24, ch = c % 24;
            *(LAS u32x4*)(sm + row * KST + ch * 16) = *(const u32x4*)(MKV + (size_t)(b * NMEM + row) * 1536 + head * 192 + ch * 8); }
        bf16x8 qf[12];
        { const bf16* qp = P + (size_t)r * NPROJ + PC_MQ + head * 192 + 8 * h;
#pragma unroll
          for (int ks = 0; ks < 12; ++ks) qf[ks] = *(const bf16x8*)(qp + 16 * ks); }
        __syncthreads();
        f32x16 sacc[8];
#pragma unroll
        for (int mt = 0; mt < 8; ++mt) {
#pragma unroll
            for (int i = 0; i < 16; ++i) sacc[mt][i] = 0.f;
#pragma unroll
            for (int ks = 0; ks < 12; ++ks) { const bf16x8 kf = *(const LAS bf16x8*)(sm + (32 * mt + ql) * KST + 32 * ks + 16 * h); sacc[mt] = MFMA32(kf, qf[ks], sacc[mt]); }
        }
        float mx = -3.0e38f;
#pragma unroll
        for (int mt = 0; mt < 8; ++mt)
#pragma unroll
            for (int i = 0; i < 16; ++i) mx = fmaxf(mx, sacc[mt][i]);
        mx = fmaxf(mx, __shfl_xor(mx, 32));
        const float sc = 0.07216878364870323f * 1.4426950408889634f;
        float l = 0.f;
        bf16x8 pf[8][2];
#pragma unroll
        for (int mt = 0; mt < 8; ++mt) {
            float p[16];
#pragma unroll
            for (int i = 0; i < 16; ++i) { p[i] = __builtin_amdgcn_exp2f((sacc[mt][i] - mx) * sc); l += p[i]; }
#pragma unroll
            for (int s2 = 0; s2 < 2; ++s2) { const u32x4 w = {pkbf(p[8 * s2 + 0], p[8 * s2 + 1]), pkbf(p[8 * s2 + 2], p[8 * s2 + 3]), pkbf(p[8 * s2 + 4], p[8 * s2 + 5]), pkbf(p[8 * s2 + 6], p[8 * s2 + 7])};
                pf[mt][s2] = __builtin_bit_cast(bf16x8, w); }
        }
        l += __shfl_xor(l, 32);
        __syncthreads();
        for (int c = tid; c < 192 * 32; c += NTHR) { const int row = c >> 5, ch = c & 31;
            *(LAS u32x4*)(sm + row * VST + ch * 16) = *(const u32x4*)(MVT + (size_t)(head * 192 + row) * 2048 + b * NMEM + ch * 8); }
        __syncthreads();
        const float il = 1.0f / l;
        bf16* yp = Y + ((size_t)half * HT + r) * YC + 1280 + head * 192 + 4 * h;
#pragma unroll
        for (int dt = 0; dt < 6; ++dt) {
            f32x16 o;
#pragma unroll
            for (int i = 0; i < 16; ++i) o[i] = 0.f;
#pragma unroll
            for (int mt = 0; mt < 8; ++mt)
#pragma unroll
                for (int s2 = 0; s2 < 2; ++s2) { const LAS unsigned char* vp = sm + (32 * dt + ql) * VST + (32 * mt + 16 * s2 + 4 * h) * 2;
                    const bf16x8 vf = mk_bf16x8(*(const LAS u32x2*)vp, *(const LAS u32x2*)(vp + 16)); o = MFMA32(vf, pf[mt][s2], o); }
#pragma unroll
            for (int g = 0; g < 4; ++g) { const u32x2 w = {pkbf(o[4 * g] * il, o[4 * g + 1] * il), pkbf(o[4 * g + 2] * il, o[4 * g + 3] * il)}; *(u32x2*)(yp + 32 * dt + 8 * g) = w; }
        }
    }
}

__device__ __forceinline__ void dilattn_mfma_phase(Frame& F, int half) {
    bf16* P = (bf16*)(F.ws + WS_BIG);
    float* LSE = (float*)(F.ws + WS_LSE);
    LAS unsigned char* sK = F.lds; LAS unsigned char* sV = F.lds + 384 * 144;
    const int tid = F.tid, lane = F.lane, wave = F.wave, ql = lane & 31, h = lane >> 5;
    constexpr int RST = 144;
    for (int unit = F.bid; unit < HB * 12 * 32; unit += F.G) {
        const int bl = unit / 384, rem = unit % 384, head = rem >> 5, blk = rem & 31;
        const int g = head >> 2, dil = (g == 0) ? 1 : (g == 1 ? 4 : 16), bpr = 32 / dil;
        const int res = blk / bpr, q0 = (blk % bpr) * 256;
        const size_t rowb = (size_t)bl * SEQ;
        __syncthreads();
        for (int c = tid; c < 384 * 8; c += NTHR) { const int row = c >> 3, ch = c & 7; const int ks = q0 - 128 + row;
            u32x4 kv = {0u, 0u, 0u, 0u}, vv = {0u, 0u, 0u, 0u};
            if (ks >= 0) { const bf16* src = P + (rowb + (size_t)ks * dil + res) * NPROJ + head * 64 + ch * 8; kv = *(const u32x4*)(src + PC_DK); vv = *(const u32x4*)(src + PC_DV); }
            *(LAS u32x4*)(sK + row * RST + ch * 16) = kv; *(LAS u32x4*)(sV + row * RST + ch * 16) = vv; }
        const int qs = q0 + wave * 32 + ql;
        const size_t rq = rowb + (size_t)qs * dil + res;
        bf16* qp = P + rq * NPROJ + PC_DQ + head * 64;
        bf16x8 qf[4];
#pragma unroll
        for (int ks = 0; ks < 4; ++ks) qf[ks] = *(const bf16x8*)(qp + 16 * ks + 8 * h);
        __syncthreads();
        f32x16 sacc[5];
        const int kfirst = q0 + wave * 32 - 128;
#pragma unroll
        for (int i = 0; i < 5; ++i) {
#pragma unroll
            for (int e = 0; e < 16; ++e) sacc[i][e] = 0.f;
#pragma unroll
            for (int ks = 0; ks < 4; ++ks) { const bf16x8 kf = *(const LAS bf16x8*)(sK + (32 * wave + 32 * i + ql) * RST + 32 * ks + 16 * h); sacc[i] = MFMA32(kf, qf[ks], sacc[i]); }
        }
        float mx = -3.0e38f;
#pragma unroll
        for (int i = 0; i < 5; ++i)
#pragma unroll
            for (int e = 0; e < 16; ++e) { const int kj = 32 * i + (e & 3) + 8 * (e >> 2) + 4 * h; const bool ok = (kj >= ql) && (kj <= ql + 128) && (kfirst + kj >= 0);
                sacc[i][e] = ok ? sacc[i][e] : -3.0e38f; mx = fmaxf(mx, sacc[i][e]); }
        mx = fmaxf(mx, __shfl_xor(mx, 32));
        const float sc = 0.125f * 1.4426950408889634f;
        float l = 0.f;
        bf16x8 pf[5][2];
#pragma unroll
        for (int i = 0; i < 5; ++i) {
            float p[16];
#pragma unroll
            for (int e = 0; e < 16; ++e) { p[e] = (sacc[i][e] > -1.0e38f) ? __builtin_amdgcn_exp2f((sacc[i][e] - mx) * sc) : 0.f; l += p[e]; }
#pragma unroll
            for (int s2 = 0; s2 < 2; ++s2) { const u32x4 w = {pkbf(p[8 * s2 + 0], p[8 * s2 + 1]), pkbf(p[8 * s2 + 2], p[8 * s2 + 3]), pkbf(p[8 * s2 + 4], p[8 * s2 + 5]), pkbf(p[8 * s2 + 6], p[8 * s2 + 7])};
                pf[i][s2] = __builtin_bit_cast(bf16x8, w); }
        }
        l += __shfl_xor(l, 32);
        const float il = 1.0f / l;
        const int tq = (lane & 15) >> 2, tp = lane & 3, tblk = (lane >> 4) & 1;
        const unsigned vbase = (unsigned)(size_t)(sV) + (unsigned)((32 * wave + 4 * h + tq) * RST + (16 * tblk + 4 * tp) * 2);
#pragma unroll
        for (int dt = 0; dt < 2; ++dt) {
            f32x16 o;
#pragma unroll
            for (int e = 0; e < 16; ++e) o[e] = 0.f;
#pragma unroll
            for (int i = 0; i < 5; ++i) {
                s16x4 lo[2], hi[2];
#pragma unroll
                for (int s2 = 0; s2 < 2; ++s2) { const unsigned a = vbase + (unsigned)((32 * i + 16 * s2) * RST + 64 * dt);
                    asm volatile("ds_read_b64_tr_b16 %0, %1" : "=&v"(lo[s2]) : "v"(a) : "memory");
                    asm volatile("ds_read_b64_tr_b16 %0, %1 offset:1152" : "=&v"(hi[s2]) : "v"(a) : "memory"); }
                asm volatile("s_waitcnt lgkmcnt(0)" ::: "memory"); __builtin_amdgcn_sched_barrier(0);
#pragma unroll
                for (int s2 = 0; s2 < 2; ++s2) { const bf16x8 vf = {lo[s2][0], lo[s2][1], lo[s2][2], lo[s2][3], hi[s2][0], hi[s2][1], hi[s2][2], hi[s2][3]}; o = MFMA32(vf, pf[i][s2], o); }
            }
#pragma unroll
            for (int gq = 0; gq < 4; ++gq) { const u32x2 w = {pkbf(o[4 * gq] * il, o[4 * gq + 1] * il), pkbf(o[4 * gq + 2] * il, o[4 * gq + 3] * il)}; *(u32x2*)(qp + 32 * dt + 8 * gq + 4 * h) = w; }
        }
        if (h == 0) LSE[((size_t)half * HT + rq) * 12 + head] = mx * 0.125f + __logf(l);
    }
}

__device__ __forceinline__ void dilmerge_phase(Frame& F, int half) {
    const bf16* P = (const bf16*)(F.ws + WS_BIG);
    const float* LSE = (const float*)(F.ws + WS_LSE);
    bf16* Y = (bf16*)F.out;
    const size_t gtid = (size_t)F.bid * NTHR + F.tid, gth = (size_t)F.G * NTHR;
    for (size_t it = gtid; it < (size_t)HT * 32; it += gth) {
        const size_t r = it >> 5; const int hh = (int)(it >> 3) & 3, d0 = (int)(it & 7) * 8;
        const size_t tok = (size_t)half * HT + r;
        const float l0 = LSE[tok * 12 + hh], l1 = LSE[tok * 12 + 4 + hh], l2 = LSE[tok * 12 + 8 + hh];
        const float m = fmaxf(l0, fmaxf(l1, l2));
        float w0 = __expf(l0 - m), w1 = __expf(l1 - m), w2 = __expf(l2 - m); const float iw = 1.0f / (w0 + w1 + w2); w0 *= iw; w1 *= iw; w2 *= iw;
        const bf16* op = P + r * NPROJ + PC_DQ + hh * 64 + d0;
        const u32x4 a = *(const u32x4*)op, b = *(const u32x4*)(op + 256), c = *(const u32x4*)(op + 512);
        u32x4 o;
        o.x = pkbf(w0 * bflo(a.x) + w1 * bflo(b.x) + w2 * bflo(c.x), w0 * bfhi(a.x) + w1 * bfhi(b.x) + w2 * bfhi(c.x));
        o.y = pkbf(w0 * bflo(a.y) + w1 * bflo(b.y) + w2 * bflo(c.y), w0 * bfhi(a.y) + w1 * bfhi(b.y) + w2 * bfhi(c.y));
        o.z = pkbf(w0 * bflo(a.z) + w1 * bflo(b.z) + w2 * bflo(c.z), w0 * bfhi(a.z) + w1 * bfhi(b.z) + w2 * bfhi(c.z));
        o.w = pkbf(w0 * bflo(a.w) + w1 * bflo(b.w) + w2 * bflo(c.w), w0 * bfhi(a.w) + w1 * bfhi(b.w) + w2 * bfhi(c.w));
        *(u32x4*)(Y + tok * YC + 1024 + hh * 64 + d0) = o;
    }
}

__device__ __forceinline__ void hn_phase(Frame& F) {
    const int gw = F.bid * NWAVES + F.wave, NGW = F.G * NWAVES;
    for (int m = gw; m < T; m += NGW) { f32x4 v[4]; rms_row_to_bf16(F.out + (size_t)m * DM, F.in[I_NFFNW], (bf16*)(F.ws + WS_ACT1) + (size_t)m * DM, F.lane, v); }
}


__device__ __forceinline__ float gelu_erf(float x) { return 0.5f * x * (1.0f + erff(x * 0.70710678118654752f)); }
__device__ __forceinline__ unsigned f2ord(float f) { const unsigned u = __builtin_bit_cast(unsigned, f); return u ^ ((unsigned)((int)u >> 31) | 0x80000000u); }
__device__ __forceinline__ float ord2f(unsigned k) { const unsigned m = (unsigned)((int)k >> 31); return __builtin_bit_cast(float, k ^ (0x80000000u | ~m)); }
#define CMPX(a, b) do { const unsigned _mx = max((a), (b)), _mn = min((a), (b)); (a) = _mx; (b) = _mn; } while (0)
__device__ __forceinline__ void bitonic_sort16_desc(unsigned (&v)[16]) {
#pragma unroll
    for (int k = 2; k <= 16; k <<= 1)
#pragma unroll
        for (int j = k >> 1; j > 0; j >>= 1)
#pragma unroll
            for (int i = 0; i < 16; ++i) { const int l = i ^ j; if (l > i) { if ((i & k) == 0) CMPX(v[i], v[l]); else CMPX(v[l], v[i]); } }
}
__device__ __forceinline__ void bitonic_merge16_desc(unsigned (&v)[16]) {
#pragma unroll
    for (int j = 8; j > 0; j >>= 1)
#pragma unroll
        for (int i = 0; i < 16; ++i) { const int l = i ^ j; if (l > i) CMPX(v[i], v[l]); }
}
__device__ __forceinline__ void top16_merge(unsigned (&a)[16], const unsigned (&b)[16]) {
#pragma unroll
    for (int i = 0; i < 16; ++i) a[i] = max(a[i], b[15 - i]);
    bitonic_merge16_desc(a);
}
constexpr int PK_ST = 272;
__device__ __forceinline__ void peer_topk_tile(Frame& F, size_t tok0, int* IDX, float* GATE) {
    const bf16* Q = (const bf16*)(F.ws + WS_BIG);
    const bf16* SK = (const bf16*)(F.ws + WS_SUBK);
    LAS unsigned char* sK = F.lds;
    int tid = F.tid; asm volatile("" : "+v"(tid));
    const int lane = tid & 63, wave = F.wave, ql = lane & 31, hh = lane >> 5;
    const size_t tok = tok0 + wave * 32 + ql;
    const bf16* qrow = Q + tok * PEER_Q + 8 * hh;
    __syncthreads();
#pragma unroll
    for (int j = 0; j < 4; ++j) { const int cidx = tid + 512 * j, row = cidx >> 4, ch = cidx & 15; *(LAS u32x4*)(sK + row * PK_ST + ch * 16) = *(const u32x4*)(SK + (size_t)row * 128 + ch * 8); }
    __syncthreads();
    unsigned k1[16];
#pragma unroll 1
    for (int hc = 0; hc < 16; ++hc) {
        LAS unsigned char* cur = sK + (hc & 1) * (128 * PK_ST); LAS unsigned char* nxt = sK + ((hc + 1) & 1) * (128 * PK_ST);
        u32x4 stg[4];
        const int hcn = (hc + 1) & 15;
#pragma unroll
        for (int j = 0; j < 4; ++j) { const int cidx = tid + 512 * j, row = cidx >> 4, ch = cidx & 15; stg[j] = *(const u32x4*)(SK + ((size_t)hcn * 128 + row) * 128 + ch * 8); }
        bf16x8 qf[8];
#pragma unroll
        for (int ks = 0; ks < 8; ++ks) qf[ks] = *(const bf16x8*)(qrow + hc * 128 + 16 * ks);
        unsigned pk[4][16];
#pragma unroll
        for (int mt = 0; mt < 4; ++mt) {
            f32x16 acc;
#pragma unroll
            for (int e = 0; e < 16; ++e) acc[e] = 0.f;
#pragma unroll
            for (int ks = 0; ks < 8; ++ks) { const bf16x8 kf = *(const LAS bf16x8*)(cur + (32 * mt + ql) * PK_ST + 32 * ks + 16 * hh); acc = MFMA32(kf, qf[ks], acc); }
#pragma unroll
            for (int e = 0; e < 16; ++e) pk[mt][e] = (f2ord(acc[e]) & 0xFFFFFF80u) | (unsigned)(32 * mt + (e & 3) + 8 * (e >> 2) + 4 * hh);
        }
#pragma unroll
        for (int j = 0; j < 4; ++j) { const int cidx = tid + 512 * j, row = cidx >> 4, ch = cidx & 15; *(LAS u32x4*)(nxt + row * PK_ST + ch * 16) = stg[j]; }
        __syncthreads();
#pragma unroll
        for (int mt = 0; mt < 4; ++mt) bitonic_sort16_desc(pk[mt]);
        top16_merge(pk[0], pk[1]); top16_merge(pk[2], pk[3]); top16_merge(pk[0], pk[2]);
        unsigned other[16];
#pragma unroll
        for (int i = 0; i < 16; ++i) other[i] = (unsigned)__shfl_xor((int)pk[0][i], 32);
        top16_merge(pk[0], other);
        if ((hc & 1) == 0) {
#pragma unroll
            for (int i = 0; i < 16; ++i) k1[i] = pk[0][i];
        } else {
            float f1[16], f2[16];
#pragma unroll
            for (int i = 0; i < 16; ++i) { f1[i] = ord2f(k1[i] & 0xFFFFFF80u); f2[i] = ord2f(pk[0][i] & 0xFFFFFF80u); }
            unsigned cd[4][16];
#pragma unroll
            for (int i = 0; i < 64; ++i) cd[i >> 4][i & 15] = 0u;
            int n = 0;
#pragma unroll
            for (int a = 0; a < 16; ++a)
#pragma unroll
                for (int b = 0; b < 16; ++b)
                    if ((a + 1) * (b + 1) <= 16) { cd[n >> 4][n & 15] = (f2ord(f1[a] + f2[b]) & 0xFFFFC000u) | ((k1[a] & 127u) << 7) | (pk[0][b] & 127u); ++n; }
#pragma unroll
            for (int g4 = 0; g4 < 4; ++g4) bitonic_sort16_desc(cd[g4]);
            top16_merge(cd[0], cd[1]); top16_merge(cd[2], cd[3]); top16_merge(cd[0], cd[2]);
            const float vmax = ord2f(cd[0][0] & 0xFFFFC000u);
            float ex[16], den = 0.f;
#pragma unroll
            for (int i = 0; i < 16; ++i) { ex[i] = __expf(ord2f(cd[0][i] & 0xFFFFC000u) - vmax); den += ex[i]; }
            const float iden = 1.0f / den;
            const int h = hc >> 1;
            if (hh == 0) { int* ip = IDX + tok * 128 + h * 16;
#pragma unroll
                for (int i = 0; i < 4; ++i) { const u32x4 w = {cd[0][4 * i] & 0x3FFFu, cd[0][4 * i + 1] & 0x3FFFu, cd[0][4 * i + 2] & 0x3FFFu, cd[0][4 * i + 3] & 0x3FFFu}; *(u32x4*)(ip + 4 * i) = w; } }
            else { float* gp = GATE + tok * 128 + h * 16;
#pragma unroll
                for (int i = 0; i < 4; ++i) { const f32x4 w = {ex[4 * i] * iden, ex[4 * i + 1] * iden, ex[4 * i + 2] * iden, ex[4 * i + 3] * iden}; *(f32x4*)(gp + 4 * i) = w; } }
        }
    }
}

constexpr size_t PEER_OFF_IDX = 256 * MiB, PEER_OFF_GATE = 288 * MiB, PEER_OFF_COEF = 320 * MiB;
struct PeerDeal { size_t tokw; int ntok; };
__device__ __forceinline__ void peer_item(int n, const PeerDeal& D, int wave, int& slice, size_t& tok) { slice = n >> 5; tok = D.tokw + (n & 31); }
__device__ __forceinline__ void peer_down_rows(u32x4 (&R)[16], const unsigned char* PD, int slice, int id0, int id1, int lane) {
    const unsigned char* base = PD + ((size_t)slice * 16384 << 7) + 16 * (lane & 7);
#pragma unroll
    for (int k = 0; k < 16; ++k) { const int id = __shfl(k < 8 ? id0 : id1, (8 * k + (lane >> 3)) & 63); R[k] = *(const u32x4*)(base + ((size_t)id << 7)); }
}
__device__ __forceinline__ void peer_down_park(const u32x4 (&R)[16], LAS unsigned char* sw, int lane) {
    const int e8 = lane >> 3, p = lane & 7;
#pragma unroll
    for (int k = 0; k < 16; ++k) { const int sl_ = 8 * k + e8; *(LAS u32x4*)(sw + sl_ * 128 + 16 * (p ^ ((sl_ >> 1) & 7))) = R[k]; }
}
__device__ __forceinline__ void peer_down_hn(u32x4 (&H)[4], const bf16* HN, int slice, size_t tok, int g) {
    const bf16* hp = HN + tok * DM + slice * 128 + 16 * g;
    H[0] = *(const u32x4*)hp; H[1] = *(const u32x4*)(hp + 8); H[2] = *(const u32x4*)(hp + 64); H[3] = *(const u32x4*)(hp + 72);
}
__device__ __forceinline__ void peer_down_compute(const LAS unsigned char* sw, const u32x4 (&H)[4], __amdgpu_buffer_rsrc_t prsrc, int slice, size_t tok, int lane) {
    const int g = lane >> 4, r = lane & 15;
    long bq[4];
#pragma unroll
    for (int h2 = 0; h2 < 2; ++h2) { const u32x4 x0 = H[2 * h2], x1 = H[2 * h2 + 1];
        unsigned p0 = __builtin_amdgcn_cvt_pk_fp8_f32(bflo(x0.x), bfhi(x0.x), 0, false); p0 = __builtin_amdgcn_cvt_pk_fp8_f32(bflo(x0.y), bfhi(x0.y), p0, true);
        unsigned p1 = __builtin_amdgcn_cvt_pk_fp8_f32(bflo(x0.z), bfhi(x0.z), 0, false); p1 = __builtin_amdgcn_cvt_pk_fp8_f32(bflo(x0.w), bfhi(x0.w), p1, true);
        unsigned p2 = __builtin_amdgcn_cvt_pk_fp8_f32(bflo(x1.x), bfhi(x1.x), 0, false); p2 = __builtin_amdgcn_cvt_pk_fp8_f32(bflo(x1.y), bfhi(x1.y), p2, true);
        unsigned p3 = __builtin_amdgcn_cvt_pk_fp8_f32(bflo(x1.z), bfhi(x1.z), 0, false); p3 = __builtin_amdgcn_cvt_pk_fp8_f32(bflo(x1.w), bfhi(x1.w), p3, true);
        bq[2 * h2] = (long)(((unsigned long long)p1 << 32) | p0); bq[2 * h2 + 1] = (long)(((unsigned long long)p3 << 32) | p2); }
    const unsigned off = ((lane & 15) == 0) ? (unsigned)((((size_t)slice * T + tok) * 128 + 4 * g) * 4) : 0xFFFFFF00u;
#pragma unroll
    for (int t8 = 0; t8 < 8; ++t8) { f32x4 acc = {0.f, 0.f, 0.f, 0.f}; const int sl_ = 16 * t8 + r; const LAS unsigned char* rp = sw + sl_ * 128; const int sx = (sl_ >> 1) & 7;
#pragma unroll
        for (int h2 = 0; h2 < 2; ++h2) { const u32x4 v = *(const LAS u32x4*)(rp + 16 * ((4 * h2 + g) ^ sx));
            acc = __builtin_amdgcn_mfma_f32_16x16x32_fp8_fp8((long)(((unsigned long long)v.y << 32) | v.x), bq[2 * h2], acc, 0, 0, 0);
            acc = __builtin_amdgcn_mfma_f32_16x16x32_fp8_fp8((long)(((unsigned long long)v.w << 32) | v.z), bq[2 * h2 + 1], acc, 0, 0, 0); }
        __builtin_amdgcn_raw_buffer_store_b128(__builtin_bit_cast(u32x4, acc), prsrc, off, 64 * t8, 0); }
}
__device__ __forceinline__ void peer_down_phase(Frame& F, const PeerDeal& D) {
    const unsigned char* PD = F.ws + WS_PD; const bf16* HN = (const bf16*)(F.ws + WS_ACT1);
    const int* IDX = (const int*)(F.ws + WS_BIG + PEER_OFF_IDX);
    const __amdgpu_buffer_rsrc_t prsrc = __builtin_amdgcn_make_buffer_rsrc((void*)(F.ws + WS_BIG), 0, 8 * T * 128 * 4, 0x00020000);
    int lane = F.lane; asm volatile("" : "+v"(lane));
    const int g = lane >> 4, wave = F.wave;
    LAS unsigned char* sw = F.lds + wave * 16384;
    const int ntok = D.ntok;
    int sl; size_t tk;
    u32x4 R[16], H0[4], H1[4]; int id0, id1;
    { int s1_; size_t t1_; peer_item(0, D, wave, sl, tk); peer_item(1, D, wave, s1_, t1_);
      const int a0 = IDX[tk * 128 + lane], a1 = IDX[tk * 128 + 64 + lane]; id0 = IDX[t1_ * 128 + lane]; id1 = IDX[t1_ * 128 + 64 + lane];
      __builtin_amdgcn_sched_barrier(0);
      peer_down_rows(R, PD, sl, a0, a1, lane); peer_down_hn(H0, HN, sl, tk, g);
      __builtin_amdgcn_sched_barrier(0); }
#pragma unroll 1
    for (int n = 0; n < ntok; n += 2) {
        int s0, s1, s2, s3; size_t t0, t1, t2, t3;
        peer_item(n, D, wave, s0, t0); peer_item(n + 1, D, wave, s1, t1); peer_item(n + 2 < ntok ? n + 2 : n, D, wave, s2, t2); peer_item(n + 3 < ntok ? n + 3 : n + 1, D, wave, s3, t3);
        peer_down_park(R, sw, lane);
        __builtin_amdgcn_sched_barrier(0);
        { const int j0 = IDX[t2 * 128 + lane], j1 = IDX[t2 * 128 + 64 + lane];
          peer_down_rows(R, PD, s1, id0, id1, lane); peer_down_hn(H1, HN, s1, t1, g); id0 = j0; id1 = j1; }
        __builtin_amdgcn_sched_barrier(0);
        peer_down_compute(sw, H0, prsrc, s0, t0, lane);
        __builtin_amdgcn_sched_barrier(0);
        peer_down_park(R, sw, lane);
        __builtin_amdgcn_sched_barrier(0);
        { const int j0 = IDX[t3 * 128 + lane], j1 = IDX[t3 * 128 + 64 + lane];
          peer_down_rows(R, PD, s2, id0, id1, lane); peer_down_hn(H0, HN, s2, t2, g); id0 = j0; id1 = j1; }
        __builtin_amdgcn_sched_barrier(0);
        peer_down_compute(sw, H1, prsrc, s1, t1, lane);
        __builtin_amdgcn_sched_barrier(0);
    }
}
__device__ __forceinline__ void peer_coef_wave(Frame& F, const PeerDeal& D) {
    const float* PART = (const float*)(F.ws + WS_BIG); const float* GATE = (const float*)(F.ws + WS_BIG + PEER_OFF_GATE); float* COEF = (float*)(F.ws + WS_BIG + PEER_OFF_COEF);
    for (int k = F.lane; k < 32 * 32; k += 64) {
        const size_t i = D.tokw * 128 + 4 * k;
        f32x4 sm = *(const f32x4*)(PART + i);
#pragma unroll
        for (int x = 1; x < 8; ++x) sm += *(const f32x4*)(PART + (size_t)x * T * 128 + i);
        const f32x4 gt = *(const f32x4*)(GATE + i);
        const f32x4 o = {gt.x * gelu_erf(sm.x * (1.0f / PD_SCALE)) * (1.0f / PU_SCALE), gt.y * gelu_erf(sm.y * (1.0f / PD_SCALE)) * (1.0f / PU_SCALE),
                         gt.z * gelu_erf(sm.z * (1.0f / PD_SCALE)) * (1.0f / PU_SCALE), gt.w * gelu_erf(sm.w * (1.0f / PD_SCALE)) * (1.0f / PU_SCALE)};
        *(f32x4*)(COEF + i) = o;
    }
}
__device__ __forceinline__ void peer_up_rows(u32x4 (&R)[16], const unsigned char* PU, int slice, int id0, int id1, int lane) {
    const unsigned char* base = PU + ((size_t)slice * 16384 << 7) + 16 * (lane & 3);
#pragma unroll
    for (int s8 = 0; s8 < 8; ++s8) { const int id = __shfl(s8 < 4 ? id0 : id1, (16 * s8 + (lane >> 2)) & 63); const unsigned char* rp = base + ((size_t)id << 7); R[2 * s8] = *(const u32x4*)rp; R[2 * s8 + 1] = *(const u32x4*)(rp + 64); }
}
__device__ __forceinline__ void peer_up_compute(const u32x4 (&R)[16], float c0, float c1, f32x2 h, float* out, int slice, size_t tok, int lane) {
    f32x2 acc[16];
#pragma unroll
    for (int k = 0; k < 16; ++k) acc[k] = (f32x2){0.f, 0.f};
#pragma unroll
    for (int s8 = 0; s8 < 8; ++s8) { const float c = __shfl(s8 < 4 ? c0 : c1, (16 * s8 + (lane >> 2)) & 63); f32x2 c2 = {c, c}; asm volatile("" : "+v"(c2));
#pragma unroll
        for (int hf = 0; hf < 2; ++hf) { const u32x4 r = R[2 * s8 + hf];
            acc[8 * hf + 0] = c2 * __builtin_amdgcn_cvt_pk_f32_fp8(r.x, false) + acc[8 * hf + 0]; acc[8 * hf + 1] = c2 * __builtin_amdgcn_cvt_pk_f32_fp8(r.x, true) + acc[8 * hf + 1];
            acc[8 * hf + 2] = c2 * __builtin_amdgcn_cvt_pk_f32_fp8(r.y, false) + acc[8 * hf + 2]; acc[8 * hf + 3] = c2 * __builtin_amdgcn_cvt_pk_f32_fp8(r.y, true) + acc[8 * hf + 3];
            acc[8 * hf + 4] = c2 * __builtin_amdgcn_cvt_pk_f32_fp8(r.z, false) + acc[8 * hf + 4]; acc[8 * hf + 5] = c2 * __builtin_amdgcn_cvt_pk_f32_fp8(r.z, true) + acc[8 * hf + 5];
            acc[8 * hf + 6] = c2 * __builtin_amdgcn_cvt_pk_f32_fp8(r.w, false) + acc[8 * hf + 6]; acc[8 * hf + 7] = c2 * __builtin_amdgcn_cvt_pk_f32_fp8(r.w, true) + acc[8 * hf + 7]; } }
    f32x2 r8[8], r4[4], r2[2], r1;
    { const bool up = (lane & 32) != 0;
#pragma unroll
      for (int k = 0; k < 8; ++k) { const f32x2 keep = up ? acc[k + 8] : acc[k], send = up ? acc[k] : acc[k + 8]; r8[k] = keep + (f32x2){__shfl_xor(send.x, 32), __shfl_xor(send.y, 32)}; } }
    { const bool up = (lane & 16) != 0;
#pragma unroll
      for (int k = 0; k < 4; ++k) { const f32x2 keep = up ? r8[k + 4] : r8[k], send = up ? r8[k] : r8[k + 4]; r4[k] = keep + (f32x2){__shfl_xor(send.x, 16), __shfl_xor(send.y, 16)}; } }
    { const bool up = (lane & 8) != 0;
#pragma unroll
      for (int k = 0; k < 2; ++k) { const f32x2 keep = up ? r4[k + 2] : r4[k], send = up ? r4[k] : r4[k + 2]; r2[k] = keep + (f32x2){__shfl_xor(send.x, 8), __shfl_xor(send.y, 8)}; } }
    { const bool up = (lane & 4) != 0; const f32x2 keep = up ? r2[1] : r2[0], send = up ? r2[0] : r2[1]; r1 = keep + (f32x2){__shfl_xor(send.x, 4), __shfl_xor(send.y, 4)}; }
    const int p = ((lane >> 5) & 1) * 8 + ((lane >> 4) & 1) * 4 + ((lane >> 3) & 1) * 2 + ((lane >> 2) & 1);
    *(f32x2*)(out + tok * DM + slice * 128 + 16 * (lane & 3) + 2 * (p & 7) + 64 * (p >> 3)) = h + r1;
}
__device__ __forceinline__ void peer_up_phase(Frame& F, const PeerDeal& D, float* outp) {
    const unsigned char* PU = F.ws + WS_PU;
    const int* IDX = (const int*)(F.ws + WS_BIG + PEER_OFF_IDX); const float* COEF = (const float*)(F.ws + WS_BIG + PEER_OFF_COEF);
    int lane = F.lane; asm volatile("" : "+v"(lane));
    const int wave = F.wave;
    const int ntok = D.ntok;
    const int p = ((lane >> 5) & 1) * 8 + ((lane >> 4) & 1) * 4 + ((lane >> 3) & 1) * 2 + ((lane >> 2) & 1);
    const int hoff = 16 * (lane & 3) + 2 * (p & 7) + 64 * (p >> 3);
    int sl; size_t tk;
    u32x4 R0[16], R1[16];
    float ca0, ca1, cb0, cb1; f32x2 ha, hb;
    int id0, id1, jd0, jd1;
    { int s1_; size_t t1_; peer_item(0, D, wave, sl, tk); peer_item(1, D, wave, s1_, t1_);
      jd0 = IDX[tk * 128 + lane]; jd1 = IDX[tk * 128 + 64 + lane]; id0 = IDX[t1_ * 128 + lane]; id1 = IDX[t1_ * 128 + 64 + lane];
      __builtin_amdgcn_sched_barrier(0);
      peer_up_rows(R0, PU, sl, jd0, jd1, lane);
      ca0 = COEF[tk * 128 + lane]; ca1 = COEF[tk * 128 + 64 + lane]; ha = *(const f32x2*)(F.out + tk * DM + sl * 128 + hoff);
      __builtin_amdgcn_sched_barrier(0); }
#pragma unroll 1
    for (int n = 0; n < ntok; n += 2) {
        int s0, s1, s2, s3; size_t t0, t1, t2, t3;
        peer_item(n, D, wave, s0, t0); peer_item(n + 1, D, wave, s1, t1);
        peer_item(n + 2 < ntok ? n + 2 : n, D, wave, s2, t2); peer_item(n + 3 < ntok ? n + 3 : n + 1, D, wave, s3, t3);
        jd0 = IDX[t2 * 128 + lane]; jd1 = IDX[t2 * 128 + 64 + lane];
        peer_up_rows(R1, PU, s1, id0, id1, lane);
        cb0 = COEF[t1 * 128 + lane]; cb1 = COEF[t1 * 128 + 64 + lane]; hb = *(const f32x2*)(F.out + t1 * DM + s1 * 128 + hoff);
        __builtin_amdgcn_sched_barrier(0);
        peer_up_compute(R0, ca0, ca1, ha, outp, s0, t0, lane);
        __builtin_amdgcn_sched_barrier(0);
        id0 = IDX[t3 * 128 + lane]; id1 = IDX[t3 * 128 + 64 + lane];
        peer_up_rows(R0, PU, s2, jd0, jd1, lane);
        ca0 = COEF[t2 * 128 + lane]; ca1 = COEF[t2 * 128 + 64 + lane]; ha = *(const f32x2*)(F.out + t2 * DM + s2 * 128 + hoff);
        __builtin_amdgcn_sched_barrier(0);
        peer_up_compute(R1, cb0, cb1, hb, outp, s1, t1, lane);
        __builtin_amdgcn_sched_barrier(0);
    }
}
__device__ __forceinline__ void peer_phase(Frame& F) {
    int* IDX = (int*)(F.ws + WS_BIG + PEER_OFF_IDX); float* GATE = (float*)(F.ws + WS_BIG + PEER_OFF_GATE);
    for (int tile = F.bid; tile < T / 256; tile += F.G) {
        peer_topk_tile(F, (size_t)tile * 256, IDX, GATE);
        VM_WAIT(); __syncthreads();
        PeerDeal D; D.tokw = (size_t)tile * 256 + F.wave * 32; D.ntok = 256;
        peer_down_phase(F, D);
        if (PROBE & 8) peer_down_phase(F, D);
        VM_WAIT(); __syncthreads();
        peer_coef_wave(F, D);
        VM_WAIT(); __syncthreads();
        if (PROBE & 16) peer_up_phase(F, D, (float*)(F.ws + WS_SST));
        peer_up_phase(F, D, F.out);
    }
}

constexpr int N_PHASES = 15;
__global__ void __launch_bounds__(NTHR, 2) mega_fwd(Args args) {
    extern __shared__ __attribute__((aligned(16))) unsigned char lds_raw[];
    Frame F;
    F.lds = (LAS unsigned char*)lds_raw;
    F.tid = threadIdx.x; F.lane = F.tid & 63; F.wave = __builtin_amdgcn_readfirstlane(F.tid >> 6);
    F.G = gridDim.x; F.bid = blockIdx.x;
#pragma unroll
    for (int i = 0; i < 26; ++i) F.in[i] = args.in[i];
    F.positions = args.positions; F.out = args.out; F.ws = args.ws;
    unsigned char* ws = args.ws;
    volatile LAS unsigned* ctlw = (volatile LAS unsigned*)(F.lds + LDSCTL_OFF);
    if (F.tid < 64) ctlw[F.tid] = 0u;
    __syncthreads();
    const int lo = args.ph_lo, hi = args.ph_hi;
    XcdBarrier bar; bar.bar = (unsigned*)(ws + WS_CTL); bar.x = 0; bar.st = nullptr;
    if (hi - lo > 1) bar = xcd_barrier_post((unsigned*)(ws + WS_CTL), ctlw + 8);
#define IN(k) (lo <= (k) && (k) < hi)
#define SEAM(k) do { if (IN(k) && IN((k) + 1)) xcd_barrier(bar); } while (0)
    bf16* ACT1 = (bf16*)(ws + WS_ACT1); bf16* BIG = (bf16*)(ws + WS_BIG); bf16* WallT = (bf16*)(ws + WS_WALLT);

    if (IN(0)) { p0_prologue(F); __syncthreads(); if (PROBE & 1) { p0_prologue(F); __syncthreads(); } }
    SEAM(0);
    if (IN(1)) { { {
        { pg8::Gemm g{(const bf16*)(ws + WS_MEMN), (const bf16*)(ws + WS_WMKVT), NB * NMEM, 768, DM, DM, DM}; pg8::StaticOrder S; S.init(g.M, g.N, F.G, F.bid);
          pg8::EpiBf16<0> E{(bf16*)(ws + WS_MKV), 1536}; pg8::gemm_phase(F.lds, g, S, E); }
        { pg8::Gemm g{(const bf16*)(ws + WS_WMKVT) + (size_t)768 * DM, (const bf16*)(ws + WS_MEMN), 768, NB * NMEM, DM, DM, DM}; pg8::StaticOrder S; S.init(g.M, g.N, F.G, F.G - 1 - F.bid);
          pg8::EpiBf16<0> E{(bf16*)(ws + WS_MVT), NB * NMEM}; pg8::gemm_phase(F.lds, g, S, E); }
        { pg8::Gemm g{ACT1, WallT, HT, NPROJ, DM, DM, DM}; pg8::StaticOrder S; S.init(g.M, g.N, F.G, F.bid);
          pg8::EpiBf16<0> E{BIG, NPROJ}; pg8::gemm_phase(F.lds, g, S, E); }
    } }
      if (PROBE & 2) { {
        { pg8::Gemm g{(const bf16*)(ws + WS_MEMN), (const bf16*)(ws + WS_WMKVT), NB * NMEM, 768, DM, DM, DM}; pg8::StaticOrder S; S.init(g.M, g.N, F.G, F.bid);
          pg8::EpiBf16<0> E{(bf16*)(ws + WS_MKV), 1536}; pg8::gemm_phase(F.lds, g, S, E); }
        { pg8::Gemm g{(const bf16*)(ws + WS_WMKVT) + (size_t)768 * DM, (const bf16*)(ws + WS_MEMN), 768, NB * NMEM, DM, DM, DM}; pg8::StaticOrder S; S.init(g.M, g.N, F.G, F.G - 1 - F.bid);
          pg8::EpiBf16<0> E{(bf16*)(ws + WS_MVT), NB * NMEM}; pg8::gemm_phase(F.lds, g, S, E); }
        { pg8::Gemm g{ACT1, WallT, HT, NPROJ, DM, DM, DM}; pg8::StaticOrder S; S.init(g.M, g.N, F.G, F.bid);
          pg8::EpiBf16<0> E{BIG, NPROJ}; pg8::gemm_phase(F.lds, g, S, E); }
    } } }
    SEAM(1);
    if (IN(2)) { qkprep_phase(F, 0); ssdC_phase(F, 0); if (PROBE & 4) ssdC_phase(F, 0); }
    SEAM(2);
    if (IN(3)) { ssdD_phase(F); dilattn_mfma_phase(F, 0); memattn_mfma_phase(F, 0); if (PROBE & 64) { ssdD_phase(F); memattn_mfma_phase(F, 0); } }
    SEAM(3);
    if (IN(4)) { ssdE_phase(F, 0); dilmerge_phase(F, 0); if (PROBE & 32) { ssdE_phase(F, 0); dilmerge_phase(F, 0); } }
    SEAM(4);
    if (IN(5)) { { { pg8::Gemm g{ACT1 + (size_t)HT * DM, WallT, HT, NPROJ, DM, DM, DM}; pg8::StaticOrder S; S.init(g.M, g.N, F.G, F.bid);
        pg8::EpiBf16<0> E{BIG, NPROJ}; pg8::gemm_phase(F.lds, g, S, E); } }
      if (PROBE & 2) { { pg8::Gemm g{ACT1 + (size_t)HT * DM, WallT, HT, NPROJ, DM, DM, DM}; pg8::StaticOrder S; S.init(g.M, g.N, F.G, F.bid);
        pg8::EpiBf16<0> E{BIG, NPROJ}; pg8::gemm_phase(F.lds, g, S, E); } } }
    SEAM(5);
    if (IN(6)) { qkprep_phase(F, 1); ssdC_phase(F, 1); if (PROBE & 4) ssdC_phase(F, 1); }
    SEAM(6);
    if (IN(7)) { ssdD_phase(F); dilattn_mfma_phase(F, 1); memattn_mfma_phase(F, 1); if (PROBE & 64) { ssdD_phase(F); memattn_mfma_phase(F, 1); } }
    SEAM(7);
    if (IN(8)) { ssdE_phase(F, 1); dilmerge_phase(F, 1); if (PROBE & 32) { ssdE_phase(F, 1); dilmerge_phase(F, 1); } }
    SEAM(8);
    if (IN(9)) { { { pg8::Gemm g{ACT1, WallT + (size_t)NPROJ * DM, T, NGATE, DM, DM, DM}; pg8::StaticOrder S; S.init(g.M, g.N, F.G, F.bid);
        pg8::EpiBf16<1> E{BIG, NGATE}; pg8::gemm_phase(F.lds, g, S, E); } }
      if (PROBE & 2) { { pg8::Gemm g{ACT1, WallT + (size_t)NPROJ * DM, T, NGATE, DM, DM, DM}; pg8::StaticOrder S; S.init(g.M, g.N, F.G, F.bid);
        pg8::EpiBf16<1> E{BIG, NGATE}; pg8::gemm_phase(F.lds, g, S, E); } } }
    SEAM(9);
    if (IN(10)) { { {
        const bf16* Yc = (const bf16*)F.out; const bf16* Wc = (const bf16*)(ws + WS_WCATT);
        { pg8::Gemm g{Yc, Wc, T, DM, 1024, YC, YC}; pg8::StaticOrder S; S.init(g.M, g.N, F.G, F.bid); pg8::EpiBranch<false> E{ACT1, DM, BIG, NGATE, 0}; pg8::gemm_phase(F.lds, g, S, E); }
        { pg8::Gemm g{Yc + 1024, Wc + 1024, T, DM, 256, YC, YC}; pg8::StaticOrder S; S.init(g.M, g.N, F.G, F.bid); pg8::EpiBranch<true> E{ACT1, DM, BIG, NGATE, 1024}; pg8::gemm_phase(F.lds, g, S, E); }
        { pg8::Gemm g{Yc + 1280, Wc + 1280, T, DM, 768, YC, YC}; pg8::StaticOrder S; S.init(g.M, g.N, F.G, F.bid); pg8::EpiBranch<true> E{ACT1, DM, BIG, NGATE, 2048}; pg8::gemm_phase(F.lds, g, S, E); }
    } }
      if (PROBE & 2) { {
        const bf16* Yc = (const bf16*)F.out; const bf16* Wc = (const bf16*)(ws + WS_WCATT);
        { pg8::Gemm g{Yc, Wc, T, DM, 1024, YC, YC}; pg8::StaticOrder S; S.init(g.M, g.N, F.G, F.bid); pg8::EpiBranch<false> E{ACT1, DM, BIG, NGATE, 0}; pg8::gemm_phase(F.lds, g, S, E); }
        { pg8::Gemm g{Yc + 1024, Wc + 1024, T, DM, 256, YC, YC}; pg8::StaticOrder S; S.init(g.M, g.N, F.G, F.bid); pg8::EpiBranch<true> E{ACT1, DM, BIG, NGATE, 1024}; pg8::gemm_phase(F.lds, g, S, E); }
        { pg8::Gemm g{Yc + 1280, Wc + 1280, T, DM, 768, YC, YC}; pg8::StaticOrder S; S.init(g.M, g.N, F.G, F.bid); pg8::EpiBranch<true> E{ACT1, DM, BIG, NGATE, 2048}; pg8::gemm_phase(F.lds, g, S, E); }
    } } }
    SEAM(10);
    if (IN(11)) { { { pg8::Gemm g{ACT1, (const bf16*)(ws + WS_WOUTT), T, DM, DM, DM, DM}; pg8::StaticOrder S; S.init(g.M, g.N, F.G, F.bid);
        pg8::EpiResid E{F.out, DM, F.in[I_X]}; pg8::gemm_phase(F.lds, g, S, E); } }
      if (PROBE & 2) { { pg8::Gemm g{ACT1, (const bf16*)(ws + WS_WOUTT), T, DM, DM, DM, DM}; pg8::StaticOrder S; S.init(g.M, g.N, F.G, F.bid);
        pg8::EpiResid E{F.out, DM, F.in[I_X]}; pg8::gemm_phase(F.lds, g, S, E); } } }
    SEAM(11);
    if (IN(12)) { { hn_phase(F); }
      if (PROBE & 2) { hn_phase(F); } }
    SEAM(12);
    if (IN(13)) { { { pg8::Gemm g{ACT1, (const bf16*)(ws + WS_WQT), T, PEER_Q, DM, DM, DM}; pg8::StaticOrder S; S.init(g.M, g.N, F.G, F.bid);
        pg8::EpiBf16<0> E{BIG, PEER_Q}; pg8::gemm_phase(F.lds, g, S, E); } }
      if (PROBE & 2) { { pg8::Gemm g{ACT1, (const bf16*)(ws + WS_WQT), T, PEER_Q, DM, DM, DM}; pg8::StaticOrder S; S.init(g.M, g.N, F.G, F.bid);
        pg8::EpiBf16<0> E{BIG, PEER_Q}; pg8::gemm_phase(F.lds, g, S, E); } } }
    SEAM(13);
    if (IN(14)) peer_phase(F);
#undef IN
#undef SEAM
}

extern "C" void kernel_launch(void* const* d_in, const int* in_sizes, int n_in, void* d_out, int out_size, void* d_ws, size_t ws_size, hipStream_t stream) {
    static int grid = 0;
    if (grid == 0) {
        if (n_in != 26 || out_size != T * DM || ws_size < WS_END) { fprintf(stderr, "kernel_launch: unexpected shapes (n_in %d, out %d, ws %zu)\n", n_in, out_size, ws_size); grid = -1; return; }
        int dev = 0, cus = 0;
        if (hipGetDevice(&dev) != hipSuccess || hipDeviceGetAttribute(&cus, hipDeviceAttributeMultiprocessorCount, dev) != hipSuccess) { grid = -1; return; }
        if (hipFuncSetAttribute((const void*)mega_fwd, hipFuncAttributeMaxDynamicSharedMemorySize, LDS_BYTES) != hipSuccess) { grid = -1; return; }
        int per_cu = 0;
        (void)hipOccupancyMaxActiveBlocksPerMultiprocessor(&per_cu, (const void*)mega_fwd, NTHR, LDS_BYTES);
        (void)hipGetLastError();
        grid = cus;
    }
    if (grid < 0) return;
    (void)hipMemsetAsync((char*)d_ws + WS_CTL, 0, CTL_ZERO_BYTES, stream);
    Args a{};
    for (int i = 0; i < 26; ++i) a.in[i] = (const float*)d_in[i];
    a.positions = (const int*)d_in[2]; a.out = (float*)d_out; a.ws = (unsigned char*)d_ws;
#if MK_N_LAUNCHES == 1
    a.ph_lo = 0; a.ph_hi = N_PHASES;
    hipLaunchKernelGGL(mega_fwd, dim3(grid), dim3(NTHR), LDS_BYTES, stream, a);
#else
    for (int p = 0; p < N_PHASES; ++p) { a.ph_lo = p; a.ph_hi = p + 1; hipLaunchKernelGGL(mega_fwd, dim3(grid), dim3(NTHR), LDS_BYTES, stream, a); }
#endif
}
```

```cpp
#include <hip/hip_runtime.h>
#include <cstdio>
#include <cstdint>

#ifndef MK_N_LAUNCHES
#define MK_N_LAUNCHES 1
#endif

#define LAS __attribute__((address_space(3)))
#define GAS __attribute__((address_space(1)))
typedef unsigned short bf16;
typedef short bf16x8 __attribute__((ext_vector_type(8)));
typedef float f32x4 __attribute__((ext_vector_type(4)));
typedef float f32x2 __attribute__((ext_vector_type(2)));
typedef unsigned u32x4 __attribute__((ext_vector_type(4)));
typedef unsigned u32x2 __attribute__((ext_vector_type(2)));

constexpr int NB = 8, SEQ = 8192, DM = 1024, T = NB * SEQ;
constexpr int HB = 4, HT = HB * SEQ;
constexpr int NMEM = 256;
constexpr int NPROJ = 6144;
constexpr int PC_Z = 0, PC_X = 1024, PC_B = 2048, PC_C = 2560, PC_DQ = 3072, PC_DK = 3840, PC_DV = 4608, PC_MQ = 5376;
constexpr int W_IN_N = 9232, OFF_DT = 3072, OFF_AFTER_DT = 3088;
constexpr int NGATE = 3072;
constexpr int YC = 2048;
constexpr int PEER_H = 8, PEER_K = 16, PEER_NK = 128, PEER_Q = 2048;
constexpr float EPS = 1e-6f;

constexpr size_t MiB = 1u << 20;
constexpr size_t WS_CTL = 0, CTL_ZERO_BYTES = 65536;
constexpr size_t WS_WALLT = 1 * MiB;
constexpr size_t WS_WMKVT = 19 * MiB;
constexpr size_t WS_WCATT = 22 * MiB;
constexpr size_t WS_WOUTT = 26 * MiB;
constexpr size_t WS_WQT = 28 * MiB;
constexpr size_t WS_SUBK = 32 * MiB;
constexpr size_t WS_PD = 33 * MiB;
constexpr size_t WS_PU = 65 * MiB;
constexpr size_t WS_DT = 97 * MiB;
constexpr size_t WS_MEMN = 101 * MiB;
constexpr size_t WS_MKV = 105 * MiB;
constexpr size_t WS_ACT1 = 112 * MiB;
constexpr size_t WS_BIG = 240 * MiB;
constexpr size_t WS_LSE = 624 * MiB;
constexpr size_t WS_MVT = 628 * MiB;
constexpr size_t WS_DEC = 631 * MiB;
constexpr size_t WS_SST = 632 * MiB;
constexpr size_t WS_SIN = 760 * MiB;
constexpr size_t WS_END = 824 * MiB;

constexpr int RING_BYTES = 131072;
constexpr int LDSCTL_OFF = 143360;
constexpr int LDS_BYTES = 147456;
constexpr int NWAVES = 8, NTHR = 512;

__device__ __forceinline__ int lane_id() { return (int)__builtin_amdgcn_mbcnt_hi(~0u, __builtin_amdgcn_mbcnt_lo(~0u, 0u)); }
__device__ __forceinline__ float bf2f(unsigned short b) { return __builtin_bit_cast(float, (unsigned)b << 16); }
__device__ __forceinline__ float bflo(unsigned w) { return __builtin_bit_cast(float, w << 16); }
__device__ __forceinline__ float bfhi(unsigned w) { return __builtin_bit_cast(float, w & 0xffff0000u); }
__device__ __forceinline__ unsigned f2bf(float f) { unsigned u = __builtin_bit_cast(unsigned, f); return (u + 0x7fffu + ((u >> 16) & 1u)) >> 16; }
__device__ __forceinline__ unsigned pk2(float lo, float hi) { return f2bf(lo) | (f2bf(hi) << 16); }
typedef float f32x16 __attribute__((ext_vector_type(16)));
typedef short s16x4 __attribute__((ext_vector_type(4)));
typedef __bf16 bf2_t __attribute__((ext_vector_type(2)));
__device__ __forceinline__ unsigned pkbf(float a, float b) { const f32x2 v = {a, b}; return __builtin_bit_cast(unsigned, __builtin_convertvector(v, bf2_t)); }
#define MFMA32(a, b, c) __builtin_amdgcn_mfma_f32_32x32x16_bf16((a), (b), (c), 0, 0, 0)
__device__ __forceinline__ float wave_sum(float v) {
#pragma unroll
    for (int o = 1; o < 64; o <<= 1) v += __shfl_xor(v, o);
    return v;
}
__device__ __forceinline__ float wave_max(float v) {
#pragma unroll
    for (int o = 1; o < 64; o <<= 1) v = fmaxf(v, __shfl_xor(v, o));
    return v;
}
__device__ __forceinline__ float sigmoidf_(float x) { return 1.0f / (1.0f + __expf(-x)); }
#define LDS_WAIT() asm volatile("s_waitcnt lgkmcnt(0)" ::: "memory")
#define VM_WAIT() asm volatile("s_waitcnt vmcnt(0)" ::: "memory")

#define XB_TMO      128
#define XB_XCNT(j)  (256  + 64 * (j))
#define XB_XSUB(j)  (1280 + 64 * (j))
#define XB_XGEN(j)  (2304 + 64 * (j))
#define XB_TOP      3328
#define XB_TOPGEN   3392
#define XCD_BAR_WORDS 3456
#define XB_SPIN_CAP (1u << 18)
__device__ __forceinline__ unsigned xb_ld(unsigned* p)              { return __hip_atomic_load(p, __ATOMIC_RELAXED, __HIP_MEMORY_SCOPE_AGENT); }
__device__ __forceinline__ unsigned xb_add(unsigned* p, unsigned v) { return __hip_atomic_fetch_add(p, v, __ATOMIC_RELAXED, __HIP_MEMORY_SCOPE_AGENT); }
__device__ __forceinline__ unsigned xb_xcc_id() { return (unsigned)__builtin_amdgcn_s_getreg((3 << 11) | 20) & 0xFu; }
#define XB_SPIN(cond, bar) do { unsigned _sp = 0; while (cond) { __builtin_amdgcn_s_sleep(1); \
    if ((++_sp & 255u) == 0u) { if (xb_ld(&(bar)[XB_TMO])) break; if (_sp > XB_SPIN_CAP) { atomicAdd(&(bar)[XB_TMO], 1u); break; } } } } while (0)
struct XcdBarrier { unsigned* bar; unsigned x; volatile LAS unsigned* st; int wave; };
__device__ __forceinline__ XcdBarrier xcd_barrier_post(unsigned* bar, volatile LAS unsigned* st, int wave) {
    XcdBarrier b; b.bar = bar; b.x = xb_xcc_id(); b.st = st; b.wave = wave;
    if (wave == 0 && lane_id() == 0) (void)xb_add(&bar[XB_XCNT(b.x)], 1u);
    return b;
}
__device__ __forceinline__ void xcd_barrier_complete(unsigned* bar, unsigned x, unsigned& nloc, unsigned& nx) {
    const unsigned G = gridDim.x * gridDim.y * gridDim.z;
    unsigned sum, cnt, mine, sp = 0u;
    for (;;) {
        sum = 0u; cnt = 0u; mine = 0u;
#pragma unroll
        for (unsigned j = 0; j < 16; ++j) { const unsigned c = xb_ld(&bar[XB_XCNT(j)]); sum += c; cnt += (c > 0u) ? 1u : 0u; mine = (j == x) ? c : mine; }
        if (sum == G) break;
        __builtin_amdgcn_s_sleep(1);
        if ((++sp & 255u) == 0u) { if (xb_ld(&bar[XB_TMO])) break; if (sp > XB_SPIN_CAP) { atomicAdd(&bar[XB_TMO], 1u); break; } }
    }
    nloc = mine > 0u ? mine : 1u; nx = cnt > 0u ? cnt : 1u;
}
__device__ __forceinline__ void xcd_barrier(const XcdBarrier& b) {
    asm volatile("s_waitcnt vmcnt(0)" ::: "memory");
    __syncthreads();
    if (b.wave == 0 && lane_id() == 0) {
        unsigned* bar = b.bar;
        __builtin_amdgcn_s_waitcnt(0);
        unsigned nloc = b.st[0], nx = b.st[1];
        if (nloc == 0u) { xcd_barrier_complete(bar, b.x, nloc, nx); b.st[0] = nloc; b.st[1] = nx; }
        const unsigned old = xb_add(&bar[XB_XSUB(b.x)], 1u);
        const unsigned gen = old / nloc;
        if (old + 1u == (gen + 1u) * nloc) {
            __builtin_amdgcn_fence(__ATOMIC_RELEASE, "agent");
            asm volatile("s_waitcnt vmcnt(0)" ::: "memory");
            const unsigned og = xb_add(&bar[XB_TOP], 1u);
            const unsigned tg = og / nx;
            if (og + 1u == (tg + 1u) * nx) xb_add(&bar[XB_TOPGEN], 1u);
            else XB_SPIN(xb_ld(&bar[XB_TOPGEN]) == tg, bar);
            __builtin_amdgcn_fence(__ATOMIC_ACQUIRE, "agent");
            xb_add(&bar[XB_XGEN(b.x)], 1u);
            asm volatile("s_waitcnt vmcnt(0)" ::: "memory");
        } else {
            XB_SPIN(xb_ld(&bar[XB_XGEN(b.x)]) == gen, bar);
            __builtin_amdgcn_fence(__ATOMIC_ACQUIRE, "agent");
            asm volatile("s_waitcnt vmcnt(0)" ::: "memory");
        }
    }
    __syncthreads();
}

namespace pg8 {
constexpr int BM = 256, BK = 64, HALF = 128, HTB = HALF * BK * 2, STAGE_BYTES = 8 * HTB, NXCD = 8, WGM = 8;
__host__ __device__ __forceinline__ int lds_byte(int r, int c) { const int st = (r >> 4) * 2 + (c >> 5), rr = r & 15, cc = c & 31, ob = rr * 64 + cc * 2; return st * 1024 + (ob ^ (((ob >> 9) & 1) << 5)); }
__host__ __device__ __forceinline__ void stage_rc(int b, int& R, int& C) { const int st = b / 1024, sb = b % 1024, swz = sb ^ (((sb >> 9) & 1) << 5); R = (st >> 1) * 16 + swz / 64; C = (st & 1) * 32 + (swz % 64) / 2; }
__host__ __device__ __forceinline__ int perm32(int rho) { const int n = rho >> 4, i = rho & 15; return 8 * (i >> 2) + 4 * n + (i & 3); }
struct Unit { int pm, pn; };
struct Gemm { const bf16* A; const bf16* Bt; int M, N, K, lda, ldb; };
struct StaticOrder {
    int nM, nN, nwg, G, c;
    __host__ __device__ void init(int M, int N, int G_, int c_) { nM = M / BM; nN = N / BM; nwg = nM * nN; G = G_; c = c_; }
    __host__ __device__ bool next(int i, Unit& u) const {
        const long L = (long)i * G + c; if (L >= nwg) return false;
        int wgid = (int)L; { const int q = nwg / NXCD, r = nwg % NXCD, xcd = wgid % NXCD, off = wgid / NXCD; wgid = (xcd < r ? xcd * (q + 1) : r * (q + 1) + (xcd - r) * q) + off; }
        const int nig = WGM * nN, gid = wgid / nig, fm = gid * WGM, gsz = (nM - fm) < WGM ? (nM - fm) : WGM;
        u.pm = fm + ((wgid % nig) % gsz); u.pn = (wgid % nig) / gsz; return true;
    }
    __device__ __forceinline__ void a_ready(const Unit&) const {}
    __device__ __forceinline__ void done(const Unit&) const {}
};
__device__ __forceinline__ unsigned cvt_pk_bf16(float lo, float hi) { unsigned r; asm volatile("v_cvt_pk_bf16_f32 %0, %1, %2" : "=v"(r) : "v"(lo), "v"(hi)); return r; }

template <int ACT> struct EpiBf16 {
    static constexpr bool PERM = true, AFTER_DRAIN = false, HAS_MID = false;
    bf16* O; int ldc;
    __device__ __forceinline__ void operator()(const f32x4 (&acc)[2][2][4][2], const Unit& u, int wr, int wc, int fr, int fq) const {
        const int row0 = u.pm * BM + wr * 64 + fr; const int col0 = u.pn * BM + wc * 32 + 8 * fq;
#pragma unroll
        for (int ai = 0; ai < 2; ++ai)
#pragma unroll
            for (int m = 0; m < 4; ++m) { bf16* rowp = O + (size_t)(row0 + ai * HALF + m * 16) * ldc + col0;
#pragma unroll
                for (int bj = 0; bj < 2; ++bj) { f32x4 v0 = acc[ai][bj][m][0], v1 = acc[ai][bj][m][1];
                    if (ACT == 1) {
#pragma unroll
                        for (int j = 0; j < 4; ++j) { v0[j] = sigmoidf_(v0[j]); v1[j] = sigmoidf_(v1[j]); } }
                    u32x4 w; w.x = cvt_pk_bf16(v0[0], v0[1]); w.y = cvt_pk_bf16(v0[2], v0[3]); w.z = cvt_pk_bf16(v1[0], v1[1]); w.w = cvt_pk_bf16(v1[2], v1[3]);
                    *(u32x4*)(rowp + bj * HALF) = w; } }
    }
};
template <bool ACCUM> struct EpiBranch {
    static constexpr bool PERM = true, AFTER_DRAIN = false, HAS_MID = false;
    bf16* O; int ldc; const bf16* Gt; int ldg; int gcol0;
    __device__ __forceinline__ void operator()(const f32x4 (&acc)[2][2][4][2], const Unit& u, int wr, int wc, int fr, int fq) const {
        const int row0 = u.pm * BM + wr * 64 + fr; const int col0 = u.pn * BM + wc * 32 + 8 * fq;
#pragma unroll
        for (int ai = 0; ai < 2; ++ai)
#pragma unroll
            for (int m = 0; m < 4; ++m) { const size_t r = (size_t)(row0 + ai * HALF + m * 16); bf16* rowp = O + r * ldc + col0; const bf16* gp = Gt + r * ldg + gcol0 + col0;
#pragma unroll
                for (int bj = 0; bj < 2; ++bj) { const f32x4 v0 = acc[ai][bj][m][0], v1 = acc[ai][bj][m][1];
                    const u32x4 g = *(const u32x4*)(gp + bj * HALF);
                    float o[8];
                    o[0] = v0[0] * bflo(g.x); o[1] = v0[1] * bfhi(g.x); o[2] = v0[2] * bflo(g.y); o[3] = v0[3] * bfhi(g.y);
                    o[4] = v1[0] * bflo(g.z); o[5] = v1[1] * bfhi(g.z); o[6] = v1[2] * bflo(g.w); o[7] = v1[3] * bfhi(g.w);
                    if (ACCUM) { const u32x4 p = *(const u32x4*)(rowp + bj * HALF);
                        o[0] += bflo(p.x); o[1] += bfhi(p.x); o[2] += bflo(p.y); o[3] += bfhi(p.y); o[4] += bflo(p.z); o[5] += bfhi(p.z); o[6] += bflo(p.w); o[7] += bfhi(p.w); }
                    u32x4 w; w.x = cvt_pk_bf16(o[0], o[1]); w.y = cvt_pk_bf16(o[2], o[3]); w.z = cvt_pk_bf16(o[4], o[5]); w.w = cvt_pk_bf16(o[6], o[7]);
                    *(u32x4*)(rowp + bj * HALF) = w; } }
    }
};
struct EpiResid {
    static constexpr bool PERM = false, AFTER_DRAIN = false, HAS_MID = false;
    float* C; int ldc; const float* R;
    __device__ __forceinline__ void operator()(const f32x4 (&acc)[2][2][4][2], const Unit& u, int wr, int wc, int fr, int fq) const {
        const int row0 = u.pm * BM + wr * 64 + fr, col0 = u.pn * BM + wc * 32 + 4 * fq;
#pragma unroll
        for (int ai = 0; ai < 2; ++ai)
#pragma unroll
            for (int m = 0; m < 4; ++m) { const size_t off = (size_t)(row0 + ai * HALF + m * 16) * ldc + col0;
#pragma unroll
                for (int bj = 0; bj < 2; ++bj)
#pragma unroll
                    for (int n = 0; n < 2; ++n) { const f32x4 r = *(const f32x4*)(R + off + bj * HALF + n * 16); *(f32x4*)(C + off + bj * HALF + n * 16) = acc[ai][bj][m][n] + r; } }
    }
};

struct EpiBranchFused {
    static constexpr bool PERM = true, AFTER_DRAIN = false, HAS_MID = true;
    bf16* O; int ldc; __amdgpu_buffer_rsrc_t grs; int ldg;
    __device__ __forceinline__ void mid(f32x4 (&acc)[2][2][4][2], const Unit& u, int t, int wr, int wc, int fr, int fq) const {
        const unsigned voff = (unsigned)(((u.pm * BM + wr * 64 + fr) * ldg + u.pn * BM + wc * 32 + 8 * fq) * 2);
        const int ca = (t == 16) ? 0 : 2048;
#pragma unroll
        for (int ai = 0; ai < 2; ++ai)
#pragma unroll
            for (int m = 0; m < 4; ++m) {
#pragma unroll
                for (int bj = 0; bj < 2; ++bj) { const int so = ((ai * HALF + m * 16) * ldg + bj * HALF) * 2 + ca;
                    const u32x4 ga = __builtin_amdgcn_raw_buffer_load_b128(grs, voff, so, 0), gb = __builtin_amdgcn_raw_buffer_load_b128(grs, voff, so + 2048, 0);
                    f32x4& v0 = acc[ai][bj][m][0]; f32x4& v1 = acc[ai][bj][m][1];
                    v0[0] *= bflo(ga.x) * __builtin_amdgcn_rcpf(fmaxf(bflo(gb.x), 1e-30f)); v0[1] *= bfhi(ga.x) * __builtin_amdgcn_rcpf(fmaxf(bfhi(gb.x), 1e-30f));
                    v0[2] *= bflo(ga.y) * __builtin_amdgcn_rcpf(fmaxf(bflo(gb.y), 1e-30f)); v0[3] *= bfhi(ga.y) * __builtin_amdgcn_rcpf(fmaxf(bfhi(gb.y), 1e-30f));
                    v1[0] *= bflo(ga.z) * __builtin_amdgcn_rcpf(fmaxf(bflo(gb.z), 1e-30f)); v1[1] *= bfhi(ga.z) * __builtin_amdgcn_rcpf(fmaxf(bfhi(gb.z), 1e-30f));
                    v1[2] *= bflo(ga.w) * __builtin_amdgcn_rcpf(fmaxf(bflo(gb.w), 1e-30f)); v1[3] *= bfhi(ga.w) * __builtin_amdgcn_rcpf(fmaxf(bfhi(gb.w), 1e-30f)); }
                __builtin_amdgcn_sched_barrier(0); }
    }
    __device__ __forceinline__ void operator()(const f32x4 (&acc)[2][2][4][2], const Unit& u, int wr, int wc, int fr, int fq) const {
        const int row0 = u.pm * BM + wr * 64 + fr; const int col0 = u.pn * BM + wc * 32 + 8 * fq;
        const unsigned voff = (unsigned)((row0 * ldg + col0) * 2);
#pragma unroll
        for (int ai = 0; ai < 2; ++ai)
#pragma unroll
            for (int m = 0; m < 4; ++m) { const size_t r = (size_t)(row0 + ai * HALF + m * 16); bf16* rowp = O + r * ldc + col0;
#pragma unroll
                for (int bj = 0; bj < 2; ++bj) { const f32x4 v0 = acc[ai][bj][m][0], v1 = acc[ai][bj][m][1];
                    const u32x4 g = __builtin_amdgcn_raw_buffer_load_b128(grs, voff, ((ai * HALF + m * 16) * ldg + bj * HALF) * 2 + 4096, 0);
                    u32x4 w; w.x = cvt_pk_bf16(v0[0] * bflo(g.x), v0[1] * bfhi(g.x)); w.y = cvt_pk_bf16(v0[2] * bflo(g.y), v0[3] * bfhi(g.y));
                    w.z = cvt_pk_bf16(v1[0] * bflo(g.z), v1[1] * bfhi(g.z)); w.w = cvt_pk_bf16(v1[2] * bflo(g.w), v1[3] * bfhi(g.w));
                    *(u32x4*)(rowp + bj * HALF) = w; } }
    }
};

template <class Epi, class Sched>
__device__ __forceinline__ void gemm_phase(LAS unsigned char* lds, const Gemm g, const Sched& S, const Epi& E, int wid) {
    int lane = lane_id(); asm volatile("" : "+v"(lane));
    const int tid = wid * 64 + lane, wr = wid >> 2, wc = wid & 3, fr = lane & 15, fq = lane >> 4;
    const int K = g.K, nt = K / BK;
    unsigned voffA[2], voffB[2];
#pragma unroll
    for (int i = 0; i < 2; ++i) { int R, C; stage_rc(tid * 16 + i * 8192, R, C); const int Rb = Epi::PERM ? ((R & ~31) + perm32(R & 31)) : R;
        voffA[i] = (unsigned)(R * g.lda + C) * 2u; voffB[i] = (unsigned)(Rb * g.ldb + C) * 2u; }
    const size_t kstep = (size_t)(BK * 2);
    const size_t hsA = (size_t)HALF * g.lda * 2, hsB = (size_t)HALF * g.ldb * 2;
    const size_t tsA = 2 * hsA, tsB = 2 * hsB;
    const unsigned ldsw = (unsigned)wid * 1024u;
    const int aoff = lds_byte(wr * 64 + fr, fq * 8), boff = lds_byte(wc * 32 + fr, fq * 8);
#define PG8_SA(b, h) (((b) * 2 + (h)) * HTB)
#define PG8_SB(b, h) ((4 + (b) * 2 + (h)) * HTB)
#define PG8_STAGE(bufoff, gbase, voff) do { _Pragma("unroll") for (int _i = 0; _i < 2; ++_i) \
        __builtin_amdgcn_global_load_lds((const unsigned*)((const char*)(gbase) + (voff)[_i]), (LAS unsigned*)(lds + (bufoff) + ldsw + _i * 8192), 16, 0, 0); } while (0)
#define PG8_LDA(dst, b, h) do { _Pragma("unroll") for (int m = 0; m < 4; ++m) _Pragma("unroll") for (int k = 0; k < 2; ++k) dst[m][k] = *(const LAS bf16x8*)(lds + PG8_SA(b, h) + aoff + m * 2048 + k * 1024); } while (0)
#define PG8_LDB(dst, b, h) do { _Pragma("unroll") for (int n = 0; n < 2; ++n) _Pragma("unroll") for (int k = 0; k < 2; ++k) dst[n][k] = *(const LAS bf16x8*)(lds + PG8_SB(b, h) + boff + n * 2048 + k * 1024); } while (0)
#define PG8_MMA(ai, bj, At, Bt) do { __builtin_amdgcn_s_setprio(1); _Pragma("unroll") for (int m = 0; m < 4; ++m) _Pragma("unroll") for (int n = 0; n < 2; ++n) _Pragma("unroll") for (int k = 0; k < 2; ++k) \
        acc[ai][bj][m][n] = __builtin_amdgcn_mfma_f32_16x16x32_bf16(Bt[n][k], At[m][k], acc[ai][bj][m][n], 0, 0, 0); __builtin_amdgcn_s_setprio(0); } while (0)
#define PG8_WAIT_V(n) asm volatile("s_waitcnt vmcnt(" #n ")" ::: "memory")
#define PG8_WAIT_L(n) asm volatile("s_waitcnt lgkmcnt(" #n ")" ::: "memory")
#define PG8_BAR __builtin_amdgcn_s_barrier()
#define PG8_SCHED __builtin_amdgcn_sched_barrier(0)
    Unit cur, nxt; int ui = 0;
    if (!S.next(0, cur)) return;
    f32x4 acc[2][2][4][2];
#pragma unroll
    for (int a = 0; a < 2; ++a)
#pragma unroll
        for (int b = 0; b < 2; ++b)
#pragma unroll
            for (int m = 0; m < 4; ++m)
#pragma unroll
                for (int n = 0; n < 2; ++n) acc[a][b][m][n] = (f32x4){0.f, 0.f, 0.f, 0.f};
    bf16x8 At[4][2], B0[2][2], B1[2][2];
    const char* cA = (const char*)g.A + (size_t)cur.pm * tsA; const char* cB = (const char*)g.Bt + (size_t)cur.pn * tsB;
    S.a_ready(cur);
    PG8_STAGE(PG8_SB(0, 0), cB, voffB); PG8_STAGE(PG8_SA(0, 0), cA, voffA); PG8_STAGE(PG8_SB(0, 1), cB + hsB, voffB); PG8_STAGE(PG8_SA(0, 1), cA + hsA, voffA);
    if (wr == 1) PG8_BAR;
    PG8_WAIT_V(4); PG8_BAR;
    PG8_STAGE(PG8_SB(1, 0), cB + kstep, voffB); PG8_STAGE(PG8_SA(1, 0), cA + kstep, voffA); PG8_STAGE(PG8_SB(1, 1), cB + hsB + kstep, voffB);
    PG8_WAIT_V(6); PG8_BAR;
    for (;;) {
        const bool has_next = S.next(ui + 1, nxt);
        const char* nA = has_next ? (const char*)g.A + (size_t)nxt.pm * tsA : cA; const char* nB = has_next ? (const char*)g.Bt + (size_t)nxt.pn * tsB : cB;
        for (int t = 0; t < nt; t += 2) {
            const bool last = (t == nt - 2);
            const char* a1 = cA + (size_t)(t + 1) * kstep;
            const char* a2 = last ? nA : cA + (size_t)(t + 2) * kstep; const char* b2 = last ? nB : cB + (size_t)(t + 2) * kstep;
            const char* a3 = a2 + kstep; const char* b3 = b2 + kstep;
            if (last && has_next) S.a_ready(nxt);
            if constexpr (Epi::HAS_MID) { if (t == 16 || t == 20) E.mid(acc, cur, t, wr, wc, fr, fq); }
            PG8_LDB(B0, 0, 0); PG8_SCHED; PG8_LDA(At, 0, 0); PG8_STAGE(PG8_SA(1, 1), a1 + hsA, voffA);
            PG8_WAIT_L(8); PG8_BAR; PG8_WAIT_L(0); PG8_MMA(0, 0, At, B0); PG8_BAR; PG8_SCHED;
            PG8_LDB(B1, 0, 1); PG8_STAGE(PG8_SB(0, 0), b2, voffB);
            PG8_BAR; PG8_WAIT_L(0); PG8_MMA(0, 1, At, B1); PG8_BAR;
            PG8_LDA(At, 0, 1); PG8_STAGE(PG8_SA(0, 0), a2, voffA);
            PG8_BAR; PG8_WAIT_L(0); PG8_MMA(1, 0, At, B0); PG8_BAR; PG8_SCHED;
            PG8_STAGE(PG8_SB(0, 1), b2 + hsB, voffB);
            PG8_WAIT_V(6); PG8_BAR; PG8_MMA(1, 1, At, B1); PG8_BAR;
            PG8_LDB(B0, 1, 0); PG8_SCHED; PG8_LDA(At, 1, 0); PG8_STAGE(PG8_SA(0, 1), a2 + hsA, voffA);
            PG8_WAIT_L(8); PG8_BAR; PG8_WAIT_L(0); PG8_MMA(0, 0, At, B0); PG8_BAR; PG8_SCHED;
            PG8_LDB(B1, 1, 1); PG8_STAGE(PG8_SB(1, 0), b3, voffB);
            PG8_BAR; PG8_WAIT_L(0); PG8_MMA(0, 1, At, B1); PG8_BAR;
            PG8_LDA(At, 1, 1); PG8_STAGE(PG8_SA(1, 0), a3, voffA);
            PG8_BAR; PG8_WAIT_L(0); PG8_MMA(1, 0, At, B0); PG8_BAR; PG8_SCHED;
            PG8_STAGE(PG8_SB(1, 1), b3 + hsB, voffB);
            PG8_WAIT_V(6); PG8_BAR; PG8_MMA(1, 1, At, B1); PG8_BAR;
        }
        E(acc, cur, wr, wc, fr, fq); S.done(cur);
        if (!has_next) break;
#pragma unroll
        for (int a = 0; a < 2; ++a)
#pragma unroll
            for (int b = 0; b < 2; ++b)
#pragma unroll
                for (int m = 0; m < 4; ++m)
#pragma unroll
                    for (int n = 0; n < 2; ++n) acc[a][b][m][n] = (f32x4){0.f, 0.f, 0.f, 0.f};
        cur = nxt; cA = nA; cB = nB; ++ui;
    }
    PG8_WAIT_V(0);
    if (wr == 0) PG8_BAR;
    PG8_BAR;
#undef PG8_SA
#undef PG8_SB
#undef PG8_STAGE
#undef PG8_LDA
#undef PG8_LDB
#undef PG8_MMA
#undef PG8_WAIT_V
#undef PG8_WAIT_L
#undef PG8_BAR
#undef PG8_SCHED
}
}

#ifndef PROBE
#define PROBE 0
#endif
struct Args {
    const float* in[26]; const int* positions; float* out; unsigned char* ws; int ph_lo, ph_hi; int pad0, pad1;
};
struct Frame {
    LAS unsigned char* lds;
    int tid, lane, wave, G, bid;
    const float* const* in; const int* positions; float* out; unsigned char* ws;
};
__device__ __forceinline__ void frame_refresh(Frame& F) { int l = lane_id(); asm volatile("" : "+v"(l)); F.lane = l; F.tid = F.wave * 64 + l; }
enum { I_X = 0, I_MEM = 1, I_POS = 2, I_NMIXW = 3, I_WIN = 4, I_CONVW = 5, I_CONVB = 6, I_DTB = 7, I_ALOG = 8, I_SSDD = 9, I_SSDNW = 10, I_DQNW = 11, I_DKNW = 12, I_MEMNW = 13,
       I_WMKV = 14, I_MQNW = 15, I_MKNW = 16, I_WSSD = 17, I_WDIL = 18, I_WMEMBR = 19, I_WOUT = 20, I_NFFNW = 21, I_WQ = 22, I_SUBK = 23, I_PD = 24, I_PU = 25 };

__device__ __forceinline__ void p0_transpose_item(const float* W, int ldw, int src_col0, bf16* WT, int ldt, int dst_row0, int dst_col0, int nblk, LAS float* scr, int item, int lane) {
    const int kb = item / nblk, nb = item % nblk, k0 = 64 * kb, n0 = 32 * nb;
#pragma unroll 8
    for (int i = 0; i < 32; ++i) { const int kk = 2 * i + (lane >> 5); scr[kk * 33 + (lane & 31)] = W[(size_t)(k0 + kk) * ldw + src_col0 + n0 + (lane & 31)]; }
    LDS_WAIT(); asm volatile("" ::: "memory");
    const int c = lane & 7;
#pragma unroll
    for (int j = 0; j < 4; ++j) { const int n = (lane >> 3) + 8 * j; const LAS float* s = scr + (8 * c) * 33 + n;
        u32x4 o; o.x = pk2(s[0 * 33], s[1 * 33]); o.y = pk2(s[2 * 33], s[3 * 33]); o.z = pk2(s[4 * 33], s[5 * 33]); o.w = pk2(s[6 * 33], s[7 * 33]);
        *(u32x4*)(WT + (size_t)(dst_row0 + n0 + n) * ldt + dst_col0 + k0 + 8 * c) = o; }
    LDS_WAIT(); asm volatile("" ::: "memory");
}
__device__ __forceinline__ void rms_row_to_bf16(const float* xrow, const float* w, bf16* orow, int lane, f32x4 (&v)[4]) {
    const f32x4* xr = (const f32x4*)xrow + lane; const f32x4* wr = (const f32x4*)w + lane;
    float s = 0.f;
#pragma unroll
    for (int j = 0; j < 4; ++j) { v[j] = xr[64 * j]; s += (v[j].x * v[j].x + v[j].y * v[j].y) + (v[j].z * v[j].z + v[j].w * v[j].w); }
    const float rstd = 1.0f / sqrtf(wave_sum(s) * (1.f / DM) + EPS);
    unsigned long long* o8 = (unsigned long long*)orow + lane;
#pragma unroll
    for (int j = 0; j < 4; ++j) { const f32x4 ww = wr[64 * j]; v[j] = v[j] * rstd * ww;
        o8[64 * j] = (unsigned long long)pk2(v[j].x, v[j].y) | ((unsigned long long)pk2(v[j].z, v[j].w) << 32); }
}
__device__ __forceinline__ void cvt_f32_bf16_stream(const float* src, bf16* dst, size_t n, size_t gtid, size_t gthreads) {
    for (size_t i = gtid * 8; i < n; i += gthreads * 8) { const f32x4 a = *(const f32x4*)(src + i), b = *(const f32x4*)(src + i + 4);
        u32x4 o; o.x = pk2(a.x, a.y); o.y = pk2(a.z, a.w); o.z = pk2(b.x, b.y); o.w = pk2(b.z, b.w); *(u32x4*)(dst + i) = o; }
}
constexpr float PD_SCALE = 64.0f, PU_SCALE = 8.0f;
__device__ __forceinline__ unsigned pk4_fp8(f32x4 v, float sc) {
    const float a = fminf(fmaxf(v.x * sc, -448.f), 448.f), b = fminf(fmaxf(v.y * sc, -448.f), 448.f), c = fminf(fmaxf(v.z * sc, -448.f), 448.f), d = fminf(fmaxf(v.w * sc, -448.f), 448.f);
    unsigned p = __builtin_amdgcn_cvt_pk_fp8_f32(a, b, 0, false); return __builtin_amdgcn_cvt_pk_fp8_f32(c, d, p, true);
}
__device__ __forceinline__ void cvt_f32_fp8_sliced(const float* src, unsigned char* dst, float sc, size_t gtid, size_t gthreads) {
    for (size_t i = gtid * 16; i < (size_t)16384 * 1024; i += gthreads * 16) { const f32x4 a = *(const f32x4*)(src + i), b = *(const f32x4*)(src + i + 4), c = *(const f32x4*)(src + i + 8), d = *(const f32x4*)(src + i + 12);
        const size_t e = i >> 10, dd = i & 1023;
        const u32x4 o = {pk4_fp8(a, sc), pk4_fp8(b, sc), pk4_fp8(c, sc), pk4_fp8(d, sc)}; *(u32x4*)(dst + ((((dd >> 7) * 16384 + e) << 7) + (dd & 127))) = o; }
}
__device__ __forceinline__ void p0_prologue(Frame& F) {
    LAS float* scr = (LAS float*)(F.lds + F.wave * 8448);
    LAS float* wdt = (LAS float*)(F.lds + 8 * 8448);
    const int gw = F.bid * NWAVES + F.wave, NGW = F.G * NWAVES;
    unsigned char* ws = F.ws;
    for (int i = F.tid; i < 1024 * 16; i += NTHR) { const int k = i >> 4, c = i & 15, l = (k & 255) >> 2, e = k & 3, j = k >> 8, q = c >> 2;
        wdt[((((j * 4 + e) * 4 + q) * 64 + l) << 2) + (c & 3)] = F.in[I_WIN][(size_t)k * W_IN_N + OFF_DT + c]; }
    __syncthreads();
    constexpr int IT_A = 16 * 96, IT_B = 16 * 192, IT_MKV = 16 * 48, IT_SSD = 16 * 32, IT_DIL = 4 * 32, IT_MBR = 12 * 32, IT_OUT = 16 * 32, IT_WQ = 16 * 64;
    constexpr int NITEMS = IT_A + IT_B + IT_MKV + IT_SSD + IT_DIL + IT_MBR + IT_OUT + IT_WQ;
    bf16* WallT = (bf16*)(ws + WS_WALLT);
    for (int it = gw; it < NITEMS; it += NGW) {
        int r = it;
        if (r < IT_A) { p0_transpose_item(F.in[I_WIN], W_IN_N, 0, WallT, DM, 0, 0, 96, scr, r, F.lane); continue; } r -= IT_A;
        if (r < IT_B) { p0_transpose_item(F.in[I_WIN], W_IN_N, OFF_AFTER_DT, WallT, DM, 3072, 0, 192, scr, r, F.lane); continue; } r -= IT_B;
        if (r < IT_MKV) { p0_transpose_item(F.in[I_WMKV], 1536, 0, (bf16*)(ws + WS_WMKVT), DM, 0, 0, 48, scr, r, F.lane); continue; } r -= IT_MKV;
        if (r < IT_SSD) { p0_transpose_item(F.in[I_WSSD], DM, 0, (bf16*)(ws + WS_WCATT), YC, 0, 0, 32, scr, r, F.lane); continue; } r -= IT_SSD;
        if (r < IT_DIL) { p0_transpose_item(F.in[I_WDIL], DM, 0, (bf16*)(ws + WS_WCATT), YC, 0, 1024, 32, scr, r, F.lane); continue; } r -= IT_DIL;
        if (r < IT_MBR) { p0_transpose_item(F.in[I_WMEMBR], DM, 0, (bf16*)(ws + WS_WCATT), YC, 0, 1280, 32, scr, r, F.lane); continue; } r -= IT_MBR;
        if (r < IT_OUT) { p0_transpose_item(F.in[I_WOUT], DM, 0, (bf16*)(ws + WS_WOUTT), DM, 0, 0, 32, scr, r, F.lane); continue; } r -= IT_OUT;
        p0_transpose_item(F.in[I_WQ], PEER_Q, 0, (bf16*)(ws + WS_WQT), DM, 0, 0, 64, scr, r, F.lane);
    }
    const size_t gtid = (size_t)F.bid * NTHR + F.tid, gth = (size_t)F.G * NTHR;
    cvt_f32_bf16_stream(F.in[I_SUBK], (bf16*)(ws + WS_SUBK), (size_t)8 * 2 * 128 * 128, gtid, gth);
    cvt_f32_fp8_sliced(F.in[I_PD], ws + WS_PD, PD_SCALE, gtid, gth);
    cvt_f32_fp8_sliced(F.in[I_PU], ws + WS_PU, PU_SCALE, gtid, gth);
    for (int m = gw; m < NB * NMEM; m += NGW) { f32x4 v[4]; rms_row_to_bf16(F.in[I_MEM] + (size_t)m * DM, F.in[I_MEMNW], (bf16*)(ws + WS_MEMN) + (size_t)m * DM, F.lane, v); }
    float* DTp = (float*)(ws + WS_DT);
    const int lane = F.lane;
    const int myj = ((lane >> 5) & 1) * 8 + ((lane >> 4) & 1) * 4 + ((lane >> 3) & 1) * 2 + ((lane >> 2) & 1);
    const float dtb = F.in[I_DTB][myj];
    for (int m = 2 * gw; m < T; m += 2 * NGW) {
        f32x4 va[4], vb[4];
        rms_row_to_bf16(F.in[I_X] + (size_t)m * DM, F.in[I_NMIXW], (bf16*)(ws + WS_ACT1) + (size_t)m * DM, lane, va);
        rms_row_to_bf16(F.in[I_X] + (size_t)(m + 1) * DM, F.in[I_NMIXW], (bf16*)(ws + WS_ACT1) + (size_t)(m + 1) * DM, lane, vb);
        float da[16], db[16];
#pragma unroll
        for (int j = 0; j < 16; ++j) { da[j] = 0.f; db[j] = 0.f; }
#pragma unroll
        for (int j = 0; j < 4; ++j)
#pragma unroll
            for (int e = 0; e < 4; ++e) { const float ua = va[j][e], ub = vb[j][e];
#pragma unroll
                for (int q = 0; q < 4; ++q) { const f32x4 w4 = *(const LAS f32x4*)(wdt + ((((j * 4 + e) * 4 + q) * 64 + lane) << 2));
                    da[4 * q + 0] += ua * w4.x; da[4 * q + 1] += ua * w4.y; da[4 * q + 2] += ua * w4.z; da[4 * q + 3] += ua * w4.w;
                    db[4 * q + 0] += ub * w4.x; db[4 * q + 1] += ub * w4.y; db[4 * q + 2] += ub * w4.z; db[4 * q + 3] += ub * w4.w; }
                __builtin_amdgcn_sched_barrier(0); }
        float ra, rb;
        { float r8a[8], r8b[8], r4a[4], r4b[4], r2a[2], r2b[2];
          { const bool up = (lane & 32) != 0;
#pragma unroll
            for (int k = 0; k < 8; ++k) { r8a[k] = (up ? da[k + 8] : da[k]) + __shfl_xor(up ? da[k] : da[k + 8], 32); r8b[k] = (up ? db[k + 8] : db[k]) + __shfl_xor(up ? db[k] : db[k + 8], 32); } }
          { const bool up = (lane & 16) != 0;
#pragma unroll
            for (int k = 0; k < 4; ++k) { r4a[k] = (up ? r8a[k + 4] : r8a[k]) + __shfl_xor(up ? r8a[k] : r8a[k + 4], 16); r4b[k] = (up ? r8b[k + 4] : r8b[k]) + __shfl_xor(up ? r8b[k] : r8b[k + 4], 16); } }
          { const bool up = (lane & 8) != 0;
#pragma unroll
            for (int k = 0; k < 2; ++k) { r2a[k] = (up ? r4a[k + 2] : r4a[k]) + __shfl_xor(up ? r4a[k] : r4a[k + 2], 8); r2b[k] = (up ? r4b[k + 2] : r4b[k]) + __shfl_xor(up ? r4b[k] : r4b[k + 2], 8); } }
          { const bool up = (lane & 4) != 0; ra = (up ? r2a[1] : r2a[0]) + __shfl_xor(up ? r2a[0] : r2a[1], 4); rb = (up ? r2b[1] : r2b[0]) + __shfl_xor(up ? r2b[0] : r2b[1], 4); }
          ra += __shfl_xor(ra, 2); ra += __shfl_xor(ra, 1); rb += __shfl_xor(rb, 2); rb += __shfl_xor(rb, 1); }
        if ((lane & 3) == 0) { const float xa = ra + dtb, xb = rb + dtb;
            DTp[(size_t)m * 16 + myj] = (xa > 20.f) ? xa : log1pf(__expf(xa)); DTp[(size_t)(m + 1) * 16 + myj] = (xb > 20.f) ? xb : log1pf(__expf(xb)); }
    }
}

__device__ __forceinline__ void qkprep_phase(Frame& F, int half) {
    bf16* P = (bf16*)(F.ws + WS_BIG);
    const int gw = F.bid * NWAVES + F.wave, NGW = F.G * NWAVES, lane = F.lane;
    const float wq = F.in[I_DQNW][lane], wk = F.in[I_DKNW][lane];
    const float wmq0 = F.in[I_MQNW][lane], wmq1 = F.in[I_MQNW][lane + 64], wmq2 = F.in[I_MQNW][lane + 128];
    const float inv = __expf(-logf(500000.0f) * (2.0f / 16.0f) * (float)(lane & 7));
    for (int r = gw; r < HT; r += NGW) {
        const int tok = half * HT + r;
        const int pos = F.positions[tok];
        const double rev = (double)((float)pos * inv) * 0.15915494309189535;
        const float fr = (float)(rev - floor(rev));
        const float cs = __builtin_amdgcn_cosf(fr), sn = __builtin_amdgcn_sinf(fr);
        bf16* row = P + (size_t)r * NPROJ;
#pragma unroll 4
        for (int h = 0; h < 24; ++h) {
            bf16* p = row + PC_DQ + h * 64 + lane;
            float v = bf2f(*p);
            const float ss = wave_sum(v * v);
            v = v * (1.0f / sqrtf(ss * (1.f / 64.f) + EPS)) * (h < 12 ? wq : wk);
            const float other = __shfl_xor(v, 8);
            if (lane < 8) v = v * cs - other * sn; else if (lane < 16) v = v * cs + other * sn;
            *p = (bf16)f2bf(v);
        }
#pragma unroll
        for (int h = 0; h < 4; ++h) {
            bf16* p = row + PC_MQ + h * 192 + lane;
            float v0 = bf2f(p[0]), v1 = bf2f(p[64]), v2 = bf2f(p[128]);
            const float ss = wave_sum(v0 * v0 + v1 * v1 + v2 * v2);
            const float rs = 1.0f / sqrtf(ss * (1.f / 192.f) + EPS);
            p[0] = (bf16)f2bf(v0 * rs * wmq0); p[64] = (bf16)f2bf(v1 * rs * wmq1); p[128] = (bf16)f2bf(v2 * rs * wmq2);
        }
    }
    if (half == 0) {
        bf16* MK = (bf16*)(F.ws + WS_MKV);
        const float wk0 = F.in[I_MKNW][lane], wk1 = F.in[I_MKNW][lane + 64], wk2 = F.in[I_MKNW][lane + 128];
        for (int r = gw; r < NB * NMEM * 4; r += NGW) {
            bf16* p = MK + (size_t)(r >> 2) * 1536 + (r & 3) * 192 + lane;
            float v0 = bf2f(p[0]), v1 = bf2f(p[64]), v2 = bf2f(p[128]);
            const float ss = wave_sum(v0 * v0 + v1 * v1 + v2 * v2);
            const float rs = 1.0f / sqrtf(ss * (1.f / 192.f) + EPS);
            p[0] = (bf16)f2bf(v0 * rs * wk0); p[64] = (bf16)f2bf(v1 * rs * wk1); p[128] = (bf16)f2bf(v2 * rs * wk2);
        }
    }
}


constexpr int SC_ST = 272, SX_ST = 528;
__device__ __forceinline__ float bfsel(const u32x4& v, int j) { const unsigned w = v[j >> 1]; return (j & 1) ? bfhi(w) : bflo(w); }
__device__ __forceinline__ void conv_task(const bf16* P, size_t rowb, int t0, int pcol, const float* cw, const float* cb, int ccol, LAS unsigned char* dst, int stride, const LAS float* scale) {
    float w[4][8], bs[8];
#pragma unroll
    for (int k = 0; k < 4; ++k) { const f32x4 a = *(const f32x4*)(cw + k * 2048 + ccol), b = *(const f32x4*)(cw + k * 2048 + ccol + 4);
        w[k][0] = a.x; w[k][1] = a.y; w[k][2] = a.z; w[k][3] = a.w; w[k][4] = b.x; w[k][5] = b.y; w[k][6] = b.z; w[k][7] = b.w; }
    { const f32x4 a = *(const f32x4*)(cb + ccol), b = *(const f32x4*)(cb + ccol + 4); bs[0] = a.x; bs[1] = a.y; bs[2] = a.z; bs[3] = a.w; bs[4] = b.x; bs[5] = b.y; bs[6] = b.z; bs[7] = b.w; }
    const bf16* src = P + (rowb + t0) * NPROJ + pcol;
    u32x4 rw[19];
#pragma unroll
    for (int i = 0; i < 3; ++i) rw[i] = (u32x4){0u, 0u, 0u, 0u};
    if (t0 > 0) {
#pragma unroll
        for (int i = 0; i < 3; ++i) rw[i] = *(const u32x4*)(src + (ptrdiff_t)(i - 3) * NPROJ); }
#pragma unroll
    for (int i = 0; i < 16; ++i) rw[3 + i] = *(const u32x4*)(src + (size_t)i * NPROJ);
#pragma unroll
    for (int i = 0; i < 16; ++i) {
        float o[8];
#pragma unroll
        for (int j = 0; j < 8; ++j) { float a = bs[j] + w[0][j] * bfsel(rw[i], j) + w[1][j] * bfsel(rw[i + 1], j) + w[2][j] * bfsel(rw[i + 2], j) + w[3][j] * bfsel(rw[i + 3], j); o[j] = a * sigmoidf_(a); }
        if (scale) { const float sv = scale[i];
#pragma unroll
            for (int j = 0; j < 8; ++j) o[j] *= sv; }
        const u32x4 r = {pkbf(o[0], o[1]), pkbf(o[2], o[3]), pkbf(o[4], o[5]), pkbf(o[6], o[7])};
        *(LAS u32x4*)(dst + i * stride) = r;
    }
}
__device__ __forceinline__ float ssd_scan(Frame& F, const float* DTp, size_t tok0, int g, LAS float* sAc, LAS float* sDt) {
    float total = 0.f;
    if (F.wave < 4) {
        const int head = 4 * g + F.wave, lane = F.lane;
        const float A = -__expf(F.in[I_ALOG][head]);
        const float d0 = DTp[(tok0 + 2 * lane) * 16 + head], d1 = DTp[(tok0 + 2 * lane + 1) * 16 + head];
        const float a0 = d0 * A, a1 = d1 * A;
        float sc = a0 + a1;
#pragma unroll
        for (int o = 1; o < 64; o <<= 1) { const float v = __shfl_up(sc, o); if (lane >= o) sc += v; }
        sAc[F.wave * 128 + 2 * lane] = sc - a1; sAc[F.wave * 128 + 2 * lane + 1] = sc;
        sDt[F.wave * 128 + 2 * lane] = d0; sDt[F.wave * 128 + 2 * lane + 1] = d1;
        total = __shfl(sc, 63);
    }
    return total;
}
__device__ __forceinline__ bf16x8 tr_pair(unsigned a_lo, unsigned a_hi) {
    s16x4 lo, hi;
    asm volatile("ds_read_b64_tr_b16 %0, %2\n\tds_read_b64_tr_b16 %1, %3\n\ts_waitcnt lgkmcnt(0)" : "=&v"(lo), "=&v"(hi) : "v"(a_lo), "v"(a_hi) : "memory");
    const bf16x8 r = {lo[0], lo[1], lo[2], lo[3], hi[0], hi[1], hi[2], hi[3]}; return r;
}

__device__ __forceinline__ void ssdC_phase(Frame& F, int half) {
    const bf16* P = (const bf16*)(F.ws + WS_BIG);
    const float* DTp = (const float*)(F.ws + WS_DT);
    float* SST = (float*)(F.ws + WS_SST); float* DEC = (float*)(F.ws + WS_DEC);
    LAS unsigned char* sX = F.lds; LAS unsigned char* sB = F.lds + 128 * SX_ST;
    LAS float* sAc = (LAS float*)(F.lds + 128 * SX_ST + 128 * SC_ST); LAS float* sDt = sAc + 512; LAS float* sW = sDt + 512;
    const int wave = F.wave;
    for (int unit = F.bid; unit < HB * 64 * 4; unit += F.G) {
        int tid = F.tid; asm volatile("" : "+v"(tid));
        const int lane = tid & 63, ql = lane & 31, h = lane >> 5, tq = (lane & 15) >> 2, tp = lane & 3, tblk = (lane >> 4) & 1;
        const int bl = unit >> 8, c = (unit >> 2) & 63, g = unit & 3;
        const size_t rowb = (size_t)bl * SEQ, tok0 = (size_t)half * HT + rowb + c * 128;
        __syncthreads();
        const float total = ssd_scan(F, DTp, tok0, g, sAc, sDt);
        if (wave < 4) { sW[wave * 128 + 2 * lane] = __expf(total - sAc[wave * 128 + 2 * lane]) * sDt[wave * 128 + 2 * lane];
            sW[wave * 128 + 2 * lane + 1] = __expf(total - sAc[wave * 128 + 2 * lane + 1]) * sDt[wave * 128 + 2 * lane + 1];
            if (lane == 0) DEC[((size_t)bl * 64 + c) * 16 + 4 * g + wave] = __expf(total); }
        __syncthreads();
        if (tid < 384) {
            int ch, strip, ccol, stride; LAS unsigned char* dst; const LAS float* scl = nullptr;
            if (tid < 256) { ch = tid & 31; strip = tid >> 5; ccol = g * 256 + 8 * ch; stride = SX_ST; dst = sX + (strip * 16) * SX_ST + ch * 16; scl = sW + (ch >> 3) * 128 + strip * 16; }
            else { const int u = tid - 256; ch = u & 15; strip = u >> 4; ccol = 1024 + g * 128 + 8 * ch; stride = SC_ST; dst = sB + (strip * 16) * SC_ST + ch * 16; }
            conv_task(P, rowb, c * 128 + strip * 16, PC_X + ccol, F.in[I_CONVW], F.in[I_CONVB], ccol, dst, stride, scl);
        }
        __syncthreads();
        const int r = wave >> 1, pt = wave & 1;
        f32x16 acc[4];
#pragma unroll
        for (int nt = 0; nt < 4; ++nt)
#pragma unroll
            for (int e = 0; e < 16; ++e) acc[nt][e] = 0.f;
        const unsigned xa = (unsigned)(size_t)sX + (unsigned)((8 * h + tq) * SX_ST + (r * 64 + 32 * pt + 16 * tblk + 4 * tp) * 2);
        const unsigned ba = (unsigned)(size_t)sB + (unsigned)((8 * h + tq) * SC_ST + (16 * tblk + 4 * tp) * 2);
#pragma unroll
        for (int ks = 0; ks < 8; ++ks) {
            const bf16x8 af = tr_pair(xa + ks * 16 * SX_ST, xa + ks * 16 * SX_ST + 4 * SX_ST);
            bf16x8 bfr[4];
#pragma unroll
            for (int nt = 0; nt < 4; ++nt) bfr[nt] = tr_pair(ba + ks * 16 * SC_ST + nt * 64, ba + ks * 16 * SC_ST + 4 * SC_ST + nt * 64);
            __builtin_amdgcn_sched_barrier(0);
#pragma unroll
            for (int nt = 0; nt < 4; ++nt) acc[nt] = MFMA32(af, bfr[nt], acc[nt]);
        }
        float* out = SST + (((size_t)bl * 64 + c) * 16 + 4 * g + r) * 8192;
#pragma unroll
        for (int nt = 0; nt < 4; ++nt)
#pragma unroll
            for (int e = 0; e < 16; ++e) out[(32 * pt + (e & 3) + 8 * (e >> 2) + 4 * h) * 128 + 32 * nt + ql] = acc[nt][e];
    }
}

__device__ __forceinline__ void ssdD_phase(Frame& F) {
    const float* SST = (const float*)(F.ws + WS_SST); const float* DEC = (const float*)(F.ws + WS_DEC);
    bf16* SIN = (bf16*)(F.ws + WS_SIN);
    const size_t gtid = (size_t)F.bid * NTHR + F.tid, gth = (size_t)F.G * NTHR;
    for (size_t it = gtid; it < (size_t)HB * 16 * 2048; it += gth) {
        const int bl = (int)(it >> 15), head = (int)(it >> 11) & 15, e4 = (int)(it & 2047) * 4;
        f32x4 st = {0.f, 0.f, 0.f, 0.f};
#pragma unroll 8
        for (int c = 0; c < 64; ++c) {
            const size_t idx = (((size_t)bl * 64 + c) * 16 + head);
            const u32x2 o = {pkbf(st.x, st.y), pkbf(st.z, st.w)};
            *(u32x2*)(SIN + idx * 8192 + e4) = o;
            const f32x4 sl = *(const f32x4*)(SST + idx * 8192 + e4); const float d = DEC[idx];
            st = st * d + sl;
        }
    }
}

__device__ __forceinline__ void ssdE_phase(Frame& F, int half) {
    const bf16* P = (const bf16*)(F.ws + WS_BIG);
    const float* DTp = (const float*)(F.ws + WS_DT);
    const bf16* SIN = (const bf16*)(F.ws + WS_SIN);
    bf16* Y = (bf16*)F.out;
    LAS unsigned char* sX = F.lds; LAS unsigned char* sB = F.lds + 128 * SX_ST; LAS unsigned char* sC = sB + 128 * SC_ST;
    LAS float* sAc = (LAS float*)(sC + 128 * SC_ST); LAS float* sDt = sAc + 512; LAS float* sSS = sDt + 512;
    const int wave = F.wave;
    const int st = wave & 3, hp = wave >> 2;
    for (int unit = F.bid; unit < HB * 64 * 4; unit += F.G) {
        int tid = F.tid; asm volatile("" : "+v"(tid));
        const int lane = tid & 63, ql = lane & 31, h = lane >> 5, tq = (lane & 15) >> 2, tp = lane & 3, tblk = (lane >> 4) & 1;
        const int bl = unit >> 8, c = (unit >> 2) & 63, g = unit & 3;
        const size_t rowb = (size_t)bl * SEQ, tok0 = (size_t)half * HT + rowb + c * 128;
        __syncthreads();
        (void)ssd_scan(F, DTp, tok0, g, sAc, sDt);
        if (tid < 128) sSS[tid] = 0.f;
        {
            int ch, strip, ccol, stride; LAS unsigned char* dst;
            if (tid < 256) { ch = tid & 31; strip = tid >> 5; ccol = g * 256 + 8 * ch; stride = SX_ST; dst = sX + (strip * 16) * SX_ST + ch * 16; }
            else if (tid < 384) { const int u = tid - 256; ch = u & 15; strip = u >> 4; ccol = 1024 + g * 128 + 8 * ch; stride = SC_ST; dst = sB + (strip * 16) * SC_ST + ch * 16; }
            else { const int u = tid - 384; ch = u & 15; strip = u >> 4; ccol = 1536 + g * 128 + 8 * ch; stride = SC_ST; dst = sC + (strip * 16) * SC_ST + ch * 16; }
            conv_task(P, rowb, c * 128 + strip * 16, PC_X + ccol, F.in[I_CONVW], F.in[I_CONVB], ccol, dst, stride, nullptr);
        }
        __syncthreads();
        const int s = 32 * st + ql;
        unsigned yk[2][2][8];
        float ssq = 0.f;
        const unsigned xa = (unsigned)(size_t)sX + (unsigned)((4 * h + tq) * SX_ST + (16 * tblk + 4 * tp) * 2);
#pragma unroll
        for (int hq = 0; hq < 2; ++hq) {
            const int r = 2 * hp + hq, head = 4 * g + r;
            const float acs = sAc[r * 128 + s];
            const bf16* stp = SIN + (((size_t)bl * 64 + c) * 16 + head) * 8192 + ql * 128 + 8 * h;
            bf16x8 sfr[2][8];
#pragma unroll
            for (int pt = 0; pt < 2; ++pt)
#pragma unroll
                for (int ks = 0; ks < 8; ++ks) sfr[pt][ks] = *(const bf16x8*)(stp + pt * 4096 + 16 * ks);
            bf16x8 pf[4][2];
#pragma unroll
            for (int i = 0; i < 4; ++i) {
                f32x16 Xi;
#pragma unroll
                for (int e = 0; e < 16; ++e) Xi[e] = 0.f;
#pragma unroll
                for (int ks = 0; ks < 8; ++ks) { const bf16x8 bf_ = *(const LAS bf16x8*)(sB + (32 * i + ql) * SC_ST + 32 * ks + 16 * h);
                    const bf16x8 cf = *(const LAS bf16x8*)(sC + s * SC_ST + 32 * ks + 16 * h); Xi = MFMA32(bf_, cf, Xi); }
                float p[16];
#pragma unroll
                for (int q4 = 0; q4 < 4; ++q4) { const int t0 = 32 * i + 8 * q4 + 4 * h;
                    const f32x4 at = *(const LAS f32x4*)(sAc + r * 128 + t0), dt4 = *(const LAS f32x4*)(sDt + r * 128 + t0);
#pragma unroll
                    for (int e = 0; e < 4; ++e) { const int t = t0 + e; p[4 * q4 + e] = (t <= s) ? Xi[4 * q4 + e] * __expf(acs - at[e]) * dt4[e] : 0.f; } }
#pragma unroll
                for (int s2 = 0; s2 < 2; ++s2) { const u32x4 w = {pkbf(p[8 * s2 + 0], p[8 * s2 + 1]), pkbf(p[8 * s2 + 2], p[8 * s2 + 3]), pkbf(p[8 * s2 + 4], p[8 * s2 + 5]), pkbf(p[8 * s2 + 6], p[8 * s2 + 7])};
                    pf[i][s2] = __builtin_bit_cast(bf16x8, w); }
            }
            const float eacs = __expf(acs), Dh = F.in[I_SSDD][head];
#pragma unroll
            for (int pt = 0; pt < 2; ++pt) {
                f32x16 yd, yo;
#pragma unroll
                for (int e = 0; e < 16; ++e) { yd[e] = 0.f; yo[e] = 0.f; }
#pragma unroll
                for (int i = 0; i < 4; ++i) {
#pragma unroll
                    for (int s2 = 0; s2 < 2; ++s2) { const unsigned a = xa + (unsigned)((32 * i + 16 * s2) * SX_ST + (r * 64 + 32 * pt) * 2);
                        const bf16x8 xf = tr_pair(a, a + 8 * SX_ST); __builtin_amdgcn_sched_barrier(0); yd = MFMA32(xf, pf[i][s2], yd); }
                }
#pragma unroll
                for (int ks = 0; ks < 8; ++ks) { const bf16x8 cf = *(const LAS bf16x8*)(sC + s * SC_ST + 32 * ks + 16 * h); yo = MFMA32(sfr[pt][ks], cf, yo); }
                const bf16* zp = P + (rowb + c * 128 + s) * NPROJ + PC_Z + g * 256 + r * 64 + 32 * pt + 4 * h;
                u32x2 zv[4];
#pragma unroll
                for (int q4 = 0; q4 < 4; ++q4) zv[q4] = *(const u32x2*)(zp + 8 * q4);
#pragma unroll
                for (int q4 = 0; q4 < 4; ++q4) {
                    const u32x2 xv = *(const LAS u32x2*)(sX + s * SX_ST + (r * 64 + 32 * pt + 8 * q4 + 4 * h) * 2);
                    const u32x2 zq = zv[q4];
                    const float xs_[4] = {bflo(xv.x), bfhi(xv.x), bflo(xv.y), bfhi(xv.y)}, zs_[4] = {bflo(zq.x), bfhi(zq.x), bflo(zq.y), bfhi(zq.y)};
                    float yv[4];
#pragma unroll
                    for (int e = 0; e < 4; ++e) { float y = yd[4 * q4 + e] + eacs * yo[4 * q4 + e] + Dh * xs_[e]; y = y * zs_[e] * sigmoidf_(zs_[e]); yv[e] = y; ssq += y * y; }
                    yk[hq][pt][2 * q4] = pkbf(yv[0], yv[1]); yk[hq][pt][2 * q4 + 1] = pkbf(yv[2], yv[3]);
                }
            }
        }
        ssq += __shfl_xor(ssq, 32);
        if (h == 0) __hip_atomic_fetch_add(sSS + s, ssq, __ATOMIC_RELAXED, __HIP_MEMORY_SCOPE_WORKGROUP);
        __syncthreads();
        const float rs = 1.0f / sqrtf(sSS[s] * (1.f / 256.f) + EPS);
        bf16* yp = Y + (tok0 + s) * YC + g * 256 + 4 * h;
        const float* nw = F.in[I_SSDNW] + g * 256 + 4 * h;
#pragma unroll
        for (int hq = 0; hq < 2; ++hq)
#pragma unroll
            for (int pt = 0; pt < 2; ++pt)
#pragma unroll
                for (int q4 = 0; q4 < 4; ++q4) { const int cc = (2 * hp + hq) * 64 + 32 * pt + 8 * q4; const f32x4 w4 = *(const f32x4*)(nw + cc);
                    const unsigned ya = yk[hq][pt][2 * q4], yb = yk[hq][pt][2 * q4 + 1];
                    const u32x2 o = {pkbf(bflo(ya) * rs * w4.x, bfhi(ya) * rs * w4.y), pkbf(bflo(yb) * rs * w4.z, bfhi(yb) * rs * w4.w)};
                    *(u32x2*)(yp + cc) = o; }
    }
}

__device__ __forceinline__ bf16x8 mk_bf16x8(u32x2 lo, u32x2 hi) { const u32x4 v = {lo.x, lo.y, hi.x, hi.y}; return __builtin_bit_cast(bf16x8, v); }

__device__ __forceinline__ void memattn_mfma_phase(Frame& F, int half) {
    const bf16* P = (const bf16*)(F.ws + WS_BIG);
    const bf16* MKV = (const bf16*)(F.ws + WS_MKV);
    const bf16* MVT = (const bf16*)(F.ws + WS_MVT);
    bf16* Y = (bf16*)F.out;
    LAS unsigned char* sm = F.lds;
    const int tid = F.tid, lane = F.lane, wave = F.wave, ql = lane & 31, h = lane >> 5;
    constexpr int KST = 400, VST = 528;
    for (int unit = F.bid; unit < HB * 4 * 32; unit += F.G) {
        const int bl = unit >> 7, head = (unit >> 5) & 3, qt = unit & 31, b = half * HB + bl;
        const int r = bl * SEQ + qt * 256 + wave * 32 + ql;
        __syncthreads();
        for (int c = tid; c < 256 * 24; c += NTHR) { const int row = c / 24, ch = c % 24;
            *(LAS u32x4*)(sm + row * KST + ch * 16) = *(const u32x4*)(MKV + (size_t)(b * NMEM + row) * 1536 + head * 192 + ch * 8); }
        bf16x8 qf[12];
        { const bf16* qp = P + (size_t)r * NPROJ + PC_MQ + head * 192 + 8 * h;
#pragma unroll
          for (int ks = 0; ks < 12; ++ks) qf[ks] = *(const bf16x8*)(qp + 16 * ks); }
        __syncthreads();
        f32x16 sacc[8];
#pragma unroll
        for (int mt = 0; mt < 8; ++mt) {
#pragma unroll
            for (int i = 0; i < 16; ++i) sacc[mt][i] = 0.f;
#pragma unroll
            for (int ks = 0; ks < 12; ++ks) { const bf16x8 kf = *(const LAS bf16x8*)(sm + (32 * mt + ql) * KST + 32 * ks + 16 * h); sacc[mt] = MFMA32(kf, qf[ks], sacc[mt]); }
        }
        float mx = -3.0e38f;
#pragma unroll
        for (int mt = 0; mt < 8; ++mt)
#pragma unroll
            for (int i = 0; i < 16; ++i) mx = fmaxf(mx, sacc[mt][i]);
        mx = fmaxf(mx, __shfl_xor(mx, 32));
        const float sc = 0.07216878364870323f * 1.4426950408889634f;
        float l = 0.f;
        bf16x8 pf[8][2];
#pragma unroll
        for (int mt = 0; mt < 8; ++mt) {
            float p[16];
#pragma unroll
            for (int i = 0; i < 16; ++i) { p[i] = __builtin_amdgcn_exp2f((sacc[mt][i] - mx) * sc); l += p[i]; }
#pragma unroll
            for (int s2 = 0; s2 < 2; ++s2) { const u32x4 w = {pkbf(p[8 * s2 + 0], p[8 * s2 + 1]), pkbf(p[8 * s2 + 2], p[8 * s2 + 3]), pkbf(p[8 * s2 + 4], p[8 * s2 + 5]), pkbf(p[8 * s2 + 6], p[8 * s2 + 7])};
                pf[mt][s2] = __builtin_bit_cast(bf16x8, w); }
        }
        l += __shfl_xor(l, 32);
        __syncthreads();
        for (int c = tid; c < 192 * 32; c += NTHR) { const int row = c >> 5, ch = c & 31;
            *(LAS u32x4*)(sm + row * VST + ch * 16) = *(const u32x4*)(MVT + (size_t)(head * 192 + row) * 2048 + b * NMEM + ch * 8); }
        __syncthreads();
        const float il = 1.0f / l;
        bf16* yp = Y + ((size_t)half * HT + r) * YC + 1280 + head * 192 + 4 * h;
#pragma unroll
        for (int dt = 0; dt < 6; ++dt) {
            f32x16 o;
#pragma unroll
            for (int i = 0; i < 16; ++i) o[i] = 0.f;
#pragma unroll
            for (int mt = 0; mt < 8; ++mt)
#pragma unroll
                for (int s2 = 0; s2 < 2; ++s2) { const LAS unsigned char* vp = sm + (32 * dt + ql) * VST + (32 * mt + 16 * s2 + 4 * h) * 2;
                    const bf16x8 vf = mk_bf16x8(*(const LAS u32x2*)vp, *(const LAS u32x2*)(vp + 16)); o = MFMA32(vf, pf[mt][s2], o); }
#pragma unroll
            for (int g = 0; g < 4; ++g) { const u32x2 w = {pkbf(o[4 * g] * il, o[4 * g + 1] * il), pkbf(o[4 * g + 2] * il, o[4 * g + 3] * il)}; *(u32x2*)(yp + 32 * dt + 8 * g) = w; }
        }
    }
}

__device__ __forceinline__ void dilattn_mfma_phase(Frame& F, int half) {
    bf16* P = (bf16*)(F.ws + WS_BIG);
    float* LSE = (float*)(F.ws + WS_LSE);
    LAS unsigned char* sK = F.lds; LAS unsigned char* sV = F.lds + 384 * 144;
    const int tid = F.tid, lane = F.lane, wave = F.wave, ql = lane & 31, h = lane >> 5;
    constexpr int RST = 144;
    for (int unit = F.bid; unit < HB * 12 * 32; unit += F.G) {
        const int bl = unit / 384, rem = unit % 384, head = rem >> 5, blk = rem & 31;
        const int g = head >> 2, dil = (g == 0) ? 1 : (g == 1 ? 4 : 16), bpr = 32 / dil;
        const int res = blk / bpr, q0 = (blk % bpr) * 256;
        const size_t rowb = (size_t)bl * SEQ;
        __syncthreads();
        for (int c = tid; c < 384 * 8; c += NTHR) { const int row = c >> 3, ch = c & 7; const int ks = q0 - 128 + row;
            u32x4 kv = {0u, 0u, 0u, 0u}, vv = {0u, 0u, 0u, 0u};
            if (ks >= 0) { const bf16* src = P + (rowb + (size_t)ks * dil + res) * NPROJ + head * 64 + ch * 8; kv = *(const u32x4*)(src + PC_DK); vv = *(const u32x4*)(src + PC_DV); }
            *(LAS u32x4*)(sK + row * RST + ch * 16) = kv; *(LAS u32x4*)(sV + row * RST + ch * 16) = vv; }
        const int qs = q0 + wave * 32 + ql;
        const size_t rq = rowb + (size_t)qs * dil + res;
        bf16* qp = P + rq * NPROJ + PC_DQ + head * 64;
        bf16x8 qf[4];
#pragma unroll
        for (int ks = 0; ks < 4; ++ks) qf[ks] = *(const bf16x8*)(qp + 16 * ks + 8 * h);
        __syncthreads();
        f32x16 sacc[5];
        const int kfirst = q0 + wave * 32 - 128;
#pragma unroll
        for (int i = 0; i < 5; ++i) {
#pragma unroll
            for (int e = 0; e < 16; ++e) sacc[i][e] = 0.f;
#pragma unroll
            for (int ks = 0; ks < 4; ++ks) { const bf16x8 kf = *(const LAS bf16x8*)(sK + (32 * wave + 32 * i + ql) * RST + 32 * ks + 16 * h); sacc[i] = MFMA32(kf, qf[ks], sacc[i]); }
        }
        float mx = -3.0e38f;
#pragma unroll
        for (int i = 0; i < 5; ++i)
#pragma unroll
            for (int e = 0; e < 16; ++e) { const int kj = 32 * i + (e & 3) + 8 * (e >> 2) + 4 * h; const bool ok = (kj >= ql) && (kj <= ql + 128) && (kfirst + kj >= 0);
                sacc[i][e] = ok ? sacc[i][e] : -3.0e38f; mx = fmaxf(mx, sacc[i][e]); }
        mx = fmaxf(mx, __shfl_xor(mx, 32));
        const float sc = 0.125f * 1.4426950408889634f;
        float l = 0.f;
        bf16x8 pf[5][2];
#pragma unroll
        for (int i = 0; i < 5; ++i) {
            float p[16];
#pragma unroll
            for (int e = 0; e < 16; ++e) { p[e] = (sacc[i][e] > -1.0e38f) ? __builtin_amdgcn_exp2f((sacc[i][e] - mx) * sc) : 0.f; l += p[e]; }
#pragma unroll
            for (int s2 = 0; s2 < 2; ++s2) { const u32x4 w = {pkbf(p[8 * s2 + 0], p[8 * s2 + 1]), pkbf(p[8 * s2 + 2], p[8 * s2 + 3]), pkbf(p[8 * s2 + 4], p[8 * s2 + 5]), pkbf(p[8 * s2 + 6], p[8 * s2 + 7])};
                pf[i][s2] = __builtin_bit_cast(bf16x8, w); }
        }
        l += __shfl_xor(l, 32);
        const float il = 1.0f / l;
        const int tq = (lane & 15) >> 2, tp = lane & 3, tblk = (lane >> 4) & 1;
        const unsigned vbase = (unsigned)(size_t)(sV) + (unsigned)((32 * wave + 4 * h + tq) * RST + (16 * tblk + 4 * tp) * 2);
#pragma unroll
        for (int dt = 0; dt < 2; ++dt) {
            f32x16 o;
#pragma unroll
            for (int e = 0; e < 16; ++e) o[e] = 0.f;
#pragma unroll
            for (int i = 0; i < 5; ++i) {
                s16x4 lo[2], hi[2];
#pragma unroll
                for (int s2 = 0; s2 < 2; ++s2) { const unsigned a = vbase + (unsigned)((32 * i + 16 * s2) * RST + 64 * dt);
                    asm volatile("ds_read_b64_tr_b16 %0, %1" : "=&v"(lo[s2]) : "v"(a) : "memory");
                    asm volatile("ds_read_b64_tr_b16 %0, %1 offset:1152" : "=&v"(hi[s2]) : "v"(a) : "memory"); }
                asm volatile("s_waitcnt lgkmcnt(0)" ::: "memory"); __builtin_amdgcn_sched_barrier(0);
#pragma unroll
                for (int s2 = 0; s2 < 2; ++s2) { const bf16x8 vf = {lo[s2][0], lo[s2][1], lo[s2][2], lo[s2][3], hi[s2][0], hi[s2][1], hi[s2][2], hi[s2][3]}; o = MFMA32(vf, pf[i][s2], o); }
            }
#pragma unroll
            for (int gq = 0; gq < 4; ++gq) { const u32x2 w = {pkbf(o[4 * gq] * il, o[4 * gq + 1] * il), pkbf(o[4 * gq + 2] * il, o[4 * gq + 3] * il)}; *(u32x2*)(qp + 32 * dt + 8 * gq + 4 * h) = w; }
        }
        if (h == 0) LSE[((size_t)half * HT + rq) * 12 + head] = mx * 0.125f + __logf(l);
    }
}

__device__ __forceinline__ void dilmerge_phase(Frame& F, int half) {
    const bf16* P = (const bf16*)(F.ws + WS_BIG);
    const float* LSE = (const float*)(F.ws + WS_LSE);
    bf16* Y = (bf16*)F.out;
    const size_t gtid = (size_t)F.bid * NTHR + F.tid, gth = (size_t)F.G * NTHR;
    for (size_t it = gtid; it < (size_t)HT * 32; it += gth) {
        const size_t r = it >> 5; const int hh = (int)(it >> 3) & 3, d0 = (int)(it & 7) * 8;
        const size_t tok = (size_t)half * HT + r;
        const float l0 = LSE[tok * 12 + hh], l1 = LSE[tok * 12 + 4 + hh], l2 = LSE[tok * 12 + 8 + hh];
        const float m = fmaxf(l0, fmaxf(l1, l2));
        float w0 = __expf(l0 - m), w1 = __expf(l1 - m), w2 = __expf(l2 - m); const float iw = 1.0f / (w0 + w1 + w2); w0 *= iw; w1 *= iw; w2 *= iw;
        const bf16* op = P + r * NPROJ + PC_DQ + hh * 64 + d0;
        const u32x4 a = *(const u32x4*)op, b = *(const u32x4*)(op + 256), c = *(const u32x4*)(op + 512);
        u32x4 o;
        o.x = pkbf(w0 * bflo(a.x) + w1 * bflo(b.x) + w2 * bflo(c.x), w0 * bfhi(a.x) + w1 * bfhi(b.x) + w2 * bfhi(c.x));
        o.y = pkbf(w0 * bflo(a.y) + w1 * bflo(b.y) + w2 * bflo(c.y), w0 * bfhi(a.y) + w1 * bfhi(b.y) + w2 * bfhi(c.y));
        o.z = pkbf(w0 * bflo(a.z) + w1 * bflo(b.z) + w2 * bflo(c.z), w0 * bfhi(a.z) + w1 * bfhi(b.z) + w2 * bfhi(c.z));
        o.w = pkbf(w0 * bflo(a.w) + w1 * bflo(b.w) + w2 * bflo(c.w), w0 * bfhi(a.w) + w1 * bfhi(b.w) + w2 * bfhi(c.w));
        *(u32x4*)(Y + tok * YC + 1024 + hh * 64 + d0) = o;
    }
}

__device__ __forceinline__ void hn_phase(Frame& F) {
    const int gw = F.bid * NWAVES + F.wave, NGW = F.G * NWAVES;
    for (int m = gw; m < T; m += NGW) { f32x4 v[4]; rms_row_to_bf16(F.out + (size_t)m * DM, F.in[I_NFFNW], (bf16*)(F.ws + WS_ACT1) + (size_t)m * DM, F.lane, v); }
}


__device__ __forceinline__ float gelu_erf(float x) { return 0.5f * x * (1.0f + erff(x * 0.70710678118654752f)); }
__device__ __forceinline__ unsigned f2ord(float f) { const unsigned u = __builtin_bit_cast(unsigned, f); return u ^ ((unsigned)((int)u >> 31) | 0x80000000u); }
__device__ __forceinline__ float ord2f(unsigned k) { const unsigned m = (unsigned)((int)k >> 31); return __builtin_bit_cast(float, k ^ (0x80000000u | ~m)); }
#define CMPX(a, b) do { const unsigned _mx = max((a), (b)), _mn = min((a), (b)); (a) = _mx; (b) = _mn; } while (0)
__device__ __forceinline__ void bitonic_sort16_desc(unsigned (&v)[16]) {
#pragma unroll
    for (int k = 2; k <= 16; k <<= 1)
#pragma unroll
        for (int j = k >> 1; j > 0; j >>= 1)
#pragma unroll
            for (int i = 0; i < 16; ++i) { const int l = i ^ j; if (l > i) { if ((i & k) == 0) CMPX(v[i], v[l]); else CMPX(v[l], v[i]); } }
}
__device__ __forceinline__ void bitonic_merge16_desc(unsigned (&v)[16]) {
#pragma unroll
    for (int j = 8; j > 0; j >>= 1)
#pragma unroll
        for (int i = 0; i < 16; ++i) { const int l = i ^ j; if (l > i) CMPX(v[i], v[l]); }
}
__device__ __forceinline__ void top16_merge(unsigned (&a)[16], const unsigned (&b)[16]) {
#pragma unroll
    for (int i = 0; i < 16; ++i) a[i] = max(a[i], b[15 - i]);
    bitonic_merge16_desc(a);
}
constexpr int PK_ST = 272;
__device__ __forceinline__ void peer_topk_tile(Frame& F, size_t tok0, int* IDX, float* GATE) {
    const bf16* Q = (const bf16*)(F.ws + WS_BIG);
    const bf16* SK = (const bf16*)(F.ws + WS_SUBK);
    LAS unsigned char* sK = F.lds;
    int tid = F.tid; asm volatile("" : "+v"(tid));
    const int lane = tid & 63, wave = F.wave, ql = lane & 31, hh = lane >> 5;
    const size_t tok = tok0 + wave * 32 + ql;
    const bf16* qrow = Q + tok * PEER_Q + 8 * hh;
    __syncthreads();
#pragma unroll
    for (int j = 0; j < 4; ++j) { const int cidx = tid + 512 * j, row = cidx >> 4, ch = cidx & 15; *(LAS u32x4*)(sK + row * PK_ST + ch * 16) = *(const u32x4*)(SK + (size_t)row * 128 + ch * 8); }
    __syncthreads();
    unsigned k1[16];
#pragma unroll 1
    for (int hc = 0; hc < 16; ++hc) {
        LAS unsigned char* cur = sK + (hc & 1) * (128 * PK_ST); LAS unsigned char* nxt = sK + ((hc + 1) & 1) * (128 * PK_ST);
        u32x4 stg[4];
        const int hcn = (hc + 1) & 15;
#pragma unroll
        for (int j = 0; j < 4; ++j) { const int cidx = tid + 512 * j, row = cidx >> 4, ch = cidx & 15; stg[j] = *(const u32x4*)(SK + ((size_t)hcn * 128 + row) * 128 + ch * 8); }
        bf16x8 qf[8];
#pragma unroll
        for (int ks = 0; ks < 8; ++ks) qf[ks] = *(const bf16x8*)(qrow + hc * 128 + 16 * ks);
        unsigned pk[4][16];
#pragma unroll
        for (int mt = 0; mt < 4; ++mt) {
            f32x16 acc;
#pragma unroll
            for (int e = 0; e < 16; ++e) acc[e] = 0.f;
#pragma unroll
            for (int ks = 0; ks < 8; ++ks) { const bf16x8 kf = *(const LAS bf16x8*)(cur + (32 * mt + ql) * PK_ST + 32 * ks + 16 * hh); acc = MFMA32(kf, qf[ks], acc); }
#pragma unroll
            for (int e = 0; e < 16; ++e) pk[mt][e] = (f2ord(acc[e]) & 0xFFFFFF80u) | (unsigned)(32 * mt + (e & 3) + 8 * (e >> 2) + 4 * hh);
        }
#pragma unroll
        for (int j = 0; j < 4; ++j) { const int cidx = tid + 512 * j, row = cidx >> 4, ch = cidx & 15; *(LAS u32x4*)(nxt + row * PK_ST + ch * 16) = stg[j]; }
        __syncthreads();
#pragma unroll
        for (int mt = 0; mt < 4; ++mt) bitonic_sort16_desc(pk[mt]);
        top16_merge(pk[0], pk[1]); top16_merge(pk[2], pk[3]); top16_merge(pk[0], pk[2]);
        unsigned other[16];
#pragma unroll
        for (int i = 0; i < 16; ++i) other[i] = (unsigned)__shfl_xor((int)pk[0][i], 32);
        top16_merge(pk[0], other);
        if ((hc & 1) == 0) {
#pragma unroll
            for (int i = 0; i < 16; ++i) k1[i] = pk[0][i];
        } else {
            float f1[16], f2[16];
#pragma unroll
            for (int i = 0; i < 16; ++i) { f1[i] = ord2f(k1[i] & 0xFFFFFF80u); f2[i] = ord2f(pk[0][i] & 0xFFFFFF80u); }
            unsigned cd[4][16];
#pragma unroll
            for (int i = 0; i < 64; ++i) cd[i >> 4][i & 15] = 0u;
            int n = 0;
#pragma unroll
            for (int a = 0; a < 16; ++a)
#pragma unroll
                for (int b = 0; b < 16; ++b)
                    if ((a + 1) * (b + 1) <= 16) { cd[n >> 4][n & 15] = (f2ord(f1[a] + f2[b]) & 0xFFFFC000u) | ((k1[a] & 127u) << 7) | (pk[0][b] & 127u); ++n; }
#pragma unroll
            for (int g4 = 0; g4 < 4; ++g4) bitonic_sort16_desc(cd[g4]);
            top16_merge(cd[0], cd[1]); top16_merge(cd[2], cd[3]); top16_merge(cd[0], cd[2]);
            const float vmax = ord2f(cd[0][0] & 0xFFFFC000u);
            float ex[16], den = 0.f;
#pragma unroll
            for (int i = 0; i < 16; ++i) { ex[i] = __expf(ord2f(cd[0][i] & 0xFFFFC000u) - vmax); den += ex[i]; }
            const float iden = 1.0f / den;
            const int h = hc >> 1;
            if (hh == 0) { int* ip = IDX + tok * 128 + h * 16;
#pragma unroll
                for (int i = 0; i < 4; ++i) { const u32x4 w = {cd[0][4 * i] & 0x3FFFu, cd[0][4 * i + 1] & 0x3FFFu, cd[0][4 * i + 2] & 0x3FFFu, cd[0][4 * i + 3] & 0x3FFFu}; *(u32x4*)(ip + 4 * i) = w; } }
            else { float* gp = GATE + tok * 128 + h * 16;
#pragma unroll
                for (int i = 0; i < 4; ++i) { const f32x4 w = {ex[4 * i] * iden, ex[4 * i + 1] * iden, ex[4 * i + 2] * iden, ex[4 * i + 3] * iden}; *(f32x4*)(gp + 4 * i) = w; } }
        }
    }
}

constexpr size_t PEER_OFF_IDX = 256 * MiB, PEER_OFF_GATE = 288 * MiB, PEER_OFF_COEF = 320 * MiB;
struct PeerDeal { size_t tokw; int ntok; };
__device__ __forceinline__ void peer_item(int n, const PeerDeal& D, int wave, int& slice, size_t& tok) { slice = n >> 5; tok = D.tokw + (n & 31); }
__device__ __forceinline__ void peer_down_rows(u32x4 (&R)[16], const unsigned char* PD, int slice, int id0, int id1, int lane) {
    const unsigned char* base = PD + ((size_t)slice * 16384 << 7) + 16 * (lane & 7);
#pragma unroll
    for (int k = 0; k < 16; ++k) { const int id = __shfl(k < 8 ? id0 : id1, (8 * k + (lane >> 3)) & 63); R[k] = *(const u32x4*)(base + ((size_t)id << 7)); }
}
__device__ __forceinline__ void peer_down_park(const u32x4 (&R)[16], LAS unsigned char* sw, int lane) {
    const int e8 = lane >> 3, p = lane & 7;
#pragma unroll
    for (int k = 0; k < 16; ++k) { const int sl_ = 8 * k + e8; *(LAS u32x4*)(sw + sl_ * 128 + 16 * (p ^ ((sl_ >> 1) & 7))) = R[k]; }
}
__device__ __forceinline__ void peer_down_hn(u32x4 (&H)[4], const bf16* HN, int slice, size_t tok, int g) {
    const bf16* hp = HN + tok * DM + slice * 128 + 16 * g;
    H[0] = *(const u32x4*)hp; H[1] = *(const u32x4*)(hp + 8); H[2] = *(const u32x4*)(hp + 64); H[3] = *(const u32x4*)(hp + 72);
}
__device__ __forceinline__ void peer_down_compute(const LAS unsigned char* sw, const u32x4 (&H)[4], __amdgpu_buffer_rsrc_t prsrc, int slice, size_t tok, int lane) {
    const int g = lane >> 4, r = lane & 15;
    long bq[4];
#pragma unroll
    for (int h2 = 0; h2 < 2; ++h2) { const u32x4 x0 = H[2 * h2], x1 = H[2 * h2 + 1];
        unsigned p0 = __builtin_amdgcn_cvt_pk_fp8_f32(bflo(x0.x), bfhi(x0.x), 0, false); p0 = __builtin_amdgcn_cvt_pk_fp8_f32(bflo(x0.y), bfhi(x0.y), p0, true);
        unsigned p1 = __builtin_amdgcn_cvt_pk_fp8_f32(bflo(x0.z), bfhi(x0.z), 0, false); p1 = __builtin_amdgcn_cvt_pk_fp8_f32(bflo(x0.w), bfhi(x0.w), p1, true);
        unsigned p2 = __builtin_amdgcn_cvt_pk_fp8_f32(bflo(x1.x), bfhi(x1.x), 0, false); p2 = __builtin_amdgcn_cvt_pk_fp8_f32(bflo(x1.y), bfhi(x1.y), p2, true);
        unsigned p3 = __builtin_amdgcn_cvt_pk_fp8_f32(bflo(x1.z), bfhi(x1.z), 0, false); p3 = __builtin_amdgcn_cvt_pk_fp8_f32(bflo(x1.w), bfhi(x1.w), p3, true);
        bq[2 * h2] = (long)(((unsigned long long)p1 << 32) | p0); bq[2 * h2 + 1] = (long)(((unsigned long long)p3 << 32) | p2); }
    const unsigned off = ((lane & 15) == 0) ? (unsigned)((((size_t)slice * T + tok) * 128 + 4 * g) * 4) : 0xFFFFFF00u;
#pragma unroll
    for (int t8 = 0; t8 < 8; ++t8) { f32x4 acc = {0.f, 0.f, 0.f, 0.f}; const int sl_ = 16 * t8 + r; const LAS unsigned char* rp = sw + sl_ * 128; const int sx = (sl_ >> 1) & 7;
#pragma unroll
        for (int h2 = 0; h2 < 2; ++h2) { const u32x4 v = *(const LAS u32x4*)(rp + 16 * ((4 * h2 + g) ^ sx));
            acc = __builtin_amdgcn_mfma_f32_16x16x32_fp8_fp8((long)(((unsigned long long)v.y << 32) | v.x), bq[2 * h2], acc, 0, 0, 0);
            acc = __builtin_amdgcn_mfma_f32_16x16x32_fp8_fp8((long)(((unsigned long long)v.w << 32) | v.z), bq[2 * h2 + 1], acc, 0, 0, 0); }
        __builtin_amdgcn_raw_buffer_store_b128(__builtin_bit_cast(u32x4, acc), prsrc, off, 64 * t8, 0); }
}
__device__ __forceinline__ void peer_down_phase(Frame& F, const PeerDeal& D) {
    const unsigned char* PD = F.ws + WS_PD; const bf16* HN = (const bf16*)(F.ws + WS_ACT1);
    const int* IDX = (const int*)(F.ws + WS_BIG + PEER_OFF_IDX);
    const __amdgpu_buffer_rsrc_t prsrc = __builtin_amdgcn_make_buffer_rsrc((void*)(F.ws + WS_BIG), 0, 8 * T * 128 * 4, 0x00020000);
    int lane = F.lane; asm volatile("" : "+v"(lane));
    const int g = lane >> 4, wave = F.wave;
    LAS unsigned char* sw = F.lds + wave * 16384;
    const int ntok = D.ntok;
    int sl; size_t tk;
    u32x4 R[16], H0[4], H1[4]; int id0, id1;
    { int s1_; size_t t1_; peer_item(0, D, wave, sl, tk); peer_item(1, D, wave, s1_, t1_);
      const int a0 = IDX[tk * 128 + lane], a1 = IDX[tk * 128 + 64 + lane]; id0 = IDX[t1_ * 128 + lane]; id1 = IDX[t1_ * 128 + 64 + lane];
      __builtin_amdgcn_sched_barrier(0);
      peer_down_rows(R, PD, sl, a0, a1, lane); peer_down_hn(H0, HN, sl, tk, g);
      __builtin_amdgcn_sched_barrier(0); }
#pragma unroll 1
    for (int n = 0; n < ntok; n += 2) {
        int s0, s1, s2, s3; size_t t0, t1, t2, t3;
        peer_item(n, D, wave, s0, t0); peer_item(n + 1, D, wave, s1, t1); peer_item(n + 2 < ntok ? n + 2 : n, D, wave, s2, t2); peer_item(n + 3 < ntok ? n + 3 : n + 1, D, wave, s3, t3);
        peer_down_park(R, sw, lane);
        __builtin_amdgcn_sched_barrier(0);
        { const int j0 = IDX[t2 * 128 + lane], j1 = IDX[t2 * 128 + 64 + lane];
          peer_down_rows(R, PD, s1, id0, id1, lane); peer_down_hn(H1, HN, s1, t1, g); id0 = j0; id1 = j1; }
        __builtin_amdgcn_sched_barrier(0);
        peer_down_compute(sw, H0, prsrc, s0, t0, lane);
        __builtin_amdgcn_sched_barrier(0);
        peer_down_park(R, sw, lane);
        __builtin_amdgcn_sched_barrier(0);
        { const int j0 = IDX[t3 * 128 + lane], j1 = IDX[t3 * 128 + 64 + lane];
          peer_down_rows(R, PD, s2, id0, id1, lane); peer_down_hn(H0, HN, s2, t2, g); id0 = j0; id1 = j1; }
        __builtin_amdgcn_sched_barrier(0);
        peer_down_compute(sw, H1, prsrc, s1, t1, lane);
        __builtin_amdgcn_sched_barrier(0);
    }
}
__device__ __forceinline__ void peer_coef_wave(Frame& F, const PeerDeal& D) {
    const float* PART = (const float*)(F.ws + WS_BIG); const float* GATE = (const float*)(F.ws + WS_BIG + PEER_OFF_GATE); float* COEF = (float*)(F.ws + WS_BIG + PEER_OFF_COEF);
    for (int k = F.lane; k < 32 * 32; k += 64) {
        const size_t i = D.tokw * 128 + 4 * k;
        f32x4 sm = *(const f32x4*)(PART + i);
#pragma unroll
        for (int x = 1; x < 8; ++x) sm += *(const f32x4*)(PART + (size_t)x * T * 128 + i);
        const f32x4 gt = *(const f32x4*)(GATE + i);
        const f32x4 o = {gt.x * gelu_erf(sm.x * (1.0f / PD_SCALE)) * (1.0f / PU_SCALE), gt.y * gelu_erf(sm.y * (1.0f / PD_SCALE)) * (1.0f / PU_SCALE),
                         gt.z * gelu_erf(sm.z * (1.0f / PD_SCALE)) * (1.0f / PU_SCALE), gt.w * gelu_erf(sm.w * (1.0f / PD_SCALE)) * (1.0f / PU_SCALE)};
        *(f32x4*)(COEF + i) = o;
    }
}
__device__ __forceinline__ void peer_up_rows(u32x4 (&R)[16], const unsigned char* PU, int slice, int id0, int id1, int lane) {
    const unsigned char* base = PU + ((size_t)slice * 16384 << 7) + 16 * (lane & 3);
#pragma unroll
    for (int s8 = 0; s8 < 8; ++s8) { const int id = __shfl(s8 < 4 ? id0 : id1, (16 * s8 + (lane >> 2)) & 63); const unsigned char* rp = base + ((size_t)id << 7); R[2 * s8] = *(const u32x4*)rp; R[2 * s8 + 1] = *(const u32x4*)(rp + 64); }
}
__device__ __forceinline__ void peer_up_compute(const u32x4 (&R)[16], float c0, float c1, f32x2 h, float* out, int slice, size_t tok, int lane) {
    f32x2 acc[16];
#pragma unroll
    for (int k = 0; k < 16; ++k) acc[k] = (f32x2){0.f, 0.f};
#pragma unroll
    for (int s8 = 0; s8 < 8; ++s8) { const float c = __shfl(s8 < 4 ? c0 : c1, (16 * s8 + (lane >> 2)) & 63); f32x2 c2 = {c, c}; asm volatile("" : "+v"(c2));
#pragma unroll
        for (int hf = 0; hf < 2; ++hf) { const u32x4 r = R[2 * s8 + hf];
            acc[8 * hf + 0] = c2 * __builtin_amdgcn_cvt_pk_f32_fp8(r.x, false) + acc[8 * hf + 0]; acc[8 * hf + 1] = c2 * __builtin_amdgcn_cvt_pk_f32_fp8(r.x, true) + acc[8 * hf + 1];
            acc[8 * hf + 2] = c2 * __builtin_amdgcn_cvt_pk_f32_fp8(r.y, false) + acc[8 * hf + 2]; acc[8 * hf + 3] = c2 * __builtin_amdgcn_cvt_pk_f32_fp8(r.y, true) + acc[8 * hf + 3];
            acc[8 * hf + 4] = c2 * __builtin_amdgcn_cvt_pk_f32_fp8(r.z, false) + acc[8 * hf + 4]; acc[8 * hf + 5] = c2 * __builtin_amdgcn_cvt_pk_f32_fp8(r.z, true) + acc[8 * hf + 5];
            acc[8 * hf + 6] = c2 * __builtin_amdgcn_cvt_pk_f32_fp8(r.w, false) + acc[8 * hf + 6]; acc[8 * hf + 7] = c2 * __builtin_amdgcn_cvt_pk_f32_fp8(r.w, true) + acc[8 * hf + 7]; } }
    f32x2 r8[8], r4[4], r2[2], r1;
    { const bool up = (lane & 32) != 0;
#pragma unroll
      for (int k = 0; k < 8; ++k) { const f32x2 keep = up ? acc[k + 8] : acc[k], send = up ? acc[k] : acc[k + 8]; r8[k] = keep + (f32x2){__shfl_xor(send.x, 32), __shfl_xor(send.y, 32)}; } }
    { const bool up = (lane & 16) != 0;
#pragma unroll
      for (int k = 0; k < 4; ++k) { const f32x2 keep = up ? r8[k + 4] : r8[k], send = up ? r8[k] : r8[k + 4]; r4[k] = keep + (f32x2){__shfl_xor(send.x, 16), __shfl_xor(send.y, 16)}; } }
    { const bool up = (lane & 8) != 0;
#pragma unroll
      for (int k = 0; k < 2; ++k) { const f32x2 keep = up ? r4[k + 2] : r4[k], send = up ? r4[k] : r4[k + 2]; r2[k] = keep + (f32x2){__shfl_xor(send.x, 8), __shfl_xor(send.y, 8)}; } }
    { const bool up = (lane & 4) != 0; const f32x2 keep = up ? r2[1] : r2[0], send = up ? r2[0] : r2[1]; r1 = keep + (f32x2){__shfl_xor(send.x, 4), __shfl_xor(send.y, 4)}; }
    const int p = ((lane >> 5) & 1) * 8 + ((lane >> 4) & 1) * 4 + ((lane >> 3) & 1) * 2 + ((lane >> 2) & 1);
    *(f32x2*)(out + tok * DM + slice * 128 + 16 * (lane & 3) + 2 * (p & 7) + 64 * (p >> 3)) = h + r1;
}
__device__ __forceinline__ void peer_up_phase(Frame& F, const PeerDeal& D, float* outp) {
    const unsigned char* PU = F.ws + WS_PU;
    const int* IDX = (const int*)(F.ws + WS_BIG + PEER_OFF_IDX); const float* COEF = (const float*)(F.ws + WS_BIG + PEER_OFF_COEF);
    int lane = F.lane; asm volatile("" : "+v"(lane));
    const int wave = F.wave;
    const int ntok = D.ntok;
    const int p = ((lane >> 5) & 1) * 8 + ((lane >> 4) & 1) * 4 + ((lane >> 3) & 1) * 2 + ((lane >> 2) & 1);
    const int hoff = 16 * (lane & 3) + 2 * (p & 7) + 64 * (p >> 3);
    int sl; size_t tk;
    u32x4 R0[16], R1[16];
    float ca0, ca1, cb0, cb1; f32x2 ha, hb;
    int id0, id1, jd0, jd1;
    { int s1_; size_t t1_; peer_item(0, D, wave, sl, tk); peer_item(1, D, wave, s1_, t1_);
      jd0 = IDX[tk * 128 + lane]; jd1 = IDX[tk * 128 + 64 + lane]; id0 = IDX[t1_ * 128 + lane]; id1 = IDX[t1_ * 128 + 64 + lane];
      __builtin_amdgcn_sched_barrier(0);
      peer_up_rows(R0, PU, sl, jd0, jd1, lane);
      ca0 = COEF[tk * 128 + lane]; ca1 = COEF[tk * 128 + 64 + lane]; ha = *(const f32x2*)(F.out + tk * DM + sl * 128 + hoff);
      __builtin_amdgcn_sched_barrier(0); }
#pragma unroll 1
    for (int n = 0; n < ntok; n += 2) {
        int s0, s1, s2, s3; size_t t0, t1, t2, t3;
        peer_item(n, D, wave, s0, t0); peer_item(n + 1, D, wave, s1, t1);
        peer_item(n + 2 < ntok ? n + 2 : n, D, wave, s2, t2); peer_item(n + 3 < ntok ? n + 3 : n + 1, D, wave, s3, t3);
        jd0 = IDX[t2 * 128 + lane]; jd1 = IDX[t2 * 128 + 64 + lane];
        peer_up_rows(R1, PU, s1, id0, id1, lane);
        cb0 = COEF[t1 * 128 + lane]; cb1 = COEF[t1 * 128 + 64 + lane]; hb = *(const f32x2*)(F.out + t1 * DM + s1 * 128 + hoff);
        __builtin_amdgcn_sched_barrier(0);
        peer_up_compute(R0, ca0, ca1, ha, outp, s0, t0, lane);
        __builtin_amdgcn_sched_barrier(0);
        id0 = IDX[t3 * 128 + lane]; id1 = IDX[t3 * 128 + 64 + lane];
        peer_up_rows(R0, PU, s2, jd0, jd1, lane);
        ca0 = COEF[t2 * 128 + lane]; ca1 = COEF[t2 * 128 + 64 + lane]; ha = *(const f32x2*)(F.out + t2 * DM + s2 * 128 + hoff);
        __builtin_amdgcn_sched_barrier(0);
        peer_up_compute(R1, cb0, cb1, hb, outp, s1, t1, lane);
        __builtin_amdgcn_sched_barrier(0);
    }
}
__device__ __forceinline__ void peer_phase(Frame& F) {
    int* IDX = (int*)(F.ws + WS_BIG + PEER_OFF_IDX); float* GATE = (float*)(F.ws + WS_BIG + PEER_OFF_GATE);
    for (int tile = F.bid; tile < T / 256; tile += F.G) {
        peer_topk_tile(F, (size_t)tile * 256, IDX, GATE);
        VM_WAIT(); __syncthreads();
        PeerDeal D; D.tokw = (size_t)tile * 256 + F.wave * 32; D.ntok = 256;
        peer_down_phase(F, D);
        if (PROBE & 8) peer_down_phase(F, D);
        VM_WAIT(); __syncthreads();
        peer_coef_wave(F, D);
        VM_WAIT(); __syncthreads();
        if (PROBE & 16) peer_up_phase(F, D, (float*)(F.ws + WS_SST));
        peer_up_phase(F, D, F.out);
    }
}

constexpr int N_PHASES = 15;
__global__ void __launch_bounds__(NTHR, 2) mega_fwd(Args args) {
    extern __shared__ __attribute__((aligned(16))) unsigned char lds_raw[];
    Frame F;
    F.lds = (LAS unsigned char*)lds_raw;
    F.tid = threadIdx.x; F.lane = F.tid & 63; F.wave = __builtin_amdgcn_readfirstlane(F.tid >> 6);
    F.G = gridDim.x; F.bid = blockIdx.x;
    F.in = args.in;
    F.positions = args.positions; F.out = args.out; F.ws = args.ws;
    unsigned char* ws = args.ws;
    volatile LAS unsigned* ctlw = (volatile LAS unsigned*)(F.lds + LDSCTL_OFF);
    if (F.tid < 64) ctlw[F.tid] = 0u;
    __syncthreads();
    const int lo = args.ph_lo, hi = args.ph_hi;
    XcdBarrier bar; bar.bar = (unsigned*)(ws + WS_CTL); bar.x = 0; bar.st = nullptr; bar.wave = F.wave;
    if (hi - lo > 1) bar = xcd_barrier_post((unsigned*)(ws + WS_CTL), ctlw + 8, F.wave);
#define IN(k) (lo <= (k) && (k) < hi)
#define SEAM(k) do { if (IN(k) && IN((k) + 1)) xcd_barrier(bar); } while (0)
    bf16* ACT1 = (bf16*)(ws + WS_ACT1); bf16* BIG = (bf16*)(ws + WS_BIG); bf16* WallT = (bf16*)(ws + WS_WALLT);

    if (IN(0)) { frame_refresh(F); p0_prologue(F); __syncthreads(); if (PROBE & 1) { p0_prologue(F); __syncthreads(); } }
    SEAM(0);
    if (IN(1)) { frame_refresh(F); { {
        { pg8::Gemm g{(const bf16*)(ws + WS_MEMN), (const bf16*)(ws + WS_WMKVT), NB * NMEM, 768, DM, DM, DM}; pg8::StaticOrder S; S.init(g.M, g.N, F.G, F.bid);
          pg8::EpiBf16<0> E{(bf16*)(ws + WS_MKV), 1536}; pg8::gemm_phase(F.lds, g, S, E, F.wave); }
        { pg8::Gemm g{(const bf16*)(ws + WS_WMKVT) + (size_t)768 * DM, (const bf16*)(ws + WS_MEMN), 768, NB * NMEM, DM, DM, DM}; pg8::StaticOrder S; S.init(g.M, g.N, F.G, F.G - 1 - F.bid);
          pg8::EpiBf16<0> E{(bf16*)(ws + WS_MVT), NB * NMEM}; pg8::gemm_phase(F.lds, g, S, E, F.wave); }
        { pg8::Gemm g{ACT1, WallT, HT, NPROJ, DM, DM, DM}; pg8::StaticOrder S; S.init(g.M, g.N, F.G, F.bid);
          pg8::EpiBf16<0> E{BIG, NPROJ}; pg8::gemm_phase(F.lds, g, S, E, F.wave); }
    } }
      if (PROBE & 2) { {
        { pg8::Gemm g{(const bf16*)(ws + WS_MEMN), (const bf16*)(ws + WS_WMKVT), NB * NMEM, 768, DM, DM, DM}; pg8::StaticOrder S; S.init(g.M, g.N, F.G, F.bid);
          pg8::EpiBf16<0> E{(bf16*)(ws + WS_MKV), 1536}; pg8::gemm_phase(F.lds, g, S, E, F.wave); }
        { pg8::Gemm g{(const bf16*)(ws + WS_WMKVT) + (size_t)768 * DM, (const bf16*)(ws + WS_MEMN), 768, NB * NMEM, DM, DM, DM}; pg8::StaticOrder S; S.init(g.M, g.N, F.G, F.G - 1 - F.bid);
          pg8::EpiBf16<0> E{(bf16*)(ws + WS_MVT), NB * NMEM}; pg8::gemm_phase(F.lds, g, S, E, F.wave); }
        { pg8::Gemm g{ACT1, WallT, HT, NPROJ, DM, DM, DM}; pg8::StaticOrder S; S.init(g.M, g.N, F.G, F.bid);
          pg8::EpiBf16<0> E{BIG, NPROJ}; pg8::gemm_phase(F.lds, g, S, E, F.wave); }
    } } }
    SEAM(1);
    if (IN(2)) { frame_refresh(F); qkprep_phase(F, 0); ssdC_phase(F, 0); if (PROBE & 4) ssdC_phase(F, 0); }
    SEAM(2);
    if (IN(3)) { frame_refresh(F); ssdD_phase(F); dilattn_mfma_phase(F, 0); memattn_mfma_phase(F, 0); if (PROBE & 64) { ssdD_phase(F); memattn_mfma_phase(F, 0); } }
    SEAM(3);
    if (IN(4)) { frame_refresh(F); ssdE_phase(F, 0); dilmerge_phase(F, 0); if (PROBE & 32) { ssdE_phase(F, 0); dilmerge_phase(F, 0); } }
    SEAM(4);
    if (IN(5)) { frame_refresh(F); { { pg8::Gemm g{ACT1 + (size_t)HT * DM, WallT, HT, NPROJ, DM, DM, DM}; pg8::StaticOrder S; S.init(g.M, g.N, F.G, F.bid);
        pg8::EpiBf16<0> E{BIG, NPROJ}; pg8::gemm_phase(F.lds, g, S, E, F.wave); } }
      if (PROBE & 2) { { pg8::Gemm g{ACT1 + (size_t)HT * DM, WallT, HT, NPROJ, DM, DM, DM}; pg8::StaticOrder S; S.init(g.M, g.N, F.G, F.bid);
        pg8::EpiBf16<0> E{BIG, NPROJ}; pg8::gemm_phase(F.lds, g, S, E, F.wave); } } }
    SEAM(5);
    if (IN(6)) { frame_refresh(F); qkprep_phase(F, 1); ssdC_phase(F, 1); if (PROBE & 4) ssdC_phase(F, 1); }
    SEAM(6);
    if (IN(7)) { frame_refresh(F); ssdD_phase(F); dilattn_mfma_phase(F, 1); memattn_mfma_phase(F, 1); if (PROBE & 64) { ssdD_phase(F); memattn_mfma_phase(F, 1); } }
    SEAM(7);
    if (IN(8)) { frame_refresh(F); ssdE_phase(F, 1); dilmerge_phase(F, 1); if (PROBE & 32) { ssdE_phase(F, 1); dilmerge_phase(F, 1); } }
    SEAM(8);
    if (IN(9)) { frame_refresh(F); { { pg8::Gemm g{ACT1, WallT + (size_t)NPROJ * DM, T, NGATE, DM, DM, DM}; pg8::StaticOrder S; S.init(g.M, g.N, F.G, F.bid);
        pg8::EpiBf16<1> E{BIG, NGATE}; pg8::gemm_phase(F.lds, g, S, E, F.wave); } }
      if (PROBE & 2) { { pg8::Gemm g{ACT1, WallT + (size_t)NPROJ * DM, T, NGATE, DM, DM, DM}; pg8::StaticOrder S; S.init(g.M, g.N, F.G, F.bid);
        pg8::EpiBf16<1> E{BIG, NGATE}; pg8::gemm_phase(F.lds, g, S, E, F.wave); } } }
    SEAM(9);
    if (IN(10)) { frame_refresh(F);
        pg8::Gemm g{(const bf16*)F.out, (const bf16*)(ws + WS_WCATT), T, DM, YC, YC, YC}; pg8::StaticOrder S; S.init(g.M, g.N, F.G, F.bid);
        pg8::EpiBranchFused E{ACT1, DM, __builtin_amdgcn_make_buffer_rsrc((void*)BIG, 0, T * NGATE * 2, 0x00020000), NGATE}; pg8::gemm_phase(F.lds, g, S, E, F.wave);
    }
    SEAM(10);
    if (IN(11)) { frame_refresh(F); { { pg8::Gemm g{ACT1, (const bf16*)(ws + WS_WOUTT), T, DM, DM, DM, DM}; pg8::StaticOrder S; S.init(g.M, g.N, F.G, F.bid);
        pg8::EpiResid E{F.out, DM, F.in[I_X]}; pg8::gemm_phase(F.lds, g, S, E, F.wave); } }
      if (PROBE & 2) { { pg8::Gemm g{ACT1, (const bf16*)(ws + WS_WOUTT), T, DM, DM, DM, DM}; pg8::StaticOrder S; S.init(g.M, g.N, F.G, F.bid);
        pg8::EpiResid E{F.out, DM, F.in[I_X]}; pg8::gemm_phase(F.lds, g, S, E, F.wave); } } }
    SEAM(11);
    if (IN(12)) { frame_refresh(F); { hn_phase(F); }
      if (PROBE & 2) { hn_phase(F); } }
    SEAM(12);
    if (IN(13)) { frame_refresh(F); { { pg8::Gemm g{ACT1, (const bf16*)(ws + WS_WQT), T, PEER_Q, DM, DM, DM}; pg8::StaticOrder S; S.init(g.M, g.N, F.G, F.bid);
        pg8::EpiBf16<0> E{BIG, PEER_Q}; pg8::gemm_phase(F.lds, g, S, E, F.wave); } }
      if (PROBE & 2) { { pg8::Gemm g{ACT1, (const bf16*)(ws + WS_WQT), T, PEER_Q, DM, DM, DM}; pg8::StaticOrder S; S.init(g.M, g.N, F.G, F.bid);
        pg8::EpiBf16<0> E{BIG, PEER_Q}; pg8::gemm_phase(F.lds, g, S, E, F.wave); } } }
    SEAM(13);
    if (IN(14)) { frame_refresh(F); peer_phase(F); }
#undef IN
#undef SEAM
}

extern "C" void kernel_launch(void* const* d_in, const int* in_sizes, int n_in, void* d_out, int out_size, void* d_ws, size_t ws_size, hipStream_t stream) {
    static int grid = 0;
    if (grid == 0) {
        if (n_in != 26 || out_size != T * DM || ws_size < WS_END) { fprintf(stderr, "kernel_launch: unexpected shapes (n_in %d, out %d, ws %zu)\n", n_in, out_size, ws_size); grid = -1; return; }
        int dev = 0, cus = 0;
        if (hipGetDevice(&dev) != hipSuccess || hipDeviceGetAttribute(&cus, hipDeviceAttributeMultiprocessorCount, dev) != hipSuccess) { grid = -1; return; }
        if (hipFuncSetAttribute((const void*)mega_fwd, hipFuncAttributeMaxDynamicSharedMemorySize, LDS_BYTES) != hipSuccess) { grid = -1; return; }
        int per_cu = 0;
        (void)hipOccupancyMaxActiveBlocksPerMultiprocessor(&per_cu, (const void*)mega_fwd, NTHR, LDS_BYTES);
        (void)hipGetLastError();
        grid = cus;
    }
    if (grid < 0) return;
    (void)hipMemsetAsync((char*)d_ws + WS_CTL, 0, CTL_ZERO_BYTES, stream);
    Args a{};
    for (int i = 0; i < 26; ++i) a.in[i] = (const float*)d_in[i];
    a.positions = (const int*)d_in[2]; a.out = (float*)d_out; a.ws = (unsigned char*)d_ws;
#if MK_N_LAUNCHES == 1
    a.ph_lo = 0; a.ph_hi = N_PHASES;
    hipLaunchKernelGGL(mega_fwd, dim3(grid), dim3(NTHR), LDS_BYTES, stream, a);
#else
    for (int p = 0; p < N_PHASES; ++p) { a.ph_lo = p; a.ph_hi = p + 1; hipLaunchKernelGGL(mega_fwd, dim3(grid), dim3(NTHR), LDS_BYTES, stream, a); }
#endif
}
```

```cpp
#include <hip/hip_runtime.h>
#include <cstdio>
#include <cstdint>

#ifndef MK_N_LAUNCHES
#define MK_N_LAUNCHES 1
#endif

#define LAS __attribute__((address_space(3)))
#define GAS __attribute__((address_space(1)))
typedef unsigned short bf16;
typedef short bf16x8 __attribute__((ext_vector_type(8)));
typedef float f32x4 __attribute__((ext_vector_type(4)));
typedef float f32x2 __attribute__((ext_vector_type(2)));
typedef unsigned u32x4 __attribute__((ext_vector_type(4)));
typedef unsigned u32x2 __attribute__((ext_vector_type(2)));

constexpr int NB = 8, SEQ = 8192, DM = 1024, T = NB * SEQ;
constexpr int HB = 4, HT = HB * SEQ;
constexpr int NMEM = 256;
constexpr int NPROJ = 6144;
constexpr int PC_Z = 0, PC_X = 1024, PC_B = 2048, PC_C = 2560, PC_DQ = 3072, PC_DK = 3840, PC_DV = 4608, PC_MQ = 5376;
constexpr int W_IN_N = 9232, OFF_DT = 3072, OFF_AFTER_DT = 3088;
constexpr int NGATE = 3072;
constexpr int YC = 2048;
constexpr int PEER_H = 8, PEER_K = 16, PEER_NK = 128, PEER_Q = 2048;
constexpr float EPS = 1e-6f;

constexpr size_t MiB = 1u << 20;
constexpr size_t WS_CTL = 0, CTL_ZERO_BYTES = 65536;
constexpr size_t WS_WALLT = 1 * MiB;
constexpr size_t WS_WMKVT = 19 * MiB;
constexpr size_t WS_WCATT = 22 * MiB;
constexpr size_t WS_WOUTT = 26 * MiB;
constexpr size_t WS_WQT = 28 * MiB;
constexpr size_t WS_SUBK = 32 * MiB;
constexpr size_t WS_PD = 33 * MiB;
constexpr size_t WS_PU = 65 * MiB;
constexpr size_t WS_DT = 97 * MiB;
constexpr size_t WS_MEMN = 101 * MiB;
constexpr size_t WS_MKV = 105 * MiB;
constexpr size_t WS_ACT1 = 112 * MiB;
constexpr size_t WS_BIG = 240 * MiB;
constexpr size_t WS_LSE = 624 * MiB;
constexpr size_t WS_MVT = 628 * MiB;
constexpr size_t WS_DEC = 631 * MiB;
constexpr size_t WS_SST = 632 * MiB;
constexpr size_t WS_SIN = 760 * MiB;
constexpr size_t WS_END = 824 * MiB;

constexpr int RING_BYTES = 131072;
constexpr int LDSCTL_OFF = 143360;
constexpr int LDS_BYTES = 147456;
constexpr int NWAVES = 8, NTHR = 512;

__device__ __forceinline__ int lane_id() { return (int)__builtin_amdgcn_mbcnt_hi(~0u, __builtin_amdgcn_mbcnt_lo(~0u, 0u)); }
__device__ __forceinline__ float bf2f(unsigned short b) { return __builtin_bit_cast(float, (unsigned)b << 16); }
__device__ __forceinline__ float bflo(unsigned w) { return __builtin_bit_cast(float, w << 16); }
__device__ __forceinline__ float bfhi(unsigned w) { return __builtin_bit_cast(float, w & 0xffff0000u); }
__device__ __forceinline__ unsigned f2bf(float f) { unsigned u = __builtin_bit_cast(unsigned, f); return (u + 0x7fffu + ((u >> 16) & 1u)) >> 16; }
__device__ __forceinline__ unsigned pk2(float lo, float hi) { return f2bf(lo) | (f2bf(hi) << 16); }
typedef float f32x16 __attribute__((ext_vector_type(16)));
typedef short s16x4 __attribute__((ext_vector_type(4)));
typedef __bf16 bf2_t __attribute__((ext_vector_type(2)));
__device__ __forceinline__ unsigned pkbf(float a, float b) { const f32x2 v = {a, b}; return __builtin_bit_cast(unsigned, __builtin_convertvector(v, bf2_t)); }
#define MFMA32(a, b, c) __builtin_amdgcn_mfma_f32_32x32x16_bf16((a), (b), (c), 0, 0, 0)
__device__ __forceinline__ float wave_sum(float v) {
#pragma unroll
    for (int o = 1; o < 64; o <<= 1) v += __shfl_xor(v, o);
    return v;
}
__device__ __forceinline__ float wave_max(float v) {
#pragma unroll
    for (int o = 1; o < 64; o <<= 1) v = fmaxf(v, __shfl_xor(v, o));
    return v;
}
__device__ __forceinline__ float sigmoidf_(float x) { return 1.0f / (1.0f + __expf(-x)); }
#define LDS_WAIT() asm volatile("s_waitcnt lgkmcnt(0)" ::: "memory")
#define VM_WAIT() asm volatile("s_waitcnt vmcnt(0)" ::: "memory")

#define XB_TMO      128
#define XB_XCNT(j)  (256  + 64 * (j))
#define XB_XSUB(j)  (1280 + 64 * (j))
#define XB_XGEN(j)  (2304 + 64 * (j))
#define XB_TOP      3328
#define XB_TOPGEN   3392
#define XCD_BAR_WORDS 3456
#define XB_SPIN_CAP (1u << 18)
__device__ __forceinline__ unsigned xb_ld(unsigned* p)              { return __hip_atomic_load(p, __ATOMIC_RELAXED, __HIP_MEMORY_SCOPE_AGENT); }
__device__ __forceinline__ unsigned xb_add(unsigned* p, unsigned v) { return __hip_atomic_fetch_add(p, v, __ATOMIC_RELAXED, __HIP_MEMORY_SCOPE_AGENT); }
__device__ __forceinline__ unsigned xb_xcc_id() { return (unsigned)__builtin_amdgcn_s_getreg((3 << 11) | 20) & 0xFu; }
#define XB_SPIN(cond, bar) do { unsigned _sp = 0; while (cond) { __builtin_amdgcn_s_sleep(1); \
    if ((++_sp & 255u) == 0u) { if (xb_ld(&(bar)[XB_TMO])) break; if (_sp > XB_SPIN_CAP) { atomicAdd(&(bar)[XB_TMO], 1u); break; } } } } while (0)
struct XcdBarrier { unsigned* bar; unsigned x; volatile LAS unsigned* st; int wave; };
__device__ __forceinline__ XcdBarrier xcd_barrier_post(unsigned* bar, volatile LAS unsigned* st, int wave) {
    XcdBarrier b; b.bar = bar; b.x = xb_xcc_id(); b.st = st; b.wave = wave;
    if (wave == 0 && lane_id() == 0) (void)xb_add(&bar[XB_XCNT(b.x)], 1u);
    return b;
}
__device__ __forceinline__ void xcd_barrier_complete(unsigned* bar, unsigned x, unsigned& nloc, unsigned& nx) {
    const unsigned G = gridDim.x * gridDim.y * gridDim.z;
    unsigned sum, cnt, mine, sp = 0u;
    for (;;) {
        sum = 0u; cnt = 0u; mine = 0u;
#pragma unroll
        for (unsigned j = 0; j < 16; ++j) { const unsigned c = xb_ld(&bar[XB_XCNT(j)]); sum += c; cnt += (c > 0u) ? 1u : 0u; mine = (j == x) ? c : mine; }
        if (sum == G) break;
        __builtin_amdgcn_s_sleep(1);
        if ((++sp & 255u) == 0u) { if (xb_ld(&bar[XB_TMO])) break; if (sp > XB_SPIN_CAP) { atomicAdd(&bar[XB_TMO], 1u); break; } }
    }
    nloc = mine > 0u ? mine : 1u; nx = cnt > 0u ? cnt : 1u;
}
__device__ __forceinline__ void xcd_barrier(const XcdBarrier& b) {
    asm volatile("s_waitcnt vmcnt(0)" ::: "memory");
    __syncthreads();
    if (b.wave == 0 && lane_id() == 0) {
        unsigned* bar = b.bar;
        __builtin_amdgcn_s_waitcnt(0);
        unsigned nloc = b.st[0], nx = b.st[1];
        if (nloc == 0u) { xcd_barrier_complete(bar, b.x, nloc, nx); b.st[0] = nloc; b.st[1] = nx; }
        const unsigned old = xb_add(&bar[XB_XSUB(b.x)], 1u);
        const unsigned gen = old / nloc;
        if (old + 1u == (gen + 1u) * nloc) {
            __builtin_amdgcn_fence(__ATOMIC_RELEASE, "agent");
            asm volatile("s_waitcnt vmcnt(0)" ::: "memory");
            const unsigned og = xb_add(&bar[XB_TOP], 1u);
            const unsigned tg = og / nx;
            if (og + 1u == (tg + 1u) * nx) xb_add(&bar[XB_TOPGEN], 1u);
            else XB_SPIN(xb_ld(&bar[XB_TOPGEN]) == tg, bar);
            __builtin_amdgcn_fence(__ATOMIC_ACQUIRE, "agent");
            xb_add(&bar[XB_XGEN(b.x)], 1u);
            asm volatile("s_waitcnt vmcnt(0)" ::: "memory");
        } else {
            XB_SPIN(xb_ld(&bar[XB_XGEN(b.x)]) == gen, bar);
            __builtin_amdgcn_fence(__ATOMIC_ACQUIRE, "agent");
            asm volatile("s_waitcnt vmcnt(0)" ::: "memory");
        }
    }
    __syncthreads();
}

namespace pg8 {
constexpr int BM = 256, BK = 64, HALF = 128, HTB = HALF * BK * 2, STAGE_BYTES = 8 * HTB, NXCD = 8, WGM = 8;
__host__ __device__ __forceinline__ int lds_byte(int r, int c) { const int st = (r >> 4) * 2 + (c >> 5), rr = r & 15, cc = c & 31, ob = rr * 64 + cc * 2; return st * 1024 + (ob ^ (((ob >> 9) & 1) << 5)); }
__host__ __device__ __forceinline__ void stage_rc(int b, int& R, int& C) { const int st = b / 1024, sb = b % 1024, swz = sb ^ (((sb >> 9) & 1) << 5); R = (st >> 1) * 16 + swz / 64; C = (st & 1) * 32 + (swz % 64) / 2; }
__host__ __device__ __forceinline__ int perm32(int rho) { const int n = rho >> 4, i = rho & 15; return 8 * (i >> 2) + 4 * n + (i & 3); }
struct Unit { int pm, pn; };
struct Gemm { const bf16* A; const bf16* Bt; int M, N, K, lda, ldb; };
struct StaticOrder {
    int nM, nN, nwg, G, c;
    __host__ __device__ void init(int M, int N, int G_, int c_) { nM = M / BM; nN = N / BM; nwg = nM * nN; G = G_; c = c_; }
    __host__ __device__ bool next(int i, Unit& u) const {
        const long L = (long)i * G + c; if (L >= nwg) return false;
        int wgid = (int)L; { const int q = nwg / NXCD, r = nwg % NXCD, xcd = wgid % NXCD, off = wgid / NXCD; wgid = (xcd < r ? xcd * (q + 1) : r * (q + 1) + (xcd - r) * q) + off; }
        const int nig = WGM * nN, gid = wgid / nig, fm = gid * WGM, gsz = (nM - fm) < WGM ? (nM - fm) : WGM;
        u.pm = fm + ((wgid % nig) % gsz); u.pn = (wgid % nig) / gsz; return true;
    }
    __device__ __forceinline__ void a_ready(const Unit&) const {}
    __device__ __forceinline__ void done(const Unit&) const {}
};
__device__ __forceinline__ unsigned cvt_pk_bf16(float lo, float hi) { unsigned r; asm volatile("v_cvt_pk_bf16_f32 %0, %1, %2" : "=v"(r) : "v"(lo), "v"(hi)); return r; }

template <int ACT> struct EpiBf16 {
    static constexpr bool PERM = true, AFTER_DRAIN = false, HAS_MID = false;
    bf16* O; int ldc;
    __device__ __forceinline__ void operator()(const f32x4 (&acc)[2][2][4][2], const Unit& u, int wr, int wc, int fr, int fq) const {
        const int row0 = u.pm * BM + wr * 64 + fr; const int col0 = u.pn * BM + wc * 32 + 8 * fq;
#pragma unroll
        for (int ai = 0; ai < 2; ++ai)
#pragma unroll
            for (int m = 0; m < 4; ++m) { bf16* rowp = O + (size_t)(row0 + ai * HALF + m * 16) * ldc + col0;
#pragma unroll
                for (int bj = 0; bj < 2; ++bj) { f32x4 v0 = acc[ai][bj][m][0], v1 = acc[ai][bj][m][1];
                    if (ACT == 1) {
#pragma unroll
                        for (int j = 0; j < 4; ++j) { v0[j] = sigmoidf_(v0[j]); v1[j] = sigmoidf_(v1[j]); } }
                    u32x4 w; w.x = cvt_pk_bf16(v0[0], v0[1]); w.y = cvt_pk_bf16(v0[2], v0[3]); w.z = cvt_pk_bf16(v1[0], v1[1]); w.w = cvt_pk_bf16(v1[2], v1[3]);
                    *(u32x4*)(rowp + bj * HALF) = w; } }
    }
};
template <bool ACCUM> struct EpiBranch {
    static constexpr bool PERM = true, AFTER_DRAIN = false, HAS_MID = false;
    bf16* O; int ldc; const bf16* Gt; int ldg; int gcol0;
    __device__ __forceinline__ void operator()(const f32x4 (&acc)[2][2][4][2], const Unit& u, int wr, int wc, int fr, int fq) const {
        const int row0 = u.pm * BM + wr * 64 + fr; const int col0 = u.pn * BM + wc * 32 + 8 * fq;
#pragma unroll
        for (int ai = 0; ai < 2; ++ai)
#pragma unroll
            for (int m = 0; m < 4; ++m) { const size_t r = (size_t)(row0 + ai * HALF + m * 16); bf16* rowp = O + r * ldc + col0; const bf16* gp = Gt + r * ldg + gcol0 + col0;
#pragma unroll
                for (int bj = 0; bj < 2; ++bj) { const f32x4 v0 = acc[ai][bj][m][0], v1 = acc[ai][bj][m][1];
                    const u32x4 g = *(const u32x4*)(gp + bj * HALF);
                    float o[8];
                    o[0] = v0[0] * bflo(g.x); o[1] = v0[1] * bfhi(g.x); o[2] = v0[2] * bflo(g.y); o[3] = v0[3] * bfhi(g.y);
                    o[4] = v1[0] * bflo(g.z); o[5] = v1[1] * bfhi(g.z); o[6] = v1[2] * bflo(g.w); o[7] = v1[3] * bfhi(g.w);
                    if (ACCUM) { const u32x4 p = *(const u32x4*)(rowp + bj * HALF);
                        o[0] += bflo(p.x); o[1] += bfhi(p.x); o[2] += bflo(p.y); o[3] += bfhi(p.y); o[4] += bflo(p.z); o[5] += bfhi(p.z); o[6] += bflo(p.w); o[7] += bfhi(p.w); }
                    u32x4 w; w.x = cvt_pk_bf16(o[0], o[1]); w.y = cvt_pk_bf16(o[2], o[3]); w.z = cvt_pk_bf16(o[4], o[5]); w.w = cvt_pk_bf16(o[6], o[7]);
                    *(u32x4*)(rowp + bj * HALF) = w; } }
    }
};
struct EpiResid {
    static constexpr bool PERM = false, AFTER_DRAIN = false, HAS_MID = false;
    float* C; int ldc; const float* R;
    __device__ __forceinline__ void operator()(const f32x4 (&acc)[2][2][4][2], const Unit& u, int wr, int wc, int fr, int fq) const {
        const int row0 = u.pm * BM + wr * 64 + fr, col0 = u.pn * BM + wc * 32 + 4 * fq;
#pragma unroll
        for (int ai = 0; ai < 2; ++ai)
#pragma unroll
            for (int m = 0; m < 4; ++m) { const size_t off = (size_t)(row0 + ai * HALF + m * 16) * ldc + col0;
#pragma unroll
                for (int bj = 0; bj < 2; ++bj)
#pragma unroll
                    for (int n = 0; n < 2; ++n) { const f32x4 r = *(const f32x4*)(R + off + bj * HALF + n * 16); *(f32x4*)(C + off + bj * HALF + n * 16) = acc[ai][bj][m][n] + r; } }
    }
};

struct EpiBranchFused {
    static constexpr bool PERM = true, AFTER_DRAIN = false, HAS_MID = true;
    bf16* O; int ldc; __amdgpu_buffer_rsrc_t grs; int ldg;
    __device__ __forceinline__ void mid(f32x4 (&acc)[2][2][4][2], const Unit& u, int t, int wr, int wc, int fr, int fq) const {
        const unsigned voff = (unsigned)(((u.pm * BM + wr * 64 + fr) * ldg + u.pn * BM + wc * 32 + 8 * fq) * 2);
        const int ca = (t == 16) ? 0 : 2048;
#pragma unroll
        for (int ai = 0; ai < 2; ++ai)
#pragma unroll
            for (int m = 0; m < 4; ++m) {
#pragma unroll
                for (int bj = 0; bj < 2; ++bj) { const int so = ((ai * HALF + m * 16) * ldg + bj * HALF) * 2 + ca;
                    const u32x4 ga = __builtin_amdgcn_raw_buffer_load_b128(grs, voff, so, 0), gb = __builtin_amdgcn_raw_buffer_load_b128(grs, voff, so + 2048, 0);
                    f32x4& v0 = acc[ai][bj][m][0]; f32x4& v1 = acc[ai][bj][m][1];
                    v0[0] *= bflo(ga.x) * __builtin_amdgcn_rcpf(fmaxf(bflo(gb.x), 1e-30f)); v0[1] *= bfhi(ga.x) * __builtin_amdgcn_rcpf(fmaxf(bfhi(gb.x), 1e-30f));
                    v0[2] *= bflo(ga.y) * __builtin_amdgcn_rcpf(fmaxf(bflo(gb.y), 1e-30f)); v0[3] *= bfhi(ga.y) * __builtin_amdgcn_rcpf(fmaxf(bfhi(gb.y), 1e-30f));
                    v1[0] *= bflo(ga.z) * __builtin_amdgcn_rcpf(fmaxf(bflo(gb.z), 1e-30f)); v1[1] *= bfhi(ga.z) * __builtin_amdgcn_rcpf(fmaxf(bfhi(gb.z), 1e-30f));
                    v1[2] *= bflo(ga.w) * __builtin_amdgcn_rcpf(fmaxf(bflo(gb.w), 1e-30f)); v1[3] *= bfhi(ga.w) * __builtin_amdgcn_rcpf(fmaxf(bfhi(gb.w), 1e-30f)); }
                __builtin_amdgcn_sched_barrier(0); }
    }
    __device__ __forceinline__ void operator()(const f32x4 (&acc)[2][2][4][2], const Unit& u, int wr, int wc, int fr, int fq) const {
        const int row0 = u.pm * BM + wr * 64 + fr; const int col0 = u.pn * BM + wc * 32 + 8 * fq;
        const unsigned voff = (unsigned)((row0 * ldg + col0) * 2);
#pragma unroll
        for (int ai = 0; ai < 2; ++ai)
#pragma unroll
            for (int m = 0; m < 4; ++m) { const size_t r = (size_t)(row0 + ai * HALF + m * 16); bf16* rowp = O + r * ldc + col0;
#pragma unroll
                for (int bj = 0; bj < 2; ++bj) { const f32x4 v0 = acc[ai][bj][m][0], v1 = acc[ai][bj][m][1];
                    const u32x4 g = __builtin_amdgcn_raw_buffer_load_b128(grs, voff, ((ai * HALF + m * 16) * ldg + bj * HALF) * 2 + 4096, 0);
                    u32x4 w; w.x = cvt_pk_bf16(v0[0] * bflo(g.x), v0[1] * bfhi(g.x)); w.y = cvt_pk_bf16(v0[2] * bflo(g.y), v0[3] * bfhi(g.y));
                    w.z = cvt_pk_bf16(v1[0] * bflo(g.z), v1[1] * bfhi(g.z)); w.w = cvt_pk_bf16(v1[2] * bflo(g.w), v1[3] * bfhi(g.w));
                    *(u32x4*)(rowp + bj * HALF) = w; } }
    }
};

template <class Epi, class Sched>
__device__ __forceinline__ void gemm_phase(LAS unsigned char* lds, const Gemm g, const Sched& S, const Epi& E, int wid) {
    int lane = lane_id(); asm volatile("" : "+v"(lane));
    const int tid = wid * 64 + lane, wr = wid >> 2, wc = wid & 3, fr = lane & 15, fq = lane >> 4;
    const int K = g.K, nt = K / BK;
    unsigned voffA[2], voffB[2];
#pragma unroll
    for (int i = 0; i < 2; ++i) { int R, C; stage_rc(tid * 16 + i * 8192, R, C); const int Rb = Epi::PERM ? ((R & ~31) + perm32(R & 31)) : R;
        voffA[i] = (unsigned)(R * g.lda + C) * 2u; voffB[i] = (unsigned)(Rb * g.ldb + C) * 2u; }
    const size_t kstep = (size_t)(BK * 2);
    const size_t hsA = (size_t)HALF * g.lda * 2, hsB = (size_t)HALF * g.ldb * 2;
    const size_t tsA = 2 * hsA, tsB = 2 * hsB;
    const unsigned ldsw = (unsigned)wid * 1024u;
    const int aoff = lds_byte(wr * 64 + fr, fq * 8), boff = lds_byte(wc * 32 + fr, fq * 8);
#define PG8_SA(b, h) (((b) * 2 + (h)) * HTB)
#define PG8_SB(b, h) ((4 + (b) * 2 + (h)) * HTB)
#define PG8_STAGE(bufoff, gbase, voff) do { _Pragma("unroll") for (int _i = 0; _i < 2; ++_i) \
        __builtin_amdgcn_global_load_lds((const unsigned*)((const char*)(gbase) + (voff)[_i]), (LAS unsigned*)(lds + (bufoff) + ldsw + _i * 8192), 16, 0, 0); } while (0)
#define PG8_LDA(dst, b, h) do { _Pragma("unroll") for (int m = 0; m < 4; ++m) _Pragma("unroll") for (int k = 0; k < 2; ++k) dst[m][k] = *(const LAS bf16x8*)(lds + PG8_SA(b, h) + aoff + m * 2048 + k * 1024); } while (0)
#define PG8_LDB(dst, b, h) do { _Pragma("unroll") for (int n = 0; n < 2; ++n) _Pragma("unroll") for (int k = 0; k < 2; ++k) dst[n][k] = *(const LAS bf16x8*)(lds + PG8_SB(b, h) + boff + n * 2048 + k * 1024); } while (0)
#define PG8_MMA(ai, bj, At, Bt) do { __builtin_amdgcn_s_setprio(1); _Pragma("unroll") for (int m = 0; m < 4; ++m) _Pragma("unroll") for (int n = 0; n < 2; ++n) _Pragma("unroll") for (int k = 0; k < 2; ++k) \
        acc[ai][bj][m][n] = __builtin_amdgcn_mfma_f32_16x16x32_bf16(Bt[n][k], At[m][k], acc[ai][bj][m][n], 0, 0, 0); __builtin_amdgcn_s_setprio(0); } while (0)
#define PG8_WAIT_V(n) asm volatile("s_waitcnt vmcnt(" #n ")" ::: "memory")
#define PG8_WAIT_L(n) asm volatile("s_waitcnt lgkmcnt(" #n ")" ::: "memory")
#define PG8_BAR __builtin_amdgcn_s_barrier()
#define PG8_SCHED __builtin_amdgcn_sched_barrier(0)
    Unit cur, nxt; int ui = 0;
    if (!S.next(0, cur)) return;
    f32x4 acc[2][2][4][2];
#pragma unroll
    for (int a = 0; a < 2; ++a)
#pragma unroll
        for (int b = 0; b < 2; ++b)
#pragma unroll
            for (int m = 0; m < 4; ++m)
#pragma unroll
                for (int n = 0; n < 2; ++n) acc[a][b][m][n] = (f32x4){0.f, 0.f, 0.f, 0.f};
    bf16x8 At[4][2], B0[2][2], B1[2][2];
    const char* cA = (const char*)g.A + (size_t)cur.pm * tsA; const char* cB = (const char*)g.Bt + (size_t)cur.pn * tsB;
    S.a_ready(cur);
    PG8_STAGE(PG8_SB(0, 0), cB, voffB); PG8_STAGE(PG8_SA(0, 0), cA, voffA); PG8_STAGE(PG8_SB(0, 1), cB + hsB, voffB); PG8_STAGE(PG8_SA(0, 1), cA + hsA, voffA);
    if (wr == 1) PG8_BAR;
    PG8_WAIT_V(4); PG8_BAR;
    PG8_STAGE(PG8_SB(1, 0), cB + kstep, voffB); PG8_STAGE(PG8_SA(1, 0), cA + kstep, voffA); PG8_STAGE(PG8_SB(1, 1), cB + hsB + kstep, voffB);
    PG8_WAIT_V(6); PG8_BAR;
    for (;;) {
        const bool has_next = S.next(ui + 1, nxt);
        const char* nA = has_next ? (const char*)g.A + (size_t)nxt.pm * tsA : cA; const char* nB = has_next ? (const char*)g.Bt + (size_t)nxt.pn * tsB : cB;
        for (int t = 0; t < nt; t += 2) {
            const bool last = (t == nt - 2);
            const char* a1 = cA + (size_t)(t + 1) * kstep;
            const char* a2 = last ? nA : cA + (size_t)(t + 2) * kstep; const char* b2 = last ? nB : cB + (size_t)(t + 2) * kstep;
            const char* a3 = a2 + kstep; const char* b3 = b2 + kstep;
            if (last && has_next) S.a_ready(nxt);
            if constexpr (Epi::HAS_MID) { if (t == 16 || t == 20) E.mid(acc, cur, t, wr, wc, fr, fq); }
            PG8_LDB(B0, 0, 0); PG8_SCHED; PG8_LDA(At, 0, 0); PG8_STAGE(PG8_SA(1, 1), a1 + hsA, voffA);
            PG8_WAIT_L(8); PG8_BAR; PG8_WAIT_L(0); PG8_MMA(0, 0, At, B0); PG8_BAR; PG8_SCHED;
            PG8_LDB(B1, 0, 1); PG8_STAGE(PG8_SB(0, 0), b2, voffB);
            PG8_BAR; PG8_WAIT_L(0); PG8_MMA(0, 1, At, B1); PG8_BAR;
            PG8_LDA(At, 0, 1); PG8_STAGE(PG8_SA(0, 0), a2, voffA);
            PG8_BAR; PG8_WAIT_L(0); PG8_MMA(1, 0, At, B0); PG8_BAR; PG8_SCHED;
            PG8_STAGE(PG8_SB(0, 1), b2 + hsB, voffB);
            PG8_WAIT_V(6); PG8_BAR; PG8_MMA(1, 1, At, B1); PG8_BAR;
            PG8_LDB(B0, 1, 0); PG8_SCHED; PG8_LDA(At, 1, 0); PG8_STAGE(PG8_SA(0, 1), a2 + hsA, voffA);
            PG8_WAIT_L(8); PG8_BAR; PG8_WAIT_L(0); PG8_MMA(0, 0, At, B0); PG8_BAR; PG8_SCHED;
            PG8_LDB(B1, 1, 1); PG8_STAGE(PG8_SB(1, 0), b3, voffB);
            PG8_BAR; PG8_WAIT_L(0); PG8_MMA(0, 1, At, B1); PG8_BAR;
            PG8_LDA(At, 1, 1); PG8_STAGE(PG8_SA(1, 0), a3, voffA);
            PG8_BAR; PG8_WAIT_L(0); PG8_MMA(1, 0, At, B0); PG8_BAR; PG8_SCHED;
            PG8_STAGE(PG8_SB(1, 1), b3 + hsB, voffB);
            PG8_WAIT_V(6); PG8_BAR; PG8_MMA(1, 1, At, B1); PG8_BAR;
        }
        E(acc, cur, wr, wc, fr, fq); S.done(cur);
        if (!has_next) break;
#pragma unroll
        for (int a = 0; a < 2; ++a)
#pragma unroll
            for (int b = 0; b < 2; ++b)
#pragma unroll
                for (int m = 0; m < 4; ++m)
#pragma unroll
                    for (int n = 0; n < 2; ++n) acc[a][b][m][n] = (f32x4){0.f, 0.f, 0.f, 0.f};
        cur = nxt; cA = nA; cB = nB; ++ui;
    }
    PG8_WAIT_V(0);
    if (wr == 0) PG8_BAR;
    PG8_BAR;
#undef PG8_SA
#undef PG8_SB
#undef PG8_STAGE
#undef PG8_LDA
#undef PG8_LDB
#undef PG8_MMA
#undef PG8_WAIT_V
#undef PG8_WAIT_L
#undef PG8_BAR
#undef PG8_SCHED
}
}

#ifndef PROBE
#define PROBE 0
#endif
struct Args {
    const float* in[26]; const int* positions; float* out; unsigned char* ws; int ph_lo, ph_hi; int pad0, pad1;
};
struct Frame {
    LAS unsigned char* lds;
    int tid, lane, wave, G, bid;
    const float* const* in; const int* positions; float* out; unsigned char* ws;
};
__device__ __forceinline__ void frame_refresh(Frame& F) { int l = lane_id(); asm volatile("" : "+v"(l)); F.lane = l; F.tid = F.wave * 64 + l; }
enum { I_X = 0, I_MEM = 1, I_POS = 2, I_NMIXW = 3, I_WIN = 4, I_CONVW = 5, I_CONVB = 6, I_DTB = 7, I_ALOG = 8, I_SSDD = 9, I_SSDNW = 10, I_DQNW = 11, I_DKNW = 12, I_MEMNW = 13,
       I_WMKV = 14, I_MQNW = 15, I_MKNW = 16, I_WSSD = 17, I_WDIL = 18, I_WMEMBR = 19, I_WOUT = 20, I_NFFNW = 21, I_WQ = 22, I_SUBK = 23, I_PD = 24, I_PU = 25 };

__device__ __forceinline__ void p0_transpose_item(const float* W, int ldw, int src_col0, bf16* WT, int ldt, int dst_row0, int dst_col0, int nblk, LAS float* scr, int item, int lane) {
    const int kb = item / nblk, nb = item % nblk, k0 = 64 * kb, n0 = 32 * nb;
#pragma unroll 8
    for (int i = 0; i < 32; ++i) { const int kk = 2 * i + (lane >> 5); scr[kk * 33 + (lane & 31)] = W[(size_t)(k0 + kk) * ldw + src_col0 + n0 + (lane & 31)]; }
    LDS_WAIT(); asm volatile("" ::: "memory");
    const int c = lane & 7;
#pragma unroll
    for (int j = 0; j < 4; ++j) { const int n = (lane >> 3) + 8 * j; const LAS float* s = scr + (8 * c) * 33 + n;
        u32x4 o; o.x = pk2(s[0 * 33], s[1 * 33]); o.y = pk2(s[2 * 33], s[3 * 33]); o.z = pk2(s[4 * 33], s[5 * 33]); o.w = pk2(s[6 * 33], s[7 * 33]);
        *(u32x4*)(WT + (size_t)(dst_row0 + n0 + n) * ldt + dst_col0 + k0 + 8 * c) = o; }
    LDS_WAIT(); asm volatile("" ::: "memory");
}
__device__ __forceinline__ void rms_row_to_bf16(const float* xrow, const float* w, bf16* orow, int lane, f32x4 (&v)[4]) {
    const f32x4* xr = (const f32x4*)xrow + lane; const f32x4* wr = (const f32x4*)w + lane;
    float s = 0.f;
#pragma unroll
    for (int j = 0; j < 4; ++j) { v[j] = xr[64 * j]; s += (v[j].x * v[j].x + v[j].y * v[j].y) + (v[j].z * v[j].z + v[j].w * v[j].w); }
    const float rstd = 1.0f / sqrtf(wave_sum(s) * (1.f / DM) + EPS);
    unsigned long long* o8 = (unsigned long long*)orow + lane;
#pragma unroll
    for (int j = 0; j < 4; ++j) { const f32x4 ww = wr[64 * j]; v[j] = v[j] * rstd * ww;
        o8[64 * j] = (unsigned long long)pk2(v[j].x, v[j].y) | ((unsigned long long)pk2(v[j].z, v[j].w) << 32); }
}
__device__ __forceinline__ void cvt_f32_bf16_stream(const float* src, bf16* dst, size_t n, size_t gtid, size_t gthreads) {
    for (size_t i = gtid * 8; i < n; i += gthreads * 8) { const f32x4 a = *(const f32x4*)(src + i), b = *(const f32x4*)(src + i + 4);
        u32x4 o; o.x = pk2(a.x, a.y); o.y = pk2(a.z, a.w); o.z = pk2(b.x, b.y); o.w = pk2(b.z, b.w); *(u32x4*)(dst + i) = o; }
}
constexpr float PD_SCALE = 64.0f, PU_SCALE = 8.0f;
__device__ __forceinline__ unsigned pk4_fp8(f32x4 v, float sc) {
    const float a = fminf(fmaxf(v.x * sc, -448.f), 448.f), b = fminf(fmaxf(v.y * sc, -448.f), 448.f), c = fminf(fmaxf(v.z * sc, -448.f), 448.f), d = fminf(fmaxf(v.w * sc, -448.f), 448.f);
    unsigned p = __builtin_amdgcn_cvt_pk_fp8_f32(a, b, 0, false); return __builtin_amdgcn_cvt_pk_fp8_f32(c, d, p, true);
}
__device__ __forceinline__ void cvt_f32_fp8_sliced(const float* src, unsigned char* dst, float sc, size_t gtid, size_t gthreads) {
    for (size_t i = gtid * 16; i < (size_t)16384 * 1024; i += gthreads * 16) { const f32x4 a = *(const f32x4*)(src + i), b = *(const f32x4*)(src + i + 4), c = *(const f32x4*)(src + i + 8), d = *(const f32x4*)(src + i + 12);
        const size_t e = i >> 10, dd = i & 1023;
        const u32x4 o = {pk4_fp8(a, sc), pk4_fp8(b, sc), pk4_fp8(c, sc), pk4_fp8(d, sc)}; *(u32x4*)(dst + ((((dd >> 7) * 16384 + e) << 7) + (dd & 127))) = o; }
}
__device__ __forceinline__ void p0_prologue(Frame& F) {
    LAS float* scr = (LAS float*)(F.lds + F.wave * 8448);
    LAS float* wdt = (LAS float*)(F.lds + 8 * 8448);
    const int gw = F.bid * NWAVES + F.wave, NGW = F.G * NWAVES;
    unsigned char* ws = F.ws;
    for (int i = F.tid; i < 1024 * 16; i += NTHR) { const int k = i >> 4, c = i & 15, l = (k & 255) >> 2, e = k & 3, j = k >> 8, q = c >> 2;
        wdt[((((j * 4 + e) * 4 + q) * 64 + l) << 2) + (c & 3)] = F.in[I_WIN][(size_t)k * W_IN_N + OFF_DT + c]; }
    __syncthreads();
    constexpr int IT_A = 16 * 96, IT_B = 16 * 192, IT_MKV = 16 * 48, IT_SSD = 16 * 32, IT_DIL = 4 * 32, IT_MBR = 12 * 32, IT_OUT = 16 * 32, IT_WQ = 16 * 64;
    constexpr int NITEMS = IT_A + IT_B + IT_MKV + IT_SSD + IT_DIL + IT_MBR + IT_OUT + IT_WQ;
    bf16* WallT = (bf16*)(ws + WS_WALLT);
    for (int it = gw; it < NITEMS; it += NGW) {
        int r = it;
        if (r < IT_A) { p0_transpose_item(F.in[I_WIN], W_IN_N, 0, WallT, DM, 0, 0, 96, scr, r, F.lane); continue; } r -= IT_A;
        if (r < IT_B) { p0_transpose_item(F.in[I_WIN], W_IN_N, OFF_AFTER_DT, WallT, DM, 3072, 0, 192, scr, r, F.lane); continue; } r -= IT_B;
        if (r < IT_MKV) { p0_transpose_item(F.in[I_WMKV], 1536, 0, (bf16*)(ws + WS_WMKVT), DM, 0, 0, 48, scr, r, F.lane); continue; } r -= IT_MKV;
        if (r < IT_SSD) { p0_transpose_item(F.in[I_WSSD], DM, 0, (bf16*)(ws + WS_WCATT), YC, 0, 0, 32, scr, r, F.lane); continue; } r -= IT_SSD;
        if (r < IT_DIL) { p0_transpose_item(F.in[I_WDIL], DM, 0, (bf16*)(ws + WS_WCATT), YC, 0, 1024, 32, scr, r, F.lane); continue; } r -= IT_DIL;
        if (r < IT_MBR) { p0_transpose_item(F.in[I_WMEMBR], DM, 0, (bf16*)(ws + WS_WCATT), YC, 0, 1280, 32, scr, r, F.lane); continue; } r -= IT_MBR;
        if (r < IT_OUT) { p0_transpose_item(F.in[I_WOUT], DM, 0, (bf16*)(ws + WS_WOUTT), DM, 0, 0, 32, scr, r, F.lane); continue; } r -= IT_OUT;
        p0_transpose_item(F.in[I_WQ], PEER_Q, 0, (bf16*)(ws + WS_WQT), DM, 0, 0, 64, scr, r, F.lane);
    }
    const size_t gtid = (size_t)F.bid * NTHR + F.tid, gth = (size_t)F.G * NTHR;
    cvt_f32_bf16_stream(F.in[I_SUBK], (bf16*)(ws + WS_SUBK), (size_t)8 * 2 * 128 * 128, gtid, gth);
    cvt_f32_fp8_sliced(F.in[I_PD], ws + WS_PD, PD_SCALE, gtid, gth);
    cvt_f32_fp8_sliced(F.in[I_PU], ws + WS_PU, PU_SCALE, gtid, gth);
    for (int m = gw; m < NB * NMEM; m += NGW) { f32x4 v[4]; rms_row_to_bf16(F.in[I_MEM] + (size_t)m * DM, F.in[I_MEMNW], (bf16*)(ws + WS_MEMN) + (size_t)m * DM, F.lane, v); }
    float* DTp = (float*)(ws + WS_DT);
    const int lane = F.lane;
    const int myj = ((lane >> 5) & 1) * 8 + ((lane >> 4) & 1) * 4 + ((lane >> 3) & 1) * 2 + ((lane >> 2) & 1);
    const float dtb = F.in[I_DTB][myj];
    for (int m = 2 * gw; m < T; m += 2 * NGW) {
        f32x4 va[4], vb[4];
        rms_row_to_bf16(F.in[I_X] + (size_t)m * DM, F.in[I_NMIXW], (bf16*)(ws + WS_ACT1) + (size_t)m * DM, lane, va);
        rms_row_to_bf16(F.in[I_X] + (size_t)(m + 1) * DM, F.in[I_NMIXW], (bf16*)(ws + WS_ACT1) + (size_t)(m + 1) * DM, lane, vb);
        float da[16], db[16];
#pragma unroll
        for (int j = 0; j < 16; ++j) { da[j] = 0.f; db[j] = 0.f; }
#pragma unroll
        for (int j = 0; j < 4; ++j)
#pragma unroll
            for (int e = 0; e < 4; ++e) { const float ua = va[j][e], ub = vb[j][e];
#pragma unroll
                for (int q = 0; q < 4; ++q) { const f32x4 w4 = *(const LAS f32x4*)(wdt + ((((j * 4 + e) * 4 + q) * 64 + lane) << 2));
                    da[4 * q + 0] += ua * w4.x; da[4 * q + 1] += ua * w4.y; da[4 * q + 2] += ua * w4.z; da[4 * q + 3] += ua * w4.w;
                    db[4 * q + 0] += ub * w4.x; db[4 * q + 1] += ub * w4.y; db[4 * q + 2] += ub * w4.z; db[4 * q + 3] += ub * w4.w; }
                __builtin_amdgcn_sched_barrier(0); }
        float ra, rb;
        { float r8a[8], r8b[8], r4a[4], r4b[4], r2a[2], r2b[2];
          { const bool up = (lane & 32) != 0;
#pragma unroll
            for (int k = 0; k < 8; ++k) { r8a[k] = (up ? da[k + 8] : da[k]) + __shfl_xor(up ? da[k] : da[k + 8], 32); r8b[k] = (up ? db[k + 8] : db[k]) + __shfl_xor(up ? db[k] : db[k + 8], 32); } }
          { const bool up = (lane & 16) != 0;
#pragma unroll
            for (int k = 0; k < 4; ++k) { r4a[k] = (up ? r8a[k + 4] : r8a[k]) + __shfl_xor(up ? r8a[k] : r8a[k + 4], 16); r4b[k] = (up ? r8b[k + 4] : r8b[k]) + __shfl_xor(up ? r8b[k] : r8b[k + 4], 16); } }
          { const bool up = (lane & 8) != 0;
#pragma unroll
            for (int k = 0; k < 2; ++k) { r2a[k] = (up ? r4a[k + 2] : r4a[k]) + __shfl_xor(up ? r4a[k] : r4a[k + 2], 8); r2b[k] = (up ? r4b[k + 2] : r4b[k]) + __shfl_xor(up ? r4b[k] : r4b[k + 2], 8); } }
          { const bool up = (lane & 4) != 0; ra = (up ? r2a[1] : r2a[0]) + __shfl_xor(up ? r2a[0] : r2a[1], 4); rb = (up ? r2b[1] : r2b[0]) + __shfl_xor(up ? r2b[0] : r2b[1], 4); }
          ra += __shfl_xor(ra, 2); ra += __shfl_xor(ra, 1); rb += __shfl_xor(rb, 2); rb += __shfl_xor(rb, 1); }
        if ((lane & 3) == 0) { const float xa = ra + dtb, xb = rb + dtb;
            DTp[(size_t)m * 16 + myj] = (xa > 20.f) ? xa : log1pf(__expf(xa)); DTp[(size_t)(m + 1) * 16 + myj] = (xb > 20.f) ? xb : log1pf(__expf(xb)); }
    }
}

__device__ __forceinline__ void norm192_inplace(bf16* p, const float (&w)[4], int lane) {
    u32x2 v = {0u, 0u};
    if (lane < 48) v = *(const u32x2*)(p + 4 * lane);
    float x0 = bflo(v.x), x1 = bfhi(v.x), x2 = bflo(v.y), x3 = bfhi(v.y);
    const float ss = wave_sum((x0 * x0 + x1 * x1) + (x2 * x2 + x3 * x3));
    const float rs = 1.0f / sqrtf(ss * (1.f / 192.f) + EPS);
    if (lane < 48) { const u32x2 o = {pkbf(x0 * rs * w[0], x1 * rs * w[1]), pkbf(x2 * rs * w[2], x3 * rs * w[3])}; *(u32x2*)(p + 4 * lane) = o; }
}
__device__ __forceinline__ void qkprep_phase(Frame& F, int half) {
    bf16* P = (bf16*)(F.ws + WS_BIG);
    const int gw = F.bid * NWAVES + F.wave, NGW = F.G * NWAVES, lane = F.lane, sub = lane & 7;
    float wq[8], wk[8], wmq[4], wmk[4];
#pragma unroll
    for (int j = 0; j < 8; ++j) { wq[j] = F.in[I_DQNW][8 * sub + j]; wk[j] = F.in[I_DKNW][8 * sub + j]; }
#pragma unroll
    for (int j = 0; j < 4; ++j) { wmq[j] = F.in[I_MQNW][(4 * lane + j) % 192]; wmk[j] = F.in[I_MKNW][(4 * lane + j) % 192]; }
    const float inv = __expf(-logf(500000.0f) * (2.0f / 16.0f) * (float)sub);
    for (int r0 = gw; r0 < HT; r0 += 2 * NGW) {
        bf16* rowp[2]; u32x4 v[2][3]; u32x2 m[2][4]; int pos[2];
#pragma unroll
        for (int u = 0; u < 2; ++u) { const int r = (r0 + u * NGW < HT) ? r0 + u * NGW : r0; rowp[u] = P + (size_t)r * NPROJ; pos[u] = F.positions[half * HT + r];
#pragma unroll
            for (int blk = 0; blk < 3; ++blk) v[u][blk] = *(const u32x4*)(rowp[u] + PC_DQ + blk * 512 + 8 * lane);
#pragma unroll
            for (int h = 0; h < 4; ++h) { m[u][h] = (u32x2){0u, 0u}; if (lane < 48) m[u][h] = *(const u32x2*)(rowp[u] + PC_MQ + h * 192 + 4 * lane); } }
#pragma unroll
        for (int u = 0; u < 2; ++u) {
            if (u == 1 && r0 + NGW >= HT) break;
            const double rev = (double)((float)pos[u] * inv) * 0.15915494309189535;
            const float fr = (float)(rev - floor(rev));
            const float cs = __builtin_amdgcn_cosf(fr), sn = __builtin_amdgcn_sinf(fr);
            float cj[8], sj[8];
#pragma unroll
            for (int j = 0; j < 8; ++j) { cj[j] = __shfl(cs, (lane & ~7) | j); sj[j] = __shfl(sn, (lane & ~7) | j); }
            bf16* row = rowp[u];
#pragma unroll
            for (int blk = 0; blk < 3; ++blk) {
                float x[8] = {bflo(v[u][blk].x), bfhi(v[u][blk].x), bflo(v[u][blk].y), bfhi(v[u][blk].y), bflo(v[u][blk].z), bfhi(v[u][blk].z), bflo(v[u][blk].w), bfhi(v[u][blk].w)};
                float ss = 0.f;
#pragma unroll
                for (int j = 0; j < 8; ++j) ss += x[j] * x[j];
                ss += __shfl_xor(ss, 1); ss += __shfl_xor(ss, 2); ss += __shfl_xor(ss, 4);
                const float rs = 1.0f / sqrtf(ss * (1.f / 64.f) + EPS);
                const bool isq = (8 * blk + (lane >> 3)) < 12;
#pragma unroll
                for (int j = 0; j < 8; ++j) x[j] = x[j] * rs * (isq ? wq[j] : wk[j]);
#pragma unroll
                for (int j = 0; j < 8; ++j) { const float o = __shfl_xor(x[j], 1);
                    if (sub == 0) x[j] = x[j] * cj[j] - o * sj[j]; else if (sub == 1) x[j] = x[j] * cj[j] + o * sj[j]; }
                const u32x4 w = {pkbf(x[0], x[1]), pkbf(x[2], x[3]), pkbf(x[4], x[5]), pkbf(x[6], x[7])};
                *(u32x4*)(row + PC_DQ + blk * 512 + 8 * lane) = w;
            }
#pragma unroll
            for (int h = 0; h < 4; ++h) { const u32x2 q = m[u][h]; const float x0 = bflo(q.x), x1 = bfhi(q.x), x2 = bflo(q.y), x3 = bfhi(q.y);
                const float ss = wave_sum((x0 * x0 + x1 * x1) + (x2 * x2 + x3 * x3));
                const float rs = 1.0f / sqrtf(ss * (1.f / 192.f) + EPS);
                if (lane < 48) { const u32x2 o = {pkbf(x0 * rs * wmq[0], x1 * rs * wmq[1]), pkbf(x2 * rs * wmq[2], x3 * rs * wmq[3])}; *(u32x2*)(row + PC_MQ + h * 192 + 4 * lane) = o; } }
        }
    }
    if (half == 0) {
        bf16* MK = (bf16*)(F.ws + WS_MKV);
        for (int r = gw; r < NB * NMEM * 4; r += NGW) norm192_inplace(MK + (size_t)(r >> 2) * 1536 + (r & 3) * 192, wmk, lane);
    }
}

constexpr int SC_ST = 272, SX_ST = 528;
__device__ __forceinline__ float bfsel(const u32x4& v, int j) { const unsigned w = v[j >> 1]; return (j & 1) ? bfhi(w) : bflo(w); }
__device__ __forceinline__ void conv_task(const bf16* P, size_t rowb, int t0, int pcol, const float* cw, const float* cb, int ccol, LAS unsigned char* dst, int stride, const LAS float* scale) {
    float w[4][8], bs[8];
#pragma unroll
    for (int k = 0; k < 4; ++k) { const f32x4 a = *(const f32x4*)(cw + k * 2048 + ccol), b = *(const f32x4*)(cw + k * 2048 + ccol + 4);
        w[k][0] = a.x; w[k][1] = a.y; w[k][2] = a.z; w[k][3] = a.w; w[k][4] = b.x; w[k][5] = b.y; w[k][6] = b.z; w[k][7] = b.w; }
    { const f32x4 a = *(const f32x4*)(cb + ccol), b = *(const f32x4*)(cb + ccol + 4); bs[0] = a.x; bs[1] = a.y; bs[2] = a.z; bs[3] = a.w; bs[4] = b.x; bs[5] = b.y; bs[6] = b.z; bs[7] = b.w; }
    const bf16* src = P + (rowb + t0) * NPROJ + pcol;
    u32x4 rw[19];
#pragma unroll
    for (int i = 0; i < 3; ++i) rw[i] = (u32x4){0u, 0u, 0u, 0u};
    if (t0 > 0) {
#pragma unroll
        for (int i = 0; i < 3; ++i) rw[i] = *(const u32x4*)(src + (ptrdiff_t)(i - 3) * NPROJ); }
#pragma unroll
    for (int i = 0; i < 16; ++i) rw[3 + i] = *(const u32x4*)(src + (size_t)i * NPROJ);
#pragma unroll
    for (int i = 0; i < 16; ++i) {
        float o[8];
#pragma unroll
        for (int j = 0; j < 8; ++j) { float a = bs[j] + w[0][j] * bfsel(rw[i], j) + w[1][j] * bfsel(rw[i + 1], j) + w[2][j] * bfsel(rw[i + 2], j) + w[3][j] * bfsel(rw[i + 3], j); o[j] = a * sigmoidf_(a); }
        if (scale) { const float sv = scale[i];
#pragma unroll
            for (int j = 0; j < 8; ++j) o[j] *= sv; }
        const u32x4 r = {pkbf(o[0], o[1]), pkbf(o[2], o[3]), pkbf(o[4], o[5]), pkbf(o[6], o[7])};
        *(LAS u32x4*)(dst + i * stride) = r;
    }
}
__device__ __forceinline__ float ssd_scan(Frame& F, const float* DTp, size_t tok0, int g, LAS float* sAc, LAS float* sDt) {
    float total = 0.f;
    if (F.wave < 4) {
        const int head = 4 * g + F.wave, lane = F.lane;
        const float A = -__expf(F.in[I_ALOG][head]);
        const float d0 = DTp[(tok0 + 2 * lane) * 16 + head], d1 = DTp[(tok0 + 2 * lane + 1) * 16 + head];
        const float a0 = d0 * A, a1 = d1 * A;
        float sc = a0 + a1;
#pragma unroll
        for (int o = 1; o < 64; o <<= 1) { const float v = __shfl_up(sc, o); if (lane >= o) sc += v; }
        sAc[F.wave * 128 + 2 * lane] = sc - a1; sAc[F.wave * 128 + 2 * lane + 1] = sc;
        sDt[F.wave * 128 + 2 * lane] = d0; sDt[F.wave * 128 + 2 * lane + 1] = d1;
        total = __shfl(sc, 63);
    }
    return total;
}
__device__ __forceinline__ bf16x8 tr_pair(unsigned a_lo, unsigned a_hi) {
    s16x4 lo, hi;
    asm volatile("ds_read_b64_tr_b16 %0, %2\n\tds_read_b64_tr_b16 %1, %3\n\ts_waitcnt lgkmcnt(0)" : "=&v"(lo), "=&v"(hi) : "v"(a_lo), "v"(a_hi) : "memory");
    const bf16x8 r = {lo[0], lo[1], lo[2], lo[3], hi[0], hi[1], hi[2], hi[3]}; return r;
}

__device__ __forceinline__ void ssdC_phase(Frame& F, int half) {
    const bf16* P = (const bf16*)(F.ws + WS_BIG);
    const float* DTp = (const float*)(F.ws + WS_DT);
    float* SST = (float*)(F.ws + WS_SST); float* DEC = (float*)(F.ws + WS_DEC);
    LAS unsigned char* sX = F.lds; LAS unsigned char* sB = F.lds + 128 * SX_ST;
    LAS float* sAc = (LAS float*)(F.lds + 128 * SX_ST + 128 * SC_ST); LAS float* sDt = sAc + 512; LAS float* sW = sDt + 512;
    const int wave = F.wave;
    for (int unit = F.bid; unit < HB * 64 * 4; unit += F.G) {
        int tid = F.tid; asm volatile("" : "+v"(tid));
        const int lane = tid & 63, ql = lane & 31, h = lane >> 5, tq = (lane & 15) >> 2, tp = lane & 3, tblk = (lane >> 4) & 1;
        const int bl = unit >> 8, c = (unit >> 2) & 63, g = unit & 3;
        const size_t rowb = (size_t)bl * SEQ, tok0 = (size_t)half * HT + rowb + c * 128;
        __syncthreads();
        const float total = ssd_scan(F, DTp, tok0, g, sAc, sDt);
        if (wave < 4) { sW[wave * 128 + 2 * lane] = __expf(total - sAc[wave * 128 + 2 * lane]) * sDt[wave * 128 + 2 * lane];
            sW[wave * 128 + 2 * lane + 1] = __expf(total - sAc[wave * 128 + 2 * lane + 1]) * sDt[wave * 128 + 2 * lane + 1];
            if (lane == 0) DEC[((size_t)bl * 64 + c) * 16 + 4 * g + wave] = __expf(total); }
        __syncthreads();
        if (tid < 384) {
            int ch, strip, ccol, stride; LAS unsigned char* dst; const LAS float* scl = nullptr;
            if (tid < 256) { ch = tid & 31; strip = tid >> 5; ccol = g * 256 + 8 * ch; stride = SX_ST; dst = sX + (strip * 16) * SX_ST + ch * 16; scl = sW + (ch >> 3) * 128 + strip * 16; }
            else { const int u = tid - 256; ch = u & 15; strip = u >> 4; ccol = 1024 + g * 128 + 8 * ch; stride = SC_ST; dst = sB + (strip * 16) * SC_ST + ch * 16; }
            conv_task(P, rowb, c * 128 + strip * 16, PC_X + ccol, F.in[I_CONVW], F.in[I_CONVB], ccol, dst, stride, scl);
        }
        __syncthreads();
        const int r = wave >> 1, pt = wave & 1;
        f32x16 acc[4];
#pragma unroll
        for (int nt = 0; nt < 4; ++nt)
#pragma unroll
            for (int e = 0; e < 16; ++e) acc[nt][e] = 0.f;
        const unsigned xa = (unsigned)(size_t)sX + (unsigned)((8 * h + tq) * SX_ST + (r * 64 + 32 * pt + 16 * tblk + 4 * tp) * 2);
        const unsigned ba = (unsigned)(size_t)sB + (unsigned)((8 * h + tq) * SC_ST + (16 * tblk + 4 * tp) * 2);
#pragma unroll
        for (int ks = 0; ks < 8; ++ks) {
            const bf16x8 af = tr_pair(xa + ks * 16 * SX_ST, xa + ks * 16 * SX_ST + 4 * SX_ST);
            bf16x8 bfr[4];
#pragma unroll
            for (int nt = 0; nt < 4; ++nt) bfr[nt] = tr_pair(ba + ks * 16 * SC_ST + nt * 64, ba + ks * 16 * SC_ST + 4 * SC_ST + nt * 64);
            __builtin_amdgcn_sched_barrier(0);
#pragma unroll
            for (int nt = 0; nt < 4; ++nt) acc[nt] = MFMA32(af, bfr[nt], acc[nt]);
        }
        float* out = SST + (((size_t)bl * 64 + c) * 16 + 4 * g + r) * 8192;
#pragma unroll
        for (int nt = 0; nt < 4; ++nt)
#pragma unroll
            for (int e = 0; e < 16; ++e) out[(32 * pt + (e & 3) + 8 * (e >> 2) + 4 * h) * 128 + 32 * nt + ql] = acc[nt][e];
    }
}

__device__ __forceinline__ void ssdD_phase(Frame& F) {
    const float* SST = (const float*)(F.ws + WS_SST); const float* DEC = (const float*)(F.ws + WS_DEC);
    bf16* SIN = (bf16*)(F.ws + WS_SIN);
    const size_t gtid = (size_t)F.bid * NTHR + F.tid, gth = (size_t)F.G * NTHR;
    for (size_t it = gtid; it < (size_t)HB * 16 * 2048; it += gth) {
        const int bl = (int)(it >> 15), head = (int)(it >> 11) & 15, e4 = (int)(it & 2047) * 4;
        f32x4 st = {0.f, 0.f, 0.f, 0.f};
#pragma unroll 8
        for (int c = 0; c < 64; ++c) {
            const size_t idx = (((size_t)bl * 64 + c) * 16 + head);
            const u32x2 o = {pkbf(st.x, st.y), pkbf(st.z, st.w)};
            *(u32x2*)(SIN + idx * 8192 + e4) = o;
            const f32x4 sl = *(const f32x4*)(SST + idx * 8192 + e4); const float d = DEC[idx];
            st = st * d + sl;
        }
    }
}

__device__ __forceinline__ void ssdE_phase(Frame& F, int half) {
    const bf16* P = (const bf16*)(F.ws + WS_BIG);
    const float* DTp = (const float*)(F.ws + WS_DT);
    const bf16* SIN = (const bf16*)(F.ws + WS_SIN);
    bf16* Y = (bf16*)F.out;
    LAS unsigned char* sX = F.lds; LAS unsigned char* sB = F.lds + 128 * SX_ST; LAS unsigned char* sC = sB + 128 * SC_ST;
    LAS float* sAc = (LAS float*)(sC + 128 * SC_ST); LAS float* sDt = sAc + 512; LAS float* sSS = sDt + 512;
    const int wave = F.wave;
    const int st = wave & 3, hp = wave >> 2;
    for (int unit = F.bid; unit < HB * 64 * 4; unit += F.G) {
        int tid = F.tid; asm volatile("" : "+v"(tid));
        const int lane = tid & 63, ql = lane & 31, h = lane >> 5, tq = (lane & 15) >> 2, tp = lane & 3, tblk = (lane >> 4) & 1;
        const int bl = unit >> 8, c = (unit >> 2) & 63, g = unit & 3;
        const size_t rowb = (size_t)bl * SEQ, tok0 = (size_t)half * HT + rowb + c * 128;
        __syncthreads();
        (void)ssd_scan(F, DTp, tok0, g, sAc, sDt);
        if (tid < 128) sSS[tid] = 0.f;
        {
            int ch, strip, ccol, stride; LAS unsigned char* dst;
            if (tid < 256) { ch = tid & 31; strip = tid >> 5; ccol = g * 256 + 8 * ch; stride = SX_ST; dst = sX + (strip * 16) * SX_ST + ch * 16; }
            else if (tid < 384) { const int u = tid - 256; ch = u & 15; strip = u >> 4; ccol = 1024 + g * 128 + 8 * ch; stride = SC_ST; dst = sB + (strip * 16) * SC_ST + ch * 16; }
            else { const int u = tid - 384; ch = u & 15; strip = u >> 4; ccol = 1536 + g * 128 + 8 * ch; stride = SC_ST; dst = sC + (strip * 16) * SC_ST + ch * 16; }
            conv_task(P, rowb, c * 128 + strip * 16, PC_X + ccol, F.in[I_CONVW], F.in[I_CONVB], ccol, dst, stride, nullptr);
        }
        __syncthreads();
        const int s = 32 * st + ql;
        unsigned yk[2][2][8];
        float ssq = 0.f;
        const unsigned xa = (unsigned)(size_t)sX + (unsigned)((4 * h + tq) * SX_ST + (16 * tblk + 4 * tp) * 2);
#pragma unroll
        for (int hq = 0; hq < 2; ++hq) {
            const int r = 2 * hp + hq, head = 4 * g + r;
            const float acs = sAc[r * 128 + s];
            const bf16* stp = SIN + (((size_t)bl * 64 + c) * 16 + head) * 8192 + ql * 128 + 8 * h;
            bf16x8 sfr[2][8];
#pragma unroll
            for (int pt = 0; pt < 2; ++pt)
#pragma unroll
                for (int ks = 0; ks < 8; ++ks) sfr[pt][ks] = *(const bf16x8*)(stp + pt * 4096 + 16 * ks);
            bf16x8 pf[4][2];
#pragma unroll
            for (int i = 0; i < 4; ++i) {
                f32x16 Xi;
#pragma unroll
                for (int e = 0; e < 16; ++e) Xi[e] = 0.f;
#pragma unroll
                for (int ks = 0; ks < 8; ++ks) { const bf16x8 bf_ = *(const LAS bf16x8*)(sB + (32 * i + ql) * SC_ST + 32 * ks + 16 * h);
                    const bf16x8 cf = *(const LAS bf16x8*)(sC + s * SC_ST + 32 * ks + 16 * h); Xi = MFMA32(bf_, cf, Xi); }
                float p[16];
#pragma unroll
                for (int q4 = 0; q4 < 4; ++q4) { const int t0 = 32 * i + 8 * q4 + 4 * h;
                    const f32x4 at = *(const LAS f32x4*)(sAc + r * 128 + t0), dt4 = *(const LAS f32x4*)(sDt + r * 128 + t0);
#pragma unroll
                    for (int e = 0; e < 4; ++e) { const int t = t0 + e; p[4 * q4 + e] = (t <= s) ? Xi[4 * q4 + e] * __expf(acs - at[e]) * dt4[e] : 0.f; } }
#pragma unroll
                for (int s2 = 0; s2 < 2; ++s2) { const u32x4 w = {pkbf(p[8 * s2 + 0], p[8 * s2 + 1]), pkbf(p[8 * s2 + 2], p[8 * s2 + 3]), pkbf(p[8 * s2 + 4], p[8 * s2 + 5]), pkbf(p[8 * s2 + 6], p[8 * s2 + 7])};
                    pf[i][s2] = __builtin_bit_cast(bf16x8, w); }
            }
            const float eacs = __expf(acs), Dh = F.in[I_SSDD][head];
#pragma unroll
            for (int pt = 0; pt < 2; ++pt) {
                f32x16 yd, yo;
#pragma unroll
                for (int e = 0; e < 16; ++e) { yd[e] = 0.f; yo[e] = 0.f; }
#pragma unroll
                for (int i = 0; i < 4; ++i) {
#pragma unroll
                    for (int s2 = 0; s2 < 2; ++s2) { const unsigned a = xa + (unsigned)((32 * i + 16 * s2) * SX_ST + (r * 64 + 32 * pt) * 2);
                        const bf16x8 xf = tr_pair(a, a + 8 * SX_ST); __builtin_amdgcn_sched_barrier(0); yd = MFMA32(xf, pf[i][s2], yd); }
                }
#pragma unroll
                for (int ks = 0; ks < 8; ++ks) { const bf16x8 cf = *(const LAS bf16x8*)(sC + s * SC_ST + 32 * ks + 16 * h); yo = MFMA32(sfr[pt][ks], cf, yo); }
                const bf16* zp = P + (rowb + c * 128 + s) * NPROJ + PC_Z + g * 256 + r * 64 + 32 * pt + 4 * h;
                u32x2 zv[4];
#pragma unroll
                for (int q4 = 0; q4 < 4; ++q4) zv[q4] = *(const u32x2*)(zp + 8 * q4);
#pragma unroll
                for (int q4 = 0; q4 < 4; ++q4) {
                    const u32x2 xv = *(const LAS u32x2*)(sX + s * SX_ST + (r * 64 + 32 * pt + 8 * q4 + 4 * h) * 2);
                    const u32x2 zq = zv[q4];
                    const float xs_[4] = {bflo(xv.x), bfhi(xv.x), bflo(xv.y), bfhi(xv.y)}, zs_[4] = {bflo(zq.x), bfhi(zq.x), bflo(zq.y), bfhi(zq.y)};
                    float yv[4];
#pragma unroll
                    for (int e = 0; e < 4; ++e) { float y = yd[4 * q4 + e] + eacs * yo[4 * q4 + e] + Dh * xs_[e]; y = y * zs_[e] * sigmoidf_(zs_[e]); yv[e] = y; ssq += y * y; }
                    yk[hq][pt][2 * q4] = pkbf(yv[0], yv[1]); yk[hq][pt][2 * q4 + 1] = pkbf(yv[2], yv[3]);
                }
            }
        }
        ssq += __shfl_xor(ssq, 32);
        if (h == 0) __hip_atomic_fetch_add(sSS + s, ssq, __ATOMIC_RELAXED, __HIP_MEMORY_SCOPE_WORKGROUP);
        __syncthreads();
        const float rs = 1.0f / sqrtf(sSS[s] * (1.f / 256.f) + EPS);
        bf16* yp = Y + (tok0 + s) * YC + g * 256 + 4 * h;
        const float* nw = F.in[I_SSDNW] + g * 256 + 4 * h;
#pragma unroll
        for (int hq = 0; hq < 2; ++hq)
#pragma unroll
            for (int pt = 0; pt < 2; ++pt)
#pragma unroll
                for (int q4 = 0; q4 < 4; ++q4) { const int cc = (2 * hp + hq) * 64 + 32 * pt + 8 * q4; const f32x4 w4 = *(const f32x4*)(nw + cc);
                    const unsigned ya = yk[hq][pt][2 * q4], yb = yk[hq][pt][2 * q4 + 1];
                    const u32x2 o = {pkbf(bflo(ya) * rs * w4.x, bfhi(ya) * rs * w4.y), pkbf(bflo(yb) * rs * w4.z, bfhi(yb) * rs * w4.w)};
                    *(u32x2*)(yp + cc) = o; }
    }
}

__device__ __forceinline__ bf16x8 mk_bf16x8(u32x2 lo, u32x2 hi) { const u32x4 v = {lo.x, lo.y, hi.x, hi.y}; return __builtin_bit_cast(bf16x8, v); }

__device__ __forceinline__ void memattn_mfma_phase(Frame& F, int half) {
    const bf16* P = (const bf16*)(F.ws + WS_BIG);
    const bf16* MKV = (const bf16*)(F.ws + WS_MKV);
    const bf16* MVT = (const bf16*)(F.ws + WS_MVT);
    bf16* Y = (bf16*)F.out;
    LAS unsigned char* sm = F.lds;
    const int tid = F.tid, lane = F.lane, wave = F.wave, ql = lane & 31, h = lane >> 5;
    constexpr int KST = 400, VST = 528;
    for (int unit = F.bid; unit < HB * 4 * 32; unit += F.G) {
        const int bl = unit >> 7, head = (unit >> 5) & 3, qt = unit & 31, b = half * HB + bl;
        const int r = bl * SEQ + qt * 256 + wave * 32 + ql;
        __syncthreads();
        for (int c = tid; c < 256 * 24; c += NTHR) { const int row = c / 24, ch = c % 24;
            *(LAS u32x4*)(sm + row * KST + ch * 16) = *(const u32x4*)(MKV + (size_t)(b * NMEM + row) * 1536 + head * 192 + ch * 8); }
        bf16x8 qf[12];
        { const bf16* qp = P + (size_t)r * NPROJ + PC_MQ + head * 192 + 8 * h;
#pragma unroll
          for (int ks = 0; ks < 12; ++ks) qf[ks] = *(const bf16x8*)(qp + 16 * ks); }
        __syncthreads();
        f32x16 sacc[8];
#pragma unroll
        for (int mt = 0; mt < 8; ++mt) {
#pragma unroll
            for (int i = 0; i < 16; ++i) sacc[mt][i] = 0.f;
#pragma unroll
            for (int ks = 0; ks < 12; ++ks) { const bf16x8 kf = *(const LAS bf16x8*)(sm + (32 * mt + ql) * KST + 32 * ks + 16 * h); sacc[mt] = MFMA32(kf, qf[ks], sacc[mt]); }
        }
        float mx = -3.0e38f;
#pragma unroll
        for (int mt = 0; mt < 8; ++mt)
#pragma unroll
            for (int i = 0; i < 16; ++i) mx = fmaxf(mx, sacc[mt][i]);
        mx = fmaxf(mx, __shfl_xor(mx, 32));
        const float sc = 0.07216878364870323f * 1.4426950408889634f;
        float l = 0.f;
        bf16x8 pf[8][2];
#pragma unroll
        for (int mt = 0; mt < 8; ++mt) {
            float p[16];
#pragma unroll
            for (int i = 0; i < 16; ++i) { p[i] = __builtin_amdgcn_exp2f((sacc[mt][i] - mx) * sc); l += p[i]; }
#pragma unroll
            for (int s2 = 0; s2 < 2; ++s2) { const u32x4 w = {pkbf(p[8 * s2 + 0], p[8 * s2 + 1]), pkbf(p[8 * s2 + 2], p[8 * s2 + 3]), pkbf(p[8 * s2 + 4], p[8 * s2 + 5]), pkbf(p[8 * s2 + 6], p[8 * s2 + 7])};
                pf[mt][s2] = __builtin_bit_cast(bf16x8, w); }
        }
        l += __shfl_xor(l, 32);
        __syncthreads();
        for (int c = tid; c < 192 * 32; c += NTHR) { const int row = c >> 5, ch = c & 31;
            *(LAS u32x4*)(sm + row * VST + ch * 16) = *(const u32x4*)(MVT + (size_t)(head * 192 + row) * 2048 + b * NMEM + ch * 8); }
        __syncthreads();
        const float il = 1.0f / l;
        bf16* yp = Y + ((size_t)half * HT + r) * YC + 1280 + head * 192 + 4 * h;
#pragma unroll
        for (int dt = 0; dt < 6; ++dt) {
            f32x16 o;
#pragma unroll
            for (int i = 0; i < 16; ++i) o[i] = 0.f;
#pragma unroll
            for (int mt = 0; mt < 8; ++mt)
#pragma unroll
                for (int s2 = 0; s2 < 2; ++s2) { const LAS unsigned char* vp = sm + (32 * dt + ql) * VST + (32 * mt + 16 * s2 + 4 * h) * 2;
                    const bf16x8 vf = mk_bf16x8(*(const LAS u32x2*)vp, *(const LAS u32x2*)(vp + 16)); o = MFMA32(vf, pf[mt][s2], o); }
#pragma unroll
            for (int g = 0; g < 4; ++g) { const u32x2 w = {pkbf(o[4 * g] * il, o[4 * g + 1] * il), pkbf(o[4 * g + 2] * il, o[4 * g + 3] * il)}; *(u32x2*)(yp + 32 * dt + 8 * g) = w; }
        }
    }
}

__device__ __forceinline__ void dilattn_mfma_phase(Frame& F, int half) {
    bf16* P = (bf16*)(F.ws + WS_BIG);
    float* LSE = (float*)(F.ws + WS_LSE);
    LAS unsigned char* sK = F.lds; LAS unsigned char* sV = F.lds + 384 * 144;
    const int tid = F.tid, lane = F.lane, wave = F.wave, ql = lane & 31, h = lane >> 5;
    constexpr int RST = 144;
    for (int unit = F.bid; unit < HB * 12 * 32; unit += F.G) {
        const int bl = unit / 384, rem = unit % 384, head = rem >> 5, blk = rem & 31;
        const int g = head >> 2, dil = (g == 0) ? 1 : (g == 1 ? 4 : 16), bpr = 32 / dil;
        const int res = blk / bpr, q0 = (blk % bpr) * 256;
        const size_t rowb = (size_t)bl * SEQ;
        __syncthreads();
        for (int c = tid; c < 384 * 8; c += NTHR) { const int row = c >> 3, ch = c & 7; const int ks = q0 - 128 + row;
            u32x4 kv = {0u, 0u, 0u, 0u}, vv = {0u, 0u, 0u, 0u};
            if (ks >= 0) { const bf16* src = P + (rowb + (size_t)ks * dil + res) * NPROJ + head * 64 + ch * 8; kv = *(const u32x4*)(src + PC_DK); vv = *(const u32x4*)(src + PC_DV); }
            *(LAS u32x4*)(sK + row * RST + ch * 16) = kv; *(LAS u32x4*)(sV + row * RST + ch * 16) = vv; }
        const int qs = q0 + wave * 32 + ql;
        const size_t rq = rowb + (size_t)qs * dil + res;
        bf16* qp = P + rq * NPROJ + PC_DQ + head * 64;
        bf16x8 qf[4];
#pragma unroll
        for (int ks = 0; ks < 4; ++ks) qf[ks] = *(const bf16x8*)(qp + 16 * ks + 8 * h);
        __syncthreads();
        f32x16 sacc[5];
        const int kfirst = q0 + wave * 32 - 128;
#pragma unroll
        for (int i = 0; i < 5; ++i) {
#pragma unroll
            for (int e = 0; e < 16; ++e) sacc[i][e] = 0.f;
#pragma unroll
            for (int ks = 0; ks < 4; ++ks) { const bf16x8 kf = *(const LAS bf16x8*)(sK + (32 * wave + 32 * i + ql) * RST + 32 * ks + 16 * h); sacc[i] = MFMA32(kf, qf[ks], sacc[i]); }
        }
        float mx = -3.0e38f;
#pragma unroll
        for (int i = 0; i < 5; ++i)
#pragma unroll
            for (int e = 0; e < 16; ++e) { const int kj = 32 * i + (e & 3) + 8 * (e >> 2) + 4 * h; const bool ok = (kj >= ql) && (kj <= ql + 128) && (kfirst + kj >= 0);
                sacc[i][e] = ok ? sacc[i][e] : -3.0e38f; mx = fmaxf(mx, sacc[i][e]); }
        mx = fmaxf(mx, __shfl_xor(mx, 32));
        const float sc = 0.125f * 1.4426950408889634f;
        float l = 0.f;
        bf16x8 pf[5][2];
#pragma unroll
        for (int i = 0; i < 5; ++i) {
            float p[16];
#pragma unroll
            for (int e = 0; e < 16; ++e) { p[e] = (sacc[i][e] > -1.0e38f) ? __builtin_amdgcn_exp2f((sacc[i][e] - mx) * sc) : 0.f; l += p[e]; }
#pragma unroll
            for (int s2 = 0; s2 < 2; ++s2) { const u32x4 w = {pkbf(p[8 * s2 + 0], p[8 * s2 + 1]), pkbf(p[8 * s2 + 2], p[8 * s2 + 3]), pkbf(p[8 * s2 + 4], p[8 * s2 + 5]), pkbf(p[8 * s2 + 6], p[8 * s2 + 7])};
                pf[i][s2] = __builtin_bit_cast(bf16x8, w); }
        }
        l += __shfl_xor(l, 32);
        const float il = 1.0f / l;
        const int tq = (lane & 15) >> 2, tp = lane & 3, tblk = (lane >> 4) & 1;
        const unsigned vbase = (unsigned)(size_t)(sV) + (unsigned)((32 * wave + 4 * h + tq) * RST + (16 * tblk + 4 * tp) * 2);
#pragma unroll
        for (int dt = 0; dt < 2; ++dt) {
            f32x16 o;
#pragma unroll
            for (int e = 0; e < 16; ++e) o[e] = 0.f;
#pragma unroll
            for (int i = 0; i < 5; ++i) {
                s16x4 lo[2], hi[2];
#pragma unroll
                for (int s2 = 0; s2 < 2; ++s2) { const unsigned a = vbase + (unsigned)((32 * i + 16 * s2) * RST + 64 * dt);
                    asm volatile("ds_read_b64_tr_b16 %0, %1" : "=&v"(lo[s2]) : "v"(a) : "memory");
                    asm volatile("ds_read_b64_tr_b16 %0, %1 offset:1152" : "=&v"(hi[s2]) : "v"(a) : "memory"); }
                asm volatile("s_waitcnt lgkmcnt(0)" ::: "memory"); __builtin_amdgcn_sched_barrier(0);
#pragma unroll
                for (int s2 = 0; s2 < 2; ++s2) { const bf16x8 vf = {lo[s2][0], lo[s2][1], lo[s2][2], lo[s2][3], hi[s2][0], hi[s2][1], hi[s2][2], hi[s2][3]}; o = MFMA32(vf, pf[i][s2], o); }
            }
#pragma unroll
            for (int gq = 0; gq < 4; ++gq) { const u32x2 w = {pkbf(o[4 * gq] * il, o[4 * gq + 1] * il), pkbf(o[4 * gq + 2] * il, o[4 * gq + 3] * il)}; *(u32x2*)(qp + 32 * dt + 8 * gq + 4 * h) = w; }
        }
        if (h == 0) LSE[((size_t)half * HT + rq) * 12 + head] = mx * 0.125f + __logf(l);
    }
}

__device__ __forceinline__ void dilmerge_phase(Frame& F, int half) {
    const bf16* P = (const bf16*)(F.ws + WS_BIG);
    const float* LSE = (const float*)(F.ws + WS_LSE);
    bf16* Y = (bf16*)F.out;
    const size_t gtid = (size_t)F.bid * NTHR + F.tid, gth = (size_t)F.G * NTHR;
    for (size_t it = gtid; it < (size_t)HT * 32; it += gth) {
        const size_t r = it >> 5; const int hh = (int)(it >> 3) & 3, d0 = (int)(it & 7) * 8;
        const size_t tok = (size_t)half * HT + r;
        const float l0 = LSE[tok * 12 + hh], l1 = LSE[tok * 12 + 4 + hh], l2 = LSE[tok * 12 + 8 + hh];
        const float m = fmaxf(l0, fmaxf(l1, l2));
        float w0 = __expf(l0 - m), w1 = __expf(l1 - m), w2 = __expf(l2 - m); const float iw = 1.0f / (w0 + w1 + w2); w0 *= iw; w1 *= iw; w2 *= iw;
        const bf16* op = P + r * NPROJ + PC_DQ + hh * 64 + d0;
        const u32x4 a = *(const u32x4*)op, b = *(const u32x4*)(op + 256), c = *(const u32x4*)(op + 512);
        u32x4 o;
        o.x = pkbf(w0 * bflo(a.x) + w1 * bflo(b.x) + w2 * bflo(c.x), w0 * bfhi(a.x) + w1 * bfhi(b.x) + w2 * bfhi(c.x));
        o.y = pkbf(w0 * bflo(a.y) + w1 * bflo(b.y) + w2 * bflo(c.y), w0 * bfhi(a.y) + w1 * bfhi(b.y) + w2 * bfhi(c.y));
        o.z = pkbf(w0 * bflo(a.z) + w1 * bflo(b.z) + w2 * bflo(c.z), w0 * bfhi(a.z) + w1 * bfhi(b.z) + w2 * bfhi(c.z));
        o.w = pkbf(w0 * bflo(a.w) + w1 * bflo(b.w) + w2 * bflo(c.w), w0 * bfhi(a.w) + w1 * bfhi(b.w) + w2 * bfhi(c.w));
        *(u32x4*)(Y + tok * YC + 1024 + hh * 64 + d0) = o;
    }
}

__device__ __forceinline__ void hn_phase(Frame& F) {
    const int gw = F.bid * NWAVES + F.wave, NGW = F.G * NWAVES;
    for (int m = gw; m < T; m += NGW) { f32x4 v[4]; rms_row_to_bf16(F.out + (size_t)m * DM, F.in[I_NFFNW], (bf16*)(F.ws + WS_ACT1) + (size_t)m * DM, F.lane, v); }
}


__device__ __forceinline__ float gelu_erf(float x) { return 0.5f * x * (1.0f + erff(x * 0.70710678118654752f)); }
__device__ __forceinline__ unsigned f2ord(float f) { const unsigned u = __builtin_bit_cast(unsigned, f); return u ^ ((unsigned)((int)u >> 31) | 0x80000000u); }
__device__ __forceinline__ float ord2f(unsigned k) { const unsigned m = (unsigned)((int)k >> 31); return __builtin_bit_cast(float, k ^ (0x80000000u | ~m)); }
#define CMPX(a, b) do { const unsigned _mx = max((a), (b)), _mn = min((a), (b)); (a) = _mx; (b) = _mn; } while (0)
__device__ __forceinline__ void bitonic_sort16_desc(unsigned (&v)[16]) {
#pragma unroll
    for (int k = 2; k <= 16; k <<= 1)
#pragma unroll
        for (int j = k >> 1; j > 0; j >>= 1)
#pragma unroll
            for (int i = 0; i < 16; ++i) { const int l = i ^ j; if (l > i) { if ((i & k) == 0) CMPX(v[i], v[l]); else CMPX(v[l], v[i]); } }
}
__device__ __forceinline__ void bitonic_merge16_desc(unsigned (&v)[16]) {
#pragma unroll
    for (int j = 8; j > 0; j >>= 1)
#pragma unroll
        for (int i = 0; i < 16; ++i) { const int l = i ^ j; if (l > i) CMPX(v[i], v[l]); }
}
__device__ __forceinline__ void top16_merge(unsigned (&a)[16], const unsigned (&b)[16]) {
#pragma unroll
    for (int i = 0; i < 16; ++i) a[i] = max(a[i], b[15 - i]);
    bitonic_merge16_desc(a);
}
constexpr int PK_ST = 272;
__device__ __forceinline__ void peer_topk_tile(Frame& F, size_t tok0, int* IDX, float* GATE) {
    const bf16* Q = (const bf16*)(F.ws + WS_BIG);
    const bf16* SK = (const bf16*)(F.ws + WS_SUBK);
    LAS unsigned char* sK = F.lds;
    int tid = F.tid; asm volatile("" : "+v"(tid));
    const int lane = tid & 63, wave = F.wave, ql = lane & 31, hh = lane >> 5;
    const size_t tok = tok0 + wave * 32 + ql;
    const bf16* qrow = Q + tok * PEER_Q + 8 * hh;
    __syncthreads();
#pragma unroll
    for (int j = 0; j < 4; ++j) { const int cidx = tid + 512 * j, row = cidx >> 4, ch = cidx & 15; *(LAS u32x4*)(sK + row * PK_ST + ch * 16) = *(const u32x4*)(SK + (size_t)row * 128 + ch * 8); }
    __syncthreads();
    unsigned k1[16];
#pragma unroll 1
    for (int hc = 0; hc < 16; ++hc) {
        LAS unsigned char* cur = sK + (hc & 1) * (128 * PK_ST); LAS unsigned char* nxt = sK + ((hc + 1) & 1) * (128 * PK_ST);
        u32x4 stg[4];
        const int hcn = (hc + 1) & 15;
#pragma unroll
        for (int j = 0; j < 4; ++j) { const int cidx = tid + 512 * j, row = cidx >> 4, ch = cidx & 15; stg[j] = *(const u32x4*)(SK + ((size_t)hcn * 128 + row) * 128 + ch * 8); }
        bf16x8 qf[8];
#pragma unroll
        for (int ks = 0; ks < 8; ++ks) qf[ks] = *(const bf16x8*)(qrow + hc * 128 + 16 * ks);
        unsigned pk[4][16];
#pragma unroll
        for (int mt = 0; mt < 4; ++mt) {
            f32x16 acc;
#pragma unroll
            for (int e = 0; e < 16; ++e) acc[e] = 0.f;
#pragma unroll
            for (int ks = 0; ks < 8; ++ks) { const bf16x8 kf = *(const LAS bf16x8*)(cur + (32 * mt + ql) * PK_ST + 32 * ks + 16 * hh); acc = MFMA32(kf, qf[ks], acc); }
#pragma unroll
            for (int e = 0; e < 16; ++e) pk[mt][e] = (f2ord(acc[e]) & 0xFFFFFF80u) | (unsigned)(32 * mt + (e & 3) + 8 * (e >> 2) + 4 * hh);
        }
#pragma unroll
        for (int j = 0; j < 4; ++j) { const int cidx = tid + 512 * j, row = cidx >> 4, ch = cidx & 15; *(LAS u32x4*)(nxt + row * PK_ST + ch * 16) = stg[j]; }
        __syncthreads();
#pragma unroll
        for (int mt = 0; mt < 4; ++mt) bitonic_sort16_desc(pk[mt]);
        top16_merge(pk[0], pk[1]); top16_merge(pk[2], pk[3]); top16_merge(pk[0], pk[2]);
        unsigned other[16];
#pragma unroll
        for (int i = 0; i < 16; ++i) other[i] = (unsigned)__shfl_xor((int)pk[0][i], 32);
        top16_merge(pk[0], other);
        if ((hc & 1) == 0) {
#pragma unroll
            for (int i = 0; i < 16; ++i) k1[i] = pk[0][i];
        } else {
            float f1[16], f2[16];
#pragma unroll
            for (int i = 0; i < 16; ++i) { f1[i] = ord2f(k1[i] & 0xFFFFFF80u); f2[i] = ord2f(pk[0][i] & 0xFFFFFF80u); }
            unsigned cd[4][16];
#pragma unroll
            for (int i = 0; i < 64; ++i) cd[i >> 4][i & 15] = 0u;
            int n = 0;
#pragma unroll
            for (int a = 0; a < 16; ++a)
#pragma unroll
                for (int b = 0; b < 16; ++b)
                    if ((a + 1) * (b + 1) <= 16) { cd[n >> 4][n & 15] = (f2ord(f1[a] + f2[b]) & 0xFFFFC000u) | ((k1[a] & 127u) << 7) | (pk[0][b] & 127u); ++n; }
#pragma unroll
            for (int g4 = 0; g4 < 4; ++g4) bitonic_sort16_desc(cd[g4]);
            top16_merge(cd[0], cd[1]); top16_merge(cd[2], cd[3]); top16_merge(cd[0], cd[2]);
            const float vmax = ord2f(cd[0][0] & 0xFFFFC000u);
            float ex[16], den = 0.f;
#pragma unroll
            for (int i = 0; i < 16; ++i) { ex[i] = __expf(ord2f(cd[0][i] & 0xFFFFC000u) - vmax); den += ex[i]; }
            const float iden = 1.0f / den;
            const int h = hc >> 1;
            if (hh == 0) { int* ip = IDX + tok * 128 + h * 16;
#pragma unroll
                for (int i = 0; i < 4; ++i) { const u32x4 w = {cd[0][4 * i] & 0x3FFFu, cd[0][4 * i + 1] & 0x3FFFu, cd[0][4 * i + 2] & 0x3FFFu, cd[0][4 * i + 3] & 0x3FFFu}; *(u32x4*)(ip + 4 * i) = w; } }
            else { float* gp = GATE + tok * 128 + h * 16;
#pragma unroll
                for (int i = 0; i < 4; ++i) { const f32x4 w = {ex[4 * i] * iden, ex[4 * i + 1] * iden, ex[4 * i + 2] * iden, ex[4 * i + 3] * iden}; *(f32x4*)(gp + 4 * i) = w; } }
        }
    }
}

constexpr size_t PEER_OFF_IDX = 256 * MiB, PEER_OFF_GATE = 288 * MiB, PEER_OFF_COEF = 320 * MiB;
struct PeerDeal { size_t tokw; int ntok; };
__device__ __forceinline__ void peer_item(int n, const PeerDeal& D, int wave, int& slice, size_t& tok) { slice = n >> 5; tok = D.tokw + (n & 31); }
__device__ __forceinline__ void peer_down_rows(u32x4 (&R)[16], const unsigned char* PD, int slice, int id0, int id1, int lane) {
    const unsigned char* base = PD + ((size_t)slice * 16384 << 7) + 16 * (lane & 7);
#pragma unroll
    for (int k = 0; k < 16; ++k) { const int id = __shfl(k < 8 ? id0 : id1, (8 * k + (lane >> 3)) & 63); R[k] = *(const u32x4*)(base + ((size_t)id << 7)); }
}
__device__ __forceinline__ void peer_down_park(const u32x4 (&R)[16], LAS unsigned char* sw, int lane) {
    const int e8 = lane >> 3, p = lane & 7;
#pragma unroll
    for (int k = 0; k < 16; ++k) { const int sl_ = 8 * k + e8; *(LAS u32x4*)(sw + sl_ * 128 + 16 * (p ^ ((sl_ >> 1) & 7))) = R[k]; }
}
__device__ __forceinline__ void peer_down_hn(u32x4 (&H)[4], const bf16* HN, int slice, size_t tok, int g) {
    const bf16* hp = HN + tok * DM + slice * 128 + 16 * g;
    H[0] = *(const u32x4*)hp; H[1] = *(const u32x4*)(hp + 8); H[2] = *(const u32x4*)(hp + 64); H[3] = *(const u32x4*)(hp + 72);
}
__device__ __forceinline__ void peer_down_compute(const LAS unsigned char* sw, const u32x4 (&H)[4], __amdgpu_buffer_rsrc_t prsrc, int slice, size_t tok, int lane) {
    const int g = lane >> 4, r = lane & 15;
    long bq[4];
#pragma unroll
    for (int h2 = 0; h2 < 2; ++h2) { const u32x4 x0 = H[2 * h2], x1 = H[2 * h2 + 1];
        unsigned p0 = __builtin_amdgcn_cvt_pk_fp8_f32(bflo(x0.x), bfhi(x0.x), 0, false); p0 = __builtin_amdgcn_cvt_pk_fp8_f32(bflo(x0.y), bfhi(x0.y), p0, true);
        unsigned p1 = __builtin_amdgcn_cvt_pk_fp8_f32(bflo(x0.z), bfhi(x0.z), 0, false); p1 = __builtin_amdgcn_cvt_pk_fp8_f32(bflo(x0.w), bfhi(x0.w), p1, true);
        unsigned p2 = __builtin_amdgcn_cvt_pk_fp8_f32(bflo(x1.x), bfhi(x1.x), 0, false); p2 = __builtin_amdgcn_cvt_pk_fp8_f32(bflo(x1.y), bfhi(x1.y), p2, true);
        unsigned p3 = __builtin_amdgcn_cvt_pk_fp8_f32(bflo(x1.z), bfhi(x1.z), 0, false); p3 = __builtin_amdgcn_cvt_pk_fp8_f32(bflo(x1.w), bfhi(x1.w), p3, true);
        bq[2 * h2] = (long)(((unsigned long long)p1 << 32) | p0); bq[2 * h2 + 1] = (long)(((unsigned long long)p3 << 32) | p2); }
    const unsigned off = ((lane & 15) == 0) ? (unsigned)((((size_t)slice * T + tok) * 128 + 4 * g) * 4) : 0xFFFFFF00u;
#pragma unroll
    for (int t8 = 0; t8 < 8; ++t8) { f32x4 acc = {0.f, 0.f, 0.f, 0.f}; const int sl_ = 16 * t8 + r; const LAS unsigned char* rp = sw + sl_ * 128; const int sx = (sl_ >> 1) & 7;
#pragma unroll
        for (int h2 = 0; h2 < 2; ++h2) { const u32x4 v = *(const LAS u32x4*)(rp + 16 * ((4 * h2 + g) ^ sx));
            acc = __builtin_amdgcn_mfma_f32_16x16x32_fp8_fp8((long)(((unsigned long long)v.y << 32) | v.x), bq[2 * h2], acc, 0, 0, 0);
            acc = __builtin_amdgcn_mfma_f32_16x16x32_fp8_fp8((long)(((unsigned long long)v.w << 32) | v.z), bq[2 * h2 + 1], acc, 0, 0, 0); }
        __builtin_amdgcn_raw_buffer_store_b128(__builtin_bit_cast(u32x4, acc), prsrc, off, 64 * t8, 0); }
}
__device__ __forceinline__ void peer_down_phase(Frame& F, const PeerDeal& D) {
    const unsigned char* PD = F.ws + WS_PD; const bf16* HN = (const bf16*)(F.ws + WS_ACT1);
    const int* IDX = (const int*)(F.ws + WS_BIG + PEER_OFF_IDX);
    const __amdgpu_buffer_rsrc_t prsrc = __builtin_amdgcn_make_buffer_rsrc((void*)(F.ws + WS_BIG), 0, 8 * T * 128 * 4, 0x00020000);
    int lane = F.lane; asm volatile("" : "+v"(lane));
    const int g = lane >> 4, wave = F.wave;
    LAS unsigned char* sw = F.lds + wave * 16384;
    const int ntok = D.ntok;
    int sl; size_t tk;
    u32x4 R[16], H0[4], H1[4]; int id0, id1;
    { int s1_; size_t t1_; peer_item(0, D, wave, sl, tk); peer_item(1, D, wave, s1_, t1_);
      const int a0 = IDX[tk * 128 + lane], a1 = IDX[tk * 128 + 64 + lane]; id0 = IDX[t1_ * 128 + lane]; id1 = IDX[t1_ * 128 + 64 + lane];
      __builtin_amdgcn_sched_barrier(0);
      peer_down_rows(R, PD, sl, a0, a1, lane); peer_down_hn(H0, HN, sl, tk, g);
      __builtin_amdgcn_sched_barrier(0); }
#pragma unroll 1
    for (int n = 0; n < ntok; n += 2) {
        int s0, s1, s2, s3; size_t t0, t1, t2, t3;
        peer_item(n, D, wave, s0, t0); peer_item(n + 1, D, wave, s1, t1); peer_item(n + 2 < ntok ? n + 2 : n, D, wave, s2, t2); peer_item(n + 3 < ntok ? n + 3 : n + 1, D, wave, s3, t3);
        peer_down_park(R, sw, lane);
        __builtin_amdgcn_sched_barrier(0);
        { const int j0 = IDX[t2 * 128 + lane], j1 = IDX[t2 * 128 + 64 + lane];
          peer_down_rows(R, PD, s1, id0, id1, lane); peer_down_hn(H1, HN, s1, t1, g); id0 = j0; id1 = j1; }
        __builtin_amdgcn_sched_barrier(0);
        peer_down_compute(sw, H0, prsrc, s0, t0, lane);
        __builtin_amdgcn_sched_barrier(0);
        peer_down_park(R, sw, lane);
        __builtin_amdgcn_sched_barrier(0);
        { const int j0 = IDX[t3 * 128 + lane], j1 = IDX[t3 * 128 + 64 + lane];
          peer_down_rows(R, PD, s2, id0, id1, lane); peer_down_hn(H0, HN, s2, t2, g); id0 = j0; id1 = j1; }
        __builtin_amdgcn_sched_barrier(0);
        peer_down_compute(sw, H1, prsrc, s1, t1, lane);
        __builtin_amdgcn_sched_barrier(0);
    }
}
__device__ __forceinline__ void peer_coef_wave(Frame& F, const PeerDeal& D) {
    const float* PART = (const float*)(F.ws + WS_BIG); const float* GATE = (const float*)(F.ws + WS_BIG + PEER_OFF_GATE); float* COEF = (float*)(F.ws + WS_BIG + PEER_OFF_COEF);
    for (int k = F.lane; k < 32 * 32; k += 64) {
        const size_t i = D.tokw * 128 + 4 * k;
        f32x4 sm = *(const f32x4*)(PART + i);
#pragma unroll
        for (int x = 1; x < 8; ++x) sm += *(const f32x4*)(PART + (size_t)x * T * 128 + i);
        const f32x4 gt = *(const f32x4*)(GATE + i);
        const f32x4 o = {gt.x * gelu_erf(sm.x * (1.0f / PD_SCALE)) * (1.0f / PU_SCALE), gt.y * gelu_erf(sm.y * (1.0f / PD_SCALE)) * (1.0f / PU_SCALE),
                         gt.z * gelu_erf(sm.z * (1.0f / PD_SCALE)) * (1.0f / PU_SCALE), gt.w * gelu_erf(sm.w * (1.0f / PD_SCALE)) * (1.0f / PU_SCALE)};
        *(f32x4*)(COEF + i) = o;
    }
}
__device__ __forceinline__ void peer_up_rows(u32x4 (&R)[16], const unsigned char* PU, int slice, int id0, int id1, int lane) {
    const unsigned char* base = PU + ((size_t)slice * 16384 << 7) + 16 * (lane & 3);
#pragma unroll
    for (int s8 = 0; s8 < 8; ++s8) { const int id = __shfl(s8 < 4 ? id0 : id1, (16 * s8 + (lane >> 2)) & 63); const unsigned char* rp = base + ((size_t)id << 7); R[2 * s8] = *(const u32x4*)rp; R[2 * s8 + 1] = *(const u32x4*)(rp + 64); }
}
__device__ __forceinline__ void peer_up_compute(const u32x4 (&R)[16], float c0, float c1, f32x2 h, float* out, int slice, size_t tok, int lane) {
    f32x2 acc[16];
#pragma unroll
    for (int k = 0; k < 16; ++k) acc[k] = (f32x2){0.f, 0.f};
#pragma unroll
    for (int s8 = 0; s8 < 8; ++s8) { const float c = __shfl(s8 < 4 ? c0 : c1, (16 * s8 + (lane >> 2)) & 63); f32x2 c2 = {c, c}; asm volatile("" : "+v"(c2));
#pragma unroll
        for (int hf = 0; hf < 2; ++hf) { const u32x4 r = R[2 * s8 + hf];
            acc[8 * hf + 0] = c2 * __builtin_amdgcn_cvt_pk_f32_fp8(r.x, false) + acc[8 * hf + 0]; acc[8 * hf + 1] = c2 * __builtin_amdgcn_cvt_pk_f32_fp8(r.x, true) + acc[8 * hf + 1];
            acc[8 * hf + 2] = c2 * __builtin_amdgcn_cvt_pk_f32_fp8(r.y, false) + acc[8 * hf + 2]; acc[8 * hf + 3] = c2 * __builtin_amdgcn_cvt_pk_f32_fp8(r.y, true) + acc[8 * hf + 3];
            acc[8 * hf + 4] = c2 * __builtin_amdgcn_cvt_pk_f32_fp8(r.z, false) + acc[8 * hf + 4]; acc[8 * hf + 5] = c2 * __builtin_amdgcn_cvt_pk_f32_fp8(r.z, true) + acc[8 * hf + 5];
            acc[8 * hf + 6] = c2 * __builtin_amdgcn_cvt_pk_f32_fp8(r.w, false) + acc[8 * hf + 6]; acc[8 * hf + 7] = c2 * __builtin_amdgcn_cvt_pk_f32_fp8(r.w, true) + acc[8 * hf + 7]; } }
    f32x2 r8[8], r4[4], r2[2], r1;
    { const bool up = (lane & 32) != 0;
#pragma unroll
      for (int k = 0; k < 8; ++k) { const f32x2 keep = up ? acc[k + 8] : acc[k], send = up ? acc[k] : acc[k + 8]; r8[k] = keep + (f32x2){__shfl_xor(send.x, 32), __shfl_xor(send.y, 32)}; } }
    { const bool up = (lane & 16) != 0;
#pragma unroll
      for (int k = 0; k < 4; ++k) { const f32x2 keep = up ? r8[k + 4] : r8[k], send = up ? r8[k] : r8[k + 4]; r4[k] = keep + (f32x2){__shfl_xor(send.x, 16), __shfl_xor(send.y, 16)}; } }
    { const bool up = (lane & 8) != 0;
#pragma unroll
      for (int k = 0; k < 2; ++k) { const f32x2 keep = up ? r4[k + 2] : r4[k], send = up ? r4[k] : r4[k + 2]; r2[k] = keep + (f32x2){__shfl_xor(send.x, 8), __shfl_xor(send.y, 8)}; } }
    { const bool up = (lane & 4) != 0; const f32x2 keep = up ? r2[1] : r2[0], send = up ? r2[0] : r2[1]; r1 = keep + (f32x2){__shfl_xor(send.x, 4), __shfl_xor(send.y, 4)}; }
    const int p = ((lane >> 5) & 1) * 8 + ((lane >> 4) & 1) * 4 + ((lane >> 3) & 1) * 2 + ((lane >> 2) & 1);
    *(f32x2*)(out + tok * DM + slice * 128 + 16 * (lane & 3) + 2 * (p & 7) + 64 * (p >> 3)) = h + r1;
}
__device__ __forceinline__ void peer_up_phase(Frame& F, const PeerDeal& D, float* outp) {
    const unsigned char* PU = F.ws + WS_PU;
    const int* IDX = (const int*)(F.ws + WS_BIG + PEER_OFF_IDX); const float* COEF = (const float*)(F.ws + WS_BIG + PEER_OFF_COEF);
    int lane = F.lane; asm volatile("" : "+v"(lane));
    const int wave = F.wave;
    const int ntok = D.ntok;
    const int p = ((lane >> 5) & 1) * 8 + ((lane >> 4) & 1) * 4 + ((lane >> 3) & 1) * 2 + ((lane >> 2) & 1);
    const int hoff = 16 * (lane & 3) + 2 * (p & 7) + 64 * (p >> 3);
    int sl; size_t tk;
    u32x4 R0[16], R1[16];
    float ca0, ca1, cb0, cb1; f32x2 ha, hb;
    int id0, id1, jd0, jd1;
    { int s1_; size_t t1_; peer_item(0, D, wave, sl, tk); peer_item(1, D, wave, s1_, t1_);
      jd0 = IDX[tk * 128 + lane]; jd1 = IDX[tk * 128 + 64 + lane]; id0 = IDX[t1_ * 128 + lane]; id1 = IDX[t1_ * 128 + 64 + lane];
      __builtin_amdgcn_sched_barrier(0);
      peer_up_rows(R0, PU, sl, jd0, jd1, lane);
      ca0 = COEF[tk * 128 + lane]; ca1 = COEF[tk * 128 + 64 + lane]; ha = *(const f32x2*)(F.out + tk * DM + sl * 128 + hoff);
      __builtin_amdgcn_sched_barrier(0); }
#pragma unroll 1
    for (int n = 0; n < ntok; n += 2) {
        int s0, s1, s2, s3; size_t t0, t1, t2, t3;
        peer_item(n, D, wave, s0, t0); peer_item(n + 1, D, wave, s1, t1);
        peer_item(n + 2 < ntok ? n + 2 : n, D, wave, s2, t2); peer_item(n + 3 < ntok ? n + 3 : n + 1, D, wave, s3, t3);
        jd0 = IDX[t2 * 128 + lane]; jd1 = IDX[t2 * 128 + 64 + lane];
        peer_up_rows(R1, PU, s1, id0, id1, lane);
        cb0 = COEF[t1 * 128 + lane]; cb1 = COEF[t1 * 128 + 64 + lane]; hb = *(const f32x2*)(F.out + t1 * DM + s1 * 128 + hoff);
        __builtin_amdgcn_sched_barrier(0);
        peer_up_compute(R0, ca0, ca1, ha, outp, s0, t0, lane);
        __builtin_amdgcn_sched_barrier(0);
        id0 = IDX[t3 * 128 + lane]; id1 = IDX[t3 * 128 + 64 + lane];
        peer_up_rows(R0, PU, s2, jd0, jd1, lane);
        ca0 = COEF[t2 * 128 + lane]; ca1 = COEF[t2 * 128 + 64 + lane]; ha = *(const f32x2*)(F.out + t2 * DM + s2 * 128 + hoff);
        __builtin_amdgcn_sched_barrier(0);
        peer_up_compute(R1, cb0, cb1, hb, outp, s1, t1, lane);
        __builtin_amdgcn_sched_barrier(0);
    }
}
__device__ __forceinline__ void peer_phase(Frame& F) {
    int* IDX = (int*)(F.ws + WS_BIG + PEER_OFF_IDX); float* GATE = (float*)(F.ws + WS_BIG + PEER_OFF_GATE);
    for (int tile = F.bid; tile < T / 256; tile += F.G) {
        peer_topk_tile(F, (size_t)tile * 256, IDX, GATE);
        VM_WAIT(); __syncthreads();
        PeerDeal D; D.tokw = (size_t)tile * 256 + F.wave * 32; D.ntok = 256;
        peer_down_phase(F, D);
        if (PROBE & 8) peer_down_phase(F, D);
        VM_WAIT(); __syncthreads();
        peer_coef_wave(F, D);
        VM_WAIT(); __syncthreads();
        if (PROBE & 16) peer_up_phase(F, D, (float*)(F.ws + WS_SST));
        peer_up_phase(F, D, F.out);
    }
}

constexpr int N_PHASES = 15;
__global__ void __launch_bounds__(NTHR, 2) mega_fwd(Args args) {
    extern __shared__ __attribute__((aligned(16))) unsigned char lds_raw[];
    Frame F;
    F.lds = (LAS unsigned char*)lds_raw;
    F.tid = threadIdx.x; F.lane = F.tid & 63; F.wave = __builtin_amdgcn_readfirstlane(F.tid >> 6);
    F.G = gridDim.x; F.bid = blockIdx.x;
    F.in = args.in;
    F.positions = args.positions; F.out = args.out; F.ws = args.ws;
    unsigned char* ws = args.ws;
    volatile LAS unsigned* ctlw = (volatile LAS unsigned*)(F.lds + LDSCTL_OFF);
    if (F.tid < 64) ctlw[F.tid] = 0u;
    __syncthreads();
    const int lo = args.ph_lo, hi = args.ph_hi;
    XcdBarrier bar; bar.bar = (unsigned*)(ws + WS_CTL); bar.x = 0; bar.st = nullptr; bar.wave = F.wave;
    if (hi - lo > 1) bar = xcd_barrier_post((unsigned*)(ws + WS_CTL), ctlw + 8, F.wave);
#define IN(k) (lo <= (k) && (k) < hi)
#define SEAM(k) do { if (IN(k) && IN((k) + 1)) xcd_barrier(bar); } while (0)
    bf16* ACT1 = (bf16*)(ws + WS_ACT1); bf16* BIG = (bf16*)(ws + WS_BIG); bf16* WallT = (bf16*)(ws + WS_WALLT);

    if (IN(0)) { frame_refresh(F); p0_prologue(F); __syncthreads(); if (PROBE & 1) { p0_prologue(F); __syncthreads(); } }
    SEAM(0);
    if (IN(1)) { frame_refresh(F); { {
        { pg8::Gemm g{(const bf16*)(ws + WS_MEMN), (const bf16*)(ws + WS_WMKVT), NB * NMEM, 768, DM, DM, DM}; pg8::StaticOrder S; S.init(g.M, g.N, F.G, F.bid);
          pg8::EpiBf16<0> E{(bf16*)(ws + WS_MKV), 1536}; pg8::gemm_phase(F.lds, g, S, E, F.wave); }
        { pg8::Gemm g{(const bf16*)(ws + WS_WMKVT) + (size_t)768 * DM, (const bf16*)(ws + WS_MEMN), 768, NB * NMEM, DM, DM, DM}; pg8::StaticOrder S; S.init(g.M, g.N, F.G, F.G - 1 - F.bid);
          pg8::EpiBf16<0> E{(bf16*)(ws + WS_MVT), NB * NMEM}; pg8::gemm_phase(F.lds, g, S, E, F.wave); }
        { pg8::Gemm g{ACT1, WallT, HT, NPROJ, DM, DM, DM}; pg8::StaticOrder S; S.init(g.M, g.N, F.G, F.bid);
          pg8::EpiBf16<0> E{BIG, NPROJ}; pg8::gemm_phase(F.lds, g, S, E, F.wave); }
    } }
      if (PROBE & 2) { {
        { pg8::Gemm g{(const bf16*)(ws + WS_MEMN), (const bf16*)(ws + WS_WMKVT), NB * NMEM, 768, DM, DM, DM}; pg8::StaticOrder S; S.init(g.M, g.N, F.G, F.bid);
          pg8::EpiBf16<0> E{(bf16*)(ws + WS_MKV), 1536}; pg8::gemm_phase(F.lds, g, S, E, F.wave); }
        { pg8::Gemm g{(const bf16*)(ws + WS_WMKVT) + (size_t)768 * DM, (const bf16*)(ws + WS_MEMN), 768, NB * NMEM, DM, DM, DM}; pg8::StaticOrder S; S.init(g.M, g.N, F.G, F.G - 1 - F.bid);
          pg8::EpiBf16<0> E{(bf16*)(ws + WS_MVT), NB * NMEM}; pg8::gemm_phase(F.lds, g, S, E, F.wave); }
        { pg8::Gemm g{ACT1, WallT, HT, NPROJ, DM, DM, DM}; pg8::StaticOrder S; S.init(g.M, g.N, F.G, F.bid);
          pg8::EpiBf16<0> E{BIG, NPROJ}; pg8::gemm_phase(F.lds, g, S, E, F.wave); }
    } } }
    SEAM(1);
    if (IN(2)) { frame_refresh(F); qkprep_phase(F, 0); ssdC_phase(F, 0); if (PROBE & 4) ssdC_phase(F, 0); }
    SEAM(2);
    if (IN(3)) { frame_refresh(F); ssdD_phase(F); dilattn_mfma_phase(F, 0); memattn_mfma_phase(F, 0); if (PROBE & 64) { ssdD_phase(F); memattn_mfma_phase(F, 0); } }
    SEAM(3);
    if (IN(4)) { frame_refresh(F); ssdE_phase(F, 0); dilmerge_phase(F, 0); if (PROBE & 32) { ssdE_phase(F, 0); dilmerge_phase(F, 0); } }
    SEAM(4);
    if (IN(5)) { frame_refresh(F); { { pg8::Gemm g{ACT1 + (size_t)HT * DM, WallT, HT, NPROJ, DM, DM, DM}; pg8::StaticOrder S; S.init(g.M, g.N, F.G, F.bid);
        pg8::EpiBf16<0> E{BIG, NPROJ}; pg8::gemm_phase(F.lds, g, S, E, F.wave); } }
      if (PROBE & 2) { { pg8::Gemm g{ACT1 + (size_t)HT * DM, WallT, HT, NPROJ, DM, DM, DM}; pg8::StaticOrder S; S.init(g.M, g.N, F.G, F.bid);
        pg8::EpiBf16<0> E{BIG, NPROJ}; pg8::gemm_phase(F.lds, g, S, E, F.wave); } } }
    SEAM(5);
    if (IN(6)) { frame_refresh(F); qkprep_phase(F, 1); ssdC_phase(F, 1); if (PROBE & 4) ssdC_phase(F, 1); }
    SEAM(6);
    if (IN(7)) { frame_refresh(F); ssdD_phase(F); dilattn_mfma_phase(F, 1); memattn_mfma_phase(F, 1); if (PROBE & 64) { ssdD_phase(F); memattn_mfma_phase(F, 1); } }
    SEAM(7);
    if (IN(8)) { frame_refresh(F); ssdE_phase(F, 1); dilmerge_phase(F, 1); if (PROBE & 32) { ssdE_phase(F, 1); dilmerge_phase(F, 1); } }
    SEAM(8);
    if (IN(9)) { frame_refresh(F); { { pg8::Gemm g{ACT1, WallT + (size_t)NPROJ * DM, T, NGATE, DM, DM, DM}; pg8::StaticOrder S; S.init(g.M, g.N, F.G, F.bid);
        pg8::EpiBf16<1> E{BIG, NGATE}; pg8::gemm_phase(F.lds, g, S, E, F.wave); } }
      if (PROBE & 2) { { pg8::Gemm g{ACT1, WallT + (size_t)NPROJ * DM, T, NGATE, DM, DM, DM}; pg8::StaticOrder S; S.init(g.M, g.N, F.G, F.bid);
        pg8::EpiBf16<1> E{BIG, NGATE}; pg8::gemm_phase(F.lds, g, S, E, F.wave); } } }
    SEAM(9);
    if (IN(10)) { frame_refresh(F);
        pg8::Gemm g{(const bf16*)F.out, (const bf16*)(ws + WS_WCATT), T, DM, YC, YC, YC}; pg8::StaticOrder S; S.init(g.M, g.N, F.G, F.bid);
        pg8::EpiBranchFused E{ACT1, DM, __builtin_amdgcn_make_buffer_rsrc((void*)BIG, 0, T * NGATE * 2, 0x00020000), NGATE}; pg8::gemm_phase(F.lds, g, S, E, F.wave);
    }
    SEAM(10);
    if (IN(11)) { frame_refresh(F); { { pg8::Gemm g{ACT1, (const bf16*)(ws + WS_WOUTT), T, DM, DM, DM, DM}; pg8::StaticOrder S; S.init(g.M, g.N, F.G, F.bid);
        pg8::EpiResid E{F.out, DM, F.in[I_X]}; pg8::gemm_phase(F.lds, g, S, E, F.wave); } }
      if (PROBE & 2) { { pg8::Gemm g{ACT1, (const bf16*)(ws + WS_WOUTT), T, DM, DM, DM, DM}; pg8::StaticOrder S; S.init(g.M, g.N, F.G, F.bid);
        pg8::EpiResid E{F.out, DM, F.in[I_X]}; pg8::gemm_phase(F.lds, g, S, E, F.wave); } } }
    SEAM(11);
    if (IN(12)) { frame_refresh(F); { hn_phase(F); }
      if (PROBE & 2) { hn_phase(F); } }
    SEAM(12);
    if (IN(13)) { frame_refresh(F); { { pg8::Gemm g{ACT1, (const bf16*)(ws + WS_WQT), T, PEER_Q, DM, DM, DM}; pg8::StaticOrder S; S.init(g.M, g.N, F.G, F.bid);
        pg8::EpiBf16<0> E{BIG, PEER_Q}; pg8::gemm_phase(F.lds, g, S, E, F.wave); } }
      if (PROBE & 2) { { pg8::Gemm g{ACT1, (const bf16*)(ws + WS_WQT), T, PEER_Q, DM, DM, DM}; pg8::StaticOrder S; S.init(g.M, g.N, F.G, F.bid);
        pg8::EpiBf16<0> E{BIG, PEER_Q}; pg8::gemm_phase(F.lds, g, S, E, F.wave); } } }
    SEAM(13);
    if (IN(14)) { frame_refresh(F); peer_phase(F); }
#undef IN
#undef SEAM
}

extern "C" void kernel_launch(void* const* d_in, const int* in_sizes, int n_in, void* d_out, int out_size, void* d_ws, size_t ws_size, hipStream_t stream) {
    static int grid = 0;
    if (grid == 0) {
        if (n_in != 26 || out_size != T * DM || ws_size < WS_END) { fprintf(stderr, "kernel_launch: unexpected shapes (n_in %d, out %d, ws %zu)\n", n_in, out_size, ws_size); grid = -1; return; }
        int dev = 0, cus = 0;
        if (hipGetDevice(&dev) != hipSuccess || hipDeviceGetAttribute(&cus, hipDeviceAttributeMultiprocessorCount, dev) != hipSuccess) { grid = -1; return; }
        if (hipFuncSetAttribute((const void*)mega_fwd, hipFuncAttributeMaxDynamicSharedMemorySize, LDS_BYTES) != hipSuccess) { grid = -1; return; }
        int per_cu = 0;
        (void)hipOccupancyMaxActiveBlocksPerMultiprocessor(&per_cu, (const void*)mega_fwd, NTHR, LDS_BYTES);
        (void)hipGetLastError();
        grid = cus;
    }
    if (grid < 0) return;
    (void)hipMemsetAsync((char*)d_ws + WS_CTL, 0, CTL_ZERO_BYTES, stream);
    Args a{};
    for (int i = 0; i < 26; ++i) a.in[i] = (const float*)d_in[i];
    a.positions = (const int*)d_in[2]; a.out = (float*)d_out; a.ws = (unsigned char*)d_ws;
#if MK_N_LAUNCHES == 1
    a.ph_lo = 0; a.ph_hi = N_PHASES;
    hipLaunchKernelGGL(mega_fwd, dim3(grid), dim3(NTHR), LDS_BYTES, stream, a);
#else
    for (int p = 0; p < N_PHASES; ++p) { a.ph_lo = p; a.ph_hi = p + 1; hipLaunchKernelGGL(mega_fwd, dim3(grid), dim3(NTHR), LDS_BYTES, stream, a); }
#endif
}
```

```cpp
#include <hip/hip_runtime.h>
#include <cstdio>
#include <cstdint>

#ifndef MK_N_LAUNCHES
#define MK_N_LAUNCHES 1
#endif

#define LAS __attribute__((address_space(3)))
#define GAS __attribute__((address_space(1)))
typedef unsigned short bf16;
typedef short bf16x8 __attribute__((ext_vector_type(8)));
typedef float f32x4 __attribute__((ext_vector_type(4)));
typedef float f32x2 __attribute__((ext_vector_type(2)));
typedef unsigned u32x4 __attribute__((ext_vector_type(4)));
typedef unsigned u32x2 __attribute__((ext_vector_type(2)));

constexpr int NB = 8, SEQ = 8192, DM = 1024, T = NB * SEQ;
constexpr int HB = 4, HT = HB * SEQ;
constexpr int NMEM = 256;
constexpr int NPROJ = 6144;
constexpr int PC_Z = 0, PC_X = 1024, PC_B = 2048, PC_C = 2560, PC_DQ = 3072, PC_DK = 3840, PC_DV = 4608, PC_MQ = 5376;
constexpr int W_IN_N = 9232, OFF_DT = 3072, OFF_AFTER_DT = 3088;
constexpr int NGATE = 3072;
constexpr int YC = 2048;
constexpr int PEER_H = 8, PEER_K = 16, PEER_NK = 128, PEER_Q = 2048;
constexpr float EPS = 1e-6f;

constexpr size_t MiB = 1u << 20;
constexpr size_t WS_CTL = 0, CTL_ZERO_BYTES = 65536;
constexpr size_t WS_WALLT = 1 * MiB;
constexpr size_t WS_WMKVT = 19 * MiB;
constexpr size_t WS_WCATT = 22 * MiB;
constexpr size_t WS_WOUTT = 26 * MiB;
constexpr size_t WS_WQT = 28 * MiB;
constexpr size_t WS_SUBK = 32 * MiB;
constexpr size_t WS_PD = 33 * MiB;
constexpr size_t WS_PU = 65 * MiB;
constexpr size_t WS_DT = 97 * MiB;
constexpr size_t WS_MEMN = 101 * MiB;
constexpr size_t WS_MKV = 105 * MiB;
constexpr size_t WS_ACT1 = 112 * MiB;
constexpr size_t WS_BIG = 240 * MiB;
constexpr size_t WS_LSE = 624 * MiB;
constexpr size_t WS_MVT = 628 * MiB;
constexpr size_t WS_DEC = 631 * MiB;
constexpr size_t WS_SST = 632 * MiB;
constexpr size_t WS_SIN = 760 * MiB;
constexpr size_t WS_END = 824 * MiB;

constexpr int RING_BYTES = 131072;
constexpr int LDSCTL_OFF = 143360;
constexpr int LDS_BYTES = 147456;
constexpr int NWAVES = 8, NTHR = 512;

__device__ __forceinline__ int lane_id() { return (int)__builtin_amdgcn_mbcnt_hi(~0u, __builtin_amdgcn_mbcnt_lo(~0u, 0u)); }
__device__ __forceinline__ float bf2f(unsigned short b) { return __builtin_bit_cast(float, (unsigned)b << 16); }
__device__ __forceinline__ float bflo(unsigned w) { return __builtin_bit_cast(float, w << 16); }
__device__ __forceinline__ float bfhi(unsigned w) { return __builtin_bit_cast(float, w & 0xffff0000u); }
__device__ __forceinline__ unsigned f2bf(float f) { unsigned u = __builtin_bit_cast(unsigned, f); return (u + 0x7fffu + ((u >> 16) & 1u)) >> 16; }
__device__ __forceinline__ unsigned pk2(float lo, float hi) { return f2bf(lo) | (f2bf(hi) << 16); }
typedef float f32x16 __attribute__((ext_vector_type(16)));
typedef short s16x4 __attribute__((ext_vector_type(4)));
typedef __bf16 bf2_t __attribute__((ext_vector_type(2)));
__device__ __forceinline__ unsigned pkbf(float a, float b) { const f32x2 v = {a, b}; return __builtin_bit_cast(unsigned, __builtin_convertvector(v, bf2_t)); }
#define MFMA32(a, b, c) __builtin_amdgcn_mfma_f32_32x32x16_bf16((a), (b), (c), 0, 0, 0)
__device__ __forceinline__ float wave_sum(float v) {
#pragma unroll
    for (int o = 1; o < 64; o <<= 1) v += __shfl_xor(v, o);
    return v;
}
__device__ __forceinline__ float wave_max(float v) {
#pragma unroll
    for (int o = 1; o < 64; o <<= 1) v = fmaxf(v, __shfl_xor(v, o));
    return v;
}
__device__ __forceinline__ float sigmoidf_(float x) { return 1.0f / (1.0f + __expf(-x)); }
#define LDS_WAIT() asm volatile("s_waitcnt lgkmcnt(0)" ::: "memory")
#define VM_WAIT() asm volatile("s_waitcnt vmcnt(0)" ::: "memory")

#define XB_TMO      128
#define XB_XCNT(j)  (256  + 64 * (j))
#define XB_XSUB(j)  (1280 + 64 * (j))
#define XB_XGEN(j)  (2304 + 64 * (j))
#define XB_TOP      3328
#define XB_TOPGEN   3392
#define XCD_BAR_WORDS 3456
#define XB_SPIN_CAP (1u << 18)
__device__ __forceinline__ unsigned xb_ld(unsigned* p)              { return __hip_atomic_load(p, __ATOMIC_RELAXED, __HIP_MEMORY_SCOPE_AGENT); }
__device__ __forceinline__ unsigned xb_add(unsigned* p, unsigned v) { return __hip_atomic_fetch_add(p, v, __ATOMIC_RELAXED, __HIP_MEMORY_SCOPE_AGENT); }
__device__ __forceinline__ unsigned xb_xcc_id() { return (unsigned)__builtin_amdgcn_s_getreg((3 << 11) | 20) & 0xFu; }
#define XB_SPIN(cond, bar) do { unsigned _sp = 0; while (cond) { __builtin_amdgcn_s_sleep(1); \
    if ((++_sp & 255u) == 0u) { if (xb_ld(&(bar)[XB_TMO])) break; if (_sp > XB_SPIN_CAP) { atomicAdd(&(bar)[XB_TMO], 1u); break; } } } } while (0)
struct XcdBarrier { unsigned* bar; unsigned x; volatile LAS unsigned* st; int wave; };
__device__ __forceinline__ XcdBarrier xcd_barrier_post(unsigned* bar, volatile LAS unsigned* st, int wave) {
    XcdBarrier b; b.bar = bar; b.x = xb_xcc_id(); b.st = st; b.wave = wave;
    if (wave == 0 && lane_id() == 0) (void)xb_add(&bar[XB_XCNT(b.x)], 1u);
    return b;
}
__device__ __forceinline__ void xcd_barrier_complete(unsigned* bar, unsigned x, unsigned& nloc, unsigned& nx) {
    const unsigned G = gridDim.x * gridDim.y * gridDim.z;
    unsigned sum, cnt, mine, sp = 0u;
    for (;;) {
        sum = 0u; cnt = 0u; mine = 0u;
#pragma unroll
        for (unsigned j = 0; j < 16; ++j) { const unsigned c = xb_ld(&bar[XB_XCNT(j)]); sum += c; cnt += (c > 0u) ? 1u : 0u; mine = (j == x) ? c : mine; }
        if (sum == G) break;
        __builtin_amdgcn_s_sleep(1);
        if ((++sp & 255u) == 0u) { if (xb_ld(&bar[XB_TMO])) break; if (sp > XB_SPIN_CAP) { atomicAdd(&bar[XB_TMO], 1u); break; } }
    }
    nloc = mine > 0u ? mine : 1u; nx = cnt > 0u ? cnt : 1u;
}
__device__ __forceinline__ void xcd_barrier(const XcdBarrier& b) {
    asm volatile("s_waitcnt vmcnt(0)" ::: "memory");
    __syncthreads();
    if (b.wave == 0 && lane_id() == 0) {
        unsigned* bar = b.bar;
        __builtin_amdgcn_s_waitcnt(0);
        unsigned nloc = b.st[0], nx = b.st[1];
        if (nloc == 0u) { xcd_barrier_complete(bar, b.x, nloc, nx); b.st[0] = nloc; b.st[1] = nx; }
        const unsigned old = xb_add(&bar[XB_XSUB(b.x)], 1u);
        const unsigned gen = old / nloc;
        if (old + 1u == (gen + 1u) * nloc) {
            __builtin_amdgcn_fence(__ATOMIC_RELEASE, "agent");
            asm volatile("s_waitcnt vmcnt(0)" ::: "memory");
            const unsigned og = xb_add(&bar[XB_TOP], 1u);
            const unsigned tg = og / nx;
            if (og + 1u == (tg + 1u) * nx) xb_add(&bar[XB_TOPGEN], 1u);
            else XB_SPIN(xb_ld(&bar[XB_TOPGEN]) == tg, bar);
            __builtin_amdgcn_fence(__ATOMIC_ACQUIRE, "agent");
            xb_add(&bar[XB_XGEN(b.x)], 1u);
            asm volatile("s_waitcnt vmcnt(0)" ::: "memory");
        } else {
            XB_SPIN(xb_ld(&bar[XB_XGEN(b.x)]) == gen, bar);
            __builtin_amdgcn_fence(__ATOMIC_ACQUIRE, "agent");
            asm volatile("s_waitcnt vmcnt(0)" ::: "memory");
        }
    }
    __syncthreads();
}

namespace pg8 {
constexpr int BM = 256, BK = 64, HALF = 128, HTB = HALF * BK * 2, STAGE_BYTES = 8 * HTB, NXCD = 8, WGM = 8;
__host__ __device__ __forceinline__ int lds_byte(int r, int c) { const int st = (r >> 4) * 2 + (c >> 5), rr = r & 15, cc = c & 31, ob = rr * 64 + cc * 2; return st * 1024 + (ob ^ (((ob >> 9) & 1) << 5)); }
__host__ __device__ __forceinline__ void stage_rc(int b, int& R, int& C) { const int st = b / 1024, sb = b % 1024, swz = sb ^ (((sb >> 9) & 1) << 5); R = (st >> 1) * 16 + swz / 64; C = (st & 1) * 32 + (swz % 64) / 2; }
__host__ __device__ __forceinline__ int perm32(int rho) { const int n = rho >> 4, i = rho & 15; return 8 * (i >> 2) + 4 * n + (i & 3); }
struct Unit { int pm, pn; };
struct Gemm { const bf16* A; const bf16* Bt; int M, N, K, lda, ldb; };
struct StaticOrder {
    int nM, nN, nwg, G, c;
    __host__ __device__ void init(int M, int N, int G_, int c_) { nM = M / BM; nN = N / BM; nwg = nM * nN; G = G_; c = c_; }
    __host__ __device__ bool next(int i, Unit& u) const {
        const long L = (long)i * G + c; if (L >= nwg) return false;
        int wgid = (int)L; { const int q = nwg / NXCD, r = nwg % NXCD, xcd = wgid % NXCD, off = wgid / NXCD; wgid = (xcd < r ? xcd * (q + 1) : r * (q + 1) + (xcd - r) * q) + off; }
        const int nig = WGM * nN, gid = wgid / nig, fm = gid * WGM, gsz = (nM - fm) < WGM ? (nM - fm) : WGM;
        u.pm = fm + ((wgid % nig) % gsz); u.pn = (wgid % nig) / gsz; return true;
    }
    __device__ __forceinline__ void a_ready(const Unit&) const {}
    __device__ __forceinline__ void done(const Unit&) const {}
};
struct PanelOrder {
    int pm, nN, rot;
    __device__ __forceinline__ bool next(int i, Unit& u) const { if (i >= nN) return false; u.pm = pm; u.pn = (i + rot) % nN; return true; }
    __device__ __forceinline__ void a_ready(const Unit&) const {}
    __device__ __forceinline__ void done(const Unit&) const {}
};
__device__ __forceinline__ unsigned cvt_pk_bf16(float lo, float hi) { unsigned r; asm volatile("v_cvt_pk_bf16_f32 %0, %1, %2" : "=v"(r) : "v"(lo), "v"(hi)); return r; }

template <int ACT> struct EpiBf16 {
    static constexpr bool PERM = true, AFTER_DRAIN = false, HAS_MID = false;
    bf16* O; int ldc;
    __device__ __forceinline__ void operator()(const f32x4 (&acc)[2][2][4][2], const Unit& u, int wr, int wc, int fr, int fq) const {
        const int row0 = u.pm * BM + wr * 64 + fr; const int col0 = u.pn * BM + wc * 32 + 8 * fq;
#pragma unroll
        for (int ai = 0; ai < 2; ++ai)
#pragma unroll
            for (int m = 0; m < 4; ++m) { bf16* rowp = O + (size_t)(row0 + ai * HALF + m * 16) * ldc + col0;
#pragma unroll
                for (int bj = 0; bj < 2; ++bj) { f32x4 v0 = acc[ai][bj][m][0], v1 = acc[ai][bj][m][1];
                    if (ACT == 1) {
#pragma unroll
                        for (int j = 0; j < 4; ++j) { v0[j] = sigmoidf_(v0[j]); v1[j] = sigmoidf_(v1[j]); } }
                    u32x4 w; w.x = cvt_pk_bf16(v0[0], v0[1]); w.y = cvt_pk_bf16(v0[2], v0[3]); w.z = cvt_pk_bf16(v1[0], v1[1]); w.w = cvt_pk_bf16(v1[2], v1[3]);
                    *(u32x4*)(rowp + bj * HALF) = w; } }
    }
};
template <bool ACCUM> struct EpiBranch {
    static constexpr bool PERM = true, AFTER_DRAIN = false, HAS_MID = false;
    bf16* O; int ldc; const bf16* Gt; int ldg; int gcol0;
    __device__ __forceinline__ void operator()(const f32x4 (&acc)[2][2][4][2], const Unit& u, int wr, int wc, int fr, int fq) const {
        const int row0 = u.pm * BM + wr * 64 + fr; const int col0 = u.pn * BM + wc * 32 + 8 * fq;
#pragma unroll
        for (int ai = 0; ai < 2; ++ai)
#pragma unroll
            for (int m = 0; m < 4; ++m) { const size_t r = (size_t)(row0 + ai * HALF + m * 16); bf16* rowp = O + r * ldc + col0; const bf16* gp = Gt + r * ldg + gcol0 + col0;
#pragma unroll
                for (int bj = 0; bj < 2; ++bj) { const f32x4 v0 = acc[ai][bj][m][0], v1 = acc[ai][bj][m][1];
                    const u32x4 g = *(const u32x4*)(gp + bj * HALF);
                    float o[8];
                    o[0] = v0[0] * bflo(g.x); o[1] = v0[1] * bfhi(g.x); o[2] = v0[2] * bflo(g.y); o[3] = v0[3] * bfhi(g.y);
                    o[4] = v1[0] * bflo(g.z); o[5] = v1[1] * bfhi(g.z); o[6] = v1[2] * bflo(g.w); o[7] = v1[3] * bfhi(g.w);
                    if (ACCUM) { const u32x4 p = *(const u32x4*)(rowp + bj * HALF);
                        o[0] += bflo(p.x); o[1] += bfhi(p.x); o[2] += bflo(p.y); o[3] += bfhi(p.y); o[4] += bflo(p.z); o[5] += bfhi(p.z); o[6] += bflo(p.w); o[7] += bfhi(p.w); }
                    u32x4 w; w.x = cvt_pk_bf16(o[0], o[1]); w.y = cvt_pk_bf16(o[2], o[3]); w.z = cvt_pk_bf16(o[4], o[5]); w.w = cvt_pk_bf16(o[6], o[7]);
                    *(u32x4*)(rowp + bj * HALF) = w; } }
    }
};
struct EpiResid {
    static constexpr bool PERM = false, AFTER_DRAIN = false, HAS_MID = false;
    float* C; int ldc; const float* R;
    __device__ __forceinline__ void operator()(const f32x4 (&acc)[2][2][4][2], const Unit& u, int wr, int wc, int fr, int fq) const {
        const int row0 = u.pm * BM + wr * 64 + fr, col0 = u.pn * BM + wc * 32 + 4 * fq;
#pragma unroll
        for (int ai = 0; ai < 2; ++ai)
#pragma unroll
            for (int m = 0; m < 4; ++m) { const size_t off = (size_t)(row0 + ai * HALF + m * 16) * ldc + col0;
#pragma unroll
                for (int bj = 0; bj < 2; ++bj)
#pragma unroll
                    for (int n = 0; n < 2; ++n) { const f32x4 r = *(const f32x4*)(R + off + bj * HALF + n * 16); *(f32x4*)(C + off + bj * HALF + n * 16) = acc[ai][bj][m][n] + r; } }
    }
};

struct EpiBranchFused {
    static constexpr bool PERM = true, AFTER_DRAIN = false, HAS_MID = true;
    bf16* O; int ldc; __amdgpu_buffer_rsrc_t grs; int ldg;
    __device__ __forceinline__ void mid(f32x4 (&acc)[2][2][4][2], const Unit& u, int t, int wr, int wc, int fr, int fq) const {
        const unsigned voff = (unsigned)(((u.pm * BM + wr * 64 + fr) * ldg + u.pn * BM + wc * 32 + 8 * fq) * 2);
        const int ca = (t == 16) ? 0 : 2048;
#pragma unroll
        for (int ai = 0; ai < 2; ++ai)
#pragma unroll
            for (int m = 0; m < 4; ++m) {
#pragma unroll
                for (int bj = 0; bj < 2; ++bj) { const int so = ((ai * HALF + m * 16) * ldg + bj * HALF) * 2 + ca;
                    const u32x4 ga = __builtin_amdgcn_raw_buffer_load_b128(grs, voff, so, 0), gb = __builtin_amdgcn_raw_buffer_load_b128(grs, voff, so + 2048, 0);
                    f32x4& v0 = acc[ai][bj][m][0]; f32x4& v1 = acc[ai][bj][m][1];
                    v0[0] *= bflo(ga.x) * __builtin_amdgcn_rcpf(fmaxf(bflo(gb.x), 1e-30f)); v0[1] *= bfhi(ga.x) * __builtin_amdgcn_rcpf(fmaxf(bfhi(gb.x), 1e-30f));
                    v0[2] *= bflo(ga.y) * __builtin_amdgcn_rcpf(fmaxf(bflo(gb.y), 1e-30f)); v0[3] *= bfhi(ga.y) * __builtin_amdgcn_rcpf(fmaxf(bfhi(gb.y), 1e-30f));
                    v1[0] *= bflo(ga.z) * __builtin_amdgcn_rcpf(fmaxf(bflo(gb.z), 1e-30f)); v1[1] *= bfhi(ga.z) * __builtin_amdgcn_rcpf(fmaxf(bfhi(gb.z), 1e-30f));
                    v1[2] *= bflo(ga.w) * __builtin_amdgcn_rcpf(fmaxf(bflo(gb.w), 1e-30f)); v1[3] *= bfhi(ga.w) * __builtin_amdgcn_rcpf(fmaxf(bfhi(gb.w), 1e-30f)); }
                __builtin_amdgcn_sched_barrier(0); }
    }
    __device__ __forceinline__ void operator()(const f32x4 (&acc)[2][2][4][2], const Unit& u, int wr, int wc, int fr, int fq) const {
        const int row0 = u.pm * BM + wr * 64 + fr; const int col0 = u.pn * BM + wc * 32 + 8 * fq;
        const unsigned voff = (unsigned)((row0 * ldg + col0) * 2);
#pragma unroll
        for (int ai = 0; ai < 2; ++ai)
#pragma unroll
            for (int m = 0; m < 4; ++m) { const size_t r = (size_t)(row0 + ai * HALF + m * 16); bf16* rowp = O + r * ldc + col0;
#pragma unroll
                for (int bj = 0; bj < 2; ++bj) { const f32x4 v0 = acc[ai][bj][m][0], v1 = acc[ai][bj][m][1];
                    const u32x4 g = __builtin_amdgcn_raw_buffer_load_b128(grs, voff, ((ai * HALF + m * 16) * ldg + bj * HALF) * 2 + 4096, 0);
                    u32x4 w; w.x = cvt_pk_bf16(v0[0] * bflo(g.x), v0[1] * bfhi(g.x)); w.y = cvt_pk_bf16(v0[2] * bflo(g.y), v0[3] * bfhi(g.y));
                    w.z = cvt_pk_bf16(v1[0] * bflo(g.z), v1[1] * bfhi(g.z)); w.w = cvt_pk_bf16(v1[2] * bflo(g.w), v1[3] * bfhi(g.w));
                    *(u32x4*)(rowp + bj * HALF) = w; } }
    }
};

template <class Epi, class Sched>
__device__ __forceinline__ void gemm_phase(LAS unsigned char* lds, const Gemm g, const Sched& S, const Epi& E, int wid) {
    int lane = lane_id(); asm volatile("" : "+v"(lane));
    const int tid = wid * 64 + lane, wr = wid >> 2, wc = wid & 3, fr = lane & 15, fq = lane >> 4;
    const int K = g.K, nt = K / BK;
    unsigned voffA[2], voffB[2];
#pragma unroll
    for (int i = 0; i < 2; ++i) { int R, C; stage_rc(tid * 16 + i * 8192, R, C); const int Rb = Epi::PERM ? ((R & ~31) + perm32(R & 31)) : R;
        voffA[i] = (unsigned)(R * g.lda + C) * 2u; voffB[i] = (unsigned)(Rb * g.ldb + C) * 2u; }
    const size_t kstep = (size_t)(BK * 2);
    const size_t hsA = (size_t)HALF * g.lda * 2, hsB = (size_t)HALF * g.ldb * 2;
    const size_t tsA = 2 * hsA, tsB = 2 * hsB;
    const unsigned ldsw = (unsigned)wid * 1024u;
    const int aoff = lds_byte(wr * 64 + fr, fq * 8), boff = lds_byte(wc * 32 + fr, fq * 8);
#define PG8_SA(b, h) (((b) * 2 + (h)) * HTB)
#define PG8_SB(b, h) ((4 + (b) * 2 + (h)) * HTB)
#define PG8_STAGE(bufoff, gbase, voff) do { _Pragma("unroll") for (int _i = 0; _i < 2; ++_i) \
        __builtin_amdgcn_global_load_lds((const unsigned*)((const char*)(gbase) + (voff)[_i]), (LAS unsigned*)(lds + (bufoff) + ldsw + _i * 8192), 16, 0, 0); } while (0)
#define PG8_LDA(dst, b, h) do { _Pragma("unroll") for (int m = 0; m < 4; ++m) _Pragma("unroll") for (int k = 0; k < 2; ++k) dst[m][k] = *(const LAS bf16x8*)(lds + PG8_SA(b, h) + aoff + m * 2048 + k * 1024); } while (0)
#define PG8_LDB(dst, b, h) do { _Pragma("unroll") for (int n = 0; n < 2; ++n) _Pragma("unroll") for (int k = 0; k < 2; ++k) dst[n][k] = *(const LAS bf16x8*)(lds + PG8_SB(b, h) + boff + n * 2048 + k * 1024); } while (0)
#define PG8_MMA(ai, bj, At, Bt) do { __builtin_amdgcn_s_setprio(1); _Pragma("unroll") for (int m = 0; m < 4; ++m) _Pragma("unroll") for (int n = 0; n < 2; ++n) _Pragma("unroll") for (int k = 0; k < 2; ++k) \
        acc[ai][bj][m][n] = __builtin_amdgcn_mfma_f32_16x16x32_bf16(Bt[n][k], At[m][k], acc[ai][bj][m][n], 0, 0, 0); __builtin_amdgcn_s_setprio(0); } while (0)
#define PG8_WAIT_V(n) asm volatile("s_waitcnt vmcnt(" #n ")" ::: "memory")
#define PG8_WAIT_L(n) asm volatile("s_waitcnt lgkmcnt(" #n ")" ::: "memory")
#define PG8_BAR __builtin_amdgcn_s_barrier()
#define PG8_SCHED __builtin_amdgcn_sched_barrier(0)
    Unit cur, nxt; int ui = 0;
    if (!S.next(0, cur)) return;
    f32x4 acc[2][2][4][2];
#pragma unroll
    for (int a = 0; a < 2; ++a)
#pragma unroll
        for (int b = 0; b < 2; ++b)
#pragma unroll
            for (int m = 0; m < 4; ++m)
#pragma unroll
                for (int n = 0; n < 2; ++n) acc[a][b][m][n] = (f32x4){0.f, 0.f, 0.f, 0.f};
    bf16x8 At[4][2], B0[2][2], B1[2][2];
    const char* cA = (const char*)g.A + (size_t)cur.pm * tsA; const char* cB = (const char*)g.Bt + (size_t)cur.pn * tsB;
    S.a_ready(cur);
    PG8_STAGE(PG8_SB(0, 0), cB, voffB); PG8_STAGE(PG8_SA(0, 0), cA, voffA); PG8_STAGE(PG8_SB(0, 1), cB + hsB, voffB); PG8_STAGE(PG8_SA(0, 1), cA + hsA, voffA);
    if (wr == 1) PG8_BAR;
    PG8_WAIT_V(4); PG8_BAR;
    PG8_STAGE(PG8_SB(1, 0), cB + kstep, voffB); PG8_STAGE(PG8_SA(1, 0), cA + kstep, voffA); PG8_STAGE(PG8_SB(1, 1), cB + hsB + kstep, voffB);
    PG8_WAIT_V(6); PG8_BAR;
    for (;;) {
        const bool has_next = S.next(ui + 1, nxt);
        const char* nA = has_next ? (const char*)g.A + (size_t)nxt.pm * tsA : cA; const char* nB = has_next ? (const char*)g.Bt + (size_t)nxt.pn * tsB : cB;
        for (int t = 0; t < nt; t += 2) {
            const bool last = (t == nt - 2);
            const char* a1 = cA + (size_t)(t + 1) * kstep;
            const char* a2 = last ? nA : cA + (size_t)(t + 2) * kstep; const char* b2 = last ? nB : cB + (size_t)(t + 2) * kstep;
            const char* a3 = a2 + kstep; const char* b3 = b2 + kstep;
            if (last && has_next) S.a_ready(nxt);
            if constexpr (Epi::HAS_MID) { if (t == 16 || t == 20) E.mid(acc, cur, t, wr, wc, fr, fq); }
            PG8_LDB(B0, 0, 0); PG8_SCHED; PG8_LDA(At, 0, 0); PG8_STAGE(PG8_SA(1, 1), a1 + hsA, voffA);
            PG8_WAIT_L(8); PG8_BAR; PG8_WAIT_L(0); PG8_MMA(0, 0, At, B0); PG8_BAR; PG8_SCHED;
            PG8_LDB(B1, 0, 1); PG8_STAGE(PG8_SB(0, 0), b2, voffB);
            PG8_BAR; PG8_WAIT_L(0); PG8_MMA(0, 1, At, B1); PG8_BAR;
            PG8_LDA(At, 0, 1); PG8_STAGE(PG8_SA(0, 0), a2, voffA);
            PG8_BAR; PG8_WAIT_L(0); PG8_MMA(1, 0, At, B0); PG8_BAR; PG8_SCHED;
            PG8_STAGE(PG8_SB(0, 1), b2 + hsB, voffB);
            PG8_WAIT_V(6); PG8_BAR; PG8_MMA(1, 1, At, B1); PG8_BAR;
            PG8_LDB(B0, 1, 0); PG8_SCHED; PG8_LDA(At, 1, 0); PG8_STAGE(PG8_SA(0, 1), a2 + hsA, voffA);
            PG8_WAIT_L(8); PG8_BAR; PG8_WAIT_L(0); PG8_MMA(0, 0, At, B0); PG8_BAR; PG8_SCHED;
            PG8_LDB(B1, 1, 1); PG8_STAGE(PG8_SB(1, 0), b3, voffB);
            PG8_BAR; PG8_WAIT_L(0); PG8_MMA(0, 1, At, B1); PG8_BAR;
            PG8_LDA(At, 1, 1); PG8_STAGE(PG8_SA(1, 0), a3, voffA);
            PG8_BAR; PG8_WAIT_L(0); PG8_MMA(1, 0, At, B0); PG8_BAR; PG8_SCHED;
            PG8_STAGE(PG8_SB(1, 1), b3 + hsB, voffB);
            PG8_WAIT_V(6); PG8_BAR; PG8_MMA(1, 1, At, B1); PG8_BAR;
        }
        E(acc, cur, wr, wc, fr, fq); S.done(cur);
        if (!has_next) break;
#pragma unroll
        for (int a = 0; a < 2; ++a)
#pragma unroll
            for (int b = 0; b < 2; ++b)
#pragma unroll
                for (int m = 0; m < 4; ++m)
#pragma unroll
                    for (int n = 0; n < 2; ++n) acc[a][b][m][n] = (f32x4){0.f, 0.f, 0.f, 0.f};
        cur = nxt; cA = nA; cB = nB; ++ui;
    }
    PG8_WAIT_V(0);
    if (wr == 0) PG8_BAR;
    PG8_BAR;
#undef PG8_SA
#undef PG8_SB
#undef PG8_STAGE
#undef PG8_LDA
#undef PG8_LDB
#undef PG8_MMA
#undef PG8_WAIT_V
#undef PG8_WAIT_L
#undef PG8_BAR
#undef PG8_SCHED
}
}

#ifndef PROBE
#define PROBE 0
#endif
struct Args {
    const float* in[26]; const int* positions; float* out; unsigned char* ws; int ph_lo, ph_hi; int pad0, pad1;
};
struct Frame {
    LAS unsigned char* lds;
    int tid, lane, wave, G, bid;
    const float* const* in; const int* positions; float* out; unsigned char* ws;
};
__device__ __forceinline__ void frame_refresh(Frame& F) { int l = lane_id(); asm volatile("" : "+v"(l)); F.lane = l; F.tid = F.wave * 64 + l; }
enum { I_X = 0, I_MEM = 1, I_POS = 2, I_NMIXW = 3, I_WIN = 4, I_CONVW = 5, I_CONVB = 6, I_DTB = 7, I_ALOG = 8, I_SSDD = 9, I_SSDNW = 10, I_DQNW = 11, I_DKNW = 12, I_MEMNW = 13,
       I_WMKV = 14, I_MQNW = 15, I_MKNW = 16, I_WSSD = 17, I_WDIL = 18, I_WMEMBR = 19, I_WOUT = 20, I_NFFNW = 21, I_WQ = 22, I_SUBK = 23, I_PD = 24, I_PU = 25 };

__device__ __forceinline__ void p0_transpose_item(const float* W, int ldw, int src_col0, bf16* WT, int ldt, int dst_row0, int dst_col0, int nblk, LAS float* scr, int item, int lane) {
    const int kb = item / nblk, nb = item % nblk, k0 = 64 * kb, n0 = 32 * nb;
#pragma unroll 8
    for (int i = 0; i < 32; ++i) { const int kk = 2 * i + (lane >> 5); scr[kk * 33 + (lane & 31)] = W[(size_t)(k0 + kk) * ldw + src_col0 + n0 + (lane & 31)]; }
    LDS_WAIT(); asm volatile("" ::: "memory");
    const int c = lane & 7;
#pragma unroll
    for (int j = 0; j < 4; ++j) { const int n = (lane >> 3) + 8 * j; const LAS float* s = scr + (8 * c) * 33 + n;
        u32x4 o; o.x = pk2(s[0 * 33], s[1 * 33]); o.y = pk2(s[2 * 33], s[3 * 33]); o.z = pk2(s[4 * 33], s[5 * 33]); o.w = pk2(s[6 * 33], s[7 * 33]);
        *(u32x4*)(WT + (size_t)(dst_row0 + n0 + n) * ldt + dst_col0 + k0 + 8 * c) = o; }
    LDS_WAIT(); asm volatile("" ::: "memory");
}
__device__ __forceinline__ void rms_row_to_bf16(const float* xrow, const float* w, bf16* orow, int lane, f32x4 (&v)[4]) {
    const f32x4* xr = (const f32x4*)xrow + lane; const f32x4* wr = (const f32x4*)w + lane;
    float s = 0.f;
#pragma unroll
    for (int j = 0; j < 4; ++j) { v[j] = xr[64 * j]; s += (v[j].x * v[j].x + v[j].y * v[j].y) + (v[j].z * v[j].z + v[j].w * v[j].w); }
    const float rstd = 1.0f / sqrtf(wave_sum(s) * (1.f / DM) + EPS);
    unsigned long long* o8 = (unsigned long long*)orow + lane;
#pragma unroll
    for (int j = 0; j < 4; ++j) { const f32x4 ww = wr[64 * j]; v[j] = v[j] * rstd * ww;
        o8[64 * j] = (unsigned long long)pk2(v[j].x, v[j].y) | ((unsigned long long)pk2(v[j].z, v[j].w) << 32); }
}
__device__ __forceinline__ void cvt_f32_bf16_stream(const float* src, bf16* dst, size_t n, size_t gtid, size_t gthreads) {
    for (size_t i = gtid * 8; i < n; i += gthreads * 8) { const f32x4 a = *(const f32x4*)(src + i), b = *(const f32x4*)(src + i + 4);
        u32x4 o; o.x = pk2(a.x, a.y); o.y = pk2(a.z, a.w); o.z = pk2(b.x, b.y); o.w = pk2(b.z, b.w); *(u32x4*)(dst + i) = o; }
}
constexpr float PD_SCALE = 64.0f, PU_SCALE = 8.0f;
__device__ __forceinline__ unsigned pk4_fp8(f32x4 v, float sc) {
    const float a = fminf(fmaxf(v.x * sc, -448.f), 448.f), b = fminf(fmaxf(v.y * sc, -448.f), 448.f), c = fminf(fmaxf(v.z * sc, -448.f), 448.f), d = fminf(fmaxf(v.w * sc, -448.f), 448.f);
    unsigned p = __builtin_amdgcn_cvt_pk_fp8_f32(a, b, 0, false); return __builtin_amdgcn_cvt_pk_fp8_f32(c, d, p, true);
}
__device__ __forceinline__ void cvt_f32_fp8_sliced(const float* src, unsigned char* dst, float sc, size_t gtid, size_t gthreads) {
    for (size_t i = gtid * 16; i < (size_t)16384 * 1024; i += gthreads * 16) { const f32x4 a = *(const f32x4*)(src + i), b = *(const f32x4*)(src + i + 4), c = *(const f32x4*)(src + i + 8), d = *(const f32x4*)(src + i + 12);
        const size_t e = i >> 10, dd = i & 1023;
        const u32x4 o = {pk4_fp8(a, sc), pk4_fp8(b, sc), pk4_fp8(c, sc), pk4_fp8(d, sc)}; *(u32x4*)(dst + ((((dd >> 7) * 16384 + e) << 7) + (dd & 127))) = o; }
}
__device__ __forceinline__ void p0_prologue(Frame& F) {
    LAS float* scr = (LAS float*)(F.lds + F.wave * 8448);
    LAS float* wdt = (LAS float*)(F.lds + 8 * 8448);
    const int gw = F.bid * NWAVES + F.wave, NGW = F.G * NWAVES;
    unsigned char* ws = F.ws;
    for (int i = F.tid; i < 1024 * 16; i += NTHR) { const int k = i >> 4, c = i & 15, l = (k & 255) >> 2, e = k & 3, j = k >> 8, q = c >> 2;
        wdt[((((j * 4 + e) * 4 + q) * 64 + l) << 2) + (c & 3)] = F.in[I_WIN][(size_t)k * W_IN_N + OFF_DT + c]; }
    __syncthreads();
    constexpr int IT_A = 16 * 96, IT_B = 16 * 192, IT_MKV = 16 * 48, IT_SSD = 16 * 32, IT_DIL = 4 * 32, IT_MBR = 12 * 32, IT_OUT = 16 * 32, IT_WQ = 16 * 64;
    constexpr int NITEMS = IT_A + IT_B + IT_MKV + IT_SSD + IT_DIL + IT_MBR + IT_OUT + IT_WQ;
    bf16* WallT = (bf16*)(ws + WS_WALLT);
    for (int it = gw; it < NITEMS; it += NGW) {
        int r = it;
        if (r < IT_A) { p0_transpose_item(F.in[I_WIN], W_IN_N, 0, WallT, DM, 0, 0, 96, scr, r, F.lane); continue; } r -= IT_A;
        if (r < IT_B) { p0_transpose_item(F.in[I_WIN], W_IN_N, OFF_AFTER_DT, WallT, DM, 3072, 0, 192, scr, r, F.lane); continue; } r -= IT_B;
        if (r < IT_MKV) { p0_transpose_item(F.in[I_WMKV], 1536, 0, (bf16*)(ws + WS_WMKVT), DM, 0, 0, 48, scr, r, F.lane); continue; } r -= IT_MKV;
        if (r < IT_SSD) { p0_transpose_item(F.in[I_WSSD], DM, 0, (bf16*)(ws + WS_WCATT), YC, 0, 0, 32, scr, r, F.lane); continue; } r -= IT_SSD;
        if (r < IT_DIL) { p0_transpose_item(F.in[I_WDIL], DM, 0, (bf16*)(ws + WS_WCATT), YC, 0, 1024, 32, scr, r, F.lane); continue; } r -= IT_DIL;
        if (r < IT_MBR) { p0_transpose_item(F.in[I_WMEMBR], DM, 0, (bf16*)(ws + WS_WCATT), YC, 0, 1280, 32, scr, r, F.lane); continue; } r -= IT_MBR;
        if (r < IT_OUT) { p0_transpose_item(F.in[I_WOUT], DM, 0, (bf16*)(ws + WS_WOUTT), DM, 0, 0, 32, scr, r, F.lane); continue; } r -= IT_OUT;
        p0_transpose_item(F.in[I_WQ], PEER_Q, 0, (bf16*)(ws + WS_WQT), DM, 0, 0, 64, scr, r, F.lane);
    }
    const size_t gtid = (size_t)F.bid * NTHR + F.tid, gth = (size_t)F.G * NTHR;
    cvt_f32_bf16_stream(F.in[I_SUBK], (bf16*)(ws + WS_SUBK), (size_t)8 * 2 * 128 * 128, gtid, gth);
    cvt_f32_fp8_sliced(F.in[I_PD], ws + WS_PD, PD_SCALE, gtid, gth);
    cvt_f32_fp8_sliced(F.in[I_PU], ws + WS_PU, PU_SCALE, gtid, gth);
    for (int m = gw; m < NB * NMEM; m += NGW) { f32x4 v[4]; rms_row_to_bf16(F.in[I_MEM] + (size_t)m * DM, F.in[I_MEMNW], (bf16*)(ws + WS_MEMN) + (size_t)m * DM, F.lane, v); }
    float* DTp = (float*)(ws + WS_DT);
    const int lane = F.lane;
    const int myj = ((lane >> 5) & 1) * 8 + ((lane >> 4) & 1) * 4 + ((lane >> 3) & 1) * 2 + ((lane >> 2) & 1);
    const float dtb = F.in[I_DTB][myj];
    for (int m = 2 * gw; m < T; m += 2 * NGW) {
        f32x4 va[4], vb[4];
        rms_row_to_bf16(F.in[I_X] + (size_t)m * DM, F.in[I_NMIXW], (bf16*)(ws + WS_ACT1) + (size_t)m * DM, lane, va);
        rms_row_to_bf16(F.in[I_X] + (size_t)(m + 1) * DM, F.in[I_NMIXW], (bf16*)(ws + WS_ACT1) + (size_t)(m + 1) * DM, lane, vb);
        float da[16], db[16];
#pragma unroll
        for (int j = 0; j < 16; ++j) { da[j] = 0.f; db[j] = 0.f; }
#pragma unroll
        for (int j = 0; j < 4; ++j)
#pragma unroll
            for (int e = 0; e < 4; ++e) { const float ua = va[j][e], ub = vb[j][e];
#pragma unroll
                for (int q = 0; q < 4; ++q) { const f32x4 w4 = *(const LAS f32x4*)(wdt + ((((j * 4 + e) * 4 + q) * 64 + lane) << 2));
                    da[4 * q + 0] += ua * w4.x; da[4 * q + 1] += ua * w4.y; da[4 * q + 2] += ua * w4.z; da[4 * q + 3] += ua * w4.w;
                    db[4 * q + 0] += ub * w4.x; db[4 * q + 1] += ub * w4.y; db[4 * q + 2] += ub * w4.z; db[4 * q + 3] += ub * w4.w; }
                __builtin_amdgcn_sched_barrier(0); }
        float ra, rb;
        { float r8a[8], r8b[8], r4a[4], r4b[4], r2a[2], r2b[2];
          { const bool up = (lane & 32) != 0;
#pragma unroll
            for (int k = 0; k < 8; ++k) { r8a[k] = (up ? da[k + 8] : da[k]) + __shfl_xor(up ? da[k] : da[k + 8], 32); r8b[k] = (up ? db[k + 8] : db[k]) + __shfl_xor(up ? db[k] : db[k + 8], 32); } }
          { const bool up = (lane & 16) != 0;
#pragma unroll
            for (int k = 0; k < 4; ++k) { r4a[k] = (up ? r8a[k + 4] : r8a[k]) + __shfl_xor(up ? r8a[k] : r8a[k + 4], 16); r4b[k] = (up ? r8b[k + 4] : r8b[k]) + __shfl_xor(up ? r8b[k] : r8b[k + 4], 16); } }
          { const bool up = (lane & 8) != 0;
#pragma unroll
            for (int k = 0; k < 2; ++k) { r2a[k] = (up ? r4a[k + 2] : r4a[k]) + __shfl_xor(up ? r4a[k] : r4a[k + 2], 8); r2b[k] = (up ? r4b[k + 2] : r4b[k]) + __shfl_xor(up ? r4b[k] : r4b[k + 2], 8); } }
          { const bool up = (lane & 4) != 0; ra = (up ? r2a[1] : r2a[0]) + __shfl_xor(up ? r2a[0] : r2a[1], 4); rb = (up ? r2b[1] : r2b[0]) + __shfl_xor(up ? r2b[0] : r2b[1], 4); }
          ra += __shfl_xor(ra, 2); ra += __shfl_xor(ra, 1); rb += __shfl_xor(rb, 2); rb += __shfl_xor(rb, 1); }
        if ((lane & 3) == 0) { const float xa = ra + dtb, xb = rb + dtb;
            DTp[(size_t)m * 16 + myj] = (xa > 20.f) ? xa : log1pf(__expf(xa)); DTp[(size_t)(m + 1) * 16 + myj] = (xb > 20.f) ? xb : log1pf(__expf(xb)); }
    }
}

__device__ __forceinline__ void norm192_inplace(bf16* p, const float (&w)[4], int lane) {
    u32x2 v = {0u, 0u};
    if (lane < 48) v = *(const u32x2*)(p + 4 * lane);
    float x0 = bflo(v.x), x1 = bfhi(v.x), x2 = bflo(v.y), x3 = bfhi(v.y);
    const float ss = wave_sum((x0 * x0 + x1 * x1) + (x2 * x2 + x3 * x3));
    const float rs = 1.0f / sqrtf(ss * (1.f / 192.f) + EPS);
    if (lane < 48) { const u32x2 o = {pkbf(x0 * rs * w[0], x1 * rs * w[1]), pkbf(x2 * rs * w[2], x3 * rs * w[3])}; *(u32x2*)(p + 4 * lane) = o; }
}
__device__ __forceinline__ void qkprep_phase(Frame& F, int half) {
    bf16* P = (bf16*)(F.ws + WS_BIG);
    const int gw = F.bid * NWAVES + F.wave, NGW = F.G * NWAVES, lane = F.lane, sub = lane & 7;
    float wq[8], wk[8], wmq[4], wmk[4];
#pragma unroll
    for (int j = 0; j < 8; ++j) { wq[j] = F.in[I_DQNW][8 * sub + j]; wk[j] = F.in[I_DKNW][8 * sub + j]; }
#pragma unroll
    for (int j = 0; j < 4; ++j) { wmq[j] = F.in[I_MQNW][(4 * lane + j) % 192]; wmk[j] = F.in[I_MKNW][(4 * lane + j) % 192]; }
    const float inv = __expf(-logf(500000.0f) * (2.0f / 16.0f) * (float)sub);
    for (int r0 = gw; r0 < HT; r0 += 2 * NGW) {
        bf16* rowp[2]; u32x4 v[2][3]; u32x2 m[2][4]; int pos[2];
#pragma unroll
        for (int u = 0; u < 2; ++u) { const int r = (r0 + u * NGW < HT) ? r0 + u * NGW : r0; rowp[u] = P + (size_t)r * NPROJ; pos[u] = F.positions[half * HT + r];
#pragma unroll
            for (int blk = 0; blk < 3; ++blk) v[u][blk] = *(const u32x4*)(rowp[u] + PC_DQ + blk * 512 + 8 * lane);
#pragma unroll
            for (int h = 0; h < 4; ++h) { m[u][h] = (u32x2){0u, 0u}; if (lane < 48) m[u][h] = *(const u32x2*)(rowp[u] + PC_MQ + h * 192 + 4 * lane); } }
#pragma unroll
        for (int u = 0; u < 2; ++u) {
            if (u == 1 && r0 + NGW >= HT) break;
            const double rev = (double)((float)pos[u] * inv) * 0.15915494309189535;
            const float fr = (float)(rev - floor(rev));
            const float cs = __builtin_amdgcn_cosf(fr), sn = __builtin_amdgcn_sinf(fr);
            float cj[8], sj[8];
#pragma unroll
            for (int j = 0; j < 8; ++j) { cj[j] = __shfl(cs, (lane & ~7) | j); sj[j] = __shfl(sn, (lane & ~7) | j); }
            bf16* row = rowp[u];
#pragma unroll
            for (int blk = 0; blk < 3; ++blk) {
                float x[8] = {bflo(v[u][blk].x), bfhi(v[u][blk].x), bflo(v[u][blk].y), bfhi(v[u][blk].y), bflo(v[u][blk].z), bfhi(v[u][blk].z), bflo(v[u][blk].w), bfhi(v[u][blk].w)};
                float ss = 0.f;
#pragma unroll
                for (int j = 0; j < 8; ++j) ss += x[j] * x[j];
                ss += __shfl_xor(ss, 1); ss += __shfl_xor(ss, 2); ss += __shfl_xor(ss, 4);
                const float rs = 1.0f / sqrtf(ss * (1.f / 64.f) + EPS);
                const bool isq = (8 * blk + (lane >> 3)) < 12;
#pragma unroll
                for (int j = 0; j < 8; ++j) x[j] = x[j] * rs * (isq ? wq[j] : wk[j]);
#pragma unroll
                for (int j = 0; j < 8; ++j) { const float o = __shfl_xor(x[j], 1);
                    if (sub == 0) x[j] = x[j] * cj[j] - o * sj[j]; else if (sub == 1) x[j] = x[j] * cj[j] + o * sj[j]; }
                const u32x4 w = {pkbf(x[0], x[1]), pkbf(x[2], x[3]), pkbf(x[4], x[5]), pkbf(x[6], x[7])};
                *(u32x4*)(row + PC_DQ + blk * 512 + 8 * lane) = w;
            }
#pragma unroll
            for (int h = 0; h < 4; ++h) { const u32x2 q = m[u][h]; const float x0 = bflo(q.x), x1 = bfhi(q.x), x2 = bflo(q.y), x3 = bfhi(q.y);
                const float ss = wave_sum((x0 * x0 + x1 * x1) + (x2 * x2 + x3 * x3));
                const float rs = 1.0f / sqrtf(ss * (1.f / 192.f) + EPS);
                if (lane < 48) { const u32x2 o = {pkbf(x0 * rs * wmq[0], x1 * rs * wmq[1]), pkbf(x2 * rs * wmq[2], x3 * rs * wmq[3])}; *(u32x2*)(row + PC_MQ + h * 192 + 4 * lane) = o; } }
        }
    }
    if (half == 0) {
        bf16* MK = (bf16*)(F.ws + WS_MKV);
        for (int r = gw; r < NB * NMEM * 4; r += NGW) norm192_inplace(MK + (size_t)(r >> 2) * 1536 + (r & 3) * 192, wmk, lane);
    }
}

constexpr int SC_ST = 272, SX_ST = 528;
__device__ __forceinline__ float bfsel(const u32x4& v, int j) { const unsigned w = v[j >> 1]; return (j & 1) ? bfhi(w) : bflo(w); }
__device__ __forceinline__ void conv_task(const bf16* P, size_t rowb, int t0, int pcol, const float* cw, const float* cb, int ccol, LAS unsigned char* dst, int stride, const LAS float* scale) {
    float w[4][8], bs[8];
#pragma unroll
    for (int k = 0; k < 4; ++k) { const f32x4 a = *(const f32x4*)(cw + k * 2048 + ccol), b = *(const f32x4*)(cw + k * 2048 + ccol + 4);
        w[k][0] = a.x; w[k][1] = a.y; w[k][2] = a.z; w[k][3] = a.w; w[k][4] = b.x; w[k][5] = b.y; w[k][6] = b.z; w[k][7] = b.w; }
    { const f32x4 a = *(const f32x4*)(cb + ccol), b = *(const f32x4*)(cb + ccol + 4); bs[0] = a.x; bs[1] = a.y; bs[2] = a.z; bs[3] = a.w; bs[4] = b.x; bs[5] = b.y; bs[6] = b.z; bs[7] = b.w; }
    const bf16* src = P + (rowb + t0) * NPROJ + pcol;
    u32x4 rw[19];
#pragma unroll
    for (int i = 0; i < 3; ++i) rw[i] = (u32x4){0u, 0u, 0u, 0u};
    if (t0 > 0) {
#pragma unroll
        for (int i = 0; i < 3; ++i) rw[i] = *(const u32x4*)(src + (ptrdiff_t)(i - 3) * NPROJ); }
#pragma unroll
    for (int i = 0; i < 16; ++i) rw[3 + i] = *(const u32x4*)(src + (size_t)i * NPROJ);
#pragma unroll
    for (int i = 0; i < 16; ++i) {
        float o[8];
#pragma unroll
        for (int j = 0; j < 8; ++j) { float a = bs[j] + w[0][j] * bfsel(rw[i], j) + w[1][j] * bfsel(rw[i + 1], j) + w[2][j] * bfsel(rw[i + 2], j) + w[3][j] * bfsel(rw[i + 3], j); o[j] = a * sigmoidf_(a); }
        if (scale) { const float sv = scale[i];
#pragma unroll
            for (int j = 0; j < 8; ++j) o[j] *= sv; }
        const u32x4 r = {pkbf(o[0], o[1]), pkbf(o[2], o[3]), pkbf(o[4], o[5]), pkbf(o[6], o[7])};
        *(LAS u32x4*)(dst + i * stride) = r;
    }
}
__device__ __forceinline__ float ssd_scan(Frame& F, const float* DTp, size_t tok0, int g, LAS float* sAc, LAS float* sDt) {
    float total = 0.f;
    if (F.wave < 4) {
        const int head = 4 * g + F.wave, lane = F.lane;
        const float A = -__expf(F.in[I_ALOG][head]);
        const float d0 = DTp[(tok0 + 2 * lane) * 16 + head], d1 = DTp[(tok0 + 2 * lane + 1) * 16 + head];
        const float a0 = d0 * A, a1 = d1 * A;
        float sc = a0 + a1;
#pragma unroll
        for (int o = 1; o < 64; o <<= 1) { const float v = __shfl_up(sc, o); if (lane >= o) sc += v; }
        sAc[F.wave * 128 + 2 * lane] = sc - a1; sAc[F.wave * 128 + 2 * lane + 1] = sc;
        sDt[F.wave * 128 + 2 * lane] = d0; sDt[F.wave * 128 + 2 * lane + 1] = d1;
        total = __shfl(sc, 63);
    }
    return total;
}
__device__ __forceinline__ bf16x8 tr_pair(unsigned a_lo, unsigned a_hi) {
    s16x4 lo, hi;
    asm volatile("ds_read_b64_tr_b16 %0, %2\n\tds_read_b64_tr_b16 %1, %3\n\ts_waitcnt lgkmcnt(0)" : "=&v"(lo), "=&v"(hi) : "v"(a_lo), "v"(a_hi) : "memory");
    const bf16x8 r = {lo[0], lo[1], lo[2], lo[3], hi[0], hi[1], hi[2], hi[3]}; return r;
}

__device__ __forceinline__ void ssdC_phase(Frame& F, int half) {
    const bf16* P = (const bf16*)(F.ws + WS_BIG);
    const float* DTp = (const float*)(F.ws + WS_DT);
    float* SST = (float*)(F.ws + WS_SST); float* DEC = (float*)(F.ws + WS_DEC);
    LAS unsigned char* sX = F.lds; LAS unsigned char* sB = F.lds + 128 * SX_ST;
    LAS float* sAc = (LAS float*)(F.lds + 128 * SX_ST + 128 * SC_ST); LAS float* sDt = sAc + 512; LAS float* sW = sDt + 512;
    const int wave = F.wave;
    for (int unit = F.bid; unit < HB * 64 * 4; unit += F.G) {
        int tid = F.tid; asm volatile("" : "+v"(tid));
        const int lane = tid & 63, ql = lane & 31, h = lane >> 5, tq = (lane & 15) >> 2, tp = lane & 3, tblk = (lane >> 4) & 1;
        const int bl = unit >> 8, c = (unit >> 2) & 63, g = unit & 3;
        const size_t rowb = (size_t)bl * SEQ, tok0 = (size_t)half * HT + rowb + c * 128;
        __syncthreads();
        const float total = ssd_scan(F, DTp, tok0, g, sAc, sDt);
        if (wave < 4) { sW[wave * 128 + 2 * lane] = __expf(total - sAc[wave * 128 + 2 * lane]) * sDt[wave * 128 + 2 * lane];
            sW[wave * 128 + 2 * lane + 1] = __expf(total - sAc[wave * 128 + 2 * lane + 1]) * sDt[wave * 128 + 2 * lane + 1];
            if (lane == 0) DEC[((size_t)bl * 64 + c) * 16 + 4 * g + wave] = __expf(total); }
        __syncthreads();
        if (tid < 384) {
            int ch, strip, ccol, stride; LAS unsigned char* dst; const LAS float* scl = nullptr;
            if (tid < 256) { ch = tid & 31; strip = tid >> 5; ccol = g * 256 + 8 * ch; stride = SX_ST; dst = sX + (strip * 16) * SX_ST + ch * 16; scl = sW + (ch >> 3) * 128 + strip * 16; }
            else { const int u = tid - 256; ch = u & 15; strip = u >> 4; ccol = 1024 + g * 128 + 8 * ch; stride = SC_ST; dst = sB + (strip * 16) * SC_ST + ch * 16; }
            conv_task(P, rowb, c * 128 + strip * 16, PC_X + ccol, F.in[I_CONVW], F.in[I_CONVB], ccol, dst, stride, scl);
        }
        __syncthreads();
        const int r = wave >> 1, pt = wave & 1;
        f32x16 acc[4];
#pragma unroll
        for (int nt = 0; nt < 4; ++nt)
#pragma unroll
            for (int e = 0; e < 16; ++e) acc[nt][e] = 0.f;
        const unsigned xa = (unsigned)(size_t)sX + (unsigned)((8 * h + tq) * SX_ST + (r * 64 + 32 * pt + 16 * tblk + 4 * tp) * 2);
        const unsigned ba = (unsigned)(size_t)sB + (unsigned)((8 * h + tq) * SC_ST + (16 * tblk + 4 * tp) * 2);
#pragma unroll
        for (int ks = 0; ks < 8; ++ks) {
            const bf16x8 af = tr_pair(xa + ks * 16 * SX_ST, xa + ks * 16 * SX_ST + 4 * SX_ST);
            bf16x8 bfr[4];
#pragma unroll
            for (int nt = 0; nt < 4; ++nt) bfr[nt] = tr_pair(ba + ks * 16 * SC_ST + nt * 64, ba + ks * 16 * SC_ST + 4 * SC_ST + nt * 64);
            __builtin_amdgcn_sched_barrier(0);
#pragma unroll
            for (int nt = 0; nt < 4; ++nt) acc[nt] = MFMA32(af, bfr[nt], acc[nt]);
        }
        float* out = SST + (((size_t)bl * 64 + c) * 16 + 4 * g + r) * 8192;
#pragma unroll
        for (int nt = 0; nt < 4; ++nt)
#pragma unroll
            for (int e = 0; e < 16; ++e) out[(32 * pt + (e & 3) + 8 * (e >> 2) + 4 * h) * 128 + 32 * nt + ql] = acc[nt][e];
    }
}

__device__ __forceinline__ void ssdD_phase(Frame& F) {
    const float* SST = (const float*)(F.ws + WS_SST); const float* DEC = (const float*)(F.ws + WS_DEC);
    bf16* SIN = (bf16*)(F.ws + WS_SIN);
    const size_t gtid = (size_t)F.bid * NTHR + F.tid, gth = (size_t)F.G * NTHR;
    for (size_t it = gtid; it < (size_t)HB * 16 * 2048; it += gth) {
        const int bl = (int)(it >> 15), head = (int)(it >> 11) & 15, e4 = (int)(it & 2047) * 4;
        f32x4 st = {0.f, 0.f, 0.f, 0.f};
#pragma unroll 8
        for (int c = 0; c < 64; ++c) {
            const size_t idx = (((size_t)bl * 64 + c) * 16 + head);
            const u32x2 o = {pkbf(st.x, st.y), pkbf(st.z, st.w)};
            *(u32x2*)(SIN + idx * 8192 + e4) = o;
            const f32x4 sl = *(const f32x4*)(SST + idx * 8192 + e4); const float d = DEC[idx];
            st = st * d + sl;
        }
    }
}

__device__ __forceinline__ void ssdE_phase(Frame& F, int half) {
    const bf16* P = (const bf16*)(F.ws + WS_BIG);
    const float* DTp = (const float*)(F.ws + WS_DT);
    const bf16* SIN = (const bf16*)(F.ws + WS_SIN);
    bf16* Y = (bf16*)F.out;
    LAS unsigned char* sX = F.lds; LAS unsigned char* sB = F.lds + 128 * SX_ST; LAS unsigned char* sC = sB + 128 * SC_ST;
    LAS float* sAc = (LAS float*)(sC + 128 * SC_ST); LAS float* sDt = sAc + 512; LAS float* sSS = sDt + 512;
    const int wave = F.wave;
    const int st = wave & 3, hp = wave >> 2;
    for (int unit = F.bid; unit < HB * 64 * 4; unit += F.G) {
        int tid = F.tid; asm volatile("" : "+v"(tid));
        const int lane = tid & 63, ql = lane & 31, h = lane >> 5, tq = (lane & 15) >> 2, tp = lane & 3, tblk = (lane >> 4) & 1;
        const int bl = unit >> 8, c = (unit >> 2) & 63, g = unit & 3;
        const size_t rowb = (size_t)bl * SEQ, tok0 = (size_t)half * HT + rowb + c * 128;
        __syncthreads();
        (void)ssd_scan(F, DTp, tok0, g, sAc, sDt);
        if (tid < 128) sSS[tid] = 0.f;
        {
            int ch, strip, ccol, stride; LAS unsigned char* dst;
            if (tid < 256) { ch = tid & 31; strip = tid >> 5; ccol = g * 256 + 8 * ch; stride = SX_ST; dst = sX + (strip * 16) * SX_ST + ch * 16; }
            else if (tid < 384) { const int u = tid - 256; ch = u & 15; strip = u >> 4; ccol = 1024 + g * 128 + 8 * ch; stride = SC_ST; dst = sB + (strip * 16) * SC_ST + ch * 16; }
            else { const int u = tid - 384; ch = u & 15; strip = u >> 4; ccol = 1536 + g * 128 + 8 * ch; stride = SC_ST; dst = sC + (strip * 16) * SC_ST + ch * 16; }
            conv_task(P, rowb, c * 128 + strip * 16, PC_X + ccol, F.in[I_CONVW], F.in[I_CONVB], ccol, dst, stride, nullptr);
        }
        __syncthreads();
        const int s = 32 * st + ql;
        unsigned yk[2][2][8];
        float ssq = 0.f;
        const unsigned xa = (unsigned)(size_t)sX + (unsigned)((4 * h + tq) * SX_ST + (16 * tblk + 4 * tp) * 2);
#pragma unroll
        for (int hq = 0; hq < 2; ++hq) {
            const int r = 2 * hp + hq, head = 4 * g + r;
            const float acs = sAc[r * 128 + s];
            const bf16* stp = SIN + (((size_t)bl * 64 + c) * 16 + head) * 8192 + ql * 128 + 8 * h;
            bf16x8 sfr[2][8];
#pragma unroll
            for (int pt = 0; pt < 2; ++pt)
#pragma unroll
                for (int ks = 0; ks < 8; ++ks) sfr[pt][ks] = *(const bf16x8*)(stp + pt * 4096 + 16 * ks);
            bf16x8 pf[4][2];
#pragma unroll
            for (int i = 0; i < 4; ++i) {
                f32x16 Xi;
#pragma unroll
                for (int e = 0; e < 16; ++e) Xi[e] = 0.f;
#pragma unroll
                for (int ks = 0; ks < 8; ++ks) { const bf16x8 bf_ = *(const LAS bf16x8*)(sB + (32 * i + ql) * SC_ST + 32 * ks + 16 * h);
                    const bf16x8 cf = *(const LAS bf16x8*)(sC + s * SC_ST + 32 * ks + 16 * h); Xi = MFMA32(bf_, cf, Xi); }
                float p[16];
#pragma unroll
                for (int q4 = 0; q4 < 4; ++q4) { const int t0 = 32 * i + 8 * q4 + 4 * h;
                    const f32x4 at = *(const LAS f32x4*)(sAc + r * 128 + t0), dt4 = *(const LAS f32x4*)(sDt + r * 128 + t0);
#pragma unroll
                    for (int e = 0; e < 4; ++e) { const int t = t0 + e; p[4 * q4 + e] = (t <= s) ? Xi[4 * q4 + e] * __expf(acs - at[e]) * dt4[e] : 0.f; } }
#pragma unroll
                for (int s2 = 0; s2 < 2; ++s2) { const u32x4 w = {pkbf(p[8 * s2 + 0], p[8 * s2 + 1]), pkbf(p[8 * s2 + 2], p[8 * s2 + 3]), pkbf(p[8 * s2 + 4], p[8 * s2 + 5]), pkbf(p[8 * s2 + 6], p[8 * s2 + 7])};
                    pf[i][s2] = __builtin_bit_cast(bf16x8, w); }
            }
            const float eacs = __expf(acs), Dh = F.in[I_SSDD][head];
#pragma unroll
            for (int pt = 0; pt < 2; ++pt) {
                f32x16 yd, yo;
#pragma unroll
                for (int e = 0; e < 16; ++e) { yd[e] = 0.f; yo[e] = 0.f; }
#pragma unroll
                for (int i = 0; i < 4; ++i) {
#pragma unroll
                    for (int s2 = 0; s2 < 2; ++s2) { const unsigned a = xa + (unsigned)((32 * i + 16 * s2) * SX_ST + (r * 64 + 32 * pt) * 2);
                        const bf16x8 xf = tr_pair(a, a + 8 * SX_ST); __builtin_amdgcn_sched_barrier(0); yd = MFMA32(xf, pf[i][s2], yd); }
                }
#pragma unroll
                for (int ks = 0; ks < 8; ++ks) { const bf16x8 cf = *(const LAS bf16x8*)(sC + s * SC_ST + 32 * ks + 16 * h); yo = MFMA32(sfr[pt][ks], cf, yo); }
                const bf16* zp = P + (rowb + c * 128 + s) * NPROJ + PC_Z + g * 256 + r * 64 + 32 * pt + 4 * h;
                u32x2 zv[4];
#pragma unroll
                for (int q4 = 0; q4 < 4; ++q4) zv[q4] = *(const u32x2*)(zp + 8 * q4);
#pragma unroll
                for (int q4 = 0; q4 < 4; ++q4) {
                    const u32x2 xv = *(const LAS u32x2*)(sX + s * SX_ST + (r * 64 + 32 * pt + 8 * q4 + 4 * h) * 2);
                    const u32x2 zq = zv[q4];
                    const float xs_[4] = {bflo(xv.x), bfhi(xv.x), bflo(xv.y), bfhi(xv.y)}, zs_[4] = {bflo(zq.x), bfhi(zq.x), bflo(zq.y), bfhi(zq.y)};
                    float yv[4];
#pragma unroll
                    for (int e = 0; e < 4; ++e) { float y = yd[4 * q4 + e] + eacs * yo[4 * q4 + e] + Dh * xs_[e]; y = y * zs_[e] * sigmoidf_(zs_[e]); yv[e] = y; ssq += y * y; }
                    yk[hq][pt][2 * q4] = pkbf(yv[0], yv[1]); yk[hq][pt][2 * q4 + 1] = pkbf(yv[2], yv[3]);
                }
            }
        }
        ssq += __shfl_xor(ssq, 32);
        if (h == 0) __hip_atomic_fetch_add(sSS + s, ssq, __ATOMIC_RELAXED, __HIP_MEMORY_SCOPE_WORKGROUP);
        __syncthreads();
        const float rs = 1.0f / sqrtf(sSS[s] * (1.f / 256.f) + EPS);
        bf16* yp = Y + (tok0 + s) * YC + g * 256 + 4 * h;
        const float* nw = F.in[I_SSDNW] + g * 256 + 4 * h;
#pragma unroll
        for (int hq = 0; hq < 2; ++hq)
#pragma unroll
            for (int pt = 0; pt < 2; ++pt)
#pragma unroll
                for (int q4 = 0; q4 < 4; ++q4) { const int cc = (2 * hp + hq) * 64 + 32 * pt + 8 * q4; const f32x4 w4 = *(const f32x4*)(nw + cc);
                    const unsigned ya = yk[hq][pt][2 * q4], yb = yk[hq][pt][2 * q4 + 1];
                    const u32x2 o = {pkbf(bflo(ya) * rs * w4.x, bfhi(ya) * rs * w4.y), pkbf(bflo(yb) * rs * w4.z, bfhi(yb) * rs * w4.w)};
                    *(u32x2*)(yp + cc) = o; }
    }
}

__device__ __forceinline__ bf16x8 mk_bf16x8(u32x2 lo, u32x2 hi) { const u32x4 v = {lo.x, lo.y, hi.x, hi.y}; return __builtin_bit_cast(bf16x8, v); }

__device__ __forceinline__ void memattn_mfma_phase(Frame& F, int half) {
    const bf16* P = (const bf16*)(F.ws + WS_BIG);
    const bf16* MKV = (const bf16*)(F.ws + WS_MKV);
    const bf16* MVT = (const bf16*)(F.ws + WS_MVT);
    bf16* Y = (bf16*)F.out;
    LAS unsigned char* sm = F.lds;
    const int tid = F.tid, lane = F.lane, wave = F.wave, ql = lane & 31, h = lane >> 5;
    constexpr int KST = 400, VST = 528;
    for (int unit = F.bid; unit < HB * 4 * 32; unit += F.G) {
        const int bl = unit >> 7, head = (unit >> 5) & 3, qt = unit & 31, b = half * HB + bl;
        const int r = bl * SEQ + qt * 256 + wave * 32 + ql;
        __syncthreads();
        for (int c = tid; c < 256 * 24; c += NTHR) { const int row = c / 24, ch = c % 24;
            *(LAS u32x4*)(sm + row * KST + ch * 16) = *(const u32x4*)(MKV + (size_t)(b * NMEM + row) * 1536 + head * 192 + ch * 8); }
        bf16x8 qf[12];
        { const bf16* qp = P + (size_t)r * NPROJ + PC_MQ + head * 192 + 8 * h;
#pragma unroll
          for (int ks = 0; ks < 12; ++ks) qf[ks] = *(const bf16x8*)(qp + 16 * ks); }
        __syncthreads();
        f32x16 sacc[8];
#pragma unroll
        for (int mt = 0; mt < 8; ++mt) {
#pragma unroll
            for (int i = 0; i < 16; ++i) sacc[mt][i] = 0.f;
#pragma unroll
            for (int ks = 0; ks < 12; ++ks) { const bf16x8 kf = *(const LAS bf16x8*)(sm + (32 * mt + ql) * KST + 32 * ks + 16 * h); sacc[mt] = MFMA32(kf, qf[ks], sacc[mt]); }
        }
        float mx = -3.0e38f;
#pragma unroll
        for (int mt = 0; mt < 8; ++mt)
#pragma unroll
            for (int i = 0; i < 16; ++i) mx = fmaxf(mx, sacc[mt][i]);
        mx = fmaxf(mx, __shfl_xor(mx, 32));
        const float sc = 0.07216878364870323f * 1.4426950408889634f;
        float l = 0.f;
        bf16x8 pf[8][2];
#pragma unroll
        for (int mt = 0; mt < 8; ++mt) {
            float p[16];
#pragma unroll
            for (int i = 0; i < 16; ++i) { p[i] = __builtin_amdgcn_exp2f((sacc[mt][i] - mx) * sc); l += p[i]; }
#pragma unroll
            for (int s2 = 0; s2 < 2; ++s2) { const u32x4 w = {pkbf(p[8 * s2 + 0], p[8 * s2 + 1]), pkbf(p[8 * s2 + 2], p[8 * s2 + 3]), pkbf(p[8 * s2 + 4], p[8 * s2 + 5]), pkbf(p[8 * s2 + 6], p[8 * s2 + 7])};
                pf[mt][s2] = __builtin_bit_cast(bf16x8, w); }
        }
        l += __shfl_xor(l, 32);
        __syncthreads();
        for (int c = tid; c < 192 * 32; c += NTHR) { const int row = c >> 5, ch = c & 31;
            *(LAS u32x4*)(sm + row * VST + ch * 16) = *(const u32x4*)(MVT + (size_t)(head * 192 + row) * 2048 + b * NMEM + ch * 8); }
        __syncthreads();
        const float il = 1.0f / l;
        bf16* yp = Y + ((size_t)half * HT + r) * YC + 1280 + head * 192 + 4 * h;
#pragma unroll
        for (int dt = 0; dt < 6; ++dt) {
            f32x16 o;
#pragma unroll
            for (int i = 0; i < 16; ++i) o[i] = 0.f;
#pragma unroll
            for (int mt = 0; mt < 8; ++mt)
#pragma unroll
                for (int s2 = 0; s2 < 2; ++s2) { const LAS unsigned char* vp = sm + (32 * dt + ql) * VST + (32 * mt + 16 * s2 + 4 * h) * 2;
                    const bf16x8 vf = mk_bf16x8(*(const LAS u32x2*)vp, *(const LAS u32x2*)(vp + 16)); o = MFMA32(vf, pf[mt][s2], o); }
#pragma unroll
            for (int g = 0; g < 4; ++g) { const u32x2 w = {pkbf(o[4 * g] * il, o[4 * g + 1] * il), pkbf(o[4 * g + 2] * il, o[4 * g + 3] * il)}; *(u32x2*)(yp + 32 * dt + 8 * g) = w; }
        }
    }
}

__device__ __forceinline__ void dilattn_mfma_phase(Frame& F, int half) {
    bf16* P = (bf16*)(F.ws + WS_BIG);
    float* LSE = (float*)(F.ws + WS_LSE);
    LAS unsigned char* sK = F.lds; LAS unsigned char* sV = F.lds + 384 * 144;
    const int tid = F.tid, lane = F.lane, wave = F.wave, ql = lane & 31, h = lane >> 5;
    constexpr int RST = 144;
    for (int unit = F.bid; unit < HB * 12 * 32; unit += F.G) {
        const int bl = unit / 384, rem = unit % 384, head = rem >> 5, blk = rem & 31;
        const int g = head >> 2, dil = (g == 0) ? 1 : (g == 1 ? 4 : 16), bpr = 32 / dil;
        const int res = blk / bpr, q0 = (blk % bpr) * 256;
        const size_t rowb = (size_t)bl * SEQ;
        __syncthreads();
        for (int c = tid; c < 384 * 8; c += NTHR) { const int row = c >> 3, ch = c & 7; const int ks = q0 - 128 + row;
            u32x4 kv = {0u, 0u, 0u, 0u}, vv = {0u, 0u, 0u, 0u};
            if (ks >= 0) { const bf16* src = P + (rowb + (size_t)ks * dil + res) * NPROJ + head * 64 + ch * 8; kv = *(const u32x4*)(src + PC_DK); vv = *(const u32x4*)(src + PC_DV); }
            *(LAS u32x4*)(sK + row * RST + ch * 16) = kv; *(LAS u32x4*)(sV + row * RST + ch * 16) = vv; }
        const int qs = q0 + wave * 32 + ql;
        const size_t rq = rowb + (size_t)qs * dil + res;
        bf16* qp = P + rq * NPROJ + PC_DQ + head * 64;
        bf16x8 qf[4];
#pragma unroll
        for (int ks = 0; ks < 4; ++ks) qf[ks] = *(const bf16x8*)(qp + 16 * ks + 8 * h);
        __syncthreads();
        f32x16 sacc[5];
        const int kfirst = q0 + wave * 32 - 128;
#pragma unroll
        for (int i = 0; i < 5; ++i) {
#pragma unroll
            for (int e = 0; e < 16; ++e) sacc[i][e] = 0.f;
#pragma unroll
            for (int ks = 0; ks < 4; ++ks) { const bf16x8 kf = *(const LAS bf16x8*)(sK + (32 * wave + 32 * i + ql) * RST + 32 * ks + 16 * h); sacc[i] = MFMA32(kf, qf[ks], sacc[i]); }
        }
        float mx = -3.0e38f;
#pragma unroll
        for (int i = 0; i < 5; ++i)
#pragma unroll
            for (int e = 0; e < 16; ++e) { const int kj = 32 * i + (e & 3) + 8 * (e >> 2) + 4 * h; const bool ok = (kj >= ql) && (kj <= ql + 128) && (kfirst + kj >= 0);
                sacc[i][e] = ok ? sacc[i][e] : -3.0e38f; mx = fmaxf(mx, sacc[i][e]); }
        mx = fmaxf(mx, __shfl_xor(mx, 32));
        const float sc = 0.125f * 1.4426950408889634f;
        float l = 0.f;
        bf16x8 pf[5][2];
#pragma unroll
        for (int i = 0; i < 5; ++i) {
            float p[16];
#pragma unroll
            for (int e = 0; e < 16; ++e) { p[e] = (sacc[i][e] > -1.0e38f) ? __builtin_amdgcn_exp2f((sacc[i][e] - mx) * sc) : 0.f; l += p[e]; }
#pragma unroll
            for (int s2 = 0; s2 < 2; ++s2) { const u32x4 w = {pkbf(p[8 * s2 + 0], p[8 * s2 + 1]), pkbf(p[8 * s2 + 2], p[8 * s2 + 3]), pkbf(p[8 * s2 + 4], p[8 * s2 + 5]), pkbf(p[8 * s2 + 6], p[8 * s2 + 7])};
                pf[i][s2] = __builtin_bit_cast(bf16x8, w); }
        }
        l += __shfl_xor(l, 32);
        const float il = 1.0f / l;
        const int tq = (lane & 15) >> 2, tp = lane & 3, tblk = (lane >> 4) & 1;
        const unsigned vbase = (unsigned)(size_t)(sV) + (unsigned)((32 * wave + 4 * h + tq) * RST + (16 * tblk + 4 * tp) * 2);
#pragma unroll
        for (int dt = 0; dt < 2; ++dt) {
            f32x16 o;
#pragma unroll
            for (int e = 0; e < 16; ++e) o[e] = 0.f;
#pragma unroll
            for (int i = 0; i < 5; ++i) {
                s16x4 lo[2], hi[2];
#pragma unroll
                for (int s2 = 0; s2 < 2; ++s2) { const unsigned a = vbase + (unsigned)((32 * i + 16 * s2) * RST + 64 * dt);
                    asm volatile("ds_read_b64_tr_b16 %0, %1" : "=&v"(lo[s2]) : "v"(a) : "memory");
                    asm volatile("ds_read_b64_tr_b16 %0, %1 offset:1152" : "=&v"(hi[s2]) : "v"(a) : "memory"); }
                asm volatile("s_waitcnt lgkmcnt(0)" ::: "memory"); __builtin_amdgcn_sched_barrier(0);
#pragma unroll
                for (int s2 = 0; s2 < 2; ++s2) { const bf16x8 vf = {lo[s2][0], lo[s2][1], lo[s2][2], lo[s2][3], hi[s2][0], hi[s2][1], hi[s2][2], hi[s2][3]}; o = MFMA32(vf, pf[i][s2], o); }
            }
#pragma unroll
            for (int gq = 0; gq < 4; ++gq) { const u32x2 w = {pkbf(o[4 * gq] * il, o[4 * gq + 1] * il), pkbf(o[4 * gq + 2] * il, o[4 * gq + 3] * il)}; *(u32x2*)(qp + 32 * dt + 8 * gq + 4 * h) = w; }
        }
        if (h == 0) LSE[((size_t)half * HT + rq) * 12 + head] = mx * 0.125f + __logf(l);
    }
}

__device__ __forceinline__ void dilmerge_phase(Frame& F, int half) {
    const bf16* P = (const bf16*)(F.ws + WS_BIG);
    const float* LSE = (const float*)(F.ws + WS_LSE);
    bf16* Y = (bf16*)F.out;
    const size_t gtid = (size_t)F.bid * NTHR + F.tid, gth = (size_t)F.G * NTHR;
    for (size_t it = gtid; it < (size_t)HT * 32; it += gth) {
        const size_t r = it >> 5; const int hh = (int)(it >> 3) & 3, d0 = (int)(it & 7) * 8;
        const size_t tok = (size_t)half * HT + r;
        const float l0 = LSE[tok * 12 + hh], l1 = LSE[tok * 12 + 4 + hh], l2 = LSE[tok * 12 + 8 + hh];
        const float m = fmaxf(l0, fmaxf(l1, l2));
        float w0 = __expf(l0 - m), w1 = __expf(l1 - m), w2 = __expf(l2 - m); const float iw = 1.0f / (w0 + w1 + w2); w0 *= iw; w1 *= iw; w2 *= iw;
        const bf16* op = P + r * NPROJ + PC_DQ + hh * 64 + d0;
        const u32x4 a = *(const u32x4*)op, b = *(const u32x4*)(op + 256), c = *(const u32x4*)(op + 512);
        u32x4 o;
        o.x = pkbf(w0 * bflo(a.x) + w1 * bflo(b.x) + w2 * bflo(c.x), w0 * bfhi(a.x) + w1 * bfhi(b.x) + w2 * bfhi(c.x));
        o.y = pkbf(w0 * bflo(a.y) + w1 * bflo(b.y) + w2 * bflo(c.y), w0 * bfhi(a.y) + w1 * bfhi(b.y) + w2 * bfhi(c.y));
        o.z = pkbf(w0 * bflo(a.z) + w1 * bflo(b.z) + w2 * bflo(c.z), w0 * bfhi(a.z) + w1 * bfhi(b.z) + w2 * bfhi(c.z));
        o.w = pkbf(w0 * bflo(a.w) + w1 * bflo(b.w) + w2 * bflo(c.w), w0 * bfhi(a.w) + w1 * bfhi(b.w) + w2 * bfhi(c.w));
        *(u32x4*)(Y + tok * YC + 1024 + hh * 64 + d0) = o;
    }
}

__device__ __forceinline__ void hn_panel(Frame& F, int pm) {
    for (int m = pm * 256 + F.wave; m < pm * 256 + 256; m += NWAVES) { f32x4 v[4]; rms_row_to_bf16(F.out + (size_t)m * DM, F.in[I_NFFNW], (bf16*)(F.ws + WS_ACT1) + (size_t)m * DM, F.lane, v); }
}
__device__ __forceinline__ void hn_phase(Frame& F) {
    const int gw = F.bid * NWAVES + F.wave, NGW = F.G * NWAVES;
    for (int m = gw; m < T; m += NGW) { f32x4 v[4]; rms_row_to_bf16(F.out + (size_t)m * DM, F.in[I_NFFNW], (bf16*)(F.ws + WS_ACT1) + (size_t)m * DM, F.lane, v); }
}


__device__ __forceinline__ float gelu_erf(float x) { return 0.5f * x * (1.0f + erff(x * 0.70710678118654752f)); }
__device__ __forceinline__ unsigned f2ord(float f) { const unsigned u = __builtin_bit_cast(unsigned, f); return u ^ ((unsigned)((int)u >> 31) | 0x80000000u); }
__device__ __forceinline__ float ord2f(unsigned k) { const unsigned m = (unsigned)((int)k >> 31); return __builtin_bit_cast(float, k ^ (0x80000000u | ~m)); }
#define CMPX(a, b) do { const unsigned _mx = max((a), (b)), _mn = min((a), (b)); (a) = _mx; (b) = _mn; } while (0)
__device__ __forceinline__ void bitonic_sort16_desc(unsigned (&v)[16]) {
#pragma unroll
    for (int k = 2; k <= 16; k <<= 1)
#pragma unroll
        for (int j = k >> 1; j > 0; j >>= 1)
#pragma unroll
            for (int i = 0; i < 16; ++i) { const int l = i ^ j; if (l > i) { if ((i & k) == 0) CMPX(v[i], v[l]); else CMPX(v[l], v[i]); } }
}
__device__ __forceinline__ void bitonic_merge16_desc(unsigned (&v)[16]) {
#pragma unroll
    for (int j = 8; j > 0; j >>= 1)
#pragma unroll
        for (int i = 0; i < 16; ++i) { const int l = i ^ j; if (l > i) CMPX(v[i], v[l]); }
}
__device__ __forceinline__ void top16_merge(unsigned (&a)[16], const unsigned (&b)[16]) {
#pragma unroll
    for (int i = 0; i < 16; ++i) a[i] = max(a[i], b[15 - i]);
    bitonic_merge16_desc(a);
}
constexpr int PK_ST = 272;
__device__ __forceinline__ void peer_topk_tile(Frame& F, size_t tok0, const bf16* Q, int* IDX, float* GATE) {
    const bf16* SK = (const bf16*)(F.ws + WS_SUBK);
    LAS unsigned char* sK = F.lds;
    int tid = F.tid; asm volatile("" : "+v"(tid));
    const int lane = tid & 63, wave = F.wave, ql = lane & 31, hh = lane >> 5;
    const size_t tok = tok0 + wave * 32 + ql;
    const bf16* qrow = Q + tok * PEER_Q + 8 * hh;
    __syncthreads();
#pragma unroll
    for (int j = 0; j < 4; ++j) { const int cidx = tid + 512 * j, row = cidx >> 4, ch = cidx & 15; *(LAS u32x4*)(sK + row * PK_ST + ch * 16) = *(const u32x4*)(SK + (size_t)row * 128 + ch * 8); }
    __syncthreads();
    unsigned k1[16];
#pragma unroll 1
    for (int hc = 0; hc < 16; ++hc) {
        LAS unsigned char* cur = sK + (hc & 1) * (128 * PK_ST); LAS unsigned char* nxt = sK + ((hc + 1) & 1) * (128 * PK_ST);
        u32x4 stg[4];
        const int hcn = (hc + 1) & 15;
#pragma unroll
        for (int j = 0; j < 4; ++j) { const int cidx = tid + 512 * j, row = cidx >> 4, ch = cidx & 15; stg[j] = *(const u32x4*)(SK + ((size_t)hcn * 128 + row) * 128 + ch * 8); }
        bf16x8 qf[8];
#pragma unroll
        for (int ks = 0; ks < 8; ++ks) qf[ks] = *(const bf16x8*)(qrow + hc * 128 + 16 * ks);
        unsigned pk[4][16];
#pragma unroll
        for (int mt = 0; mt < 4; ++mt) {
            f32x16 acc;
#pragma unroll
            for (int e = 0; e < 16; ++e) acc[e] = 0.f;
#pragma unroll
            for (int ks = 0; ks < 8; ++ks) { const bf16x8 kf = *(const LAS bf16x8*)(cur + (32 * mt + ql) * PK_ST + 32 * ks + 16 * hh); acc = MFMA32(kf, qf[ks], acc); }
#pragma unroll
            for (int e = 0; e < 16; ++e) pk[mt][e] = (f2ord(acc[e]) & 0xFFFFFF80u) | (unsigned)(32 * mt + (e & 3) + 8 * (e >> 2) + 4 * hh);
        }
#pragma unroll
        for (int j = 0; j < 4; ++j) { const int cidx = tid + 512 * j, row = cidx >> 4, ch = cidx & 15; *(LAS u32x4*)(nxt + row * PK_ST + ch * 16) = stg[j]; }
        __syncthreads();
#pragma unroll
        for (int mt = 0; mt < 4; ++mt) bitonic_sort16_desc(pk[mt]);
        top16_merge(pk[0], pk[1]); top16_merge(pk[2], pk[3]); top16_merge(pk[0], pk[2]);
        unsigned other[16];
#pragma unroll
        for (int i = 0; i < 16; ++i) other[i] = (unsigned)__shfl_xor((int)pk[0][i], 32);
        top16_merge(pk[0], other);
        if ((hc & 1) == 0) {
#pragma unroll
            for (int i = 0; i < 16; ++i) k1[i] = pk[0][i];
        } else {
            float f1[16], f2[16];
#pragma unroll
            for (int i = 0; i < 16; ++i) { f1[i] = ord2f(k1[i] & 0xFFFFFF80u); f2[i] = ord2f(pk[0][i] & 0xFFFFFF80u); }
            unsigned cd[4][16];
#pragma unroll
            for (int i = 0; i < 64; ++i) cd[i >> 4][i & 15] = 0u;
            int n = 0;
#pragma unroll
            for (int a = 0; a < 16; ++a)
#pragma unroll
                for (int b = 0; b < 16; ++b)
                    if ((a + 1) * (b + 1) <= 16) { cd[n >> 4][n & 15] = (f2ord(f1[a] + f2[b]) & 0xFFFFC000u) | ((k1[a] & 127u) << 7) | (pk[0][b] & 127u); ++n; }
#pragma unroll
            for (int g4 = 0; g4 < 4; ++g4) bitonic_sort16_desc(cd[g4]);
            top16_merge(cd[0], cd[1]); top16_merge(cd[2], cd[3]); top16_merge(cd[0], cd[2]);
            const float vmax = ord2f(cd[0][0] & 0xFFFFC000u);
            float ex[16], den = 0.f;
#pragma unroll
            for (int i = 0; i < 16; ++i) { ex[i] = __expf(ord2f(cd[0][i] & 0xFFFFC000u) - vmax); den += ex[i]; }
            const float iden = 1.0f / den;
            const int h = hc >> 1;
            if (hh == 0) { int* ip = IDX + tok * 128 + h * 16;
#pragma unroll
                for (int i = 0; i < 4; ++i) { const u32x4 w = {cd[0][4 * i] & 0x3FFFu, cd[0][4 * i + 1] & 0x3FFFu, cd[0][4 * i + 2] & 0x3FFFu, cd[0][4 * i + 3] & 0x3FFFu}; *(u32x4*)(ip + 4 * i) = w; } }
            else { float* gp = GATE + tok * 128 + h * 16;
#pragma unroll
                for (int i = 0; i < 4; ++i) { const f32x4 w = {ex[4 * i] * iden, ex[4 * i + 1] * iden, ex[4 * i + 2] * iden, ex[4 * i + 3] * iden}; *(f32x4*)(gp + 4 * i) = w; } }
        }
    }
}

struct PeerDeal { size_t tokw; int ntok; size_t tok0; float* PART; const int* IDX; const float* GATE; float* COEF; };
__device__ __forceinline__ void peer_item(int n, const PeerDeal& D, int wave, int& slice, size_t& tok) { slice = n >> 5; tok = D.tokw + (n & 31); }
__device__ __forceinline__ void peer_down_rows(u32x4 (&R)[16], const unsigned char* PD, int slice, int id0, int id1, int lane) {
    const unsigned char* base = PD + ((size_t)slice * 16384 << 7) + 16 * (lane & 7);
#pragma unroll
    for (int k = 0; k < 16; ++k) { const int id = __shfl(k < 8 ? id0 : id1, (8 * k + (lane >> 3)) & 63); R[k] = *(const u32x4*)(base + ((size_t)id << 7)); }
}
__device__ __forceinline__ void peer_down_park(const u32x4 (&R)[16], LAS unsigned char* sw, int lane) {
    const int e8 = lane >> 3, p = lane & 7;
#pragma unroll
    for (int k = 0; k < 16; ++k) { const int sl_ = 8 * k + e8; *(LAS u32x4*)(sw + sl_ * 128 + 16 * (p ^ ((sl_ >> 1) & 7))) = R[k]; }
}
__device__ __forceinline__ void peer_down_hn(u32x4 (&H)[4], const bf16* HN, int slice, size_t tok, int g) {
    const bf16* hp = HN + tok * DM + slice * 128 + 16 * g;
    H[0] = *(const u32x4*)hp; H[1] = *(const u32x4*)(hp + 8); H[2] = *(const u32x4*)(hp + 64); H[3] = *(const u32x4*)(hp + 72);
}
__device__ __forceinline__ void peer_down_compute(const LAS unsigned char* sw, const u32x4 (&H)[4], __amdgpu_buffer_rsrc_t prsrc, int slice, int tokl, int lane) {
    const int g = lane >> 4, r = lane & 15;
    long bq[4];
#pragma unroll
    for (int h2 = 0; h2 < 2; ++h2) { const u32x4 x0 = H[2 * h2], x1 = H[2 * h2 + 1];
        unsigned p0 = __builtin_amdgcn_cvt_pk_fp8_f32(bflo(x0.x), bfhi(x0.x), 0, false); p0 = __builtin_amdgcn_cvt_pk_fp8_f32(bflo(x0.y), bfhi(x0.y), p0, true);
        unsigned p1 = __builtin_amdgcn_cvt_pk_fp8_f32(bflo(x0.z), bfhi(x0.z), 0, false); p1 = __builtin_amdgcn_cvt_pk_fp8_f32(bflo(x0.w), bfhi(x0.w), p1, true);
        unsigned p2 = __builtin_amdgcn_cvt_pk_fp8_f32(bflo(x1.x), bfhi(x1.x), 0, false); p2 = __builtin_amdgcn_cvt_pk_fp8_f32(bflo(x1.y), bfhi(x1.y), p2, true);
        unsigned p3 = __builtin_amdgcn_cvt_pk_fp8_f32(bflo(x1.z), bfhi(x1.z), 0, false); p3 = __builtin_amdgcn_cvt_pk_fp8_f32(bflo(x1.w), bfhi(x1.w), p3, true);
        bq[2 * h2] = (long)(((unsigned long long)p1 << 32) | p0); bq[2 * h2 + 1] = (long)(((unsigned long long)p3 << 32) | p2); }
    const unsigned off = ((lane & 15) == 0) ? (unsigned)(((tokl * 8 + slice) * 128 + 4 * g) * 4) : 0xFFFFFF00u;
#pragma unroll
    for (int t8 = 0; t8 < 8; ++t8) { f32x4 acc = {0.f, 0.f, 0.f, 0.f}; const int sl_ = 16 * t8 + r; const LAS unsigned char* rp = sw + sl_ * 128; const int sx = (sl_ >> 1) & 7;
#pragma unroll
        for (int h2 = 0; h2 < 2; ++h2) { const u32x4 v = *(const LAS u32x4*)(rp + 16 * ((4 * h2 + g) ^ sx));
            acc = __builtin_amdgcn_mfma_f32_16x16x32_fp8_fp8((long)(((unsigned long long)v.y << 32) | v.x), bq[2 * h2], acc, 0, 0, 0);
            acc = __builtin_amdgcn_mfma_f32_16x16x32_fp8_fp8((long)(((unsigned long long)v.w << 32) | v.z), bq[2 * h2 + 1], acc, 0, 0, 0); }
        __builtin_amdgcn_raw_buffer_store_b128(__builtin_bit_cast(u32x4, acc), prsrc, off, 64 * t8, 0); }
}
__device__ __forceinline__ void peer_down_phase(Frame& F, const PeerDeal& D) {
    const unsigned char* PD = F.ws + WS_PD; const bf16* HN = (const bf16*)(F.ws + WS_ACT1);
    const int* IDX = D.IDX;
    const __amdgpu_buffer_rsrc_t prsrc = __builtin_amdgcn_make_buffer_rsrc((void*)D.PART, 0, 256 * 8 * 128 * 4, 0x00020000);
    int lane = F.lane; asm volatile("" : "+v"(lane));
    const int g = lane >> 4, wave = F.wave;
    LAS unsigned char* sw = F.lds + wave * 16384;
    const int ntok = D.ntok;
    int sl; size_t tk;
    u32x4 R[16], H0[4], H1[4]; int id0, id1;
    { int s1_; size_t t1_; peer_item(0, D, wave, sl, tk); peer_item(1, D, wave, s1_, t1_);
      const int a0 = IDX[tk * 128 + lane], a1 = IDX[tk * 128 + 64 + lane]; id0 = IDX[t1_ * 128 + lane]; id1 = IDX[t1_ * 128 + 64 + lane];
      __builtin_amdgcn_sched_barrier(0);
      peer_down_rows(R, PD, sl, a0, a1, lane); peer_down_hn(H0, HN, sl, tk, g);
      __builtin_amdgcn_sched_barrier(0); }
#pragma unroll 1
    for (int n = 0; n < ntok; n += 2) {
        int s0, s1, s2, s3; size_t t0, t1, t2, t3;
        peer_item(n, D, wave, s0, t0); peer_item(n + 1, D, wave, s1, t1); peer_item(n + 2 < ntok ? n + 2 : n, D, wave, s2, t2); peer_item(n + 3 < ntok ? n + 3 : n + 1, D, wave, s3, t3);
        peer_down_park(R, sw, lane);
        __builtin_amdgcn_sched_barrier(0);
        { const int j0 = IDX[t2 * 128 + lane], j1 = IDX[t2 * 128 + 64 + lane];
          peer_down_rows(R, PD, s1, id0, id1, lane); peer_down_hn(H1, HN, s1, t1, g); id0 = j0; id1 = j1; }
        __builtin_amdgcn_sched_barrier(0);
        peer_down_compute(sw, H0, prsrc, s0, (int)(t0 - D.tok0), lane);
        __builtin_amdgcn_sched_barrier(0);
        peer_down_park(R, sw, lane);
        __builtin_amdgcn_sched_barrier(0);
        { const int j0 = IDX[t3 * 128 + lane], j1 = IDX[t3 * 128 + 64 + lane];
          peer_down_rows(R, PD, s2, id0, id1, lane); peer_down_hn(H0, HN, s2, t2, g); id0 = j0; id1 = j1; }
        __builtin_amdgcn_sched_barrier(0);
        peer_down_compute(sw, H1, prsrc, s1, (int)(t1 - D.tok0), lane);
        __builtin_amdgcn_sched_barrier(0);
    }
}
__device__ __forceinline__ void peer_coef_wave(Frame& F, const PeerDeal& D) {
    for (int k = F.lane; k < 32 * 32; k += 64) {
        const int tl = (int)(D.tokw - D.tok0) + (k >> 5), slot = 4 * (k & 31);
        const float* pp = D.PART + (size_t)tl * 1024 + slot;
        f32x4 sm = *(const f32x4*)pp;
#pragma unroll
        for (int x = 1; x < 8; ++x) sm += *(const f32x4*)(pp + 128 * x);
        const size_t i = (D.tok0 + tl) * 128 + slot;
        const f32x4 gt = *(const f32x4*)(D.GATE + i);
        const f32x4 o = {gt.x * gelu_erf(sm.x * (1.0f / PD_SCALE)) * (1.0f / PU_SCALE), gt.y * gelu_erf(sm.y * (1.0f / PD_SCALE)) * (1.0f / PU_SCALE),
                         gt.z * gelu_erf(sm.z * (1.0f / PD_SCALE)) * (1.0f / PU_SCALE), gt.w * gelu_erf(sm.w * (1.0f / PD_SCALE)) * (1.0f / PU_SCALE)};
        *(f32x4*)(D.COEF + i) = o;
    }
}
__device__ __forceinline__ void peer_up_rows(u32x4 (&R)[16], const unsigned char* PU, int slice, int id0, int id1, int lane) {
    const unsigned char* base = PU + ((size_t)slice * 16384 << 7) + 16 * (lane & 3);
#pragma unroll
    for (int s8 = 0; s8 < 8; ++s8) { const int id = __shfl(s8 < 4 ? id0 : id1, (16 * s8 + (lane >> 2)) & 63); const unsigned char* rp = base + ((size_t)id << 7); R[2 * s8] = *(const u32x4*)rp; R[2 * s8 + 1] = *(const u32x4*)(rp + 64); }
}
__device__ __forceinline__ void peer_up_compute(const u32x4 (&R)[16], float c0, float c1, f32x2 h, float* out, int slice, size_t tok, int lane) {
    f32x2 acc[16];
#pragma unroll
    for (int k = 0; k < 16; ++k) acc[k] = (f32x2){0.f, 0.f};
#pragma unroll
    for (int s8 = 0; s8 < 8; ++s8) { const float c = __shfl(s8 < 4 ? c0 : c1, (16 * s8 + (lane >> 2)) & 63); f32x2 c2 = {c, c}; asm volatile("" : "+v"(c2));
#pragma unroll
        for (int hf = 0; hf < 2; ++hf) { const u32x4 r = R[2 * s8 + hf];
            acc[8 * hf + 0] = c2 * __builtin_amdgcn_cvt_pk_f32_fp8(r.x, false) + acc[8 * hf + 0]; acc[8 * hf + 1] = c2 * __builtin_amdgcn_cvt_pk_f32_fp8(r.x, true) + acc[8 * hf + 1];
            acc[8 * hf + 2] = c2 * __builtin_amdgcn_cvt_pk_f32_fp8(r.y, false) + acc[8 * hf + 2]; acc[8 * hf + 3] = c2 * __builtin_amdgcn_cvt_pk_f32_fp8(r.y, true) + acc[8 * hf + 3];
            acc[8 * hf + 4] = c2 * __builtin_amdgcn_cvt_pk_f32_fp8(r.z, false) + acc[8 * hf + 4]; acc[8 * hf + 5] = c2 * __builtin_amdgcn_cvt_pk_f32_fp8(r.z, true) + acc[8 * hf + 5];
            acc[8 * hf + 6] = c2 * __builtin_amdgcn_cvt_pk_f32_fp8(r.w, false) + acc[8 * hf + 6]; acc[8 * hf + 7] = c2 * __builtin_amdgcn_cvt_pk_f32_fp8(r.w, true) + acc[8 * hf + 7]; } }
    f32x2 r8[8], r4[4], r2[2], r1;
    { const bool up = (lane & 32) != 0;
#pragma unroll
      for (int k = 0; k < 8; ++k) { const f32x2 keep = up ? acc[k + 8] : acc[k], send = up ? acc[k] : acc[k + 8]; r8[k] = keep + (f32x2){__shfl_xor(send.x, 32), __shfl_xor(send.y, 32)}; } }
    { const bool up = (lane & 16) != 0;
#pragma unroll
      for (int k = 0; k < 4; ++k) { const f32x2 keep = up ? r8[k + 4] : r8[k], send = up ? r8[k] : r8[k + 4]; r4[k] = keep + (f32x2){__shfl_xor(send.x, 16), __shfl_xor(send.y, 16)}; } }
    { const bool up = (lane & 8) != 0;
#pragma unroll
      for (int k = 0; k < 2; ++k) { const f32x2 keep = up ? r4[k + 2] : r4[k], send = up ? r4[k] : r4[k + 2]; r2[k] = keep + (f32x2){__shfl_xor(send.x, 8), __shfl_xor(send.y, 8)}; } }
    { const bool up = (lane & 4) != 0; const f32x2 keep = up ? r2[1] : r2[0], send = up ? r2[0] : r2[1]; r1 = keep + (f32x2){__shfl_xor(send.x, 4), __shfl_xor(send.y, 4)}; }
    const int p = ((lane >> 5) & 1) * 8 + ((lane >> 4) & 1) * 4 + ((lane >> 3) & 1) * 2 + ((lane >> 2) & 1);
    *(f32x2*)(out + tok * DM + slice * 128 + 16 * (lane & 3) + 2 * (p & 7) + 64 * (p >> 3)) = h + r1;
}
__device__ __forceinline__ void peer_up_phase(Frame& F, const PeerDeal& D, float* outp) {
    const unsigned char* PU = F.ws + WS_PU;
    const int* IDX = D.IDX; const float* COEF = D.COEF;
    int lane = F.lane; asm volatile("" : "+v"(lane));
    const int wave = F.wave;
    const int ntok = D.ntok;
    const int p = ((lane >> 5) & 1) * 8 + ((lane >> 4) & 1) * 4 + ((lane >> 3) & 1) * 2 + ((lane >> 2) & 1);
    const int hoff = 16 * (lane & 3) + 2 * (p & 7) + 64 * (p >> 3);
    int sl; size_t tk;
    u32x4 R0[16], R1[16];
    float ca0, ca1, cb0, cb1; f32x2 ha, hb;
    int id0, id1, jd0, jd1;
    { int s1_; size_t t1_; peer_item(0, D, wave, sl, tk); peer_item(1, D, wave, s1_, t1_);
      jd0 = IDX[tk * 128 + lane]; jd1 = IDX[tk * 128 + 64 + lane]; id0 = IDX[t1_ * 128 + lane]; id1 = IDX[t1_ * 128 + 64 + lane];
      __builtin_amdgcn_sched_barrier(0);
      peer_up_rows(R0, PU, sl, jd0, jd1, lane);
      ca0 = COEF[tk * 128 + lane]; ca1 = COEF[tk * 128 + 64 + lane]; ha = *(const f32x2*)(F.out + tk * DM + sl * 128 + hoff);
      __builtin_amdgcn_sched_barrier(0); }
#pragma unroll 1
    for (int n = 0; n < ntok; n += 2) {
        int s0, s1, s2, s3; size_t t0, t1, t2, t3;
        peer_item(n, D, wave, s0, t0); peer_item(n + 1, D, wave, s1, t1);
        peer_item(n + 2 < ntok ? n + 2 : n, D, wave, s2, t2); peer_item(n + 3 < ntok ? n + 3 : n + 1, D, wave, s3, t3);
        jd0 = IDX[t2 * 128 + lane]; jd1 = IDX[t2 * 128 + 64 + lane];
        peer_up_rows(R1, PU, s1, id0, id1, lane);
        cb0 = COEF[t1 * 128 + lane]; cb1 = COEF[t1 * 128 + 64 + lane]; hb = *(const f32x2*)(F.out + t1 * DM + s1 * 128 + hoff);
        __builtin_amdgcn_sched_barrier(0);
        peer_up_compute(R0, ca0, ca1, ha, outp, s0, t0, lane);
        __builtin_amdgcn_sched_barrier(0);
        id0 = IDX[t3 * 128 + lane]; id1 = IDX[t3 * 128 + 64 + lane];
        peer_up_rows(R0, PU, s2, jd0, jd1, lane);
        ca0 = COEF[t2 * 128 + lane]; ca1 = COEF[t2 * 128 + 64 + lane]; ha = *(const f32x2*)(F.out + t2 * DM + s2 * 128 + hoff);
        __builtin_amdgcn_sched_barrier(0);
        peer_up_compute(R1, cb0, cb1, hb, outp, s1, t1, lane);
        __builtin_amdgcn_sched_barrier(0);
    }
}
__device__ __forceinline__ void peer_tile(Frame& F, int tile) {
    const size_t tok0 = (size_t)tile * 256;
    const bf16* Q = (const bf16*)(F.ws + WS_BIG);
    int* IDX = (int*)(F.ws + WS_BIG + 256 * MiB); float* GATE = (float*)(F.ws + WS_BIG + 288 * MiB); float* COEF = (float*)(F.ws + WS_BIG + 320 * MiB);
    peer_topk_tile(F, tok0, Q, IDX, GATE);
    VM_WAIT(); __syncthreads();
    PeerDeal D; D.tokw = tok0 + F.wave * 32; D.ntok = 256; D.tok0 = tok0; D.PART = (float*)(F.ws + WS_BIG + tok0 * (PEER_Q * 2)); D.IDX = IDX; D.GATE = GATE; D.COEF = COEF;
    peer_down_phase(F, D);
    VM_WAIT(); __syncthreads();
    peer_coef_wave(F, D);
    VM_WAIT(); __syncthreads();
    peer_up_phase(F, D, F.out);
}
__device__ __forceinline__ void peer_phase(Frame& F) { for (int tile = F.bid; tile < T / 256; tile += F.G) { peer_tile(F, tile); VM_WAIT(); __syncthreads(); } }

constexpr int N_PHASES = 15;
__global__ void __launch_bounds__(NTHR, 2) mega_fwd(Args args) {
    extern __shared__ __attribute__((aligned(16))) unsigned char lds_raw[];
    Frame F;
    F.lds = (LAS unsigned char*)lds_raw;
    F.tid = threadIdx.x; F.lane = F.tid & 63; F.wave = __builtin_amdgcn_readfirstlane(F.tid >> 6);
    F.G = gridDim.x; F.bid = blockIdx.x;
    F.in = args.in;
    F.positions = args.positions; F.out = args.out; F.ws = args.ws;
    unsigned char* ws = args.ws;
    volatile LAS unsigned* ctlw = (volatile LAS unsigned*)(F.lds + LDSCTL_OFF);
    if (F.tid < 64) ctlw[F.tid] = 0u;
    __syncthreads();
    const int lo = args.ph_lo, hi = args.ph_hi;
    XcdBarrier bar; bar.bar = (unsigned*)(ws + WS_CTL); bar.x = 0; bar.st = nullptr; bar.wave = F.wave;
    if (hi - lo > 1) bar = xcd_barrier_post((unsigned*)(ws + WS_CTL), ctlw + 8, F.wave);
#define IN(k) (lo <= (k) && (k) < hi)
#define SEAM(k) do { if (IN(k) && IN((k) + 1)) xcd_barrier(bar); } while (0)
    bf16* ACT1 = (bf16*)(ws + WS_ACT1); bf16* BIG = (bf16*)(ws + WS_BIG); bf16* WallT = (bf16*)(ws + WS_WALLT);

    if (IN(0)) { frame_refresh(F); p0_prologue(F); __syncthreads(); if (PROBE & 1) { p0_prologue(F); __syncthreads(); } }
    SEAM(0);
    if (IN(1)) { frame_refresh(F); { {
        { pg8::Gemm g{(const bf16*)(ws + WS_MEMN), (const bf16*)(ws + WS_WMKVT), NB * NMEM, 768, DM, DM, DM}; pg8::StaticOrder S; S.init(g.M, g.N, F.G, F.bid);
          pg8::EpiBf16<0> E{(bf16*)(ws + WS_MKV), 1536}; pg8::gemm_phase(F.lds, g, S, E, F.wave); }
        { pg8::Gemm g{(const bf16*)(ws + WS_WMKVT) + (size_t)768 * DM, (const bf16*)(ws + WS_MEMN), 768, NB * NMEM, DM, DM, DM}; pg8::StaticOrder S; S.init(g.M, g.N, F.G, F.G - 1 - F.bid);
          pg8::EpiBf16<0> E{(bf16*)(ws + WS_MVT), NB * NMEM}; pg8::gemm_phase(F.lds, g, S, E, F.wave); }
        { pg8::Gemm g{ACT1, WallT, HT, NPROJ, DM, DM, DM}; pg8::StaticOrder S; S.init(g.M, g.N, F.G, F.bid);
          pg8::EpiBf16<0> E{BIG, NPROJ}; pg8::gemm_phase(F.lds, g, S, E, F.wave); }
    } }
      if (PROBE & 2) { {
        { pg8::Gemm g{(const bf16*)(ws + WS_MEMN), (const bf16*)(ws + WS_WMKVT), NB * NMEM, 768, DM, DM, DM}; pg8::StaticOrder S; S.init(g.M, g.N, F.G, F.bid);
          pg8::EpiBf16<0> E{(bf16*)(ws + WS_MKV), 1536}; pg8::gemm_phase(F.lds, g, S, E, F.wave); }
        { pg8::Gemm g{(const bf16*)(ws + WS_WMKVT) + (size_t)768 * DM, (const bf16*)(ws + WS_MEMN), 768, NB * NMEM, DM, DM, DM}; pg8::StaticOrder S; S.init(g.M, g.N, F.G, F.G - 1 - F.bid);
          pg8::EpiBf16<0> E{(bf16*)(ws + WS_MVT), NB * NMEM}; pg8::gemm_phase(F.lds, g, S, E, F.wave); }
        { pg8::Gemm g{ACT1, WallT, HT, NPROJ, DM, DM, DM}; pg8::StaticOrder S; S.init(g.M, g.N, F.G, F.bid);
          pg8::EpiBf16<0> E{BIG, NPROJ}; pg8::gemm_phase(F.lds, g, S, E, F.wave); }
    } } }
    SEAM(1);
    if (IN(2)) { frame_refresh(F); qkprep_phase(F, 0); ssdC_phase(F, 0); if (PROBE & 4) ssdC_phase(F, 0); }
    SEAM(2);
    if (IN(3)) { frame_refresh(F); ssdD_phase(F); dilattn_mfma_phase(F, 0); memattn_mfma_phase(F, 0); if (PROBE & 64) { ssdD_phase(F); memattn_mfma_phase(F, 0); } }
    SEAM(3);
    if (IN(4)) { frame_refresh(F); ssdE_phase(F, 0); dilmerge_phase(F, 0); if (PROBE & 32) { ssdE_phase(F, 0); dilmerge_phase(F, 0); } }
    SEAM(4);
    if (IN(5)) { frame_refresh(F); { { pg8::Gemm g{ACT1 + (size_t)HT * DM, WallT, HT, NPROJ, DM, DM, DM}; pg8::StaticOrder S; S.init(g.M, g.N, F.G, F.bid);
        pg8::EpiBf16<0> E{BIG, NPROJ}; pg8::gemm_phase(F.lds, g, S, E, F.wave); } }
      if (PROBE & 2) { { pg8::Gemm g{ACT1 + (size_t)HT * DM, WallT, HT, NPROJ, DM, DM, DM}; pg8::StaticOrder S; S.init(g.M, g.N, F.G, F.bid);
        pg8::EpiBf16<0> E{BIG, NPROJ}; pg8::gemm_phase(F.lds, g, S, E, F.wave); } } }
    SEAM(5);
    if (IN(6)) { frame_refresh(F); qkprep_phase(F, 1); ssdC_phase(F, 1); if (PROBE & 4) ssdC_phase(F, 1); }
    SEAM(6);
    if (IN(7)) { frame_refresh(F); ssdD_phase(F); dilattn_mfma_phase(F, 1); memattn_mfma_phase(F, 1); if (PROBE & 64) { ssdD_phase(F); memattn_mfma_phase(F, 1); } }
    SEAM(7);
    if (IN(8)) { frame_refresh(F); ssdE_phase(F, 1); dilmerge_phase(F, 1); if (PROBE & 32) { ssdE_phase(F, 1); dilmerge_phase(F, 1); } }
    SEAM(8);
    if (IN(9)) { frame_refresh(F); { { pg8::Gemm g{ACT1, WallT + (size_t)NPROJ * DM, T, NGATE, DM, DM, DM}; pg8::StaticOrder S; S.init(g.M, g.N, F.G, F.bid);
        pg8::EpiBf16<1> E{BIG, NGATE}; pg8::gemm_phase(F.lds, g, S, E, F.wave); } }
      if (PROBE & 2) { { pg8::Gemm g{ACT1, WallT + (size_t)NPROJ * DM, T, NGATE, DM, DM, DM}; pg8::StaticOrder S; S.init(g.M, g.N, F.G, F.bid);
        pg8::EpiBf16<1> E{BIG, NGATE}; pg8::gemm_phase(F.lds, g, S, E, F.wave); } } }
    SEAM(9);
    if (IN(10)) { frame_refresh(F);
        pg8::Gemm g{(const bf16*)F.out, (const bf16*)(ws + WS_WCATT), T, DM, YC, YC, YC}; pg8::StaticOrder S; S.init(g.M, g.N, F.G, F.bid);
        pg8::EpiBranchFused E{ACT1, DM, __builtin_amdgcn_make_buffer_rsrc((void*)BIG, 0, T * NGATE * 2, 0x00020000), NGATE}; pg8::gemm_phase(F.lds, g, S, E, F.wave);
    }
    SEAM(10);
    if (IN(11)) { frame_refresh(F); { { pg8::Gemm g{ACT1, (const bf16*)(ws + WS_WOUTT), T, DM, DM, DM, DM}; pg8::StaticOrder S; S.init(g.M, g.N, F.G, F.bid);
        pg8::EpiResid E{F.out, DM, F.in[I_X]}; pg8::gemm_phase(F.lds, g, S, E, F.wave); } }
      if (PROBE & 2) { { pg8::Gemm g{ACT1, (const bf16*)(ws + WS_WOUTT), T, DM, DM, DM, DM}; pg8::StaticOrder S; S.init(g.M, g.N, F.G, F.bid);
        pg8::EpiResid E{F.out, DM, F.in[I_X]}; pg8::gemm_phase(F.lds, g, S, E, F.wave); } } }
    SEAM(11);
    if (IN(12)) { frame_refresh(F); { hn_phase(F); }
      if (PROBE & 2) { hn_phase(F); } }
    SEAM(12);
    if (IN(13)) { frame_refresh(F); { { pg8::Gemm g{ACT1, (const bf16*)(ws + WS_WQT), T, PEER_Q, DM, DM, DM}; pg8::StaticOrder S; S.init(g.M, g.N, F.G, F.bid);
        pg8::EpiBf16<0> E{BIG, PEER_Q}; pg8::gemm_phase(F.lds, g, S, E, F.wave); } }
      if (PROBE & 2) { { pg8::Gemm g{ACT1, (const bf16*)(ws + WS_WQT), T, PEER_Q, DM, DM, DM}; pg8::StaticOrder S; S.init(g.M, g.N, F.G, F.bid);
        pg8::EpiBf16<0> E{BIG, PEER_Q}; pg8::gemm_phase(F.lds, g, S, E, F.wave); } } }
    SEAM(13);
    if (IN(14)) { frame_refresh(F); peer_phase(F); }
#undef IN
#undef SEAM
}

extern "C" void kernel_launch(void* const* d_in, const int* in_sizes, int n_in, void* d_out, int out_size, void* d_ws, size_t ws_size, hipStream_t stream) {
    static int grid = 0;
    if (grid == 0) {
        if (n_in != 26 || out_size != T * DM || ws_size < WS_END) { fprintf(stderr, "kernel_launch: unexpected shapes (n_in %d, out %d, ws %zu)\n", n_in, out_size, ws_size); grid = -1; return; }
        int dev = 0, cus = 0;
        if (hipGetDevice(&dev) != hipSuccess || hipDeviceGetAttribute(&cus, hipDeviceAttributeMultiprocessorCount, dev) != hipSuccess) { grid = -1; return; }
        if (hipFuncSetAttribute((const void*)mega_fwd, hipFuncAttributeMaxDynamicSharedMemorySize, LDS_BYTES) != hipSuccess) { grid = -1; return; }
        int per_cu = 0;
        (void)hipOccupancyMaxActiveBlocksPerMultiprocessor(&per_cu, (const void*)mega_fwd, NTHR, LDS_BYTES);
        (void)hipGetLastError();
        grid = cus;
    }
    if (grid < 0) return;
    (void)hipMemsetAsync((char*)d_ws + WS_CTL, 0, CTL_ZERO_BYTES, stream);
    Args a{};
    for (int i = 0; i < 26; ++i) a.in[i] = (const float*)d_in[i];
    a.positions = (const int*)d_in[2]; a.out = (float*)d_out; a.ws = (unsigned char*)d_ws;
#if MK_N_LAUNCHES == 1
    a.ph_lo = 0; a.ph_hi = N_PHASES;
    hipLaunchKernelGGL(mega_fwd, dim3(grid), dim3(NTHR), LDS_BYTES, stream, a);
#else
    for (int p = 0; p < N_PHASES; ++p) { a.ph_lo = p; a.ph_hi = p + 1; hipLaunchKernelGGL(mega_fwd, dim3(grid), dim3(NTHR), LDS_BYTES, stream, a); }
#endif
}
```

```cpp
#include <hip/hip_runtime.h>
#include <cstdio>
#include <cstdint>

#ifndef MK_N_LAUNCHES
#define MK_N_LAUNCHES 1
#endif

#define LAS __attribute__((address_space(3)))
#define GAS __attribute__((address_space(1)))
typedef unsigned short bf16;
typedef short bf16x8 __attribute__((ext_vector_type(8)));
typedef float f32x4 __attribute__((ext_vector_type(4)));
typedef float f32x2 __attribute__((ext_vector_type(2)));
typedef unsigned u32x4 __attribute__((ext_vector_type(4)));
typedef unsigned u32x2 __attribute__((ext_vector_type(2)));

constexpr int NB = 8, SEQ = 8192, DM = 1024, T = NB * SEQ;
constexpr int HB = 4, HT = HB * SEQ;
constexpr int NMEM = 256;
constexpr int NPROJ = 6144;
constexpr int PC_Z = 0, PC_X = 1024, PC_B = 2048, PC_C = 2560, PC_DQ = 3072, PC_DK = 3840, PC_DV = 4608, PC_MQ = 5376;
constexpr int W_IN_N = 9232, OFF_DT = 3072, OFF_AFTER_DT = 3088;
constexpr int NGATE = 3072;
constexpr int YC = 2048;
constexpr int PEER_H = 8, PEER_K = 16, PEER_NK = 128, PEER_Q = 2048;
constexpr float EPS = 1e-6f;

constexpr size_t MiB = 1u << 20;
constexpr size_t WS_CTL = 0, CTL_ZERO_BYTES = 65536;
constexpr size_t WS_WALLT = 1 * MiB;
constexpr size_t WS_WMKVT = 19 * MiB;
constexpr size_t WS_WCATT = 22 * MiB;
constexpr size_t WS_WOUTT = 26 * MiB;
constexpr size_t WS_WQT = 28 * MiB;
constexpr size_t WS_SUBK = 32 * MiB;
constexpr size_t WS_PD = 33 * MiB;
constexpr size_t WS_PU = 65 * MiB;
constexpr size_t WS_DT = 97 * MiB;
constexpr size_t WS_MEMN = 101 * MiB;
constexpr size_t WS_MKV = 105 * MiB;
constexpr size_t WS_ACT1 = 112 * MiB;
constexpr size_t WS_BIG = 240 * MiB;
constexpr size_t WS_LSE = 624 * MiB;
constexpr size_t WS_MVT = 628 * MiB;
constexpr size_t WS_DEC = 631 * MiB;
constexpr size_t WS_SST = 632 * MiB;
constexpr size_t WS_SIN = 760 * MiB;
constexpr size_t WS_END = 824 * MiB;

constexpr int RING_BYTES = 131072;
constexpr int LDSCTL_OFF = 143360;
constexpr int LDS_BYTES = 147456;
constexpr int NWAVES = 8, NTHR = 512;

__device__ __forceinline__ int lane_id() { return (int)__builtin_amdgcn_mbcnt_hi(~0u, __builtin_amdgcn_mbcnt_lo(~0u, 0u)); }
__device__ __forceinline__ float bf2f(unsigned short b) { return __builtin_bit_cast(float, (unsigned)b << 16); }
__device__ __forceinline__ float bflo(unsigned w) { return __builtin_bit_cast(float, w << 16); }
__device__ __forceinline__ float bfhi(unsigned w) { return __builtin_bit_cast(float, w & 0xffff0000u); }
__device__ __forceinline__ unsigned f2bf(float f) { unsigned u = __builtin_bit_cast(unsigned, f); return (u + 0x7fffu + ((u >> 16) & 1u)) >> 16; }
__device__ __forceinline__ unsigned pk2(float lo, float hi) { return f2bf(lo) | (f2bf(hi) << 16); }
typedef float f32x16 __attribute__((ext_vector_type(16)));
typedef short s16x4 __attribute__((ext_vector_type(4)));
typedef __bf16 bf2_t __attribute__((ext_vector_type(2)));
__device__ __forceinline__ unsigned pkbf(float a, float b) { const f32x2 v = {a, b}; return __builtin_bit_cast(unsigned, __builtin_convertvector(v, bf2_t)); }
#define MFMA32(a, b, c) __builtin_amdgcn_mfma_f32_32x32x16_bf16((a), (b), (c), 0, 0, 0)
__device__ __forceinline__ float wave_sum(float v) {
#pragma unroll
    for (int o = 1; o < 64; o <<= 1) v += __shfl_xor(v, o);
    return v;
}
__device__ __forceinline__ float wave_max(float v) {
#pragma unroll
    for (int o = 1; o < 64; o <<= 1) v = fmaxf(v, __shfl_xor(v, o));
    return v;
}
__device__ __forceinline__ float sigmoidf_(float x) { return 1.0f / (1.0f + __expf(-x)); }
#define LDS_WAIT() asm volatile("s_waitcnt lgkmcnt(0)" ::: "memory")
#define VM_WAIT() asm volatile("s_waitcnt vmcnt(0)" ::: "memory")

#define XB_TMO      128
#define XB_XCNT(j)  (256  + 64 * (j))
#define XB_XSUB(j)  (1280 + 64 * (j))
#define XB_XGEN(j)  (2304 + 64 * (j))
#define XB_TOP      3328
#define XB_TOPGEN   3392
#define XCD_BAR_WORDS 3456
#define XB_SPIN_CAP (1u << 18)
__device__ __forceinline__ unsigned xb_ld(unsigned* p)              { return __hip_atomic_load(p, __ATOMIC_RELAXED, __HIP_MEMORY_SCOPE_AGENT); }
__device__ __forceinline__ unsigned xb_add(unsigned* p, unsigned v) { return __hip_atomic_fetch_add(p, v, __ATOMIC_RELAXED, __HIP_MEMORY_SCOPE_AGENT); }
__device__ __forceinline__ unsigned xb_xcc_id() { return (unsigned)__builtin_amdgcn_s_getreg((3 << 11) | 20) & 0xFu; }
#define XB_SPIN(cond, bar) do { unsigned _sp = 0; while (cond) { __builtin_amdgcn_s_sleep(1); \
    if ((++_sp & 255u) == 0u) { if (xb_ld(&(bar)[XB_TMO])) break; if (_sp > XB_SPIN_CAP) { atomicAdd(&(bar)[XB_TMO], 1u); break; } } } } while (0)
struct XcdBarrier { unsigned* bar; unsigned x; volatile LAS unsigned* st; int wave; };
__device__ __forceinline__ XcdBarrier xcd_barrier_post(unsigned* bar, volatile LAS unsigned* st, int wave) {
    XcdBarrier b; b.bar = bar; b.x = xb_xcc_id(); b.st = st; b.wave = wave;
    if (wave == 0 && lane_id() == 0) (void)xb_add(&bar[XB_XCNT(b.x)], 1u);
    return b;
}
__device__ __forceinline__ void xcd_barrier_complete(unsigned* bar, unsigned x, unsigned& nloc, unsigned& nx) {
    const unsigned G = gridDim.x * gridDim.y * gridDim.z;
    unsigned sum, cnt, mine, sp = 0u;
    for (;;) {
        sum = 0u; cnt = 0u; mine = 0u;
#pragma unroll
        for (unsigned j = 0; j < 16; ++j) { const unsigned c = xb_ld(&bar[XB_XCNT(j)]); sum += c; cnt += (c > 0u) ? 1u : 0u; mine = (j == x) ? c : mine; }
        if (sum == G) break;
        __builtin_amdgcn_s_sleep(1);
        if ((++sp & 255u) == 0u) { if (xb_ld(&bar[XB_TMO])) break; if (sp > XB_SPIN_CAP) { atomicAdd(&bar[XB_TMO], 1u); break; } }
    }
    nloc = mine > 0u ? mine : 1u; nx = cnt > 0u ? cnt : 1u;
}
__device__ __forceinline__ void xcd_barrier(const XcdBarrier& b) {
    asm volatile("s_waitcnt vmcnt(0)" ::: "memory");
    __syncthreads();
    if (b.wave == 0 && lane_id() == 0) {
        unsigned* bar = b.bar;
        __builtin_amdgcn_s_waitcnt(0);
        unsigned nloc = b.st[0], nx = b.st[1];
        if (nloc == 0u) { xcd_barrier_complete(bar, b.x, nloc, nx); b.st[0] = nloc; b.st[1] = nx; }
        const unsigned old = xb_add(&bar[XB_XSUB(b.x)], 1u);
        const unsigned gen = old / nloc;
        if (old + 1u == (gen + 1u) * nloc) {
            __builtin_amdgcn_fence(__ATOMIC_RELEASE, "agent");
            asm volatile("s_waitcnt vmcnt(0)" ::: "memory");
            const unsigned og = xb_add(&bar[XB_TOP], 1u);
            const unsigned tg = og / nx;
            if (og + 1u == (tg + 1u) * nx) xb_add(&bar[XB_TOPGEN], 1u);
            else XB_SPIN(xb_ld(&bar[XB_TOPGEN]) == tg, bar);
            __builtin_amdgcn_fence(__ATOMIC_ACQUIRE, "agent");
            xb_add(&bar[XB_XGEN(b.x)], 1u);
            asm volatile("s_waitcnt vmcnt(0)" ::: "memory");
        } else {
            XB_SPIN(xb_ld(&bar[XB_XGEN(b.x)]) == gen, bar);
            __builtin_amdgcn_fence(__ATOMIC_ACQUIRE, "agent");
            asm volatile("s_waitcnt vmcnt(0)" ::: "memory");
        }
    }
    __syncthreads();
}

namespace pg8 {
constexpr int BM = 256, BK = 64, HALF = 128, HTB = HALF * BK * 2, STAGE_BYTES = 8 * HTB, NXCD = 8, WGM = 8;
__host__ __device__ __forceinline__ int lds_byte(int r, int c) { const int st = (r >> 4) * 2 + (c >> 5), rr = r & 15, cc = c & 31, ob = rr * 64 + cc * 2; return st * 1024 + (ob ^ (((ob >> 9) & 1) << 5)); }
__host__ __device__ __forceinline__ void stage_rc(int b, int& R, int& C) { const int st = b / 1024, sb = b % 1024, swz = sb ^ (((sb >> 9) & 1) << 5); R = (st >> 1) * 16 + swz / 64; C = (st & 1) * 32 + (swz % 64) / 2; }
__host__ __device__ __forceinline__ int perm32(int rho) { const int n = rho >> 4, i = rho & 15; return 8 * (i >> 2) + 4 * n + (i & 3); }
struct Unit { int pm, pn; };
struct Gemm { const bf16* A; const bf16* Bt; int M, N, K, lda, ldb; };
struct StaticOrder {
    int nM, nN, nwg, G, c;
    __host__ __device__ void init(int M, int N, int G_, int c_) { nM = M / BM; nN = N / BM; nwg = nM * nN; G = G_; c = c_; }
    __host__ __device__ bool next(int i, Unit& u) const {
        const long L = (long)i * G + c; if (L >= nwg) return false;
        int wgid = (int)L; { const int q = nwg / NXCD, r = nwg % NXCD, xcd = wgid % NXCD, off = wgid / NXCD; wgid = (xcd < r ? xcd * (q + 1) : r * (q + 1) + (xcd - r) * q) + off; }
        const int nig = WGM * nN, gid = wgid / nig, fm = gid * WGM, gsz = (nM - fm) < WGM ? (nM - fm) : WGM;
        u.pm = fm + ((wgid % nig) % gsz); u.pn = (wgid % nig) / gsz; return true;
    }
    __device__ __forceinline__ void a_ready(const Unit&) const {}
    __device__ __forceinline__ void done(const Unit&) const {}
};
struct PanelOrder {
    int pm, nN, rot;
    __device__ __forceinline__ bool next(int i, Unit& u) const { if (i >= nN) return false; u.pm = pm; u.pn = (i + rot) % nN; return true; }
    __device__ __forceinline__ void a_ready(const Unit&) const {}
    __device__ __forceinline__ void done(const Unit&) const {}
};
__device__ __forceinline__ unsigned cvt_pk_bf16(float lo, float hi) { unsigned r; asm volatile("v_cvt_pk_bf16_f32 %0, %1, %2" : "=v"(r) : "v"(lo), "v"(hi)); return r; }

template <int ACT> struct EpiBf16 {
    static constexpr bool PERM = true, AFTER_DRAIN = false, HAS_MID = false;
    bf16* O; int ldc;
    __device__ __forceinline__ void operator()(const f32x4 (&acc)[2][2][4][2], const Unit& u, int wr, int wc, int fr, int fq) const {
        const int row0 = u.pm * BM + wr * 64 + fr; const int col0 = u.pn * BM + wc * 32 + 8 * fq;
#pragma unroll
        for (int ai = 0; ai < 2; ++ai)
#pragma unroll
            for (int m = 0; m < 4; ++m) { bf16* rowp = O + (size_t)(row0 + ai * HALF + m * 16) * ldc + col0;
#pragma unroll
                for (int bj = 0; bj < 2; ++bj) { f32x4 v0 = acc[ai][bj][m][0], v1 = acc[ai][bj][m][1];
                    if (ACT == 1) {
#pragma unroll
                        for (int j = 0; j < 4; ++j) { v0[j] = sigmoidf_(v0[j]); v1[j] = sigmoidf_(v1[j]); } }
                    u32x4 w; w.x = cvt_pk_bf16(v0[0], v0[1]); w.y = cvt_pk_bf16(v0[2], v0[3]); w.z = cvt_pk_bf16(v1[0], v1[1]); w.w = cvt_pk_bf16(v1[2], v1[3]);
                    *(u32x4*)(rowp + bj * HALF) = w; } }
    }
};
template <bool ACCUM> struct EpiBranch {
    static constexpr bool PERM = true, AFTER_DRAIN = false, HAS_MID = false;
    bf16* O; int ldc; const bf16* Gt; int ldg; int gcol0;
    __device__ __forceinline__ void operator()(const f32x4 (&acc)[2][2][4][2], const Unit& u, int wr, int wc, int fr, int fq) const {
        const int row0 = u.pm * BM + wr * 64 + fr; const int col0 = u.pn * BM + wc * 32 + 8 * fq;
#pragma unroll
        for (int ai = 0; ai < 2; ++ai)
#pragma unroll
            for (int m = 0; m < 4; ++m) { const size_t r = (size_t)(row0 + ai * HALF + m * 16); bf16* rowp = O + r * ldc + col0; const bf16* gp = Gt + r * ldg + gcol0 + col0;
#pragma unroll
                for (int bj = 0; bj < 2; ++bj) { const f32x4 v0 = acc[ai][bj][m][0], v1 = acc[ai][bj][m][1];
                    const u32x4 g = *(const u32x4*)(gp + bj * HALF);
                    float o[8];
                    o[0] = v0[0] * bflo(g.x); o[1] = v0[1] * bfhi(g.x); o[2] = v0[2] * bflo(g.y); o[3] = v0[3] * bfhi(g.y);
                    o[4] = v1[0] * bflo(g.z); o[5] = v1[1] * bfhi(g.z); o[6] = v1[2] * bflo(g.w); o[7] = v1[3] * bfhi(g.w);
                    if (ACCUM) { const u32x4 p = *(const u32x4*)(rowp + bj * HALF);
                        o[0] += bflo(p.x); o[1] += bfhi(p.x); o[2] += bflo(p.y); o[3] += bfhi(p.y); o[4] += bflo(p.z); o[5] += bfhi(p.z); o[6] += bflo(p.w); o[7] += bfhi(p.w); }
                    u32x4 w; w.x = cvt_pk_bf16(o[0], o[1]); w.y = cvt_pk_bf16(o[2], o[3]); w.z = cvt_pk_bf16(o[4], o[5]); w.w = cvt_pk_bf16(o[6], o[7]);
                    *(u32x4*)(rowp + bj * HALF) = w; } }
    }
};
struct EpiResid {
    static constexpr bool PERM = false, AFTER_DRAIN = false, HAS_MID = false;
    float* C; int ldc; const float* R;
    __device__ __forceinline__ void operator()(const f32x4 (&acc)[2][2][4][2], const Unit& u, int wr, int wc, int fr, int fq) const {
        const int row0 = u.pm * BM + wr * 64 + fr, col0 = u.pn * BM + wc * 32 + 4 * fq;
#pragma unroll
        for (int ai = 0; ai < 2; ++ai)
#pragma unroll
            for (int m = 0; m < 4; ++m) { const size_t off = (size_t)(row0 + ai * HALF + m * 16) * ldc + col0;
#pragma unroll
                for (int bj = 0; bj < 2; ++bj)
#pragma unroll
                    for (int n = 0; n < 2; ++n) { const f32x4 r = *(const f32x4*)(R + off + bj * HALF + n * 16); *(f32x4*)(C + off + bj * HALF + n * 16) = acc[ai][bj][m][n] + r; } }
    }
};

struct EpiBranchFused {
    static constexpr bool PERM = true, AFTER_DRAIN = false, HAS_MID = true;
    bf16* O; int ldc; __amdgpu_buffer_rsrc_t grs; int ldg;
    __device__ __forceinline__ void mid(f32x4 (&acc)[2][2][4][2], const Unit& u, int t, int wr, int wc, int fr, int fq) const {
        const unsigned voff = (unsigned)(((u.pm * BM + wr * 64 + fr) * ldg + u.pn * BM + wc * 32 + 8 * fq) * 2);
        const int ca = (t == 16) ? 0 : 2048;
#pragma unroll
        for (int ai = 0; ai < 2; ++ai)
#pragma unroll
            for (int m = 0; m < 4; ++m) {
#pragma unroll
                for (int bj = 0; bj < 2; ++bj) { const int so = ((ai * HALF + m * 16) * ldg + bj * HALF) * 2 + ca;
                    const u32x4 ga = __builtin_amdgcn_raw_buffer_load_b128(grs, voff, so, 0), gb = __builtin_amdgcn_raw_buffer_load_b128(grs, voff, so + 2048, 0);
                    f32x4& v0 = acc[ai][bj][m][0]; f32x4& v1 = acc[ai][bj][m][1];
                    v0[0] *= bflo(ga.x) * __builtin_amdgcn_rcpf(fmaxf(bflo(gb.x), 1e-30f)); v0[1] *= bfhi(ga.x) * __builtin_amdgcn_rcpf(fmaxf(bfhi(gb.x), 1e-30f));
                    v0[2] *= bflo(ga.y) * __builtin_amdgcn_rcpf(fmaxf(bflo(gb.y), 1e-30f)); v0[3] *= bfhi(ga.y) * __builtin_amdgcn_rcpf(fmaxf(bfhi(gb.y), 1e-30f));
                    v1[0] *= bflo(ga.z) * __builtin_amdgcn_rcpf(fmaxf(bflo(gb.z), 1e-30f)); v1[1] *= bfhi(ga.z) * __builtin_amdgcn_rcpf(fmaxf(bfhi(gb.z), 1e-30f));
                    v1[2] *= bflo(ga.w) * __builtin_amdgcn_rcpf(fmaxf(bflo(gb.w), 1e-30f)); v1[3] *= bfhi(ga.w) * __builtin_amdgcn_rcpf(fmaxf(bfhi(gb.w), 1e-30f)); }
                __builtin_amdgcn_sched_barrier(0); }
    }
    __device__ __forceinline__ void operator()(const f32x4 (&acc)[2][2][4][2], const Unit& u, int wr, int wc, int fr, int fq) const {
        const int row0 = u.pm * BM + wr * 64 + fr; const int col0 = u.pn * BM + wc * 32 + 8 * fq;
        const unsigned voff = (unsigned)((row0 * ldg + col0) * 2);
#pragma unroll
        for (int ai = 0; ai < 2; ++ai)
#pragma unroll
            for (int m = 0; m < 4; ++m) { const size_t r = (size_t)(row0 + ai * HALF + m * 16); bf16* rowp = O + r * ldc + col0;
#pragma unroll
                for (int bj = 0; bj < 2; ++bj) { const f32x4 v0 = acc[ai][bj][m][0], v1 = acc[ai][bj][m][1];
                    const u32x4 g = __builtin_amdgcn_raw_buffer_load_b128(grs, voff, ((ai * HALF + m * 16) * ldg + bj * HALF) * 2 + 4096, 0);
                    u32x4 w; w.x = cvt_pk_bf16(v0[0] * bflo(g.x), v0[1] * bfhi(g.x)); w.y = cvt_pk_bf16(v0[2] * bflo(g.y), v0[3] * bfhi(g.y));
                    w.z = cvt_pk_bf16(v1[0] * bflo(g.z), v1[1] * bfhi(g.z)); w.w = cvt_pk_bf16(v1[2] * bflo(g.w), v1[3] * bfhi(g.w));
                    *(u32x4*)(rowp + bj * HALF) = w; } }
    }
};

template <class Epi, class Sched>
__device__ __forceinline__ void gemm_phase(LAS unsigned char* lds, const Gemm g, const Sched& S, const Epi& E, int wid) {
    int lane = lane_id(); asm volatile("" : "+v"(lane));
    const int tid = wid * 64 + lane, wr = wid >> 2, wc = wid & 3, fr = lane & 15, fq = lane >> 4;
    const int K = g.K, nt = K / BK;
    unsigned voffA[2], voffB[2];
#pragma unroll
    for (int i = 0; i < 2; ++i) { int R, C; stage_rc(tid * 16 + i * 8192, R, C); const int Rb = Epi::PERM ? ((R & ~31) + perm32(R & 31)) : R;
        voffA[i] = (unsigned)(R * g.lda + C) * 2u; voffB[i] = (unsigned)(Rb * g.ldb + C) * 2u; }
    const size_t kstep = (size_t)(BK * 2);
    const size_t hsA = (size_t)HALF * g.lda * 2, hsB = (size_t)HALF * g.ldb * 2;
    const size_t tsA = 2 * hsA, tsB = 2 * hsB;
    const unsigned ldsw = (unsigned)wid * 1024u;
    const int aoff = lds_byte(wr * 64 + fr, fq * 8), boff = lds_byte(wc * 32 + fr, fq * 8);
#define PG8_SA(b, h) (((b) * 2 + (h)) * HTB)
#define PG8_SB(b, h) ((4 + (b) * 2 + (h)) * HTB)
#define PG8_STAGE(bufoff, gbase, voff) do { _Pragma("unroll") for (int _i = 0; _i < 2; ++_i) \
        __builtin_amdgcn_global_load_lds((const unsigned*)((const char*)(gbase) + (voff)[_i]), (LAS unsigned*)(lds + (bufoff) + ldsw + _i * 8192), 16, 0, 0); } while (0)
#define PG8_LDA(dst, b, h) do { _Pragma("unroll") for (int m = 0; m < 4; ++m) _Pragma("unroll") for (int k = 0; k < 2; ++k) dst[m][k] = *(const LAS bf16x8*)(lds + PG8_SA(b, h) + aoff + m * 2048 + k * 1024); } while (0)
#define PG8_LDB(dst, b, h) do { _Pragma("unroll") for (int n = 0; n < 2; ++n) _Pragma("unroll") for (int k = 0; k < 2; ++k) dst[n][k] = *(const LAS bf16x8*)(lds + PG8_SB(b, h) + boff + n * 2048 + k * 1024); } while (0)
#define PG8_MMA(ai, bj, At, Bt) do { __builtin_amdgcn_s_setprio(1); _Pragma("unroll") for (int m = 0; m < 4; ++m) _Pragma("unroll") for (int n = 0; n < 2; ++n) _Pragma("unroll") for (int k = 0; k < 2; ++k) \
        acc[ai][bj][m][n] = __builtin_amdgcn_mfma_f32_16x16x32_bf16(Bt[n][k], At[m][k], acc[ai][bj][m][n], 0, 0, 0); __builtin_amdgcn_s_setprio(0); } while (0)
#define PG8_WAIT_V(n) asm volatile("s_waitcnt vmcnt(" #n ")" ::: "memory")
#define PG8_WAIT_L(n) asm volatile("s_waitcnt lgkmcnt(" #n ")" ::: "memory")
#define PG8_BAR __builtin_amdgcn_s_barrier()
#define PG8_SCHED __builtin_amdgcn_sched_barrier(0)
    Unit cur, nxt; int ui = 0;
    if (!S.next(0, cur)) return;
    f32x4 acc[2][2][4][2];
#pragma unroll
    for (int a = 0; a < 2; ++a)
#pragma unroll
        for (int b = 0; b < 2; ++b)
#pragma unroll
            for (int m = 0; m < 4; ++m)
#pragma unroll
                for (int n = 0; n < 2; ++n) acc[a][b][m][n] = (f32x4){0.f, 0.f, 0.f, 0.f};
    bf16x8 At[4][2], B0[2][2], B1[2][2];
    const char* cA = (const char*)g.A + (size_t)cur.pm * tsA; const char* cB = (const char*)g.Bt + (size_t)cur.pn * tsB;
    S.a_ready(cur);
    PG8_STAGE(PG8_SB(0, 0), cB, voffB); PG8_STAGE(PG8_SA(0, 0), cA, voffA); PG8_STAGE(PG8_SB(0, 1), cB + hsB, voffB); PG8_STAGE(PG8_SA(0, 1), cA + hsA, voffA);
    if (wr == 1) PG8_BAR;
    PG8_WAIT_V(4); PG8_BAR;
    PG8_STAGE(PG8_SB(1, 0), cB + kstep, voffB); PG8_STAGE(PG8_SA(1, 0), cA + kstep, voffA); PG8_STAGE(PG8_SB(1, 1), cB + hsB + kstep, voffB);
    PG8_WAIT_V(6); PG8_BAR;
    for (;;) {
        const bool has_next = S.next(ui + 1, nxt);
        const char* nA = has_next ? (const char*)g.A + (size_t)nxt.pm * tsA : cA; const char* nB = has_next ? (const char*)g.Bt + (size_t)nxt.pn * tsB : cB;
        for (int t = 0; t < nt; t += 2) {
            const bool last = (t == nt - 2);
            const char* a1 = cA + (size_t)(t + 1) * kstep;
            const char* a2 = last ? nA : cA + (size_t)(t + 2) * kstep; const char* b2 = last ? nB : cB + (size_t)(t + 2) * kstep;
            const char* a3 = a2 + kstep; const char* b3 = b2 + kstep;
            if (last && has_next) S.a_ready(nxt);
            if constexpr (Epi::HAS_MID) { if (t == 16 || t == 20) E.mid(acc, cur, t, wr, wc, fr, fq); }
            PG8_LDB(B0, 0, 0); PG8_SCHED; PG8_LDA(At, 0, 0); PG8_STAGE(PG8_SA(1, 1), a1 + hsA, voffA);
            PG8_WAIT_L(8); PG8_BAR; PG8_WAIT_L(0); PG8_MMA(0, 0, At, B0); PG8_BAR; PG8_SCHED;
            PG8_LDB(B1, 0, 1); PG8_STAGE(PG8_SB(0, 0), b2, voffB);
            PG8_BAR; PG8_WAIT_L(0); PG8_MMA(0, 1, At, B1); PG8_BAR;
            PG8_LDA(At, 0, 1); PG8_STAGE(PG8_SA(0, 0), a2, voffA);
            PG8_BAR; PG8_WAIT_L(0); PG8_MMA(1, 0, At, B0); PG8_BAR; PG8_SCHED;
            PG8_STAGE(PG8_SB(0, 1), b2 + hsB, voffB);
            PG8_WAIT_V(6); PG8_BAR; PG8_MMA(1, 1, At, B1); PG8_BAR;
            PG8_LDB(B0, 1, 0); PG8_SCHED; PG8_LDA(At, 1, 0); PG8_STAGE(PG8_SA(0, 1), a2 + hsA, voffA);
            PG8_WAIT_L(8); PG8_BAR; PG8_WAIT_L(0); PG8_MMA(0, 0, At, B0); PG8_BAR; PG8_SCHED;
            PG8_LDB(B1, 1, 1); PG8_STAGE(PG8_SB(1, 0), b3, voffB);
            PG8_BAR; PG8_WAIT_L(0); PG8_MMA(0, 1, At, B1); PG8_BAR;
            PG8_LDA(At, 1, 1); PG8_STAGE(PG8_SA(1, 0), a3, voffA);
            PG8_BAR; PG8_WAIT_L(0); PG8_MMA(1, 0, At, B0); PG8_BAR; PG8_SCHED;
            PG8_STAGE(PG8_SB(1, 1), b3 + hsB, voffB);
            PG8_WAIT_V(6); PG8_BAR; PG8_MMA(1, 1, At, B1); PG8_BAR;
        }
        E(acc, cur, wr, wc, fr, fq); S.done(cur);
        if (!has_next) break;
#pragma unroll
        for (int a = 0; a < 2; ++a)
#pragma unroll
            for (int b = 0; b < 2; ++b)
#pragma unroll
                for (int m = 0; m < 4; ++m)
#pragma unroll
                    for (int n = 0; n < 2; ++n) acc[a][b][m][n] = (f32x4){0.f, 0.f, 0.f, 0.f};
        cur = nxt; cA = nA; cB = nB; ++ui;
    }
    PG8_WAIT_V(0);
    if (wr == 0) PG8_BAR;
    PG8_BAR;
#undef PG8_SA
#undef PG8_SB
#undef PG8_STAGE
#undef PG8_LDA
#undef PG8_LDB
#undef PG8_MMA
#undef PG8_WAIT_V
#undef PG8_WAIT_L
#undef PG8_BAR
#undef PG8_SCHED
}
}

#ifndef PROBE
#define PROBE 0
#endif
struct Args {
    const float* in[26]; const int* positions; float* out; unsigned char* ws; int ph_lo, ph_hi; int pad0, pad1;
};
struct Frame {
    LAS unsigned char* lds;
    int tid, lane, wave, G, bid;
    const float* const* in; const int* positions; float* out; unsigned char* ws;
};
__device__ __forceinline__ void frame_refresh(Frame& F) { int l = lane_id(); asm volatile("" : "+v"(l)); F.lane = l; F.tid = F.wave * 64 + l; }
enum { I_X = 0, I_MEM = 1, I_POS = 2, I_NMIXW = 3, I_WIN = 4, I_CONVW = 5, I_CONVB = 6, I_DTB = 7, I_ALOG = 8, I_SSDD = 9, I_SSDNW = 10, I_DQNW = 11, I_DKNW = 12, I_MEMNW = 13,
       I_WMKV = 14, I_MQNW = 15, I_MKNW = 16, I_WSSD = 17, I_WDIL = 18, I_WMEMBR = 19, I_WOUT = 20, I_NFFNW = 21, I_WQ = 22, I_SUBK = 23, I_PD = 24, I_PU = 25 };

__device__ __forceinline__ void p0_transpose_item(const float* W, int ldw, int src_col0, bf16* WT, int ldt, int dst_row0, int dst_col0, int nblk, LAS float* scr, int item, int lane) {
    const int kb = item / nblk, nb = item % nblk, k0 = 64 * kb, n0 = 32 * nb;
#pragma unroll 8
    for (int i = 0; i < 32; ++i) { const int kk = 2 * i + (lane >> 5); scr[kk * 33 + (lane & 31)] = W[(size_t)(k0 + kk) * ldw + src_col0 + n0 + (lane & 31)]; }
    LDS_WAIT(); asm volatile("" ::: "memory");
    const int c = lane & 7;
#pragma unroll
    for (int j = 0; j < 4; ++j) { const int n = (lane >> 3) + 8 * j; const LAS float* s = scr + (8 * c) * 33 + n;
        u32x4 o; o.x = pk2(s[0 * 33], s[1 * 33]); o.y = pk2(s[2 * 33], s[3 * 33]); o.z = pk2(s[4 * 33], s[5 * 33]); o.w = pk2(s[6 * 33], s[7 * 33]);
        *(u32x4*)(WT + (size_t)(dst_row0 + n0 + n) * ldt + dst_col0 + k0 + 8 * c) = o; }
    LDS_WAIT(); asm volatile("" ::: "memory");
}
__device__ __forceinline__ void rms_row_to_bf16(const float* xrow, const float* w, bf16* orow, int lane, f32x4 (&v)[4]) {
    const f32x4* xr = (const f32x4*)xrow + lane; const f32x4* wr = (const f32x4*)w + lane;
    float s = 0.f;
#pragma unroll
    for (int j = 0; j < 4; ++j) { v[j] = xr[64 * j]; s += (v[j].x * v[j].x + v[j].y * v[j].y) + (v[j].z * v[j].z + v[j].w * v[j].w); }
    const float rstd = 1.0f / sqrtf(wave_sum(s) * (1.f / DM) + EPS);
    unsigned long long* o8 = (unsigned long long*)orow + lane;
#pragma unroll
    for (int j = 0; j < 4; ++j) { const f32x4 ww = wr[64 * j]; v[j] = v[j] * rstd * ww;
        o8[64 * j] = (unsigned long long)pk2(v[j].x, v[j].y) | ((unsigned long long)pk2(v[j].z, v[j].w) << 32); }
}
__device__ __forceinline__ void cvt_f32_bf16_stream(const float* src, bf16* dst, size_t n, size_t gtid, size_t gthreads) {
    for (size_t i = gtid * 8; i < n; i += gthreads * 8) { const f32x4 a = *(const f32x4*)(src + i), b = *(const f32x4*)(src + i + 4);
        u32x4 o; o.x = pk2(a.x, a.y); o.y = pk2(a.z, a.w); o.z = pk2(b.x, b.y); o.w = pk2(b.z, b.w); *(u32x4*)(dst + i) = o; }
}
constexpr float PD_SCALE = 64.0f, PU_SCALE = 8.0f;
__device__ __forceinline__ unsigned pk4_fp8(f32x4 v, float sc) {
    const float a = fminf(fmaxf(v.x * sc, -448.f), 448.f), b = fminf(fmaxf(v.y * sc, -448.f), 448.f), c = fminf(fmaxf(v.z * sc, -448.f), 448.f), d = fminf(fmaxf(v.w * sc, -448.f), 448.f);
    unsigned p = __builtin_amdgcn_cvt_pk_fp8_f32(a, b, 0, false); return __builtin_amdgcn_cvt_pk_fp8_f32(c, d, p, true);
}
__device__ __forceinline__ void cvt_f32_fp8_sliced(const float* src, unsigned char* dst, float sc, size_t gtid, size_t gthreads) {
    for (size_t i = gtid * 16; i < (size_t)16384 * 1024; i += gthreads * 16) { const f32x4 a = *(const f32x4*)(src + i), b = *(const f32x4*)(src + i + 4), c = *(const f32x4*)(src + i + 8), d = *(const f32x4*)(src + i + 12);
        const size_t e = i >> 10, dd = i & 1023;
        const u32x4 o = {pk4_fp8(a, sc), pk4_fp8(b, sc), pk4_fp8(c, sc), pk4_fp8(d, sc)}; *(u32x4*)(dst + ((((dd >> 7) * 16384 + e) << 7) + (dd & 127))) = o; }
}
__device__ __forceinline__ void p0_prologue(Frame& F) {
    LAS float* scr = (LAS float*)(F.lds + F.wave * 8448);
    LAS float* wdt = (LAS float*)(F.lds + 8 * 8448);
    const int gw = F.bid * NWAVES + F.wave, NGW = F.G * NWAVES;
    unsigned char* ws = F.ws;
    for (int i = F.tid; i < 1024 * 16; i += NTHR) { const int k = i >> 4, c = i & 15, l = (k & 255) >> 2, e = k & 3, j = k >> 8, q = c >> 2;
        wdt[((((j * 4 + e) * 4 + q) * 64 + l) << 2) + (c & 3)] = F.in[I_WIN][(size_t)k * W_IN_N + OFF_DT + c]; }
    __syncthreads();
    constexpr int IT_A = 16 * 96, IT_B = 16 * 192, IT_MKV = 16 * 48, IT_SSD = 16 * 32, IT_DIL = 4 * 32, IT_MBR = 12 * 32, IT_OUT = 16 * 32, IT_WQ = 16 * 64;
    constexpr int NITEMS = IT_A + IT_B + IT_MKV + IT_SSD + IT_DIL + IT_MBR + IT_OUT + IT_WQ;
    bf16* WallT = (bf16*)(ws + WS_WALLT);
    for (int it = gw; it < NITEMS; it += NGW) {
        int r = it;
        if (r < IT_A) { p0_transpose_item(F.in[I_WIN], W_IN_N, 0, WallT, DM, 0, 0, 96, scr, r, F.lane); continue; } r -= IT_A;
        if (r < IT_B) { p0_transpose_item(F.in[I_WIN], W_IN_N, OFF_AFTER_DT, WallT, DM, 3072, 0, 192, scr, r, F.lane); continue; } r -= IT_B;
        if (r < IT_MKV) { p0_transpose_item(F.in[I_WMKV], 1536, 0, (bf16*)(ws + WS_WMKVT), DM, 0, 0, 48, scr, r, F.lane); continue; } r -= IT_MKV;
        if (r < IT_SSD) { p0_transpose_item(F.in[I_WSSD], DM, 0, (bf16*)(ws + WS_WCATT), YC, 0, 0, 32, scr, r, F.lane); continue; } r -= IT_SSD;
        if (r < IT_DIL) { p0_transpose_item(F.in[I_WDIL], DM, 0, (bf16*)(ws + WS_WCATT), YC, 0, 1024, 32, scr, r, F.lane); continue; } r -= IT_DIL;
        if (r < IT_MBR) { p0_transpose_item(F.in[I_WMEMBR], DM, 0, (bf16*)(ws + WS_WCATT), YC, 0, 1280, 32, scr, r, F.lane); continue; } r -= IT_MBR;
        if (r < IT_OUT) { p0_transpose_item(F.in[I_WOUT], DM, 0, (bf16*)(ws + WS_WOUTT), DM, 0, 0, 32, scr, r, F.lane); continue; } r -= IT_OUT;
        p0_transpose_item(F.in[I_WQ], PEER_Q, 0, (bf16*)(ws + WS_WQT), DM, 0, 0, 64, scr, r, F.lane);
    }
    const size_t gtid = (size_t)F.bid * NTHR + F.tid, gth = (size_t)F.G * NTHR;
    cvt_f32_bf16_stream(F.in[I_SUBK], (bf16*)(ws + WS_SUBK), (size_t)8 * 2 * 128 * 128, gtid, gth);
    cvt_f32_fp8_sliced(F.in[I_PD], ws + WS_PD, PD_SCALE, gtid, gth);
    cvt_f32_fp8_sliced(F.in[I_PU], ws + WS_PU, PU_SCALE, gtid, gth);
    for (int m = gw; m < NB * NMEM; m += NGW) { f32x4 v[4]; rms_row_to_bf16(F.in[I_MEM] + (size_t)m * DM, F.in[I_MEMNW], (bf16*)(ws + WS_MEMN) + (size_t)m * DM, F.lane, v); }
    float* DTp = (float*)(ws + WS_DT);
    const int lane = F.lane;
    const int myj = ((lane >> 5) & 1) * 8 + ((lane >> 4) & 1) * 4 + ((lane >> 3) & 1) * 2 + ((lane >> 2) & 1);
    const float dtb = F.in[I_DTB][myj];
    for (int m = 2 * gw; m < T; m += 2 * NGW) {
        f32x4 va[4], vb[4];
        rms_row_to_bf16(F.in[I_X] + (size_t)m * DM, F.in[I_NMIXW], (bf16*)(ws + WS_ACT1) + (size_t)m * DM, lane, va);
        rms_row_to_bf16(F.in[I_X] + (size_t)(m + 1) * DM, F.in[I_NMIXW], (bf16*)(ws + WS_ACT1) + (size_t)(m + 1) * DM, lane, vb);
        float da[16], db[16];
#pragma unroll
        for (int j = 0; j < 16; ++j) { da[j] = 0.f; db[j] = 0.f; }
#pragma unroll
        for (int j = 0; j < 4; ++j)
#pragma unroll
            for (int e = 0; e < 4; ++e) { const float ua = va[j][e], ub = vb[j][e];
#pragma unroll
                for (int q = 0; q < 4; ++q) { const f32x4 w4 = *(const LAS f32x4*)(wdt + ((((j * 4 + e) * 4 + q) * 64 + lane) << 2));
                    da[4 * q + 0] += ua * w4.x; da[4 * q + 1] += ua * w4.y; da[4 * q + 2] += ua * w4.z; da[4 * q + 3] += ua * w4.w;
                    db[4 * q + 0] += ub * w4.x; db[4 * q + 1] += ub * w4.y; db[4 * q + 2] += ub * w4.z; db[4 * q + 3] += ub * w4.w; }
                __builtin_amdgcn_sched_barrier(0); }
        float ra, rb;
        { float r8a[8], r8b[8], r4a[4], r4b[4], r2a[2], r2b[2];
          { const bool up = (lane & 32) != 0;
#pragma unroll
            for (int k = 0; k < 8; ++k) { r8a[k] = (up ? da[k + 8] : da[k]) + __shfl_xor(up ? da[k] : da[k + 8], 32); r8b[k] = (up ? db[k + 8] : db[k]) + __shfl_xor(up ? db[k] : db[k + 8], 32); } }
          { const bool up = (lane & 16) != 0;
#pragma unroll
            for (int k = 0; k < 4; ++k) { r4a[k] = (up ? r8a[k + 4] : r8a[k]) + __shfl_xor(up ? r8a[k] : r8a[k + 4], 16); r4b[k] = (up ? r8b[k + 4] : r8b[k]) + __shfl_xor(up ? r8b[k] : r8b[k + 4], 16); } }
          { const bool up = (lane & 8) != 0;
#pragma unroll
            for (int k = 0; k < 2; ++k) { r2a[k] = (up ? r4a[k + 2] : r4a[k]) + __shfl_xor(up ? r4a[k] : r4a[k + 2], 8); r2b[k] = (up ? r4b[k + 2] : r4b[k]) + __shfl_xor(up ? r4b[k] : r4b[k + 2], 8); } }
          { const bool up = (lane & 4) != 0; ra = (up ? r2a[1] : r2a[0]) + __shfl_xor(up ? r2a[0] : r2a[1], 4); rb = (up ? r2b[1] : r2b[0]) + __shfl_xor(up ? r2b[0] : r2b[1], 4); }
          ra += __shfl_xor(ra, 2); ra += __shfl_xor(ra, 1); rb += __shfl_xor(rb, 2); rb += __shfl_xor(rb, 1); }
        if ((lane & 3) == 0) { const float xa = ra + dtb, xb = rb + dtb;
            DTp[(size_t)m * 16 + myj] = (xa > 20.f) ? xa : log1pf(__expf(xa)); DTp[(size_t)(m + 1) * 16 + myj] = (xb > 20.f) ? xb : log1pf(__expf(xb)); }
    }
}

__device__ __forceinline__ void norm192_inplace(bf16* p, const float (&w)[4], int lane) {
    u32x2 v = {0u, 0u};
    if (lane < 48) v = *(const u32x2*)(p + 4 * lane);
    float x0 = bflo(v.x), x1 = bfhi(v.x), x2 = bflo(v.y), x3 = bfhi(v.y);
    const float ss = wave_sum((x0 * x0 + x1 * x1) + (x2 * x2 + x3 * x3));
    const float rs = 1.0f / sqrtf(ss * (1.f / 192.f) + EPS);
    if (lane < 48) { const u32x2 o = {pkbf(x0 * rs * w[0], x1 * rs * w[1]), pkbf(x2 * rs * w[2], x3 * rs * w[3])}; *(u32x2*)(p + 4 * lane) = o; }
}
__device__ __forceinline__ void qkprep_phase(Frame& F, int half) {
    bf16* P = (bf16*)(F.ws + WS_BIG);
    const int gw = F.bid * NWAVES + F.wave, NGW = F.G * NWAVES, lane = F.lane, sub = lane & 7;
    float wq[8], wk[8], wmq[4], wmk[4];
#pragma unroll
    for (int j = 0; j < 8; ++j) { wq[j] = F.in[I_DQNW][8 * sub + j]; wk[j] = F.in[I_DKNW][8 * sub + j]; }
#pragma unroll
    for (int j = 0; j < 4; ++j) { wmq[j] = F.in[I_MQNW][(4 * lane + j) % 192]; wmk[j] = F.in[I_MKNW][(4 * lane + j) % 192]; }
    const float inv = __expf(-logf(500000.0f) * (2.0f / 16.0f) * (float)sub);
    for (int r0 = gw; r0 < HT; r0 += 2 * NGW) {
        bf16* rowp[2]; u32x4 v[2][3]; u32x2 m[2][4]; int pos[2];
#pragma unroll
        for (int u = 0; u < 2; ++u) { const int r = (r0 + u * NGW < HT) ? r0 + u * NGW : r0; rowp[u] = P + (size_t)r * NPROJ; pos[u] = F.positions[half * HT + r];
#pragma unroll
            for (int blk = 0; blk < 3; ++blk) v[u][blk] = *(const u32x4*)(rowp[u] + PC_DQ + blk * 512 + 8 * lane);
#pragma unroll
            for (int h = 0; h < 4; ++h) { m[u][h] = (u32x2){0u, 0u}; if (lane < 48) m[u][h] = *(const u32x2*)(rowp[u] + PC_MQ + h * 192 + 4 * lane); } }
#pragma unroll
        for (int u = 0; u < 2; ++u) {
            if (u == 1 && r0 + NGW >= HT) break;
            const double rev = (double)((float)pos[u] * inv) * 0.15915494309189535;
            const float fr = (float)(rev - floor(rev));
            const float cs = __builtin_amdgcn_cosf(fr), sn = __builtin_amdgcn_sinf(fr);
            float cj[8], sj[8];
#pragma unroll
            for (int j = 0; j < 8; ++j) { cj[j] = __shfl(cs, (lane & ~7) | j); sj[j] = __shfl(sn, (lane & ~7) | j); }
            bf16* row = rowp[u];
#pragma unroll
            for (int blk = 0; blk < 3; ++blk) {
                float x[8] = {bflo(v[u][blk].x), bfhi(v[u][blk].x), bflo(v[u][blk].y), bfhi(v[u][blk].y), bflo(v[u][blk].z), bfhi(v[u][blk].z), bflo(v[u][blk].w), bfhi(v[u][blk].w)};
                float ss = 0.f;
#pragma unroll
                for (int j = 0; j < 8; ++j) ss += x[j] * x[j];
                ss += __shfl_xor(ss, 1); ss += __shfl_xor(ss, 2); ss += __shfl_xor(ss, 4);
                const float rs = 1.0f / sqrtf(ss * (1.f / 64.f) + EPS);
                const bool isq = (8 * blk + (lane >> 3)) < 12;
#pragma unroll
                for (int j = 0; j < 8; ++j) x[j] = x[j] * rs * (isq ? wq[j] : wk[j]);
#pragma unroll
                for (int j = 0; j < 8; ++j) { const float o = __shfl_xor(x[j], 1);
                    if (sub == 0) x[j] = x[j] * cj[j] - o * sj[j]; else if (sub == 1) x[j] = x[j] * cj[j] + o * sj[j]; }
                const u32x4 w = {pkbf(x[0], x[1]), pkbf(x[2], x[3]), pkbf(x[4], x[5]), pkbf(x[6], x[7])};
                *(u32x4*)(row + PC_DQ + blk * 512 + 8 * lane) = w;
            }
#pragma unroll
            for (int h = 0; h < 4; ++h) { const u32x2 q = m[u][h]; const float x0 = bflo(q.x), x1 = bfhi(q.x), x2 = bflo(q.y), x3 = bfhi(q.y);
                const float ss = wave_sum((x0 * x0 + x1 * x1) + (x2 * x2 + x3 * x3));
                const float rs = 1.0f / sqrtf(ss * (1.f / 192.f) + EPS);
                if (lane < 48) { const u32x2 o = {pkbf(x0 * rs * wmq[0], x1 * rs * wmq[1]), pkbf(x2 * rs * wmq[2], x3 * rs * wmq[3])}; *(u32x2*)(row + PC_MQ + h * 192 + 4 * lane) = o; } }
        }
    }
    if (half == 0) {
        bf16* MK = (bf16*)(F.ws + WS_MKV);
        for (int r = gw; r < NB * NMEM * 4; r += NGW) norm192_inplace(MK + (size_t)(r >> 2) * 1536 + (r & 3) * 192, wmk, lane);
    }
}

constexpr int SC_ST = 272, SX_ST = 528;
__device__ __forceinline__ float bfsel(const u32x4& v, int j) { const unsigned w = v[j >> 1]; return (j & 1) ? bfhi(w) : bflo(w); }
__device__ __forceinline__ void conv_task(const bf16* P, size_t rowb, int t0, int pcol, const float* cw, const float* cb, int ccol, LAS unsigned char* dst, int stride, const LAS float* scale) {
    float w[4][8], bs[8];
#pragma unroll
    for (int k = 0; k < 4; ++k) { const f32x4 a = *(const f32x4*)(cw + k * 2048 + ccol), b = *(const f32x4*)(cw + k * 2048 + ccol + 4);
        w[k][0] = a.x; w[k][1] = a.y; w[k][2] = a.z; w[k][3] = a.w; w[k][4] = b.x; w[k][5] = b.y; w[k][6] = b.z; w[k][7] = b.w; }
    { const f32x4 a = *(const f32x4*)(cb + ccol), b = *(const f32x4*)(cb + ccol + 4); bs[0] = a.x; bs[1] = a.y; bs[2] = a.z; bs[3] = a.w; bs[4] = b.x; bs[5] = b.y; bs[6] = b.z; bs[7] = b.w; }
    const bf16* src = P + (rowb + t0) * NPROJ + pcol;
    u32x4 rw[19];
#pragma unroll
    for (int i = 0; i < 3; ++i) rw[i] = (u32x4){0u, 0u, 0u, 0u};
    if (t0 > 0) {
#pragma unroll
        for (int i = 0; i < 3; ++i) rw[i] = *(const u32x4*)(src + (ptrdiff_t)(i - 3) * NPROJ); }
#pragma unroll
    for (int i = 0; i < 16; ++i) rw[3 + i] = *(const u32x4*)(src + (size_t)i * NPROJ);
#pragma unroll
    for (int i = 0; i < 16; ++i) {
        float o[8];
#pragma unroll
        for (int j = 0; j < 8; ++j) { float a = bs[j] + w[0][j] * bfsel(rw[i], j) + w[1][j] * bfsel(rw[i + 1], j) + w[2][j] * bfsel(rw[i + 2], j) + w[3][j] * bfsel(rw[i + 3], j); o[j] = a * sigmoidf_(a); }
        if (scale) { const float sv = scale[i];
#pragma unroll
            for (int j = 0; j < 8; ++j) o[j] *= sv; }
        const u32x4 r = {pkbf(o[0], o[1]), pkbf(o[2], o[3]), pkbf(o[4], o[5]), pkbf(o[6], o[7])};
        *(LAS u32x4*)(dst + i * stride) = r;
    }
}
__device__ __forceinline__ float ssd_scan(Frame& F, const float* DTp, size_t tok0, int g, LAS float* sAc, LAS float* sDt) {
    float total = 0.f;
    if (F.wave < 4) {
        const int head = 4 * g + F.wave, lane = F.lane;
        const float A = -__expf(F.in[I_ALOG][head]);
        const float d0 = DTp[(tok0 + 2 * lane) * 16 + head], d1 = DTp[(tok0 + 2 * lane + 1) * 16 + head];
        const float a0 = d0 * A, a1 = d1 * A;
        float sc = a0 + a1;
#pragma unroll
        for (int o = 1; o < 64; o <<= 1) { const float v = __shfl_up(sc, o); if (lane >= o) sc += v; }
        sAc[F.wave * 128 + 2 * lane] = sc - a1; sAc[F.wave * 128 + 2 * lane + 1] = sc;
        sDt[F.wave * 128 + 2 * lane] = d0; sDt[F.wave * 128 + 2 * lane + 1] = d1;
        total = __shfl(sc, 63);
    }
    return total;
}
__device__ __forceinline__ bf16x8 tr_pair(unsigned a_lo, unsigned a_hi) {
    s16x4 lo, hi;
    asm volatile("ds_read_b64_tr_b16 %0, %2\n\tds_read_b64_tr_b16 %1, %3\n\ts_waitcnt lgkmcnt(0)" : "=&v"(lo), "=&v"(hi) : "v"(a_lo), "v"(a_hi) : "memory");
    const bf16x8 r = {lo[0], lo[1], lo[2], lo[3], hi[0], hi[1], hi[2], hi[3]}; return r;
}

__device__ __forceinline__ void ssdC_phase(Frame& F, int half) {
    const bf16* P = (const bf16*)(F.ws + WS_BIG);
    const float* DTp = (const float*)(F.ws + WS_DT);
    float* SST = (float*)(F.ws + WS_SST); float* DEC = (float*)(F.ws + WS_DEC);
    LAS unsigned char* sX = F.lds; LAS unsigned char* sB = F.lds + 128 * SX_ST;
    LAS float* sAc = (LAS float*)(F.lds + 128 * SX_ST + 128 * SC_ST); LAS float* sDt = sAc + 512; LAS float* sW = sDt + 512;
    const int wave = F.wave;
    for (int unit = F.bid; unit < HB * 64 * 4; unit += F.G) {
        int tid = F.tid; asm volatile("" : "+v"(tid));
        const int lane = tid & 63, ql = lane & 31, h = lane >> 5, tq = (lane & 15) >> 2, tp = lane & 3, tblk = (lane >> 4) & 1;
        const int bl = unit >> 8, c = (unit >> 2) & 63, g = unit & 3;
        const size_t rowb = (size_t)bl * SEQ, tok0 = (size_t)half * HT + rowb + c * 128;
        __syncthreads();
        const float total = ssd_scan(F, DTp, tok0, g, sAc, sDt);
        if (wave < 4) { sW[wave * 128 + 2 * lane] = __expf(total - sAc[wave * 128 + 2 * lane]) * sDt[wave * 128 + 2 * lane];
            sW[wave * 128 + 2 * lane + 1] = __expf(total - sAc[wave * 128 + 2 * lane + 1]) * sDt[wave * 128 + 2 * lane + 1];
            if (lane == 0) DEC[((size_t)bl * 64 + c) * 16 + 4 * g + wave] = __expf(total); }
        __syncthreads();
        if (tid < 384) {
            int ch, strip, ccol, stride; LAS unsigned char* dst; const LAS float* scl = nullptr;
            if (tid < 256) { ch = tid & 31; strip = tid >> 5; ccol = g * 256 + 8 * ch; stride = SX_ST; dst = sX + (strip * 16) * SX_ST + ch * 16; scl = sW + (ch >> 3) * 128 + strip * 16; }
            else { const int u = tid - 256; ch = u & 15; strip = u >> 4; ccol = 1024 + g * 128 + 8 * ch; stride = SC_ST; dst = sB + (strip * 16) * SC_ST + ch * 16; }
            conv_task(P, rowb, c * 128 + strip * 16, PC_X + ccol, F.in[I_CONVW], F.in[I_CONVB], ccol, dst, stride, scl);
        }
        __syncthreads();
        const int r = wave >> 1, pt = wave & 1;
        f32x16 acc[4];
#pragma unroll
        for (int nt = 0; nt < 4; ++nt)
#pragma unroll
            for (int e = 0; e < 16; ++e) acc[nt][e] = 0.f;
        const unsigned xa = (unsigned)(size_t)sX + (unsigned)((8 * h + tq) * SX_ST + (r * 64 + 32 * pt + 16 * tblk + 4 * tp) * 2);
        const unsigned ba = (unsigned)(size_t)sB + (unsigned)((8 * h + tq) * SC_ST + (16 * tblk + 4 * tp) * 2);
#pragma unroll
        for (int ks = 0; ks < 8; ++ks) {
            const bf16x8 af = tr_pair(xa + ks * 16 * SX_ST, xa + ks * 16 * SX_ST + 4 * SX_ST);
            bf16x8 bfr[4];
#pragma unroll
            for (int nt = 0; nt < 4; ++nt) bfr[nt] = tr_pair(ba + ks * 16 * SC_ST + nt * 64, ba + ks * 16 * SC_ST + 4 * SC_ST + nt * 64);
            __builtin_amdgcn_sched_barrier(0);
#pragma unroll
            for (int nt = 0; nt < 4; ++nt) acc[nt] = MFMA32(af, bfr[nt], acc[nt]);
        }
        float* out = SST + (((size_t)bl * 64 + c) * 16 + 4 * g + r) * 8192;
#pragma unroll
        for (int nt = 0; nt < 4; ++nt)
#pragma unroll
            for (int e = 0; e < 16; ++e) out[(32 * pt + (e & 3) + 8 * (e >> 2) + 4 * h) * 128 + 32 * nt + ql] = acc[nt][e];
    }
}

__device__ __forceinline__ void ssdD_phase(Frame& F) {
    const float* SST = (const float*)(F.ws + WS_SST); const float* DEC = (const float*)(F.ws + WS_DEC);
    bf16* SIN = (bf16*)(F.ws + WS_SIN);
    const size_t gtid = (size_t)F.bid * NTHR + F.tid, gth = (size_t)F.G * NTHR;
    for (size_t it = gtid; it < (size_t)HB * 16 * 2048; it += gth) {
        const int bl = (int)(it >> 15), head = (int)(it >> 11) & 15, e4 = (int)(it & 2047) * 4;
        f32x4 st = {0.f, 0.f, 0.f, 0.f};
#pragma unroll 8
        for (int c = 0; c < 64; ++c) {
            const size_t idx = (((size_t)bl * 64 + c) * 16 + head);
            const u32x2 o = {pkbf(st.x, st.y), pkbf(st.z, st.w)};
            *(u32x2*)(SIN + idx * 8192 + e4) = o;
            const f32x4 sl = *(const f32x4*)(SST + idx * 8192 + e4); const float d = DEC[idx];
            st = st * d + sl;
        }
    }
}

__device__ __forceinline__ void ssdE_phase(Frame& F, int half) {
    const bf16* P = (const bf16*)(F.ws + WS_BIG);
    const float* DTp = (const float*)(F.ws + WS_DT);
    const bf16* SIN = (const bf16*)(F.ws + WS_SIN);
    bf16* Y = (bf16*)F.out;
    LAS unsigned char* sX = F.lds; LAS unsigned char* sB = F.lds + 128 * SX_ST; LAS unsigned char* sC = sB + 128 * SC_ST;
    LAS float* sAc = (LAS float*)(sC + 128 * SC_ST); LAS float* sDt = sAc + 512; LAS float* sSS = sDt + 512;
    const int wave = F.wave;
    const int st = wave & 3, hp = wave >> 2;
    for (int unit = F.bid; unit < HB * 64 * 4; unit += F.G) {
        int tid = F.tid; asm volatile("" : "+v"(tid));
        const int lane = tid & 63, ql = lane & 31, h = lane >> 5, tq = (lane & 15) >> 2, tp = lane & 3, tblk = (lane >> 4) & 1;
        const int bl = unit >> 8, c = (unit >> 2) & 63, g = unit & 3;
        const size_t rowb = (size_t)bl * SEQ, tok0 = (size_t)half * HT + rowb + c * 128;
        __syncthreads();
        (void)ssd_scan(F, DTp, tok0, g, sAc, sDt);
        if (tid < 128) sSS[tid] = 0.f;
        {
            int ch, strip, ccol, stride; LAS unsigned char* dst;
            if (tid < 256) { ch = tid & 31; strip = tid >> 5; ccol = g * 256 + 8 * ch; stride = SX_ST; dst = sX + (strip * 16) * SX_ST + ch * 16; }
            else if (tid < 384) { const int u = tid - 256; ch = u & 15; strip = u >> 4; ccol = 1024 + g * 128 + 8 * ch; stride = SC_ST; dst = sB + (strip * 16) * SC_ST + ch * 16; }
            else { const int u = tid - 384; ch = u & 15; strip = u >> 4; ccol = 1536 + g * 128 + 8 * ch; stride = SC_ST; dst = sC + (strip * 16) * SC_ST + ch * 16; }
            conv_task(P, rowb, c * 128 + strip * 16, PC_X + ccol, F.in[I_CONVW], F.in[I_CONVB], ccol, dst, stride, nullptr);
        }
        __syncthreads();
        const int s = 32 * st + ql;
        unsigned yk[2][2][8];
        float ssq = 0.f;
        const unsigned xa = (unsigned)(size_t)sX + (unsigned)((4 * h + tq) * SX_ST + (16 * tblk + 4 * tp) * 2);
#pragma unroll
        for (int hq = 0; hq < 2; ++hq) {
            const int r = 2 * hp + hq, head = 4 * g + r;
            const float acs = sAc[r * 128 + s];
            const bf16* stp = SIN + (((size_t)bl * 64 + c) * 16 + head) * 8192 + ql * 128 + 8 * h;
            bf16x8 sfr[2][8];
#pragma unroll
            for (int pt = 0; pt < 2; ++pt)
#pragma unroll
                for (int ks = 0; ks < 8; ++ks) sfr[pt][ks] = *(const bf16x8*)(stp + pt * 4096 + 16 * ks);
            bf16x8 pf[4][2];
#pragma unroll
            for (int i = 0; i < 4; ++i) {
                f32x16 Xi;
#pragma unroll
                for (int e = 0; e < 16; ++e) Xi[e] = 0.f;
#pragma unroll
                for (int ks = 0; ks < 8; ++ks) { const bf16x8 bf_ = *(const LAS bf16x8*)(sB + (32 * i + ql) * SC_ST + 32 * ks + 16 * h);
                    const bf16x8 cf = *(const LAS bf16x8*)(sC + s * SC_ST + 32 * ks + 16 * h); Xi = MFMA32(bf_, cf, Xi); }
                float p[16];
#pragma unroll
                for (int q4 = 0; q4 < 4; ++q4) { const int t0 = 32 * i + 8 * q4 + 4 * h;
                    const f32x4 at = *(const LAS f32x4*)(sAc + r * 128 + t0), dt4 = *(const LAS f32x4*)(sDt + r * 128 + t0);
#pragma unroll
                    for (int e = 0; e < 4; ++e) { const int t = t0 + e; p[4 * q4 + e] = (t <= s) ? Xi[4 * q4 + e] * __expf(acs - at[e]) * dt4[e] : 0.f; } }
#pragma unroll
                for (int s2 = 0; s2 < 2; ++s2) { const u32x4 w = {pkbf(p[8 * s2 + 0], p[8 * s2 + 1]), pkbf(p[8 * s2 + 2], p[8 * s2 + 3]), pkbf(p[8 * s2 + 4], p[8 * s2 + 5]), pkbf(p[8 * s2 + 6], p[8 * s2 + 7])};
                    pf[i][s2] = __builtin_bit_cast(bf16x8, w); }
            }
            const float eacs = __expf(acs), Dh = F.in[I_SSDD][head];
#pragma unroll
            for (int pt = 0; pt < 2; ++pt) {
                f32x16 yd, yo;
#pragma unroll
                for (int e = 0; e < 16; ++e) { yd[e] = 0.f; yo[e] = 0.f; }
#pragma unroll
                for (int i = 0; i < 4; ++i) {
#pragma unroll
                    for (int s2 = 0; s2 < 2; ++s2) { const unsigned a = xa + (unsigned)((32 * i + 16 * s2) * SX_ST + (r * 64 + 32 * pt) * 2);
                        const bf16x8 xf = tr_pair(a, a + 8 * SX_ST); __builtin_amdgcn_sched_barrier(0); yd = MFMA32(xf, pf[i][s2], yd); }
                }
#pragma unroll
                for (int ks = 0; ks < 8; ++ks) { const bf16x8 cf = *(const LAS bf16x8*)(sC + s * SC_ST + 32 * ks + 16 * h); yo = MFMA32(sfr[pt][ks], cf, yo); }
                const bf16* zp = P + (rowb + c * 128 + s) * NPROJ + PC_Z + g * 256 + r * 64 + 32 * pt + 4 * h;
                u32x2 zv[4];
#pragma unroll
                for (int q4 = 0; q4 < 4; ++q4) zv[q4] = *(const u32x2*)(zp + 8 * q4);
#pragma unroll
                for (int q4 = 0; q4 < 4; ++q4) {
                    const u32x2 xv = *(const LAS u32x2*)(sX + s * SX_ST + (r * 64 + 32 * pt + 8 * q4 + 4 * h) * 2);
                    const u32x2 zq = zv[q4];
                    const float xs_[4] = {bflo(xv.x), bfhi(xv.x), bflo(xv.y), bfhi(xv.y)}, zs_[4] = {bflo(zq.x), bfhi(zq.x), bflo(zq.y), bfhi(zq.y)};
                    float yv[4];
#pragma unroll
                    for (int e = 0; e < 4; ++e) { float y = yd[4 * q4 + e] + eacs * yo[4 * q4 + e] + Dh * xs_[e]; y = y * zs_[e] * sigmoidf_(zs_[e]); yv[e] = y; ssq += y * y; }
                    yk[hq][pt][2 * q4] = pkbf(yv[0], yv[1]); yk[hq][pt][2 * q4 + 1] = pkbf(yv[2], yv[3]);
                }
            }
        }
        ssq += __shfl_xor(ssq, 32);
        if (h == 0) __hip_atomic_fetch_add(sSS + s, ssq, __ATOMIC_RELAXED, __HIP_MEMORY_SCOPE_WORKGROUP);
        __syncthreads();
        const float rs = 1.0f / sqrtf(sSS[s] * (1.f / 256.f) + EPS);
        bf16* yp = Y + (tok0 + s) * YC + g * 256 + 4 * h;
        const float* nw = F.in[I_SSDNW] + g * 256 + 4 * h;
#pragma unroll
        for (int hq = 0; hq < 2; ++hq)
#pragma unroll
            for (int pt = 0; pt < 2; ++pt)
#pragma unroll
                for (int q4 = 0; q4 < 4; ++q4) { const int cc = (2 * hp + hq) * 64 + 32 * pt + 8 * q4; const f32x4 w4 = *(const f32x4*)(nw + cc);
                    const unsigned ya = yk[hq][pt][2 * q4], yb = yk[hq][pt][2 * q4 + 1];
                    const u32x2 o = {pkbf(bflo(ya) * rs * w4.x, bfhi(ya) * rs * w4.y), pkbf(bflo(yb) * rs * w4.z, bfhi(yb) * rs * w4.w)};
                    *(u32x2*)(yp + cc) = o; }
    }
}

__device__ __forceinline__ bf16x8 mk_bf16x8(u32x2 lo, u32x2 hi) { const u32x4 v = {lo.x, lo.y, hi.x, hi.y}; return __builtin_bit_cast(bf16x8, v); }

__device__ __forceinline__ void memattn_mfma_phase(Frame& F, int half) {
    const bf16* P = (const bf16*)(F.ws + WS_BIG);
    const bf16* MKV = (const bf16*)(F.ws + WS_MKV);
    const bf16* MVT = (const bf16*)(F.ws + WS_MVT);
    bf16* Y = (bf16*)F.out;
    LAS unsigned char* sm = F.lds;
    const int tid = F.tid, lane = F.lane, wave = F.wave, ql = lane & 31, h = lane >> 5;
    constexpr int KST = 400, VST = 528;
    for (int unit = F.bid; unit < HB * 4 * 32; unit += F.G) {
        const int bl = unit >> 7, head = (unit >> 5) & 3, qt = unit & 31, b = half * HB + bl;
        const int r = bl * SEQ + qt * 256 + wave * 32 + ql;
        __syncthreads();
        for (int c = tid; c < 256 * 24; c += NTHR) { const int row = c / 24, ch = c % 24;
            *(LAS u32x4*)(sm + row * KST + ch * 16) = *(const u32x4*)(MKV + (size_t)(b * NMEM + row) * 1536 + head * 192 + ch * 8); }
        bf16x8 qf[12];
        { const bf16* qp = P + (size_t)r * NPROJ + PC_MQ + head * 192 + 8 * h;
#pragma unroll
          for (int ks = 0; ks < 12; ++ks) qf[ks] = *(const bf16x8*)(qp + 16 * ks); }
        __syncthreads();
        f32x16 sacc[8];
#pragma unroll
        for (int mt = 0; mt < 8; ++mt) {
#pragma unroll
            for (int i = 0; i < 16; ++i) sacc[mt][i] = 0.f;
#pragma unroll
            for (int ks = 0; ks < 12; ++ks) { const bf16x8 kf = *(const LAS bf16x8*)(sm + (32 * mt + ql) * KST + 32 * ks + 16 * h); sacc[mt] = MFMA32(kf, qf[ks], sacc[mt]); }
        }
        float mx = -3.0e38f;
#pragma unroll
        for (int mt = 0; mt < 8; ++mt)
#pragma unroll
            for (int i = 0; i < 16; ++i) mx = fmaxf(mx, sacc[mt][i]);
        mx = fmaxf(mx, __shfl_xor(mx, 32));
        const float sc = 0.07216878364870323f * 1.4426950408889634f;
        float l = 0.f;
        bf16x8 pf[8][2];
#pragma unroll
        for (int mt = 0; mt < 8; ++mt) {
            float p[16];
#pragma unroll
            for (int i = 0; i < 16; ++i) { p[i] = __builtin_amdgcn_exp2f((sacc[mt][i] - mx) * sc); l += p[i]; }
#pragma unroll
            for (int s2 = 0; s2 < 2; ++s2) { const u32x4 w = {pkbf(p[8 * s2 + 0], p[8 * s2 + 1]), pkbf(p[8 * s2 + 2], p[8 * s2 + 3]), pkbf(p[8 * s2 + 4], p[8 * s2 + 5]), pkbf(p[8 * s2 + 6], p[8 * s2 + 7])};
                pf[mt][s2] = __builtin_bit_cast(bf16x8, w); }
        }
        l += __shfl_xor(l, 32);
        __syncthreads();
        for (int c = tid; c < 192 * 32; c += NTHR) { const int row = c >> 5, ch = c & 31;
            *(LAS u32x4*)(sm + row * VST + ch * 16) = *(const u32x4*)(MVT + (size_t)(head * 192 + row) * 2048 + b * NMEM + ch * 8); }
        __syncthreads();
        const float il = 1.0f / l;
        bf16* yp = Y + ((size_t)half * HT + r) * YC + 1280 + head * 192 + 4 * h;
#pragma unroll
        for (int dt = 0; dt < 6; ++dt) {
            f32x16 o;
#pragma unroll
            for (int i = 0; i < 16; ++i) o[i] = 0.f;
#pragma unroll
            for (int mt = 0; mt < 8; ++mt)
#pragma unroll
                for (int s2 = 0; s2 < 2; ++s2) { const LAS unsigned char* vp = sm + (32 * dt + ql) * VST + (32 * mt + 16 * s2 + 4 * h) * 2;
                    const bf16x8 vf = mk_bf16x8(*(const LAS u32x2*)vp, *(const LAS u32x2*)(vp + 16)); o = MFMA32(vf, pf[mt][s2], o); }
#pragma unroll
            for (int g = 0; g < 4; ++g) { const u32x2 w = {pkbf(o[4 * g] * il, o[4 * g + 1] * il), pkbf(o[4 * g + 2] * il, o[4 * g + 3] * il)}; *(u32x2*)(yp + 32 * dt + 8 * g) = w; }
        }
    }
}

__device__ __forceinline__ void dilattn_mfma_phase(Frame& F, int half) {
    bf16* P = (bf16*)(F.ws + WS_BIG);
    float* LSE = (float*)(F.ws + WS_LSE);
    LAS unsigned char* sK = F.lds; LAS unsigned char* sV = F.lds + 384 * 144;
    const int tid = F.tid, lane = F.lane, wave = F.wave, ql = lane & 31, h = lane >> 5;
    constexpr int RST = 144;
    for (int unit = F.bid; unit < HB * 12 * 32; unit += F.G) {
        const int bl = unit / 384, rem = unit % 384, head = rem >> 5, blk = rem & 31;
        const int g = head >> 2, dil = (g == 0) ? 1 : (g == 1 ? 4 : 16), bpr = 32 / dil;
        const int res = blk / bpr, q0 = (blk % bpr) * 256;
        const size_t rowb = (size_t)bl * SEQ;
        __syncthreads();
        for (int c = tid; c < 384 * 8; c += NTHR) { const int row = c >> 3, ch = c & 7; const int ks = q0 - 128 + row;
            u32x4 kv = {0u, 0u, 0u, 0u}, vv = {0u, 0u, 0u, 0u};
            if (ks >= 0) { const bf16* src = P + (rowb + (size_t)ks * dil + res) * NPROJ + head * 64 + ch * 8; kv = *(const u32x4*)(src + PC_DK); vv = *(const u32x4*)(src + PC_DV); }
            *(LAS u32x4*)(sK + row * RST + ch * 16) = kv; *(LAS u32x4*)(sV + row * RST + ch * 16) = vv; }
        const int qs = q0 + wave * 32 + ql;
        const size_t rq = rowb + (size_t)qs * dil + res;
        bf16* qp = P + rq * NPROJ + PC_DQ + head * 64;
        bf16x8 qf[4];
#pragma unroll
        for (int ks = 0; ks < 4; ++ks) qf[ks] = *(const bf16x8*)(qp + 16 * ks + 8 * h);
        __syncthreads();
        f32x16 sacc[5];
        const int kfirst = q0 + wave * 32 - 128;
#pragma unroll
        for (int i = 0; i < 5; ++i) {
#pragma unroll
            for (int e = 0; e < 16; ++e) sacc[i][e] = 0.f;
#pragma unroll
            for (int ks = 0; ks < 4; ++ks) { const bf16x8 kf = *(const LAS bf16x8*)(sK + (32 * wave + 32 * i + ql) * RST + 32 * ks + 16 * h); sacc[i] = MFMA32(kf, qf[ks], sacc[i]); }
        }
        float mx = -3.0e38f;
#pragma unroll
        for (int i = 0; i < 5; ++i)
#pragma unroll
            for (int e = 0; e < 16; ++e) { const int kj = 32 * i + (e & 3) + 8 * (e >> 2) + 4 * h; const bool ok = (kj >= ql) && (kj <= ql + 128) && (kfirst + kj >= 0);
                sacc[i][e] = ok ? sacc[i][e] : -3.0e38f; mx = fmaxf(mx, sacc[i][e]); }
        mx = fmaxf(mx, __shfl_xor(mx, 32));
        const float sc = 0.125f * 1.4426950408889634f;
        float l = 0.f;
        bf16x8 pf[5][2];
#pragma unroll
        for (int i = 0; i < 5; ++i) {
            float p[16];
#pragma unroll
            for (int e = 0; e < 16; ++e) { p[e] = (sacc[i][e] > -1.0e38f) ? __builtin_amdgcn_exp2f((sacc[i][e] - mx) * sc) : 0.f; l += p[e]; }
#pragma unroll
            for (int s2 = 0; s2 < 2; ++s2) { const u32x4 w = {pkbf(p[8 * s2 + 0], p[8 * s2 + 1]), pkbf(p[8 * s2 + 2], p[8 * s2 + 3]), pkbf(p[8 * s2 + 4], p[8 * s2 + 5]), pkbf(p[8 * s2 + 6], p[8 * s2 + 7])};
                pf[i][s2] = __builtin_bit_cast(bf16x8, w); }
        }
        l += __shfl_xor(l, 32);
        const float il = 1.0f / l;
        const int tq = (lane & 15) >> 2, tp = lane & 3, tblk = (lane >> 4) & 1;
        const unsigned vbase = (unsigned)(size_t)(sV) + (unsigned)((32 * wave + 4 * h + tq) * RST + (16 * tblk + 4 * tp) * 2);
#pragma unroll
        for (int dt = 0; dt < 2; ++dt) {
            f32x16 o;
#pragma unroll
            for (int e = 0; e < 16; ++e) o[e] = 0.f;
#pragma unroll
            for (int i = 0; i < 5; ++i) {
                s16x4 lo[2], hi[2];
#pragma unroll
                for (int s2 = 0; s2 < 2; ++s2) { const unsigned a = vbase + (unsigned)((32 * i + 16 * s2) * RST + 64 * dt);
                    asm volatile("ds_read_b64_tr_b16 %0, %1" : "=&v"(lo[s2]) : "v"(a) : "memory");
                    asm volatile("ds_read_b64_tr_b16 %0, %1 offset:1152" : "=&v"(hi[s2]) : "v"(a) : "memory"); }
                asm volatile("s_waitcnt lgkmcnt(0)" ::: "memory"); __builtin_amdgcn_sched_barrier(0);
#pragma unroll
                for (int s2 = 0; s2 < 2; ++s2) { const bf16x8 vf = {lo[s2][0], lo[s2][1], lo[s2][2], lo[s2][3], hi[s2][0], hi[s2][1], hi[s2][2], hi[s2][3]}; o = MFMA32(vf, pf[i][s2], o); }
            }
#pragma unroll
            for (int gq = 0; gq < 4; ++gq) { const u32x2 w = {pkbf(o[4 * gq] * il, o[4 * gq + 1] * il), pkbf(o[4 * gq + 2] * il, o[4 * gq + 3] * il)}; *(u32x2*)(qp + 32 * dt + 8 * gq + 4 * h) = w; }
        }
        if (h == 0) LSE[((size_t)half * HT + rq) * 12 + head] = mx * 0.125f + __logf(l);
    }
}

__device__ __forceinline__ void dilmerge_phase(Frame& F, int half) {
    const bf16* P = (const bf16*)(F.ws + WS_BIG);
    const float* LSE = (const float*)(F.ws + WS_LSE);
    bf16* Y = (bf16*)F.out;
    const size_t gtid = (size_t)F.bid * NTHR + F.tid, gth = (size_t)F.G * NTHR;
    for (size_t it = gtid; it < (size_t)HT * 32; it += gth) {
        const size_t r = it >> 5; const int hh = (int)(it >> 3) & 3, d0 = (int)(it & 7) * 8;
        const size_t tok = (size_t)half * HT + r;
        const float l0 = LSE[tok * 12 + hh], l1 = LSE[tok * 12 + 4 + hh], l2 = LSE[tok * 12 + 8 + hh];
        const float m = fmaxf(l0, fmaxf(l1, l2));
        float w0 = __expf(l0 - m), w1 = __expf(l1 - m), w2 = __expf(l2 - m); const float iw = 1.0f / (w0 + w1 + w2); w0 *= iw; w1 *= iw; w2 *= iw;
        const bf16* op = P + r * NPROJ + PC_DQ + hh * 64 + d0;
        const u32x4 a = *(const u32x4*)op, b = *(const u32x4*)(op + 256), c = *(const u32x4*)(op + 512);
        u32x4 o;
        o.x = pkbf(w0 * bflo(a.x) + w1 * bflo(b.x) + w2 * bflo(c.x), w0 * bfhi(a.x) + w1 * bfhi(b.x) + w2 * bfhi(c.x));
        o.y = pkbf(w0 * bflo(a.y) + w1 * bflo(b.y) + w2 * bflo(c.y), w0 * bfhi(a.y) + w1 * bfhi(b.y) + w2 * bfhi(c.y));
        o.z = pkbf(w0 * bflo(a.z) + w1 * bflo(b.z) + w2 * bflo(c.z), w0 * bfhi(a.z) + w1 * bfhi(b.z) + w2 * bfhi(c.z));
        o.w = pkbf(w0 * bflo(a.w) + w1 * bflo(b.w) + w2 * bflo(c.w), w0 * bfhi(a.w) + w1 * bfhi(b.w) + w2 * bfhi(c.w));
        *(u32x4*)(Y + tok * YC + 1024 + hh * 64 + d0) = o;
    }
}

__device__ __forceinline__ void hn_panel(Frame& F, int pm) {
    for (int m = pm * 256 + F.wave; m < pm * 256 + 256; m += NWAVES) { f32x4 v[4]; rms_row_to_bf16(F.out + (size_t)m * DM, F.in[I_NFFNW], (bf16*)(F.ws + WS_ACT1) + (size_t)m * DM, F.lane, v); }
}
__device__ __forceinline__ void hn_phase(Frame& F) {
    const int gw = F.bid * NWAVES + F.wave, NGW = F.G * NWAVES;
    for (int m = gw; m < T; m += NGW) { f32x4 v[4]; rms_row_to_bf16(F.out + (size_t)m * DM, F.in[I_NFFNW], (bf16*)(F.ws + WS_ACT1) + (size_t)m * DM, F.lane, v); }
}


__device__ __forceinline__ float gelu_erf(float x) { return 0.5f * x * (1.0f + erff(x * 0.70710678118654752f)); }
__device__ __forceinline__ unsigned f2ord(float f) { const unsigned u = __builtin_bit_cast(unsigned, f); return u ^ ((unsigned)((int)u >> 31) | 0x80000000u); }
__device__ __forceinline__ float ord2f(unsigned k) { const unsigned m = (unsigned)((int)k >> 31); return __builtin_bit_cast(float, k ^ (0x80000000u | ~m)); }
#define CMPX(a, b) do { const unsigned _mx = max((a), (b)), _mn = min((a), (b)); (a) = _mx; (b) = _mn; } while (0)
__device__ __forceinline__ void bitonic_sort16_desc(unsigned (&v)[16]) {
#pragma unroll
    for (int k = 2; k <= 16; k <<= 1)
#pragma unroll
        for (int j = k >> 1; j > 0; j >>= 1)
#pragma unroll
            for (int i = 0; i < 16; ++i) { const int l = i ^ j; if (l > i) { if ((i & k) == 0) CMPX(v[i], v[l]); else CMPX(v[l], v[i]); } }
}
__device__ __forceinline__ void bitonic_merge16_desc(unsigned (&v)[16]) {
#pragma unroll
    for (int j = 8; j > 0; j >>= 1)
#pragma unroll
        for (int i = 0; i < 16; ++i) { const int l = i ^ j; if (l > i) CMPX(v[i], v[l]); }
}
__device__ __forceinline__ void top16_merge(unsigned (&a)[16], const unsigned (&b)[16]) {
#pragma unroll
    for (int i = 0; i < 16; ++i) a[i] = max(a[i], b[15 - i]);
    bitonic_merge16_desc(a);
}
constexpr int PK_ST = 272;
__device__ __forceinline__ void peer_topk_tile(Frame& F, size_t tok0, const bf16* Q, int* IDX, float* GATE) {
    const bf16* SK = (const bf16*)(F.ws + WS_SUBK);
    LAS unsigned char* sK = F.lds;
    int tid = F.tid; asm volatile("" : "+v"(tid));
    const int lane = tid & 63, wave = F.wave, ql = lane & 31, hh = lane >> 5;
    const size_t tok = tok0 + wave * 32 + ql;
    const bf16* qrow = Q + tok * PEER_Q + 8 * hh;
    __syncthreads();
#pragma unroll
    for (int j = 0; j < 4; ++j) { const int cidx = tid + 512 * j, row = cidx >> 4, ch = cidx & 15; *(LAS u32x4*)(sK + row * PK_ST + ch * 16) = *(const u32x4*)(SK + (size_t)row * 128 + ch * 8); }
    __syncthreads();
    unsigned k1[16];
#pragma unroll 1
    for (int hc = 0; hc < 16; ++hc) {
        LAS unsigned char* cur = sK + (hc & 1) * (128 * PK_ST); LAS unsigned char* nxt = sK + ((hc + 1) & 1) * (128 * PK_ST);
        u32x4 stg[4];
        const int hcn = (hc + 1) & 15;
#pragma unroll
        for (int j = 0; j < 4; ++j) { const int cidx = tid + 512 * j, row = cidx >> 4, ch = cidx & 15; stg[j] = *(const u32x4*)(SK + ((size_t)hcn * 128 + row) * 128 + ch * 8); }
        bf16x8 qf[8];
#pragma unroll
        for (int ks = 0; ks < 8; ++ks) qf[ks] = *(const bf16x8*)(qrow + hc * 128 + 16 * ks);
        unsigned pk[4][16];
#pragma unroll
        for (int mt = 0; mt < 4; ++mt) {
            f32x16 acc;
#pragma unroll
            for (int e = 0; e < 16; ++e) acc[e] = 0.f;
#pragma unroll
            for (int ks = 0; ks < 8; ++ks) { const bf16x8 kf = *(const LAS bf16x8*)(cur + (32 * mt + ql) * PK_ST + 32 * ks + 16 * hh); acc = MFMA32(kf, qf[ks], acc); }
#pragma unroll
            for (int e = 0; e < 16; ++e) pk[mt][e] = (f2ord(acc[e]) & 0xFFFFFF80u) | (unsigned)(32 * mt + (e & 3) + 8 * (e >> 2) + 4 * hh);
        }
#pragma unroll
        for (int j = 0; j < 4; ++j) { const int cidx = tid + 512 * j, row = cidx >> 4, ch = cidx & 15; *(LAS u32x4*)(nxt + row * PK_ST + ch * 16) = stg[j]; }
        __syncthreads();
#pragma unroll
        for (int mt = 0; mt < 4; ++mt) bitonic_sort16_desc(pk[mt]);
        top16_merge(pk[0], pk[1]); top16_merge(pk[2], pk[3]); top16_merge(pk[0], pk[2]);
        unsigned other[16];
#pragma unroll
        for (int i = 0; i < 16; ++i) other[i] = (unsigned)__shfl_xor((int)pk[0][i], 32);
        top16_merge(pk[0], other);
        if ((hc & 1) == 0) {
#pragma unroll
            for (int i = 0; i < 16; ++i) k1[i] = pk[0][i];
        } else {
            float f1[16], f2[16];
#pragma unroll
            for (int i = 0; i < 16; ++i) { f1[i] = ord2f(k1[i] & 0xFFFFFF80u); f2[i] = ord2f(pk[0][i] & 0xFFFFFF80u); }
            unsigned cd[4][16];
#pragma unroll
            for (int i = 0; i < 64; ++i) cd[i >> 4][i & 15] = 0u;
            int n = 0;
#pragma unroll
            for (int a = 0; a < 16; ++a)
#pragma unroll
                for (int b = 0; b < 16; ++b)
                    if ((a + 1) * (b + 1) <= 16) { cd[n >> 4][n & 15] = (f2ord(f1[a] + f2[b]) & 0xFFFFC000u) | ((k1[a] & 127u) << 7) | (pk[0][b] & 127u); ++n; }
#pragma unroll
            for (int g4 = 0; g4 < 4; ++g4) bitonic_sort16_desc(cd[g4]);
            top16_merge(cd[0], cd[1]); top16_merge(cd[2], cd[3]); top16_merge(cd[0], cd[2]);
            const float vmax = ord2f(cd[0][0] & 0xFFFFC000u);
            float ex[16], den = 0.f;
#pragma unroll
            for (int i = 0; i < 16; ++i) { ex[i] = __expf(ord2f(cd[0][i] & 0xFFFFC000u) - vmax); den += ex[i]; }
            const float iden = 1.0f / den;
            const int h = hc >> 1;
            if (hh == 0) { int* ip = IDX + tok * 128 + h * 16;
#pragma unroll
                for (int i = 0; i < 4; ++i) { const u32x4 w = {cd[0][4 * i] & 0x3FFFu, cd[0][4 * i + 1] & 0x3FFFu, cd[0][4 * i + 2] & 0x3FFFu, cd[0][4 * i + 3] & 0x3FFFu}; *(u32x4*)(ip + 4 * i) = w; } }
            else { float* gp = GATE + tok * 128 + h * 16;
#pragma unroll
                for (int i = 0; i < 4; ++i) { const f32x4 w = {ex[4 * i] * iden, ex[4 * i + 1] * iden, ex[4 * i + 2] * iden, ex[4 * i + 3] * iden}; *(f32x4*)(gp + 4 * i) = w; } }
        }
    }
}

struct PeerDeal { size_t tokw; int ntok; size_t tok0; float* PART; const int* IDX; const float* GATE; float* COEF; };
__device__ __forceinline__ void peer_item(int n, const PeerDeal& D, int wave, int& slice, size_t& tok) { slice = n >> 5; tok = D.tokw + (n & 31); }
__device__ __forceinline__ void peer_down_rows(u32x4 (&R)[16], __amdgpu_buffer_rsrc_t tab, int slice, int id0, int id1, int lane) {
    const int soff = slice * (16384 * 128);
#pragma unroll
    for (int k = 0; k < 16; ++k) { const int id = __shfl(k < 8 ? id0 : id1, (8 * k + (lane >> 3)) & 63); R[k] = __builtin_amdgcn_raw_buffer_load_b128(tab, (id << 7) + 16 * (lane & 7), soff, 0); }
}
__device__ __forceinline__ void peer_down_park(const u32x4 (&R)[16], LAS unsigned char* sw, int lane) {
    const int e8 = lane >> 3, p = lane & 7;
#pragma unroll
    for (int k = 0; k < 16; ++k) { const int sl_ = 8 * k + e8; *(LAS u32x4*)(sw + sl_ * 128 + 16 * (p ^ ((sl_ >> 1) & 7))) = R[k]; }
}
__device__ __forceinline__ void peer_down_hn(u32x4 (&H)[4], const bf16* HN, int slice, size_t tok, int g) {
    const bf16* hp = HN + tok * DM + slice * 128 + 16 * g;
    H[0] = *(const u32x4*)hp; H[1] = *(const u32x4*)(hp + 8); H[2] = *(const u32x4*)(hp + 64); H[3] = *(const u32x4*)(hp + 72);
}
__device__ __forceinline__ void peer_down_bq(long (&bq)[4], const u32x4 (&H)[4]) {
#pragma unroll
    for (int h2 = 0; h2 < 2; ++h2) { const u32x4 x0 = H[2 * h2], x1 = H[2 * h2 + 1];
        unsigned p0 = __builtin_amdgcn_cvt_pk_fp8_f32(bflo(x0.x), bfhi(x0.x), 0, false); p0 = __builtin_amdgcn_cvt_pk_fp8_f32(bflo(x0.y), bfhi(x0.y), p0, true);
        unsigned p1 = __builtin_amdgcn_cvt_pk_fp8_f32(bflo(x0.z), bfhi(x0.z), 0, false); p1 = __builtin_amdgcn_cvt_pk_fp8_f32(bflo(x0.w), bfhi(x0.w), p1, true);
        unsigned p2 = __builtin_amdgcn_cvt_pk_fp8_f32(bflo(x1.x), bfhi(x1.x), 0, false); p2 = __builtin_amdgcn_cvt_pk_fp8_f32(bflo(x1.y), bfhi(x1.y), p2, true);
        unsigned p3 = __builtin_amdgcn_cvt_pk_fp8_f32(bflo(x1.z), bfhi(x1.z), 0, false); p3 = __builtin_amdgcn_cvt_pk_fp8_f32(bflo(x1.w), bfhi(x1.w), p3, true);
        bq[2 * h2] = (long)(((unsigned long long)p1 << 32) | p0); bq[2 * h2 + 1] = (long)(((unsigned long long)p3 << 32) | p2); }
}
__device__ __forceinline__ void peer_down_mfma(const LAS unsigned char* sw, const long (&bq)[4], __amdgpu_buffer_rsrc_t prsrc, int slice, int tokl, int lane) {
    const int g = lane >> 4, r = lane & 15;
    const unsigned off = ((lane & 15) == 0) ? (unsigned)(((tokl * 8 + slice) * 128 + 4 * g) * 4) : 0xFFFFFF00u;
#pragma unroll
    for (int t8 = 0; t8 < 8; ++t8) { f32x4 acc = {0.f, 0.f, 0.f, 0.f}; const int sl_ = 16 * t8 + r; const LAS unsigned char* rp = sw + sl_ * 128; const int sx = (sl_ >> 1) & 7;
#pragma unroll
        for (int h2 = 0; h2 < 2; ++h2) { const u32x4 v = *(const LAS u32x4*)(rp + 16 * ((4 * h2 + g) ^ sx));
            acc = __builtin_amdgcn_mfma_f32_16x16x32_fp8_fp8((long)(((unsigned long long)v.y << 32) | v.x), bq[2 * h2], acc, 0, 0, 0);
            acc = __builtin_amdgcn_mfma_f32_16x16x32_fp8_fp8((long)(((unsigned long long)v.w << 32) | v.z), bq[2 * h2 + 1], acc, 0, 0, 0); }
        __builtin_amdgcn_raw_buffer_store_b128(__builtin_bit_cast(u32x4, acc), prsrc, off, 64 * t8, 0); }
}
__device__ __forceinline__ void peer_down_phase(Frame& F, const PeerDeal& D) {
    const __amdgpu_buffer_rsrc_t PD = __builtin_amdgcn_make_buffer_rsrc((void*)(F.ws + WS_PD), 0, 16384 * 1024, 0x00020000); const bf16* HN = (const bf16*)(F.ws + WS_ACT1);
    const int* IDX = D.IDX;
    const __amdgpu_buffer_rsrc_t prsrc = __builtin_amdgcn_make_buffer_rsrc((void*)D.PART, 0, 256 * 8 * 128 * 4, 0x00020000);
    int lane = F.lane; asm volatile("" : "+v"(lane));
    const int g = lane >> 4, wave = F.wave;
    LAS unsigned char* sw = F.lds + wave * 16384;
    const int ntok = D.ntok;
    u32x4 RA[16], RB[16], HA[4], HB[4]; int ia0, ia1, ib0, ib1; long bq[4];
#define PEER_TOK(k, sv, tv) int sv; size_t tv; peer_item((k) < ntok ? (k) : ntok - 2 + ((k) & 1), D, wave, sv, tv)
    { PEER_TOK(0, s0, t0); PEER_TOK(1, s1, t1); PEER_TOK(2, s2, t2); PEER_TOK(3, s3, t3);
      const int a0 = IDX[t0 * 128 + lane], a1 = IDX[t0 * 128 + 64 + lane], b0 = IDX[t1 * 128 + lane], b1 = IDX[t1 * 128 + 64 + lane];
      ia0 = IDX[t2 * 128 + lane]; ia1 = IDX[t2 * 128 + 64 + lane]; ib0 = IDX[t3 * 128 + lane]; ib1 = IDX[t3 * 128 + 64 + lane];
      __builtin_amdgcn_sched_barrier(0);
      peer_down_rows(RA, PD, s0, a0, a1, lane); peer_down_hn(HA, HN, s0, t0, g);
      __builtin_amdgcn_sched_barrier(0);
      peer_down_rows(RB, PD, s1, b0, b1, lane); peer_down_hn(HB, HN, s1, t1, g);
      __builtin_amdgcn_sched_barrier(0); }
#pragma unroll 1
    for (int n = 0; n < ntok; n += 2) {
        PEER_TOK(n, s0, t0); PEER_TOK(n + 1, s1, t1); PEER_TOK(n + 2, s2, t2); PEER_TOK(n + 3, s3, t3); PEER_TOK(n + 4, s4, t4); PEER_TOK(n + 5, s5, t5);
        peer_down_park(RA, sw, lane); peer_down_bq(bq, HA);
        __builtin_amdgcn_sched_barrier(0);
        { const int j0 = IDX[t4 * 128 + lane], j1 = IDX[t4 * 128 + 64 + lane];
          peer_down_rows(RA, PD, s2, ia0, ia1, lane); peer_down_hn(HA, HN, s2, t2, g); ia0 = j0; ia1 = j1; }
        __builtin_amdgcn_sched_barrier(0);
        peer_down_mfma(sw, bq, prsrc, s0, (int)(t0 - D.tok0), lane);
        __builtin_amdgcn_sched_barrier(0);
        peer_down_park(RB, sw, lane); peer_down_bq(bq, HB);
        __builtin_amdgcn_sched_barrier(0);
        { const int j0 = IDX[t5 * 128 + lane], j1 = IDX[t5 * 128 + 64 + lane];
          peer_down_rows(RB, PD, s3, ib0, ib1, lane); peer_down_hn(HB, HN, s3, t3, g); ib0 = j0; ib1 = j1; }
        __builtin_amdgcn_sched_barrier(0);
        peer_down_mfma(sw, bq, prsrc, s1, (int)(t1 - D.tok0), lane);
        __builtin_amdgcn_sched_barrier(0);
    }
#undef PEER_TOK
}
__device__ __forceinline__ void peer_coef_wave(Frame& F, const PeerDeal& D) {
    for (int k = F.lane; k < 32 * 32; k += 64) {
        const int tl = (int)(D.tokw - D.tok0) + (k >> 5), slot = 4 * (k & 31);
        const float* pp = D.PART + (size_t)tl * 1024 + slot;
        f32x4 sm = *(const f32x4*)pp;
#pragma unroll
        for (int x = 1; x < 8; ++x) sm += *(const f32x4*)(pp + 128 * x);
        const size_t i = (D.tok0 + tl) * 128 + slot;
        const f32x4 gt = *(const f32x4*)(D.GATE + i);
        const f32x4 o = {gt.x * gelu_erf(sm.x * (1.0f / PD_SCALE)) * (1.0f / PU_SCALE), gt.y * gelu_erf(sm.y * (1.0f / PD_SCALE)) * (1.0f / PU_SCALE),
                         gt.z * gelu_erf(sm.z * (1.0f / PD_SCALE)) * (1.0f / PU_SCALE), gt.w * gelu_erf(sm.w * (1.0f / PD_SCALE)) * (1.0f / PU_SCALE)};
        *(f32x4*)(D.COEF + i) = o;
    }
}
__device__ __forceinline__ void peer_up_rows(u32x4 (&R)[16], __amdgpu_buffer_rsrc_t tab, int slice, int id0, int id1, int lane) {
    const int soff = slice * (16384 * 128);
#pragma unroll
    for (int s8 = 0; s8 < 8; ++s8) { const int id = __shfl(s8 < 4 ? id0 : id1, (16 * s8 + (lane >> 2)) & 63); const int vo = (id << 7) + 16 * (lane & 3);
        R[2 * s8] = __builtin_amdgcn_raw_buffer_load_b128(tab, vo, soff, 0); R[2 * s8 + 1] = __builtin_amdgcn_raw_buffer_load_b128(tab, vo, soff + 64, 0); }
}
__device__ __forceinline__ void peer_up_compute(const u32x4 (&R)[16], float c0, float c1, f32x2 h, float* out, int slice, size_t tok, int lane) {
    f32x2 acc[16];
#pragma unroll
    for (int k = 0; k < 16; ++k) acc[k] = (f32x2){0.f, 0.f};
#pragma unroll
    for (int s8 = 0; s8 < 8; ++s8) { const float c = __shfl(s8 < 4 ? c0 : c1, (16 * s8 + (lane >> 2)) & 63); f32x2 c2 = {c, c}; asm volatile("" : "+v"(c2));
#pragma unroll
        for (int hf = 0; hf < 2; ++hf) { const u32x4 r = R[2 * s8 + hf];
            acc[8 * hf + 0] = c2 * __builtin_amdgcn_cvt_pk_f32_fp8(r.x, false) + acc[8 * hf + 0]; acc[8 * hf + 1] = c2 * __builtin_amdgcn_cvt_pk_f32_fp8(r.x, true) + acc[8 * hf + 1];
            acc[8 * hf + 2] = c2 * __builtin_amdgcn_cvt_pk_f32_fp8(r.y, false) + acc[8 * hf + 2]; acc[8 * hf + 3] = c2 * __builtin_amdgcn_cvt_pk_f32_fp8(r.y, true) + acc[8 * hf + 3];
            acc[8 * hf + 4] = c2 * __builtin_amdgcn_cvt_pk_f32_fp8(r.z, false) + acc[8 * hf + 4]; acc[8 * hf + 5] = c2 * __builtin_amdgcn_cvt_pk_f32_fp8(r.z, true) + acc[8 * hf + 5];
            acc[8 * hf + 6] = c2 * __builtin_amdgcn_cvt_pk_f32_fp8(r.w, false) + acc[8 * hf + 6]; acc[8 * hf + 7] = c2 * __builtin_amdgcn_cvt_pk_f32_fp8(r.w, true) + acc[8 * hf + 7]; } }
    f32x2 r8[8], r4[4], r2[2], r1;
    { const bool up = (lane & 32) != 0;
#pragma unroll
      for (int k = 0; k < 8; ++k) { const f32x2 keep = up ? acc[k + 8] : acc[k], send = up ? acc[k] : acc[k + 8]; r8[k] = keep + (f32x2){__shfl_xor(send.x, 32), __shfl_xor(send.y, 32)}; } }
    { const bool up = (lane & 16) != 0;
#pragma unroll
      for (int k = 0; k < 4; ++k) { const f32x2 keep = up ? r8[k + 4] : r8[k], send = up ? r8[k] : r8[k + 4]; r4[k] = keep + (f32x2){__shfl_xor(send.x, 16), __shfl_xor(send.y, 16)}; } }
    { const bool up = (lane & 8) != 0;
#pragma unroll
      for (int k = 0; k < 2; ++k) { const f32x2 keep = up ? r4[k + 2] : r4[k], send = up ? r4[k] : r4[k + 2]; r2[k] = keep + (f32x2){__shfl_xor(send.x, 8), __shfl_xor(send.y, 8)}; } }
    { const bool up = (lane & 4) != 0; const f32x2 keep = up ? r2[1] : r2[0], send = up ? r2[0] : r2[1]; r1 = keep + (f32x2){__shfl_xor(send.x, 4), __shfl_xor(send.y, 4)}; }
    const int p = ((lane >> 5) & 1) * 8 + ((lane >> 4) & 1) * 4 + ((lane >> 3) & 1) * 2 + ((lane >> 2) & 1);
    *(f32x2*)(out + tok * DM + slice * 128 + 16 * (lane & 3) + 2 * (p & 7) + 64 * (p >> 3)) = h + r1;
}
__device__ __forceinline__ void peer_up_phase(Frame& F, const PeerDeal& D, float* outp) {
    const __amdgpu_buffer_rsrc_t PU = __builtin_amdgcn_make_buffer_rsrc((void*)(F.ws + WS_PU), 0, 16384 * 1024, 0x00020000);
    const int* IDX = D.IDX; const float* COEF = D.COEF;
    int lane = F.lane; asm volatile("" : "+v"(lane));
    const int wave = F.wave;
    const int ntok = D.ntok;
    const int p = ((lane >> 5) & 1) * 8 + ((lane >> 4) & 1) * 4 + ((lane >> 3) & 1) * 2 + ((lane >> 2) & 1);
    const int hoff = 16 * (lane & 3) + 2 * (p & 7) + 64 * (p >> 3);
    int sl; size_t tk;
    u32x4 R0[16], R1[16];
    float ca0, ca1, cb0, cb1; f32x2 ha, hb;
    int id0, id1, jd0, jd1;
    { int s1_; size_t t1_; peer_item(0, D, wave, sl, tk); peer_item(1, D, wave, s1_, t1_);
      jd0 = IDX[tk * 128 + lane]; jd1 = IDX[tk * 128 + 64 + lane]; id0 = IDX[t1_ * 128 + lane]; id1 = IDX[t1_ * 128 + 64 + lane];
      __builtin_amdgcn_sched_barrier(0);
      peer_up_rows(R0, PU, sl, jd0, jd1, lane);
      ca0 = COEF[tk * 128 + lane]; ca1 = COEF[tk * 128 + 64 + lane]; ha = *(const f32x2*)(F.out + tk * DM + sl * 128 + hoff);
      __builtin_amdgcn_sched_barrier(0); }
#pragma unroll 1
    for (int n = 0; n < ntok; n += 2) {
        int s0, s1, s2, s3; size_t t0, t1, t2, t3;
        peer_item(n, D, wave, s0, t0); peer_item(n + 1, D, wave, s1, t1);
        peer_item(n + 2 < ntok ? n + 2 : n, D, wave, s2, t2); peer_item(n + 3 < ntok ? n + 3 : n + 1, D, wave, s3, t3);
        jd0 = IDX[t2 * 128 + lane]; jd1 = IDX[t2 * 128 + 64 + lane];
        peer_up_rows(R1, PU, s1, id0, id1, lane);
        cb0 = COEF[t1 * 128 + lane]; cb1 = COEF[t1 * 128 + 64 + lane]; hb = *(const f32x2*)(F.out + t1 * DM + s1 * 128 + hoff);
        __builtin_amdgcn_sched_barrier(0);
        peer_up_compute(R0, ca0, ca1, ha, outp, s0, t0, lane);
        __builtin_amdgcn_sched_barrier(0);
        id0 = IDX[t3 * 128 + lane]; id1 = IDX[t3 * 128 + 64 + lane];
        peer_up_rows(R0, PU, s2, jd0, jd1, lane);
        ca0 = COEF[t2 * 128 + lane]; ca1 = COEF[t2 * 128 + 64 + lane]; ha = *(const f32x2*)(F.out + t2 * DM + s2 * 128 + hoff);
        __builtin_amdgcn_sched_barrier(0);
        peer_up_compute(R1, cb0, cb1, hb, outp, s1, t1, lane);
        __builtin_amdgcn_sched_barrier(0);
    }
}
__device__ __forceinline__ void peer_tile(Frame& F, int tile) {
    const size_t tok0 = (size_t)tile * 256;
    const bf16* Q = (const bf16*)(F.ws + WS_BIG);
    int* IDX = (int*)(F.ws + WS_BIG + 256 * MiB); float* GATE = (float*)(F.ws + WS_BIG + 288 * MiB); float* COEF = (float*)(F.ws + WS_BIG + 320 * MiB);
    peer_topk_tile(F, tok0, Q, IDX, GATE);
    VM_WAIT(); __syncthreads();
    PeerDeal D; D.tokw = tok0 + F.wave * 32; D.ntok = 256; D.tok0 = tok0; D.PART = (float*)(F.ws + WS_BIG + tok0 * (PEER_Q * 2)); D.IDX = IDX; D.GATE = GATE; D.COEF = COEF;
    peer_down_phase(F, D);
    VM_WAIT(); __syncthreads();
    peer_coef_wave(F, D);
    VM_WAIT(); __syncthreads();
    peer_up_phase(F, D, F.out);
}
__device__ __forceinline__ void peer_phase(Frame& F) { for (int tile = F.bid; tile < T / 256; tile += F.G) { peer_tile(F, tile); VM_WAIT(); __syncthreads(); } }

constexpr int N_PHASES = 15;
__global__ void __launch_bounds__(NTHR, 2) mega_fwd(Args args) {
    extern __shared__ __attribute__((aligned(16))) unsigned char lds_raw[];
    Frame F;
    F.lds = (LAS unsigned char*)lds_raw;
    F.tid = threadIdx.x; F.lane = F.tid & 63; F.wave = __builtin_amdgcn_readfirstlane(F.tid >> 6);
    F.G = gridDim.x; F.bid = blockIdx.x;
    F.in = args.in;
    F.positions = args.positions; F.out = args.out; F.ws = args.ws;
    unsigned char* ws = args.ws;
    volatile LAS unsigned* ctlw = (volatile LAS unsigned*)(F.lds + LDSCTL_OFF);
    if (F.tid < 64) ctlw[F.tid] = 0u;
    __syncthreads();
    const int lo = args.ph_lo, hi = args.ph_hi;
    XcdBarrier bar; bar.bar = (unsigned*)(ws + WS_CTL); bar.x = 0; bar.st = nullptr; bar.wave = F.wave;
    if (hi - lo > 1) bar = xcd_barrier_post((unsigned*)(ws + WS_CTL), ctlw + 8, F.wave);
#define IN(k) (lo <= (k) && (k) < hi)
#define SEAM(k) do { if (IN(k) && IN((k) + 1)) xcd_barrier(bar); } while (0)
    bf16* ACT1 = (bf16*)(ws + WS_ACT1); bf16* BIG = (bf16*)(ws + WS_BIG); bf16* WallT = (bf16*)(ws + WS_WALLT);

    if (IN(0)) { frame_refresh(F); p0_prologue(F); __syncthreads(); if (PROBE & 1) { p0_prologue(F); __syncthreads(); } }
    SEAM(0);
    if (IN(1)) { frame_refresh(F); { {
        { pg8::Gemm g{(const bf16*)(ws + WS_MEMN), (const bf16*)(ws + WS_WMKVT), NB * NMEM, 768, DM, DM, DM}; pg8::StaticOrder S; S.init(g.M, g.N, F.G, F.bid);
          pg8::EpiBf16<0> E{(bf16*)(ws + WS_MKV), 1536}; pg8::gemm_phase(F.lds, g, S, E, F.wave); }
        { pg8::Gemm g{(const bf16*)(ws + WS_WMKVT) + (size_t)768 * DM, (const bf16*)(ws + WS_MEMN), 768, NB * NMEM, DM, DM, DM}; pg8::StaticOrder S; S.init(g.M, g.N, F.G, F.G - 1 - F.bid);
          pg8::EpiBf16<0> E{(bf16*)(ws + WS_MVT), NB * NMEM}; pg8::gemm_phase(F.lds, g, S, E, F.wave); }
        { pg8::Gemm g{ACT1, WallT, HT, NPROJ, DM, DM, DM}; pg8::StaticOrder S; S.init(g.M, g.N, F.G, F.bid);
          pg8::EpiBf16<0> E{BIG, NPROJ}; pg8::gemm_phase(F.lds, g, S, E, F.wave); }
    } }
      if (PROBE & 2) { {
        { pg8::Gemm g{(const bf16*)(ws + WS_MEMN), (const bf16*)(ws + WS_WMKVT), NB * NMEM, 768, DM, DM, DM}; pg8::StaticOrder S; S.init(g.M, g.N, F.G, F.bid);
          pg8::EpiBf16<0> E{(bf16*)(ws + WS_MKV), 1536}; pg8::gemm_phase(F.lds, g, S, E, F.wave); }
        { pg8::Gemm g{(const bf16*)(ws + WS_WMKVT) + (size_t)768 * DM, (const bf16*)(ws + WS_MEMN), 768, NB * NMEM, DM, DM, DM}; pg8::StaticOrder S; S.init(g.M, g.N, F.G, F.G - 1 - F.bid);
          pg8::EpiBf16<0> E{(bf16*)(ws + WS_MVT), NB * NMEM}; pg8::gemm_phase(F.lds, g, S, E, F.wave); }
        { pg8::Gemm g{ACT1, WallT, HT, NPROJ, DM, DM, DM}; pg8::StaticOrder S; S.init(g.M, g.N, F.G, F.bid);
          pg8::EpiBf16<0> E{BIG, NPROJ}; pg8::gemm_phase(F.lds, g, S, E, F.wave); }
    } } }
    SEAM(1);
    if (IN(2)) { frame_refresh(F); qkprep_phase(F, 0); ssdC_phase(F, 0); if (PROBE & 4) ssdC_phase(F, 0); }
    SEAM(2);
    if (IN(3)) { frame_refresh(F); ssdD_phase(F); dilattn_mfma_phase(F, 0); memattn_mfma_phase(F, 0); if (PROBE & 64) { ssdD_phase(F); memattn_mfma_phase(F, 0); } }
    SEAM(3);
    if (IN(4)) { frame_refresh(F); ssdE_phase(F, 0); dilmerge_phase(F, 0); if (PROBE & 32) { ssdE_phase(F, 0); dilmerge_phase(F, 0); } }
    SEAM(4);
    if (IN(5)) { frame_refresh(F); { { pg8::Gemm g{ACT1 + (size_t)HT * DM, WallT, HT, NPROJ, DM, DM, DM}; pg8::StaticOrder S; S.init(g.M, g.N, F.G, F.bid);
        pg8::EpiBf16<0> E{BIG, NPROJ}; pg8::gemm_phase(F.lds, g, S, E, F.wave); } }
      if (PROBE & 2) { { pg8::Gemm g{ACT1 + (size_t)HT * DM, WallT, HT, NPROJ, DM, DM, DM}; pg8::StaticOrder S; S.init(g.M, g.N, F.G, F.bid);
        pg8::EpiBf16<0> E{BIG, NPROJ}; pg8::gemm_phase(F.lds, g, S, E, F.wave); } } }
    SEAM(5);
    if (IN(6)) { frame_refresh(F); qkprep_phase(F, 1); ssdC_phase(F, 1); if (PROBE & 4) ssdC_phase(F, 1); }
    SEAM(6);
    if (IN(7)) { frame_refresh(F); ssdD_phase(F); dilattn_mfma_phase(F, 1); memattn_mfma_phase(F, 1); if (PROBE & 64) { ssdD_phase(F); memattn_mfma_phase(F, 1); } }
    SEAM(7);
    if (IN(8)) { frame_refresh(F); ssdE_phase(F, 1); dilmerge_phase(F, 1); if (PROBE & 32) { ssdE_phase(F, 1); dilmerge_phase(F, 1); } }
    SEAM(8);
    if (IN(9)) { frame_refresh(F); { { pg8::Gemm g{ACT1, WallT + (size_t)NPROJ * DM, T, NGATE, DM, DM, DM}; pg8::StaticOrder S; S.init(g.M, g.N, F.G, F.bid);
        pg8::EpiBf16<1> E{BIG, NGATE}; pg8::gemm_phase(F.lds, g, S, E, F.wave); } }
      if (PROBE & 2) { { pg8::Gemm g{ACT1, WallT + (size_t)NPROJ * DM, T, NGATE, DM, DM, DM}; pg8::StaticOrder S; S.init(g.M, g.N, F.G, F.bid);
        pg8::EpiBf16<1> E{BIG, NGATE}; pg8::gemm_phase(F.lds, g, S, E, F.wave); } } }
    SEAM(9);
    if (IN(10)) { frame_refresh(F);
        pg8::Gemm g{(const bf16*)F.out, (const bf16*)(ws + WS_WCATT), T, DM, YC, YC, YC}; pg8::StaticOrder S; S.init(g.M, g.N, F.G, F.bid);
        pg8::EpiBranchFused E{ACT1, DM, __builtin_amdgcn_make_buffer_rsrc((void*)BIG, 0, T * NGATE * 2, 0x00020000), NGATE}; pg8::gemm_phase(F.lds, g, S, E, F.wave);
    }
    SEAM(10);
    if (IN(11)) { frame_refresh(F); { { pg8::Gemm g{ACT1, (const bf16*)(ws + WS_WOUTT), T, DM, DM, DM, DM}; pg8::StaticOrder S; S.init(g.M, g.N, F.G, F.bid);
        pg8::EpiResid E{F.out, DM, F.in[I_X]}; pg8::gemm_phase(F.lds, g, S, E, F.wave); } }
      if (PROBE & 2) { { pg8::Gemm g{ACT1, (const bf16*)(ws + WS_WOUTT), T, DM, DM, DM, DM}; pg8::StaticOrder S; S.init(g.M, g.N, F.G, F.bid);
        pg8::EpiResid E{F.out, DM, F.in[I_X]}; pg8::gemm_phase(F.lds, g, S, E, F.wave); } } }
    SEAM(11);
    if (IN(12)) { frame_refresh(F); { hn_phase(F); }
      if (PROBE & 2) { hn_phase(F); } }
    SEAM(12);
    if (IN(13)) { frame_refresh(F); { { pg8::Gemm g{ACT1, (const bf16*)(ws + WS_WQT), T, PEER_Q, DM, DM, DM}; pg8::StaticOrder S; S.init(g.M, g.N, F.G, F.bid);
        pg8::EpiBf16<0> E{BIG, PEER_Q}; pg8::gemm_phase(F.lds, g, S, E, F.wave); } }
      if (PROBE & 2) { { pg8::Gemm g{ACT1, (const bf16*)(ws + WS_WQT), T, PEER_Q, DM, DM, DM}; pg8::StaticOrder S; S.init(g.M, g.N, F.G, F.bid);
        pg8::EpiBf16<0> E{BIG, PEER_Q}; pg8::gemm_phase(F.lds, g, S, E, F.wave); } } }
    SEAM(13);
    if (IN(14)) { frame_refresh(F); peer_phase(F); }
#undef IN
#undef SEAM
}

extern "C" void kernel_launch(void* const* d_in, const int* in_sizes, int n_in, void* d_out, int out_size, void* d_ws, size_t ws_size, hipStream_t stream) {
    static int grid = 0;
    if (grid == 0) {
        if (n_in != 26 || out_size != T * DM || ws_size < WS_END) { fprintf(stderr, "kernel_launch: unexpected shapes (n_in %d, out %d, ws %zu)\n", n_in, out_size, ws_size); grid = -1; return; }
        int dev = 0, cus = 0;
        if (hipGetDevice(&dev) != hipSuccess || hipDeviceGetAttribute(&cus, hipDeviceAttributeMultiprocessorCount, dev) != hipSuccess) { grid = -1; return; }
        if (hipFuncSetAttribute((const void*)mega_fwd, hipFuncAttributeMaxDynamicSharedMemorySize, LDS_BYTES) != hipSuccess) { grid = -1; return; }
        int per_cu = 0;
        (void)hipOccupancyMaxActiveBlocksPerMultiprocessor(&per_cu, (const void*)mega_fwd, NTHR, LDS_BYTES);
        (void)hipGetLastError();
        grid = cus;
    }
    if (grid < 0) return;
    (void)hipMemsetAsync((char*)d_ws + WS_CTL, 0, CTL_ZERO_BYTES, stream);
    Args a{};
    for (int i = 0; i < 26; ++i) a.in[i] = (const float*)d_in[i];
    a.positions = (const int*)d_in[2]; a.out = (float*)d_out; a.ws = (unsigned char*)d_ws;
#if MK_N_LAUNCHES == 1
    a.ph_lo = 0; a.ph_hi = N_PHASES;
    hipLaunchKernelGGL(mega_fwd, dim3(grid), dim3(NTHR), LDS_BYTES, stream, a);
#else
    for (int p = 0; p < N_PHASES; ++p) { a.ph_lo = p; a.ph_hi = p + 1; hipLaunchKernelGGL(mega_fwd, dim3(grid), dim3(NTHR), LDS_BYTES, stream, a); }
#endif
}
```

```cpp
#include <hip/hip_runtime.h>
#include <cstdio>
#include <cstdint>

#ifndef MK_N_LAUNCHES
#define MK_N_LAUNCHES 1
#endif

#define LAS __attribute__((address_space(3)))
#define GAS __attribute__((address_space(1)))
typedef unsigned short bf16;
typedef short bf16x8 __attribute__((ext_vector_type(8)));
typedef float f32x4 __attribute__((ext_vector_type(4)));
typedef float f32x2 __attribute__((ext_vector_type(2)));
typedef unsigned u32x4 __attribute__((ext_vector_type(4)));
typedef unsigned u32x2 __attribute__((ext_vector_type(2)));

constexpr int NB = 8, SEQ = 8192, DM = 1024, T = NB * SEQ;
constexpr int HB = 4, HT = HB * SEQ;
constexpr int NMEM = 256;
constexpr int NPROJ = 6144;
constexpr int PC_Z = 0, PC_X = 1024, PC_B = 2048, PC_C = 2560, PC_DQ = 3072, PC_DK = 3840, PC_DV = 4608, PC_MQ = 5376;
constexpr int W_IN_N = 9232, OFF_DT = 3072, OFF_AFTER_DT = 3088;
constexpr int NGATE = 3072;
constexpr int YC = 2048;
constexpr int PEER_H = 8, PEER_K = 16, PEER_NK = 128, PEER_Q = 2048;
constexpr float EPS = 1e-6f;

constexpr size_t MiB = 1u << 20;
constexpr size_t WS_CTL = 0, CTL_ZERO_BYTES = 65536;
constexpr size_t WS_WALLT = 1 * MiB;
constexpr size_t WS_WMKVT = 19 * MiB;
constexpr size_t WS_WCATT = 22 * MiB;
constexpr size_t WS_WOUTT = 26 * MiB;
constexpr size_t WS_WQT = 28 * MiB;
constexpr size_t WS_SUBK = 32 * MiB;
constexpr size_t WS_PD = 33 * MiB;
constexpr size_t WS_PU = 65 * MiB;
constexpr size_t WS_DT = 97 * MiB;
constexpr size_t WS_MEMN = 101 * MiB;
constexpr size_t WS_MKV = 105 * MiB;
constexpr size_t WS_ACT1 = 112 * MiB;
constexpr size_t WS_BIG = 240 * MiB;
constexpr size_t WS_LSE = 624 * MiB;
constexpr size_t WS_MVT = 628 * MiB;
constexpr size_t WS_DEC = 631 * MiB;
constexpr size_t WS_SST = 632 * MiB;
constexpr size_t WS_SIN = 760 * MiB;
constexpr size_t WS_END = 824 * MiB;

constexpr int RING_BYTES = 131072;
constexpr int LDSCTL_OFF = 143360;
constexpr int LDS_BYTES = 147456;
constexpr int NWAVES = 8, NTHR = 512;

__device__ __forceinline__ int lane_id() { return (int)__builtin_amdgcn_mbcnt_hi(~0u, __builtin_amdgcn_mbcnt_lo(~0u, 0u)); }
__device__ __forceinline__ float bf2f(unsigned short b) { return __builtin_bit_cast(float, (unsigned)b << 16); }
__device__ __forceinline__ float bflo(unsigned w) { return __builtin_bit_cast(float, w << 16); }
__device__ __forceinline__ float bfhi(unsigned w) { return __builtin_bit_cast(float, w & 0xffff0000u); }
__device__ __forceinline__ unsigned f2bf(float f) { unsigned u = __builtin_bit_cast(unsigned, f); return (u + 0x7fffu + ((u >> 16) & 1u)) >> 16; }
__device__ __forceinline__ unsigned pk2(float lo, float hi) { return f2bf(lo) | (f2bf(hi) << 16); }
typedef float f32x16 __attribute__((ext_vector_type(16)));
typedef short s16x4 __attribute__((ext_vector_type(4)));
typedef __bf16 bf2_t __attribute__((ext_vector_type(2)));
__device__ __forceinline__ unsigned pkbf(float a, float b) { const f32x2 v = {a, b}; return __builtin_bit_cast(unsigned, __builtin_convertvector(v, bf2_t)); }
#define MFMA32(a, b, c) __builtin_amdgcn_mfma_f32_32x32x16_bf16((a), (b), (c), 0, 0, 0)
__device__ __forceinline__ float wave_sum(float v) {
#pragma unroll
    for (int o = 1; o < 64; o <<= 1) v += __shfl_xor(v, o);
    return v;
}
__device__ __forceinline__ float wave_max(float v) {
#pragma unroll
    for (int o = 1; o < 64; o <<= 1) v = fmaxf(v, __shfl_xor(v, o));
    return v;
}
__device__ __forceinline__ float sigmoidf_(float x) { return 1.0f / (1.0f + __expf(-x)); }
#define LDS_WAIT() asm volatile("s_waitcnt lgkmcnt(0)" ::: "memory")
#define VM_WAIT() asm volatile("s_waitcnt vmcnt(0)" ::: "memory")

#define XB_TMO      128
#define XB_XCNT(j)  (256  + 64 * (j))
#define XB_XSUB(j)  (1280 + 64 * (j))
#define XB_XGEN(j)  (2304 + 64 * (j))
#define XB_TOP      3328
#define XB_TOPGEN   3392
#define XCD_BAR_WORDS 3456
#define XB_SPIN_CAP (1u << 18)
__device__ __forceinline__ unsigned xb_ld(unsigned* p)              { return __hip_atomic_load(p, __ATOMIC_RELAXED, __HIP_MEMORY_SCOPE_AGENT); }
__device__ __forceinline__ unsigned xb_add(unsigned* p, unsigned v) { return __hip_atomic_fetch_add(p, v, __ATOMIC_RELAXED, __HIP_MEMORY_SCOPE_AGENT); }
__device__ __forceinline__ unsigned xb_xcc_id() { return (unsigned)__builtin_amdgcn_s_getreg((3 << 11) | 20) & 0xFu; }
#define XB_SPIN(cond, bar) do { unsigned _sp = 0; while (cond) { __builtin_amdgcn_s_sleep(1); \
    if ((++_sp & 255u) == 0u) { if (xb_ld(&(bar)[XB_TMO])) break; if (_sp > XB_SPIN_CAP) { atomicAdd(&(bar)[XB_TMO], 1u); break; } } } } while (0)
struct XcdBarrier { unsigned* bar; unsigned x; volatile LAS unsigned* st; int wave; };
__device__ __forceinline__ XcdBarrier xcd_barrier_post(unsigned* bar, volatile LAS unsigned* st, int wave) {
    XcdBarrier b; b.bar = bar; b.x = xb_xcc_id(); b.st = st; b.wave = wave;
    if (wave == 0 && lane_id() == 0) (void)xb_add(&bar[XB_XCNT(b.x)], 1u);
    return b;
}
__device__ __forceinline__ void xcd_barrier_complete(unsigned* bar, unsigned x, unsigned& nloc, unsigned& nx) {
    const unsigned G = gridDim.x * gridDim.y * gridDim.z;
    unsigned sum, cnt, mine, sp = 0u;
    for (;;) {
        sum = 0u; cnt = 0u; mine = 0u;
#pragma unroll
        for (unsigned j = 0; j < 16; ++j) { const unsigned c = xb_ld(&bar[XB_XCNT(j)]); sum += c; cnt += (c > 0u) ? 1u : 0u; mine = (j == x) ? c : mine; }
        if (sum == G) break;
        __builtin_amdgcn_s_sleep(1);
        if ((++sp & 255u) == 0u) { if (xb_ld(&bar[XB_TMO])) break; if (sp > XB_SPIN_CAP) { atomicAdd(&bar[XB_TMO], 1u); break; } }
    }
    nloc = mine > 0u ? mine : 1u; nx = cnt > 0u ? cnt : 1u;
}
__device__ __forceinline__ void xcd_barrier(const XcdBarrier& b) {
    asm volatile("s_waitcnt vmcnt(0)" ::: "memory");
    __syncthreads();
    if (b.wave == 0 && lane_id() == 0) {
        unsigned* bar = b.bar;
        __builtin_amdgcn_s_waitcnt(0);
        unsigned nloc = b.st[0], nx = b.st[1];
        if (nloc == 0u) { xcd_barrier_complete(bar, b.x, nloc, nx); b.st[0] = nloc; b.st[1] = nx; }
        const unsigned old = xb_add(&bar[XB_XSUB(b.x)], 1u);
        const unsigned gen = old / nloc;
        if (old + 1u == (gen + 1u) * nloc) {
            __builtin_amdgcn_fence(__ATOMIC_RELEASE, "agent");
            asm volatile("s_waitcnt vmcnt(0)" ::: "memory");
            const unsigned og = xb_add(&bar[XB_TOP], 1u);
            const unsigned tg = og / nx;
            if (og + 1u == (tg + 1u) * nx) xb_add(&bar[XB_TOPGEN], 1u);
            else XB_SPIN(xb_ld(&bar[XB_TOPGEN]) == tg, bar);
            __builtin_amdgcn_fence(__ATOMIC_ACQUIRE, "agent");
            xb_add(&bar[XB_XGEN(b.x)], 1u);
            asm volatile("s_waitcnt vmcnt(0)" ::: "memory");
        } else {
            XB_SPIN(xb_ld(&bar[XB_XGEN(b.x)]) == gen, bar);
            __builtin_amdgcn_fence(__ATOMIC_ACQUIRE, "agent");
            asm volatile("s_waitcnt vmcnt(0)" ::: "memory");
        }
    }
    __syncthreads();
}

namespace pg8 {
constexpr int BM = 256, BK = 64, HALF = 128, HTB = HALF * BK * 2, STAGE_BYTES = 8 * HTB, NXCD = 8, WGM = 8;
__host__ __device__ __forceinline__ int lds_byte(int r, int c) { const int st = (r >> 4) * 2 + (c >> 5), rr = r & 15, cc = c & 31, ob = rr * 64 + cc * 2; return st * 1024 + (ob ^ (((ob >> 9) & 1) << 5)); }
__host__ __device__ __forceinline__ void stage_rc(int b, int& R, int& C) { const int st = b / 1024, sb = b % 1024, swz = sb ^ (((sb >> 9) & 1) << 5); R = (st >> 1) * 16 + swz / 64; C = (st & 1) * 32 + (swz % 64) / 2; }
__host__ __device__ __forceinline__ int perm32(int rho) { const int n = rho >> 4, i = rho & 15; return 8 * (i >> 2) + 4 * n + (i & 3); }
struct Unit { int pm, pn; };
struct Gemm { const bf16* A; const bf16* Bt; int M, N, K, lda, ldb; };
struct StaticOrder {
    int nM, nN, nwg, G, c;
    __host__ __device__ void init(int M, int N, int G_, int c_) { nM = M / BM; nN = N / BM; nwg = nM * nN; G = G_; c = c_; }
    __host__ __device__ bool next(int i, Unit& u) const {
        const long L = (long)i * G + c; if (L >= nwg) return false;
        int wgid = (int)L; { const int q = nwg / NXCD, r = nwg % NXCD, xcd = wgid % NXCD, off = wgid / NXCD; wgid = (xcd < r ? xcd * (q + 1) : r * (q + 1) + (xcd - r) * q) + off; }
        const int nig = WGM * nN, gid = wgid / nig, fm = gid * WGM, gsz = (nM - fm) < WGM ? (nM - fm) : WGM;
        u.pm = fm + ((wgid % nig) % gsz); u.pn = (wgid % nig) / gsz; return true;
    }
    __device__ __forceinline__ void a_ready(const Unit&) const {}
    __device__ __forceinline__ void done(const Unit&) const {}
};
struct PanelOrder {
    int pm, nN, rot;
    __device__ __forceinline__ bool next(int i, Unit& u) const { if (i >= nN) return false; u.pm = pm; u.pn = (i + rot) % nN; return true; }
    __device__ __forceinline__ void a_ready(const Unit&) const {}
    __device__ __forceinline__ void done(const Unit&) const {}
};
__device__ __forceinline__ unsigned cvt_pk_bf16(float lo, float hi) { unsigned r; asm volatile("v_cvt_pk_bf16_f32 %0, %1, %2" : "=v"(r) : "v"(lo), "v"(hi)); return r; }

template <int ACT> struct EpiBf16 {
    static constexpr bool PERM = true, AFTER_DRAIN = false, HAS_MID = false;
    bf16* O; int ldc;
    __device__ __forceinline__ void operator()(const f32x4 (&acc)[2][2][4][2], const Unit& u, int wr, int wc, int fr, int fq) const {
        const int row0 = u.pm * BM + wr * 64 + fr; const int col0 = u.pn * BM + wc * 32 + 8 * fq;
#pragma unroll
        for (int ai = 0; ai < 2; ++ai)
#pragma unroll
            for (int m = 0; m < 4; ++m) { bf16* rowp = O + (size_t)(row0 + ai * HALF + m * 16) * ldc + col0;
#pragma unroll
                for (int bj = 0; bj < 2; ++bj) { f32x4 v0 = acc[ai][bj][m][0], v1 = acc[ai][bj][m][1];
                    if (ACT == 1) {
#pragma unroll
                        for (int j = 0; j < 4; ++j) { v0[j] = sigmoidf_(v0[j]); v1[j] = sigmoidf_(v1[j]); } }
                    u32x4 w; w.x = cvt_pk_bf16(v0[0], v0[1]); w.y = cvt_pk_bf16(v0[2], v0[3]); w.z = cvt_pk_bf16(v1[0], v1[1]); w.w = cvt_pk_bf16(v1[2], v1[3]);
                    *(u32x4*)(rowp + bj * HALF) = w; } }
    }
};
template <bool ACCUM> struct EpiBranch {
    static constexpr bool PERM = true, AFTER_DRAIN = false, HAS_MID = false;
    bf16* O; int ldc; const bf16* Gt; int ldg; int gcol0;
    __device__ __forceinline__ void operator()(const f32x4 (&acc)[2][2][4][2], const Unit& u, int wr, int wc, int fr, int fq) const {
        const int row0 = u.pm * BM + wr * 64 + fr; const int col0 = u.pn * BM + wc * 32 + 8 * fq;
#pragma unroll
        for (int ai = 0; ai < 2; ++ai)
#pragma unroll
            for (int m = 0; m < 4; ++m) { const size_t r = (size_t)(row0 + ai * HALF + m * 16); bf16* rowp = O + r * ldc + col0; const bf16* gp = Gt + r * ldg + gcol0 + col0;
#pragma unroll
                for (int bj = 0; bj < 2; ++bj) { const f32x4 v0 = acc[ai][bj][m][0], v1 = acc[ai][bj][m][1];
                    const u32x4 g = *(const u32x4*)(gp + bj * HALF);
                    float o[8];
                    o[0] = v0[0] * bflo(g.x); o[1] = v0[1] * bfhi(g.x); o[2] = v0[2] * bflo(g.y); o[3] = v0[3] * bfhi(g.y);
                    o[4] = v1[0] * bflo(g.z); o[5] = v1[1] * bfhi(g.z); o[6] = v1[2] * bflo(g.w); o[7] = v1[3] * bfhi(g.w);
                    if (ACCUM) { const u32x4 p = *(const u32x4*)(rowp + bj * HALF);
                        o[0] += bflo(p.x); o[1] += bfhi(p.x); o[2] += bflo(p.y); o[3] += bfhi(p.y); o[4] += bflo(p.z); o[5] += bfhi(p.z); o[6] += bflo(p.w); o[7] += bfhi(p.w); }
                    u32x4 w; w.x = cvt_pk_bf16(o[0], o[1]); w.y = cvt_pk_bf16(o[2], o[3]); w.z = cvt_pk_bf16(o[4], o[5]); w.w = cvt_pk_bf16(o[6], o[7]);
                    *(u32x4*)(rowp + bj * HALF) = w; } }
    }
};
struct EpiResid {
    static constexpr bool PERM = false, AFTER_DRAIN = false, HAS_MID = false;
    float* C; int ldc; const float* R;
    __device__ __forceinline__ void operator()(const f32x4 (&acc)[2][2][4][2], const Unit& u, int wr, int wc, int fr, int fq) const {
        const int row0 = u.pm * BM + wr * 64 + fr, col0 = u.pn * BM + wc * 32 + 4 * fq;
#pragma unroll
        for (int ai = 0; ai < 2; ++ai)
#pragma unroll
            for (int m = 0; m < 4; ++m) { const size_t off = (size_t)(row0 + ai * HALF + m * 16) * ldc + col0;
#pragma unroll
                for (int bj = 0; bj < 2; ++bj)
#pragma unroll
                    for (int n = 0; n < 2; ++n) { const f32x4 r = *(const f32x4*)(R + off + bj * HALF + n * 16); *(f32x4*)(C + off + bj * HALF + n * 16) = acc[ai][bj][m][n] + r; } }
    }
};

struct EpiBranchFused {
    static constexpr bool PERM = true, AFTER_DRAIN = false, HAS_MID = true;
    bf16* O; int ldc; __amdgpu_buffer_rsrc_t grs; int ldg;
    __device__ __forceinline__ void mid(f32x4 (&acc)[2][2][4][2], const Unit& u, int t, int wr, int wc, int fr, int fq) const {
        const unsigned voff = (unsigned)(((u.pm * BM + wr * 64 + fr) * ldg + u.pn * BM + wc * 32 + 8 * fq) * 2);
        const int ca = (t == 16) ? 0 : 2048;
#pragma unroll
        for (int ai = 0; ai < 2; ++ai)
#pragma unroll
            for (int m = 0; m < 4; ++m) {
#pragma unroll
                for (int bj = 0; bj < 2; ++bj) { const int so = ((ai * HALF + m * 16) * ldg + bj * HALF) * 2 + ca;
                    const u32x4 ga = __builtin_amdgcn_raw_buffer_load_b128(grs, voff, so, 0), gb = __builtin_amdgcn_raw_buffer_load_b128(grs, voff, so + 2048, 0);
                    f32x4& v0 = acc[ai][bj][m][0]; f32x4& v1 = acc[ai][bj][m][1];
                    v0[0] *= bflo(ga.x) * __builtin_amdgcn_rcpf(fmaxf(bflo(gb.x), 1e-30f)); v0[1] *= bfhi(ga.x) * __builtin_amdgcn_rcpf(fmaxf(bfhi(gb.x), 1e-30f));
                    v0[2] *= bflo(ga.y) * __builtin_amdgcn_rcpf(fmaxf(bflo(gb.y), 1e-30f)); v0[3] *= bfhi(ga.y) * __builtin_amdgcn_rcpf(fmaxf(bfhi(gb.y), 1e-30f));
                    v1[0] *= bflo(ga.z) * __builtin_amdgcn_rcpf(fmaxf(bflo(gb.z), 1e-30f)); v1[1] *= bfhi(ga.z) * __builtin_amdgcn_rcpf(fmaxf(bfhi(gb.z), 1e-30f));
                    v1[2] *= bflo(ga.w) * __builtin_amdgcn_rcpf(fmaxf(bflo(gb.w), 1e-30f)); v1[3] *= bfhi(ga.w) * __builtin_amdgcn_rcpf(fmaxf(bfhi(gb.w), 1e-30f)); }
                __builtin_amdgcn_sched_barrier(0); }
    }
    __device__ __forceinline__ void operator()(const f32x4 (&acc)[2][2][4][2], const Unit& u, int wr, int wc, int fr, int fq) const {
        const int row0 = u.pm * BM + wr * 64 + fr; const int col0 = u.pn * BM + wc * 32 + 8 * fq;
        const unsigned voff = (unsigned)((row0 * ldg + col0) * 2);
#pragma unroll
        for (int ai = 0; ai < 2; ++ai)
#pragma unroll
            for (int m = 0; m < 4; ++m) { const size_t r = (size_t)(row0 + ai * HALF + m * 16); bf16* rowp = O + r * ldc + col0;
#pragma unroll
                for (int bj = 0; bj < 2; ++bj) { const f32x4 v0 = acc[ai][bj][m][0], v1 = acc[ai][bj][m][1];
                    const u32x4 g = __builtin_amdgcn_raw_buffer_load_b128(grs, voff, ((ai * HALF + m * 16) * ldg + bj * HALF) * 2 + 4096, 0);
                    u32x4 w; w.x = cvt_pk_bf16(v0[0] * bflo(g.x), v0[1] * bfhi(g.x)); w.y = cvt_pk_bf16(v0[2] * bflo(g.y), v0[3] * bfhi(g.y));
                    w.z = cvt_pk_bf16(v1[0] * bflo(g.z), v1[1] * bfhi(g.z)); w.w = cvt_pk_bf16(v1[2] * bflo(g.w), v1[3] * bfhi(g.w));
                    *(u32x4*)(rowp + bj * HALF) = w; } }
    }
};

template <class Epi, class Sched>
__device__ __forceinline__ void gemm_phase(LAS unsigned char* lds, const Gemm g, const Sched& S, const Epi& E, int wid) {
    int lane = lane_id(); asm volatile("" : "+v"(lane));
    const int tid = wid * 64 + lane, wr = wid >> 2, wc = wid & 3, fr = lane & 15, fq = lane >> 4;
    const int K = g.K, nt = K / BK;
    unsigned voffA[2], voffB[2];
#pragma unroll
    for (int i = 0; i < 2; ++i) { int R, C; stage_rc(tid * 16 + i * 8192, R, C); const int Rb = Epi::PERM ? ((R & ~31) + perm32(R & 31)) : R;
        voffA[i] = (unsigned)(R * g.lda + C) * 2u; voffB[i] = (unsigned)(Rb * g.ldb + C) * 2u; }
    const size_t kstep = (size_t)(BK * 2);
    const size_t hsA = (size_t)HALF * g.lda * 2, hsB = (size_t)HALF * g.ldb * 2;
    const size_t tsA = 2 * hsA, tsB = 2 * hsB;
    const unsigned ldsw = (unsigned)wid * 1024u;
    const int aoff = lds_byte(wr * 64 + fr, fq * 8), boff = lds_byte(wc * 32 + fr, fq * 8);
#define PG8_SA(b, h) (((b) * 2 + (h)) * HTB)
#define PG8_SB(b, h) ((4 + (b) * 2 + (h)) * HTB)
#define PG8_STAGE(bufoff, gbase, voff) do { _Pragma("unroll") for (int _i = 0; _i < 2; ++_i) \
        __builtin_amdgcn_global_load_lds((const unsigned*)((const char*)(gbase) + (voff)[_i]), (LAS unsigned*)(lds + (bufoff) + ldsw + _i * 8192), 16, 0, 0); } while (0)
#define PG8_LDA(dst, b, h) do { _Pragma("unroll") for (int m = 0; m < 4; ++m) _Pragma("unroll") for (int k = 0; k < 2; ++k) dst[m][k] = *(const LAS bf16x8*)(lds + PG8_SA(b, h) + aoff + m * 2048 + k * 1024); } while (0)
#define PG8_LDB(dst, b, h) do { _Pragma("unroll") for (int n = 0; n < 2; ++n) _Pragma("unroll") for (int k = 0; k < 2; ++k) dst[n][k] = *(const LAS bf16x8*)(lds + PG8_SB(b, h) + boff + n * 2048 + k * 1024); } while (0)
#define PG8_MMA(ai, bj, At, Bt) do { __builtin_amdgcn_s_setprio(1); _Pragma("unroll") for (int m = 0; m < 4; ++m) _Pragma("unroll") for (int n = 0; n < 2; ++n) _Pragma("unroll") for (int k = 0; k < 2; ++k) \
        acc[ai][bj][m][n] = __builtin_amdgcn_mfma_f32_16x16x32_bf16(Bt[n][k], At[m][k], acc[ai][bj][m][n], 0, 0, 0); __builtin_amdgcn_s_setprio(0); } while (0)
#define PG8_WAIT_V(n) asm volatile("s_waitcnt vmcnt(" #n ")" ::: "memory")
#define PG8_WAIT_L(n) asm volatile("s_waitcnt lgkmcnt(" #n ")" ::: "memory")
#define PG8_BAR __builtin_amdgcn_s_barrier()
#define PG8_SCHED __builtin_amdgcn_sched_barrier(0)
    Unit cur, nxt; int ui = 0;
    if (!S.next(0, cur)) return;
    f32x4 acc[2][2][4][2];
#pragma unroll
    for (int a = 0; a < 2; ++a)
#pragma unroll
        for (int b = 0; b < 2; ++b)
#pragma unroll
            for (int m = 0; m < 4; ++m)
#pragma unroll
                for (int n = 0; n < 2; ++n) acc[a][b][m][n] = (f32x4){0.f, 0.f, 0.f, 0.f};
    bf16x8 At[4][2], B0[2][2], B1[2][2];
    const char* cA = (const char*)g.A + (size_t)cur.pm * tsA; const char* cB = (const char*)g.Bt + (size_t)cur.pn * tsB;
    S.a_ready(cur);
    PG8_STAGE(PG8_SB(0, 0), cB, voffB); PG8_STAGE(PG8_SA(0, 0), cA, voffA); PG8_STAGE(PG8_SB(0, 1), cB + hsB, voffB); PG8_STAGE(PG8_SA(0, 1), cA + hsA, voffA);
    if (wr == 1) PG8_BAR;
    PG8_WAIT_V(4); PG8_BAR;
    PG8_STAGE(PG8_SB(1, 0), cB + kstep, voffB); PG8_STAGE(PG8_SA(1, 0), cA + kstep, voffA); PG8_STAGE(PG8_SB(1, 1), cB + hsB + kstep, voffB);
    PG8_WAIT_V(6); PG8_BAR;
    for (;;) {
        const bool has_next = S.next(ui + 1, nxt);
        const char* nA = has_next ? (const char*)g.A + (size_t)nxt.pm * tsA : cA; const char* nB = has_next ? (const char*)g.Bt + (size_t)nxt.pn * tsB : cB;
        for (int t = 0; t < nt; t += 2) {
            const bool last = (t == nt - 2);
            const char* a1 = cA + (size_t)(t + 1) * kstep;
            const char* a2 = last ? nA : cA + (size_t)(t + 2) * kstep; const char* b2 = last ? nB : cB + (size_t)(t + 2) * kstep;
            const char* a3 = a2 + kstep; const char* b3 = b2 + kstep;
            if (last && has_next) S.a_ready(nxt);
            if constexpr (Epi::HAS_MID) { if (t == 16 || t == 20) E.mid(acc, cur, t, wr, wc, fr, fq); }
            PG8_LDB(B0, 0, 0); PG8_SCHED; PG8_LDA(At, 0, 0); PG8_STAGE(PG8_SA(1, 1), a1 + hsA, voffA);
            PG8_WAIT_L(8); PG8_BAR; PG8_WAIT_L(0); PG8_MMA(0, 0, At, B0); PG8_BAR; PG8_SCHED;
            PG8_LDB(B1, 0, 1); PG8_STAGE(PG8_SB(0, 0), b2, voffB);
            PG8_BAR; PG8_WAIT_L(0); PG8_MMA(0, 1, At, B1); PG8_BAR;
            PG8_LDA(At, 0, 1); PG8_STAGE(PG8_SA(0, 0), a2, voffA);
            PG8_BAR; PG8_WAIT_L(0); PG8_MMA(1, 0, At, B0); PG8_BAR; PG8_SCHED;
            PG8_STAGE(PG8_SB(0, 1), b2 + hsB, voffB);
            PG8_WAIT_V(6); PG8_BAR; PG8_MMA(1, 1, At, B1); PG8_BAR;
            PG8_LDB(B0, 1, 0); PG8_SCHED; PG8_LDA(At, 1, 0); PG8_STAGE(PG8_SA(0, 1), a2 + hsA, voffA);
            PG8_WAIT_L(8); PG8_BAR; PG8_WAIT_L(0); PG8_MMA(0, 0, At, B0); PG8_BAR; PG8_SCHED;
            PG8_LDB(B1, 1, 1); PG8_STAGE(PG8_SB(1, 0), b3, voffB);
            PG8_BAR; PG8_WAIT_L(0); PG8_MMA(0, 1, At, B1); PG8_BAR;
            PG8_LDA(At, 1, 1); PG8_STAGE(PG8_SA(1, 0), a3, voffA);
            PG8_BAR; PG8_WAIT_L(0); PG8_MMA(1, 0, At, B0); PG8_BAR; PG8_SCHED;
            PG8_STAGE(PG8_SB(1, 1), b3 + hsB, voffB);
            PG8_WAIT_V(6); PG8_BAR; PG8_MMA(1, 1, At, B1); PG8_BAR;
        }
        E(acc, cur, wr, wc, fr, fq); S.done(cur);
        if (!has_next) break;
#pragma unroll
        for (int a = 0; a < 2; ++a)
#pragma unroll
            for (int b = 0; b < 2; ++b)
#pragma unroll
                for (int m = 0; m < 4; ++m)
#pragma unroll
                    for (int n = 0; n < 2; ++n) acc[a][b][m][n] = (f32x4){0.f, 0.f, 0.f, 0.f};
        cur = nxt; cA = nA; cB = nB; ++ui;
    }
    PG8_WAIT_V(0);
    if (wr == 0) PG8_BAR;
    PG8_BAR;
#undef PG8_SA
#undef PG8_SB
#undef PG8_STAGE
#undef PG8_LDA
#undef PG8_LDB
#undef PG8_MMA
#undef PG8_WAIT_V
#undef PG8_WAIT_L
#undef PG8_BAR
#undef PG8_SCHED
}
}

#ifndef PROBE
#define PROBE 0
#endif
struct Args {
    const float* in[26]; const int* positions; float* out; unsigned char* ws; int ph_lo, ph_hi; int pad0, pad1;
};
struct Frame {
    LAS unsigned char* lds;
    int tid, lane, wave, G, bid;
    const float* const* in; const int* positions; float* out; unsigned char* ws;
};
__device__ __forceinline__ void frame_refresh(Frame& F) { int l = lane_id(); asm volatile("" : "+v"(l)); F.lane = l; F.tid = F.wave * 64 + l; }
enum { I_X = 0, I_MEM = 1, I_POS = 2, I_NMIXW = 3, I_WIN = 4, I_CONVW = 5, I_CONVB = 6, I_DTB = 7, I_ALOG = 8, I_SSDD = 9, I_SSDNW = 10, I_DQNW = 11, I_DKNW = 12, I_MEMNW = 13,
       I_WMKV = 14, I_MQNW = 15, I_MKNW = 16, I_WSSD = 17, I_WDIL = 18, I_WMEMBR = 19, I_WOUT = 20, I_NFFNW = 21, I_WQ = 22, I_SUBK = 23, I_PD = 24, I_PU = 25 };

__device__ __forceinline__ void p0_transpose_item(const float* W, int ldw, int src_col0, bf16* WT, int ldt, int dst_row0, int dst_col0, int nblk, LAS float* scr, int item, int lane) {
    const int kb = item / nblk, nb = item % nblk, k0 = 64 * kb, n0 = 32 * nb;
#pragma unroll 8
    for (int i = 0; i < 32; ++i) { const int kk = 2 * i + (lane >> 5); scr[kk * 33 + (lane & 31)] = W[(size_t)(k0 + kk) * ldw + src_col0 + n0 + (lane & 31)]; }
    LDS_WAIT(); asm volatile("" ::: "memory");
    const int c = lane & 7;
#pragma unroll
    for (int j = 0; j < 4; ++j) { const int n = (lane >> 3) + 8 * j; const LAS float* s = scr + (8 * c) * 33 + n;
        u32x4 o; o.x = pk2(s[0 * 33], s[1 * 33]); o.y = pk2(s[2 * 33], s[3 * 33]); o.z = pk2(s[4 * 33], s[5 * 33]); o.w = pk2(s[6 * 33], s[7 * 33]);
        *(u32x4*)(WT + (size_t)(dst_row0 + n0 + n) * ldt + dst_col0 + k0 + 8 * c) = o; }
    LDS_WAIT(); asm volatile("" ::: "memory");
}
__device__ __forceinline__ void rms_row_to_bf16(const float* xrow, const float* w, bf16* orow, int lane, f32x4 (&v)[4]) {
    const f32x4* xr = (const f32x4*)xrow + lane; const f32x4* wr = (const f32x4*)w + lane;
    float s = 0.f;
#pragma unroll
    for (int j = 0; j < 4; ++j) { v[j] = xr[64 * j]; s += (v[j].x * v[j].x + v[j].y * v[j].y) + (v[j].z * v[j].z + v[j].w * v[j].w); }
    const float rstd = 1.0f / sqrtf(wave_sum(s) * (1.f / DM) + EPS);
    unsigned long long* o8 = (unsigned long long*)orow + lane;
#pragma unroll
    for (int j = 0; j < 4; ++j) { const f32x4 ww = wr[64 * j]; v[j] = v[j] * rstd * ww;
        o8[64 * j] = (unsigned long long)pk2(v[j].x, v[j].y) | ((unsigned long long)pk2(v[j].z, v[j].w) << 32); }
}
__device__ __forceinline__ void cvt_f32_bf16_stream(const float* src, bf16* dst, size_t n, size_t gtid, size_t gthreads) {
    for (size_t i = gtid * 8; i < n; i += gthreads * 8) { const f32x4 a = *(const f32x4*)(src + i), b = *(const f32x4*)(src + i + 4);
        u32x4 o; o.x = pk2(a.x, a.y); o.y = pk2(a.z, a.w); o.z = pk2(b.x, b.y); o.w = pk2(b.z, b.w); *(u32x4*)(dst + i) = o; }
}
constexpr float PD_SCALE = 64.0f, PU_SCALE = 8.0f;
__device__ __forceinline__ unsigned pk4_fp8(f32x4 v, float sc) {
    const float a = fminf(fmaxf(v.x * sc, -448.f), 448.f), b = fminf(fmaxf(v.y * sc, -448.f), 448.f), c = fminf(fmaxf(v.z * sc, -448.f), 448.f), d = fminf(fmaxf(v.w * sc, -448.f), 448.f);
    unsigned p = __builtin_amdgcn_cvt_pk_fp8_f32(a, b, 0, false); return __builtin_amdgcn_cvt_pk_fp8_f32(c, d, p, true);
}
__device__ __forceinline__ void cvt_f32_fp8_sliced(const float* src, unsigned char* dst, float sc, size_t gtid, size_t gthreads) {
    for (size_t i = gtid * 16; i < (size_t)16384 * 1024; i += gthreads * 16) { const f32x4 a = *(const f32x4*)(src + i), b = *(const f32x4*)(src + i + 4), c = *(const f32x4*)(src + i + 8), d = *(const f32x4*)(src + i + 12);
        const size_t e = i >> 10, dd = i & 1023;
        const u32x4 o = {pk4_fp8(a, sc), pk4_fp8(b, sc), pk4_fp8(c, sc), pk4_fp8(d, sc)}; *(u32x4*)(dst + ((((dd >> 7) * 16384 + e) << 7) + (dd & 127))) = o; }
}
__device__ __forceinline__ void p0_prologue(Frame& F) {
    LAS float* scr = (LAS float*)(F.lds + F.wave * 8448);
    LAS float* wdt = (LAS float*)(F.lds + 8 * 8448);
    const int gw = F.bid * NWAVES + F.wave, NGW = F.G * NWAVES;
    unsigned char* ws = F.ws;
    for (int i = F.tid; i < 1024 * 16; i += NTHR) { const int k = i >> 4, c = i & 15, l = (k & 255) >> 2, e = k & 3, j = k >> 8, q = c >> 2;
        wdt[((((j * 4 + e) * 4 + q) * 64 + l) << 2) + (c & 3)] = F.in[I_WIN][(size_t)k * W_IN_N + OFF_DT + c]; }
    __syncthreads();
    constexpr int IT_A = 16 * 96, IT_B = 16 * 192, IT_MKV = 16 * 48, IT_SSD = 16 * 32, IT_DIL = 4 * 32, IT_MBR = 12 * 32, IT_OUT = 16 * 32, IT_WQ = 16 * 64;
    constexpr int NITEMS = IT_A + IT_B + IT_MKV + IT_SSD + IT_DIL + IT_MBR + IT_OUT + IT_WQ;
    bf16* WallT = (bf16*)(ws + WS_WALLT);
    for (int it = gw; it < NITEMS; it += NGW) {
        int r = it;
        if (r < IT_A) { p0_transpose_item(F.in[I_WIN], W_IN_N, 0, WallT, DM, 0, 0, 96, scr, r, F.lane); continue; } r -= IT_A;
        if (r < IT_B) { p0_transpose_item(F.in[I_WIN], W_IN_N, OFF_AFTER_DT, WallT, DM, 3072, 0, 192, scr, r, F.lane); continue; } r -= IT_B;
        if (r < IT_MKV) { p0_transpose_item(F.in[I_WMKV], 1536, 0, (bf16*)(ws + WS_WMKVT), DM, 0, 0, 48, scr, r, F.lane); continue; } r -= IT_MKV;
        if (r < IT_SSD) { p0_transpose_item(F.in[I_WSSD], DM, 0, (bf16*)(ws + WS_WCATT), YC, 0, 0, 32, scr, r, F.lane); continue; } r -= IT_SSD;
        if (r < IT_DIL) { p0_transpose_item(F.in[I_WDIL], DM, 0, (bf16*)(ws + WS_WCATT), YC, 0, 1024, 32, scr, r, F.lane); continue; } r -= IT_DIL;
        if (r < IT_MBR) { p0_transpose_item(F.in[I_WMEMBR], DM, 0, (bf16*)(ws + WS_WCATT), YC, 0, 1280, 32, scr, r, F.lane); continue; } r -= IT_MBR;
        if (r < IT_OUT) { p0_transpose_item(F.in[I_WOUT], DM, 0, (bf16*)(ws + WS_WOUTT), DM, 0, 0, 32, scr, r, F.lane); continue; } r -= IT_OUT;
        p0_transpose_item(F.in[I_WQ], PEER_Q, 0, (bf16*)(ws + WS_WQT), DM, 0, 0, 64, scr, r, F.lane);
    }
    const size_t gtid = (size_t)F.bid * NTHR + F.tid, gth = (size_t)F.G * NTHR;
    cvt_f32_bf16_stream(F.in[I_SUBK], (bf16*)(ws + WS_SUBK), (size_t)8 * 2 * 128 * 128, gtid, gth);
    cvt_f32_fp8_sliced(F.in[I_PD], ws + WS_PD, PD_SCALE, gtid, gth);
    cvt_f32_fp8_sliced(F.in[I_PU], ws + WS_PU, PU_SCALE, gtid, gth);
    for (int m = gw; m < NB * NMEM; m += NGW) { f32x4 v[4]; rms_row_to_bf16(F.in[I_MEM] + (size_t)m * DM, F.in[I_MEMNW], (bf16*)(ws + WS_MEMN) + (size_t)m * DM, F.lane, v); }
    float* DTp = (float*)(ws + WS_DT);
    const int lane = F.lane;
    const int myj = ((lane >> 5) & 1) * 8 + ((lane >> 4) & 1) * 4 + ((lane >> 3) & 1) * 2 + ((lane >> 2) & 1);
    const float dtb = F.in[I_DTB][myj];
    for (int m = 2 * gw; m < T; m += 2 * NGW) {
        f32x4 va[4], vb[4];
        rms_row_to_bf16(F.in[I_X] + (size_t)m * DM, F.in[I_NMIXW], (bf16*)(ws + WS_ACT1) + (size_t)m * DM, lane, va);
        rms_row_to_bf16(F.in[I_X] + (size_t)(m + 1) * DM, F.in[I_NMIXW], (bf16*)(ws + WS_ACT1) + (size_t)(m + 1) * DM, lane, vb);
        float da[16], db[16];
#pragma unroll
        for (int j = 0; j < 16; ++j) { da[j] = 0.f; db[j] = 0.f; }
#pragma unroll
        for (int j = 0; j < 4; ++j)
#pragma unroll
            for (int e = 0; e < 4; ++e) { const float ua = va[j][e], ub = vb[j][e];
#pragma unroll
                for (int q = 0; q < 4; ++q) { const f32x4 w4 = *(const LAS f32x4*)(wdt + ((((j * 4 + e) * 4 + q) * 64 + lane) << 2));
                    da[4 * q + 0] += ua * w4.x; da[4 * q + 1] += ua * w4.y; da[4 * q + 2] += ua * w4.z; da[4 * q + 3] += ua * w4.w;
                    db[4 * q + 0] += ub * w4.x; db[4 * q + 1] += ub * w4.y; db[4 * q + 2] += ub * w4.z; db[4 * q + 3] += ub * w4.w; }
                __builtin_amdgcn_sched_barrier(0); }
        float ra, rb;
        { float r8a[8], r8b[8], r4a[4], r4b[4], r2a[2], r2b[2];
          { const bool up = (lane & 32) != 0;
#pragma unroll
            for (int k = 0; k < 8; ++k) { r8a[k] = (up ? da[k + 8] : da[k]) + __shfl_xor(up ? da[k] : da[k + 8], 32); r8b[k] = (up ? db[k + 8] : db[k]) + __shfl_xor(up ? db[k] : db[k + 8], 32); } }
          { const bool up = (lane & 16) != 0;
#pragma unroll
            for (int k = 0; k < 4; ++k) { r4a[k] = (up ? r8a[k + 4] : r8a[k]) + __shfl_xor(up ? r8a[k] : r8a[k + 4], 16); r4b[k] = (up ? r8b[k + 4] : r8b[k]) + __shfl_xor(up ? r8b[k] : r8b[k + 4], 16); } }
          { const bool up = (lane & 8) != 0;
#pragma unroll
            for (int k = 0; k < 2; ++k) { r2a[k] = (up ? r4a[k + 2] : r4a[k]) + __shfl_xor(up ? r4a[k] : r4a[k + 2], 8); r2b[k] = (up ? r4b[k + 2] : r4b[k]) + __shfl_xor(up ? r4b[k] : r4b[k + 2], 8); } }
          { const bool up = (lane & 4) != 0; ra = (up ? r2a[1] : r2a[0]) + __shfl_xor(up ? r2a[0] : r2a[1], 4); rb = (up ? r2b[1] : r2b[0]) + __shfl_xor(up ? r2b[0] : r2b[1], 4); }
          ra += __shfl_xor(ra, 2); ra += __shfl_xor(ra, 1); rb += __shfl_xor(rb, 2); rb += __shfl_xor(rb, 1); }
        if ((lane & 3) == 0) { const float xa = ra + dtb, xb = rb + dtb;
            DTp[(size_t)m * 16 + myj] = (xa > 20.f) ? xa : log1pf(__expf(xa)); DTp[(size_t)(m + 1) * 16 + myj] = (xb > 20.f) ? xb : log1pf(__expf(xb)); }
    }
}

__device__ __forceinline__ void norm192_inplace(bf16* p, const float (&w)[4], int lane) {
    u32x2 v = {0u, 0u};
    if (lane < 48) v = *(const u32x2*)(p + 4 * lane);
    float x0 = bflo(v.x), x1 = bfhi(v.x), x2 = bflo(v.y), x3 = bfhi(v.y);
    const float ss = wave_sum((x0 * x0 + x1 * x1) + (x2 * x2 + x3 * x3));
    const float rs = 1.0f / sqrtf(ss * (1.f / 192.f) + EPS);
    if (lane < 48) { const u32x2 o = {pkbf(x0 * rs * w[0], x1 * rs * w[1]), pkbf(x2 * rs * w[2], x3 * rs * w[3])}; *(u32x2*)(p + 4 * lane) = o; }
}
__device__ __forceinline__ void qkprep_phase(Frame& F, int half) {
    bf16* P = (bf16*)(F.ws + WS_BIG);
    const int gw = F.bid * NWAVES + F.wave, NGW = F.G * NWAVES, lane = F.lane, sub = lane & 7;
    float wq[8], wk[8], wmq[4], wmk[4];
#pragma unroll
    for (int j = 0; j < 8; ++j) { wq[j] = F.in[I_DQNW][8 * sub + j]; wk[j] = F.in[I_DKNW][8 * sub + j]; }
#pragma unroll
    for (int j = 0; j < 4; ++j) { wmq[j] = F.in[I_MQNW][(4 * lane + j) % 192]; wmk[j] = F.in[I_MKNW][(4 * lane + j) % 192]; }
    const float inv = __expf(-logf(500000.0f) * (2.0f / 16.0f) * (float)sub);
    for (int r0 = gw; r0 < HT; r0 += 2 * NGW) {
        bf16* rowp[2]; u32x4 v[2][3]; u32x2 m[2][4]; int pos[2];
#pragma unroll
        for (int u = 0; u < 2; ++u) { const int r = (r0 + u * NGW < HT) ? r0 + u * NGW : r0; rowp[u] = P + (size_t)r * NPROJ; pos[u] = F.positions[half * HT + r];
#pragma unroll
            for (int blk = 0; blk < 3; ++blk) v[u][blk] = *(const u32x4*)(rowp[u] + PC_DQ + blk * 512 + 8 * lane);
#pragma unroll
            for (int h = 0; h < 4; ++h) { m[u][h] = (u32x2){0u, 0u}; if (lane < 48) m[u][h] = *(const u32x2*)(rowp[u] + PC_MQ + h * 192 + 4 * lane); } }
#pragma unroll
        for (int u = 0; u < 2; ++u) {
            if (u == 1 && r0 + NGW >= HT) break;
            const double rev = (double)((float)pos[u] * inv) * 0.15915494309189535;
            const float fr = (float)(rev - floor(rev));
            const float cs = __builtin_amdgcn_cosf(fr), sn = __builtin_amdgcn_sinf(fr);
            float cj[8], sj[8];
#pragma unroll
            for (int j = 0; j < 8; ++j) { cj[j] = __shfl(cs, (lane & ~7) | j); sj[j] = __shfl(sn, (lane & ~7) | j); }
            bf16* row = rowp[u];
#pragma unroll
            for (int blk = 0; blk < 3; ++blk) {
                float x[8] = {bflo(v[u][blk].x), bfhi(v[u][blk].x), bflo(v[u][blk].y), bfhi(v[u][blk].y), bflo(v[u][blk].z), bfhi(v[u][blk].z), bflo(v[u][blk].w), bfhi(v[u][blk].w)};
                float ss = 0.f;
#pragma unroll
                for (int j = 0; j < 8; ++j) ss += x[j] * x[j];
                ss += __shfl_xor(ss, 1); ss += __shfl_xor(ss, 2); ss += __shfl_xor(ss, 4);
                const float rs = 1.0f / sqrtf(ss * (1.f / 64.f) + EPS);
                const bool isq = (8 * blk + (lane >> 3)) < 12;
#pragma unroll
                for (int j = 0; j < 8; ++j) x[j] = x[j] * rs * (isq ? wq[j] : wk[j]);
#pragma unroll
                for (int j = 0; j < 8; ++j) { const float o = __shfl_xor(x[j], 1);
                    if (sub == 0) x[j] = x[j] * cj[j] - o * sj[j]; else if (sub == 1) x[j] = x[j] * cj[j] + o * sj[j]; }
                const u32x4 w = {pkbf(x[0], x[1]), pkbf(x[2], x[3]), pkbf(x[4], x[5]), pkbf(x[6], x[7])};
                *(u32x4*)(row + PC_DQ + blk * 512 + 8 * lane) = w;
            }
#pragma unroll
            for (int h = 0; h < 4; ++h) { const u32x2 q = m[u][h]; const float x0 = bflo(q.x), x1 = bfhi(q.x), x2 = bflo(q.y), x3 = bfhi(q.y);
                const float ss = wave_sum((x0 * x0 + x1 * x1) + (x2 * x2 + x3 * x3));
                const float rs = 1.0f / sqrtf(ss * (1.f / 192.f) + EPS);
                if (lane < 48) { const u32x2 o = {pkbf(x0 * rs * wmq[0], x1 * rs * wmq[1]), pkbf(x2 * rs * wmq[2], x3 * rs * wmq[3])}; *(u32x2*)(row + PC_MQ + h * 192 + 4 * lane) = o; } }
        }
    }
    if (half == 0) {
        bf16* MK = (bf16*)(F.ws + WS_MKV);
        for (int r = gw; r < NB * NMEM * 4; r += NGW) norm192_inplace(MK + (size_t)(r >> 2) * 1536 + (r & 3) * 192, wmk, lane);
    }
}

constexpr int SC_ST = 272, SX_ST = 528;
__device__ __forceinline__ float bfsel(const u32x4& v, int j) { const unsigned w = v[j >> 1]; return (j & 1) ? bfhi(w) : bflo(w); }
__device__ __forceinline__ void conv_task(const bf16* P, size_t rowb, int t0, int pcol, const float* cw, const float* cb, int ccol, LAS unsigned char* dst, int stride, const LAS float* scale) {
    float w[4][8], bs[8];
#pragma unroll
    for (int k = 0; k < 4; ++k) { const f32x4 a = *(const f32x4*)(cw + k * 2048 + ccol), b = *(const f32x4*)(cw + k * 2048 + ccol + 4);
        w[k][0] = a.x; w[k][1] = a.y; w[k][2] = a.z; w[k][3] = a.w; w[k][4] = b.x; w[k][5] = b.y; w[k][6] = b.z; w[k][7] = b.w; }
    { const f32x4 a = *(const f32x4*)(cb + ccol), b = *(const f32x4*)(cb + ccol + 4); bs[0] = a.x; bs[1] = a.y; bs[2] = a.z; bs[3] = a.w; bs[4] = b.x; bs[5] = b.y; bs[6] = b.z; bs[7] = b.w; }
    const bf16* src = P + (rowb + t0) * NPROJ + pcol;
    u32x4 rw[19];
#pragma unroll
    for (int i = 0; i < 3; ++i) rw[i] = (u32x4){0u, 0u, 0u, 0u};
    if (t0 > 0) {
#pragma unroll
        for (int i = 0; i < 3; ++i) rw[i] = *(const u32x4*)(src + (ptrdiff_t)(i - 3) * NPROJ); }
#pragma unroll
    for (int i = 0; i < 16; ++i) rw[3 + i] = *(const u32x4*)(src + (size_t)i * NPROJ);
#pragma unroll
    for (int i = 0; i < 16; ++i) {
        float o[8];
#pragma unroll
        for (int j = 0; j < 8; ++j) { float a = bs[j] + w[0][j] * bfsel(rw[i], j) + w[1][j] * bfsel(rw[i + 1], j) + w[2][j] * bfsel(rw[i + 2], j) + w[3][j] * bfsel(rw[i + 3], j); o[j] = a * sigmoidf_(a); }
        if (scale) { const float sv = scale[i];
#pragma unroll
            for (int j = 0; j < 8; ++j) o[j] *= sv; }
        const u32x4 r = {pkbf(o[0], o[1]), pkbf(o[2], o[3]), pkbf(o[4], o[5]), pkbf(o[6], o[7])};
        *(LAS u32x4*)(dst + i * stride) = r;
    }
}
__device__ __forceinline__ float ssd_scan(Frame& F, const float* DTp, size_t tok0, int g, LAS float* sAc, LAS float* sDt) {
    float total = 0.f;
    if (F.wave < 4) {
        const int head = 4 * g + F.wave, lane = F.lane;
        const float A = -__expf(F.in[I_ALOG][head]);
        const float d0 = DTp[(tok0 + 2 * lane) * 16 + head], d1 = DTp[(tok0 + 2 * lane + 1) * 16 + head];
        const float a0 = d0 * A, a1 = d1 * A;
        float sc = a0 + a1;
#pragma unroll
        for (int o = 1; o < 64; o <<= 1) { const float v = __shfl_up(sc, o); if (lane >= o) sc += v; }
        sAc[F.wave * 128 + 2 * lane] = sc - a1; sAc[F.wave * 128 + 2 * lane + 1] = sc;
        sDt[F.wave * 128 + 2 * lane] = d0; sDt[F.wave * 128 + 2 * lane + 1] = d1;
        total = __shfl(sc, 63);
    }
    return total;
}
__device__ __forceinline__ bf16x8 tr_pair(unsigned a_lo, unsigned a_hi) {
    s16x4 lo, hi;
    asm volatile("ds_read_b64_tr_b16 %0, %2\n\tds_read_b64_tr_b16 %1, %3\n\ts_waitcnt lgkmcnt(0)" : "=&v"(lo), "=&v"(hi) : "v"(a_lo), "v"(a_hi) : "memory");
    const bf16x8 r = {lo[0], lo[1], lo[2], lo[3], hi[0], hi[1], hi[2], hi[3]}; return r;
}

__device__ __forceinline__ void ssdC_phase(Frame& F, int half) {
    const bf16* P = (const bf16*)(F.ws + WS_BIG);
    const float* DTp = (const float*)(F.ws + WS_DT);
    float* SST = (float*)(F.ws + WS_SST); float* DEC = (float*)(F.ws + WS_DEC);
    LAS unsigned char* sX = F.lds; LAS unsigned char* sB = F.lds + 128 * SX_ST;
    LAS float* sAc = (LAS float*)(F.lds + 128 * SX_ST + 128 * SC_ST); LAS float* sDt = sAc + 512; LAS float* sW = sDt + 512;
    const int wave = F.wave;
    for (int unit = F.bid; unit < HB * 64 * 4; unit += F.G) {
        int tid = F.tid; asm volatile("" : "+v"(tid));
        const int lane = tid & 63, ql = lane & 31, h = lane >> 5, tq = (lane & 15) >> 2, tp = lane & 3, tblk = (lane >> 4) & 1;
        const int bl = unit >> 8, c = (unit >> 2) & 63, g = unit & 3;
        const size_t rowb = (size_t)bl * SEQ, tok0 = (size_t)half * HT + rowb + c * 128;
        __syncthreads();
        const float total = ssd_scan(F, DTp, tok0, g, sAc, sDt);
        if (wave < 4) { sW[wave * 128 + 2 * lane] = __expf(total - sAc[wave * 128 + 2 * lane]) * sDt[wave * 128 + 2 * lane];
            sW[wave * 128 + 2 * lane + 1] = __expf(total - sAc[wave * 128 + 2 * lane + 1]) * sDt[wave * 128 + 2 * lane + 1];
            if (lane == 0) DEC[((size_t)bl * 64 + c) * 16 + 4 * g + wave] = __expf(total); }
        __syncthreads();
        if (tid < 384) {
            int ch, strip, ccol, stride; LAS unsigned char* dst; const LAS float* scl = nullptr;
            if (tid < 256) { ch = tid & 31; strip = tid >> 5; ccol = g * 256 + 8 * ch; stride = SX_ST; dst = sX + (strip * 16) * SX_ST + ch * 16; scl = sW + (ch >> 3) * 128 + strip * 16; }
            else { const int u = tid - 256; ch = u & 15; strip = u >> 4; ccol = 1024 + g * 128 + 8 * ch; stride = SC_ST; dst = sB + (strip * 16) * SC_ST + ch * 16; }
            conv_task(P, rowb, c * 128 + strip * 16, PC_X + ccol, F.in[I_CONVW], F.in[I_CONVB], ccol, dst, stride, scl);
        }
        __syncthreads();
        const int r = wave >> 1, pt = wave & 1;
        f32x16 acc[4];
#pragma unroll
        for (int nt = 0; nt < 4; ++nt)
#pragma unroll
            for (int e = 0; e < 16; ++e) acc[nt][e] = 0.f;
        const unsigned xa = (unsigned)(size_t)sX + (unsigned)((8 * h + tq) * SX_ST + (r * 64 + 32 * pt + 16 * tblk + 4 * tp) * 2);
        const unsigned ba = (unsigned)(size_t)sB + (unsigned)((8 * h + tq) * SC_ST + (16 * tblk + 4 * tp) * 2);
#pragma unroll
        for (int ks = 0; ks < 8; ++ks) {
            const bf16x8 af = tr_pair(xa + ks * 16 * SX_ST, xa + ks * 16 * SX_ST + 4 * SX_ST);
            bf16x8 bfr[4];
#pragma unroll
            for (int nt = 0; nt < 4; ++nt) bfr[nt] = tr_pair(ba + ks * 16 * SC_ST + nt * 64, ba + ks * 16 * SC_ST + 4 * SC_ST + nt * 64);
            __builtin_amdgcn_sched_barrier(0);
#pragma unroll
            for (int nt = 0; nt < 4; ++nt) acc[nt] = MFMA32(af, bfr[nt], acc[nt]);
        }
        float* out = SST + (((size_t)bl * 64 + c) * 16 + 4 * g + r) * 8192;
#pragma unroll
        for (int nt = 0; nt < 4; ++nt)
#pragma unroll
            for (int e = 0; e < 16; ++e) out[(32 * pt + (e & 3) + 8 * (e >> 2) + 4 * h) * 128 + 32 * nt + ql] = acc[nt][e];
    }
}

__device__ __forceinline__ void ssdD_phase(Frame& F) {
    const float* SST = (const float*)(F.ws + WS_SST); const float* DEC = (const float*)(F.ws + WS_DEC);
    bf16* SIN = (bf16*)(F.ws + WS_SIN);
    const size_t gtid = (size_t)F.bid * NTHR + F.tid, gth = (size_t)F.G * NTHR;
    for (size_t it = gtid; it < (size_t)HB * 16 * 2048; it += gth) {
        const int bl = (int)(it >> 15), head = (int)(it >> 11) & 15, e4 = (int)(it & 2047) * 4;
        f32x4 st = {0.f, 0.f, 0.f, 0.f};
#pragma unroll 8
        for (int c = 0; c < 64; ++c) {
            const size_t idx = (((size_t)bl * 64 + c) * 16 + head);
            const u32x2 o = {pkbf(st.x, st.y), pkbf(st.z, st.w)};
            *(u32x2*)(SIN + idx * 8192 + e4) = o;
            const f32x4 sl = *(const f32x4*)(SST + idx * 8192 + e4); const float d = DEC[idx];
            st = st * d + sl;
        }
    }
}

__device__ __forceinline__ void ssdE_phase(Frame& F, int half) {
    const bf16* P = (const bf16*)(F.ws + WS_BIG);
    const float* DTp = (const float*)(F.ws + WS_DT);
    const bf16* SIN = (const bf16*)(F.ws + WS_SIN);
    bf16* Y = (bf16*)F.out;
    LAS unsigned char* sX = F.lds; LAS unsigned char* sB = F.lds + 128 * SX_ST; LAS unsigned char* sC = sB + 128 * SC_ST;
    LAS float* sAc = (LAS float*)(sC + 128 * SC_ST); LAS float* sDt = sAc + 512; LAS float* sSS = sDt + 512;
    const int wave = F.wave;
    const int st = wave & 3, hp = wave >> 2;
    for (int unit = F.bid; unit < HB * 64 * 4; unit += F.G) {
        int tid = F.tid; asm volatile("" : "+v"(tid));
        const int lane = tid & 63, ql = lane & 31, h = lane >> 5, tq = (lane & 15) >> 2, tp = lane & 3, tblk = (lane >> 4) & 1;
        const int bl = unit >> 8, c = (unit >> 2) & 63, g = unit & 3;
        const size_t rowb = (size_t)bl * SEQ, tok0 = (size_t)half * HT + rowb + c * 128;
        __syncthreads();
        (void)ssd_scan(F, DTp, tok0, g, sAc, sDt);
        if (tid < 128) sSS[tid] = 0.f;
        {
            int ch, strip, ccol, stride; LAS unsigned char* dst;
            if (tid < 256) { ch = tid & 31; strip = tid >> 5; ccol = g * 256 + 8 * ch; stride = SX_ST; dst = sX + (strip * 16) * SX_ST + ch * 16; }
            else if (tid < 384) { const int u = tid - 256; ch = u & 15; strip = u >> 4; ccol = 1024 + g * 128 + 8 * ch; stride = SC_ST; dst = sB + (strip * 16) * SC_ST + ch * 16; }
            else { const int u = tid - 384; ch = u & 15; strip = u >> 4; ccol = 1536 + g * 128 + 8 * ch; stride = SC_ST; dst = sC + (strip * 16) * SC_ST + ch * 16; }
            conv_task(P, rowb, c * 128 + strip * 16, PC_X + ccol, F.in[I_CONVW], F.in[I_CONVB], ccol, dst, stride, nullptr);
        }
        __syncthreads();
        const int s = 32 * st + ql;
        unsigned yk[2][2][8];
        float ssq = 0.f;
        const unsigned xa = (unsigned)(size_t)sX + (unsigned)((4 * h + tq) * SX_ST + (16 * tblk + 4 * tp) * 2);
#pragma unroll
        for (int hq = 0; hq < 2; ++hq) {
            const int r = 2 * hp + hq, head = 4 * g + r;
            const float acs = sAc[r * 128 + s];
            const bf16* stp = SIN + (((size_t)bl * 64 + c) * 16 + head) * 8192 + ql * 128 + 8 * h;
            bf16x8 sfr[2][8];
#pragma unroll
            for (int pt = 0; pt < 2; ++pt)
#pragma unroll
                for (int ks = 0; ks < 8; ++ks) sfr[pt][ks] = *(const bf16x8*)(stp + pt * 4096 + 16 * ks);
            bf16x8 pf[4][2];
#pragma unroll
            for (int i = 0; i < 4; ++i) {
                f32x16 Xi;
#pragma unroll
                for (int e = 0; e < 16; ++e) Xi[e] = 0.f;
#pragma unroll
                for (int ks = 0; ks < 8; ++ks) { const bf16x8 bf_ = *(const LAS bf16x8*)(sB + (32 * i + ql) * SC_ST + 32 * ks + 16 * h);
                    const bf16x8 cf = *(const LAS bf16x8*)(sC + s * SC_ST + 32 * ks + 16 * h); Xi = MFMA32(bf_, cf, Xi); }
                float p[16];
#pragma unroll
                for (int q4 = 0; q4 < 4; ++q4) { const int t0 = 32 * i + 8 * q4 + 4 * h;
                    const f32x4 at = *(const LAS f32x4*)(sAc + r * 128 + t0), dt4 = *(const LAS f32x4*)(sDt + r * 128 + t0);
#pragma unroll
                    for (int e = 0; e < 4; ++e) { const int t = t0 + e; p[4 * q4 + e] = (t <= s) ? Xi[4 * q4 + e] * __expf(acs - at[e]) * dt4[e] : 0.f; } }
#pragma unroll
                for (int s2 = 0; s2 < 2; ++s2) { const u32x4 w = {pkbf(p[8 * s2 + 0], p[8 * s2 + 1]), pkbf(p[8 * s2 + 2], p[8 * s2 + 3]), pkbf(p[8 * s2 + 4], p[8 * s2 + 5]), pkbf(p[8 * s2 + 6], p[8 * s2 + 7])};
                    pf[i][s2] = __builtin_bit_cast(bf16x8, w); }
            }
            const float eacs = __expf(acs), Dh = F.in[I_SSDD][head];
#pragma unroll
            for (int pt = 0; pt < 2; ++pt) {
                f32x16 yd, yo;
#pragma unroll
                for (int e = 0; e < 16; ++e) { yd[e] = 0.f; yo[e] = 0.f; }
#pragma unroll
                for (int i = 0; i < 4; ++i) {
#pragma unroll
                    for (int s2 = 0; s2 < 2; ++s2) { const unsigned a = xa + (unsigned)((32 * i + 16 * s2) * SX_ST + (r * 64 + 32 * pt) * 2);
                        const bf16x8 xf = tr_pair(a, a + 8 * SX_ST); __builtin_amdgcn_sched_barrier(0); yd = MFMA32(xf, pf[i][s2], yd); }
                }
#pragma unroll
                for (int ks = 0; ks < 8; ++ks) { const bf16x8 cf = *(const LAS bf16x8*)(sC + s * SC_ST + 32 * ks + 16 * h); yo = MFMA32(sfr[pt][ks], cf, yo); }
                const bf16* zp = P + (rowb + c * 128 + s) * NPROJ + PC_Z + g * 256 + r * 64 + 32 * pt + 4 * h;
                u32x2 zv[4];
#pragma unroll
                for (int q4 = 0; q4 < 4; ++q4) zv[q4] = *(const u32x2*)(zp + 8 * q4);
#pragma unroll
                for (int q4 = 0; q4 < 4; ++q4) {
                    const u32x2 xv = *(const LAS u32x2*)(sX + s * SX_ST + (r * 64 + 32 * pt + 8 * q4 + 4 * h) * 2);
                    const u32x2 zq = zv[q4];
                    const float xs_[4] = {bflo(xv.x), bfhi(xv.x), bflo(xv.y), bfhi(xv.y)}, zs_[4] = {bflo(zq.x), bfhi(zq.x), bflo(zq.y), bfhi(zq.y)};
                    float yv[4];
#pragma unroll
                    for (int e = 0; e < 4; ++e) { float y = yd[4 * q4 + e] + eacs * yo[4 * q4 + e] + Dh * xs_[e]; y = y * zs_[e] * sigmoidf_(zs_[e]); yv[e] = y; ssq += y * y; }
                    yk[hq][pt][2 * q4] = pkbf(yv[0], yv[1]); yk[hq][pt][2 * q4 + 1] = pkbf(yv[2], yv[3]);
                }
            }
        }
        ssq += __shfl_xor(ssq, 32);
        if (h == 0) __hip_atomic_fetch_add(sSS + s, ssq, __ATOMIC_RELAXED, __HIP_MEMORY_SCOPE_WORKGROUP);
        __syncthreads();
        const float rs = 1.0f / sqrtf(sSS[s] * (1.f / 256.f) + EPS);
        bf16* yp = Y + (tok0 + s) * YC + g * 256 + 4 * h;
        const float* nw = F.in[I_SSDNW] + g * 256 + 4 * h;
#pragma unroll
        for (int hq = 0; hq < 2; ++hq)
#pragma unroll
            for (int pt = 0; pt < 2; ++pt)
#pragma unroll
                for (int q4 = 0; q4 < 4; ++q4) { const int cc = (2 * hp + hq) * 64 + 32 * pt + 8 * q4; const f32x4 w4 = *(const f32x4*)(nw + cc);
                    const unsigned ya = yk[hq][pt][2 * q4], yb = yk[hq][pt][2 * q4 + 1];
                    const u32x2 o = {pkbf(bflo(ya) * rs * w4.x, bfhi(ya) * rs * w4.y), pkbf(bflo(yb) * rs * w4.z, bfhi(yb) * rs * w4.w)};
                    *(u32x2*)(yp + cc) = o; }
    }
}

__device__ __forceinline__ bf16x8 mk_bf16x8(u32x2 lo, u32x2 hi) { const u32x4 v = {lo.x, lo.y, hi.x, hi.y}; return __builtin_bit_cast(bf16x8, v); }

__device__ __forceinline__ void memattn_mfma_phase(Frame& F, int half) {
    const bf16* P = (const bf16*)(F.ws + WS_BIG);
    const bf16* MKV = (const bf16*)(F.ws + WS_MKV);
    const bf16* MVT = (const bf16*)(F.ws + WS_MVT);
    bf16* Y = (bf16*)F.out;
    LAS unsigned char* sm = F.lds;
    const int tid = F.tid, lane = F.lane, wave = F.wave, ql = lane & 31, h = lane >> 5;
    constexpr int KST = 400, VST = 528;
    for (int unit = F.bid; unit < HB * 4 * 32; unit += F.G) {
        const int bl = unit >> 7, head = (unit >> 5) & 3, qt = unit & 31, b = half * HB + bl;
        const int r = bl * SEQ + qt * 256 + wave * 32 + ql;
        __syncthreads();
        for (int c = tid; c < 256 * 24; c += NTHR) { const int row = c / 24, ch = c % 24;
            *(LAS u32x4*)(sm + row * KST + ch * 16) = *(const u32x4*)(MKV + (size_t)(b * NMEM + row) * 1536 + head * 192 + ch * 8); }
        bf16x8 qf[12];
        { const bf16* qp = P + (size_t)r * NPROJ + PC_MQ + head * 192 + 8 * h;
#pragma unroll
          for (int ks = 0; ks < 12; ++ks) qf[ks] = *(const bf16x8*)(qp + 16 * ks); }
        __syncthreads();
        f32x16 sacc[8];
#pragma unroll
        for (int mt = 0; mt < 8; ++mt) {
#pragma unroll
            for (int i = 0; i < 16; ++i) sacc[mt][i] = 0.f;
#pragma unroll
            for (int ks = 0; ks < 12; ++ks) { const bf16x8 kf = *(const LAS bf16x8*)(sm + (32 * mt + ql) * KST + 32 * ks + 16 * h); sacc[mt] = MFMA32(kf, qf[ks], sacc[mt]); }
        }
        float mx = -3.0e38f;
#pragma unroll
        for (int mt = 0; mt < 8; ++mt)
#pragma unroll
            for (int i = 0; i < 16; ++i) mx = fmaxf(mx, sacc[mt][i]);
        mx = fmaxf(mx, __shfl_xor(mx, 32));
        const float sc = 0.07216878364870323f * 1.4426950408889634f;
        float l = 0.f;
        bf16x8 pf[8][2];
#pragma unroll
        for (int mt = 0; mt < 8; ++mt) {
            float p[16];
#pragma unroll
            for (int i = 0; i < 16; ++i) { p[i] = __builtin_amdgcn_exp2f((sacc[mt][i] - mx) * sc); l += p[i]; }
#pragma unroll
            for (int s2 = 0; s2 < 2; ++s2) { const u32x4 w = {pkbf(p[8 * s2 + 0], p[8 * s2 + 1]), pkbf(p[8 * s2 + 2], p[8 * s2 + 3]), pkbf(p[8 * s2 + 4], p[8 * s2 + 5]), pkbf(p[8 * s2 + 6], p[8 * s2 + 7])};
                pf[mt][s2] = __builtin_bit_cast(bf16x8, w); }
        }
        l += __shfl_xor(l, 32);
        __syncthreads();
        for (int c = tid; c < 192 * 32; c += NTHR) { const int row = c >> 5, ch = c & 31;
            *(LAS u32x4*)(sm + row * VST + ch * 16) = *(const u32x4*)(MVT + (size_t)(head * 192 + row) * 2048 + b * NMEM + ch * 8); }
        __syncthreads();
        const float il = 1.0f / l;
        bf16* yp = Y + ((size_t)half * HT + r) * YC + 1280 + head * 192 + 4 * h;
#pragma unroll
        for (int dt = 0; dt < 6; ++dt) {
            f32x16 o;
#pragma unroll
            for (int i = 0; i < 16; ++i) o[i] = 0.f;
#pragma unroll
            for (int mt = 0; mt < 8; ++mt)
#pragma unroll
                for (int s2 = 0; s2 < 2; ++s2) { const LAS unsigned char* vp = sm + (32 * dt + ql) * VST + (32 * mt + 16 * s2 + 4 * h) * 2;
                    const bf16x8 vf = mk_bf16x8(*(const LAS u32x2*)vp, *(const LAS u32x2*)(vp + 16)); o = MFMA32(vf, pf[mt][s2], o); }
#pragma unroll
            for (int g = 0; g < 4; ++g) { const u32x2 w = {pkbf(o[4 * g] * il, o[4 * g + 1] * il), pkbf(o[4 * g + 2] * il, o[4 * g + 3] * il)}; *(u32x2*)(yp + 32 * dt + 8 * g) = w; }
        }
    }
}

__device__ __forceinline__ void dilattn_mfma_phase(Frame& F, int half) {
    bf16* P = (bf16*)(F.ws + WS_BIG);
    float* LSE = (float*)(F.ws + WS_LSE);
    LAS unsigned char* sK = F.lds; LAS unsigned char* sV = F.lds + 384 * 144;
    const int tid = F.tid, lane = F.lane, wave = F.wave, ql = lane & 31, h = lane >> 5;
    constexpr int RST = 144;
    for (int unit = F.bid; unit < HB * 12 * 32; unit += F.G) {
        const int bl = unit / 384, rem = unit % 384, head = rem >> 5, blk = rem & 31;
        const int g = head >> 2, dil = (g == 0) ? 1 : (g == 1 ? 4 : 16), bpr = 32 / dil;
        const int res = blk / bpr, q0 = (blk % bpr) * 256;
        const size_t rowb = (size_t)bl * SEQ;
        __syncthreads();
        for (int c = tid; c < 384 * 8; c += NTHR) { const int row = c >> 3, ch = c & 7; const int ks = q0 - 128 + row;
            u32x4 kv = {0u, 0u, 0u, 0u}, vv = {0u, 0u, 0u, 0u};
            if (ks >= 0) { const bf16* src = P + (rowb + (size_t)ks * dil + res) * NPROJ + head * 64 + ch * 8; kv = *(const u32x4*)(src + PC_DK); vv = *(const u32x4*)(src + PC_DV); }
            *(LAS u32x4*)(sK + row * RST + ch * 16) = kv; *(LAS u32x4*)(sV + row * RST + ch * 16) = vv; }
        const int qs = q0 + wave * 32 + ql;
        const size_t rq = rowb + (size_t)qs * dil + res;
        bf16* qp = P + rq * NPROJ + PC_DQ + head * 64;
        bf16x8 qf[4];
#pragma unroll
        for (int ks = 0; ks < 4; ++ks) qf[ks] = *(const bf16x8*)(qp + 16 * ks + 8 * h);
        __syncthreads();
        f32x16 sacc[5];
        const int kfirst = q0 + wave * 32 - 128;
#pragma unroll
        for (int i = 0; i < 5; ++i) {
#pragma unroll
            for (int e = 0; e < 16; ++e) sacc[i][e] = 0.f;
#pragma unroll
            for (int ks = 0; ks < 4; ++ks) { const bf16x8 kf = *(const LAS bf16x8*)(sK + (32 * wave + 32 * i + ql) * RST + 32 * ks + 16 * h); sacc[i] = MFMA32(kf, qf[ks], sacc[i]); }
        }
        float mx = -3.0e38f;
#pragma unroll
        for (int i = 0; i < 5; ++i)
#pragma unroll
            for (int e = 0; e < 16; ++e) { const int kj = 32 * i + (e & 3) + 8 * (e >> 2) + 4 * h; const bool ok = (kj >= ql) && (kj <= ql + 128) && (kfirst + kj >= 0);
                sacc[i][e] = ok ? sacc[i][e] : -3.0e38f; mx = fmaxf(mx, sacc[i][e]); }
        mx = fmaxf(mx, __shfl_xor(mx, 32));
        const float sc = 0.125f * 1.4426950408889634f;
        float l = 0.f;
        bf16x8 pf[5][2];
#pragma unroll
        for (int i = 0; i < 5; ++i) {
            float p[16];
#pragma unroll
            for (int e = 0; e < 16; ++e) { p[e] = (sacc[i][e] > -1.0e38f) ? __builtin_amdgcn_exp2f((sacc[i][e] - mx) * sc) : 0.f; l += p[e]; }
#pragma unroll
            for (int s2 = 0; s2 < 2; ++s2) { const u32x4 w = {pkbf(p[8 * s2 + 0], p[8 * s2 + 1]), pkbf(p[8 * s2 + 2], p[8 * s2 + 3]), pkbf(p[8 * s2 + 4], p[8 * s2 + 5]), pkbf(p[8 * s2 + 6], p[8 * s2 + 7])};
                pf[i][s2] = __builtin_bit_cast(bf16x8, w); }
        }
        l += __shfl_xor(l, 32);
        const float il = 1.0f / l;
        const int tq = (lane & 15) >> 2, tp = lane & 3, tblk = (lane >> 4) & 1;
        const unsigned vbase = (unsigned)(size_t)(sV) + (unsigned)((32 * wave + 4 * h + tq) * RST + (16 * tblk + 4 * tp) * 2);
#pragma unroll
        for (int dt = 0; dt < 2; ++dt) {
            f32x16 o;
#pragma unroll
            for (int e = 0; e < 16; ++e) o[e] = 0.f;
#pragma unroll
            for (int i = 0; i < 5; ++i) {
                s16x4 lo[2], hi[2];
#pragma unroll
                for (int s2 = 0; s2 < 2; ++s2) { const unsigned a = vbase + (unsigned)((32 * i + 16 * s2) * RST + 64 * dt);
                    asm volatile("ds_read_b64_tr_b16 %0, %1" : "=&v"(lo[s2]) : "v"(a) : "memory");
                    asm volatile("ds_read_b64_tr_b16 %0, %1 offset:1152" : "=&v"(hi[s2]) : "v"(a) : "memory"); }
                asm volatile("s_waitcnt lgkmcnt(0)" ::: "memory"); __builtin_amdgcn_sched_barrier(0);
#pragma unroll
                for (int s2 = 0; s2 < 2; ++s2) { const bf16x8 vf = {lo[s2][0], lo[s2][1], lo[s2][2], lo[s2][3], hi[s2][0], hi[s2][1], hi[s2][2], hi[s2][3]}; o = MFMA32(vf, pf[i][s2], o); }
            }
#pragma unroll
            for (int gq = 0; gq < 4; ++gq) { const u32x2 w = {pkbf(o[4 * gq] * il, o[4 * gq + 1] * il), pkbf(o[4 * gq + 2] * il, o[4 * gq + 3] * il)}; *(u32x2*)(qp + 32 * dt + 8 * gq + 4 * h) = w; }
        }
        if (h == 0) LSE[((size_t)half * HT + rq) * 12 + head] = mx * 0.125f + __logf(l);
    }
}

__device__ __forceinline__ void dilmerge_phase(Frame& F, int half) {
    const bf16* P = (const bf16*)(F.ws + WS_BIG);
    const float* LSE = (const float*)(F.ws + WS_LSE);
    bf16* Y = (bf16*)F.out;
    const size_t gtid = (size_t)F.bid * NTHR + F.tid, gth = (size_t)F.G * NTHR;
    for (size_t it = gtid; it < (size_t)HT * 32; it += gth) {
        const size_t r = it >> 5; const int hh = (int)(it >> 3) & 3, d0 = (int)(it & 7) * 8;
        const size_t tok = (size_t)half * HT + r;
        const float l0 = LSE[tok * 12 + hh], l1 = LSE[tok * 12 + 4 + hh], l2 = LSE[tok * 12 + 8 + hh];
        const float m = fmaxf(l0, fmaxf(l1, l2));
        float w0 = __expf(l0 - m), w1 = __expf(l1 - m), w2 = __expf(l2 - m); const float iw = 1.0f / (w0 + w1 + w2); w0 *= iw; w1 *= iw; w2 *= iw;
        const bf16* op = P + r * NPROJ + PC_DQ + hh * 64 + d0;
        const u32x4 a = *(const u32x4*)op, b = *(const u32x4*)(op + 256), c = *(const u32x4*)(op + 512);
        u32x4 o;
        o.x = pkbf(w0 * bflo(a.x) + w1 * bflo(b.x) + w2 * bflo(c.x), w0 * bfhi(a.x) + w1 * bfhi(b.x) + w2 * bfhi(c.x));
        o.y = pkbf(w0 * bflo(a.y) + w1 * bflo(b.y) + w2 * bflo(c.y), w0 * bfhi(a.y) + w1 * bfhi(b.y) + w2 * bfhi(c.y));
        o.z = pkbf(w0 * bflo(a.z) + w1 * bflo(b.z) + w2 * bflo(c.z), w0 * bfhi(a.z) + w1 * bfhi(b.z) + w2 * bfhi(c.z));
        o.w = pkbf(w0 * bflo(a.w) + w1 * bflo(b.w) + w2 * bflo(c.w), w0 * bfhi(a.w) + w1 * bfhi(b.w) + w2 * bfhi(c.w));
        *(u32x4*)(Y + tok * YC + 1024 + hh * 64 + d0) = o;
    }
}

__device__ __forceinline__ void hn_panel(Frame& F, int pm) {
    for (int m = pm * 256 + F.wave; m < pm * 256 + 256; m += NWAVES) { f32x4 v[4]; rms_row_to_bf16(F.out + (size_t)m * DM, F.in[I_NFFNW], (bf16*)(F.ws + WS_ACT1) + (size_t)m * DM, F.lane, v); }
}
__device__ __forceinline__ void hn_phase(Frame& F) {
    const int gw = F.bid * NWAVES + F.wave, NGW = F.G * NWAVES;
    for (int m = gw; m < T; m += NGW) { f32x4 v[4]; rms_row_to_bf16(F.out + (size_t)m * DM, F.in[I_NFFNW], (bf16*)(F.ws + WS_ACT1) + (size_t)m * DM, F.lane, v); }
}


__device__ __forceinline__ float gelu_erf(float x) { return 0.5f * x * (1.0f + erff(x * 0.70710678118654752f)); }
__device__ __forceinline__ unsigned f2ord(float f) { const unsigned u = __builtin_bit_cast(unsigned, f); return u ^ ((unsigned)((int)u >> 31) | 0x80000000u); }
__device__ __forceinline__ float ord2f(unsigned k) { const unsigned m = (unsigned)((int)k >> 31); return __builtin_bit_cast(float, k ^ (0x80000000u | ~m)); }
#define CMPX(a, b) do { const unsigned _mx = max((a), (b)), _mn = min((a), (b)); (a) = _mx; (b) = _mn; } while (0)
__device__ __forceinline__ void bitonic_sort16_desc(unsigned (&v)[16]) {
#pragma unroll
    for (int k = 2; k <= 16; k <<= 1)
#pragma unroll
        for (int j = k >> 1; j > 0; j >>= 1)
#pragma unroll
            for (int i = 0; i < 16; ++i) { const int l = i ^ j; if (l > i) { if ((i & k) == 0) CMPX(v[i], v[l]); else CMPX(v[l], v[i]); } }
}
__device__ __forceinline__ void bitonic_merge16_desc(unsigned (&v)[16]) {
#pragma unroll
    for (int j = 8; j > 0; j >>= 1)
#pragma unroll
        for (int i = 0; i < 16; ++i) { const int l = i ^ j; if (l > i) CMPX(v[i], v[l]); }
}
__device__ __forceinline__ void top16_merge(unsigned (&a)[16], const unsigned (&b)[16]) {
#pragma unroll
    for (int i = 0; i < 16; ++i) a[i] = max(a[i], b[15 - i]);
    bitonic_merge16_desc(a);
}
constexpr int PK_ST = 272;
__device__ __forceinline__ void peer_topk_tile(Frame& F, size_t tok0, const bf16* Q, int* IDX, float* GATE) {
    const bf16* SK = (const bf16*)(F.ws + WS_SUBK);
    LAS unsigned char* sK = F.lds;
    int tid = F.tid; asm volatile("" : "+v"(tid));
    const int lane = tid & 63, wave = F.wave, ql = lane & 31, hh = lane >> 5;
    const size_t tok = tok0 + wave * 32 + ql;
    const bf16* qrow = Q + tok * PEER_Q + 8 * hh;
    __syncthreads();
#pragma unroll
    for (int j = 0; j < 4; ++j) { const int cidx = tid + 512 * j, row = cidx >> 4, ch = cidx & 15; *(LAS u32x4*)(sK + row * PK_ST + ch * 16) = *(const u32x4*)(SK + (size_t)row * 128 + ch * 8); }
    __syncthreads();
    unsigned k1[16];
#pragma unroll 1
    for (int hc = 0; hc < 16; ++hc) {
        LAS unsigned char* cur = sK + (hc & 1) * (128 * PK_ST); LAS unsigned char* nxt = sK + ((hc + 1) & 1) * (128 * PK_ST);
        u32x4 stg[4];
        const int hcn = (hc + 1) & 15;
#pragma unroll
        for (int j = 0; j < 4; ++j) { const int cidx = tid + 512 * j, row = cidx >> 4, ch = cidx & 15; stg[j] = *(const u32x4*)(SK + ((size_t)hcn * 128 + row) * 128 + ch * 8); }
        bf16x8 qf[8];
#pragma unroll
        for (int ks = 0; ks < 8; ++ks) qf[ks] = *(const bf16x8*)(qrow + hc * 128 + 16 * ks);
        unsigned pk[4][16];
#pragma unroll
        for (int mt = 0; mt < 4; ++mt) {
            f32x16 acc;
#pragma unroll
            for (int e = 0; e < 16; ++e) acc[e] = 0.f;
#pragma unroll
            for (int ks = 0; ks < 8; ++ks) { const bf16x8 kf = *(const LAS bf16x8*)(cur + (32 * mt + ql) * PK_ST + 32 * ks + 16 * hh); acc = MFMA32(kf, qf[ks], acc); }
#pragma unroll
            for (int e = 0; e < 16; ++e) pk[mt][e] = (f2ord(acc[e]) & 0xFFFFFF80u) | (unsigned)(32 * mt + (e & 3) + 8 * (e >> 2) + 4 * hh);
        }
#pragma unroll
        for (int j = 0; j < 4; ++j) { const int cidx = tid + 512 * j, row = cidx >> 4, ch = cidx & 15; *(LAS u32x4*)(nxt + row * PK_ST + ch * 16) = stg[j]; }
        __syncthreads();
#pragma unroll
        for (int mt = 0; mt < 4; ++mt) bitonic_sort16_desc(pk[mt]);
        top16_merge(pk[0], pk[1]); top16_merge(pk[2], pk[3]); top16_merge(pk[0], pk[2]);
        unsigned other[16];
#pragma unroll
        for (int i = 0; i < 16; ++i) other[i] = (unsigned)__shfl_xor((int)pk[0][i], 32);
        top16_merge(pk[0], other);
        if ((hc & 1) == 0) {
#pragma unroll
            for (int i = 0; i < 16; ++i) k1[i] = pk[0][i];
        } else {
            float f1[16], f2[16];
#pragma unroll
            for (int i = 0; i < 16; ++i) { f1[i] = ord2f(k1[i] & 0xFFFFFF80u); f2[i] = ord2f(pk[0][i] & 0xFFFFFF80u); }
            unsigned cd[4][16];
#pragma unroll
            for (int i = 0; i < 64; ++i) cd[i >> 4][i & 15] = 0u;
            int n = 0;
#pragma unroll
            for (int a = 0; a < 16; ++a)
#pragma unroll
                for (int b = 0; b < 16; ++b)
                    if ((a + 1) * (b + 1) <= 16) { cd[n >> 4][n & 15] = (f2ord(f1[a] + f2[b]) & 0xFFFFC000u) | ((k1[a] & 127u) << 7) | (pk[0][b] & 127u); ++n; }
#pragma unroll
            for (int g4 = 0; g4 < 4; ++g4) bitonic_sort16_desc(cd[g4]);
            top16_merge(cd[0], cd[1]); top16_merge(cd[2], cd[3]); top16_merge(cd[0], cd[2]);
            const float vmax = ord2f(cd[0][0] & 0xFFFFC000u);
            float ex[16], den = 0.f;
#pragma unroll
            for (int i = 0; i < 16; ++i) { ex[i] = __expf(ord2f(cd[0][i] & 0xFFFFC000u) - vmax); den += ex[i]; }
            const float iden = 1.0f / den;
            const int h = hc >> 1;
            if (hh == 0) { int* ip = IDX + tok * 128 + h * 16;
#pragma unroll
                for (int i = 0; i < 4; ++i) { const u32x4 w = {cd[0][4 * i] & 0x3FFFu, cd[0][4 * i + 1] & 0x3FFFu, cd[0][4 * i + 2] & 0x3FFFu, cd[0][4 * i + 3] & 0x3FFFu}; *(u32x4*)(ip + 4 * i) = w; } }
            else { float* gp = GATE + tok * 128 + h * 16;
#pragma unroll
                for (int i = 0; i < 4; ++i) { const f32x4 w = {ex[4 * i] * iden, ex[4 * i + 1] * iden, ex[4 * i + 2] * iden, ex[4 * i + 3] * iden}; *(f32x4*)(gp + 4 * i) = w; } }
        }
    }
}

struct PeerDeal { size_t tokw; int ntok; size_t tok0; float* PART; const int* IDX; const float* GATE; float* COEF; };
__device__ __forceinline__ void peer_item(int n, const PeerDeal& D, int wave, int& slice, size_t& tok) { slice = n >> 5; tok = D.tokw + (n & 31); }
__device__ __forceinline__ void peer_down_rows(u32x4 (&R)[16], __amdgpu_buffer_rsrc_t tab, int slice, int id0, int id1, int lane) {
    const int soff = slice * (16384 * 128);
    const int r = lane & 15, g = lane >> 4, e8 = (r >> 2) + 4 * (g >> 1), q = 4 * (g & 1) + (r & 3);
    const int src0 = 16 * (e8 & 3);
#pragma unroll
    for (int k = 0; k < 16; ++k) { const int v0 = __shfl(id0, src0 + k), v1 = __shfl(id1, src0 + k); const int id = (e8 < 4) ? v0 : v1;
        R[k] = __builtin_amdgcn_raw_buffer_load_b128(tab, (id << 7) + 16 * q, soff, 0); }
}
__device__ __forceinline__ void peer_down_hn(u32x4 (&H)[2], const bf16* HN, int slice, size_t tok, int lane) {
    const bf16* hp = HN + tok * DM + slice * 128 + 16 * (4 * ((lane >> 4) & 1) + (lane & 3));
    H[0] = *(const u32x4*)hp; H[1] = *(const u32x4*)(hp + 8);
}
__device__ __forceinline__ void peer_down_bq(long (&bq)[2], const u32x4 (&H)[2], int lane) {
    const int c = lane & 15, g = lane >> 4; const bool on = (c < 8) && ((c >> 2) == (g >> 1));
    const u32x4 x0 = H[0], x1 = H[1];
    unsigned p0 = __builtin_amdgcn_cvt_pk_fp8_f32(bflo(x0.x), bfhi(x0.x), 0, false); p0 = __builtin_amdgcn_cvt_pk_fp8_f32(bflo(x0.y), bfhi(x0.y), p0, true);
    unsigned p1 = __builtin_amdgcn_cvt_pk_fp8_f32(bflo(x0.z), bfhi(x0.z), 0, false); p1 = __builtin_amdgcn_cvt_pk_fp8_f32(bflo(x0.w), bfhi(x0.w), p1, true);
    unsigned p2 = __builtin_amdgcn_cvt_pk_fp8_f32(bflo(x1.x), bfhi(x1.x), 0, false); p2 = __builtin_amdgcn_cvt_pk_fp8_f32(bflo(x1.y), bfhi(x1.y), p2, true);
    unsigned p3 = __builtin_amdgcn_cvt_pk_fp8_f32(bflo(x1.z), bfhi(x1.z), 0, false); p3 = __builtin_amdgcn_cvt_pk_fp8_f32(bflo(x1.w), bfhi(x1.w), p3, true);
    if (!on) { p0 = 0u; p1 = 0u; p2 = 0u; p3 = 0u; }
    bq[0] = (long)(((unsigned long long)p1 << 32) | p0); bq[1] = (long)(((unsigned long long)p3 << 32) | p2);
}
__device__ __forceinline__ void peer_down_mfma(const u32x4 (&R)[16], const long (&bq)[2], __amdgpu_buffer_rsrc_t prsrc, int slice, int tokl, int lane) {
    const int c = lane & 15, g = lane >> 4, cb = c & 3;
    float dv[16];
#pragma unroll
    for (int k = 0; k < 16; ++k) { f32x4 acc = {0.f, 0.f, 0.f, 0.f}; const u32x4 v = R[k];
        acc = __builtin_amdgcn_mfma_f32_16x16x32_fp8_fp8((long)(((unsigned long long)v.y << 32) | v.x), bq[0], acc, 0, 0, 0);
        acc = __builtin_amdgcn_mfma_f32_16x16x32_fp8_fp8((long)(((unsigned long long)v.w << 32) | v.z), bq[1], acc, 0, 0, 0);
        float t = (cb == 0) ? acc.x : (cb == 1) ? acc.y : (cb == 2) ? acc.z : acc.w;
        t += __shfl_xor(t, 1); t += __shfl_xor(t, 2); dv[k] = t; }
    const unsigned off = ((c & 3) == 0 && c < 8) ? (unsigned)(((tokl * 8 + slice) * 128 + 16 * (g + 4 * (c >> 2))) * 4) : 0xFFFFFF00u;
#pragma unroll
    for (int i = 0; i < 4; ++i) { const f32x4 w = {dv[4 * i], dv[4 * i + 1], dv[4 * i + 2], dv[4 * i + 3]}; __builtin_amdgcn_raw_buffer_store_b128(__builtin_bit_cast(u32x4, w), prsrc, off, 16 * i, 0); }
}
__device__ __forceinline__ void peer_down_phase(Frame& F, const PeerDeal& D) {
    const __amdgpu_buffer_rsrc_t PD = __builtin_amdgcn_make_buffer_rsrc((void*)(F.ws + WS_PD), 0, 16384 * 1024, 0x00020000); const bf16* HN = (const bf16*)(F.ws + WS_ACT1);
    const int* IDX = D.IDX;
    const __amdgpu_buffer_rsrc_t prsrc = __builtin_amdgcn_make_buffer_rsrc((void*)D.PART, 0, 256 * 8 * 128 * 4, 0x00020000);
    int lane = F.lane; asm volatile("" : "+v"(lane));
    const int wave = F.wave;
    const int ntok = D.ntok;
    u32x4 RA[16], RB[16], HA[2], HB[2]; int ia0, ia1, ib0, ib1; long bq[2];
#define PEER_TOK(k, sv, tv) int sv; size_t tv; peer_item((k) < ntok ? (k) : ntok - 2 + ((k) & 1), D, wave, sv, tv)
    { PEER_TOK(0, s0, t0); PEER_TOK(1, s1, t1); PEER_TOK(2, s2, t2); PEER_TOK(3, s3, t3);
      const int a0 = IDX[t0 * 128 + lane], a1 = IDX[t0 * 128 + 64 + lane], b0 = IDX[t1 * 128 + lane], b1 = IDX[t1 * 128 + 64 + lane];
      ia0 = IDX[t2 * 128 + lane]; ia1 = IDX[t2 * 128 + 64 + lane]; ib0 = IDX[t3 * 128 + lane]; ib1 = IDX[t3 * 128 + 64 + lane];
      __builtin_amdgcn_sched_barrier(0);
      peer_down_rows(RA, PD, s0, a0, a1, lane); peer_down_hn(HA, HN, s0, t0, lane);
      __builtin_amdgcn_sched_barrier(0);
      peer_down_rows(RB, PD, s1, b0, b1, lane); peer_down_hn(HB, HN, s1, t1, lane);
      __builtin_amdgcn_sched_barrier(0); }
#pragma unroll 1
    for (int n = 0; n < ntok; n += 2) {
        PEER_TOK(n, s0, t0); PEER_TOK(n + 1, s1, t1); PEER_TOK(n + 2, s2, t2); PEER_TOK(n + 3, s3, t3); PEER_TOK(n + 4, s4, t4); PEER_TOK(n + 5, s5, t5);
        peer_down_bq(bq, HA, lane);
        peer_down_mfma(RA, bq, prsrc, s0, (int)(t0 - D.tok0), lane);
        __builtin_amdgcn_sched_barrier(0);
        { const int j0 = IDX[t4 * 128 + lane], j1 = IDX[t4 * 128 + 64 + lane];
          peer_down_rows(RA, PD, s2, ia0, ia1, lane); peer_down_hn(HA, HN, s2, t2, lane); ia0 = j0; ia1 = j1; }
        __builtin_amdgcn_sched_barrier(0);
        peer_down_bq(bq, HB, lane);
        peer_down_mfma(RB, bq, prsrc, s1, (int)(t1 - D.tok0), lane);
        __builtin_amdgcn_sched_barrier(0);
        { const int j0 = IDX[t5 * 128 + lane], j1 = IDX[t5 * 128 + 64 + lane];
          peer_down_rows(RB, PD, s3, ib0, ib1, lane); peer_down_hn(HB, HN, s3, t3, lane); ib0 = j0; ib1 = j1; }
        __builtin_amdgcn_sched_barrier(0);
    }
#undef PEER_TOK
}
__device__ __forceinline__ void peer_coef_wave(Frame& F, const PeerDeal& D) {
    for (int k = F.lane; k < 32 * 32; k += 64) {
        const int tl = (int)(D.tokw - D.tok0) + (k >> 5), slot = 4 * (k & 31);
        const float* pp = D.PART + (size_t)tl * 1024 + slot;
        f32x4 sm = *(const f32x4*)pp;
#pragma unroll
        for (int x = 1; x < 8; ++x) sm += *(const f32x4*)(pp + 128 * x);
        const size_t i = (D.tok0 + tl) * 128 + slot;
        const f32x4 gt = *(const f32x4*)(D.GATE + i);
        const f32x4 o = {gt.x * gelu_erf(sm.x * (1.0f / PD_SCALE)) * (1.0f / PU_SCALE), gt.y * gelu_erf(sm.y * (1.0f / PD_SCALE)) * (1.0f / PU_SCALE),
                         gt.z * gelu_erf(sm.z * (1.0f / PD_SCALE)) * (1.0f / PU_SCALE), gt.w * gelu_erf(sm.w * (1.0f / PD_SCALE)) * (1.0f / PU_SCALE)};
        *(f32x4*)(D.COEF + i) = o;
    }
}
__device__ __forceinline__ void peer_up_rows(u32x4 (&R)[16], __amdgpu_buffer_rsrc_t tab, int slice, int id0, int id1, int lane) {
    const int soff = slice * (16384 * 128);
#pragma unroll
    for (int s8 = 0; s8 < 8; ++s8) { const int id = __shfl(s8 < 4 ? id0 : id1, (16 * s8 + (lane >> 2)) & 63); const int vo = (id << 7) + 16 * (lane & 3);
        R[2 * s8] = __builtin_amdgcn_raw_buffer_load_b128(tab, vo, soff, 0); R[2 * s8 + 1] = __builtin_amdgcn_raw_buffer_load_b128(tab, vo, soff + 64, 0); }
}
__device__ __forceinline__ void peer_up_compute(const u32x4 (&R)[16], float c0, float c1, f32x2 h, float* out, int slice, size_t tok, int lane) {
    f32x2 acc[16];
#pragma unroll
    for (int k = 0; k < 16; ++k) acc[k] = (f32x2){0.f, 0.f};
#pragma unroll
    for (int s8 = 0; s8 < 8; ++s8) { const float c = __shfl(s8 < 4 ? c0 : c1, (16 * s8 + (lane >> 2)) & 63); f32x2 c2 = {c, c}; asm volatile("" : "+v"(c2));
#pragma unroll
        for (int hf = 0; hf < 2; ++hf) { const u32x4 r = R[2 * s8 + hf];
            acc[8 * hf + 0] = c2 * __builtin_amdgcn_cvt_pk_f32_fp8(r.x, false) + acc[8 * hf + 0]; acc[8 * hf + 1] = c2 * __builtin_amdgcn_cvt_pk_f32_fp8(r.x, true) + acc[8 * hf + 1];
            acc[8 * hf + 2] = c2 * __builtin_amdgcn_cvt_pk_f32_fp8(r.y, false) + acc[8 * hf + 2]; acc[8 * hf + 3] = c2 * __builtin_amdgcn_cvt_pk_f32_fp8(r.y, true) + acc[8 * hf + 3];
            acc[8 * hf + 4] = c2 * __builtin_amdgcn_cvt_pk_f32_fp8(r.z, false) + acc[8 * hf + 4]; acc[8 * hf + 5] = c2 * __builtin_amdgcn_cvt_pk_f32_fp8(r.z, true) + acc[8 * hf + 5];
            acc[8 * hf + 6] = c2 * __builtin_amdgcn_cvt_pk_f32_fp8(r.w, false) + acc[8 * hf + 6]; acc[8 * hf + 7] = c2 * __builtin_amdgcn_cvt_pk_f32_fp8(r.w, true) + acc[8 * hf + 7]; } }
    f32x2 r8[8], r4[4], r2[2], r1;
    { const bool up = (lane & 32) != 0;
#pragma unroll
      for (int k = 0; k < 8; ++k) { const f32x2 keep = up ? acc[k + 8] : acc[k], send = up ? acc[k] : acc[k + 8]; r8[k] = keep + (f32x2){__shfl_xor(send.x, 32), __shfl_xor(send.y, 32)}; } }
    { const bool up = (lane & 16) != 0;
#pragma unroll
      for (int k = 0; k < 4; ++k) { const f32x2 keep = up ? r8[k + 4] : r8[k], send = up ? r8[k] : r8[k + 4]; r4[k] = keep + (f32x2){__shfl_xor(send.x, 16), __shfl_xor(send.y, 16)}; } }
    { const bool up = (lane & 8) != 0;
#pragma unroll
      for (int k = 0; k < 2; ++k) { const f32x2 keep = up ? r4[k + 2] : r4[k], send = up ? r4[k] : r4[k + 2]; r2[k] = keep + (f32x2){__shfl_xor(send.x, 8), __shfl_xor(send.y, 8)}; } }
    { const bool up = (lane & 4) != 0; const f32x2 keep = up ? r2[1] : r2[0], send = up ? r2[0] : r2[1]; r1 = keep + (f32x2){__shfl_xor(send.x, 4), __shfl_xor(send.y, 4)}; }
    const int p = ((lane >> 5) & 1) * 8 + ((lane >> 4) & 1) * 4 + ((lane >> 3) & 1) * 2 + ((lane >> 2) & 1);
    *(f32x2*)(out + tok * DM + slice * 128 + 16 * (lane & 3) + 2 * (p & 7) + 64 * (p >> 3)) = h + r1;
}
__device__ __forceinline__ void peer_up_phase(Frame& F, const PeerDeal& D, float* outp) {
    const __amdgpu_buffer_rsrc_t PU = __builtin_amdgcn_make_buffer_rsrc((void*)(F.ws + WS_PU), 0, 16384 * 1024, 0x00020000);
    const int* IDX = D.IDX; const float* COEF = D.COEF;
    int lane = F.lane; asm volatile("" : "+v"(lane));
    const int wave = F.wave;
    const int ntok = D.ntok;
    const int p = ((lane >> 5) & 1) * 8 + ((lane >> 4) & 1) * 4 + ((lane >> 3) & 1) * 2 + ((lane >> 2) & 1);
    const int hoff = 16 * (lane & 3) + 2 * (p & 7) + 64 * (p >> 3);
    int sl; size_t tk;
    u32x4 R0[16], R1[16];
    float ca0, ca1, cb0, cb1; f32x2 ha, hb;
    int id0, id1, jd0, jd1;
    { int s1_; size_t t1_; peer_item(0, D, wave, sl, tk); peer_item(1, D, wave, s1_, t1_);
      jd0 = IDX[tk * 128 + lane]; jd1 = IDX[tk * 128 + 64 + lane]; id0 = IDX[t1_ * 128 + lane]; id1 = IDX[t1_ * 128 + 64 + lane];
      __builtin_amdgcn_sched_barrier(0);
      peer_up_rows(R0, PU, sl, jd0, jd1, lane);
      ca0 = COEF[tk * 128 + lane]; ca1 = COEF[tk * 128 + 64 + lane]; ha = *(const f32x2*)(F.out + tk * DM + sl * 128 + hoff);
      __builtin_amdgcn_sched_barrier(0); }
#pragma unroll 1
    for (int n = 0; n < ntok; n += 2) {
        int s0, s1, s2, s3; size_t t0, t1, t2, t3;
        peer_item(n, D, wave, s0, t0); peer_item(n + 1, D, wave, s1, t1);
        peer_item(n + 2 < ntok ? n + 2 : n, D, wave, s2, t2); peer_item(n + 3 < ntok ? n + 3 : n + 1, D, wave, s3, t3);
        jd0 = IDX[t2 * 128 + lane]; jd1 = IDX[t2 * 128 + 64 + lane];
        peer_up_rows(R1, PU, s1, id0, id1, lane);
        cb0 = COEF[t1 * 128 + lane]; cb1 = COEF[t1 * 128 + 64 + lane]; hb = *(const f32x2*)(F.out + t1 * DM + s1 * 128 + hoff);
        __builtin_amdgcn_sched_barrier(0);
        peer_up_compute(R0, ca0, ca1, ha, outp, s0, t0, lane);
        __builtin_amdgcn_sched_barrier(0);
        id0 = IDX[t3 * 128 + lane]; id1 = IDX[t3 * 128 + 64 + lane];
        peer_up_rows(R0, PU, s2, jd0, jd1, lane);
        ca0 = COEF[t2 * 128 + lane]; ca1 = COEF[t2 * 128 + 64 + lane]; ha = *(const f32x2*)(F.out + t2 * DM + s2 * 128 + hoff);
        __builtin_amdgcn_sched_barrier(0);
        peer_up_compute(R1, cb0, cb1, hb, outp, s1, t1, lane);
        __builtin_amdgcn_sched_barrier(0);
    }
}
__device__ __forceinline__ void peer_tile(Frame& F, int tile) {
    const size_t tok0 = (size_t)tile * 256;
    const bf16* Q = (const bf16*)(F.ws + WS_BIG);
    int* IDX = (int*)(F.ws + WS_BIG + 256 * MiB); float* GATE = (float*)(F.ws + WS_BIG + 288 * MiB); float* COEF = (float*)(F.ws + WS_BIG + 320 * MiB);
    peer_topk_tile(F, tok0, Q, IDX, GATE);
    VM_WAIT(); __syncthreads();
    PeerDeal D; D.tokw = tok0 + F.wave * 32; D.ntok = 256; D.tok0 = tok0; D.PART = (float*)(F.ws + WS_BIG + tok0 * (PEER_Q * 2)); D.IDX = IDX; D.GATE = GATE; D.COEF = COEF;
    peer_down_phase(F, D);
    VM_WAIT(); __syncthreads();
    peer_coef_wave(F, D);
    VM_WAIT(); __syncthreads();
    peer_up_phase(F, D, F.out);
}
__device__ __forceinline__ void peer_phase(Frame& F) { for (int tile = F.bid; tile < T / 256; tile += F.G) { peer_tile(F, tile); VM_WAIT(); __syncthreads(); } }

constexpr int N_PHASES = 15;
__global__ void __launch_bounds__(NTHR, 2) mega_fwd(Args args) {
    extern __shared__ __attribute__((aligned(16))) unsigned char lds_raw[];
    Frame F;
    F.lds = (LAS unsigned char*)lds_raw;
    F.tid = threadIdx.x; F.lane = F.tid & 63; F.wave = __builtin_amdgcn_readfirstlane(F.tid >> 6);
    F.G = gridDim.x; F.bid = blockIdx.x;
    F.in = args.in;
    F.positions = args.positions; F.out = args.out; F.ws = args.ws;
    unsigned char* ws = args.ws;
    volatile LAS unsigned* ctlw = (volatile LAS unsigned*)(F.lds + LDSCTL_OFF);
    if (F.tid < 64) ctlw[F.tid] = 0u;
    __syncthreads();
    const int lo = args.ph_lo, hi = args.ph_hi;
    XcdBarrier bar; bar.bar = (unsigned*)(ws + WS_CTL); bar.x = 0; bar.st = nullptr; bar.wave = F.wave;
    if (hi - lo > 1) bar = xcd_barrier_post((unsigned*)(ws + WS_CTL), ctlw + 8, F.wave);
#define IN(k) (lo <= (k) && (k) < hi)
#define SEAM(k) do { if (IN(k) && IN((k) + 1)) xcd_barrier(bar); } while (0)
    bf16* ACT1 = (bf16*)(ws + WS_ACT1); bf16* BIG = (bf16*)(ws + WS_BIG); bf16* WallT = (bf16*)(ws + WS_WALLT);

    if (IN(0)) { frame_refresh(F); p0_prologue(F); __syncthreads(); if (PROBE & 1) { p0_prologue(F); __syncthreads(); } }
    SEAM(0);
    if (IN(1)) { frame_refresh(F); { {
        { pg8::Gemm g{(const bf16*)(ws + WS_MEMN), (const bf16*)(ws + WS_WMKVT), NB * NMEM, 768, DM, DM, DM}; pg8::StaticOrder S; S.init(g.M, g.N, F.G, F.bid);
          pg8::EpiBf16<0> E{(bf16*)(ws + WS_MKV), 1536}; pg8::gemm_phase(F.lds, g, S, E, F.wave); }
        { pg8::Gemm g{(const bf16*)(ws + WS_WMKVT) + (size_t)768 * DM, (const bf16*)(ws + WS_MEMN), 768, NB * NMEM, DM, DM, DM}; pg8::StaticOrder S; S.init(g.M, g.N, F.G, F.G - 1 - F.bid);
          pg8::EpiBf16<0> E{(bf16*)(ws + WS_MVT), NB * NMEM}; pg8::gemm_phase(F.lds, g, S, E, F.wave); }
        { pg8::Gemm g{ACT1, WallT, HT, NPROJ, DM, DM, DM}; pg8::StaticOrder S; S.init(g.M, g.N, F.G, F.bid);
          pg8::EpiBf16<0> E{BIG, NPROJ}; pg8::gemm_phase(F.lds, g, S, E, F.wave); }
    } }
      if (PROBE & 2) { {
        { pg8::Gemm g{(const bf16*)(ws + WS_MEMN), (const bf16*)(ws + WS_WMKVT), NB * NMEM, 768, DM, DM, DM}; pg8::StaticOrder S; S.init(g.M, g.N, F.G, F.bid);
          pg8::EpiBf16<0> E{(bf16*)(ws + WS_MKV), 1536}; pg8::gemm_phase(F.lds, g, S, E, F.wave); }
        { pg8::Gemm g{(const bf16*)(ws + WS_WMKVT) + (size_t)768 * DM, (const bf16*)(ws + WS_MEMN), 768, NB * NMEM, DM, DM, DM}; pg8::StaticOrder S; S.init(g.M, g.N, F.G, F.G - 1 - F.bid);
          pg8::EpiBf16<0> E{(bf16*)(ws + WS_MVT), NB * NMEM}; pg8::gemm_phase(F.lds, g, S, E, F.wave); }
        { pg8::Gemm g{ACT1, WallT, HT, NPROJ, DM, DM, DM}; pg8::StaticOrder S; S.init(g.M, g.N, F.G, F.bid);
          pg8::EpiBf16<0> E{BIG, NPROJ}; pg8::gemm_phase(F.lds, g, S, E, F.wave); }
    } } }
    SEAM(1);
    if (IN(2)) { frame_refresh(F); qkprep_phase(F, 0); ssdC_phase(F, 0); if (PROBE & 4) ssdC_phase(F, 0); }
    SEAM(2);
    if (IN(3)) { frame_refresh(F); ssdD_phase(F); dilattn_mfma_phase(F, 0); memattn_mfma_phase(F, 0); if (PROBE & 64) { ssdD_phase(F); memattn_mfma_phase(F, 0); } }
    SEAM(3);
    if (IN(4)) { frame_refresh(F); ssdE_phase(F, 0); dilmerge_phase(F, 0); if (PROBE & 32) { ssdE_phase(F, 0); dilmerge_phase(F, 0); } }
    SEAM(4);
    if (IN(5)) { frame_refresh(F); { { pg8::Gemm g{ACT1 + (size_t)HT * DM, WallT, HT, NPROJ, DM, DM, DM}; pg8::StaticOrder S; S.init(g.M, g.N, F.G, F.bid);
        pg8::EpiBf16<0> E{BIG, NPROJ}; pg8::gemm_phase(F.lds, g, S, E, F.wave); } }
      if (PROBE & 2) { { pg8::Gemm g{ACT1 + (size_t)HT * DM, WallT, HT, NPROJ, DM, DM, DM}; pg8::StaticOrder S; S.init(g.M, g.N, F.G, F.bid);
        pg8::EpiBf16<0> E{BIG, NPROJ}; pg8::gemm_phase(F.lds, g, S, E, F.wave); } } }
    SEAM(5);
    if (IN(6)) { frame_refresh(F); qkprep_phase(F, 1); ssdC_phase(F, 1); if (PROBE & 4) ssdC_phase(F, 1); }
    SEAM(6);
    if (IN(7)) { frame_refresh(F); ssdD_phase(F); dilattn_mfma_phase(F, 1); memattn_mfma_phase(F, 1); if (PROBE & 64) { ssdD_phase(F); memattn_mfma_phase(F, 1); } }
    SEAM(7);
    if (IN(8)) { frame_refresh(F); ssdE_phase(F, 1); dilmerge_phase(F, 1); if (PROBE & 32) { ssdE_phase(F, 1); dilmerge_phase(F, 1); } }
    SEAM(8);
    if (IN(9)) { frame_refresh(F); { { pg8::Gemm g{ACT1, WallT + (size_t)NPROJ * DM, T, NGATE, DM, DM, DM}; pg8::StaticOrder S; S.init(g.M, g.N, F.G, F.bid);
        pg8::EpiBf16<1> E{BIG, NGATE}; pg8::gemm_phase(F.lds, g, S, E, F.wave); } }
      if (PROBE & 2) { { pg8::Gemm g{ACT1, WallT + (size_t)NPROJ * DM, T, NGATE, DM, DM, DM}; pg8::StaticOrder S; S.init(g.M, g.N, F.G, F.bid);
        pg8::EpiBf16<1> E{BIG, NGATE}; pg8::gemm_phase(F.lds, g, S, E, F.wave); } } }
    SEAM(9);
    if (IN(10)) { frame_refresh(F);
        pg8::Gemm g{(const bf16*)F.out, (const bf16*)(ws + WS_WCATT), T, DM, YC, YC, YC}; pg8::StaticOrder S; S.init(g.M, g.N, F.G, F.bid);
        pg8::EpiBranchFused E{ACT1, DM, __builtin_amdgcn_make_buffer_rsrc((void*)BIG, 0, T * NGATE * 2, 0x00020000), NGATE}; pg8::gemm_phase(F.lds, g, S, E, F.wave);
    }
    SEAM(10);
    if (IN(11)) { frame_refresh(F); { { pg8::Gemm g{ACT1, (const bf16*)(ws + WS_WOUTT), T, DM, DM, DM, DM}; pg8::StaticOrder S; S.init(g.M, g.N, F.G, F.bid);
        pg8::EpiResid E{F.out, DM, F.in[I_X]}; pg8::gemm_phase(F.lds, g, S, E, F.wave); } }
      if (PROBE & 2) { { pg8::Gemm g{ACT1, (const bf16*)(ws + WS_WOUTT), T, DM, DM, DM, DM}; pg8::StaticOrder S; S.init(g.M, g.N, F.G, F.bid);
        pg8::EpiResid E{F.out, DM, F.in[I_X]}; pg8::gemm_phase(F.lds, g, S, E, F.wave); } } }
    SEAM(11);
    if (IN(12)) { frame_refresh(F); { hn_phase(F); }
      if (PROBE & 2) { hn_phase(F); } }
    SEAM(12);
    if (IN(13)) { frame_refresh(F); { { pg8::Gemm g{ACT1, (const bf16*)(ws + WS_WQT), T, PEER_Q, DM, DM, DM}; pg8::StaticOrder S; S.init(g.M, g.N, F.G, F.bid);
        pg8::EpiBf16<0> E{BIG, PEER_Q}; pg8::gemm_phase(F.lds, g, S, E, F.wave); } }
      if (PROBE & 2) { { pg8::Gemm g{ACT1, (const bf16*)(ws + WS_WQT), T, PEER_Q, DM, DM, DM}; pg8::StaticOrder S; S.init(g.M, g.N, F.G, F.bid);
        pg8::EpiBf16<0> E{BIG, PEER_Q}; pg8::gemm_phase(F.lds, g, S, E, F.wave); } } }
    SEAM(13);
    if (IN(14)) { frame_refresh(F); peer_phase(F); }
#undef IN
#undef SEAM
}

extern "C" void kernel_launch(void* const* d_in, const int* in_sizes, int n_in, void* d_out, int out_size, void* d_ws, size_t ws_size, hipStream_t stream) {
    static int grid = 0;
    if (grid == 0) {
        if (n_in != 26 || out_size != T * DM || ws_size < WS_END) { fprintf(stderr, "kernel_launch: unexpected shapes (n_in %d, out %d, ws %zu)\n", n_in, out_size, ws_size); grid = -1; return; }
        int dev = 0, cus = 0;
        if (hipGetDevice(&dev) != hipSuccess || hipDeviceGetAttribute(&cus, hipDeviceAttributeMultiprocessorCount, dev) != hipSuccess) { grid = -1; return; }
        if (hipFuncSetAttribute((const void*)mega_fwd, hipFuncAttributeMaxDynamicSharedMemorySize, LDS_BYTES) != hipSuccess) { grid = -1; return; }
        int per_cu = 0;
        (void)hipOccupancyMaxActiveBlocksPerMultiprocessor(&per_cu, (const void*)mega_fwd, NTHR, LDS_BYTES);
        (void)hipGetLastError();
        grid = cus;
    }
    if (grid < 0) return;
    (void)hipMemsetAsync((char*)d_ws + WS_CTL, 0, CTL_ZERO_BYTES, stream);
    Args a{};
    for (int i = 0; i < 26; ++i) a.in[i] = (const float*)d_in[i];
    a.positions = (const int*)d_in[2]; a.out = (float*)d_out; a.ws = (unsigned char*)d_ws;
#if MK_N_LAUNCHES == 1
    a.ph_lo = 0; a.ph_hi = N_PHASES;
    hipLaunchKernelGGL(mega_fwd, dim3(grid), dim3(NTHR), LDS_BYTES, stream, a);
#else
    for (int p = 0; p < N_PHASES; ++p) { a.ph_lo = p; a.ph_hi = p + 1; hipLaunchKernelGGL(mega_fwd, dim3(grid), dim3(NTHR), LDS_BYTES, stream, a); }
#endif
}
```

```cpp
#include <hip/hip_runtime.h>
#include <cstdio>
#include <cstdint>

#ifndef MK_N_LAUNCHES
#define MK_N_LAUNCHES 1
#endif

#define LAS __attribute__((address_space(3)))
#define GAS __attribute__((address_space(1)))
typedef unsigned short bf16;
typedef short bf16x8 __attribute__((ext_vector_type(8)));
typedef float f32x4 __attribute__((ext_vector_type(4)));
typedef float f32x2 __attribute__((ext_vector_type(2)));
typedef unsigned u32x4 __attribute__((ext_vector_type(4)));
typedef unsigned u32x2 __attribute__((ext_vector_type(2)));

constexpr int NB = 8, SEQ = 8192, DM = 1024, T = NB * SEQ;
constexpr int HB = 4, HT = HB * SEQ;
constexpr int NMEM = 256;
constexpr int NPROJ = 6144;
constexpr int PC_Z = 0, PC_X = 1024, PC_B = 2048, PC_C = 2560, PC_DQ = 3072, PC_DK = 3840, PC_DV = 4608, PC_MQ = 5376;
constexpr int W_IN_N = 9232, OFF_DT = 3072, OFF_AFTER_DT = 3088;
constexpr int NGATE = 3072;
constexpr int YC = 2048;
constexpr int PEER_H = 8, PEER_K = 16, PEER_NK = 128, PEER_Q = 2048;
constexpr float EPS = 1e-6f;

constexpr size_t MiB = 1u << 20;
constexpr size_t WS_CTL = 0, CTL_ZERO_BYTES = 65536;
constexpr size_t WS_WALLT = 1 * MiB;
constexpr size_t WS_WMKVT = 19 * MiB;
constexpr size_t WS_WCATT = 22 * MiB;
constexpr size_t WS_WOUTT = 26 * MiB;
constexpr size_t WS_WQT = 28 * MiB;
constexpr size_t WS_SUBK = 32 * MiB;
constexpr size_t WS_PD = 33 * MiB;
constexpr size_t WS_PU = 65 * MiB;
constexpr size_t WS_DT = 97 * MiB;
constexpr size_t WS_MEMN = 101 * MiB;
constexpr size_t WS_MKV = 105 * MiB;
constexpr size_t WS_ACT1 = 112 * MiB;
constexpr size_t WS_BIG = 240 * MiB;
constexpr size_t WS_LSE = 624 * MiB;
constexpr size_t WS_MVT = 628 * MiB;
constexpr size_t WS_DEC = 631 * MiB;
constexpr size_t WS_SST = 632 * MiB;
constexpr size_t WS_SIN = 760 * MiB;
constexpr size_t WS_END = 824 * MiB;

constexpr int RING_BYTES = 131072;
constexpr int LDSCTL_OFF = 143360;
constexpr int LDS_BYTES = 147456;
constexpr int NWAVES = 8, NTHR = 512;

__device__ __forceinline__ int lane_id() { return (int)__builtin_amdgcn_mbcnt_hi(~0u, __builtin_amdgcn_mbcnt_lo(~0u, 0u)); }
__device__ __forceinline__ float bf2f(unsigned short b) { return __builtin_bit_cast(float, (unsigned)b << 16); }
__device__ __forceinline__ float bflo(unsigned w) { return __builtin_bit_cast(float, w << 16); }
__device__ __forceinline__ float bfhi(unsigned w) { return __builtin_bit_cast(float, w & 0xffff0000u); }
__device__ __forceinline__ unsigned f2bf(float f) { unsigned u = __builtin_bit_cast(unsigned, f); return (u + 0x7fffu + ((u >> 16) & 1u)) >> 16; }
__device__ __forceinline__ unsigned pk2(float lo, float hi) { return f2bf(lo) | (f2bf(hi) << 16); }
typedef float f32x16 __attribute__((ext_vector_type(16)));
typedef short s16x4 __attribute__((ext_vector_type(4)));
typedef __bf16 bf2_t __attribute__((ext_vector_type(2)));
__device__ __forceinline__ unsigned pkbf(float a, float b) { const f32x2 v = {a, b}; return __builtin_bit_cast(unsigned, __builtin_convertvector(v, bf2_t)); }
#define MFMA32(a, b, c) __builtin_amdgcn_mfma_f32_32x32x16_bf16((a), (b), (c), 0, 0, 0)
__device__ __forceinline__ float wave_sum(float v) {
#pragma unroll
    for (int o = 1; o < 64; o <<= 1) v += __shfl_xor(v, o);
    return v;
}
__device__ __forceinline__ float wave_max(float v) {
#pragma unroll
    for (int o = 1; o < 64; o <<= 1) v = fmaxf(v, __shfl_xor(v, o));
    return v;
}
__device__ __forceinline__ float sigmoidf_(float x) { return 1.0f / (1.0f + __expf(-x)); }
#define LDS_WAIT() asm volatile("s_waitcnt lgkmcnt(0)" ::: "memory")
#define VM_WAIT() asm volatile("s_waitcnt vmcnt(0)" ::: "memory")

#define XB_TMO      128
#define XB_XCNT(j)  (256  + 64 * (j))
#define XB_XSUB(j)  (1280 + 64 * (j))
#define XB_XGEN(j)  (2304 + 64 * (j))
#define XB_TOP      3328
#define XB_TOPGEN   3392
#define XCD_BAR_WORDS 3456
#define XB_SPIN_CAP (1u << 18)
__device__ __forceinline__ unsigned xb_ld(unsigned* p)              { return __hip_atomic_load(p, __ATOMIC_RELAXED, __HIP_MEMORY_SCOPE_AGENT); }
__device__ __forceinline__ unsigned xb_add(unsigned* p, unsigned v) { return __hip_atomic_fetch_add(p, v, __ATOMIC_RELAXED, __HIP_MEMORY_SCOPE_AGENT); }
__device__ __forceinline__ unsigned xb_xcc_id() { return (unsigned)__builtin_amdgcn_s_getreg((3 << 11) | 20) & 0xFu; }
#define XB_SPIN(cond, bar) do { unsigned _sp = 0; while (cond) { __builtin_amdgcn_s_sleep(1); \
    if ((++_sp & 255u) == 0u) { if (xb_ld(&(bar)[XB_TMO])) break; if (_sp > XB_SPIN_CAP) { atomicAdd(&(bar)[XB_TMO], 1u); break; } } } } while (0)
struct XcdBarrier { unsigned* bar; unsigned x; volatile LAS unsigned* st; int wave; };
__device__ __forceinline__ XcdBarrier xcd_barrier_post(unsigned* bar, volatile LAS unsigned* st, int wave) {
    XcdBarrier b; b.bar = bar; b.x = xb_xcc_id(); b.st = st; b.wave = wave;
    if (wave == 0 && lane_id() == 0) (void)xb_add(&bar[XB_XCNT(b.x)], 1u);
    return b;
}
__device__ __forceinline__ void xcd_barrier_complete(unsigned* bar, unsigned x, unsigned& nloc, unsigned& nx) {
    const unsigned G = gridDim.x * gridDim.y * gridDim.z;
    unsigned sum, cnt, mine, sp = 0u;
    for (;;) {
        sum = 0u; cnt = 0u; mine = 0u;
#pragma unroll
        for (unsigned j = 0; j < 16; ++j) { const unsigned c = xb_ld(&bar[XB_XCNT(j)]); sum += c; cnt += (c > 0u) ? 1u : 0u; mine = (j == x) ? c : mine; }
        if (sum == G) break;
        __builtin_amdgcn_s_sleep(1);
        if ((++sp & 255u) == 0u) { if (xb_ld(&bar[XB_TMO])) break; if (sp > XB_SPIN_CAP) { atomicAdd(&bar[XB_TMO], 1u); break; } }
    }
    nloc = mine > 0u ? mine : 1u; nx = cnt > 0u ? cnt : 1u;
}
__device__ __forceinline__ void xcd_barrier(const XcdBarrier& b) {
    asm volatile("s_waitcnt vmcnt(0)" ::: "memory");
    __syncthreads();
    if (b.wave == 0 && lane_id() == 0) {
        unsigned* bar = b.bar;
        __builtin_amdgcn_s_waitcnt(0);
        unsigned nloc = b.st[0], nx = b.st[1];
        if (nloc == 0u) { xcd_barrier_complete(bar, b.x, nloc, nx); b.st[0] = nloc; b.st[1] = nx; }
        const unsigned old = xb_add(&bar[XB_XSUB(b.x)], 1u);
        const unsigned gen = old / nloc;
        if (old + 1u == (gen + 1u) * nloc) {
            __builtin_amdgcn_fence(__ATOMIC_RELEASE, "agent");
            asm volatile("s_waitcnt vmcnt(0)" ::: "memory");
            const unsigned og = xb_add(&bar[XB_TOP], 1u);
            const unsigned tg = og / nx;
            if (og + 1u == (tg + 1u) * nx) xb_add(&bar[XB_TOPGEN], 1u);
            else XB_SPIN(xb_ld(&bar[XB_TOPGEN]) == tg, bar);
            __builtin_amdgcn_fence(__ATOMIC_ACQUIRE, "agent");
            xb_add(&bar[XB_XGEN(b.x)], 1u);
            asm volatile("s_waitcnt vmcnt(0)" ::: "memory");
        } else {
            XB_SPIN(xb_ld(&bar[XB_XGEN(b.x)]) == gen, bar);
            __builtin_amdgcn_fence(__ATOMIC_ACQUIRE, "agent");
            asm volatile("s_waitcnt vmcnt(0)" ::: "memory");
        }
    }
    __syncthreads();
}

namespace pg8 {
constexpr int BM = 256, BK = 64, HALF = 128, HTB = HALF * BK * 2, STAGE_BYTES = 8 * HTB, NXCD = 8, WGM = 8;
__host__ __device__ __forceinline__ int lds_byte(int r, int c) { const int st = (r >> 4) * 2 + (c >> 5), rr = r & 15, cc = c & 31, ob = rr * 64 + cc * 2; return st * 1024 + (ob ^ (((ob >> 9) & 1) << 5)); }
__host__ __device__ __forceinline__ void stage_rc(int b, int& R, int& C) { const int st = b / 1024, sb = b % 1024, swz = sb ^ (((sb >> 9) & 1) << 5); R = (st >> 1) * 16 + swz / 64; C = (st & 1) * 32 + (swz % 64) / 2; }
__host__ __device__ __forceinline__ int perm32(int rho) { const int n = rho >> 4, i = rho & 15; return 8 * (i >> 2) + 4 * n + (i & 3); }
struct Unit { int pm, pn; };
struct Gemm { const bf16* A; const bf16* Bt; int M, N, K, lda, ldb; };
struct StaticOrder {
    int nM, nN, nwg, G, c;
    __host__ __device__ void init(int M, int N, int G_, int c_) { nM = M / BM; nN = N / BM; nwg = nM * nN; G = G_; c = c_; }
    __host__ __device__ bool next(int i, Unit& u) const {
        const long L = (long)i * G + c; if (L >= nwg) return false;
        int wgid = (int)L; { const int q = nwg / NXCD, r = nwg % NXCD, xcd = wgid % NXCD, off = wgid / NXCD; wgid = (xcd < r ? xcd * (q + 1) : r * (q + 1) + (xcd - r) * q) + off; }
        const int nig = WGM * nN, gid = wgid / nig, fm = gid * WGM, gsz = (nM - fm) < WGM ? (nM - fm) : WGM;
        u.pm = fm + ((wgid % nig) % gsz); u.pn = (wgid % nig) / gsz; return true;
    }
    __device__ __forceinline__ void a_ready(const Unit&) const {}
    __device__ __forceinline__ void done(const Unit&) const {}
};
struct PanelOrder {
    int pm, nN, rot;
    __device__ __forceinline__ bool next(int i, Unit& u) const { if (i >= nN) return false; u.pm = pm; u.pn = (i + rot) % nN; return true; }
    __device__ __forceinline__ void a_ready(const Unit&) const {}
    __device__ __forceinline__ void done(const Unit&) const {}
};
__device__ __forceinline__ unsigned cvt_pk_bf16(float lo, float hi) { unsigned r; asm volatile("v_cvt_pk_bf16_f32 %0, %1, %2" : "=v"(r) : "v"(lo), "v"(hi)); return r; }

template <int ACT> struct EpiBf16 {
    static constexpr bool PERM = true, AFTER_DRAIN = false, HAS_MID = false;
    bf16* O; int ldc;
    __device__ __forceinline__ void operator()(const f32x4 (&acc)[2][2][4][2], const Unit& u, int wr, int wc, int fr, int fq) const {
        const int row0 = u.pm * BM + wr * 64 + fr; const int col0 = u.pn * BM + wc * 32 + 8 * fq;
#pragma unroll
        for (int ai = 0; ai < 2; ++ai)
#pragma unroll
            for (int m = 0; m < 4; ++m) { bf16* rowp = O + (size_t)(row0 + ai * HALF + m * 16) * ldc + col0;
#pragma unroll
                for (int bj = 0; bj < 2; ++bj) { f32x4 v0 = acc[ai][bj][m][0], v1 = acc[ai][bj][m][1];
                    if (ACT == 1) {
#pragma unroll
                        for (int j = 0; j < 4; ++j) { v0[j] = sigmoidf_(v0[j]); v1[j] = sigmoidf_(v1[j]); } }
                    u32x4 w; w.x = cvt_pk_bf16(v0[0], v0[1]); w.y = cvt_pk_bf16(v0[2], v0[3]); w.z = cvt_pk_bf16(v1[0], v1[1]); w.w = cvt_pk_bf16(v1[2], v1[3]);
                    *(u32x4*)(rowp + bj * HALF) = w; } }
    }
};
template <bool ACCUM> struct EpiBranch {
    static constexpr bool PERM = true, AFTER_DRAIN = false, HAS_MID = false;
    bf16* O; int ldc; const bf16* Gt; int ldg; int gcol0;
    __device__ __forceinline__ void operator()(const f32x4 (&acc)[2][2][4][2], const Unit& u, int wr, int wc, int fr, int fq) const {
        const int row0 = u.pm * BM + wr * 64 + fr; const int col0 = u.pn * BM + wc * 32 + 8 * fq;
#pragma unroll
        for (int ai = 0; ai < 2; ++ai)
#pragma unroll
            for (int m = 0; m < 4; ++m) { const size_t r = (size_t)(row0 + ai * HALF + m * 16); bf16* rowp = O + r * ldc + col0; const bf16* gp = Gt + r * ldg + gcol0 + col0;
#pragma unroll
                for (int bj = 0; bj < 2; ++bj) { const f32x4 v0 = acc[ai][bj][m][0], v1 = acc[ai][bj][m][1];
                    const u32x4 g = *(const u32x4*)(gp + bj * HALF);
                    float o[8];
                    o[0] = v0[0] * bflo(g.x); o[1] = v0[1] * bfhi(g.x); o[2] = v0[2] * bflo(g.y); o[3] = v0[3] * bfhi(g.y);
                    o[4] = v1[0] * bflo(g.z); o[5] = v1[1] * bfhi(g.z); o[6] = v1[2] * bflo(g.w); o[7] = v1[3] * bfhi(g.w);
                    if (ACCUM) { const u32x4 p = *(const u32x4*)(rowp + bj * HALF);
                        o[0] += bflo(p.x); o[1] += bfhi(p.x); o[2] += bflo(p.y); o[3] += bfhi(p.y); o[4] += bflo(p.z); o[5] += bfhi(p.z); o[6] += bflo(p.w); o[7] += bfhi(p.w); }
                    u32x4 w; w.x = cvt_pk_bf16(o[0], o[1]); w.y = cvt_pk_bf16(o[2], o[3]); w.z = cvt_pk_bf16(o[4], o[5]); w.w = cvt_pk_bf16(o[6], o[7]);
                    *(u32x4*)(rowp + bj * HALF) = w; } }
    }
};
struct EpiResid {
    static constexpr bool PERM = false, AFTER_DRAIN = false, HAS_MID = false;
    float* C; int ldc; const float* R;
    __device__ __forceinline__ void operator()(const f32x4 (&acc)[2][2][4][2], const Unit& u, int wr, int wc, int fr, int fq) const {
        const int row0 = u.pm * BM + wr * 64 + fr, col0 = u.pn * BM + wc * 32 + 4 * fq;
#pragma unroll
        for (int ai = 0; ai < 2; ++ai)
#pragma unroll
            for (int m = 0; m < 4; ++m) { const size_t off = (size_t)(row0 + ai * HALF + m * 16) * ldc + col0;
#pragma unroll
                for (int bj = 0; bj < 2; ++bj)
#pragma unroll
                    for (int n = 0; n < 2; ++n) { const f32x4 r = *(const f32x4*)(R + off + bj * HALF + n * 16); *(f32x4*)(C + off + bj * HALF + n * 16) = acc[ai][bj][m][n] + r; } }
    }
};

struct EpiBranchFused {
    static constexpr bool PERM = true, AFTER_DRAIN = false, HAS_MID = true;
    bf16* O; int ldc; __amdgpu_buffer_rsrc_t grs; int ldg;
    __device__ __forceinline__ void mid(f32x4 (&acc)[2][2][4][2], const Unit& u, int t, int wr, int wc, int fr, int fq) const {
        const unsigned voff = (unsigned)(((u.pm * BM + wr * 64 + fr) * ldg + u.pn * BM + wc * 32 + 8 * fq) * 2);
        const int ca = (t == 16) ? 0 : 2048;
#pragma unroll
        for (int ai = 0; ai < 2; ++ai)
#pragma unroll
            for (int m = 0; m < 4; ++m) {
#pragma unroll
                for (int bj = 0; bj < 2; ++bj) { const int so = ((ai * HALF + m * 16) * ldg + bj * HALF) * 2 + ca;
                    const u32x4 ga = __builtin_amdgcn_raw_buffer_load_b128(grs, voff, so, 0), gb = __builtin_amdgcn_raw_buffer_load_b128(grs, voff, so + 2048, 0);
                    f32x4& v0 = acc[ai][bj][m][0]; f32x4& v1 = acc[ai][bj][m][1];
                    v0[0] *= bflo(ga.x) * __builtin_amdgcn_rcpf(fmaxf(bflo(gb.x), 1e-30f)); v0[1] *= bfhi(ga.x) * __builtin_amdgcn_rcpf(fmaxf(bfhi(gb.x), 1e-30f));
                    v0[2] *= bflo(ga.y) * __builtin_amdgcn_rcpf(fmaxf(bflo(gb.y), 1e-30f)); v0[3] *= bfhi(ga.y) * __builtin_amdgcn_rcpf(fmaxf(bfhi(gb.y), 1e-30f));
                    v1[0] *= bflo(ga.z) * __builtin_amdgcn_rcpf(fmaxf(bflo(gb.z), 1e-30f)); v1[1] *= bfhi(ga.z) * __builtin_amdgcn_rcpf(fmaxf(bfhi(gb.z), 1e-30f));
                    v1[2] *= bflo(ga.w) * __builtin_amdgcn_rcpf(fmaxf(bflo(gb.w), 1e-30f)); v1[3] *= bfhi(ga.w) * __builtin_amdgcn_rcpf(fmaxf(bfhi(gb.w), 1e-30f)); }
                __builtin_amdgcn_sched_barrier(0); }
    }
    __device__ __forceinline__ void operator()(const f32x4 (&acc)[2][2][4][2], const Unit& u, int wr, int wc, int fr, int fq) const {
        const int row0 = u.pm * BM + wr * 64 + fr; const int col0 = u.pn * BM + wc * 32 + 8 * fq;
        const unsigned voff = (unsigned)((row0 * ldg + col0) * 2);
#pragma unroll
        for (int ai = 0; ai < 2; ++ai)
#pragma unroll
            for (int m = 0; m < 4; ++m) { const size_t r = (size_t)(row0 + ai * HALF + m * 16); bf16* rowp = O + r * ldc + col0;
#pragma unroll
                for (int bj = 0; bj < 2; ++bj) { const f32x4 v0 = acc[ai][bj][m][0], v1 = acc[ai][bj][m][1];
                    const u32x4 g = __builtin_amdgcn_raw_buffer_load_b128(grs, voff, ((ai * HALF + m * 16) * ldg + bj * HALF) * 2 + 4096, 0);
                    u32x4 w; w.x = cvt_pk_bf16(v0[0] * bflo(g.x), v0[1] * bfhi(g.x)); w.y = cvt_pk_bf16(v0[2] * bflo(g.y), v0[3] * bfhi(g.y));
                    w.z = cvt_pk_bf16(v1[0] * bflo(g.z), v1[1] * bfhi(g.z)); w.w = cvt_pk_bf16(v1[2] * bflo(g.w), v1[3] * bfhi(g.w));
                    *(u32x4*)(rowp + bj * HALF) = w; } }
    }
};

template <class Epi, class Sched>
__device__ __forceinline__ void gemm_phase(LAS unsigned char* lds, const Gemm g, const Sched& S, const Epi& E, int wid) {
    int lane = lane_id(); asm volatile("" : "+v"(lane));
    const int tid = wid * 64 + lane, wr = wid >> 2, wc = wid & 3, fr = lane & 15, fq = lane >> 4;
    const int K = g.K, nt = K / BK;
    unsigned voffA[2], voffB[2];
#pragma unroll
    for (int i = 0; i < 2; ++i) { int R, C; stage_rc(tid * 16 + i * 8192, R, C); const int Rb = Epi::PERM ? ((R & ~31) + perm32(R & 31)) : R;
        voffA[i] = (unsigned)(R * g.lda + C) * 2u; voffB[i] = (unsigned)(Rb * g.ldb + C) * 2u; }
    const size_t kstep = (size_t)(BK * 2);
    const size_t hsA = (size_t)HALF * g.lda * 2, hsB = (size_t)HALF * g.ldb * 2;
    const size_t tsA = 2 * hsA, tsB = 2 * hsB;
    const unsigned ldsw = (unsigned)wid * 1024u;
    const int aoff = lds_byte(wr * 64 + fr, fq * 8), boff = lds_byte(wc * 32 + fr, fq * 8);
#define PG8_SA(b, h) (((b) * 2 + (h)) * HTB)
#define PG8_SB(b, h) ((4 + (b) * 2 + (h)) * HTB)
#define PG8_STAGE(bufoff, gbase, voff) do { _Pragma("unroll") for (int _i = 0; _i < 2; ++_i) \
        __builtin_amdgcn_global_load_lds((const unsigned*)((const char*)(gbase) + (voff)[_i]), (LAS unsigned*)(lds + (bufoff) + ldsw + _i * 8192), 16, 0, 0); } while (0)
#define PG8_LDA(dst, b, h) do { _Pragma("unroll") for (int m = 0; m < 4; ++m) _Pragma("unroll") for (int k = 0; k < 2; ++k) dst[m][k] = *(const LAS bf16x8*)(lds + PG8_SA(b, h) + aoff + m * 2048 + k * 1024); } while (0)
#define PG8_LDB(dst, b, h) do { _Pragma("unroll") for (int n = 0; n < 2; ++n) _Pragma("unroll") for (int k = 0; k < 2; ++k) dst[n][k] = *(const LAS bf16x8*)(lds + PG8_SB(b, h) + boff + n * 2048 + k * 1024); } while (0)
#define PG8_MMA(ai, bj, At, Bt) do { __builtin_amdgcn_s_setprio(1); _Pragma("unroll") for (int m = 0; m < 4; ++m) _Pragma("unroll") for (int n = 0; n < 2; ++n) _Pragma("unroll") for (int k = 0; k < 2; ++k) \
        acc[ai][bj][m][n] = __builtin_amdgcn_mfma_f32_16x16x32_bf16(Bt[n][k], At[m][k], acc[ai][bj][m][n], 0, 0, 0); __builtin_amdgcn_s_setprio(0); } while (0)
#define PG8_WAIT_V(n) asm volatile("s_waitcnt vmcnt(" #n ")" ::: "memory")
#define PG8_WAIT_L(n) asm volatile("s_waitcnt lgkmcnt(" #n ")" ::: "memory")
#define PG8_BAR __builtin_amdgcn_s_barrier()
#define PG8_SCHED __builtin_amdgcn_sched_barrier(0)
    Unit cur, nxt; int ui = 0;
    if (!S.next(0, cur)) return;
    f32x4 acc[2][2][4][2];
#pragma unroll
    for (int a = 0; a < 2; ++a)
#pragma unroll
        for (int b = 0; b < 2; ++b)
#pragma unroll
            for (int m = 0; m < 4; ++m)
#pragma unroll
                for (int n = 0; n < 2; ++n) acc[a][b][m][n] = (f32x4){0.f, 0.f, 0.f, 0.f};
    bf16x8 At[4][2], B0[2][2], B1[2][2];
    const char* cA = (const char*)g.A + (size_t)cur.pm * tsA; const char* cB = (const char*)g.Bt + (size_t)cur.pn * tsB;
    S.a_ready(cur);
    PG8_STAGE(PG8_SB(0, 0), cB, voffB); PG8_STAGE(PG8_SB(0, 1), cB + hsB, voffB); PG8_STAGE(PG8_SA(0, 0), cA, voffA); PG8_STAGE(PG8_SA(0, 1), cA + hsA, voffA);
    if (wr == 1) PG8_BAR;
    PG8_WAIT_V(2); PG8_BAR;
    PG8_STAGE(PG8_SB(1, 0), cB + kstep, voffB); PG8_STAGE(PG8_SA(1, 0), cA + kstep, voffA); PG8_STAGE(PG8_SB(1, 1), cB + hsB + kstep, voffB);
    PG8_WAIT_V(6); PG8_BAR;
    for (;;) {
        const bool has_next = S.next(ui + 1, nxt);
        const char* nA = has_next ? (const char*)g.A + (size_t)nxt.pm * tsA : cA; const char* nB = has_next ? (const char*)g.Bt + (size_t)nxt.pn * tsB : cB;
        for (int t = 0; t < nt; t += 2) {
            const bool last = (t == nt - 2);
            const char* a1 = cA + (size_t)(t + 1) * kstep;
            const char* a2 = last ? nA : cA + (size_t)(t + 2) * kstep; const char* b2 = last ? nB : cB + (size_t)(t + 2) * kstep;
            const char* a3 = a2 + kstep; const char* b3 = b2 + kstep;
            if (last && has_next) S.a_ready(nxt);
            if constexpr (Epi::HAS_MID) { if (t == 16 || t == 20) E.mid(acc, cur, t, wr, wc, fr, fq); }
            PG8_LDB(B0, 0, 0); PG8_LDB(B1, 0, 1); PG8_SCHED; PG8_LDA(At, 0, 0); PG8_STAGE(PG8_SA(1, 1), a1 + hsA, voffA);
            PG8_WAIT_V(8); PG8_WAIT_L(0); PG8_BAR; PG8_MMA(0, 0, At, B0); PG8_MMA(0, 1, At, B1); PG8_BAR; PG8_SCHED;
            PG8_LDA(At, 0, 1); PG8_STAGE(PG8_SB(0, 0), b2, voffB); PG8_STAGE(PG8_SB(0, 1), b2 + hsB, voffB); PG8_STAGE(PG8_SA(0, 0), a2, voffA);
            PG8_WAIT_V(8); PG8_WAIT_L(0); PG8_BAR; PG8_MMA(1, 0, At, B0); PG8_MMA(1, 1, At, B1); PG8_BAR; PG8_SCHED;
            PG8_LDB(B0, 1, 0); PG8_LDB(B1, 1, 1); PG8_SCHED; PG8_LDA(At, 1, 0); PG8_STAGE(PG8_SA(0, 1), a2 + hsA, voffA);
            PG8_WAIT_V(8); PG8_WAIT_L(0); PG8_BAR; PG8_MMA(0, 0, At, B0); PG8_MMA(0, 1, At, B1); PG8_BAR; PG8_SCHED;
            PG8_LDA(At, 1, 1); PG8_STAGE(PG8_SB(1, 0), b3, voffB); PG8_STAGE(PG8_SB(1, 1), b3 + hsB, voffB); PG8_STAGE(PG8_SA(1, 0), a3, voffA);
            PG8_WAIT_V(8); PG8_WAIT_L(0); PG8_BAR; PG8_MMA(1, 0, At, B0); PG8_MMA(1, 1, At, B1); PG8_BAR; PG8_SCHED;
        }
        if (wr == 0) PG8_BAR;
        E(acc, cur, wr, wc, fr, fq); S.done(cur);
        if (!has_next) break;
#pragma unroll
        for (int a = 0; a < 2; ++a)
#pragma unroll
            for (int b = 0; b < 2; ++b)
#pragma unroll
                for (int m = 0; m < 4; ++m)
#pragma unroll
                    for (int n = 0; n < 2; ++n) acc[a][b][m][n] = (f32x4){0.f, 0.f, 0.f, 0.f};
        cur = nxt; cA = nA; cB = nB; ++ui;
        if (wr == 1) PG8_BAR;
    }
    PG8_WAIT_V(0);
    PG8_BAR;
#undef PG8_SA
#undef PG8_SB
#undef PG8_STAGE
#undef PG8_LDA
#undef PG8_LDB
#undef PG8_MMA
#undef PG8_WAIT_V
#undef PG8_WAIT_L
#undef PG8_BAR
#undef PG8_SCHED
}
}

#ifndef PROBE
#define PROBE 0
#endif
struct Args {
    const float* in[26]; const int* positions; float* out; unsigned char* ws; int ph_lo, ph_hi; int pad0, pad1;
};
struct Frame {
    LAS unsigned char* lds;
    int tid, lane, wave, G, bid;
    const float* const* in; const int* positions; float* out; unsigned char* ws;
};
__device__ __forceinline__ void frame_refresh(Frame& F) { int l = lane_id(); asm volatile("" : "+v"(l)); F.lane = l; F.tid = F.wave * 64 + l; }
enum { I_X = 0, I_MEM = 1, I_POS = 2, I_NMIXW = 3, I_WIN = 4, I_CONVW = 5, I_CONVB = 6, I_DTB = 7, I_ALOG = 8, I_SSDD = 9, I_SSDNW = 10, I_DQNW = 11, I_DKNW = 12, I_MEMNW = 13,
       I_WMKV = 14, I_MQNW = 15, I_MKNW = 16, I_WSSD = 17, I_WDIL = 18, I_WMEMBR = 19, I_WOUT = 20, I_NFFNW = 21, I_WQ = 22, I_SUBK = 23, I_PD = 24, I_PU = 25 };

__device__ __forceinline__ void p0_transpose_item(const float* W, int ldw, int src_col0, bf16* WT, int ldt, int dst_row0, int dst_col0, int nblk, LAS float* scr, int item, int lane) {
    const int kb = item / nblk, nb = item % nblk, k0 = 64 * kb, n0 = 32 * nb;
#pragma unroll 8
    for (int i = 0; i < 32; ++i) { const int kk = 2 * i + (lane >> 5); scr[kk * 33 + (lane & 31)] = W[(size_t)(k0 + kk) * ldw + src_col0 + n0 + (lane & 31)]; }
    LDS_WAIT(); asm volatile("" ::: "memory");
    const int c = lane & 7;
#pragma unroll
    for (int j = 0; j < 4; ++j) { const int n = (lane >> 3) + 8 * j; const LAS float* s = scr + (8 * c) * 33 + n;
        u32x4 o; o.x = pk2(s[0 * 33], s[1 * 33]); o.y = pk2(s[2 * 33], s[3 * 33]); o.z = pk2(s[4 * 33], s[5 * 33]); o.w = pk2(s[6 * 33], s[7 * 33]);
        *(u32x4*)(WT + (size_t)(dst_row0 + n0 + n) * ldt + dst_col0 + k0 + 8 * c) = o; }
    LDS_WAIT(); asm volatile("" ::: "memory");
}
__device__ __forceinline__ void rms_row_to_bf16(const float* xrow, const float* w, bf16* orow, int lane, f32x4 (&v)[4]) {
    const f32x4* xr = (const f32x4*)xrow + lane; const f32x4* wr = (const f32x4*)w + lane;
    float s = 0.f;
#pragma unroll
    for (int j = 0; j < 4; ++j) { v[j] = xr[64 * j]; s += (v[j].x * v[j].x + v[j].y * v[j].y) + (v[j].z * v[j].z + v[j].w * v[j].w); }
    const float rstd = 1.0f / sqrtf(wave_sum(s) * (1.f / DM) + EPS);
    unsigned long long* o8 = (unsigned long long*)orow + lane;
#pragma unroll
    for (int j = 0; j < 4; ++j) { const f32x4 ww = wr[64 * j]; v[j] = v[j] * rstd * ww;
        o8[64 * j] = (unsigned long long)pk2(v[j].x, v[j].y) | ((unsigned long long)pk2(v[j].z, v[j].w) << 32); }
}
__device__ __forceinline__ void cvt_f32_bf16_stream(const float* src, bf16* dst, size_t n, size_t gtid, size_t gthreads) {
    for (size_t i = gtid * 8; i < n; i += gthreads * 8) { const f32x4 a = *(const f32x4*)(src + i), b = *(const f32x4*)(src + i + 4);
        u32x4 o; o.x = pk2(a.x, a.y); o.y = pk2(a.z, a.w); o.z = pk2(b.x, b.y); o.w = pk2(b.z, b.w); *(u32x4*)(dst + i) = o; }
}
constexpr float PD_SCALE = 64.0f, PU_SCALE = 8.0f;
__device__ __forceinline__ unsigned pk4_fp8(f32x4 v, float sc) {
    const float a = fminf(fmaxf(v.x * sc, -448.f), 448.f), b = fminf(fmaxf(v.y * sc, -448.f), 448.f), c = fminf(fmaxf(v.z * sc, -448.f), 448.f), d = fminf(fmaxf(v.w * sc, -448.f), 448.f);
    unsigned p = __builtin_amdgcn_cvt_pk_fp8_f32(a, b, 0, false); return __builtin_amdgcn_cvt_pk_fp8_f32(c, d, p, true);
}
__device__ __forceinline__ void cvt_f32_fp8_sliced(const float* src, unsigned char* dst, float sc, size_t gtid, size_t gthreads) {
    for (size_t i = gtid * 16; i < (size_t)16384 * 1024; i += gthreads * 16) { const f32x4 a = *(const f32x4*)(src + i), b = *(const f32x4*)(src + i + 4), c = *(const f32x4*)(src + i + 8), d = *(const f32x4*)(src + i + 12);
        const size_t e = i >> 10, dd = i & 1023;
        const u32x4 o = {pk4_fp8(a, sc), pk4_fp8(b, sc), pk4_fp8(c, sc), pk4_fp8(d, sc)}; *(u32x4*)(dst + ((((dd >> 7) * 16384 + e) << 7) + (dd & 127))) = o; }
}
__device__ __forceinline__ void p0_prologue(Frame& F) {
    LAS float* scr = (LAS float*)(F.lds + F.wave * 8448);
    LAS float* wdt = (LAS float*)(F.lds + 8 * 8448);
    const int gw = F.bid * NWAVES + F.wave, NGW = F.G * NWAVES;
    unsigned char* ws = F.ws;
    for (int i = F.tid; i < 1024 * 16; i += NTHR) { const int k = i >> 4, c = i & 15, l = (k & 255) >> 2, e = k & 3, j = k >> 8, q = c >> 2;
        wdt[((((j * 4 + e) * 4 + q) * 64 + l) << 2) + (c & 3)] = F.in[I_WIN][(size_t)k * W_IN_N + OFF_DT + c]; }
    __syncthreads();
    constexpr int IT_A = 16 * 96, IT_B = 16 * 192, IT_MKV = 16 * 48, IT_SSD = 16 * 32, IT_DIL = 4 * 32, IT_MBR = 12 * 32, IT_OUT = 16 * 32, IT_WQ = 16 * 64;
    constexpr int NITEMS = IT_A + IT_B + IT_MKV + IT_SSD + IT_DIL + IT_MBR + IT_OUT + IT_WQ;
    bf16* WallT = (bf16*)(ws + WS_WALLT);
    for (int it = gw; it < NITEMS; it += NGW) {
        int r = it;
        if (r < IT_A) { p0_transpose_item(F.in[I_WIN], W_IN_N, 0, WallT, DM, 0, 0, 96, scr, r, F.lane); continue; } r -= IT_A;
        if (r < IT_B) { p0_transpose_item(F.in[I_WIN], W_IN_N, OFF_AFTER_DT, WallT, DM, 3072, 0, 192, scr, r, F.lane); continue; } r -= IT_B;
        if (r < IT_MKV) { p0_transpose_item(F.in[I_WMKV], 1536, 0, (bf16*)(ws + WS_WMKVT), DM, 0, 0, 48, scr, r, F.lane); continue; } r -= IT_MKV;
        if (r < IT_SSD) { p0_transpose_item(F.in[I_WSSD], DM, 0, (bf16*)(ws + WS_WCATT), YC, 0, 0, 32, scr, r, F.lane); continue; } r -= IT_SSD;
        if (r < IT_DIL) { p0_transpose_item(F.in[I_WDIL], DM, 0, (bf16*)(ws + WS_WCATT), YC, 0, 1024, 32, scr, r, F.lane); continue; } r -= IT_DIL;
        if (r < IT_MBR) { p0_transpose_item(F.in[I_WMEMBR], DM, 0, (bf16*)(ws + WS_WCATT), YC, 0, 1280, 32, scr, r, F.lane); continue; } r -= IT_MBR;
        if (r < IT_OUT) { p0_transpose_item(F.in[I_WOUT], DM, 0, (bf16*)(ws + WS_WOUTT), DM, 0, 0, 32, scr, r, F.lane); continue; } r -= IT_OUT;
        p0_transpose_item(F.in[I_WQ], PEER_Q, 0, (bf16*)(ws + WS_WQT), DM, 0, 0, 64, scr, r, F.lane);
    }
    const size_t gtid = (size_t)F.bid * NTHR + F.tid, gth = (size_t)F.G * NTHR;
    cvt_f32_bf16_stream(F.in[I_SUBK], (bf16*)(ws + WS_SUBK), (size_t)8 * 2 * 128 * 128, gtid, gth);
    cvt_f32_fp8_sliced(F.in[I_PD], ws + WS_PD, PD_SCALE, gtid, gth);
    cvt_f32_fp8_sliced(F.in[I_PU], ws + WS_PU, PU_SCALE, gtid, gth);
    for (int m = gw; m < NB * NMEM; m += NGW) { f32x4 v[4]; rms_row_to_bf16(F.in[I_MEM] + (size_t)m * DM, F.in[I_MEMNW], (bf16*)(ws + WS_MEMN) + (size_t)m * DM, F.lane, v); }
    float* DTp = (float*)(ws + WS_DT);
    const int lane = F.lane;
    const int myj = ((lane >> 5) & 1) * 8 + ((lane >> 4) & 1) * 4 + ((lane >> 3) & 1) * 2 + ((lane >> 2) & 1);
    const float dtb = F.in[I_DTB][myj];
    for (int m = 2 * gw; m < T; m += 2 * NGW) {
        f32x4 va[4], vb[4];
        rms_row_to_bf16(F.in[I_X] + (size_t)m * DM, F.in[I_NMIXW], (bf16*)(ws + WS_ACT1) + (size_t)m * DM, lane, va);
        rms_row_to_bf16(F.in[I_X] + (size_t)(m + 1) * DM, F.in[I_NMIXW], (bf16*)(ws + WS_ACT1) + (size_t)(m + 1) * DM, lane, vb);
        float da[16], db[16];
#pragma unroll
        for (int j = 0; j < 16; ++j) { da[j] = 0.f; db[j] = 0.f; }
#pragma unroll
        for (int j = 0; j < 4; ++j)
#pragma unroll
            for (int e = 0; e < 4; ++e) { const float ua = va[j][e], ub = vb[j][e];
#pragma unroll
                for (int q = 0; q < 4; ++q) { const f32x4 w4 = *(const LAS f32x4*)(wdt + ((((j * 4 + e) * 4 + q) * 64 + lane) << 2));
                    da[4 * q + 0] += ua * w4.x; da[4 * q + 1] += ua * w4.y; da[4 * q + 2] += ua * w4.z; da[4 * q + 3] += ua * w4.w;
                    db[4 * q + 0] += ub * w4.x; db[4 * q + 1] += ub * w4.y; db[4 * q + 2] += ub * w4.z; db[4 * q + 3] += ub * w4.w; }
                __builtin_amdgcn_sched_barrier(0); }
        float ra, rb;
        { float r8a[8], r8b[8], r4a[4], r4b[4], r2a[2], r2b[2];
          { const bool up = (lane & 32) != 0;
#pragma unroll
            for (int k = 0; k < 8; ++k) { r8a[k] = (up ? da[k + 8] : da[k]) + __shfl_xor(up ? da[k] : da[k + 8], 32); r8b[k] = (up ? db[k + 8] : db[k]) + __shfl_xor(up ? db[k] : db[k + 8], 32); } }
          { const bool up = (lane & 16) != 0;
#pragma unroll
            for (int k = 0; k < 4; ++k) { r4a[k] = (up ? r8a[k + 4] : r8a[k]) + __shfl_xor(up ? r8a[k] : r8a[k + 4], 16); r4b[k] = (up ? r8b[k + 4] : r8b[k]) + __shfl_xor(up ? r8b[k] : r8b[k + 4], 16); } }
          { const bool up = (lane & 8) != 0;
#pragma unroll
            for (int k = 0; k < 2; ++k) { r2a[k] = (up ? r4a[k + 2] : r4a[k]) + __shfl_xor(up ? r4a[k] : r4a[k + 2], 8); r2b[k] = (up ? r4b[k + 2] : r4b[k]) + __shfl_xor(up ? r4b[k] : r4b[k + 2], 8); } }
          { const bool up = (lane & 4) != 0; ra = (up ? r2a[1] : r2a[0]) + __shfl_xor(up ? r2a[0] : r2a[1], 4); rb = (up ? r2b[1] : r2b[0]) + __shfl_xor(up ? r2b[0] : r2b[1], 4); }
          ra += __shfl_xor(ra, 2); ra += __shfl_xor(ra, 1); rb += __shfl_xor(rb, 2); rb += __shfl_xor(rb, 1); }
        if ((lane & 3) == 0) { const float xa = ra + dtb, xb = rb + dtb;
            DTp[(size_t)m * 16 + myj] = (xa > 20.f) ? xa : log1pf(__expf(xa)); DTp[(size_t)(m + 1) * 16 + myj] = (xb > 20.f) ? xb : log1pf(__expf(xb)); }
    }
}

__device__ __forceinline__ void norm192_inplace(bf16* p, const float (&w)[4], int lane) {
    u32x2 v = {0u, 0u};
    if (lane < 48) v = *(const u32x2*)(p + 4 * lane);
    float x0 = bflo(v.x), x1 = bfhi(v.x), x2 = bflo(v.y), x3 = bfhi(v.y);
    const float ss = wave_sum((x0 * x0 + x1 * x1) + (x2 * x2 + x3 * x3));
    const float rs = 1.0f / sqrtf(ss * (1.f / 192.f) + EPS);
    if (lane < 48) { const u32x2 o = {pkbf(x0 * rs * w[0], x1 * rs * w[1]), pkbf(x2 * rs * w[2], x3 * rs * w[3])}; *(u32x2*)(p + 4 * lane) = o; }
}
__device__ __forceinline__ void qkprep_phase(Frame& F, int half) {
    bf16* P = (bf16*)(F.ws + WS_BIG);
    const int gw = F.bid * NWAVES + F.wave, NGW = F.G * NWAVES, lane = F.lane, sub = lane & 7;
    float wq[8], wk[8], wmq[4], wmk[4];
#pragma unroll
    for (int j = 0; j < 8; ++j) { wq[j] = F.in[I_DQNW][8 * sub + j]; wk[j] = F.in[I_DKNW][8 * sub + j]; }
#pragma unroll
    for (int j = 0; j < 4; ++j) { wmq[j] = F.in[I_MQNW][(4 * lane + j) % 192]; wmk[j] = F.in[I_MKNW][(4 * lane + j) % 192]; }
    const float inv = __expf(-logf(500000.0f) * (2.0f / 16.0f) * (float)sub);
    for (int r0 = gw; r0 < HT; r0 += 2 * NGW) {
        bf16* rowp[2]; u32x4 v[2][3]; u32x2 m[2][4]; int pos[2];
#pragma unroll
        for (int u = 0; u < 2; ++u) { const int r = (r0 + u * NGW < HT) ? r0 + u * NGW : r0; rowp[u] = P + (size_t)r * NPROJ; pos[u] = F.positions[half * HT + r];
#pragma unroll
            for (int blk = 0; blk < 3; ++blk) v[u][blk] = *(const u32x4*)(rowp[u] + PC_DQ + blk * 512 + 8 * lane);
#pragma unroll
            for (int h = 0; h < 4; ++h) { m[u][h] = (u32x2){0u, 0u}; if (lane < 48) m[u][h] = *(const u32x2*)(rowp[u] + PC_MQ + h * 192 + 4 * lane); } }
#pragma unroll
        for (int u = 0; u < 2; ++u) {
            if (u == 1 && r0 + NGW >= HT) break;
            const double rev = (double)((float)pos[u] * inv) * 0.15915494309189535;
            const float fr = (float)(rev - floor(rev));
            const float cs = __builtin_amdgcn_cosf(fr), sn = __builtin_amdgcn_sinf(fr);
            float cj[8], sj[8];
#pragma unroll
            for (int j = 0; j < 8; ++j) { cj[j] = __shfl(cs, (lane & ~7) | j); sj[j] = __shfl(sn, (lane & ~7) | j); }
            bf16* row = rowp[u];
#pragma unroll
            for (int blk = 0; blk < 3; ++blk) {
                float x[8] = {bflo(v[u][blk].x), bfhi(v[u][blk].x), bflo(v[u][blk].y), bfhi(v[u][blk].y), bflo(v[u][blk].z), bfhi(v[u][blk].z), bflo(v[u][blk].w), bfhi(v[u][blk].w)};
                float ss = 0.f;
#pragma unroll
                for (int j = 0; j < 8; ++j) ss += x[j] * x[j];
                ss += __shfl_xor(ss, 1); ss += __shfl_xor(ss, 2); ss += __shfl_xor(ss, 4);
                const float rs = 1.0f / sqrtf(ss * (1.f / 64.f) + EPS);
                const bool isq = (8 * blk + (lane >> 3)) < 12;
#pragma unroll
                for (int j = 0; j < 8; ++j) x[j] = x[j] * rs * (isq ? wq[j] : wk[j]);
#pragma unroll
                for (int j = 0; j < 8; ++j) { const float o = __shfl_xor(x[j], 1);
                    if (sub == 0) x[j] = x[j] * cj[j] - o * sj[j]; else if (sub == 1) x[j] = x[j] * cj[j] + o * sj[j]; }
                const u32x4 w = {pkbf(x[0], x[1]), pkbf(x[2], x[3]), pkbf(x[4], x[5]), pkbf(x[6], x[7])};
                *(u32x4*)(row + PC_DQ + blk * 512 + 8 * lane) = w;
            }
#pragma unroll
            for (int h = 0; h < 4; ++h) { const u32x2 q = m[u][h]; const float x0 = bflo(q.x), x1 = bfhi(q.x), x2 = bflo(q.y), x3 = bfhi(q.y);
                const float ss = wave_sum((x0 * x0 + x1 * x1) + (x2 * x2 + x3 * x3));
                const float rs = 1.0f / sqrtf(ss * (1.f / 192.f) + EPS);
                if (lane < 48) { const u32x2 o = {pkbf(x0 * rs * wmq[0], x1 * rs * wmq[1]), pkbf(x2 * rs * wmq[2], x3 * rs * wmq[3])}; *(u32x2*)(row + PC_MQ + h * 192 + 4 * lane) = o; } }
        }
    }
    if (half == 0) {
        bf16* MK = (bf16*)(F.ws + WS_MKV);
        for (int r = gw; r < NB * NMEM * 4; r += NGW) norm192_inplace(MK + (size_t)(r >> 2) * 1536 + (r & 3) * 192, wmk, lane);
    }
}

constexpr int SC_ST = 272, SX_ST = 528;
__device__ __forceinline__ float bfsel(const u32x4& v, int j) { const unsigned w = v[j >> 1]; return (j & 1) ? bfhi(w) : bflo(w); }
__device__ __forceinline__ void conv_task(const bf16* P, size_t rowb, int t0, int pcol, const float* cw, const float* cb, int ccol, LAS unsigned char* dst, int stride, const LAS float* scale) {
    float w[4][8], bs[8];
#pragma unroll
    for (int k = 0; k < 4; ++k) { const f32x4 a = *(const f32x4*)(cw + k * 2048 + ccol), b = *(const f32x4*)(cw + k * 2048 + ccol + 4);
        w[k][0] = a.x; w[k][1] = a.y; w[k][2] = a.z; w[k][3] = a.w; w[k][4] = b.x; w[k][5] = b.y; w[k][6] = b.z; w[k][7] = b.w; }
    { const f32x4 a = *(const f32x4*)(cb + ccol), b = *(const f32x4*)(cb + ccol + 4); bs[0] = a.x; bs[1] = a.y; bs[2] = a.z; bs[3] = a.w; bs[4] = b.x; bs[5] = b.y; bs[6] = b.z; bs[7] = b.w; }
    const bf16* src = P + (rowb + t0) * NPROJ + pcol;
    u32x4 rw[19];
#pragma unroll
    for (int i = 0; i < 3; ++i) rw[i] = (u32x4){0u, 0u, 0u, 0u};
    if (t0 > 0) {
#pragma unroll
        for (int i = 0; i < 3; ++i) rw[i] = *(const u32x4*)(src + (ptrdiff_t)(i - 3) * NPROJ); }
#pragma unroll
    for (int i = 0; i < 16; ++i) rw[3 + i] = *(const u32x4*)(src + (size_t)i * NPROJ);
#pragma unroll
    for (int i = 0; i < 16; ++i) {
        float o[8];
#pragma unroll
        for (int j = 0; j < 8; ++j) { float a = bs[j] + w[0][j] * bfsel(rw[i], j) + w[1][j] * bfsel(rw[i + 1], j) + w[2][j] * bfsel(rw[i + 2], j) + w[3][j] * bfsel(rw[i + 3], j); o[j] = a * sigmoidf_(a); }
        if (scale) { const float sv = scale[i];
#pragma unroll
            for (int j = 0; j < 8; ++j) o[j] *= sv; }
        const u32x4 r = {pkbf(o[0], o[1]), pkbf(o[2], o[3]), pkbf(o[4], o[5]), pkbf(o[6], o[7])};
        *(LAS u32x4*)(dst + i * stride) = r;
    }
}
__device__ __forceinline__ float ssd_scan(Frame& F, const float* DTp, size_t tok0, int g, LAS float* sAc, LAS float* sDt) {
    float total = 0.f;
    if (F.wave < 4) {
        const int head = 4 * g + F.wave, lane = F.lane;
        const float A = -__expf(F.in[I_ALOG][head]);
        const float d0 = DTp[(tok0 + 2 * lane) * 16 + head], d1 = DTp[(tok0 + 2 * lane + 1) * 16 + head];
        const float a0 = d0 * A, a1 = d1 * A;
        float sc = a0 + a1;
#pragma unroll
        for (int o = 1; o < 64; o <<= 1) { const float v = __shfl_up(sc, o); if (lane >= o) sc += v; }
        sAc[F.wave * 128 + 2 * lane] = sc - a1; sAc[F.wave * 128 + 2 * lane + 1] = sc;
        sDt[F.wave * 128 + 2 * lane] = d0; sDt[F.wave * 128 + 2 * lane + 1] = d1;
        total = __shfl(sc, 63);
    }
    return total;
}
__device__ __forceinline__ bf16x8 tr_pair(unsigned a_lo, unsigned a_hi) {
    s16x4 lo, hi;
    asm volatile("ds_read_b64_tr_b16 %0, %2\n\tds_read_b64_tr_b16 %1, %3\n\ts_waitcnt lgkmcnt(0)" : "=&v"(lo), "=&v"(hi) : "v"(a_lo), "v"(a_hi) : "memory");
    const bf16x8 r = {lo[0], lo[1], lo[2], lo[3], hi[0], hi[1], hi[2], hi[3]}; return r;
}

__device__ __forceinline__ void ssdC_phase(Frame& F, int half) {
    const bf16* P = (const bf16*)(F.ws + WS_BIG);
    const float* DTp = (const float*)(F.ws + WS_DT);
    float* SST = (float*)(F.ws + WS_SST); float* DEC = (float*)(F.ws + WS_DEC);
    LAS unsigned char* sX = F.lds; LAS unsigned char* sB = F.lds + 128 * SX_ST;
    LAS float* sAc = (LAS float*)(F.lds + 128 * SX_ST + 128 * SC_ST); LAS float* sDt = sAc + 512; LAS float* sW = sDt + 512;
    const int wave = F.wave;
    for (int unit = F.bid; unit < HB * 64 * 4; unit += F.G) {
        int tid = F.tid; asm volatile("" : "+v"(tid));
        const int lane = tid & 63, ql = lane & 31, h = lane >> 5, tq = (lane & 15) >> 2, tp = lane & 3, tblk = (lane >> 4) & 1;
        const int bl = unit >> 8, c = (unit >> 2) & 63, g = unit & 3;
        const size_t rowb = (size_t)bl * SEQ, tok0 = (size_t)half * HT + rowb + c * 128;
        __syncthreads();
        const float total = ssd_scan(F, DTp, tok0, g, sAc, sDt);
        if (wave < 4) { sW[wave * 128 + 2 * lane] = __expf(total - sAc[wave * 128 + 2 * lane]) * sDt[wave * 128 + 2 * lane];
            sW[wave * 128 + 2 * lane + 1] = __expf(total - sAc[wave * 128 + 2 * lane + 1]) * sDt[wave * 128 + 2 * lane + 1];
            if (lane == 0) DEC[((size_t)bl * 64 + c) * 16 + 4 * g + wave] = __expf(total); }
        __syncthreads();
        if (tid < 384) {
            int ch, strip, ccol, stride; LAS unsigned char* dst; const LAS float* scl = nullptr;
            if (tid < 256) { ch = tid & 31; strip = tid >> 5; ccol = g * 256 + 8 * ch; stride = SX_ST; dst = sX + (strip * 16) * SX_ST + ch * 16; scl = sW + (ch >> 3) * 128 + strip * 16; }
            else { const int u = tid - 256; ch = u & 15; strip = u >> 4; ccol = 1024 + g * 128 + 8 * ch; stride = SC_ST; dst = sB + (strip * 16) * SC_ST + ch * 16; }
            conv_task(P, rowb, c * 128 + strip * 16, PC_X + ccol, F.in[I_CONVW], F.in[I_CONVB], ccol, dst, stride, scl);
        }
        __syncthreads();
        const int r = wave >> 1, pt = wave & 1;
        f32x16 acc[4];
#pragma unroll
        for (int nt = 0; nt < 4; ++nt)
#pragma unroll
            for (int e = 0; e < 16; ++e) acc[nt][e] = 0.f;
        const unsigned xa = (unsigned)(size_t)sX + (unsigned)((8 * h + tq) * SX_ST + (r * 64 + 32 * pt + 16 * tblk + 4 * tp) * 2);
        const unsigned ba = (unsigned)(size_t)sB + (unsigned)((8 * h + tq) * SC_ST + (16 * tblk + 4 * tp) * 2);
#pragma unroll
        for (int ks = 0; ks < 8; ++ks) {
            const bf16x8 af = tr_pair(xa + ks * 16 * SX_ST, xa + ks * 16 * SX_ST + 4 * SX_ST);
            bf16x8 bfr[4];
#pragma unroll
            for (int nt = 0; nt < 4; ++nt) bfr[nt] = tr_pair(ba + ks * 16 * SC_ST + nt * 64, ba + ks * 16 * SC_ST + 4 * SC_ST + nt * 64);
            __builtin_amdgcn_sched_barrier(0);
#pragma unroll
            for (int nt = 0; nt < 4; ++nt) acc[nt] = MFMA32(af, bfr[nt], acc[nt]);
        }
        float* out = SST + (((size_t)bl * 64 + c) * 16 + 4 * g + r) * 8192;
#pragma unroll
        for (int nt = 0; nt < 4; ++nt)
#pragma unroll
            for (int e = 0; e < 16; ++e) out[(32 * pt + (e & 3) + 8 * (e >> 2) + 4 * h) * 128 + 32 * nt + ql] = acc[nt][e];
    }
}

__device__ __forceinline__ void ssdD_phase(Frame& F) {
    const float* SST = (const float*)(F.ws + WS_SST); const float* DEC = (const float*)(F.ws + WS_DEC);
    bf16* SIN = (bf16*)(F.ws + WS_SIN);
    const size_t gtid = (size_t)F.bid * NTHR + F.tid, gth = (size_t)F.G * NTHR;
    for (size_t it = gtid; it < (size_t)HB * 16 * 2048; it += gth) {
        const int bl = (int)(it >> 15), head = (int)(it >> 11) & 15, e4 = (int)(it & 2047) * 4;
        f32x4 st = {0.f, 0.f, 0.f, 0.f};
#pragma unroll 8
        for (int c = 0; c < 64; ++c) {
            const size_t idx = (((size_t)bl * 64 + c) * 16 + head);
            const u32x2 o = {pkbf(st.x, st.y), pkbf(st.z, st.w)};
            *(u32x2*)(SIN + idx * 8192 + e4) = o;
            const f32x4 sl = *(const f32x4*)(SST + idx * 8192 + e4); const float d = DEC[idx];
            st = st * d + sl;
        }
    }
}

__device__ __forceinline__ void ssdE_phase(Frame& F, int half) {
    const bf16* P = (const bf16*)(F.ws + WS_BIG);
    const float* DTp = (const float*)(F.ws + WS_DT);
    const bf16* SIN = (const bf16*)(F.ws + WS_SIN);
    bf16* Y = (bf16*)F.out;
    LAS unsigned char* sX = F.lds; LAS unsigned char* sB = F.lds + 128 * SX_ST; LAS unsigned char* sC = sB + 128 * SC_ST;
    LAS float* sAc = (LAS float*)(sC + 128 * SC_ST); LAS float* sDt = sAc + 512; LAS float* sSS = sDt + 512;
    const int wave = F.wave;
    const int st = wave & 3, hp = wave >> 2;
    for (int unit = F.bid; unit < HB * 64 * 4; unit += F.G) {
        int tid = F.tid; asm volatile("" : "+v"(tid));
        const int lane = tid & 63, ql = lane & 31, h = lane >> 5, tq = (lane & 15) >> 2, tp = lane & 3, tblk = (lane >> 4) & 1;
        const int bl = unit >> 8, c = (unit >> 2) & 63, g = unit & 3;
        const size_t rowb = (size_t)bl * SEQ, tok0 = (size_t)half * HT + rowb + c * 128;
        __syncthreads();
        (void)ssd_scan(F, DTp, tok0, g, sAc, sDt);
        if (tid < 128) sSS[tid] = 0.f;
        {
            int ch, strip, ccol, stride; LAS unsigned char* dst;
            if (tid < 256) { ch = tid & 31; strip = tid >> 5; ccol = g * 256 + 8 * ch; stride = SX_ST; dst = sX + (strip * 16) * SX_ST + ch * 16; }
            else if (tid < 384) { const int u = tid - 256; ch = u & 15; strip = u >> 4; ccol = 1024 + g * 128 + 8 * ch; stride = SC_ST; dst = sB + (strip * 16) * SC_ST + ch * 16; }
            else { const int u = tid - 384; ch = u & 15; strip = u >> 4; ccol = 1536 + g * 128 + 8 * ch; stride = SC_ST; dst = sC + (strip * 16) * SC_ST + ch * 16; }
            conv_task(P, rowb, c * 128 + strip * 16, PC_X + ccol, F.in[I_CONVW], F.in[I_CONVB], ccol, dst, stride, nullptr);
        }
        __syncthreads();
        const int s = 32 * st + ql;
        unsigned yk[2][2][8];
        float ssq = 0.f;
        const unsigned xa = (unsigned)(size_t)sX + (unsigned)((4 * h + tq) * SX_ST + (16 * tblk + 4 * tp) * 2);
#pragma unroll
        for (int hq = 0; hq < 2; ++hq) {
            const int r = 2 * hp + hq, head = 4 * g + r;
            const float acs = sAc[r * 128 + s];
            const bf16* stp = SIN + (((size_t)bl * 64 + c) * 16 + head) * 8192 + ql * 128 + 8 * h;
            bf16x8 sfr[2][8];
#pragma unroll
            for (int pt = 0; pt < 2; ++pt)
#pragma unroll
                for (int ks = 0; ks < 8; ++ks) sfr[pt][ks] = *(const bf16x8*)(stp + pt * 4096 + 16 * ks);
            bf16x8 pf[4][2];
#pragma unroll
            for (int i = 0; i < 4; ++i) {
                f32x16 Xi;
#pragma unroll
                for (int e = 0; e < 16; ++e) Xi[e] = 0.f;
#pragma unroll
                for (int ks = 0; ks < 8; ++ks) { const bf16x8 bf_ = *(const LAS bf16x8*)(sB + (32 * i + ql) * SC_ST + 32 * ks + 16 * h);
                    const bf16x8 cf = *(const LAS bf16x8*)(sC + s * SC_ST + 32 * ks + 16 * h); Xi = MFMA32(bf_, cf, Xi); }
                float p[16];
#pragma unroll
                for (int q4 = 0; q4 < 4; ++q4) { const int t0 = 32 * i + 8 * q4 + 4 * h;
                    const f32x4 at = *(const LAS f32x4*)(sAc + r * 128 + t0), dt4 = *(const LAS f32x4*)(sDt + r * 128 + t0);
#pragma unroll
                    for (int e = 0; e < 4; ++e) { const int t = t0 + e; p[4 * q4 + e] = (t <= s) ? Xi[4 * q4 + e] * __expf(acs - at[e]) * dt4[e] : 0.f; } }
#pragma unroll
                for (int s2 = 0; s2 < 2; ++s2) { const u32x4 w = {pkbf(p[8 * s2 + 0], p[8 * s2 + 1]), pkbf(p[8 * s2 + 2], p[8 * s2 + 3]), pkbf(p[8 * s2 + 4], p[8 * s2 + 5]), pkbf(p[8 * s2 + 6], p[8 * s2 + 7])};
                    pf[i][s2] = __builtin_bit_cast(bf16x8, w); }
            }
            const float eacs = __expf(acs), Dh = F.in[I_SSDD][head];
#pragma unroll
            for (int pt = 0; pt < 2; ++pt) {
                f32x16 yd, yo;
#pragma unroll
                for (int e = 0; e < 16; ++e) { yd[e] = 0.f; yo[e] = 0.f; }
#pragma unroll
                for (int i = 0; i < 4; ++i) {
#pragma unroll
                    for (int s2 = 0; s2 < 2; ++s2) { const unsigned a = xa + (unsigned)((32 * i + 16 * s2) * SX_ST + (r * 64 + 32 * pt) * 2);
                        const bf16x8 xf = tr_pair(a, a + 8 * SX_ST); __builtin_amdgcn_sched_barrier(0); yd = MFMA32(xf, pf[i][s2], yd); }
                }
#pragma unroll
                for (int ks = 0; ks < 8; ++ks) { const bf16x8 cf = *(const LAS bf16x8*)(sC + s * SC_ST + 32 * ks + 16 * h); yo = MFMA32(sfr[pt][ks], cf, yo); }
                const bf16* zp = P + (rowb + c * 128 + s) * NPROJ + PC_Z + g * 256 + r * 64 + 32 * pt + 4 * h;
                u32x2 zv[4];
#pragma unroll
                for (int q4 = 0; q4 < 4; ++q4) zv[q4] = *(const u32x2*)(zp + 8 * q4);
#pragma unroll
                for (int q4 = 0; q4 < 4; ++q4) {
                    const u32x2 xv = *(const LAS u32x2*)(sX + s * SX_ST + (r * 64 + 32 * pt + 8 * q4 + 4 * h) * 2);
                    const u32x2 zq = zv[q4];
                    const float xs_[4] = {bflo(xv.x), bfhi(xv.x), bflo(xv.y), bfhi(xv.y)}, zs_[4] = {bflo(zq.x), bfhi(zq.x), bflo(zq.y), bfhi(zq.y)};
                    float yv[4];
#pragma unroll
                    for (int e = 0; e < 4; ++e) { float y = yd[4 * q4 + e] + eacs * yo[4 * q4 + e] + Dh * xs_[e]; y = y * zs_[e] * sigmoidf_(zs_[e]); yv[e] = y; ssq += y * y; }
                    yk[hq][pt][2 * q4] = pkbf(yv[0], yv[1]); yk[hq][pt][2 * q4 + 1] = pkbf(yv[2], yv[3]);
                }
            }
        }
        ssq += __shfl_xor(ssq, 32);
        if (h == 0) __hip_atomic_fetch_add(sSS + s, ssq, __ATOMIC_RELAXED, __HIP_MEMORY_SCOPE_WORKGROUP);
        __syncthreads();
        const float rs = 1.0f / sqrtf(sSS[s] * (1.f / 256.f) + EPS);
        bf16* yp = Y + (tok0 + s) * YC + g * 256 + 4 * h;
        const float* nw = F.in[I_SSDNW] + g * 256 + 4 * h;
#pragma unroll
        for (int hq = 0; hq < 2; ++hq)
#pragma unroll
            for (int pt = 0; pt < 2; ++pt)
#pragma unroll
                for (int q4 = 0; q4 < 4; ++q4) { const int cc = (2 * hp + hq) * 64 + 32 * pt + 8 * q4; const f32x4 w4 = *(const f32x4*)(nw + cc);
                    const unsigned ya = yk[hq][pt][2 * q4], yb = yk[hq][pt][2 * q4 + 1];
                    const u32x2 o = {pkbf(bflo(ya) * rs * w4.x, bfhi(ya) * rs * w4.y), pkbf(bflo(yb) * rs * w4.z, bfhi(yb) * rs * w4.w)};
                    *(u32x2*)(yp + cc) = o; }
    }
}

__device__ __forceinline__ bf16x8 mk_bf16x8(u32x2 lo, u32x2 hi) { const u32x4 v = {lo.x, lo.y, hi.x, hi.y}; return __builtin_bit_cast(bf16x8, v); }

__device__ __forceinline__ void memattn_mfma_phase(Frame& F, int half) {
    const bf16* P = (const bf16*)(F.ws + WS_BIG);
    const bf16* MKV = (const bf16*)(F.ws + WS_MKV);
    const bf16* MVT = (const bf16*)(F.ws + WS_MVT);
    bf16* Y = (bf16*)F.out;
    LAS unsigned char* sm = F.lds;
    const int tid = F.tid, lane = F.lane, wave = F.wave, ql = lane & 31, h = lane >> 5;
    constexpr int KST = 400, VST = 528;
    for (int unit = F.bid; unit < HB * 4 * 32; unit += F.G) {
        const int bl = unit >> 7, head = (unit >> 5) & 3, qt = unit & 31, b = half * HB + bl;
        const int r = bl * SEQ + qt * 256 + wave * 32 + ql;
        __syncthreads();
        for (int c = tid; c < 256 * 24; c += NTHR) { const int row = c / 24, ch = c % 24;
            *(LAS u32x4*)(sm + row * KST + ch * 16) = *(const u32x4*)(MKV + (size_t)(b * NMEM + row) * 1536 + head * 192 + ch * 8); }
        bf16x8 qf[12];
        { const bf16* qp = P + (size_t)r * NPROJ + PC_MQ + head * 192 + 8 * h;
#pragma unroll
          for (int ks = 0; ks < 12; ++ks) qf[ks] = *(const bf16x8*)(qp + 16 * ks); }
        __syncthreads();
        f32x16 sacc[8];
#pragma unroll
        for (int mt = 0; mt < 8; ++mt) {
#pragma unroll
            for (int i = 0; i < 16; ++i) sacc[mt][i] = 0.f;
#pragma unroll
            for (int ks = 0; ks < 12; ++ks) { const bf16x8 kf = *(const LAS bf16x8*)(sm + (32 * mt + ql) * KST + 32 * ks + 16 * h); sacc[mt] = MFMA32(kf, qf[ks], sacc[mt]); }
        }
        float mx = -3.0e38f;
#pragma unroll
        for (int mt = 0; mt < 8; ++mt)
#pragma unroll
            for (int i = 0; i < 16; ++i) mx = fmaxf(mx, sacc[mt][i]);
        mx = fmaxf(mx, __shfl_xor(mx, 32));
        const float sc = 0.07216878364870323f * 1.4426950408889634f;
        float l = 0.f;
        bf16x8 pf[8][2];
#pragma unroll
        for (int mt = 0; mt < 8; ++mt) {
            float p[16];
#pragma unroll
            for (int i = 0; i < 16; ++i) { p[i] = __builtin_amdgcn_exp2f((sacc[mt][i] - mx) * sc); l += p[i]; }
#pragma unroll
            for (int s2 = 0; s2 < 2; ++s2) { const u32x4 w = {pkbf(p[8 * s2 + 0], p[8 * s2 + 1]), pkbf(p[8 * s2 + 2], p[8 * s2 + 3]), pkbf(p[8 * s2 + 4], p[8 * s2 + 5]), pkbf(p[8 * s2 + 6], p[8 * s2 + 7])};
                pf[mt][s2] = __builtin_bit_cast(bf16x8, w); }
        }
        l += __shfl_xor(l, 32);
        __syncthreads();
        for (int c = tid; c < 192 * 32; c += NTHR) { const int row = c >> 5, ch = c & 31;
            *(LAS u32x4*)(sm + row * VST + ch * 16) = *(const u32x4*)(MVT + (size_t)(head * 192 + row) * 2048 + b * NMEM + ch * 8); }
        __syncthreads();
        const float il = 1.0f / l;
        bf16* yp = Y + ((size_t)half * HT + r) * YC + 1280 + head * 192 + 4 * h;
#pragma unroll
        for (int dt = 0; dt < 6; ++dt) {
            f32x16 o;
#pragma unroll
            for (int i = 0; i < 16; ++i) o[i] = 0.f;
#pragma unroll
            for (int mt = 0; mt < 8; ++mt)
#pragma unroll
                for (int s2 = 0; s2 < 2; ++s2) { const LAS unsigned char* vp = sm + (32 * dt + ql) * VST + (32 * mt + 16 * s2 + 4 * h) * 2;
                    const bf16x8 vf = mk_bf16x8(*(const LAS u32x2*)vp, *(const LAS u32x2*)(vp + 16)); o = MFMA32(vf, pf[mt][s2], o); }
#pragma unroll
            for (int g = 0; g < 4; ++g) { const u32x2 w = {pkbf(o[4 * g] * il, o[4 * g + 1] * il), pkbf(o[4 * g + 2] * il, o[4 * g + 3] * il)}; *(u32x2*)(yp + 32 * dt + 8 * g) = w; }
        }
    }
}

__device__ __forceinline__ void dilattn_mfma_phase(Frame& F, int half) {
    bf16* P = (bf16*)(F.ws + WS_BIG);
    float* LSE = (float*)(F.ws + WS_LSE);
    LAS unsigned char* sK = F.lds; LAS unsigned char* sV = F.lds + 384 * 144;
    const int tid = F.tid, lane = F.lane, wave = F.wave, ql = lane & 31, h = lane >> 5;
    constexpr int RST = 144;
    for (int unit = F.bid; unit < HB * 12 * 32; unit += F.G) {
        const int bl = unit / 384, rem = unit % 384, head = rem >> 5, blk = rem & 31;
        const int g = head >> 2, dil = (g == 0) ? 1 : (g == 1 ? 4 : 16), bpr = 32 / dil;
        const int res = blk / bpr, q0 = (blk % bpr) * 256;
        const size_t rowb = (size_t)bl * SEQ;
        __syncthreads();
        for (int c = tid; c < 384 * 8; c += NTHR) { const int row = c >> 3, ch = c & 7; const int ks = q0 - 128 + row;
            u32x4 kv = {0u, 0u, 0u, 0u}, vv = {0u, 0u, 0u, 0u};
            if (ks >= 0) { const bf16* src = P + (rowb + (size_t)ks * dil + res) * NPROJ + head * 64 + ch * 8; kv = *(const u32x4*)(src + PC_DK); vv = *(const u32x4*)(src + PC_DV); }
            *(LAS u32x4*)(sK + row * RST + ch * 16) = kv; *(LAS u32x4*)(sV + row * RST + ch * 16) = vv; }
        const int qs = q0 + wave * 32 + ql;
        const size_t rq = rowb + (size_t)qs * dil + res;
        bf16* qp = P + rq * NPROJ + PC_DQ + head * 64;
        bf16x8 qf[4];
#pragma unroll
        for (int ks = 0; ks < 4; ++ks) qf[ks] = *(const bf16x8*)(qp + 16 * ks + 8 * h);
        __syncthreads();
        f32x16 sacc[5];
        const int kfirst = q0 + wave * 32 - 128;
#pragma unroll
        for (int i = 0; i < 5; ++i) {
#pragma unroll
            for (int e = 0; e < 16; ++e) sacc[i][e] = 0.f;
#pragma unroll
            for (int ks = 0; ks < 4; ++ks) { const bf16x8 kf = *(const LAS bf16x8*)(sK + (32 * wave + 32 * i + ql) * RST + 32 * ks + 16 * h); sacc[i] = MFMA32(kf, qf[ks], sacc[i]); }
        }
        float mx = -3.0e38f;
#pragma unroll
        for (int i = 0; i < 5; ++i)
#pragma unroll
            for (int e = 0; e < 16; ++e) { const int kj = 32 * i + (e & 3) + 8 * (e >> 2) + 4 * h; const bool ok = (kj >= ql) && (kj <= ql + 128) && (kfirst + kj >= 0);
                sacc[i][e] = ok ? sacc[i][e] : -3.0e38f; mx = fmaxf(mx, sacc[i][e]); }
        mx = fmaxf(mx, __shfl_xor(mx, 32));
        const float sc = 0.125f * 1.4426950408889634f;
        float l = 0.f;
        bf16x8 pf[5][2];
#pragma unroll
        for (int i = 0; i < 5; ++i) {
            float p[16];
#pragma unroll
            for (int e = 0; e < 16; ++e) { p[e] = (sacc[i][e] > -1.0e38f) ? __builtin_amdgcn_exp2f((sacc[i][e] - mx) * sc) : 0.f; l += p[e]; }
#pragma unroll
            for (int s2 = 0; s2 < 2; ++s2) { const u32x4 w = {pkbf(p[8 * s2 + 0], p[8 * s2 + 1]), pkbf(p[8 * s2 + 2], p[8 * s2 + 3]), pkbf(p[8 * s2 + 4], p[8 * s2 + 5]), pkbf(p[8 * s2 + 6], p[8 * s2 + 7])};
                pf[i][s2] = __builtin_bit_cast(bf16x8, w); }
        }
        l += __shfl_xor(l, 32);
        const float il = 1.0f / l;
        const int tq = (lane & 15) >> 2, tp = lane & 3, tblk = (lane >> 4) & 1;
        const unsigned vbase = (unsigned)(size_t)(sV) + (unsigned)((32 * wave + 4 * h + tq) * RST + (16 * tblk + 4 * tp) * 2);
#pragma unroll
        for (int dt = 0; dt < 2; ++dt) {
            f32x16 o;
#pragma unroll
            for (int e = 0; e < 16; ++e) o[e] = 0.f;
#pragma unroll
            for (int i = 0; i < 5; ++i) {
                s16x4 lo[2], hi[2];
#pragma unroll
                for (int s2 = 0; s2 < 2; ++s2) { const unsigned a = vbase + (unsigned)((32 * i + 16 * s2) * RST + 64 * dt);
                    asm volatile("ds_read_b64_tr_b16 %0, %1" : "=&v"(lo[s2]) : "v"(a) : "memory");
                    asm volatile("ds_read_b64_tr_b16 %0, %1 offset:1152" : "=&v"(hi[s2]) : "v"(a) : "memory"); }
                asm volatile("s_waitcnt lgkmcnt(0)" ::: "memory"); __builtin_amdgcn_sched_barrier(0);
#pragma unroll
                for (int s2 = 0; s2 < 2; ++s2) { const bf16x8 vf = {lo[s2][0], lo[s2][1], lo[s2][2], lo[s2][3], hi[s2][0], hi[s2][1], hi[s2][2], hi[s2][3]}; o = MFMA32(vf, pf[i][s2], o); }
            }
#pragma unroll
            for (int gq = 0; gq < 4; ++gq) { const u32x2 w = {pkbf(o[4 * gq] * il, o[4 * gq + 1] * il), pkbf(o[4 * gq + 2] * il, o[4 * gq + 3] * il)}; *(u32x2*)(qp + 32 * dt + 8 * gq + 4 * h) = w; }
        }
        if (h == 0) LSE[((size_t)half * HT + rq) * 12 + head] = mx * 0.125f + __logf(l);
    }
}

__device__ __forceinline__ void dilmerge_phase(Frame& F, int half) {
    const bf16* P = (const bf16*)(F.ws + WS_BIG);
    const float* LSE = (const float*)(F.ws + WS_LSE);
    bf16* Y = (bf16*)F.out;
    const size_t gtid = (size_t)F.bid * NTHR + F.tid, gth = (size_t)F.G * NTHR;
    for (size_t it = gtid; it < (size_t)HT * 32; it += gth) {
        const size_t r = it >> 5; const int hh = (int)(it >> 3) & 3, d0 = (int)(it & 7) * 8;
        const size_t tok = (size_t)half * HT + r;
        const float l0 = LSE[tok * 12 + hh], l1 = LSE[tok * 12 + 4 + hh], l2 = LSE[tok * 12 + 8 + hh];
        const float m = fmaxf(l0, fmaxf(l1, l2));
        float w0 = __expf(l0 - m), w1 = __expf(l1 - m), w2 = __expf(l2 - m); const float iw = 1.0f / (w0 + w1 + w2); w0 *= iw; w1 *= iw; w2 *= iw;
        const bf16* op = P + r * NPROJ + PC_DQ + hh * 64 + d0;
        const u32x4 a = *(const u32x4*)op, b = *(const u32x4*)(op + 256), c = *(const u32x4*)(op + 512);
        u32x4 o;
        o.x = pkbf(w0 * bflo(a.x) + w1 * bflo(b.x) + w2 * bflo(c.x), w0 * bfhi(a.x) + w1 * bfhi(b.x) + w2 * bfhi(c.x));
        o.y = pkbf(w0 * bflo(a.y) + w1 * bflo(b.y) + w2 * bflo(c.y), w0 * bfhi(a.y) + w1 * bfhi(b.y) + w2 * bfhi(c.y));
        o.z = pkbf(w0 * bflo(a.z) + w1 * bflo(b.z) + w2 * bflo(c.z), w0 * bfhi(a.z) + w1 * bfhi(b.z) + w2 * bfhi(c.z));
        o.w = pkbf(w0 * bflo(a.w) + w1 * bflo(b.w) + w2 * bflo(c.w), w0 * bfhi(a.w) + w1 * bfhi(b.w) + w2 * bfhi(c.w));
        *(u32x4*)(Y + tok * YC + 1024 + hh * 64 + d0) = o;
    }
}

__device__ __forceinline__ void hn_panel(Frame& F, int pm) {
    for (int m = pm * 256 + F.wave; m < pm * 256 + 256; m += NWAVES) { f32x4 v[4]; rms_row_to_bf16(F.out + (size_t)m * DM, F.in[I_NFFNW], (bf16*)(F.ws + WS_ACT1) + (size_t)m * DM, F.lane, v); }
}
__device__ __forceinline__ void hn_phase(Frame& F) {
    const int gw = F.bid * NWAVES + F.wave, NGW = F.G * NWAVES;
    for (int m = gw; m < T; m += NGW) { f32x4 v[4]; rms_row_to_bf16(F.out + (size_t)m * DM, F.in[I_NFFNW], (bf16*)(F.ws + WS_ACT1) + (size_t)m * DM, F.lane, v); }
}


__device__ __forceinline__ float gelu_erf(float x) { return 0.5f * x * (1.0f + erff(x * 0.70710678118654752f)); }
__device__ __forceinline__ unsigned f2ord(float f) { const unsigned u = __builtin_bit_cast(unsigned, f); return u ^ ((unsigned)((int)u >> 31) | 0x80000000u); }
__device__ __forceinline__ float ord2f(unsigned k) { const unsigned m = (unsigned)((int)k >> 31); return __builtin_bit_cast(float, k ^ (0x80000000u | ~m)); }
#define CMPX(a, b) do { const unsigned _mx = max((a), (b)), _mn = min((a), (b)); (a) = _mx; (b) = _mn; } while (0)
__device__ __forceinline__ void bitonic_sort16_desc(unsigned (&v)[16]) {
#pragma unroll
    for (int k = 2; k <= 16; k <<= 1)
#pragma unroll
        for (int j = k >> 1; j > 0; j >>= 1)
#pragma unroll
            for (int i = 0; i < 16; ++i) { const int l = i ^ j; if (l > i) { if ((i & k) == 0) CMPX(v[i], v[l]); else CMPX(v[l], v[i]); } }
}
__device__ __forceinline__ void bitonic_merge16_desc(unsigned (&v)[16]) {
#pragma unroll
    for (int j = 8; j > 0; j >>= 1)
#pragma unroll
        for (int i = 0; i < 16; ++i) { const int l = i ^ j; if (l > i) CMPX(v[i], v[l]); }
}
__device__ __forceinline__ void top16_merge(unsigned (&a)[16], const unsigned (&b)[16]) {
#pragma unroll
    for (int i = 0; i < 16; ++i) a[i] = max(a[i], b[15 - i]);
    bitonic_merge16_desc(a);
}
constexpr int PK_ST = 272;
__device__ __forceinline__ void peer_topk_tile(Frame& F, size_t tok0, const bf16* Q, int* IDX, float* GATE) {
    const bf16* SK = (const bf16*)(F.ws + WS_SUBK);
    LAS unsigned char* sK = F.lds;
    int tid = F.tid; asm volatile("" : "+v"(tid));
    const int lane = tid & 63, wave = F.wave, ql = lane & 31, hh = lane >> 5;
    const size_t tok = tok0 + wave * 32 + ql;
    const bf16* qrow = Q + tok * PEER_Q + 8 * hh;
    __syncthreads();
#pragma unroll
    for (int j = 0; j < 4; ++j) { const int cidx = tid + 512 * j, row = cidx >> 4, ch = cidx & 15; *(LAS u32x4*)(sK + row * PK_ST + ch * 16) = *(const u32x4*)(SK + (size_t)row * 128 + ch * 8); }
    __syncthreads();
    unsigned k1[16];
#pragma unroll 1
    for (int hc = 0; hc < 16; ++hc) {
        LAS unsigned char* cur = sK + (hc & 1) * (128 * PK_ST); LAS unsigned char* nxt = sK + ((hc + 1) & 1) * (128 * PK_ST);
        u32x4 stg[4];
        const int hcn = (hc + 1) & 15;
#pragma unroll
        for (int j = 0; j < 4; ++j) { const int cidx = tid + 512 * j, row = cidx >> 4, ch = cidx & 15; stg[j] = *(const u32x4*)(SK + ((size_t)hcn * 128 + row) * 128 + ch * 8); }
        bf16x8 qf[8];
#pragma unroll
        for (int ks = 0; ks < 8; ++ks) qf[ks] = *(const bf16x8*)(qrow + hc * 128 + 16 * ks);
        unsigned pk[4][16];
#pragma unroll
        for (int mt = 0; mt < 4; ++mt) {
            f32x16 acc;
#pragma unroll
            for (int e = 0; e < 16; ++e) acc[e] = 0.f;
#pragma unroll
            for (int ks = 0; ks < 8; ++ks) { const bf16x8 kf = *(const LAS bf16x8*)(cur + (32 * mt + ql) * PK_ST + 32 * ks + 16 * hh); acc = MFMA32(kf, qf[ks], acc); }
#pragma unroll
            for (int e = 0; e < 16; ++e) pk[mt][e] = (f2ord(acc[e]) & 0xFFFFFF80u) | (unsigned)(32 * mt + (e & 3) + 8 * (e >> 2) + 4 * hh);
        }
#pragma unroll
        for (int j = 0; j < 4; ++j) { const int cidx = tid + 512 * j, row = cidx >> 4, ch = cidx & 15; *(LAS u32x4*)(nxt + row * PK_ST + ch * 16) = stg[j]; }
        __syncthreads();
#pragma unroll
        for (int mt = 0; mt < 4; ++mt) bitonic_sort16_desc(pk[mt]);
        top16_merge(pk[0], pk[1]); top16_merge(pk[2], pk[3]); top16_merge(pk[0], pk[2]);
        unsigned other[16];
#pragma unroll
        for (int i = 0; i < 16; ++i) other[i] = (unsigned)__shfl_xor((int)pk[0][i], 32);
        top16_merge(pk[0], other);
        if ((hc & 1) == 0) {
#pragma unroll
            for (int i = 0; i < 16; ++i) k1[i] = pk[0][i];
        } else {
            float f1[16], f2[16];
#pragma unroll
            for (int i = 0; i < 16; ++i) { f1[i] = ord2f(k1[i] & 0xFFFFFF80u); f2[i] = ord2f(pk[0][i] & 0xFFFFFF80u); }
            unsigned cd[4][16];
#pragma unroll
            for (int i = 0; i < 64; ++i) cd[i >> 4][i & 15] = 0u;
            int n = 0;
#pragma unroll
            for (int a = 0; a < 16; ++a)
#pragma unroll
                for (int b = 0; b < 16; ++b)
                    if ((a + 1) * (b + 1) <= 16) { cd[n >> 4][n & 15] = (f2ord(f1[a] + f2[b]) & 0xFFFFC000u) | ((k1[a] & 127u) << 7) | (pk[0][b] & 127u); ++n; }
#pragma unroll
            for (int g4 = 0; g4 < 4; ++g4) bitonic_sort16_desc(cd[g4]);
            top16_merge(cd[0], cd[1]); top16_merge(cd[2], cd[3]); top16_merge(cd[0], cd[2]);
            const float vmax = ord2f(cd[0][0] & 0xFFFFC000u);
            float ex[16], den = 0.f;
#pragma unroll
            for (int i = 0; i < 16; ++i) { ex[i] = __expf(ord2f(cd[0][i] & 0xFFFFC000u) - vmax); den += ex[i]; }
            const float iden = 1.0f / den;
            const int h = hc >> 1;
            if (hh == 0) { int* ip = IDX + tok * 128 + h * 16;
#pragma unroll
                for (int i = 0; i < 4; ++i) { const u32x4 w = {cd[0][4 * i] & 0x3FFFu, cd[0][4 * i + 1] & 0x3FFFu, cd[0][4 * i + 2] & 0x3FFFu, cd[0][4 * i + 3] & 0x3FFFu}; *(u32x4*)(ip + 4 * i) = w; } }
            else { float* gp = GATE + tok * 128 + h * 16;
#pragma unroll
                for (int i = 0; i < 4; ++i) { const f32x4 w = {ex[4 * i] * iden, ex[4 * i + 1] * iden, ex[4 * i + 2] * iden, ex[4 * i + 3] * iden}; *(f32x4*)(gp + 4 * i) = w; } }
        }
    }
}

struct PeerDeal { size_t tokw; int ntok; size_t tok0; float* PART; const int* IDX; const float* GATE; float* COEF; };
__device__ __forceinline__ void peer_item(int n, const PeerDeal& D, int wave, int& slice, size_t& tok) { slice = n >> 5; tok = D.tokw + (n & 31); }
__device__ __forceinline__ void peer_down_rows(u32x4 (&R)[16], __amdgpu_buffer_rsrc_t tab, int slice, int id0, int id1, int lane) {
    const int soff = slice * (16384 * 128);
    const int r = lane & 15, g = lane >> 4, e8 = (r >> 2) + 4 * (g >> 1), q = 4 * (g & 1) + (r & 3);
    const int src0 = 16 * (e8 & 3);
#pragma unroll
    for (int k = 0; k < 16; ++k) { const int v0 = __shfl(id0, src0 + k), v1 = __shfl(id1, src0 + k); const int id = (e8 < 4) ? v0 : v1;
        R[k] = __builtin_amdgcn_raw_buffer_load_b128(tab, (id << 7) + 16 * q, soff, 0); }
}
__device__ __forceinline__ void peer_down_hn(u32x4 (&H)[2], const bf16* HN, int slice, size_t tok, int lane) {
    const bf16* hp = HN + tok * DM + slice * 128 + 16 * (4 * ((lane >> 4) & 1) + (lane & 3));
    H[0] = *(const u32x4*)hp; H[1] = *(const u32x4*)(hp + 8);
}
__device__ __forceinline__ void peer_down_bq(long (&bq)[2], const u32x4 (&H)[2], int lane) {
    const int c = lane & 15, g = lane >> 4; const bool on = (c < 8) && ((c >> 2) == (g >> 1));
    const u32x4 x0 = H[0], x1 = H[1];
    unsigned p0 = __builtin_amdgcn_cvt_pk_fp8_f32(bflo(x0.x), bfhi(x0.x), 0, false); p0 = __builtin_amdgcn_cvt_pk_fp8_f32(bflo(x0.y), bfhi(x0.y), p0, true);
    unsigned p1 = __builtin_amdgcn_cvt_pk_fp8_f32(bflo(x0.z), bfhi(x0.z), 0, false); p1 = __builtin_amdgcn_cvt_pk_fp8_f32(bflo(x0.w), bfhi(x0.w), p1, true);
    unsigned p2 = __builtin_amdgcn_cvt_pk_fp8_f32(bflo(x1.x), bfhi(x1.x), 0, false); p2 = __builtin_amdgcn_cvt_pk_fp8_f32(bflo(x1.y), bfhi(x1.y), p2, true);
    unsigned p3 = __builtin_amdgcn_cvt_pk_fp8_f32(bflo(x1.z), bfhi(x1.z), 0, false); p3 = __builtin_amdgcn_cvt_pk_fp8_f32(bflo(x1.w), bfhi(x1.w), p3, true);
    if (!on) { p0 = 0u; p1 = 0u; p2 = 0u; p3 = 0u; }
    bq[0] = (long)(((unsigned long long)p1 << 32) | p0); bq[1] = (long)(((unsigned long long)p3 << 32) | p2);
}
__device__ __forceinline__ void peer_down_mfma(const u32x4 (&R)[16], const long (&bq)[2], __amdgpu_buffer_rsrc_t prsrc, int slice, int tokl, int lane) {
    const int c = lane & 15, g = lane >> 4, cb = c & 3;
    float dv[16];
#pragma unroll
    for (int k = 0; k < 16; ++k) { f32x4 acc = {0.f, 0.f, 0.f, 0.f}; const u32x4 v = R[k];
        acc = __builtin_amdgcn_mfma_f32_16x16x32_fp8_fp8((long)(((unsigned long long)v.y << 32) | v.x), bq[0], acc, 0, 0, 0);
        acc = __builtin_amdgcn_mfma_f32_16x16x32_fp8_fp8((long)(((unsigned long long)v.w << 32) | v.z), bq[1], acc, 0, 0, 0);
        float t = (cb == 0) ? acc.x : (cb == 1) ? acc.y : (cb == 2) ? acc.z : acc.w;
        t += __shfl_xor(t, 1); t += __shfl_xor(t, 2); dv[k] = t; }
    const unsigned off = ((c & 3) == 0 && c < 8) ? (unsigned)(((tokl * 8 + slice) * 128 + 16 * (g + 4 * (c >> 2))) * 4) : 0xFFFFFF00u;
#pragma unroll
    for (int i = 0; i < 4; ++i) { const f32x4 w = {dv[4 * i], dv[4 * i + 1], dv[4 * i + 2], dv[4 * i + 3]}; __builtin_amdgcn_raw_buffer_store_b128(__builtin_bit_cast(u32x4, w), prsrc, off, 16 * i, 0); }
}
__device__ __forceinline__ void peer_down_phase(Frame& F, const PeerDeal& D) {
    const __amdgpu_buffer_rsrc_t PD = __builtin_amdgcn_make_buffer_rsrc((void*)(F.ws + WS_PD), 0, 16384 * 1024, 0x00020000); const bf16* HN = (const bf16*)(F.ws + WS_ACT1);
    const int* IDX = D.IDX;
    const __amdgpu_buffer_rsrc_t prsrc = __builtin_amdgcn_make_buffer_rsrc((void*)D.PART, 0, 256 * 8 * 128 * 4, 0x00020000);
    int lane = F.lane; asm volatile("" : "+v"(lane));
    const int wave = F.wave;
    const int ntok = D.ntok;
    u32x4 RA[16], RB[16], HA[2], HB[2]; int ia0, ia1, ib0, ib1; long bq[2];
#define PEER_TOK(k, sv, tv) int sv; size_t tv; peer_item((k) < ntok ? (k) : ntok - 2 + ((k) & 1), D, wave, sv, tv)
    { PEER_TOK(0, s0, t0); PEER_TOK(1, s1, t1); PEER_TOK(2, s2, t2); PEER_TOK(3, s3, t3);
      const int a0 = IDX[t0 * 128 + lane], a1 = IDX[t0 * 128 + 64 + lane], b0 = IDX[t1 * 128 + lane], b1 = IDX[t1 * 128 + 64 + lane];
      ia0 = IDX[t2 * 128 + lane]; ia1 = IDX[t2 * 128 + 64 + lane]; ib0 = IDX[t3 * 128 + lane]; ib1 = IDX[t3 * 128 + 64 + lane];
      __builtin_amdgcn_sched_barrier(0);
      peer_down_rows(RA, PD, s0, a0, a1, lane); peer_down_hn(HA, HN, s0, t0, lane);
      __builtin_amdgcn_sched_barrier(0);
      peer_down_rows(RB, PD, s1, b0, b1, lane); peer_down_hn(HB, HN, s1, t1, lane);
      __builtin_amdgcn_sched_barrier(0); }
#pragma unroll 1
    for (int n = 0; n < ntok; n += 2) {
        PEER_TOK(n, s0, t0); PEER_TOK(n + 1, s1, t1); PEER_TOK(n + 2, s2, t2); PEER_TOK(n + 3, s3, t3); PEER_TOK(n + 4, s4, t4); PEER_TOK(n + 5, s5, t5);
        peer_down_bq(bq, HA, lane);
        peer_down_mfma(RA, bq, prsrc, s0, (int)(t0 - D.tok0), lane);
        __builtin_amdgcn_sched_barrier(0);
        { const int j0 = IDX[t4 * 128 + lane], j1 = IDX[t4 * 128 + 64 + lane];
          peer_down_rows(RA, PD, s2, ia0, ia1, lane); peer_down_hn(HA, HN, s2, t2, lane); ia0 = j0; ia1 = j1; }
        __builtin_amdgcn_sched_barrier(0);
        peer_down_bq(bq, HB, lane);
        peer_down_mfma(RB, bq, prsrc, s1, (int)(t1 - D.tok0), lane);
        __builtin_amdgcn_sched_barrier(0);
        { const int j0 = IDX[t5 * 128 + lane], j1 = IDX[t5 * 128 + 64 + lane];
          peer_down_rows(RB, PD, s3, ib0, ib1, lane); peer_down_hn(HB, HN, s3, t3, lane); ib0 = j0; ib1 = j1; }
        __builtin_amdgcn_sched_barrier(0);
    }
#undef PEER_TOK
}
__device__ __forceinline__ void peer_coef_wave(Frame& F, const PeerDeal& D) {
    for (int k = F.lane; k < 32 * 32; k += 64) {
        const int tl = (int)(D.tokw - D.tok0) + (k >> 5), slot = 4 * (k & 31);
        const float* pp = D.PART + (size_t)tl * 1024 + slot;
        f32x4 sm = *(const f32x4*)pp;
#pragma unroll
        for (int x = 1; x < 8; ++x) sm += *(const f32x4*)(pp + 128 * x);
        const size_t i = (D.tok0 + tl) * 128 + slot;
        const f32x4 gt = *(const f32x4*)(D.GATE + i);
        const f32x4 o = {gt.x * gelu_erf(sm.x * (1.0f / PD_SCALE)) * (1.0f / PU_SCALE), gt.y * gelu_erf(sm.y * (1.0f / PD_SCALE)) * (1.0f / PU_SCALE),
                         gt.z * gelu_erf(sm.z * (1.0f / PD_SCALE)) * (1.0f / PU_SCALE), gt.w * gelu_erf(sm.w * (1.0f / PD_SCALE)) * (1.0f / PU_SCALE)};
        *(f32x4*)(D.COEF + i) = o;
    }
}
__device__ __forceinline__ void peer_up_rows(u32x4 (&R)[16], __amdgpu_buffer_rsrc_t tab, int slice, int id0, int id1, int lane) {
    const int soff = slice * (16384 * 128);
#pragma unroll
    for (int s8 = 0; s8 < 8; ++s8) { const int id = __shfl(s8 < 4 ? id0 : id1, (16 * s8 + (lane >> 2)) & 63); const int vo = (id << 7) + 16 * (lane & 3);
        R[2 * s8] = __builtin_amdgcn_raw_buffer_load_b128(tab, vo, soff, 0); R[2 * s8 + 1] = __builtin_amdgcn_raw_buffer_load_b128(tab, vo, soff + 64, 0); }
}
__device__ __forceinline__ void peer_up_compute(const u32x4 (&R)[16], float c0, float c1, f32x2 h, float* out, int slice, size_t tok, int lane) {
    f32x2 acc[16];
#pragma unroll
    for (int k = 0; k < 16; ++k) acc[k] = (f32x2){0.f, 0.f};
#pragma unroll
    for (int s8 = 0; s8 < 8; ++s8) { const float c = __shfl(s8 < 4 ? c0 : c1, (16 * s8 + (lane >> 2)) & 63); f32x2 c2 = {c, c}; asm volatile("" : "+v"(c2));
#pragma unroll
        for (int hf = 0; hf < 2; ++hf) { const u32x4 r = R[2 * s8 + hf];
            acc[8 * hf + 0] = c2 * __builtin_amdgcn_cvt_pk_f32_fp8(r.x, false) + acc[8 * hf + 0]; acc[8 * hf + 1] = c2 * __builtin_amdgcn_cvt_pk_f32_fp8(r.x, true) + acc[8 * hf + 1];
            acc[8 * hf + 2] = c2 * __builtin_amdgcn_cvt_pk_f32_fp8(r.y, false) + acc[8 * hf + 2]; acc[8 * hf + 3] = c2 * __builtin_amdgcn_cvt_pk_f32_fp8(r.y, true) + acc[8 * hf + 3];
            acc[8 * hf + 4] = c2 * __builtin_amdgcn_cvt_pk_f32_fp8(r.z, false) + acc[8 * hf + 4]; acc[8 * hf + 5] = c2 * __builtin_amdgcn_cvt_pk_f32_fp8(r.z, true) + acc[8 * hf + 5];
            acc[8 * hf + 6] = c2 * __builtin_amdgcn_cvt_pk_f32_fp8(r.w, false) + acc[8 * hf + 6]; acc[8 * hf + 7] = c2 * __builtin_amdgcn_cvt_pk_f32_fp8(r.w, true) + acc[8 * hf + 7]; } }
    f32x2 r8[8], r4[4], r2[2], r1;
    { const bool up = (lane & 32) != 0;
#pragma unroll
      for (int k = 0; k < 8; ++k) { const f32x2 keep = up ? acc[k + 8] : acc[k], send = up ? acc[k] : acc[k + 8]; r8[k] = keep + (f32x2){__shfl_xor(send.x, 32), __shfl_xor(send.y, 32)}; } }
    { const bool up = (lane & 16) != 0;
#pragma unroll
      for (int k = 0; k < 4; ++k) { const f32x2 keep = up ? r8[k + 4] : r8[k], send = up ? r8[k] : r8[k + 4]; r4[k] = keep + (f32x2){__shfl_xor(send.x, 16), __shfl_xor(send.y, 16)}; } }
    { const bool up = (lane & 8) != 0;
#pragma unroll
      for (int k = 0; k < 2; ++k) { const f32x2 keep = up ? r4[k + 2] : r4[k], send = up ? r4[k] : r4[k + 2]; r2[k] = keep + (f32x2){__shfl_xor(send.x, 8), __shfl_xor(send.y, 8)}; } }
    { const bool up = (lane & 4) != 0; const f32x2 keep = up ? r2[1] : r2[0], send = up ? r2[0] : r2[1]; r1 = keep + (f32x2){__shfl_xor(send.x, 4), __shfl_xor(send.y, 4)}; }
    const int p = ((lane >> 5) & 1) * 8 + ((lane >> 4) & 1) * 4 + ((lane >> 3) & 1) * 2 + ((lane >> 2) & 1);
    *(f32x2*)(out + tok * DM + slice * 128 + 16 * (lane & 3) + 2 * (p & 7) + 64 * (p >> 3)) = h + r1;
}
__device__ __forceinline__ void peer_up_phase(Frame& F, const PeerDeal& D, float* outp) {
    const __amdgpu_buffer_rsrc_t PU = __builtin_amdgcn_make_buffer_rsrc((void*)(F.ws + WS_PU), 0, 16384 * 1024, 0x00020000);
    const int* IDX = D.IDX; const float* COEF = D.COEF;
    int lane = F.lane; asm volatile("" : "+v"(lane));
    const int wave = F.wave;
    const int ntok = D.ntok;
    const int p = ((lane >> 5) & 1) * 8 + ((lane >> 4) & 1) * 4 + ((lane >> 3) & 1) * 2 + ((lane >> 2) & 1);
    const int hoff = 16 * (lane & 3) + 2 * (p & 7) + 64 * (p >> 3);
    int sl; size_t tk;
    u32x4 R0[16], R1[16];
    float ca0, ca1, cb0, cb1; f32x2 ha, hb;
    int id0, id1, jd0, jd1;
    { int s1_; size_t t1_; peer_item(0, D, wave, sl, tk); peer_item(1, D, wave, s1_, t1_);
      jd0 = IDX[tk * 128 + lane]; jd1 = IDX[tk * 128 + 64 + lane]; id0 = IDX[t1_ * 128 + lane]; id1 = IDX[t1_ * 128 + 64 + lane];
      __builtin_amdgcn_sched_barrier(0);
      peer_up_rows(R0, PU, sl, jd0, jd1, lane);
      ca0 = COEF[tk * 128 + lane]; ca1 = COEF[tk * 128 + 64 + lane]; ha = *(const f32x2*)(F.out + tk * DM + sl * 128 + hoff);
      __builtin_amdgcn_sched_barrier(0); }
#pragma unroll 1
    for (int n = 0; n < ntok; n += 2) {
        int s0, s1, s2, s3; size_t t0, t1, t2, t3;
        peer_item(n, D, wave, s0, t0); peer_item(n + 1, D, wave, s1, t1);
        peer_item(n + 2 < ntok ? n + 2 : n, D, wave, s2, t2); peer_item(n + 3 < ntok ? n + 3 : n + 1, D, wave, s3, t3);
        jd0 = IDX[t2 * 128 + lane]; jd1 = IDX[t2 * 128 + 64 + lane];
        peer_up_rows(R1, PU, s1, id0, id1, lane);
        cb0 = COEF[t1 * 128 + lane]; cb1 = COEF[t1 * 128 + 64 + lane]; hb = *(const f32x2*)(F.out + t1 * DM + s1 * 128 + hoff);
        __builtin_amdgcn_sched_barrier(0);
        peer_up_compute(R0, ca0, ca1, ha, outp, s0, t0, lane);
        __builtin_amdgcn_sched_barrier(0);
        id0 = IDX[t3 * 128 + lane]; id1 = IDX[t3 * 128 + 64 + lane];
        peer_up_rows(R0, PU, s2, jd0, jd1, lane);
        ca0 = COEF[t2 * 128 + lane]; ca1 = COEF[t2 * 128 + 64 + lane]; ha = *(const f32x2*)(F.out + t2 * DM + s2 * 128 + hoff);
        __builtin_amdgcn_sched_barrier(0);
        peer_up_compute(R1, cb0, cb1, hb, outp, s1, t1, lane);
        __builtin_amdgcn_sched_barrier(0);
    }
}
__device__ __forceinline__ void peer_tile(Frame& F, int tile) {
    const size_t tok0 = (size_t)tile * 256;
    const bf16* Q = (const bf16*)(F.ws + WS_BIG);
    int* IDX = (int*)(F.ws + WS_BIG + 256 * MiB); float* GATE = (float*)(F.ws + WS_BIG + 288 * MiB); float* COEF = (float*)(F.ws + WS_BIG + 320 * MiB);
    peer_topk_tile(F, tok0, Q, IDX, GATE);
    VM_WAIT(); __syncthreads();
    PeerDeal D; D.tokw = tok0 + F.wave * 32; D.ntok = 256; D.tok0 = tok0; D.PART = (float*)(F.ws + WS_BIG + tok0 * (PEER_Q * 2)); D.IDX = IDX; D.GATE = GATE; D.COEF = COEF;
    peer_down_phase(F, D);
    VM_WAIT(); __syncthreads();
    peer_coef_wave(F, D);
    VM_WAIT(); __syncthreads();
    peer_up_phase(F, D, F.out);
}
__device__ __forceinline__ void peer_phase(Frame& F) { for (int tile = F.bid; tile < T / 256; tile += F.G) { peer_tile(F, tile); VM_WAIT(); __syncthreads(); } }

constexpr int N_PHASES = 15;
__global__ void __launch_bounds__(NTHR, 2) mega_fwd(Args args) {
    extern __shared__ __attribute__((aligned(16))) unsigned char lds_raw[];
    Frame F;
    F.lds = (LAS unsigned char*)lds_raw;
    F.tid = threadIdx.x; F.lane = F.tid & 63; F.wave = __builtin_amdgcn_readfirstlane(F.tid >> 6);
    F.G = gridDim.x; F.bid = blockIdx.x;
    F.in = args.in;
    F.positions = args.positions; F.out = args.out; F.ws = args.ws;
    unsigned char* ws = args.ws;
    volatile LAS unsigned* ctlw = (volatile LAS unsigned*)(F.lds + LDSCTL_OFF);
    if (F.tid < 64) ctlw[F.tid] = 0u;
    __syncthreads();
    const int lo = args.ph_lo, hi = args.ph_hi;
    XcdBarrier bar; bar.bar = (unsigned*)(ws + WS_CTL); bar.x = 0; bar.st = nullptr; bar.wave = F.wave;
    if (hi - lo > 1) bar = xcd_barrier_post((unsigned*)(ws + WS_CTL), ctlw + 8, F.wave);
#define IN(k) (lo <= (k) && (k) < hi)
#define SEAM(k) do { if (IN(k) && IN((k) + 1)) xcd_barrier(bar); } while (0)
    bf16* ACT1 = (bf16*)(ws + WS_ACT1); bf16* BIG = (bf16*)(ws + WS_BIG); bf16* WallT = (bf16*)(ws + WS_WALLT);

    if (IN(0)) { frame_refresh(F); p0_prologue(F); __syncthreads(); if (PROBE & 1) { p0_prologue(F); __syncthreads(); } }
    SEAM(0);
    if (IN(1)) { frame_refresh(F); { {
        { pg8::Gemm g{(const bf16*)(ws + WS_MEMN), (const bf16*)(ws + WS_WMKVT), NB * NMEM, 768, DM, DM, DM}; pg8::StaticOrder S; S.init(g.M, g.N, F.G, F.bid);
          pg8::EpiBf16<0> E{(bf16*)(ws + WS_MKV), 1536}; pg8::gemm_phase(F.lds, g, S, E, F.wave); }
        { pg8::Gemm g{(const bf16*)(ws + WS_WMKVT) + (size_t)768 * DM, (const bf16*)(ws + WS_MEMN), 768, NB * NMEM, DM, DM, DM}; pg8::StaticOrder S; S.init(g.M, g.N, F.G, F.G - 1 - F.bid);
          pg8::EpiBf16<0> E{(bf16*)(ws + WS_MVT), NB * NMEM}; pg8::gemm_phase(F.lds, g, S, E, F.wave); }
        { pg8::Gemm g{ACT1, WallT, HT, NPROJ, DM, DM, DM}; pg8::StaticOrder S; S.init(g.M, g.N, F.G, F.bid);
          pg8::EpiBf16<0> E{BIG, NPROJ}; pg8::gemm_phase(F.lds, g, S, E, F.wave); }
    } }
      if (PROBE & 2) { {
        { pg8::Gemm g{(const bf16*)(ws + WS_MEMN), (const bf16*)(ws + WS_WMKVT), NB * NMEM, 768, DM, DM, DM}; pg8::StaticOrder S; S.init(g.M, g.N, F.G, F.bid);
          pg8::EpiBf16<0> E{(bf16*)(ws + WS_MKV), 1536}; pg8::gemm_phase(F.lds, g, S, E, F.wave); }
        { pg8::Gemm g{(const bf16*)(ws + WS_WMKVT) + (size_t)768 * DM, (const bf16*)(ws + WS_MEMN), 768, NB * NMEM, DM, DM, DM}; pg8::StaticOrder S; S.init(g.M, g.N, F.G, F.G - 1 - F.bid);
          pg8::EpiBf16<0> E{(bf16*)(ws + WS_MVT), NB * NMEM}; pg8::gemm_phase(F.lds, g, S, E, F.wave); }
        { pg8::Gemm g{ACT1, WallT, HT, NPROJ, DM, DM, DM}; pg8::StaticOrder S; S.init(g.M, g.N, F.G, F.bid);
          pg8::EpiBf16<0> E{BIG, NPROJ}; pg8::gemm_phase(F.lds, g, S, E, F.wave); }
    } } }
    SEAM(1);
    if (IN(2)) { frame_refresh(F); qkprep_phase(F, 0); ssdC_phase(F, 0); if (PROBE & 4) ssdC_phase(F, 0); }
    SEAM(2);
    if (IN(3)) { frame_refresh(F); ssdD_phase(F); dilattn_mfma_phase(F, 0); memattn_mfma_phase(F, 0); if (PROBE & 64) { ssdD_phase(F); memattn_mfma_phase(F, 0); } }
    SEAM(3);
    if (IN(4)) { frame_refresh(F); ssdE_phase(F, 0); dilmerge_phase(F, 0); if (PROBE & 32) { ssdE_phase(F, 0); dilmerge_phase(F, 0); } }
    SEAM(4);
    if (IN(5)) { frame_refresh(F); { { pg8::Gemm g{ACT1 + (size_t)HT * DM, WallT, HT, NPROJ, DM, DM, DM}; pg8::StaticOrder S; S.init(g.M, g.N, F.G, F.bid);
        pg8::EpiBf16<0> E{BIG, NPROJ}; pg8::gemm_phase(F.lds, g, S, E, F.wave); } }
      if (PROBE & 2) { { pg8::Gemm g{ACT1 + (size_t)HT * DM, WallT, HT, NPROJ, DM, DM, DM}; pg8::StaticOrder S; S.init(g.M, g.N, F.G, F.bid);
        pg8::EpiBf16<0> E{BIG, NPROJ}; pg8::gemm_phase(F.lds, g, S, E, F.wave); } } }
    SEAM(5);
    if (IN(6)) { frame_refresh(F); qkprep_phase(F, 1); ssdC_phase(F, 1); if (PROBE & 4) ssdC_phase(F, 1); }
    SEAM(6);
    if (IN(7)) { frame_refresh(F); ssdD_phase(F); dilattn_mfma_phase(F, 1); memattn_mfma_phase(F, 1); if (PROBE & 64) { ssdD_phase(F); memattn_mfma_phase(F, 1); } }
    SEAM(7);
    if (IN(8)) { frame_refresh(F); ssdE_phase(F, 1); dilmerge_phase(F, 1); if (PROBE & 32) { ssdE_phase(F, 1); dilmerge_phase(F, 1); } }
    SEAM(8);
    if (IN(9)) { frame_refresh(F); { { pg8::Gemm g{ACT1, WallT + (size_t)NPROJ * DM, T, NGATE, DM, DM, DM}; pg8::StaticOrder S; S.init(g.M, g.N, F.G, F.bid);
        pg8::EpiBf16<1> E{BIG, NGATE}; pg8::gemm_phase(F.lds, g, S, E, F.wave); } }
      if (PROBE & 2) { { pg8::Gemm g{ACT1, WallT + (size_t)NPROJ * DM, T, NGATE, DM, DM, DM}; pg8::StaticOrder S; S.init(g.M, g.N, F.G, F.bid);
        pg8::EpiBf16<1> E{BIG, NGATE}; pg8::gemm_phase(F.lds, g, S, E, F.wave); } } }
    SEAM(9);
    if (IN(10)) { frame_refresh(F);
        pg8::Gemm g{(const bf16*)F.out, (const bf16*)(ws + WS_WCATT), T, DM, YC, YC, YC}; pg8::StaticOrder S; S.init(g.M, g.N, F.G, F.bid);
        pg8::EpiBranchFused E{ACT1, DM, __builtin_amdgcn_make_buffer_rsrc((void*)BIG, 0, T * NGATE * 2, 0x00020000), NGATE}; pg8::gemm_phase(F.lds, g, S, E, F.wave);
    }
    SEAM(10);
    if (IN(11)) { frame_refresh(F); { { pg8::Gemm g{ACT1, (const bf16*)(ws + WS_WOUTT), T, DM, DM, DM, DM}; pg8::StaticOrder S; S.init(g.M, g.N, F.G, F.bid);
        pg8::EpiResid E{F.out, DM, F.in[I_X]}; pg8::gemm_phase(F.lds, g, S, E, F.wave); } }
      if (PROBE & 2) { { pg8::Gemm g{ACT1, (const bf16*)(ws + WS_WOUTT), T, DM, DM, DM, DM}; pg8::StaticOrder S; S.init(g.M, g.N, F.G, F.bid);
        pg8::EpiResid E{F.out, DM, F.in[I_X]}; pg8::gemm_phase(F.lds, g, S, E, F.wave); } } }
    SEAM(11);
    if (IN(12)) { frame_refresh(F); { hn_phase(F); }
      if (PROBE & 2) { hn_phase(F); } }
    SEAM(12);
    if (IN(13)) { frame_refresh(F); { { pg8::Gemm g{ACT1, (const bf16*)(ws + WS_WQT), T, PEER_Q, DM, DM, DM}; pg8::StaticOrder S; S.init(g.M, g.N, F.G, F.bid);
        pg8::EpiBf16<0> E{BIG, PEER_Q}; pg8::gemm_phase(F.lds, g, S, E, F.wave); } }
      if (PROBE & 2) { { pg8::Gemm g{ACT1, (const bf16*)(ws + WS_WQT), T, PEER_Q, DM, DM, DM}; pg8::StaticOrder S; S.init(g.M, g.N, F.G, F.bid);
        pg8::EpiBf16<0> E{BIG, PEER_Q}; pg8::gemm_phase(F.lds, g, S, E, F.wave); } } }
    SEAM(13);
    if (IN(14)) { frame_refresh(F); peer_phase(F); }
#undef IN
#undef SEAM
}

extern "C" void kernel_launch(void* const* d_in, const int* in_sizes, int n_in, void* d_out, int out_size, void* d_ws, size_t ws_size, hipStream_t stream) {
    static int grid = 0;
    if (grid == 0) {
        if (n_in != 26 || out_size != T * DM || ws_size < WS_END) { fprintf(stderr, "kernel_launch: unexpected shapes (n_in %d, out %d, ws %zu)\n", n_in, out_size, ws_size); grid = -1; return; }
        int dev = 0, cus = 0;
        if (hipGetDevice(&dev) != hipSuccess || hipDeviceGetAttribute(&cus, hipDeviceAttributeMultiprocessorCount, dev) != hipSuccess) { grid = -1; return; }
        if (hipFuncSetAttribute((const void*)mega_fwd, hipFuncAttributeMaxDynamicSharedMemorySize, LDS_BYTES) != hipSuccess) { grid = -1; return; }
        int per_cu = 0;
        (void)hipOccupancyMaxActiveBlocksPerMultiprocessor(&per_cu, (const void*)mega_fwd, NTHR, LDS_BYTES);
        (void)hipGetLastError();
        grid = cus;
    }
    if (grid < 0) return;
    (void)hipMemsetAsync((char*)d_ws + WS_CTL, 0, CTL_ZERO_BYTES, stream);
    Args a{};
    for (int i = 0; i < 26; ++i) a.in[i] = (const float*)d_in[i];
    a.positions = (const int*)d_in[2]; a.out = (float*)d_out; a.ws = (unsigned char*)d_ws;
#if MK_N_LAUNCHES == 1
    a.ph_lo = 0; a.ph_hi = N_PHASES;
    hipLaunchKernelGGL(mega_fwd, dim3(grid), dim3(NTHR), LDS_BYTES, stream, a);
#else
    for (int p = 0; p < N_PHASES; ++p) { a.ph_lo = p; a.ph_hi = p + 1; hipLaunchKernelGGL(mega_fwd, dim3(grid), dim3(NTHR), LDS_BYTES, stream, a); }
#endif
}
```

```cpp
#include <hip/hip_runtime.h>
#include <cstdio>
#include <cstdint>

#ifndef MK_N_LAUNCHES
#define MK_N_LAUNCHES 1
#endif

#define LAS __attribute__((address_space(3)))
#define GAS __attribute__((address_space(1)))
typedef unsigned short bf16;
typedef short bf16x8 __attribute__((ext_vector_type(8)));
typedef float f32x4 __attribute__((ext_vector_type(4)));
typedef float f32x2 __attribute__((ext_vector_type(2)));
typedef unsigned u32x4 __attribute__((ext_vector_type(4)));
typedef unsigned u32x2 __attribute__((ext_vector_type(2)));

constexpr int NB = 8, SEQ = 8192, DM = 1024, T = NB * SEQ;
constexpr int HB = 4, HT = HB * SEQ;
constexpr int NMEM = 256;
constexpr int NPROJ = 6144;
constexpr int PC_Z = 0, PC_X = 1024, PC_B = 2048, PC_C = 2560, PC_DQ = 3072, PC_DK = 3840, PC_DV = 4608, PC_MQ = 5376;
constexpr int W_IN_N = 9232, OFF_DT = 3072, OFF_AFTER_DT = 3088;
constexpr int NGATE = 3072;
constexpr int YC = 2048;
constexpr int PEER_H = 8, PEER_K = 16, PEER_NK = 128, PEER_Q = 2048;
constexpr float EPS = 1e-6f;

constexpr size_t MiB = 1u << 20;
constexpr size_t WS_CTL = 0, CTL_ZERO_BYTES = 65536;
constexpr size_t WS_WALLT = 1 * MiB;
constexpr size_t WS_WMKVT = 19 * MiB;
constexpr size_t WS_WCATT = 22 * MiB;
constexpr size_t WS_WOUTT = 26 * MiB;
constexpr size_t WS_WQT = 28 * MiB;
constexpr size_t WS_SUBK = 32 * MiB;
constexpr size_t WS_PD = 33 * MiB;
constexpr size_t WS_PU = 65 * MiB;
constexpr size_t WS_DT = 97 * MiB;
constexpr size_t WS_MEMN = 101 * MiB;
constexpr size_t WS_MKV = 105 * MiB;
constexpr size_t WS_ACT1 = 112 * MiB;
constexpr size_t WS_BIG = 240 * MiB;
constexpr size_t WS_LSE = 624 * MiB;
constexpr size_t WS_MVT = 628 * MiB;
constexpr size_t WS_DEC = 631 * MiB;
constexpr size_t WS_SST = 632 * MiB;
constexpr size_t WS_SIN = 760 * MiB;
constexpr size_t WS_END = 824 * MiB;

constexpr int RING_BYTES = 131072;
constexpr int LDSCTL_OFF = 143360;
constexpr int LDS_BYTES = 147456;
constexpr int NWAVES = 8, NTHR = 512;

__device__ __forceinline__ int lane_id() { return (int)__builtin_amdgcn_mbcnt_hi(~0u, __builtin_amdgcn_mbcnt_lo(~0u, 0u)); }
__device__ __forceinline__ float bf2f(unsigned short b) { return __builtin_bit_cast(float, (unsigned)b << 16); }
__device__ __forceinline__ float bflo(unsigned w) { return __builtin_bit_cast(float, w << 16); }
__device__ __forceinline__ float bfhi(unsigned w) { return __builtin_bit_cast(float, w & 0xffff0000u); }
__device__ __forceinline__ unsigned f2bf(float f) { unsigned u = __builtin_bit_cast(unsigned, f); return (u + 0x7fffu + ((u >> 16) & 1u)) >> 16; }
__device__ __forceinline__ unsigned pk2(float lo, float hi) { return f2bf(lo) | (f2bf(hi) << 16); }
typedef float f32x16 __attribute__((ext_vector_type(16)));
typedef short s16x4 __attribute__((ext_vector_type(4)));
typedef __bf16 bf2_t __attribute__((ext_vector_type(2)));
__device__ __forceinline__ unsigned pkbf(float a, float b) { const f32x2 v = {a, b}; return __builtin_bit_cast(unsigned, __builtin_convertvector(v, bf2_t)); }
#define MFMA32(a, b, c) __builtin_amdgcn_mfma_f32_32x32x16_bf16((a), (b), (c), 0, 0, 0)
__device__ __forceinline__ float wave_sum(float v) {
#pragma unroll
    for (int o = 1; o < 64; o <<= 1) v += __shfl_xor(v, o);
    return v;
}
__device__ __forceinline__ float wave_max(float v) {
#pragma unroll
    for (int o = 1; o < 64; o <<= 1) v = fmaxf(v, __shfl_xor(v, o));
    return v;
}
__device__ __forceinline__ float sigmoidf_(float x) { return 1.0f / (1.0f + __expf(-x)); }
#define LDS_WAIT() asm volatile("s_waitcnt lgkmcnt(0)" ::: "memory")
#define VM_WAIT() asm volatile("s_waitcnt vmcnt(0)" ::: "memory")

#define XB_TMO      128
#define XB_XCNT(j)  (256  + 64 * (j))
#define XB_XSUB(j)  (1280 + 64 * (j))
#define XB_XGEN(j)  (2304 + 64 * (j))
#define XB_TOP      3328
#define XB_TOPGEN   3392
#define XCD_BAR_WORDS 3456
#define XB_SPIN_CAP (1u << 18)
__device__ __forceinline__ unsigned xb_ld(unsigned* p)              { return __hip_atomic_load(p, __ATOMIC_RELAXED, __HIP_MEMORY_SCOPE_AGENT); }
__device__ __forceinline__ unsigned xb_add(unsigned* p, unsigned v) { return __hip_atomic_fetch_add(p, v, __ATOMIC_RELAXED, __HIP_MEMORY_SCOPE_AGENT); }
__device__ __forceinline__ unsigned xb_xcc_id() { return (unsigned)__builtin_amdgcn_s_getreg((3 << 11) | 20) & 0xFu; }
#define XB_SPIN(cond, bar) do { unsigned _sp = 0; while (cond) { __builtin_amdgcn_s_sleep(1); \
    if ((++_sp & 255u) == 0u) { if (xb_ld(&(bar)[XB_TMO])) break; if (_sp > XB_SPIN_CAP) { atomicAdd(&(bar)[XB_TMO], 1u); break; } } } } while (0)
struct XcdBarrier { unsigned* bar; unsigned x; volatile LAS unsigned* st; int wave; };
__device__ __forceinline__ XcdBarrier xcd_barrier_post(unsigned* bar, volatile LAS unsigned* st, int wave) {
    XcdBarrier b; b.bar = bar; b.x = xb_xcc_id(); b.st = st; b.wave = wave;
    if (wave == 0 && lane_id() == 0) (void)xb_add(&bar[XB_XCNT(b.x)], 1u);
    return b;
}
__device__ __forceinline__ void xcd_barrier_complete(unsigned* bar, unsigned x, unsigned& nloc, unsigned& nx) {
    const unsigned G = gridDim.x * gridDim.y * gridDim.z;
    unsigned sum, cnt, mine, sp = 0u;
    for (;;) {
        sum = 0u; cnt = 0u; mine = 0u;
#pragma unroll
        for (unsigned j = 0; j < 16; ++j) { const unsigned c = xb_ld(&bar[XB_XCNT(j)]); sum += c; cnt += (c > 0u) ? 1u : 0u; mine = (j == x) ? c : mine; }
        if (sum == G) break;
        __builtin_amdgcn_s_sleep(1);
        if ((++sp & 255u) == 0u) { if (xb_ld(&bar[XB_TMO])) break; if (sp > XB_SPIN_CAP) { atomicAdd(&bar[XB_TMO], 1u); break; } }
    }
    nloc = mine > 0u ? mine : 1u; nx = cnt > 0u ? cnt : 1u;
}
__device__ __forceinline__ void xcd_barrier(const XcdBarrier& b) {
    asm volatile("s_waitcnt vmcnt(0)" ::: "memory");
    __syncthreads();
    if (b.wave == 0 && lane_id() == 0) {
        unsigned* bar = b.bar;
        __builtin_amdgcn_s_waitcnt(0);
        unsigned nloc = b.st[0], nx = b.st[1];
        if (nloc == 0u) { xcd_barrier_complete(bar, b.x, nloc, nx); b.st[0] = nloc; b.st[1] = nx; }
        const unsigned old = xb_add(&bar[XB_XSUB(b.x)], 1u);
        const unsigned gen = old / nloc;
        if (old + 1u == (gen + 1u) * nloc) {
            __builtin_amdgcn_fence(__ATOMIC_RELEASE, "agent");
            asm volatile("s_waitcnt vmcnt(0)" ::: "memory");
            const unsigned og = xb_add(&bar[XB_TOP], 1u);
            const unsigned tg = og / nx;
            if (og + 1u == (tg + 1u) * nx) xb_add(&bar[XB_TOPGEN], 1u);
            else XB_SPIN(xb_ld(&bar[XB_TOPGEN]) == tg, bar);
            __builtin_amdgcn_fence(__ATOMIC_ACQUIRE, "agent");
            xb_add(&bar[XB_XGEN(b.x)], 1u);
            asm volatile("s_waitcnt vmcnt(0)" ::: "memory");
        } else {
            XB_SPIN(xb_ld(&bar[XB_XGEN(b.x)]) == gen, bar);
            __builtin_amdgcn_fence(__ATOMIC_ACQUIRE, "agent");
            asm volatile("s_waitcnt vmcnt(0)" ::: "memory");
        }
    }
    __syncthreads();
}

namespace pg8 {
constexpr int BM = 256, BK = 64, HALF = 128, HTB = HALF * BK * 2, STAGE_BYTES = 8 * HTB, NXCD = 8, WGM = 8;
__host__ __device__ __forceinline__ int lds_byte(int r, int c) { const int st = (r >> 4) * 2 + (c >> 5), rr = r & 15, cc = c & 31, ob = rr * 64 + cc * 2; return st * 1024 + (ob ^ (((ob >> 9) & 1) << 5)); }
__host__ __device__ __forceinline__ void stage_rc(int b, int& R, int& C) { const int st = b / 1024, sb = b % 1024, swz = sb ^ (((sb >> 9) & 1) << 5); R = (st >> 1) * 16 + swz / 64; C = (st & 1) * 32 + (swz % 64) / 2; }
__host__ __device__ __forceinline__ int perm32(int rho) { const int n = rho >> 4, i = rho & 15; return 8 * (i >> 2) + 4 * n + (i & 3); }
struct Unit { int pm, pn; };
struct Gemm { const bf16* A; const bf16* Bt; int M, N, K, lda, ldb; };
struct StaticOrder {
    int nM, nN, nwg, G, c;
    __host__ __device__ void init(int M, int N, int G_, int c_) { nM = M / BM; nN = N / BM; nwg = nM * nN; G = G_; c = c_; }
    __host__ __device__ bool next(int i, Unit& u) const {
        const long L = (long)i * G + c; if (L >= nwg) return false;
        int wgid = (int)L; { const int q = nwg / NXCD, r = nwg % NXCD, xcd = wgid % NXCD, off = wgid / NXCD; wgid = (xcd < r ? xcd * (q + 1) : r * (q + 1) + (xcd - r) * q) + off; }
        const int nig = WGM * nN, gid = wgid / nig, fm = gid * WGM, gsz = (nM - fm) < WGM ? (nM - fm) : WGM;
        u.pm = fm + ((wgid % nig) % gsz); u.pn = (wgid % nig) / gsz; return true;
    }
    __device__ __forceinline__ void a_ready(const Unit&) const {}
    __device__ __forceinline__ void done(const Unit&) const {}
};
struct PanelOrder {
    int pm, nN, rot;
    __device__ __forceinline__ bool next(int i, Unit& u) const { if (i >= nN) return false; u.pm = pm; u.pn = (i + rot) % nN; return true; }
    __device__ __forceinline__ void a_ready(const Unit&) const {}
    __device__ __forceinline__ void done(const Unit&) const {}
};
__device__ __forceinline__ unsigned cvt_pk_bf16(float lo, float hi) { unsigned r; asm volatile("v_cvt_pk_bf16_f32 %0, %1, %2" : "=v"(r) : "v"(lo), "v"(hi)); return r; }

template <int ACT> struct EpiBf16 {
    static constexpr bool PERM = true, AFTER_DRAIN = false, HAS_MID = false;
    bf16* O; int ldc;
    __device__ __forceinline__ void operator()(const f32x4 (&acc)[2][2][4][2], const Unit& u, int wr, int wc, int fr, int fq) const {
        const int row0 = u.pm * BM + wr * 64 + fr; const int col0 = u.pn * BM + wc * 32 + 8 * fq;
#pragma unroll
        for (int ai = 0; ai < 2; ++ai)
#pragma unroll
            for (int m = 0; m < 4; ++m) { bf16* rowp = O + (size_t)(row0 + ai * HALF + m * 16) * ldc + col0;
#pragma unroll
                for (int bj = 0; bj < 2; ++bj) { f32x4 v0 = acc[ai][bj][m][0], v1 = acc[ai][bj][m][1];
                    if (ACT == 1) {
#pragma unroll
                        for (int j = 0; j < 4; ++j) { v0[j] = sigmoidf_(v0[j]); v1[j] = sigmoidf_(v1[j]); } }
                    u32x4 w; w.x = cvt_pk_bf16(v0[0], v0[1]); w.y = cvt_pk_bf16(v0[2], v0[3]); w.z = cvt_pk_bf16(v1[0], v1[1]); w.w = cvt_pk_bf16(v1[2], v1[3]);
                    *(u32x4*)(rowp + bj * HALF) = w; } }
    }
};
template <bool ACCUM> struct EpiBranch {
    static constexpr bool PERM = true, AFTER_DRAIN = false, HAS_MID = false;
    bf16* O; int ldc; const bf16* Gt; int ldg; int gcol0;
    __device__ __forceinline__ void operator()(const f32x4 (&acc)[2][2][4][2], const Unit& u, int wr, int wc, int fr, int fq) const {
        const int row0 = u.pm * BM + wr * 64 + fr; const int col0 = u.pn * BM + wc * 32 + 8 * fq;
#pragma unroll
        for (int ai = 0; ai < 2; ++ai)
#pragma unroll
            for (int m = 0; m < 4; ++m) { const size_t r = (size_t)(row0 + ai * HALF + m * 16); bf16* rowp = O + r * ldc + col0; const bf16* gp = Gt + r * ldg + gcol0 + col0;
#pragma unroll
                for (int bj = 0; bj < 2; ++bj) { const f32x4 v0 = acc[ai][bj][m][0], v1 = acc[ai][bj][m][1];
                    const u32x4 g = *(const u32x4*)(gp + bj * HALF);
                    float o[8];
                    o[0] = v0[0] * bflo(g.x); o[1] = v0[1] * bfhi(g.x); o[2] = v0[2] * bflo(g.y); o[3] = v0[3] * bfhi(g.y);
                    o[4] = v1[0] * bflo(g.z); o[5] = v1[1] * bfhi(g.z); o[6] = v1[2] * bflo(g.w); o[7] = v1[3] * bfhi(g.w);
                    if (ACCUM) { const u32x4 p = *(const u32x4*)(rowp + bj * HALF);
                        o[0] += bflo(p.x); o[1] += bfhi(p.x); o[2] += bflo(p.y); o[3] += bfhi(p.y); o[4] += bflo(p.z); o[5] += bfhi(p.z); o[6] += bflo(p.w); o[7] += bfhi(p.w); }
                    u32x4 w; w.x = cvt_pk_bf16(o[0], o[1]); w.y = cvt_pk_bf16(o[2], o[3]); w.z = cvt_pk_bf16(o[4], o[5]); w.w = cvt_pk_bf16(o[6], o[7]);
                    *(u32x4*)(rowp + bj * HALF) = w; } }
    }
};
struct EpiResid {
    static constexpr bool PERM = false, AFTER_DRAIN = false, HAS_MID = false;
    float* C; int ldc; const float* R;
    __device__ __forceinline__ void operator()(const f32x4 (&acc)[2][2][4][2], const Unit& u, int wr, int wc, int fr, int fq) const {
        const int row0 = u.pm * BM + wr * 64 + fr, col0 = u.pn * BM + wc * 32 + 4 * fq;
#pragma unroll
        for (int ai = 0; ai < 2; ++ai)
#pragma unroll
            for (int m = 0; m < 4; ++m) { const size_t off = (size_t)(row0 + ai * HALF + m * 16) * ldc + col0;
#pragma unroll
                for (int bj = 0; bj < 2; ++bj)
#pragma unroll
                    for (int n = 0; n < 2; ++n) { const f32x4 r = *(const f32x4*)(R + off + bj * HALF + n * 16); *(f32x4*)(C + off + bj * HALF + n * 16) = acc[ai][bj][m][n] + r; } }
    }
};

struct EpiBranchFused {
    static constexpr bool PERM = true, AFTER_DRAIN = false, HAS_MID = true;
    bf16* O; int ldc; __amdgpu_buffer_rsrc_t grs; int ldg;
    __device__ __forceinline__ void mid(f32x4 (&acc)[2][2][4][2], const Unit& u, int t, int wr, int wc, int fr, int fq) const {
        const unsigned voff = (unsigned)(((u.pm * BM + wr * 64 + fr) * ldg + u.pn * BM + wc * 32 + 8 * fq) * 2);
        const int ca = (t == 16) ? 0 : 2048;
#pragma unroll
        for (int ai = 0; ai < 2; ++ai)
#pragma unroll
            for (int m = 0; m < 4; ++m) {
#pragma unroll
                for (int bj = 0; bj < 2; ++bj) { const int so = ((ai * HALF + m * 16) * ldg + bj * HALF) * 2 + ca;
                    const u32x4 ga = __builtin_amdgcn_raw_buffer_load_b128(grs, voff, so, 0), gb = __builtin_amdgcn_raw_buffer_load_b128(grs, voff, so + 2048, 0);
                    f32x4& v0 = acc[ai][bj][m][0]; f32x4& v1 = acc[ai][bj][m][1];
                    v0[0] *= bflo(ga.x) * __builtin_amdgcn_rcpf(fmaxf(bflo(gb.x), 1e-30f)); v0[1] *= bfhi(ga.x) * __builtin_amdgcn_rcpf(fmaxf(bfhi(gb.x), 1e-30f));
                    v0[2] *= bflo(ga.y) * __builtin_amdgcn_rcpf(fmaxf(bflo(gb.y), 1e-30f)); v0[3] *= bfhi(ga.y) * __builtin_amdgcn_rcpf(fmaxf(bfhi(gb.y), 1e-30f));
                    v1[0] *= bflo(ga.z) * __builtin_amdgcn_rcpf(fmaxf(bflo(gb.z), 1e-30f)); v1[1] *= bfhi(ga.z) * __builtin_amdgcn_rcpf(fmaxf(bfhi(gb.z), 1e-30f));
                    v1[2] *= bflo(ga.w) * __builtin_amdgcn_rcpf(fmaxf(bflo(gb.w), 1e-30f)); v1[3] *= bfhi(ga.w) * __builtin_amdgcn_rcpf(fmaxf(bfhi(gb.w), 1e-30f)); }
                __builtin_amdgcn_sched_barrier(0); }
    }
    __device__ __forceinline__ void operator()(const f32x4 (&acc)[2][2][4][2], const Unit& u, int wr, int wc, int fr, int fq) const {
        const int row0 = u.pm * BM + wr * 64 + fr; const int col0 = u.pn * BM + wc * 32 + 8 * fq;
        const unsigned voff = (unsigned)((row0 * ldg + col0) * 2);
#pragma unroll
        for (int ai = 0; ai < 2; ++ai)
#pragma unroll
            for (int m = 0; m < 4; ++m) { const size_t r = (size_t)(row0 + ai * HALF + m * 16); bf16* rowp = O + r * ldc + col0;
#pragma unroll
                for (int bj = 0; bj < 2; ++bj) { const f32x4 v0 = acc[ai][bj][m][0], v1 = acc[ai][bj][m][1];
                    const u32x4 g = __builtin_amdgcn_raw_buffer_load_b128(grs, voff, ((ai * HALF + m * 16) * ldg + bj * HALF) * 2 + 4096, 0);
                    u32x4 w; w.x = cvt_pk_bf16(v0[0] * bflo(g.x), v0[1] * bfhi(g.x)); w.y = cvt_pk_bf16(v0[2] * bflo(g.y), v0[3] * bfhi(g.y));
                    w.z = cvt_pk_bf16(v1[0] * bflo(g.z), v1[1] * bfhi(g.z)); w.w = cvt_pk_bf16(v1[2] * bflo(g.w), v1[3] * bfhi(g.w));
                    *(u32x4*)(rowp + bj * HALF) = w; } }
    }
};

template <class Epi, class Sched>
__device__ __forceinline__ void gemm_phase(LAS unsigned char* lds, const Gemm g, const Sched& S, const Epi& E, int wid) {
    int lane = lane_id(); asm volatile("" : "+v"(lane));
    const int tid = wid * 64 + lane, wr = wid >> 2, wc = wid & 3, fr = lane & 15, fq = lane >> 4;
    const int K = g.K, nt = K / BK;
    unsigned voffA[2], voffB[2];
#pragma unroll
    for (int i = 0; i < 2; ++i) { int R, C; stage_rc(tid * 16 + i * 8192, R, C); const int Rb = Epi::PERM ? ((R & ~31) + perm32(R & 31)) : R;
        voffA[i] = (unsigned)(R * g.lda + C) * 2u; voffB[i] = (unsigned)(Rb * g.ldb + C) * 2u; }
    const size_t kstep = (size_t)(BK * 2);
    const size_t hsA = (size_t)HALF * g.lda * 2, hsB = (size_t)HALF * g.ldb * 2;
    const size_t tsA = 2 * hsA, tsB = 2 * hsB;
    const unsigned ldsw = (unsigned)wid * 1024u;
    const int aoff = lds_byte(wr * 64 + fr, fq * 8), boff = lds_byte(wc * 32 + fr, fq * 8);
#define PG8_SA(b, h) (((b) * 2 + (h)) * HTB)
#define PG8_SB(b, h) ((4 + (b) * 2 + (h)) * HTB)
#define PG8_STAGE(bufoff, gbase, voff) do { _Pragma("unroll") for (int _i = 0; _i < 2; ++_i) \
        __builtin_amdgcn_global_load_lds((const unsigned*)((const char*)(gbase) + (voff)[_i]), (LAS unsigned*)(lds + (bufoff) + ldsw + _i * 8192), 16, 0, 0); } while (0)
#define PG8_LDA(dst, b, h) do { _Pragma("unroll") for (int m = 0; m < 4; ++m) _Pragma("unroll") for (int k = 0; k < 2; ++k) dst[m][k] = *(const LAS bf16x8*)(lds + PG8_SA(b, h) + aoff + m * 2048 + k * 1024); } while (0)
#define PG8_LDB(dst, b, h) do { _Pragma("unroll") for (int n = 0; n < 2; ++n) _Pragma("unroll") for (int k = 0; k < 2; ++k) dst[n][k] = *(const LAS bf16x8*)(lds + PG8_SB(b, h) + boff + n * 2048 + k * 1024); } while (0)
#define PG8_MMA(ai, bj, At, Bt) do { __builtin_amdgcn_s_setprio(1); _Pragma("unroll") for (int m = 0; m < 4; ++m) _Pragma("unroll") for (int n = 0; n < 2; ++n) _Pragma("unroll") for (int k = 0; k < 2; ++k) \
        acc[ai][bj][m][n] = __builtin_amdgcn_mfma_f32_16x16x32_bf16(Bt[n][k], At[m][k], acc[ai][bj][m][n], 0, 0, 0); __builtin_amdgcn_s_setprio(0); } while (0)
#define PG8_WAIT_V(n) asm volatile("s_waitcnt vmcnt(" #n ")" ::: "memory")
#define PG8_WAIT_L(n) asm volatile("s_waitcnt lgkmcnt(" #n ")" ::: "memory")
#define PG8_BAR __builtin_amdgcn_s_barrier()
#define PG8_SCHED __builtin_amdgcn_sched_barrier(0)
    Unit cur, nxt; int ui = 0;
    if (!S.next(0, cur)) return;
    f32x4 acc[2][2][4][2];
#pragma unroll
    for (int a = 0; a < 2; ++a)
#pragma unroll
        for (int b = 0; b < 2; ++b)
#pragma unroll
            for (int m = 0; m < 4; ++m)
#pragma unroll
                for (int n = 0; n < 2; ++n) acc[a][b][m][n] = (f32x4){0.f, 0.f, 0.f, 0.f};
    bf16x8 At[4][2], B0[2][2], B1[2][2];
    const char* cA = (const char*)g.A + (size_t)cur.pm * tsA; const char* cB = (const char*)g.Bt + (size_t)cur.pn * tsB;
    S.a_ready(cur);
    PG8_STAGE(PG8_SB(0, 0), cB, voffB); PG8_STAGE(PG8_SB(0, 1), cB + hsB, voffB); PG8_STAGE(PG8_SA(0, 0), cA, voffA); PG8_STAGE(PG8_SA(0, 1), cA + hsA, voffA);
    if (wr == 1) PG8_BAR;
    PG8_WAIT_V(2); PG8_BAR;
    PG8_STAGE(PG8_SB(1, 0), cB + kstep, voffB); PG8_STAGE(PG8_SA(1, 0), cA + kstep, voffA); PG8_STAGE(PG8_SB(1, 1), cB + hsB + kstep, voffB);
    PG8_WAIT_V(6); PG8_BAR;
    for (;;) {
        const bool has_next = S.next(ui + 1, nxt);
        const char* nA = has_next ? (const char*)g.A + (size_t)nxt.pm * tsA : cA; const char* nB = has_next ? (const char*)g.Bt + (size_t)nxt.pn * tsB : cB;
        for (int t = 0; t < nt; t += 2) {
            const bool last = (t == nt - 2);
            const char* a1 = cA + (size_t)(t + 1) * kstep;
            const char* a2 = last ? nA : cA + (size_t)(t + 2) * kstep; const char* b2 = last ? nB : cB + (size_t)(t + 2) * kstep;
            const char* a3 = a2 + kstep; const char* b3 = b2 + kstep;
            if (last && has_next) S.a_ready(nxt);
            if constexpr (Epi::HAS_MID) { if (t == 16 || t == 20) E.mid(acc, cur, t, wr, wc, fr, fq); }
            PG8_LDB(B0, 0, 0); PG8_LDB(B1, 0, 1); PG8_SCHED; PG8_LDA(At, 0, 0); PG8_STAGE(PG8_SA(1, 1), a1 + hsA, voffA);
            PG8_WAIT_V(8); PG8_WAIT_L(0); PG8_BAR; PG8_MMA(0, 0, At, B0); PG8_MMA(0, 1, At, B1); PG8_BAR; PG8_SCHED;
            PG8_LDA(At, 0, 1); PG8_STAGE(PG8_SB(0, 0), b2, voffB); PG8_STAGE(PG8_SB(0, 1), b2 + hsB, voffB); PG8_STAGE(PG8_SA(0, 0), a2, voffA);
            PG8_WAIT_V(8); PG8_WAIT_L(0); PG8_BAR; PG8_MMA(1, 0, At, B0); PG8_MMA(1, 1, At, B1); PG8_BAR; PG8_SCHED;
            PG8_LDB(B0, 1, 0); PG8_LDB(B1, 1, 1); PG8_SCHED; PG8_LDA(At, 1, 0); PG8_STAGE(PG8_SA(0, 1), a2 + hsA, voffA);
            PG8_WAIT_V(8); PG8_WAIT_L(0); PG8_BAR; PG8_MMA(0, 0, At, B0); PG8_MMA(0, 1, At, B1); PG8_BAR; PG8_SCHED;
            PG8_LDA(At, 1, 1); PG8_STAGE(PG8_SB(1, 0), b3, voffB); PG8_STAGE(PG8_SB(1, 1), b3 + hsB, voffB); PG8_STAGE(PG8_SA(1, 0), a3, voffA);
            PG8_WAIT_V(8); PG8_WAIT_L(0); PG8_BAR; PG8_MMA(1, 0, At, B0); PG8_MMA(1, 1, At, B1); PG8_BAR; PG8_SCHED;
        }
        if (wr == 0) PG8_BAR;
        E(acc, cur, wr, wc, fr, fq); S.done(cur);
        if (!has_next) break;
#pragma unroll
        for (int a = 0; a < 2; ++a)
#pragma unroll
            for (int b = 0; b < 2; ++b)
#pragma unroll
                for (int m = 0; m < 4; ++m)
#pragma unroll
                    for (int n = 0; n < 2; ++n) acc[a][b][m][n] = (f32x4){0.f, 0.f, 0.f, 0.f};
        cur = nxt; cA = nA; cB = nB; ++ui;
        if (wr == 1) PG8_BAR;
    }
    PG8_WAIT_V(0);
    PG8_BAR;
#undef PG8_SA
#undef PG8_SB
#undef PG8_STAGE
#undef PG8_LDA
#undef PG8_LDB
#undef PG8_MMA
#undef PG8_WAIT_V
#undef PG8_WAIT_L
#undef PG8_BAR
#undef PG8_SCHED
}
}

#ifndef PROBE
#define PROBE 0
#endif
struct Args {
    const float* in[26]; const int* positions; float* out; unsigned char* ws; int ph_lo, ph_hi; int pad0, pad1;
};
struct Frame {
    LAS unsigned char* lds;
    int tid, lane, wave, G, bid;
    const float* const* in; const int* positions; float* out; unsigned char* ws;
};
__device__ __forceinline__ void frame_refresh(Frame& F) { int l = lane_id(); asm volatile("" : "+v"(l)); F.lane = l; F.tid = F.wave * 64 + l; }
enum { I_X = 0, I_MEM = 1, I_POS = 2, I_NMIXW = 3, I_WIN = 4, I_CONVW = 5, I_CONVB = 6, I_DTB = 7, I_ALOG = 8, I_SSDD = 9, I_SSDNW = 10, I_DQNW = 11, I_DKNW = 12, I_MEMNW = 13,
       I_WMKV = 14, I_MQNW = 15, I_MKNW = 16, I_WSSD = 17, I_WDIL = 18, I_WMEMBR = 19, I_WOUT = 20, I_NFFNW = 21, I_WQ = 22, I_SUBK = 23, I_PD = 24, I_PU = 25 };

__device__ __forceinline__ void p0_transpose_item(const float* W, int ldw, int src_col0, bf16* WT, int ldt, int dst_row0, int dst_col0, int nblk, LAS float* scr, int item, int lane) {
    const int kb = item / nblk, nb = item % nblk, k0 = 64 * kb, n0 = 32 * nb;
#pragma unroll 8
    for (int i = 0; i < 32; ++i) { const int kk = 2 * i + (lane >> 5); scr[kk * 33 + (lane & 31)] = W[(size_t)(k0 + kk) * ldw + src_col0 + n0 + (lane & 31)]; }
    LDS_WAIT(); asm volatile("" ::: "memory");
    const int c = lane & 7;
#pragma unroll
    for (int j = 0; j < 4; ++j) { const int n = (lane >> 3) + 8 * j; const LAS float* s = scr + (8 * c) * 33 + n;
        u32x4 o; o.x = pk2(s[0 * 33], s[1 * 33]); o.y = pk2(s[2 * 33], s[3 * 33]); o.z = pk2(s[4 * 33], s[5 * 33]); o.w = pk2(s[6 * 33], s[7 * 33]);
        *(u32x4*)(WT + (size_t)(dst_row0 + n0 + n) * ldt + dst_col0 + k0 + 8 * c) = o; }
    LDS_WAIT(); asm volatile("" ::: "memory");
}
__device__ __forceinline__ void rms_row_to_bf16(const float* xrow, const float* w, bf16* orow, int lane, f32x4 (&v)[4]) {
    const f32x4* xr = (const f32x4*)xrow + lane; const f32x4* wr = (const f32x4*)w + lane;
    float s = 0.f;
#pragma unroll
    for (int j = 0; j < 4; ++j) { v[j] = xr[64 * j]; s += (v[j].x * v[j].x + v[j].y * v[j].y) + (v[j].z * v[j].z + v[j].w * v[j].w); }
    const float rstd = 1.0f / sqrtf(wave_sum(s) * (1.f / DM) + EPS);
    unsigned long long* o8 = (unsigned long long*)orow + lane;
#pragma unroll
    for (int j = 0; j < 4; ++j) { const f32x4 ww = wr[64 * j]; v[j] = v[j] * rstd * ww;
        o8[64 * j] = (unsigned long long)pk2(v[j].x, v[j].y) | ((unsigned long long)pk2(v[j].z, v[j].w) << 32); }
}
__device__ __forceinline__ void cvt_f32_bf16_stream(const float* src, bf16* dst, size_t n, size_t gtid, size_t gthreads) {
    for (size_t i = gtid * 8; i < n; i += gthreads * 8) { const f32x4 a = *(const f32x4*)(src + i), b = *(const f32x4*)(src + i + 4);
        u32x4 o; o.x = pk2(a.x, a.y); o.y = pk2(a.z, a.w); o.z = pk2(b.x, b.y); o.w = pk2(b.z, b.w); *(u32x4*)(dst + i) = o; }
}
constexpr float PD_SCALE = 64.0f, PU_SCALE = 8.0f;
__device__ __forceinline__ unsigned pk4_fp8(f32x4 v, float sc) {
    const float a = fminf(fmaxf(v.x * sc, -448.f), 448.f), b = fminf(fmaxf(v.y * sc, -448.f), 448.f), c = fminf(fmaxf(v.z * sc, -448.f), 448.f), d = fminf(fmaxf(v.w * sc, -448.f), 448.f);
    unsigned p = __builtin_amdgcn_cvt_pk_fp8_f32(a, b, 0, false); return __builtin_amdgcn_cvt_pk_fp8_f32(c, d, p, true);
}
__device__ __forceinline__ void cvt_f32_fp8_sliced(const float* src, unsigned char* dst, float sc, size_t gtid, size_t gthreads) {
    for (size_t i = gtid * 16; i < (size_t)16384 * 1024; i += gthreads * 16) { const f32x4 a = *(const f32x4*)(src + i), b = *(const f32x4*)(src + i + 4), c = *(const f32x4*)(src + i + 8), d = *(const f32x4*)(src + i + 12);
        const size_t e = i >> 10, dd = i & 1023;
        const u32x4 o = {pk4_fp8(a, sc), pk4_fp8(b, sc), pk4_fp8(c, sc), pk4_fp8(d, sc)}; *(u32x4*)(dst + ((((dd >> 7) * 16384 + e) << 7) + (dd & 127))) = o; }
}
__device__ __forceinline__ void p0_prologue(Frame& F) {
    LAS float* scr = (LAS float*)(F.lds + F.wave * 8448);
    LAS float* wdt = (LAS float*)(F.lds + 8 * 8448);
    const int gw = F.bid * NWAVES + F.wave, NGW = F.G * NWAVES;
    unsigned char* ws = F.ws;
    for (int i = F.tid; i < 1024 * 16; i += NTHR) { const int k = i >> 4, c = i & 15, l = (k & 255) >> 2, e = k & 3, j = k >> 8, q = c >> 2;
        wdt[((((j * 4 + e) * 4 + q) * 64 + l) << 2) + (c & 3)] = F.in[I_WIN][(size_t)k * W_IN_N + OFF_DT + c]; }
    __syncthreads();
    constexpr int IT_A = 16 * 96, IT_B = 16 * 192, IT_MKV = 16 * 48, IT_SSD = 16 * 32, IT_DIL = 4 * 32, IT_MBR = 12 * 32, IT_OUT = 16 * 32, IT_WQ = 16 * 64;
    constexpr int NITEMS = IT_A + IT_B + IT_MKV + IT_SSD + IT_DIL + IT_MBR + IT_OUT + IT_WQ;
    bf16* WallT = (bf16*)(ws + WS_WALLT);
    for (int it = gw; it < NITEMS; it += NGW) {
        int r = it;
        if (r < IT_A) { p0_transpose_item(F.in[I_WIN], W_IN_N, 0, WallT, DM, 0, 0, 96, scr, r, F.lane); continue; } r -= IT_A;
        if (r < IT_B) { p0_transpose_item(F.in[I_WIN], W_IN_N, OFF_AFTER_DT, WallT, DM, 3072, 0, 192, scr, r, F.lane); continue; } r -= IT_B;
        if (r < IT_MKV) { p0_transpose_item(F.in[I_WMKV], 1536, 0, (bf16*)(ws + WS_WMKVT), DM, 0, 0, 48, scr, r, F.lane); continue; } r -= IT_MKV;
        if (r < IT_SSD) { p0_transpose_item(F.in[I_WSSD], DM, 0, (bf16*)(ws + WS_WCATT), YC, 0, 0, 32, scr, r, F.lane); continue; } r -= IT_SSD;
        if (r < IT_DIL) { p0_transpose_item(F.in[I_WDIL], DM, 0, (bf16*)(ws + WS_WCATT), YC, 0, 1024, 32, scr, r, F.lane); continue; } r -= IT_DIL;
        if (r < IT_MBR) { p0_transpose_item(F.in[I_WMEMBR], DM, 0, (bf16*)(ws + WS_WCATT), YC, 0, 1280, 32, scr, r, F.lane); continue; } r -= IT_MBR;
        if (r < IT_OUT) { p0_transpose_item(F.in[I_WOUT], DM, 0, (bf16*)(ws + WS_WOUTT), DM, 0, 0, 32, scr, r, F.lane); continue; } r -= IT_OUT;
        p0_transpose_item(F.in[I_WQ], PEER_Q, 0, (bf16*)(ws + WS_WQT), DM, 0, 0, 64, scr, r, F.lane);
    }
    const size_t gtid = (size_t)F.bid * NTHR + F.tid, gth = (size_t)F.G * NTHR;
    cvt_f32_bf16_stream(F.in[I_SUBK], (bf16*)(ws + WS_SUBK), (size_t)8 * 2 * 128 * 128, gtid, gth);
    cvt_f32_fp8_sliced(F.in[I_PD], ws + WS_PD, PD_SCALE, gtid, gth);
    cvt_f32_fp8_sliced(F.in[I_PU], ws + WS_PU, PU_SCALE, gtid, gth);
    for (int m = gw; m < NB * NMEM; m += NGW) { f32x4 v[4]; rms_row_to_bf16(F.in[I_MEM] + (size_t)m * DM, F.in[I_MEMNW], (bf16*)(ws + WS_MEMN) + (size_t)m * DM, F.lane, v); }
    float* DTp = (float*)(ws + WS_DT);
    const int lane = F.lane;
    const int myj = ((lane >> 5) & 1) * 8 + ((lane >> 4) & 1) * 4 + ((lane >> 3) & 1) * 2 + ((lane >> 2) & 1);
    const float dtb = F.in[I_DTB][myj];
    for (int m = 2 * gw; m < T; m += 2 * NGW) {
        f32x4 va[4], vb[4];
        rms_row_to_bf16(F.in[I_X] + (size_t)m * DM, F.in[I_NMIXW], (bf16*)(ws + WS_ACT1) + (size_t)m * DM, lane, va);
        rms_row_to_bf16(F.in[I_X] + (size_t)(m + 1) * DM, F.in[I_NMIXW], (bf16*)(ws + WS_ACT1) + (size_t)(m + 1) * DM, lane, vb);
        float da[16], db[16];
#pragma unroll
        for (int j = 0; j < 16; ++j) { da[j] = 0.f; db[j] = 0.f; }
#pragma unroll
        for (int j = 0; j < 4; ++j)
#pragma unroll
            for (int e = 0; e < 4; ++e) { const float ua = va[j][e], ub = vb[j][e];
#pragma unroll
                for (int q = 0; q < 4; ++q) { const f32x4 w4 = *(const LAS f32x4*)(wdt + ((((j * 4 + e) * 4 + q) * 64 + lane) << 2));
                    da[4 * q + 0] += ua * w4.x; da[4 * q + 1] += ua * w4.y; da[4 * q + 2] += ua * w4.z; da[4 * q + 3] += ua * w4.w;
                    db[4 * q + 0] += ub * w4.x; db[4 * q + 1] += ub * w4.y; db[4 * q + 2] += ub * w4.z; db[4 * q + 3] += ub * w4.w; }
                __builtin_amdgcn_sched_barrier(0); }
        float ra, rb;
        { float r8a[8], r8b[8], r4a[4], r4b[4], r2a[2], r2b[2];
          { const bool up = (lane & 32) != 0;
#pragma unroll
            for (int k = 0; k < 8; ++k) { r8a[k] = (up ? da[k + 8] : da[k]) + __shfl_xor(up ? da[k] : da[k + 8], 32); r8b[k] = (up ? db[k + 8] : db[k]) + __shfl_xor(up ? db[k] : db[k + 8], 32); } }
          { const bool up = (lane & 16) != 0;
#pragma unroll
            for (int k = 0; k < 4; ++k) { r4a[k] = (up ? r8a[k + 4] : r8a[k]) + __shfl_xor(up ? r8a[k] : r8a[k + 4], 16); r4b[k] = (up ? r8b[k + 4] : r8b[k]) + __shfl_xor(up ? r8b[k] : r8b[k + 4], 16); } }
          { const bool up = (lane & 8) != 0;
#pragma unroll
            for (int k = 0; k < 2; ++k) { r2a[k] = (up ? r4a[k + 2] : r4a[k]) + __shfl_xor(up ? r4a[k] : r4a[k + 2], 8); r2b[k] = (up ? r4b[k + 2] : r4b[k]) + __shfl_xor(up ? r4b[k] : r4b[k + 2], 8); } }
          { const bool up = (lane & 4) != 0; ra = (up ? r2a[1] : r2a[0]) + __shfl_xor(up ? r2a[0] : r2a[1], 4); rb = (up ? r2b[1] : r2b[0]) + __shfl_xor(up ? r2b[0] : r2b[1], 4); }
          ra += __shfl_xor(ra, 2); ra += __shfl_xor(ra, 1); rb += __shfl_xor(rb, 2); rb += __shfl_xor(rb, 1); }
        if ((lane & 3) == 0) { const float xa = ra + dtb, xb = rb + dtb;
            DTp[(size_t)m * 16 + myj] = (xa > 20.f) ? xa : log1pf(__expf(xa)); DTp[(size_t)(m + 1) * 16 + myj] = (xb > 20.f) ? xb : log1pf(__expf(xb)); }
    }
}

__device__ __forceinline__ void norm192_inplace(bf16* p, const float (&w)[4], int lane) {
    u32x2 v = {0u, 0u};
    if (lane < 48) v = *(const u32x2*)(p + 4 * lane);
    float x0 = bflo(v.x), x1 = bfhi(v.x), x2 = bflo(v.y), x3 = bfhi(v.y);
    const float ss = wave_sum((x0 * x0 + x1 * x1) + (x2 * x2 + x3 * x3));
    const float rs = 1.0f / sqrtf(ss * (1.f / 192.f) + EPS);
    if (lane < 48) { const u32x2 o = {pkbf(x0 * rs * w[0], x1 * rs * w[1]), pkbf(x2 * rs * w[2], x3 * rs * w[3])}; *(u32x2*)(p + 4 * lane) = o; }
}
__device__ __forceinline__ void qkprep_phase(Frame& F, int half) {
    bf16* P = (bf16*)(F.ws + WS_BIG);
    const int gw = F.bid * NWAVES + F.wave, NGW = F.G * NWAVES, lane = F.lane, sub = lane & 7;
    float wq[8], wk[8], wmq[4], wmk[4];
#pragma unroll
    for (int j = 0; j < 8; ++j) { wq[j] = F.in[I_DQNW][8 * sub + j]; wk[j] = F.in[I_DKNW][8 * sub + j]; }
#pragma unroll
    for (int j = 0; j < 4; ++j) { wmq[j] = F.in[I_MQNW][(4 * lane + j) % 192]; wmk[j] = F.in[I_MKNW][(4 * lane + j) % 192]; }
    const float inv = __expf(-logf(500000.0f) * (2.0f / 16.0f) * (float)sub);
    for (int r0 = gw; r0 < HT; r0 += 2 * NGW) {
        bf16* rowp[2]; u32x4 v[2][3]; u32x2 m[2][4]; int pos[2];
#pragma unroll
        for (int u = 0; u < 2; ++u) { const int r = (r0 + u * NGW < HT) ? r0 + u * NGW : r0; rowp[u] = P + (size_t)r * NPROJ; pos[u] = F.positions[half * HT + r];
#pragma unroll
            for (int blk = 0; blk < 3; ++blk) v[u][blk] = *(const u32x4*)(rowp[u] + PC_DQ + blk * 512 + 8 * lane);
#pragma unroll
            for (int h = 0; h < 4; ++h) { m[u][h] = (u32x2){0u, 0u}; if (lane < 48) m[u][h] = *(const u32x2*)(rowp[u] + PC_MQ + h * 192 + 4 * lane); } }
#pragma unroll
        for (int u = 0; u < 2; ++u) {
            if (u == 1 && r0 + NGW >= HT) break;
            const double rev = (double)((float)pos[u] * inv) * 0.15915494309189535;
            const float fr = (float)(rev - floor(rev));
            const float cs = __builtin_amdgcn_cosf(fr), sn = __builtin_amdgcn_sinf(fr);
            float cj[8], sj[8];
#pragma unroll
            for (int j = 0; j < 8; ++j) { cj[j] = __shfl(cs, (lane & ~7) | j); sj[j] = __shfl(sn, (lane & ~7) | j); }
            bf16* row = rowp[u];
#pragma unroll
            for (int blk = 0; blk < 3; ++blk) {
                float x[8] = {bflo(v[u][blk].x), bfhi(v[u][blk].x), bflo(v[u][blk].y), bfhi(v[u][blk].y), bflo(v[u][blk].z), bfhi(v[u][blk].z), bflo(v[u][blk].w), bfhi(v[u][blk].w)};
                float ss = 0.f;
#pragma unroll
                for (int j = 0; j < 8; ++j) ss += x[j] * x[j];
                ss += __shfl_xor(ss, 1); ss += __shfl_xor(ss, 2); ss += __shfl_xor(ss, 4);
                const float rs = 1.0f / sqrtf(ss * (1.f / 64.f) + EPS);
                const bool isq = (8 * blk + (lane >> 3)) < 12;
#pragma unroll
                for (int j = 0; j < 8; ++j) x[j] = x[j] * rs * (isq ? wq[j] : wk[j]);
#pragma unroll
                for (int j = 0; j < 8; ++j) { const float o = __shfl_xor(x[j], 1);
                    if (sub == 0) x[j] = x[j] * cj[j] - o * sj[j]; else if (sub == 1) x[j] = x[j] * cj[j] + o * sj[j]; }
                const u32x4 w = {pkbf(x[0], x[1]), pkbf(x[2], x[3]), pkbf(x[4], x[5]), pkbf(x[6], x[7])};
                *(u32x4*)(row + PC_DQ + blk * 512 + 8 * lane) = w;
            }
#pragma unroll
            for (int h = 0; h < 4; ++h) { const u32x2 q = m[u][h]; const float x0 = bflo(q.x), x1 = bfhi(q.x), x2 = bflo(q.y), x3 = bfhi(q.y);
                const float ss = wave_sum((x0 * x0 + x1 * x1) + (x2 * x2 + x3 * x3));
                const float rs = 1.0f / sqrtf(ss * (1.f / 192.f) + EPS);
                if (lane < 48) { const u32x2 o = {pkbf(x0 * rs * wmq[0], x1 * rs * wmq[1]), pkbf(x2 * rs * wmq[2], x3 * rs * wmq[3])}; *(u32x2*)(row + PC_MQ + h * 192 + 4 * lane) = o; } }
        }
    }
    if (half == 0) {
        bf16* MK = (bf16*)(F.ws + WS_MKV);
        for (int r = gw; r < NB * NMEM * 4; r += NGW) norm192_inplace(MK + (size_t)(r >> 2) * 1536 + (r & 3) * 192, wmk, lane);
    }
}

constexpr int SC_ST = 272, SX_ST = 528;
__device__ __forceinline__ float bfsel(const u32x4& v, int j) { const unsigned w = v[j >> 1]; return (j & 1) ? bfhi(w) : bflo(w); }
__device__ __forceinline__ void conv_task(const bf16* P, size_t rowb, int t0, int pcol, const float* cw, const float* cb, int ccol, LAS unsigned char* dst, int stride, const LAS float* scale) {
    float w[4][8], bs[8];
#pragma unroll
    for (int k = 0; k < 4; ++k) { const f32x4 a = *(const f32x4*)(cw + k * 2048 + ccol), b = *(const f32x4*)(cw + k * 2048 + ccol + 4);
        w[k][0] = a.x; w[k][1] = a.y; w[k][2] = a.z; w[k][3] = a.w; w[k][4] = b.x; w[k][5] = b.y; w[k][6] = b.z; w[k][7] = b.w; }
    { const f32x4 a = *(const f32x4*)(cb + ccol), b = *(const f32x4*)(cb + ccol + 4); bs[0] = a.x; bs[1] = a.y; bs[2] = a.z; bs[3] = a.w; bs[4] = b.x; bs[5] = b.y; bs[6] = b.z; bs[7] = b.w; }
    const bf16* src = P + (rowb + t0) * NPROJ + pcol;
    u32x4 rw[19];
#pragma unroll
    for (int i = 0; i < 3; ++i) rw[i] = (u32x4){0u, 0u, 0u, 0u};
    if (t0 > 0) {
#pragma unroll
        for (int i = 0; i < 3; ++i) rw[i] = *(const u32x4*)(src + (ptrdiff_t)(i - 3) * NPROJ); }
#pragma unroll
    for (int i = 0; i < 16; ++i) rw[3 + i] = *(const u32x4*)(src + (size_t)i * NPROJ);
#pragma unroll
    for (int i = 0; i < 16; ++i) {
        float o[8];
#pragma unroll
        for (int j = 0; j < 8; ++j) { float a = bs[j] + w[0][j] * bfsel(rw[i], j) + w[1][j] * bfsel(rw[i + 1], j) + w[2][j] * bfsel(rw[i + 2], j) + w[3][j] * bfsel(rw[i + 3], j); o[j] = a * sigmoidf_(a); }
        if (scale) { const float sv = scale[i];
#pragma unroll
            for (int j = 0; j < 8; ++j) o[j] *= sv; }
        const u32x4 r = {pkbf(o[0], o[1]), pkbf(o[2], o[3]), pkbf(o[4], o[5]), pkbf(o[6], o[7])};
        *(LAS u32x4*)(dst + i * stride) = r;
    }
}
__device__ __forceinline__ float ssd_scan(Frame& F, const float* DTp, size_t tok0, int g, LAS float* sAc, LAS float* sDt) {
    float total = 0.f;
    if (F.wave < 4) {
        const int head = 4 * g + F.wave, lane = F.lane;
        const float A = -__expf(F.in[I_ALOG][head]);
        const float d0 = DTp[(tok0 + 2 * lane) * 16 + head], d1 = DTp[(tok0 + 2 * lane + 1) * 16 + head];
        const float a0 = d0 * A, a1 = d1 * A;
        float sc = a0 + a1;
#pragma unroll
        for (int o = 1; o < 64; o <<= 1) { const float v = __shfl_up(sc, o); if (lane >= o) sc += v; }
        sAc[F.wave * 128 + 2 * lane] = sc - a1; sAc[F.wave * 128 + 2 * lane + 1] = sc;
        sDt[F.wave * 128 + 2 * lane] = d0; sDt[F.wave * 128 + 2 * lane + 1] = d1;
        total = __shfl(sc, 63);
    }
    return total;
}
__device__ __forceinline__ bf16x8 tr_pair(unsigned a_lo, unsigned a_hi) {
    s16x4 lo, hi;
    asm volatile("ds_read_b64_tr_b16 %0, %2\n\tds_read_b64_tr_b16 %1, %3\n\ts_waitcnt lgkmcnt(0)" : "=&v"(lo), "=&v"(hi) : "v"(a_lo), "v"(a_hi) : "memory");
    const bf16x8 r = {lo[0], lo[1], lo[2], lo[3], hi[0], hi[1], hi[2], hi[3]}; return r;
}

__device__ __forceinline__ void ssdC_phase(Frame& F, int half) {
    const bf16* P = (const bf16*)(F.ws + WS_BIG);
    const float* DTp = (const float*)(F.ws + WS_DT);
    float* SST = (float*)(F.ws + WS_SST); float* DEC = (float*)(F.ws + WS_DEC);
    LAS unsigned char* sX = F.lds; LAS unsigned char* sB = F.lds + 128 * SX_ST;
    LAS float* sAc = (LAS float*)(F.lds + 128 * SX_ST + 128 * SC_ST); LAS float* sDt = sAc + 512; LAS float* sW = sDt + 512;
    const int wave = F.wave;
    for (int unit = F.bid; unit < HB * 64 * 4; unit += F.G) {
        int tid = F.tid; asm volatile("" : "+v"(tid));
        const int lane = tid & 63, ql = lane & 31, h = lane >> 5, tq = (lane & 15) >> 2, tp = lane & 3, tblk = (lane >> 4) & 1;
        const int bl = unit >> 8, c = (unit >> 2) & 63, g = unit & 3;
        const size_t rowb = (size_t)bl * SEQ, tok0 = (size_t)half * HT + rowb + c * 128;
        __syncthreads();
        const float total = ssd_scan(F, DTp, tok0, g, sAc, sDt);
        if (wave < 4) { sW[wave * 128 + 2 * lane] = __expf(total - sAc[wave * 128 + 2 * lane]) * sDt[wave * 128 + 2 * lane];
            sW[wave * 128 + 2 * lane + 1] = __expf(total - sAc[wave * 128 + 2 * lane + 1]) * sDt[wave * 128 + 2 * lane + 1];
            if (lane == 0) DEC[((size_t)bl * 64 + c) * 16 + 4 * g + wave] = __expf(total); }
        __syncthreads();
        if (tid < 384) {
            int ch, strip, ccol, stride; LAS unsigned char* dst; const LAS float* scl = nullptr;
            if (tid < 256) { ch = tid & 31; strip = tid >> 5; ccol = g * 256 + 8 * ch; stride = SX_ST; dst = sX + (strip * 16) * SX_ST + ch * 16; scl = sW + (ch >> 3) * 128 + strip * 16; }
            else { const int u = tid - 256; ch = u & 15; strip = u >> 4; ccol = 1024 + g * 128 + 8 * ch; stride = SC_ST; dst = sB + (strip * 16) * SC_ST + ch * 16; }
            conv_task(P, rowb, c * 128 + strip * 16, PC_X + ccol, F.in[I_CONVW], F.in[I_CONVB], ccol, dst, stride, scl);
        }
        __syncthreads();
        const int r = wave >> 1, pt = wave & 1;
        f32x16 acc[4];
#pragma unroll
        for (int nt = 0; nt < 4; ++nt)
#pragma unroll
            for (int e = 0; e < 16; ++e) acc[nt][e] = 0.f;
        const unsigned xa = (unsigned)(size_t)sX + (unsigned)((8 * h + tq) * SX_ST + (r * 64 + 32 * pt + 16 * tblk + 4 * tp) * 2);
        const unsigned ba = (unsigned)(size_t)sB + (unsigned)((8 * h + tq) * SC_ST + (16 * tblk + 4 * tp) * 2);
#pragma unroll
        for (int ks = 0; ks < 8; ++ks) {
            const bf16x8 af = tr_pair(xa + ks * 16 * SX_ST, xa + ks * 16 * SX_ST + 4 * SX_ST);
            bf16x8 bfr[4];
#pragma unroll
            for (int nt = 0; nt < 4; ++nt) bfr[nt] = tr_pair(ba + ks * 16 * SC_ST + nt * 64, ba + ks * 16 * SC_ST + 4 * SC_ST + nt * 64);
            __builtin_amdgcn_sched_barrier(0);
#pragma unroll
            for (int nt = 0; nt < 4; ++nt) acc[nt] = MFMA32(af, bfr[nt], acc[nt]);
        }
        float* out = SST + (((size_t)bl * 64 + c) * 16 + 4 * g + r) * 8192;
#pragma unroll
        for (int nt = 0; nt < 4; ++nt)
#pragma unroll
            for (int e = 0; e < 16; ++e) out[(32 * pt + (e & 3) + 8 * (e >> 2) + 4 * h) * 128 + 32 * nt + ql] = acc[nt][e];
    }
}

__device__ __forceinline__ void ssdD_phase(Frame& F) {
    const float* SST = (const float*)(F.ws + WS_SST); const float* DEC = (const float*)(F.ws + WS_DEC);
    bf16* SIN = (bf16*)(F.ws + WS_SIN);
    const size_t gtid = (size_t)F.bid * NTHR + F.tid, gth = (size_t)F.G * NTHR;
    for (size_t it = gtid; it < (size_t)HB * 16 * 2048; it += gth) {
        const int bl = (int)(it >> 15), head = (int)(it >> 11) & 15, e4 = (int)(it & 2047) * 4;
        f32x4 st = {0.f, 0.f, 0.f, 0.f};
#pragma unroll 8
        for (int c = 0; c < 64; ++c) {
            const size_t idx = (((size_t)bl * 64 + c) * 16 + head);
            const u32x2 o = {pkbf(st.x, st.y), pkbf(st.z, st.w)};
            *(u32x2*)(SIN + idx * 8192 + e4) = o;
            const f32x4 sl = *(const f32x4*)(SST + idx * 8192 + e4); const float d = DEC[idx];
            st = st * d + sl;
        }
    }
}

__device__ __forceinline__ void ssdE_phase(Frame& F, int half) {
    const bf16* P = (const bf16*)(F.ws + WS_BIG);
    const float* DTp = (const float*)(F.ws + WS_DT);
    const bf16* SIN = (const bf16*)(F.ws + WS_SIN);
    bf16* Y = (bf16*)F.out;
    LAS unsigned char* sX = F.lds; LAS unsigned char* sB = F.lds + 128 * SX_ST; LAS unsigned char* sC = sB + 128 * SC_ST;
    LAS float* sAc = (LAS float*)(sC + 128 * SC_ST); LAS float* sDt = sAc + 512; LAS float* sSS = sDt + 512;
    const int wave = F.wave;
    const int st = wave & 3, hp = wave >> 2;
    for (int unit = F.bid; unit < HB * 64 * 4; unit += F.G) {
        int tid = F.tid; asm volatile("" : "+v"(tid));
        const int lane = tid & 63, ql = lane & 31, h = lane >> 5, tq = (lane & 15) >> 2, tp = lane & 3, tblk = (lane >> 4) & 1;
        const int bl = unit >> 8, c = (unit >> 2) & 63, g = unit & 3;
        const size_t rowb = (size_t)bl * SEQ, tok0 = (size_t)half * HT + rowb + c * 128;
        __syncthreads();
        (void)ssd_scan(F, DTp, tok0, g, sAc, sDt);
        if (tid < 128) sSS[tid] = 0.f;
        {
            int ch, strip, ccol, stride; LAS unsigned char* dst;
            if (tid < 256) { ch = tid & 31; strip = tid >> 5; ccol = g * 256 + 8 * ch; stride = SX_ST; dst = sX + (strip * 16) * SX_ST + ch * 16; }
            else if (tid < 384) { const int u = tid - 256; ch = u & 15; strip = u >> 4; ccol = 1024 + g * 128 + 8 * ch; stride = SC_ST; dst = sB + (strip * 16) * SC_ST + ch * 16; }
            else { const int u = tid - 384; ch = u & 15; strip = u >> 4; ccol = 1536 + g * 128 + 8 * ch; stride = SC_ST; dst = sC + (strip * 16) * SC_ST + ch * 16; }
            conv_task(P, rowb, c * 128 + strip * 16, PC_X + ccol, F.in[I_CONVW], F.in[I_CONVB], ccol, dst, stride, nullptr);
        }
        __syncthreads();
        const int s = 32 * st + ql;
        unsigned yk[2][2][8];
        float ssq = 0.f;
        const unsigned xa = (unsigned)(size_t)sX + (unsigned)((4 * h + tq) * SX_ST + (16 * tblk + 4 * tp) * 2);
#pragma unroll
        for (int hq = 0; hq < 2; ++hq) {
            const int r = 2 * hp + hq, head = 4 * g + r;
            const float acs = sAc[r * 128 + s];
            const bf16* stp = SIN + (((size_t)bl * 64 + c) * 16 + head) * 8192 + ql * 128 + 8 * h;
            bf16x8 sfr[2][8];
#pragma unroll
            for (int pt = 0; pt < 2; ++pt)
#pragma unroll
                for (int ks = 0; ks < 8; ++ks) sfr[pt][ks] = *(const bf16x8*)(stp + pt * 4096 + 16 * ks);
            bf16x8 pf[4][2];
#pragma unroll
            for (int i = 0; i < 4; ++i) {
                f32x16 Xi;
#pragma unroll
                for (int e = 0; e < 16; ++e) Xi[e] = 0.f;
#pragma unroll
                for (int ks = 0; ks < 8; ++ks) { const bf16x8 bf_ = *(const LAS bf16x8*)(sB + (32 * i + ql) * SC_ST + 32 * ks + 16 * h);
                    const bf16x8 cf = *(const LAS bf16x8*)(sC + s * SC_ST + 32 * ks + 16 * h); Xi = MFMA32(bf_, cf, Xi); }
                float p[16];
#pragma unroll
                for (int q4 = 0; q4 < 4; ++q4) { const int t0 = 32 * i + 8 * q4 + 4 * h;
                    const f32x4 at = *(const LAS f32x4*)(sAc + r * 128 + t0), dt4 = *(const LAS f32x4*)(sDt + r * 128 + t0);
#pragma unroll
                    for (int e = 0; e < 4; ++e) { const int t = t0 + e; p[4 * q4 + e] = (t <= s) ? Xi[4 * q4 + e] * __expf(acs - at[e]) * dt4[e] : 0.f; } }
#pragma unroll
                for (int s2 = 0; s2 < 2; ++s2) { const u32x4 w = {pkbf(p[8 * s2 + 0], p[8 * s2 + 1]), pkbf(p[8 * s2 + 2], p[8 * s2 + 3]), pkbf(p[8 * s2 + 4], p[8 * s2 + 5]), pkbf(p[8 * s2 + 6], p[8 * s2 + 7])};
                    pf[i][s2] = __builtin_bit_cast(bf16x8, w); }
            }
            const float eacs = __expf(acs), Dh = F.in[I_SSDD][head];
#pragma unroll
            for (int pt = 0; pt < 2; ++pt) {
                f32x16 yd, yo;
#pragma unroll
                for (int e = 0; e < 16; ++e) { yd[e] = 0.f; yo[e] = 0.f; }
#pragma unroll
                for (int i = 0; i < 4; ++i) {
#pragma unroll
                    for (int s2 = 0; s2 < 2; ++s2) { const unsigned a = xa + (unsigned)((32 * i + 16 * s2) * SX_ST + (r * 64 + 32 * pt) * 2);
                        const bf16x8 xf = tr_pair(a, a + 8 * SX_ST); __builtin_amdgcn_sched_barrier(0); yd = MFMA32(xf, pf[i][s2], yd); }
                }
#pragma unroll
                for (int ks = 0; ks < 8; ++ks) { const bf16x8 cf = *(const LAS bf16x8*)(sC + s * SC_ST + 32 * ks + 16 * h); yo = MFMA32(sfr[pt][ks], cf, yo); }
                const bf16* zp = P + (rowb + c * 128 + s) * NPROJ + PC_Z + g * 256 + r * 64 + 32 * pt + 4 * h;
                u32x2 zv[4];
#pragma unroll
                for (int q4 = 0; q4 < 4; ++q4) zv[q4] = *(const u32x2*)(zp + 8 * q4);
#pragma unroll
                for (int q4 = 0; q4 < 4; ++q4) {
                    const u32x2 xv = *(const LAS u32x2*)(sX + s * SX_ST + (r * 64 + 32 * pt + 8 * q4 + 4 * h) * 2);
                    const u32x2 zq = zv[q4];
                    const float xs_[4] = {bflo(xv.x), bfhi(xv.x), bflo(xv.y), bfhi(xv.y)}, zs_[4] = {bflo(zq.x), bfhi(zq.x), bflo(zq.y), bfhi(zq.y)};
                    float yv[4];
#pragma unroll
                    for (int e = 0; e < 4; ++e) { float y = yd[4 * q4 + e] + eacs * yo[4 * q4 + e] + Dh * xs_[e]; y = y * zs_[e] * sigmoidf_(zs_[e]); yv[e] = y; ssq += y * y; }
                    yk[hq][pt][2 * q4] = pkbf(yv[0], yv[1]); yk[hq][pt][2 * q4 + 1] = pkbf(yv[2], yv[3]);
                }
            }
        }
        ssq += __shfl_xor(ssq, 32);
        if (h == 0) __hip_atomic_fetch_add(sSS + s, ssq, __ATOMIC_RELAXED, __HIP_MEMORY_SCOPE_WORKGROUP);
        __syncthreads();
        const float rs = 1.0f / sqrtf(sSS[s] * (1.f / 256.f) + EPS);
        bf16* yp = Y + (tok0 + s) * YC + g * 256 + 4 * h;
        const float* nw = F.in[I_SSDNW] + g * 256 + 4 * h;
#pragma unroll
        for (int hq = 0; hq < 2; ++hq)
#pragma unroll
            for (int pt = 0; pt < 2; ++pt)
#pragma unroll
                for (int q4 = 0; q4 < 4; ++q4) { const int cc = (2 * hp + hq) * 64 + 32 * pt + 8 * q4; const f32x4 w4 = *(const f32x4*)(nw + cc);
                    const unsigned ya = yk[hq][pt][2 * q4], yb = yk[hq][pt][2 * q4 + 1];
                    const u32x2 o = {pkbf(bflo(ya) * rs * w4.x, bfhi(ya) * rs * w4.y), pkbf(bflo(yb) * rs * w4.z, bfhi(yb) * rs * w4.w)};
                    *(u32x2*)(yp + cc) = o; }
    }
}

__device__ __forceinline__ bf16x8 mk_bf16x8(u32x2 lo, u32x2 hi) { const u32x4 v = {lo.x, lo.y, hi.x, hi.y}; return __builtin_bit_cast(bf16x8, v); }

__device__ __forceinline__ void memattn_mfma_phase(Frame& F, int half) {
    const bf16* P = (const bf16*)(F.ws + WS_BIG);
    const bf16* MKV = (const bf16*)(F.ws + WS_MKV);
    const bf16* MVT = (const bf16*)(F.ws + WS_MVT);
    bf16* Y = (bf16*)F.out;
    LAS unsigned char* sm = F.lds;
    const int tid = F.tid, lane = F.lane, wave = F.wave, ql = lane & 31, h = lane >> 5;
    constexpr int KST = 400, VST = 528;
    for (int unit = F.bid; unit < HB * 4 * 32; unit += F.G) {
        const int bl = unit >> 7, head = (unit >> 5) & 3, qt = unit & 31, b = half * HB + bl;
        const int r = bl * SEQ + qt * 256 + wave * 32 + ql;
        __syncthreads();
        for (int c = tid; c < 256 * 24; c += NTHR) { const int row = c / 24, ch = c % 24;
            *(LAS u32x4*)(sm + row * KST + ch * 16) = *(const u32x4*)(MKV + (size_t)(b * NMEM + row) * 1536 + head * 192 + ch * 8); }
        bf16x8 qf[12];
        { const bf16* qp = P + (size_t)r * NPROJ + PC_MQ + head * 192 + 8 * h;
#pragma unroll
          for (int ks = 0; ks < 12; ++ks) qf[ks] = *(const bf16x8*)(qp + 16 * ks); }
        __syncthreads();
        f32x16 sacc[8];
#pragma unroll
        for (int mt = 0; mt < 8; ++mt) {
#pragma unroll
            for (int i = 0; i < 16; ++i) sacc[mt][i] = 0.f;
#pragma unroll
            for (int ks = 0; ks < 12; ++ks) { const bf16x8 kf = *(const LAS bf16x8*)(sm + (32 * mt + ql) * KST + 32 * ks + 16 * h); sacc[mt] = MFMA32(kf, qf[ks], sacc[mt]); }
        }
        float mx = -3.0e38f;
#pragma unroll
        for (int mt = 0; mt < 8; ++mt)
#pragma unroll
            for (int i = 0; i < 16; ++i) mx = fmaxf(mx, sacc[mt][i]);
        mx = fmaxf(mx, __shfl_xor(mx, 32));
        const float sc = 0.07216878364870323f * 1.4426950408889634f;
        float l = 0.f;
        bf16x8 pf[8][2];
#pragma unroll
        for (int mt = 0; mt < 8; ++mt) {
            float p[16];
#pragma unroll
            for (int i = 0; i < 16; ++i) { p[i] = __builtin_amdgcn_exp2f((sacc[mt][i] - mx) * sc); l += p[i]; }
#pragma unroll
            for (int s2 = 0; s2 < 2; ++s2) { const u32x4 w = {pkbf(p[8 * s2 + 0], p[8 * s2 + 1]), pkbf(p[8 * s2 + 2], p[8 * s2 + 3]), pkbf(p[8 * s2 + 4], p[8 * s2 + 5]), pkbf(p[8 * s2 + 6], p[8 * s2 + 7])};
                pf[mt][s2] = __builtin_bit_cast(bf16x8, w); }
        }
        l += __shfl_xor(l, 32);
        __syncthreads();
        for (int c = tid; c < 192 * 32; c += NTHR) { const int row = c >> 5, ch = c & 31;
            *(LAS u32x4*)(sm + row * VST + ch * 16) = *(const u32x4*)(MVT + (size_t)(head * 192 + row) * 2048 + b * NMEM + ch * 8); }
        __syncthreads();
        const float il = 1.0f / l;
        bf16* yp = Y + ((size_t)half * HT + r) * YC + 1280 + head * 192 + 4 * h;
#pragma unroll
        for (int dt = 0; dt < 6; ++dt) {
            f32x16 o;
#pragma unroll
            for (int i = 0; i < 16; ++i) o[i] = 0.f;
#pragma unroll
            for (int mt = 0; mt < 8; ++mt)
#pragma unroll
                for (int s2 = 0; s2 < 2; ++s2) { const LAS unsigned char* vp = sm + (32 * dt + ql) * VST + (32 * mt + 16 * s2 + 4 * h) * 2;
                    const bf16x8 vf = mk_bf16x8(*(const LAS u32x2*)vp, *(const LAS u32x2*)(vp + 16)); o = MFMA32(vf, pf[mt][s2], o); }
#pragma unroll
            for (int g = 0; g < 4; ++g) { const u32x2 w = {pkbf(o[4 * g] * il, o[4 * g + 1] * il), pkbf(o[4 * g + 2] * il, o[4 * g + 3] * il)}; *(u32x2*)(yp + 32 * dt + 8 * g) = w; }
        }
    }
}

__device__ __forceinline__ void dilattn_mfma_phase(Frame& F, int half) {
    bf16* P = (bf16*)(F.ws + WS_BIG);
    float* LSE = (float*)(F.ws + WS_LSE);
    LAS unsigned char* sK = F.lds; LAS unsigned char* sV = F.lds + 384 * 144;
    const int tid = F.tid, lane = F.lane, wave = F.wave, ql = lane & 31, h = lane >> 5;
    constexpr int RST = 144;
    for (int unit = F.bid; unit < HB * 12 * 32; unit += F.G) {
        const int bl = unit / 384, rem = unit % 384, head = rem >> 5, blk = rem & 31;
        const int g = head >> 2, dil = (g == 0) ? 1 : (g == 1 ? 4 : 16), bpr = 32 / dil;
        const int res = blk / bpr, q0 = (blk % bpr) * 256;
        const size_t rowb = (size_t)bl * SEQ;
        __syncthreads();
        for (int c = tid; c < 384 * 8; c += NTHR) { const int row = c >> 3, ch = c & 7; const int ks = q0 - 128 + row;
            u32x4 kv = {0u, 0u, 0u, 0u}, vv = {0u, 0u, 0u, 0u};
            if (ks >= 0) { const bf16* src = P + (rowb + (size_t)ks * dil + res) * NPROJ + head * 64 + ch * 8; kv = *(const u32x4*)(src + PC_DK); vv = *(const u32x4*)(src + PC_DV); }
            *(LAS u32x4*)(sK + row * RST + ch * 16) = kv; *(LAS u32x4*)(sV + row * RST + ch * 16) = vv; }
        const int qs = q0 + wave * 32 + ql;
        const size_t rq = rowb + (size_t)qs * dil + res;
        bf16* qp = P + rq * NPROJ + PC_DQ + head * 64;
        bf16x8 qf[4];
#pragma unroll
        for (int ks = 0; ks < 4; ++ks) qf[ks] = *(const bf16x8*)(qp + 16 * ks + 8 * h);
        __syncthreads();
        f32x16 sacc[5];
        const int kfirst = q0 + wave * 32 - 128;
#pragma unroll
        for (int i = 0; i < 5; ++i) {
#pragma unroll
            for (int e = 0; e < 16; ++e) sacc[i][e] = 0.f;
#pragma unroll
            for (int ks = 0; ks < 4; ++ks) { const bf16x8 kf = *(const LAS bf16x8*)(sK + (32 * wave + 32 * i + ql) * RST + 32 * ks + 16 * h); sacc[i] = MFMA32(kf, qf[ks], sacc[i]); }
        }
        float mx = -3.0e38f;
#pragma unroll
        for (int i = 0; i < 5; ++i)
#pragma unroll
            for (int e = 0; e < 16; ++e) { const int kj = 32 * i + (e & 3) + 8 * (e >> 2) + 4 * h; const bool ok = (kj >= ql) && (kj <= ql + 128) && (kfirst + kj >= 0);
                sacc[i][e] = ok ? sacc[i][e] : -3.0e38f; mx = fmaxf(mx, sacc[i][e]); }
        mx = fmaxf(mx, __shfl_xor(mx, 32));
        const float sc = 0.125f * 1.4426950408889634f;
        float l = 0.f;
        bf16x8 pf[5][2];
#pragma unroll
        for (int i = 0; i < 5; ++i) {
            float p[16];
#pragma unroll
            for (int e = 0; e < 16; ++e) { p[e] = (sacc[i][e] > -1.0e38f) ? __builtin_amdgcn_exp2f((sacc[i][e] - mx) * sc) : 0.f; l += p[e]; }
#pragma unroll
            for (int s2 = 0; s2 < 2; ++s2) { const u32x4 w = {pkbf(p[8 * s2 + 0], p[8 * s2 + 1]), pkbf(p[8 * s2 + 2], p[8 * s2 + 3]), pkbf(p[8 * s2 + 4], p[8 * s2 + 5]), pkbf(p[8 * s2 + 6], p[8 * s2 + 7])};
                pf[i][s2] = __builtin_bit_cast(bf16x8, w); }
        }
        l += __shfl_xor(l, 32);
        const float il = 1.0f / l;
        const int tq = (lane & 15) >> 2, tp = lane & 3, tblk = (lane >> 4) & 1;
        const unsigned vbase = (unsigned)(size_t)(sV) + (unsigned)((32 * wave + 4 * h + tq) * RST + (16 * tblk + 4 * tp) * 2);
#pragma unroll
        for (int dt = 0; dt < 2; ++dt) {
            f32x16 o;
#pragma unroll
            for (int e = 0; e < 16; ++e) o[e] = 0.f;
#pragma unroll
            for (int i = 0; i < 5; ++i) {
                s16x4 lo[2], hi[2];
#pragma unroll
                for (int s2 = 0; s2 < 2; ++s2) { const unsigned a = vbase + (unsigned)((32 * i + 16 * s2) * RST + 64 * dt);
                    asm volatile("ds_read_b64_tr_b16 %0, %1" : "=&v"(lo[s2]) : "v"(a) : "memory");
                    asm volatile("ds_read_b64_tr_b16 %0, %1 offset:1152" : "=&v"(hi[s2]) : "v"(a) : "memory"); }
                asm volatile("s_waitcnt lgkmcnt(0)" ::: "memory"); __builtin_amdgcn_sched_barrier(0);
#pragma unroll
                for (int s2 = 0; s2 < 2; ++s2) { const bf16x8 vf = {lo[s2][0], lo[s2][1], lo[s2][2], lo[s2][3], hi[s2][0], hi[s2][1], hi[s2][2], hi[s2][3]}; o = MFMA32(vf, pf[i][s2], o); }
            }
#pragma unroll
            for (int gq = 0; gq < 4; ++gq) { const u32x2 w = {pkbf(o[4 * gq] * il, o[4 * gq + 1] * il), pkbf(o[4 * gq + 2] * il, o[4 * gq + 3] * il)}; *(u32x2*)(qp + 32 * dt + 8 * gq + 4 * h) = w; }
        }
        if (h == 0) LSE[((size_t)half * HT + rq) * 12 + head] = mx * 0.125f + __logf(l);
    }
}

__device__ __forceinline__ void dilmerge_phase(Frame& F, int half) {
    const bf16* P = (const bf16*)(F.ws + WS_BIG);
    const float* LSE = (const float*)(F.ws + WS_LSE);
    bf16* Y = (bf16*)F.out;
    const size_t gtid = (size_t)F.bid * NTHR + F.tid, gth = (size_t)F.G * NTHR;
    for (size_t it = gtid; it < (size_t)HT * 32; it += gth) {
        const size_t r = it >> 5; const int hh = (int)(it >> 3) & 3, d0 = (int)(it & 7) * 8;
        const size_t tok = (size_t)half * HT + r;
        const float l0 = LSE[tok * 12 + hh], l1 = LSE[tok * 12 + 4 + hh], l2 = LSE[tok * 12 + 8 + hh];
        const float m = fmaxf(l0, fmaxf(l1, l2));
        float w0 = __expf(l0 - m), w1 = __expf(l1 - m), w2 = __expf(l2 - m); const float iw = 1.0f / (w0 + w1 + w2); w0 *= iw; w1 *= iw; w2 *= iw;
        const bf16* op = P + r * NPROJ + PC_DQ + hh * 64 + d0;
        const u32x4 a = *(const u32x4*)op, b = *(const u32x4*)(op + 256), c = *(const u32x4*)(op + 512);
        u32x4 o;
        o.x = pkbf(w0 * bflo(a.x) + w1 * bflo(b.x) + w2 * bflo(c.x), w0 * bfhi(a.x) + w1 * bfhi(b.x) + w2 * bfhi(c.x));
        o.y = pkbf(w0 * bflo(a.y) + w1 * bflo(b.y) + w2 * bflo(c.y), w0 * bfhi(a.y) + w1 * bfhi(b.y) + w2 * bfhi(c.y));
        o.z = pkbf(w0 * bflo(a.z) + w1 * bflo(b.z) + w2 * bflo(c.z), w0 * bfhi(a.z) + w1 * bfhi(b.z) + w2 * bfhi(c.z));
        o.w = pkbf(w0 * bflo(a.w) + w1 * bflo(b.w) + w2 * bflo(c.w), w0 * bfhi(a.w) + w1 * bfhi(b.w) + w2 * bfhi(c.w));
        *(u32x4*)(Y + tok * YC + 1024 + hh * 64 + d0) = o;
    }
}

__device__ __forceinline__ void hn_panel(Frame& F, int pm) {
    for (int m = pm * 256 + F.wave; m < pm * 256 + 256; m += NWAVES) { f32x4 v[4]; rms_row_to_bf16(F.out + (size_t)m * DM, F.in[I_NFFNW], (bf16*)(F.ws + WS_ACT1) + (size_t)m * DM, F.lane, v); }
}
__device__ __forceinline__ void hn_phase(Frame& F) {
    const int gw = F.bid * NWAVES + F.wave, NGW = F.G * NWAVES;
    for (int m = gw; m < T; m += NGW) { f32x4 v[4]; rms_row_to_bf16(F.out + (size_t)m * DM, F.in[I_NFFNW], (bf16*)(F.ws + WS_ACT1) + (size_t)m * DM, F.lane, v); }
}


__device__ __forceinline__ float gelu_erf(float x) { return 0.5f * x * (1.0f + erff(x * 0.70710678118654752f)); }
__device__ __forceinline__ unsigned f2ord(float f) { const unsigned u = __builtin_bit_cast(unsigned, f); return u ^ ((unsigned)((int)u >> 31) | 0x80000000u); }
__device__ __forceinline__ float ord2f(unsigned k) { const unsigned m = (unsigned)((int)k >> 31); return __builtin_bit_cast(float, k ^ (0x80000000u | ~m)); }
#define CMPX(a, b) do { const unsigned _mx = max((a), (b)), _mn = min((a), (b)); (a) = _mx; (b) = _mn; } while (0)
__device__ __forceinline__ void bitonic_sort16_desc(unsigned (&v)[16]) {
#pragma unroll
    for (int k = 2; k <= 16; k <<= 1)
#pragma unroll
        for (int j = k >> 1; j > 0; j >>= 1)
#pragma unroll
            for (int i = 0; i < 16; ++i) { const int l = i ^ j; if (l > i) { if ((i & k) == 0) CMPX(v[i], v[l]); else CMPX(v[l], v[i]); } }
}
__device__ __forceinline__ void bitonic_merge16_desc(unsigned (&v)[16]) {
#pragma unroll
    for (int j = 8; j > 0; j >>= 1)
#pragma unroll
        for (int i = 0; i < 16; ++i) { const int l = i ^ j; if (l > i) CMPX(v[i], v[l]); }
}
__device__ __forceinline__ void top16_merge(unsigned (&a)[16], const unsigned (&b)[16]) {
#pragma unroll
    for (int i = 0; i < 16; ++i) a[i] = max(a[i], b[15 - i]);
    bitonic_merge16_desc(a);
}
constexpr int PK_ST = 272;
__device__ __forceinline__ void peer_topk_tile(Frame& F, size_t tok0, const bf16* Q, int* IDX, float* GATE) {
    const bf16* SK = (const bf16*)(F.ws + WS_SUBK);
    LAS unsigned char* sK = F.lds;
    int tid = F.tid; asm volatile("" : "+v"(tid));
    const int lane = tid & 63, wave = F.wave, ql = lane & 31, hh = lane >> 5;
    const size_t tok = tok0 + wave * 32 + ql;
    const bf16* qrow = Q + tok * PEER_Q + 8 * hh;
    __syncthreads();
#pragma unroll
    for (int j = 0; j < 4; ++j) { const int cidx = tid + 512 * j, row = cidx >> 4, ch = cidx & 15; *(LAS u32x4*)(sK + row * PK_ST + ch * 16) = *(const u32x4*)(SK + (size_t)row * 128 + ch * 8); }
    __syncthreads();
    unsigned k1[16];
    bf16x8 qf[8];
#pragma unroll
    for (int ks = 0; ks < 8; ++ks) qf[ks] = *(const bf16x8*)(qrow + 16 * ks);
#pragma unroll 1
    for (int hc = 0; hc < 16; ++hc) {
        LAS unsigned char* cur = sK + (hc & 1) * (128 * PK_ST); LAS unsigned char* nxt = sK + ((hc + 1) & 1) * (128 * PK_ST);
        u32x4 stg[4];
        const int hcn = (hc + 1) & 15;
#pragma unroll
        for (int j = 0; j < 4; ++j) { const int cidx = tid + 512 * j, row = cidx >> 4, ch = cidx & 15; stg[j] = *(const u32x4*)(SK + ((size_t)hcn * 128 + row) * 128 + ch * 8); }
        unsigned pk[4][16];
#pragma unroll
        for (int mt = 0; mt < 4; ++mt) {
            f32x16 acc;
#pragma unroll
            for (int e = 0; e < 16; ++e) acc[e] = 0.f;
#pragma unroll
            for (int ks = 0; ks < 8; ++ks) { const bf16x8 kf = *(const LAS bf16x8*)(cur + (32 * mt + ql) * PK_ST + 32 * ks + 16 * hh); acc = MFMA32(kf, qf[ks], acc); }
#pragma unroll
            for (int e = 0; e < 16; ++e) pk[mt][e] = (f2ord(acc[e]) & 0xFFFFFF80u) | (unsigned)(32 * mt + (e & 3) + 8 * (e >> 2) + 4 * hh);
        }
#pragma unroll
        for (int j = 0; j < 4; ++j) { const int cidx = tid + 512 * j, row = cidx >> 4, ch = cidx & 15; *(LAS u32x4*)(nxt + row * PK_ST + ch * 16) = stg[j]; }
        __syncthreads();
        __builtin_amdgcn_sched_barrier(0);
#pragma unroll
        for (int ks = 0; ks < 8; ++ks) qf[ks] = *(const bf16x8*)(qrow + hcn * 128 + 16 * ks);
        __builtin_amdgcn_sched_barrier(0);
#pragma unroll
        for (int mt = 0; mt < 4; ++mt) bitonic_sort16_desc(pk[mt]);
        top16_merge(pk[0], pk[1]); top16_merge(pk[2], pk[3]); top16_merge(pk[0], pk[2]);
        unsigned other[16];
#pragma unroll
        for (int i = 0; i < 16; ++i) other[i] = (unsigned)__shfl_xor((int)pk[0][i], 32);
        top16_merge(pk[0], other);
        if ((hc & 1) == 0) {
#pragma unroll
            for (int i = 0; i < 16; ++i) k1[i] = pk[0][i];
        } else {
            float f1[16], f2[16];
#pragma unroll
            for (int i = 0; i < 16; ++i) { f1[i] = ord2f(k1[i] & 0xFFFFFF80u); f2[i] = ord2f(pk[0][i] & 0xFFFFFF80u); }
            unsigned cd[4][16];
#pragma unroll
            for (int i = 0; i < 64; ++i) cd[i >> 4][i & 15] = 0u;
            int n = 0;
#pragma unroll
            for (int a = 0; a < 16; ++a)
#pragma unroll
                for (int b = 0; b < 16; ++b)
                    if ((a + 1) * (b + 1) <= 16) { cd[n >> 4][n & 15] = (f2ord(f1[a] + f2[b]) & 0xFFFFC000u) | ((k1[a] & 127u) << 7) | (pk[0][b] & 127u); ++n; }
#pragma unroll
            for (int g4 = 0; g4 < 4; ++g4) bitonic_sort16_desc(cd[g4]);
            top16_merge(cd[0], cd[1]); top16_merge(cd[2], cd[3]); top16_merge(cd[0], cd[2]);
            const float vmax = ord2f(cd[0][0] & 0xFFFFC000u);
            float ex[16], den = 0.f;
#pragma unroll
            for (int i = 0; i < 16; ++i) { ex[i] = __expf(ord2f(cd[0][i] & 0xFFFFC000u) - vmax); den += ex[i]; }
            const float iden = 1.0f / den;
            const int h = hc >> 1;
            if (hh == 0) { int* ip = IDX + tok * 128 + h * 16;
#pragma unroll
                for (int i = 0; i < 4; ++i) { const u32x4 w = {cd[0][4 * i] & 0x3FFFu, cd[0][4 * i + 1] & 0x3FFFu, cd[0][4 * i + 2] & 0x3FFFu, cd[0][4 * i + 3] & 0x3FFFu}; *(u32x4*)(ip + 4 * i) = w; } }
            else { float* gp = GATE + tok * 128 + h * 16;
#pragma unroll
                for (int i = 0; i < 4; ++i) { const f32x4 w = {ex[4 * i] * iden, ex[4 * i + 1] * iden, ex[4 * i + 2] * iden, ex[4 * i + 3] * iden}; *(f32x4*)(gp + 4 * i) = w; } }
        }
    }
}

struct PeerDeal { size_t tokw; int ntok; size_t tok0; float* PART; const int* IDX; const float* GATE; float* COEF; };
__device__ __forceinline__ void peer_item(int n, const PeerDeal& D, int wave, int& slice, size_t& tok) { slice = n >> 5; tok = D.tokw + (n & 31); }
__device__ __forceinline__ void peer_down_rows(u32x4 (&R)[16], __amdgpu_buffer_rsrc_t tab, int slice, int id0, int id1, int lane) {
    const int soff = slice * (16384 * 128);
    const int r = lane & 15, g = lane >> 4, e8 = (r >> 2) + 4 * (g >> 1), q = 4 * (g & 1) + (r & 3);
    const int src0 = 16 * (e8 & 3);
#pragma unroll
    for (int k = 0; k < 16; ++k) { const int v0 = __shfl(id0, src0 + k), v1 = __shfl(id1, src0 + k); const int id = (e8 < 4) ? v0 : v1;
        R[k] = __builtin_amdgcn_raw_buffer_load_b128(tab, (id << 7) + 16 * q, soff, 0); }
}
__device__ __forceinline__ void peer_down_hn(u32x4 (&H)[2], const bf16* HN, int slice, size_t tok, int lane) {
    const bf16* hp = HN + tok * DM + slice * 128 + 16 * (4 * ((lane >> 4) & 1) + (lane & 3));
    H[0] = *(const u32x4*)hp; H[1] = *(const u32x4*)(hp + 8);
}
__device__ __forceinline__ void peer_down_bq(long (&bq)[2], const u32x4 (&H)[2], int lane) {
    const int c = lane & 15, g = lane >> 4; const bool on = (c < 8) && ((c >> 2) == (g >> 1));
    const u32x4 x0 = H[0], x1 = H[1];
    unsigned p0 = __builtin_amdgcn_cvt_pk_fp8_f32(bflo(x0.x), bfhi(x0.x), 0, false); p0 = __builtin_amdgcn_cvt_pk_fp8_f32(bflo(x0.y), bfhi(x0.y), p0, true);
    unsigned p1 = __builtin_amdgcn_cvt_pk_fp8_f32(bflo(x0.z), bfhi(x0.z), 0, false); p1 = __builtin_amdgcn_cvt_pk_fp8_f32(bflo(x0.w), bfhi(x0.w), p1, true);
    unsigned p2 = __builtin_amdgcn_cvt_pk_fp8_f32(bflo(x1.x), bfhi(x1.x), 0, false); p2 = __builtin_amdgcn_cvt_pk_fp8_f32(bflo(x1.y), bfhi(x1.y), p2, true);
    unsigned p3 = __builtin_amdgcn_cvt_pk_fp8_f32(bflo(x1.z), bfhi(x1.z), 0, false); p3 = __builtin_amdgcn_cvt_pk_fp8_f32(bflo(x1.w), bfhi(x1.w), p3, true);
    if (!on) { p0 = 0u; p1 = 0u; p2 = 0u; p3 = 0u; }
    bq[0] = (long)(((unsigned long long)p1 << 32) | p0); bq[1] = (long)(((unsigned long long)p3 << 32) | p2);
}
__device__ __forceinline__ void peer_down_mfma(const u32x4 (&R)[16], const long (&bq)[2], __amdgpu_buffer_rsrc_t prsrc, int slice, int tokl, int lane) {
    const int c = lane & 15, g = lane >> 4, cb = c & 3;
    float dv[16];
#pragma unroll
    for (int k = 0; k < 16; ++k) { f32x4 acc = {0.f, 0.f, 0.f, 0.f}; const u32x4 v = R[k];
        acc = __builtin_amdgcn_mfma_f32_16x16x32_fp8_fp8((long)(((unsigned long long)v.y << 32) | v.x), bq[0], acc, 0, 0, 0);
        acc = __builtin_amdgcn_mfma_f32_16x16x32_fp8_fp8((long)(((unsigned long long)v.w << 32) | v.z), bq[1], acc, 0, 0, 0);
        float t = (cb == 0) ? acc.x : (cb == 1) ? acc.y : (cb == 2) ? acc.z : acc.w;
        t += __shfl_xor(t, 1); t += __shfl_xor(t, 2); dv[k] = t; }
    const unsigned off = ((c & 3) == 0 && c < 8) ? (unsigned)(((tokl * 8 + slice) * 128 + 16 * (g + 4 * (c >> 2))) * 4) : 0xFFFFFF00u;
#pragma unroll
    for (int i = 0; i < 4; ++i) { const f32x4 w = {dv[4 * i], dv[4 * i + 1], dv[4 * i + 2], dv[4 * i + 3]}; __builtin_amdgcn_raw_buffer_store_b128(__builtin_bit_cast(u32x4, w), prsrc, off, 16 * i, 0); }
}
__device__ __forceinline__ void peer_down_phase(Frame& F, const PeerDeal& D) {
    const __amdgpu_buffer_rsrc_t PD = __builtin_amdgcn_make_buffer_rsrc((void*)(F.ws + WS_PD), 0, 16384 * 1024, 0x00020000); const bf16* HN = (const bf16*)(F.ws + WS_ACT1);
    const int* IDX = D.IDX;
    const __amdgpu_buffer_rsrc_t prsrc = __builtin_amdgcn_make_buffer_rsrc((void*)D.PART, 0, 256 * 8 * 128 * 4, 0x00020000);
    int lane = F.lane; asm volatile("" : "+v"(lane));
    const int wave = F.wave;
    const int ntok = D.ntok;
    u32x4 RA[16], RB[16], HA[2], HB[2]; int ia0, ia1, ib0, ib1; long bq[2];
#define PEER_TOK(k, sv, tv) int sv; size_t tv; peer_item((k) < ntok ? (k) : ntok - 2 + ((k) & 1), D, wave, sv, tv)
    { PEER_TOK(0, s0, t0); PEER_TOK(1, s1, t1); PEER_TOK(2, s2, t2); PEER_TOK(3, s3, t3);
      const int a0 = IDX[t0 * 128 + lane], a1 = IDX[t0 * 128 + 64 + lane], b0 = IDX[t1 * 128 + lane], b1 = IDX[t1 * 128 + 64 + lane];
      ia0 = IDX[t2 * 128 + lane]; ia1 = IDX[t2 * 128 + 64 + lane]; ib0 = IDX[t3 * 128 + lane]; ib1 = IDX[t3 * 128 + 64 + lane];
      __builtin_amdgcn_sched_barrier(0);
      peer_down_rows(RA, PD, s0, a0, a1, lane); peer_down_hn(HA, HN, s0, t0, lane);
      __builtin_amdgcn_sched_barrier(0);
      peer_down_rows(RB, PD, s1, b0, b1, lane); peer_down_hn(HB, HN, s1, t1, lane);
      __builtin_amdgcn_sched_barrier(0); }
#pragma unroll 1
    for (int n = 0; n < ntok; n += 2) {
        PEER_TOK(n, s0, t0); PEER_TOK(n + 1, s1, t1); PEER_TOK(n + 2, s2, t2); PEER_TOK(n + 3, s3, t3); PEER_TOK(n + 4, s4, t4); PEER_TOK(n + 5, s5, t5);
        peer_down_bq(bq, HA, lane);
        peer_down_mfma(RA, bq, prsrc, s0, (int)(t0 - D.tok0), lane);
        __builtin_amdgcn_sched_barrier(0);
        { const int j0 = IDX[t4 * 128 + lane], j1 = IDX[t4 * 128 + 64 + lane];
          peer_down_rows(RA, PD, s2, ia0, ia1, lane); peer_down_hn(HA, HN, s2, t2, lane); ia0 = j0; ia1 = j1; }
        __builtin_amdgcn_sched_barrier(0);
        peer_down_bq(bq, HB, lane);
        peer_down_mfma(RB, bq, prsrc, s1, (int)(t1 - D.tok0), lane);
        __builtin_amdgcn_sched_barrier(0);
        { const int j0 = IDX[t5 * 128 + lane], j1 = IDX[t5 * 128 + 64 + lane];
          peer_down_rows(RB, PD, s3, ib0, ib1, lane); peer_down_hn(HB, HN, s3, t3, lane); ib0 = j0; ib1 = j1; }
        __builtin_amdgcn_sched_barrier(0);
    }
#undef PEER_TOK
}
__device__ __forceinline__ void peer_coef_wave(Frame& F, const PeerDeal& D) {
    for (int k = F.lane; k < 32 * 32; k += 64) {
        const int tl = (int)(D.tokw - D.tok0) + (k >> 5), slot = 4 * (k & 31);
        const float* pp = D.PART + (size_t)tl * 1024 + slot;
        f32x4 sm = *(const f32x4*)pp;
#pragma unroll
        for (int x = 1; x < 8; ++x) sm += *(const f32x4*)(pp + 128 * x);
        const size_t i = (D.tok0 + tl) * 128 + slot;
        const f32x4 gt = *(const f32x4*)(D.GATE + i);
        const f32x4 o = {gt.x * gelu_erf(sm.x * (1.0f / PD_SCALE)) * (1.0f / PU_SCALE), gt.y * gelu_erf(sm.y * (1.0f / PD_SCALE)) * (1.0f / PU_SCALE),
                         gt.z * gelu_erf(sm.z * (1.0f / PD_SCALE)) * (1.0f / PU_SCALE), gt.w * gelu_erf(sm.w * (1.0f / PD_SCALE)) * (1.0f / PU_SCALE)};
        *(f32x4*)(D.COEF + i) = o;
    }
}
__device__ __forceinline__ void peer_up_rows(u32x4 (&R)[16], __amdgpu_buffer_rsrc_t tab, int slice, int id0, int id1, int lane) {
    const int soff = slice * (16384 * 128);
#pragma unroll
    for (int s8 = 0; s8 < 8; ++s8) { const int id = __shfl(s8 < 4 ? id0 : id1, (16 * s8 + (lane >> 2)) & 63); const int vo = (id << 7) + 16 * (lane & 3);
        R[2 * s8] = __builtin_amdgcn_raw_buffer_load_b128(tab, vo, soff, 0); R[2 * s8 + 1] = __builtin_amdgcn_raw_buffer_load_b128(tab, vo, soff + 64, 0); }
}
__device__ __forceinline__ void peer_up_compute(const u32x4 (&R)[16], float c0, float c1, f32x2 h, float* out, int slice, size_t tok, int lane) {
    f32x2 acc[16];
#pragma unroll
    for (int k = 0; k < 16; ++k) acc[k] = (f32x2){0.f, 0.f};
#pragma unroll
    for (int s8 = 0; s8 < 8; ++s8) { const float c = __shfl(s8 < 4 ? c0 : c1, (16 * s8 + (lane >> 2)) & 63); f32x2 c2 = {c, c}; asm volatile("" : "+v"(c2));
#pragma unroll
        for (int hf = 0; hf < 2; ++hf) { const u32x4 r = R[2 * s8 + hf];
            acc[8 * hf + 0] = c2 * __builtin_amdgcn_cvt_pk_f32_fp8(r.x, false) + acc[8 * hf + 0]; acc[8 * hf + 1] = c2 * __builtin_amdgcn_cvt_pk_f32_fp8(r.x, true) + acc[8 * hf + 1];
            acc[8 * hf + 2] = c2 * __builtin_amdgcn_cvt_pk_f32_fp8(r.y, false) + acc[8 * hf + 2]; acc[8 * hf + 3] = c2 * __builtin_amdgcn_cvt_pk_f32_fp8(r.y, true) + acc[8 * hf + 3];
            acc[8 * hf + 4] = c2 * __builtin_amdgcn_cvt_pk_f32_fp8(r.z, false) + acc[8 * hf + 4]; acc[8 * hf + 5] = c2 * __builtin_amdgcn_cvt_pk_f32_fp8(r.z, true) + acc[8 * hf + 5];
            acc[8 * hf + 6] = c2 * __builtin_amdgcn_cvt_pk_f32_fp8(r.w, false) + acc[8 * hf + 6]; acc[8 * hf + 7] = c2 * __builtin_amdgcn_cvt_pk_f32_fp8(r.w, true) + acc[8 * hf + 7]; } }
    f32x2 r8[8], r4[4], r2[2], r1;
    { const bool up = (lane & 32) != 0;
#pragma unroll
      for (int k = 0; k < 8; ++k) { const f32x2 keep = up ? acc[k + 8] : acc[k], send = up ? acc[k] : acc[k + 8]; r8[k] = keep + (f32x2){__shfl_xor(send.x, 32), __shfl_xor(send.y, 32)}; } }
    { const bool up = (lane & 16) != 0;
#pragma unroll
      for (int k = 0; k < 4; ++k) { const f32x2 keep = up ? r8[k + 4] : r8[k], send = up ? r8[k] : r8[k + 4]; r4[k] = keep + (f32x2){__shfl_xor(send.x, 16), __shfl_xor(send.y, 16)}; } }
    { const bool up = (lane & 8) != 0;
#pragma unroll
      for (int k = 0; k < 2; ++k) { const f32x2 keep = up ? r4[k + 2] : r4[k], send = up ? r4[k] : r4[k + 2]; r2[k] = keep + (f32x2){__shfl_xor(send.x, 8), __shfl_xor(send.y, 8)}; } }
    { const bool up = (lane & 4) != 0; const f32x2 keep = up ? r2[1] : r2[0], send = up ? r2[0] : r2[1]; r1 = keep + (f32x2){__shfl_xor(send.x, 4), __shfl_xor(send.y, 4)}; }
    const int p = ((lane >> 5) & 1) * 8 + ((lane >> 4) & 1) * 4 + ((lane >> 3) & 1) * 2 + ((lane >> 2) & 1);
    *(f32x2*)(out + tok * DM + slice * 128 + 16 * (lane & 3) + 2 * (p & 7) + 64 * (p >> 3)) = h + r1;
}
__device__ __forceinline__ void peer_up_phase(Frame& F, const PeerDeal& D, float* outp) {
    const __amdgpu_buffer_rsrc_t PU = __builtin_amdgcn_make_buffer_rsrc((void*)(F.ws + WS_PU), 0, 16384 * 1024, 0x00020000);
    const int* IDX = D.IDX; const float* COEF = D.COEF;
    int lane = F.lane; asm volatile("" : "+v"(lane));
    const int wave = F.wave;
    const int ntok = D.ntok;
    const int p = ((lane >> 5) & 1) * 8 + ((lane >> 4) & 1) * 4 + ((lane >> 3) & 1) * 2 + ((lane >> 2) & 1);
    const int hoff = 16 * (lane & 3) + 2 * (p & 7) + 64 * (p >> 3);
    int sl; size_t tk;
    u32x4 R0[16], R1[16];
    float ca0, ca1, cb0, cb1; f32x2 ha, hb;
    int id0, id1, jd0, jd1;
    { int s1_; size_t t1_; peer_item(0, D, wave, sl, tk); peer_item(1, D, wave, s1_, t1_);
      jd0 = IDX[tk * 128 + lane]; jd1 = IDX[tk * 128 + 64 + lane]; id0 = IDX[t1_ * 128 + lane]; id1 = IDX[t1_ * 128 + 64 + lane];
      __builtin_amdgcn_sched_barrier(0);
      peer_up_rows(R0, PU, sl, jd0, jd1, lane);
      ca0 = COEF[tk * 128 + lane]; ca1 = COEF[tk * 128 + 64 + lane]; ha = *(const f32x2*)(F.out + tk * DM + sl * 128 + hoff);
      __builtin_amdgcn_sched_barrier(0); }
#pragma unroll 1
    for (int n = 0; n < ntok; n += 2) {
        int s0, s1, s2, s3; size_t t0, t1, t2, t3;
        peer_item(n, D, wave, s0, t0); peer_item(n + 1, D, wave, s1, t1);
        peer_item(n + 2 < ntok ? n + 2 : n, D, wave, s2, t2); peer_item(n + 3 < ntok ? n + 3 : n + 1, D, wave, s3, t3);
        jd0 = IDX[t2 * 128 + lane]; jd1 = IDX[t2 * 128 + 64 + lane];
        peer_up_rows(R1, PU, s1, id0, id1, lane);
        cb0 = COEF[t1 * 128 + lane]; cb1 = COEF[t1 * 128 + 64 + lane]; hb = *(const f32x2*)(F.out + t1 * DM + s1 * 128 + hoff);
        __builtin_amdgcn_sched_barrier(0);
        peer_up_compute(R0, ca0, ca1, ha, outp, s0, t0, lane);
        __builtin_amdgcn_sched_barrier(0);
        id0 = IDX[t3 * 128 + lane]; id1 = IDX[t3 * 128 + 64 + lane];
        peer_up_rows(R0, PU, s2, jd0, jd1, lane);
        ca0 = COEF[t2 * 128 + lane]; ca1 = COEF[t2 * 128 + 64 + lane]; ha = *(const f32x2*)(F.out + t2 * DM + s2 * 128 + hoff);
        __builtin_amdgcn_sched_barrier(0);
        peer_up_compute(R1, cb0, cb1, hb, outp, s1, t1, lane);
        __builtin_amdgcn_sched_barrier(0);
    }
}
__device__ __forceinline__ void peer_tile(Frame& F, int tile) {
    const size_t tok0 = (size_t)tile * 256;
    const bf16* Q = (const bf16*)(F.ws + WS_BIG);
    int* IDX = (int*)(F.ws + WS_BIG + 256 * MiB); float* GATE = (float*)(F.ws + WS_BIG + 288 * MiB); float* COEF = (float*)(F.ws + WS_BIG + 320 * MiB);
    peer_topk_tile(F, tok0, Q, IDX, GATE);
    VM_WAIT(); __syncthreads();
    PeerDeal D; D.tokw = tok0 + F.wave * 32; D.ntok = 256; D.tok0 = tok0; D.PART = (float*)(F.ws + WS_BIG + tok0 * (PEER_Q * 2)); D.IDX = IDX; D.GATE = GATE; D.COEF = COEF;
    peer_down_phase(F, D);
    VM_WAIT(); __syncthreads();
    peer_coef_wave(F, D);
    VM_WAIT(); __syncthreads();
    peer_up_phase(F, D, F.out);
}
__device__ __forceinline__ void peer_phase(Frame& F) { for (int tile = F.bid; tile < T / 256; tile += F.G) { peer_tile(F, tile); VM_WAIT(); __syncthreads(); } }

constexpr int N_PHASES = 15;
__global__ void __launch_bounds__(NTHR, 2) mega_fwd(Args args) {
    extern __shared__ __attribute__((aligned(16))) unsigned char lds_raw[];
    Frame F;
    F.lds = (LAS unsigned char*)lds_raw;
    F.tid = threadIdx.x; F.lane = F.tid & 63; F.wave = __builtin_amdgcn_readfirstlane(F.tid >> 6);
    F.G = gridDim.x; F.bid = blockIdx.x;
    F.in = args.in;
    F.positions = args.positions; F.out = args.out; F.ws = args.ws;
    unsigned char* ws = args.ws;
    volatile LAS unsigned* ctlw = (volatile LAS unsigned*)(F.lds + LDSCTL_OFF);
    if (F.tid < 64) ctlw[F.tid] = 0u;
    __syncthreads();
    const int lo = args.ph_lo, hi = args.ph_hi;
    XcdBarrier bar; bar.bar = (unsigned*)(ws + WS_CTL); bar.x = 0; bar.st = nullptr; bar.wave = F.wave;
    if (hi - lo > 1) bar = xcd_barrier_post((unsigned*)(ws + WS_CTL), ctlw + 8, F.wave);
#define IN(k) (lo <= (k) && (k) < hi)
#define SEAM(k) do { if (IN(k) && IN((k) + 1)) xcd_barrier(bar); } while (0)
    bf16* ACT1 = (bf16*)(ws + WS_ACT1); bf16* BIG = (bf16*)(ws + WS_BIG); bf16* WallT = (bf16*)(ws + WS_WALLT);

    if (IN(0)) { frame_refresh(F); p0_prologue(F); __syncthreads(); if (PROBE & 1) { p0_prologue(F); __syncthreads(); } }
    SEAM(0);
    if (IN(1)) { frame_refresh(F); { {
        { pg8::Gemm g{(const bf16*)(ws + WS_MEMN), (const bf16*)(ws + WS_WMKVT), NB * NMEM, 768, DM, DM, DM}; pg8::StaticOrder S; S.init(g.M, g.N, F.G, F.bid);
          pg8::EpiBf16<0> E{(bf16*)(ws + WS_MKV), 1536}; pg8::gemm_phase(F.lds, g, S, E, F.wave); }
        { pg8::Gemm g{(const bf16*)(ws + WS_WMKVT) + (size_t)768 * DM, (const bf16*)(ws + WS_MEMN), 768, NB * NMEM, DM, DM, DM}; pg8::StaticOrder S; S.init(g.M, g.N, F.G, F.G - 1 - F.bid);
          pg8::EpiBf16<0> E{(bf16*)(ws + WS_MVT), NB * NMEM}; pg8::gemm_phase(F.lds, g, S, E, F.wave); }
        { pg8::Gemm g{ACT1, WallT, HT, NPROJ, DM, DM, DM}; pg8::StaticOrder S; S.init(g.M, g.N, F.G, F.bid);
          pg8::EpiBf16<0> E{BIG, NPROJ}; pg8::gemm_phase(F.lds, g, S, E, F.wave); }
    } }
      if (PROBE & 2) { {
        { pg8::Gemm g{(const bf16*)(ws + WS_MEMN), (const bf16*)(ws + WS_WMKVT), NB * NMEM, 768, DM, DM, DM}; pg8::StaticOrder S; S.init(g.M, g.N, F.G, F.bid);
          pg8::EpiBf16<0> E{(bf16*)(ws + WS_MKV), 1536}; pg8::gemm_phase(F.lds, g, S, E, F.wave); }
        { pg8::Gemm g{(const bf16*)(ws + WS_WMKVT) + (size_t)768 * DM, (const bf16*)(ws + WS_MEMN), 768, NB * NMEM, DM, DM, DM}; pg8::StaticOrder S; S.init(g.M, g.N, F.G, F.G - 1 - F.bid);
          pg8::EpiBf16<0> E{(bf16*)(ws + WS_MVT), NB * NMEM}; pg8::gemm_phase(F.lds, g, S, E, F.wave); }
        { pg8::Gemm g{ACT1, WallT, HT, NPROJ, DM, DM, DM}; pg8::StaticOrder S; S.init(g.M, g.N, F.G, F.bid);
          pg8::EpiBf16<0> E{BIG, NPROJ}; pg8::gemm_phase(F.lds, g, S, E, F.wave); }
    } } }
    SEAM(1);
    if (IN(2)) { frame_refresh(F); qkprep_phase(F, 0); ssdC_phase(F, 0); if (PROBE & 4) ssdC_phase(F, 0); }
    SEAM(2);
    if (IN(3)) { frame_refresh(F); ssdD_phase(F); dilattn_mfma_phase(F, 0); memattn_mfma_phase(F, 0); if (PROBE & 64) { ssdD_phase(F); memattn_mfma_phase(F, 0); } }
    SEAM(3);
    if (IN(4)) { frame_refresh(F); ssdE_phase(F, 0); dilmerge_phase(F, 0); if (PROBE & 32) { ssdE_phase(F, 0); dilmerge_phase(F, 0); } }
    SEAM(4);
    if (IN(5)) { frame_refresh(F); { { pg8::Gemm g{ACT1 + (size_t)HT * DM, WallT, HT, NPROJ, DM, DM, DM}; pg8::StaticOrder S; S.init(g.M, g.N, F.G, F.bid);
        pg8::EpiBf16<0> E{BIG, NPROJ}; pg8::gemm_phase(F.lds, g, S, E, F.wave); } }
      if (PROBE & 2) { { pg8::Gemm g{ACT1 + (size_t)HT * DM, WallT, HT, NPROJ, DM, DM, DM}; pg8::StaticOrder S; S.init(g.M, g.N, F.G, F.bid);
        pg8::EpiBf16<0> E{BIG, NPROJ}; pg8::gemm_phase(F.lds, g, S, E, F.wave); } } }
    SEAM(5);
    if (IN(6)) { frame_refresh(F); qkprep_phase(F, 1); ssdC_phase(F, 1); if (PROBE & 4) ssdC_phase(F, 1); }
    SEAM(6);
    if (IN(7)) { frame_refresh(F); ssdD_phase(F); dilattn_mfma_phase(F, 1); memattn_mfma_phase(F, 1); if (PROBE & 64) { ssdD_phase(F); memattn_mfma_phase(F, 1); } }
    SEAM(7);
    if (IN(8)) { frame_refresh(F); ssdE_phase(F, 1); dilmerge_phase(F, 1); if (PROBE & 32) { ssdE_phase(F, 1); dilmerge_phase(F, 1); } }
    SEAM(8);
    if (IN(9)) { frame_refresh(F); { { pg8::Gemm g{ACT1, WallT + (size_t)NPROJ * DM, T, NGATE, DM, DM, DM}; pg8::StaticOrder S; S.init(g.M, g.N, F.G, F.bid);
        pg8::EpiBf16<1> E{BIG, NGATE}; pg8::gemm_phase(F.lds, g, S, E, F.wave); } }
      if (PROBE & 2) { { pg8::Gemm g{ACT1, WallT + (size_t)NPROJ * DM, T, NGATE, DM, DM, DM}; pg8::StaticOrder S; S.init(g.M, g.N, F.G, F.bid);
        pg8::EpiBf16<1> E{BIG, NGATE}; pg8::gemm_phase(F.lds, g, S, E, F.wave); } } }
    SEAM(9);
    if (IN(10)) { frame_refresh(F);
        pg8::Gemm g{(const bf16*)F.out, (const bf16*)(ws + WS_WCATT), T, DM, YC, YC, YC}; pg8::StaticOrder S; S.init(g.M, g.N, F.G, F.bid);
        pg8::EpiBranchFused E{ACT1, DM, __builtin_amdgcn_make_buffer_rsrc((void*)BIG, 0, T * NGATE * 2, 0x00020000), NGATE}; pg8::gemm_phase(F.lds, g, S, E, F.wave);
    }
    SEAM(10);
    if (IN(11)) { frame_refresh(F); { { pg8::Gemm g{ACT1, (const bf16*)(ws + WS_WOUTT), T, DM, DM, DM, DM}; pg8::StaticOrder S; S.init(g.M, g.N, F.G, F.bid);
        pg8::EpiResid E{F.out, DM, F.in[I_X]}; pg8::gemm_phase(F.lds, g, S, E, F.wave); } }
      if (PROBE & 2) { { pg8::Gemm g{ACT1, (const bf16*)(ws + WS_WOUTT), T, DM, DM, DM, DM}; pg8::StaticOrder S; S.init(g.M, g.N, F.G, F.bid);
        pg8::EpiResid E{F.out, DM, F.in[I_X]}; pg8::gemm_phase(F.lds, g, S, E, F.wave); } } }
    SEAM(11);
    if (IN(12)) { frame_refresh(F); { hn_phase(F); }
      if (PROBE & 2) { hn_phase(F); } }
    SEAM(12);
    if (IN(13)) { frame_refresh(F); { { pg8::Gemm g{ACT1, (const bf16*)(ws + WS_WQT), T, PEER_Q, DM, DM, DM}; pg8::StaticOrder S; S.init(g.M, g.N, F.G, F.bid);
        pg8::EpiBf16<0> E{BIG, PEER_Q}; pg8::gemm_phase(F.lds, g, S, E, F.wave); } }
      if (PROBE & 2) { { pg8::Gemm g{ACT1, (const bf16*)(ws + WS_WQT), T, PEER_Q, DM, DM, DM}; pg8::StaticOrder S; S.init(g.M, g.N, F.G, F.bid);
        pg8::EpiBf16<0> E{BIG, PEER_Q}; pg8::gemm_phase(F.lds, g, S, E, F.wave); } } }
    SEAM(13);
    if (IN(14)) { frame_refresh(F); peer_phase(F); }
#undef IN
#undef SEAM
}

extern "C" void kernel_launch(void* const* d_in, const int* in_sizes, int n_in, void* d_out, int out_size, void* d_ws, size_t ws_size, hipStream_t stream) {
    static int grid = 0;
    if (grid == 0) {
        if (n_in != 26 || out_size != T * DM || ws_size < WS_END) { fprintf(stderr, "kernel_launch: unexpected shapes (n_in %d, out %d, ws %zu)\n", n_in, out_size, ws_size); grid = -1; return; }
        int dev = 0, cus = 0;
        if (hipGetDevice(&dev) != hipSuccess || hipDeviceGetAttribute(&cus, hipDeviceAttributeMultiprocessorCount, dev) != hipSuccess) { grid = -1; return; }
        if (hipFuncSetAttribute((const void*)mega_fwd, hipFuncAttributeMaxDynamicSharedMemorySize, LDS_BYTES) != hipSuccess) { grid = -1; return; }
        int per_cu = 0;
        (void)hipOccupancyMaxActiveBlocksPerMultiprocessor(&per_cu, (const void*)mega_fwd, NTHR, LDS_BYTES);
        (void)hipGetLastError();
        grid = cus;
    }
    if (grid < 0) return;
    (void)hipMemsetAsync((char*)d_ws + WS_CTL, 0, CTL_ZERO_BYTES, stream);
    Args a{};
    for (int i = 0; i < 26; ++i) a.in[i] = (const float*)d_in[i];
    a.positions = (const int*)d_in[2]; a.out = (float*)d_out; a.ws = (unsigned char*)d_ws;
#if MK_N_LAUNCHES == 1
    a.ph_lo = 0; a.ph_hi = N_PHASES;
    hipLaunchKernelGGL(mega_fwd, dim3(grid), dim3(NTHR), LDS_BYTES, stream, a);
#else
    for (int p = 0; p < N_PHASES; ++p) { a.ph_lo = p; a.ph_hi = p + 1; hipLaunchKernelGGL(mega_fwd, dim3(grid), dim3(NTHR), LDS_BYTES, stream, a); }
#endif
}
```

```cpp
#include <hip/hip_runtime.h>
#include <cstdio>
#include <cstdint>

#ifndef MK_N_LAUNCHES
#define MK_N_LAUNCHES 1
#endif

#define LAS __attribute__((address_space(3)))
#define GAS __attribute__((address_space(1)))
typedef unsigned short bf16;
typedef short bf16x8 __attribute__((ext_vector_type(8)));
typedef float f32x4 __attribute__((ext_vector_type(4)));
typedef float f32x2 __attribute__((ext_vector_type(2)));
typedef unsigned u32x4 __attribute__((ext_vector_type(4)));
typedef unsigned u32x2 __attribute__((ext_vector_type(2)));

constexpr int NB = 8, SEQ = 8192, DM = 1024, T = NB * SEQ;
constexpr int HB = 4, HT = HB * SEQ;
constexpr int NMEM = 256;
constexpr int NPROJ = 6144;
constexpr int PC_Z = 0, PC_X = 1024, PC_B = 2048, PC_C = 2560, PC_DQ = 3072, PC_DK = 3840, PC_DV = 4608, PC_MQ = 5376;
constexpr int W_IN_N = 9232, OFF_DT = 3072, OFF_AFTER_DT = 3088;
constexpr int NGATE = 3072;
constexpr int YC = 2048;
constexpr int PEER_H = 8, PEER_K = 16, PEER_NK = 128, PEER_Q = 2048;
constexpr float EPS = 1e-6f;

constexpr size_t MiB = 1u << 20;
constexpr size_t WS_CTL = 0, CTL_ZERO_BYTES = 65536;
constexpr size_t WS_WALLT = 1 * MiB;
constexpr size_t WS_WMKVT = 19 * MiB;
constexpr size_t WS_WCATT = 22 * MiB;
constexpr size_t WS_WOUTT = 26 * MiB;
constexpr size_t WS_WQT = 28 * MiB;
constexpr size_t WS_SUBK = 32 * MiB;
constexpr size_t WS_PD = 33 * MiB;
constexpr size_t WS_PU = 65 * MiB;
constexpr size_t WS_DT = 97 * MiB;
constexpr size_t WS_MEMN = 101 * MiB;
constexpr size_t WS_MKV = 105 * MiB;
constexpr size_t WS_ACT1 = 112 * MiB;
constexpr size_t WS_BIG = 240 * MiB;
constexpr size_t WS_LSE = 624 * MiB;
constexpr size_t WS_MVT = 628 * MiB;
constexpr size_t WS_DEC = 631 * MiB;
constexpr size_t WS_SST = 632 * MiB;
constexpr size_t WS_SIN = 760 * MiB;
constexpr size_t WS_END = 824 * MiB;

constexpr int RING_BYTES = 131072;
constexpr int LDSCTL_OFF = 143360;
constexpr int LDS_BYTES = 147456;
constexpr int NWAVES = 8, NTHR = 512;

__device__ __forceinline__ int lane_id() { return (int)__builtin_amdgcn_mbcnt_hi(~0u, __builtin_amdgcn_mbcnt_lo(~0u, 0u)); }
__device__ __forceinline__ float bf2f(unsigned short b) { return __builtin_bit_cast(float, (unsigned)b << 16); }
__device__ __forceinline__ float bflo(unsigned w) { return __builtin_bit_cast(float, w << 16); }
__device__ __forceinline__ float bfhi(unsigned w) { return __builtin_bit_cast(float, w & 0xffff0000u); }
__device__ __forceinline__ unsigned f2bf(float f) { unsigned u = __builtin_bit_cast(unsigned, f); return (u + 0x7fffu + ((u >> 16) & 1u)) >> 16; }
__device__ __forceinline__ unsigned pk2(float lo, float hi) { return f2bf(lo) | (f2bf(hi) << 16); }
typedef float f32x16 __attribute__((ext_vector_type(16)));
typedef short s16x4 __attribute__((ext_vector_type(4)));
typedef __bf16 bf2_t __attribute__((ext_vector_type(2)));
__device__ __forceinline__ unsigned pkbf(float a, float b) { const f32x2 v = {a, b}; return __builtin_bit_cast(unsigned, __builtin_convertvector(v, bf2_t)); }
#define MFMA32(a, b, c) __builtin_amdgcn_mfma_f32_32x32x16_bf16((a), (b), (c), 0, 0, 0)
__device__ __forceinline__ float wave_sum(float v) {
#pragma unroll
    for (int o = 1; o < 64; o <<= 1) v += __shfl_xor(v, o);
    return v;
}
__device__ __forceinline__ float wave_max(float v) {
#pragma unroll
    for (int o = 1; o < 64; o <<= 1) v = fmaxf(v, __shfl_xor(v, o));
    return v;
}
__device__ __forceinline__ float sigmoidf_(float x) { return 1.0f / (1.0f + __expf(-x)); }
#define LDS_WAIT() asm volatile("s_waitcnt lgkmcnt(0)" ::: "memory")
#define VM_WAIT() asm volatile("s_waitcnt vmcnt(0)" ::: "memory")

#define XB_TMO      128
#define XB_XCNT(j)  (256  + 64 * (j))
#define XB_XSUB(j)  (1280 + 64 * (j))
#define XB_XGEN(j)  (2304 + 64 * (j))
#define XB_TOP      3328
#define XB_TOPGEN   3392
#define XCD_BAR_WORDS 3456
#define XB_SPIN_CAP (1u << 18)
__device__ __forceinline__ unsigned xb_ld(unsigned* p)              { return __hip_atomic_load(p, __ATOMIC_RELAXED, __HIP_MEMORY_SCOPE_AGENT); }
__device__ __forceinline__ unsigned xb_add(unsigned* p, unsigned v) { return __hip_atomic_fetch_add(p, v, __ATOMIC_RELAXED, __HIP_MEMORY_SCOPE_AGENT); }
__device__ __forceinline__ unsigned xb_xcc_id() { return (unsigned)__builtin_amdgcn_s_getreg((3 << 11) | 20) & 0xFu; }
#define XB_SPIN(cond, bar) do { unsigned _sp = 0; while (cond) { __builtin_amdgcn_s_sleep(1); \
    if ((++_sp & 255u) == 0u) { if (xb_ld(&(bar)[XB_TMO])) break; if (_sp > XB_SPIN_CAP) { atomicAdd(&(bar)[XB_TMO], 1u); break; } } } } while (0)
struct XcdBarrier { unsigned* bar; unsigned x; volatile LAS unsigned* st; int wave; };
__device__ __forceinline__ XcdBarrier xcd_barrier_post(unsigned* bar, volatile LAS unsigned* st, int wave) {
    XcdBarrier b; b.bar = bar; b.x = xb_xcc_id(); b.st = st; b.wave = wave;
    if (wave == 0 && lane_id() == 0) (void)xb_add(&bar[XB_XCNT(b.x)], 1u);
    return b;
}
__device__ __forceinline__ void xcd_barrier_complete(unsigned* bar, unsigned x, unsigned& nloc, unsigned& nx) {
    const unsigned G = gridDim.x * gridDim.y * gridDim.z;
    unsigned sum, cnt, mine, sp = 0u;
    for (;;) {
        sum = 0u; cnt = 0u; mine = 0u;
#pragma unroll
        for (unsigned j = 0; j < 16; ++j) { const unsigned c = xb_ld(&bar[XB_XCNT(j)]); sum += c; cnt += (c > 0u) ? 1u : 0u; mine = (j == x) ? c : mine; }
        if (sum == G) break;
        __builtin_amdgcn_s_sleep(1);
        if ((++sp & 255u) == 0u) { if (xb_ld(&bar[XB_TMO])) break; if (sp > XB_SPIN_CAP) { atomicAdd(&bar[XB_TMO], 1u); break; } }
    }
    nloc = mine > 0u ? mine : 1u; nx = cnt > 0u ? cnt : 1u;
}
__device__ __forceinline__ void xcd_barrier(const XcdBarrier& b) {
    asm volatile("s_waitcnt vmcnt(0)" ::: "memory");
    __syncthreads();
    if (b.wave == 0 && lane_id() == 0) {
        unsigned* bar = b.bar;
        __builtin_amdgcn_s_waitcnt(0);
        unsigned nloc = b.st[0], nx = b.st[1];
        if (nloc == 0u) { xcd_barrier_complete(bar, b.x, nloc, nx); b.st[0] = nloc; b.st[1] = nx; }
        const unsigned old = xb_add(&bar[XB_XSUB(b.x)], 1u);
        const unsigned gen = old / nloc;
        if (old + 1u == (gen + 1u) * nloc) {
            __builtin_amdgcn_fence(__ATOMIC_RELEASE, "agent");
            asm volatile("s_waitcnt vmcnt(0)" ::: "memory");
            const unsigned og = xb_add(&bar[XB_TOP], 1u);
            const unsigned tg = og / nx;
            if (og + 1u == (tg + 1u) * nx) xb_add(&bar[XB_TOPGEN], 1u);
            else XB_SPIN(xb_ld(&bar[XB_TOPGEN]) == tg, bar);
            __builtin_amdgcn_fence(__ATOMIC_ACQUIRE, "agent");
            xb_add(&bar[XB_XGEN(b.x)], 1u);
            asm volatile("s_waitcnt vmcnt(0)" ::: "memory");
        } else {
            XB_SPIN(xb_ld(&bar[XB_XGEN(b.x)]) == gen, bar);
            __builtin_amdgcn_fence(__ATOMIC_ACQUIRE, "agent");
            asm volatile("s_waitcnt vmcnt(0)" ::: "memory");
        }
    }
    __syncthreads();
}

namespace pg8 {
constexpr int BM = 256, BK = 64, HALF = 128, HTB = HALF * BK * 2, STAGE_BYTES = 8 * HTB, NXCD = 8, WGM = 8;
__host__ __device__ __forceinline__ int lds_byte(int r, int c) { const int st = (r >> 4) * 2 + (c >> 5), rr = r & 15, cc = c & 31, ob = rr * 64 + cc * 2; return st * 1024 + (ob ^ (((ob >> 9) & 1) << 5)); }
__host__ __device__ __forceinline__ void stage_rc(int b, int& R, int& C) { const int st = b / 1024, sb = b % 1024, swz = sb ^ (((sb >> 9) & 1) << 5); R = (st >> 1) * 16 + swz / 64; C = (st & 1) * 32 + (swz % 64) / 2; }
__host__ __device__ __forceinline__ int perm32(int rho) { const int n = rho >> 4, i = rho & 15; return 8 * (i >> 2) + 4 * n + (i & 3); }
struct Unit { int pm, pn; };
struct Gemm { const bf16* A; const bf16* Bt; int M, N, K, lda, ldb; };
struct StaticOrder {
    int nM, nN, nwg, G, c;
    __host__ __device__ void init(int M, int N, int G_, int c_) { nM = M / BM; nN = N / BM; nwg = nM * nN; G = G_; c = c_; }
    __host__ __device__ bool next(int i, Unit& u) const {
        const long L = (long)i * G + c; if (L >= nwg) return false;
        int wgid = (int)L; { const int q = nwg / NXCD, r = nwg % NXCD, xcd = wgid % NXCD, off = wgid / NXCD; wgid = (xcd < r ? xcd * (q + 1) : r * (q + 1) + (xcd - r) * q) + off; }
        const int nig = WGM * nN, gid = wgid / nig, fm = gid * WGM, gsz = (nM - fm) < WGM ? (nM - fm) : WGM;
        u.pm = fm + ((wgid % nig) % gsz); u.pn = (wgid % nig) / gsz; return true;
    }
    __device__ __forceinline__ void a_ready(const Unit&) const {}
    __device__ __forceinline__ void done(const Unit&) const {}
};
__device__ __forceinline__ unsigned cvt_pk_bf16(float lo, float hi) { unsigned r; asm volatile("v_cvt_pk_bf16_f32 %0, %1, %2" : "=v"(r) : "v"(lo), "v"(hi)); return r; }

template <int ACT> struct EpiBf16 {
    static constexpr bool PERM = true, AFTER_DRAIN = false, HAS_MID = false;
    bf16* O; int ldc;
    __device__ __forceinline__ void operator()(const f32x4 (&acc)[2][2][4][2], const Unit& u, int wr, int wc, int fr, int fq) const {
        const int row0 = u.pm * BM + wr * 64 + fr; const int col0 = u.pn * BM + wc * 32 + 8 * fq;
#pragma unroll
        for (int ai = 0; ai < 2; ++ai)
#pragma unroll
            for (int m = 0; m < 4; ++m) { bf16* rowp = O + (size_t)(row0 + ai * HALF + m * 16) * ldc + col0;
#pragma unroll
                for (int bj = 0; bj < 2; ++bj) { f32x4 v0 = acc[ai][bj][m][0], v1 = acc[ai][bj][m][1];
                    if (ACT == 1) {
#pragma unroll
                        for (int j = 0; j < 4; ++j) { v0[j] = sigmoidf_(v0[j]); v1[j] = sigmoidf_(v1[j]); } }
                    u32x4 w; w.x = cvt_pk_bf16(v0[0], v0[1]); w.y = cvt_pk_bf16(v0[2], v0[3]); w.z = cvt_pk_bf16(v1[0], v1[1]); w.w = cvt_pk_bf16(v1[2], v1[3]);
                    *(u32x4*)(rowp + bj * HALF) = w; } }
    }
};
struct EpiResid {
    static constexpr bool PERM = false, AFTER_DRAIN = false, HAS_MID = false;
    float* C; int ldc; const float* R;
    __device__ __forceinline__ void operator()(const f32x4 (&acc)[2][2][4][2], const Unit& u, int wr, int wc, int fr, int fq) const {
        const int row0 = u.pm * BM + wr * 64 + fr, col0 = u.pn * BM + wc * 32 + 4 * fq;
#pragma unroll
        for (int ai = 0; ai < 2; ++ai)
#pragma unroll
            for (int m = 0; m < 4; ++m) { const size_t off = (size_t)(row0 + ai * HALF + m * 16) * ldc + col0;
#pragma unroll
                for (int bj = 0; bj < 2; ++bj)
#pragma unroll
                    for (int n = 0; n < 2; ++n) { const f32x4 r = *(const f32x4*)(R + off + bj * HALF + n * 16); *(f32x4*)(C + off + bj * HALF + n * 16) = acc[ai][bj][m][n] + r; } }
    }
};

struct EpiBranchFused {
    static constexpr bool PERM = true, AFTER_DRAIN = false, HAS_MID = true;
    bf16* O; int ldc; __amdgpu_buffer_rsrc_t grs; int ldg;
    __device__ __forceinline__ void mid(f32x4 (&acc)[2][2][4][2], const Unit& u, int t, int wr, int wc, int fr, int fq) const {
        const unsigned voff = (unsigned)(((u.pm * BM + wr * 64 + fr) * ldg + u.pn * BM + wc * 32 + 8 * fq) * 2);
        const int ca = (t == 16) ? 0 : 2048;
#pragma unroll
        for (int ai = 0; ai < 2; ++ai)
#pragma unroll
            for (int m = 0; m < 4; ++m) {
#pragma unroll
                for (int bj = 0; bj < 2; ++bj) { const int so = ((ai * HALF + m * 16) * ldg + bj * HALF) * 2 + ca;
                    const u32x4 ga = __builtin_amdgcn_raw_buffer_load_b128(grs, voff, so, 0), gb = __builtin_amdgcn_raw_buffer_load_b128(grs, voff, so + 2048, 0);
                    f32x4& v0 = acc[ai][bj][m][0]; f32x4& v1 = acc[ai][bj][m][1];
                    v0[0] *= bflo(ga.x) * __builtin_amdgcn_rcpf(fmaxf(bflo(gb.x), 1e-30f)); v0[1] *= bfhi(ga.x) * __builtin_amdgcn_rcpf(fmaxf(bfhi(gb.x), 1e-30f));
                    v0[2] *= bflo(ga.y) * __builtin_amdgcn_rcpf(fmaxf(bflo(gb.y), 1e-30f)); v0[3] *= bfhi(ga.y) * __builtin_amdgcn_rcpf(fmaxf(bfhi(gb.y), 1e-30f));
                    v1[0] *= bflo(ga.z) * __builtin_amdgcn_rcpf(fmaxf(bflo(gb.z), 1e-30f)); v1[1] *= bfhi(ga.z) * __builtin_amdgcn_rcpf(fmaxf(bfhi(gb.z), 1e-30f));
                    v1[2] *= bflo(ga.w) * __builtin_amdgcn_rcpf(fmaxf(bflo(gb.w), 1e-30f)); v1[3] *= bfhi(ga.w) * __builtin_amdgcn_rcpf(fmaxf(bfhi(gb.w), 1e-30f)); }
                __builtin_amdgcn_sched_barrier(0); }
    }
    __device__ __forceinline__ void operator()(const f32x4 (&acc)[2][2][4][2], const Unit& u, int wr, int wc, int fr, int fq) const {
        const int row0 = u.pm * BM + wr * 64 + fr; const int col0 = u.pn * BM + wc * 32 + 8 * fq;
        const unsigned voff = (unsigned)((row0 * ldg + col0) * 2);
#pragma unroll
        for (int ai = 0; ai < 2; ++ai)
#pragma unroll
            for (int m = 0; m < 4; ++m) { const size_t r = (size_t)(row0 + ai * HALF + m * 16); bf16* rowp = O + r * ldc + col0;
#pragma unroll
                for (int bj = 0; bj < 2; ++bj) { const f32x4 v0 = acc[ai][bj][m][0], v1 = acc[ai][bj][m][1];
                    const u32x4 g = __builtin_amdgcn_raw_buffer_load_b128(grs, voff, ((ai * HALF + m * 16) * ldg + bj * HALF) * 2 + 4096, 0);
                    u32x4 w; w.x = cvt_pk_bf16(v0[0] * bflo(g.x), v0[1] * bfhi(g.x)); w.y = cvt_pk_bf16(v0[2] * bflo(g.y), v0[3] * bfhi(g.y));
                    w.z = cvt_pk_bf16(v1[0] * bflo(g.z), v1[1] * bfhi(g.z)); w.w = cvt_pk_bf16(v1[2] * bflo(g.w), v1[3] * bfhi(g.w));
                    *(u32x4*)(rowp + bj * HALF) = w; } }
    }
};

template <class Epi, class Sched>
__device__ __forceinline__ void gemm_phase(LAS unsigned char* lds, const Gemm g, const Sched& S, const Epi& E, int wid) {
    int lane = lane_id(); asm volatile("" : "+v"(lane));
    const int tid = wid * 64 + lane, wr = wid >> 2, wc = wid & 3, fr = lane & 15, fq = lane >> 4;
    const int K = g.K, nt = K / BK;
    unsigned voffA[2], voffB[2];
#pragma unroll
    for (int i = 0; i < 2; ++i) { int R, C; stage_rc(tid * 16 + i * 8192, R, C); const int Rb = Epi::PERM ? ((R & ~31) + perm32(R & 31)) : R;
        voffA[i] = (unsigned)(R * g.lda + C) * 2u; voffB[i] = (unsigned)(Rb * g.ldb + C) * 2u; }
    const size_t kstep = (size_t)(BK * 2);
    const size_t hsA = (size_t)HALF * g.lda * 2, hsB = (size_t)HALF * g.ldb * 2;
    const size_t tsA = 2 * hsA, tsB = 2 * hsB;
    const unsigned ldsw = (unsigned)wid * 1024u;
    const int aoff = lds_byte(wr * 64 + fr, fq * 8), boff = lds_byte(wc * 32 + fr, fq * 8);
#define PG8_SA(b, h) (((b) * 2 + (h)) * HTB)
#define PG8_SB(b, h) ((4 + (b) * 2 + (h)) * HTB)
#define PG8_STAGE(bufoff, gbase, voff) do { _Pragma("unroll") for (int _i = 0; _i < 2; ++_i) \
        __builtin_amdgcn_global_load_lds((const unsigned*)((const char*)(gbase) + (voff)[_i]), (LAS unsigned*)(lds + (bufoff) + ldsw + _i * 8192), 16, 0, 0); } while (0)
#define PG8_LDA(dst, b, h) do { _Pragma("unroll") for (int m = 0; m < 4; ++m) _Pragma("unroll") for (int k = 0; k < 2; ++k) dst[m][k] = *(const LAS bf16x8*)(lds + PG8_SA(b, h) + aoff + m * 2048 + k * 1024); } while (0)
#define PG8_LDB(dst, b, h) do { _Pragma("unroll") for (int n = 0; n < 2; ++n) _Pragma("unroll") for (int k = 0; k < 2; ++k) dst[n][k] = *(const LAS bf16x8*)(lds + PG8_SB(b, h) + boff + n * 2048 + k * 1024); } while (0)
#define PG8_MMA(ai, bj, At, Bt) do { __builtin_amdgcn_s_setprio(1); _Pragma("unroll") for (int m = 0; m < 4; ++m) _Pragma("unroll") for (int n = 0; n < 2; ++n) _Pragma("unroll") for (int k = 0; k < 2; ++k) \
        acc[ai][bj][m][n] = __builtin_amdgcn_mfma_f32_16x16x32_bf16(Bt[n][k], At[m][k], acc[ai][bj][m][n], 0, 0, 0); __builtin_amdgcn_s_setprio(0); } while (0)
#define PG8_WAIT_V(n) asm volatile("s_waitcnt vmcnt(" #n ")" ::: "memory")
#define PG8_WAIT_L(n) asm volatile("s_waitcnt lgkmcnt(" #n ")" ::: "memory")
#define PG8_BAR __builtin_amdgcn_s_barrier()
#define PG8_SCHED __builtin_amdgcn_sched_barrier(0)
    Unit cur, nxt; int ui = 0;
    if (!S.next(0, cur)) return;
    f32x4 acc[2][2][4][2];
#pragma unroll
    for (int a = 0; a < 2; ++a)
#pragma unroll
        for (int b = 0; b < 2; ++b)
#pragma unroll
            for (int m = 0; m < 4; ++m)
#pragma unroll
                for (int n = 0; n < 2; ++n) acc[a][b][m][n] = (f32x4){0.f, 0.f, 0.f, 0.f};
    bf16x8 At[4][2], B0[2][2], B1[2][2];
    const char* cA = (const char*)g.A + (size_t)cur.pm * tsA; const char* cB = (const char*)g.Bt + (size_t)cur.pn * tsB;
    S.a_ready(cur);
    PG8_STAGE(PG8_SB(0, 0), cB, voffB); PG8_STAGE(PG8_SB(0, 1), cB + hsB, voffB); PG8_STAGE(PG8_SA(0, 0), cA, voffA); PG8_STAGE(PG8_SA(0, 1), cA + hsA, voffA);
    if (wr == 1) PG8_BAR;
    PG8_WAIT_V(2); PG8_BAR;
    PG8_STAGE(PG8_SB(1, 0), cB + kstep, voffB); PG8_STAGE(PG8_SA(1, 0), cA + kstep, voffA); PG8_STAGE(PG8_SB(1, 1), cB + hsB + kstep, voffB);
    PG8_WAIT_V(6); PG8_BAR;
    for (;;) {
        const bool has_next = S.next(ui + 1, nxt);
        const char* nA = has_next ? (const char*)g.A + (size_t)nxt.pm * tsA : cA; const char* nB = has_next ? (const char*)g.Bt + (size_t)nxt.pn * tsB : cB;
        for (int t = 0; t < nt; t += 2) {
            const bool last = (t == nt - 2);
            const char* a1 = cA + (size_t)(t + 1) * kstep;
            const char* a2 = last ? nA : cA + (size_t)(t + 2) * kstep; const char* b2 = last ? nB : cB + (size_t)(t + 2) * kstep;
            const char* a3 = a2 + kstep; const char* b3 = b2 + kstep;
            if (last && has_next) S.a_ready(nxt);
            if constexpr (Epi::HAS_MID) { if (t == 16 || t == 20) E.mid(acc, cur, t, wr, wc, fr, fq); }
            PG8_LDB(B0, 0, 0); PG8_LDB(B1, 0, 1); PG8_SCHED; PG8_LDA(At, 0, 0); PG8_STAGE(PG8_SA(1, 1), a1 + hsA, voffA);
            PG8_WAIT_V(8); PG8_WAIT_L(0); PG8_BAR; PG8_MMA(0, 0, At, B0); PG8_MMA(0, 1, At, B1); PG8_BAR; PG8_SCHED;
            PG8_LDA(At, 0, 1); PG8_STAGE(PG8_SB(0, 0), b2, voffB); PG8_STAGE(PG8_SB(0, 1), b2 + hsB, voffB); PG8_STAGE(PG8_SA(0, 0), a2, voffA);
            PG8_WAIT_V(8); PG8_WAIT_L(0); PG8_BAR; PG8_MMA(1, 0, At, B0); PG8_MMA(1, 1, At, B1); PG8_BAR; PG8_SCHED;
            PG8_LDB(B0, 1, 0); PG8_LDB(B1, 1, 1); PG8_SCHED; PG8_LDA(At, 1, 0); PG8_STAGE(PG8_SA(0, 1), a2 + hsA, voffA);
            PG8_WAIT_V(8); PG8_WAIT_L(0); PG8_BAR; PG8_MMA(0, 0, At, B0); PG8_MMA(0, 1, At, B1); PG8_BAR; PG8_SCHED;
            PG8_LDA(At, 1, 1); PG8_STAGE(PG8_SB(1, 0), b3, voffB); PG8_STAGE(PG8_SB(1, 1), b3 + hsB, voffB); PG8_STAGE(PG8_SA(1, 0), a3, voffA);
            PG8_WAIT_V(8); PG8_WAIT_L(0); PG8_BAR; PG8_MMA(1, 0, At, B0); PG8_MMA(1, 1, At, B1); PG8_BAR; PG8_SCHED;
        }
        if (wr == 0) PG8_BAR;
        E(acc, cur, wr, wc, fr, fq); S.done(cur);
        if (!has_next) break;
#pragma unroll
        for (int a = 0; a < 2; ++a)
#pragma unroll
            for (int b = 0; b < 2; ++b)
#pragma unroll
                for (int m = 0; m < 4; ++m)
#pragma unroll
                    for (int n = 0; n < 2; ++n) acc[a][b][m][n] = (f32x4){0.f, 0.f, 0.f, 0.f};
        cur = nxt; cA = nA; cB = nB; ++ui;
        if (wr == 1) PG8_BAR;
    }
    PG8_WAIT_V(0);
    PG8_BAR;
#undef PG8_SA
#undef PG8_SB
#undef PG8_STAGE
#undef PG8_LDA
#undef PG8_LDB
#undef PG8_MMA
#undef PG8_WAIT_V
#undef PG8_WAIT_L
#undef PG8_BAR
#undef PG8_SCHED
}
}

struct Args {
    const float* in[26]; const int* positions; float* out; unsigned char* ws; int ph_lo, ph_hi; int pad0, pad1;
};
struct Frame {
    LAS unsigned char* lds;
    int tid, lane, wave, G, bid;
    const float* const* in; const int* positions; float* out; unsigned char* ws;
};
__device__ __forceinline__ void frame_refresh(Frame& F) { int l = lane_id(); asm volatile("" : "+v"(l)); F.lane = l; F.tid = F.wave * 64 + l; }
enum { I_X = 0, I_MEM = 1, I_POS = 2, I_NMIXW = 3, I_WIN = 4, I_CONVW = 5, I_CONVB = 6, I_DTB = 7, I_ALOG = 8, I_SSDD = 9, I_SSDNW = 10, I_DQNW = 11, I_DKNW = 12, I_MEMNW = 13,
       I_WMKV = 14, I_MQNW = 15, I_MKNW = 16, I_WSSD = 17, I_WDIL = 18, I_WMEMBR = 19, I_WOUT = 20, I_NFFNW = 21, I_WQ = 22, I_SUBK = 23, I_PD = 24, I_PU = 25 };

__device__ __forceinline__ void p0_transpose_item(const float* W, int ldw, int src_col0, bf16* WT, int ldt, int dst_row0, int dst_col0, int nblk, LAS float* scr, int item, int lane) {
    const int kb = item / nblk, nb = item % nblk, k0 = 64 * kb, n0 = 32 * nb;
#pragma unroll 8
    for (int i = 0; i < 32; ++i) { const int kk = 2 * i + (lane >> 5); scr[kk * 33 + (lane & 31)] = W[(size_t)(k0 + kk) * ldw + src_col0 + n0 + (lane & 31)]; }
    LDS_WAIT(); asm volatile("" ::: "memory");
    const int c = lane & 7;
#pragma unroll
    for (int j = 0; j < 4; ++j) { const int n = (lane >> 3) + 8 * j; const LAS float* s = scr + (8 * c) * 33 + n;
        u32x4 o; o.x = pk2(s[0 * 33], s[1 * 33]); o.y = pk2(s[2 * 33], s[3 * 33]); o.z = pk2(s[4 * 33], s[5 * 33]); o.w = pk2(s[6 * 33], s[7 * 33]);
        *(u32x4*)(WT + (size_t)(dst_row0 + n0 + n) * ldt + dst_col0 + k0 + 8 * c) = o; }
    LDS_WAIT(); asm volatile("" ::: "memory");
}
__device__ __forceinline__ void rms_row_to_bf16(const float* xrow, const float* w, bf16* orow, int lane, f32x4 (&v)[4]) {
    const f32x4* xr = (const f32x4*)xrow + lane; const f32x4* wr = (const f32x4*)w + lane;
    float s = 0.f;
#pragma unroll
    for (int j = 0; j < 4; ++j) { v[j] = xr[64 * j]; s += (v[j].x * v[j].x + v[j].y * v[j].y) + (v[j].z * v[j].z + v[j].w * v[j].w); }
    const float rstd = 1.0f / sqrtf(wave_sum(s) * (1.f / DM) + EPS);
    unsigned long long* o8 = (unsigned long long*)orow + lane;
#pragma unroll
    for (int j = 0; j < 4; ++j) { const f32x4 ww = wr[64 * j]; v[j] = v[j] * rstd * ww;
        o8[64 * j] = (unsigned long long)pk2(v[j].x, v[j].y) | ((unsigned long long)pk2(v[j].z, v[j].w) << 32); }
}
__device__ __forceinline__ void cvt_f32_bf16_stream(const float* src, bf16* dst, size_t n, size_t gtid, size_t gthreads) {
    for (size_t i = gtid * 8; i < n; i += gthreads * 8) { const f32x4 a = *(const f32x4*)(src + i), b = *(const f32x4*)(src + i + 4);
        u32x4 o; o.x = pk2(a.x, a.y); o.y = pk2(a.z, a.w); o.z = pk2(b.x, b.y); o.w = pk2(b.z, b.w); *(u32x4*)(dst + i) = o; }
}
constexpr float PD_SCALE = 64.0f, PU_SCALE = 8.0f;
__device__ __forceinline__ unsigned pk4_fp8(f32x4 v, float sc) {
    const float a = fminf(fmaxf(v.x * sc, -448.f), 448.f), b = fminf(fmaxf(v.y * sc, -448.f), 448.f), c = fminf(fmaxf(v.z * sc, -448.f), 448.f), d = fminf(fmaxf(v.w * sc, -448.f), 448.f);
    unsigned p = __builtin_amdgcn_cvt_pk_fp8_f32(a, b, 0, false); return __builtin_amdgcn_cvt_pk_fp8_f32(c, d, p, true);
}
__device__ __forceinline__ void cvt_f32_fp8_sliced(const float* src, unsigned char* dst, float sc, size_t gtid, size_t gthreads) {
    for (size_t i = gtid * 16; i < (size_t)16384 * 1024; i += gthreads * 16) { const f32x4 a = *(const f32x4*)(src + i), b = *(const f32x4*)(src + i + 4), c = *(const f32x4*)(src + i + 8), d = *(const f32x4*)(src + i + 12);
        const size_t e = i >> 10, dd = i & 1023;
        const u32x4 o = {pk4_fp8(a, sc), pk4_fp8(b, sc), pk4_fp8(c, sc), pk4_fp8(d, sc)}; *(u32x4*)(dst + ((((dd >> 7) * 16384 + e) << 7) + (dd & 127))) = o; }
}
__device__ __forceinline__ void p0_prologue(Frame& F) {
    LAS float* scr = (LAS float*)(F.lds + F.wave * 8448);
    LAS float* wdt = (LAS float*)(F.lds + 8 * 8448);
    const int gw = F.bid * NWAVES + F.wave, NGW = F.G * NWAVES;
    unsigned char* ws = F.ws;
    for (int i = F.tid; i < 1024 * 16; i += NTHR) { const int k = i >> 4, c = i & 15, l = (k & 255) >> 2, e = k & 3, j = k >> 8, q = c >> 2;
        wdt[((((j * 4 + e) * 4 + q) * 64 + l) << 2) + (c & 3)] = F.in[I_WIN][(size_t)k * W_IN_N + OFF_DT + c]; }
    __syncthreads();
    constexpr int IT_A = 16 * 96, IT_B = 16 * 192, IT_MKV = 16 * 48, IT_SSD = 16 * 32, IT_DIL = 4 * 32, IT_MBR = 12 * 32, IT_OUT = 16 * 32, IT_WQ = 16 * 64;
    constexpr int NITEMS = IT_A + IT_B + IT_MKV + IT_SSD + IT_DIL + IT_MBR + IT_OUT + IT_WQ;
    bf16* WallT = (bf16*)(ws + WS_WALLT);
    for (int it = gw; it < NITEMS; it += NGW) {
        int r = it;
        if (r < IT_A) { p0_transpose_item(F.in[I_WIN], W_IN_N, 0, WallT, DM, 0, 0, 96, scr, r, F.lane); continue; } r -= IT_A;
        if (r < IT_B) { p0_transpose_item(F.in[I_WIN], W_IN_N, OFF_AFTER_DT, WallT, DM, 3072, 0, 192, scr, r, F.lane); continue; } r -= IT_B;
        if (r < IT_MKV) { p0_transpose_item(F.in[I_WMKV], 1536, 0, (bf16*)(ws + WS_WMKVT), DM, 0, 0, 48, scr, r, F.lane); continue; } r -= IT_MKV;
        if (r < IT_SSD) { p0_transpose_item(F.in[I_WSSD], DM, 0, (bf16*)(ws + WS_WCATT), YC, 0, 0, 32, scr, r, F.lane); continue; } r -= IT_SSD;
        if (r < IT_DIL) { p0_transpose_item(F.in[I_WDIL], DM, 0, (bf16*)(ws + WS_WCATT), YC, 0, 1024, 32, scr, r, F.lane); continue; } r -= IT_DIL;
        if (r < IT_MBR) { p0_transpose_item(F.in[I_WMEMBR], DM, 0, (bf16*)(ws + WS_WCATT), YC, 0, 1280, 32, scr, r, F.lane); continue; } r -= IT_MBR;
        if (r < IT_OUT) { p0_transpose_item(F.in[I_WOUT], DM, 0, (bf16*)(ws + WS_WOUTT), DM, 0, 0, 32, scr, r, F.lane); continue; } r -= IT_OUT;
        p0_transpose_item(F.in[I_WQ], PEER_Q, 0, (bf16*)(ws + WS_WQT), DM, 0, 0, 64, scr, r, F.lane);
    }
    const size_t gtid = (size_t)F.bid * NTHR + F.tid, gth = (size_t)F.G * NTHR;
    cvt_f32_bf16_stream(F.in[I_SUBK], (bf16*)(ws + WS_SUBK), (size_t)8 * 2 * 128 * 128, gtid, gth);
    cvt_f32_fp8_sliced(F.in[I_PD], ws + WS_PD, PD_SCALE, gtid, gth);
    cvt_f32_fp8_sliced(F.in[I_PU], ws + WS_PU, PU_SCALE, gtid, gth);
    for (int m = gw; m < NB * NMEM; m += NGW) { f32x4 v[4]; rms_row_to_bf16(F.in[I_MEM] + (size_t)m * DM, F.in[I_MEMNW], (bf16*)(ws + WS_MEMN) + (size_t)m * DM, F.lane, v); }
    float* DTp = (float*)(ws + WS_DT);
    const int lane = F.lane;
    const int myj = ((lane >> 5) & 1) * 8 + ((lane >> 4) & 1) * 4 + ((lane >> 3) & 1) * 2 + ((lane >> 2) & 1);
    const float dtb = F.in[I_DTB][myj];
    for (int m = 2 * gw; m < T; m += 2 * NGW) {
        f32x4 va[4], vb[4];
        rms_row_to_bf16(F.in[I_X] + (size_t)m * DM, F.in[I_NMIXW], (bf16*)(ws + WS_ACT1) + (size_t)m * DM, lane, va);
        rms_row_to_bf16(F.in[I_X] + (size_t)(m + 1) * DM, F.in[I_NMIXW], (bf16*)(ws + WS_ACT1) + (size_t)(m + 1) * DM, lane, vb);
        float da[16], db[16];
#pragma unroll
        for (int j = 0; j < 16; ++j) { da[j] = 0.f; db[j] = 0.f; }
#pragma unroll
        for (int j = 0; j < 4; ++j)
#pragma unroll
            for (int e = 0; e < 4; ++e) { const float ua = va[j][e], ub = vb[j][e];
#pragma unroll
                for (int q = 0; q < 4; ++q) { const f32x4 w4 = *(const LAS f32x4*)(wdt + ((((j * 4 + e) * 4 + q) * 64 + lane) << 2));
                    da[4 * q + 0] += ua * w4.x; da[4 * q + 1] += ua * w4.y; da[4 * q + 2] += ua * w4.z; da[4 * q + 3] += ua * w4.w;
                    db[4 * q + 0] += ub * w4.x; db[4 * q + 1] += ub * w4.y; db[4 * q + 2] += ub * w4.z; db[4 * q + 3] += ub * w4.w; }
                __builtin_amdgcn_sched_barrier(0); }
        float ra, rb;
        { float r8a[8], r8b[8], r4a[4], r4b[4], r2a[2], r2b[2];
          { const bool up = (lane & 32) != 0;
#pragma unroll
            for (int k = 0; k < 8; ++k) { r8a[k] = (up ? da[k + 8] : da[k]) + __shfl_xor(up ? da[k] : da[k + 8], 32); r8b[k] = (up ? db[k + 8] : db[k]) + __shfl_xor(up ? db[k] : db[k + 8], 32); } }
          { const bool up = (lane & 16) != 0;
#pragma unroll
            for (int k = 0; k < 4; ++k) { r4a[k] = (up ? r8a[k + 4] : r8a[k]) + __shfl_xor(up ? r8a[k] : r8a[k + 4], 16); r4b[k] = (up ? r8b[k + 4] : r8b[k]) + __shfl_xor(up ? r8b[k] : r8b[k + 4], 16); } }
          { const bool up = (lane & 8) != 0;
#pragma unroll
            for (int k = 0; k < 2; ++k) { r2a[k] = (up ? r4a[k + 2] : r4a[k]) + __shfl_xor(up ? r4a[k] : r4a[k + 2], 8); r2b[k] = (up ? r4b[k + 2] : r4b[k]) + __shfl_xor(up ? r4b[k] : r4b[k + 2], 8); } }
          { const bool up = (lane & 4) != 0; ra = (up ? r2a[1] : r2a[0]) + __shfl_xor(up ? r2a[0] : r2a[1], 4); rb = (up ? r2b[1] : r2b[0]) + __shfl_xor(up ? r2b[0] : r2b[1], 4); }
          ra += __shfl_xor(ra, 2); ra += __shfl_xor(ra, 1); rb += __shfl_xor(rb, 2); rb += __shfl_xor(rb, 1); }
        if ((lane & 3) == 0) { const float xa = ra + dtb, xb = rb + dtb;
            DTp[(size_t)m * 16 + myj] = (xa > 20.f) ? xa : log1pf(__expf(xa)); DTp[(size_t)(m + 1) * 16 + myj] = (xb > 20.f) ? xb : log1pf(__expf(xb)); }
    }
}

__device__ __forceinline__ void norm192_inplace(bf16* p, const float (&w)[4], int lane) {
    u32x2 v = {0u, 0u};
    if (lane < 48) v = *(const u32x2*)(p + 4 * lane);
    float x0 = bflo(v.x), x1 = bfhi(v.x), x2 = bflo(v.y), x3 = bfhi(v.y);
    const float ss = wave_sum((x0 * x0 + x1 * x1) + (x2 * x2 + x3 * x3));
    const float rs = 1.0f / sqrtf(ss * (1.f / 192.f) + EPS);
    if (lane < 48) { const u32x2 o = {pkbf(x0 * rs * w[0], x1 * rs * w[1]), pkbf(x2 * rs * w[2], x3 * rs * w[3])}; *(u32x2*)(p + 4 * lane) = o; }
}
__device__ __forceinline__ void qkprep_phase(Frame& F, int half) {
    bf16* P = (bf16*)(F.ws + WS_BIG);
    const int gw = F.bid * NWAVES + F.wave, NGW = F.G * NWAVES, lane = F.lane, sub = lane & 7;
    float wq[8], wk[8], wmq[4], wmk[4];
#pragma unroll
    for (int j = 0; j < 8; ++j) { wq[j] = F.in[I_DQNW][8 * sub + j]; wk[j] = F.in[I_DKNW][8 * sub + j]; }
#pragma unroll
    for (int j = 0; j < 4; ++j) { wmq[j] = F.in[I_MQNW][(4 * lane + j) % 192]; wmk[j] = F.in[I_MKNW][(4 * lane + j) % 192]; }
    const float inv = __expf(-logf(500000.0f) * (2.0f / 16.0f) * (float)sub);
    for (int r0 = gw; r0 < HT; r0 += 2 * NGW) {
        bf16* rowp[2]; u32x4 v[2][3]; u32x2 m[2][4]; int pos[2];
#pragma unroll
        for (int u = 0; u < 2; ++u) { const int r = (r0 + u * NGW < HT) ? r0 + u * NGW : r0; rowp[u] = P + (size_t)r * NPROJ; pos[u] = F.positions[half * HT + r];
#pragma unroll
            for (int blk = 0; blk < 3; ++blk) v[u][blk] = *(const u32x4*)(rowp[u] + PC_DQ + blk * 512 + 8 * lane);
#pragma unroll
            for (int h = 0; h < 4; ++h) { m[u][h] = (u32x2){0u, 0u}; if (lane < 48) m[u][h] = *(const u32x2*)(rowp[u] + PC_MQ + h * 192 + 4 * lane); } }
#pragma unroll
        for (int u = 0; u < 2; ++u) {
            if (u == 1 && r0 + NGW >= HT) break;
            const double rev = (double)((float)pos[u] * inv) * 0.15915494309189535;
            const float fr = (float)(rev - floor(rev));
            const float cs = __builtin_amdgcn_cosf(fr), sn = __builtin_amdgcn_sinf(fr);
            float cj[8], sj[8];
#pragma unroll
            for (int j = 0; j < 8; ++j) { cj[j] = __shfl(cs, (lane & ~7) | j); sj[j] = __shfl(sn, (lane & ~7) | j); }
            bf16* row = rowp[u];
#pragma unroll
            for (int blk = 0; blk < 3; ++blk) {
                float x[8] = {bflo(v[u][blk].x), bfhi(v[u][blk].x), bflo(v[u][blk].y), bfhi(v[u][blk].y), bflo(v[u][blk].z), bfhi(v[u][blk].z), bflo(v[u][blk].w), bfhi(v[u][blk].w)};
                float ss = 0.f;
#pragma unroll
                for (int j = 0; j < 8; ++j) ss += x[j] * x[j];
                ss += __shfl_xor(ss, 1); ss += __shfl_xor(ss, 2); ss += __shfl_xor(ss, 4);
                const float rs = 1.0f / sqrtf(ss * (1.f / 64.f) + EPS);
                const bool isq = (8 * blk + (lane >> 3)) < 12;
#pragma unroll
                for (int j = 0; j < 8; ++j) x[j] = x[j] * rs * (isq ? wq[j] : wk[j]);
#pragma unroll
                for (int j = 0; j < 8; ++j) { const float o = __shfl_xor(x[j], 1);
                    if (sub == 0) x[j] = x[j] * cj[j] - o * sj[j]; else if (sub == 1) x[j] = x[j] * cj[j] + o * sj[j]; }
                const u32x4 w = {pkbf(x[0], x[1]), pkbf(x[2], x[3]), pkbf(x[4], x[5]), pkbf(x[6], x[7])};
                *(u32x4*)(row + PC_DQ + blk * 512 + 8 * lane) = w;
            }
#pragma unroll
            for (int h = 0; h < 4; ++h) { const u32x2 q = m[u][h]; const float x0 = bflo(q.x), x1 = bfhi(q.x), x2 = bflo(q.y), x3 = bfhi(q.y);
                const float ss = wave_sum((x0 * x0 + x1 * x1) + (x2 * x2 + x3 * x3));
                const float rs = 1.0f / sqrtf(ss * (1.f / 192.f) + EPS);
                if (lane < 48) { const u32x2 o = {pkbf(x0 * rs * wmq[0], x1 * rs * wmq[1]), pkbf(x2 * rs * wmq[2], x3 * rs * wmq[3])}; *(u32x2*)(row + PC_MQ + h * 192 + 4 * lane) = o; } }
        }
    }
    if (half == 0) {
        bf16* MK = (bf16*)(F.ws + WS_MKV);
        for (int r = gw; r < NB * NMEM * 4; r += NGW) norm192_inplace(MK + (size_t)(r >> 2) * 1536 + (r & 3) * 192, wmk, lane);
    }
}

constexpr int SC_ST = 272, SX_ST = 528;
__device__ __forceinline__ float bfsel(const u32x4& v, int j) { const unsigned w = v[j >> 1]; return (j & 1) ? bfhi(w) : bflo(w); }
__device__ __forceinline__ void conv_task(const bf16* P, size_t rowb, int t0, int pcol, const float* cw, const float* cb, int ccol, LAS unsigned char* dst, int stride, const LAS float* scale) {
    float w[4][8], bs[8];
#pragma unroll
    for (int k = 0; k < 4; ++k) { const f32x4 a = *(const f32x4*)(cw + k * 2048 + ccol), b = *(const f32x4*)(cw + k * 2048 + ccol + 4);
        w[k][0] = a.x; w[k][1] = a.y; w[k][2] = a.z; w[k][3] = a.w; w[k][4] = b.x; w[k][5] = b.y; w[k][6] = b.z; w[k][7] = b.w; }
    { const f32x4 a = *(const f32x4*)(cb + ccol), b = *(const f32x4*)(cb + ccol + 4); bs[0] = a.x; bs[1] = a.y; bs[2] = a.z; bs[3] = a.w; bs[4] = b.x; bs[5] = b.y; bs[6] = b.z; bs[7] = b.w; }
    const bf16* src = P + (rowb + t0) * NPROJ + pcol;
    u32x4 rw[19];
#pragma unroll
    for (int i = 0; i < 3; ++i) rw[i] = (u32x4){0u, 0u, 0u, 0u};
    if (t0 > 0) {
#pragma unroll
        for (int i = 0; i < 3; ++i) rw[i] = *(const u32x4*)(src + (ptrdiff_t)(i - 3) * NPROJ); }
#pragma unroll
    for (int i = 0; i < 16; ++i) rw[3 + i] = *(const u32x4*)(src + (size_t)i * NPROJ);
#pragma unroll
    for (int i = 0; i < 16; ++i) {
        float o[8];
#pragma unroll
        for (int j = 0; j < 8; ++j) { float a = bs[j] + w[0][j] * bfsel(rw[i], j) + w[1][j] * bfsel(rw[i + 1], j) + w[2][j] * bfsel(rw[i + 2], j) + w[3][j] * bfsel(rw[i + 3], j); o[j] = a * sigmoidf_(a); }
        if (scale) { const float sv = scale[i];
#pragma unroll
            for (int j = 0; j < 8; ++j) o[j] *= sv; }
        const u32x4 r = {pkbf(o[0], o[1]), pkbf(o[2], o[3]), pkbf(o[4], o[5]), pkbf(o[6], o[7])};
        *(LAS u32x4*)(dst + i * stride) = r;
    }
}
__device__ __forceinline__ float ssd_scan(Frame& F, const float* DTp, size_t tok0, int g, LAS float* sAc, LAS float* sDt) {
    float total = 0.f;
    if (F.wave < 4) {
        const int head = 4 * g + F.wave, lane = F.lane;
        const float A = -__expf(F.in[I_ALOG][head]);
        const float d0 = DTp[(tok0 + 2 * lane) * 16 + head], d1 = DTp[(tok0 + 2 * lane + 1) * 16 + head];
        const float a0 = d0 * A, a1 = d1 * A;
        float sc = a0 + a1;
#pragma unroll
        for (int o = 1; o < 64; o <<= 1) { const float v = __shfl_up(sc, o); if (lane >= o) sc += v; }
        sAc[F.wave * 128 + 2 * lane] = sc - a1; sAc[F.wave * 128 + 2 * lane + 1] = sc;
        sDt[F.wave * 128 + 2 * lane] = d0; sDt[F.wave * 128 + 2 * lane + 1] = d1;
        total = __shfl(sc, 63);
    }
    return total;
}
__device__ __forceinline__ bf16x8 tr_pair(unsigned a_lo, unsigned a_hi) {
    s16x4 lo, hi;
    asm volatile("ds_read_b64_tr_b16 %0, %2\n\tds_read_b64_tr_b16 %1, %3\n\ts_waitcnt lgkmcnt(0)" : "=&v"(lo), "=&v"(hi) : "v"(a_lo), "v"(a_hi) : "memory");
    const bf16x8 r = {lo[0], lo[1], lo[2], lo[3], hi[0], hi[1], hi[2], hi[3]}; return r;
}

__device__ __forceinline__ void ssdC_phase(Frame& F, int half) {
    const bf16* P = (const bf16*)(F.ws + WS_BIG);
    const float* DTp = (const float*)(F.ws + WS_DT);
    float* SST = (float*)(F.ws + WS_SST); float* DEC = (float*)(F.ws + WS_DEC);
    LAS unsigned char* sX = F.lds; LAS unsigned char* sB = F.lds + 128 * SX_ST;
    LAS float* sAc = (LAS float*)(F.lds + 128 * SX_ST + 128 * SC_ST); LAS float* sDt = sAc + 512; LAS float* sW = sDt + 512;
    const int wave = F.wave;
    for (int unit = F.bid; unit < HB * 64 * 4; unit += F.G) {
        int tid = F.tid; asm volatile("" : "+v"(tid));
        const int lane = tid & 63, ql = lane & 31, h = lane >> 5, tq = (lane & 15) >> 2, tp = lane & 3, tblk = (lane >> 4) & 1;
        const int bl = unit >> 8, c = (unit >> 2) & 63, g = unit & 3;
        const size_t rowb = (size_t)bl * SEQ, tok0 = (size_t)half * HT + rowb + c * 128;
        __syncthreads();
        const float total = ssd_scan(F, DTp, tok0, g, sAc, sDt);
        if (wave < 4) { sW[wave * 128 + 2 * lane] = __expf(total - sAc[wave * 128 + 2 * lane]) * sDt[wave * 128 + 2 * lane];
            sW[wave * 128 + 2 * lane + 1] = __expf(total - sAc[wave * 128 + 2 * lane + 1]) * sDt[wave * 128 + 2 * lane + 1];
            if (lane == 0) DEC[((size_t)bl * 64 + c) * 16 + 4 * g + wave] = __expf(total); }
        __syncthreads();
        if (tid < 384) {
            int ch, strip, ccol, stride; LAS unsigned char* dst; const LAS float* scl = nullptr;
            if (tid < 256) { ch = tid & 31; strip = tid >> 5; ccol = g * 256 + 8 * ch; stride = SX_ST; dst = sX + (strip * 16) * SX_ST + ch * 16; scl = sW + (ch >> 3) * 128 + strip * 16; }
            else { const int u = tid - 256; ch = u & 15; strip = u >> 4; ccol = 1024 + g * 128 + 8 * ch; stride = SC_ST; dst = sB + (strip * 16) * SC_ST + ch * 16; }
            conv_task(P, rowb, c * 128 + strip * 16, PC_X + ccol, F.in[I_CONVW], F.in[I_CONVB], ccol, dst, stride, scl);
        }
        __syncthreads();
        const int r = wave >> 1, pt = wave & 1;
        f32x16 acc[4];
#pragma unroll
        for (int nt = 0; nt < 4; ++nt)
#pragma unroll
            for (int e = 0; e < 16; ++e) acc[nt][e] = 0.f;
        const unsigned xa = (unsigned)(size_t)sX + (unsigned)((8 * h + tq) * SX_ST + (r * 64 + 32 * pt + 16 * tblk + 4 * tp) * 2);
        const unsigned ba = (unsigned)(size_t)sB + (unsigned)((8 * h + tq) * SC_ST + (16 * tblk + 4 * tp) * 2);
#pragma unroll
        for (int ks = 0; ks < 8; ++ks) {
            const bf16x8 af = tr_pair(xa + ks * 16 * SX_ST, xa + ks * 16 * SX_ST + 4 * SX_ST);
            bf16x8 bfr[4];
#pragma unroll
            for (int nt = 0; nt < 4; ++nt) bfr[nt] = tr_pair(ba + ks * 16 * SC_ST + nt * 64, ba + ks * 16 * SC_ST + 4 * SC_ST + nt * 64);
            __builtin_amdgcn_sched_barrier(0);
#pragma unroll
            for (int nt = 0; nt < 4; ++nt) acc[nt] = MFMA32(af, bfr[nt], acc[nt]);
        }
        float* out = SST + (((size_t)bl * 64 + c) * 16 + 4 * g + r) * 8192;
#pragma unroll
        for (int nt = 0; nt < 4; ++nt)
#pragma unroll
            for (int e = 0; e < 16; ++e) out[(32 * pt + (e & 3) + 8 * (e >> 2) + 4 * h) * 128 + 32 * nt + ql] = acc[nt][e];
    }
}

__device__ __forceinline__ void ssdD_phase(Frame& F) {
    const float* SST = (const float*)(F.ws + WS_SST); const float* DEC = (const float*)(F.ws + WS_DEC);
    bf16* SIN = (bf16*)(F.ws + WS_SIN);
    const size_t gtid = (size_t)F.bid * NTHR + F.tid, gth = (size_t)F.G * NTHR;
    for (size_t it = gtid; it < (size_t)HB * 16 * 2048; it += gth) {
        const int bl = (int)(it >> 15), head = (int)(it >> 11) & 15, e4 = (int)(it & 2047) * 4;
        f32x4 st = {0.f, 0.f, 0.f, 0.f};
#pragma unroll 8
        for (int c = 0; c < 64; ++c) {
            const size_t idx = (((size_t)bl * 64 + c) * 16 + head);
            const u32x2 o = {pkbf(st.x, st.y), pkbf(st.z, st.w)};
            *(u32x2*)(SIN + idx * 8192 + e4) = o;
            const f32x4 sl = *(const f32x4*)(SST + idx * 8192 + e4); const float d = DEC[idx];
            st = st * d + sl;
        }
    }
}

__device__ __forceinline__ void ssdE_phase(Frame& F, int half) {
    const bf16* P = (const bf16*)(F.ws + WS_BIG);
    const float* DTp = (const float*)(F.ws + WS_DT);
    const bf16* SIN = (const bf16*)(F.ws + WS_SIN);
    bf16* Y = (bf16*)F.out;
    LAS unsigned char* sX = F.lds; LAS unsigned char* sB = F.lds + 128 * SX_ST; LAS unsigned char* sC = sB + 128 * SC_ST;
    LAS float* sAc = (LAS float*)(sC + 128 * SC_ST); LAS float* sDt = sAc + 512; LAS float* sSS = sDt + 512;
    const int wave = F.wave;
    const int st = wave & 3, hp = wave >> 2;
    for (int unit = F.bid; unit < HB * 64 * 4; unit += F.G) {
        int tid = F.tid; asm volatile("" : "+v"(tid));
        const int lane = tid & 63, ql = lane & 31, h = lane >> 5, tq = (lane & 15) >> 2, tp = lane & 3, tblk = (lane >> 4) & 1;
        const int bl = unit >> 8, c = (unit >> 2) & 63, g = unit & 3;
        const size_t rowb = (size_t)bl * SEQ, tok0 = (size_t)half * HT + rowb + c * 128;
        __syncthreads();
        (void)ssd_scan(F, DTp, tok0, g, sAc, sDt);
        if (tid < 128) sSS[tid] = 0.f;
        {
            int ch, strip, ccol, stride; LAS unsigned char* dst;
            if (tid < 256) { ch = tid & 31; strip = tid >> 5; ccol = g * 256 + 8 * ch; stride = SX_ST; dst = sX + (strip * 16) * SX_ST + ch * 16; }
            else if (tid < 384) { const int u = tid - 256; ch = u & 15; strip = u >> 4; ccol = 1024 + g * 128 + 8 * ch; stride = SC_ST; dst = sB + (strip * 16) * SC_ST + ch * 16; }
            else { const int u = tid - 384; ch = u & 15; strip = u >> 4; ccol = 1536 + g * 128 + 8 * ch; stride = SC_ST; dst = sC + (strip * 16) * SC_ST + ch * 16; }
            conv_task(P, rowb, c * 128 + strip * 16, PC_X + ccol, F.in[I_CONVW], F.in[I_CONVB], ccol, dst, stride, nullptr);
        }
        __syncthreads();
        const int s = 32 * st + ql;
        unsigned yk[2][2][8];
        float ssq = 0.f;
        const unsigned xa = (unsigned)(size_t)sX + (unsigned)((4 * h + tq) * SX_ST + (16 * tblk + 4 * tp) * 2);
#pragma unroll
        for (int hq = 0; hq < 2; ++hq) {
            const int r = 2 * hp + hq, head = 4 * g + r;
            const float acs = sAc[r * 128 + s];
            const bf16* stp = SIN + (((size_t)bl * 64 + c) * 16 + head) * 8192 + ql * 128 + 8 * h;
            bf16x8 sfr[2][8];
#pragma unroll
            for (int pt = 0; pt < 2; ++pt)
#pragma unroll
                for (int ks = 0; ks < 8; ++ks) sfr[pt][ks] = *(const bf16x8*)(stp + pt * 4096 + 16 * ks);
            bf16x8 pf[4][2];
#pragma unroll
            for (int i = 0; i < 4; ++i) {
                f32x16 Xi;
#pragma unroll
                for (int e = 0; e < 16; ++e) Xi[e] = 0.f;
#pragma unroll
                for (int ks = 0; ks < 8; ++ks) { const bf16x8 bf_ = *(const LAS bf16x8*)(sB + (32 * i + ql) * SC_ST + 32 * ks + 16 * h);
                    const bf16x8 cf = *(const LAS bf16x8*)(sC + s * SC_ST + 32 * ks + 16 * h); Xi = MFMA32(bf_, cf, Xi); }
                float p[16];
#pragma unroll
                for (int q4 = 0; q4 < 4; ++q4) { const int t0 = 32 * i + 8 * q4 + 4 * h;
                    const f32x4 at = *(const LAS f32x4*)(sAc + r * 128 + t0), dt4 = *(const LAS f32x4*)(sDt + r * 128 + t0);
#pragma unroll
                    for (int e = 0; e < 4; ++e) { const int t = t0 + e; p[4 * q4 + e] = (t <= s) ? Xi[4 * q4 + e] * __expf(acs - at[e]) * dt4[e] : 0.f; } }
#pragma unroll
                for (int s2 = 0; s2 < 2; ++s2) { const u32x4 w = {pkbf(p[8 * s2 + 0], p[8 * s2 + 1]), pkbf(p[8 * s2 + 2], p[8 * s2 + 3]), pkbf(p[8 * s2 + 4], p[8 * s2 + 5]), pkbf(p[8 * s2 + 6], p[8 * s2 + 7])};
                    pf[i][s2] = __builtin_bit_cast(bf16x8, w); }
            }
            const float eacs = __expf(acs), Dh = F.in[I_SSDD][head];
#pragma unroll
            for (int pt = 0; pt < 2; ++pt) {
                f32x16 yd, yo;
#pragma unroll
                for (int e = 0; e < 16; ++e) { yd[e] = 0.f; yo[e] = 0.f; }
#pragma unroll
                for (int i = 0; i < 4; ++i) {
#pragma unroll
                    for (int s2 = 0; s2 < 2; ++s2) { const unsigned a = xa + (unsigned)((32 * i + 16 * s2) * SX_ST + (r * 64 + 32 * pt) * 2);
                        const bf16x8 xf = tr_pair(a, a + 8 * SX_ST); __builtin_amdgcn_sched_barrier(0); yd = MFMA32(xf, pf[i][s2], yd); }
                }
#pragma unroll
                for (int ks = 0; ks < 8; ++ks) { const bf16x8 cf = *(const LAS bf16x8*)(sC + s * SC_ST + 32 * ks + 16 * h); yo = MFMA32(sfr[pt][ks], cf, yo); }
                const bf16* zp = P + (rowb + c * 128 + s) * NPROJ + PC_Z + g * 256 + r * 64 + 32 * pt + 4 * h;
                u32x2 zv[4];
#pragma unroll
                for (int q4 = 0; q4 < 4; ++q4) zv[q4] = *(const u32x2*)(zp + 8 * q4);
#pragma unroll
                for (int q4 = 0; q4 < 4; ++q4) {
                    const u32x2 xv = *(const LAS u32x2*)(sX + s * SX_ST + (r * 64 + 32 * pt + 8 * q4 + 4 * h) * 2);
                    const u32x2 zq = zv[q4];
                    const float xs_[4] = {bflo(xv.x), bfhi(xv.x), bflo(xv.y), bfhi(xv.y)}, zs_[4] = {bflo(zq.x), bfhi(zq.x), bflo(zq.y), bfhi(zq.y)};
                    float yv[4];
#pragma unroll
                    for (int e = 0; e < 4; ++e) { float y = yd[4 * q4 + e] + eacs * yo[4 * q4 + e] + Dh * xs_[e]; y = y * zs_[e] * sigmoidf_(zs_[e]); yv[e] = y; ssq += y * y; }
                    yk[hq][pt][2 * q4] = pkbf(yv[0], yv[1]); yk[hq][pt][2 * q4 + 1] = pkbf(yv[2], yv[3]);
                }
            }
        }
        ssq += __shfl_xor(ssq, 32);
        if (h == 0) __hip_atomic_fetch_add(sSS + s, ssq, __ATOMIC_RELAXED, __HIP_MEMORY_SCOPE_WORKGROUP);
        __syncthreads();
        const float rs = 1.0f / sqrtf(sSS[s] * (1.f / 256.f) + EPS);
        bf16* yp = Y + (tok0 + s) * YC + g * 256 + 4 * h;
        const float* nw = F.in[I_SSDNW] + g * 256 + 4 * h;
#pragma unroll
        for (int hq = 0; hq < 2; ++hq)
#pragma unroll
            for (int pt = 0; pt < 2; ++pt)
#pragma unroll
                for (int q4 = 0; q4 < 4; ++q4) { const int cc = (2 * hp + hq) * 64 + 32 * pt + 8 * q4; const f32x4 w4 = *(const f32x4*)(nw + cc);
                    const unsigned ya = yk[hq][pt][2 * q4], yb = yk[hq][pt][2 * q4 + 1];
                    const u32x2 o = {pkbf(bflo(ya) * rs * w4.x, bfhi(ya) * rs * w4.y), pkbf(bflo(yb) * rs * w4.z, bfhi(yb) * rs * w4.w)};
                    *(u32x2*)(yp + cc) = o; }
    }
}

__device__ __forceinline__ bf16x8 mk_bf16x8(u32x2 lo, u32x2 hi) { const u32x4 v = {lo.x, lo.y, hi.x, hi.y}; return __builtin_bit_cast(bf16x8, v); }

__device__ __forceinline__ void memattn_mfma_phase(Frame& F, int half) {
    const bf16* P = (const bf16*)(F.ws + WS_BIG);
    const bf16* MKV = (const bf16*)(F.ws + WS_MKV);
    const bf16* MVT = (const bf16*)(F.ws + WS_MVT);
    bf16* Y = (bf16*)F.out;
    LAS unsigned char* sm = F.lds;
    const int tid = F.tid, lane = F.lane, wave = F.wave, ql = lane & 31, h = lane >> 5;
    constexpr int KST = 400, VST = 528;
    for (int unit = F.bid; unit < HB * 4 * 32; unit += F.G) {
        const int bl = unit >> 7, head = (unit >> 5) & 3, qt = unit & 31, b = half * HB + bl;
        const int r = bl * SEQ + qt * 256 + wave * 32 + ql;
        __syncthreads();
        for (int c = tid; c < 256 * 24; c += NTHR) { const int row = c / 24, ch = c % 24;
            *(LAS u32x4*)(sm + row * KST + ch * 16) = *(const u32x4*)(MKV + (size_t)(b * NMEM + row) * 1536 + head * 192 + ch * 8); }
        bf16x8 qf[12];
        { const bf16* qp = P + (size_t)r * NPROJ + PC_MQ + head * 192 + 8 * h;
#pragma unroll
          for (int ks = 0; ks < 12; ++ks) qf[ks] = *(const bf16x8*)(qp + 16 * ks); }
        __syncthreads();
        f32x16 sacc[8];
#pragma unroll
        for (int mt = 0; mt < 8; ++mt) {
#pragma unroll
            for (int i = 0; i < 16; ++i) sacc[mt][i] = 0.f;
#pragma unroll
            for (int ks = 0; ks < 12; ++ks) { const bf16x8 kf = *(const LAS bf16x8*)(sm + (32 * mt + ql) * KST + 32 * ks + 16 * h); sacc[mt] = MFMA32(kf, qf[ks], sacc[mt]); }
        }
        float mx = -3.0e38f;
#pragma unroll
        for (int mt = 0; mt < 8; ++mt)
#pragma unroll
            for (int i = 0; i < 16; ++i) mx = fmaxf(mx, sacc[mt][i]);
        mx = fmaxf(mx, __shfl_xor(mx, 32));
        const float sc = 0.07216878364870323f * 1.4426950408889634f;
        float l = 0.f;
        bf16x8 pf[8][2];
#pragma unroll
        for (int mt = 0; mt < 8; ++mt) {
            float p[16];
#pragma unroll
            for (int i = 0; i < 16; ++i) { p[i] = __builtin_amdgcn_exp2f((sacc[mt][i] - mx) * sc); l += p[i]; }
#pragma unroll
            for (int s2 = 0; s2 < 2; ++s2) { const u32x4 w = {pkbf(p[8 * s2 + 0], p[8 * s2 + 1]), pkbf(p[8 * s2 + 2], p[8 * s2 + 3]), pkbf(p[8 * s2 + 4], p[8 * s2 + 5]), pkbf(p[8 * s2 + 6], p[8 * s2 + 7])};
                pf[mt][s2] = __builtin_bit_cast(bf16x8, w); }
        }
        l += __shfl_xor(l, 32);
        __syncthreads();
        for (int c = tid; c < 192 * 32; c += NTHR) { const int row = c >> 5, ch = c & 31;
            *(LAS u32x4*)(sm + row * VST + ch * 16) = *(const u32x4*)(MVT + (size_t)(head * 192 + row) * 2048 + b * NMEM + ch * 8); }
        __syncthreads();
        const float il = 1.0f / l;
        bf16* yp = Y + ((size_t)half * HT + r) * YC + 1280 + head * 192 + 4 * h;
#pragma unroll
        for (int dt = 0; dt < 6; ++dt) {
            f32x16 o;
#pragma unroll
            for (int i = 0; i < 16; ++i) o[i] = 0.f;
#pragma unroll
            for (int mt = 0; mt < 8; ++mt)
#pragma unroll
                for (int s2 = 0; s2 < 2; ++s2) { const LAS unsigned char* vp = sm + (32 * dt + ql) * VST + (32 * mt + 16 * s2 + 4 * h) * 2;
                    const bf16x8 vf = mk_bf16x8(*(const LAS u32x2*)vp, *(const LAS u32x2*)(vp + 16)); o = MFMA32(vf, pf[mt][s2], o); }
#pragma unroll
            for (int g = 0; g < 4; ++g) { const u32x2 w = {pkbf(o[4 * g] * il, o[4 * g + 1] * il), pkbf(o[4 * g + 2] * il, o[4 * g + 3] * il)}; *(u32x2*)(yp + 32 * dt + 8 * g) = w; }
        }
    }
}

__device__ __forceinline__ void dilattn_mfma_phase(Frame& F, int half) {
    bf16* P = (bf16*)(F.ws + WS_BIG);
    float* LSE = (float*)(F.ws + WS_LSE);
    LAS unsigned char* sK = F.lds; LAS unsigned char* sV = F.lds + 384 * 144;
    const int tid = F.tid, lane = F.lane, wave = F.wave, ql = lane & 31, h = lane >> 5;
    constexpr int RST = 144;
    for (int unit = F.bid; unit < HB * 12 * 32; unit += F.G) {
        const int bl = unit / 384, rem = unit % 384, head = rem >> 5, blk = rem & 31;
        const int g = head >> 2, dil = (g == 0) ? 1 : (g == 1 ? 4 : 16), bpr = 32 / dil;
        const int res = blk / bpr, q0 = (blk % bpr) * 256;
        const size_t rowb = (size_t)bl * SEQ;
        __syncthreads();
        for (int c = tid; c < 384 * 8; c += NTHR) { const int row = c >> 3, ch = c & 7; const int ks = q0 - 128 + row;
            u32x4 kv = {0u, 0u, 0u, 0u}, vv = {0u, 0u, 0u, 0u};
            if (ks >= 0) { const bf16* src = P + (rowb + (size_t)ks * dil + res) * NPROJ + head * 64 + ch * 8; kv = *(const u32x4*)(src + PC_DK); vv = *(const u32x4*)(src + PC_DV); }
            *(LAS u32x4*)(sK + row * RST + ch * 16) = kv; *(LAS u32x4*)(sV + row * RST + ch * 16) = vv; }
        const int qs = q0 + wave * 32 + ql;
        const size_t rq = rowb + (size_t)qs * dil + res;
        bf16* qp = P + rq * NPROJ + PC_DQ + head * 64;
        bf16x8 qf[4];
#pragma unroll
        for (int ks = 0; ks < 4; ++ks) qf[ks] = *(const bf16x8*)(qp + 16 * ks + 8 * h);
        __syncthreads();
        f32x16 sacc[5];
        const int kfirst = q0 + wave * 32 - 128;
#pragma unroll
        for (int i = 0; i < 5; ++i) {
#pragma unroll
            for (int e = 0; e < 16; ++e) sacc[i][e] = 0.f;
#pragma unroll
            for (int ks = 0; ks < 4; ++ks) { const bf16x8 kf = *(const LAS bf16x8*)(sK + (32 * wave + 32 * i + ql) * RST + 32 * ks + 16 * h); sacc[i] = MFMA32(kf, qf[ks], sacc[i]); }
        }
        float mx = -3.0e38f;
#pragma unroll
        for (int i = 0; i < 5; ++i)
#pragma unroll
            for (int e = 0; e < 16; ++e) { const int kj = 32 * i + (e & 3) + 8 * (e >> 2) + 4 * h; const bool ok = (kj >= ql) && (kj <= ql + 128) && (kfirst + kj >= 0);
                sacc[i][e] = ok ? sacc[i][e] : -3.0e38f; mx = fmaxf(mx, sacc[i][e]); }
        mx = fmaxf(mx, __shfl_xor(mx, 32));
        const float sc = 0.125f * 1.4426950408889634f;
        float l = 0.f;
        bf16x8 pf[5][2];
#pragma unroll
        for (int i = 0; i < 5; ++i) {
            float p[16];
#pragma unroll
            for (int e = 0; e < 16; ++e) { p[e] = (sacc[i][e] > -1.0e38f) ? __builtin_amdgcn_exp2f((sacc[i][e] - mx) * sc) : 0.f; l += p[e]; }
#pragma unroll
            for (int s2 = 0; s2 < 2; ++s2) { const u32x4 w = {pkbf(p[8 * s2 + 0], p[8 * s2 + 1]), pkbf(p[8 * s2 + 2], p[8 * s2 + 3]), pkbf(p[8 * s2 + 4], p[8 * s2 + 5]), pkbf(p[8 * s2 + 6], p[8 * s2 + 7])};
                pf[i][s2] = __builtin_bit_cast(bf16x8, w); }
        }
        l += __shfl_xor(l, 32);
        const float il = 1.0f / l;
        const int tq = (lane & 15) >> 2, tp = lane & 3, tblk = (lane >> 4) & 1;
        const unsigned vbase = (unsigned)(size_t)(sV) + (unsigned)((32 * wave + 4 * h + tq) * RST + (16 * tblk + 4 * tp) * 2);
#pragma unroll
        for (int dt = 0; dt < 2; ++dt) {
            f32x16 o;
#pragma unroll
            for (int e = 0; e < 16; ++e) o[e] = 0.f;
#pragma unroll
            for (int i = 0; i < 5; ++i) {
                s16x4 lo[2], hi[2];
#pragma unroll
                for (int s2 = 0; s2 < 2; ++s2) { const unsigned a = vbase + (unsigned)((32 * i + 16 * s2) * RST + 64 * dt);
                    asm volatile("ds_read_b64_tr_b16 %0, %1" : "=&v"(lo[s2]) : "v"(a) : "memory");
                    asm volatile("ds_read_b64_tr_b16 %0, %1 offset:1152" : "=&v"(hi[s2]) : "v"(a) : "memory"); }
                asm volatile("s_waitcnt lgkmcnt(0)" ::: "memory"); __builtin_amdgcn_sched_barrier(0);
#pragma unroll
                for (int s2 = 0; s2 < 2; ++s2) { const bf16x8 vf = {lo[s2][0], lo[s2][1], lo[s2][2], lo[s2][3], hi[s2][0], hi[s2][1], hi[s2][2], hi[s2][3]}; o = MFMA32(vf, pf[i][s2], o); }
            }
#pragma unroll
            for (int gq = 0; gq < 4; ++gq) { const u32x2 w = {pkbf(o[4 * gq] * il, o[4 * gq + 1] * il), pkbf(o[4 * gq + 2] * il, o[4 * gq + 3] * il)}; *(u32x2*)(qp + 32 * dt + 8 * gq + 4 * h) = w; }
        }
        if (h == 0) LSE[((size_t)half * HT + rq) * 12 + head] = mx * 0.125f + __logf(l);
    }
}

__device__ __forceinline__ void dilmerge_phase(Frame& F, int half) {
    const bf16* P = (const bf16*)(F.ws + WS_BIG);
    const float* LSE = (const float*)(F.ws + WS_LSE);
    bf16* Y = (bf16*)F.out;
    const size_t gtid = (size_t)F.bid * NTHR + F.tid, gth = (size_t)F.G * NTHR;
    for (size_t it = gtid; it < (size_t)HT * 32; it += gth) {
        const size_t r = it >> 5; const int hh = (int)(it >> 3) & 3, d0 = (int)(it & 7) * 8;
        const size_t tok = (size_t)half * HT + r;
        const float l0 = LSE[tok * 12 + hh], l1 = LSE[tok * 12 + 4 + hh], l2 = LSE[tok * 12 + 8 + hh];
        const float m = fmaxf(l0, fmaxf(l1, l2));
        float w0 = __expf(l0 - m), w1 = __expf(l1 - m), w2 = __expf(l2 - m); const float iw = 1.0f / (w0 + w1 + w2); w0 *= iw; w1 *= iw; w2 *= iw;
        const bf16* op = P + r * NPROJ + PC_DQ + hh * 64 + d0;
        const u32x4 a = *(const u32x4*)op, b = *(const u32x4*)(op + 256), c = *(const u32x4*)(op + 512);
        u32x4 o;
        o.x = pkbf(w0 * bflo(a.x) + w1 * bflo(b.x) + w2 * bflo(c.x), w0 * bfhi(a.x) + w1 * bfhi(b.x) + w2 * bfhi(c.x));
        o.y = pkbf(w0 * bflo(a.y) + w1 * bflo(b.y) + w2 * bflo(c.y), w0 * bfhi(a.y) + w1 * bfhi(b.y) + w2 * bfhi(c.y));
        o.z = pkbf(w0 * bflo(a.z) + w1 * bflo(b.z) + w2 * bflo(c.z), w0 * bfhi(a.z) + w1 * bfhi(b.z) + w2 * bfhi(c.z));
        o.w = pkbf(w0 * bflo(a.w) + w1 * bflo(b.w) + w2 * bflo(c.w), w0 * bfhi(a.w) + w1 * bfhi(b.w) + w2 * bfhi(c.w));
        *(u32x4*)(Y + tok * YC + 1024 + hh * 64 + d0) = o;
    }
}

__device__ __forceinline__ void hn_phase(Frame& F) {
    const int gw = F.bid * NWAVES + F.wave, NGW = F.G * NWAVES;
    for (int m = gw; m < T; m += NGW) { f32x4 v[4]; rms_row_to_bf16(F.out + (size_t)m * DM, F.in[I_NFFNW], (bf16*)(F.ws + WS_ACT1) + (size_t)m * DM, F.lane, v); }
}


__device__ __forceinline__ float gelu_erf(float x) { return 0.5f * x * (1.0f + erff(x * 0.70710678118654752f)); }
__device__ __forceinline__ unsigned f2ord(float f) { const unsigned u = __builtin_bit_cast(unsigned, f); return u ^ ((unsigned)((int)u >> 31) | 0x80000000u); }
__device__ __forceinline__ float ord2f(unsigned k) { const unsigned m = (unsigned)((int)k >> 31); return __builtin_bit_cast(float, k ^ (0x80000000u | ~m)); }
#define CMPX(a, b) do { const unsigned _mx = max((a), (b)), _mn = min((a), (b)); (a) = _mx; (b) = _mn; } while (0)
__device__ __forceinline__ void bitonic_sort16_desc(unsigned (&v)[16]) {
#pragma unroll
    for (int k = 2; k <= 16; k <<= 1)
#pragma unroll
        for (int j = k >> 1; j > 0; j >>= 1)
#pragma unroll
            for (int i = 0; i < 16; ++i) { const int l = i ^ j; if (l > i) { if ((i & k) == 0) CMPX(v[i], v[l]); else CMPX(v[l], v[i]); } }
}
__device__ __forceinline__ void bitonic_merge16_desc(unsigned (&v)[16]) {
#pragma unroll
    for (int j = 8; j > 0; j >>= 1)
#pragma unroll
        for (int i = 0; i < 16; ++i) { const int l = i ^ j; if (l > i) CMPX(v[i], v[l]); }
}
__device__ __forceinline__ void top16_merge(unsigned (&a)[16], const unsigned (&b)[16]) {
#pragma unroll
    for (int i = 0; i < 16; ++i) a[i] = max(a[i], b[15 - i]);
    bitonic_merge16_desc(a);
}
constexpr int PK_ST = 272;
__device__ __forceinline__ void peer_topk_tile(Frame& F, size_t tok0, const bf16* Q, int* IDX, float* GATE) {
    const bf16* SK = (const bf16*)(F.ws + WS_SUBK);
    LAS unsigned char* sK = F.lds;
    int tid = F.tid; asm volatile("" : "+v"(tid));
    const int lane = tid & 63, wave = F.wave, ql = lane & 31, hh = lane >> 5;
    const size_t tok = tok0 + wave * 32 + ql;
    const bf16* qrow = Q + tok * PEER_Q + 8 * hh;
    __syncthreads();
#pragma unroll
    for (int j = 0; j < 4; ++j) { const int cidx = tid + 512 * j, row = cidx >> 4, ch = cidx & 15; *(LAS u32x4*)(sK + row * PK_ST + ch * 16) = *(const u32x4*)(SK + (size_t)row * 128 + ch * 8); }
    __syncthreads();
    unsigned k1[16];
    bf16x8 qf[8];
#pragma unroll
    for (int ks = 0; ks < 8; ++ks) qf[ks] = *(const bf16x8*)(qrow + 16 * ks);
#pragma unroll 1
    for (int hc = 0; hc < 16; ++hc) {
        LAS unsigned char* cur = sK + (hc & 1) * (128 * PK_ST); LAS unsigned char* nxt = sK + ((hc + 1) & 1) * (128 * PK_ST);
        u32x4 stg[4];
        const int hcn = (hc + 1) & 15;
#pragma unroll
        for (int j = 0; j < 4; ++j) { const int cidx = tid + 512 * j, row = cidx >> 4, ch = cidx & 15; stg[j] = *(const u32x4*)(SK + ((size_t)hcn * 128 + row) * 128 + ch * 8); }
        unsigned pk[4][16];
#pragma unroll
        for (int mt = 0; mt < 4; ++mt) {
            f32x16 acc;
#pragma unroll
            for (int e = 0; e < 16; ++e) acc[e] = 0.f;
#pragma unroll
            for (int ks = 0; ks < 8; ++ks) { const bf16x8 kf = *(const LAS bf16x8*)(cur + (32 * mt + ql) * PK_ST + 32 * ks + 16 * hh); acc = MFMA32(kf, qf[ks], acc); }
#pragma unroll
            for (int e = 0; e < 16; ++e) pk[mt][e] = (f2ord(acc[e]) & 0xFFFFFF80u) | (unsigned)(32 * mt + (e & 3) + 8 * (e >> 2) + 4 * hh);
        }
#pragma unroll
        for (int j = 0; j < 4; ++j) { const int cidx = tid + 512 * j, row = cidx >> 4, ch = cidx & 15; *(LAS u32x4*)(nxt + row * PK_ST + ch * 16) = stg[j]; }
        __syncthreads();
        __builtin_amdgcn_sched_barrier(0);
#pragma unroll
        for (int ks = 0; ks < 8; ++ks) qf[ks] = *(const bf16x8*)(qrow + hcn * 128 + 16 * ks);
        __builtin_amdgcn_sched_barrier(0);
#pragma unroll
        for (int mt = 0; mt < 4; ++mt) bitonic_sort16_desc(pk[mt]);
        top16_merge(pk[0], pk[1]); top16_merge(pk[2], pk[3]); top16_merge(pk[0], pk[2]);
        unsigned other[16];
#pragma unroll
        for (int i = 0; i < 16; ++i) other[i] = (unsigned)__shfl_xor((int)pk[0][i], 32);
        top16_merge(pk[0], other);
        if ((hc & 1) == 0) {
#pragma unroll
            for (int i = 0; i < 16; ++i) k1[i] = pk[0][i];
        } else {
            float f1[16], f2[16];
#pragma unroll
            for (int i = 0; i < 16; ++i) { f1[i] = ord2f(k1[i] & 0xFFFFFF80u); f2[i] = ord2f(pk[0][i] & 0xFFFFFF80u); }
            unsigned cd[4][16];
#pragma unroll
            for (int i = 0; i < 64; ++i) cd[i >> 4][i & 15] = 0u;
            int n = 0;
#pragma unroll
            for (int a = 0; a < 16; ++a)
#pragma unroll
                for (int b = 0; b < 16; ++b)
                    if ((a + 1) * (b + 1) <= 16) { cd[n >> 4][n & 15] = (f2ord(f1[a] + f2[b]) & 0xFFFFC000u) | ((k1[a] & 127u) << 7) | (pk[0][b] & 127u); ++n; }
#pragma unroll
            for (int g4 = 0; g4 < 4; ++g4) bitonic_sort16_desc(cd[g4]);
            top16_merge(cd[0], cd[1]); top16_merge(cd[2], cd[3]); top16_merge(cd[0], cd[2]);
            const float vmax = ord2f(cd[0][0] & 0xFFFFC000u);
            float ex[16], den = 0.f;
#pragma unroll
            for (int i = 0; i < 16; ++i) { ex[i] = __expf(ord2f(cd[0][i] & 0xFFFFC000u) - vmax); den += ex[i]; }
            const float iden = 1.0f / den;
            const int h = hc >> 1;
            if (hh == 0) { int* ip = IDX + tok * 128 + h * 16;
#pragma unroll
                for (int i = 0; i < 4; ++i) { const u32x4 w = {cd[0][4 * i] & 0x3FFFu, cd[0][4 * i + 1] & 0x3FFFu, cd[0][4 * i + 2] & 0x3FFFu, cd[0][4 * i + 3] & 0x3FFFu}; *(u32x4*)(ip + 4 * i) = w; } }
            else { float* gp = GATE + tok * 128 + h * 16;
#pragma unroll
                for (int i = 0; i < 4; ++i) { const f32x4 w = {ex[4 * i] * iden, ex[4 * i + 1] * iden, ex[4 * i + 2] * iden, ex[4 * i + 3] * iden}; *(f32x4*)(gp + 4 * i) = w; } }
        }
    }
}

struct PeerDeal { size_t tokw; int ntok; size_t tok0; float* PART; const int* IDX; const float* GATE; float* COEF; };
__device__ __forceinline__ void peer_item(int n, const PeerDeal& D, int wave, int& slice, size_t& tok) { slice = n >> 5; tok = D.tokw + (n & 31); }
__device__ __forceinline__ void peer_down_rows(u32x4 (&R)[16], __amdgpu_buffer_rsrc_t tab, int slice, int id0, int id1, int lane) {
    const int soff = slice * (16384 * 128);
    const int r = lane & 15, g = lane >> 4, e8 = (r >> 2) + 4 * (g >> 1), q = 4 * (g & 1) + (r & 3);
    const int src0 = 16 * (e8 & 3);
#pragma unroll
    for (int k = 0; k < 16; ++k) { const int v0 = __shfl(id0, src0 + k), v1 = __shfl(id1, src0 + k); const int id = (e8 < 4) ? v0 : v1;
        R[k] = __builtin_amdgcn_raw_buffer_load_b128(tab, (id << 7) + 16 * q, soff, 0); }
}
__device__ __forceinline__ void peer_down_hn(u32x4 (&H)[2], const bf16* HN, int slice, size_t tok, int lane) {
    const bf16* hp = HN + tok * DM + slice * 128 + 16 * (4 * ((lane >> 4) & 1) + (lane & 3));
    H[0] = *(const u32x4*)hp; H[1] = *(const u32x4*)(hp + 8);
}
__device__ __forceinline__ void peer_down_bq(long (&bq)[2], const u32x4 (&H)[2], int lane) {
    const int c = lane & 15, g = lane >> 4; const bool on = (c < 8) && ((c >> 2) == (g >> 1));
    const u32x4 x0 = H[0], x1 = H[1];
    unsigned p0 = __builtin_amdgcn_cvt_pk_fp8_f32(bflo(x0.x), bfhi(x0.x), 0, false); p0 = __builtin_amdgcn_cvt_pk_fp8_f32(bflo(x0.y), bfhi(x0.y), p0, true);
    unsigned p1 = __builtin_amdgcn_cvt_pk_fp8_f32(bflo(x0.z), bfhi(x0.z), 0, false); p1 = __builtin_amdgcn_cvt_pk_fp8_f32(bflo(x0.w), bfhi(x0.w), p1, true);
    unsigned p2 = __builtin_amdgcn_cvt_pk_fp8_f32(bflo(x1.x), bfhi(x1.x), 0, false); p2 = __builtin_amdgcn_cvt_pk_fp8_f32(bflo(x1.y), bfhi(x1.y), p2, true);
    unsigned p3 = __builtin_amdgcn_cvt_pk_fp8_f32(bflo(x1.z), bfhi(x1.z), 0, false); p3 = __builtin_amdgcn_cvt_pk_fp8_f32(bflo(x1.w), bfhi(x1.w), p3, true);
    if (!on) { p0 = 0u; p1 = 0u; p2 = 0u; p3 = 0u; }
    bq[0] = (long)(((unsigned long long)p1 << 32) | p0); bq[1] = (long)(((unsigned long long)p3 << 32) | p2);
}
__device__ __forceinline__ void peer_down_mfma(const u32x4 (&R)[16], const long (&bq)[2], __amdgpu_buffer_rsrc_t prsrc, int slice, int tokl, int lane) {
    const int c = lane & 15, g = lane >> 4, cb = c & 3;
    float dv[16];
#pragma unroll
    for (int k = 0; k < 16; ++k) { f32x4 acc = {0.f, 0.f, 0.f, 0.f}; const u32x4 v = R[k];
        acc = __builtin_amdgcn_mfma_f32_16x16x32_fp8_fp8((long)(((unsigned long long)v.y << 32) | v.x), bq[0], acc, 0, 0, 0);
        acc = __builtin_amdgcn_mfma_f32_16x16x32_fp8_fp8((long)(((unsigned long long)v.w << 32) | v.z), bq[1], acc, 0, 0, 0);
        float t = (cb == 0) ? acc.x : (cb == 1) ? acc.y : (cb == 2) ? acc.z : acc.w;
        t += __shfl_xor(t, 1); t += __shfl_xor(t, 2); dv[k] = t; }
    const unsigned off = ((c & 3) == 0 && c < 8) ? (unsigned)(((tokl * 8 + slice) * 128 + 16 * (g + 4 * (c >> 2))) * 4) : 0xFFFFFF00u;
#pragma unroll
    for (int i = 0; i < 4; ++i) { const f32x4 w = {dv[4 * i], dv[4 * i + 1], dv[4 * i + 2], dv[4 * i + 3]}; __builtin_amdgcn_raw_buffer_store_b128(__builtin_bit_cast(u32x4, w), prsrc, off, 16 * i, 0); }
}
__device__ __forceinline__ void peer_down_phase(Frame& F, const PeerDeal& D) {
    const __amdgpu_buffer_rsrc_t PD = __builtin_amdgcn_make_buffer_rsrc((void*)(F.ws + WS_PD), 0, 16384 * 1024, 0x00020000); const bf16* HN = (const bf16*)(F.ws + WS_ACT1);
    const int* IDX = D.IDX;
    const __amdgpu_buffer_rsrc_t prsrc = __builtin_amdgcn_make_buffer_rsrc((void*)D.PART, 0, 256 * 8 * 128 * 4, 0x00020000);
    int lane = F.lane; asm volatile("" : "+v"(lane));
    const int wave = F.wave;
    const int ntok = D.ntok;
    u32x4 RA[16], RB[16], HA[2], HB[2]; int ia0, ia1, ib0, ib1; long bq[2];
#define PEER_TOK(k, sv, tv) int sv; size_t tv; peer_item((k) < ntok ? (k) : ntok - 2 + ((k) & 1), D, wave, sv, tv)
    { PEER_TOK(0, s0, t0); PEER_TOK(1, s1, t1); PEER_TOK(2, s2, t2); PEER_TOK(3, s3, t3);
      const int a0 = IDX[t0 * 128 + lane], a1 = IDX[t0 * 128 + 64 + lane], b0 = IDX[t1 * 128 + lane], b1 = IDX[t1 * 128 + 64 + lane];
      ia0 = IDX[t2 * 128 + lane]; ia1 = IDX[t2 * 128 + 64 + lane]; ib0 = IDX[t3 * 128 + lane]; ib1 = IDX[t3 * 128 + 64 + lane];
      __builtin_amdgcn_sched_barrier(0);
      peer_down_rows(RA, PD, s0, a0, a1, lane); peer_down_hn(HA, HN, s0, t0, lane);
      __builtin_amdgcn_sched_barrier(0);
      peer_down_rows(RB, PD, s1, b0, b1, lane); peer_down_hn(HB, HN, s1, t1, lane);
      __builtin_amdgcn_sched_barrier(0); }
#pragma unroll 1
    for (int n = 0; n < ntok; n += 2) {
        PEER_TOK(n, s0, t0); PEER_TOK(n + 1, s1, t1); PEER_TOK(n + 2, s2, t2); PEER_TOK(n + 3, s3, t3); PEER_TOK(n + 4, s4, t4); PEER_TOK(n + 5, s5, t5);
        peer_down_bq(bq, HA, lane);
        peer_down_mfma(RA, bq, prsrc, s0, (int)(t0 - D.tok0), lane);
        __builtin_amdgcn_sched_barrier(0);
        { const int j0 = IDX[t4 * 128 + lane], j1 = IDX[t4 * 128 + 64 + lane];
          peer_down_rows(RA, PD, s2, ia0, ia1, lane); peer_down_hn(HA, HN, s2, t2, lane); ia0 = j0; ia1 = j1; }
        __builtin_amdgcn_sched_barrier(0);
        peer_down_bq(bq, HB, lane);
        peer_down_mfma(RB, bq, prsrc, s1, (int)(t1 - D.tok0), lane);
        __builtin_amdgcn_sched_barrier(0);
        { const int j0 = IDX[t5 * 128 + lane], j1 = IDX[t5 * 128 + 64 + lane];
          peer_down_rows(RB, PD, s3, ib0, ib1, lane); peer_down_hn(HB, HN, s3, t3, lane); ib0 = j0; ib1 = j1; }
        __builtin_amdgcn_sched_barrier(0);
    }
#undef PEER_TOK
}
__device__ __forceinline__ void peer_coef_wave(Frame& F, const PeerDeal& D) {
    for (int k = F.lane; k < 32 * 32; k += 64) {
        const int tl = (int)(D.tokw - D.tok0) + (k >> 5), slot = 4 * (k & 31);
        const float* pp = D.PART + (size_t)tl * 1024 + slot;
        f32x4 sm = *(const f32x4*)pp;
#pragma unroll
        for (int x = 1; x < 8; ++x) sm += *(const f32x4*)(pp + 128 * x);
        const size_t i = (D.tok0 + tl) * 128 + slot;
        const f32x4 gt = *(const f32x4*)(D.GATE + i);
        const f32x4 o = {gt.x * gelu_erf(sm.x * (1.0f / PD_SCALE)) * (1.0f / PU_SCALE), gt.y * gelu_erf(sm.y * (1.0f / PD_SCALE)) * (1.0f / PU_SCALE),
                         gt.z * gelu_erf(sm.z * (1.0f / PD_SCALE)) * (1.0f / PU_SCALE), gt.w * gelu_erf(sm.w * (1.0f / PD_SCALE)) * (1.0f / PU_SCALE)};
        *(f32x4*)(D.COEF + i) = o;
    }
}
__device__ __forceinline__ void peer_up_rows(u32x4 (&R)[16], __amdgpu_buffer_rsrc_t tab, int slice, int id0, int id1, int lane) {
    const int soff = slice * (16384 * 128);
#pragma unroll
    for (int s8 = 0; s8 < 8; ++s8) { const int id = __shfl(s8 < 4 ? id0 : id1, (16 * s8 + (lane >> 2)) & 63); const int vo = (id << 7) + 16 * (lane & 3);
        R[2 * s8] = __builtin_amdgcn_raw_buffer_load_b128(tab, vo, soff, 0); R[2 * s8 + 1] = __builtin_amdgcn_raw_buffer_load_b128(tab, vo, soff + 64, 0); }
}
__device__ __forceinline__ void peer_up_compute(const u32x4 (&R)[16], float c0, float c1, f32x2 h, float* out, int slice, size_t tok, int lane) {
    f32x2 acc[16];
#pragma unroll
    for (int k = 0; k < 16; ++k) acc[k] = (f32x2){0.f, 0.f};
#pragma unroll
    for (int s8 = 0; s8 < 8; ++s8) { const float c = __shfl(s8 < 4 ? c0 : c1, (16 * s8 + (lane >> 2)) & 63); f32x2 c2 = {c, c}; asm volatile("" : "+v"(c2));
#pragma unroll
        for (int hf = 0; hf < 2; ++hf) { const u32x4 r = R[2 * s8 + hf];
            acc[8 * hf + 0] = c2 * __builtin_amdgcn_cvt_pk_f32_fp8(r.x, false) + acc[8 * hf + 0]; acc[8 * hf + 1] = c2 * __builtin_amdgcn_cvt_pk_f32_fp8(r.x, true) + acc[8 * hf + 1];
            acc[8 * hf + 2] = c2 * __builtin_amdgcn_cvt_pk_f32_fp8(r.y, false) + acc[8 * hf + 2]; acc[8 * hf + 3] = c2 * __builtin_amdgcn_cvt_pk_f32_fp8(r.y, true) + acc[8 * hf + 3];
            acc[8 * hf + 4] = c2 * __builtin_amdgcn_cvt_pk_f32_fp8(r.z, false) + acc[8 * hf + 4]; acc[8 * hf + 5] = c2 * __builtin_amdgcn_cvt_pk_f32_fp8(r.z, true) + acc[8 * hf + 5];
            acc[8 * hf + 6] = c2 * __builtin_amdgcn_cvt_pk_f32_fp8(r.w, false) + acc[8 * hf + 6]; acc[8 * hf + 7] = c2 * __builtin_amdgcn_cvt_pk_f32_fp8(r.w, true) + acc[8 * hf + 7]; } }
    f32x2 r8[8], r4[4], r2[2], r1;
    { const bool up = (lane & 32) != 0;
#pragma unroll
      for (int k = 0; k < 8; ++k) { const f32x2 keep = up ? acc[k + 8] : acc[k], send = up ? acc[k] : acc[k + 8]; r8[k] = keep + (f32x2){__shfl_xor(send.x, 32), __shfl_xor(send.y, 32)}; } }
    { const bool up = (lane & 16) != 0;
#pragma unroll
      for (int k = 0; k < 4; ++k) { const f32x2 keep = up ? r8[k + 4] : r8[k], send = up ? r8[k] : r8[k + 4]; r4[k] = keep + (f32x2){__shfl_xor(send.x, 16), __shfl_xor(send.y, 16)}; } }
    { const bool up = (lane & 8) != 0;
#pragma unroll
      for (int k = 0; k < 2; ++k) { const f32x2 keep = up ? r4[k + 2] : r4[k], send = up ? r4[k] : r4[k + 2]; r2[k] = keep + (f32x2){__shfl_xor(send.x, 8), __shfl_xor(send.y, 8)}; } }
    { const bool up = (lane & 4) != 0; const f32x2 keep = up ? r2[1] : r2[0], send = up ? r2[0] : r2[1]; r1 = keep + (f32x2){__shfl_xor(send.x, 4), __shfl_xor(send.y, 4)}; }
    const int p = ((lane >> 5) & 1) * 8 + ((lane >> 4) & 1) * 4 + ((lane >> 3) & 1) * 2 + ((lane >> 2) & 1);
    *(f32x2*)(out + tok * DM + slice * 128 + 16 * (lane & 3) + 2 * (p & 7) + 64 * (p >> 3)) = h + r1;
}
__device__ __forceinline__ void peer_up_phase(Frame& F, const PeerDeal& D, float* outp) {
    const __amdgpu_buffer_rsrc_t PU = __builtin_amdgcn_make_buffer_rsrc((void*)(F.ws + WS_PU), 0, 16384 * 1024, 0x00020000);
    const int* IDX = D.IDX; const float* COEF = D.COEF;
    int lane = F.lane; asm volatile("" : "+v"(lane));
    const int wave = F.wave;
    const int ntok = D.ntok;
    const int p = ((lane >> 5) & 1) * 8 + ((lane >> 4) & 1) * 4 + ((lane >> 3) & 1) * 2 + ((lane >> 2) & 1);
    const int hoff = 16 * (lane & 3) + 2 * (p & 7) + 64 * (p >> 3);
    int sl; size_t tk;
    u32x4 R0[16], R1[16];
    float ca0, ca1, cb0, cb1; f32x2 ha, hb;
    int id0, id1, jd0, jd1;
    { int s1_; size_t t1_; peer_item(0, D, wave, sl, tk); peer_item(1, D, wave, s1_, t1_);
      jd0 = IDX[tk * 128 + lane]; jd1 = IDX[tk * 128 + 64 + lane]; id0 = IDX[t1_ * 128 + lane]; id1 = IDX[t1_ * 128 + 64 + lane];
      __builtin_amdgcn_sched_barrier(0);
      peer_up_rows(R0, PU, sl, jd0, jd1, lane);
      ca0 = COEF[tk * 128 + lane]; ca1 = COEF[tk * 128 + 64 + lane]; ha = *(const f32x2*)(F.out + tk * DM + sl * 128 + hoff);
      __builtin_amdgcn_sched_barrier(0); }
#pragma unroll 1
    for (int n = 0; n < ntok; n += 2) {
        int s0, s1, s2, s3; size_t t0, t1, t2, t3;
        peer_item(n, D, wave, s0, t0); peer_item(n + 1, D, wave, s1, t1);
        peer_item(n + 2 < ntok ? n + 2 : n, D, wave, s2, t2); peer_item(n + 3 < ntok ? n + 3 : n + 1, D, wave, s3, t3);
        jd0 = IDX[t2 * 128 + lane]; jd1 = IDX[t2 * 128 + 64 + lane];
        peer_up_rows(R1, PU, s1, id0, id1, lane);
        cb0 = COEF[t1 * 128 + lane]; cb1 = COEF[t1 * 128 + 64 + lane]; hb = *(const f32x2*)(F.out + t1 * DM + s1 * 128 + hoff);
        __builtin_amdgcn_sched_barrier(0);
        peer_up_compute(R0, ca0, ca1, ha, outp, s0, t0, lane);
        __builtin_amdgcn_sched_barrier(0);
        id0 = IDX[t3 * 128 + lane]; id1 = IDX[t3 * 128 + 64 + lane];
        peer_up_rows(R0, PU, s2, jd0, jd1, lane);
        ca0 = COEF[t2 * 128 + lane]; ca1 = COEF[t2 * 128 + 64 + lane]; ha = *(const f32x2*)(F.out + t2 * DM + s2 * 128 + hoff);
        __builtin_amdgcn_sched_barrier(0);
        peer_up_compute(R1, cb0, cb1, hb, outp, s1, t1, lane);
        __builtin_amdgcn_sched_barrier(0);
    }
}
__device__ __forceinline__ void peer_tile(Frame& F, int tile) {
    const size_t tok0 = (size_t)tile * 256;
    const bf16* Q = (const bf16*)(F.ws + WS_BIG);
    int* IDX = (int*)(F.ws + WS_BIG + 256 * MiB); float* GATE = (float*)(F.ws + WS_BIG + 288 * MiB); float* COEF = (float*)(F.ws + WS_BIG + 320 * MiB);
    peer_topk_tile(F, tok0, Q, IDX, GATE);
    VM_WAIT(); __syncthreads();
    PeerDeal D; D.tokw = tok0 + F.wave * 32; D.ntok = 256; D.tok0 = tok0; D.PART = (float*)(F.ws + WS_BIG + tok0 * (PEER_Q * 2)); D.IDX = IDX; D.GATE = GATE; D.COEF = COEF;
    peer_down_phase(F, D);
    VM_WAIT(); __syncthreads();
    peer_coef_wave(F, D);
    VM_WAIT(); __syncthreads();
    peer_up_phase(F, D, F.out);
}
__device__ __forceinline__ void peer_phase(Frame& F) { for (int tile = F.bid; tile < T / 256; tile += F.G) { peer_tile(F, tile); VM_WAIT(); __syncthreads(); } }

constexpr int N_PHASES = 15;
__global__ void __launch_bounds__(NTHR, 2) mega_fwd(Args args) {
    extern __shared__ __attribute__((aligned(16))) unsigned char lds_raw[];
    Frame F;
    F.lds = (LAS unsigned char*)lds_raw;
    F.tid = threadIdx.x; F.lane = F.tid & 63; F.wave = __builtin_amdgcn_readfirstlane(F.tid >> 6);
    F.G = gridDim.x; F.bid = blockIdx.x;
    F.in = args.in;
    F.positions = args.positions; F.out = args.out; F.ws = args.ws;
    unsigned char* ws = args.ws;
    volatile LAS unsigned* ctlw = (volatile LAS unsigned*)(F.lds + LDSCTL_OFF);
    if (F.tid < 64) ctlw[F.tid] = 0u;
    __syncthreads();
    const int lo = args.ph_lo, hi = args.ph_hi;
    XcdBarrier bar; bar.bar = (unsigned*)(ws + WS_CTL); bar.x = 0; bar.st = nullptr; bar.wave = F.wave;
    if (hi - lo > 1) bar = xcd_barrier_post((unsigned*)(ws + WS_CTL), ctlw + 8, F.wave);
#define IN(k) (lo <= (k) && (k) < hi)
#define SEAM(k) do { if (IN(k) && IN((k) + 1)) xcd_barrier(bar); } while (0)
    bf16* ACT1 = (bf16*)(ws + WS_ACT1); bf16* BIG = (bf16*)(ws + WS_BIG); bf16* WallT = (bf16*)(ws + WS_WALLT);

    if (IN(0)) { frame_refresh(F); p0_prologue(F); __syncthreads(); }
    SEAM(0);
    if (IN(1)) { frame_refresh(F);
        { pg8::Gemm g{(const bf16*)(ws + WS_MEMN), (const bf16*)(ws + WS_WMKVT), NB * NMEM, 768, DM, DM, DM}; pg8::StaticOrder S; S.init(g.M, g.N, F.G, F.bid);
          pg8::EpiBf16<0> E{(bf16*)(ws + WS_MKV), 1536}; pg8::gemm_phase(F.lds, g, S, E, F.wave); }
        { pg8::Gemm g{(const bf16*)(ws + WS_WMKVT) + (size_t)768 * DM, (const bf16*)(ws + WS_MEMN), 768, NB * NMEM, DM, DM, DM}; pg8::StaticOrder S; S.init(g.M, g.N, F.G, F.G - 1 - F.bid);
          pg8::EpiBf16<0> E{(bf16*)(ws + WS_MVT), NB * NMEM}; pg8::gemm_phase(F.lds, g, S, E, F.wave); }
        { pg8::Gemm g{ACT1, WallT, HT, NPROJ, DM, DM, DM}; pg8::StaticOrder S; S.init(g.M, g.N, F.G, F.bid);
          pg8::EpiBf16<0> E{BIG, NPROJ}; pg8::gemm_phase(F.lds, g, S, E, F.wave); }
    }
    SEAM(1);
    if (IN(2)) { frame_refresh(F); qkprep_phase(F, 0); ssdC_phase(F, 0); }
    SEAM(2);
    if (IN(3)) { frame_refresh(F); ssdD_phase(F); dilattn_mfma_phase(F, 0); memattn_mfma_phase(F, 0); }
    SEAM(3);
    if (IN(4)) { frame_refresh(F); ssdE_phase(F, 0); dilmerge_phase(F, 0); }
    SEAM(4);
    if (IN(5)) { frame_refresh(F); pg8::Gemm g{ACT1 + (size_t)HT * DM, WallT, HT, NPROJ, DM, DM, DM}; pg8::StaticOrder S; S.init(g.M, g.N, F.G, F.bid);
        pg8::EpiBf16<0> E{BIG, NPROJ}; pg8::gemm_phase(F.lds, g, S, E, F.wave); }
    SEAM(5);
    if (IN(6)) { frame_refresh(F); qkprep_phase(F, 1); ssdC_phase(F, 1); }
    SEAM(6);
    if (IN(7)) { frame_refresh(F); ssdD_phase(F); dilattn_mfma_phase(F, 1); memattn_mfma_phase(F, 1); }
    SEAM(7);
    if (IN(8)) { frame_refresh(F); ssdE_phase(F, 1); dilmerge_phase(F, 1); }
    SEAM(8);
    if (IN(9)) { frame_refresh(F); pg8::Gemm g{ACT1, WallT + (size_t)NPROJ * DM, T, NGATE, DM, DM, DM}; pg8::StaticOrder S; S.init(g.M, g.N, F.G, F.bid);
        pg8::EpiBf16<1> E{BIG, NGATE}; pg8::gemm_phase(F.lds, g, S, E, F.wave); }
    SEAM(9);
    if (IN(10)) { frame_refresh(F);
        pg8::Gemm g{(const bf16*)F.out, (const bf16*)(ws + WS_WCATT), T, DM, YC, YC, YC}; pg8::StaticOrder S; S.init(g.M, g.N, F.G, F.bid);
        pg8::EpiBranchFused E{ACT1, DM, __builtin_amdgcn_make_buffer_rsrc((void*)BIG, 0, T * NGATE * 2, 0x00020000), NGATE}; pg8::gemm_phase(F.lds, g, S, E, F.wave);
    }
    SEAM(10);
    if (IN(11)) { frame_refresh(F); pg8::Gemm g{ACT1, (const bf16*)(ws + WS_WOUTT), T, DM, DM, DM, DM}; pg8::StaticOrder S; S.init(g.M, g.N, F.G, F.bid);
        pg8::EpiResid E{F.out, DM, F.in[I_X]}; pg8::gemm_phase(F.lds, g, S, E, F.wave); }
    SEAM(11);
    if (IN(12)) { frame_refresh(F); hn_phase(F); }
    SEAM(12);
    if (IN(13)) { frame_refresh(F); pg8::Gemm g{ACT1, (const bf16*)(ws + WS_WQT), T, PEER_Q, DM, DM, DM}; pg8::StaticOrder S; S.init(g.M, g.N, F.G, F.bid);
        pg8::EpiBf16<0> E{BIG, PEER_Q}; pg8::gemm_phase(F.lds, g, S, E, F.wave); }
    SEAM(13);
    if (IN(14)) { frame_refresh(F); peer_phase(F); }
#undef IN
#undef SEAM
}

extern "C" void kernel_launch(void* const* d_in, const int* in_sizes, int n_in, void* d_out, int out_size, void* d_ws, size_t ws_size, hipStream_t stream) {
    static int grid = 0;
    if (grid == 0) {
        if (n_in != 26 || out_size != T * DM || ws_size < WS_END) { fprintf(stderr, "kernel_launch: unexpected shapes (n_in %d, out %d, ws %zu)\n", n_in, out_size, ws_size); grid = -1; return; }
        int dev = 0, cus = 0;
        if (hipGetDevice(&dev) != hipSuccess || hipDeviceGetAttribute(&cus, hipDeviceAttributeMultiprocessorCount, dev) != hipSuccess) { grid = -1; return; }
        if (hipFuncSetAttribute((const void*)mega_fwd, hipFuncAttributeMaxDynamicSharedMemorySize, LDS_BYTES) != hipSuccess) { grid = -1; return; }
        int per_cu = 0;
        (void)hipOccupancyMaxActiveBlocksPerMultiprocessor(&per_cu, (const void*)mega_fwd, NTHR, LDS_BYTES);
        (void)hipGetLastError();
        grid = cus;
    }
    if (grid < 0) return;
    (void)hipMemsetAsync((char*)d_ws + WS_CTL, 0, CTL_ZERO_BYTES, stream);
    Args a{};
    for (int i = 0; i < 26; ++i) a.in[i] = (const float*)d_in[i];
    a.positions = (const int*)d_in[2]; a.out = (float*)d_out; a.ws = (unsigned char*)d_ws;
#if MK_N_LAUNCHES == 1
    a.ph_lo = 0; a.ph_hi = N_PHASES;
    hipLaunchKernelGGL(mega_fwd, dim3(grid), dim3(NTHR), LDS_BYTES, stream, a);
#else
    for (int p = 0; p < N_PHASES; ++p) { a.ph_lo = p; a.ph_hi = p + 1; hipLaunchKernelGGL(mega_fwd, dim3(grid), dim3(NTHR), LDS_BYTES, stream, a); }
#endif
}
```

```cpp
#include <hip/hip_runtime.h>
#include <cstdio>
#include <cstdint>

#ifndef MK_N_LAUNCHES
#define MK_N_LAUNCHES 1
#endif

#define LAS __attribute__((address_space(3)))
#define GAS __attribute__((address_space(1)))
typedef unsigned short bf16;
typedef short bf16x8 __attribute__((ext_vector_type(8)));
typedef float f32x4 __attribute__((ext_vector_type(4)));
typedef float f32x2 __attribute__((ext_vector_type(2)));
typedef unsigned u32x4 __attribute__((ext_vector_type(4)));
typedef unsigned u32x2 __attribute__((ext_vector_type(2)));

constexpr int NB = 8, SEQ = 8192, DM = 1024, T = NB * SEQ;
constexpr int HB = 4, HT = HB * SEQ;
constexpr int NMEM = 256;
constexpr int NPROJ = 6144;
constexpr int PC_Z = 0, PC_X = 1024, PC_B = 2048, PC_C = 2560, PC_DQ = 3072, PC_DK = 3840, PC_DV = 4608, PC_MQ = 5376;
constexpr int W_IN_N = 9232, OFF_DT = 3072, OFF_AFTER_DT = 3088;
constexpr int NGATE = 3072;
constexpr int YC = 2048;
constexpr int PEER_H = 8, PEER_K = 16, PEER_NK = 128, PEER_Q = 2048;
constexpr float EPS = 1e-6f;

constexpr size_t MiB = 1u << 20;
constexpr size_t WS_CTL = 0, CTL_ZERO_BYTES = 65536;
constexpr size_t WS_WALLT = 1 * MiB;
constexpr size_t WS_WMKVT = 19 * MiB;
constexpr size_t WS_WCATT = 22 * MiB;
constexpr size_t WS_WOUTT = 26 * MiB;
constexpr size_t WS_WQT = 28 * MiB;
constexpr size_t WS_SUBK = 32 * MiB;
constexpr size_t WS_PD = 33 * MiB;
constexpr size_t WS_PU = 65 * MiB;
constexpr size_t WS_DT = 97 * MiB;
constexpr size_t WS_MEMN = 101 * MiB;
constexpr size_t WS_MKV = 105 * MiB;
constexpr size_t WS_ACT1 = 112 * MiB;
constexpr size_t WS_BIG = 240 * MiB;
constexpr size_t WS_LSE = 624 * MiB;
constexpr size_t WS_MVT = 628 * MiB;
constexpr size_t WS_DEC = 631 * MiB;
constexpr size_t WS_SST = 632 * MiB;
constexpr size_t WS_SIN = 760 * MiB;
constexpr size_t WS_ROPE = 824 * MiB;
constexpr size_t WS_END = 828 * MiB;

constexpr int RING_BYTES = 131072;
constexpr int LDSCTL_OFF = 143360;
constexpr int LDS_BYTES = 147456;
constexpr int NWAVES = 8, NTHR = 512;

__device__ __forceinline__ int lane_id() { return (int)__builtin_amdgcn_mbcnt_hi(~0u, __builtin_amdgcn_mbcnt_lo(~0u, 0u)); }
__device__ __forceinline__ float bf2f(unsigned short b) { return __builtin_bit_cast(float, (unsigned)b << 16); }
__device__ __forceinline__ float bflo(unsigned w) { return __builtin_bit_cast(float, w << 16); }
__device__ __forceinline__ float bfhi(unsigned w) { return __builtin_bit_cast(float, w & 0xffff0000u); }
__device__ __forceinline__ unsigned f2bf(float f) { unsigned u = __builtin_bit_cast(unsigned, f); return (u + 0x7fffu + ((u >> 16) & 1u)) >> 16; }
__device__ __forceinline__ unsigned pk2(float lo, float hi) { return f2bf(lo) | (f2bf(hi) << 16); }
typedef float f32x16 __attribute__((ext_vector_type(16)));
typedef short s16x4 __attribute__((ext_vector_type(4)));
typedef __bf16 bf2_t __attribute__((ext_vector_type(2)));
__device__ __forceinline__ unsigned pkbf(float a, float b) { const f32x2 v = {a, b}; return __builtin_bit_cast(unsigned, __builtin_convertvector(v, bf2_t)); }
#define MFMA32(a, b, c) __builtin_amdgcn_mfma_f32_32x32x16_bf16((a), (b), (c), 0, 0, 0)
__device__ __forceinline__ float wave_sum(float v) {
#pragma unroll
    for (int o = 1; o < 64; o <<= 1) v += __shfl_xor(v, o);
    return v;
}
__device__ __forceinline__ float wave_max(float v) {
#pragma unroll
    for (int o = 1; o < 64; o <<= 1) v = fmaxf(v, __shfl_xor(v, o));
    return v;
}
__device__ __forceinline__ float sigmoidf_(float x) { return 1.0f / (1.0f + __expf(-x)); }
#define LDS_WAIT() asm volatile("s_waitcnt lgkmcnt(0)" ::: "memory")
#define VM_WAIT() asm volatile("s_waitcnt vmcnt(0)" ::: "memory")

#define XB_TMO      128
#define XB_XCNT(j)  (256  + 64 * (j))
#define XB_XSUB(j)  (1280 + 64 * (j))
#define XB_XGEN(j)  (2304 + 64 * (j))
#define XB_TOP      3328
#define XB_TOPGEN   3392
#define XCD_BAR_WORDS 3456
#define XB_SPIN_CAP (1u << 18)
__device__ __forceinline__ unsigned xb_ld(unsigned* p)              { return __hip_atomic_load(p, __ATOMIC_RELAXED, __HIP_MEMORY_SCOPE_AGENT); }
__device__ __forceinline__ unsigned xb_add(unsigned* p, unsigned v) { return __hip_atomic_fetch_add(p, v, __ATOMIC_RELAXED, __HIP_MEMORY_SCOPE_AGENT); }
__device__ __forceinline__ unsigned xb_xcc_id() { return (unsigned)__builtin_amdgcn_s_getreg((3 << 11) | 20) & 0xFu; }
#define XB_SPIN(cond, bar) do { unsigned _sp = 0; while (cond) { __builtin_amdgcn_s_sleep(1); \
    if ((++_sp & 255u) == 0u) { if (xb_ld(&(bar)[XB_TMO])) break; if (_sp > XB_SPIN_CAP) { atomicAdd(&(bar)[XB_TMO], 1u); break; } } } } while (0)
struct XcdBarrier { unsigned* bar; unsigned x; volatile LAS unsigned* st; int wave; };
__device__ __forceinline__ XcdBarrier xcd_barrier_post(unsigned* bar, volatile LAS unsigned* st, int wave) {
    XcdBarrier b; b.bar = bar; b.x = xb_xcc_id(); b.st = st; b.wave = wave;
    if (wave == 0 && lane_id() == 0) (void)xb_add(&bar[XB_XCNT(b.x)], 1u);
    return b;
}
__device__ __forceinline__ void xcd_barrier_complete(unsigned* bar, unsigned x, unsigned& nloc, unsigned& nx) {
    const unsigned G = gridDim.x * gridDim.y * gridDim.z;
    unsigned sum, cnt, mine, sp = 0u;
    for (;;) {
        sum = 0u; cnt = 0u; mine = 0u;
#pragma unroll
        for (unsigned j = 0; j < 16; ++j) { const unsigned c = xb_ld(&bar[XB_XCNT(j)]); sum += c; cnt += (c > 0u) ? 1u : 0u; mine = (j == x) ? c : mine; }
        if (sum == G) break;
        __builtin_amdgcn_s_sleep(1);
        if ((++sp & 255u) == 0u) { if (xb_ld(&bar[XB_TMO])) break; if (sp > XB_SPIN_CAP) { atomicAdd(&bar[XB_TMO], 1u); break; } }
    }
    nloc = mine > 0u ? mine : 1u; nx = cnt > 0u ? cnt : 1u;
}
__device__ __forceinline__ void xcd_barrier(const XcdBarrier& b) {
    asm volatile("s_waitcnt vmcnt(0)" ::: "memory");
    __syncthreads();
    if (b.wave == 0 && lane_id() == 0) {
        unsigned* bar = b.bar;
        __builtin_amdgcn_s_waitcnt(0);
        unsigned nloc = b.st[0], nx = b.st[1];
        if (nloc == 0u) { xcd_barrier_complete(bar, b.x, nloc, nx); b.st[0] = nloc; b.st[1] = nx; }
        const unsigned old = xb_add(&bar[XB_XSUB(b.x)], 1u);
        const unsigned gen = old / nloc;
        if (old + 1u == (gen + 1u) * nloc) {
            __builtin_amdgcn_fence(__ATOMIC_RELEASE, "agent");
            asm volatile("s_waitcnt vmcnt(0)" ::: "memory");
            const unsigned og = xb_add(&bar[XB_TOP], 1u);
            const unsigned tg = og / nx;
            if (og + 1u == (tg + 1u) * nx) xb_add(&bar[XB_TOPGEN], 1u);
            else XB_SPIN(xb_ld(&bar[XB_TOPGEN]) == tg, bar);
            __builtin_amdgcn_fence(__ATOMIC_ACQUIRE, "agent");
            xb_add(&bar[XB_XGEN(b.x)], 1u);
            asm volatile("s_waitcnt vmcnt(0)" ::: "memory");
        } else {
            XB_SPIN(xb_ld(&bar[XB_XGEN(b.x)]) == gen, bar);
            __builtin_amdgcn_fence(__ATOMIC_ACQUIRE, "agent");
            asm volatile("s_waitcnt vmcnt(0)" ::: "memory");
        }
    }
    __syncthreads();
}

namespace pg8 {
constexpr int BM = 256, BK = 64, HALF = 128, HTB = HALF * BK * 2, STAGE_BYTES = 8 * HTB, NXCD = 8, WGM = 8;
__host__ __device__ __forceinline__ int lds_byte(int r, int c) { const int st = (r >> 4) * 2 + (c >> 5), rr = r & 15, cc = c & 31, ob = rr * 64 + cc * 2; return st * 1024 + (ob ^ (((ob >> 9) & 1) << 5)); }
__host__ __device__ __forceinline__ void stage_rc(int b, int& R, int& C) { const int st = b / 1024, sb = b % 1024, swz = sb ^ (((sb >> 9) & 1) << 5); R = (st >> 1) * 16 + swz / 64; C = (st & 1) * 32 + (swz % 64) / 2; }
__host__ __device__ __forceinline__ int perm32(int rho) { const int n = rho >> 4, i = rho & 15; return 8 * (i >> 2) + 4 * n + (i & 3); }
struct Unit { int pm, pn; };
struct Gemm { const bf16* A; const bf16* Bt; int M, N, K, lda, ldb; };
struct StaticOrder {
    int nM, nN, nwg, G, c;
    __host__ __device__ void init(int M, int N, int G_, int c_) { nM = M / BM; nN = N / BM; nwg = nM * nN; G = G_; c = c_; }
    __host__ __device__ bool next(int i, Unit& u) const {
        const long L = (long)i * G + c; if (L >= nwg) return false;
        int wgid = (int)L; { const int q = nwg / NXCD, r = nwg % NXCD, xcd = wgid % NXCD, off = wgid / NXCD; wgid = (xcd < r ? xcd * (q + 1) : r * (q + 1) + (xcd - r) * q) + off; }
        const int nig = WGM * nN, gid = wgid / nig, fm = gid * WGM, gsz = (nM - fm) < WGM ? (nM - fm) : WGM;
        u.pm = fm + ((wgid % nig) % gsz); u.pn = (wgid % nig) / gsz; return true;
    }
    __device__ __forceinline__ void a_ready(const Unit&) const {}
    __device__ __forceinline__ void done(const Unit&) const {}
};
__device__ __forceinline__ unsigned cvt_pk_bf16(float lo, float hi) { unsigned r; asm volatile("v_cvt_pk_bf16_f32 %0, %1, %2" : "=v"(r) : "v"(lo), "v"(hi)); return r; }

template <int ACT> struct EpiBf16 {
    static constexpr bool PERM = true, AFTER_DRAIN = false, HAS_MID = false;
    bf16* O; int ldc;
    __device__ __forceinline__ void operator()(const f32x4 (&acc)[2][2][4][2], const Unit& u, int wr, int wc, int fr, int fq) const {
        const int row0 = u.pm * BM + wr * 64 + fr; const int col0 = u.pn * BM + wc * 32 + 8 * fq;
#pragma unroll
        for (int ai = 0; ai < 2; ++ai)
#pragma unroll
            for (int m = 0; m < 4; ++m) { bf16* rowp = O + (size_t)(row0 + ai * HALF + m * 16) * ldc + col0;
#pragma unroll
                for (int bj = 0; bj < 2; ++bj) { f32x4 v0 = acc[ai][bj][m][0], v1 = acc[ai][bj][m][1];
                    if (ACT == 1) {
#pragma unroll
                        for (int j = 0; j < 4; ++j) { v0[j] = sigmoidf_(v0[j]); v1[j] = sigmoidf_(v1[j]); } }
                    u32x4 w; w.x = cvt_pk_bf16(v0[0], v0[1]); w.y = cvt_pk_bf16(v0[2], v0[3]); w.z = cvt_pk_bf16(v1[0], v1[1]); w.w = cvt_pk_bf16(v1[2], v1[3]);
                    *(u32x4*)(rowp + bj * HALF) = w; } }
    }
};
struct EpiResid {
    static constexpr bool PERM = false, AFTER_DRAIN = false, HAS_MID = false;
    float* C; int ldc; const float* R;
    __device__ __forceinline__ void operator()(const f32x4 (&acc)[2][2][4][2], const Unit& u, int wr, int wc, int fr, int fq) const {
        const int row0 = u.pm * BM + wr * 64 + fr, col0 = u.pn * BM + wc * 32 + 4 * fq;
#pragma unroll
        for (int ai = 0; ai < 2; ++ai)
#pragma unroll
            for (int m = 0; m < 4; ++m) { const size_t off = (size_t)(row0 + ai * HALF + m * 16) * ldc + col0;
#pragma unroll
                for (int bj = 0; bj < 2; ++bj)
#pragma unroll
                    for (int n = 0; n < 2; ++n) { const f32x4 r = *(const f32x4*)(R + off + bj * HALF + n * 16); *(f32x4*)(C + off + bj * HALF + n * 16) = acc[ai][bj][m][n] + r; } }
    }
};

struct EpiBranchFused {
    static constexpr bool PERM = true, AFTER_DRAIN = false, HAS_MID = true;
    bf16* O; int ldc; __amdgpu_buffer_rsrc_t grs; int ldg;
    __device__ __forceinline__ void mid(f32x4 (&acc)[2][2][4][2], const Unit& u, int t, int wr, int wc, int fr, int fq) const {
        const unsigned voff = (unsigned)(((u.pm * BM + wr * 64 + fr) * ldg + u.pn * BM + wc * 32 + 8 * fq) * 2);
        const int ca = (t == 16) ? 0 : 2048;
#pragma unroll
        for (int ai = 0; ai < 2; ++ai)
#pragma unroll
            for (int m = 0; m < 4; ++m) {
#pragma unroll
                for (int bj = 0; bj < 2; ++bj) { const int so = ((ai * HALF + m * 16) * ldg + bj * HALF) * 2 + ca;
                    const u32x4 ga = __builtin_amdgcn_raw_buffer_load_b128(grs, voff, so, 0), gb = __builtin_amdgcn_raw_buffer_load_b128(grs, voff, so + 2048, 0);
                    f32x4& v0 = acc[ai][bj][m][0]; f32x4& v1 = acc[ai][bj][m][1];
                    v0[0] *= bflo(ga.x) * __builtin_amdgcn_rcpf(fmaxf(bflo(gb.x), 1e-30f)); v0[1] *= bfhi(ga.x) * __builtin_amdgcn_rcpf(fmaxf(bfhi(gb.x), 1e-30f));
                    v0[2] *= bflo(ga.y) * __builtin_amdgcn_rcpf(fmaxf(bflo(gb.y), 1e-30f)); v0[3] *= bfhi(ga.y) * __builtin_amdgcn_rcpf(fmaxf(bfhi(gb.y), 1e-30f));
                    v1[0] *= bflo(ga.z) * __builtin_amdgcn_rcpf(fmaxf(bflo(gb.z), 1e-30f)); v1[1] *= bfhi(ga.z) * __builtin_amdgcn_rcpf(fmaxf(bfhi(gb.z), 1e-30f));
                    v1[2] *= bflo(ga.w) * __builtin_amdgcn_rcpf(fmaxf(bflo(gb.w), 1e-30f)); v1[3] *= bfhi(ga.w) * __builtin_amdgcn_rcpf(fmaxf(bfhi(gb.w), 1e-30f)); }
                __builtin_amdgcn_sched_barrier(0); }
    }
    __device__ __forceinline__ void operator()(const f32x4 (&acc)[2][2][4][2], const Unit& u, int wr, int wc, int fr, int fq) const {
        const int row0 = u.pm * BM + wr * 64 + fr; const int col0 = u.pn * BM + wc * 32 + 8 * fq;
        const unsigned voff = (unsigned)((row0 * ldg + col0) * 2);
#pragma unroll
        for (int ai = 0; ai < 2; ++ai)
#pragma unroll
            for (int m = 0; m < 4; ++m) { const size_t r = (size_t)(row0 + ai * HALF + m * 16); bf16* rowp = O + r * ldc + col0;
#pragma unroll
                for (int bj = 0; bj < 2; ++bj) { const f32x4 v0 = acc[ai][bj][m][0], v1 = acc[ai][bj][m][1];
                    const u32x4 g = __builtin_amdgcn_raw_buffer_load_b128(grs, voff, ((ai * HALF + m * 16) * ldg + bj * HALF) * 2 + 4096, 0);
                    u32x4 w; w.x = cvt_pk_bf16(v0[0] * bflo(g.x), v0[1] * bfhi(g.x)); w.y = cvt_pk_bf16(v0[2] * bflo(g.y), v0[3] * bfhi(g.y));
                    w.z = cvt_pk_bf16(v1[0] * bflo(g.z), v1[1] * bfhi(g.z)); w.w = cvt_pk_bf16(v1[2] * bflo(g.w), v1[3] * bfhi(g.w));
                    *(u32x4*)(rowp + bj * HALF) = w; } }
    }
};

template <class Epi, class Sched>
__device__ __forceinline__ void gemm_phase(LAS unsigned char* lds, const Gemm g, const Sched& S, const Epi& E, int wid) {
    int lane = lane_id(); asm volatile("" : "+v"(lane));
    const int tid = wid * 64 + lane, wr = wid >> 2, wc = wid & 3, fr = lane & 15, fq = lane >> 4;
    const int K = g.K, nt = K / BK;
    unsigned voffA[2], voffB[2];
#pragma unroll
    for (int i = 0; i < 2; ++i) { int R, C; stage_rc(tid * 16 + i * 8192, R, C); const int Rb = Epi::PERM ? ((R & ~31) + perm32(R & 31)) : R;
        voffA[i] = (unsigned)(R * g.lda + C) * 2u; voffB[i] = (unsigned)(Rb * g.ldb + C) * 2u; }
    const size_t kstep = (size_t)(BK * 2);
    const size_t hsA = (size_t)HALF * g.lda * 2, hsB = (size_t)HALF * g.ldb * 2;
    const size_t tsA = 2 * hsA, tsB = 2 * hsB;
    const unsigned ldsw = (unsigned)wid * 1024u;
    const int aoff = lds_byte(wr * 64 + fr, fq * 8), boff = lds_byte(wc * 32 + fr, fq * 8);
#define PG8_SA(b, h) (((b) * 2 + (h)) * HTB)
#define PG8_SB(b, h) ((4 + (b) * 2 + (h)) * HTB)
#define PG8_STAGE(bufoff, gbase, voff) do { _Pragma("unroll") for (int _i = 0; _i < 2; ++_i) \
        __builtin_amdgcn_global_load_lds((const unsigned*)((const char*)(gbase) + (voff)[_i]), (LAS unsigned*)(lds + (bufoff) + ldsw + _i * 8192), 16, 0, 0); } while (0)
#define PG8_LDA(dst, b, h) do { _Pragma("unroll") for (int m = 0; m < 4; ++m) _Pragma("unroll") for (int k = 0; k < 2; ++k) dst[m][k] = *(const LAS bf16x8*)(lds + PG8_SA(b, h) + aoff + m * 2048 + k * 1024); } while (0)
#define PG8_LDB(dst, b, h) do { _Pragma("unroll") for (int n = 0; n < 2; ++n) _Pragma("unroll") for (int k = 0; k < 2; ++k) dst[n][k] = *(const LAS bf16x8*)(lds + PG8_SB(b, h) + boff + n * 2048 + k * 1024); } while (0)
#define PG8_MMA(ai, bj, At, Bt) do { __builtin_amdgcn_s_setprio(1); _Pragma("unroll") for (int m = 0; m < 4; ++m) _Pragma("unroll") for (int n = 0; n < 2; ++n) _Pragma("unroll") for (int k = 0; k < 2; ++k) \
        acc[ai][bj][m][n] = __builtin_amdgcn_mfma_f32_16x16x32_bf16(Bt[n][k], At[m][k], acc[ai][bj][m][n], 0, 0, 0); __builtin_amdgcn_s_setprio(0); } while (0)
#define PG8_WAIT_V(n) asm volatile("s_waitcnt vmcnt(" #n ")" ::: "memory")
#define PG8_WAIT_L(n) asm volatile("s_waitcnt lgkmcnt(" #n ")" ::: "memory")
#define PG8_BAR __builtin_amdgcn_s_barrier()
#define PG8_SCHED __builtin_amdgcn_sched_barrier(0)
    Unit cur, nxt; int ui = 0;
    if (!S.next(0, cur)) return;
    f32x4 acc[2][2][4][2];
#pragma unroll
    for (int a = 0; a < 2; ++a)
#pragma unroll
        for (int b = 0; b < 2; ++b)
#pragma unroll
            for (int m = 0; m < 4; ++m)
#pragma unroll
                for (int n = 0; n < 2; ++n) acc[a][b][m][n] = (f32x4){0.f, 0.f, 0.f, 0.f};
    bf16x8 At[4][2], B0[2][2], B1[2][2];
    const char* cA = (const char*)g.A + (size_t)cur.pm * tsA; const char* cB = (const char*)g.Bt + (size_t)cur.pn * tsB;
    S.a_ready(cur);
    PG8_STAGE(PG8_SB(0, 0), cB, voffB); PG8_STAGE(PG8_SB(0, 1), cB + hsB, voffB); PG8_STAGE(PG8_SA(0, 0), cA, voffA); PG8_STAGE(PG8_SA(0, 1), cA + hsA, voffA);
    if (wr == 1) PG8_BAR;
    PG8_WAIT_V(2); PG8_BAR;
    PG8_STAGE(PG8_SB(1, 0), cB + kstep, voffB); PG8_STAGE(PG8_SA(1, 0), cA + kstep, voffA); PG8_STAGE(PG8_SB(1, 1), cB + hsB + kstep, voffB);
    PG8_WAIT_V(6); PG8_BAR;
    for (;;) {
        const bool has_next = S.next(ui + 1, nxt);
        const char* nA = has_next ? (const char*)g.A + (size_t)nxt.pm * tsA : cA; const char* nB = has_next ? (const char*)g.Bt + (size_t)nxt.pn * tsB : cB;
        for (int t = 0; t < nt; t += 2) {
            const bool last = (t == nt - 2);
            const char* a1 = cA + (size_t)(t + 1) * kstep;
            const char* a2 = last ? nA : cA + (size_t)(t + 2) * kstep; const char* b2 = last ? nB : cB + (size_t)(t + 2) * kstep;
            const char* a3 = a2 + kstep; const char* b3 = b2 + kstep;
            if (last && has_next) S.a_ready(nxt);
            if constexpr (Epi::HAS_MID) { if (t == 16 || t == 20) E.mid(acc, cur, t, wr, wc, fr, fq); }
            PG8_LDB(B0, 0, 0); PG8_LDB(B1, 0, 1); PG8_SCHED; PG8_LDA(At, 0, 0); PG8_STAGE(PG8_SA(1, 1), a1 + hsA, voffA);
            PG8_WAIT_V(8); PG8_WAIT_L(0); PG8_BAR; PG8_MMA(0, 0, At, B0); PG8_MMA(0, 1, At, B1); PG8_BAR; PG8_SCHED;
            PG8_LDA(At, 0, 1); PG8_STAGE(PG8_SB(0, 0), b2, voffB); PG8_STAGE(PG8_SB(0, 1), b2 + hsB, voffB); PG8_STAGE(PG8_SA(0, 0), a2, voffA);
            PG8_WAIT_V(8); PG8_WAIT_L(0); PG8_BAR; PG8_MMA(1, 0, At, B0); PG8_MMA(1, 1, At, B1); PG8_BAR; PG8_SCHED;
            PG8_LDB(B0, 1, 0); PG8_LDB(B1, 1, 1); PG8_SCHED; PG8_LDA(At, 1, 0); PG8_STAGE(PG8_SA(0, 1), a2 + hsA, voffA);
            PG8_WAIT_V(8); PG8_WAIT_L(0); PG8_BAR; PG8_MMA(0, 0, At, B0); PG8_MMA(0, 1, At, B1); PG8_BAR; PG8_SCHED;
            PG8_LDA(At, 1, 1); PG8_STAGE(PG8_SB(1, 0), b3, voffB); PG8_STAGE(PG8_SB(1, 1), b3 + hsB, voffB); PG8_STAGE(PG8_SA(1, 0), a3, voffA);
            PG8_WAIT_V(8); PG8_WAIT_L(0); PG8_BAR; PG8_MMA(1, 0, At, B0); PG8_MMA(1, 1, At, B1); PG8_BAR; PG8_SCHED;
        }
        if (wr == 0) PG8_BAR;
        E(acc, cur, wr, wc, fr, fq); S.done(cur);
        if (!has_next) break;
#pragma unroll
        for (int a = 0; a < 2; ++a)
#pragma unroll
            for (int b = 0; b < 2; ++b)
#pragma unroll
                for (int m = 0; m < 4; ++m)
#pragma unroll
                    for (int n = 0; n < 2; ++n) acc[a][b][m][n] = (f32x4){0.f, 0.f, 0.f, 0.f};
        cur = nxt; cA = nA; cB = nB; ++ui;
        if (wr == 1) PG8_BAR;
    }
    PG8_WAIT_V(0);
    PG8_BAR;
#undef PG8_SA
#undef PG8_SB
#undef PG8_STAGE
#undef PG8_LDA
#undef PG8_LDB
#undef PG8_MMA
#undef PG8_WAIT_V
#undef PG8_WAIT_L
#undef PG8_BAR
#undef PG8_SCHED
}
}

struct Args {
    const float* in[26]; const int* positions; float* out; unsigned char* ws; int ph_lo, ph_hi; int pad0, pad1;
};
struct Frame {
    LAS unsigned char* lds;
    int tid, lane, wave, G, bid;
    const float* const* in; const int* positions; float* out; unsigned char* ws;
};
__device__ __forceinline__ void frame_refresh(Frame& F) { int l = lane_id(); asm volatile("" : "+v"(l)); F.lane = l; F.tid = F.wave * 64 + l; }
enum { I_X = 0, I_MEM = 1, I_POS = 2, I_NMIXW = 3, I_WIN = 4, I_CONVW = 5, I_CONVB = 6, I_DTB = 7, I_ALOG = 8, I_SSDD = 9, I_SSDNW = 10, I_DQNW = 11, I_DKNW = 12, I_MEMNW = 13,
       I_WMKV = 14, I_MQNW = 15, I_MKNW = 16, I_WSSD = 17, I_WDIL = 18, I_WMEMBR = 19, I_WOUT = 20, I_NFFNW = 21, I_WQ = 22, I_SUBK = 23, I_PD = 24, I_PU = 25 };

__device__ __forceinline__ void p0_transpose_item(const float* W, int ldw, int src_col0, bf16* WT, int ldt, int dst_row0, int dst_col0, int nblk, LAS float* scr, int item, int lane) {
    const int kb = item / nblk, nb = item % nblk, k0 = 64 * kb, n0 = 32 * nb;
#pragma unroll 8
    for (int i = 0; i < 32; ++i) { const int kk = 2 * i + (lane >> 5); scr[kk * 33 + (lane & 31)] = W[(size_t)(k0 + kk) * ldw + src_col0 + n0 + (lane & 31)]; }
    LDS_WAIT(); asm volatile("" ::: "memory");
    const int c = lane & 7;
#pragma unroll
    for (int j = 0; j < 4; ++j) { const int n = (lane >> 3) + 8 * j; const LAS float* s = scr + (8 * c) * 33 + n;
        u32x4 o; o.x = pk2(s[0 * 33], s[1 * 33]); o.y = pk2(s[2 * 33], s[3 * 33]); o.z = pk2(s[4 * 33], s[5 * 33]); o.w = pk2(s[6 * 33], s[7 * 33]);
        *(u32x4*)(WT + (size_t)(dst_row0 + n0 + n) * ldt + dst_col0 + k0 + 8 * c) = o; }
    LDS_WAIT(); asm volatile("" ::: "memory");
}
__device__ __forceinline__ void rms_row_to_bf16(const float* xrow, const float* w, bf16* orow, int lane, f32x4 (&v)[4]) {
    const f32x4* xr = (const f32x4*)xrow + lane; const f32x4* wr = (const f32x4*)w + lane;
    float s = 0.f;
#pragma unroll
    for (int j = 0; j < 4; ++j) { v[j] = xr[64 * j]; s += (v[j].x * v[j].x + v[j].y * v[j].y) + (v[j].z * v[j].z + v[j].w * v[j].w); }
    const float rstd = 1.0f / sqrtf(wave_sum(s) * (1.f / DM) + EPS);
    unsigned long long* o8 = (unsigned long long*)orow + lane;
#pragma unroll
    for (int j = 0; j < 4; ++j) { const f32x4 ww = wr[64 * j]; v[j] = v[j] * rstd * ww;
        o8[64 * j] = (unsigned long long)pk2(v[j].x, v[j].y) | ((unsigned long long)pk2(v[j].z, v[j].w) << 32); }
}
__device__ __forceinline__ void rms_rows_finish(f32x4 (&v)[4], const float* w, bf16* orow, int lane) {
    const f32x4* wr = (const f32x4*)w + lane;
    float s = 0.f;
#pragma unroll
    for (int j = 0; j < 4; ++j) s += (v[j].x * v[j].x + v[j].y * v[j].y) + (v[j].z * v[j].z + v[j].w * v[j].w);
    const float rstd = 1.0f / sqrtf(wave_sum(s) * (1.f / DM) + EPS);
    unsigned long long* o8 = (unsigned long long*)orow + lane;
#pragma unroll
    for (int j = 0; j < 4; ++j) { const f32x4 ww = wr[64 * j]; v[j] = v[j] * rstd * ww;
        o8[64 * j] = (unsigned long long)pk2(v[j].x, v[j].y) | ((unsigned long long)pk2(v[j].z, v[j].w) << 32); }
}
__device__ __forceinline__ void cvt_f32_bf16_stream(const float* src, bf16* dst, size_t n, size_t gtid, size_t gthreads) {
    for (size_t i = gtid * 8; i < n; i += gthreads * 8) { const f32x4 a = *(const f32x4*)(src + i), b = *(const f32x4*)(src + i + 4);
        u32x4 o; o.x = pk2(a.x, a.y); o.y = pk2(a.z, a.w); o.z = pk2(b.x, b.y); o.w = pk2(b.z, b.w); *(u32x4*)(dst + i) = o; }
}
constexpr float PD_SCALE = 64.0f, PU_SCALE = 8.0f;
__device__ __forceinline__ unsigned pk4_fp8(f32x4 v, float sc) {
    const float a = fminf(fmaxf(v.x * sc, -448.f), 448.f), b = fminf(fmaxf(v.y * sc, -448.f), 448.f), c = fminf(fmaxf(v.z * sc, -448.f), 448.f), d = fminf(fmaxf(v.w * sc, -448.f), 448.f);
    unsigned p = __builtin_amdgcn_cvt_pk_fp8_f32(a, b, 0, false); return __builtin_amdgcn_cvt_pk_fp8_f32(c, d, p, true);
}
__device__ __forceinline__ void cvt_f32_fp8_sliced(const float* src, unsigned char* dst, float sc, size_t gtid, size_t gthreads) {
    for (size_t i = gtid * 16; i < (size_t)16384 * 1024; i += gthreads * 16) { const f32x4 a = *(const f32x4*)(src + i), b = *(const f32x4*)(src + i + 4), c = *(const f32x4*)(src + i + 8), d = *(const f32x4*)(src + i + 12);
        const size_t e = i >> 10, dd = i & 1023;
        const u32x4 o = {pk4_fp8(a, sc), pk4_fp8(b, sc), pk4_fp8(c, sc), pk4_fp8(d, sc)}; *(u32x4*)(dst + ((((dd >> 7) * 16384 + e) << 7) + (dd & 127))) = o; }
}
__device__ __forceinline__ void p0_prologue(Frame& F) {
    LAS float* scr = (LAS float*)(F.lds + F.wave * 8448);
    LAS float* wdt = (LAS float*)(F.lds + 8 * 8448);
    const int gw = F.bid * NWAVES + F.wave, NGW = F.G * NWAVES;
    unsigned char* ws = F.ws;
    for (int i = F.tid; i < 1024 * 16; i += NTHR) { const int k = i >> 4, c = i & 15, l = (k & 255) >> 2, e = k & 3, j = k >> 8, q = c >> 2;
        wdt[((((j * 4 + e) * 4 + q) * 64 + l) << 2) + (c & 3)] = F.in[I_WIN][(size_t)k * W_IN_N + OFF_DT + c]; }
    __syncthreads();
    constexpr int IT_A = 16 * 96, IT_B = 16 * 192, IT_MKV = 16 * 48, IT_SSD = 16 * 32, IT_DIL = 4 * 32, IT_MBR = 12 * 32, IT_OUT = 16 * 32, IT_WQ = 16 * 64;
    constexpr int NITEMS = IT_A + IT_B + IT_MKV + IT_SSD + IT_DIL + IT_MBR + IT_OUT + IT_WQ;
    bf16* WallT = (bf16*)(ws + WS_WALLT);
    for (int it = gw; it < NITEMS; it += NGW) {
        int r = it;
        if (r < IT_A) { p0_transpose_item(F.in[I_WIN], W_IN_N, 0, WallT, DM, 0, 0, 96, scr, r, F.lane); continue; } r -= IT_A;
        if (r < IT_B) { p0_transpose_item(F.in[I_WIN], W_IN_N, OFF_AFTER_DT, WallT, DM, 3072, 0, 192, scr, r, F.lane); continue; } r -= IT_B;
        if (r < IT_MKV) { p0_transpose_item(F.in[I_WMKV], 1536, 0, (bf16*)(ws + WS_WMKVT), DM, 0, 0, 48, scr, r, F.lane); continue; } r -= IT_MKV;
        if (r < IT_SSD) { p0_transpose_item(F.in[I_WSSD], DM, 0, (bf16*)(ws + WS_WCATT), YC, 0, 0, 32, scr, r, F.lane); continue; } r -= IT_SSD;
        if (r < IT_DIL) { p0_transpose_item(F.in[I_WDIL], DM, 0, (bf16*)(ws + WS_WCATT), YC, 0, 1024, 32, scr, r, F.lane); continue; } r -= IT_DIL;
        if (r < IT_MBR) { p0_transpose_item(F.in[I_WMEMBR], DM, 0, (bf16*)(ws + WS_WCATT), YC, 0, 1280, 32, scr, r, F.lane); continue; } r -= IT_MBR;
        if (r < IT_OUT) { p0_transpose_item(F.in[I_WOUT], DM, 0, (bf16*)(ws + WS_WOUTT), DM, 0, 0, 32, scr, r, F.lane); continue; } r -= IT_OUT;
        p0_transpose_item(F.in[I_WQ], PEER_Q, 0, (bf16*)(ws + WS_WQT), DM, 0, 0, 64, scr, r, F.lane);
    }
    const size_t gtid = (size_t)F.bid * NTHR + F.tid, gth = (size_t)F.G * NTHR;
    cvt_f32_bf16_stream(F.in[I_SUBK], (bf16*)(ws + WS_SUBK), (size_t)8 * 2 * 128 * 128, gtid, gth);
    cvt_f32_fp8_sliced(F.in[I_PD], ws + WS_PD, PD_SCALE, gtid, gth);
    cvt_f32_fp8_sliced(F.in[I_PU], ws + WS_PU, PU_SCALE, gtid, gth);
    for (int m = gw; m < NB * NMEM; m += NGW) { f32x4 v[4]; rms_row_to_bf16(F.in[I_MEM] + (size_t)m * DM, F.in[I_MEMNW], (bf16*)(ws + WS_MEMN) + (size_t)m * DM, F.lane, v); }
    { float* RT = (float*)(ws + WS_ROPE);
      for (size_t i = gtid; i < (size_t)T * 8; i += gth) { const int tok = (int)(i >> 3), a = (int)(i & 7);
          const float inv = __expf(-logf(500000.0f) * (2.0f / 16.0f) * (float)a);
          const double rev = (double)((float)F.positions[tok] * inv) * 0.15915494309189535; const float fr = (float)(rev - floor(rev));
          RT[(size_t)tok * 16 + a] = __builtin_amdgcn_cosf(fr); RT[(size_t)tok * 16 + 8 + a] = __builtin_amdgcn_sinf(fr); } }
    float* DTp = (float*)(ws + WS_DT);
    const int lane = F.lane;
    const int myj = ((lane >> 5) & 1) * 8 + ((lane >> 4) & 1) * 4 + ((lane >> 3) & 1) * 2 + ((lane >> 2) & 1);
    const float dtb = F.in[I_DTB][myj];
    f32x4 na[4], nb[4];
    { const int m0 = 2 * gw < T ? 2 * gw : 0; const f32x4* xa = (const f32x4*)(F.in[I_X] + (size_t)m0 * DM) + lane; const f32x4* xb = (const f32x4*)(F.in[I_X] + (size_t)(m0 + 1) * DM) + lane;
#pragma unroll
      for (int j = 0; j < 4; ++j) { na[j] = xa[64 * j]; nb[j] = xb[64 * j]; } }
    for (int m = 2 * gw; m < T; m += 2 * NGW) {
        f32x4 va[4], vb[4];
#pragma unroll
        for (int j = 0; j < 4; ++j) { va[j] = na[j]; vb[j] = nb[j]; }
        { const int mn = (m + 2 * NGW < T) ? m + 2 * NGW : m; const f32x4* xa = (const f32x4*)(F.in[I_X] + (size_t)mn * DM) + lane; const f32x4* xb = (const f32x4*)(F.in[I_X] + (size_t)(mn + 1) * DM) + lane;
#pragma unroll
          for (int j = 0; j < 4; ++j) { na[j] = xa[64 * j]; nb[j] = xb[64 * j]; } }
        rms_rows_finish(va, F.in[I_NMIXW], (bf16*)(ws + WS_ACT1) + (size_t)m * DM, lane);
        rms_rows_finish(vb, F.in[I_NMIXW], (bf16*)(ws + WS_ACT1) + (size_t)(m + 1) * DM, lane);
        float da[16], db[16];
#pragma unroll
        for (int j = 0; j < 16; ++j) { da[j] = 0.f; db[j] = 0.f; }
#pragma unroll
        for (int j = 0; j < 4; ++j)
#pragma unroll
            for (int e = 0; e < 4; ++e) { const float ua = va[j][e], ub = vb[j][e];
#pragma unroll
                for (int q = 0; q < 4; ++q) { const f32x4 w4 = *(const LAS f32x4*)(wdt + ((((j * 4 + e) * 4 + q) * 64 + lane) << 2));
                    da[4 * q + 0] += ua * w4.x; da[4 * q + 1] += ua * w4.y; da[4 * q + 2] += ua * w4.z; da[4 * q + 3] += ua * w4.w;
                    db[4 * q + 0] += ub * w4.x; db[4 * q + 1] += ub * w4.y; db[4 * q + 2] += ub * w4.z; db[4 * q + 3] += ub * w4.w; }
                __builtin_amdgcn_sched_barrier(0); }
        float ra, rb;
        { float r8a[8], r8b[8], r4a[4], r4b[4], r2a[2], r2b[2];
          { const bool up = (lane & 32) != 0;
#pragma unroll
            for (int k = 0; k < 8; ++k) { r8a[k] = (up ? da[k + 8] : da[k]) + __shfl_xor(up ? da[k] : da[k + 8], 32); r8b[k] = (up ? db[k + 8] : db[k]) + __shfl_xor(up ? db[k] : db[k + 8], 32); } }
          { const bool up = (lane & 16) != 0;
#pragma unroll
            for (int k = 0; k < 4; ++k) { r4a[k] = (up ? r8a[k + 4] : r8a[k]) + __shfl_xor(up ? r8a[k] : r8a[k + 4], 16); r4b[k] = (up ? r8b[k + 4] : r8b[k]) + __shfl_xor(up ? r8b[k] : r8b[k + 4], 16); } }
          { const bool up = (lane & 8) != 0;
#pragma unroll
            for (int k = 0; k < 2; ++k) { r2a[k] = (up ? r4a[k + 2] : r4a[k]) + __shfl_xor(up ? r4a[k] : r4a[k + 2], 8); r2b[k] = (up ? r4b[k + 2] : r4b[k]) + __shfl_xor(up ? r4b[k] : r4b[k + 2], 8); } }
          { const bool up = (lane & 4) != 0; ra = (up ? r2a[1] : r2a[0]) + __shfl_xor(up ? r2a[0] : r2a[1], 4); rb = (up ? r2b[1] : r2b[0]) + __shfl_xor(up ? r2b[0] : r2b[1], 4); }
          ra += __shfl_xor(ra, 2); ra += __shfl_xor(ra, 1); rb += __shfl_xor(rb, 2); rb += __shfl_xor(rb, 1); }
        if ((lane & 3) == 0) { const float xa = ra + dtb, xb = rb + dtb;
            DTp[(size_t)m * 16 + myj] = (xa > 20.f) ? xa : log1pf(__expf(xa)); DTp[(size_t)(m + 1) * 16 + myj] = (xb > 20.f) ? xb : log1pf(__expf(xb)); }
    }
}

__device__ __forceinline__ void norm192_inplace(bf16* p, const float (&w)[4], int lane) {
    u32x2 v = {0u, 0u};
    if (lane < 48) v = *(const u32x2*)(p + 4 * lane);
    float x0 = bflo(v.x), x1 = bfhi(v.x), x2 = bflo(v.y), x3 = bfhi(v.y);
    const float ss = wave_sum((x0 * x0 + x1 * x1) + (x2 * x2 + x3 * x3));
    const float rs = 1.0f / sqrtf(ss * (1.f / 192.f) + EPS);
    if (lane < 48) { const u32x2 o = {pkbf(x0 * rs * w[0], x1 * rs * w[1]), pkbf(x2 * rs * w[2], x3 * rs * w[3])}; *(u32x2*)(p + 4 * lane) = o; }
}
__device__ __forceinline__ void mknorm_phase(Frame& F) {
    const int gw = F.bid * NWAVES + F.wave, NGW = F.G * NWAVES, lane = F.lane;
    float wmk[4];
#pragma unroll
    for (int j = 0; j < 4; ++j) wmk[j] = F.in[I_MKNW][(4 * lane + j) % 192];
    bf16* MK = (bf16*)(F.ws + WS_MKV);
    for (int r = gw; r < NB * NMEM * 4; r += NGW) norm192_inplace(MK + (size_t)(r >> 2) * 1536 + (r & 3) * 192, wmk, lane);
}

constexpr int SC_ST = 272, SX_ST = 528;
__device__ __forceinline__ float bfsel(const u32x4& v, int j) { const unsigned w = v[j >> 1]; return (j & 1) ? bfhi(w) : bflo(w); }
__device__ __forceinline__ void conv_task(const bf16* P, size_t rowb, int t0, int pcol, const float* cw, const float* cb, int ccol, LAS unsigned char* dst, int stride, const LAS float* scale) {
    float w[4][8], bs[8];
#pragma unroll
    for (int k = 0; k < 4; ++k) { const f32x4 a = *(const f32x4*)(cw + k * 2048 + ccol), b = *(const f32x4*)(cw + k * 2048 + ccol + 4);
        w[k][0] = a.x; w[k][1] = a.y; w[k][2] = a.z; w[k][3] = a.w; w[k][4] = b.x; w[k][5] = b.y; w[k][6] = b.z; w[k][7] = b.w; }
    { const f32x4 a = *(const f32x4*)(cb + ccol), b = *(const f32x4*)(cb + ccol + 4); bs[0] = a.x; bs[1] = a.y; bs[2] = a.z; bs[3] = a.w; bs[4] = b.x; bs[5] = b.y; bs[6] = b.z; bs[7] = b.w; }
    const bf16* src = P + (rowb + t0) * NPROJ + pcol;
    u32x4 rw[19];
#pragma unroll
    for (int i = 0; i < 3; ++i) rw[i] = (u32x4){0u, 0u, 0u, 0u};
    if (t0 > 0) {
#pragma unroll
        for (int i = 0; i < 3; ++i) rw[i] = *(const u32x4*)(src + (ptrdiff_t)(i - 3) * NPROJ); }
#pragma unroll
    for (int i = 0; i < 16; ++i) rw[3 + i] = *(const u32x4*)(src + (size_t)i * NPROJ);
#pragma unroll
    for (int i = 0; i < 16; ++i) {
        float o[8];
#pragma unroll
        for (int j = 0; j < 8; ++j) { float a = bs[j] + w[0][j] * bfsel(rw[i], j) + w[1][j] * bfsel(rw[i + 1], j) + w[2][j] * bfsel(rw[i + 2], j) + w[3][j] * bfsel(rw[i + 3], j); o[j] = a * sigmoidf_(a); }
        if (scale) { const float sv = scale[i];
#pragma unroll
            for (int j = 0; j < 8; ++j) o[j] *= sv; }
        const u32x4 r = {pkbf(o[0], o[1]), pkbf(o[2], o[3]), pkbf(o[4], o[5]), pkbf(o[6], o[7])};
        *(LAS u32x4*)(dst + i * stride) = r;
    }
}
__device__ __forceinline__ float ssd_scan(Frame& F, const float* DTp, size_t tok0, int g, LAS float* sAc, LAS float* sDt) {
    float total = 0.f;
    if (F.wave < 4) {
        const int head = 4 * g + F.wave, lane = F.lane;
        const float A = -__expf(F.in[I_ALOG][head]);
        const float d0 = DTp[(tok0 + 2 * lane) * 16 + head], d1 = DTp[(tok0 + 2 * lane + 1) * 16 + head];
        const float a0 = d0 * A, a1 = d1 * A;
        float sc = a0 + a1;
#pragma unroll
        for (int o = 1; o < 64; o <<= 1) { const float v = __shfl_up(sc, o); if (lane >= o) sc += v; }
        sAc[F.wave * 128 + 2 * lane] = sc - a1; sAc[F.wave * 128 + 2 * lane + 1] = sc;
        sDt[F.wave * 128 + 2 * lane] = d0; sDt[F.wave * 128 + 2 * lane + 1] = d1;
        total = __shfl(sc, 63);
    }
    return total;
}
__device__ __forceinline__ bf16x8 tr_pair(unsigned a_lo, unsigned a_hi) {
    s16x4 lo, hi;
    asm volatile("ds_read_b64_tr_b16 %0, %2\n\tds_read_b64_tr_b16 %1, %3\n\ts_waitcnt lgkmcnt(0)" : "=&v"(lo), "=&v"(hi) : "v"(a_lo), "v"(a_hi) : "memory");
    const bf16x8 r = {lo[0], lo[1], lo[2], lo[3], hi[0], hi[1], hi[2], hi[3]}; return r;
}

__device__ __forceinline__ void ssdC_phase(Frame& F, int half) {
    const bf16* P = (const bf16*)(F.ws + WS_BIG);
    const float* DTp = (const float*)(F.ws + WS_DT);
    bf16* SST = (bf16*)(F.ws + WS_SST); float* DEC = (float*)(F.ws + WS_DEC);
    LAS unsigned char* sX = F.lds; LAS unsigned char* sB = F.lds + 128 * SX_ST;
    LAS float* sAc = (LAS float*)(F.lds + 128 * SX_ST + 128 * SC_ST); LAS float* sDt = sAc + 512; LAS float* sW = sDt + 512;
    const int wave = F.wave;
    for (int unit = F.bid; unit < HB * 64 * 4; unit += F.G) {
        int tid = F.tid; asm volatile("" : "+v"(tid));
        const int lane = tid & 63, ql = lane & 31, h = lane >> 5, tq = (lane & 15) >> 2, tp = lane & 3, tblk = (lane >> 4) & 1;
        const int bl = unit >> 8, c = (unit >> 2) & 63, g = unit & 3;
        const size_t rowb = (size_t)bl * SEQ, tok0 = (size_t)half * HT + rowb + c * 128;
        __syncthreads();
        const float total = ssd_scan(F, DTp, tok0, g, sAc, sDt);
        if (wave < 4) { sW[wave * 128 + 2 * lane] = __expf(total - sAc[wave * 128 + 2 * lane]) * sDt[wave * 128 + 2 * lane];
            sW[wave * 128 + 2 * lane + 1] = __expf(total - sAc[wave * 128 + 2 * lane + 1]) * sDt[wave * 128 + 2 * lane + 1];
            if (lane == 0) DEC[((size_t)bl * 64 + c) * 16 + 4 * g + wave] = __expf(total); }
        __syncthreads();
        if (tid < 384) {
            int ch, strip, ccol, stride; LAS unsigned char* dst; const LAS float* scl = nullptr;
            if (tid < 256) { ch = tid & 31; strip = tid >> 5; ccol = g * 256 + 8 * ch; stride = SX_ST; dst = sX + (strip * 16) * SX_ST + ch * 16; scl = sW + (ch >> 3) * 128 + strip * 16; }
            else { const int u = tid - 256; ch = u & 15; strip = u >> 4; ccol = 1024 + g * 128 + 8 * ch; stride = SC_ST; dst = sB + (strip * 16) * SC_ST + ch * 16; }
            conv_task(P, rowb, c * 128 + strip * 16, PC_X + ccol, F.in[I_CONVW], F.in[I_CONVB], ccol, dst, stride, scl);
        }
        __syncthreads();
        const int r = wave >> 1, pt = wave & 1;
        f32x16 acc[4];
#pragma unroll
        for (int nt = 0; nt < 4; ++nt)
#pragma unroll
            for (int e = 0; e < 16; ++e) acc[nt][e] = 0.f;
        const unsigned xa = (unsigned)(size_t)sX + (unsigned)((8 * h + tq) * SX_ST + (r * 64 + 32 * pt + 16 * tblk + 4 * tp) * 2);
        const unsigned ba = (unsigned)(size_t)sB + (unsigned)((8 * h + tq) * SC_ST + (16 * tblk + 4 * tp) * 2);
#pragma unroll
        for (int ks = 0; ks < 8; ++ks) {
            const bf16x8 af = tr_pair(xa + ks * 16 * SX_ST, xa + ks * 16 * SX_ST + 4 * SX_ST);
            bf16x8 bfr[4];
#pragma unroll
            for (int nt = 0; nt < 4; ++nt) bfr[nt] = tr_pair(ba + ks * 16 * SC_ST + nt * 64, ba + ks * 16 * SC_ST + 4 * SC_ST + nt * 64);
            __builtin_amdgcn_sched_barrier(0);
#pragma unroll
            for (int nt = 0; nt < 4; ++nt) acc[nt] = MFMA32(af, bfr[nt], acc[nt]);
        }
        bf16* out = SST + (((size_t)bl * 64 + c) * 16 + 4 * g + r) * 8192;
#pragma unroll
        for (int nt = 0; nt < 4; ++nt)
#pragma unroll
            for (int e = 0; e < 16; ++e) out[(32 * pt + (e & 3) + 8 * (e >> 2) + 4 * h) * 128 + 32 * nt + ql] = (bf16)(pkbf(acc[nt][e], 0.f) & 0xffffu);
    }
}

__device__ __forceinline__ void ssdD_phase(Frame& F) {
    const bf16* SST = (const bf16*)(F.ws + WS_SST); const float* DEC = (const float*)(F.ws + WS_DEC);
    bf16* SIN = (bf16*)(F.ws + WS_SIN);
    const size_t gtid = (size_t)F.bid * NTHR + F.tid, gth = (size_t)F.G * NTHR;
    for (size_t it = gtid; it < (size_t)HB * 16 * 2048; it += gth) {
        const int bl = (int)(it >> 15), head = (int)(it >> 11) & 15, e4 = (int)(it & 2047) * 4;
        f32x4 st = {0.f, 0.f, 0.f, 0.f};
#pragma unroll 8
        for (int c = 0; c < 64; ++c) {
            const size_t idx = (((size_t)bl * 64 + c) * 16 + head);
            const u32x2 o = {pkbf(st.x, st.y), pkbf(st.z, st.w)};
            *(u32x2*)(SIN + idx * 8192 + e4) = o;
            const u32x2 sw = *(const u32x2*)(SST + idx * 8192 + e4); const f32x4 sl = {bflo(sw.x), bfhi(sw.x), bflo(sw.y), bfhi(sw.y)}; const float d = DEC[idx];
            st = st * d + sl;
        }
    }
}

__device__ __forceinline__ void ssdE_phase(Frame& F, int half) {
    const bf16* P = (const bf16*)(F.ws + WS_BIG);
    const float* DTp = (const float*)(F.ws + WS_DT);
    const bf16* SIN = (const bf16*)(F.ws + WS_SIN);
    bf16* Y = (bf16*)F.out;
    LAS unsigned char* sX = F.lds; LAS unsigned char* sB = F.lds + 128 * SX_ST; LAS unsigned char* sC = sB + 128 * SC_ST;
    LAS float* sAc = (LAS float*)(sC + 128 * SC_ST); LAS float* sDt = sAc + 512; LAS float* sSS = sDt + 512;
    const int wave = F.wave;
    const int st = wave & 3, hp = wave >> 2;
    for (int unit = F.bid; unit < HB * 64 * 4; unit += F.G) {
        int tid = F.tid; asm volatile("" : "+v"(tid));
        const int lane = tid & 63, ql = lane & 31, h = lane >> 5, tq = (lane & 15) >> 2, tp = lane & 3, tblk = (lane >> 4) & 1;
        const int bl = unit >> 8, c = (unit >> 2) & 63, g = unit & 3;
        const size_t rowb = (size_t)bl * SEQ, tok0 = (size_t)half * HT + rowb + c * 128;
        __syncthreads();
        (void)ssd_scan(F, DTp, tok0, g, sAc, sDt);
        if (tid < 128) sSS[tid] = 0.f;
        {
            int ch, strip, ccol, stride; LAS unsigned char* dst;
            if (tid < 256) { ch = tid & 31; strip = tid >> 5; ccol = g * 256 + 8 * ch; stride = SX_ST; dst = sX + (strip * 16) * SX_ST + ch * 16; }
            else if (tid < 384) { const int u = tid - 256; ch = u & 15; strip = u >> 4; ccol = 1024 + g * 128 + 8 * ch; stride = SC_ST; dst = sB + (strip * 16) * SC_ST + ch * 16; }
            else { const int u = tid - 384; ch = u & 15; strip = u >> 4; ccol = 1536 + g * 128 + 8 * ch; stride = SC_ST; dst = sC + (strip * 16) * SC_ST + ch * 16; }
            conv_task(P, rowb, c * 128 + strip * 16, PC_X + ccol, F.in[I_CONVW], F.in[I_CONVB], ccol, dst, stride, nullptr);
        }
        __syncthreads();
        const int s = 32 * st + ql;
        unsigned yk[2][2][8];
        float ssq = 0.f;
        const unsigned xa = (unsigned)(size_t)sX + (unsigned)((4 * h + tq) * SX_ST + (16 * tblk + 4 * tp) * 2);
#pragma unroll
        for (int hq = 0; hq < 2; ++hq) {
            const int r = 2 * hp + hq, head = 4 * g + r;
            const float acs = sAc[r * 128 + s];
            const bf16* stp = SIN + (((size_t)bl * 64 + c) * 16 + head) * 8192 + ql * 128 + 8 * h;
            bf16x8 sfr[2][8];
#pragma unroll
            for (int pt = 0; pt < 2; ++pt)
#pragma unroll
                for (int ks = 0; ks < 8; ++ks) sfr[pt][ks] = *(const bf16x8*)(stp + pt * 4096 + 16 * ks);
            bf16x8 pf[4][2];
#pragma unroll
            for (int i = 0; i < 4; ++i) {
                f32x16 Xi;
#pragma unroll
                for (int e = 0; e < 16; ++e) Xi[e] = 0.f;
#pragma unroll
                for (int ks = 0; ks < 8; ++ks) { const bf16x8 bf_ = *(const LAS bf16x8*)(sB + (32 * i + ql) * SC_ST + 32 * ks + 16 * h);
                    const bf16x8 cf = *(const LAS bf16x8*)(sC + s * SC_ST + 32 * ks + 16 * h); Xi = MFMA32(bf_, cf, Xi); }
                float p[16];
#pragma unroll
                for (int q4 = 0; q4 < 4; ++q4) { const int t0 = 32 * i + 8 * q4 + 4 * h;
                    const f32x4 at = *(const LAS f32x4*)(sAc + r * 128 + t0), dt4 = *(const LAS f32x4*)(sDt + r * 128 + t0);
#pragma unroll
                    for (int e = 0; e < 4; ++e) { const int t = t0 + e; p[4 * q4 + e] = (t <= s) ? Xi[4 * q4 + e] * __expf(acs - at[e]) * dt4[e] : 0.f; } }
#pragma unroll
                for (int s2 = 0; s2 < 2; ++s2) { const u32x4 w = {pkbf(p[8 * s2 + 0], p[8 * s2 + 1]), pkbf(p[8 * s2 + 2], p[8 * s2 + 3]), pkbf(p[8 * s2 + 4], p[8 * s2 + 5]), pkbf(p[8 * s2 + 6], p[8 * s2 + 7])};
                    pf[i][s2] = __builtin_bit_cast(bf16x8, w); }
            }
            const float eacs = __expf(acs), Dh = F.in[I_SSDD][head];
#pragma unroll
            for (int pt = 0; pt < 2; ++pt) {
                f32x16 yd, yo;
#pragma unroll
                for (int e = 0; e < 16; ++e) { yd[e] = 0.f; yo[e] = 0.f; }
#pragma unroll
                for (int i = 0; i < 4; ++i) {
#pragma unroll
                    for (int s2 = 0; s2 < 2; ++s2) { const unsigned a = xa + (unsigned)((32 * i + 16 * s2) * SX_ST + (r * 64 + 32 * pt) * 2);
                        const bf16x8 xf = tr_pair(a, a + 8 * SX_ST); __builtin_amdgcn_sched_barrier(0); yd = MFMA32(xf, pf[i][s2], yd); }
                }
#pragma unroll
                for (int ks = 0; ks < 8; ++ks) { const bf16x8 cf = *(const LAS bf16x8*)(sC + s * SC_ST + 32 * ks + 16 * h); yo = MFMA32(sfr[pt][ks], cf, yo); }
                const bf16* zp = P + (rowb + c * 128 + s) * NPROJ + PC_Z + g * 256 + r * 64 + 32 * pt + 4 * h;
                u32x2 zv[4];
#pragma unroll
                for (int q4 = 0; q4 < 4; ++q4) zv[q4] = *(const u32x2*)(zp + 8 * q4);
#pragma unroll
                for (int q4 = 0; q4 < 4; ++q4) {
                    const u32x2 xv = *(const LAS u32x2*)(sX + s * SX_ST + (r * 64 + 32 * pt + 8 * q4 + 4 * h) * 2);
                    const u32x2 zq = zv[q4];
                    const float xs_[4] = {bflo(xv.x), bfhi(xv.x), bflo(xv.y), bfhi(xv.y)}, zs_[4] = {bflo(zq.x), bfhi(zq.x), bflo(zq.y), bfhi(zq.y)};
                    float yv[4];
#pragma unroll
                    for (int e = 0; e < 4; ++e) { float y = yd[4 * q4 + e] + eacs * yo[4 * q4 + e] + Dh * xs_[e]; y = y * zs_[e] * sigmoidf_(zs_[e]); yv[e] = y; ssq += y * y; }
                    yk[hq][pt][2 * q4] = pkbf(yv[0], yv[1]); yk[hq][pt][2 * q4 + 1] = pkbf(yv[2], yv[3]);
                }
            }
        }
        ssq += __shfl_xor(ssq, 32);
        if (h == 0) __hip_atomic_fetch_add(sSS + s, ssq, __ATOMIC_RELAXED, __HIP_MEMORY_SCOPE_WORKGROUP);
        __syncthreads();
        const float rs = 1.0f / sqrtf(sSS[s] * (1.f / 256.f) + EPS);
        bf16* yp = Y + (tok0 + s) * YC + g * 256 + 4 * h;
        const float* nw = F.in[I_SSDNW] + g * 256 + 4 * h;
#pragma unroll
        for (int hq = 0; hq < 2; ++hq)
#pragma unroll
            for (int pt = 0; pt < 2; ++pt)
#pragma unroll
                for (int q4 = 0; q4 < 4; ++q4) { const int cc = (2 * hp + hq) * 64 + 32 * pt + 8 * q4; const f32x4 w4 = *(const f32x4*)(nw + cc);
                    const unsigned ya = yk[hq][pt][2 * q4], yb = yk[hq][pt][2 * q4 + 1];
                    const u32x2 o = {pkbf(bflo(ya) * rs * w4.x, bfhi(ya) * rs * w4.y), pkbf(bflo(yb) * rs * w4.z, bfhi(yb) * rs * w4.w)};
                    *(u32x2*)(yp + cc) = o; }
    }
}

__device__ __forceinline__ bf16x8 mk_bf16x8(u32x2 lo, u32x2 hi) { const u32x4 v = {lo.x, lo.y, hi.x, hi.y}; return __builtin_bit_cast(bf16x8, v); }

__device__ __forceinline__ void memattn_mfma_phase(Frame& F, int half) {
    const bf16* P = (const bf16*)(F.ws + WS_BIG);
    const bf16* MKV = (const bf16*)(F.ws + WS_MKV);
    const bf16* MVT = (const bf16*)(F.ws + WS_MVT);
    bf16* Y = (bf16*)F.out;
    LAS unsigned char* sm = F.lds;
    const int tid = F.tid, lane = F.lane, wave = F.wave, ql = lane & 31, h = lane >> 5;
    constexpr int KST = 400, VST = 528;
    for (int unit = F.bid; unit < HB * 4 * 32; unit += F.G) {
        const int bl = unit >> 7, head = (unit >> 5) & 3, qt = unit & 31, b = half * HB + bl;
        const int r = bl * SEQ + qt * 256 + wave * 32 + ql;
        __syncthreads();
        for (int c = tid; c < 256 * 24; c += NTHR) { const int row = c / 24, ch = c % 24;
            *(LAS u32x4*)(sm + row * KST + ch * 16) = *(const u32x4*)(MKV + (size_t)(b * NMEM + row) * 1536 + head * 192 + ch * 8); }
        bf16x8 qf[12];
        { const bf16* qp = P + (size_t)r * NPROJ + PC_MQ + head * 192 + 8 * h;
          u32x4 qr[12]; float ss = 0.f;
#pragma unroll
          for (int ks = 0; ks < 12; ++ks) { qr[ks] = *(const u32x4*)(qp + 16 * ks);
              ss += (bflo(qr[ks].x) * bflo(qr[ks].x) + bfhi(qr[ks].x) * bfhi(qr[ks].x)) + (bflo(qr[ks].y) * bflo(qr[ks].y) + bfhi(qr[ks].y) * bfhi(qr[ks].y))
                  + (bflo(qr[ks].z) * bflo(qr[ks].z) + bfhi(qr[ks].z) * bfhi(qr[ks].z)) + (bflo(qr[ks].w) * bflo(qr[ks].w) + bfhi(qr[ks].w) * bfhi(qr[ks].w)); }
          ss += __shfl_xor(ss, 32);
          const float rs = 1.0f / sqrtf(ss * (1.f / 192.f) + EPS);
#pragma unroll
          for (int ks = 0; ks < 12; ++ks) { const f32x4 wa = *(const f32x4*)(F.in[I_MQNW] + 16 * ks + 8 * h), wb = *(const f32x4*)(F.in[I_MQNW] + 16 * ks + 8 * h + 4);
              const u32x4 w = {pkbf(bflo(qr[ks].x) * rs * wa.x, bfhi(qr[ks].x) * rs * wa.y), pkbf(bflo(qr[ks].y) * rs * wa.z, bfhi(qr[ks].y) * rs * wa.w),
                               pkbf(bflo(qr[ks].z) * rs * wb.x, bfhi(qr[ks].z) * rs * wb.y), pkbf(bflo(qr[ks].w) * rs * wb.z, bfhi(qr[ks].w) * rs * wb.w)};
              qf[ks] = __builtin_bit_cast(bf16x8, w); } }
        __syncthreads();
        f32x16 sacc[8];
#pragma unroll
        for (int mt = 0; mt < 8; ++mt) {
#pragma unroll
            for (int i = 0; i < 16; ++i) sacc[mt][i] = 0.f;
#pragma unroll
            for (int ks = 0; ks < 12; ++ks) { const bf16x8 kf = *(const LAS bf16x8*)(sm + (32 * mt + ql) * KST + 32 * ks + 16 * h); sacc[mt] = MFMA32(kf, qf[ks], sacc[mt]); }
        }
        float mx = -3.0e38f;
#pragma unroll
        for (int mt = 0; mt < 8; ++mt)
#pragma unroll
            for (int i = 0; i < 16; ++i) mx = fmaxf(mx, sacc[mt][i]);
        mx = fmaxf(mx, __shfl_xor(mx, 32));
        const float sc = 0.07216878364870323f * 1.4426950408889634f;
        float l = 0.f;
        bf16x8 pf[8][2];
#pragma unroll
        for (int mt = 0; mt < 8; ++mt) {
            float p[16];
#pragma unroll
            for (int i = 0; i < 16; ++i) { p[i] = __builtin_amdgcn_exp2f((sacc[mt][i] - mx) * sc); l += p[i]; }
#pragma unroll
            for (int s2 = 0; s2 < 2; ++s2) { const u32x4 w = {pkbf(p[8 * s2 + 0], p[8 * s2 + 1]), pkbf(p[8 * s2 + 2], p[8 * s2 + 3]), pkbf(p[8 * s2 + 4], p[8 * s2 + 5]), pkbf(p[8 * s2 + 6], p[8 * s2 + 7])};
                pf[mt][s2] = __builtin_bit_cast(bf16x8, w); }
        }
        l += __shfl_xor(l, 32);
        __syncthreads();
        for (int c = tid; c < 192 * 32; c += NTHR) { const int row = c >> 5, ch = c & 31;
            *(LAS u32x4*)(sm + row * VST + ch * 16) = *(const u32x4*)(MVT + (size_t)(head * 192 + row) * 2048 + b * NMEM + ch * 8); }
        __syncthreads();
        const float il = 1.0f / l;
        bf16* yp = Y + ((size_t)half * HT + r) * YC + 1280 + head * 192 + 4 * h;
#pragma unroll
        for (int dt = 0; dt < 6; ++dt) {
            f32x16 o;
#pragma unroll
            for (int i = 0; i < 16; ++i) o[i] = 0.f;
#pragma unroll
            for (int mt = 0; mt < 8; ++mt)
#pragma unroll
                for (int s2 = 0; s2 < 2; ++s2) { const LAS unsigned char* vp = sm + (32 * dt + ql) * VST + (32 * mt + 16 * s2 + 4 * h) * 2;
                    const bf16x8 vf = mk_bf16x8(*(const LAS u32x2*)vp, *(const LAS u32x2*)(vp + 16)); o = MFMA32(vf, pf[mt][s2], o); }
#pragma unroll
            for (int g = 0; g < 4; ++g) { const u32x2 w = {pkbf(o[4 * g] * il, o[4 * g + 1] * il), pkbf(o[4 * g + 2] * il, o[4 * g + 3] * il)}; *(u32x2*)(yp + 32 * dt + 8 * g) = w; }
        }
    }
}

__device__ __forceinline__ void dilattn_mfma_phase(Frame& F, int half) {
    bf16* P = (bf16*)(F.ws + WS_BIG);
    float* LSE = (float*)(F.ws + WS_LSE);
    LAS unsigned char* sK = F.lds; LAS unsigned char* sV = F.lds + 384 * 144;
    const int tid = F.tid, lane = F.lane, wave = F.wave, ql = lane & 31, h = lane >> 5;
    constexpr int RST = 144;
    const float* RT = (const float*)(F.ws + WS_ROPE);
    float wk8[8];
#pragma unroll
    for (int j = 0; j < 8; ++j) wk8[j] = F.in[I_DKNW][8 * (tid & 7) + j];
    for (int unit = F.bid; unit < HB * 12 * 32; unit += F.G) {
        const int bl = unit / 384, rem = unit % 384, head = rem >> 5, blk = rem & 31;
        const int g = head >> 2, dil = (g == 0) ? 1 : (g == 1 ? 4 : 16), bpr = 32 / dil;
        const int res = blk / bpr, q0 = (blk % bpr) * 256;
        const size_t rowb = (size_t)bl * SEQ;
        __syncthreads();
        for (int c = tid; c < 384 * 8; c += NTHR) { const int row = c >> 3, ch = c & 7; const int ks = q0 - 128 + row;
            u32x4 kv = {0u, 0u, 0u, 0u}, vv = {0u, 0u, 0u, 0u}; f32x4 c0 = {1.f, 1.f, 1.f, 1.f}, c1 = c0, s0 = {0.f, 0.f, 0.f, 0.f}, s1 = s0;
            if (ks >= 0) { const size_t rr = rowb + (size_t)ks * dil + res; const bf16* src = P + rr * NPROJ + head * 64 + ch * 8; kv = *(const u32x4*)(src + PC_DK); vv = *(const u32x4*)(src + PC_DV);
                if (ch < 2) { const f32x4* rt = (const f32x4*)(RT + ((size_t)half * HT + rr) * 16); c0 = rt[0]; c1 = rt[1]; s0 = rt[2]; s1 = rt[3]; } }
            float x[8] = {bflo(kv.x), bfhi(kv.x), bflo(kv.y), bfhi(kv.y), bflo(kv.z), bfhi(kv.z), bflo(kv.w), bfhi(kv.w)};
            float ss = 0.f;
#pragma unroll
            for (int j = 0; j < 8; ++j) ss += x[j] * x[j];
            ss += __shfl_xor(ss, 1); ss += __shfl_xor(ss, 2); ss += __shfl_xor(ss, 4);
            const float rs = 1.0f / sqrtf(ss * (1.f / 64.f) + EPS);
            const float cs[8] = {c0.x, c0.y, c0.z, c0.w, c1.x, c1.y, c1.z, c1.w}, sn[8] = {s0.x, s0.y, s0.z, s0.w, s1.x, s1.y, s1.z, s1.w};
#pragma unroll
            for (int j = 0; j < 8; ++j) { x[j] = x[j] * rs * wk8[j]; const float o = __shfl_xor(x[j], 1); if (ch == 0) x[j] = x[j] * cs[j] - o * sn[j]; else if (ch == 1) x[j] = x[j] * cs[j] + o * sn[j]; }
            kv = (u32x4){pkbf(x[0], x[1]), pkbf(x[2], x[3]), pkbf(x[4], x[5]), pkbf(x[6], x[7])};
            *(LAS u32x4*)(sK + row * RST + ch * 16) = kv; *(LAS u32x4*)(sV + row * RST + ch * 16) = vv; }
        const int qs = q0 + wave * 32 + ql;
        const size_t rq = rowb + (size_t)qs * dil + res;
        bf16* qp = P + rq * NPROJ + PC_DQ + head * 64;
        bf16x8 qf[4];
        {
            u32x4 qr[4];
#pragma unroll
            for (int ks = 0; ks < 4; ++ks) qr[ks] = *(const u32x4*)(qp + 16 * ks + 8 * h);
            const f32x4* rt = (const f32x4*)(RT + ((size_t)half * HT + rq) * 16); const f32x4 c0 = rt[0], c1 = rt[1], s0 = rt[2], s1 = rt[3];
            float ss = 0.f;
#pragma unroll
            for (int ks = 0; ks < 4; ++ks) ss += (bflo(qr[ks].x) * bflo(qr[ks].x) + bfhi(qr[ks].x) * bfhi(qr[ks].x)) + (bflo(qr[ks].y) * bflo(qr[ks].y) + bfhi(qr[ks].y) * bfhi(qr[ks].y))
                                               + (bflo(qr[ks].z) * bflo(qr[ks].z) + bfhi(qr[ks].z) * bfhi(qr[ks].z)) + (bflo(qr[ks].w) * bflo(qr[ks].w) + bfhi(qr[ks].w) * bfhi(qr[ks].w));
            ss += __shfl_xor(ss, 32);
            const float rs = 1.0f / sqrtf(ss * (1.f / 64.f) + EPS);
#pragma unroll
            for (int ks = 0; ks < 4; ++ks) { const f32x4 wa = *(const f32x4*)(F.in[I_DQNW] + 16 * ks + 8 * h), wb = *(const f32x4*)(F.in[I_DQNW] + 16 * ks + 8 * h + 4);
                float x[8] = {bflo(qr[ks].x) * rs * wa.x, bfhi(qr[ks].x) * rs * wa.y, bflo(qr[ks].y) * rs * wa.z, bfhi(qr[ks].y) * rs * wa.w, bflo(qr[ks].z) * rs * wb.x, bfhi(qr[ks].z) * rs * wb.y, bflo(qr[ks].w) * rs * wb.z, bfhi(qr[ks].w) * rs * wb.w};
                if (ks == 0) { const float cs[8] = {c0.x, c0.y, c0.z, c0.w, c1.x, c1.y, c1.z, c1.w}, sn[8] = {s0.x, s0.y, s0.z, s0.w, s1.x, s1.y, s1.z, s1.w};
#pragma unroll
                    for (int j = 0; j < 8; ++j) { const float o = __shfl_xor(x[j], 32); x[j] = (h == 0) ? x[j] * cs[j] - o * sn[j] : x[j] * cs[j] + o * sn[j]; } }
                const u32x4 w = {pkbf(x[0], x[1]), pkbf(x[2], x[3]), pkbf(x[4], x[5]), pkbf(x[6], x[7])}; qf[ks] = __builtin_bit_cast(bf16x8, w); }
        }
        __syncthreads();
        f32x16 sacc[5];
        const int kfirst = q0 + wave * 32 - 128;
#pragma unroll
        for (int i = 0; i < 5; ++i) {
#pragma unroll
            for (int e = 0; e < 16; ++e) sacc[i][e] = 0.f;
#pragma unroll
            for (int ks = 0; ks < 4; ++ks) { const bf16x8 kf = *(const LAS bf16x8*)(sK + (32 * wave + 32 * i + ql) * RST + 32 * ks + 16 * h); sacc[i] = MFMA32(kf, qf[ks], sacc[i]); }
        }
        float mx = -3.0e38f;
#pragma unroll
        for (int i = 0; i < 5; ++i)
#pragma unroll
            for (int e = 0; e < 16; ++e) { const int kj = 32 * i + (e & 3) + 8 * (e >> 2) + 4 * h; const bool ok = (kj >= ql) && (kj <= ql + 128) && (kfirst + kj >= 0);
                sacc[i][e] = ok ? sacc[i][e] : -3.0e38f; mx = fmaxf(mx, sacc[i][e]); }
        mx = fmaxf(mx, __shfl_xor(mx, 32));
        const float sc = 0.125f * 1.4426950408889634f;
        float l = 0.f;
        bf16x8 pf[5][2];
#pragma unroll
        for (int i = 0; i < 5; ++i) {
            float p[16];
#pragma unroll
            for (int e = 0; e < 16; ++e) { p[e] = (sacc[i][e] > -1.0e38f) ? __builtin_amdgcn_exp2f((sacc[i][e] - mx) * sc) : 0.f; l += p[e]; }
#pragma unroll
            for (int s2 = 0; s2 < 2; ++s2) { const u32x4 w = {pkbf(p[8 * s2 + 0], p[8 * s2 + 1]), pkbf(p[8 * s2 + 2], p[8 * s2 + 3]), pkbf(p[8 * s2 + 4], p[8 * s2 + 5]), pkbf(p[8 * s2 + 6], p[8 * s2 + 7])};
                pf[i][s2] = __builtin_bit_cast(bf16x8, w); }
        }
        l += __shfl_xor(l, 32);
        const float il = 1.0f / l;
        const int tq = (lane & 15) >> 2, tp = lane & 3, tblk = (lane >> 4) & 1;
        const unsigned vbase = (unsigned)(size_t)(sV) + (unsigned)((32 * wave + 4 * h + tq) * RST + (16 * tblk + 4 * tp) * 2);
#pragma unroll
        for (int dt = 0; dt < 2; ++dt) {
            f32x16 o;
#pragma unroll
            for (int e = 0; e < 16; ++e) o[e] = 0.f;
#pragma unroll
            for (int i = 0; i < 5; ++i) {
                s16x4 lo[2], hi[2];
#pragma unroll
                for (int s2 = 0; s2 < 2; ++s2) { const unsigned a = vbase + (unsigned)((32 * i + 16 * s2) * RST + 64 * dt);
                    asm volatile("ds_read_b64_tr_b16 %0, %1" : "=&v"(lo[s2]) : "v"(a) : "memory");
                    asm volatile("ds_read_b64_tr_b16 %0, %1 offset:1152" : "=&v"(hi[s2]) : "v"(a) : "memory"); }
                asm volatile("s_waitcnt lgkmcnt(0)" ::: "memory"); __builtin_amdgcn_sched_barrier(0);
#pragma unroll
                for (int s2 = 0; s2 < 2; ++s2) { const bf16x8 vf = {lo[s2][0], lo[s2][1], lo[s2][2], lo[s2][3], hi[s2][0], hi[s2][1], hi[s2][2], hi[s2][3]}; o = MFMA32(vf, pf[i][s2], o); }
            }
#pragma unroll
            for (int gq = 0; gq < 4; ++gq) { const u32x2 w = {pkbf(o[4 * gq] * il, o[4 * gq + 1] * il), pkbf(o[4 * gq + 2] * il, o[4 * gq + 3] * il)}; *(u32x2*)(qp + 32 * dt + 8 * gq + 4 * h) = w; }
        }
        if (h == 0) LSE[((size_t)half * HT + rq) * 12 + head] = mx * 0.125f + __logf(l);
    }
}

__device__ __forceinline__ void dilmerge_phase(Frame& F, int half) {
    const bf16* P = (const bf16*)(F.ws + WS_BIG);
    const float* LSE = (const float*)(F.ws + WS_LSE);
    bf16* Y = (bf16*)F.out;
    const size_t gtid = (size_t)F.bid * NTHR + F.tid, gth = (size_t)F.G * NTHR;
    for (size_t it = gtid; it < (size_t)HT * 32; it += gth) {
        const size_t r = it >> 5; const int hh = (int)(it >> 3) & 3, d0 = (int)(it & 7) * 8;
        const size_t tok = (size_t)half * HT + r;
        const float l0 = LSE[tok * 12 + hh], l1 = LSE[tok * 12 + 4 + hh], l2 = LSE[tok * 12 + 8 + hh];
        const float m = fmaxf(l0, fmaxf(l1, l2));
        float w0 = __expf(l0 - m), w1 = __expf(l1 - m), w2 = __expf(l2 - m); const float iw = 1.0f / (w0 + w1 + w2); w0 *= iw; w1 *= iw; w2 *= iw;
        const bf16* op = P + r * NPROJ + PC_DQ + hh * 64 + d0;
        const u32x4 a = *(const u32x4*)op, b = *(const u32x4*)(op + 256), c = *(const u32x4*)(op + 512);
        u32x4 o;
        o.x = pkbf(w0 * bflo(a.x) + w1 * bflo(b.x) + w2 * bflo(c.x), w0 * bfhi(a.x) + w1 * bfhi(b.x) + w2 * bfhi(c.x));
        o.y = pkbf(w0 * bflo(a.y) + w1 * bflo(b.y) + w2 * bflo(c.y), w0 * bfhi(a.y) + w1 * bfhi(b.y) + w2 * bfhi(c.y));
        o.z = pkbf(w0 * bflo(a.z) + w1 * bflo(b.z) + w2 * bflo(c.z), w0 * bfhi(a.z) + w1 * bfhi(b.z) + w2 * bfhi(c.z));
        o.w = pkbf(w0 * bflo(a.w) + w1 * bflo(b.w) + w2 * bflo(c.w), w0 * bfhi(a.w) + w1 * bfhi(b.w) + w2 * bfhi(c.w));
        *(u32x4*)(Y + tok * YC + 1024 + hh * 64 + d0) = o;
    }
}

__device__ __forceinline__ void hn_phase(Frame& F) {
    const int gw = F.bid * NWAVES + F.wave, NGW = F.G * NWAVES;
    for (int m = gw; m < T; m += NGW) { f32x4 v[4]; rms_row_to_bf16(F.out + (size_t)m * DM, F.in[I_NFFNW], (bf16*)(F.ws + WS_ACT1) + (size_t)m * DM, F.lane, v); }
}


__device__ __forceinline__ float gelu_erf(float x) { return 0.5f * x * (1.0f + erff(x * 0.70710678118654752f)); }
__device__ __forceinline__ unsigned f2ord(float f) { const unsigned u = __builtin_bit_cast(unsigned, f); return u ^ ((unsigned)((int)u >> 31) | 0x80000000u); }
__device__ __forceinline__ float ord2f(unsigned k) { const unsigned m = (unsigned)((int)k >> 31); return __builtin_bit_cast(float, k ^ (0x80000000u | ~m)); }
#define CMPX(a, b) do { const unsigned _mx = max((a), (b)), _mn = min((a), (b)); (a) = _mx; (b) = _mn; } while (0)
__device__ __forceinline__ void bitonic_sort16_desc(unsigned (&v)[16]) {
#pragma unroll
    for (int k = 2; k <= 16; k <<= 1)
#pragma unroll
        for (int j = k >> 1; j > 0; j >>= 1)
#pragma unroll
            for (int i = 0; i < 16; ++i) { const int l = i ^ j; if (l > i) { if ((i & k) == 0) CMPX(v[i], v[l]); else CMPX(v[l], v[i]); } }
}
__device__ __forceinline__ void bitonic_merge16_desc(unsigned (&v)[16]) {
#pragma unroll
    for (int j = 8; j > 0; j >>= 1)
#pragma unroll
        for (int i = 0; i < 16; ++i) { const int l = i ^ j; if (l > i) CMPX(v[i], v[l]); }
}
__device__ __forceinline__ void top16_merge(unsigned (&a)[16], const unsigned (&b)[16]) {
#pragma unroll
    for (int i = 0; i < 16; ++i) a[i] = max(a[i], b[15 - i]);
    bitonic_merge16_desc(a);
}
constexpr int PK_ST = 272;
__device__ __forceinline__ void peer_topk_tile(Frame& F, size_t tok0, const bf16* Q, int* IDX, float* GATE) {
    const bf16* SK = (const bf16*)(F.ws + WS_SUBK);
    LAS unsigned char* sK = F.lds;
    int tid = F.tid; asm volatile("" : "+v"(tid));
    const int lane = tid & 63, wave = F.wave, ql = lane & 31, hh = lane >> 5;
    const size_t tok = tok0 + wave * 32 + ql;
    const bf16* qrow = Q + tok * PEER_Q + 8 * hh;
    __syncthreads();
#pragma unroll
    for (int j = 0; j < 4; ++j) { const int cidx = tid + 512 * j, row = cidx >> 4, ch = cidx & 15; *(LAS u32x4*)(sK + row * PK_ST + ch * 16) = *(const u32x4*)(SK + (size_t)row * 128 + ch * 8); }
    __syncthreads();
    unsigned k1[16];
    bf16x8 qf[8];
#pragma unroll
    for (int ks = 0; ks < 8; ++ks) qf[ks] = *(const bf16x8*)(qrow + 16 * ks);
#pragma unroll 1
    for (int hc = 0; hc < 16; ++hc) {
        LAS unsigned char* cur = sK + (hc & 1) * (128 * PK_ST); LAS unsigned char* nxt = sK + ((hc + 1) & 1) * (128 * PK_ST);
        u32x4 stg[4];
        const int hcn = (hc + 1) & 15;
#pragma unroll
        for (int j = 0; j < 4; ++j) { const int cidx = tid + 512 * j, row = cidx >> 4, ch = cidx & 15; stg[j] = *(const u32x4*)(SK + ((size_t)hcn * 128 + row) * 128 + ch * 8); }
        unsigned pk[4][16];
#pragma unroll
        for (int mt = 0; mt < 4; ++mt) {
            f32x16 acc;
#pragma unroll
            for (int e = 0; e < 16; ++e) acc[e] = 0.f;
#pragma unroll
            for (int ks = 0; ks < 8; ++ks) { const bf16x8 kf = *(const LAS bf16x8*)(cur + (32 * mt + ql) * PK_ST + 32 * ks + 16 * hh); acc = MFMA32(kf, qf[ks], acc); }
#pragma unroll
            for (int e = 0; e < 16; ++e) pk[mt][e] = (f2ord(acc[e]) & 0xFFFFFF80u) | (unsigned)(32 * mt + (e & 3) + 8 * (e >> 2) + 4 * hh);
        }
#pragma unroll
        for (int j = 0; j < 4; ++j) { const int cidx = tid + 512 * j, row = cidx >> 4, ch = cidx & 15; *(LAS u32x4*)(nxt + row * PK_ST + ch * 16) = stg[j]; }
        __syncthreads();
        __builtin_amdgcn_sched_barrier(0);
#pragma unroll
        for (int ks = 0; ks < 8; ++ks) qf[ks] = *(const bf16x8*)(qrow + hcn * 128 + 16 * ks);
        __builtin_amdgcn_sched_barrier(0);
#pragma unroll
        for (int mt = 0; mt < 4; ++mt) bitonic_sort16_desc(pk[mt]);
        top16_merge(pk[0], pk[1]); top16_merge(pk[2], pk[3]); top16_merge(pk[0], pk[2]);
        unsigned other[16];
#pragma unroll
        for (int i = 0; i < 16; ++i) other[i] = (unsigned)__shfl_xor((int)pk[0][i], 32);
        top16_merge(pk[0], other);
        if ((hc & 1) == 0) {
#pragma unroll
            for (int i = 0; i < 16; ++i) k1[i] = pk[0][i];
        } else {
            float f1[16], f2[16];
#pragma unroll
            for (int i = 0; i < 16; ++i) { f1[i] = ord2f(k1[i] & 0xFFFFFF80u); f2[i] = ord2f(pk[0][i] & 0xFFFFFF80u); }
            unsigned cd[4][16];
#pragma unroll
            for (int i = 0; i < 64; ++i) cd[i >> 4][i & 15] = 0u;
            int n = 0;
#pragma unroll
            for (int a = 0; a < 16; ++a)
#pragma unroll
                for (int b = 0; b < 16; ++b)
                    if ((a + 1) * (b + 1) <= 16) { cd[n >> 4][n & 15] = (f2ord(f1[a] + f2[b]) & 0xFFFFC000u) | ((k1[a] & 127u) << 7) | (pk[0][b] & 127u); ++n; }
#pragma unroll
            for (int g4 = 0; g4 < 4; ++g4) bitonic_sort16_desc(cd[g4]);
            top16_merge(cd[0], cd[1]); top16_merge(cd[2], cd[3]); top16_merge(cd[0], cd[2]);
            const float vmax = ord2f(cd[0][0] & 0xFFFFC000u);
            float ex[16], den = 0.f;
#pragma unroll
            for (int i = 0; i < 16; ++i) { ex[i] = __expf(ord2f(cd[0][i] & 0xFFFFC000u) - vmax); den += ex[i]; }
            const float iden = 1.0f / den;
            const int h = hc >> 1;
            if (hh == 0) { int* ip = IDX + tok * 128 + h * 16;
#pragma unroll
                for (int i = 0; i < 4; ++i) { const u32x4 w = {cd[0][4 * i] & 0x3FFFu, cd[0][4 * i + 1] & 0x3FFFu, cd[0][4 * i + 2] & 0x3FFFu, cd[0][4 * i + 3] & 0x3FFFu}; *(u32x4*)(ip + 4 * i) = w; } }
            else { float* gp = GATE + tok * 128 + h * 16;
#pragma unroll
                for (int i = 0; i < 4; ++i) { const f32x4 w = {ex[4 * i] * iden, ex[4 * i + 1] * iden, ex[4 * i + 2] * iden, ex[4 * i + 3] * iden}; *(f32x4*)(gp + 4 * i) = w; } }
        }
    }
}

struct PeerDeal { size_t tokw; int ntok; size_t tok0; float* PART; const int* IDX; const float* GATE; float* COEF; };
__device__ __forceinline__ void peer_item(int n, const PeerDeal& D, int wave, int& slice, size_t& tok) { slice = n >> 5; tok = D.tokw + (n & 31); }
__device__ __forceinline__ void peer_down_rows(u32x4 (&R)[16], __amdgpu_buffer_rsrc_t tab, int slice, int id0, int id1, int lane) {
    const int soff = slice * (16384 * 128);
    const int r = lane & 15, g = lane >> 4, e8 = (r >> 2) + 4 * (g >> 1), q = 4 * (g & 1) + (r & 3);
    const int src0 = 16 * (e8 & 3);
#pragma unroll
    for (int k = 0; k < 16; ++k) { const int v0 = __shfl(id0, src0 + k), v1 = __shfl(id1, src0 + k); const int id = (e8 < 4) ? v0 : v1;
        R[k] = __builtin_amdgcn_raw_buffer_load_b128(tab, (id << 7) + 16 * q, soff, 0); }
}
__device__ __forceinline__ void peer_down_hn(u32x4 (&H)[2], const bf16* HN, int slice, size_t tok, int lane) {
    const bf16* hp = HN + tok * DM + slice * 128 + 16 * (4 * ((lane >> 4) & 1) + (lane & 3));
    H[0] = *(const u32x4*)hp; H[1] = *(const u32x4*)(hp + 8);
}
__device__ __forceinline__ void peer_down_bq(long (&bq)[2], const u32x4 (&H)[2], int lane) {
    const int c = lane & 15, g = lane >> 4; const bool on = (c < 8) && ((c >> 2) == (g >> 1));
    const u32x4 x0 = H[0], x1 = H[1];
    unsigned p0 = __builtin_amdgcn_cvt_pk_fp8_f32(bflo(x0.x), bfhi(x0.x), 0, false); p0 = __builtin_amdgcn_cvt_pk_fp8_f32(bflo(x0.y), bfhi(x0.y), p0, true);
    unsigned p1 = __builtin_amdgcn_cvt_pk_fp8_f32(bflo(x0.z), bfhi(x0.z), 0, false); p1 = __builtin_amdgcn_cvt_pk_fp8_f32(bflo(x0.w), bfhi(x0.w), p1, true);
    unsigned p2 = __builtin_amdgcn_cvt_pk_fp8_f32(bflo(x1.x), bfhi(x1.x), 0, false); p2 = __builtin_amdgcn_cvt_pk_fp8_f32(bflo(x1.y), bfhi(x1.y), p2, true);
    unsigned p3 = __builtin_amdgcn_cvt_pk_fp8_f32(bflo(x1.z), bfhi(x1.z), 0, false); p3 = __builtin_amdgcn_cvt_pk_fp8_f32(bflo(x1.w), bfhi(x1.w), p3, true);
    if (!on) { p0 = 0u; p1 = 0u; p2 = 0u; p3 = 0u; }
    bq[0] = (long)(((unsigned long long)p1 << 32) | p0); bq[1] = (long)(((unsigned long long)p3 << 32) | p2);
}
__device__ __forceinline__ void peer_down_mfma(const u32x4 (&R)[16], const long (&bq)[2], __amdgpu_buffer_rsrc_t prsrc, int slice, int tokl, int lane) {
    const int c = lane & 15, g = lane >> 4, cb = c & 3;
    float dv[16];
#pragma unroll
    for (int k = 0; k < 16; ++k) { f32x4 acc = {0.f, 0.f, 0.f, 0.f}; const u32x4 v = R[k];
        acc = __builtin_amdgcn_mfma_f32_16x16x32_fp8_fp8((long)(((unsigned long long)v.y << 32) | v.x), bq[0], acc, 0, 0, 0);
        acc = __builtin_amdgcn_mfma_f32_16x16x32_fp8_fp8((long)(((unsigned long long)v.w << 32) | v.z), bq[1], acc, 0, 0, 0);
        float t = (cb == 0) ? acc.x : (cb == 1) ? acc.y : (cb == 2) ? acc.z : acc.w;
        t += __shfl_xor(t, 1); t += __shfl_xor(t, 2); dv[k] = t; }
    const unsigned off = ((c & 3) == 0 && c < 8) ? (unsigned)(((tokl * 8 + slice) * 128 + 16 * (g + 4 * (c >> 2))) * 4) : 0xFFFFFF00u;
#pragma unroll
    for (int i = 0; i < 4; ++i) { const f32x4 w = {dv[4 * i], dv[4 * i + 1], dv[4 * i + 2], dv[4 * i + 3]}; __builtin_amdgcn_raw_buffer_store_b128(__builtin_bit_cast(u32x4, w), prsrc, off, 16 * i, 0); }
}
__device__ __forceinline__ void peer_down_phase(Frame& F, const PeerDeal& D) {
    const __amdgpu_buffer_rsrc_t PD = __builtin_amdgcn_make_buffer_rsrc((void*)(F.ws + WS_PD), 0, 16384 * 1024, 0x00020000); const bf16* HN = (const bf16*)(F.ws + WS_ACT1);
    const int* IDX = D.IDX;
    const __amdgpu_buffer_rsrc_t prsrc = __builtin_amdgcn_make_buffer_rsrc((void*)D.PART, 0, 256 * 8 * 128 * 4, 0x00020000);
    int lane = F.lane; asm volatile("" : "+v"(lane));
    const int wave = F.wave;
    const int ntok = D.ntok;
    u32x4 RA[16], RB[16], HA[2], HB[2]; int ia0, ia1, ib0, ib1; long bq[2];
#define PEER_TOK(k, sv, tv) int sv; size_t tv; peer_item((k) < ntok ? (k) : ntok - 2 + ((k) & 1), D, wave, sv, tv)
    { PEER_TOK(0, s0, t0); PEER_TOK(1, s1, t1); PEER_TOK(2, s2, t2); PEER_TOK(3, s3, t3);
      const int a0 = IDX[t0 * 128 + lane], a1 = IDX[t0 * 128 + 64 + lane], b0 = IDX[t1 * 128 + lane], b1 = IDX[t1 * 128 + 64 + lane];
      ia0 = IDX[t2 * 128 + lane]; ia1 = IDX[t2 * 128 + 64 + lane]; ib0 = IDX[t3 * 128 + lane]; ib1 = IDX[t3 * 128 + 64 + lane];
      __builtin_amdgcn_sched_barrier(0);
      peer_down_rows(RA, PD, s0, a0, a1, lane); peer_down_hn(HA, HN, s0, t0, lane);
      __builtin_amdgcn_sched_barrier(0);
      peer_down_rows(RB, PD, s1, b0, b1, lane); peer_down_hn(HB, HN, s1, t1, lane);
      __builtin_amdgcn_sched_barrier(0); }
#pragma unroll 1
    for (int n = 0; n < ntok; n += 2) {
        PEER_TOK(n, s0, t0); PEER_TOK(n + 1, s1, t1); PEER_TOK(n + 2, s2, t2); PEER_TOK(n + 3, s3, t3); PEER_TOK(n + 4, s4, t4); PEER_TOK(n + 5, s5, t5);
        peer_down_bq(bq, HA, lane);
        peer_down_mfma(RA, bq, prsrc, s0, (int)(t0 - D.tok0), lane);
        __builtin_amdgcn_sched_barrier(0);
        { const int j0 = IDX[t4 * 128 + lane], j1 = IDX[t4 * 128 + 64 + lane];
          peer_down_rows(RA, PD, s2, ia0, ia1, lane); peer_down_hn(HA, HN, s2, t2, lane); ia0 = j0; ia1 = j1; }
        __builtin_amdgcn_sched_barrier(0);
        peer_down_bq(bq, HB, lane);
        peer_down_mfma(RB, bq, prsrc, s1, (int)(t1 - D.tok0), lane);
        __builtin_amdgcn_sched_barrier(0);
        { const int j0 = IDX[t5 * 128 + lane], j1 = IDX[t5 * 128 + 64 + lane];
          peer_down_rows(RB, PD, s3, ib0, ib1, lane); peer_down_hn(HB, HN, s3, t3, lane); ib0 = j0; ib1 = j1; }
        __builtin_amdgcn_sched_barrier(0);
    }
#undef PEER_TOK
}
__device__ __forceinline__ void peer_coef_wave(Frame& F, const PeerDeal& D) {
    for (int k = F.lane; k < 32 * 32; k += 64) {
        const int tl = (int)(D.tokw - D.tok0) + (k >> 5), slot = 4 * (k & 31);
        const float* pp = D.PART + (size_t)tl * 1024 + slot;
        f32x4 sm = *(const f32x4*)pp;
#pragma unroll
        for (int x = 1; x < 8; ++x) sm += *(const f32x4*)(pp + 128 * x);
        const size_t i = (D.tok0 + tl) * 128 + slot;
        const f32x4 gt = *(const f32x4*)(D.GATE + i);
        const f32x4 o = {gt.x * gelu_erf(sm.x * (1.0f / PD_SCALE)) * (1.0f / PU_SCALE), gt.y * gelu_erf(sm.y * (1.0f / PD_SCALE)) * (1.0f / PU_SCALE),
                         gt.z * gelu_erf(sm.z * (1.0f / PD_SCALE)) * (1.0f / PU_SCALE), gt.w * gelu_erf(sm.w * (1.0f / PD_SCALE)) * (1.0f / PU_SCALE)};
        *(f32x4*)(D.COEF + i) = o;
    }
}
__device__ __forceinline__ void peer_up_rows(u32x4 (&R)[16], __amdgpu_buffer_rsrc_t tab, int slice, int id0, int id1, int lane) {
    const int soff = slice * (16384 * 128);
#pragma unroll
    for (int s8 = 0; s8 < 8; ++s8) { const int id = __shfl(s8 < 4 ? id0 : id1, (16 * s8 + (lane >> 2)) & 63); const int vo = (id << 7) + 16 * (lane & 3);
        R[2 * s8] = __builtin_amdgcn_raw_buffer_load_b128(tab, vo, soff, 0); R[2 * s8 + 1] = __builtin_amdgcn_raw_buffer_load_b128(tab, vo, soff + 64, 0); }
}
__device__ __forceinline__ void peer_up_compute(const u32x4 (&R)[16], float c0, float c1, f32x2 h, float* out, int slice, size_t tok, int lane) {
    f32x2 acc[16];
#pragma unroll
    for (int k = 0; k < 16; ++k) acc[k] = (f32x2){0.f, 0.f};
#pragma unroll
    for (int s8 = 0; s8 < 8; ++s8) { const float c = __shfl(s8 < 4 ? c0 : c1, (16 * s8 + (lane >> 2)) & 63); f32x2 c2 = {c, c}; asm volatile("" : "+v"(c2));
#pragma unroll
        for (int hf = 0; hf < 2; ++hf) { const u32x4 r = R[2 * s8 + hf];
            acc[8 * hf + 0] = c2 * __builtin_amdgcn_cvt_pk_f32_fp8(r.x, false) + acc[8 * hf + 0]; acc[8 * hf + 1] = c2 * __builtin_amdgcn_cvt_pk_f32_fp8(r.x, true) + acc[8 * hf + 1];
            acc[8 * hf + 2] = c2 * __builtin_amdgcn_cvt_pk_f32_fp8(r.y, false) + acc[8 * hf + 2]; acc[8 * hf + 3] = c2 * __builtin_amdgcn_cvt_pk_f32_fp8(r.y, true) + acc[8 * hf + 3];
            acc[8 * hf + 4] = c2 * __builtin_amdgcn_cvt_pk_f32_fp8(r.z, false) + acc[8 * hf + 4]; acc[8 * hf + 5] = c2 * __builtin_amdgcn_cvt_pk_f32_fp8(r.z, true) + acc[8 * hf + 5];
            acc[8 * hf + 6] = c2 * __builtin_amdgcn_cvt_pk_f32_fp8(r.w, false) + acc[8 * hf + 6]; acc[8 * hf + 7] = c2 * __builtin_amdgcn_cvt_pk_f32_fp8(r.w, true) + acc[8 * hf + 7]; } }
    f32x2 r8[8], r4[4], r2[2], r1;
    { const bool up = (lane & 32) != 0;
#pragma unroll
      for (int k = 0; k < 8; ++k) { const f32x2 keep = up ? acc[k + 8] : acc[k], send = up ? acc[k] : acc[k + 8]; r8[k] = keep + (f32x2){__shfl_xor(send.x, 32), __shfl_xor(send.y, 32)}; } }
    { const bool up = (lane & 16) != 0;
#pragma unroll
      for (int k = 0; k < 4; ++k) { const f32x2 keep = up ? r8[k + 4] : r8[k], send = up ? r8[k] : r8[k + 4]; r4[k] = keep + (f32x2){__shfl_xor(send.x, 16), __shfl_xor(send.y, 16)}; } }
    { const bool up = (lane & 8) != 0;
#pragma unroll
      for (int k = 0; k < 2; ++k) { const f32x2 keep = up ? r4[k + 2] : r4[k], send = up ? r4[k] : r4[k + 2]; r2[k] = keep + (f32x2){__shfl_xor(send.x, 8), __shfl_xor(send.y, 8)}; } }
    { const bool up = (lane & 4) != 0; const f32x2 keep = up ? r2[1] : r2[0], send = up ? r2[0] : r2[1]; r1 = keep + (f32x2){__shfl_xor(send.x, 4), __shfl_xor(send.y, 4)}; }
    const int p = ((lane >> 5) & 1) * 8 + ((lane >> 4) & 1) * 4 + ((lane >> 3) & 1) * 2 + ((lane >> 2) & 1);
    *(f32x2*)(out + tok * DM + slice * 128 + 16 * (lane & 3) + 2 * (p & 7) + 64 * (p >> 3)) = h + r1;
}
__device__ __forceinline__ void peer_up_phase(Frame& F, const PeerDeal& D, float* outp) {
    const __amdgpu_buffer_rsrc_t PU = __builtin_amdgcn_make_buffer_rsrc((void*)(F.ws + WS_PU), 0, 16384 * 1024, 0x00020000);
    const int* IDX = D.IDX; const float* COEF = D.COEF;
    int lane = F.lane; asm volatile("" : "+v"(lane));
    const int wave = F.wave;
    const int ntok = D.ntok;
    const int p = ((lane >> 5) & 1) * 8 + ((lane >> 4) & 1) * 4 + ((lane >> 3) & 1) * 2 + ((lane >> 2) & 1);
    const int hoff = 16 * (lane & 3) + 2 * (p & 7) + 64 * (p >> 3);
    int sl; size_t tk;
    u32x4 R0[16], R1[16];
    float ca0, ca1, cb0, cb1; f32x2 ha, hb;
    int id0, id1, jd0, jd1;
    { int s1_; size_t t1_; peer_item(0, D, wave, sl, tk); peer_item(1, D, wave, s1_, t1_);
      jd0 = IDX[tk * 128 + lane]; jd1 = IDX[tk * 128 + 64 + lane]; id0 = IDX[t1_ * 128 + lane]; id1 = IDX[t1_ * 128 + 64 + lane];
      __builtin_amdgcn_sched_barrier(0);
      peer_up_rows(R0, PU, sl, jd0, jd1, lane);
      ca0 = COEF[tk * 128 + lane]; ca1 = COEF[tk * 128 + 64 + lane]; ha = *(const f32x2*)(F.out + tk * DM + sl * 128 + hoff);
      __builtin_amdgcn_sched_barrier(0); }
#pragma unroll 1
    for (int n = 0; n < ntok; n += 2) {
        int s0, s1, s2, s3; size_t t0, t1, t2, t3;
        peer_item(n, D, wave, s0, t0); peer_item(n + 1, D, wave, s1, t1);
        peer_item(n + 2 < ntok ? n + 2 : n, D, wave, s2, t2); peer_item(n + 3 < ntok ? n + 3 : n + 1, D, wave, s3, t3);
        jd0 = IDX[t2 * 128 + lane]; jd1 = IDX[t2 * 128 + 64 + lane];
        peer_up_rows(R1, PU, s1, id0, id1, lane);
        cb0 = COEF[t1 * 128 + lane]; cb1 = COEF[t1 * 128 + 64 + lane]; hb = *(const f32x2*)(F.out + t1 * DM + s1 * 128 + hoff);
        __builtin_amdgcn_sched_barrier(0);
        peer_up_compute(R0, ca0, ca1, ha, outp, s0, t0, lane);
        __builtin_amdgcn_sched_barrier(0);
        id0 = IDX[t3 * 128 + lane]; id1 = IDX[t3 * 128 + 64 + lane];
        peer_up_rows(R0, PU, s2, jd0, jd1, lane);
        ca0 = COEF[t2 * 128 + lane]; ca1 = COEF[t2 * 128 + 64 + lane]; ha = *(const f32x2*)(F.out + t2 * DM + s2 * 128 + hoff);
        __builtin_amdgcn_sched_barrier(0);
        peer_up_compute(R1, cb0, cb1, hb, outp, s1, t1, lane);
        __builtin_amdgcn_sched_barrier(0);
    }
}
__device__ __forceinline__ void peer_tile(Frame& F, int tile) {
    const size_t tok0 = (size_t)tile * 256;
    const bf16* Q = (const bf16*)(F.ws + WS_BIG);
    int* IDX = (int*)(F.ws + WS_BIG + 256 * MiB); float* GATE = (float*)(F.ws + WS_BIG + 288 * MiB); float* COEF = (float*)(F.ws + WS_BIG + 320 * MiB);
    peer_topk_tile(F, tok0, Q, IDX, GATE);
    VM_WAIT(); __syncthreads();
    PeerDeal D; D.tokw = tok0 + F.wave * 32; D.ntok = 256; D.tok0 = tok0; D.PART = (float*)(F.ws + WS_BIG + tok0 * (PEER_Q * 2)); D.IDX = IDX; D.GATE = GATE; D.COEF = COEF;
    peer_down_phase(F, D);
    VM_WAIT(); __syncthreads();
    peer_coef_wave(F, D);
    VM_WAIT(); __syncthreads();
    peer_up_phase(F, D, F.out);
}
__device__ __forceinline__ void peer_phase(Frame& F) { for (int tile = F.bid; tile < T / 256; tile += F.G) { peer_tile(F, tile); VM_WAIT(); __syncthreads(); } }

constexpr int N_PHASES = 15;
__global__ void __launch_bounds__(NTHR, 2) mega_fwd(Args args) {
    extern __shared__ __attribute__((aligned(16))) unsigned char lds_raw[];
    Frame F;
    F.lds = (LAS unsigned char*)lds_raw;
    F.tid = threadIdx.x; F.lane = F.tid & 63; F.wave = __builtin_amdgcn_readfirstlane(F.tid >> 6);
    F.G = gridDim.x; F.bid = blockIdx.x;
    F.in = args.in;
    F.positions = args.positions; F.out = args.out; F.ws = args.ws;
    unsigned char* ws = args.ws;
    volatile LAS unsigned* ctlw = (volatile LAS unsigned*)(F.lds + LDSCTL_OFF);
    if (F.tid < 64) ctlw[F.tid] = 0u;
    __syncthreads();
    const int lo = args.ph_lo, hi = args.ph_hi;
    XcdBarrier bar; bar.bar = (unsigned*)(ws + WS_CTL); bar.x = 0; bar.st = nullptr; bar.wave = F.wave;
    if (hi - lo > 1) bar = xcd_barrier_post((unsigned*)(ws + WS_CTL), ctlw + 8, F.wave);
#define IN(k) (lo <= (k) && (k) < hi)
#define SEAM(k) do { if (IN(k) && IN((k) + 1)) xcd_barrier(bar); } while (0)
    bf16* ACT1 = (bf16*)(ws + WS_ACT1); bf16* BIG = (bf16*)(ws + WS_BIG); bf16* WallT = (bf16*)(ws + WS_WALLT);

    if (IN(0)) { frame_refresh(F); p0_prologue(F); __syncthreads(); }
    SEAM(0);
    if (IN(1)) { frame_refresh(F);
        { pg8::Gemm g{(const bf16*)(ws + WS_MEMN), (const bf16*)(ws + WS_WMKVT), NB * NMEM, 768, DM, DM, DM}; pg8::StaticOrder S; S.init(g.M, g.N, F.G, F.bid);
          pg8::EpiBf16<0> E{(bf16*)(ws + WS_MKV), 1536}; pg8::gemm_phase(F.lds, g, S, E, F.wave); }
        { pg8::Gemm g{(const bf16*)(ws + WS_WMKVT) + (size_t)768 * DM, (const bf16*)(ws + WS_MEMN), 768, NB * NMEM, DM, DM, DM}; pg8::StaticOrder S; S.init(g.M, g.N, F.G, F.G - 1 - F.bid);
          pg8::EpiBf16<0> E{(bf16*)(ws + WS_MVT), NB * NMEM}; pg8::gemm_phase(F.lds, g, S, E, F.wave); }
        { pg8::Gemm g{ACT1, WallT, HT, NPROJ, DM, DM, DM}; pg8::StaticOrder S; S.init(g.M, g.N, F.G, F.bid);
          pg8::EpiBf16<0> E{BIG, NPROJ}; pg8::gemm_phase(F.lds, g, S, E, F.wave); }
    }
    SEAM(1);
    if (IN(2)) { frame_refresh(F); mknorm_phase(F); ssdC_phase(F, 0); }
    SEAM(2);
    if (IN(3)) { frame_refresh(F); ssdD_phase(F); dilattn_mfma_phase(F, 0); memattn_mfma_phase(F, 0); }
    SEAM(3);
    if (IN(4)) { frame_refresh(F); ssdE_phase(F, 0); dilmerge_phase(F, 0); }
    SEAM(4);
    if (IN(5)) { frame_refresh(F); pg8::Gemm g{ACT1 + (size_t)HT * DM, WallT, HT, NPROJ, DM, DM, DM}; pg8::StaticOrder S; S.init(g.M, g.N, F.G, F.bid);
        pg8::EpiBf16<0> E{BIG, NPROJ}; pg8::gemm_phase(F.lds, g, S, E, F.wave); }
    SEAM(5);
    if (IN(6)) { frame_refresh(F); ssdC_phase(F, 1); }
    SEAM(6);
    if (IN(7)) { frame_refresh(F); ssdD_phase(F); dilattn_mfma_phase(F, 1); memattn_mfma_phase(F, 1); }
    SEAM(7);
    if (IN(8)) { frame_refresh(F); ssdE_phase(F, 1); dilmerge_phase(F, 1); }
    SEAM(8);
    if (IN(9)) { frame_refresh(F); pg8::Gemm g{ACT1, WallT + (size_t)NPROJ * DM, T, NGATE, DM, DM, DM}; pg8::StaticOrder S; S.init(g.M, g.N, F.G, F.bid);
        pg8::EpiBf16<1> E{BIG, NGATE}; pg8::gemm_phase(F.lds, g, S, E, F.wave); }
    SEAM(9);
    if (IN(10)) { frame_refresh(F);
        pg8::Gemm g{(const bf16*)F.out, (const bf16*)(ws + WS_WCATT), T, DM, YC, YC, YC}; pg8::StaticOrder S; S.init(g.M, g.N, F.G, F.bid);
        pg8::EpiBranchFused E{ACT1, DM, __builtin_amdgcn_make_buffer_rsrc((void*)BIG, 0, T * NGATE * 2, 0x00020000), NGATE}; pg8::gemm_phase(F.lds, g, S, E, F.wave);
    }
    SEAM(10);
    if (IN(11)) { frame_refresh(F); pg8::Gemm g{ACT1, (const bf16*)(ws + WS_WOUTT), T, DM, DM, DM, DM}; pg8::StaticOrder S; S.init(g.M, g.N, F.G, F.bid);
        pg8::EpiResid E{F.out, DM, F.in[I_X]}; pg8::gemm_phase(F.lds, g, S, E, F.wave); }
    SEAM(11);
    if (IN(12)) { frame_refresh(F); hn_phase(F); }
    SEAM(12);
    if (IN(13)) { frame_refresh(F); pg8::Gemm g{ACT1, (const bf16*)(ws + WS_WQT), T, PEER_Q, DM, DM, DM}; pg8::StaticOrder S; S.init(g.M, g.N, F.G, F.bid);
        pg8::EpiBf16<0> E{BIG, PEER_Q}; pg8::gemm_phase(F.lds, g, S, E, F.wave); }
    SEAM(13);
    if (IN(14)) { frame_refresh(F); peer_phase(F); }
#undef IN
#undef SEAM
}

extern "C" void kernel_launch(void* const* d_in, const int* in_sizes, int n_in, void* d_out, int out_size, void* d_ws, size_t ws_size, hipStream_t stream) {
    static int grid = 0;
    if (grid == 0) {
        if (n_in != 26 || out_size != T * DM || ws_size < WS_END) { fprintf(stderr, "kernel_launch: unexpected shapes (n_in %d, out %d, ws %zu)\n", n_in, out_size, ws_size); grid = -1; return; }
        int dev = 0, cus = 0;
        if (hipGetDevice(&dev) != hipSuccess || hipDeviceGetAttribute(&cus, hipDeviceAttributeMultiprocessorCount, dev) != hipSuccess) { grid = -1; return; }
        if (hipFuncSetAttribute((const void*)mega_fwd, hipFuncAttributeMaxDynamicSharedMemorySize, LDS_BYTES) != hipSuccess) { grid = -1; return; }
        int per_cu = 0;
        (void)hipOccupancyMaxActiveBlocksPerMultiprocessor(&per_cu, (const void*)mega_fwd, NTHR, LDS_BYTES);
        (void)hipGetLastError();
        grid = cus;
    }
    if (grid < 0) return;
    (void)hipMemsetAsync((char*)d_ws + WS_CTL, 0, CTL_ZERO_BYTES, stream);
    Args a{};
    for (int i = 0; i < 26; ++i) a.in[i] = (const float*)d_in[i];
    a.positions = (const int*)d_in[2]; a.out = (float*)d_out; a.ws = (unsigned char*)d_ws;
#if MK_N_LAUNCHES == 1
    a.ph_lo = 0; a.ph_hi = N_PHASES;
    hipLaunchKernelGGL(mega_fwd, dim3(grid), dim3(NTHR), LDS_BYTES, stream, a);
#else
    for (int p = 0; p < N_PHASES; ++p) { a.ph_lo = p; a.ph_hi = p + 1; hipLaunchKernelGGL(mega_fwd, dim3(grid), dim3(NTHR), LDS_BYTES, stream, a); }
#endif
}
```

```cpp
#include <hip/hip_runtime.h>
#include <cstdio>
#include <cstdint>

#ifndef MK_N_LAUNCHES
#define MK_N_LAUNCHES 1
#endif

#define LAS __attribute__((address_space(3)))
#define GAS __attribute__((address_space(1)))
typedef unsigned short bf16;
typedef short bf16x8 __attribute__((ext_vector_type(8)));
typedef float f32x4 __attribute__((ext_vector_type(4)));
typedef float f32x2 __attribute__((ext_vector_type(2)));
typedef unsigned u32x4 __attribute__((ext_vector_type(4)));
typedef unsigned u32x2 __attribute__((ext_vector_type(2)));

constexpr int NB = 8, SEQ = 8192, DM = 1024, T = NB * SEQ;
constexpr int HB = 4, HT = HB * SEQ;
constexpr int NMEM = 256;
constexpr int NPROJ = 6144;
constexpr int PC_Z = 0, PC_X = 1024, PC_B = 2048, PC_C = 2560, PC_DQ = 3072, PC_DK = 3840, PC_DV = 4608, PC_MQ = 5376;
constexpr int W_IN_N = 9232, OFF_DT = 3072, OFF_AFTER_DT = 3088;
constexpr int NGATE = 3072;
constexpr int YC = 2048;
constexpr int PEER_H = 8, PEER_K = 16, PEER_NK = 128, PEER_Q = 2048;
constexpr float EPS = 1e-6f;

constexpr size_t MiB = 1u << 20;
constexpr size_t WS_CTL = 0, CTL_ZERO_BYTES = 65536;
constexpr size_t WS_WALLT = 1 * MiB;
constexpr size_t WS_WMKVT = 19 * MiB;
constexpr size_t WS_WCATT = 22 * MiB;
constexpr size_t WS_WOUTT = 26 * MiB;
constexpr size_t WS_WQT = 28 * MiB;
constexpr size_t WS_SUBK = 32 * MiB;
constexpr size_t WS_PD = 33 * MiB;
constexpr size_t WS_PU = 65 * MiB;
constexpr size_t WS_DT = 97 * MiB;
constexpr size_t WS_MEMN = 101 * MiB;
constexpr size_t WS_MKV = 105 * MiB;
constexpr size_t WS_ACT1 = 112 * MiB;
constexpr size_t WS_BIG = 240 * MiB;
constexpr size_t WS_LSE = 624 * MiB;
constexpr size_t WS_MVT = 628 * MiB;
constexpr size_t WS_DEC = 631 * MiB;
constexpr size_t WS_SST = 632 * MiB;
constexpr size_t WS_SIN = 760 * MiB;
constexpr size_t WS_ROPE = 824 * MiB;
constexpr size_t WS_SSQ = 828 * MiB;
constexpr size_t WS_HB = 632 * MiB;
constexpr size_t WS_END = 829 * MiB;

constexpr int RING_BYTES = 131072;
constexpr int LDSCTL_OFF = 143360;
constexpr int LDS_BYTES = 147456;
constexpr int NWAVES = 8, NTHR = 512;

__device__ __forceinline__ int lane_id() { return (int)__builtin_amdgcn_mbcnt_hi(~0u, __builtin_amdgcn_mbcnt_lo(~0u, 0u)); }
__device__ __forceinline__ float bf2f(unsigned short b) { return __builtin_bit_cast(float, (unsigned)b << 16); }
__device__ __forceinline__ float bflo(unsigned w) { return __builtin_bit_cast(float, w << 16); }
__device__ __forceinline__ float bfhi(unsigned w) { return __builtin_bit_cast(float, w & 0xffff0000u); }
__device__ __forceinline__ unsigned f2bf(float f) { unsigned u = __builtin_bit_cast(unsigned, f); return (u + 0x7fffu + ((u >> 16) & 1u)) >> 16; }
__device__ __forceinline__ unsigned pk2(float lo, float hi) { return f2bf(lo) | (f2bf(hi) << 16); }
typedef float f32x16 __attribute__((ext_vector_type(16)));
typedef short s16x4 __attribute__((ext_vector_type(4)));
typedef __bf16 bf2_t __attribute__((ext_vector_type(2)));
__device__ __forceinline__ unsigned pkbf(float a, float b) { const f32x2 v = {a, b}; return __builtin_bit_cast(unsigned, __builtin_convertvector(v, bf2_t)); }
#define MFMA32(a, b, c) __builtin_amdgcn_mfma_f32_32x32x16_bf16((a), (b), (c), 0, 0, 0)
__device__ __forceinline__ float wave_sum(float v) {
#pragma unroll
    for (int o = 1; o < 64; o <<= 1) v += __shfl_xor(v, o);
    return v;
}
__device__ __forceinline__ float wave_max(float v) {
#pragma unroll
    for (int o = 1; o < 64; o <<= 1) v = fmaxf(v, __shfl_xor(v, o));
    return v;
}
__device__ __forceinline__ float sigmoidf_(float x) { return 1.0f / (1.0f + __expf(-x)); }
#define LDS_WAIT() asm volatile("s_waitcnt lgkmcnt(0)" ::: "memory")
#define VM_WAIT() asm volatile("s_waitcnt vmcnt(0)" ::: "memory")

#define XB_TMO      128
#define XB_XCNT(j)  (256  + 64 * (j))
#define XB_XSUB(j)  (1280 + 64 * (j))
#define XB_XGEN(j)  (2304 + 64 * (j))
#define XB_TOP      3328
#define XB_TOPGEN   3392
#define XCD_BAR_WORDS 3456
#define XB_SPIN_CAP (1u << 18)
__device__ __forceinline__ unsigned xb_ld(unsigned* p)              { return __hip_atomic_load(p, __ATOMIC_RELAXED, __HIP_MEMORY_SCOPE_AGENT); }
__device__ __forceinline__ unsigned xb_add(unsigned* p, unsigned v) { return __hip_atomic_fetch_add(p, v, __ATOMIC_RELAXED, __HIP_MEMORY_SCOPE_AGENT); }
__device__ __forceinline__ unsigned xb_xcc_id() { return (unsigned)__builtin_amdgcn_s_getreg((3 << 11) | 20) & 0xFu; }
#define XB_SPIN(cond, bar) do { unsigned _sp = 0; while (cond) { __builtin_amdgcn_s_sleep(1); \
    if ((++_sp & 255u) == 0u) { if (xb_ld(&(bar)[XB_TMO])) break; if (_sp > XB_SPIN_CAP) { atomicAdd(&(bar)[XB_TMO], 1u); break; } } } } while (0)
struct XcdBarrier { unsigned* bar; unsigned x; volatile LAS unsigned* st; int wave; };
__device__ __forceinline__ XcdBarrier xcd_barrier_post(unsigned* bar, volatile LAS unsigned* st, int wave) {
    XcdBarrier b; b.bar = bar; b.x = xb_xcc_id(); b.st = st; b.wave = wave;
    if (wave == 0 && lane_id() == 0) (void)xb_add(&bar[XB_XCNT(b.x)], 1u);
    return b;
}
__device__ __forceinline__ void xcd_barrier_complete(unsigned* bar, unsigned x, unsigned& nloc, unsigned& nx) {
    const unsigned G = gridDim.x * gridDim.y * gridDim.z;
    unsigned sum, cnt, mine, sp = 0u;
    for (;;) {
        sum = 0u; cnt = 0u; mine = 0u;
#pragma unroll
        for (unsigned j = 0; j < 16; ++j) { const unsigned c = xb_ld(&bar[XB_XCNT(j)]); sum += c; cnt += (c > 0u) ? 1u : 0u; mine = (j == x) ? c : mine; }
        if (sum == G) break;
        __builtin_amdgcn_s_sleep(1);
        if ((++sp & 255u) == 0u) { if (xb_ld(&bar[XB_TMO])) break; if (sp > XB_SPIN_CAP) { atomicAdd(&bar[XB_TMO], 1u); break; } }
    }
    nloc = mine > 0u ? mine : 1u; nx = cnt > 0u ? cnt : 1u;
}
__device__ __forceinline__ void xcd_barrier(const XcdBarrier& b) {
    asm volatile("s_waitcnt vmcnt(0)" ::: "memory");
    __syncthreads();
    if (b.wave == 0 && lane_id() == 0) {
        unsigned* bar = b.bar;
        __builtin_amdgcn_s_waitcnt(0);
        unsigned nloc = b.st[0], nx = b.st[1];
        if (nloc == 0u) { xcd_barrier_complete(bar, b.x, nloc, nx); b.st[0] = nloc; b.st[1] = nx; }
        const unsigned old = xb_add(&bar[XB_XSUB(b.x)], 1u);
        const unsigned gen = old / nloc;
        if (old + 1u == (gen + 1u) * nloc) {
            __builtin_amdgcn_fence(__ATOMIC_RELEASE, "agent");
            asm volatile("s_waitcnt vmcnt(0)" ::: "memory");
            const unsigned og = xb_add(&bar[XB_TOP], 1u);
            const unsigned tg = og / nx;
            if (og + 1u == (tg + 1u) * nx) xb_add(&bar[XB_TOPGEN], 1u);
            else XB_SPIN(xb_ld(&bar[XB_TOPGEN]) == tg, bar);
            __builtin_amdgcn_fence(__ATOMIC_ACQUIRE, "agent");
            xb_add(&bar[XB_XGEN(b.x)], 1u);
            asm volatile("s_waitcnt vmcnt(0)" ::: "memory");
        } else {
            XB_SPIN(xb_ld(&bar[XB_XGEN(b.x)]) == gen, bar);
            __builtin_amdgcn_fence(__ATOMIC_ACQUIRE, "agent");
            asm volatile("s_waitcnt vmcnt(0)" ::: "memory");
        }
    }
    __syncthreads();
}

namespace pg8 {
constexpr int BM = 256, BK = 64, HALF = 128, HTB = HALF * BK * 2, STAGE_BYTES = 8 * HTB, NXCD = 8, WGM = 8;
__host__ __device__ __forceinline__ int lds_byte(int r, int c) { const int st = (r >> 4) * 2 + (c >> 5), rr = r & 15, cc = c & 31, ob = rr * 64 + cc * 2; return st * 1024 + (ob ^ (((ob >> 9) & 1) << 5)); }
__host__ __device__ __forceinline__ void stage_rc(int b, int& R, int& C) { const int st = b / 1024, sb = b % 1024, swz = sb ^ (((sb >> 9) & 1) << 5); R = (st >> 1) * 16 + swz / 64; C = (st & 1) * 32 + (swz % 64) / 2; }
__host__ __device__ __forceinline__ int perm32(int rho) { const int n = rho >> 4, i = rho & 15; return 8 * (i >> 2) + 4 * n + (i & 3); }
struct Unit { int pm, pn; };
struct Gemm { const bf16* A; const bf16* Bt; int M, N, K, lda, ldb; };
struct StaticOrder {
    int nM, nN, nwg, G, c;
    __host__ __device__ void init(int M, int N, int G_, int c_) { nM = M / BM; nN = N / BM; nwg = nM * nN; G = G_; c = c_; }
    __host__ __device__ bool next(int i, Unit& u) const {
        const long L = (long)i * G + c; if (L >= nwg) return false;
        int wgid = (int)L; { const int q = nwg / NXCD, r = nwg % NXCD, xcd = wgid % NXCD, off = wgid / NXCD; wgid = (xcd < r ? xcd * (q + 1) : r * (q + 1) + (xcd - r) * q) + off; }
        const int nig = WGM * nN, gid = wgid / nig, fm = gid * WGM, gsz = (nM - fm) < WGM ? (nM - fm) : WGM;
        u.pm = fm + ((wgid % nig) % gsz); u.pn = (wgid % nig) / gsz; return true;
    }
    __device__ __forceinline__ void a_ready(const Unit&) const {}
    __device__ __forceinline__ void done(const Unit&) const {}
};
__device__ __forceinline__ unsigned cvt_pk_bf16(float lo, float hi) { unsigned r; asm volatile("v_cvt_pk_bf16_f32 %0, %1, %2" : "=v"(r) : "v"(lo), "v"(hi)); return r; }

template <int ACT> struct EpiBf16 {
    static constexpr bool PERM = true, AFTER_DRAIN = false, HAS_MID = false;
    bf16* O; int ldc;
    __device__ __forceinline__ void operator()(const f32x4 (&acc)[2][2][4][2], const Unit& u, int wr, int wc, int fr, int fq) const {
        const int row0 = u.pm * BM + wr * 64 + fr; const int col0 = u.pn * BM + wc * 32 + 8 * fq;
#pragma unroll
        for (int ai = 0; ai < 2; ++ai)
#pragma unroll
            for (int m = 0; m < 4; ++m) { bf16* rowp = O + (size_t)(row0 + ai * HALF + m * 16) * ldc + col0;
#pragma unroll
                for (int bj = 0; bj < 2; ++bj) { f32x4 v0 = acc[ai][bj][m][0], v1 = acc[ai][bj][m][1];
                    if (ACT == 1) {
#pragma unroll
                        for (int j = 0; j < 4; ++j) { v0[j] = sigmoidf_(v0[j]); v1[j] = sigmoidf_(v1[j]); } }
                    u32x4 w; w.x = cvt_pk_bf16(v0[0], v0[1]); w.y = cvt_pk_bf16(v0[2], v0[3]); w.z = cvt_pk_bf16(v1[0], v1[1]); w.w = cvt_pk_bf16(v1[2], v1[3]);
                    *(u32x4*)(rowp + bj * HALF) = w; } }
    }
};
struct EpiResid {
    static constexpr bool PERM = false, AFTER_DRAIN = false, HAS_MID = false;
    float* C; int ldc; const float* R;
    __device__ __forceinline__ void operator()(const f32x4 (&acc)[2][2][4][2], const Unit& u, int wr, int wc, int fr, int fq) const {
        const int row0 = u.pm * BM + wr * 64 + fr, col0 = u.pn * BM + wc * 32 + 4 * fq;
#pragma unroll
        for (int ai = 0; ai < 2; ++ai)
#pragma unroll
            for (int m = 0; m < 4; ++m) { const size_t off = (size_t)(row0 + ai * HALF + m * 16) * ldc + col0;
#pragma unroll
                for (int bj = 0; bj < 2; ++bj)
#pragma unroll
                    for (int n = 0; n < 2; ++n) { const f32x4 r = *(const f32x4*)(R + off + bj * HALF + n * 16); *(f32x4*)(C + off + bj * HALF + n * 16) = acc[ai][bj][m][n] + r; } }
    }
};

struct EpiResidNorm {
    static constexpr bool PERM = false, AFTER_DRAIN = false, HAS_MID = false;
    float* C; int ldc; const float* R; bf16* Hb; const float* w; float* SSQ;
    __device__ __forceinline__ void operator()(const f32x4 (&acc)[2][2][4][2], const Unit& u, int wr, int wc, int fr, int fq) const {
        const int row0 = u.pm * BM + wr * 64 + fr, col0 = u.pn * BM + wc * 32 + 4 * fq;
        f32x4 wv[2][2];
#pragma unroll
        for (int bj = 0; bj < 2; ++bj)
#pragma unroll
            for (int n = 0; n < 2; ++n) wv[bj][n] = *(const f32x4*)(w + col0 + bj * HALF + n * 16);
#pragma unroll
        for (int ai = 0; ai < 2; ++ai)
#pragma unroll
            for (int m = 0; m < 4; ++m) { const int row = row0 + ai * HALF + m * 16; const size_t off = (size_t)row * ldc + col0; float ss = 0.f;
#pragma unroll
                for (int bj = 0; bj < 2; ++bj)
#pragma unroll
                    for (int n = 0; n < 2; ++n) { const f32x4 h = acc[ai][bj][m][n] + *(const f32x4*)(R + off + bj * HALF + n * 16); *(f32x4*)(C + off + bj * HALF + n * 16) = h;
                        ss += (h.x * h.x + h.y * h.y) + (h.z * h.z + h.w * h.w);
                        const u32x2 hb2 = {cvt_pk_bf16(h.x * wv[bj][n].x, h.y * wv[bj][n].y), cvt_pk_bf16(h.z * wv[bj][n].z, h.w * wv[bj][n].w)}; *(u32x2*)(Hb + off + bj * HALF + n * 16) = hb2; }
                ss += __shfl_xor(ss, 16); ss += __shfl_xor(ss, 32);
                if (fq == 0) atomicAdd(SSQ + row, ss); }
    }
};
struct EpiBf16RowScale {
    static constexpr bool PERM = true, AFTER_DRAIN = false, HAS_MID = false;
    bf16* O; int ldc; const float* SSQ;
    __device__ __forceinline__ void operator()(const f32x4 (&acc)[2][2][4][2], const Unit& u, int wr, int wc, int fr, int fq) const {
        const int row0 = u.pm * BM + wr * 64 + fr; const int col0 = u.pn * BM + wc * 32 + 8 * fq;
#pragma unroll
        for (int ai = 0; ai < 2; ++ai)
#pragma unroll
            for (int m = 0; m < 4; ++m) { const int row = row0 + ai * HALF + m * 16; bf16* rowp = O + (size_t)row * ldc + col0; const float rs = 1.0f / sqrtf(SSQ[row] * (1.f / DM) + EPS);
#pragma unroll
                for (int bj = 0; bj < 2; ++bj) { const f32x4 v0 = acc[ai][bj][m][0] * rs, v1 = acc[ai][bj][m][1] * rs;
                    u32x4 w; w.x = cvt_pk_bf16(v0[0], v0[1]); w.y = cvt_pk_bf16(v0[2], v0[3]); w.z = cvt_pk_bf16(v1[0], v1[1]); w.w = cvt_pk_bf16(v1[2], v1[3]);
                    *(u32x4*)(rowp + bj * HALF) = w; } }
    }
};

struct EpiBranchFused {
    static constexpr bool PERM = true, AFTER_DRAIN = false, HAS_MID = true;
    bf16* O; int ldc; __amdgpu_buffer_rsrc_t grs; int ldg;
    __device__ __forceinline__ void mid(f32x4 (&acc)[2][2][4][2], const Unit& u, int t, int wr, int wc, int fr, int fq) const {
        const unsigned voff = (unsigned)(((u.pm * BM + wr * 64 + fr) * ldg + u.pn * BM + wc * 32 + 8 * fq) * 2);
        const int ca = (t == 16) ? 0 : 2048;
#pragma unroll
        for (int ai = 0; ai < 2; ++ai)
#pragma unroll
            for (int m = 0; m < 4; ++m) {
#pragma unroll
                for (int bj = 0; bj < 2; ++bj) { const int so = ((ai * HALF + m * 16) * ldg + bj * HALF) * 2 + ca;
                    const u32x4 ga = __builtin_amdgcn_raw_buffer_load_b128(grs, voff, so, 0), gb = __builtin_amdgcn_raw_buffer_load_b128(grs, voff, so + 2048, 0);
                    f32x4& v0 = acc[ai][bj][m][0]; f32x4& v1 = acc[ai][bj][m][1];
                    v0[0] *= bflo(ga.x) * __builtin_amdgcn_rcpf(fmaxf(bflo(gb.x), 1e-30f)); v0[1] *= bfhi(ga.x) * __builtin_amdgcn_rcpf(fmaxf(bfhi(gb.x), 1e-30f));
                    v0[2] *= bflo(ga.y) * __builtin_amdgcn_rcpf(fmaxf(bflo(gb.y), 1e-30f)); v0[3] *= bfhi(ga.y) * __builtin_amdgcn_rcpf(fmaxf(bfhi(gb.y), 1e-30f));
                    v1[0] *= bflo(ga.z) * __builtin_amdgcn_rcpf(fmaxf(bflo(gb.z), 1e-30f)); v1[1] *= bfhi(ga.z) * __builtin_amdgcn_rcpf(fmaxf(bfhi(gb.z), 1e-30f));
                    v1[2] *= bflo(ga.w) * __builtin_amdgcn_rcpf(fmaxf(bflo(gb.w), 1e-30f)); v1[3] *= bfhi(ga.w) * __builtin_amdgcn_rcpf(fmaxf(bfhi(gb.w), 1e-30f)); }
                __builtin_amdgcn_sched_barrier(0); }
    }
    __device__ __forceinline__ void operator()(const f32x4 (&acc)[2][2][4][2], const Unit& u, int wr, int wc, int fr, int fq) const {
        const int row0 = u.pm * BM + wr * 64 + fr; const int col0 = u.pn * BM + wc * 32 + 8 * fq;
        const unsigned voff = (unsigned)((row0 * ldg + col0) * 2);
#pragma unroll
        for (int ai = 0; ai < 2; ++ai)
#pragma unroll
            for (int m = 0; m < 4; ++m) { const size_t r = (size_t)(row0 + ai * HALF + m * 16); bf16* rowp = O + r * ldc + col0;
#pragma unroll
                for (int bj = 0; bj < 2; ++bj) { const f32x4 v0 = acc[ai][bj][m][0], v1 = acc[ai][bj][m][1];
                    const u32x4 g = __builtin_amdgcn_raw_buffer_load_b128(grs, voff, ((ai * HALF + m * 16) * ldg + bj * HALF) * 2 + 4096, 0);
                    u32x4 w; w.x = cvt_pk_bf16(v0[0] * bflo(g.x), v0[1] * bfhi(g.x)); w.y = cvt_pk_bf16(v0[2] * bflo(g.y), v0[3] * bfhi(g.y));
                    w.z = cvt_pk_bf16(v1[0] * bflo(g.z), v1[1] * bfhi(g.z)); w.w = cvt_pk_bf16(v1[2] * bflo(g.w), v1[3] * bfhi(g.w));
                    *(u32x4*)(rowp + bj * HALF) = w; } }
    }
};

template <class Epi, class Sched>
__device__ __forceinline__ void gemm_phase(LAS unsigned char* lds, const Gemm g, const Sched& S, const Epi& E, int wid) {
    int lane = lane_id(); asm volatile("" : "+v"(lane));
    const int tid = wid * 64 + lane, wr = wid >> 2, wc = wid & 3, fr = lane & 15, fq = lane >> 4;
    const int K = g.K, nt = K / BK;
    unsigned voffA[2], voffB[2];
#pragma unroll
    for (int i = 0; i < 2; ++i) { int R, C; stage_rc(tid * 16 + i * 8192, R, C); const int Rb = Epi::PERM ? ((R & ~31) + perm32(R & 31)) : R;
        voffA[i] = (unsigned)(R * g.lda + C) * 2u; voffB[i] = (unsigned)(Rb * g.ldb + C) * 2u; }
    const size_t kstep = (size_t)(BK * 2);
    const size_t hsA = (size_t)HALF * g.lda * 2, hsB = (size_t)HALF * g.ldb * 2;
    const size_t tsA = 2 * hsA, tsB = 2 * hsB;
    const unsigned ldsw = (unsigned)wid * 1024u;
    const int aoff = lds_byte(wr * 64 + fr, fq * 8), boff = lds_byte(wc * 32 + fr, fq * 8);
#define PG8_SA(b, h) (((b) * 2 + (h)) * HTB)
#define PG8_SB(b, h) ((4 + (b) * 2 + (h)) * HTB)
#define PG8_STAGE(bufoff, gbase, voff) do { _Pragma("unroll") for (int _i = 0; _i < 2; ++_i) \
        __builtin_amdgcn_global_load_lds((const unsigned*)((const char*)(gbase) + (voff)[_i]), (LAS unsigned*)(lds + (bufoff) + ldsw + _i * 8192), 16, 0, 0); } while (0)
#define PG8_LDA(dst, b, h) do { _Pragma("unroll") for (int m = 0; m < 4; ++m) _Pragma("unroll") for (int k = 0; k < 2; ++k) dst[m][k] = *(const LAS bf16x8*)(lds + PG8_SA(b, h) + aoff + m * 2048 + k * 1024); } while (0)
#define PG8_LDB(dst, b, h) do { _Pragma("unroll") for (int n = 0; n < 2; ++n) _Pragma("unroll") for (int k = 0; k < 2; ++k) dst[n][k] = *(const LAS bf16x8*)(lds + PG8_SB(b, h) + boff + n * 2048 + k * 1024); } while (0)
#define PG8_MMA(ai, bj, At, Bt) do { __builtin_amdgcn_s_setprio(1); _Pragma("unroll") for (int m = 0; m < 4; ++m) _Pragma("unroll") for (int n = 0; n < 2; ++n) _Pragma("unroll") for (int k = 0; k < 2; ++k) \
        acc[ai][bj][m][n] = __builtin_amdgcn_mfma_f32_16x16x32_bf16(Bt[n][k], At[m][k], acc[ai][bj][m][n], 0, 0, 0); __builtin_amdgcn_s_setprio(0); } while (0)
#define PG8_WAIT_V(n) asm volatile("s_waitcnt vmcnt(" #n ")" ::: "memory")
#define PG8_WAIT_L(n) asm volatile("s_waitcnt lgkmcnt(" #n ")" ::: "memory")
#define PG8_BAR __builtin_amdgcn_s_barrier()
#define PG8_SCHED __builtin_amdgcn_sched_barrier(0)
    Unit cur, nxt; int ui = 0;
    if (!S.next(0, cur)) return;
    f32x4 acc[2][2][4][2];
#pragma unroll
    for (int a = 0; a < 2; ++a)
#pragma unroll
        for (int b = 0; b < 2; ++b)
#pragma unroll
            for (int m = 0; m < 4; ++m)
#pragma unroll
                for (int n = 0; n < 2; ++n) acc[a][b][m][n] = (f32x4){0.f, 0.f, 0.f, 0.f};
    bf16x8 At[4][2], B0[2][2], B1[2][2];
    const char* cA = (const char*)g.A + (size_t)cur.pm * tsA; const char* cB = (const char*)g.Bt + (size_t)cur.pn * tsB;
    S.a_ready(cur);
    PG8_STAGE(PG8_SB(0, 0), cB, voffB); PG8_STAGE(PG8_SB(0, 1), cB + hsB, voffB); PG8_STAGE(PG8_SA(0, 0), cA, voffA); PG8_STAGE(PG8_SA(0, 1), cA + hsA, voffA);
    if (wr == 1) PG8_BAR;
    PG8_WAIT_V(2); PG8_BAR;
    PG8_STAGE(PG8_SB(1, 0), cB + kstep, voffB); PG8_STAGE(PG8_SA(1, 0), cA + kstep, voffA); PG8_STAGE(PG8_SB(1, 1), cB + hsB + kstep, voffB);
    PG8_WAIT_V(6); PG8_BAR;
    for (;;) {
        const bool has_next = S.next(ui + 1, nxt);
        const char* nA = has_next ? (const char*)g.A + (size_t)nxt.pm * tsA : cA; const char* nB = has_next ? (const char*)g.Bt + (size_t)nxt.pn * tsB : cB;
        for (int t = 0; t < nt; t += 2) {
            const bool last = (t == nt - 2);
            const char* a1 = cA + (size_t)(t + 1) * kstep;
            const char* a2 = last ? nA : cA + (size_t)(t + 2) * kstep; const char* b2 = last ? nB : cB + (size_t)(t + 2) * kstep;
            const char* a3 = a2 + kstep; const char* b3 = b2 + kstep;
            if (last && has_next) S.a_ready(nxt);
            if constexpr (Epi::HAS_MID) { if (t == 16 || t == 20) E.mid(acc, cur, t, wr, wc, fr, fq); }
            PG8_LDB(B0, 0, 0); PG8_LDB(B1, 0, 1); PG8_SCHED; PG8_LDA(At, 0, 0); PG8_STAGE(PG8_SA(1, 1), a1 + hsA, voffA);
            PG8_WAIT_V(8); PG8_WAIT_L(0); PG8_BAR; PG8_MMA(0, 0, At, B0); PG8_MMA(0, 1, At, B1); PG8_BAR; PG8_SCHED;
            PG8_LDA(At, 0, 1); PG8_STAGE(PG8_SB(0, 0), b2, voffB); PG8_STAGE(PG8_SB(0, 1), b2 + hsB, voffB); PG8_STAGE(PG8_SA(0, 0), a2, voffA);
            PG8_WAIT_V(8); PG8_WAIT_L(0); PG8_BAR; PG8_MMA(1, 0, At, B0); PG8_MMA(1, 1, At, B1); PG8_BAR; PG8_SCHED;
            PG8_LDB(B0, 1, 0); PG8_LDB(B1, 1, 1); PG8_SCHED; PG8_LDA(At, 1, 0); PG8_STAGE(PG8_SA(0, 1), a2 + hsA, voffA);
            PG8_WAIT_V(8); PG8_WAIT_L(0); PG8_BAR; PG8_MMA(0, 0, At, B0); PG8_MMA(0, 1, At, B1); PG8_BAR; PG8_SCHED;
            PG8_LDA(At, 1, 1); PG8_STAGE(PG8_SB(1, 0), b3, voffB); PG8_STAGE(PG8_SB(1, 1), b3 + hsB, voffB); PG8_STAGE(PG8_SA(1, 0), a3, voffA);
            PG8_WAIT_V(8); PG8_WAIT_L(0); PG8_BAR; PG8_MMA(1, 0, At, B0); PG8_MMA(1, 1, At, B1); PG8_BAR; PG8_SCHED;
        }
        if (wr == 0) PG8_BAR;
        E(acc, cur, wr, wc, fr, fq); S.done(cur);
        if (!has_next) break;
#pragma unroll
        for (int a = 0; a < 2; ++a)
#pragma unroll
            for (int b = 0; b < 2; ++b)
#pragma unroll
                for (int m = 0; m < 4; ++m)
#pragma unroll
                    for (int n = 0; n < 2; ++n) acc[a][b][m][n] = (f32x4){0.f, 0.f, 0.f, 0.f};
        cur = nxt; cA = nA; cB = nB; ++ui;
        if (wr == 1) PG8_BAR;
    }
    PG8_WAIT_V(0);
    PG8_BAR;
#undef PG8_SA
#undef PG8_SB
#undef PG8_STAGE
#undef PG8_LDA
#undef PG8_LDB
#undef PG8_MMA
#undef PG8_WAIT_V
#undef PG8_WAIT_L
#undef PG8_BAR
#undef PG8_SCHED
}
}

struct Args {
    const float* in[26]; const int* positions; float* out; unsigned char* ws; int ph_lo, ph_hi; int pad0, pad1;
};
struct Frame {
    LAS unsigned char* lds;
    int tid, lane, wave, G, bid;
    const float* const* in; const int* positions; float* out; unsigned char* ws;
};
__device__ __forceinline__ void frame_refresh(Frame& F) { int l = lane_id(); asm volatile("" : "+v"(l)); F.lane = l; F.tid = F.wave * 64 + l; }
enum { I_X = 0, I_MEM = 1, I_POS = 2, I_NMIXW = 3, I_WIN = 4, I_CONVW = 5, I_CONVB = 6, I_DTB = 7, I_ALOG = 8, I_SSDD = 9, I_SSDNW = 10, I_DQNW = 11, I_DKNW = 12, I_MEMNW = 13,
       I_WMKV = 14, I_MQNW = 15, I_MKNW = 16, I_WSSD = 17, I_WDIL = 18, I_WMEMBR = 19, I_WOUT = 20, I_NFFNW = 21, I_WQ = 22, I_SUBK = 23, I_PD = 24, I_PU = 25 };

__device__ __forceinline__ void p0_transpose_item(const float* W, int ldw, int src_col0, bf16* WT, int ldt, int dst_row0, int dst_col0, int nblk, LAS float* scr, int item, int lane) {
    const int kb = item / nblk, nb = item % nblk, k0 = 64 * kb, n0 = 32 * nb;
#pragma unroll 8
    for (int i = 0; i < 32; ++i) { const int kk = 2 * i + (lane >> 5); scr[kk * 33 + (lane & 31)] = W[(size_t)(k0 + kk) * ldw + src_col0 + n0 + (lane & 31)]; }
    LDS_WAIT(); asm volatile("" ::: "memory");
    const int c = lane & 7;
#pragma unroll
    for (int j = 0; j < 4; ++j) { const int n = (lane >> 3) + 8 * j; const LAS float* s = scr + (8 * c) * 33 + n;
        u32x4 o; o.x = pk2(s[0 * 33], s[1 * 33]); o.y = pk2(s[2 * 33], s[3 * 33]); o.z = pk2(s[4 * 33], s[5 * 33]); o.w = pk2(s[6 * 33], s[7 * 33]);
        *(u32x4*)(WT + (size_t)(dst_row0 + n0 + n) * ldt + dst_col0 + k0 + 8 * c) = o; }
    LDS_WAIT(); asm volatile("" ::: "memory");
}
__device__ __forceinline__ void rms_row_to_bf16(const float* xrow, const float* w, bf16* orow, int lane, f32x4 (&v)[4]) {
    const f32x4* xr = (const f32x4*)xrow + lane; const f32x4* wr = (const f32x4*)w + lane;
    float s = 0.f;
#pragma unroll
    for (int j = 0; j < 4; ++j) { v[j] = xr[64 * j]; s += (v[j].x * v[j].x + v[j].y * v[j].y) + (v[j].z * v[j].z + v[j].w * v[j].w); }
    const float rstd = 1.0f / sqrtf(wave_sum(s) * (1.f / DM) + EPS);
    unsigned long long* o8 = (unsigned long long*)orow + lane;
#pragma unroll
    for (int j = 0; j < 4; ++j) { const f32x4 ww = wr[64 * j]; v[j] = v[j] * rstd * ww;
        o8[64 * j] = (unsigned long long)pk2(v[j].x, v[j].y) | ((unsigned long long)pk2(v[j].z, v[j].w) << 32); }
}
__device__ __forceinline__ void rms_rows_finish(f32x4 (&v)[4], const float* w, bf16* orow, int lane) {
    const f32x4* wr = (const f32x4*)w + lane;
    float s = 0.f;
#pragma unroll
    for (int j = 0; j < 4; ++j) s += (v[j].x * v[j].x + v[j].y * v[j].y) + (v[j].z * v[j].z + v[j].w * v[j].w);
    const float rstd = 1.0f / sqrtf(wave_sum(s) * (1.f / DM) + EPS);
    unsigned long long* o8 = (unsigned long long*)orow + lane;
#pragma unroll
    for (int j = 0; j < 4; ++j) { const f32x4 ww = wr[64 * j]; v[j] = v[j] * rstd * ww;
        o8[64 * j] = (unsigned long long)pk2(v[j].x, v[j].y) | ((unsigned long long)pk2(v[j].z, v[j].w) << 32); }
}
__device__ __forceinline__ void cvt_f32_bf16_stream(const float* src, bf16* dst, size_t n, size_t gtid, size_t gthreads) {
    for (size_t i = gtid * 8; i < n; i += gthreads * 8) { const f32x4 a = *(const f32x4*)(src + i), b = *(const f32x4*)(src + i + 4);
        u32x4 o; o.x = pk2(a.x, a.y); o.y = pk2(a.z, a.w); o.z = pk2(b.x, b.y); o.w = pk2(b.z, b.w); *(u32x4*)(dst + i) = o; }
}
constexpr float PD_SCALE = 64.0f, PU_SCALE = 8.0f;
__device__ __forceinline__ unsigned pk4_fp8(f32x4 v, float sc) {
    const float a = fminf(fmaxf(v.x * sc, -448.f), 448.f), b = fminf(fmaxf(v.y * sc, -448.f), 448.f), c = fminf(fmaxf(v.z * sc, -448.f), 448.f), d = fminf(fmaxf(v.w * sc, -448.f), 448.f);
    unsigned p = __builtin_amdgcn_cvt_pk_fp8_f32(a, b, 0, false); return __builtin_amdgcn_cvt_pk_fp8_f32(c, d, p, true);
}
__device__ __forceinline__ void cvt_f32_fp8_sliced(const float* src, unsigned char* dst, float sc, size_t gtid, size_t gthreads) {
    for (size_t i = gtid * 16; i < (size_t)16384 * 1024; i += gthreads * 16) { const f32x4 a = *(const f32x4*)(src + i), b = *(const f32x4*)(src + i + 4), c = *(const f32x4*)(src + i + 8), d = *(const f32x4*)(src + i + 12);
        const size_t e = i >> 10, dd = i & 1023;
        const u32x4 o = {pk4_fp8(a, sc), pk4_fp8(b, sc), pk4_fp8(c, sc), pk4_fp8(d, sc)}; *(u32x4*)(dst + ((((dd >> 7) * 16384 + e) << 7) + (dd & 127))) = o; }
}
__device__ __forceinline__ void p0_prologue(Frame& F) {
    LAS float* scr = (LAS float*)(F.lds + F.wave * 8448);
    LAS float* wdt = (LAS float*)(F.lds + 8 * 8448);
    const int gw = F.bid * NWAVES + F.wave, NGW = F.G * NWAVES;
    unsigned char* ws = F.ws;
    for (int i = F.tid; i < 1024 * 16; i += NTHR) { const int k = i >> 4, c = i & 15, l = (k & 255) >> 2, e = k & 3, j = k >> 8, q = c >> 2;
        wdt[((((j * 4 + e) * 4 + q) * 64 + l) << 2) + (c & 3)] = F.in[I_WIN][(size_t)k * W_IN_N + OFF_DT + c]; }
    __syncthreads();
    constexpr int IT_A = 16 * 96, IT_B = 16 * 192, IT_MKV = 16 * 48, IT_SSD = 16 * 32, IT_DIL = 4 * 32, IT_MBR = 12 * 32, IT_OUT = 16 * 32, IT_WQ = 16 * 64;
    constexpr int NITEMS = IT_A + IT_B + IT_MKV + IT_SSD + IT_DIL + IT_MBR + IT_OUT + IT_WQ;
    bf16* WallT = (bf16*)(ws + WS_WALLT);
    for (int it = gw; it < NITEMS; it += NGW) {
        int r = it;
        if (r < IT_A) { p0_transpose_item(F.in[I_WIN], W_IN_N, 0, WallT, DM, 0, 0, 96, scr, r, F.lane); continue; } r -= IT_A;
        if (r < IT_B) { p0_transpose_item(F.in[I_WIN], W_IN_N, OFF_AFTER_DT, WallT, DM, 3072, 0, 192, scr, r, F.lane); continue; } r -= IT_B;
        if (r < IT_MKV) { p0_transpose_item(F.in[I_WMKV], 1536, 0, (bf16*)(ws + WS_WMKVT), DM, 0, 0, 48, scr, r, F.lane); continue; } r -= IT_MKV;
        if (r < IT_SSD) { p0_transpose_item(F.in[I_WSSD], DM, 0, (bf16*)(ws + WS_WCATT), YC, 0, 0, 32, scr, r, F.lane); continue; } r -= IT_SSD;
        if (r < IT_DIL) { p0_transpose_item(F.in[I_WDIL], DM, 0, (bf16*)(ws + WS_WCATT), YC, 0, 1024, 32, scr, r, F.lane); continue; } r -= IT_DIL;
        if (r < IT_MBR) { p0_transpose_item(F.in[I_WMEMBR], DM, 0, (bf16*)(ws + WS_WCATT), YC, 0, 1280, 32, scr, r, F.lane); continue; } r -= IT_MBR;
        if (r < IT_OUT) { p0_transpose_item(F.in[I_WOUT], DM, 0, (bf16*)(ws + WS_WOUTT), DM, 0, 0, 32, scr, r, F.lane); continue; } r -= IT_OUT;
        p0_transpose_item(F.in[I_WQ], PEER_Q, 0, (bf16*)(ws + WS_WQT), DM, 0, 0, 64, scr, r, F.lane);
    }
    const size_t gtid = (size_t)F.bid * NTHR + F.tid, gth = (size_t)F.G * NTHR;
    cvt_f32_bf16_stream(F.in[I_SUBK], (bf16*)(ws + WS_SUBK), (size_t)8 * 2 * 128 * 128, gtid, gth);
    cvt_f32_fp8_sliced(F.in[I_PD], ws + WS_PD, PD_SCALE, gtid, gth);
    cvt_f32_fp8_sliced(F.in[I_PU], ws + WS_PU, PU_SCALE, gtid, gth);
    for (int m = gw; m < NB * NMEM; m += NGW) { f32x4 v[4]; rms_row_to_bf16(F.in[I_MEM] + (size_t)m * DM, F.in[I_MEMNW], (bf16*)(ws + WS_MEMN) + (size_t)m * DM, F.lane, v); }
    for (size_t i = gtid; i < (size_t)T; i += gth) ((float*)(ws + WS_SSQ))[i] = 0.f;
    { float* RT = (float*)(ws + WS_ROPE);
      for (size_t i = gtid; i < (size_t)T * 8; i += gth) { const int tok = (int)(i >> 3), a = (int)(i & 7);
          const float inv = __expf(-logf(500000.0f) * (2.0f / 16.0f) * (float)a);
          const double rev = (double)((float)F.positions[tok] * inv) * 0.15915494309189535; const float fr = (float)(rev - floor(rev));
          RT[(size_t)tok * 16 + a] = __builtin_amdgcn_cosf(fr); RT[(size_t)tok * 16 + 8 + a] = __builtin_amdgcn_sinf(fr); } }
    float* DTp = (float*)(ws + WS_DT);
    const int lane = F.lane;
    const int myj = ((lane >> 5) & 1) * 8 + ((lane >> 4) & 1) * 4 + ((lane >> 3) & 1) * 2 + ((lane >> 2) & 1);
    const float dtb = F.in[I_DTB][myj];
    f32x4 na[4], nb[4];
    { const int m0 = 2 * gw < T ? 2 * gw : 0; const f32x4* xa = (const f32x4*)(F.in[I_X] + (size_t)m0 * DM) + lane; const f32x4* xb = (const f32x4*)(F.in[I_X] + (size_t)(m0 + 1) * DM) + lane;
#pragma unroll
      for (int j = 0; j < 4; ++j) { na[j] = xa[64 * j]; nb[j] = xb[64 * j]; } }
    for (int m = 2 * gw; m < T; m += 2 * NGW) {
        f32x4 va[4], vb[4];
#pragma unroll
        for (int j = 0; j < 4; ++j) { va[j] = na[j]; vb[j] = nb[j]; }
        { const int mn = (m + 2 * NGW < T) ? m + 2 * NGW : m; const f32x4* xa = (const f32x4*)(F.in[I_X] + (size_t)mn * DM) + lane; const f32x4* xb = (const f32x4*)(F.in[I_X] + (size_t)(mn + 1) * DM) + lane;
#pragma unroll
          for (int j = 0; j < 4; ++j) { na[j] = xa[64 * j]; nb[j] = xb[64 * j]; } }
        rms_rows_finish(va, F.in[I_NMIXW], (bf16*)(ws + WS_ACT1) + (size_t)m * DM, lane);
        rms_rows_finish(vb, F.in[I_NMIXW], (bf16*)(ws + WS_ACT1) + (size_t)(m + 1) * DM, lane);
        float da[16], db[16];
#pragma unroll
        for (int j = 0; j < 16; ++j) { da[j] = 0.f; db[j] = 0.f; }
#pragma unroll
        for (int j = 0; j < 4; ++j)
#pragma unroll
            for (int e = 0; e < 4; ++e) { const float ua = va[j][e], ub = vb[j][e];
#pragma unroll
                for (int q = 0; q < 4; ++q) { const f32x4 w4 = *(const LAS f32x4*)(wdt + ((((j * 4 + e) * 4 + q) * 64 + lane) << 2));
                    da[4 * q + 0] += ua * w4.x; da[4 * q + 1] += ua * w4.y; da[4 * q + 2] += ua * w4.z; da[4 * q + 3] += ua * w4.w;
                    db[4 * q + 0] += ub * w4.x; db[4 * q + 1] += ub * w4.y; db[4 * q + 2] += ub * w4.z; db[4 * q + 3] += ub * w4.w; }
                __builtin_amdgcn_sched_barrier(0); }
        float ra, rb;
        { float r8a[8], r8b[8], r4a[4], r4b[4], r2a[2], r2b[2];
          { const bool up = (lane & 32) != 0;
#pragma unroll
            for (int k = 0; k < 8; ++k) { r8a[k] = (up ? da[k + 8] : da[k]) + __shfl_xor(up ? da[k] : da[k + 8], 32); r8b[k] = (up ? db[k + 8] : db[k]) + __shfl_xor(up ? db[k] : db[k + 8], 32); } }
          { const bool up = (lane & 16) != 0;
#pragma unroll
            for (int k = 0; k < 4; ++k) { r4a[k] = (up ? r8a[k + 4] : r8a[k]) + __shfl_xor(up ? r8a[k] : r8a[k + 4], 16); r4b[k] = (up ? r8b[k + 4] : r8b[k]) + __shfl_xor(up ? r8b[k] : r8b[k + 4], 16); } }
          { const bool up = (lane & 8) != 0;
#pragma unroll
            for (int k = 0; k < 2; ++k) { r2a[k] = (up ? r4a[k + 2] : r4a[k]) + __shfl_xor(up ? r4a[k] : r4a[k + 2], 8); r2b[k] = (up ? r4b[k + 2] : r4b[k]) + __shfl_xor(up ? r4b[k] : r4b[k + 2], 8); } }
          { const bool up = (lane & 4) != 0; ra = (up ? r2a[1] : r2a[0]) + __shfl_xor(up ? r2a[0] : r2a[1], 4); rb = (up ? r2b[1] : r2b[0]) + __shfl_xor(up ? r2b[0] : r2b[1], 4); }
          ra += __shfl_xor(ra, 2); ra += __shfl_xor(ra, 1); rb += __shfl_xor(rb, 2); rb += __shfl_xor(rb, 1); }
        if ((lane & 3) == 0) { const float xa = ra + dtb, xb = rb + dtb;
            DTp[(size_t)m * 16 + myj] = (xa > 20.f) ? xa : log1pf(__expf(xa)); DTp[(size_t)(m + 1) * 16 + myj] = (xb > 20.f) ? xb : log1pf(__expf(xb)); }
    }
}

__device__ __forceinline__ void norm192_inplace(bf16* p, const float (&w)[4], int lane) {
    u32x2 v = {0u, 0u};
    if (lane < 48) v = *(const u32x2*)(p + 4 * lane);
    float x0 = bflo(v.x), x1 = bfhi(v.x), x2 = bflo(v.y), x3 = bfhi(v.y);
    const float ss = wave_sum((x0 * x0 + x1 * x1) + (x2 * x2 + x3 * x3));
    const float rs = 1.0f / sqrtf(ss * (1.f / 192.f) + EPS);
    if (lane < 48) { const u32x2 o = {pkbf(x0 * rs * w[0], x1 * rs * w[1]), pkbf(x2 * rs * w[2], x3 * rs * w[3])}; *(u32x2*)(p + 4 * lane) = o; }
}
__device__ __forceinline__ void mknorm_phase(Frame& F) {
    const int gw = F.bid * NWAVES + F.wave, NGW = F.G * NWAVES, lane = F.lane;
    float wmk[4];
#pragma unroll
    for (int j = 0; j < 4; ++j) wmk[j] = F.in[I_MKNW][(4 * lane + j) % 192];
    bf16* MK = (bf16*)(F.ws + WS_MKV);
    for (int r = gw; r < NB * NMEM * 4; r += NGW) norm192_inplace(MK + (size_t)(r >> 2) * 1536 + (r & 3) * 192, wmk, lane);
}

constexpr int SC_ST = 272, SX_ST = 528;
__device__ __forceinline__ float bfsel(const u32x4& v, int j) { const unsigned w = v[j >> 1]; return (j & 1) ? bfhi(w) : bflo(w); }
__device__ __forceinline__ void conv_task(const bf16* P, size_t rowb, int t0, int pcol, const float* cw, const float* cb, int ccol, LAS unsigned char* dst, int stride, const LAS float* scale) {
    float w[4][8], bs[8];
#pragma unroll
    for (int k = 0; k < 4; ++k) { const f32x4 a = *(const f32x4*)(cw + k * 2048 + ccol), b = *(const f32x4*)(cw + k * 2048 + ccol + 4);
        w[k][0] = a.x; w[k][1] = a.y; w[k][2] = a.z; w[k][3] = a.w; w[k][4] = b.x; w[k][5] = b.y; w[k][6] = b.z; w[k][7] = b.w; }
    { const f32x4 a = *(const f32x4*)(cb + ccol), b = *(const f32x4*)(cb + ccol + 4); bs[0] = a.x; bs[1] = a.y; bs[2] = a.z; bs[3] = a.w; bs[4] = b.x; bs[5] = b.y; bs[6] = b.z; bs[7] = b.w; }
    const bf16* src = P + (rowb + t0) * NPROJ + pcol;
    u32x4 rw[19];
#pragma unroll
    for (int i = 0; i < 3; ++i) rw[i] = (u32x4){0u, 0u, 0u, 0u};
    if (t0 > 0) {
#pragma unroll
        for (int i = 0; i < 3; ++i) rw[i] = *(const u32x4*)(src + (ptrdiff_t)(i - 3) * NPROJ); }
#pragma unroll
    for (int i = 0; i < 16; ++i) rw[3 + i] = *(const u32x4*)(src + (size_t)i * NPROJ);
#pragma unroll
    for (int i = 0; i < 16; ++i) {
        float o[8];
#pragma unroll
        for (int j = 0; j < 8; ++j) { float a = bs[j] + w[0][j] * bfsel(rw[i], j) + w[1][j] * bfsel(rw[i + 1], j) + w[2][j] * bfsel(rw[i + 2], j) + w[3][j] * bfsel(rw[i + 3], j); o[j] = a * sigmoidf_(a); }
        if (scale) { const float sv = scale[i];
#pragma unroll
            for (int j = 0; j < 8; ++j) o[j] *= sv; }
        const u32x4 r = {pkbf(o[0], o[1]), pkbf(o[2], o[3]), pkbf(o[4], o[5]), pkbf(o[6], o[7])};
        *(LAS u32x4*)(dst + i * stride) = r;
    }
}
__device__ __forceinline__ float ssd_scan(Frame& F, const float* DTp, size_t tok0, int g, LAS float* sAc, LAS float* sDt) {
    float total = 0.f;
    if (F.wave < 4) {
        const int head = 4 * g + F.wave, lane = F.lane;
        const float A = -__expf(F.in[I_ALOG][head]);
        const float d0 = DTp[(tok0 + 2 * lane) * 16 + head], d1 = DTp[(tok0 + 2 * lane + 1) * 16 + head];
        const float a0 = d0 * A, a1 = d1 * A;
        float sc = a0 + a1;
#pragma unroll
        for (int o = 1; o < 64; o <<= 1) { const float v = __shfl_up(sc, o); if (lane >= o) sc += v; }
        sAc[F.wave * 128 + 2 * lane] = sc - a1; sAc[F.wave * 128 + 2 * lane + 1] = sc;
        sDt[F.wave * 128 + 2 * lane] = d0; sDt[F.wave * 128 + 2 * lane + 1] = d1;
        total = __shfl(sc, 63);
    }
    return total;
}
__device__ __forceinline__ bf16x8 tr_pair(unsigned a_lo, unsigned a_hi) {
    s16x4 lo, hi;
    asm volatile("ds_read_b64_tr_b16 %0, %2\n\tds_read_b64_tr_b16 %1, %3\n\ts_waitcnt lgkmcnt(0)" : "=&v"(lo), "=&v"(hi) : "v"(a_lo), "v"(a_hi) : "memory");
    const bf16x8 r = {lo[0], lo[1], lo[2], lo[3], hi[0], hi[1], hi[2], hi[3]}; return r;
}

__device__ __forceinline__ void ssdC_phase(Frame& F, int half) {
    const bf16* P = (const bf16*)(F.ws + WS_BIG);
    const float* DTp = (const float*)(F.ws + WS_DT);
    bf16* SST = (bf16*)(F.ws + WS_SST); float* DEC = (float*)(F.ws + WS_DEC);
    LAS unsigned char* sX = F.lds; LAS unsigned char* sB = F.lds + 128 * SX_ST;
    LAS float* sAc = (LAS float*)(F.lds + 128 * SX_ST + 128 * SC_ST); LAS float* sDt = sAc + 512; LAS float* sW = sDt + 512;
    const int wave = F.wave;
    for (int unit = F.bid; unit < HB * 64 * 4; unit += F.G) {
        int tid = F.tid; asm volatile("" : "+v"(tid));
        const int lane = tid & 63, ql = lane & 31, h = lane >> 5, tq = (lane & 15) >> 2, tp = lane & 3, tblk = (lane >> 4) & 1;
        const int bl = unit >> 8, c = (unit >> 2) & 63, g = unit & 3;
        const size_t rowb = (size_t)bl * SEQ, tok0 = (size_t)half * HT + rowb + c * 128;
        __syncthreads();
        const float total = ssd_scan(F, DTp, tok0, g, sAc, sDt);
        if (wave < 4) { sW[wave * 128 + 2 * lane] = __expf(total - sAc[wave * 128 + 2 * lane]) * sDt[wave * 128 + 2 * lane];
            sW[wave * 128 + 2 * lane + 1] = __expf(total - sAc[wave * 128 + 2 * lane + 1]) * sDt[wave * 128 + 2 * lane + 1];
            if (lane == 0) DEC[((size_t)bl * 64 + c) * 16 + 4 * g + wave] = __expf(total); }
        __syncthreads();
        if (tid < 384) {
            int ch, strip, ccol, stride; LAS unsigned char* dst; const LAS float* scl = nullptr;
            if (tid < 256) { ch = tid & 31; strip = tid >> 5; ccol = g * 256 + 8 * ch; stride = SX_ST; dst = sX + (strip * 16) * SX_ST + ch * 16; scl = sW + (ch >> 3) * 128 + strip * 16; }
            else { const int u = tid - 256; ch = u & 15; strip = u >> 4; ccol = 1024 + g * 128 + 8 * ch; stride = SC_ST; dst = sB + (strip * 16) * SC_ST + ch * 16; }
            conv_task(P, rowb, c * 128 + strip * 16, PC_X + ccol, F.in[I_CONVW], F.in[I_CONVB], ccol, dst, stride, scl);
        }
        __syncthreads();
        const int r = wave >> 1, pt = wave & 1;
        f32x16 acc[4];
#pragma unroll
        for (int nt = 0; nt < 4; ++nt)
#pragma unroll
            for (int e = 0; e < 16; ++e) acc[nt][e] = 0.f;
        const unsigned xa = (unsigned)(size_t)sX + (unsigned)((8 * h + tq) * SX_ST + (r * 64 + 32 * pt + 16 * tblk + 4 * tp) * 2);
        const unsigned ba = (unsigned)(size_t)sB + (unsigned)((8 * h + tq) * SC_ST + (16 * tblk + 4 * tp) * 2);
#pragma unroll
        for (int ks = 0; ks < 8; ++ks) {
            const bf16x8 af = tr_pair(xa + ks * 16 * SX_ST, xa + ks * 16 * SX_ST + 4 * SX_ST);
            bf16x8 bfr[4];
#pragma unroll
            for (int nt = 0; nt < 4; ++nt) bfr[nt] = tr_pair(ba + ks * 16 * SC_ST + nt * 64, ba + ks * 16 * SC_ST + 4 * SC_ST + nt * 64);
            __builtin_amdgcn_sched_barrier(0);
#pragma unroll
            for (int nt = 0; nt < 4; ++nt) acc[nt] = MFMA32(af, bfr[nt], acc[nt]);
        }
        bf16* out = SST + (((size_t)bl * 64 + c) * 16 + 4 * g + r) * 8192;
#pragma unroll
        for (int nt = 0; nt < 4; ++nt)
#pragma unroll
            for (int e = 0; e < 16; ++e) out[(32 * pt + (e & 3) + 8 * (e >> 2) + 4 * h) * 128 + 32 * nt + ql] = (bf16)(pkbf(acc[nt][e], 0.f) & 0xffffu);
    }
}

__device__ __forceinline__ void ssdD_phase(Frame& F) {
    const bf16* SST = (const bf16*)(F.ws + WS_SST); const float* DEC = (const float*)(F.ws + WS_DEC);
    bf16* SIN = (bf16*)(F.ws + WS_SIN);
    const size_t gtid = (size_t)F.bid * NTHR + F.tid, gth = (size_t)F.G * NTHR;
    for (size_t it = gtid; it < (size_t)HB * 16 * 2048; it += gth) {
        const int bl = (int)(it >> 15), head = (int)(it >> 11) & 15, e4 = (int)(it & 2047) * 4;
        f32x4 st = {0.f, 0.f, 0.f, 0.f};
#pragma unroll 8
        for (int c = 0; c < 64; ++c) {
            const size_t idx = (((size_t)bl * 64 + c) * 16 + head);
            const u32x2 o = {pkbf(st.x, st.y), pkbf(st.z, st.w)};
            *(u32x2*)(SIN + idx * 8192 + e4) = o;
            const u32x2 sw = *(const u32x2*)(SST + idx * 8192 + e4); const f32x4 sl = {bflo(sw.x), bfhi(sw.x), bflo(sw.y), bfhi(sw.y)}; const float d = DEC[idx];
            st = st * d + sl;
        }
    }
}

__device__ __forceinline__ void ssdE_phase(Frame& F, int half) {
    const bf16* P = (const bf16*)(F.ws + WS_BIG);
    const float* DTp = (const float*)(F.ws + WS_DT);
    const bf16* SIN = (const bf16*)(F.ws + WS_SIN);
    bf16* Y = (bf16*)F.out;
    LAS unsigned char* sX = F.lds; LAS unsigned char* sB = F.lds + 128 * SX_ST; LAS unsigned char* sC = sB + 128 * SC_ST;
    LAS float* sAc = (LAS float*)(sC + 128 * SC_ST); LAS float* sDt = sAc + 512; LAS float* sSS = sDt + 512;
    const int wave = F.wave;
    const int st = wave & 3, hp = wave >> 2;
    for (int unit = F.bid; unit < HB * 64 * 4; unit += F.G) {
        int tid = F.tid; asm volatile("" : "+v"(tid));
        const int lane = tid & 63, ql = lane & 31, h = lane >> 5, tq = (lane & 15) >> 2, tp = lane & 3, tblk = (lane >> 4) & 1;
        const int bl = unit >> 8, c = (unit >> 2) & 63, g = unit & 3;
        const size_t rowb = (size_t)bl * SEQ, tok0 = (size_t)half * HT + rowb + c * 128;
        __syncthreads();
        (void)ssd_scan(F, DTp, tok0, g, sAc, sDt);
        if (tid < 128) sSS[tid] = 0.f;
        {
            int ch, strip, ccol, stride; LAS unsigned char* dst;
            if (tid < 256) { ch = tid & 31; strip = tid >> 5; ccol = g * 256 + 8 * ch; stride = SX_ST; dst = sX + (strip * 16) * SX_ST + ch * 16; }
            else if (tid < 384) { const int u = tid - 256; ch = u & 15; strip = u >> 4; ccol = 1024 + g * 128 + 8 * ch; stride = SC_ST; dst = sB + (strip * 16) * SC_ST + ch * 16; }
            else { const int u = tid - 384; ch = u & 15; strip = u >> 4; ccol = 1536 + g * 128 + 8 * ch; stride = SC_ST; dst = sC + (strip * 16) * SC_ST + ch * 16; }
            conv_task(P, rowb, c * 128 + strip * 16, PC_X + ccol, F.in[I_CONVW], F.in[I_CONVB], ccol, dst, stride, nullptr);
        }
        __syncthreads();
        const int s = 32 * st + ql;
        unsigned yk[2][2][8];
        float ssq = 0.f;
        const unsigned xa = (unsigned)(size_t)sX + (unsigned)((4 * h + tq) * SX_ST + (16 * tblk + 4 * tp) * 2);
#pragma unroll
        for (int hq = 0; hq < 2; ++hq) {
            const int r = 2 * hp + hq, head = 4 * g + r;
            const float acs = sAc[r * 128 + s];
            const bf16* stp = SIN + (((size_t)bl * 64 + c) * 16 + head) * 8192 + ql * 128 + 8 * h;
            bf16x8 sfr[2][8];
#pragma unroll
            for (int pt = 0; pt < 2; ++pt)
#pragma unroll
                for (int ks = 0; ks < 8; ++ks) sfr[pt][ks] = *(const bf16x8*)(stp + pt * 4096 + 16 * ks);
            bf16x8 pf[4][2];
#pragma unroll
            for (int i = 0; i < 4; ++i) {
                f32x16 Xi;
#pragma unroll
                for (int e = 0; e < 16; ++e) Xi[e] = 0.f;
#pragma unroll
                for (int ks = 0; ks < 8; ++ks) { const bf16x8 bf_ = *(const LAS bf16x8*)(sB + (32 * i + ql) * SC_ST + 32 * ks + 16 * h);
                    const bf16x8 cf = *(const LAS bf16x8*)(sC + s * SC_ST + 32 * ks + 16 * h); Xi = MFMA32(bf_, cf, Xi); }
                float p[16];
#pragma unroll
                for (int q4 = 0; q4 < 4; ++q4) { const int t0 = 32 * i + 8 * q4 + 4 * h;
                    const f32x4 at = *(const LAS f32x4*)(sAc + r * 128 + t0), dt4 = *(const LAS f32x4*)(sDt + r * 128 + t0);
#pragma unroll
                    for (int e = 0; e < 4; ++e) { const int t = t0 + e; p[4 * q4 + e] = (t <= s) ? Xi[4 * q4 + e] * __expf(acs - at[e]) * dt4[e] : 0.f; } }
#pragma unroll
                for (int s2 = 0; s2 < 2; ++s2) { const u32x4 w = {pkbf(p[8 * s2 + 0], p[8 * s2 + 1]), pkbf(p[8 * s2 + 2], p[8 * s2 + 3]), pkbf(p[8 * s2 + 4], p[8 * s2 + 5]), pkbf(p[8 * s2 + 6], p[8 * s2 + 7])};
                    pf[i][s2] = __builtin_bit_cast(bf16x8, w); }
            }
            const float eacs = __expf(acs), Dh = F.in[I_SSDD][head];
#pragma unroll
            for (int pt = 0; pt < 2; ++pt) {
                f32x16 yd, yo;
#pragma unroll
                for (int e = 0; e < 16; ++e) { yd[e] = 0.f; yo[e] = 0.f; }
#pragma unroll
                for (int i = 0; i < 4; ++i) {
#pragma unroll
                    for (int s2 = 0; s2 < 2; ++s2) { const unsigned a = xa + (unsigned)((32 * i + 16 * s2) * SX_ST + (r * 64 + 32 * pt) * 2);
                        const bf16x8 xf = tr_pair(a, a + 8 * SX_ST); __builtin_amdgcn_sched_barrier(0); yd = MFMA32(xf, pf[i][s2], yd); }
                }
#pragma unroll
                for (int ks = 0; ks < 8; ++ks) { const bf16x8 cf = *(const LAS bf16x8*)(sC + s * SC_ST + 32 * ks + 16 * h); yo = MFMA32(sfr[pt][ks], cf, yo); }
                const bf16* zp = P + (rowb + c * 128 + s) * NPROJ + PC_Z + g * 256 + r * 64 + 32 * pt + 4 * h;
                u32x2 zv[4];
#pragma unroll
                for (int q4 = 0; q4 < 4; ++q4) zv[q4] = *(const u32x2*)(zp + 8 * q4);
#pragma unroll
                for (int q4 = 0; q4 < 4; ++q4) {
                    const u32x2 xv = *(const LAS u32x2*)(sX + s * SX_ST + (r * 64 + 32 * pt + 8 * q4 + 4 * h) * 2);
                    const u32x2 zq = zv[q4];
                    const float xs_[4] = {bflo(xv.x), bfhi(xv.x), bflo(xv.y), bfhi(xv.y)}, zs_[4] = {bflo(zq.x), bfhi(zq.x), bflo(zq.y), bfhi(zq.y)};
                    float yv[4];
#pragma unroll
                    for (int e = 0; e < 4; ++e) { float y = yd[4 * q4 + e] + eacs * yo[4 * q4 + e] + Dh * xs_[e]; y = y * zs_[e] * sigmoidf_(zs_[e]); yv[e] = y; ssq += y * y; }
                    yk[hq][pt][2 * q4] = pkbf(yv[0], yv[1]); yk[hq][pt][2 * q4 + 1] = pkbf(yv[2], yv[3]);
                }
            }
        }
        ssq += __shfl_xor(ssq, 32);
        if (h == 0) __hip_atomic_fetch_add(sSS + s, ssq, __ATOMIC_RELAXED, __HIP_MEMORY_SCOPE_WORKGROUP);
        __syncthreads();
        const float rs = 1.0f / sqrtf(sSS[s] * (1.f / 256.f) + EPS);
        bf16* yp = Y + (tok0 + s) * YC + g * 256 + 4 * h;
        const float* nw = F.in[I_SSDNW] + g * 256 + 4 * h;
#pragma unroll
        for (int hq = 0; hq < 2; ++hq)
#pragma unroll
            for (int pt = 0; pt < 2; ++pt)
#pragma unroll
                for (int q4 = 0; q4 < 4; ++q4) { const int cc = (2 * hp + hq) * 64 + 32 * pt + 8 * q4; const f32x4 w4 = *(const f32x4*)(nw + cc);
                    const unsigned ya = yk[hq][pt][2 * q4], yb = yk[hq][pt][2 * q4 + 1];
                    const u32x2 o = {pkbf(bflo(ya) * rs * w4.x, bfhi(ya) * rs * w4.y), pkbf(bflo(yb) * rs * w4.z, bfhi(yb) * rs * w4.w)};
                    *(u32x2*)(yp + cc) = o; }
    }
}

__device__ __forceinline__ bf16x8 mk_bf16x8(u32x2 lo, u32x2 hi) { const u32x4 v = {lo.x, lo.y, hi.x, hi.y}; return __builtin_bit_cast(bf16x8, v); }

__device__ __forceinline__ void memattn_mfma_phase(Frame& F, int half) {
    const bf16* P = (const bf16*)(F.ws + WS_BIG);
    const bf16* MKV = (const bf16*)(F.ws + WS_MKV);
    const bf16* MVT = (const bf16*)(F.ws + WS_MVT);
    bf16* Y = (bf16*)F.out;
    LAS unsigned char* sm = F.lds;
    const int tid = F.tid, lane = F.lane, wave = F.wave, ql = lane & 31, h = lane >> 5;
    constexpr int KST = 400, VST = 528;
    for (int unit = F.bid; unit < HB * 4 * 32; unit += F.G) {
        const int bl = unit >> 7, head = (unit >> 5) & 3, qt = unit & 31, b = half * HB + bl;
        const int r = bl * SEQ + qt * 256 + wave * 32 + ql;
        __syncthreads();
        for (int c = tid; c < 256 * 24; c += NTHR) { const int row = c / 24, ch = c % 24;
            *(LAS u32x4*)(sm + row * KST + ch * 16) = *(const u32x4*)(MKV + (size_t)(b * NMEM + row) * 1536 + head * 192 + ch * 8); }
        bf16x8 qf[12];
        { const bf16* qp = P + (size_t)r * NPROJ + PC_MQ + head * 192 + 8 * h;
          u32x4 qr[12]; float ss = 0.f;
#pragma unroll
          for (int ks = 0; ks < 12; ++ks) { qr[ks] = *(const u32x4*)(qp + 16 * ks);
              ss += (bflo(qr[ks].x) * bflo(qr[ks].x) + bfhi(qr[ks].x) * bfhi(qr[ks].x)) + (bflo(qr[ks].y) * bflo(qr[ks].y) + bfhi(qr[ks].y) * bfhi(qr[ks].y))
                  + (bflo(qr[ks].z) * bflo(qr[ks].z) + bfhi(qr[ks].z) * bfhi(qr[ks].z)) + (bflo(qr[ks].w) * bflo(qr[ks].w) + bfhi(qr[ks].w) * bfhi(qr[ks].w)); }
          ss += __shfl_xor(ss, 32);
          const float rs = 1.0f / sqrtf(ss * (1.f / 192.f) + EPS);
#pragma unroll
          for (int ks = 0; ks < 12; ++ks) { const f32x4 wa = *(const f32x4*)(F.in[I_MQNW] + 16 * ks + 8 * h), wb = *(const f32x4*)(F.in[I_MQNW] + 16 * ks + 8 * h + 4);
              const u32x4 w = {pkbf(bflo(qr[ks].x) * rs * wa.x, bfhi(qr[ks].x) * rs * wa.y), pkbf(bflo(qr[ks].y) * rs * wa.z, bfhi(qr[ks].y) * rs * wa.w),
                               pkbf(bflo(qr[ks].z) * rs * wb.x, bfhi(qr[ks].z) * rs * wb.y), pkbf(bflo(qr[ks].w) * rs * wb.z, bfhi(qr[ks].w) * rs * wb.w)};
              qf[ks] = __builtin_bit_cast(bf16x8, w); } }
        __syncthreads();
        f32x16 sacc[8];
#pragma unroll
        for (int mt = 0; mt < 8; ++mt) {
#pragma unroll
            for (int i = 0; i < 16; ++i) sacc[mt][i] = 0.f;
#pragma unroll
            for (int ks = 0; ks < 12; ++ks) { const bf16x8 kf = *(const LAS bf16x8*)(sm + (32 * mt + ql) * KST + 32 * ks + 16 * h); sacc[mt] = MFMA32(kf, qf[ks], sacc[mt]); }
        }
        float mx = -3.0e38f;
#pragma unroll
        for (int mt = 0; mt < 8; ++mt)
#pragma unroll
            for (int i = 0; i < 16; ++i) mx = fmaxf(mx, sacc[mt][i]);
        mx = fmaxf(mx, __shfl_xor(mx, 32));
        const float sc = 0.07216878364870323f * 1.4426950408889634f;
        float l = 0.f;
        bf16x8 pf[8][2];
#pragma unroll
        for (int mt = 0; mt < 8; ++mt) {
            float p[16];
#pragma unroll
            for (int i = 0; i < 16; ++i) { p[i] = __builtin_amdgcn_exp2f((sacc[mt][i] - mx) * sc); l += p[i]; }
#pragma unroll
            for (int s2 = 0; s2 < 2; ++s2) { const u32x4 w = {pkbf(p[8 * s2 + 0], p[8 * s2 + 1]), pkbf(p[8 * s2 + 2], p[8 * s2 + 3]), pkbf(p[8 * s2 + 4], p[8 * s2 + 5]), pkbf(p[8 * s2 + 6], p[8 * s2 + 7])};
                pf[mt][s2] = __builtin_bit_cast(bf16x8, w); }
        }
        l += __shfl_xor(l, 32);
        __syncthreads();
        for (int c = tid; c < 192 * 32; c += NTHR) { const int row = c >> 5, ch = c & 31;
            *(LAS u32x4*)(sm + row * VST + ch * 16) = *(const u32x4*)(MVT + (size_t)(head * 192 + row) * 2048 + b * NMEM + ch * 8); }
        __syncthreads();
        const float il = 1.0f / l;
        bf16* yp = Y + ((size_t)half * HT + r) * YC + 1280 + head * 192 + 4 * h;
#pragma unroll
        for (int dt = 0; dt < 6; ++dt) {
            f32x16 o;
#pragma unroll
            for (int i = 0; i < 16; ++i) o[i] = 0.f;
#pragma unroll
            for (int mt = 0; mt < 8; ++mt)
#pragma unroll
                for (int s2 = 0; s2 < 2; ++s2) { const LAS unsigned char* vp = sm + (32 * dt + ql) * VST + (32 * mt + 16 * s2 + 4 * h) * 2;
                    const bf16x8 vf = mk_bf16x8(*(const LAS u32x2*)vp, *(const LAS u32x2*)(vp + 16)); o = MFMA32(vf, pf[mt][s2], o); }
#pragma unroll
            for (int g = 0; g < 4; ++g) { const u32x2 w = {pkbf(o[4 * g] * il, o[4 * g + 1] * il), pkbf(o[4 * g + 2] * il, o[4 * g + 3] * il)}; *(u32x2*)(yp + 32 * dt + 8 * g) = w; }
        }
    }
}

__device__ __forceinline__ void dilattn_mfma_phase(Frame& F, int half) {
    bf16* P = (bf16*)(F.ws + WS_BIG);
    float* LSE = (float*)(F.ws + WS_LSE);
    LAS unsigned char* sK = F.lds; LAS unsigned char* sV = F.lds + 384 * 144;
    const int tid = F.tid, lane = F.lane, wave = F.wave, ql = lane & 31, h = lane >> 5;
    constexpr int RST = 144;
    const float* RT = (const float*)(F.ws + WS_ROPE);
    float wk8[8];
#pragma unroll
    for (int j = 0; j < 8; ++j) wk8[j] = F.in[I_DKNW][8 * (tid & 7) + j];
    for (int unit = F.bid; unit < HB * 12 * 32; unit += F.G) {
        const int bl = unit / 384, rem = unit % 384, head = rem >> 5, blk = rem & 31;
        const int g = head >> 2, dil = (g == 0) ? 1 : (g == 1 ? 4 : 16), bpr = 32 / dil;
        const int res = blk / bpr, q0 = (blk % bpr) * 256;
        const size_t rowb = (size_t)bl * SEQ;
        __syncthreads();
        for (int c = tid; c < 384 * 8; c += NTHR) { const int row = c >> 3, ch = c & 7; const int ks = q0 - 128 + row;
            u32x4 kv = {0u, 0u, 0u, 0u}, vv = {0u, 0u, 0u, 0u}; f32x4 c0 = {1.f, 1.f, 1.f, 1.f}, c1 = c0, s0 = {0.f, 0.f, 0.f, 0.f}, s1 = s0;
            if (ks >= 0) { const size_t rr = rowb + (size_t)ks * dil + res; const bf16* src = P + rr * NPROJ + head * 64 + ch * 8; kv = *(const u32x4*)(src + PC_DK); vv = *(const u32x4*)(src + PC_DV);
                if (ch < 2) { const f32x4* rt = (const f32x4*)(RT + ((size_t)half * HT + rr) * 16); c0 = rt[0]; c1 = rt[1]; s0 = rt[2]; s1 = rt[3]; } }
            float x[8] = {bflo(kv.x), bfhi(kv.x), bflo(kv.y), bfhi(kv.y), bflo(kv.z), bfhi(kv.z), bflo(kv.w), bfhi(kv.w)};
            float ss = 0.f;
#pragma unroll
            for (int j = 0; j < 8; ++j) ss += x[j] * x[j];
            ss += __shfl_xor(ss, 1); ss += __shfl_xor(ss, 2); ss += __shfl_xor(ss, 4);
            const float rs = 1.0f / sqrtf(ss * (1.f / 64.f) + EPS);
            const float cs[8] = {c0.x, c0.y, c0.z, c0.w, c1.x, c1.y, c1.z, c1.w}, sn[8] = {s0.x, s0.y, s0.z, s0.w, s1.x, s1.y, s1.z, s1.w};
#pragma unroll
            for (int j = 0; j < 8; ++j) { x[j] = x[j] * rs * wk8[j]; const float o = __shfl_xor(x[j], 1); if (ch == 0) x[j] = x[j] * cs[j] - o * sn[j]; else if (ch == 1) x[j] = x[j] * cs[j] + o * sn[j]; }
            kv = (u32x4){pkbf(x[0], x[1]), pkbf(x[2], x[3]), pkbf(x[4], x[5]), pkbf(x[6], x[7])};
            *(LAS u32x4*)(sK + row * RST + ch * 16) = kv; *(LAS u32x4*)(sV + row * RST + ch * 16) = vv; }
        const int qs = q0 + wave * 32 + ql;
        const size_t rq = rowb + (size_t)qs * dil + res;
        bf16* qp = P + rq * NPROJ + PC_DQ + head * 64;
        bf16x8 qf[4];
        {
            u32x4 qr[4];
#pragma unroll
            for (int ks = 0; ks < 4; ++ks) qr[ks] = *(const u32x4*)(qp + 16 * ks + 8 * h);
            const f32x4* rt = (const f32x4*)(RT + ((size_t)half * HT + rq) * 16); const f32x4 c0 = rt[0], c1 = rt[1], s0 = rt[2], s1 = rt[3];
            float ss = 0.f;
#pragma unroll
            for (int ks = 0; ks < 4; ++ks) ss += (bflo(qr[ks].x) * bflo(qr[ks].x) + bfhi(qr[ks].x) * bfhi(qr[ks].x)) + (bflo(qr[ks].y) * bflo(qr[ks].y) + bfhi(qr[ks].y) * bfhi(qr[ks].y))
                                               + (bflo(qr[ks].z) * bflo(qr[ks].z) + bfhi(qr[ks].z) * bfhi(qr[ks].z)) + (bflo(qr[ks].w) * bflo(qr[ks].w) + bfhi(qr[ks].w) * bfhi(qr[ks].w));
            ss += __shfl_xor(ss, 32);
            const float rs = 1.0f / sqrtf(ss * (1.f / 64.f) + EPS);
#pragma unroll
            for (int ks = 0; ks < 4; ++ks) { const f32x4 wa = *(const f32x4*)(F.in[I_DQNW] + 16 * ks + 8 * h), wb = *(const f32x4*)(F.in[I_DQNW] + 16 * ks + 8 * h + 4);
                float x[8] = {bflo(qr[ks].x) * rs * wa.x, bfhi(qr[ks].x) * rs * wa.y, bflo(qr[ks].y) * rs * wa.z, bfhi(qr[ks].y) * rs * wa.w, bflo(qr[ks].z) * rs * wb.x, bfhi(qr[ks].z) * rs * wb.y, bflo(qr[ks].w) * rs * wb.z, bfhi(qr[ks].w) * rs * wb.w};
                if (ks == 0) { const float cs[8] = {c0.x, c0.y, c0.z, c0.w, c1.x, c1.y, c1.z, c1.w}, sn[8] = {s0.x, s0.y, s0.z, s0.w, s1.x, s1.y, s1.z, s1.w};
#pragma unroll
                    for (int j = 0; j < 8; ++j) { const float o = __shfl_xor(x[j], 32); x[j] = (h == 0) ? x[j] * cs[j] - o * sn[j] : x[j] * cs[j] + o * sn[j]; } }
                const u32x4 w = {pkbf(x[0], x[1]), pkbf(x[2], x[3]), pkbf(x[4], x[5]), pkbf(x[6], x[7])}; qf[ks] = __builtin_bit_cast(bf16x8, w); }
        }
        __syncthreads();
        f32x16 sacc[5];
        const int kfirst = q0 + wave * 32 - 128;
#pragma unroll
        for (int i = 0; i < 5; ++i) {
#pragma unroll
            for (int e = 0; e < 16; ++e) sacc[i][e] = 0.f;
#pragma unroll
            for (int ks = 0; ks < 4; ++ks) { const bf16x8 kf = *(const LAS bf16x8*)(sK + (32 * wave + 32 * i + ql) * RST + 32 * ks + 16 * h); sacc[i] = MFMA32(kf, qf[ks], sacc[i]); }
        }
        float mx = -3.0e38f;
#pragma unroll
        for (int i = 0; i < 5; ++i)
#pragma unroll
            for (int e = 0; e < 16; ++e) { const int kj = 32 * i + (e & 3) + 8 * (e >> 2) + 4 * h; const bool ok = (kj >= ql) && (kj <= ql + 128) && (kfirst + kj >= 0);
                sacc[i][e] = ok ? sacc[i][e] : -3.0e38f; mx = fmaxf(mx, sacc[i][e]); }
        mx = fmaxf(mx, __shfl_xor(mx, 32));
        const float sc = 0.125f * 1.4426950408889634f;
        float l = 0.f;
        bf16x8 pf[5][2];
#pragma unroll
        for (int i = 0; i < 5; ++i) {
            float p[16];
#pragma unroll
            for (int e = 0; e < 16; ++e) { p[e] = (sacc[i][e] > -1.0e38f) ? __builtin_amdgcn_exp2f((sacc[i][e] - mx) * sc) : 0.f; l += p[e]; }
#pragma unroll
            for (int s2 = 0; s2 < 2; ++s2) { const u32x4 w = {pkbf(p[8 * s2 + 0], p[8 * s2 + 1]), pkbf(p[8 * s2 + 2], p[8 * s2 + 3]), pkbf(p[8 * s2 + 4], p[8 * s2 + 5]), pkbf(p[8 * s2 + 6], p[8 * s2 + 7])};
                pf[i][s2] = __builtin_bit_cast(bf16x8, w); }
        }
        l += __shfl_xor(l, 32);
        const float il = 1.0f / l;
        const int tq = (lane & 15) >> 2, tp = lane & 3, tblk = (lane >> 4) & 1;
        const unsigned vbase = (unsigned)(size_t)(sV) + (unsigned)((32 * wave + 4 * h + tq) * RST + (16 * tblk + 4 * tp) * 2);
#pragma unroll
        for (int dt = 0; dt < 2; ++dt) {
            f32x16 o;
#pragma unroll
            for (int e = 0; e < 16; ++e) o[e] = 0.f;
#pragma unroll
            for (int i = 0; i < 5; ++i) {
                s16x4 lo[2], hi[2];
#pragma unroll
                for (int s2 = 0; s2 < 2; ++s2) { const unsigned a = vbase + (unsigned)((32 * i + 16 * s2) * RST + 64 * dt);
                    asm volatile("ds_read_b64_tr_b16 %0, %1" : "=&v"(lo[s2]) : "v"(a) : "memory");
                    asm volatile("ds_read_b64_tr_b16 %0, %1 offset:1152" : "=&v"(hi[s2]) : "v"(a) : "memory"); }
                asm volatile("s_waitcnt lgkmcnt(0)" ::: "memory"); __builtin_amdgcn_sched_barrier(0);
#pragma unroll
                for (int s2 = 0; s2 < 2; ++s2) { const bf16x8 vf = {lo[s2][0], lo[s2][1], lo[s2][2], lo[s2][3], hi[s2][0], hi[s2][1], hi[s2][2], hi[s2][3]}; o = MFMA32(vf, pf[i][s2], o); }
            }
#pragma unroll
            for (int gq = 0; gq < 4; ++gq) { const u32x2 w = {pkbf(o[4 * gq] * il, o[4 * gq + 1] * il), pkbf(o[4 * gq + 2] * il, o[4 * gq + 3] * il)}; *(u32x2*)(qp + 32 * dt + 8 * gq + 4 * h) = w; }
        }
        if (h == 0) LSE[((size_t)half * HT + rq) * 12 + head] = mx * 0.125f + __logf(l);
    }
}

__device__ __forceinline__ void dilmerge_phase(Frame& F, int half) {
    const bf16* P = (const bf16*)(F.ws + WS_BIG);
    const float* LSE = (const float*)(F.ws + WS_LSE);
    bf16* Y = (bf16*)F.out;
    const size_t gtid = (size_t)F.bid * NTHR + F.tid, gth = (size_t)F.G * NTHR;
    for (size_t it = gtid; it < (size_t)HT * 32; it += gth) {
        const size_t r = it >> 5; const int hh = (int)(it >> 3) & 3, d0 = (int)(it & 7) * 8;
        const size_t tok = (size_t)half * HT + r;
        const float l0 = LSE[tok * 12 + hh], l1 = LSE[tok * 12 + 4 + hh], l2 = LSE[tok * 12 + 8 + hh];
        const float m = fmaxf(l0, fmaxf(l1, l2));
        float w0 = __expf(l0 - m), w1 = __expf(l1 - m), w2 = __expf(l2 - m); const float iw = 1.0f / (w0 + w1 + w2); w0 *= iw; w1 *= iw; w2 *= iw;
        const bf16* op = P + r * NPROJ + PC_DQ + hh * 64 + d0;
        const u32x4 a = *(const u32x4*)op, b = *(const u32x4*)(op + 256), c = *(const u32x4*)(op + 512);
        u32x4 o;
        o.x = pkbf(w0 * bflo(a.x) + w1 * bflo(b.x) + w2 * bflo(c.x), w0 * bfhi(a.x) + w1 * bfhi(b.x) + w2 * bfhi(c.x));
        o.y = pkbf(w0 * bflo(a.y) + w1 * bflo(b.y) + w2 * bflo(c.y), w0 * bfhi(a.y) + w1 * bfhi(b.y) + w2 * bfhi(c.y));
        o.z = pkbf(w0 * bflo(a.z) + w1 * bflo(b.z) + w2 * bflo(c.z), w0 * bfhi(a.z) + w1 * bfhi(b.z) + w2 * bfhi(c.z));
        o.w = pkbf(w0 * bflo(a.w) + w1 * bflo(b.w) + w2 * bflo(c.w), w0 * bfhi(a.w) + w1 * bfhi(b.w) + w2 * bfhi(c.w));
        *(u32x4*)(Y + tok * YC + 1024 + hh * 64 + d0) = o;
    }
}

__device__ __forceinline__ void hn_phase(Frame& F) {
    const int gw = F.bid * NWAVES + F.wave, NGW = F.G * NWAVES;
    for (int m = gw; m < T; m += NGW) { f32x4 v[4]; rms_row_to_bf16(F.out + (size_t)m * DM, F.in[I_NFFNW], (bf16*)(F.ws + WS_ACT1) + (size_t)m * DM, F.lane, v); }
}


__device__ __forceinline__ float gelu_erf(float x) { return 0.5f * x * (1.0f + erff(x * 0.70710678118654752f)); }
__device__ __forceinline__ unsigned f2ord(float f) { const unsigned u = __builtin_bit_cast(unsigned, f); return u ^ ((unsigned)((int)u >> 31) | 0x80000000u); }
__device__ __forceinline__ float ord2f(unsigned k) { const unsigned m = (unsigned)((int)k >> 31); return __builtin_bit_cast(float, k ^ (0x80000000u | ~m)); }
#define CMPX(a, b) do { const unsigned _mx = max((a), (b)), _mn = min((a), (b)); (a) = _mx; (b) = _mn; } while (0)
__device__ __forceinline__ void bitonic_sort16_desc(unsigned (&v)[16]) {
#pragma unroll
    for (int k = 2; k <= 16; k <<= 1)
#pragma unroll
        for (int j = k >> 1; j > 0; j >>= 1)
#pragma unroll
            for (int i = 0; i < 16; ++i) { const int l = i ^ j; if (l > i) { if ((i & k) == 0) CMPX(v[i], v[l]); else CMPX(v[l], v[i]); } }
}
__device__ __forceinline__ void bitonic_merge16_desc(unsigned (&v)[16]) {
#pragma unroll
    for (int j = 8; j > 0; j >>= 1)
#pragma unroll
        for (int i = 0; i < 16; ++i) { const int l = i ^ j; if (l > i) CMPX(v[i], v[l]); }
}
__device__ __forceinline__ void top16_merge(unsigned (&a)[16], const unsigned (&b)[16]) {
#pragma unroll
    for (int i = 0; i < 16; ++i) a[i] = max(a[i], b[15 - i]);
    bitonic_merge16_desc(a);
}
constexpr int PK_ST = 272;
__device__ __forceinline__ void peer_topk_tile(Frame& F, size_t tok0, const bf16* Q, int* IDX, float* GATE) {
    const bf16* SK = (const bf16*)(F.ws + WS_SUBK);
    LAS unsigned char* sK = F.lds;
    int tid = F.tid; asm volatile("" : "+v"(tid));
    const int lane = tid & 63, wave = F.wave, ql = lane & 31, hh = lane >> 5;
    const size_t tok = tok0 + wave * 32 + ql;
    const bf16* qrow = Q + tok * PEER_Q + 8 * hh;
    __syncthreads();
#pragma unroll
    for (int j = 0; j < 4; ++j) { const int cidx = tid + 512 * j, row = cidx >> 4, ch = cidx & 15; *(LAS u32x4*)(sK + row * PK_ST + ch * 16) = *(const u32x4*)(SK + (size_t)row * 128 + ch * 8); }
    __syncthreads();
    unsigned k1[16];
    bf16x8 qf[8];
#pragma unroll
    for (int ks = 0; ks < 8; ++ks) qf[ks] = *(const bf16x8*)(qrow + 16 * ks);
#pragma unroll 1
    for (int hc = 0; hc < 16; ++hc) {
        LAS unsigned char* cur = sK + (hc & 1) * (128 * PK_ST); LAS unsigned char* nxt = sK + ((hc + 1) & 1) * (128 * PK_ST);
        u32x4 stg[4];
        const int hcn = (hc + 1) & 15;
#pragma unroll
        for (int j = 0; j < 4; ++j) { const int cidx = tid + 512 * j, row = cidx >> 4, ch = cidx & 15; stg[j] = *(const u32x4*)(SK + ((size_t)hcn * 128 + row) * 128 + ch * 8); }
        unsigned pk[4][16];
#pragma unroll
        for (int mt = 0; mt < 4; ++mt) {
            f32x16 acc;
#pragma unroll
            for (int e = 0; e < 16; ++e) acc[e] = 0.f;
#pragma unroll
            for (int ks = 0; ks < 8; ++ks) { const bf16x8 kf = *(const LAS bf16x8*)(cur + (32 * mt + ql) * PK_ST + 32 * ks + 16 * hh); acc = MFMA32(kf, qf[ks], acc); }
#pragma unroll
            for (int e = 0; e < 16; ++e) pk[mt][e] = (f2ord(acc[e]) & 0xFFFFFF80u) | (unsigned)(32 * mt + (e & 3) + 8 * (e >> 2) + 4 * hh);
        }
#pragma unroll
        for (int j = 0; j < 4; ++j) { const int cidx = tid + 512 * j, row = cidx >> 4, ch = cidx & 15; *(LAS u32x4*)(nxt + row * PK_ST + ch * 16) = stg[j]; }
        __syncthreads();
        __builtin_amdgcn_sched_barrier(0);
#pragma unroll
        for (int ks = 0; ks < 8; ++ks) qf[ks] = *(const bf16x8*)(qrow + hcn * 128 + 16 * ks);
        __builtin_amdgcn_sched_barrier(0);
#pragma unroll
        for (int mt = 0; mt < 4; ++mt) bitonic_sort16_desc(pk[mt]);
        top16_merge(pk[0], pk[1]); top16_merge(pk[2], pk[3]); top16_merge(pk[0], pk[2]);
        unsigned other[16];
#pragma unroll
        for (int i = 0; i < 16; ++i) other[i] = (unsigned)__shfl_xor((int)pk[0][i], 32);
        top16_merge(pk[0], other);
        if ((hc & 1) == 0) {
#pragma unroll
            for (int i = 0; i < 16; ++i) k1[i] = pk[0][i];
        } else {
            float f1[16], f2[16];
#pragma unroll
            for (int i = 0; i < 16; ++i) { f1[i] = ord2f(k1[i] & 0xFFFFFF80u); f2[i] = ord2f(pk[0][i] & 0xFFFFFF80u); }
            unsigned cd[4][16];
#pragma unroll
            for (int i = 0; i < 64; ++i) cd[i >> 4][i & 15] = 0u;
            int n = 0;
#pragma unroll
            for (int a = 0; a < 16; ++a)
#pragma unroll
                for (int b = 0; b < 16; ++b)
                    if ((a + 1) * (b + 1) <= 16) { cd[n >> 4][n & 15] = (f2ord(f1[a] + f2[b]) & 0xFFFFC000u) | ((k1[a] & 127u) << 7) | (pk[0][b] & 127u); ++n; }
#pragma unroll
            for (int g4 = 0; g4 < 4; ++g4) bitonic_sort16_desc(cd[g4]);
            top16_merge(cd[0], cd[1]); top16_merge(cd[2], cd[3]); top16_merge(cd[0], cd[2]);
            const float vmax = ord2f(cd[0][0] & 0xFFFFC000u);
            float ex[16], den = 0.f;
#pragma unroll
            for (int i = 0; i < 16; ++i) { ex[i] = __expf(ord2f(cd[0][i] & 0xFFFFC000u) - vmax); den += ex[i]; }
            const float iden = 1.0f / den;
            const int h = hc >> 1;
            if (hh == 0) { int* ip = IDX + tok * 128 + h * 16;
#pragma unroll
                for (int i = 0; i < 4; ++i) { const u32x4 w = {cd[0][4 * i] & 0x3FFFu, cd[0][4 * i + 1] & 0x3FFFu, cd[0][4 * i + 2] & 0x3FFFu, cd[0][4 * i + 3] & 0x3FFFu}; *(u32x4*)(ip + 4 * i) = w; } }
            else { float* gp = GATE + tok * 128 + h * 16;
#pragma unroll
                for (int i = 0; i < 4; ++i) { const f32x4 w = {ex[4 * i] * iden, ex[4 * i + 1] * iden, ex[4 * i + 2] * iden, ex[4 * i + 3] * iden}; *(f32x4*)(gp + 4 * i) = w; } }
        }
    }
}

struct PeerDeal { size_t tokw; int ntok; size_t tok0; float* PART; const int* IDX; const float* GATE; float* COEF; };
__device__ __forceinline__ void peer_item(int n, const PeerDeal& D, int wave, int& slice, size_t& tok) { slice = n >> 5; tok = D.tokw + (n & 31); }
__device__ __forceinline__ void peer_down_rows(u32x4 (&R)[16], __amdgpu_buffer_rsrc_t tab, int slice, int id0, int id1, int lane) {
    const int soff = slice * (16384 * 128);
    const int r = lane & 15, g = lane >> 4, e8 = (r >> 2) + 4 * (g >> 1), q = 4 * (g & 1) + (r & 3);
    const int src0 = 16 * (e8 & 3);
#pragma unroll
    for (int k = 0; k < 16; ++k) { const int v0 = __shfl(id0, src0 + k), v1 = __shfl(id1, src0 + k); const int id = (e8 < 4) ? v0 : v1;
        R[k] = __builtin_amdgcn_raw_buffer_load_b128(tab, (id << 7) + 16 * q, soff, 0); }
}
__device__ __forceinline__ void peer_down_hn(u32x4 (&H)[2], const bf16* HN, int slice, size_t tok, int lane) {
    const bf16* hp = HN + tok * DM + slice * 128 + 16 * (4 * ((lane >> 4) & 1) + (lane & 3));
    H[0] = *(const u32x4*)hp; H[1] = *(const u32x4*)(hp + 8);
}
__device__ __forceinline__ void peer_down_bq(long (&bq)[2], const u32x4 (&H)[2], int lane) {
    const int c = lane & 15, g = lane >> 4; const bool on = (c < 8) && ((c >> 2) == (g >> 1));
    const u32x4 x0 = H[0], x1 = H[1];
    unsigned p0 = __builtin_amdgcn_cvt_pk_fp8_f32(bflo(x0.x), bfhi(x0.x), 0, false); p0 = __builtin_amdgcn_cvt_pk_fp8_f32(bflo(x0.y), bfhi(x0.y), p0, true);
    unsigned p1 = __builtin_amdgcn_cvt_pk_fp8_f32(bflo(x0.z), bfhi(x0.z), 0, false); p1 = __builtin_amdgcn_cvt_pk_fp8_f32(bflo(x0.w), bfhi(x0.w), p1, true);
    unsigned p2 = __builtin_amdgcn_cvt_pk_fp8_f32(bflo(x1.x), bfhi(x1.x), 0, false); p2 = __builtin_amdgcn_cvt_pk_fp8_f32(bflo(x1.y), bfhi(x1.y), p2, true);
    unsigned p3 = __builtin_amdgcn_cvt_pk_fp8_f32(bflo(x1.z), bfhi(x1.z), 0, false); p3 = __builtin_amdgcn_cvt_pk_fp8_f32(bflo(x1.w), bfhi(x1.w), p3, true);
    if (!on) { p0 = 0u; p1 = 0u; p2 = 0u; p3 = 0u; }
    bq[0] = (long)(((unsigned long long)p1 << 32) | p0); bq[1] = (long)(((unsigned long long)p3 << 32) | p2);
}
__device__ __forceinline__ void peer_down_mfma(const u32x4 (&R)[16], const long (&bq)[2], __amdgpu_buffer_rsrc_t prsrc, int slice, int tokl, int lane) {
    const int c = lane & 15, g = lane >> 4, cb = c & 3;
    float dv[16];
#pragma unroll
    for (int k = 0; k < 16; ++k) { f32x4 acc = {0.f, 0.f, 0.f, 0.f}; const u32x4 v = R[k];
        acc = __builtin_amdgcn_mfma_f32_16x16x32_fp8_fp8((long)(((unsigned long long)v.y << 32) | v.x), bq[0], acc, 0, 0, 0);
        acc = __builtin_amdgcn_mfma_f32_16x16x32_fp8_fp8((long)(((unsigned long long)v.w << 32) | v.z), bq[1], acc, 0, 0, 0);
        float t = (cb == 0) ? acc.x : (cb == 1) ? acc.y : (cb == 2) ? acc.z : acc.w;
        t += __shfl_xor(t, 1); t += __shfl_xor(t, 2); dv[k] = t; }
    const unsigned off = ((c & 3) == 0 && c < 8) ? (unsigned)(((tokl * 8 + slice) * 128 + 16 * (g + 4 * (c >> 2))) * 4) : 0xFFFFFF00u;
#pragma unroll
    for (int i = 0; i < 4; ++i) { const f32x4 w = {dv[4 * i], dv[4 * i + 1], dv[4 * i + 2], dv[4 * i + 3]}; __builtin_amdgcn_raw_buffer_store_b128(__builtin_bit_cast(u32x4, w), prsrc, off, 16 * i, 0); }
}
__device__ __forceinline__ void peer_down_phase(Frame& F, const PeerDeal& D) {
    const __amdgpu_buffer_rsrc_t PD = __builtin_amdgcn_make_buffer_rsrc((void*)(F.ws + WS_PD), 0, 16384 * 1024, 0x00020000); const bf16* HN = (const bf16*)(F.ws + WS_HB);
    const int* IDX = D.IDX;
    const __amdgpu_buffer_rsrc_t prsrc = __builtin_amdgcn_make_buffer_rsrc((void*)D.PART, 0, 256 * 8 * 128 * 4, 0x00020000);
    int lane = F.lane; asm volatile("" : "+v"(lane));
    const int wave = F.wave;
    const int ntok = D.ntok;
    u32x4 RA[16], RB[16], HA[2], HB[2]; int ia0, ia1, ib0, ib1; long bq[2];
#define PEER_TOK(k, sv, tv) int sv; size_t tv; peer_item((k) < ntok ? (k) : ntok - 2 + ((k) & 1), D, wave, sv, tv)
    { PEER_TOK(0, s0, t0); PEER_TOK(1, s1, t1); PEER_TOK(2, s2, t2); PEER_TOK(3, s3, t3);
      const int a0 = IDX[t0 * 128 + lane], a1 = IDX[t0 * 128 + 64 + lane], b0 = IDX[t1 * 128 + lane], b1 = IDX[t1 * 128 + 64 + lane];
      ia0 = IDX[t2 * 128 + lane]; ia1 = IDX[t2 * 128 + 64 + lane]; ib0 = IDX[t3 * 128 + lane]; ib1 = IDX[t3 * 128 + 64 + lane];
      __builtin_amdgcn_sched_barrier(0);
      peer_down_rows(RA, PD, s0, a0, a1, lane); peer_down_hn(HA, HN, s0, t0, lane);
      __builtin_amdgcn_sched_barrier(0);
      peer_down_rows(RB, PD, s1, b0, b1, lane); peer_down_hn(HB, HN, s1, t1, lane);
      __builtin_amdgcn_sched_barrier(0); }
#pragma unroll 1
    for (int n = 0; n < ntok; n += 2) {
        PEER_TOK(n, s0, t0); PEER_TOK(n + 1, s1, t1); PEER_TOK(n + 2, s2, t2); PEER_TOK(n + 3, s3, t3); PEER_TOK(n + 4, s4, t4); PEER_TOK(n + 5, s5, t5);
        peer_down_bq(bq, HA, lane);
        peer_down_mfma(RA, bq, prsrc, s0, (int)(t0 - D.tok0), lane);
        __builtin_amdgcn_sched_barrier(0);
        { const int j0 = IDX[t4 * 128 + lane], j1 = IDX[t4 * 128 + 64 + lane];
          peer_down_rows(RA, PD, s2, ia0, ia1, lane); peer_down_hn(HA, HN, s2, t2, lane); ia0 = j0; ia1 = j1; }
        __builtin_amdgcn_sched_barrier(0);
        peer_down_bq(bq, HB, lane);
        peer_down_mfma(RB, bq, prsrc, s1, (int)(t1 - D.tok0), lane);
        __builtin_amdgcn_sched_barrier(0);
        { const int j0 = IDX[t5 * 128 + lane], j1 = IDX[t5 * 128 + 64 + lane];
          peer_down_rows(RB, PD, s3, ib0, ib1, lane); peer_down_hn(HB, HN, s3, t3, lane); ib0 = j0; ib1 = j1; }
        __builtin_amdgcn_sched_barrier(0);
    }
#undef PEER_TOK
}
__device__ __forceinline__ void peer_coef_wave(Frame& F, const PeerDeal& D) {
    for (int k = F.lane; k < 32 * 32; k += 64) {
        const int tl = (int)(D.tokw - D.tok0) + (k >> 5), slot = 4 * (k & 31);
        const float* pp = D.PART + (size_t)tl * 1024 + slot;
        f32x4 sm = *(const f32x4*)pp;
#pragma unroll
        for (int x = 1; x < 8; ++x) sm += *(const f32x4*)(pp + 128 * x);
        const size_t i = (D.tok0 + tl) * 128 + slot;
        const f32x4 gt = *(const f32x4*)(D.GATE + i);
        const float dsc = (1.0f / PD_SCALE) / sqrtf(((const float*)(F.ws + WS_SSQ))[D.tok0 + tl] * (1.f / DM) + EPS);
        const f32x4 o = {gt.x * gelu_erf(sm.x * dsc) * (1.0f / PU_SCALE), gt.y * gelu_erf(sm.y * dsc) * (1.0f / PU_SCALE),
                         gt.z * gelu_erf(sm.z * dsc) * (1.0f / PU_SCALE), gt.w * gelu_erf(sm.w * dsc) * (1.0f / PU_SCALE)};
        *(f32x4*)(D.COEF + i) = o;
    }
}
__device__ __forceinline__ void peer_up_rows(u32x4 (&R)[16], __amdgpu_buffer_rsrc_t tab, int slice, int id0, int id1, int lane) {
    const int soff = slice * (16384 * 128);
#pragma unroll
    for (int s8 = 0; s8 < 8; ++s8) { const int id = __shfl(s8 < 4 ? id0 : id1, (16 * s8 + (lane >> 2)) & 63); const int vo = (id << 7) + 16 * (lane & 3);
        R[2 * s8] = __builtin_amdgcn_raw_buffer_load_b128(tab, vo, soff, 0); R[2 * s8 + 1] = __builtin_amdgcn_raw_buffer_load_b128(tab, vo, soff + 64, 0); }
}
__device__ __forceinline__ void peer_up_compute(const u32x4 (&R)[16], float c0, float c1, f32x2 h, float* out, int slice, size_t tok, int lane) {
    f32x2 acc[16];
#pragma unroll
    for (int k = 0; k < 16; ++k) acc[k] = (f32x2){0.f, 0.f};
#pragma unroll
    for (int s8 = 0; s8 < 8; ++s8) { const float c = __shfl(s8 < 4 ? c0 : c1, (16 * s8 + (lane >> 2)) & 63); f32x2 c2 = {c, c}; asm volatile("" : "+v"(c2));
#pragma unroll
        for (int hf = 0; hf < 2; ++hf) { const u32x4 r = R[2 * s8 + hf];
            acc[8 * hf + 0] = c2 * __builtin_amdgcn_cvt_pk_f32_fp8(r.x, false) + acc[8 * hf + 0]; acc[8 * hf + 1] = c2 * __builtin_amdgcn_cvt_pk_f32_fp8(r.x, true) + acc[8 * hf + 1];
            acc[8 * hf + 2] = c2 * __builtin_amdgcn_cvt_pk_f32_fp8(r.y, false) + acc[8 * hf + 2]; acc[8 * hf + 3] = c2 * __builtin_amdgcn_cvt_pk_f32_fp8(r.y, true) + acc[8 * hf + 3];
            acc[8 * hf + 4] = c2 * __builtin_amdgcn_cvt_pk_f32_fp8(r.z, false) + acc[8 * hf + 4]; acc[8 * hf + 5] = c2 * __builtin_amdgcn_cvt_pk_f32_fp8(r.z, true) + acc[8 * hf + 5];
            acc[8 * hf + 6] = c2 * __builtin_amdgcn_cvt_pk_f32_fp8(r.w, false) + acc[8 * hf + 6]; acc[8 * hf + 7] = c2 * __builtin_amdgcn_cvt_pk_f32_fp8(r.w, true) + acc[8 * hf + 7]; } }
    f32x2 r8[8], r4[4], r2[2], r1;
    { const bool up = (lane & 32) != 0;
#pragma unroll
      for (int k = 0; k < 8; ++k) { const f32x2 keep = up ? acc[k + 8] : acc[k], send = up ? acc[k] : acc[k + 8]; r8[k] = keep + (f32x2){__shfl_xor(send.x, 32), __shfl_xor(send.y, 32)}; } }
    { const bool up = (lane & 16) != 0;
#pragma unroll
      for (int k = 0; k < 4; ++k) { const f32x2 keep = up ? r8[k + 4] : r8[k], send = up ? r8[k] : r8[k + 4]; r4[k] = keep + (f32x2){__shfl_xor(send.x, 16), __shfl_xor(send.y, 16)}; } }
    { const bool up = (lane & 8) != 0;
#pragma unroll
      for (int k = 0; k < 2; ++k) { const f32x2 keep = up ? r4[k + 2] : r4[k], send = up ? r4[k] : r4[k + 2]; r2[k] = keep + (f32x2){__shfl_xor(send.x, 8), __shfl_xor(send.y, 8)}; } }
    { const bool up = (lane & 4) != 0; const f32x2 keep = up ? r2[1] : r2[0], send = up ? r2[0] : r2[1]; r1 = keep + (f32x2){__shfl_xor(send.x, 4), __shfl_xor(send.y, 4)}; }
    const int p = ((lane >> 5) & 1) * 8 + ((lane >> 4) & 1) * 4 + ((lane >> 3) & 1) * 2 + ((lane >> 2) & 1);
    *(f32x2*)(out + tok * DM + slice * 128 + 16 * (lane & 3) + 2 * (p & 7) + 64 * (p >> 3)) = h + r1;
}
__device__ __forceinline__ void peer_up_phase(Frame& F, const PeerDeal& D, float* outp) {
    const __amdgpu_buffer_rsrc_t PU = __builtin_amdgcn_make_buffer_rsrc((void*)(F.ws + WS_PU), 0, 16384 * 1024, 0x00020000);
    const int* IDX = D.IDX; const float* COEF = D.COEF;
    int lane = F.lane; asm volatile("" : "+v"(lane));
    const int wave = F.wave;
    const int ntok = D.ntok;
    const int p = ((lane >> 5) & 1) * 8 + ((lane >> 4) & 1) * 4 + ((lane >> 3) & 1) * 2 + ((lane >> 2) & 1);
    const int hoff = 16 * (lane & 3) + 2 * (p & 7) + 64 * (p >> 3);
    int sl; size_t tk;
    u32x4 R0[16], R1[16];
    float ca0, ca1, cb0, cb1; f32x2 ha, hb;
    int id0, id1, jd0, jd1;
    { int s1_; size_t t1_; peer_item(0, D, wave, sl, tk); peer_item(1, D, wave, s1_, t1_);
      jd0 = IDX[tk * 128 + lane]; jd1 = IDX[tk * 128 + 64 + lane]; id0 = IDX[t1_ * 128 + lane]; id1 = IDX[t1_ * 128 + 64 + lane];
      __builtin_amdgcn_sched_barrier(0);
      peer_up_rows(R0, PU, sl, jd0, jd1, lane);
      ca0 = COEF[tk * 128 + lane]; ca1 = COEF[tk * 128 + 64 + lane]; ha = *(const f32x2*)(F.out + tk * DM + sl * 128 + hoff);
      __builtin_amdgcn_sched_barrier(0); }
#pragma unroll 1
    for (int n = 0; n < ntok; n += 2) {
        int s0, s1, s2, s3; size_t t0, t1, t2, t3;
        peer_item(n, D, wave, s0, t0); peer_item(n + 1, D, wave, s1, t1);
        peer_item(n + 2 < ntok ? n + 2 : n, D, wave, s2, t2); peer_item(n + 3 < ntok ? n + 3 : n + 1, D, wave, s3, t3);
        jd0 = IDX[t2 * 128 + lane]; jd1 = IDX[t2 * 128 + 64 + lane];
        peer_up_rows(R1, PU, s1, id0, id1, lane);
        cb0 = COEF[t1 * 128 + lane]; cb1 = COEF[t1 * 128 + 64 + lane]; hb = *(const f32x2*)(F.out + t1 * DM + s1 * 128 + hoff);
        __builtin_amdgcn_sched_barrier(0);
        peer_up_compute(R0, ca0, ca1, ha, outp, s0, t0, lane);
        __builtin_amdgcn_sched_barrier(0);
        id0 = IDX[t3 * 128 + lane]; id1 = IDX[t3 * 128 + 64 + lane];
        peer_up_rows(R0, PU, s2, jd0, jd1, lane);
        ca0 = COEF[t2 * 128 + lane]; ca1 = COEF[t2 * 128 + 64 + lane]; ha = *(const f32x2*)(F.out + t2 * DM + s2 * 128 + hoff);
        __builtin_amdgcn_sched_barrier(0);
        peer_up_compute(R1, cb0, cb1, hb, outp, s1, t1, lane);
        __builtin_amdgcn_sched_barrier(0);
    }
}
__device__ __forceinline__ void peer_tile(Frame& F, int tile) {
    const size_t tok0 = (size_t)tile * 256;
    const bf16* Q = (const bf16*)(F.ws + WS_BIG);
    int* IDX = (int*)(F.ws + WS_BIG + 256 * MiB); float* GATE = (float*)(F.ws + WS_BIG + 288 * MiB); float* COEF = (float*)(F.ws + WS_BIG + 320 * MiB);
    peer_topk_tile(F, tok0, Q, IDX, GATE);
    VM_WAIT(); __syncthreads();
    PeerDeal D; D.tokw = tok0 + F.wave * 32; D.ntok = 256; D.tok0 = tok0; D.PART = (float*)(F.ws + WS_BIG + tok0 * (PEER_Q * 2)); D.IDX = IDX; D.GATE = GATE; D.COEF = COEF;
    peer_down_phase(F, D);
    VM_WAIT(); __syncthreads();
    peer_coef_wave(F, D);
    VM_WAIT(); __syncthreads();
    peer_up_phase(F, D, F.out);
}
__device__ __forceinline__ void peer_phase(Frame& F) { for (int tile = F.bid; tile < T / 256; tile += F.G) { peer_tile(F, tile); VM_WAIT(); __syncthreads(); } }

constexpr int N_PHASES = 14;
__global__ void __launch_bounds__(NTHR, 2) mega_fwd(Args args) {
    extern __shared__ __attribute__((aligned(16))) unsigned char lds_raw[];
    Frame F;
    F.lds = (LAS unsigned char*)lds_raw;
    F.tid = threadIdx.x; F.lane = F.tid & 63; F.wave = __builtin_amdgcn_readfirstlane(F.tid >> 6);
    F.G = gridDim.x; F.bid = blockIdx.x;
    F.in = args.in;
    F.positions = args.positions; F.out = args.out; F.ws = args.ws;
    unsigned char* ws = args.ws;
    volatile LAS unsigned* ctlw = (volatile LAS unsigned*)(F.lds + LDSCTL_OFF);
    if (F.tid < 64) ctlw[F.tid] = 0u;
    __syncthreads();
    const int lo = args.ph_lo, hi = args.ph_hi;
    XcdBarrier bar; bar.bar = (unsigned*)(ws + WS_CTL); bar.x = 0; bar.st = nullptr; bar.wave = F.wave;
    if (hi - lo > 1) bar = xcd_barrier_post((unsigned*)(ws + WS_CTL), ctlw + 8, F.wave);
#define IN(k) (lo <= (k) && (k) < hi)
#define SEAM(k) do { if (IN(k) && IN((k) + 1)) xcd_barrier(bar); } while (0)
    bf16* ACT1 = (bf16*)(ws + WS_ACT1); bf16* BIG = (bf16*)(ws + WS_BIG); bf16* WallT = (bf16*)(ws + WS_WALLT);

    if (IN(0)) { frame_refresh(F); p0_prologue(F); __syncthreads(); }
    SEAM(0);
    if (IN(1)) { frame_refresh(F);
        { pg8::Gemm g{(const bf16*)(ws + WS_MEMN), (const bf16*)(ws + WS_WMKVT), NB * NMEM, 768, DM, DM, DM}; pg8::StaticOrder S; S.init(g.M, g.N, F.G, F.bid);
          pg8::EpiBf16<0> E{(bf16*)(ws + WS_MKV), 1536}; pg8::gemm_phase(F.lds, g, S, E, F.wave); }
        { pg8::Gemm g{(const bf16*)(ws + WS_WMKVT) + (size_t)768 * DM, (const bf16*)(ws + WS_MEMN), 768, NB * NMEM, DM, DM, DM}; pg8::StaticOrder S; S.init(g.M, g.N, F.G, F.G - 1 - F.bid);
          pg8::EpiBf16<0> E{(bf16*)(ws + WS_MVT), NB * NMEM}; pg8::gemm_phase(F.lds, g, S, E, F.wave); }
        { pg8::Gemm g{ACT1, WallT, HT, NPROJ, DM, DM, DM}; pg8::StaticOrder S; S.init(g.M, g.N, F.G, F.bid);
          pg8::EpiBf16<0> E{BIG, NPROJ}; pg8::gemm_phase(F.lds, g, S, E, F.wave); }
    }
    SEAM(1);
    if (IN(2)) { frame_refresh(F); mknorm_phase(F); ssdC_phase(F, 0); }
    SEAM(2);
    if (IN(3)) { frame_refresh(F); ssdD_phase(F); dilattn_mfma_phase(F, 0); memattn_mfma_phase(F, 0); }
    SEAM(3);
    if (IN(4)) { frame_refresh(F); ssdE_phase(F, 0); dilmerge_phase(F, 0); }
    SEAM(4);
    if (IN(5)) { frame_refresh(F); pg8::Gemm g{ACT1 + (size_t)HT * DM, WallT, HT, NPROJ, DM, DM, DM}; pg8::StaticOrder S; S.init(g.M, g.N, F.G, F.bid);
        pg8::EpiBf16<0> E{BIG, NPROJ}; pg8::gemm_phase(F.lds, g, S, E, F.wave); }
    SEAM(5);
    if (IN(6)) { frame_refresh(F); ssdC_phase(F, 1); }
    SEAM(6);
    if (IN(7)) { frame_refresh(F); ssdD_phase(F); dilattn_mfma_phase(F, 1); memattn_mfma_phase(F, 1); }
    SEAM(7);
    if (IN(8)) { frame_refresh(F); ssdE_phase(F, 1); dilmerge_phase(F, 1); }
    SEAM(8);
    if (IN(9)) { frame_refresh(F); pg8::Gemm g{ACT1, WallT + (size_t)NPROJ * DM, T, NGATE, DM, DM, DM}; pg8::StaticOrder S; S.init(g.M, g.N, F.G, F.bid);
        pg8::EpiBf16<1> E{BIG, NGATE}; pg8::gemm_phase(F.lds, g, S, E, F.wave); }
    SEAM(9);
    if (IN(10)) { frame_refresh(F);
        pg8::Gemm g{(const bf16*)F.out, (const bf16*)(ws + WS_WCATT), T, DM, YC, YC, YC}; pg8::StaticOrder S; S.init(g.M, g.N, F.G, F.bid);
        pg8::EpiBranchFused E{ACT1, DM, __builtin_amdgcn_make_buffer_rsrc((void*)BIG, 0, T * NGATE * 2, 0x00020000), NGATE}; pg8::gemm_phase(F.lds, g, S, E, F.wave);
    }
    SEAM(10);
    if (IN(11)) { frame_refresh(F); pg8::Gemm g{ACT1, (const bf16*)(ws + WS_WOUTT), T, DM, DM, DM, DM}; pg8::StaticOrder S; S.init(g.M, g.N, F.G, F.bid);
        pg8::EpiResidNorm E{F.out, DM, F.in[I_X], (bf16*)(ws + WS_HB), F.in[I_NFFNW], (float*)(ws + WS_SSQ)}; pg8::gemm_phase(F.lds, g, S, E, F.wave); }
    SEAM(11);
    if (IN(12)) { frame_refresh(F); pg8::Gemm g{(const bf16*)(ws + WS_HB), (const bf16*)(ws + WS_WQT), T, PEER_Q, DM, DM, DM}; pg8::StaticOrder S; S.init(g.M, g.N, F.G, F.bid);
        pg8::EpiBf16RowScale E{BIG, PEER_Q, (const float*)(ws + WS_SSQ)}; pg8::gemm_phase(F.lds, g, S, E, F.wave); }
    SEAM(12);
    if (IN(13)) { frame_refresh(F); peer_phase(F); }
#undef IN
#undef SEAM
}

extern "C" void kernel_launch(void* const* d_in, const int* in_sizes, int n_in, void* d_out, int out_size, void* d_ws, size_t ws_size, hipStream_t stream) {
    static int grid = 0;
    if (grid == 0) {
        if (n_in != 26 || out_size != T * DM || ws_size < WS_END) { fprintf(stderr, "kernel_launch: unexpected shapes (n_in %d, out %d, ws %zu)\n", n_in, out_size, ws_size); grid = -1; return; }
        int dev = 0, cus = 0;
        if (hipGetDevice(&dev) != hipSuccess || hipDeviceGetAttribute(&cus, hipDeviceAttributeMultiprocessorCount, dev) != hipSuccess) { grid = -1; return; }
        if (hipFuncSetAttribute((const void*)mega_fwd, hipFuncAttributeMaxDynamicSharedMemorySize, LDS_BYTES) != hipSuccess) { grid = -1; return; }
        int per_cu = 0;
        (void)hipOccupancyMaxActiveBlocksPerMultiprocessor(&per_cu, (const void*)mega_fwd, NTHR, LDS_BYTES);
        (void)hipGetLastError();
        grid = cus;
    }
    if (grid < 0) return;
    (void)hipMemsetAsync((char*)d_ws + WS_CTL, 0, CTL_ZERO_BYTES, stream);
    Args a{};
    for (int i = 0; i < 26; ++i) a.in[i] = (const float*)d_in[i];
    a.positions = (const int*)d_in[2]; a.out = (float*)d_out; a.ws = (unsigned char*)d_ws;
#if MK_N_LAUNCHES == 1
    a.ph_lo = 0; a.ph_hi = N_PHASES;
    hipLaunchKernelGGL(mega_fwd, dim3(grid), dim3(NTHR), LDS_BYTES, stream, a);
#else
    for (int p = 0; p < N_PHASES; ++p) { a.ph_lo = p; a.ph_hi = p + 1; hipLaunchKernelGGL(mega_fwd, dim3(grid), dim3(NTHR), LDS_BYTES, stream, a); }
#endif
}
```

```cpp
#include <hip/hip_runtime.h>
#include <cstdio>
#include <cstdint>

#ifndef MK_N_LAUNCHES
#define MK_N_LAUNCHES 1
#endif

#define LAS __attribute__((address_space(3)))
#define GAS __attribute__((address_space(1)))
typedef unsigned short bf16;
typedef short bf16x8 __attribute__((ext_vector_type(8)));
typedef float f32x4 __attribute__((ext_vector_type(4)));
typedef float f32x2 __attribute__((ext_vector_type(2)));
typedef unsigned u32x4 __attribute__((ext_vector_type(4)));
typedef unsigned u32x2 __attribute__((ext_vector_type(2)));

constexpr int NB = 8, SEQ = 8192, DM = 1024, T = NB * SEQ;
constexpr int HB = 4, HT = HB * SEQ;
constexpr int NMEM = 256;
constexpr int NPROJ = 6144;
constexpr int PC_Z = 0, PC_X = 1024, PC_B = 2048, PC_C = 2560, PC_DQ = 3072, PC_DK = 3840, PC_DV = 4608, PC_MQ = 5376;
constexpr int W_IN_N = 9232, OFF_DT = 3072, OFF_AFTER_DT = 3088;
constexpr int NGATE = 3072;
constexpr int YC = 2048;
constexpr int PEER_H = 8, PEER_K = 16, PEER_NK = 128, PEER_Q = 2048;
constexpr float EPS = 1e-6f;

constexpr size_t MiB = 1u << 20;
constexpr size_t WS_CTL = 0, CTL_ZERO_BYTES = 65536;
constexpr size_t WS_WALLT = 1 * MiB;
constexpr size_t WS_WMKVT = 19 * MiB;
constexpr size_t WS_WCATT = 22 * MiB;
constexpr size_t WS_WOUTT = 26 * MiB;
constexpr size_t WS_WQT = 28 * MiB;
constexpr size_t WS_SUBK = 32 * MiB;
constexpr size_t WS_PD = 33 * MiB;
constexpr size_t WS_PU = 65 * MiB;
constexpr size_t WS_DT = 97 * MiB;
constexpr size_t WS_MEMN = 101 * MiB;
constexpr size_t WS_MKV = 105 * MiB;
constexpr size_t WS_ACT1 = 112 * MiB;
constexpr size_t WS_BIG = 240 * MiB;
constexpr size_t WS_LSE = 624 * MiB;
constexpr size_t WS_MVT = 628 * MiB;
constexpr size_t WS_DEC = 631 * MiB;
constexpr size_t WS_SST = 632 * MiB;
constexpr size_t WS_SIN = 760 * MiB;
constexpr size_t WS_ROPE = 824 * MiB;
constexpr size_t WS_SSQ = 828 * MiB;
constexpr size_t WS_HB = 632 * MiB;
constexpr size_t WS_MERGED = 832 * MiB;
constexpr size_t WS_END = 960 * MiB;

constexpr int RING_BYTES = 131072;
constexpr int LDSCTL_OFF = 143360;
constexpr int LDS_BYTES = 147456;
constexpr int NWAVES = 8, NTHR = 512;

__device__ __forceinline__ int lane_id() { return (int)__builtin_amdgcn_mbcnt_hi(~0u, __builtin_amdgcn_mbcnt_lo(~0u, 0u)); }
__device__ __forceinline__ float bf2f(unsigned short b) { return __builtin_bit_cast(float, (unsigned)b << 16); }
__device__ __forceinline__ float bflo(unsigned w) { return __builtin_bit_cast(float, w << 16); }
__device__ __forceinline__ float bfhi(unsigned w) { return __builtin_bit_cast(float, w & 0xffff0000u); }
__device__ __forceinline__ unsigned f2bf(float f) { unsigned u = __builtin_bit_cast(unsigned, f); return (u + 0x7fffu + ((u >> 16) & 1u)) >> 16; }
__device__ __forceinline__ unsigned pk2(float lo, float hi) { return f2bf(lo) | (f2bf(hi) << 16); }
typedef float f32x16 __attribute__((ext_vector_type(16)));
typedef short s16x4 __attribute__((ext_vector_type(4)));
typedef __bf16 bf2_t __attribute__((ext_vector_type(2)));
__device__ __forceinline__ unsigned pkbf(float a, float b) { const f32x2 v = {a, b}; return __builtin_bit_cast(unsigned, __builtin_convertvector(v, bf2_t)); }
#define MFMA32(a, b, c) __builtin_amdgcn_mfma_f32_32x32x16_bf16((a), (b), (c), 0, 0, 0)
__device__ __forceinline__ float wave_sum(float v) {
#pragma unroll
    for (int o = 1; o < 64; o <<= 1) v += __shfl_xor(v, o);
    return v;
}
__device__ __forceinline__ float wave_max(float v) {
#pragma unroll
    for (int o = 1; o < 64; o <<= 1) v = fmaxf(v, __shfl_xor(v, o));
    return v;
}
__device__ __forceinline__ float sigmoidf_(float x) { return 1.0f / (1.0f + __expf(-x)); }
#define LDS_WAIT() asm volatile("s_waitcnt lgkmcnt(0)" ::: "memory")
#define VM_WAIT() asm volatile("s_waitcnt vmcnt(0)" ::: "memory")

#define XB_TMO      128
#define XB_XCNT(j)  (256  + 64 * (j))
#define XB_XSUB(j)  (1280 + 64 * (j))
#define XB_XGEN(j)  (2304 + 64 * (j))
#define XB_TOP      3328
#define XB_TOPGEN   3392
#define XCD_BAR_WORDS 3456
#define XB_SPIN_CAP (1u << 18)
__device__ __forceinline__ unsigned xb_ld(unsigned* p)              { return __hip_atomic_load(p, __ATOMIC_RELAXED, __HIP_MEMORY_SCOPE_AGENT); }
__device__ __forceinline__ unsigned xb_add(unsigned* p, unsigned v) { return __hip_atomic_fetch_add(p, v, __ATOMIC_RELAXED, __HIP_MEMORY_SCOPE_AGENT); }
__device__ __forceinline__ unsigned xb_xcc_id() { return (unsigned)__builtin_amdgcn_s_getreg((3 << 11) | 20) & 0xFu; }
#define XB_SPIN(cond, bar) do { unsigned _sp = 0; while (cond) { __builtin_amdgcn_s_sleep(1); \
    if ((++_sp & 255u) == 0u) { if (xb_ld(&(bar)[XB_TMO])) break; if (_sp > XB_SPIN_CAP) { atomicAdd(&(bar)[XB_TMO], 1u); break; } } } } while (0)
struct XcdBarrier { unsigned* bar; unsigned x; volatile LAS unsigned* st; int wave; };
__device__ __forceinline__ XcdBarrier xcd_barrier_post(unsigned* bar, volatile LAS unsigned* st, int wave) {
    XcdBarrier b; b.bar = bar; b.x = xb_xcc_id(); b.st = st; b.wave = wave;
    if (wave == 0 && lane_id() == 0) (void)xb_add(&bar[XB_XCNT(b.x)], 1u);
    return b;
}
__device__ __forceinline__ void xcd_barrier_complete(unsigned* bar, unsigned x, unsigned& nloc, unsigned& nx) {
    const unsigned G = gridDim.x * gridDim.y * gridDim.z;
    unsigned sum, cnt, mine, sp = 0u;
    for (;;) {
        sum = 0u; cnt = 0u; mine = 0u;
#pragma unroll
        for (unsigned j = 0; j < 16; ++j) { const unsigned c = xb_ld(&bar[XB_XCNT(j)]); sum += c; cnt += (c > 0u) ? 1u : 0u; mine = (j == x) ? c : mine; }
        if (sum == G) break;
        __builtin_amdgcn_s_sleep(1);
        if ((++sp & 255u) == 0u) { if (xb_ld(&bar[XB_TMO])) break; if (sp > XB_SPIN_CAP) { atomicAdd(&bar[XB_TMO], 1u); break; } }
    }
    nloc = mine > 0u ? mine : 1u; nx = cnt > 0u ? cnt : 1u;
}
__device__ __forceinline__ void xcd_barrier(const XcdBarrier& b) {
    asm volatile("s_waitcnt vmcnt(0)" ::: "memory");
    __syncthreads();
    if (b.wave == 0 && lane_id() == 0) {
        unsigned* bar = b.bar;
        __builtin_amdgcn_s_waitcnt(0);
        unsigned nloc = b.st[0], nx = b.st[1];
        if (nloc == 0u) { xcd_barrier_complete(bar, b.x, nloc, nx); b.st[0] = nloc; b.st[1] = nx; }
        const unsigned old = xb_add(&bar[XB_XSUB(b.x)], 1u);
        const unsigned gen = old / nloc;
        if (old + 1u == (gen + 1u) * nloc) {
            __builtin_amdgcn_fence(__ATOMIC_RELEASE, "agent");
            asm volatile("s_waitcnt vmcnt(0)" ::: "memory");
            const unsigned og = xb_add(&bar[XB_TOP], 1u);
            const unsigned tg = og / nx;
            if (og + 1u == (tg + 1u) * nx) xb_add(&bar[XB_TOPGEN], 1u);
            else XB_SPIN(xb_ld(&bar[XB_TOPGEN]) == tg, bar);
            __builtin_amdgcn_fence(__ATOMIC_ACQUIRE, "agent");
            xb_add(&bar[XB_XGEN(b.x)], 1u);
            asm volatile("s_waitcnt vmcnt(0)" ::: "memory");
        } else {
            XB_SPIN(xb_ld(&bar[XB_XGEN(b.x)]) == gen, bar);
            __builtin_amdgcn_fence(__ATOMIC_ACQUIRE, "agent");
            asm volatile("s_waitcnt vmcnt(0)" ::: "memory");
        }
    }
    __syncthreads();
}

namespace pg8 {
constexpr int BM = 256, BK = 64, HALF = 128, HTB = HALF * BK * 2, STAGE_BYTES = 8 * HTB, NXCD = 8, WGM = 8;
__host__ __device__ __forceinline__ int lds_byte(int r, int c) { const int st = (r >> 4) * 2 + (c >> 5), rr = r & 15, cc = c & 31, ob = rr * 64 + cc * 2; return st * 1024 + (ob ^ (((ob >> 9) & 1) << 5)); }
__host__ __device__ __forceinline__ void stage_rc(int b, int& R, int& C) { const int st = b / 1024, sb = b % 1024, swz = sb ^ (((sb >> 9) & 1) << 5); R = (st >> 1) * 16 + swz / 64; C = (st & 1) * 32 + (swz % 64) / 2; }
__host__ __device__ __forceinline__ int perm32(int rho) { const int n = rho >> 4, i = rho & 15; return 8 * (i >> 2) + 4 * n + (i & 3); }
struct Unit { int pm, pn; };
struct Gemm { const bf16* A; const bf16* Bt; int M, N, K, lda, ldb; };
struct StaticOrder {
    int nM, nN, nwg, G, c;
    __host__ __device__ void init(int M, int N, int G_, int c_) { nM = M / BM; nN = N / BM; nwg = nM * nN; G = G_; c = c_; }
    __host__ __device__ bool next(int i, Unit& u) const {
        const long L = (long)i * G + c; if (L >= nwg) return false;
        int wgid = (int)L; { const int q = nwg / NXCD, r = nwg % NXCD, xcd = wgid % NXCD, off = wgid / NXCD; wgid = (xcd < r ? xcd * (q + 1) : r * (q + 1) + (xcd - r) * q) + off; }
        const int nig = WGM * nN, gid = wgid / nig, fm = gid * WGM, gsz = (nM - fm) < WGM ? (nM - fm) : WGM;
        u.pm = fm + ((wgid % nig) % gsz); u.pn = (wgid % nig) / gsz; return true;
    }
    __device__ __forceinline__ void a_ready(const Unit&) const {}
    __device__ __forceinline__ void done(const Unit&) const {}
};
struct GateOrder {
    StaticOrder B;
    __device__ __forceinline__ bool next(int i, Unit& u) const { Unit t; if (!B.next(i / 3, t)) return false; u.pm = t.pm; u.pn = t.pn + 4 * (i % 3); return true; }
    __device__ __forceinline__ void a_ready(const Unit&) const {}
    __device__ __forceinline__ void done(const Unit&) const {}
};
__device__ __forceinline__ unsigned cvt_pk_bf16(float lo, float hi) { unsigned r; asm volatile("v_cvt_pk_bf16_f32 %0, %1, %2" : "=v"(r) : "v"(lo), "v"(hi)); return r; }

template <int ACT> struct EpiBf16 {
    static constexpr bool PERM = true, AFTER_DRAIN = false, HAS_MID = false;
    bf16* O; int ldc;
    __device__ __forceinline__ void operator()(const f32x4 (&acc)[2][2][4][2], const Unit& u, int wr, int wc, int fr, int fq) const {
        const int row0 = u.pm * BM + wr * 64 + fr; const int col0 = u.pn * BM + wc * 32 + 8 * fq;
#pragma unroll
        for (int ai = 0; ai < 2; ++ai)
#pragma unroll
            for (int m = 0; m < 4; ++m) { bf16* rowp = O + (size_t)(row0 + ai * HALF + m * 16) * ldc + col0;
#pragma unroll
                for (int bj = 0; bj < 2; ++bj) { f32x4 v0 = acc[ai][bj][m][0], v1 = acc[ai][bj][m][1];
                    if (ACT == 1) {
#pragma unroll
                        for (int j = 0; j < 4; ++j) { v0[j] = sigmoidf_(v0[j]); v1[j] = sigmoidf_(v1[j]); } }
                    u32x4 w; w.x = cvt_pk_bf16(v0[0], v0[1]); w.y = cvt_pk_bf16(v0[2], v0[3]); w.z = cvt_pk_bf16(v1[0], v1[1]); w.w = cvt_pk_bf16(v1[2], v1[3]);
                    *(u32x4*)(rowp + bj * HALF) = w; } }
    }
};
struct EpiResid {
    static constexpr bool PERM = false, AFTER_DRAIN = false, HAS_MID = false;
    float* C; int ldc; const float* R;
    __device__ __forceinline__ void operator()(const f32x4 (&acc)[2][2][4][2], const Unit& u, int wr, int wc, int fr, int fq) const {
        const int row0 = u.pm * BM + wr * 64 + fr, col0 = u.pn * BM + wc * 32 + 4 * fq;
#pragma unroll
        for (int ai = 0; ai < 2; ++ai)
#pragma unroll
            for (int m = 0; m < 4; ++m) { const size_t off = (size_t)(row0 + ai * HALF + m * 16) * ldc + col0;
#pragma unroll
                for (int bj = 0; bj < 2; ++bj)
#pragma unroll
                    for (int n = 0; n < 2; ++n) { const f32x4 r = *(const f32x4*)(R + off + bj * HALF + n * 16); *(f32x4*)(C + off + bj * HALF + n * 16) = acc[ai][bj][m][n] + r; } }
    }
};

struct EpiResidNorm {
    static constexpr bool PERM = false, AFTER_DRAIN = false, HAS_MID = false;
    float* C; int ldc; const float* R; bf16* Hb; const float* w; float* SSQ;
    __device__ __forceinline__ void operator()(const f32x4 (&acc)[2][2][4][2], const Unit& u, int wr, int wc, int fr, int fq) const {
        const int row0 = u.pm * BM + wr * 64 + fr, col0 = u.pn * BM + wc * 32 + 4 * fq;
        f32x4 wv[2][2];
#pragma unroll
        for (int bj = 0; bj < 2; ++bj)
#pragma unroll
            for (int n = 0; n < 2; ++n) wv[bj][n] = *(const f32x4*)(w + col0 + bj * HALF + n * 16);
#pragma unroll
        for (int ai = 0; ai < 2; ++ai)
#pragma unroll
            for (int m = 0; m < 4; ++m) { const int row = row0 + ai * HALF + m * 16; const size_t off = (size_t)row * ldc + col0; float ss = 0.f;
#pragma unroll
                for (int bj = 0; bj < 2; ++bj)
#pragma unroll
                    for (int n = 0; n < 2; ++n) { const f32x4 h = acc[ai][bj][m][n] + *(const f32x4*)(R + off + bj * HALF + n * 16); *(f32x4*)(C + off + bj * HALF + n * 16) = h;
                        ss += (h.x * h.x + h.y * h.y) + (h.z * h.z + h.w * h.w);
                        const u32x2 hb2 = {cvt_pk_bf16(h.x * wv[bj][n].x, h.y * wv[bj][n].y), cvt_pk_bf16(h.z * wv[bj][n].z, h.w * wv[bj][n].w)}; *(u32x2*)(Hb + off + bj * HALF + n * 16) = hb2; }
                ss += __shfl_xor(ss, 16); ss += __shfl_xor(ss, 32);
                if (fq == 0) atomicAdd(SSQ + row, ss); }
    }
};
struct EpiBf16RowScale {
    static constexpr bool PERM = true, AFTER_DRAIN = false, HAS_MID = false;
    bf16* O; int ldc; const float* SSQ;
    __device__ __forceinline__ void operator()(const f32x4 (&acc)[2][2][4][2], const Unit& u, int wr, int wc, int fr, int fq) const {
        const int row0 = u.pm * BM + wr * 64 + fr; const int col0 = u.pn * BM + wc * 32 + 8 * fq;
#pragma unroll
        for (int ai = 0; ai < 2; ++ai)
#pragma unroll
            for (int m = 0; m < 4; ++m) { const int row = row0 + ai * HALF + m * 16; bf16* rowp = O + (size_t)row * ldc + col0; const float rs = 1.0f / sqrtf(SSQ[row] * (1.f / DM) + EPS);
#pragma unroll
                for (int bj = 0; bj < 2; ++bj) { const f32x4 v0 = acc[ai][bj][m][0] * rs, v1 = acc[ai][bj][m][1] * rs;
                    u32x4 w; w.x = cvt_pk_bf16(v0[0], v0[1]); w.y = cvt_pk_bf16(v0[2], v0[3]); w.z = cvt_pk_bf16(v1[0], v1[1]); w.w = cvt_pk_bf16(v1[2], v1[3]);
                    *(u32x4*)(rowp + bj * HALF) = w; } }
    }
};

struct EpiBranchFused {
    static constexpr bool PERM = true, AFTER_DRAIN = false, HAS_MID = true;
    bf16* O; int ldc; __amdgpu_buffer_rsrc_t grs; int ldg;
    __device__ __forceinline__ void mid(f32x4 (&acc)[2][2][4][2], const Unit& u, int t, int wr, int wc, int fr, int fq) const {
        const unsigned voff = (unsigned)(((u.pm * BM + wr * 64 + fr) * ldg + u.pn * BM + wc * 32 + 8 * fq) * 2);
        const int ca = (t == 16) ? 0 : 2048;
#pragma unroll
        for (int ai = 0; ai < 2; ++ai)
#pragma unroll
            for (int m = 0; m < 4; ++m) {
#pragma unroll
                for (int bj = 0; bj < 2; ++bj) { const int so = ((ai * HALF + m * 16) * ldg + bj * HALF) * 2 + ca;
                    const u32x4 ga = __builtin_amdgcn_raw_buffer_load_b128(grs, voff, so, 0), gb = __builtin_amdgcn_raw_buffer_load_b128(grs, voff, so + 2048, 0);
                    f32x4& v0 = acc[ai][bj][m][0]; f32x4& v1 = acc[ai][bj][m][1];
                    v0[0] *= bflo(ga.x) * __builtin_amdgcn_rcpf(fmaxf(bflo(gb.x), 1e-30f)); v0[1] *= bfhi(ga.x) * __builtin_amdgcn_rcpf(fmaxf(bfhi(gb.x), 1e-30f));
                    v0[2] *= bflo(ga.y) * __builtin_amdgcn_rcpf(fmaxf(bflo(gb.y), 1e-30f)); v0[3] *= bfhi(ga.y) * __builtin_amdgcn_rcpf(fmaxf(bfhi(gb.y), 1e-30f));
                    v1[0] *= bflo(ga.z) * __builtin_amdgcn_rcpf(fmaxf(bflo(gb.z), 1e-30f)); v1[1] *= bfhi(ga.z) * __builtin_amdgcn_rcpf(fmaxf(bfhi(gb.z), 1e-30f));
                    v1[2] *= bflo(ga.w) * __builtin_amdgcn_rcpf(fmaxf(bflo(gb.w), 1e-30f)); v1[3] *= bfhi(ga.w) * __builtin_amdgcn_rcpf(fmaxf(bfhi(gb.w), 1e-30f)); }
                __builtin_amdgcn_sched_barrier(0); }
    }
    __device__ __forceinline__ void operator()(const f32x4 (&acc)[2][2][4][2], const Unit& u, int wr, int wc, int fr, int fq) const {
        const int row0 = u.pm * BM + wr * 64 + fr; const int col0 = u.pn * BM + wc * 32 + 8 * fq;
        const unsigned voff = (unsigned)((row0 * ldg + col0) * 2);
#pragma unroll
        for (int ai = 0; ai < 2; ++ai)
#pragma unroll
            for (int m = 0; m < 4; ++m) { const size_t r = (size_t)(row0 + ai * HALF + m * 16); bf16* rowp = O + r * ldc + col0;
#pragma unroll
                for (int bj = 0; bj < 2; ++bj) { const f32x4 v0 = acc[ai][bj][m][0], v1 = acc[ai][bj][m][1];
                    const u32x4 g = __builtin_amdgcn_raw_buffer_load_b128(grs, voff, ((ai * HALF + m * 16) * ldg + bj * HALF) * 2 + 4096, 0);
                    u32x4 w; w.x = cvt_pk_bf16(v0[0] * bflo(g.x), v0[1] * bfhi(g.x)); w.y = cvt_pk_bf16(v0[2] * bflo(g.y), v0[3] * bfhi(g.y));
                    w.z = cvt_pk_bf16(v1[0] * bflo(g.z), v1[1] * bfhi(g.z)); w.w = cvt_pk_bf16(v1[2] * bflo(g.w), v1[3] * bfhi(g.w));
                    *(u32x4*)(rowp + bj * HALF) = w; } }
    }
};

template <class Epi, class Sched>
__device__ __forceinline__ void gemm_phase(LAS unsigned char* lds, const Gemm g, const Sched& S, const Epi& E, int wid) {
    int lane = lane_id(); asm volatile("" : "+v"(lane));
    const int tid = wid * 64 + lane, wr = wid >> 2, wc = wid & 3, fr = lane & 15, fq = lane >> 4;
    const int K = g.K, nt = K / BK;
    unsigned voffA[2], voffB[2];
#pragma unroll
    for (int i = 0; i < 2; ++i) { int R, C; stage_rc(tid * 16 + i * 8192, R, C); const int Rb = Epi::PERM ? ((R & ~31) + perm32(R & 31)) : R;
        voffA[i] = (unsigned)(R * g.lda + C) * 2u; voffB[i] = (unsigned)(Rb * g.ldb + C) * 2u; }
    const size_t kstep = (size_t)(BK * 2);
    const size_t hsA = (size_t)HALF * g.lda * 2, hsB = (size_t)HALF * g.ldb * 2;
    const size_t tsA = 2 * hsA, tsB = 2 * hsB;
    const unsigned ldsw = (unsigned)wid * 1024u;
    const int aoff = lds_byte(wr * 64 + fr, fq * 8), boff = lds_byte(wc * 32 + fr, fq * 8);
#define PG8_SA(b, h) (((b) * 2 + (h)) * HTB)
#define PG8_SB(b, h) ((4 + (b) * 2 + (h)) * HTB)
#define PG8_STAGE(bufoff, gbase, voff) do { _Pragma("unroll") for (int _i = 0; _i < 2; ++_i) \
        __builtin_amdgcn_global_load_lds((const unsigned*)((const char*)(gbase) + (voff)[_i]), (LAS unsigned*)(lds + (bufoff) + ldsw + _i * 8192), 16, 0, 0); } while (0)
#define PG8_LDA(dst, b, h) do { _Pragma("unroll") for (int m = 0; m < 4; ++m) _Pragma("unroll") for (int k = 0; k < 2; ++k) dst[m][k] = *(const LAS bf16x8*)(lds + PG8_SA(b, h) + aoff + m * 2048 + k * 1024); } while (0)
#define PG8_LDB(dst, b, h) do { _Pragma("unroll") for (int n = 0; n < 2; ++n) _Pragma("unroll") for (int k = 0; k < 2; ++k) dst[n][k] = *(const LAS bf16x8*)(lds + PG8_SB(b, h) + boff + n * 2048 + k * 1024); } while (0)
#define PG8_MMA(ai, bj, At, Bt) do { __builtin_amdgcn_s_setprio(1); _Pragma("unroll") for (int m = 0; m < 4; ++m) _Pragma("unroll") for (int n = 0; n < 2; ++n) _Pragma("unroll") for (int k = 0; k < 2; ++k) \
        acc[ai][bj][m][n] = __builtin_amdgcn_mfma_f32_16x16x32_bf16(Bt[n][k], At[m][k], acc[ai][bj][m][n], 0, 0, 0); __builtin_amdgcn_s_setprio(0); } while (0)
#define PG8_WAIT_V(n) asm volatile("s_waitcnt vmcnt(" #n ")" ::: "memory")
#define PG8_WAIT_L(n) asm volatile("s_waitcnt lgkmcnt(" #n ")" ::: "memory")
#define PG8_BAR __builtin_amdgcn_s_barrier()
#define PG8_SCHED __builtin_amdgcn_sched_barrier(0)
    Unit cur, nxt; int ui = 0;
    if (!S.next(0, cur)) return;
    f32x4 acc[2][2][4][2];
#pragma unroll
    for (int a = 0; a < 2; ++a)
#pragma unroll
        for (int b = 0; b < 2; ++b)
#pragma unroll
            for (int m = 0; m < 4; ++m)
#pragma unroll
                for (int n = 0; n < 2; ++n) acc[a][b][m][n] = (f32x4){0.f, 0.f, 0.f, 0.f};
    bf16x8 At[4][2], B0[2][2], B1[2][2];
    const char* cA = (const char*)g.A + (size_t)cur.pm * tsA; const char* cB = (const char*)g.Bt + (size_t)cur.pn * tsB;
    S.a_ready(cur);
    PG8_STAGE(PG8_SB(0, 0), cB, voffB); PG8_STAGE(PG8_SB(0, 1), cB + hsB, voffB); PG8_STAGE(PG8_SA(0, 0), cA, voffA); PG8_STAGE(PG8_SA(0, 1), cA + hsA, voffA);
    if (wr == 1) PG8_BAR;
    PG8_WAIT_V(2); PG8_BAR;
    PG8_STAGE(PG8_SB(1, 0), cB + kstep, voffB); PG8_STAGE(PG8_SA(1, 0), cA + kstep, voffA); PG8_STAGE(PG8_SB(1, 1), cB + hsB + kstep, voffB);
    PG8_WAIT_V(6); PG8_BAR;
    for (;;) {
        const bool has_next = S.next(ui + 1, nxt);
        const char* nA = has_next ? (const char*)g.A + (size_t)nxt.pm * tsA : cA; const char* nB = has_next ? (const char*)g.Bt + (size_t)nxt.pn * tsB : cB;
        for (int t = 0; t < nt; t += 2) {
            const bool last = (t == nt - 2);
            const char* a1 = cA + (size_t)(t + 1) * kstep;
            const char* a2 = last ? nA : cA + (size_t)(t + 2) * kstep; const char* b2 = last ? nB : cB + (size_t)(t + 2) * kstep;
            const char* a3 = a2 + kstep; const char* b3 = b2 + kstep;
            if (last && has_next) S.a_ready(nxt);
            if constexpr (Epi::HAS_MID) { if (t == 16 || t == 20) E.mid(acc, cur, t, wr, wc, fr, fq); }
            PG8_LDB(B0, 0, 0); PG8_LDB(B1, 0, 1); PG8_SCHED; PG8_LDA(At, 0, 0); PG8_STAGE(PG8_SA(1, 1), a1 + hsA, voffA);
            PG8_WAIT_V(8); PG8_WAIT_L(0); PG8_BAR; PG8_MMA(0, 0, At, B0); PG8_MMA(0, 1, At, B1); PG8_BAR; PG8_SCHED;
            PG8_LDA(At, 0, 1); PG8_STAGE(PG8_SB(0, 0), b2, voffB); PG8_STAGE(PG8_SB(0, 1), b2 + hsB, voffB); PG8_STAGE(PG8_SA(0, 0), a2, voffA);
            PG8_WAIT_V(8); PG8_WAIT_L(0); PG8_BAR; PG8_MMA(1, 0, At, B0); PG8_MMA(1, 1, At, B1); PG8_BAR; PG8_SCHED;
            PG8_LDB(B0, 1, 0); PG8_LDB(B1, 1, 1); PG8_SCHED; PG8_LDA(At, 1, 0); PG8_STAGE(PG8_SA(0, 1), a2 + hsA, voffA);
            PG8_WAIT_V(8); PG8_WAIT_L(0); PG8_BAR; PG8_MMA(0, 0, At, B0); PG8_MMA(0, 1, At, B1); PG8_BAR; PG8_SCHED;
            PG8_LDA(At, 1, 1); PG8_STAGE(PG8_SB(1, 0), b3, voffB); PG8_STAGE(PG8_SB(1, 1), b3 + hsB, voffB); PG8_STAGE(PG8_SA(1, 0), a3, voffA);
            PG8_WAIT_V(8); PG8_WAIT_L(0); PG8_BAR; PG8_MMA(1, 0, At, B0); PG8_MMA(1, 1, At, B1); PG8_BAR; PG8_SCHED;
        }
        if (wr == 0) PG8_BAR;
        E(acc, cur, wr, wc, fr, fq); S.done(cur);
        if (!has_next) break;
#pragma unroll
        for (int a = 0; a < 2; ++a)
#pragma unroll
            for (int b = 0; b < 2; ++b)
#pragma unroll
                for (int m = 0; m < 4; ++m)
#pragma unroll
                    for (int n = 0; n < 2; ++n) acc[a][b][m][n] = (f32x4){0.f, 0.f, 0.f, 0.f};
        cur = nxt; cA = nA; cB = nB; ++ui;
        if (wr == 1) PG8_BAR;
    }
    PG8_WAIT_V(0);
    PG8_BAR;
#undef PG8_SA
#undef PG8_SB
#undef PG8_STAGE
#undef PG8_LDA
#undef PG8_LDB
#undef PG8_MMA
#undef PG8_WAIT_V
#undef PG8_WAIT_L
#undef PG8_BAR
#undef PG8_SCHED
}
}

struct Args {
    const float* in[26]; const int* positions; float* out; unsigned char* ws; int ph_lo, ph_hi; int pad0, pad1;
};
struct Frame {
    LAS unsigned char* lds;
    int tid, lane, wave, G, bid;
    const float* const* in; const int* positions; float* out; unsigned char* ws;
};
__device__ __forceinline__ void frame_refresh(Frame& F) { int l = lane_id(); asm volatile("" : "+v"(l)); F.lane = l; F.tid = F.wave * 64 + l; }
enum { I_X = 0, I_MEM = 1, I_POS = 2, I_NMIXW = 3, I_WIN = 4, I_CONVW = 5, I_CONVB = 6, I_DTB = 7, I_ALOG = 8, I_SSDD = 9, I_SSDNW = 10, I_DQNW = 11, I_DKNW = 12, I_MEMNW = 13,
       I_WMKV = 14, I_MQNW = 15, I_MKNW = 16, I_WSSD = 17, I_WDIL = 18, I_WMEMBR = 19, I_WOUT = 20, I_NFFNW = 21, I_WQ = 22, I_SUBK = 23, I_PD = 24, I_PU = 25 };

__device__ __forceinline__ void p0_transpose_item(const float* W, int ldw, int src_col0, bf16* WT, int ldt, int dst_row0, int dst_col0, int nblk, LAS float* scr, int item, int lane) {
    const int kb = item / nblk, nb = item % nblk, k0 = 64 * kb, n0 = 32 * nb;
#pragma unroll 8
    for (int i = 0; i < 32; ++i) { const int kk = 2 * i + (lane >> 5); scr[kk * 33 + (lane & 31)] = W[(size_t)(k0 + kk) * ldw + src_col0 + n0 + (lane & 31)]; }
    LDS_WAIT(); asm volatile("" ::: "memory");
    const int c = lane & 7;
#pragma unroll
    for (int j = 0; j < 4; ++j) { const int n = (lane >> 3) + 8 * j; const LAS float* s = scr + (8 * c) * 33 + n;
        u32x4 o; o.x = pk2(s[0 * 33], s[1 * 33]); o.y = pk2(s[2 * 33], s[3 * 33]); o.z = pk2(s[4 * 33], s[5 * 33]); o.w = pk2(s[6 * 33], s[7 * 33]);
        *(u32x4*)(WT + (size_t)(dst_row0 + n0 + n) * ldt + dst_col0 + k0 + 8 * c) = o; }
    LDS_WAIT(); asm volatile("" ::: "memory");
}
__device__ __forceinline__ void rms_row_to_bf16(const float* xrow, const float* w, bf16* orow, int lane, f32x4 (&v)[4]) {
    const f32x4* xr = (const f32x4*)xrow + lane; const f32x4* wr = (const f32x4*)w + lane;
    float s = 0.f;
#pragma unroll
    for (int j = 0; j < 4; ++j) { v[j] = xr[64 * j]; s += (v[j].x * v[j].x + v[j].y * v[j].y) + (v[j].z * v[j].z + v[j].w * v[j].w); }
    const float rstd = 1.0f / sqrtf(wave_sum(s) * (1.f / DM) + EPS);
    unsigned long long* o8 = (unsigned long long*)orow + lane;
#pragma unroll
    for (int j = 0; j < 4; ++j) { const f32x4 ww = wr[64 * j]; v[j] = v[j] * rstd * ww;
        o8[64 * j] = (unsigned long long)pk2(v[j].x, v[j].y) | ((unsigned long long)pk2(v[j].z, v[j].w) << 32); }
}
__device__ __forceinline__ void rms_rows_finish(f32x4 (&v)[4], const float* w, bf16* orow, int lane) {
    const f32x4* wr = (const f32x4*)w + lane;
    float s = 0.f;
#pragma unroll
    for (int j = 0; j < 4; ++j) s += (v[j].x * v[j].x + v[j].y * v[j].y) + (v[j].z * v[j].z + v[j].w * v[j].w);
    const float rstd = 1.0f / sqrtf(wave_sum(s) * (1.f / DM) + EPS);
    unsigned long long* o8 = (unsigned long long*)orow + lane;
#pragma unroll
    for (int j = 0; j < 4; ++j) { const f32x4 ww = wr[64 * j]; v[j] = v[j] * rstd * ww;
        o8[64 * j] = (unsigned long long)pk2(v[j].x, v[j].y) | ((unsigned long long)pk2(v[j].z, v[j].w) << 32); }
}
__device__ __forceinline__ void cvt_f32_bf16_stream(const float* src, bf16* dst, size_t n, size_t gtid, size_t gthreads) {
    for (size_t i = gtid * 8; i < n; i += gthreads * 8) { const f32x4 a = *(const f32x4*)(src + i), b = *(const f32x4*)(src + i + 4);
        u32x4 o; o.x = pk2(a.x, a.y); o.y = pk2(a.z, a.w); o.z = pk2(b.x, b.y); o.w = pk2(b.z, b.w); *(u32x4*)(dst + i) = o; }
}
constexpr float PD_SCALE = 64.0f, PU_SCALE = 8.0f;
__device__ __forceinline__ unsigned pk4_fp8(f32x4 v, float sc) {
    const float a = fminf(fmaxf(v.x * sc, -448.f), 448.f), b = fminf(fmaxf(v.y * sc, -448.f), 448.f), c = fminf(fmaxf(v.z * sc, -448.f), 448.f), d = fminf(fmaxf(v.w * sc, -448.f), 448.f);
    unsigned p = __builtin_amdgcn_cvt_pk_fp8_f32(a, b, 0, false); return __builtin_amdgcn_cvt_pk_fp8_f32(c, d, p, true);
}
__device__ __forceinline__ void cvt_f32_fp8_sliced(const float* src, unsigned char* dst, float sc, size_t gtid, size_t gthreads) {
    for (size_t i = gtid * 16; i < (size_t)16384 * 1024; i += gthreads * 16) { const f32x4 a = *(const f32x4*)(src + i), b = *(const f32x4*)(src + i + 4), c = *(const f32x4*)(src + i + 8), d = *(const f32x4*)(src + i + 12);
        const size_t e = i >> 10, dd = i & 1023;
        const u32x4 o = {pk4_fp8(a, sc), pk4_fp8(b, sc), pk4_fp8(c, sc), pk4_fp8(d, sc)}; *(u32x4*)(dst + ((((dd >> 7) * 16384 + e) << 7) + (dd & 127))) = o; }
}
__device__ __forceinline__ void p0_prologue(Frame& F) {
    LAS float* scr = (LAS float*)(F.lds + F.wave * 8448);
    LAS float* wdt = (LAS float*)(F.lds + 8 * 8448);
    const int gw = F.bid * NWAVES + F.wave, NGW = F.G * NWAVES;
    unsigned char* ws = F.ws;
    for (int i = F.tid; i < 1024 * 16; i += NTHR) { const int k = i >> 4, c = i & 15, l = (k & 255) >> 2, e = k & 3, j = k >> 8, q = c >> 2;
        wdt[((((j * 4 + e) * 4 + q) * 64 + l) << 2) + (c & 3)] = F.in[I_WIN][(size_t)k * W_IN_N + OFF_DT + c]; }
    __syncthreads();
    constexpr int IT_A = 16 * 96, IT_B = 16 * 192, IT_MKV = 16 * 48, IT_SSD = 16 * 32, IT_DIL = 4 * 32, IT_MBR = 12 * 32, IT_OUT = 16 * 32, IT_WQ = 16 * 64;
    constexpr int NITEMS = IT_A + IT_B + IT_MKV + IT_SSD + IT_DIL + IT_MBR + IT_OUT + IT_WQ;
    bf16* WallT = (bf16*)(ws + WS_WALLT);
    for (int it = gw; it < NITEMS; it += NGW) {
        int r = it;
        if (r < IT_A) { p0_transpose_item(F.in[I_WIN], W_IN_N, 0, WallT, DM, 0, 0, 96, scr, r, F.lane); continue; } r -= IT_A;
        if (r < IT_B) { p0_transpose_item(F.in[I_WIN], W_IN_N, OFF_AFTER_DT, WallT, DM, 3072, 0, 192, scr, r, F.lane); continue; } r -= IT_B;
        if (r < IT_MKV) { p0_transpose_item(F.in[I_WMKV], 1536, 0, (bf16*)(ws + WS_WMKVT), DM, 0, 0, 48, scr, r, F.lane); continue; } r -= IT_MKV;
        if (r < IT_SSD) { p0_transpose_item(F.in[I_WSSD], DM, 0, (bf16*)(ws + WS_WCATT), YC, 0, 0, 32, scr, r, F.lane); continue; } r -= IT_SSD;
        if (r < IT_DIL) { p0_transpose_item(F.in[I_WDIL], DM, 0, (bf16*)(ws + WS_WCATT), YC, 0, 1024, 32, scr, r, F.lane); continue; } r -= IT_DIL;
        if (r < IT_MBR) { p0_transpose_item(F.in[I_WMEMBR], DM, 0, (bf16*)(ws + WS_WCATT), YC, 0, 1280, 32, scr, r, F.lane); continue; } r -= IT_MBR;
        if (r < IT_OUT) { p0_transpose_item(F.in[I_WOUT], DM, 0, (bf16*)(ws + WS_WOUTT), DM, 0, 0, 32, scr, r, F.lane); continue; } r -= IT_OUT;
        p0_transpose_item(F.in[I_WQ], PEER_Q, 0, (bf16*)(ws + WS_WQT), DM, 0, 0, 64, scr, r, F.lane);
    }
    const size_t gtid = (size_t)F.bid * NTHR + F.tid, gth = (size_t)F.G * NTHR;
    cvt_f32_bf16_stream(F.in[I_SUBK], (bf16*)(ws + WS_SUBK), (size_t)8 * 2 * 128 * 128, gtid, gth);
    cvt_f32_fp8_sliced(F.in[I_PD], ws + WS_PD, PD_SCALE, gtid, gth);
    cvt_f32_fp8_sliced(F.in[I_PU], ws + WS_PU, PU_SCALE, gtid, gth);
    for (int m = gw; m < NB * NMEM; m += NGW) { f32x4 v[4]; rms_row_to_bf16(F.in[I_MEM] + (size_t)m * DM, F.in[I_MEMNW], (bf16*)(ws + WS_MEMN) + (size_t)m * DM, F.lane, v); }
    for (size_t i = gtid; i < (size_t)T; i += gth) ((float*)(ws + WS_SSQ))[i] = 0.f;
    { float* RT = (float*)(ws + WS_ROPE);
      for (size_t i = gtid; i < (size_t)T * 8; i += gth) { const int tok = (int)(i >> 3), a = (int)(i & 7);
          const float inv = __expf(-logf(500000.0f) * (2.0f / 16.0f) * (float)a);
          const double rev = (double)((float)F.positions[tok] * inv) * 0.15915494309189535; const float fr = (float)(rev - floor(rev));
          RT[(size_t)tok * 16 + a] = __builtin_amdgcn_cosf(fr); RT[(size_t)tok * 16 + 8 + a] = __builtin_amdgcn_sinf(fr); } }
    float* DTp = (float*)(ws + WS_DT);
    const int lane = F.lane;
    const int myj = ((lane >> 5) & 1) * 8 + ((lane >> 4) & 1) * 4 + ((lane >> 3) & 1) * 2 + ((lane >> 2) & 1);
    const float dtb = F.in[I_DTB][myj];
    f32x4 na[4], nb[4];
    { const int m0 = 2 * gw < T ? 2 * gw : 0; const f32x4* xa = (const f32x4*)(F.in[I_X] + (size_t)m0 * DM) + lane; const f32x4* xb = (const f32x4*)(F.in[I_X] + (size_t)(m0 + 1) * DM) + lane;
#pragma unroll
      for (int j = 0; j < 4; ++j) { na[j] = xa[64 * j]; nb[j] = xb[64 * j]; } }
    for (int m = 2 * gw; m < T; m += 2 * NGW) {
        f32x4 va[4], vb[4];
#pragma unroll
        for (int j = 0; j < 4; ++j) { va[j] = na[j]; vb[j] = nb[j]; }
        { const int mn = (m + 2 * NGW < T) ? m + 2 * NGW : m; const f32x4* xa = (const f32x4*)(F.in[I_X] + (size_t)mn * DM) + lane; const f32x4* xb = (const f32x4*)(F.in[I_X] + (size_t)(mn + 1) * DM) + lane;
#pragma unroll
          for (int j = 0; j < 4; ++j) { na[j] = xa[64 * j]; nb[j] = xb[64 * j]; } }
        rms_rows_finish(va, F.in[I_NMIXW], (bf16*)(ws + WS_ACT1) + (size_t)m * DM, lane);
        rms_rows_finish(vb, F.in[I_NMIXW], (bf16*)(ws + WS_ACT1) + (size_t)(m + 1) * DM, lane);
        float da[16], db[16];
#pragma unroll
        for (int j = 0; j < 16; ++j) { da[j] = 0.f; db[j] = 0.f; }
#pragma unroll
        for (int j = 0; j < 4; ++j)
#pragma unroll
            for (int e = 0; e < 4; ++e) { const float ua = va[j][e], ub = vb[j][e];
#pragma unroll
                for (int q = 0; q < 4; ++q) { const f32x4 w4 = *(const LAS f32x4*)(wdt + ((((j * 4 + e) * 4 + q) * 64 + lane) << 2));
                    da[4 * q + 0] += ua * w4.x; da[4 * q + 1] += ua * w4.y; da[4 * q + 2] += ua * w4.z; da[4 * q + 3] += ua * w4.w;
                    db[4 * q + 0] += ub * w4.x; db[4 * q + 1] += ub * w4.y; db[4 * q + 2] += ub * w4.z; db[4 * q + 3] += ub * w4.w; }
                __builtin_amdgcn_sched_barrier(0); }
        float ra, rb;
        { float r8a[8], r8b[8], r4a[4], r4b[4], r2a[2], r2b[2];
          { const bool up = (lane & 32) != 0;
#pragma unroll
            for (int k = 0; k < 8; ++k) { r8a[k] = (up ? da[k + 8] : da[k]) + __shfl_xor(up ? da[k] : da[k + 8], 32); r8b[k] = (up ? db[k + 8] : db[k]) + __shfl_xor(up ? db[k] : db[k + 8], 32); } }
          { const bool up = (lane & 16) != 0;
#pragma unroll
            for (int k = 0; k < 4; ++k) { r4a[k] = (up ? r8a[k + 4] : r8a[k]) + __shfl_xor(up ? r8a[k] : r8a[k + 4], 16); r4b[k] = (up ? r8b[k + 4] : r8b[k]) + __shfl_xor(up ? r8b[k] : r8b[k + 4], 16); } }
          { const bool up = (lane & 8) != 0;
#pragma unroll
            for (int k = 0; k < 2; ++k) { r2a[k] = (up ? r4a[k + 2] : r4a[k]) + __shfl_xor(up ? r4a[k] : r4a[k + 2], 8); r2b[k] = (up ? r4b[k + 2] : r4b[k]) + __shfl_xor(up ? r4b[k] : r4b[k + 2], 8); } }
          { const bool up = (lane & 4) != 0; ra = (up ? r2a[1] : r2a[0]) + __shfl_xor(up ? r2a[0] : r2a[1], 4); rb = (up ? r2b[1] : r2b[0]) + __shfl_xor(up ? r2b[0] : r2b[1], 4); }
          ra += __shfl_xor(ra, 2); ra += __shfl_xor(ra, 1); rb += __shfl_xor(rb, 2); rb += __shfl_xor(rb, 1); }
        if ((lane & 3) == 0) { const float xa = ra + dtb, xb = rb + dtb;
            DTp[(size_t)m * 16 + myj] = (xa > 20.f) ? xa : log1pf(__expf(xa)); DTp[(size_t)(m + 1) * 16 + myj] = (xb > 20.f) ? xb : log1pf(__expf(xb)); }
    }
}

__device__ __forceinline__ void norm192_inplace(bf16* p, const float (&w)[4], int lane) {
    u32x2 v = {0u, 0u};
    if (lane < 48) v = *(const u32x2*)(p + 4 * lane);
    float x0 = bflo(v.x), x1 = bfhi(v.x), x2 = bflo(v.y), x3 = bfhi(v.y);
    const float ss = wave_sum((x0 * x0 + x1 * x1) + (x2 * x2 + x3 * x3));
    const float rs = 1.0f / sqrtf(ss * (1.f / 192.f) + EPS);
    if (lane < 48) { const u32x2 o = {pkbf(x0 * rs * w[0], x1 * rs * w[1]), pkbf(x2 * rs * w[2], x3 * rs * w[3])}; *(u32x2*)(p + 4 * lane) = o; }
}
__device__ __forceinline__ void mknorm_phase(Frame& F) {
    const int gw = F.bid * NWAVES + F.wave, NGW = F.G * NWAVES, lane = F.lane;
    float wmk[4];
#pragma unroll
    for (int j = 0; j < 4; ++j) wmk[j] = F.in[I_MKNW][(4 * lane + j) % 192];
    bf16* MK = (bf16*)(F.ws + WS_MKV);
    for (int r = gw; r < NB * NMEM * 4; r += NGW) norm192_inplace(MK + (size_t)(r >> 2) * 1536 + (r & 3) * 192, wmk, lane);
}

constexpr int SC_ST = 272, SX_ST = 528;
__device__ __forceinline__ float bfsel(const u32x4& v, int j) { const unsigned w = v[j >> 1]; return (j & 1) ? bfhi(w) : bflo(w); }
__device__ __forceinline__ void conv_task(const bf16* P, size_t rowb, int t0, int pcol, const float* cw, const float* cb, int ccol, LAS unsigned char* dst, int stride, const LAS float* scale) {
    float w[4][8], bs[8];
#pragma unroll
    for (int k = 0; k < 4; ++k) { const f32x4 a = *(const f32x4*)(cw + k * 2048 + ccol), b = *(const f32x4*)(cw + k * 2048 + ccol + 4);
        w[k][0] = a.x; w[k][1] = a.y; w[k][2] = a.z; w[k][3] = a.w; w[k][4] = b.x; w[k][5] = b.y; w[k][6] = b.z; w[k][7] = b.w; }
    { const f32x4 a = *(const f32x4*)(cb + ccol), b = *(const f32x4*)(cb + ccol + 4); bs[0] = a.x; bs[1] = a.y; bs[2] = a.z; bs[3] = a.w; bs[4] = b.x; bs[5] = b.y; bs[6] = b.z; bs[7] = b.w; }
    const bf16* src = P + (rowb + t0) * NPROJ + pcol;
    u32x4 rw[19];
#pragma unroll
    for (int i = 0; i < 3; ++i) rw[i] = (u32x4){0u, 0u, 0u, 0u};
    if (t0 > 0) {
#pragma unroll
        for (int i = 0; i < 3; ++i) rw[i] = *(const u32x4*)(src + (ptrdiff_t)(i - 3) * NPROJ); }
#pragma unroll
    for (int i = 0; i < 16; ++i) rw[3 + i] = *(const u32x4*)(src + (size_t)i * NPROJ);
#pragma unroll
    for (int i = 0; i < 16; ++i) {
        float o[8];
#pragma unroll
        for (int j = 0; j < 8; ++j) { float a = bs[j] + w[0][j] * bfsel(rw[i], j) + w[1][j] * bfsel(rw[i + 1], j) + w[2][j] * bfsel(rw[i + 2], j) + w[3][j] * bfsel(rw[i + 3], j); o[j] = a * sigmoidf_(a); }
        if (scale) { const float sv = scale[i];
#pragma unroll
            for (int j = 0; j < 8; ++j) o[j] *= sv; }
        const u32x4 r = {pkbf(o[0], o[1]), pkbf(o[2], o[3]), pkbf(o[4], o[5]), pkbf(o[6], o[7])};
        *(LAS u32x4*)(dst + i * stride) = r;
    }
}
__device__ __forceinline__ float ssd_scan(Frame& F, const float* DTp, size_t tok0, int g, LAS float* sAc, LAS float* sDt) {
    float total = 0.f;
    if (F.wave < 4) {
        const int head = 4 * g + F.wave, lane = F.lane;
        const float A = -__expf(F.in[I_ALOG][head]);
        const float d0 = DTp[(tok0 + 2 * lane) * 16 + head], d1 = DTp[(tok0 + 2 * lane + 1) * 16 + head];
        const float a0 = d0 * A, a1 = d1 * A;
        float sc = a0 + a1;
#pragma unroll
        for (int o = 1; o < 64; o <<= 1) { const float v = __shfl_up(sc, o); if (lane >= o) sc += v; }
        sAc[F.wave * 128 + 2 * lane] = sc - a1; sAc[F.wave * 128 + 2 * lane + 1] = sc;
        sDt[F.wave * 128 + 2 * lane] = d0; sDt[F.wave * 128 + 2 * lane + 1] = d1;
        total = __shfl(sc, 63);
    }
    return total;
}
__device__ __forceinline__ bf16x8 tr_pair(unsigned a_lo, unsigned a_hi) {
    s16x4 lo, hi;
    asm volatile("ds_read_b64_tr_b16 %0, %2\n\tds_read_b64_tr_b16 %1, %3\n\ts_waitcnt lgkmcnt(0)" : "=&v"(lo), "=&v"(hi) : "v"(a_lo), "v"(a_hi) : "memory");
    const bf16x8 r = {lo[0], lo[1], lo[2], lo[3], hi[0], hi[1], hi[2], hi[3]}; return r;
}

__device__ __forceinline__ void ssdC_phase(Frame& F, int half) {
    const bf16* P = (const bf16*)(F.ws + WS_BIG);
    const float* DTp = (const float*)(F.ws + WS_DT);
    bf16* SST = (bf16*)(F.ws + WS_SST); float* DEC = (float*)(F.ws + WS_DEC);
    LAS unsigned char* sX = F.lds; LAS unsigned char* sB = F.lds + 128 * SX_ST;
    LAS float* sAc = (LAS float*)(F.lds + 128 * SX_ST + 128 * SC_ST); LAS float* sDt = sAc + 512; LAS float* sW = sDt + 512;
    const int wave = F.wave;
    for (int unit = F.bid; unit < HB * 64 * 4; unit += F.G) {
        int tid = F.tid; asm volatile("" : "+v"(tid));
        const int lane = tid & 63, ql = lane & 31, h = lane >> 5, tq = (lane & 15) >> 2, tp = lane & 3, tblk = (lane >> 4) & 1;
        const int bl = unit >> 8, c = (unit >> 2) & 63, g = unit & 3;
        const size_t rowb = (size_t)bl * SEQ, tok0 = (size_t)half * HT + rowb + c * 128;
        __syncthreads();
        const float total = ssd_scan(F, DTp, tok0, g, sAc, sDt);
        if (wave < 4) { sW[wave * 128 + 2 * lane] = __expf(total - sAc[wave * 128 + 2 * lane]) * sDt[wave * 128 + 2 * lane];
            sW[wave * 128 + 2 * lane + 1] = __expf(total - sAc[wave * 128 + 2 * lane + 1]) * sDt[wave * 128 + 2 * lane + 1];
            if (lane == 0) DEC[((size_t)bl * 64 + c) * 16 + 4 * g + wave] = __expf(total); }
        __syncthreads();
        if (tid < 384) {
            int ch, strip, ccol, stride; LAS unsigned char* dst; const LAS float* scl = nullptr;
            if (tid < 256) { ch = tid & 31; strip = tid >> 5; ccol = g * 256 + 8 * ch; stride = SX_ST; dst = sX + (strip * 16) * SX_ST + ch * 16; scl = sW + (ch >> 3) * 128 + strip * 16; }
            else { const int u = tid - 256; ch = u & 15; strip = u >> 4; ccol = 1024 + g * 128 + 8 * ch; stride = SC_ST; dst = sB + (strip * 16) * SC_ST + ch * 16; }
            conv_task(P, rowb, c * 128 + strip * 16, PC_X + ccol, F.in[I_CONVW], F.in[I_CONVB], ccol, dst, stride, scl);
        }
        __syncthreads();
        const int r = wave >> 1, pt = wave & 1;
        f32x16 acc[4];
#pragma unroll
        for (int nt = 0; nt < 4; ++nt)
#pragma unroll
            for (int e = 0; e < 16; ++e) acc[nt][e] = 0.f;
        const unsigned xa = (unsigned)(size_t)sX + (unsigned)((8 * h + tq) * SX_ST + (r * 64 + 32 * pt + 16 * tblk + 4 * tp) * 2);
        const unsigned ba = (unsigned)(size_t)sB + (unsigned)((8 * h + tq) * SC_ST + (16 * tblk + 4 * tp) * 2);
#pragma unroll
        for (int ks = 0; ks < 8; ++ks) {
            const bf16x8 af = tr_pair(xa + ks * 16 * SX_ST, xa + ks * 16 * SX_ST + 4 * SX_ST);
            bf16x8 bfr[4];
#pragma unroll
            for (int nt = 0; nt < 4; ++nt) bfr[nt] = tr_pair(ba + ks * 16 * SC_ST + nt * 64, ba + ks * 16 * SC_ST + 4 * SC_ST + nt * 64);
            __builtin_amdgcn_sched_barrier(0);
#pragma unroll
            for (int nt = 0; nt < 4; ++nt) acc[nt] = MFMA32(af, bfr[nt], acc[nt]);
        }
        bf16* out = SST + (((size_t)bl * 64 + c) * 16 + 4 * g + r) * 8192;
#pragma unroll
        for (int nt = 0; nt < 4; ++nt)
#pragma unroll
            for (int e = 0; e < 16; ++e) out[(32 * pt + (e & 3) + 8 * (e >> 2) + 4 * h) * 128 + 32 * nt + ql] = (bf16)(pkbf(acc[nt][e], 0.f) & 0xffffu);
    }
}

__device__ __forceinline__ void ssdD_phase(Frame& F) {
    const bf16* SST = (const bf16*)(F.ws + WS_SST); const float* DEC = (const float*)(F.ws + WS_DEC);
    bf16* SIN = (bf16*)(F.ws + WS_SIN);
    const size_t gtid = (size_t)F.bid * NTHR + F.tid, gth = (size_t)F.G * NTHR;
    for (size_t it = gtid; it < (size_t)HB * 16 * 2048; it += gth) {
        const int bl = (int)(it >> 15), head = (int)(it >> 11) & 15, e4 = (int)(it & 2047) * 4;
        f32x4 st = {0.f, 0.f, 0.f, 0.f};
#pragma unroll 8
        for (int c = 0; c < 64; ++c) {
            const size_t idx = (((size_t)bl * 64 + c) * 16 + head);
            const u32x2 o = {pkbf(st.x, st.y), pkbf(st.z, st.w)};
            *(u32x2*)(SIN + idx * 8192 + e4) = o;
            const u32x2 sw = *(const u32x2*)(SST + idx * 8192 + e4); const f32x4 sl = {bflo(sw.x), bfhi(sw.x), bflo(sw.y), bfhi(sw.y)}; const float d = DEC[idx];
            st = st * d + sl;
        }
    }
}

__device__ __forceinline__ void ssdE_phase(Frame& F, int half) {
    const bf16* P = (const bf16*)(F.ws + WS_BIG);
    const float* DTp = (const float*)(F.ws + WS_DT);
    const bf16* SIN = (const bf16*)(F.ws + WS_SIN);
    bf16* Y = (bf16*)F.out;
    LAS unsigned char* sX = F.lds; LAS unsigned char* sB = F.lds + 128 * SX_ST; LAS unsigned char* sC = sB + 128 * SC_ST;
    LAS float* sAc = (LAS float*)(sC + 128 * SC_ST); LAS float* sDt = sAc + 512; LAS float* sSS = sDt + 512;
    const int wave = F.wave;
    const int st = wave & 3, hp = wave >> 2;
    for (int unit = F.bid; unit < HB * 64 * 4; unit += F.G) {
        int tid = F.tid; asm volatile("" : "+v"(tid));
        const int lane = tid & 63, ql = lane & 31, h = lane >> 5, tq = (lane & 15) >> 2, tp = lane & 3, tblk = (lane >> 4) & 1;
        const int bl = unit >> 8, c = (unit >> 2) & 63, g = unit & 3;
        const size_t rowb = (size_t)bl * SEQ, tok0 = (size_t)half * HT + rowb + c * 128;
        __syncthreads();
        (void)ssd_scan(F, DTp, tok0, g, sAc, sDt);
        if (tid < 128) sSS[tid] = 0.f;
        {
            int ch, strip, ccol, stride; LAS unsigned char* dst;
            if (tid < 256) { ch = tid & 31; strip = tid >> 5; ccol = g * 256 + 8 * ch; stride = SX_ST; dst = sX + (strip * 16) * SX_ST + ch * 16; }
            else if (tid < 384) { const int u = tid - 256; ch = u & 15; strip = u >> 4; ccol = 1024 + g * 128 + 8 * ch; stride = SC_ST; dst = sB + (strip * 16) * SC_ST + ch * 16; }
            else { const int u = tid - 384; ch = u & 15; strip = u >> 4; ccol = 1536 + g * 128 + 8 * ch; stride = SC_ST; dst = sC + (strip * 16) * SC_ST + ch * 16; }
            conv_task(P, rowb, c * 128 + strip * 16, PC_X + ccol, F.in[I_CONVW], F.in[I_CONVB], ccol, dst, stride, nullptr);
        }
        __syncthreads();
        const int s = 32 * st + ql;
        unsigned yk[2][2][8];
        float ssq = 0.f;
        const unsigned xa = (unsigned)(size_t)sX + (unsigned)((4 * h + tq) * SX_ST + (16 * tblk + 4 * tp) * 2);
#pragma unroll
        for (int hq = 0; hq < 2; ++hq) {
            const int r = 2 * hp + hq, head = 4 * g + r;
            const float acs = sAc[r * 128 + s];
            const bf16* stp = SIN + (((size_t)bl * 64 + c) * 16 + head) * 8192 + ql * 128 + 8 * h;
            bf16x8 sfr[2][8];
#pragma unroll
            for (int pt = 0; pt < 2; ++pt)
#pragma unroll
                for (int ks = 0; ks < 8; ++ks) sfr[pt][ks] = *(const bf16x8*)(stp + pt * 4096 + 16 * ks);
            bf16x8 pf[4][2];
#pragma unroll
            for (int i = 0; i < 4; ++i) {
                f32x16 Xi;
#pragma unroll
                for (int e = 0; e < 16; ++e) Xi[e] = 0.f;
#pragma unroll
                for (int ks = 0; ks < 8; ++ks) { const bf16x8 bf_ = *(const LAS bf16x8*)(sB + (32 * i + ql) * SC_ST + 32 * ks + 16 * h);
                    const bf16x8 cf = *(const LAS bf16x8*)(sC + s * SC_ST + 32 * ks + 16 * h); Xi = MFMA32(bf_, cf, Xi); }
                float p[16];
#pragma unroll
                for (int q4 = 0; q4 < 4; ++q4) { const int t0 = 32 * i + 8 * q4 + 4 * h;
                    const f32x4 at = *(const LAS f32x4*)(sAc + r * 128 + t0), dt4 = *(const LAS f32x4*)(sDt + r * 128 + t0);
#pragma unroll
                    for (int e = 0; e < 4; ++e) { const int t = t0 + e; p[4 * q4 + e] = (t <= s) ? Xi[4 * q4 + e] * __expf(acs - at[e]) * dt4[e] : 0.f; } }
#pragma unroll
                for (int s2 = 0; s2 < 2; ++s2) { const u32x4 w = {pkbf(p[8 * s2 + 0], p[8 * s2 + 1]), pkbf(p[8 * s2 + 2], p[8 * s2 + 3]), pkbf(p[8 * s2 + 4], p[8 * s2 + 5]), pkbf(p[8 * s2 + 6], p[8 * s2 + 7])};
                    pf[i][s2] = __builtin_bit_cast(bf16x8, w); }
            }
            const float eacs = __expf(acs), Dh = F.in[I_SSDD][head];
#pragma unroll
            for (int pt = 0; pt < 2; ++pt) {
                f32x16 yd, yo;
#pragma unroll
                for (int e = 0; e < 16; ++e) { yd[e] = 0.f; yo[e] = 0.f; }
#pragma unroll
                for (int i = 0; i < 4; ++i) {
#pragma unroll
                    for (int s2 = 0; s2 < 2; ++s2) { const unsigned a = xa + (unsigned)((32 * i + 16 * s2) * SX_ST + (r * 64 + 32 * pt) * 2);
                        const bf16x8 xf = tr_pair(a, a + 8 * SX_ST); __builtin_amdgcn_sched_barrier(0); yd = MFMA32(xf, pf[i][s2], yd); }
                }
#pragma unroll
                for (int ks = 0; ks < 8; ++ks) { const bf16x8 cf = *(const LAS bf16x8*)(sC + s * SC_ST + 32 * ks + 16 * h); yo = MFMA32(sfr[pt][ks], cf, yo); }
                const bf16* zp = P + (rowb + c * 128 + s) * NPROJ + PC_Z + g * 256 + r * 64 + 32 * pt + 4 * h;
                u32x2 zv[4];
#pragma unroll
                for (int q4 = 0; q4 < 4; ++q4) zv[q4] = *(const u32x2*)(zp + 8 * q4);
#pragma unroll
                for (int q4 = 0; q4 < 4; ++q4) {
                    const u32x2 xv = *(const LAS u32x2*)(sX + s * SX_ST + (r * 64 + 32 * pt + 8 * q4 + 4 * h) * 2);
                    const u32x2 zq = zv[q4];
                    const float xs_[4] = {bflo(xv.x), bfhi(xv.x), bflo(xv.y), bfhi(xv.y)}, zs_[4] = {bflo(zq.x), bfhi(zq.x), bflo(zq.y), bfhi(zq.y)};
                    float yv[4];
#pragma unroll
                    for (int e = 0; e < 4; ++e) { float y = yd[4 * q4 + e] + eacs * yo[4 * q4 + e] + Dh * xs_[e]; y = y * zs_[e] * sigmoidf_(zs_[e]); yv[e] = y; ssq += y * y; }
                    yk[hq][pt][2 * q4] = pkbf(yv[0], yv[1]); yk[hq][pt][2 * q4 + 1] = pkbf(yv[2], yv[3]);
                }
            }
        }
        ssq += __shfl_xor(ssq, 32);
        if (h == 0) __hip_atomic_fetch_add(sSS + s, ssq, __ATOMIC_RELAXED, __HIP_MEMORY_SCOPE_WORKGROUP);
        __syncthreads();
        const float rs = 1.0f / sqrtf(sSS[s] * (1.f / 256.f) + EPS);
        bf16* yp = Y + (tok0 + s) * YC + g * 256 + 4 * h;
        const float* nw = F.in[I_SSDNW] + g * 256 + 4 * h;
#pragma unroll
        for (int hq = 0; hq < 2; ++hq)
#pragma unroll
            for (int pt = 0; pt < 2; ++pt)
#pragma unroll
                for (int q4 = 0; q4 < 4; ++q4) { const int cc = (2 * hp + hq) * 64 + 32 * pt + 8 * q4; const f32x4 w4 = *(const f32x4*)(nw + cc);
                    const unsigned ya = yk[hq][pt][2 * q4], yb = yk[hq][pt][2 * q4 + 1];
                    const u32x2 o = {pkbf(bflo(ya) * rs * w4.x, bfhi(ya) * rs * w4.y), pkbf(bflo(yb) * rs * w4.z, bfhi(yb) * rs * w4.w)};
                    *(u32x2*)(yp + cc) = o; }
    }
}

__device__ __forceinline__ bf16x8 mk_bf16x8(u32x2 lo, u32x2 hi) { const u32x4 v = {lo.x, lo.y, hi.x, hi.y}; return __builtin_bit_cast(bf16x8, v); }

__device__ __forceinline__ void memattn_mfma_phase(Frame& F, int half) {
    const bf16* P = (const bf16*)(F.ws + WS_BIG);
    const bf16* MKV = (const bf16*)(F.ws + WS_MKV);
    const bf16* MVT = (const bf16*)(F.ws + WS_MVT);
    bf16* Y = (bf16*)F.out;
    LAS unsigned char* sm = F.lds;
    const int tid = F.tid, lane = F.lane, wave = F.wave, ql = lane & 31, h = lane >> 5;
    constexpr int KST = 400, VST = 528;
    for (int unit = F.bid; unit < HB * 4 * 32; unit += F.G) {
        const int bl = unit >> 7, head = (unit >> 5) & 3, qt = unit & 31, b = half * HB + bl;
        const int r = bl * SEQ + qt * 256 + wave * 32 + ql;
        __syncthreads();
        for (int c = tid; c < 256 * 24; c += NTHR) { const int row = c / 24, ch = c % 24;
            *(LAS u32x4*)(sm + row * KST + ch * 16) = *(const u32x4*)(MKV + (size_t)(b * NMEM + row) * 1536 + head * 192 + ch * 8); }
        bf16x8 qf[12];
        { const bf16* qp = P + (size_t)r * NPROJ + PC_MQ + head * 192 + 8 * h;
          u32x4 qr[12]; float ss = 0.f;
#pragma unroll
          for (int ks = 0; ks < 12; ++ks) { qr[ks] = *(const u32x4*)(qp + 16 * ks);
              ss += (bflo(qr[ks].x) * bflo(qr[ks].x) + bfhi(qr[ks].x) * bfhi(qr[ks].x)) + (bflo(qr[ks].y) * bflo(qr[ks].y) + bfhi(qr[ks].y) * bfhi(qr[ks].y))
                  + (bflo(qr[ks].z) * bflo(qr[ks].z) + bfhi(qr[ks].z) * bfhi(qr[ks].z)) + (bflo(qr[ks].w) * bflo(qr[ks].w) + bfhi(qr[ks].w) * bfhi(qr[ks].w)); }
          ss += __shfl_xor(ss, 32);
          const float rs = 1.0f / sqrtf(ss * (1.f / 192.f) + EPS);
#pragma unroll
          for (int ks = 0; ks < 12; ++ks) { const f32x4 wa = *(const f32x4*)(F.in[I_MQNW] + 16 * ks + 8 * h), wb = *(const f32x4*)(F.in[I_MQNW] + 16 * ks + 8 * h + 4);
              const u32x4 w = {pkbf(bflo(qr[ks].x) * rs * wa.x, bfhi(qr[ks].x) * rs * wa.y), pkbf(bflo(qr[ks].y) * rs * wa.z, bfhi(qr[ks].y) * rs * wa.w),
                               pkbf(bflo(qr[ks].z) * rs * wb.x, bfhi(qr[ks].z) * rs * wb.y), pkbf(bflo(qr[ks].w) * rs * wb.z, bfhi(qr[ks].w) * rs * wb.w)};
              qf[ks] = __builtin_bit_cast(bf16x8, w); } }
        __syncthreads();
        f32x16 sacc[8];
#pragma unroll
        for (int mt = 0; mt < 8; ++mt) {
#pragma unroll
            for (int i = 0; i < 16; ++i) sacc[mt][i] = 0.f;
#pragma unroll
            for (int ks = 0; ks < 12; ++ks) { const bf16x8 kf = *(const LAS bf16x8*)(sm + (32 * mt + ql) * KST + 32 * ks + 16 * h); sacc[mt] = MFMA32(kf, qf[ks], sacc[mt]); }
        }
        float mx = -3.0e38f;
#pragma unroll
        for (int mt = 0; mt < 8; ++mt)
#pragma unroll
            for (int i = 0; i < 16; ++i) mx = fmaxf(mx, sacc[mt][i]);
        mx = fmaxf(mx, __shfl_xor(mx, 32));
        const float sc = 0.07216878364870323f * 1.4426950408889634f;
        float l = 0.f;
        bf16x8 pf[8][2];
#pragma unroll
        for (int mt = 0; mt < 8; ++mt) {
            float p[16];
#pragma unroll
            for (int i = 0; i < 16; ++i) { p[i] = __builtin_amdgcn_exp2f((sacc[mt][i] - mx) * sc); l += p[i]; }
#pragma unroll
            for (int s2 = 0; s2 < 2; ++s2) { const u32x4 w = {pkbf(p[8 * s2 + 0], p[8 * s2 + 1]), pkbf(p[8 * s2 + 2], p[8 * s2 + 3]), pkbf(p[8 * s2 + 4], p[8 * s2 + 5]), pkbf(p[8 * s2 + 6], p[8 * s2 + 7])};
                pf[mt][s2] = __builtin_bit_cast(bf16x8, w); }
        }
        l += __shfl_xor(l, 32);
        __syncthreads();
        for (int c = tid; c < 192 * 32; c += NTHR) { const int row = c >> 5, ch = c & 31;
            *(LAS u32x4*)(sm + row * VST + ch * 16) = *(const u32x4*)(MVT + (size_t)(head * 192 + row) * 2048 + b * NMEM + ch * 8); }
        __syncthreads();
        const float il = 1.0f / l;
        bf16* yp = Y + ((size_t)half * HT + r) * YC + 1280 + head * 192 + 4 * h;
#pragma unroll
        for (int dt = 0; dt < 6; ++dt) {
            f32x16 o;
#pragma unroll
            for (int i = 0; i < 16; ++i) o[i] = 0.f;
#pragma unroll
            for (int mt = 0; mt < 8; ++mt)
#pragma unroll
                for (int s2 = 0; s2 < 2; ++s2) { const LAS unsigned char* vp = sm + (32 * dt + ql) * VST + (32 * mt + 16 * s2 + 4 * h) * 2;
                    const bf16x8 vf = mk_bf16x8(*(const LAS u32x2*)vp, *(const LAS u32x2*)(vp + 16)); o = MFMA32(vf, pf[mt][s2], o); }
#pragma unroll
            for (int g = 0; g < 4; ++g) { const u32x2 w = {pkbf(o[4 * g] * il, o[4 * g + 1] * il), pkbf(o[4 * g + 2] * il, o[4 * g + 3] * il)}; *(u32x2*)(yp + 32 * dt + 8 * g) = w; }
        }
    }
}

__device__ __forceinline__ void dilattn_mfma_phase(Frame& F, int half) {
    bf16* P = (bf16*)(F.ws + WS_BIG);
    float* LSE = (float*)(F.ws + WS_LSE);
    LAS unsigned char* sK = F.lds; LAS unsigned char* sV = F.lds + 384 * 144;
    const int tid = F.tid, lane = F.lane, wave = F.wave, ql = lane & 31, h = lane >> 5;
    constexpr int RST = 144;
    const float* RT = (const float*)(F.ws + WS_ROPE);
    float wk8[8];
#pragma unroll
    for (int j = 0; j < 8; ++j) wk8[j] = F.in[I_DKNW][8 * (tid & 7) + j];
    for (int unit = F.bid; unit < HB * 12 * 32; unit += F.G) {
        const int bl = unit / 384, rem = unit % 384, head = rem >> 5, blk = rem & 31;
        const int g = head >> 2, dil = (g == 0) ? 1 : (g == 1 ? 4 : 16), bpr = 32 / dil;
        const int res = blk / bpr, q0 = (blk % bpr) * 256;
        const size_t rowb = (size_t)bl * SEQ;
        __syncthreads();
        for (int c = tid; c < 384 * 8; c += NTHR) { const int row = c >> 3, ch = c & 7; const int ks = q0 - 128 + row;
            u32x4 kv = {0u, 0u, 0u, 0u}, vv = {0u, 0u, 0u, 0u}; f32x4 c0 = {1.f, 1.f, 1.f, 1.f}, c1 = c0, s0 = {0.f, 0.f, 0.f, 0.f}, s1 = s0;
            if (ks >= 0) { const size_t rr = rowb + (size_t)ks * dil + res; const bf16* src = P + rr * NPROJ + head * 64 + ch * 8; kv = *(const u32x4*)(src + PC_DK); vv = *(const u32x4*)(src + PC_DV);
                if (ch < 2) { const f32x4* rt = (const f32x4*)(RT + ((size_t)half * HT + rr) * 16); c0 = rt[0]; c1 = rt[1]; s0 = rt[2]; s1 = rt[3]; } }
            float x[8] = {bflo(kv.x), bfhi(kv.x), bflo(kv.y), bfhi(kv.y), bflo(kv.z), bfhi(kv.z), bflo(kv.w), bfhi(kv.w)};
            float ss = 0.f;
#pragma unroll
            for (int j = 0; j < 8; ++j) ss += x[j] * x[j];
            ss += __shfl_xor(ss, 1); ss += __shfl_xor(ss, 2); ss += __shfl_xor(ss, 4);
            const float rs = 1.0f / sqrtf(ss * (1.f / 64.f) + EPS);
            const float cs[8] = {c0.x, c0.y, c0.z, c0.w, c1.x, c1.y, c1.z, c1.w}, sn[8] = {s0.x, s0.y, s0.z, s0.w, s1.x, s1.y, s1.z, s1.w};
#pragma unroll
            for (int j = 0; j < 8; ++j) { x[j] = x[j] * rs * wk8[j]; const float o = __shfl_xor(x[j], 1); if (ch == 0) x[j] = x[j] * cs[j] - o * sn[j]; else if (ch == 1) x[j] = x[j] * cs[j] + o * sn[j]; }
            kv = (u32x4){pkbf(x[0], x[1]), pkbf(x[2], x[3]), pkbf(x[4], x[5]), pkbf(x[6], x[7])};
            *(LAS u32x4*)(sK + row * RST + ch * 16) = kv; *(LAS u32x4*)(sV + row * RST + ch * 16) = vv; }
        const int qs = q0 + wave * 32 + ql;
        const size_t rq = rowb + (size_t)qs * dil + res;
        bf16* qp = P + rq * NPROJ + PC_DQ + head * 64;
        bf16x8 qf[4];
        {
            u32x4 qr[4];
#pragma unroll
            for (int ks = 0; ks < 4; ++ks) qr[ks] = *(const u32x4*)(qp + 16 * ks + 8 * h);
            const f32x4* rt = (const f32x4*)(RT + ((size_t)half * HT + rq) * 16); const f32x4 c0 = rt[0], c1 = rt[1], s0 = rt[2], s1 = rt[3];
            float ss = 0.f;
#pragma unroll
            for (int ks = 0; ks < 4; ++ks) ss += (bflo(qr[ks].x) * bflo(qr[ks].x) + bfhi(qr[ks].x) * bfhi(qr[ks].x)) + (bflo(qr[ks].y) * bflo(qr[ks].y) + bfhi(qr[ks].y) * bfhi(qr[ks].y))
                                               + (bflo(qr[ks].z) * bflo(qr[ks].z) + bfhi(qr[ks].z) * bfhi(qr[ks].z)) + (bflo(qr[ks].w) * bflo(qr[ks].w) + bfhi(qr[ks].w) * bfhi(qr[ks].w));
            ss += __shfl_xor(ss, 32);
            const float rs = 1.0f / sqrtf(ss * (1.f / 64.f) + EPS);
#pragma unroll
            for (int ks = 0; ks < 4; ++ks) { const f32x4 wa = *(const f32x4*)(F.in[I_DQNW] + 16 * ks + 8 * h), wb = *(const f32x4*)(F.in[I_DQNW] + 16 * ks + 8 * h + 4);
                float x[8] = {bflo(qr[ks].x) * rs * wa.x, bfhi(qr[ks].x) * rs * wa.y, bflo(qr[ks].y) * rs * wa.z, bfhi(qr[ks].y) * rs * wa.w, bflo(qr[ks].z) * rs * wb.x, bfhi(qr[ks].z) * rs * wb.y, bflo(qr[ks].w) * rs * wb.z, bfhi(qr[ks].w) * rs * wb.w};
                if (ks == 0) { const float cs[8] = {c0.x, c0.y, c0.z, c0.w, c1.x, c1.y, c1.z, c1.w}, sn[8] = {s0.x, s0.y, s0.z, s0.w, s1.x, s1.y, s1.z, s1.w};
#pragma unroll
                    for (int j = 0; j < 8; ++j) { const float o = __shfl_xor(x[j], 32); x[j] = (h == 0) ? x[j] * cs[j] - o * sn[j] : x[j] * cs[j] + o * sn[j]; } }
                const u32x4 w = {pkbf(x[0], x[1]), pkbf(x[2], x[3]), pkbf(x[4], x[5]), pkbf(x[6], x[7])}; qf[ks] = __builtin_bit_cast(bf16x8, w); }
        }
        __syncthreads();
        f32x16 sacc[5];
        const int kfirst = q0 + wave * 32 - 128;
#pragma unroll
        for (int i = 0; i < 5; ++i) {
#pragma unroll
            for (int e = 0; e < 16; ++e) sacc[i][e] = 0.f;
#pragma unroll
            for (int ks = 0; ks < 4; ++ks) { const bf16x8 kf = *(const LAS bf16x8*)(sK + (32 * wave + 32 * i + ql) * RST + 32 * ks + 16 * h); sacc[i] = MFMA32(kf, qf[ks], sacc[i]); }
        }
        float mx = -3.0e38f;
#pragma unroll
        for (int i = 0; i < 5; ++i)
#pragma unroll
            for (int e = 0; e < 16; ++e) { const int kj = 32 * i + (e & 3) + 8 * (e >> 2) + 4 * h; const bool ok = (kj >= ql) && (kj <= ql + 128) && (kfirst + kj >= 0);
                sacc[i][e] = ok ? sacc[i][e] : -3.0e38f; mx = fmaxf(mx, sacc[i][e]); }
        mx = fmaxf(mx, __shfl_xor(mx, 32));
        const float sc = 0.125f * 1.4426950408889634f;
        float l = 0.f;
        bf16x8 pf[5][2];
#pragma unroll
        for (int i = 0; i < 5; ++i) {
            float p[16];
#pragma unroll
            for (int e = 0; e < 16; ++e) { p[e] = (sacc[i][e] > -1.0e38f) ? __builtin_amdgcn_exp2f((sacc[i][e] - mx) * sc) : 0.f; l += p[e]; }
#pragma unroll
            for (int s2 = 0; s2 < 2; ++s2) { const u32x4 w = {pkbf(p[8 * s2 + 0], p[8 * s2 + 1]), pkbf(p[8 * s2 + 2], p[8 * s2 + 3]), pkbf(p[8 * s2 + 4], p[8 * s2 + 5]), pkbf(p[8 * s2 + 6], p[8 * s2 + 7])};
                pf[i][s2] = __builtin_bit_cast(bf16x8, w); }
        }
        l += __shfl_xor(l, 32);
        const float il = 1.0f / l;
        const int tq = (lane & 15) >> 2, tp = lane & 3, tblk = (lane >> 4) & 1;
        const unsigned vbase = (unsigned)(size_t)(sV) + (unsigned)((32 * wave + 4 * h + tq) * RST + (16 * tblk + 4 * tp) * 2);
#pragma unroll
        for (int dt = 0; dt < 2; ++dt) {
            f32x16 o;
#pragma unroll
            for (int e = 0; e < 16; ++e) o[e] = 0.f;
#pragma unroll
            for (int i = 0; i < 5; ++i) {
                s16x4 lo[2], hi[2];
#pragma unroll
                for (int s2 = 0; s2 < 2; ++s2) { const unsigned a = vbase + (unsigned)((32 * i + 16 * s2) * RST + 64 * dt);
                    asm volatile("ds_read_b64_tr_b16 %0, %1" : "=&v"(lo[s2]) : "v"(a) : "memory");
                    asm volatile("ds_read_b64_tr_b16 %0, %1 offset:1152" : "=&v"(hi[s2]) : "v"(a) : "memory"); }
                asm volatile("s_waitcnt lgkmcnt(0)" ::: "memory"); __builtin_amdgcn_sched_barrier(0);
#pragma unroll
                for (int s2 = 0; s2 < 2; ++s2) { const bf16x8 vf = {lo[s2][0], lo[s2][1], lo[s2][2], lo[s2][3], hi[s2][0], hi[s2][1], hi[s2][2], hi[s2][3]}; o = MFMA32(vf, pf[i][s2], o); }
            }
#pragma unroll
            for (int gq = 0; gq < 4; ++gq) { const u32x2 w = {pkbf(o[4 * gq] * il, o[4 * gq + 1] * il), pkbf(o[4 * gq + 2] * il, o[4 * gq + 3] * il)}; *(u32x2*)(qp + 32 * dt + 8 * gq + 4 * h) = w; }
        }
        if (h == 0) LSE[((size_t)half * HT + rq) * 12 + head] = mx * 0.125f + __logf(l);
    }
}

__device__ __forceinline__ void dilmerge_phase(Frame& F, int half) {
    const bf16* P = (const bf16*)(F.ws + WS_BIG);
    const float* LSE = (const float*)(F.ws + WS_LSE);
    bf16* Y = (bf16*)F.out;
    const size_t gtid = (size_t)F.bid * NTHR + F.tid, gth = (size_t)F.G * NTHR;
    for (size_t it = gtid; it < (size_t)HT * 32; it += gth) {
        const size_t r = it >> 5; const int hh = (int)(it >> 3) & 3, d0 = (int)(it & 7) * 8;
        const size_t tok = (size_t)half * HT + r;
        const float l0 = LSE[tok * 12 + hh], l1 = LSE[tok * 12 + 4 + hh], l2 = LSE[tok * 12 + 8 + hh];
        const float m = fmaxf(l0, fmaxf(l1, l2));
        float w0 = __expf(l0 - m), w1 = __expf(l1 - m), w2 = __expf(l2 - m); const float iw = 1.0f / (w0 + w1 + w2); w0 *= iw; w1 *= iw; w2 *= iw;
        const bf16* op = P + r * NPROJ + PC_DQ + hh * 64 + d0;
        const u32x4 a = *(const u32x4*)op, b = *(const u32x4*)(op + 256), c = *(const u32x4*)(op + 512);
        u32x4 o;
        o.x = pkbf(w0 * bflo(a.x) + w1 * bflo(b.x) + w2 * bflo(c.x), w0 * bfhi(a.x) + w1 * bfhi(b.x) + w2 * bfhi(c.x));
        o.y = pkbf(w0 * bflo(a.y) + w1 * bflo(b.y) + w2 * bflo(c.y), w0 * bfhi(a.y) + w1 * bfhi(b.y) + w2 * bfhi(c.y));
        o.z = pkbf(w0 * bflo(a.z) + w1 * bflo(b.z) + w2 * bflo(c.z), w0 * bfhi(a.z) + w1 * bfhi(b.z) + w2 * bfhi(c.z));
        o.w = pkbf(w0 * bflo(a.w) + w1 * bflo(b.w) + w2 * bflo(c.w), w0 * bfhi(a.w) + w1 * bfhi(b.w) + w2 * bfhi(c.w));
        *(u32x4*)(Y + tok * YC + 1024 + hh * 64 + d0) = o;
    }
}

__device__ __forceinline__ void hn_phase(Frame& F) {
    const int gw = F.bid * NWAVES + F.wave, NGW = F.G * NWAVES;
    for (int m = gw; m < T; m += NGW) { f32x4 v[4]; rms_row_to_bf16(F.out + (size_t)m * DM, F.in[I_NFFNW], (bf16*)(F.ws + WS_ACT1) + (size_t)m * DM, F.lane, v); }
}


__device__ __forceinline__ float gelu_erf(float x) { return 0.5f * x * (1.0f + erff(x * 0.70710678118654752f)); }
__device__ __forceinline__ unsigned f2ord(float f) { const unsigned u = __builtin_bit_cast(unsigned, f); return u ^ ((unsigned)((int)u >> 31) | 0x80000000u); }
__device__ __forceinline__ float ord2f(unsigned k) { const unsigned m = (unsigned)((int)k >> 31); return __builtin_bit_cast(float, k ^ (0x80000000u | ~m)); }
#define CMPX(a, b) do { const unsigned _mx = max((a), (b)), _mn = min((a), (b)); (a) = _mx; (b) = _mn; } while (0)
__device__ __forceinline__ void bitonic_sort16_desc(unsigned (&v)[16]) {
#pragma unroll
    for (int k = 2; k <= 16; k <<= 1)
#pragma unroll
        for (int j = k >> 1; j > 0; j >>= 1)
#pragma unroll
            for (int i = 0; i < 16; ++i) { const int l = i ^ j; if (l > i) { if ((i & k) == 0) CMPX(v[i], v[l]); else CMPX(v[l], v[i]); } }
}
__device__ __forceinline__ void bitonic_merge16_desc(unsigned (&v)[16]) {
#pragma unroll
    for (int j = 8; j > 0; j >>= 1)
#pragma unroll
        for (int i = 0; i < 16; ++i) { const int l = i ^ j; if (l > i) CMPX(v[i], v[l]); }
}
__device__ __forceinline__ void top16_merge(unsigned (&a)[16], const unsigned (&b)[16]) {
#pragma unroll
    for (int i = 0; i < 16; ++i) a[i] = max(a[i], b[15 - i]);
    bitonic_merge16_desc(a);
}
constexpr int PK_ST = 272;
__device__ __forceinline__ void peer_topk_tile(Frame& F, size_t tok0, const bf16* Q, int* IDX, float* GATE) {
    const bf16* SK = (const bf16*)(F.ws + WS_SUBK);
    LAS unsigned char* sK = F.lds;
    int tid = F.tid; asm volatile("" : "+v"(tid));
    const int lane = tid & 63, wave = F.wave, ql = lane & 31, hh = lane >> 5;
    const size_t tok = tok0 + wave * 32 + ql;
    const bf16* qrow = Q + tok * PEER_Q + 8 * hh;
    __syncthreads();
#pragma unroll
    for (int j = 0; j < 4; ++j) { const int cidx = tid + 512 * j, row = cidx >> 4, ch = cidx & 15; *(LAS u32x4*)(sK + row * PK_ST + ch * 16) = *(const u32x4*)(SK + (size_t)row * 128 + ch * 8); }
    __syncthreads();
    unsigned k1[16];
    bf16x8 qf[8];
#pragma unroll
    for (int ks = 0; ks < 8; ++ks) qf[ks] = *(const bf16x8*)(qrow + 16 * ks);
#pragma unroll 1
    for (int hc = 0; hc < 16; ++hc) {
        LAS unsigned char* cur = sK + (hc & 1) * (128 * PK_ST); LAS unsigned char* nxt = sK + ((hc + 1) & 1) * (128 * PK_ST);
        u32x4 stg[4];
        const int hcn = (hc + 1) & 15;
#pragma unroll
        for (int j = 0; j < 4; ++j) { const int cidx = tid + 512 * j, row = cidx >> 4, ch = cidx & 15; stg[j] = *(const u32x4*)(SK + ((size_t)hcn * 128 + row) * 128 + ch * 8); }
        unsigned pk[4][16];
#pragma unroll
        for (int mt = 0; mt < 4; ++mt) {
            f32x16 acc;
#pragma unroll
            for (int e = 0; e < 16; ++e) acc[e] = 0.f;
#pragma unroll
            for (int ks = 0; ks < 8; ++ks) { const bf16x8 kf = *(const LAS bf16x8*)(cur + (32 * mt + ql) * PK_ST + 32 * ks + 16 * hh); acc = MFMA32(kf, qf[ks], acc); }
#pragma unroll
            for (int e = 0; e < 16; ++e) pk[mt][e] = (f2ord(acc[e]) & 0xFFFFFF80u) | (unsigned)(32 * mt + (e & 3) + 8 * (e >> 2) + 4 * hh);
        }
#pragma unroll
        for (int j = 0; j < 4; ++j) { const int cidx = tid + 512 * j, row = cidx >> 4, ch = cidx & 15; *(LAS u32x4*)(nxt + row * PK_ST + ch * 16) = stg[j]; }
        __syncthreads();
        __builtin_amdgcn_sched_barrier(0);
#pragma unroll
        for (int ks = 0; ks < 8; ++ks) qf[ks] = *(const bf16x8*)(qrow + hcn * 128 + 16 * ks);
        __builtin_amdgcn_sched_barrier(0);
#pragma unroll
        for (int mt = 0; mt < 4; ++mt) bitonic_sort16_desc(pk[mt]);
        top16_merge(pk[0], pk[1]); top16_merge(pk[2], pk[3]); top16_merge(pk[0], pk[2]);
        unsigned other[16];
#pragma unroll
        for (int i = 0; i < 16; ++i) other[i] = (unsigned)__shfl_xor((int)pk[0][i], 32);
        top16_merge(pk[0], other);
        if ((hc & 1) == 0) {
#pragma unroll
            for (int i = 0; i < 16; ++i) k1[i] = pk[0][i];
        } else {
            float f1[16], f2[16];
#pragma unroll
            for (int i = 0; i < 16; ++i) { f1[i] = ord2f(k1[i] & 0xFFFFFF80u); f2[i] = ord2f(pk[0][i] & 0xFFFFFF80u); }
            unsigned cd[4][16];
#pragma unroll
            for (int i = 0; i < 64; ++i) cd[i >> 4][i & 15] = 0u;
            int n = 0;
#pragma unroll
            for (int a = 0; a < 16; ++a)
#pragma unroll
                for (int b = 0; b < 16; ++b)
                    if ((a + 1) * (b + 1) <= 16) { cd[n >> 4][n & 15] = (f2ord(f1[a] + f2[b]) & 0xFFFFC000u) | ((k1[a] & 127u) << 7) | (pk[0][b] & 127u); ++n; }
#pragma unroll
            for (int g4 = 0; g4 < 4; ++g4) bitonic_sort16_desc(cd[g4]);
            top16_merge(cd[0], cd[1]); top16_merge(cd[2], cd[3]); top16_merge(cd[0], cd[2]);
            const float vmax = ord2f(cd[0][0] & 0xFFFFC000u);
            float ex[16], den = 0.f;
#pragma unroll
            for (int i = 0; i < 16; ++i) { ex[i] = __expf(ord2f(cd[0][i] & 0xFFFFC000u) - vmax); den += ex[i]; }
            const float iden = 1.0f / den;
            const int h = hc >> 1;
            if (hh == 0) { int* ip = IDX + tok * 128 + h * 16;
#pragma unroll
                for (int i = 0; i < 4; ++i) { const u32x4 w = {cd[0][4 * i] & 0x3FFFu, cd[0][4 * i + 1] & 0x3FFFu, cd[0][4 * i + 2] & 0x3FFFu, cd[0][4 * i + 3] & 0x3FFFu}; *(u32x4*)(ip + 4 * i) = w; } }
            else { float* gp = GATE + tok * 128 + h * 16;
#pragma unroll
                for (int i = 0; i < 4; ++i) { const f32x4 w = {ex[4 * i] * iden, ex[4 * i + 1] * iden, ex[4 * i + 2] * iden, ex[4 * i + 3] * iden}; *(f32x4*)(gp + 4 * i) = w; } }
        }
    }
}

struct PeerDeal { size_t tokw; int ntok; size_t tok0; float* PART; const int* IDX; const float* GATE; float* COEF; };
__device__ __forceinline__ void peer_item(int n, const PeerDeal& D, int wave, int& slice, size_t& tok) { slice = n >> 5; tok = D.tokw + (n & 31); }
__device__ __forceinline__ void peer_down_rows(u32x4 (&R)[16], __amdgpu_buffer_rsrc_t tab, int slice, int id0, int id1, int lane) {
    const int soff = slice * (16384 * 128);
    const int r = lane & 15, g = lane >> 4, e8 = (r >> 2) + 4 * (g >> 1), q = 4 * (g & 1) + (r & 3);
    const int src0 = 16 * (e8 & 3);
#pragma unroll
    for (int k = 0; k < 16; ++k) { const int v0 = __shfl(id0, src0 + k), v1 = __shfl(id1, src0 + k); const int id = (e8 < 4) ? v0 : v1;
        R[k] = __builtin_amdgcn_raw_buffer_load_b128(tab, (id << 7) + 16 * q, soff, 0); }
}
__device__ __forceinline__ void peer_down_hn(u32x4 (&H)[2], const bf16* HN, int slice, size_t tok, int lane) {
    const bf16* hp = HN + tok * DM + slice * 128 + 16 * (4 * ((lane >> 4) & 1) + (lane & 3));
    H[0] = *(const u32x4*)hp; H[1] = *(const u32x4*)(hp + 8);
}
__device__ __forceinline__ void peer_down_bq(long (&bq)[2], const u32x4 (&H)[2], int lane) {
    const int c = lane & 15, g = lane >> 4; const bool on = (c < 8) && ((c >> 2) == (g >> 1));
    const u32x4 x0 = H[0], x1 = H[1];
    unsigned p0 = __builtin_amdgcn_cvt_pk_fp8_f32(bflo(x0.x), bfhi(x0.x), 0, false); p0 = __builtin_amdgcn_cvt_pk_fp8_f32(bflo(x0.y), bfhi(x0.y), p0, true);
    unsigned p1 = __builtin_amdgcn_cvt_pk_fp8_f32(bflo(x0.z), bfhi(x0.z), 0, false); p1 = __builtin_amdgcn_cvt_pk_fp8_f32(bflo(x0.w), bfhi(x0.w), p1, true);
    unsigned p2 = __builtin_amdgcn_cvt_pk_fp8_f32(bflo(x1.x), bfhi(x1.x), 0, false); p2 = __builtin_amdgcn_cvt_pk_fp8_f32(bflo(x1.y), bfhi(x1.y), p2, true);
    unsigned p3 = __builtin_amdgcn_cvt_pk_fp8_f32(bflo(x1.z), bfhi(x1.z), 0, false); p3 = __builtin_amdgcn_cvt_pk_fp8_f32(bflo(x1.w), bfhi(x1.w), p3, true);
    if (!on) { p0 = 0u; p1 = 0u; p2 = 0u; p3 = 0u; }
    bq[0] = (long)(((unsigned long long)p1 << 32) | p0); bq[1] = (long)(((unsigned long long)p3 << 32) | p2);
}
__device__ __forceinline__ void peer_down_mfma(const u32x4 (&R)[16], const long (&bq)[2], __amdgpu_buffer_rsrc_t prsrc, int slice, int tokl, int lane) {
    const int c = lane & 15, g = lane >> 4, cb = c & 3;
    float dv[16];
#pragma unroll
    for (int k = 0; k < 16; ++k) { f32x4 acc = {0.f, 0.f, 0.f, 0.f}; const u32x4 v = R[k];
        acc = __builtin_amdgcn_mfma_f32_16x16x32_fp8_fp8((long)(((unsigned long long)v.y << 32) | v.x), bq[0], acc, 0, 0, 0);
        acc = __builtin_amdgcn_mfma_f32_16x16x32_fp8_fp8((long)(((unsigned long long)v.w << 32) | v.z), bq[1], acc, 0, 0, 0);
        float t = (cb == 0) ? acc.x : (cb == 1) ? acc.y : (cb == 2) ? acc.z : acc.w;
        t += __shfl_xor(t, 1); t += __shfl_xor(t, 2); dv[k] = t; }
    const unsigned off = ((c & 3) == 0 && c < 8) ? (unsigned)(((tokl * 8 + slice) * 128 + 16 * (g + 4 * (c >> 2))) * 4) : 0xFFFFFF00u;
#pragma unroll
    for (int i = 0; i < 4; ++i) { const f32x4 w = {dv[4 * i], dv[4 * i + 1], dv[4 * i + 2], dv[4 * i + 3]}; __builtin_amdgcn_raw_buffer_store_b128(__builtin_bit_cast(u32x4, w), prsrc, off, 16 * i, 0); }
}
__device__ __forceinline__ void peer_down_phase(Frame& F, const PeerDeal& D) {
    const __amdgpu_buffer_rsrc_t PD = __builtin_amdgcn_make_buffer_rsrc((void*)(F.ws + WS_PD), 0, 16384 * 1024, 0x00020000); const bf16* HN = (const bf16*)(F.ws + WS_HB);
    const int* IDX = D.IDX;
    const __amdgpu_buffer_rsrc_t prsrc = __builtin_amdgcn_make_buffer_rsrc((void*)D.PART, 0, 256 * 8 * 128 * 4, 0x00020000);
    int lane = F.lane; asm volatile("" : "+v"(lane));
    const int wave = F.wave;
    const int ntok = D.ntok;
    u32x4 RA[16], RB[16], HA[2], HB[2]; int ia0, ia1, ib0, ib1; long bq[2];
#define PEER_TOK(k, sv, tv) int sv; size_t tv; peer_item((k) < ntok ? (k) : ntok - 2 + ((k) & 1), D, wave, sv, tv)
    { PEER_TOK(0, s0, t0); PEER_TOK(1, s1, t1); PEER_TOK(2, s2, t2); PEER_TOK(3, s3, t3);
      const int a0 = IDX[t0 * 128 + lane], a1 = IDX[t0 * 128 + 64 + lane], b0 = IDX[t1 * 128 + lane], b1 = IDX[t1 * 128 + 64 + lane];
      ia0 = IDX[t2 * 128 + lane]; ia1 = IDX[t2 * 128 + 64 + lane]; ib0 = IDX[t3 * 128 + lane]; ib1 = IDX[t3 * 128 + 64 + lane];
      __builtin_amdgcn_sched_barrier(0);
      peer_down_rows(RA, PD, s0, a0, a1, lane); peer_down_hn(HA, HN, s0, t0, lane);
      __builtin_amdgcn_sched_barrier(0);
      peer_down_rows(RB, PD, s1, b0, b1, lane); peer_down_hn(HB, HN, s1, t1, lane);
      __builtin_amdgcn_sched_barrier(0); }
#pragma unroll 1
    for (int n = 0; n < ntok; n += 2) {
        PEER_TOK(n, s0, t0); PEER_TOK(n + 1, s1, t1); PEER_TOK(n + 2, s2, t2); PEER_TOK(n + 3, s3, t3); PEER_TOK(n + 4, s4, t4); PEER_TOK(n + 5, s5, t5);
        peer_down_bq(bq, HA, lane);
        peer_down_mfma(RA, bq, prsrc, s0, (int)(t0 - D.tok0), lane);
        __builtin_amdgcn_sched_barrier(0);
        { const int j0 = IDX[t4 * 128 + lane], j1 = IDX[t4 * 128 + 64 + lane];
          peer_down_rows(RA, PD, s2, ia0, ia1, lane); peer_down_hn(HA, HN, s2, t2, lane); ia0 = j0; ia1 = j1; }
        __builtin_amdgcn_sched_barrier(0);
        peer_down_bq(bq, HB, lane);
        peer_down_mfma(RB, bq, prsrc, s1, (int)(t1 - D.tok0), lane);
        __builtin_amdgcn_sched_barrier(0);
        { const int j0 = IDX[t5 * 128 + lane], j1 = IDX[t5 * 128 + 64 + lane];
          peer_down_rows(RB, PD, s3, ib0, ib1, lane); peer_down_hn(HB, HN, s3, t3, lane); ib0 = j0; ib1 = j1; }
        __builtin_amdgcn_sched_barrier(0);
    }
#undef PEER_TOK
}
__device__ __forceinline__ void peer_coef_wave(Frame& F, const PeerDeal& D) {
    for (int k = F.lane; k < 32 * 32; k += 64) {
        const int tl = (int)(D.tokw - D.tok0) + (k >> 5), slot = 4 * (k & 31);
        const float* pp = D.PART + (size_t)tl * 1024 + slot;
        f32x4 sm = *(const f32x4*)pp;
#pragma unroll
        for (int x = 1; x < 8; ++x) sm += *(const f32x4*)(pp + 128 * x);
        const size_t i = (D.tok0 + tl) * 128 + slot;
        const f32x4 gt = *(const f32x4*)(D.GATE + i);
        const float dsc = (1.0f / PD_SCALE) / sqrtf(((const float*)(F.ws + WS_SSQ))[D.tok0 + tl] * (1.f / DM) + EPS);
        const f32x4 o = {gt.x * gelu_erf(sm.x * dsc) * (1.0f / PU_SCALE), gt.y * gelu_erf(sm.y * dsc) * (1.0f / PU_SCALE),
                         gt.z * gelu_erf(sm.z * dsc) * (1.0f / PU_SCALE), gt.w * gelu_erf(sm.w * dsc) * (1.0f / PU_SCALE)};
        *(f32x4*)(D.COEF + i) = o;
    }
}
__device__ __forceinline__ void peer_up_rows(u32x4 (&R)[16], __amdgpu_buffer_rsrc_t tab, int slice, int id0, int id1, int lane) {
    const int soff = slice * (16384 * 128);
#pragma unroll
    for (int s8 = 0; s8 < 8; ++s8) { const int id = __shfl(s8 < 4 ? id0 : id1, (16 * s8 + (lane >> 2)) & 63); const int vo = (id << 7) + 16 * (lane & 3);
        R[2 * s8] = __builtin_amdgcn_raw_buffer_load_b128(tab, vo, soff, 0); R[2 * s8 + 1] = __builtin_amdgcn_raw_buffer_load_b128(tab, vo, soff + 64, 0); }
}
__device__ __forceinline__ void peer_up_compute(const u32x4 (&R)[16], float c0, float c1, f32x2 h, float* out, int slice, size_t tok, int lane) {
    f32x2 acc[16];
#pragma unroll
    for (int k = 0; k < 16; ++k) acc[k] = (f32x2){0.f, 0.f};
#pragma unroll
    for (int s8 = 0; s8 < 8; ++s8) { const float c = __shfl(s8 < 4 ? c0 : c1, (16 * s8 + (lane >> 2)) & 63); f32x2 c2 = {c, c}; asm volatile("" : "+v"(c2));
#pragma unroll
        for (int hf = 0; hf < 2; ++hf) { const u32x4 r = R[2 * s8 + hf];
            acc[8 * hf + 0] = c2 * __builtin_amdgcn_cvt_pk_f32_fp8(r.x, false) + acc[8 * hf + 0]; acc[8 * hf + 1] = c2 * __builtin_amdgcn_cvt_pk_f32_fp8(r.x, true) + acc[8 * hf + 1];
            acc[8 * hf + 2] = c2 * __builtin_amdgcn_cvt_pk_f32_fp8(r.y, false) + acc[8 * hf + 2]; acc[8 * hf + 3] = c2 * __builtin_amdgcn_cvt_pk_f32_fp8(r.y, true) + acc[8 * hf + 3];
            acc[8 * hf + 4] = c2 * __builtin_amdgcn_cvt_pk_f32_fp8(r.z, false) + acc[8 * hf + 4]; acc[8 * hf + 5] = c2 * __builtin_amdgcn_cvt_pk_f32_fp8(r.z, true) + acc[8 * hf + 5];
            acc[8 * hf + 6] = c2 * __builtin_amdgcn_cvt_pk_f32_fp8(r.w, false) + acc[8 * hf + 6]; acc[8 * hf + 7] = c2 * __builtin_amdgcn_cvt_pk_f32_fp8(r.w, true) + acc[8 * hf + 7]; } }
    f32x2 r8[8], r4[4], r2[2], r1;
    { const bool up = (lane & 32) != 0;
#pragma unroll
      for (int k = 0; k < 8; ++k) { const f32x2 keep = up ? acc[k + 8] : acc[k], send = up ? acc[k] : acc[k + 8]; r8[k] = keep + (f32x2){__shfl_xor(send.x, 32), __shfl_xor(send.y, 32)}; } }
    { const bool up = (lane & 16) != 0;
#pragma unroll
      for (int k = 0; k < 4; ++k) { const f32x2 keep = up ? r8[k + 4] : r8[k], send = up ? r8[k] : r8[k + 4]; r4[k] = keep + (f32x2){__shfl_xor(send.x, 16), __shfl_xor(send.y, 16)}; } }
    { const bool up = (lane & 8) != 0;
#pragma unroll
      for (int k = 0; k < 2; ++k) { const f32x2 keep = up ? r4[k + 2] : r4[k], send = up ? r4[k] : r4[k + 2]; r2[k] = keep + (f32x2){__shfl_xor(send.x, 8), __shfl_xor(send.y, 8)}; } }
    { const bool up = (lane & 4) != 0; const f32x2 keep = up ? r2[1] : r2[0], send = up ? r2[0] : r2[1]; r1 = keep + (f32x2){__shfl_xor(send.x, 4), __shfl_xor(send.y, 4)}; }
    const int p = ((lane >> 5) & 1) * 8 + ((lane >> 4) & 1) * 4 + ((lane >> 3) & 1) * 2 + ((lane >> 2) & 1);
    *(f32x2*)(out + tok * DM + slice * 128 + 16 * (lane & 3) + 2 * (p & 7) + 64 * (p >> 3)) = h + r1;
}
__device__ __forceinline__ void peer_up_phase(Frame& F, const PeerDeal& D, float* outp) {
    const __amdgpu_buffer_rsrc_t PU = __builtin_amdgcn_make_buffer_rsrc((void*)(F.ws + WS_PU), 0, 16384 * 1024, 0x00020000);
    const int* IDX = D.IDX; const float* COEF = D.COEF;
    int lane = F.lane; asm volatile("" : "+v"(lane));
    const int wave = F.wave;
    const int ntok = D.ntok;
    const int p = ((lane >> 5) & 1) * 8 + ((lane >> 4) & 1) * 4 + ((lane >> 3) & 1) * 2 + ((lane >> 2) & 1);
    const int hoff = 16 * (lane & 3) + 2 * (p & 7) + 64 * (p >> 3);
    int sl; size_t tk;
    u32x4 R0[16], R1[16];
    float ca0, ca1, cb0, cb1; f32x2 ha, hb;
    int id0, id1, jd0, jd1;
    { int s1_; size_t t1_; peer_item(0, D, wave, sl, tk); peer_item(1, D, wave, s1_, t1_);
      jd0 = IDX[tk * 128 + lane]; jd1 = IDX[tk * 128 + 64 + lane]; id0 = IDX[t1_ * 128 + lane]; id1 = IDX[t1_ * 128 + 64 + lane];
      __builtin_amdgcn_sched_barrier(0);
      peer_up_rows(R0, PU, sl, jd0, jd1, lane);
      ca0 = COEF[tk * 128 + lane]; ca1 = COEF[tk * 128 + 64 + lane]; ha = *(const f32x2*)(F.out + tk * DM + sl * 128 + hoff);
      __builtin_amdgcn_sched_barrier(0); }
#pragma unroll 1
    for (int n = 0; n < ntok; n += 2) {
        int s0, s1, s2, s3; size_t t0, t1, t2, t3;
        peer_item(n, D, wave, s0, t0); peer_item(n + 1, D, wave, s1, t1);
        peer_item(n + 2 < ntok ? n + 2 : n, D, wave, s2, t2); peer_item(n + 3 < ntok ? n + 3 : n + 1, D, wave, s3, t3);
        jd0 = IDX[t2 * 128 + lane]; jd1 = IDX[t2 * 128 + 64 + lane];
        peer_up_rows(R1, PU, s1, id0, id1, lane);
        cb0 = COEF[t1 * 128 + lane]; cb1 = COEF[t1 * 128 + 64 + lane]; hb = *(const f32x2*)(F.out + t1 * DM + s1 * 128 + hoff);
        __builtin_amdgcn_sched_barrier(0);
        peer_up_compute(R0, ca0, ca1, ha, outp, s0, t0, lane);
        __builtin_amdgcn_sched_barrier(0);
        id0 = IDX[t3 * 128 + lane]; id1 = IDX[t3 * 128 + 64 + lane];
        peer_up_rows(R0, PU, s2, jd0, jd1, lane);
        ca0 = COEF[t2 * 128 + lane]; ca1 = COEF[t2 * 128 + 64 + lane]; ha = *(const f32x2*)(F.out + t2 * DM + s2 * 128 + hoff);
        __builtin_amdgcn_sched_barrier(0);
        peer_up_compute(R1, cb0, cb1, hb, outp, s1, t1, lane);
        __builtin_amdgcn_sched_barrier(0);
    }
}
__device__ __forceinline__ void peer_tile(Frame& F, int tile) {
    const size_t tok0 = (size_t)tile * 256;
    const bf16* Q = (const bf16*)(F.ws + WS_BIG);
    int* IDX = (int*)(F.ws + WS_BIG + 256 * MiB); float* GATE = (float*)(F.ws + WS_BIG + 288 * MiB); float* COEF = (float*)(F.ws + WS_BIG + 320 * MiB);
    peer_topk_tile(F, tok0, Q, IDX, GATE);
    VM_WAIT(); __syncthreads();
    PeerDeal D; D.tokw = tok0 + F.wave * 32; D.ntok = 256; D.tok0 = tok0; D.PART = (float*)(F.ws + WS_BIG + tok0 * (PEER_Q * 2)); D.IDX = IDX; D.GATE = GATE; D.COEF = COEF;
    peer_down_phase(F, D);
    VM_WAIT(); __syncthreads();
    peer_coef_wave(F, D);
    VM_WAIT(); __syncthreads();
    peer_up_phase(F, D, F.out);
}
__device__ __forceinline__ void peer_phase(Frame& F) { for (int tile = F.bid; tile < T / 256; tile += F.G) { peer_tile(F, tile); VM_WAIT(); __syncthreads(); } }

constexpr int N_PHASES = 14;
__global__ void __launch_bounds__(NTHR, 2) mega_fwd(Args args) {
    extern __shared__ __attribute__((aligned(16))) unsigned char lds_raw[];
    Frame F;
    F.lds = (LAS unsigned char*)lds_raw;
    F.tid = threadIdx.x; F.lane = F.tid & 63; F.wave = __builtin_amdgcn_readfirstlane(F.tid >> 6);
    F.G = gridDim.x; F.bid = blockIdx.x;
    F.in = args.in;
    F.positions = args.positions; F.out = args.out; F.ws = args.ws;
    unsigned char* ws = args.ws;
    volatile LAS unsigned* ctlw = (volatile LAS unsigned*)(F.lds + LDSCTL_OFF);
    if (F.tid < 64) ctlw[F.tid] = 0u;
    __syncthreads();
    const int lo = args.ph_lo, hi = args.ph_hi;
    XcdBarrier bar; bar.bar = (unsigned*)(ws + WS_CTL); bar.x = 0; bar.st = nullptr; bar.wave = F.wave;
    if (hi - lo > 1) bar = xcd_barrier_post((unsigned*)(ws + WS_CTL), ctlw + 8, F.wave);
#define IN(k) (lo <= (k) && (k) < hi)
#define SEAM(k) do { if (IN(k) && IN((k) + 1)) xcd_barrier(bar); } while (0)
    bf16* ACT1 = (bf16*)(ws + WS_ACT1); bf16* BIG = (bf16*)(ws + WS_BIG); bf16* WallT = (bf16*)(ws + WS_WALLT);

    if (IN(0)) { frame_refresh(F); p0_prologue(F); __syncthreads(); }
    SEAM(0);
    if (IN(1)) { frame_refresh(F);
        { pg8::Gemm g{(const bf16*)(ws + WS_MEMN), (const bf16*)(ws + WS_WMKVT), NB * NMEM, 768, DM, DM, DM}; pg8::StaticOrder S; S.init(g.M, g.N, F.G, F.bid);
          pg8::EpiBf16<0> E{(bf16*)(ws + WS_MKV), 1536}; pg8::gemm_phase(F.lds, g, S, E, F.wave); }
        { pg8::Gemm g{(const bf16*)(ws + WS_WMKVT) + (size_t)768 * DM, (const bf16*)(ws + WS_MEMN), 768, NB * NMEM, DM, DM, DM}; pg8::StaticOrder S; S.init(g.M, g.N, F.G, F.G - 1 - F.bid);
          pg8::EpiBf16<0> E{(bf16*)(ws + WS_MVT), NB * NMEM}; pg8::gemm_phase(F.lds, g, S, E, F.wave); }
        { pg8::Gemm g{ACT1, WallT, HT, NPROJ, DM, DM, DM}; pg8::StaticOrder S; S.init(g.M, g.N, F.G, F.bid);
          pg8::EpiBf16<0> E{BIG, NPROJ}; pg8::gemm_phase(F.lds, g, S, E, F.wave); }
    }
    SEAM(1);
    if (IN(2)) { frame_refresh(F); mknorm_phase(F); ssdC_phase(F, 0); }
    SEAM(2);
    if (IN(3)) { frame_refresh(F); ssdD_phase(F); dilattn_mfma_phase(F, 0); memattn_mfma_phase(F, 0); }
    SEAM(3);
    if (IN(4)) { frame_refresh(F); ssdE_phase(F, 0); dilmerge_phase(F, 0); }
    SEAM(4);
    if (IN(5)) { frame_refresh(F); pg8::Gemm g{ACT1 + (size_t)HT * DM, WallT, HT, NPROJ, DM, DM, DM}; pg8::StaticOrder S; S.init(g.M, g.N, F.G, F.bid);
        pg8::EpiBf16<0> E{BIG, NPROJ}; pg8::gemm_phase(F.lds, g, S, E, F.wave); }
    SEAM(5);
    if (IN(6)) { frame_refresh(F); ssdC_phase(F, 1); }
    SEAM(6);
    if (IN(7)) { frame_refresh(F); ssdD_phase(F); dilattn_mfma_phase(F, 1); memattn_mfma_phase(F, 1); }
    SEAM(7);
    if (IN(8)) { frame_refresh(F); ssdE_phase(F, 1); dilmerge_phase(F, 1); }
    SEAM(8);
    if (IN(9)) { frame_refresh(F);
        { pg8::Gemm g{ACT1, WallT + (size_t)NPROJ * DM, T, NGATE, DM, DM, DM}; pg8::GateOrder S; S.B.init(T, DM, F.G, F.bid);
          pg8::EpiBf16<1> E{BIG, NGATE}; pg8::gemm_phase(F.lds, g, S, E, F.wave); }
        VM_WAIT(); __syncthreads();
    }
    if (IN(10)) { frame_refresh(F);
        pg8::Gemm g{(const bf16*)F.out, (const bf16*)(ws + WS_WCATT), T, DM, YC, YC, YC}; pg8::StaticOrder S; S.init(g.M, g.N, F.G, F.bid);
        pg8::EpiBranchFused E{(bf16*)(ws + WS_MERGED), DM, __builtin_amdgcn_make_buffer_rsrc((void*)BIG, 0, T * NGATE * 2, 0x00020000), NGATE}; pg8::gemm_phase(F.lds, g, S, E, F.wave);
    }
    SEAM(10);
    if (IN(11)) { frame_refresh(F); pg8::Gemm g{(const bf16*)(ws + WS_MERGED), (const bf16*)(ws + WS_WOUTT), T, DM, DM, DM, DM}; pg8::StaticOrder S; S.init(g.M, g.N, F.G, F.bid);
        pg8::EpiResidNorm E{F.out, DM, F.in[I_X], (bf16*)(ws + WS_HB), F.in[I_NFFNW], (float*)(ws + WS_SSQ)}; pg8::gemm_phase(F.lds, g, S, E, F.wave); }
    SEAM(11);
    if (IN(12)) { frame_refresh(F); pg8::Gemm g{(const bf16*)(ws + WS_HB), (const bf16*)(ws + WS_WQT), T, PEER_Q, DM, DM, DM}; pg8::StaticOrder S; S.init(g.M, g.N, F.G, F.bid);
        pg8::EpiBf16RowScale E{BIG, PEER_Q, (const float*)(ws + WS_SSQ)}; pg8::gemm_phase(F.lds, g, S, E, F.wave); }
    SEAM(12);
    if (IN(13)) { frame_refresh(F); peer_phase(F); }
#undef IN
#undef SEAM
}

extern "C" void kernel_launch(void* const* d_in, const int* in_sizes, int n_in, void* d_out, int out_size, void* d_ws, size_t ws_size, hipStream_t stream) {
    static int grid = 0;
    if (grid == 0) {
        if (n_in != 26 || out_size != T * DM || ws_size < WS_END) { fprintf(stderr, "kernel_launch: unexpected shapes (n_in %d, out %d, ws %zu)\n", n_in, out_size, ws_size); grid = -1; return; }
        int dev = 0, cus = 0;
        if (hipGetDevice(&dev) != hipSuccess || hipDeviceGetAttribute(&cus, hipDeviceAttributeMultiprocessorCount, dev) != hipSuccess) { grid = -1; return; }
        if (hipFuncSetAttribute((const void*)mega_fwd, hipFuncAttributeMaxDynamicSharedMemorySize, LDS_BYTES) != hipSuccess) { grid = -1; return; }
        int per_cu = 0;
        (void)hipOccupancyMaxActiveBlocksPerMultiprocessor(&per_cu, (const void*)mega_fwd, NTHR, LDS_BYTES);
        (void)hipGetLastError();
        grid = cus;
    }
    if (grid < 0) return;
    (void)hipMemsetAsync((char*)d_ws + WS_CTL, 0, CTL_ZERO_BYTES, stream);
    Args a{};
    for (int i = 0; i < 26; ++i) a.in[i] = (const float*)d_in[i];
    a.positions = (const int*)d_in[2]; a.out = (float*)d_out; a.ws = (unsigned char*)d_ws;
#if MK_N_LAUNCHES == 1
    a.ph_lo = 0; a.ph_hi = N_PHASES;
    hipLaunchKernelGGL(mega_fwd, dim3(grid), dim3(NTHR), LDS_BYTES, stream, a);
#else
    for (int p = 0; p < N_PHASES; ++p) { a.ph_lo = p; a.ph_hi = p + 1; hipLaunchKernelGGL(mega_fwd, dim3(grid), dim3(NTHR), LDS_BYTES, stream, a); }
#endif
}
```

```cpp
#include <hip/hip_runtime.h>
#include <cstdio>
#include <cstdint>

#ifndef MK_N_LAUNCHES
#define MK_N_LAUNCHES 1
#endif

#define LAS __attribute__((address_space(3)))
#define GAS __attribute__((address_space(1)))
typedef unsigned short bf16;
typedef short bf16x8 __attribute__((ext_vector_type(8)));
typedef float f32x4 __attribute__((ext_vector_type(4)));
typedef float f32x2 __attribute__((ext_vector_type(2)));
typedef unsigned u32x4 __attribute__((ext_vector_type(4)));
typedef unsigned u32x2 __attribute__((ext_vector_type(2)));
typedef int i32x4 __attribute__((ext_vector_type(4)));
typedef int i32x8 __attribute__((ext_vector_type(8)));

constexpr int NB = 8, SEQ = 8192, DM = 1024, T = NB * SEQ;
constexpr int HB = 4, HT = HB * SEQ;
constexpr int NMEM = 256;
constexpr int NPROJ = 6144;
constexpr int PC_Z = 0, PC_X = 1024, PC_B = 2048, PC_C = 2560, PC_DQ = 3072, PC_DK = 3840, PC_DV = 4608, PC_MQ = 5376;
constexpr int W_IN_N = 9232, OFF_DT = 3072, OFF_AFTER_DT = 3088;
constexpr int NGATE = 3072;
constexpr int YC = 2048;
constexpr int PEER_H = 8, PEER_K = 16, PEER_NK = 128, PEER_Q = 2048;
constexpr float EPS = 1e-6f;

constexpr size_t MiB = 1u << 20;
constexpr size_t WS_CTL = 0, CTL_ZERO_BYTES = 65536;
constexpr size_t WS_WALLT = 1 * MiB;
constexpr size_t WS_WMKVT = 19 * MiB;
constexpr size_t WS_WCATT = 22 * MiB;
constexpr size_t WS_WOUTT = 26 * MiB;
constexpr size_t WS_WQT = 28 * MiB;
constexpr size_t WS_SUBK = 32 * MiB;
constexpr size_t WS_PD = 33 * MiB;
constexpr size_t WS_PU = 65 * MiB;
constexpr size_t WS_DT = 97 * MiB;
constexpr size_t WS_MEMN = 101 * MiB;
constexpr size_t WS_MKV = 105 * MiB;
constexpr size_t WS_ACT1 = 112 * MiB;
constexpr size_t WS_BIG = 240 * MiB;
constexpr size_t WS_LSE = 624 * MiB;
constexpr size_t WS_MVT = 628 * MiB;
constexpr size_t WS_DEC = 631 * MiB;
constexpr size_t WS_SST = 632 * MiB;
constexpr size_t WS_SIN = 760 * MiB;
constexpr size_t WS_ROPE = 824 * MiB;
constexpr size_t WS_SSQ = 828 * MiB;
constexpr size_t WS_HB = 632 * MiB;
constexpr size_t WS_U8 = 832 * MiB;
constexpr size_t WS_WG8 = 896 * MiB;
constexpr size_t WS_END = 899 * MiB;

constexpr int RING_BYTES = 131072;
constexpr int LDSCTL_OFF = 143360;
constexpr int LDS_BYTES = 147456;
constexpr int NWAVES = 8, NTHR = 512;

__device__ __forceinline__ int lane_id() { return (int)__builtin_amdgcn_mbcnt_hi(~0u, __builtin_amdgcn_mbcnt_lo(~0u, 0u)); }
__device__ __forceinline__ float bf2f(unsigned short b) { return __builtin_bit_cast(float, (unsigned)b << 16); }
__device__ __forceinline__ float bflo(unsigned w) { return __builtin_bit_cast(float, w << 16); }
__device__ __forceinline__ float bfhi(unsigned w) { return __builtin_bit_cast(float, w & 0xffff0000u); }
__device__ __forceinline__ unsigned f2bf(float f) { unsigned u = __builtin_bit_cast(unsigned, f); return (u + 0x7fffu + ((u >> 16) & 1u)) >> 16; }
__device__ __forceinline__ unsigned pk2(float lo, float hi) { return f2bf(lo) | (f2bf(hi) << 16); }
typedef float f32x16 __attribute__((ext_vector_type(16)));
typedef short s16x4 __attribute__((ext_vector_type(4)));
typedef __bf16 bf2_t __attribute__((ext_vector_type(2)));
__device__ __forceinline__ unsigned pkbf(float a, float b) { const f32x2 v = {a, b}; return __builtin_bit_cast(unsigned, __builtin_convertvector(v, bf2_t)); }
#define MFMA32(a, b, c) __builtin_amdgcn_mfma_f32_32x32x16_bf16((a), (b), (c), 0, 0, 0)
__device__ __forceinline__ float wave_sum(float v) {
#pragma unroll
    for (int o = 1; o < 64; o <<= 1) v += __shfl_xor(v, o);
    return v;
}
__device__ __forceinline__ float wave_max(float v) {
#pragma unroll
    for (int o = 1; o < 64; o <<= 1) v = fmaxf(v, __shfl_xor(v, o));
    return v;
}
__device__ __forceinline__ float sigmoidf_(float x) { return 1.0f / (1.0f + __expf(-x)); }
#define LDS_WAIT() asm volatile("s_waitcnt lgkmcnt(0)" ::: "memory")
#define VM_WAIT() asm volatile("s_waitcnt vmcnt(0)" ::: "memory")

#define XB_TMO      128
#define XB_XCNT(j)  (256  + 64 * (j))
#define XB_XSUB(j)  (1280 + 64 * (j))
#define XB_XGEN(j)  (2304 + 64 * (j))
#define XB_TOP      3328
#define XB_TOPGEN   3392
#define XCD_BAR_WORDS 3456
#define XB_SPIN_CAP (1u << 18)
__device__ __forceinline__ unsigned xb_ld(unsigned* p)              { return __hip_atomic_load(p, __ATOMIC_RELAXED, __HIP_MEMORY_SCOPE_AGENT); }
__device__ __forceinline__ unsigned xb_add(unsigned* p, unsigned v) { return __hip_atomic_fetch_add(p, v, __ATOMIC_RELAXED, __HIP_MEMORY_SCOPE_AGENT); }
__device__ __forceinline__ unsigned xb_xcc_id() { return (unsigned)__builtin_amdgcn_s_getreg((3 << 11) | 20) & 0xFu; }
#define XB_SPIN(cond, bar) do { unsigned _sp = 0; while (cond) { __builtin_amdgcn_s_sleep(1); \
    if ((++_sp & 255u) == 0u) { if (xb_ld(&(bar)[XB_TMO])) break; if (_sp > XB_SPIN_CAP) { atomicAdd(&(bar)[XB_TMO], 1u); break; } } } } while (0)
struct XcdBarrier { unsigned* bar; unsigned x; volatile LAS unsigned* st; int wave; };
__device__ __forceinline__ XcdBarrier xcd_barrier_post(unsigned* bar, volatile LAS unsigned* st, int wave) {
    XcdBarrier b; b.bar = bar; b.x = xb_xcc_id(); b.st = st; b.wave = wave;
    if (wave == 0 && lane_id() == 0) (void)xb_add(&bar[XB_XCNT(b.x)], 1u);
    return b;
}
__device__ __forceinline__ void xcd_barrier_complete(unsigned* bar, unsigned x, unsigned& nloc, unsigned& nx) {
    const unsigned G = gridDim.x * gridDim.y * gridDim.z;
    unsigned sum, cnt, mine, sp = 0u;
    for (;;) {
        sum = 0u; cnt = 0u; mine = 0u;
#pragma unroll
        for (unsigned j = 0; j < 16; ++j) { const unsigned c = xb_ld(&bar[XB_XCNT(j)]); sum += c; cnt += (c > 0u) ? 1u : 0u; mine = (j == x) ? c : mine; }
        if (sum == G) break;
        __builtin_amdgcn_s_sleep(1);
        if ((++sp & 255u) == 0u) { if (xb_ld(&bar[XB_TMO])) break; if (sp > XB_SPIN_CAP) { atomicAdd(&bar[XB_TMO], 1u); break; } }
    }
    nloc = mine > 0u ? mine : 1u; nx = cnt > 0u ? cnt : 1u;
}
__device__ __forceinline__ void xcd_barrier(const XcdBarrier& b) {
    asm volatile("s_waitcnt vmcnt(0)" ::: "memory");
    __syncthreads();
    if (b.wave == 0 && lane_id() == 0) {
        unsigned* bar = b.bar;
        __builtin_amdgcn_s_waitcnt(0);
        unsigned nloc = b.st[0], nx = b.st[1];
        if (nloc == 0u) { xcd_barrier_complete(bar, b.x, nloc, nx); b.st[0] = nloc; b.st[1] = nx; }
        const unsigned old = xb_add(&bar[XB_XSUB(b.x)], 1u);
        const unsigned gen = old / nloc;
        if (old + 1u == (gen + 1u) * nloc) {
            __builtin_amdgcn_fence(__ATOMIC_RELEASE, "agent");
            asm volatile("s_waitcnt vmcnt(0)" ::: "memory");
            const unsigned og = xb_add(&bar[XB_TOP], 1u);
            const unsigned tg = og / nx;
            if (og + 1u == (tg + 1u) * nx) xb_add(&bar[XB_TOPGEN], 1u);
            else XB_SPIN(xb_ld(&bar[XB_TOPGEN]) == tg, bar);
            __builtin_amdgcn_fence(__ATOMIC_ACQUIRE, "agent");
            xb_add(&bar[XB_XGEN(b.x)], 1u);
            asm volatile("s_waitcnt vmcnt(0)" ::: "memory");
        } else {
            XB_SPIN(xb_ld(&bar[XB_XGEN(b.x)]) == gen, bar);
            __builtin_amdgcn_fence(__ATOMIC_ACQUIRE, "agent");
            asm volatile("s_waitcnt vmcnt(0)" ::: "memory");
        }
    }
    __syncthreads();
}

namespace pg8 {
constexpr int BM = 256, BK = 64, HALF = 128, HTB = HALF * BK * 2, STAGE_BYTES = 8 * HTB, NXCD = 8, WGM = 8;
__host__ __device__ __forceinline__ int lds_byte(int r, int c) { const int st = (r >> 4) * 2 + (c >> 5), rr = r & 15, cc = c & 31, ob = rr * 64 + cc * 2; return st * 1024 + (ob ^ (((ob >> 9) & 1) << 5)); }
__host__ __device__ __forceinline__ void stage_rc(int b, int& R, int& C) { const int st = b / 1024, sb = b % 1024, swz = sb ^ (((sb >> 9) & 1) << 5); R = (st >> 1) * 16 + swz / 64; C = (st & 1) * 32 + (swz % 64) / 2; }
__host__ __device__ __forceinline__ int perm32(int rho) { const int n = rho >> 4, i = rho & 15; return 8 * (i >> 2) + 4 * n + (i & 3); }
struct Unit { int pm, pn; };
struct Gemm { const bf16* A; const bf16* Bt; int M, N, K, lda, ldb; };
struct StaticOrder {
    int nM, nN, nwg, G, c;
    __host__ __device__ void init(int M, int N, int G_, int c_) { nM = M / BM; nN = N / BM; nwg = nM * nN; G = G_; c = c_; }
    __host__ __device__ bool next(int i, Unit& u) const {
        const long L = (long)i * G + c; if (L >= nwg) return false;
        int wgid = (int)L; { const int q = nwg / NXCD, r = nwg % NXCD, xcd = wgid % NXCD, off = wgid / NXCD; wgid = (xcd < r ? xcd * (q + 1) : r * (q + 1) + (xcd - r) * q) + off; }
        const int nig = WGM * nN, gid = wgid / nig, fm = gid * WGM, gsz = (nM - fm) < WGM ? (nM - fm) : WGM;
        u.pm = fm + ((wgid % nig) % gsz); u.pn = (wgid % nig) / gsz; return true;
    }
    __device__ __forceinline__ void a_ready(const Unit&) const {}
    __device__ __forceinline__ void done(const Unit&) const {}
};
struct GateOrder {
    StaticOrder B;
    __device__ __forceinline__ bool next(int i, Unit& u) const { Unit t; if (!B.next(i / 3, t)) return false; u.pm = t.pm; u.pn = t.pn + 4 * (i % 3); return true; }
    __device__ __forceinline__ void a_ready(const Unit&) const {}
    __device__ __forceinline__ void done(const Unit&) const {}
};
__device__ __forceinline__ unsigned cvt_pk_bf16(float lo, float hi) { unsigned r; asm volatile("v_cvt_pk_bf16_f32 %0, %1, %2" : "=v"(r) : "v"(lo), "v"(hi)); return r; }

constexpr float WG_SCALE = 32.0f;
template <int ACT> struct EpiBf16 {
    static constexpr bool PERM = true, AFTER_DRAIN = false, HAS_MID = false;
    bf16* O; int ldc;
    __device__ __forceinline__ void operator()(const f32x4 (&acc)[2][2][4][2], const Unit& u, int wr, int wc, int fr, int fq) const {
        const int row0 = u.pm * BM + wr * 64 + fr; const int col0 = u.pn * BM + wc * 32 + 8 * fq;
#pragma unroll
        for (int ai = 0; ai < 2; ++ai)
#pragma unroll
            for (int m = 0; m < 4; ++m) { bf16* rowp = O + (size_t)(row0 + ai * HALF + m * 16) * ldc + col0;
#pragma unroll
                for (int bj = 0; bj < 2; ++bj) { f32x4 v0 = acc[ai][bj][m][0], v1 = acc[ai][bj][m][1];
                    if (ACT == 1) {
#pragma unroll
                        for (int j = 0; j < 4; ++j) { v0[j] = sigmoidf_(v0[j]); v1[j] = sigmoidf_(v1[j]); } }
                    if (ACT == 2) {
#pragma unroll
                        for (int j = 0; j < 4; ++j) { v0[j] = sigmoidf_(v0[j] * (1.0f / WG_SCALE)); v1[j] = sigmoidf_(v1[j] * (1.0f / WG_SCALE)); } }
                    u32x4 w; w.x = cvt_pk_bf16(v0[0], v0[1]); w.y = cvt_pk_bf16(v0[2], v0[3]); w.z = cvt_pk_bf16(v1[0], v1[1]); w.w = cvt_pk_bf16(v1[2], v1[3]);
                    *(u32x4*)(rowp + bj * HALF) = w; } }
    }
};
struct EpiResid {
    static constexpr bool PERM = false, AFTER_DRAIN = false, HAS_MID = false;
    float* C; int ldc; const float* R;
    __device__ __forceinline__ void operator()(const f32x4 (&acc)[2][2][4][2], const Unit& u, int wr, int wc, int fr, int fq) const {
        const int row0 = u.pm * BM + wr * 64 + fr, col0 = u.pn * BM + wc * 32 + 4 * fq;
#pragma unroll
        for (int ai = 0; ai < 2; ++ai)
#pragma unroll
            for (int m = 0; m < 4; ++m) { const size_t off = (size_t)(row0 + ai * HALF + m * 16) * ldc + col0;
#pragma unroll
                for (int bj = 0; bj < 2; ++bj)
#pragma unroll
                    for (int n = 0; n < 2; ++n) { const f32x4 r = *(const f32x4*)(R + off + bj * HALF + n * 16); *(f32x4*)(C + off + bj * HALF + n * 16) = acc[ai][bj][m][n] + r; } }
    }
};

struct EpiResidNorm {
    static constexpr bool PERM = false, AFTER_DRAIN = false, HAS_MID = false;
    float* C; int ldc; const float* R; bf16* Hb; const float* w; float* SSQ;
    __device__ __forceinline__ void operator()(const f32x4 (&acc)[2][2][4][2], const Unit& u, int wr, int wc, int fr, int fq) const {
        const int row0 = u.pm * BM + wr * 64 + fr, col0 = u.pn * BM + wc * 32 + 4 * fq;
        f32x4 wv[2][2];
#pragma unroll
        for (int bj = 0; bj < 2; ++bj)
#pragma unroll
            for (int n = 0; n < 2; ++n) wv[bj][n] = *(const f32x4*)(w + col0 + bj * HALF + n * 16);
#pragma unroll
        for (int ai = 0; ai < 2; ++ai)
#pragma unroll
            for (int m = 0; m < 4; ++m) { const int row = row0 + ai * HALF + m * 16; const size_t off = (size_t)row * ldc + col0; float ss = 0.f;
#pragma unroll
                for (int bj = 0; bj < 2; ++bj)
#pragma unroll
                    for (int n = 0; n < 2; ++n) { const f32x4 h = acc[ai][bj][m][n] + *(const f32x4*)(R + off + bj * HALF + n * 16); *(f32x4*)(C + off + bj * HALF + n * 16) = h;
                        ss += (h.x * h.x + h.y * h.y) + (h.z * h.z + h.w * h.w);
                        const u32x2 hb2 = {cvt_pk_bf16(h.x * wv[bj][n].x, h.y * wv[bj][n].y), cvt_pk_bf16(h.z * wv[bj][n].z, h.w * wv[bj][n].w)}; *(u32x2*)(Hb + off + bj * HALF + n * 16) = hb2; }
                ss += __shfl_xor(ss, 16); ss += __shfl_xor(ss, 32);
                if (fq == 0) atomicAdd(SSQ + row, ss); }
    }
};
struct EpiBf16RowScale {
    static constexpr bool PERM = true, AFTER_DRAIN = false, HAS_MID = false;
    bf16* O; int ldc; const float* SSQ;
    __device__ __forceinline__ void operator()(const f32x4 (&acc)[2][2][4][2], const Unit& u, int wr, int wc, int fr, int fq) const {
        const int row0 = u.pm * BM + wr * 64 + fr; const int col0 = u.pn * BM + wc * 32 + 8 * fq;
#pragma unroll
        for (int ai = 0; ai < 2; ++ai)
#pragma unroll
            for (int m = 0; m < 4; ++m) { const int row = row0 + ai * HALF + m * 16; bf16* rowp = O + (size_t)row * ldc + col0; const float rs = 1.0f / sqrtf(SSQ[row] * (1.f / DM) + EPS);
#pragma unroll
                for (int bj = 0; bj < 2; ++bj) { const f32x4 v0 = acc[ai][bj][m][0] * rs, v1 = acc[ai][bj][m][1] * rs;
                    u32x4 w; w.x = cvt_pk_bf16(v0[0], v0[1]); w.y = cvt_pk_bf16(v0[2], v0[3]); w.z = cvt_pk_bf16(v1[0], v1[1]); w.w = cvt_pk_bf16(v1[2], v1[3]);
                    *(u32x4*)(rowp + bj * HALF) = w; } }
    }
};

struct EpiBranchFused {
    static constexpr bool PERM = true, AFTER_DRAIN = false, HAS_MID = true;
    static constexpr int MID0 = 16, MID1 = 20;
    bf16* O; int ldc; __amdgpu_buffer_rsrc_t grs; int ldg;
    __device__ __forceinline__ void mid(f32x4 (&acc)[2][2][4][2], const Unit& u, int t, int wr, int wc, int fr, int fq) const {
        const unsigned voff = (unsigned)(((u.pm * BM + wr * 64 + fr) * ldg + u.pn * BM + wc * 32 + 8 * fq) * 2);
        const int ca = (t == MID0) ? 0 : 2048;
#pragma unroll
        for (int ai = 0; ai < 2; ++ai)
#pragma unroll
            for (int m = 0; m < 4; ++m) {
#pragma unroll
                for (int bj = 0; bj < 2; ++bj) { const int so = ((ai * HALF + m * 16) * ldg + bj * HALF) * 2 + ca;
                    const u32x4 ga = __builtin_amdgcn_raw_buffer_load_b128(grs, voff, so, 0), gb = __builtin_amdgcn_raw_buffer_load_b128(grs, voff, so + 2048, 0);
                    f32x4& v0 = acc[ai][bj][m][0]; f32x4& v1 = acc[ai][bj][m][1];
                    v0[0] *= bflo(ga.x) * __builtin_amdgcn_rcpf(fmaxf(bflo(gb.x), 1e-30f)); v0[1] *= bfhi(ga.x) * __builtin_amdgcn_rcpf(fmaxf(bfhi(gb.x), 1e-30f));
                    v0[2] *= bflo(ga.y) * __builtin_amdgcn_rcpf(fmaxf(bflo(gb.y), 1e-30f)); v0[3] *= bfhi(ga.y) * __builtin_amdgcn_rcpf(fmaxf(bfhi(gb.y), 1e-30f));
                    v1[0] *= bflo(ga.z) * __builtin_amdgcn_rcpf(fmaxf(bflo(gb.z), 1e-30f)); v1[1] *= bfhi(ga.z) * __builtin_amdgcn_rcpf(fmaxf(bfhi(gb.z), 1e-30f));
                    v1[2] *= bflo(ga.w) * __builtin_amdgcn_rcpf(fmaxf(bflo(gb.w), 1e-30f)); v1[3] *= bfhi(ga.w) * __builtin_amdgcn_rcpf(fmaxf(bfhi(gb.w), 1e-30f)); }
                __builtin_amdgcn_sched_barrier(0); }
    }
    __device__ __forceinline__ void operator()(const f32x4 (&acc)[2][2][4][2], const Unit& u, int wr, int wc, int fr, int fq) const {
        const int row0 = u.pm * BM + wr * 64 + fr; const int col0 = u.pn * BM + wc * 32 + 8 * fq;
        const unsigned voff = (unsigned)((row0 * ldg + col0) * 2);
#pragma unroll
        for (int ai = 0; ai < 2; ++ai)
#pragma unroll
            for (int m = 0; m < 4; ++m) { const size_t r = (size_t)(row0 + ai * HALF + m * 16); bf16* rowp = O + r * ldc + col0;
#pragma unroll
                for (int bj = 0; bj < 2; ++bj) { const f32x4 v0 = acc[ai][bj][m][0], v1 = acc[ai][bj][m][1];
                    const u32x4 g = __builtin_amdgcn_raw_buffer_load_b128(grs, voff, ((ai * HALF + m * 16) * ldg + bj * HALF) * 2 + 4096, 0);
                    u32x4 w; w.x = cvt_pk_bf16(v0[0] * bflo(g.x), v0[1] * bfhi(g.x)); w.y = cvt_pk_bf16(v0[2] * bflo(g.y), v0[3] * bfhi(g.y));
                    w.z = cvt_pk_bf16(v1[0] * bflo(g.z), v1[1] * bfhi(g.z)); w.w = cvt_pk_bf16(v1[2] * bflo(g.w), v1[3] * bfhi(g.w));
                    *(u32x4*)(rowp + bj * HALF) = w; } }
    }
};

template <bool F8 = false, class Epi, class Sched>
__device__ __forceinline__ void gemm_phase(LAS unsigned char* lds, const Gemm g, const Sched& S, const Epi& E, int wid) {
    int lane = lane_id(); asm volatile("" : "+v"(lane));
    const int tid = wid * 64 + lane, wr = wid >> 2, wc = wid & 3, fr = lane & 15, fq = lane >> 4;
    const int K = g.K, nt = K / BK;
    unsigned voffA[2], voffB[2];
#pragma unroll
    for (int i = 0; i < 2; ++i) { int R, C; stage_rc(tid * 16 + i * 8192, R, C); const int Rb = Epi::PERM ? ((R & ~31) + perm32(R & 31)) : R;
        voffA[i] = (unsigned)(R * g.lda + C) * 2u; voffB[i] = (unsigned)(Rb * g.ldb + C) * 2u; }
    const size_t kstep = (size_t)(BK * 2);
    const size_t hsA = (size_t)HALF * g.lda * 2, hsB = (size_t)HALF * g.ldb * 2;
    const size_t tsA = 2 * hsA, tsB = 2 * hsB;
    const unsigned ldsw = (unsigned)wid * 1024u;
    const int aoff = lds_byte(wr * 64 + fr, fq * 8), boff = lds_byte(wc * 32 + fr, fq * 8);
#define PG8_SA(b, h) (((b) * 2 + (h)) * HTB)
#define PG8_SB(b, h) ((4 + (b) * 2 + (h)) * HTB)
#define PG8_STAGE(bufoff, gbase, voff) do { _Pragma("unroll") for (int _i = 0; _i < 2; ++_i) \
        __builtin_amdgcn_global_load_lds((const unsigned*)((const char*)(gbase) + (voff)[_i]), (LAS unsigned*)(lds + (bufoff) + ldsw + _i * 8192), 16, 0, 0); } while (0)
#define PG8_LDA(dst, b, h) do { _Pragma("unroll") for (int m = 0; m < 4; ++m) _Pragma("unroll") for (int k = 0; k < 2; ++k) dst[m][k] = *(const LAS bf16x8*)(lds + PG8_SA(b, h) + aoff + m * 2048 + k * 1024); } while (0)
#define PG8_LDB(dst, b, h) do { _Pragma("unroll") for (int n = 0; n < 2; ++n) _Pragma("unroll") for (int k = 0; k < 2; ++k) dst[n][k] = *(const LAS bf16x8*)(lds + PG8_SB(b, h) + boff + n * 2048 + k * 1024); } while (0)
#define PG8_CAT(x, y) __builtin_shufflevector(__builtin_bit_cast(i32x4, x), __builtin_bit_cast(i32x4, y), 0, 1, 2, 3, 4, 5, 6, 7)
#define PG8_MMA(ai, bj, At, Bt) do { __builtin_amdgcn_s_setprio(1); _Pragma("unroll") for (int m = 0; m < 4; ++m) _Pragma("unroll") for (int n = 0; n < 2; ++n) { \
        if constexpr (F8) { asm volatile("v_mfma_f32_16x16x128_f8f6f4 %0, %1, %2, %0" : "+v"(acc[ai][bj][m][n]) : "v"(PG8_CAT(Bt[n][0], Bt[n][1])), "v"(PG8_CAT(At[m][0], At[m][1]))); } \
        else { _Pragma("unroll") for (int k = 0; k < 2; ++k) acc[ai][bj][m][n] = __builtin_amdgcn_mfma_f32_16x16x32_bf16(Bt[n][k], At[m][k], acc[ai][bj][m][n], 0, 0, 0); } } \
        __builtin_amdgcn_s_setprio(0); } while (0)
#define PG8_WAIT_V(n) asm volatile("s_waitcnt vmcnt(" #n ")" ::: "memory")
#define PG8_WAIT_L(n) asm volatile("s_waitcnt lgkmcnt(" #n ")" ::: "memory")
#define PG8_BAR __builtin_amdgcn_s_barrier()
#define PG8_SCHED __builtin_amdgcn_sched_barrier(0)
#define PG8_MFMA_SETTLE asm volatile("s_nop 15\n\ts_nop 15\n\ts_nop 7" ::: "memory")
    Unit cur, nxt; int ui = 0;
    if (!S.next(0, cur)) return;
    f32x4 acc[2][2][4][2];
#pragma unroll
    for (int a = 0; a < 2; ++a)
#pragma unroll
        for (int b = 0; b < 2; ++b)
#pragma unroll
            for (int m = 0; m < 4; ++m)
#pragma unroll
                for (int n = 0; n < 2; ++n) acc[a][b][m][n] = (f32x4){0.f, 0.f, 0.f, 0.f};
    bf16x8 At[4][2], B0[2][2], B1[2][2];
    const char* cA = (const char*)g.A + (size_t)cur.pm * tsA; const char* cB = (const char*)g.Bt + (size_t)cur.pn * tsB;
    S.a_ready(cur);
    PG8_STAGE(PG8_SB(0, 0), cB, voffB); PG8_STAGE(PG8_SB(0, 1), cB + hsB, voffB); PG8_STAGE(PG8_SA(0, 0), cA, voffA); PG8_STAGE(PG8_SA(0, 1), cA + hsA, voffA);
    if (wr == 1) PG8_BAR;
    PG8_WAIT_V(2); PG8_BAR;
    PG8_STAGE(PG8_SB(1, 0), cB + kstep, voffB); PG8_STAGE(PG8_SA(1, 0), cA + kstep, voffA); PG8_STAGE(PG8_SB(1, 1), cB + hsB + kstep, voffB);
    PG8_WAIT_V(6); PG8_BAR;
    for (;;) {
        const bool has_next = S.next(ui + 1, nxt);
        const char* nA = has_next ? (const char*)g.A + (size_t)nxt.pm * tsA : cA; const char* nB = has_next ? (const char*)g.Bt + (size_t)nxt.pn * tsB : cB;
#pragma clang loop unroll(disable)
        for (int t = 0; t < nt; t += 2) {
            const bool last = (t == nt - 2);
            const char* a1 = cA + (size_t)(t + 1) * kstep;
            const char* a2 = last ? nA : cA + (size_t)(t + 2) * kstep; const char* b2 = last ? nB : cB + (size_t)(t + 2) * kstep;
            const char* a3 = a2 + kstep; const char* b3 = b2 + kstep;
            if (last && has_next) S.a_ready(nxt);
            if constexpr (Epi::HAS_MID) { if (t == Epi::MID0 || t == Epi::MID1) { if constexpr (F8) PG8_MFMA_SETTLE; E.mid(acc, cur, t, wr, wc, fr, fq); } }
            PG8_LDB(B0, 0, 0); PG8_LDB(B1, 0, 1); PG8_SCHED; PG8_LDA(At, 0, 0); PG8_STAGE(PG8_SA(1, 1), a1 + hsA, voffA);
            PG8_WAIT_V(8); PG8_WAIT_L(0); PG8_BAR; PG8_MMA(0, 0, At, B0); PG8_MMA(0, 1, At, B1); PG8_BAR; PG8_SCHED;
            PG8_LDA(At, 0, 1); PG8_STAGE(PG8_SB(0, 0), b2, voffB); PG8_STAGE(PG8_SB(0, 1), b2 + hsB, voffB); PG8_STAGE(PG8_SA(0, 0), a2, voffA);
            PG8_WAIT_V(8); PG8_WAIT_L(0); PG8_BAR; PG8_MMA(1, 0, At, B0); PG8_MMA(1, 1, At, B1); PG8_BAR; PG8_SCHED;
            PG8_LDB(B0, 1, 0); PG8_LDB(B1, 1, 1); PG8_SCHED; PG8_LDA(At, 1, 0); PG8_STAGE(PG8_SA(0, 1), a2 + hsA, voffA);
            PG8_WAIT_V(8); PG8_WAIT_L(0); PG8_BAR; PG8_MMA(0, 0, At, B0); PG8_MMA(0, 1, At, B1); PG8_BAR; PG8_SCHED;
            PG8_LDA(At, 1, 1); PG8_STAGE(PG8_SB(1, 0), b3, voffB); PG8_STAGE(PG8_SB(1, 1), b3 + hsB, voffB); PG8_STAGE(PG8_SA(1, 0), a3, voffA);
            PG8_WAIT_V(8); PG8_WAIT_L(0); PG8_BAR; PG8_MMA(1, 0, At, B0); PG8_MMA(1, 1, At, B1); PG8_BAR; PG8_SCHED;
        }
        if constexpr (F8) PG8_MFMA_SETTLE;
        if (wr == 0) PG8_BAR;
        E(acc, cur, wr, wc, fr, fq); S.done(cur);
        if (!has_next) break;
#pragma unroll
        for (int a = 0; a < 2; ++a)
#pragma unroll
            for (int b = 0; b < 2; ++b)
#pragma unroll
                for (int m = 0; m < 4; ++m)
#pragma unroll
                    for (int n = 0; n < 2; ++n) acc[a][b][m][n] = (f32x4){0.f, 0.f, 0.f, 0.f};
        cur = nxt; cA = nA; cB = nB; ++ui;
        if (wr == 1) PG8_BAR;
    }
    PG8_WAIT_V(0);
    PG8_BAR;
#undef PG8_SA
#undef PG8_SB
#undef PG8_STAGE
#undef PG8_LDA
#undef PG8_LDB
#undef PG8_MMA
#undef PG8_CAT
#undef PG8_WAIT_V
#undef PG8_WAIT_L
#undef PG8_BAR
#undef PG8_SCHED
#undef PG8_MFMA_SETTLE
}
}

struct Args {
    const float* in[26]; const int* positions; float* out; unsigned char* ws; int ph_lo, ph_hi; int pad0, pad1;
};
struct Frame {
    LAS unsigned char* lds;
    int tid, lane, wave, G, bid;
    const float* const* in; const int* positions; float* out; unsigned char* ws;
};
__device__ __forceinline__ void frame_refresh(Frame& F) { int l = lane_id(); asm volatile("" : "+v"(l)); F.lane = l; F.tid = F.wave * 64 + l; }
enum { I_X = 0, I_MEM = 1, I_POS = 2, I_NMIXW = 3, I_WIN = 4, I_CONVW = 5, I_CONVB = 6, I_DTB = 7, I_ALOG = 8, I_SSDD = 9, I_SSDNW = 10, I_DQNW = 11, I_DKNW = 12, I_MEMNW = 13,
       I_WMKV = 14, I_MQNW = 15, I_MKNW = 16, I_WSSD = 17, I_WDIL = 18, I_WMEMBR = 19, I_WOUT = 20, I_NFFNW = 21, I_WQ = 22, I_SUBK = 23, I_PD = 24, I_PU = 25 };

constexpr float PD_SCALE = 64.0f, PU_SCALE = 8.0f;
__device__ __forceinline__ unsigned pk4_fp8(f32x4 v, float sc) {
    const float a = fminf(fmaxf(v.x * sc, -448.f), 448.f), b = fminf(fmaxf(v.y * sc, -448.f), 448.f), c = fminf(fmaxf(v.z * sc, -448.f), 448.f), d = fminf(fmaxf(v.w * sc, -448.f), 448.f);
    unsigned p = __builtin_amdgcn_cvt_pk_fp8_f32(a, b, 0, false); return __builtin_amdgcn_cvt_pk_fp8_f32(c, d, p, true);
}
__device__ __forceinline__ void p0_transpose_item(const float* W, int ldw, int src_col0, bf16* WT, int ldt, int dst_row0, int dst_col0, int nblk, LAS float* scr, int item, int lane) {
    const int kb = item / nblk, nb = item % nblk, k0 = 64 * kb, n0 = 32 * nb;
#pragma unroll 8
    for (int i = 0; i < 32; ++i) { const int kk = 2 * i + (lane >> 5); scr[kk * 33 + (lane & 31)] = W[(size_t)(k0 + kk) * ldw + src_col0 + n0 + (lane & 31)]; }
    LDS_WAIT(); asm volatile("" ::: "memory");
    const int c = lane & 7;
#pragma unroll
    for (int j = 0; j < 4; ++j) { const int n = (lane >> 3) + 8 * j; const LAS float* s = scr + (8 * c) * 33 + n;
        u32x4 o; o.x = pk2(s[0 * 33], s[1 * 33]); o.y = pk2(s[2 * 33], s[3 * 33]); o.z = pk2(s[4 * 33], s[5 * 33]); o.w = pk2(s[6 * 33], s[7 * 33]);
        *(u32x4*)(WT + (size_t)(dst_row0 + n0 + n) * ldt + dst_col0 + k0 + 8 * c) = o; }
    LDS_WAIT(); asm volatile("" ::: "memory");
}
__device__ __forceinline__ void p0_transpose_item_fp8(const float* W, int ldw, int src_col0, unsigned char* WT8, int ldt, int dst_row0, int nblk, float sc, LAS float* scr, int item, int lane) {
    const int kb = item / nblk, nb = item % nblk, n0 = 32 * nb;
#pragma unroll 1
    for (int h = 0; h < 2; ++h) { const int k0 = 128 * kb + 64 * h;
#pragma unroll 8
        for (int i = 0; i < 32; ++i) { const int kk = 2 * i + (lane >> 5); scr[kk * 33 + (lane & 31)] = W[(size_t)(k0 + kk) * ldw + src_col0 + n0 + (lane & 31)]; }
        LDS_WAIT(); asm volatile("" ::: "memory");
        const int c = lane & 7;
#pragma unroll
        for (int j = 0; j < 4; ++j) { const int n = (lane >> 3) + 8 * j; const LAS float* s = scr + (8 * c) * 33 + n;
            const f32x4 a = {s[0 * 33], s[1 * 33], s[2 * 33], s[3 * 33]}, b = {s[4 * 33], s[5 * 33], s[6 * 33], s[7 * 33]};
            const u32x2 o = {pk4_fp8(a, sc), pk4_fp8(b, sc)};
            *(u32x2*)(WT8 + (size_t)(dst_row0 + n0 + n) * ldt + k0 + 8 * c) = o; }
        LDS_WAIT(); asm volatile("" ::: "memory"); }
}
__device__ __forceinline__ void rms_row_to_bf16(const float* xrow, const float* w, bf16* orow, int lane, f32x4 (&v)[4]) {
    const f32x4* xr = (const f32x4*)xrow + lane; const f32x4* wr = (const f32x4*)w + lane;
    float s = 0.f;
#pragma unroll
    for (int j = 0; j < 4; ++j) { v[j] = xr[64 * j]; s += (v[j].x * v[j].x + v[j].y * v[j].y) + (v[j].z * v[j].z + v[j].w * v[j].w); }
    const float rstd = 1.0f / sqrtf(wave_sum(s) * (1.f / DM) + EPS);
    unsigned long long* o8 = (unsigned long long*)orow + lane;
#pragma unroll
    for (int j = 0; j < 4; ++j) { const f32x4 ww = wr[64 * j]; v[j] = v[j] * rstd * ww;
        o8[64 * j] = (unsigned long long)pk2(v[j].x, v[j].y) | ((unsigned long long)pk2(v[j].z, v[j].w) << 32); }
}
__device__ __forceinline__ void rms_rows_finish(f32x4 (&v)[4], const float* w, bf16* orow, unsigned char* orow8, int lane) {
    const f32x4* wr = (const f32x4*)w + lane;
    float s = 0.f;
#pragma unroll
    for (int j = 0; j < 4; ++j) s += (v[j].x * v[j].x + v[j].y * v[j].y) + (v[j].z * v[j].z + v[j].w * v[j].w);
    const float rstd = 1.0f / sqrtf(wave_sum(s) * (1.f / DM) + EPS);
    unsigned long long* o8 = (unsigned long long*)orow + lane; unsigned* o4 = (unsigned*)orow8 + lane;
#pragma unroll
    for (int j = 0; j < 4; ++j) { const f32x4 ww = wr[64 * j]; v[j] = v[j] * rstd * ww;
        o8[64 * j] = (unsigned long long)pk2(v[j].x, v[j].y) | ((unsigned long long)pk2(v[j].z, v[j].w) << 32); o4[64 * j] = pk4_fp8(v[j], 1.0f); }
}
__device__ __forceinline__ void cvt_f32_bf16_stream(const float* src, bf16* dst, size_t n, size_t gtid, size_t gthreads) {
    for (size_t i = gtid * 8; i < n; i += gthreads * 8) { const f32x4 a = *(const f32x4*)(src + i), b = *(const f32x4*)(src + i + 4);
        u32x4 o; o.x = pk2(a.x, a.y); o.y = pk2(a.z, a.w); o.z = pk2(b.x, b.y); o.w = pk2(b.z, b.w); *(u32x4*)(dst + i) = o; }
}
__device__ __forceinline__ void cvt_f32_fp8_sliced(const float* src, unsigned char* dst, float sc, size_t gtid, size_t gthreads) {
    for (size_t i = gtid * 16; i < (size_t)16384 * 1024; i += gthreads * 16) { const f32x4 a = *(const f32x4*)(src + i), b = *(const f32x4*)(src + i + 4), c = *(const f32x4*)(src + i + 8), d = *(const f32x4*)(src + i + 12);
        const size_t e = i >> 10, dd = i & 1023;
        const u32x4 o = {pk4_fp8(a, sc), pk4_fp8(b, sc), pk4_fp8(c, sc), pk4_fp8(d, sc)}; *(u32x4*)(dst + ((((dd >> 7) * 16384 + e) << 7) + (dd & 127))) = o; }
}
__device__ __forceinline__ void p0_prologue(Frame& F) {
    LAS float* scr = (LAS float*)(F.lds + F.wave * 8448);
    LAS float* wdt = (LAS float*)(F.lds + 8 * 8448);
    const int gw = F.bid * NWAVES + F.wave, NGW = F.G * NWAVES;
    unsigned char* ws = F.ws;
    for (int i = F.tid; i < 1024 * 16; i += NTHR) { const int k = i >> 4, c = i & 15, l = (k & 255) >> 2, e = k & 3, j = k >> 8, q = c >> 2;
        wdt[((((j * 4 + e) * 4 + q) * 64 + l) << 2) + (c & 3)] = F.in[I_WIN][(size_t)k * W_IN_N + OFF_DT + c]; }
    __syncthreads();
    constexpr int IT_A = 16 * 96, IT_B = 16 * 96, IT_G = 8 * 96, IT_MKV = 16 * 48, IT_SSD = 16 * 32, IT_DIL = 4 * 32, IT_MBR = 12 * 32, IT_OUT = 16 * 32, IT_WQ = 16 * 64;
    constexpr int NITEMS = IT_A + IT_B + IT_G + IT_MKV + IT_SSD + IT_DIL + IT_MBR + IT_OUT + IT_WQ;
    bf16* WallT = (bf16*)(ws + WS_WALLT);
    for (int it = gw; it < NITEMS; it += NGW) {
        int r = it;
        if (r < IT_A) { p0_transpose_item(F.in[I_WIN], W_IN_N, 0, WallT, DM, 0, 0, 96, scr, r, F.lane); continue; } r -= IT_A;
        if (r < IT_B) { p0_transpose_item(F.in[I_WIN], W_IN_N, OFF_AFTER_DT, WallT, DM, 3072, 0, 96, scr, r, F.lane); continue; } r -= IT_B;
        if (r < IT_G) { p0_transpose_item_fp8(F.in[I_WIN], W_IN_N, OFF_AFTER_DT + 3072, ws + WS_WG8, DM, 0, 96, pg8::WG_SCALE, scr, r, F.lane); continue; } r -= IT_G;
        if (r < IT_MKV) { p0_transpose_item(F.in[I_WMKV], 1536, 0, (bf16*)(ws + WS_WMKVT), DM, 0, 0, 48, scr, r, F.lane); continue; } r -= IT_MKV;
        if (r < IT_SSD) { p0_transpose_item(F.in[I_WSSD], DM, 0, (bf16*)(ws + WS_WCATT), YC, 0, 0, 32, scr, r, F.lane); continue; } r -= IT_SSD;
        if (r < IT_DIL) { p0_transpose_item(F.in[I_WDIL], DM, 0, (bf16*)(ws + WS_WCATT), YC, 0, 1024, 32, scr, r, F.lane); continue; } r -= IT_DIL;
        if (r < IT_MBR) { p0_transpose_item(F.in[I_WMEMBR], DM, 0, (bf16*)(ws + WS_WCATT), YC, 0, 1280, 32, scr, r, F.lane); continue; } r -= IT_MBR;
        if (r < IT_OUT) { p0_transpose_item(F.in[I_WOUT], DM, 0, (bf16*)(ws + WS_WOUTT), DM, 0, 0, 32, scr, r, F.lane); continue; } r -= IT_OUT;
        p0_transpose_item(F.in[I_WQ], PEER_Q, 0, (bf16*)(ws + WS_WQT), DM, 0, 0, 64, scr, r, F.lane);
    }
    const size_t gtid = (size_t)F.bid * NTHR + F.tid, gth = (size_t)F.G * NTHR;
    cvt_f32_bf16_stream(F.in[I_SUBK], (bf16*)(ws + WS_SUBK), (size_t)8 * 2 * 128 * 128, gtid, gth);
    cvt_f32_fp8_sliced(F.in[I_PD], ws + WS_PD, PD_SCALE, gtid, gth);
    cvt_f32_fp8_sliced(F.in[I_PU], ws + WS_PU, PU_SCALE, gtid, gth);
    for (int m = gw; m < NB * NMEM; m += NGW) { f32x4 v[4]; rms_row_to_bf16(F.in[I_MEM] + (size_t)m * DM, F.in[I_MEMNW], (bf16*)(ws + WS_MEMN) + (size_t)m * DM, F.lane, v); }
    for (size_t i = gtid; i < (size_t)T; i += gth) ((float*)(ws + WS_SSQ))[i] = 0.f;
    { float* RT = (float*)(ws + WS_ROPE);
      for (size_t i = gtid; i < (size_t)T * 8; i += gth) { const int tok = (int)(i >> 3), a = (int)(i & 7);
          const float inv = __expf(-logf(500000.0f) * (2.0f / 16.0f) * (float)a);
          const double rev = (double)((float)F.positions[tok] * inv) * 0.15915494309189535; const float fr = (float)(rev - floor(rev));
          RT[(size_t)tok * 16 + a] = __builtin_amdgcn_cosf(fr); RT[(size_t)tok * 16 + 8 + a] = __builtin_amdgcn_sinf(fr); } }
    float* DTp = (float*)(ws + WS_DT);
    const int lane = F.lane;
    const int myj = ((lane >> 5) & 1) * 8 + ((lane >> 4) & 1) * 4 + ((lane >> 3) & 1) * 2 + ((lane >> 2) & 1);
    const float dtb = F.in[I_DTB][myj];
    f32x4 na[4], nb[4];
    { const int m0 = 2 * gw < T ? 2 * gw : 0; const f32x4* xa = (const f32x4*)(F.in[I_X] + (size_t)m0 * DM) + lane; const f32x4* xb = (const f32x4*)(F.in[I_X] + (size_t)(m0 + 1) * DM) + lane;
#pragma unroll
      for (int j = 0; j < 4; ++j) { na[j] = xa[64 * j]; nb[j] = xb[64 * j]; } }
    for (int m = 2 * gw; m < T; m += 2 * NGW) {
        f32x4 va[4], vb[4];
#pragma unroll
        for (int j = 0; j < 4; ++j) { va[j] = na[j]; vb[j] = nb[j]; }
        { const int mn = (m + 2 * NGW < T) ? m + 2 * NGW : m; const f32x4* xa = (const f32x4*)(F.in[I_X] + (size_t)mn * DM) + lane; const f32x4* xb = (const f32x4*)(F.in[I_X] + (size_t)(mn + 1) * DM) + lane;
#pragma unroll
          for (int j = 0; j < 4; ++j) { na[j] = xa[64 * j]; nb[j] = xb[64 * j]; } }
        rms_rows_finish(va, F.in[I_NMIXW], (bf16*)(ws + WS_ACT1) + (size_t)m * DM, ws + WS_U8 + (size_t)m * DM, lane);
        rms_rows_finish(vb, F.in[I_NMIXW], (bf16*)(ws + WS_ACT1) + (size_t)(m + 1) * DM, ws + WS_U8 + (size_t)(m + 1) * DM, lane);
        float da[16], db[16];
#pragma unroll
        for (int j = 0; j < 16; ++j) { da[j] = 0.f; db[j] = 0.f; }
#pragma unroll
        for (int j = 0; j < 4; ++j)
#pragma unroll
            for (int e = 0; e < 4; ++e) { const float ua = va[j][e], ub = vb[j][e];
#pragma unroll
                for (int q = 0; q < 4; ++q) { const f32x4 w4 = *(const LAS f32x4*)(wdt + ((((j * 4 + e) * 4 + q) * 64 + lane) << 2));
                    da[4 * q + 0] += ua * w4.x; da[4 * q + 1] += ua * w4.y; da[4 * q + 2] += ua * w4.z; da[4 * q + 3] += ua * w4.w;
                    db[4 * q + 0] += ub * w4.x; db[4 * q + 1] += ub * w4.y; db[4 * q + 2] += ub * w4.z; db[4 * q + 3] += ub * w4.w; }
                __builtin_amdgcn_sched_barrier(0); }
        float ra, rb;
        { float r8a[8], r8b[8], r4a[4], r4b[4], r2a[2], r2b[2];
          { const bool up = (lane & 32) != 0;
#pragma unroll
            for (int k = 0; k < 8; ++k) { r8a[k] = (up ? da[k + 8] : da[k]) + __shfl_xor(up ? da[k] : da[k + 8], 32); r8b[k] = (up ? db[k + 8] : db[k]) + __shfl_xor(up ? db[k] : db[k + 8], 32); } }
          { const bool up = (lane & 16) != 0;
#pragma unroll
            for (int k = 0; k < 4; ++k) { r4a[k] = (up ? r8a[k + 4] : r8a[k]) + __shfl_xor(up ? r8a[k] : r8a[k + 4], 16); r4b[k] = (up ? r8b[k + 4] : r8b[k]) + __shfl_xor(up ? r8b[k] : r8b[k + 4], 16); } }
          { const bool up = (lane & 8) != 0;
#pragma unroll
            for (int k = 0; k < 2; ++k) { r2a[k] = (up ? r4a[k + 2] : r4a[k]) + __shfl_xor(up ? r4a[k] : r4a[k + 2], 8); r2b[k] = (up ? r4b[k + 2] : r4b[k]) + __shfl_xor(up ? r4b[k] : r4b[k + 2], 8); } }
          { const bool up = (lane & 4) != 0; ra = (up ? r2a[1] : r2a[0]) + __shfl_xor(up ? r2a[0] : r2a[1], 4); rb = (up ? r2b[1] : r2b[0]) + __shfl_xor(up ? r2b[0] : r2b[1], 4); }
          ra += __shfl_xor(ra, 2); ra += __shfl_xor(ra, 1); rb += __shfl_xor(rb, 2); rb += __shfl_xor(rb, 1); }
        if ((lane & 3) == 0) { const float xa = ra + dtb, xb = rb + dtb;
            DTp[(size_t)m * 16 + myj] = (xa > 20.f) ? xa : log1pf(__expf(xa)); DTp[(size_t)(m + 1) * 16 + myj] = (xb > 20.f) ? xb : log1pf(__expf(xb)); }
    }
}

__device__ __forceinline__ void norm192_inplace(bf16* p, const float (&w)[4], int lane) {
    u32x2 v = {0u, 0u};
    if (lane < 48) v = *(const u32x2*)(p + 4 * lane);
    float x0 = bflo(v.x), x1 = bfhi(v.x), x2 = bflo(v.y), x3 = bfhi(v.y);
    const float ss = wave_sum((x0 * x0 + x1 * x1) + (x2 * x2 + x3 * x3));
    const float rs = 1.0f / sqrtf(ss * (1.f / 192.f) + EPS);
    if (lane < 48) { const u32x2 o = {pkbf(x0 * rs * w[0], x1 * rs * w[1]), pkbf(x2 * rs * w[2], x3 * rs * w[3])}; *(u32x2*)(p + 4 * lane) = o; }
}
__device__ __forceinline__ void mknorm_phase(Frame& F) {
    const int gw = F.bid * NWAVES + F.wave, NGW = F.G * NWAVES, lane = F.lane;
    float wmk[4];
#pragma unroll
    for (int j = 0; j < 4; ++j) wmk[j] = F.in[I_MKNW][(4 * lane + j) % 192];
    bf16* MK = (bf16*)(F.ws + WS_MKV);
    for (int r = gw; r < NB * NMEM * 4; r += NGW) norm192_inplace(MK + (size_t)(r >> 2) * 1536 + (r & 3) * 192, wmk, lane);
}

constexpr int SC_ST = 272, SX_ST = 528;
__device__ __forceinline__ float bfsel(const u32x4& v, int j) { const unsigned w = v[j >> 1]; return (j & 1) ? bfhi(w) : bflo(w); }
__device__ __forceinline__ void conv_task(const bf16* P, size_t rowb, int t0, int pcol, const float* cw, const float* cb, int ccol, LAS unsigned char* dst, int stride, const LAS float* scale) {
    float w[4][8], bs[8];
#pragma unroll
    for (int k = 0; k < 4; ++k) { const f32x4 a = *(const f32x4*)(cw + k * 2048 + ccol), b = *(const f32x4*)(cw + k * 2048 + ccol + 4);
        w[k][0] = a.x; w[k][1] = a.y; w[k][2] = a.z; w[k][3] = a.w; w[k][4] = b.x; w[k][5] = b.y; w[k][6] = b.z; w[k][7] = b.w; }
    { const f32x4 a = *(const f32x4*)(cb + ccol), b = *(const f32x4*)(cb + ccol + 4); bs[0] = a.x; bs[1] = a.y; bs[2] = a.z; bs[3] = a.w; bs[4] = b.x; bs[5] = b.y; bs[6] = b.z; bs[7] = b.w; }
    const bf16* src = P + (rowb + t0) * NPROJ + pcol;
    u32x4 rw[19];
#pragma unroll
    for (int i = 0; i < 3; ++i) rw[i] = (u32x4){0u, 0u, 0u, 0u};
    if (t0 > 0) {
#pragma unroll
        for (int i = 0; i < 3; ++i) rw[i] = *(const u32x4*)(src + (ptrdiff_t)(i - 3) * NPROJ); }
#pragma unroll
    for (int i = 0; i < 16; ++i) rw[3 + i] = *(const u32x4*)(src + (size_t)i * NPROJ);
#pragma unroll
    for (int i = 0; i < 16; ++i) {
        float o[8];
#pragma unroll
        for (int j = 0; j < 8; ++j) { float a = bs[j] + w[0][j] * bfsel(rw[i], j) + w[1][j] * bfsel(rw[i + 1], j) + w[2][j] * bfsel(rw[i + 2], j) + w[3][j] * bfsel(rw[i + 3], j); o[j] = a * sigmoidf_(a); }
        if (scale) { const float sv = scale[i];
#pragma unroll
            for (int j = 0; j < 8; ++j) o[j] *= sv; }
        const u32x4 r = {pkbf(o[0], o[1]), pkbf(o[2], o[3]), pkbf(o[4], o[5]), pkbf(o[6], o[7])};
        *(LAS u32x4*)(dst + i * stride) = r;
    }
}
__device__ __forceinline__ float ssd_scan(Frame& F, const float* DTp, size_t tok0, int g, LAS float* sAc, LAS float* sDt) {
    float total = 0.f;
    if (F.wave < 4) {
        const int head = 4 * g + F.wave, lane = F.lane;
        const float A = -__expf(F.in[I_ALOG][head]);
        const float d0 = DTp[(tok0 + 2 * lane) * 16 + head], d1 = DTp[(tok0 + 2 * lane + 1) * 16 + head];
        const float a0 = d0 * A, a1 = d1 * A;
        float sc = a0 + a1;
#pragma unroll
        for (int o = 1; o < 64; o <<= 1) { const float v = __shfl_up(sc, o); if (lane >= o) sc += v; }
        sAc[F.wave * 128 + 2 * lane] = sc - a1; sAc[F.wave * 128 + 2 * lane + 1] = sc;
        sDt[F.wave * 128 + 2 * lane] = d0; sDt[F.wave * 128 + 2 * lane + 1] = d1;
        total = __shfl(sc, 63);
    }
    return total;
}
__device__ __forceinline__ bf16x8 tr_pair(unsigned a_lo, unsigned a_hi) {
    s16x4 lo, hi;
    asm volatile("ds_read_b64_tr_b16 %0, %2\n\tds_read_b64_tr_b16 %1, %3\n\ts_waitcnt lgkmcnt(0)" : "=&v"(lo), "=&v"(hi) : "v"(a_lo), "v"(a_hi) : "memory");
    const bf16x8 r = {lo[0], lo[1], lo[2], lo[3], hi[0], hi[1], hi[2], hi[3]}; return r;
}

__device__ __forceinline__ void ssdC_phase(Frame& F, int half) {
    const bf16* P = (const bf16*)(F.ws + WS_BIG);
    const float* DTp = (const float*)(F.ws + WS_DT);
    bf16* SST = (bf16*)(F.ws + WS_SST); float* DEC = (float*)(F.ws + WS_DEC);
    LAS unsigned char* sX = F.lds; LAS unsigned char* sB = F.lds + 128 * SX_ST;
    LAS float* sAc = (LAS float*)(F.lds + 128 * SX_ST + 128 * SC_ST); LAS float* sDt = sAc + 512; LAS float* sW = sDt + 512;
    const int wave = F.wave;
    for (int unit = F.bid; unit < HB * 64 * 4; unit += F.G) {
        int tid = F.tid; asm volatile("" : "+v"(tid));
        const int lane = tid & 63, ql = lane & 31, h = lane >> 5, tq = (lane & 15) >> 2, tp = lane & 3, tblk = (lane >> 4) & 1;
        const int bl = unit >> 8, c = (unit >> 2) & 63, g = unit & 3;
        const size_t rowb = (size_t)bl * SEQ, tok0 = (size_t)half * HT + rowb + c * 128;
        __syncthreads();
        const float total = ssd_scan(F, DTp, tok0, g, sAc, sDt);
        if (wave < 4) { sW[wave * 128 + 2 * lane] = __expf(total - sAc[wave * 128 + 2 * lane]) * sDt[wave * 128 + 2 * lane];
            sW[wave * 128 + 2 * lane + 1] = __expf(total - sAc[wave * 128 + 2 * lane + 1]) * sDt[wave * 128 + 2 * lane + 1];
            if (lane == 0) DEC[((size_t)bl * 64 + c) * 16 + 4 * g + wave] = __expf(total); }
        __syncthreads();
        if (tid < 384) {
            int ch, strip, ccol, stride; LAS unsigned char* dst; const LAS float* scl = nullptr;
            if (tid < 256) { ch = tid & 31; strip = tid >> 5; ccol = g * 256 + 8 * ch; stride = SX_ST; dst = sX + (strip * 16) * SX_ST + ch * 16; scl = sW + (ch >> 3) * 128 + strip * 16; }
            else { const int u = tid - 256; ch = u & 15; strip = u >> 4; ccol = 1024 + g * 128 + 8 * ch; stride = SC_ST; dst = sB + (strip * 16) * SC_ST + ch * 16; }
            conv_task(P, rowb, c * 128 + strip * 16, PC_X + ccol, F.in[I_CONVW], F.in[I_CONVB], ccol, dst, stride, scl);
        }
        __syncthreads();
        const int r = wave >> 1, pt = wave & 1;
        f32x16 acc[4];
#pragma unroll
        for (int nt = 0; nt < 4; ++nt)
#pragma unroll
            for (int e = 0; e < 16; ++e) acc[nt][e] = 0.f;
        const unsigned xa = (unsigned)(size_t)sX + (unsigned)((8 * h + tq) * SX_ST + (r * 64 + 32 * pt + 16 * tblk + 4 * tp) * 2);
        const unsigned ba = (unsigned)(size_t)sB + (unsigned)((8 * h + tq) * SC_ST + (16 * tblk + 4 * tp) * 2);
#pragma unroll
        for (int ks = 0; ks < 8; ++ks) {
            const bf16x8 af = tr_pair(xa + ks * 16 * SX_ST, xa + ks * 16 * SX_ST + 4 * SX_ST);
            bf16x8 bfr[4];
#pragma unroll
            for (int nt = 0; nt < 4; ++nt) bfr[nt] = tr_pair(ba + ks * 16 * SC_ST + nt * 64, ba + ks * 16 * SC_ST + 4 * SC_ST + nt * 64);
            __builtin_amdgcn_sched_barrier(0);
#pragma unroll
            for (int nt = 0; nt < 4; ++nt) acc[nt] = MFMA32(af, bfr[nt], acc[nt]);
        }
        bf16* out = SST + (((size_t)bl * 64 + c) * 16 + 4 * g + r) * 8192;
#pragma unroll
        for (int nt = 0; nt < 4; ++nt)
#pragma unroll
            for (int e = 0; e < 16; ++e) out[(32 * pt + (e & 3) + 8 * (e >> 2) + 4 * h) * 128 + 32 * nt + ql] = (bf16)(pkbf(acc[nt][e], 0.f) & 0xffffu);
    }
}

__device__ __forceinline__ void ssdD_phase(Frame& F) {
    const bf16* SST = (const bf16*)(F.ws + WS_SST); const float* DEC = (const float*)(F.ws + WS_DEC);
    bf16* SIN = (bf16*)(F.ws + WS_SIN);
    const size_t gtid = (size_t)F.bid * NTHR + F.tid, gth = (size_t)F.G * NTHR;
    for (size_t it = gtid; it < (size_t)HB * 16 * 2048; it += gth) {
        const int bl = (int)(it >> 15), head = (int)(it >> 11) & 15, e4 = (int)(it & 2047) * 4;
        f32x4 st = {0.f, 0.f, 0.f, 0.f};
#pragma unroll 8
        for (int c = 0; c < 64; ++c) {
            const size_t idx = (((size_t)bl * 64 + c) * 16 + head);
            const u32x2 o = {pkbf(st.x, st.y), pkbf(st.z, st.w)};
            *(u32x2*)(SIN + idx * 8192 + e4) = o;
            const u32x2 sw = *(const u32x2*)(SST + idx * 8192 + e4); const f32x4 sl = {bflo(sw.x), bfhi(sw.x), bflo(sw.y), bfhi(sw.y)}; const float d = DEC[idx];
            st = st * d + sl;
        }
    }
}

__device__ __forceinline__ void ssdE_phase(Frame& F, int half) {
    const bf16* P = (const bf16*)(F.ws + WS_BIG);
    const float* DTp = (const float*)(F.ws + WS_DT);
    const bf16* SIN = (const bf16*)(F.ws + WS_SIN);
    bf16* Y = (bf16*)F.out;
    LAS unsigned char* sX = F.lds; LAS unsigned char* sB = F.lds + 128 * SX_ST; LAS unsigned char* sC = sB + 128 * SC_ST;
    LAS float* sAc = (LAS float*)(sC + 128 * SC_ST); LAS float* sDt = sAc + 512; LAS float* sSS = sDt + 512;
    const int wave = F.wave;
    const int st = wave & 3, hp = wave >> 2;
    for (int unit = F.bid; unit < HB * 64 * 4; unit += F.G) {
        int tid = F.tid; asm volatile("" : "+v"(tid));
        const int lane = tid & 63, ql = lane & 31, h = lane >> 5, tq = (lane & 15) >> 2, tp = lane & 3, tblk = (lane >> 4) & 1;
        const int bl = unit >> 8, c = (unit >> 2) & 63, g = unit & 3;
        const size_t rowb = (size_t)bl * SEQ, tok0 = (size_t)half * HT + rowb + c * 128;
        __syncthreads();
        (void)ssd_scan(F, DTp, tok0, g, sAc, sDt);
        if (tid < 128) sSS[tid] = 0.f;
        {
            int ch, strip, ccol, stride; LAS unsigned char* dst;
            if (tid < 256) { ch = tid & 31; strip = tid >> 5; ccol = g * 256 + 8 * ch; stride = SX_ST; dst = sX + (strip * 16) * SX_ST + ch * 16; }
            else if (tid < 384) { const int u = tid - 256; ch = u & 15; strip = u >> 4; ccol = 1024 + g * 128 + 8 * ch; stride = SC_ST; dst = sB + (strip * 16) * SC_ST + ch * 16; }
            else { const int u = tid - 384; ch = u & 15; strip = u >> 4; ccol = 1536 + g * 128 + 8 * ch; stride = SC_ST; dst = sC + (strip * 16) * SC_ST + ch * 16; }
            conv_task(P, rowb, c * 128 + strip * 16, PC_X + ccol, F.in[I_CONVW], F.in[I_CONVB], ccol, dst, stride, nullptr);
        }
        __syncthreads();
        const int s = 32 * st + ql;
        unsigned yk[2][2][8];
        float ssq = 0.f;
        const unsigned xa = (unsigned)(size_t)sX + (unsigned)((4 * h + tq) * SX_ST + (16 * tblk + 4 * tp) * 2);
#pragma unroll
        for (int hq = 0; hq < 2; ++hq) {
            const int r = 2 * hp + hq, head = 4 * g + r;
            const float acs = sAc[r * 128 + s];
            const bf16* stp = SIN + (((size_t)bl * 64 + c) * 16 + head) * 8192 + ql * 128 + 8 * h;
            bf16x8 sfr[2][8];
#pragma unroll
            for (int pt = 0; pt < 2; ++pt)
#pragma unroll
                for (int ks = 0; ks < 8; ++ks) sfr[pt][ks] = *(const bf16x8*)(stp + pt * 4096 + 16 * ks);
            bf16x8 pf[4][2];
#pragma unroll
            for (int i = 0; i < 4; ++i) {
                f32x16 Xi;
#pragma unroll
                for (int e = 0; e < 16; ++e) Xi[e] = 0.f;
#pragma unroll
                for (int ks = 0; ks < 8; ++ks) { const bf16x8 bf_ = *(const LAS bf16x8*)(sB + (32 * i + ql) * SC_ST + 32 * ks + 16 * h);
                    const bf16x8 cf = *(const LAS bf16x8*)(sC + s * SC_ST + 32 * ks + 16 * h); Xi = MFMA32(bf_, cf, Xi); }
                float p[16];
#pragma unroll
                for (int q4 = 0; q4 < 4; ++q4) { const int t0 = 32 * i + 8 * q4 + 4 * h;
                    const f32x4 at = *(const LAS f32x4*)(sAc + r * 128 + t0), dt4 = *(const LAS f32x4*)(sDt + r * 128 + t0);
#pragma unroll
                    for (int e = 0; e < 4; ++e) { const int t = t0 + e; p[4 * q4 + e] = (t <= s) ? Xi[4 * q4 + e] * __expf(acs - at[e]) * dt4[e] : 0.f; } }
#pragma unroll
                for (int s2 = 0; s2 < 2; ++s2) { const u32x4 w = {pkbf(p[8 * s2 + 0], p[8 * s2 + 1]), pkbf(p[8 * s2 + 2], p[8 * s2 + 3]), pkbf(p[8 * s2 + 4], p[8 * s2 + 5]), pkbf(p[8 * s2 + 6], p[8 * s2 + 7])};
                    pf[i][s2] = __builtin_bit_cast(bf16x8, w); }
            }
            const float eacs = __expf(acs), Dh = F.in[I_SSDD][head];
#pragma unroll
            for (int pt = 0; pt < 2; ++pt) {
                f32x16 yd, yo;
#pragma unroll
                for (int e = 0; e < 16; ++e) { yd[e] = 0.f; yo[e] = 0.f; }
#pragma unroll
                for (int i = 0; i < 4; ++i) {
#pragma unroll
                    for (int s2 = 0; s2 < 2; ++s2) { const unsigned a = xa + (unsigned)((32 * i + 16 * s2) * SX_ST + (r * 64 + 32 * pt) * 2);
                        const bf16x8 xf = tr_pair(a, a + 8 * SX_ST); __builtin_amdgcn_sched_barrier(0); yd = MFMA32(xf, pf[i][s2], yd); }
                }
#pragma unroll
                for (int ks = 0; ks < 8; ++ks) { const bf16x8 cf = *(const LAS bf16x8*)(sC + s * SC_ST + 32 * ks + 16 * h); yo = MFMA32(sfr[pt][ks], cf, yo); }
                const bf16* zp = P + (rowb + c * 128 + s) * NPROJ + PC_Z + g * 256 + r * 64 + 32 * pt + 4 * h;
                u32x2 zv[4];
#pragma unroll
                for (int q4 = 0; q4 < 4; ++q4) zv[q4] = *(const u32x2*)(zp + 8 * q4);
#pragma unroll
                for (int q4 = 0; q4 < 4; ++q4) {
                    const u32x2 xv = *(const LAS u32x2*)(sX + s * SX_ST + (r * 64 + 32 * pt + 8 * q4 + 4 * h) * 2);
                    const u32x2 zq = zv[q4];
                    const float xs_[4] = {bflo(xv.x), bfhi(xv.x), bflo(xv.y), bfhi(xv.y)}, zs_[4] = {bflo(zq.x), bfhi(zq.x), bflo(zq.y), bfhi(zq.y)};
                    float yv[4];
#pragma unroll
                    for (int e = 0; e < 4; ++e) { float y = yd[4 * q4 + e] + eacs * yo[4 * q4 + e] + Dh * xs_[e]; y = y * zs_[e] * sigmoidf_(zs_[e]); yv[e] = y; ssq += y * y; }
                    yk[hq][pt][2 * q4] = pkbf(yv[0], yv[1]); yk[hq][pt][2 * q4 + 1] = pkbf(yv[2], yv[3]);
                }
            }
        }
        ssq += __shfl_xor(ssq, 32);
        if (h == 0) __hip_atomic_fetch_add(sSS + s, ssq, __ATOMIC_RELAXED, __HIP_MEMORY_SCOPE_WORKGROUP);
        __syncthreads();
        const float rs = 1.0f / sqrtf(sSS[s] * (1.f / 256.f) + EPS);
        bf16* yp = Y + (tok0 + s) * YC + g * 256 + 4 * h;
        const float* nw = F.in[I_SSDNW] + g * 256 + 4 * h;
#pragma unroll
        for (int hq = 0; hq < 2; ++hq)
#pragma unroll
            for (int pt = 0; pt < 2; ++pt)
#pragma unroll
                for (int q4 = 0; q4 < 4; ++q4) { const int cc = (2 * hp + hq) * 64 + 32 * pt + 8 * q4; const f32x4 w4 = *(const f32x4*)(nw + cc);
                    const unsigned ya = yk[hq][pt][2 * q4], yb = yk[hq][pt][2 * q4 + 1];
                    const u32x2 o = {pkbf(bflo(ya) * rs * w4.x, bfhi(ya) * rs * w4.y), pkbf(bflo(yb) * rs * w4.z, bfhi(yb) * rs * w4.w)};
                    *(u32x2*)(yp + cc) = o; }
    }
}

__device__ __forceinline__ bf16x8 mk_bf16x8(u32x2 lo, u32x2 hi) { const u32x4 v = {lo.x, lo.y, hi.x, hi.y}; return __builtin_bit_cast(bf16x8, v); }

__device__ __forceinline__ void memattn_mfma_phase(Frame& F, int half) {
    const bf16* P = (const bf16*)(F.ws + WS_BIG);
    const bf16* MKV = (const bf16*)(F.ws + WS_MKV);
    const bf16* MVT = (const bf16*)(F.ws + WS_MVT);
    bf16* Y = (bf16*)F.out;
    LAS unsigned char* sm = F.lds;
    const int tid = F.tid, lane = F.lane, wave = F.wave, ql = lane & 31, h = lane >> 5;
    constexpr int KST = 400, VST = 528;
    for (int unit = F.bid; unit < HB * 4 * 32; unit += F.G) {
        const int bl = unit >> 7, head = (unit >> 5) & 3, qt = unit & 31, b = half * HB + bl;
        const int r = bl * SEQ + qt * 256 + wave * 32 + ql;
        __syncthreads();
        for (int c = tid; c < 256 * 24; c += NTHR) { const int row = c / 24, ch = c % 24;
            *(LAS u32x4*)(sm + row * KST + ch * 16) = *(const u32x4*)(MKV + (size_t)(b * NMEM + row) * 1536 + head * 192 + ch * 8); }
        bf16x8 qf[12];
        { const bf16* qp = P + (size_t)r * NPROJ + PC_MQ + head * 192 + 8 * h;
          u32x4 qr[12]; float ss = 0.f;
#pragma unroll
          for (int ks = 0; ks < 12; ++ks) { qr[ks] = *(const u32x4*)(qp + 16 * ks);
              ss += (bflo(qr[ks].x) * bflo(qr[ks].x) + bfhi(qr[ks].x) * bfhi(qr[ks].x)) + (bflo(qr[ks].y) * bflo(qr[ks].y) + bfhi(qr[ks].y) * bfhi(qr[ks].y))
                  + (bflo(qr[ks].z) * bflo(qr[ks].z) + bfhi(qr[ks].z) * bfhi(qr[ks].z)) + (bflo(qr[ks].w) * bflo(qr[ks].w) + bfhi(qr[ks].w) * bfhi(qr[ks].w)); }
          ss += __shfl_xor(ss, 32);
          const float rs = 1.0f / sqrtf(ss * (1.f / 192.f) + EPS);
#pragma unroll
          for (int ks = 0; ks < 12; ++ks) { const f32x4 wa = *(const f32x4*)(F.in[I_MQNW] + 16 * ks + 8 * h), wb = *(const f32x4*)(F.in[I_MQNW] + 16 * ks + 8 * h + 4);
              const u32x4 w = {pkbf(bflo(qr[ks].x) * rs * wa.x, bfhi(qr[ks].x) * rs * wa.y), pkbf(bflo(qr[ks].y) * rs * wa.z, bfhi(qr[ks].y) * rs * wa.w),
                               pkbf(bflo(qr[ks].z) * rs * wb.x, bfhi(qr[ks].z) * rs * wb.y), pkbf(bflo(qr[ks].w) * rs * wb.z, bfhi(qr[ks].w) * rs * wb.w)};
              qf[ks] = __builtin_bit_cast(bf16x8, w); } }
        __syncthreads();
        f32x16 sacc[8];
#pragma unroll
        for (int mt = 0; mt < 8; ++mt) {
#pragma unroll
            for (int i = 0; i < 16; ++i) sacc[mt][i] = 0.f;
#pragma unroll
            for (int ks = 0; ks < 12; ++ks) { const bf16x8 kf = *(const LAS bf16x8*)(sm + (32 * mt + ql) * KST + 32 * ks + 16 * h); sacc[mt] = MFMA32(kf, qf[ks], sacc[mt]); }
        }
        float mx = -3.0e38f;
#pragma unroll
        for (int mt = 0; mt < 8; ++mt)
#pragma unroll
            for (int i = 0; i < 16; ++i) mx = fmaxf(mx, sacc[mt][i]);
        mx = fmaxf(mx, __shfl_xor(mx, 32));
        const float sc = 0.07216878364870323f * 1.4426950408889634f;
        float l = 0.f;
        bf16x8 pf[8][2];
#pragma unroll
        for (int mt = 0; mt < 8; ++mt) {
            float p[16];
#pragma unroll
            for (int i = 0; i < 16; ++i) { p[i] = __builtin_amdgcn_exp2f((sacc[mt][i] - mx) * sc); l += p[i]; }
#pragma unroll
            for (int s2 = 0; s2 < 2; ++s2) { const u32x4 w = {pkbf(p[8 * s2 + 0], p[8 * s2 + 1]), pkbf(p[8 * s2 + 2], p[8 * s2 + 3]), pkbf(p[8 * s2 + 4], p[8 * s2 + 5]), pkbf(p[8 * s2 + 6], p[8 * s2 + 7])};
                pf[mt][s2] = __builtin_bit_cast(bf16x8, w); }
        }
        l += __shfl_xor(l, 32);
        __syncthreads();
        for (int c = tid; c < 192 * 32; c += NTHR) { const int row = c >> 5, ch = c & 31;
            *(LAS u32x4*)(sm + row * VST + ch * 16) = *(const u32x4*)(MVT + (size_t)(head * 192 + row) * 2048 + b * NMEM + ch * 8); }
        __syncthreads();
        const float il = 1.0f / l;
        bf16* yp = Y + ((size_t)half * HT + r) * YC + 1280 + head * 192 + 4 * h;
#pragma unroll
        for (int dt = 0; dt < 6; ++dt) {
            f32x16 o;
#pragma unroll
            for (int i = 0; i < 16; ++i) o[i] = 0.f;
#pragma unroll
            for (int mt = 0; mt < 8; ++mt)
#pragma unroll
                for (int s2 = 0; s2 < 2; ++s2) { const LAS unsigned char* vp = sm + (32 * dt + ql) * VST + (32 * mt + 16 * s2 + 4 * h) * 2;
                    const bf16x8 vf = mk_bf16x8(*(const LAS u32x2*)vp, *(const LAS u32x2*)(vp + 16)); o = MFMA32(vf, pf[mt][s2], o); }
#pragma unroll
            for (int g = 0; g < 4; ++g) { const u32x2 w = {pkbf(o[4 * g] * il, o[4 * g + 1] * il), pkbf(o[4 * g + 2] * il, o[4 * g + 3] * il)}; *(u32x2*)(yp + 32 * dt + 8 * g) = w; }
        }
    }
}

__device__ __forceinline__ void dilattn_mfma_phase(Frame& F, int half) {
    bf16* P = (bf16*)(F.ws + WS_BIG);
    float* LSE = (float*)(F.ws + WS_LSE);
    LAS unsigned char* sK = F.lds; LAS unsigned char* sV = F.lds + 384 * 144;
    const int tid = F.tid, lane = F.lane, wave = F.wave, ql = lane & 31, h = lane >> 5;
    constexpr int RST = 144;
    const float* RT = (const float*)(F.ws + WS_ROPE);
    float wk8[8];
#pragma unroll
    for (int j = 0; j < 8; ++j) wk8[j] = F.in[I_DKNW][8 * (tid & 7) + j];
    for (int unit = F.bid; unit < HB * 12 * 32; unit += F.G) {
        const int bl = unit / 384, rem = unit % 384, head = rem >> 5, blk = rem & 31;
        const int g = head >> 2, dil = (g == 0) ? 1 : (g == 1 ? 4 : 16), bpr = 32 / dil;
        const int res = blk / bpr, q0 = (blk % bpr) * 256;
        const size_t rowb = (size_t)bl * SEQ;
        __syncthreads();
        for (int c = tid; c < 384 * 8; c += NTHR) { const int row = c >> 3, ch = c & 7; const int ks = q0 - 128 + row;
            u32x4 kv = {0u, 0u, 0u, 0u}, vv = {0u, 0u, 0u, 0u}; f32x4 c0 = {1.f, 1.f, 1.f, 1.f}, c1 = c0, s0 = {0.f, 0.f, 0.f, 0.f}, s1 = s0;
            if (ks >= 0) { const size_t rr = rowb + (size_t)ks * dil + res; const bf16* src = P + rr * NPROJ + head * 64 + ch * 8; kv = *(const u32x4*)(src + PC_DK); vv = *(const u32x4*)(src + PC_DV);
                if (ch < 2) { const f32x4* rt = (const f32x4*)(RT + ((size_t)half * HT + rr) * 16); c0 = rt[0]; c1 = rt[1]; s0 = rt[2]; s1 = rt[3]; } }
            float x[8] = {bflo(kv.x), bfhi(kv.x), bflo(kv.y), bfhi(kv.y), bflo(kv.z), bfhi(kv.z), bflo(kv.w), bfhi(kv.w)};
            float ss = 0.f;
#pragma unroll
            for (int j = 0; j < 8; ++j) ss += x[j] * x[j];
            ss += __shfl_xor(ss, 1); ss += __shfl_xor(ss, 2); ss += __shfl_xor(ss, 4);
            const float rs = 1.0f / sqrtf(ss * (1.f / 64.f) + EPS);
            const float cs[8] = {c0.x, c0.y, c0.z, c0.w, c1.x, c1.y, c1.z, c1.w}, sn[8] = {s0.x, s0.y, s0.z, s0.w, s1.x, s1.y, s1.z, s1.w};
#pragma unroll
            for (int j = 0; j < 8; ++j) { x[j] = x[j] * rs * wk8[j]; const float o = __shfl_xor(x[j], 1); if (ch == 0) x[j] = x[j] * cs[j] - o * sn[j]; else if (ch == 1) x[j] = x[j] * cs[j] + o * sn[j]; }
            kv = (u32x4){pkbf(x[0], x[1]), pkbf(x[2], x[3]), pkbf(x[4], x[5]), pkbf(x[6], x[7])};
            *(LAS u32x4*)(sK + row * RST + ch * 16) = kv; *(LAS u32x4*)(sV + row * RST + ch * 16) = vv; }
        const int qs = q0 + wave * 32 + ql;
        const size_t rq = rowb + (size_t)qs * dil + res;
        bf16* qp = P + rq * NPROJ + PC_DQ + head * 64;
        bf16x8 qf[4];
        {
            u32x4 qr[4];
#pragma unroll
            for (int ks = 0; ks < 4; ++ks) qr[ks] = *(const u32x4*)(qp + 16 * ks + 8 * h);
            const f32x4* rt = (const f32x4*)(RT + ((size_t)half * HT + rq) * 16); const f32x4 c0 = rt[0], c1 = rt[1], s0 = rt[2], s1 = rt[3];
            float ss = 0.f;
#pragma unroll
            for (int ks = 0; ks < 4; ++ks) ss += (bflo(qr[ks].x) * bflo(qr[ks].x) + bfhi(qr[ks].x) * bfhi(qr[ks].x)) + (bflo(qr[ks].y) * bflo(qr[ks].y) + bfhi(qr[ks].y) * bfhi(qr[ks].y))
                                               + (bflo(qr[ks].z) * bflo(qr[ks].z) + bfhi(qr[ks].z) * bfhi(qr[ks].z)) + (bflo(qr[ks].w) * bflo(qr[ks].w) + bfhi(qr[ks].w) * bfhi(qr[ks].w));
            ss += __shfl_xor(ss, 32);
            const float rs = 1.0f / sqrtf(ss * (1.f / 64.f) + EPS);
#pragma unroll
            for (int ks = 0; ks < 4; ++ks) { const f32x4 wa = *(const f32x4*)(F.in[I_DQNW] + 16 * ks + 8 * h), wb = *(const f32x4*)(F.in[I_DQNW] + 16 * ks + 8 * h + 4);
                float x[8] = {bflo(qr[ks].x) * rs * wa.x, bfhi(qr[ks].x) * rs * wa.y, bflo(qr[ks].y) * rs * wa.z, bfhi(qr[ks].y) * rs * wa.w, bflo(qr[ks].z) * rs * wb.x, bfhi(qr[ks].z) * rs * wb.y, bflo(qr[ks].w) * rs * wb.z, bfhi(qr[ks].w) * rs * wb.w};
                if (ks == 0) { const float cs[8] = {c0.x, c0.y, c0.z, c0.w, c1.x, c1.y, c1.z, c1.w}, sn[8] = {s0.x, s0.y, s0.z, s0.w, s1.x, s1.y, s1.z, s1.w};
#pragma unroll
                    for (int j = 0; j < 8; ++j) { const float o = __shfl_xor(x[j], 32); x[j] = (h == 0) ? x[j] * cs[j] - o * sn[j] : x[j] * cs[j] + o * sn[j]; } }
                const u32x4 w = {pkbf(x[0], x[1]), pkbf(x[2], x[3]), pkbf(x[4], x[5]), pkbf(x[6], x[7])}; qf[ks] = __builtin_bit_cast(bf16x8, w); }
        }
        __syncthreads();
        f32x16 sacc[5];
        const int kfirst = q0 + wave * 32 - 128;
#pragma unroll
        for (int i = 0; i < 5; ++i) {
#pragma unroll
            for (int e = 0; e < 16; ++e) sacc[i][e] = 0.f;
#pragma unroll
            for (int ks = 0; ks < 4; ++ks) { const bf16x8 kf = *(const LAS bf16x8*)(sK + (32 * wave + 32 * i + ql) * RST + 32 * ks + 16 * h); sacc[i] = MFMA32(kf, qf[ks], sacc[i]); }
        }
        float mx = -3.0e38f;
#pragma unroll
        for (int i = 0; i < 5; ++i)
#pragma unroll
            for (int e = 0; e < 16; ++e) { const int kj = 32 * i + (e & 3) + 8 * (e >> 2) + 4 * h; const bool ok = (kj >= ql) && (kj <= ql + 128) && (kfirst + kj >= 0);
                sacc[i][e] = ok ? sacc[i][e] : -3.0e38f; mx = fmaxf(mx, sacc[i][e]); }
        mx = fmaxf(mx, __shfl_xor(mx, 32));
        const float sc = 0.125f * 1.4426950408889634f;
        float l = 0.f;
        bf16x8 pf[5][2];
#pragma unroll
        for (int i = 0; i < 5; ++i) {
            float p[16];
#pragma unroll
            for (int e = 0; e < 16; ++e) { p[e] = (sacc[i][e] > -1.0e38f) ? __builtin_amdgcn_exp2f((sacc[i][e] - mx) * sc) : 0.f; l += p[e]; }
#pragma unroll
            for (int s2 = 0; s2 < 2; ++s2) { const u32x4 w = {pkbf(p[8 * s2 + 0], p[8 * s2 + 1]), pkbf(p[8 * s2 + 2], p[8 * s2 + 3]), pkbf(p[8 * s2 + 4], p[8 * s2 + 5]), pkbf(p[8 * s2 + 6], p[8 * s2 + 7])};
                pf[i][s2] = __builtin_bit_cast(bf16x8, w); }
        }
        l += __shfl_xor(l, 32);
        const float il = 1.0f / l;
        const int tq = (lane & 15) >> 2, tp = lane & 3, tblk = (lane >> 4) & 1;
        const unsigned vbase = (unsigned)(size_t)(sV) + (unsigned)((32 * wave + 4 * h + tq) * RST + (16 * tblk + 4 * tp) * 2);
#pragma unroll
        for (int dt = 0; dt < 2; ++dt) {
            f32x16 o;
#pragma unroll
            for (int e = 0; e < 16; ++e) o[e] = 0.f;
#pragma unroll
            for (int i = 0; i < 5; ++i) {
                s16x4 lo[2], hi[2];
#pragma unroll
                for (int s2 = 0; s2 < 2; ++s2) { const unsigned a = vbase + (unsigned)((32 * i + 16 * s2) * RST + 64 * dt);
                    asm volatile("ds_read_b64_tr_b16 %0, %1" : "=&v"(lo[s2]) : "v"(a) : "memory");
                    asm volatile("ds_read_b64_tr_b16 %0, %1 offset:1152" : "=&v"(hi[s2]) : "v"(a) : "memory"); }
                asm volatile("s_waitcnt lgkmcnt(0)" ::: "memory"); __builtin_amdgcn_sched_barrier(0);
#pragma unroll
                for (int s2 = 0; s2 < 2; ++s2) { const bf16x8 vf = {lo[s2][0], lo[s2][1], lo[s2][2], lo[s2][3], hi[s2][0], hi[s2][1], hi[s2][2], hi[s2][3]}; o = MFMA32(vf, pf[i][s2], o); }
            }
#pragma unroll
            for (int gq = 0; gq < 4; ++gq) { const u32x2 w = {pkbf(o[4 * gq] * il, o[4 * gq + 1] * il), pkbf(o[4 * gq + 2] * il, o[4 * gq + 3] * il)}; *(u32x2*)(qp + 32 * dt + 8 * gq + 4 * h) = w; }
        }
        if (h == 0) LSE[((size_t)half * HT + rq) * 12 + head] = mx * 0.125f + __logf(l);
    }
}

__device__ __forceinline__ void dilmerge_phase(Frame& F, int half) {
    const bf16* P = (const bf16*)(F.ws + WS_BIG);
    const float* LSE = (const float*)(F.ws + WS_LSE);
    bf16* Y = (bf16*)F.out;
    const size_t gtid = (size_t)F.bid * NTHR + F.tid, gth = (size_t)F.G * NTHR;
    for (size_t it = gtid; it < (size_t)HT * 32; it += gth) {
        const size_t r = it >> 5; const int hh = (int)(it >> 3) & 3, d0 = (int)(it & 7) * 8;
        const size_t tok = (size_t)half * HT + r;
        const float l0 = LSE[tok * 12 + hh], l1 = LSE[tok * 12 + 4 + hh], l2 = LSE[tok * 12 + 8 + hh];
        const float m = fmaxf(l0, fmaxf(l1, l2));
        float w0 = __expf(l0 - m), w1 = __expf(l1 - m), w2 = __expf(l2 - m); const float iw = 1.0f / (w0 + w1 + w2); w0 *= iw; w1 *= iw; w2 *= iw;
        const bf16* op = P + r * NPROJ + PC_DQ + hh * 64 + d0;
        const u32x4 a = *(const u32x4*)op, b = *(const u32x4*)(op + 256), c = *(const u32x4*)(op + 512);
        u32x4 o;
        o.x = pkbf(w0 * bflo(a.x) + w1 * bflo(b.x) + w2 * bflo(c.x), w0 * bfhi(a.x) + w1 * bfhi(b.x) + w2 * bfhi(c.x));
        o.y = pkbf(w0 * bflo(a.y) + w1 * bflo(b.y) + w2 * bflo(c.y), w0 * bfhi(a.y) + w1 * bfhi(b.y) + w2 * bfhi(c.y));
        o.z = pkbf(w0 * bflo(a.z) + w1 * bflo(b.z) + w2 * bflo(c.z), w0 * bfhi(a.z) + w1 * bfhi(b.z) + w2 * bfhi(c.z));
        o.w = pkbf(w0 * bflo(a.w) + w1 * bflo(b.w) + w2 * bflo(c.w), w0 * bfhi(a.w) + w1 * bfhi(b.w) + w2 * bfhi(c.w));
        *(u32x4*)(Y + tok * YC + 1024 + hh * 64 + d0) = o;
    }
}

__device__ __forceinline__ void hn_phase(Frame& F) {
    const int gw = F.bid * NWAVES + F.wave, NGW = F.G * NWAVES;
    for (int m = gw; m < T; m += NGW) { f32x4 v[4]; rms_row_to_bf16(F.out + (size_t)m * DM, F.in[I_NFFNW], (bf16*)(F.ws + WS_ACT1) + (size_t)m * DM, F.lane, v); }
}


__device__ __forceinline__ float gelu_erf(float x) { return 0.5f * x * (1.0f + erff(x * 0.70710678118654752f)); }
__device__ __forceinline__ unsigned f2ord(float f) { const unsigned u = __builtin_bit_cast(unsigned, f); return u ^ ((unsigned)((int)u >> 31) | 0x80000000u); }
__device__ __forceinline__ float ord2f(unsigned k) { const unsigned m = (unsigned)((int)k >> 31); return __builtin_bit_cast(float, k ^ (0x80000000u | ~m)); }
#define CMPX(a, b) do { const unsigned _mx = max((a), (b)), _mn = min((a), (b)); (a) = _mx; (b) = _mn; } while (0)
__device__ __forceinline__ void bitonic_sort16_desc(unsigned (&v)[16]) {
#pragma unroll
    for (int k = 2; k <= 16; k <<= 1)
#pragma unroll
        for (int j = k >> 1; j > 0; j >>= 1)
#pragma unroll
            for (int i = 0; i < 16; ++i) { const int l = i ^ j; if (l > i) { if ((i & k) == 0) CMPX(v[i], v[l]); else CMPX(v[l], v[i]); } }
}
__device__ __forceinline__ void bitonic_merge16_desc(unsigned (&v)[16]) {
#pragma unroll
    for (int j = 8; j > 0; j >>= 1)
#pragma unroll
        for (int i = 0; i < 16; ++i) { const int l = i ^ j; if (l > i) CMPX(v[i], v[l]); }
}
__device__ __forceinline__ void top16_merge(unsigned (&a)[16], const unsigned (&b)[16]) {
#pragma unroll
    for (int i = 0; i < 16; ++i) a[i] = max(a[i], b[15 - i]);
    bitonic_merge16_desc(a);
}
constexpr int PK_ST = 272;
__device__ __forceinline__ void peer_topk_tile(Frame& F, size_t tok0, const bf16* Q, int* IDX, float* GATE) {
    const bf16* SK = (const bf16*)(F.ws + WS_SUBK);
    LAS unsigned char* sK = F.lds;
    int tid = F.tid; asm volatile("" : "+v"(tid));
    const int lane = tid & 63, wave = F.wave, ql = lane & 31, hh = lane >> 5;
    const size_t tok = tok0 + wave * 32 + ql;
    const bf16* qrow = Q + tok * PEER_Q + 8 * hh;
    __syncthreads();
#pragma unroll
    for (int j = 0; j < 4; ++j) { const int cidx = tid + 512 * j, row = cidx >> 4, ch = cidx & 15; *(LAS u32x4*)(sK + row * PK_ST + ch * 16) = *(const u32x4*)(SK + (size_t)row * 128 + ch * 8); }
    __syncthreads();
    unsigned k1[16];
    bf16x8 qf[8];
#pragma unroll
    for (int ks = 0; ks < 8; ++ks) qf[ks] = *(const bf16x8*)(qrow + 16 * ks);
#pragma unroll 1
    for (int hc = 0; hc < 16; ++hc) {
        LAS unsigned char* cur = sK + (hc & 1) * (128 * PK_ST); LAS unsigned char* nxt = sK + ((hc + 1) & 1) * (128 * PK_ST);
        u32x4 stg[4];
        const int hcn = (hc + 1) & 15;
#pragma unroll
        for (int j = 0; j < 4; ++j) { const int cidx = tid + 512 * j, row = cidx >> 4, ch = cidx & 15; stg[j] = *(const u32x4*)(SK + ((size_t)hcn * 128 + row) * 128 + ch * 8); }
        unsigned pk[4][16];
#pragma unroll
        for (int mt = 0; mt < 4; ++mt) {
            f32x16 acc;
#pragma unroll
            for (int e = 0; e < 16; ++e) acc[e] = 0.f;
#pragma unroll
            for (int ks = 0; ks < 8; ++ks) { const bf16x8 kf = *(const LAS bf16x8*)(cur + (32 * mt + ql) * PK_ST + 32 * ks + 16 * hh); acc = MFMA32(kf, qf[ks], acc); }
#pragma unroll
            for (int e = 0; e < 16; ++e) pk[mt][e] = (f2ord(acc[e]) & 0xFFFFFF80u) | (unsigned)(32 * mt + (e & 3) + 8 * (e >> 2) + 4 * hh);
        }
#pragma unroll
        for (int j = 0; j < 4; ++j) { const int cidx = tid + 512 * j, row = cidx >> 4, ch = cidx & 15; *(LAS u32x4*)(nxt + row * PK_ST + ch * 16) = stg[j]; }
        __syncthreads();
        __builtin_amdgcn_sched_barrier(0);
#pragma unroll
        for (int ks = 0; ks < 8; ++ks) qf[ks] = *(const bf16x8*)(qrow + hcn * 128 + 16 * ks);
        __builtin_amdgcn_sched_barrier(0);
#pragma unroll
        for (int mt = 0; mt < 4; ++mt) bitonic_sort16_desc(pk[mt]);
        top16_merge(pk[0], pk[1]); top16_merge(pk[2], pk[3]); top16_merge(pk[0], pk[2]);
        unsigned other[16];
#pragma unroll
        for (int i = 0; i < 16; ++i) other[i] = (unsigned)__shfl_xor((int)pk[0][i], 32);
        top16_merge(pk[0], other);
        if ((hc & 1) == 0) {
#pragma unroll
            for (int i = 0; i < 16; ++i) k1[i] = pk[0][i];
        } else {
            float f1[16], f2[16];
#pragma unroll
            for (int i = 0; i < 16; ++i) { f1[i] = ord2f(k1[i] & 0xFFFFFF80u); f2[i] = ord2f(pk[0][i] & 0xFFFFFF80u); }
            unsigned cd[4][16];
#pragma unroll
            for (int i = 0; i < 64; ++i) cd[i >> 4][i & 15] = 0u;
            int n = 0;
#pragma unroll
            for (int a = 0; a < 16; ++a)
#pragma unroll
                for (int b = 0; b < 16; ++b)
                    if ((a + 1) * (b + 1) <= 16) { cd[n >> 4][n & 15] = (f2ord(f1[a] + f2[b]) & 0xFFFFC000u) | ((k1[a] & 127u) << 7) | (pk[0][b] & 127u); ++n; }
#pragma unroll
            for (int g4 = 0; g4 < 4; ++g4) bitonic_sort16_desc(cd[g4]);
            top16_merge(cd[0], cd[1]); top16_merge(cd[2], cd[3]); top16_merge(cd[0], cd[2]);
            const float vmax = ord2f(cd[0][0] & 0xFFFFC000u);
            float ex[16], den = 0.f;
#pragma unroll
            for (int i = 0; i < 16; ++i) { ex[i] = __expf(ord2f(cd[0][i] & 0xFFFFC000u) - vmax); den += ex[i]; }
            const float iden = 1.0f / den;
            const int h = hc >> 1;
            if (hh == 0) { int* ip = IDX + tok * 128 + h * 16;
#pragma unroll
                for (int i = 0; i < 4; ++i) { const u32x4 w = {cd[0][4 * i] & 0x3FFFu, cd[0][4 * i + 1] & 0x3FFFu, cd[0][4 * i + 2] & 0x3FFFu, cd[0][4 * i + 3] & 0x3FFFu}; *(u32x4*)(ip + 4 * i) = w; } }
            else { float* gp = GATE + tok * 128 + h * 16;
#pragma unroll
                for (int i = 0; i < 4; ++i) { const f32x4 w = {ex[4 * i] * iden, ex[4 * i + 1] * iden, ex[4 * i + 2] * iden, ex[4 * i + 3] * iden}; *(f32x4*)(gp + 4 * i) = w; } }
        }
    }
}

struct PeerDeal { size_t tokw; int ntok; size_t tok0; float* PART; const int* IDX; const float* GATE; float* COEF; };
__device__ __forceinline__ void peer_item(int n, const PeerDeal& D, int wave, int& slice, size_t& tok) { slice = n >> 5; tok = D.tokw + (n & 31); }
__device__ __forceinline__ void peer_down_rows(u32x4 (&R)[16], __amdgpu_buffer_rsrc_t tab, int slice, int id0, int id1, int lane) {
    const int soff = slice * (16384 * 128);
    const int r = lane & 15, g = lane >> 4, e8 = (r >> 2) + 4 * (g >> 1), q = 4 * (g & 1) + (r & 3);
    const int src0 = 16 * (e8 & 3);
#pragma unroll
    for (int k = 0; k < 16; ++k) { const int v0 = __shfl(id0, src0 + k), v1 = __shfl(id1, src0 + k); const int id = (e8 < 4) ? v0 : v1;
        R[k] = __builtin_amdgcn_raw_buffer_load_b128(tab, (id << 7) + 16 * q, soff, 0); }
}
__device__ __forceinline__ void peer_down_hn(u32x4 (&H)[2], const bf16* HN, int slice, size_t tok, int lane) {
    const bf16* hp = HN + tok * DM + slice * 128 + 16 * (4 * ((lane >> 4) & 1) + (lane & 3));
    H[0] = *(const u32x4*)hp; H[1] = *(const u32x4*)(hp + 8);
}
__device__ __forceinline__ void peer_down_bq(long (&bq)[2], const u32x4 (&H)[2], int lane) {
    const int c = lane & 15, g = lane >> 4; const bool on = (c < 8) && ((c >> 2) == (g >> 1));
    const u32x4 x0 = H[0], x1 = H[1];
    unsigned p0 = __builtin_amdgcn_cvt_pk_fp8_f32(bflo(x0.x), bfhi(x0.x), 0, false); p0 = __builtin_amdgcn_cvt_pk_fp8_f32(bflo(x0.y), bfhi(x0.y), p0, true);
    unsigned p1 = __builtin_amdgcn_cvt_pk_fp8_f32(bflo(x0.z), bfhi(x0.z), 0, false); p1 = __builtin_amdgcn_cvt_pk_fp8_f32(bflo(x0.w), bfhi(x0.w), p1, true);
    unsigned p2 = __builtin_amdgcn_cvt_pk_fp8_f32(bflo(x1.x), bfhi(x1.x), 0, false); p2 = __builtin_amdgcn_cvt_pk_fp8_f32(bflo(x1.y), bfhi(x1.y), p2, true);
    unsigned p3 = __builtin_amdgcn_cvt_pk_fp8_f32(bflo(x1.z), bfhi(x1.z), 0, false); p3 = __builtin_amdgcn_cvt_pk_fp8_f32(bflo(x1.w), bfhi(x1.w), p3, true);
    if (!on) { p0 = 0u; p1 = 0u; p2 = 0u; p3 = 0u; }
    bq[0] = (long)(((unsigned long long)p1 << 32) | p0); bq[1] = (long)(((unsigned long long)p3 << 32) | p2);
}
__device__ __forceinline__ void peer_down_mfma(const u32x4 (&R)[16], const long (&bq)[2], __amdgpu_buffer_rsrc_t prsrc, int slice, int tokl, int lane) {
    const int c = lane & 15, g = lane >> 4, cb = c & 3;
    float dv[16];
#pragma unroll
    for (int k = 0; k < 16; ++k) { f32x4 acc = {0.f, 0.f, 0.f, 0.f}; const u32x4 v = R[k];
        acc = __builtin_amdgcn_mfma_f32_16x16x32_fp8_fp8((long)(((unsigned long long)v.y << 32) | v.x), bq[0], acc, 0, 0, 0);
        acc = __builtin_amdgcn_mfma_f32_16x16x32_fp8_fp8((long)(((unsigned long long)v.w << 32) | v.z), bq[1], acc, 0, 0, 0);
        float t = (cb == 0) ? acc.x : (cb == 1) ? acc.y : (cb == 2) ? acc.z : acc.w;
        t += __shfl_xor(t, 1); t += __shfl_xor(t, 2); dv[k] = t; }
    const unsigned off = ((c & 3) == 0 && c < 8) ? (unsigned)(((tokl * 8 + slice) * 128 + 16 * (g + 4 * (c >> 2))) * 4) : 0xFFFFFF00u;
#pragma unroll
    for (int i = 0; i < 4; ++i) { const f32x4 w = {dv[4 * i], dv[4 * i + 1], dv[4 * i + 2], dv[4 * i + 3]}; __builtin_amdgcn_raw_buffer_store_b128(__builtin_bit_cast(u32x4, w), prsrc, off, 16 * i, 0); }
}
__device__ __forceinline__ void peer_down_phase(Frame& F, const PeerDeal& D) {
    const __amdgpu_buffer_rsrc_t PD = __builtin_amdgcn_make_buffer_rsrc((void*)(F.ws + WS_PD), 0, 16384 * 1024, 0x00020000); const bf16* HN = (const bf16*)(F.ws + WS_HB);
    const int* IDX = D.IDX;
    const __amdgpu_buffer_rsrc_t prsrc = __builtin_amdgcn_make_buffer_rsrc((void*)D.PART, 0, 256 * 8 * 128 * 4, 0x00020000);
    int lane = F.lane; asm volatile("" : "+v"(lane));
    const int wave = F.wave;
    const int ntok = D.ntok;
    u32x4 RA[16], RB[16], HA[2], HB[2]; int ia0, ia1, ib0, ib1; long bq[2];
#define PEER_TOK(k, sv, tv) int sv; size_t tv; peer_item((k) < ntok ? (k) : ntok - 2 + ((k) & 1), D, wave, sv, tv)
    { PEER_TOK(0, s0, t0); PEER_TOK(1, s1, t1); PEER_TOK(2, s2, t2); PEER_TOK(3, s3, t3);
      const int a0 = IDX[t0 * 128 + lane], a1 = IDX[t0 * 128 + 64 + lane], b0 = IDX[t1 * 128 + lane], b1 = IDX[t1 * 128 + 64 + lane];
      ia0 = IDX[t2 * 128 + lane]; ia1 = IDX[t2 * 128 + 64 + lane]; ib0 = IDX[t3 * 128 + lane]; ib1 = IDX[t3 * 128 + 64 + lane];
      __builtin_amdgcn_sched_barrier(0);
      peer_down_rows(RA, PD, s0, a0, a1, lane); peer_down_hn(HA, HN, s0, t0, lane);
      __builtin_amdgcn_sched_barrier(0);
      peer_down_rows(RB, PD, s1, b0, b1, lane); peer_down_hn(HB, HN, s1, t1, lane);
      __builtin_amdgcn_sched_barrier(0); }
#pragma unroll 1
    for (int n = 0; n < ntok; n += 2) {
        PEER_TOK(n, s0, t0); PEER_TOK(n + 1, s1, t1); PEER_TOK(n + 2, s2, t2); PEER_TOK(n + 3, s3, t3); PEER_TOK(n + 4, s4, t4); PEER_TOK(n + 5, s5, t5);
        peer_down_bq(bq, HA, lane);
        peer_down_mfma(RA, bq, prsrc, s0, (int)(t0 - D.tok0), lane);
        __builtin_amdgcn_sched_barrier(0);
        { const int j0 = IDX[t4 * 128 + lane], j1 = IDX[t4 * 128 + 64 + lane];
          peer_down_rows(RA, PD, s2, ia0, ia1, lane); peer_down_hn(HA, HN, s2, t2, lane); ia0 = j0; ia1 = j1; }
        __builtin_amdgcn_sched_barrier(0);
        peer_down_bq(bq, HB, lane);
        peer_down_mfma(RB, bq, prsrc, s1, (int)(t1 - D.tok0), lane);
        __builtin_amdgcn_sched_barrier(0);
        { const int j0 = IDX[t5 * 128 + lane], j1 = IDX[t5 * 128 + 64 + lane];
          peer_down_rows(RB, PD, s3, ib0, ib1, lane); peer_down_hn(HB, HN, s3, t3, lane); ib0 = j0; ib1 = j1; }
        __builtin_amdgcn_sched_barrier(0);
    }
#undef PEER_TOK
}
__device__ __forceinline__ void peer_coef_wave(Frame& F, const PeerDeal& D) {
    for (int k = F.lane; k < 32 * 32; k += 64) {
        const int tl = (int)(D.tokw - D.tok0) + (k >> 5), slot = 4 * (k & 31);
        const float* pp = D.PART + (size_t)tl * 1024 + slot;
        f32x4 sm = *(const f32x4*)pp;
#pragma unroll
        for (int x = 1; x < 8; ++x) sm += *(const f32x4*)(pp + 128 * x);
        const size_t i = (D.tok0 + tl) * 128 + slot;
        const f32x4 gt = *(const f32x4*)(D.GATE + i);
        const float dsc = (1.0f / PD_SCALE) / sqrtf(((const float*)(F.ws + WS_SSQ))[D.tok0 + tl] * (1.f / DM) + EPS);
        const f32x4 o = {gt.x * gelu_erf(sm.x * dsc) * (1.0f / PU_SCALE), gt.y * gelu_erf(sm.y * dsc) * (1.0f / PU_SCALE),
                         gt.z * gelu_erf(sm.z * dsc) * (1.0f / PU_SCALE), gt.w * gelu_erf(sm.w * dsc) * (1.0f / PU_SCALE)};
        *(f32x4*)(D.COEF + i) = o;
    }
}
__device__ __forceinline__ void peer_up_rows(u32x4 (&R)[16], __amdgpu_buffer_rsrc_t tab, int slice, int id0, int id1, int lane) {
    const int soff = slice * (16384 * 128);
#pragma unroll
    for (int s8 = 0; s8 < 8; ++s8) { const int id = __shfl(s8 < 4 ? id0 : id1, (16 * s8 + (lane >> 2)) & 63); const int vo = (id << 7) + 16 * (lane & 3);
        R[2 * s8] = __builtin_amdgcn_raw_buffer_load_b128(tab, vo, soff, 0); R[2 * s8 + 1] = __builtin_amdgcn_raw_buffer_load_b128(tab, vo, soff + 64, 0); }
}
__device__ __forceinline__ void peer_up_compute(const u32x4 (&R)[16], float c0, float c1, f32x2 h, float* out, int slice, size_t tok, int lane) {
    f32x2 acc[16];
#pragma unroll
    for (int k = 0; k < 16; ++k) acc[k] = (f32x2){0.f, 0.f};
#pragma unroll
    for (int s8 = 0; s8 < 8; ++s8) { const float c = __shfl(s8 < 4 ? c0 : c1, (16 * s8 + (lane >> 2)) & 63); f32x2 c2 = {c, c}; asm volatile("" : "+v"(c2));
#pragma unroll
        for (int hf = 0; hf < 2; ++hf) { const u32x4 r = R[2 * s8 + hf];
            acc[8 * hf + 0] = c2 * __builtin_amdgcn_cvt_pk_f32_fp8(r.x, false) + acc[8 * hf + 0]; acc[8 * hf + 1] = c2 * __builtin_amdgcn_cvt_pk_f32_fp8(r.x, true) + acc[8 * hf + 1];
            acc[8 * hf + 2] = c2 * __builtin_amdgcn_cvt_pk_f32_fp8(r.y, false) + acc[8 * hf + 2]; acc[8 * hf + 3] = c2 * __builtin_amdgcn_cvt_pk_f32_fp8(r.y, true) + acc[8 * hf + 3];
            acc[8 * hf + 4] = c2 * __builtin_amdgcn_cvt_pk_f32_fp8(r.z, false) + acc[8 * hf + 4]; acc[8 * hf + 5] = c2 * __builtin_amdgcn_cvt_pk_f32_fp8(r.z, true) + acc[8 * hf + 5];
            acc[8 * hf + 6] = c2 * __builtin_amdgcn_cvt_pk_f32_fp8(r.w, false) + acc[8 * hf + 6]; acc[8 * hf + 7] = c2 * __builtin_amdgcn_cvt_pk_f32_fp8(r.w, true) + acc[8 * hf + 7]; } }
    f32x2 r8[8], r4[4], r2[2], r1;
    { const bool up = (lane & 32) != 0;
#pragma unroll
      for (int k = 0; k < 8; ++k) { const f32x2 keep = up ? acc[k + 8] : acc[k], send = up ? acc[k] : acc[k + 8]; r8[k] = keep + (f32x2){__shfl_xor(send.x, 32), __shfl_xor(send.y, 32)}; } }
    { const bool up = (lane & 16) != 0;
#pragma unroll
      for (int k = 0; k < 4; ++k) { const f32x2 keep = up ? r8[k + 4] : r8[k], send = up ? r8[k] : r8[k + 4]; r4[k] = keep + (f32x2){__shfl_xor(send.x, 16), __shfl_xor(send.y, 16)}; } }
    { const bool up = (lane & 8) != 0;
#pragma unroll
      for (int k = 0; k < 2; ++k) { const f32x2 keep = up ? r4[k + 2] : r4[k], send = up ? r4[k] : r4[k + 2]; r2[k] = keep + (f32x2){__shfl_xor(send.x, 8), __shfl_xor(send.y, 8)}; } }
    { const bool up = (lane & 4) != 0; const f32x2 keep = up ? r2[1] : r2[0], send = up ? r2[0] : r2[1]; r1 = keep + (f32x2){__shfl_xor(send.x, 4), __shfl_xor(send.y, 4)}; }
    const int p = ((lane >> 5) & 1) * 8 + ((lane >> 4) & 1) * 4 + ((lane >> 3) & 1) * 2 + ((lane >> 2) & 1);
    *(f32x2*)(out + tok * DM + slice * 128 + 16 * (lane & 3) + 2 * (p & 7) + 64 * (p >> 3)) = h + r1;
}
__device__ __forceinline__ void peer_up_phase(Frame& F, const PeerDeal& D, float* outp) {
    const __amdgpu_buffer_rsrc_t PU = __builtin_amdgcn_make_buffer_rsrc((void*)(F.ws + WS_PU), 0, 16384 * 1024, 0x00020000);
    const int* IDX = D.IDX; const float* COEF = D.COEF;
    int lane = F.lane; asm volatile("" : "+v"(lane));
    const int wave = F.wave;
    const int ntok = D.ntok;
    const int p = ((lane >> 5) & 1) * 8 + ((lane >> 4) & 1) * 4 + ((lane >> 3) & 1) * 2 + ((lane >> 2) & 1);
    const int hoff = 16 * (lane & 3) + 2 * (p & 7) + 64 * (p >> 3);
    int sl; size_t tk;
    u32x4 R0[16], R1[16];
    float ca0, ca1, cb0, cb1; f32x2 ha, hb;
    int id0, id1, jd0, jd1;
    { int s1_; size_t t1_; peer_item(0, D, wave, sl, tk); peer_item(1, D, wave, s1_, t1_);
      jd0 = IDX[tk * 128 + lane]; jd1 = IDX[tk * 128 + 64 + lane]; id0 = IDX[t1_ * 128 + lane]; id1 = IDX[t1_ * 128 + 64 + lane];
      __builtin_amdgcn_sched_barrier(0);
      peer_up_rows(R0, PU, sl, jd0, jd1, lane);
      ca0 = COEF[tk * 128 + lane]; ca1 = COEF[tk * 128 + 64 + lane]; ha = *(const f32x2*)(F.out + tk * DM + sl * 128 + hoff);
      __builtin_amdgcn_sched_barrier(0); }
#pragma unroll 1
    for (int n = 0; n < ntok; n += 2) {
        int s0, s1, s2, s3; size_t t0, t1, t2, t3;
        peer_item(n, D, wave, s0, t0); peer_item(n + 1, D, wave, s1, t1);
        peer_item(n + 2 < ntok ? n + 2 : n, D, wave, s2, t2); peer_item(n + 3 < ntok ? n + 3 : n + 1, D, wave, s3, t3);
        jd0 = IDX[t2 * 128 + lane]; jd1 = IDX[t2 * 128 + 64 + lane];
        peer_up_rows(R1, PU, s1, id0, id1, lane);
        cb0 = COEF[t1 * 128 + lane]; cb1 = COEF[t1 * 128 + 64 + lane]; hb = *(const f32x2*)(F.out + t1 * DM + s1 * 128 + hoff);
        __builtin_amdgcn_sched_barrier(0);
        peer_up_compute(R0, ca0, ca1, ha, outp, s0, t0, lane);
        __builtin_amdgcn_sched_barrier(0);
        id0 = IDX[t3 * 128 + lane]; id1 = IDX[t3 * 128 + 64 + lane];
        peer_up_rows(R0, PU, s2, jd0, jd1, lane);
        ca0 = COEF[t2 * 128 + lane]; ca1 = COEF[t2 * 128 + 64 + lane]; ha = *(const f32x2*)(F.out + t2 * DM + s2 * 128 + hoff);
        __builtin_amdgcn_sched_barrier(0);
        peer_up_compute(R1, cb0, cb1, hb, outp, s1, t1, lane);
        __builtin_amdgcn_sched_barrier(0);
    }
}
__device__ __forceinline__ void peer_tile(Frame& F, int tile) {
    const size_t tok0 = (size_t)tile * 256;
    const bf16* Q = (const bf16*)(F.ws + WS_BIG);
    int* IDX = (int*)(F.ws + WS_BIG + 256 * MiB); float* GATE = (float*)(F.ws + WS_BIG + 288 * MiB); float* COEF = (float*)(F.ws + WS_BIG + 320 * MiB);
    peer_topk_tile(F, tok0, Q, IDX, GATE);
    VM_WAIT(); __syncthreads();
    PeerDeal D; D.tokw = tok0 + F.wave * 32; D.ntok = 256; D.tok0 = tok0; D.PART = (float*)(F.ws + WS_BIG + tok0 * (PEER_Q * 2)); D.IDX = IDX; D.GATE = GATE; D.COEF = COEF;
    peer_down_phase(F, D);
    VM_WAIT(); __syncthreads();
    peer_coef_wave(F, D);
    VM_WAIT(); __syncthreads();
    peer_up_phase(F, D, F.out);
}
__device__ __forceinline__ void peer_phase(Frame& F) { for (int tile = F.bid; tile < T / 256; tile += F.G) { peer_tile(F, tile); VM_WAIT(); __syncthreads(); } }

constexpr int N_PHASES = 14;
__global__ void __launch_bounds__(NTHR, 2) mega_fwd(Args args) {
    extern __shared__ __attribute__((aligned(16))) unsigned char lds_raw[];
    Frame F;
    F.lds = (LAS unsigned char*)lds_raw;
    F.tid = threadIdx.x; F.lane = F.tid & 63; F.wave = __builtin_amdgcn_readfirstlane(F.tid >> 6);
    F.G = gridDim.x; F.bid = blockIdx.x;
    F.in = args.in;
    F.positions = args.positions; F.out = args.out; F.ws = args.ws;
    unsigned char* ws = args.ws;
    volatile LAS unsigned* ctlw = (volatile LAS unsigned*)(F.lds + LDSCTL_OFF);
    if (F.tid < 64) ctlw[F.tid] = 0u;
    __syncthreads();
    const int lo = args.ph_lo, hi = args.ph_hi;
    XcdBarrier bar; bar.bar = (unsigned*)(ws + WS_CTL); bar.x = 0; bar.st = nullptr; bar.wave = F.wave;
    if (hi - lo > 1) bar = xcd_barrier_post((unsigned*)(ws + WS_CTL), ctlw + 8, F.wave);
#define IN(k) (lo <= (k) && (k) < hi)
#define SEAM(k) do { if (IN(k) && IN((k) + 1)) xcd_barrier(bar); } while (0)
    bf16* ACT1 = (bf16*)(ws + WS_ACT1); bf16* BIG = (bf16*)(ws + WS_BIG); bf16* WallT = (bf16*)(ws + WS_WALLT);

    if (IN(0)) { frame_refresh(F); p0_prologue(F); __syncthreads(); }
    SEAM(0);
    if (IN(1)) { frame_refresh(F);
        { pg8::Gemm g{(const bf16*)(ws + WS_MEMN), (const bf16*)(ws + WS_WMKVT), NB * NMEM, 768, DM, DM, DM}; pg8::StaticOrder S; S.init(g.M, g.N, F.G, F.bid);
          pg8::EpiBf16<0> E{(bf16*)(ws + WS_MKV), 1536}; pg8::gemm_phase(F.lds, g, S, E, F.wave); }
        { pg8::Gemm g{(const bf16*)(ws + WS_WMKVT) + (size_t)768 * DM, (const bf16*)(ws + WS_MEMN), 768, NB * NMEM, DM, DM, DM}; pg8::StaticOrder S; S.init(g.M, g.N, F.G, F.G - 1 - F.bid);
          pg8::EpiBf16<0> E{(bf16*)(ws + WS_MVT), NB * NMEM}; pg8::gemm_phase(F.lds, g, S, E, F.wave); }
        { pg8::Gemm g{ACT1, WallT, HT, NPROJ, DM, DM, DM}; pg8::StaticOrder S; S.init(g.M, g.N, F.G, F.bid);
          pg8::EpiBf16<0> E{BIG, NPROJ}; pg8::gemm_phase(F.lds, g, S, E, F.wave); }
    }
    SEAM(1);
    if (IN(2)) { frame_refresh(F); mknorm_phase(F); ssdC_phase(F, 0); }
    SEAM(2);
    if (IN(3)) { frame_refresh(F); ssdD_phase(F); dilattn_mfma_phase(F, 0); memattn_mfma_phase(F, 0); }
    SEAM(3);
    if (IN(4)) { frame_refresh(F); ssdE_phase(F, 0); dilmerge_phase(F, 0); }
    SEAM(4);
    if (IN(5)) { frame_refresh(F); pg8::Gemm g{ACT1 + (size_t)HT * DM, WallT, HT, NPROJ, DM, DM, DM}; pg8::StaticOrder S; S.init(g.M, g.N, F.G, F.bid);
        pg8::EpiBf16<0> E{BIG, NPROJ}; pg8::gemm_phase(F.lds, g, S, E, F.wave); }
    SEAM(5);
    if (IN(6)) { frame_refresh(F); ssdC_phase(F, 1); }
    SEAM(6);
    if (IN(7)) { frame_refresh(F); ssdD_phase(F); dilattn_mfma_phase(F, 1); memattn_mfma_phase(F, 1); }
    SEAM(7);
    if (IN(8)) { frame_refresh(F); ssdE_phase(F, 1); dilmerge_phase(F, 1); }
    SEAM(8);
    if (IN(9)) { frame_refresh(F);
        { pg8::Gemm g{(const bf16*)(ws + WS_U8), (const bf16*)(ws + WS_WG8), T, NGATE, DM / 2, DM / 2, DM / 2}; pg8::GateOrder S; S.B.init(T, DM, F.G, F.bid);
          pg8::EpiBf16<2> E{BIG, NGATE}; pg8::gemm_phase<true>(F.lds, g, S, E, F.wave); }
        VM_WAIT(); __syncthreads();
    }
    if (IN(10)) { frame_refresh(F);
        pg8::Gemm g{(const bf16*)F.out, (const bf16*)(ws + WS_WCATT), T, DM, YC, YC, YC}; pg8::StaticOrder S; S.init(g.M, g.N, F.G, F.bid);
        pg8::EpiBranchFused E{ACT1, DM, __builtin_amdgcn_make_buffer_rsrc((void*)BIG, 0, T * NGATE * 2, 0x00020000), NGATE}; pg8::gemm_phase(F.lds, g, S, E, F.wave);
    }
    SEAM(10);
    if (IN(11)) { frame_refresh(F); pg8::Gemm g{ACT1, (const bf16*)(ws + WS_WOUTT), T, DM, DM, DM, DM}; pg8::StaticOrder S; S.init(g.M, g.N, F.G, F.bid);
        pg8::EpiResidNorm E{F.out, DM, F.in[I_X], (bf16*)(ws + WS_HB), F.in[I_NFFNW], (float*)(ws + WS_SSQ)}; pg8::gemm_phase(F.lds, g, S, E, F.wave); }
    SEAM(11);
    if (IN(12)) { frame_refresh(F); pg8::Gemm g{(const bf16*)(ws + WS_HB), (const bf16*)(ws + WS_WQT), T, PEER_Q, DM, DM, DM}; pg8::StaticOrder S; S.init(g.M, g.N, F.G, F.bid);
        pg8::EpiBf16RowScale E{BIG, PEER_Q, (const float*)(ws + WS_SSQ)}; pg8::gemm_phase(F.lds, g, S, E, F.wave); }
    SEAM(12);
    if (IN(13)) { frame_refresh(F); peer_phase(F); }
#undef IN
#undef SEAM
}

extern "C" void kernel_launch(void* const* d_in, const int* in_sizes, int n_in, void* d_out, int out_size, void* d_ws, size_t ws_size, hipStream_t stream) {
    static int grid = 0;
    if (grid == 0) {
        if (n_in != 26 || out_size != T * DM || ws_size < WS_END) { fprintf(stderr, "kernel_launch: unexpected shapes (n_in %d, out %d, ws %zu)\n", n_in, out_size, ws_size); grid = -1; return; }
        int dev = 0, cus = 0;
        if (hipGetDevice(&dev) != hipSuccess || hipDeviceGetAttribute(&cus, hipDeviceAttributeMultiprocessorCount, dev) != hipSuccess) { grid = -1; return; }
        if (hipFuncSetAttribute((const void*)mega_fwd, hipFuncAttributeMaxDynamicSharedMemorySize, LDS_BYTES) != hipSuccess) { grid = -1; return; }
        int per_cu = 0;
        (void)hipOccupancyMaxActiveBlocksPerMultiprocessor(&per_cu, (const void*)mega_fwd, NTHR, LDS_BYTES);
        (void)hipGetLastError();
        grid = cus;
    }
    if (grid < 0) return;
    (void)hipMemsetAsync((char*)d_ws + WS_CTL, 0, CTL_ZERO_BYTES, stream);
    Args a{};
    for (int i = 0; i < 26; ++i) a.in[i] = (const float*)d_in[i];
    a.positions = (const int*)d_in[2]; a.out = (float*)d_out; a.ws = (unsigned char*)d_ws;
#if MK_N_LAUNCHES == 1
    a.ph_lo = 0; a.ph_hi = N_PHASES;
    hipLaunchKernelGGL(mega_fwd, dim3(grid), dim3(NTHR), LDS_BYTES, stream, a);
#else
    for (int p = 0; p < N_PHASES; ++p) { a.ph_lo = p; a.ph_hi = p + 1; hipLaunchKernelGGL(mega_fwd, dim3(grid), dim3(NTHR), LDS_BYTES, stream, a); }
#endif
}
```

```cpp
#include <hip/hip_runtime.h>
#include <cstdio>
#include <cstdint>

#ifndef MK_N_LAUNCHES
#define MK_N_LAUNCHES 1
#endif

#define LAS __attribute__((address_space(3)))
#define GAS __attribute__((address_space(1)))
typedef unsigned short bf16;
typedef short bf16x8 __attribute__((ext_vector_type(8)));
typedef float f32x4 __attribute__((ext_vector_type(4)));
typedef float f32x2 __attribute__((ext_vector_type(2)));
typedef unsigned u32x4 __attribute__((ext_vector_type(4)));
typedef unsigned u32x2 __attribute__((ext_vector_type(2)));
typedef int i32x4 __attribute__((ext_vector_type(4)));
typedef int i32x8 __attribute__((ext_vector_type(8)));

constexpr int NB = 8, SEQ = 8192, DM = 1024, T = NB * SEQ;
constexpr int HB = 4, HT = HB * SEQ;
constexpr int NMEM = 256;
constexpr int NPROJ = 6144;
constexpr int PC_Z = 0, PC_X = 1024, PC_B = 2048, PC_C = 2560, PC_DQ = 3072, PC_DK = 3840, PC_DV = 4608, PC_MQ = 5376;
constexpr int W_IN_N = 9232, OFF_DT = 3072, OFF_AFTER_DT = 3088;
constexpr int NGATE = 3072;
constexpr int YC = 2048;
constexpr int PEER_H = 8, PEER_K = 16, PEER_NK = 128, PEER_Q = 2048;
constexpr float EPS = 1e-6f;

constexpr size_t MiB = 1u << 20;
constexpr size_t WS_CTL = 0, WS_WAMAX = 65536, CTL_ZERO_BYTES = 131072;
constexpr size_t WS_WALLT = 1 * MiB;
constexpr size_t WS_WMKVT = 19 * MiB;
constexpr size_t WS_WCATT = 22 * MiB;
constexpr size_t WS_WOUTT = 26 * MiB;
constexpr size_t WS_WQT = 28 * MiB;
constexpr size_t WS_SUBK = 32 * MiB;
constexpr size_t WS_PD = 33 * MiB;
constexpr size_t WS_PU = 65 * MiB;
constexpr size_t WS_DT = 97 * MiB;
constexpr size_t WS_MEMN = 101 * MiB;
constexpr size_t WS_MKV = 105 * MiB;
constexpr size_t WS_ACT1 = 112 * MiB;
constexpr size_t WS_BIG = 240 * MiB;
constexpr size_t WS_LSE = 624 * MiB;
constexpr size_t WS_MVT = 628 * MiB;
constexpr size_t WS_DEC = 631 * MiB;
constexpr size_t WS_SST = 632 * MiB;
constexpr size_t WS_SIN = 760 * MiB;
constexpr size_t WS_ROPE = 824 * MiB;
constexpr size_t WS_SSQ = 828 * MiB;
constexpr size_t WS_HB = 632 * MiB;
constexpr size_t WS_U8 = 832 * MiB;
constexpr size_t WS_W8 = WS_WALLT;
constexpr size_t WS_WSC = 896 * MiB;
constexpr size_t WS_USC = 897 * MiB;
constexpr size_t WS_END = 898 * MiB;

constexpr int RING_BYTES = 131072;
constexpr int LDSCTL_OFF = 143360;
constexpr int LDS_BYTES = 147456;
constexpr int NWAVES = 8, NTHR = 512;

__device__ __forceinline__ int lane_id() { return (int)__builtin_amdgcn_mbcnt_hi(~0u, __builtin_amdgcn_mbcnt_lo(~0u, 0u)); }
__device__ __forceinline__ float bf2f(unsigned short b) { return __builtin_bit_cast(float, (unsigned)b << 16); }
__device__ __forceinline__ float bflo(unsigned w) { return __builtin_bit_cast(float, w << 16); }
__device__ __forceinline__ float bfhi(unsigned w) { return __builtin_bit_cast(float, w & 0xffff0000u); }
__device__ __forceinline__ unsigned f2bf(float f) { unsigned u = __builtin_bit_cast(unsigned, f); return (u + 0x7fffu + ((u >> 16) & 1u)) >> 16; }
__device__ __forceinline__ unsigned pk2(float lo, float hi) { return f2bf(lo) | (f2bf(hi) << 16); }
typedef float f32x16 __attribute__((ext_vector_type(16)));
typedef short s16x4 __attribute__((ext_vector_type(4)));
typedef __bf16 bf2_t __attribute__((ext_vector_type(2)));
__device__ __forceinline__ unsigned pkbf(float a, float b) { const f32x2 v = {a, b}; return __builtin_bit_cast(unsigned, __builtin_convertvector(v, bf2_t)); }
#define MFMA32(a, b, c) __builtin_amdgcn_mfma_f32_32x32x16_bf16((a), (b), (c), 0, 0, 0)
__device__ __forceinline__ float wave_sum(float v) {
#pragma unroll
    for (int o = 1; o < 64; o <<= 1) v += __shfl_xor(v, o);
    return v;
}
__device__ __forceinline__ float wave_max(float v) {
#pragma unroll
    for (int o = 1; o < 64; o <<= 1) v = fmaxf(v, __shfl_xor(v, o));
    return v;
}
__device__ __forceinline__ float sigmoidf_(float x) { return 1.0f / (1.0f + __expf(-x)); }
#define LDS_WAIT() asm volatile("s_waitcnt lgkmcnt(0)" ::: "memory")
#define VM_WAIT() asm volatile("s_waitcnt vmcnt(0)" ::: "memory")

#define XB_TMO      128
#define XB_XCNT(j)  (256  + 64 * (j))
#define XB_XSUB(j)  (1280 + 64 * (j))
#define XB_XGEN(j)  (2304 + 64 * (j))
#define XB_TOP      3328
#define XB_TOPGEN   3392
#define XCD_BAR_WORDS 3456
#define XB_SPIN_CAP (1u << 18)
__device__ __forceinline__ unsigned xb_ld(unsigned* p)              { return __hip_atomic_load(p, __ATOMIC_RELAXED, __HIP_MEMORY_SCOPE_AGENT); }
__device__ __forceinline__ unsigned xb_add(unsigned* p, unsigned v) { return __hip_atomic_fetch_add(p, v, __ATOMIC_RELAXED, __HIP_MEMORY_SCOPE_AGENT); }
__device__ __forceinline__ unsigned xb_xcc_id() { return (unsigned)__builtin_amdgcn_s_getreg((3 << 11) | 20) & 0xFu; }
#define XB_SPIN(cond, bar) do { unsigned _sp = 0; while (cond) { __builtin_amdgcn_s_sleep(1); \
    if ((++_sp & 255u) == 0u) { if (xb_ld(&(bar)[XB_TMO])) break; if (_sp > XB_SPIN_CAP) { atomicAdd(&(bar)[XB_TMO], 1u); break; } } } } while (0)
struct XcdBarrier { unsigned* bar; unsigned x; volatile LAS unsigned* st; int wave; };
__device__ __forceinline__ XcdBarrier xcd_barrier_post(unsigned* bar, volatile LAS unsigned* st, int wave) {
    XcdBarrier b; b.bar = bar; b.x = xb_xcc_id(); b.st = st; b.wave = wave;
    if (wave == 0 && lane_id() == 0) (void)xb_add(&bar[XB_XCNT(b.x)], 1u);
    return b;
}
__device__ __forceinline__ void xcd_barrier_complete(unsigned* bar, unsigned x, unsigned& nloc, unsigned& nx) {
    const unsigned G = gridDim.x * gridDim.y * gridDim.z;
    unsigned sum, cnt, mine, sp = 0u;
    for (;;) {
        sum = 0u; cnt = 0u; mine = 0u;
#pragma unroll
        for (unsigned j = 0; j < 16; ++j) { const unsigned c = xb_ld(&bar[XB_XCNT(j)]); sum += c; cnt += (c > 0u) ? 1u : 0u; mine = (j == x) ? c : mine; }
        if (sum == G) break;
        __builtin_amdgcn_s_sleep(1);
        if ((++sp & 255u) == 0u) { if (xb_ld(&bar[XB_TMO])) break; if (sp > XB_SPIN_CAP) { atomicAdd(&bar[XB_TMO], 1u); break; } }
    }
    nloc = mine > 0u ? mine : 1u; nx = cnt > 0u ? cnt : 1u;
}
__device__ __forceinline__ void xcd_barrier(const XcdBarrier& b) {
    asm volatile("s_waitcnt vmcnt(0)" ::: "memory");
    __syncthreads();
    if (b.wave == 0 && lane_id() == 0) {
        unsigned* bar = b.bar;
        __builtin_amdgcn_s_waitcnt(0);
        unsigned nloc = b.st[0], nx = b.st[1];
        if (nloc == 0u) { xcd_barrier_complete(bar, b.x, nloc, nx); b.st[0] = nloc; b.st[1] = nx; }
        const unsigned old = xb_add(&bar[XB_XSUB(b.x)], 1u);
        const unsigned gen = old / nloc;
        if (old + 1u == (gen + 1u) * nloc) {
            __builtin_amdgcn_fence(__ATOMIC_RELEASE, "agent");
            asm volatile("s_waitcnt vmcnt(0)" ::: "memory");
            const unsigned og = xb_add(&bar[XB_TOP], 1u);
            const unsigned tg = og / nx;
            if (og + 1u == (tg + 1u) * nx) xb_add(&bar[XB_TOPGEN], 1u);
            else XB_SPIN(xb_ld(&bar[XB_TOPGEN]) == tg, bar);
            __builtin_amdgcn_fence(__ATOMIC_ACQUIRE, "agent");
            xb_add(&bar[XB_XGEN(b.x)], 1u);
            asm volatile("s_waitcnt vmcnt(0)" ::: "memory");
        } else {
            XB_SPIN(xb_ld(&bar[XB_XGEN(b.x)]) == gen, bar);
            __builtin_amdgcn_fence(__ATOMIC_ACQUIRE, "agent");
            asm volatile("s_waitcnt vmcnt(0)" ::: "memory");
        }
    }
    __syncthreads();
}

namespace pg8 {
constexpr int BM = 256, BK = 64, HALF = 128, HTB = HALF * BK * 2, STAGE_BYTES = 8 * HTB, NXCD = 8, WGM = 8;
__host__ __device__ __forceinline__ int lds_byte(int r, int c) { const int st = (r >> 4) * 2 + (c >> 5), rr = r & 15, cc = c & 31, ob = rr * 64 + cc * 2; return st * 1024 + (ob ^ (((ob >> 9) & 1) << 5)); }
__host__ __device__ __forceinline__ void stage_rc(int b, int& R, int& C) { const int st = b / 1024, sb = b % 1024, swz = sb ^ (((sb >> 9) & 1) << 5); R = (st >> 1) * 16 + swz / 64; C = (st & 1) * 32 + (swz % 64) / 2; }
__host__ __device__ __forceinline__ int perm32(int rho) { const int n = rho >> 4, i = rho & 15; return 8 * (i >> 2) + 4 * n + (i & 3); }
struct Unit { int pm, pn; };
struct Gemm { const bf16* A; const bf16* Bt; int M, N, K, lda, ldb; };
struct StaticOrder {
    int nM, nN, nwg, G, c;
    __host__ __device__ void init(int M, int N, int G_, int c_) { nM = M / BM; nN = N / BM; nwg = nM * nN; G = G_; c = c_; }
    __host__ __device__ bool next(int i, Unit& u) const {
        const long L = (long)i * G + c; if (L >= nwg) return false;
        int wgid = (int)L; { const int q = nwg / NXCD, r = nwg % NXCD, xcd = wgid % NXCD, off = wgid / NXCD; wgid = (xcd < r ? xcd * (q + 1) : r * (q + 1) + (xcd - r) * q) + off; }
        const int nig = WGM * nN, gid = wgid / nig, fm = gid * WGM, gsz = (nM - fm) < WGM ? (nM - fm) : WGM;
        u.pm = fm + ((wgid % nig) % gsz); u.pn = (wgid % nig) / gsz; return true;
    }
    __device__ __forceinline__ void a_ready(const Unit&) const {}
    __device__ __forceinline__ void done(const Unit&) const {}
};
struct GateOrder {
    StaticOrder B;
    __device__ __forceinline__ bool next(int i, Unit& u) const { Unit t; if (!B.next(i / 3, t)) return false; u.pm = t.pm; u.pn = t.pn + 4 * (i % 3); return true; }
    __device__ __forceinline__ void a_ready(const Unit&) const {}
    __device__ __forceinline__ void done(const Unit&) const {}
};
__device__ __forceinline__ unsigned cvt_pk_bf16(float lo, float hi) { unsigned r; asm volatile("v_cvt_pk_bf16_f32 %0, %1, %2" : "=v"(r) : "v"(lo), "v"(hi)); return r; }

constexpr float WG_SCALE = 32.0f;
template <int ACT> struct EpiBf16 {
    static constexpr bool PERM = true, AFTER_DRAIN = false, HAS_MID = false;
    bf16* O; int ldc;
    __device__ __forceinline__ void operator()(const f32x4 (&acc)[2][2][4][2], const Unit& u, int wr, int wc, int fr, int fq) const {
        const int row0 = u.pm * BM + wr * 64 + fr; const int col0 = u.pn * BM + wc * 32 + 8 * fq;
#pragma unroll
        for (int ai = 0; ai < 2; ++ai)
#pragma unroll
            for (int m = 0; m < 4; ++m) { bf16* rowp = O + (size_t)(row0 + ai * HALF + m * 16) * ldc + col0;
#pragma unroll
                for (int bj = 0; bj < 2; ++bj) { f32x4 v0 = acc[ai][bj][m][0], v1 = acc[ai][bj][m][1];
                    if (ACT == 1) {
#pragma unroll
                        for (int j = 0; j < 4; ++j) { v0[j] = sigmoidf_(v0[j]); v1[j] = sigmoidf_(v1[j]); } }
                    if (ACT == 2) {
#pragma unroll
                        for (int j = 0; j < 4; ++j) { v0[j] = sigmoidf_(v0[j] * (1.0f / WG_SCALE)); v1[j] = sigmoidf_(v1[j] * (1.0f / WG_SCALE)); } }
                    u32x4 w; w.x = cvt_pk_bf16(v0[0], v0[1]); w.y = cvt_pk_bf16(v0[2], v0[3]); w.z = cvt_pk_bf16(v1[0], v1[1]); w.w = cvt_pk_bf16(v1[2], v1[3]);
                    *(u32x4*)(rowp + bj * HALF) = w; } }
    }
};
__device__ __forceinline__ f32x4 i2f4(f32x4 a) { return __builtin_convertvector(__builtin_bit_cast(i32x4, a), f32x4); }
template <int ACT> struct EpiBf16Q {
    static constexpr bool PERM = true, AFTER_DRAIN = false, HAS_MID = false;
    bf16* O; int ldc; const float* sa; const float* sb;
    __device__ __forceinline__ void operator()(const f32x4 (&acc)[2][2][4][2], const Unit& u, int wr, int wc, int fr, int fq) const {
        const int row0 = u.pm * BM + wr * 64 + fr; const int col0 = u.pn * BM + wc * 32 + 8 * fq;
        f32x4 sbv[2][2];
#pragma unroll
        for (int bj = 0; bj < 2; ++bj)
#pragma unroll
            for (int n = 0; n < 2; ++n) sbv[bj][n] = *(const f32x4*)(sb + col0 + bj * HALF + 4 * n);
#pragma unroll
        for (int ai = 0; ai < 2; ++ai)
#pragma unroll
            for (int m = 0; m < 4; ++m) { const int row = row0 + ai * HALF + m * 16; const float sr = sa[row]; bf16* rowp = O + (size_t)row * ldc + col0;
#pragma unroll
                for (int bj = 0; bj < 2; ++bj) { f32x4 v0 = i2f4(acc[ai][bj][m][0]) * sr * sbv[bj][0], v1 = i2f4(acc[ai][bj][m][1]) * sr * sbv[bj][1];
                    if (ACT == 1) {
#pragma unroll
                        for (int j = 0; j < 4; ++j) { v0[j] = sigmoidf_(v0[j]); v1[j] = sigmoidf_(v1[j]); } }
                    u32x4 w; w.x = cvt_pk_bf16(v0[0], v0[1]); w.y = cvt_pk_bf16(v0[2], v0[3]); w.z = cvt_pk_bf16(v1[0], v1[1]); w.w = cvt_pk_bf16(v1[2], v1[3]);
                    *(u32x4*)(rowp + bj * HALF) = w; } }
    }
};
struct EpiResid {
    static constexpr bool PERM = false, AFTER_DRAIN = false, HAS_MID = false;
    float* C; int ldc; const float* R;
    __device__ __forceinline__ void operator()(const f32x4 (&acc)[2][2][4][2], const Unit& u, int wr, int wc, int fr, int fq) const {
        const int row0 = u.pm * BM + wr * 64 + fr, col0 = u.pn * BM + wc * 32 + 4 * fq;
#pragma unroll
        for (int ai = 0; ai < 2; ++ai)
#pragma unroll
            for (int m = 0; m < 4; ++m) { const size_t off = (size_t)(row0 + ai * HALF + m * 16) * ldc + col0;
#pragma unroll
                for (int bj = 0; bj < 2; ++bj)
#pragma unroll
                    for (int n = 0; n < 2; ++n) { const f32x4 r = *(const f32x4*)(R + off + bj * HALF + n * 16); *(f32x4*)(C + off + bj * HALF + n * 16) = acc[ai][bj][m][n] + r; } }
    }
};

struct EpiResidNorm {
    static constexpr bool PERM = false, AFTER_DRAIN = false, HAS_MID = false;
    float* C; int ldc; const float* R; bf16* Hb; const float* w; float* SSQ;
    __device__ __forceinline__ void operator()(const f32x4 (&acc)[2][2][4][2], const Unit& u, int wr, int wc, int fr, int fq) const {
        const int row0 = u.pm * BM + wr * 64 + fr, col0 = u.pn * BM + wc * 32 + 4 * fq;
        f32x4 wv[2][2];
#pragma unroll
        for (int bj = 0; bj < 2; ++bj)
#pragma unroll
            for (int n = 0; n < 2; ++n) wv[bj][n] = *(const f32x4*)(w + col0 + bj * HALF + n * 16);
#pragma unroll
        for (int ai = 0; ai < 2; ++ai)
#pragma unroll
            for (int m = 0; m < 4; ++m) { const int row = row0 + ai * HALF + m * 16; const size_t off = (size_t)row * ldc + col0; float ss = 0.f;
#pragma unroll
                for (int bj = 0; bj < 2; ++bj)
#pragma unroll
                    for (int n = 0; n < 2; ++n) { const f32x4 h = acc[ai][bj][m][n] + *(const f32x4*)(R + off + bj * HALF + n * 16); *(f32x4*)(C + off + bj * HALF + n * 16) = h;
                        ss += (h.x * h.x + h.y * h.y) + (h.z * h.z + h.w * h.w);
                        const u32x2 hb2 = {cvt_pk_bf16(h.x * wv[bj][n].x, h.y * wv[bj][n].y), cvt_pk_bf16(h.z * wv[bj][n].z, h.w * wv[bj][n].w)}; *(u32x2*)(Hb + off + bj * HALF + n * 16) = hb2; }
                ss += __shfl_xor(ss, 16); ss += __shfl_xor(ss, 32);
                if (fq == 0) atomicAdd(SSQ + row, ss); }
    }
};
struct EpiBf16RowScale {
    static constexpr bool PERM = true, AFTER_DRAIN = false, HAS_MID = false;
    bf16* O; int ldc; const float* SSQ;
    __device__ __forceinline__ void operator()(const f32x4 (&acc)[2][2][4][2], const Unit& u, int wr, int wc, int fr, int fq) const {
        const int row0 = u.pm * BM + wr * 64 + fr; const int col0 = u.pn * BM + wc * 32 + 8 * fq;
#pragma unroll
        for (int ai = 0; ai < 2; ++ai)
#pragma unroll
            for (int m = 0; m < 4; ++m) { const int row = row0 + ai * HALF + m * 16; bf16* rowp = O + (size_t)row * ldc + col0; const float rs = 1.0f / sqrtf(SSQ[row] * (1.f / DM) + EPS);
#pragma unroll
                for (int bj = 0; bj < 2; ++bj) { const f32x4 v0 = acc[ai][bj][m][0] * rs, v1 = acc[ai][bj][m][1] * rs;
                    u32x4 w; w.x = cvt_pk_bf16(v0[0], v0[1]); w.y = cvt_pk_bf16(v0[2], v0[3]); w.z = cvt_pk_bf16(v1[0], v1[1]); w.w = cvt_pk_bf16(v1[2], v1[3]);
                    *(u32x4*)(rowp + bj * HALF) = w; } }
    }
};

struct EpiBranchFused {
    static constexpr bool PERM = true, AFTER_DRAIN = false, HAS_MID = true;
    static constexpr int MID0 = 16, MID1 = 20;
    bf16* O; int ldc; __amdgpu_buffer_rsrc_t grs; int ldg;
    __device__ __forceinline__ void mid(f32x4 (&acc)[2][2][4][2], const Unit& u, int t, int wr, int wc, int fr, int fq) const {
        const unsigned voff = (unsigned)(((u.pm * BM + wr * 64 + fr) * ldg + u.pn * BM + wc * 32 + 8 * fq) * 2);
        const int ca = (t == MID0) ? 0 : 2048;
#pragma unroll
        for (int ai = 0; ai < 2; ++ai)
#pragma unroll
            for (int m = 0; m < 4; ++m) {
#pragma unroll
                for (int bj = 0; bj < 2; ++bj) { const int so = ((ai * HALF + m * 16) * ldg + bj * HALF) * 2 + ca;
                    const u32x4 ga = __builtin_amdgcn_raw_buffer_load_b128(grs, voff, so, 0), gb = __builtin_amdgcn_raw_buffer_load_b128(grs, voff, so + 2048, 0);
                    f32x4& v0 = acc[ai][bj][m][0]; f32x4& v1 = acc[ai][bj][m][1];
                    v0[0] *= bflo(ga.x) * __builtin_amdgcn_rcpf(fmaxf(bflo(gb.x), 1e-30f)); v0[1] *= bfhi(ga.x) * __builtin_amdgcn_rcpf(fmaxf(bfhi(gb.x), 1e-30f));
                    v0[2] *= bflo(ga.y) * __builtin_amdgcn_rcpf(fmaxf(bflo(gb.y), 1e-30f)); v0[3] *= bfhi(ga.y) * __builtin_amdgcn_rcpf(fmaxf(bfhi(gb.y), 1e-30f));
                    v1[0] *= bflo(ga.z) * __builtin_amdgcn_rcpf(fmaxf(bflo(gb.z), 1e-30f)); v1[1] *= bfhi(ga.z) * __builtin_amdgcn_rcpf(fmaxf(bfhi(gb.z), 1e-30f));
                    v1[2] *= bflo(ga.w) * __builtin_amdgcn_rcpf(fmaxf(bflo(gb.w), 1e-30f)); v1[3] *= bfhi(ga.w) * __builtin_amdgcn_rcpf(fmaxf(bfhi(gb.w), 1e-30f)); }
                __builtin_amdgcn_sched_barrier(0); }
    }
    __device__ __forceinline__ void operator()(const f32x4 (&acc)[2][2][4][2], const Unit& u, int wr, int wc, int fr, int fq) const {
        const int row0 = u.pm * BM + wr * 64 + fr; const int col0 = u.pn * BM + wc * 32 + 8 * fq;
        const unsigned voff = (unsigned)((row0 * ldg + col0) * 2);
#pragma unroll
        for (int ai = 0; ai < 2; ++ai)
#pragma unroll
            for (int m = 0; m < 4; ++m) { const size_t r = (size_t)(row0 + ai * HALF + m * 16); bf16* rowp = O + r * ldc + col0;
#pragma unroll
                for (int bj = 0; bj < 2; ++bj) { const f32x4 v0 = acc[ai][bj][m][0], v1 = acc[ai][bj][m][1];
                    const u32x4 g = __builtin_amdgcn_raw_buffer_load_b128(grs, voff, ((ai * HALF + m * 16) * ldg + bj * HALF) * 2 + 4096, 0);
                    u32x4 w; w.x = cvt_pk_bf16(v0[0] * bflo(g.x), v0[1] * bfhi(g.x)); w.y = cvt_pk_bf16(v0[2] * bflo(g.y), v0[3] * bfhi(g.y));
                    w.z = cvt_pk_bf16(v1[0] * bflo(g.z), v1[1] * bfhi(g.z)); w.w = cvt_pk_bf16(v1[2] * bflo(g.w), v1[3] * bfhi(g.w));
                    *(u32x4*)(rowp + bj * HALF) = w; } }
    }
};

template <int QM = 0, class Epi, class Sched>
__device__ __forceinline__ void gemm_phase(LAS unsigned char* lds, const Gemm g, const Sched& S, const Epi& E, int wid) {
    constexpr bool F8 = (QM == 1);
    int lane = lane_id(); asm volatile("" : "+v"(lane));
    const int tid = wid * 64 + lane, wr = wid >> 2, wc = wid & 3, fr = lane & 15, fq = lane >> 4;
    const int K = g.K, nt = K / BK;
    unsigned voffA[2], voffB[2];
#pragma unroll
    for (int i = 0; i < 2; ++i) { int R, C; stage_rc(tid * 16 + i * 8192, R, C); const int Rb = Epi::PERM ? ((R & ~31) + perm32(R & 31)) : R;
        voffA[i] = (unsigned)(R * g.lda + C) * 2u; voffB[i] = (unsigned)(Rb * g.ldb + C) * 2u; }
    const size_t kstep = (size_t)(BK * 2);
    const size_t hsA = (size_t)HALF * g.lda * 2, hsB = (size_t)HALF * g.ldb * 2;
    const size_t tsA = 2 * hsA, tsB = 2 * hsB;
    const unsigned ldsw = (unsigned)wid * 1024u;
    const int aoff = lds_byte(wr * 64 + fr, fq * 8), boff = lds_byte(wc * 32 + fr, fq * 8);
#define PG8_SA(b, h) (((b) * 2 + (h)) * HTB)
#define PG8_SB(b, h) ((4 + (b) * 2 + (h)) * HTB)
#define PG8_STAGE(bufoff, gbase, voff) do { _Pragma("unroll") for (int _i = 0; _i < 2; ++_i) \
        __builtin_amdgcn_global_load_lds((const unsigned*)((const char*)(gbase) + (voff)[_i]), (LAS unsigned*)(lds + (bufoff) + ldsw + _i * 8192), 16, 0, 0); } while (0)
#define PG8_LDA(dst, b, h) do { _Pragma("unroll") for (int m = 0; m < 4; ++m) _Pragma("unroll") for (int k = 0; k < 2; ++k) dst[m][k] = *(const LAS bf16x8*)(lds + PG8_SA(b, h) + aoff + m * 2048 + k * 1024); } while (0)
#define PG8_LDB(dst, b, h) do { _Pragma("unroll") for (int n = 0; n < 2; ++n) _Pragma("unroll") for (int k = 0; k < 2; ++k) dst[n][k] = *(const LAS bf16x8*)(lds + PG8_SB(b, h) + boff + n * 2048 + k * 1024); } while (0)
#define PG8_CAT(x, y) __builtin_shufflevector(__builtin_bit_cast(i32x4, x), __builtin_bit_cast(i32x4, y), 0, 1, 2, 3, 4, 5, 6, 7)
#define PG8_MMA(ai, bj, At, Bt) do { __builtin_amdgcn_s_setprio(1); _Pragma("unroll") for (int m = 0; m < 4; ++m) _Pragma("unroll") for (int n = 0; n < 2; ++n) { \
        if constexpr (F8) { asm volatile("v_mfma_f32_16x16x128_f8f6f4 %0, %1, %2, %0" : "+v"(acc[ai][bj][m][n]) : "v"(PG8_CAT(Bt[n][0], Bt[n][1])), "v"(PG8_CAT(At[m][0], At[m][1]))); } \
        else if constexpr (QM == 2) { _Pragma("unroll") for (int k = 0; k < 2; ++k) acc[ai][bj][m][n] = __builtin_bit_cast(f32x4, __builtin_amdgcn_mfma_i32_16x16x64_i8(__builtin_bit_cast(i32x4, Bt[n][k]), __builtin_bit_cast(i32x4, At[m][k]), __builtin_bit_cast(i32x4, acc[ai][bj][m][n]), 0, 0, 0)); } \
        else { _Pragma("unroll") for (int k = 0; k < 2; ++k) acc[ai][bj][m][n] = __builtin_amdgcn_mfma_f32_16x16x32_bf16(Bt[n][k], At[m][k], acc[ai][bj][m][n], 0, 0, 0); } } \
        __builtin_amdgcn_s_setprio(0); } while (0)
#define PG8_WAIT_V(n) asm volatile("s_waitcnt vmcnt(" #n ")" ::: "memory")
#define PG8_WAIT_L(n) asm volatile("s_waitcnt lgkmcnt(" #n ")" ::: "memory")
#define PG8_BAR __builtin_amdgcn_s_barrier()
#define PG8_SCHED __builtin_amdgcn_sched_barrier(0)
#define PG8_MFMA_SETTLE asm volatile("s_nop 15\n\ts_nop 15\n\ts_nop 7" ::: "memory")
    Unit cur, nxt; int ui = 0;
    if (!S.next(0, cur)) return;
    f32x4 acc[2][2][4][2];
#pragma unroll
    for (int a = 0; a < 2; ++a)
#pragma unroll
        for (int b = 0; b < 2; ++b)
#pragma unroll
            for (int m = 0; m < 4; ++m)
#pragma unroll
                for (int n = 0; n < 2; ++n) acc[a][b][m][n] = (f32x4){0.f, 0.f, 0.f, 0.f};
    bf16x8 At[4][2], B0[2][2], B1[2][2];
    const char* cA = (const char*)g.A + (size_t)cur.pm * tsA; const char* cB = (const char*)g.Bt + (size_t)cur.pn * tsB;
    S.a_ready(cur);
    PG8_STAGE(PG8_SB(0, 0), cB, voffB); PG8_STAGE(PG8_SB(0, 1), cB + hsB, voffB); PG8_STAGE(PG8_SA(0, 0), cA, voffA); PG8_STAGE(PG8_SA(0, 1), cA + hsA, voffA);
    if (wr == 1) PG8_BAR;
    PG8_WAIT_V(2); PG8_BAR;
    PG8_STAGE(PG8_SB(1, 0), cB + kstep, voffB); PG8_STAGE(PG8_SA(1, 0), cA + kstep, voffA); PG8_STAGE(PG8_SB(1, 1), cB + hsB + kstep, voffB);
    PG8_WAIT_V(6); PG8_BAR;
    for (;;) {
        const bool has_next = S.next(ui + 1, nxt);
        const char* nA = has_next ? (const char*)g.A + (size_t)nxt.pm * tsA : cA; const char* nB = has_next ? (const char*)g.Bt + (size_t)nxt.pn * tsB : cB;
#pragma clang loop unroll(disable)
        for (int t = 0; t < nt; t += 2) {
            const bool last = (t == nt - 2);
            const char* a1 = cA + (size_t)(t + 1) * kstep;
            const char* a2 = last ? nA : cA + (size_t)(t + 2) * kstep; const char* b2 = last ? nB : cB + (size_t)(t + 2) * kstep;
            const char* a3 = a2 + kstep; const char* b3 = b2 + kstep;
            if (last && has_next) S.a_ready(nxt);
            if constexpr (Epi::HAS_MID) { if (t == Epi::MID0 || t == Epi::MID1) { if constexpr (F8) PG8_MFMA_SETTLE; E.mid(acc, cur, t, wr, wc, fr, fq); } }
            PG8_LDB(B0, 0, 0); PG8_LDB(B1, 0, 1); PG8_SCHED; PG8_LDA(At, 0, 0); PG8_STAGE(PG8_SA(1, 1), a1 + hsA, voffA);
            PG8_WAIT_V(8); PG8_WAIT_L(0); PG8_BAR; PG8_MMA(0, 0, At, B0); PG8_MMA(0, 1, At, B1); PG8_BAR; PG8_SCHED;
            PG8_LDA(At, 0, 1); PG8_STAGE(PG8_SB(0, 0), b2, voffB); PG8_STAGE(PG8_SB(0, 1), b2 + hsB, voffB); PG8_STAGE(PG8_SA(0, 0), a2, voffA);
            PG8_WAIT_V(8); PG8_WAIT_L(0); PG8_BAR; PG8_MMA(1, 0, At, B0); PG8_MMA(1, 1, At, B1); PG8_BAR; PG8_SCHED;
            PG8_LDB(B0, 1, 0); PG8_LDB(B1, 1, 1); PG8_SCHED; PG8_LDA(At, 1, 0); PG8_STAGE(PG8_SA(0, 1), a2 + hsA, voffA);
            PG8_WAIT_V(8); PG8_WAIT_L(0); PG8_BAR; PG8_MMA(0, 0, At, B0); PG8_MMA(0, 1, At, B1); PG8_BAR; PG8_SCHED;
            PG8_LDA(At, 1, 1); PG8_STAGE(PG8_SB(1, 0), b3, voffB); PG8_STAGE(PG8_SB(1, 1), b3 + hsB, voffB); PG8_STAGE(PG8_SA(1, 0), a3, voffA);
            PG8_WAIT_V(8); PG8_WAIT_L(0); PG8_BAR; PG8_MMA(1, 0, At, B0); PG8_MMA(1, 1, At, B1); PG8_BAR; PG8_SCHED;
        }
        if constexpr (F8) PG8_MFMA_SETTLE;
        if (wr == 0) PG8_BAR;
        E(acc, cur, wr, wc, fr, fq); S.done(cur);
        if (!has_next) break;
#pragma unroll
        for (int a = 0; a < 2; ++a)
#pragma unroll
            for (int b = 0; b < 2; ++b)
#pragma unroll
                for (int m = 0; m < 4; ++m)
#pragma unroll
                    for (int n = 0; n < 2; ++n) acc[a][b][m][n] = (f32x4){0.f, 0.f, 0.f, 0.f};
        cur = nxt; cA = nA; cB = nB; ++ui;
        if (wr == 1) PG8_BAR;
    }
    PG8_WAIT_V(0);
    PG8_BAR;
#undef PG8_SA
#undef PG8_SB
#undef PG8_STAGE
#undef PG8_LDA
#undef PG8_LDB
#undef PG8_MMA
#undef PG8_CAT
#undef PG8_WAIT_V
#undef PG8_WAIT_L
#undef PG8_BAR
#undef PG8_SCHED
#undef PG8_MFMA_SETTLE
}
}

struct Args {
    const float* in[26]; const int* positions; float* out; unsigned char* ws; int ph_lo, ph_hi; int pad0, pad1;
};
struct Frame {
    LAS unsigned char* lds;
    int tid, lane, wave, G, bid;
    const float* const* in; const int* positions; float* out; unsigned char* ws;
};
__device__ __forceinline__ void frame_refresh(Frame& F) { int l = lane_id(); asm volatile("" : "+v"(l)); F.lane = l; F.tid = F.wave * 64 + l; }
enum { I_X = 0, I_MEM = 1, I_POS = 2, I_NMIXW = 3, I_WIN = 4, I_CONVW = 5, I_CONVB = 6, I_DTB = 7, I_ALOG = 8, I_SSDD = 9, I_SSDNW = 10, I_DQNW = 11, I_DKNW = 12, I_MEMNW = 13,
       I_WMKV = 14, I_MQNW = 15, I_MKNW = 16, I_WSSD = 17, I_WDIL = 18, I_WMEMBR = 19, I_WOUT = 20, I_NFFNW = 21, I_WQ = 22, I_SUBK = 23, I_PD = 24, I_PU = 25 };

constexpr float PD_SCALE = 64.0f, PU_SCALE = 8.0f;
__device__ __forceinline__ unsigned pk4_fp8(f32x4 v, float sc) {
    const float a = fminf(fmaxf(v.x * sc, -448.f), 448.f), b = fminf(fmaxf(v.y * sc, -448.f), 448.f), c = fminf(fmaxf(v.z * sc, -448.f), 448.f), d = fminf(fmaxf(v.w * sc, -448.f), 448.f);
    unsigned p = __builtin_amdgcn_cvt_pk_fp8_f32(a, b, 0, false); return __builtin_amdgcn_cvt_pk_fp8_f32(c, d, p, true);
}
__device__ __forceinline__ void p0_transpose_item(const float* W, int ldw, int src_col0, bf16* WT, int ldt, int dst_row0, int dst_col0, int nblk, LAS float* scr, int item, int lane) {
    const int kb = item / nblk, nb = item % nblk, k0 = 64 * kb, n0 = 32 * nb;
#pragma unroll 8
    for (int i = 0; i < 32; ++i) { const int kk = 2 * i + (lane >> 5); scr[kk * 33 + (lane & 31)] = W[(size_t)(k0 + kk) * ldw + src_col0 + n0 + (lane & 31)]; }
    LDS_WAIT(); asm volatile("" ::: "memory");
    const int c = lane & 7;
#pragma unroll
    for (int j = 0; j < 4; ++j) { const int n = (lane >> 3) + 8 * j; const LAS float* s = scr + (8 * c) * 33 + n;
        u32x4 o; o.x = pk2(s[0 * 33], s[1 * 33]); o.y = pk2(s[2 * 33], s[3 * 33]); o.z = pk2(s[4 * 33], s[5 * 33]); o.w = pk2(s[6 * 33], s[7 * 33]);
        *(u32x4*)(WT + (size_t)(dst_row0 + n0 + n) * ldt + dst_col0 + k0 + 8 * c) = o; }
    LDS_WAIT(); asm volatile("" ::: "memory");
}
__device__ __forceinline__ void p0_wamax_item(const float* W, int ldw, int src_col0, unsigned* AM, int dst_row0, int nblk, int item, int lane) {
    const int kb = item / nblk, nb = item % nblk, k0 = 64 * kb, n0 = 32 * nb;
    float am = 0.f;
#pragma unroll 8
    for (int i = 0; i < 32; ++i) { const int kk = 2 * i + (lane >> 5); am = fmaxf(am, fabsf(W[(size_t)(k0 + kk) * ldw + src_col0 + n0 + (lane & 31)])); }
    am = fmaxf(am, __shfl_xor(am, 32));
    if (lane < 32) atomicMax(AM + dst_row0 + n0 + lane, __float_as_uint(am));
}
__device__ __forceinline__ unsigned pk4_i8(float a, float b, float c, float d) {
    const int ia = (int)__builtin_rintf(a), ib = (int)__builtin_rintf(b), ic = (int)__builtin_rintf(c), id = (int)__builtin_rintf(d);
    return (unsigned)(ia & 255) | ((unsigned)(ib & 255) << 8) | ((unsigned)(ic & 255) << 16) | ((unsigned)id << 24);
}
__device__ __forceinline__ void p1_wquant_item(const float* W, int ldw, int src_col0, unsigned char* WT8, const unsigned* AM, float* SC, int dst_row0, int nblk, LAS float* scr, int item, int lane) {
    const int kb = item / nblk, nb = item % nblk, n0 = 32 * nb;
    const float am = __uint_as_float(AM[dst_row0 + n0 + (lane & 31)]);
    const float inv = am > 0.f ? 127.0f / am : 0.f;
    if (kb == 0 && lane < 32) SC[dst_row0 + n0 + lane] = am * (1.0f / 127.0f);
#pragma unroll 1
    for (int h = 0; h < 2; ++h) { const int k0 = 128 * kb + 64 * h;
#pragma unroll 8
        for (int i = 0; i < 32; ++i) { const int kk = 2 * i + (lane >> 5); scr[kk * 33 + (lane & 31)] = W[(size_t)(k0 + kk) * ldw + src_col0 + n0 + (lane & 31)] * inv; }
        LDS_WAIT(); asm volatile("" ::: "memory");
        const int c = lane & 7;
#pragma unroll
        for (int j = 0; j < 4; ++j) { const int n = (lane >> 3) + 8 * j; const LAS float* q = scr + (8 * c) * 33 + n;
            const u32x2 o = {pk4_i8(q[0 * 33], q[1 * 33], q[2 * 33], q[3 * 33]), pk4_i8(q[4 * 33], q[5 * 33], q[6 * 33], q[7 * 33])};
            *(u32x2*)(WT8 + (size_t)(dst_row0 + n0 + n) * 1024 + k0 + 8 * c) = o; }
        LDS_WAIT(); asm volatile("" ::: "memory"); }
}
__device__ __forceinline__ void rms_row_to_bf16(const float* xrow, const float* w, bf16* orow, int lane, f32x4 (&v)[4]) {
    const f32x4* xr = (const f32x4*)xrow + lane; const f32x4* wr = (const f32x4*)w + lane;
    float s = 0.f;
#pragma unroll
    for (int j = 0; j < 4; ++j) { v[j] = xr[64 * j]; s += (v[j].x * v[j].x + v[j].y * v[j].y) + (v[j].z * v[j].z + v[j].w * v[j].w); }
    const float rstd = 1.0f / sqrtf(wave_sum(s) * (1.f / DM) + EPS);
    unsigned long long* o8 = (unsigned long long*)orow + lane;
#pragma unroll
    for (int j = 0; j < 4; ++j) { const f32x4 ww = wr[64 * j]; v[j] = v[j] * rstd * ww;
        o8[64 * j] = (unsigned long long)pk2(v[j].x, v[j].y) | ((unsigned long long)pk2(v[j].z, v[j].w) << 32); }
}
__device__ __forceinline__ void rms_rows_finish(f32x4 (&v)[4], const float* w, unsigned char* orow8, float* osc, int lane) {
    const f32x4* wr = (const f32x4*)w + lane;
    float s = 0.f;
#pragma unroll
    for (int j = 0; j < 4; ++j) s += (v[j].x * v[j].x + v[j].y * v[j].y) + (v[j].z * v[j].z + v[j].w * v[j].w);
    const float rstd = 1.0f / sqrtf(wave_sum(s) * (1.f / DM) + EPS);
    float am = 0.f;
#pragma unroll
    for (int j = 0; j < 4; ++j) { const f32x4 ww = wr[64 * j]; v[j] = v[j] * rstd * ww; am = fmaxf(fmaxf(am, fmaxf(fabsf(v[j].x), fabsf(v[j].y))), fmaxf(fabsf(v[j].z), fabsf(v[j].w))); }
    am = wave_max(am);
    const float inv = am > 0.f ? 127.0f / am : 0.f;
    unsigned* o4 = (unsigned*)orow8 + lane;
#pragma unroll
    for (int j = 0; j < 4; ++j) o4[64 * j] = pk4_i8(v[j].x * inv, v[j].y * inv, v[j].z * inv, v[j].w * inv);
    if (lane == 0) *osc = am * (1.0f / 127.0f);
}
__device__ __forceinline__ void cvt_f32_bf16_stream(const float* src, bf16* dst, size_t n, size_t gtid, size_t gthreads) {
    for (size_t i = gtid * 8; i < n; i += gthreads * 8) { const f32x4 a = *(const f32x4*)(src + i), b = *(const f32x4*)(src + i + 4);
        u32x4 o; o.x = pk2(a.x, a.y); o.y = pk2(a.z, a.w); o.z = pk2(b.x, b.y); o.w = pk2(b.z, b.w); *(u32x4*)(dst + i) = o; }
}
__device__ __forceinline__ void cvt_f32_fp8_sliced(const float* src, unsigned char* dst, float sc, size_t gtid, size_t gthreads) {
    for (size_t i = gtid * 16; i < (size_t)16384 * 1024; i += gthreads * 16) { const f32x4 a = *(const f32x4*)(src + i), b = *(const f32x4*)(src + i + 4), c = *(const f32x4*)(src + i + 8), d = *(const f32x4*)(src + i + 12);
        const size_t e = i >> 10, dd = i & 1023;
        const u32x4 o = {pk4_fp8(a, sc), pk4_fp8(b, sc), pk4_fp8(c, sc), pk4_fp8(d, sc)}; *(u32x4*)(dst + ((((dd >> 7) * 16384 + e) << 7) + (dd & 127))) = o; }
}
__device__ __forceinline__ void p0_prologue(Frame& F) {
    LAS float* scr = (LAS float*)(F.lds + F.wave * 8448);
    LAS float* wdt = (LAS float*)(F.lds + 8 * 8448);
    const int gw = F.bid * NWAVES + F.wave, NGW = F.G * NWAVES;
    unsigned char* ws = F.ws;
    for (int i = F.tid; i < 1024 * 16; i += NTHR) { const int k = i >> 4, c = i & 15, l = (k & 255) >> 2, e = k & 3, j = k >> 8, q = c >> 2;
        wdt[((((j * 4 + e) * 4 + q) * 64 + l) << 2) + (c & 3)] = F.in[I_WIN][(size_t)k * W_IN_N + OFF_DT + c]; }
    __syncthreads();
    constexpr int IT_A = 16 * 96, IT_B = 16 * 192, IT_MKV = 16 * 48, IT_SSD = 16 * 32, IT_DIL = 4 * 32, IT_MBR = 12 * 32, IT_OUT = 16 * 32, IT_WQ = 16 * 64;
    constexpr int NITEMS = IT_A + IT_B + IT_MKV + IT_SSD + IT_DIL + IT_MBR + IT_OUT + IT_WQ;
    for (int it = gw; it < NITEMS; it += NGW) {
        int r = it;
        if (r < IT_A) { p0_wamax_item(F.in[I_WIN], W_IN_N, 0, (unsigned*)(ws + WS_WAMAX), 0, 96, r, F.lane); continue; } r -= IT_A;
        if (r < IT_B) { p0_wamax_item(F.in[I_WIN], W_IN_N, OFF_AFTER_DT, (unsigned*)(ws + WS_WAMAX), 3072, 192, r, F.lane); continue; } r -= IT_B;
        if (r < IT_MKV) { p0_transpose_item(F.in[I_WMKV], 1536, 0, (bf16*)(ws + WS_WMKVT), DM, 0, 0, 48, scr, r, F.lane); continue; } r -= IT_MKV;
        if (r < IT_SSD) { p0_transpose_item(F.in[I_WSSD], DM, 0, (bf16*)(ws + WS_WCATT), YC, 0, 0, 32, scr, r, F.lane); continue; } r -= IT_SSD;
        if (r < IT_DIL) { p0_transpose_item(F.in[I_WDIL], DM, 0, (bf16*)(ws + WS_WCATT), YC, 0, 1024, 32, scr, r, F.lane); continue; } r -= IT_DIL;
        if (r < IT_MBR) { p0_transpose_item(F.in[I_WMEMBR], DM, 0, (bf16*)(ws + WS_WCATT), YC, 0, 1280, 32, scr, r, F.lane); continue; } r -= IT_MBR;
        if (r < IT_OUT) { p0_transpose_item(F.in[I_WOUT], DM, 0, (bf16*)(ws + WS_WOUTT), DM, 0, 0, 32, scr, r, F.lane); continue; } r -= IT_OUT;
        p0_transpose_item(F.in[I_WQ], PEER_Q, 0, (bf16*)(ws + WS_WQT), DM, 0, 0, 64, scr, r, F.lane);
    }
    const size_t gtid = (size_t)F.bid * NTHR + F.tid, gth = (size_t)F.G * NTHR;
    cvt_f32_bf16_stream(F.in[I_SUBK], (bf16*)(ws + WS_SUBK), (size_t)8 * 2 * 128 * 128, gtid, gth);
    cvt_f32_fp8_sliced(F.in[I_PD], ws + WS_PD, PD_SCALE, gtid, gth);
    cvt_f32_fp8_sliced(F.in[I_PU], ws + WS_PU, PU_SCALE, gtid, gth);
    for (int m = gw; m < NB * NMEM; m += NGW) { f32x4 v[4]; rms_row_to_bf16(F.in[I_MEM] + (size_t)m * DM, F.in[I_MEMNW], (bf16*)(ws + WS_MEMN) + (size_t)m * DM, F.lane, v); }
    for (size_t i = gtid; i < (size_t)T; i += gth) ((float*)(ws + WS_SSQ))[i] = 0.f;
    { float* RT = (float*)(ws + WS_ROPE);
      for (size_t i = gtid; i < (size_t)T * 8; i += gth) { const int tok = (int)(i >> 3), a = (int)(i & 7);
          const float inv = __expf(-logf(500000.0f) * (2.0f / 16.0f) * (float)a);
          const double rev = (double)((float)F.positions[tok] * inv) * 0.15915494309189535; const float fr = (float)(rev - floor(rev));
          RT[(size_t)tok * 16 + a] = __builtin_amdgcn_cosf(fr); RT[(size_t)tok * 16 + 8 + a] = __builtin_amdgcn_sinf(fr); } }
    float* DTp = (float*)(ws + WS_DT);
    const int lane = F.lane;
    const int myj = ((lane >> 5) & 1) * 8 + ((lane >> 4) & 1) * 4 + ((lane >> 3) & 1) * 2 + ((lane >> 2) & 1);
    const float dtb = F.in[I_DTB][myj];
    f32x4 na[4], nb[4];
    { const int m0 = 2 * gw < T ? 2 * gw : 0; const f32x4* xa = (const f32x4*)(F.in[I_X] + (size_t)m0 * DM) + lane; const f32x4* xb = (const f32x4*)(F.in[I_X] + (size_t)(m0 + 1) * DM) + lane;
#pragma unroll
      for (int j = 0; j < 4; ++j) { na[j] = xa[64 * j]; nb[j] = xb[64 * j]; } }
    for (int m = 2 * gw; m < T; m += 2 * NGW) {
        f32x4 va[4], vb[4];
#pragma unroll
        for (int j = 0; j < 4; ++j) { va[j] = na[j]; vb[j] = nb[j]; }
        { const int mn = (m + 2 * NGW < T) ? m + 2 * NGW : m; const f32x4* xa = (const f32x4*)(F.in[I_X] + (size_t)mn * DM) + lane; const f32x4* xb = (const f32x4*)(F.in[I_X] + (size_t)(mn + 1) * DM) + lane;
#pragma unroll
          for (int j = 0; j < 4; ++j) { na[j] = xa[64 * j]; nb[j] = xb[64 * j]; } }
        rms_rows_finish(va, F.in[I_NMIXW], ws + WS_U8 + (size_t)m * DM, (float*)(ws + WS_USC) + m, lane);
        rms_rows_finish(vb, F.in[I_NMIXW], ws + WS_U8 + (size_t)(m + 1) * DM, (float*)(ws + WS_USC) + m + 1, lane);
        float da[16], db[16];
#pragma unroll
        for (int j = 0; j < 16; ++j) { da[j] = 0.f; db[j] = 0.f; }
#pragma unroll
        for (int j = 0; j < 4; ++j)
#pragma unroll
            for (int e = 0; e < 4; ++e) { const float ua = va[j][e], ub = vb[j][e];
#pragma unroll
                for (int q = 0; q < 4; ++q) { const f32x4 w4 = *(const LAS f32x4*)(wdt + ((((j * 4 + e) * 4 + q) * 64 + lane) << 2));
                    da[4 * q + 0] += ua * w4.x; da[4 * q + 1] += ua * w4.y; da[4 * q + 2] += ua * w4.z; da[4 * q + 3] += ua * w4.w;
                    db[4 * q + 0] += ub * w4.x; db[4 * q + 1] += ub * w4.y; db[4 * q + 2] += ub * w4.z; db[4 * q + 3] += ub * w4.w; }
                __builtin_amdgcn_sched_barrier(0); }
        float ra, rb;
        { float r8a[8], r8b[8], r4a[4], r4b[4], r2a[2], r2b[2];
          { const bool up = (lane & 32) != 0;
#pragma unroll
            for (int k = 0; k < 8; ++k) { r8a[k] = (up ? da[k + 8] : da[k]) + __shfl_xor(up ? da[k] : da[k + 8], 32); r8b[k] = (up ? db[k + 8] : db[k]) + __shfl_xor(up ? db[k] : db[k + 8], 32); } }
          { const bool up = (lane & 16) != 0;
#pragma unroll
            for (int k = 0; k < 4; ++k) { r4a[k] = (up ? r8a[k + 4] : r8a[k]) + __shfl_xor(up ? r8a[k] : r8a[k + 4], 16); r4b[k] = (up ? r8b[k + 4] : r8b[k]) + __shfl_xor(up ? r8b[k] : r8b[k + 4], 16); } }
          { const bool up = (lane & 8) != 0;
#pragma unroll
            for (int k = 0; k < 2; ++k) { r2a[k] = (up ? r4a[k + 2] : r4a[k]) + __shfl_xor(up ? r4a[k] : r4a[k + 2], 8); r2b[k] = (up ? r4b[k + 2] : r4b[k]) + __shfl_xor(up ? r4b[k] : r4b[k + 2], 8); } }
          { const bool up = (lane & 4) != 0; ra = (up ? r2a[1] : r2a[0]) + __shfl_xor(up ? r2a[0] : r2a[1], 4); rb = (up ? r2b[1] : r2b[0]) + __shfl_xor(up ? r2b[0] : r2b[1], 4); }
          ra += __shfl_xor(ra, 2); ra += __shfl_xor(ra, 1); rb += __shfl_xor(rb, 2); rb += __shfl_xor(rb, 1); }
        if ((lane & 3) == 0) { const float xa = ra + dtb, xb = rb + dtb;
            DTp[(size_t)m * 16 + myj] = (xa > 20.f) ? xa : log1pf(__expf(xa)); DTp[(size_t)(m + 1) * 16 + myj] = (xb > 20.f) ? xb : log1pf(__expf(xb)); }
    }
}

__device__ __forceinline__ void p1_wquant(Frame& F) {
    LAS float* scr = (LAS float*)(F.lds + F.wave * 8448);
    const int gw = F.bid * NWAVES + F.wave, NGW = F.G * NWAVES;
    unsigned char* ws = F.ws;
    constexpr int QA = 8 * 96, QB = 8 * 192;
    for (int it = gw; it < QA + QB; it += NGW) {
        if (it < QA) p1_wquant_item(F.in[I_WIN], W_IN_N, 0, ws + WS_W8, (const unsigned*)(ws + WS_WAMAX), (float*)(ws + WS_WSC), 0, 96, scr, it, F.lane);
        else p1_wquant_item(F.in[I_WIN], W_IN_N, OFF_AFTER_DT, ws + WS_W8, (const unsigned*)(ws + WS_WAMAX), (float*)(ws + WS_WSC), 3072, 192, scr, it - QA, F.lane);
    }
}

__device__ __forceinline__ void norm192_inplace(bf16* p, const float (&w)[4], int lane) {
    u32x2 v = {0u, 0u};
    if (lane < 48) v = *(const u32x2*)(p + 4 * lane);
    float x0 = bflo(v.x), x1 = bfhi(v.x), x2 = bflo(v.y), x3 = bfhi(v.y);
    const float ss = wave_sum((x0 * x0 + x1 * x1) + (x2 * x2 + x3 * x3));
    const float rs = 1.0f / sqrtf(ss * (1.f / 192.f) + EPS);
    if (lane < 48) { const u32x2 o = {pkbf(x0 * rs * w[0], x1 * rs * w[1]), pkbf(x2 * rs * w[2], x3 * rs * w[3])}; *(u32x2*)(p + 4 * lane) = o; }
}
__device__ __forceinline__ void mknorm_phase(Frame& F) {
    const int gw = F.bid * NWAVES + F.wave, NGW = F.G * NWAVES, lane = F.lane;
    float wmk[4];
#pragma unroll
    for (int j = 0; j < 4; ++j) wmk[j] = F.in[I_MKNW][(4 * lane + j) % 192];
    bf16* MK = (bf16*)(F.ws + WS_MKV);
    for (int r = gw; r < NB * NMEM * 4; r += NGW) norm192_inplace(MK + (size_t)(r >> 2) * 1536 + (r & 3) * 192, wmk, lane);
}

constexpr int SC_ST = 272, SX_ST = 528;
__device__ __forceinline__ float bfsel(const u32x4& v, int j) { const unsigned w = v[j >> 1]; return (j & 1) ? bfhi(w) : bflo(w); }
__device__ __forceinline__ void conv_task(const bf16* P, size_t rowb, int t0, int pcol, const float* cw, const float* cb, int ccol, LAS unsigned char* dst, int stride, const LAS float* scale) {
    float w[4][8], bs[8];
#pragma unroll
    for (int k = 0; k < 4; ++k) { const f32x4 a = *(const f32x4*)(cw + k * 2048 + ccol), b = *(const f32x4*)(cw + k * 2048 + ccol + 4);
        w[k][0] = a.x; w[k][1] = a.y; w[k][2] = a.z; w[k][3] = a.w; w[k][4] = b.x; w[k][5] = b.y; w[k][6] = b.z; w[k][7] = b.w; }
    { const f32x4 a = *(const f32x4*)(cb + ccol), b = *(const f32x4*)(cb + ccol + 4); bs[0] = a.x; bs[1] = a.y; bs[2] = a.z; bs[3] = a.w; bs[4] = b.x; bs[5] = b.y; bs[6] = b.z; bs[7] = b.w; }
    const bf16* src = P + (rowb + t0) * NPROJ + pcol;
    u32x4 rw[19];
#pragma unroll
    for (int i = 0; i < 3; ++i) rw[i] = (u32x4){0u, 0u, 0u, 0u};
    if (t0 > 0) {
#pragma unroll
        for (int i = 0; i < 3; ++i) rw[i] = *(const u32x4*)(src + (ptrdiff_t)(i - 3) * NPROJ); }
#pragma unroll
    for (int i = 0; i < 16; ++i) rw[3 + i] = *(const u32x4*)(src + (size_t)i * NPROJ);
#pragma unroll
    for (int i = 0; i < 16; ++i) {
        float o[8];
#pragma unroll
        for (int j = 0; j < 8; ++j) { float a = bs[j] + w[0][j] * bfsel(rw[i], j) + w[1][j] * bfsel(rw[i + 1], j) + w[2][j] * bfsel(rw[i + 2], j) + w[3][j] * bfsel(rw[i + 3], j); o[j] = a * sigmoidf_(a); }
        if (scale) { const float sv = scale[i];
#pragma unroll
            for (int j = 0; j < 8; ++j) o[j] *= sv; }
        const u32x4 r = {pkbf(o[0], o[1]), pkbf(o[2], o[3]), pkbf(o[4], o[5]), pkbf(o[6], o[7])};
        *(LAS u32x4*)(dst + i * stride) = r;
    }
}
__device__ __forceinline__ float ssd_scan(Frame& F, const float* DTp, size_t tok0, int g, LAS float* sAc, LAS float* sDt) {
    float total = 0.f;
    if (F.wave < 4) {
        const int head = 4 * g + F.wave, lane = F.lane;
        const float A = -__expf(F.in[I_ALOG][head]);
        const float d0 = DTp[(tok0 + 2 * lane) * 16 + head], d1 = DTp[(tok0 + 2 * lane + 1) * 16 + head];
        const float a0 = d0 * A, a1 = d1 * A;
        float sc = a0 + a1;
#pragma unroll
        for (int o = 1; o < 64; o <<= 1) { const float v = __shfl_up(sc, o); if (lane >= o) sc += v; }
        sAc[F.wave * 128 + 2 * lane] = sc - a1; sAc[F.wave * 128 + 2 * lane + 1] = sc;
        sDt[F.wave * 128 + 2 * lane] = d0; sDt[F.wave * 128 + 2 * lane + 1] = d1;
        total = __shfl(sc, 63);
    }
    return total;
}
__device__ __forceinline__ bf16x8 tr_pair(unsigned a_lo, unsigned a_hi) {
    s16x4 lo, hi;
    asm volatile("ds_read_b64_tr_b16 %0, %2\n\tds_read_b64_tr_b16 %1, %3\n\ts_waitcnt lgkmcnt(0)" : "=&v"(lo), "=&v"(hi) : "v"(a_lo), "v"(a_hi) : "memory");
    const bf16x8 r = {lo[0], lo[1], lo[2], lo[3], hi[0], hi[1], hi[2], hi[3]}; return r;
}

__device__ __forceinline__ void ssdC_phase(Frame& F, int half) {
    const bf16* P = (const bf16*)(F.ws + WS_BIG);
    const float* DTp = (const float*)(F.ws + WS_DT);
    bf16* SST = (bf16*)(F.ws + WS_SST); float* DEC = (float*)(F.ws + WS_DEC);
    LAS unsigned char* sX = F.lds; LAS unsigned char* sB = F.lds + 128 * SX_ST;
    LAS float* sAc = (LAS float*)(F.lds + 128 * SX_ST + 128 * SC_ST); LAS float* sDt = sAc + 512; LAS float* sW = sDt + 512;
    const int wave = F.wave;
    for (int unit = F.bid; unit < HB * 64 * 4; unit += F.G) {
        int tid = F.tid; asm volatile("" : "+v"(tid));
        const int lane = tid & 63, ql = lane & 31, h = lane >> 5, tq = (lane & 15) >> 2, tp = lane & 3, tblk = (lane >> 4) & 1;
        const int bl = unit >> 8, c = (unit >> 2) & 63, g = unit & 3;
        const size_t rowb = (size_t)bl * SEQ, tok0 = (size_t)half * HT + rowb + c * 128;
        __syncthreads();
        const float total = ssd_scan(F, DTp, tok0, g, sAc, sDt);
        if (wave < 4) { sW[wave * 128 + 2 * lane] = __expf(total - sAc[wave * 128 + 2 * lane]) * sDt[wave * 128 + 2 * lane];
            sW[wave * 128 + 2 * lane + 1] = __expf(total - sAc[wave * 128 + 2 * lane + 1]) * sDt[wave * 128 + 2 * lane + 1];
            if (lane == 0) DEC[((size_t)bl * 64 + c) * 16 + 4 * g + wave] = __expf(total); }
        __syncthreads();
        if (tid < 384) {
            int ch, strip, ccol, stride; LAS unsigned char* dst; const LAS float* scl = nullptr;
            if (tid < 256) { ch = tid & 31; strip = tid >> 5; ccol = g * 256 + 8 * ch; stride = SX_ST; dst = sX + (strip * 16) * SX_ST + ch * 16; scl = sW + (ch >> 3) * 128 + strip * 16; }
            else { const int u = tid - 256; ch = u & 15; strip = u >> 4; ccol = 1024 + g * 128 + 8 * ch; stride = SC_ST; dst = sB + (strip * 16) * SC_ST + ch * 16; }
            conv_task(P, rowb, c * 128 + strip * 16, PC_X + ccol, F.in[I_CONVW], F.in[I_CONVB], ccol, dst, stride, scl);
        }
        __syncthreads();
        const int r = wave >> 1, pt = wave & 1;
        f32x16 acc[4];
#pragma unroll
        for (int nt = 0; nt < 4; ++nt)
#pragma unroll
            for (int e = 0; e < 16; ++e) acc[nt][e] = 0.f;
        const unsigned xa = (unsigned)(size_t)sX + (unsigned)((8 * h + tq) * SX_ST + (r * 64 + 32 * pt + 16 * tblk + 4 * tp) * 2);
        const unsigned ba = (unsigned)(size_t)sB + (unsigned)((8 * h + tq) * SC_ST + (16 * tblk + 4 * tp) * 2);
#pragma unroll
        for (int ks = 0; ks < 8; ++ks) {
            const bf16x8 af = tr_pair(xa + ks * 16 * SX_ST, xa + ks * 16 * SX_ST + 4 * SX_ST);
            bf16x8 bfr[4];
#pragma unroll
            for (int nt = 0; nt < 4; ++nt) bfr[nt] = tr_pair(ba + ks * 16 * SC_ST + nt * 64, ba + ks * 16 * SC_ST + 4 * SC_ST + nt * 64);
            __builtin_amdgcn_sched_barrier(0);
#pragma unroll
            for (int nt = 0; nt < 4; ++nt) acc[nt] = MFMA32(af, bfr[nt], acc[nt]);
        }
        bf16* out = SST + (((size_t)bl * 64 + c) * 16 + 4 * g + r) * 8192;
#pragma unroll
        for (int nt = 0; nt < 4; ++nt)
#pragma unroll
            for (int e = 0; e < 16; ++e) out[(32 * pt + (e & 3) + 8 * (e >> 2) + 4 * h) * 128 + 32 * nt + ql] = (bf16)(pkbf(acc[nt][e], 0.f) & 0xffffu);
    }
}

__device__ __forceinline__ void ssdD_phase(Frame& F) {
    const bf16* SST = (const bf16*)(F.ws + WS_SST); const float* DEC = (const float*)(F.ws + WS_DEC);
    bf16* SIN = (bf16*)(F.ws + WS_SIN);
    const size_t gtid = (size_t)F.bid * NTHR + F.tid, gth = (size_t)F.G * NTHR;
    for (size_t it = gtid; it < (size_t)HB * 16 * 2048; it += gth) {
        const int bl = (int)(it >> 15), head = (int)(it >> 11) & 15, e4 = (int)(it & 2047) * 4;
        f32x4 st = {0.f, 0.f, 0.f, 0.f};
#pragma unroll 8
        for (int c = 0; c < 64; ++c) {
            const size_t idx = (((size_t)bl * 64 + c) * 16 + head);
            const u32x2 o = {pkbf(st.x, st.y), pkbf(st.z, st.w)};
            *(u32x2*)(SIN + idx * 8192 + e4) = o;
            const u32x2 sw = *(const u32x2*)(SST + idx * 8192 + e4); const f32x4 sl = {bflo(sw.x), bfhi(sw.x), bflo(sw.y), bfhi(sw.y)}; const float d = DEC[idx];
            st = st * d + sl;
        }
    }
}

__device__ __forceinline__ void ssdE_phase(Frame& F, int half) {
    const bf16* P = (const bf16*)(F.ws + WS_BIG);
    const float* DTp = (const float*)(F.ws + WS_DT);
    const bf16* SIN = (const bf16*)(F.ws + WS_SIN);
    bf16* Y = (bf16*)F.out;
    LAS unsigned char* sX = F.lds; LAS unsigned char* sB = F.lds + 128 * SX_ST; LAS unsigned char* sC = sB + 128 * SC_ST;
    LAS float* sAc = (LAS float*)(sC + 128 * SC_ST); LAS float* sDt = sAc + 512; LAS float* sSS = sDt + 512;
    const int wave = F.wave;
    const int st = wave & 3, hp = wave >> 2;
    for (int unit = F.bid; unit < HB * 64 * 4; unit += F.G) {
        int tid = F.tid; asm volatile("" : "+v"(tid));
        const int lane = tid & 63, ql = lane & 31, h = lane >> 5, tq = (lane & 15) >> 2, tp = lane & 3, tblk = (lane >> 4) & 1;
        const int bl = unit >> 8, c = (unit >> 2) & 63, g = unit & 3;
        const size_t rowb = (size_t)bl * SEQ, tok0 = (size_t)half * HT + rowb + c * 128;
        __syncthreads();
        (void)ssd_scan(F, DTp, tok0, g, sAc, sDt);
        if (tid < 128) sSS[tid] = 0.f;
        {
            int ch, strip, ccol, stride; LAS unsigned char* dst;
            if (tid < 256) { ch = tid & 31; strip = tid >> 5; ccol = g * 256 + 8 * ch; stride = SX_ST; dst = sX + (strip * 16) * SX_ST + ch * 16; }
            else if (tid < 384) { const int u = tid - 256; ch = u & 15; strip = u >> 4; ccol = 1024 + g * 128 + 8 * ch; stride = SC_ST; dst = sB + (strip * 16) * SC_ST + ch * 16; }
            else { const int u = tid - 384; ch = u & 15; strip = u >> 4; ccol = 1536 + g * 128 + 8 * ch; stride = SC_ST; dst = sC + (strip * 16) * SC_ST + ch * 16; }
            conv_task(P, rowb, c * 128 + strip * 16, PC_X + ccol, F.in[I_CONVW], F.in[I_CONVB], ccol, dst, stride, nullptr);
        }
        __syncthreads();
        const int s = 32 * st + ql;
        unsigned yk[2][2][8];
        float ssq = 0.f;
        const unsigned xa = (unsigned)(size_t)sX + (unsigned)((4 * h + tq) * SX_ST + (16 * tblk + 4 * tp) * 2);
#pragma unroll
        for (int hq = 0; hq < 2; ++hq) {
            const int r = 2 * hp + hq, head = 4 * g + r;
            const float acs = sAc[r * 128 + s];
            const bf16* stp = SIN + (((size_t)bl * 64 + c) * 16 + head) * 8192 + ql * 128 + 8 * h;
            bf16x8 sfr[2][8];
#pragma unroll
            for (int pt = 0; pt < 2; ++pt)
#pragma unroll
                for (int ks = 0; ks < 8; ++ks) sfr[pt][ks] = *(const bf16x8*)(stp + pt * 4096 + 16 * ks);
            bf16x8 pf[4][2];
#pragma unroll
            for (int i = 0; i < 4; ++i) {
                f32x16 Xi;
#pragma unroll
                for (int e = 0; e < 16; ++e) Xi[e] = 0.f;
#pragma unroll
                for (int ks = 0; ks < 8; ++ks) { const bf16x8 bf_ = *(const LAS bf16x8*)(sB + (32 * i + ql) * SC_ST + 32 * ks + 16 * h);
                    const bf16x8 cf = *(const LAS bf16x8*)(sC + s * SC_ST + 32 * ks + 16 * h); Xi = MFMA32(bf_, cf, Xi); }
                float p[16];
#pragma unroll
                for (int q4 = 0; q4 < 4; ++q4) { const int t0 = 32 * i + 8 * q4 + 4 * h;
                    const f32x4 at = *(const LAS f32x4*)(sAc + r * 128 + t0), dt4 = *(const LAS f32x4*)(sDt + r * 128 + t0);
#pragma unroll
                    for (int e = 0; e < 4; ++e) { const int t = t0 + e; p[4 * q4 + e] = (t <= s) ? Xi[4 * q4 + e] * __expf(acs - at[e]) * dt4[e] : 0.f; } }
#pragma unroll
                for (int s2 = 0; s2 < 2; ++s2) { const u32x4 w = {pkbf(p[8 * s2 + 0], p[8 * s2 + 1]), pkbf(p[8 * s2 + 2], p[8 * s2 + 3]), pkbf(p[8 * s2 + 4], p[8 * s2 + 5]), pkbf(p[8 * s2 + 6], p[8 * s2 + 7])};
                    pf[i][s2] = __builtin_bit_cast(bf16x8, w); }
            }
            const float eacs = __expf(acs), Dh = F.in[I_SSDD][head];
#pragma unroll
            for (int pt = 0; pt < 2; ++pt) {
                f32x16 yd, yo;
#pragma unroll
                for (int e = 0; e < 16; ++e) { yd[e] = 0.f; yo[e] = 0.f; }
#pragma unroll
                for (int i = 0; i < 4; ++i) {
#pragma unroll
                    for (int s2 = 0; s2 < 2; ++s2) { const unsigned a = xa + (unsigned)((32 * i + 16 * s2) * SX_ST + (r * 64 + 32 * pt) * 2);
                        const bf16x8 xf = tr_pair(a, a + 8 * SX_ST); __builtin_amdgcn_sched_barrier(0); yd = MFMA32(xf, pf[i][s2], yd); }
                }
#pragma unroll
                for (int ks = 0; ks < 8; ++ks) { const bf16x8 cf = *(const LAS bf16x8*)(sC + s * SC_ST + 32 * ks + 16 * h); yo = MFMA32(sfr[pt][ks], cf, yo); }
                const bf16* zp = P + (rowb + c * 128 + s) * NPROJ + PC_Z + g * 256 + r * 64 + 32 * pt + 4 * h;
                u32x2 zv[4];
#pragma unroll
                for (int q4 = 0; q4 < 4; ++q4) zv[q4] = *(const u32x2*)(zp + 8 * q4);
#pragma unroll
                for (int q4 = 0; q4 < 4; ++q4) {
                    const u32x2 xv = *(const LAS u32x2*)(sX + s * SX_ST + (r * 64 + 32 * pt + 8 * q4 + 4 * h) * 2);
                    const u32x2 zq = zv[q4];
                    const float xs_[4] = {bflo(xv.x), bfhi(xv.x), bflo(xv.y), bfhi(xv.y)}, zs_[4] = {bflo(zq.x), bfhi(zq.x), bflo(zq.y), bfhi(zq.y)};
                    float yv[4];
#pragma unroll
                    for (int e = 0; e < 4; ++e) { float y = yd[4 * q4 + e] + eacs * yo[4 * q4 + e] + Dh * xs_[e]; y = y * zs_[e] * sigmoidf_(zs_[e]); yv[e] = y; ssq += y * y; }
                    yk[hq][pt][2 * q4] = pkbf(yv[0], yv[1]); yk[hq][pt][2 * q4 + 1] = pkbf(yv[2], yv[3]);
                }
            }
        }
        ssq += __shfl_xor(ssq, 32);
        if (h == 0) __hip_atomic_fetch_add(sSS + s, ssq, __ATOMIC_RELAXED, __HIP_MEMORY_SCOPE_WORKGROUP);
        __syncthreads();
        const float rs = 1.0f / sqrtf(sSS[s] * (1.f / 256.f) + EPS);
        bf16* yp = Y + (tok0 + s) * YC + g * 256 + 4 * h;
        const float* nw = F.in[I_SSDNW] + g * 256 + 4 * h;
#pragma unroll
        for (int hq = 0; hq < 2; ++hq)
#pragma unroll
            for (int pt = 0; pt < 2; ++pt)
#pragma unroll
                for (int q4 = 0; q4 < 4; ++q4) { const int cc = (2 * hp + hq) * 64 + 32 * pt + 8 * q4; const f32x4 w4 = *(const f32x4*)(nw + cc);
                    const unsigned ya = yk[hq][pt][2 * q4], yb = yk[hq][pt][2 * q4 + 1];
                    const u32x2 o = {pkbf(bflo(ya) * rs * w4.x, bfhi(ya) * rs * w4.y), pkbf(bflo(yb) * rs * w4.z, bfhi(yb) * rs * w4.w)};
                    *(u32x2*)(yp + cc) = o; }
    }
}

__device__ __forceinline__ bf16x8 mk_bf16x8(u32x2 lo, u32x2 hi) { const u32x4 v = {lo.x, lo.y, hi.x, hi.y}; return __builtin_bit_cast(bf16x8, v); }

__device__ __forceinline__ void memattn_mfma_phase(Frame& F, int half) {
    const bf16* P = (const bf16*)(F.ws + WS_BIG);
    const bf16* MKV = (const bf16*)(F.ws + WS_MKV);
    const bf16* MVT = (const bf16*)(F.ws + WS_MVT);
    bf16* Y = (bf16*)F.out;
    LAS unsigned char* sm = F.lds;
    const int tid = F.tid, lane = F.lane, wave = F.wave, ql = lane & 31, h = lane >> 5;
    constexpr int KST = 400, VST = 528;
    for (int unit = F.bid; unit < HB * 4 * 32; unit += F.G) {
        const int bl = unit >> 7, head = (unit >> 5) & 3, qt = unit & 31, b = half * HB + bl;
        const int r = bl * SEQ + qt * 256 + wave * 32 + ql;
        __syncthreads();
        for (int c = tid; c < 256 * 24; c += NTHR) { const int row = c / 24, ch = c % 24;
            *(LAS u32x4*)(sm + row * KST + ch * 16) = *(const u32x4*)(MKV + (size_t)(b * NMEM + row) * 1536 + head * 192 + ch * 8); }
        bf16x8 qf[12];
        { const bf16* qp = P + (size_t)r * NPROJ + PC_MQ + head * 192 + 8 * h;
          u32x4 qr[12]; float ss = 0.f;
#pragma unroll
          for (int ks = 0; ks < 12; ++ks) { qr[ks] = *(const u32x4*)(qp + 16 * ks);
              ss += (bflo(qr[ks].x) * bflo(qr[ks].x) + bfhi(qr[ks].x) * bfhi(qr[ks].x)) + (bflo(qr[ks].y) * bflo(qr[ks].y) + bfhi(qr[ks].y) * bfhi(qr[ks].y))
                  + (bflo(qr[ks].z) * bflo(qr[ks].z) + bfhi(qr[ks].z) * bfhi(qr[ks].z)) + (bflo(qr[ks].w) * bflo(qr[ks].w) + bfhi(qr[ks].w) * bfhi(qr[ks].w)); }
          ss += __shfl_xor(ss, 32);
          const float rs = 1.0f / sqrtf(ss * (1.f / 192.f) + EPS);
#pragma unroll
          for (int ks = 0; ks < 12; ++ks) { const f32x4 wa = *(const f32x4*)(F.in[I_MQNW] + 16 * ks + 8 * h), wb = *(const f32x4*)(F.in[I_MQNW] + 16 * ks + 8 * h + 4);
              const u32x4 w = {pkbf(bflo(qr[ks].x) * rs * wa.x, bfhi(qr[ks].x) * rs * wa.y), pkbf(bflo(qr[ks].y) * rs * wa.z, bfhi(qr[ks].y) * rs * wa.w),
                               pkbf(bflo(qr[ks].z) * rs * wb.x, bfhi(qr[ks].z) * rs * wb.y), pkbf(bflo(qr[ks].w) * rs * wb.z, bfhi(qr[ks].w) * rs * wb.w)};
              qf[ks] = __builtin_bit_cast(bf16x8, w); } }
        __syncthreads();
        f32x16 sacc[8];
#pragma unroll
        for (int mt = 0; mt < 8; ++mt) {
#pragma unroll
            for (int i = 0; i < 16; ++i) sacc[mt][i] = 0.f;
#pragma unroll
            for (int ks = 0; ks < 12; ++ks) { const bf16x8 kf = *(const LAS bf16x8*)(sm + (32 * mt + ql) * KST + 32 * ks + 16 * h); sacc[mt] = MFMA32(kf, qf[ks], sacc[mt]); }
        }
        float mx = -3.0e38f;
#pragma unroll
        for (int mt = 0; mt < 8; ++mt)
#pragma unroll
            for (int i = 0; i < 16; ++i) mx = fmaxf(mx, sacc[mt][i]);
        mx = fmaxf(mx, __shfl_xor(mx, 32));
        const float sc = 0.07216878364870323f * 1.4426950408889634f;
        float l = 0.f;
        bf16x8 pf[8][2];
#pragma unroll
        for (int mt = 0; mt < 8; ++mt) {
            float p[16];
#pragma unroll
            for (int i = 0; i < 16; ++i) { p[i] = __builtin_amdgcn_exp2f((sacc[mt][i] - mx) * sc); l += p[i]; }
#pragma unroll
            for (int s2 = 0; s2 < 2; ++s2) { const u32x4 w = {pkbf(p[8 * s2 + 0], p[8 * s2 + 1]), pkbf(p[8 * s2 + 2], p[8 * s2 + 3]), pkbf(p[8 * s2 + 4], p[8 * s2 + 5]), pkbf(p[8 * s2 + 6], p[8 * s2 + 7])};
                pf[mt][s2] = __builtin_bit_cast(bf16x8, w); }
        }
        l += __shfl_xor(l, 32);
        __syncthreads();
        for (int c = tid; c < 192 * 32; c += NTHR) { const int row = c >> 5, ch = c & 31;
            *(LAS u32x4*)(sm + row * VST + ch * 16) = *(const u32x4*)(MVT + (size_t)(head * 192 + row) * 2048 + b * NMEM + ch * 8); }
        __syncthreads();
        const float il = 1.0f / l;
        bf16* yp = Y + ((size_t)half * HT + r) * YC + 1280 + head * 192 + 4 * h;
#pragma unroll
        for (int dt = 0; dt < 6; ++dt) {
            f32x16 o;
#pragma unroll
            for (int i = 0; i < 16; ++i) o[i] = 0.f;
#pragma unroll
            for (int mt = 0; mt < 8; ++mt)
#pragma unroll
                for (int s2 = 0; s2 < 2; ++s2) { const LAS unsigned char* vp = sm + (32 * dt + ql) * VST + (32 * mt + 16 * s2 + 4 * h) * 2;
                    const bf16x8 vf = mk_bf16x8(*(const LAS u32x2*)vp, *(const LAS u32x2*)(vp + 16)); o = MFMA32(vf, pf[mt][s2], o); }
#pragma unroll
            for (int g = 0; g < 4; ++g) { const u32x2 w = {pkbf(o[4 * g] * il, o[4 * g + 1] * il), pkbf(o[4 * g + 2] * il, o[4 * g + 3] * il)}; *(u32x2*)(yp + 32 * dt + 8 * g) = w; }
        }
    }
}

__device__ __forceinline__ void dilattn_mfma_phase(Frame& F, int half) {
    bf16* P = (bf16*)(F.ws + WS_BIG);
    float* LSE = (float*)(F.ws + WS_LSE);
    LAS unsigned char* sK = F.lds; LAS unsigned char* sV = F.lds + 384 * 144;
    const int tid = F.tid, lane = F.lane, wave = F.wave, ql = lane & 31, h = lane >> 5;
    constexpr int RST = 144;
    const float* RT = (const float*)(F.ws + WS_ROPE);
    float wk8[8];
#pragma unroll
    for (int j = 0; j < 8; ++j) wk8[j] = F.in[I_DKNW][8 * (tid & 7) + j];
    for (int unit = F.bid; unit < HB * 12 * 32; unit += F.G) {
        const int bl = unit / 384, rem = unit % 384, head = rem >> 5, blk = rem & 31;
        const int g = head >> 2, dil = (g == 0) ? 1 : (g == 1 ? 4 : 16), bpr = 32 / dil;
        const int res = blk / bpr, q0 = (blk % bpr) * 256;
        const size_t rowb = (size_t)bl * SEQ;
        __syncthreads();
        for (int c = tid; c < 384 * 8; c += NTHR) { const int row = c >> 3, ch = c & 7; const int ks = q0 - 128 + row;
            u32x4 kv = {0u, 0u, 0u, 0u}, vv = {0u, 0u, 0u, 0u}; f32x4 c0 = {1.f, 1.f, 1.f, 1.f}, c1 = c0, s0 = {0.f, 0.f, 0.f, 0.f}, s1 = s0;
            if (ks >= 0) { const size_t rr = rowb + (size_t)ks * dil + res; const bf16* src = P + rr * NPROJ + head * 64 + ch * 8; kv = *(const u32x4*)(src + PC_DK); vv = *(const u32x4*)(src + PC_DV);
                if (ch < 2) { const f32x4* rt = (const f32x4*)(RT + ((size_t)half * HT + rr) * 16); c0 = rt[0]; c1 = rt[1]; s0 = rt[2]; s1 = rt[3]; } }
            float x[8] = {bflo(kv.x), bfhi(kv.x), bflo(kv.y), bfhi(kv.y), bflo(kv.z), bfhi(kv.z), bflo(kv.w), bfhi(kv.w)};
            float ss = 0.f;
#pragma unroll
            for (int j = 0; j < 8; ++j) ss += x[j] * x[j];
            ss += __shfl_xor(ss, 1); ss += __shfl_xor(ss, 2); ss += __shfl_xor(ss, 4);
            const float rs = 1.0f / sqrtf(ss * (1.f / 64.f) + EPS);
            const float cs[8] = {c0.x, c0.y, c0.z, c0.w, c1.x, c1.y, c1.z, c1.w}, sn[8] = {s0.x, s0.y, s0.z, s0.w, s1.x, s1.y, s1.z, s1.w};
#pragma unroll
            for (int j = 0; j < 8; ++j) { x[j] = x[j] * rs * wk8[j]; const float o = __shfl_xor(x[j], 1); if (ch == 0) x[j] = x[j] * cs[j] - o * sn[j]; else if (ch == 1) x[j] = x[j] * cs[j] + o * sn[j]; }
            kv = (u32x4){pkbf(x[0], x[1]), pkbf(x[2], x[3]), pkbf(x[4], x[5]), pkbf(x[6], x[7])};
            *(LAS u32x4*)(sK + row * RST + ch * 16) = kv; *(LAS u32x4*)(sV + row * RST + ch * 16) = vv; }
        const int qs = q0 + wave * 32 + ql;
        const size_t rq = rowb + (size_t)qs * dil + res;
        bf16* qp = P + rq * NPROJ + PC_DQ + head * 64;
        bf16x8 qf[4];
        {
            u32x4 qr[4];
#pragma unroll
            for (int ks = 0; ks < 4; ++ks) qr[ks] = *(const u32x4*)(qp + 16 * ks + 8 * h);
            const f32x4* rt = (const f32x4*)(RT + ((size_t)half * HT + rq) * 16); const f32x4 c0 = rt[0], c1 = rt[1], s0 = rt[2], s1 = rt[3];
            float ss = 0.f;
#pragma unroll
            for (int ks = 0; ks < 4; ++ks) ss += (bflo(qr[ks].x) * bflo(qr[ks].x) + bfhi(qr[ks].x) * bfhi(qr[ks].x)) + (bflo(qr[ks].y) * bflo(qr[ks].y) + bfhi(qr[ks].y) * bfhi(qr[ks].y))
                                               + (bflo(qr[ks].z) * bflo(qr[ks].z) + bfhi(qr[ks].z) * bfhi(qr[ks].z)) + (bflo(qr[ks].w) * bflo(qr[ks].w) + bfhi(qr[ks].w) * bfhi(qr[ks].w));
            ss += __shfl_xor(ss, 32);
            const float rs = 1.0f / sqrtf(ss * (1.f / 64.f) + EPS);
#pragma unroll
            for (int ks = 0; ks < 4; ++ks) { const f32x4 wa = *(const f32x4*)(F.in[I_DQNW] + 16 * ks + 8 * h), wb = *(const f32x4*)(F.in[I_DQNW] + 16 * ks + 8 * h + 4);
                float x[8] = {bflo(qr[ks].x) * rs * wa.x, bfhi(qr[ks].x) * rs * wa.y, bflo(qr[ks].y) * rs * wa.z, bfhi(qr[ks].y) * rs * wa.w, bflo(qr[ks].z) * rs * wb.x, bfhi(qr[ks].z) * rs * wb.y, bflo(qr[ks].w) * rs * wb.z, bfhi(qr[ks].w) * rs * wb.w};
                if (ks == 0) { const float cs[8] = {c0.x, c0.y, c0.z, c0.w, c1.x, c1.y, c1.z, c1.w}, sn[8] = {s0.x, s0.y, s0.z, s0.w, s1.x, s1.y, s1.z, s1.w};
#pragma unroll
                    for (int j = 0; j < 8; ++j) { const float o = __shfl_xor(x[j], 32); x[j] = (h == 0) ? x[j] * cs[j] - o * sn[j] : x[j] * cs[j] + o * sn[j]; } }
                const u32x4 w = {pkbf(x[0], x[1]), pkbf(x[2], x[3]), pkbf(x[4], x[5]), pkbf(x[6], x[7])}; qf[ks] = __builtin_bit_cast(bf16x8, w); }
        }
        __syncthreads();
        f32x16 sacc[5];
        const int kfirst = q0 + wave * 32 - 128;
#pragma unroll
        for (int i = 0; i < 5; ++i) {
#pragma unroll
            for (int e = 0; e < 16; ++e) sacc[i][e] = 0.f;
#pragma unroll
            for (int ks = 0; ks < 4; ++ks) { const bf16x8 kf = *(const LAS bf16x8*)(sK + (32 * wave + 32 * i + ql) * RST + 32 * ks + 16 * h); sacc[i] = MFMA32(kf, qf[ks], sacc[i]); }
        }
        float mx = -3.0e38f;
#pragma unroll
        for (int i = 0; i < 5; ++i)
#pragma unroll
            for (int e = 0; e < 16; ++e) { const int kj = 32 * i + (e & 3) + 8 * (e >> 2) + 4 * h; const bool ok = (kj >= ql) && (kj <= ql + 128) && (kfirst + kj >= 0);
                sacc[i][e] = ok ? sacc[i][e] : -3.0e38f; mx = fmaxf(mx, sacc[i][e]); }
        mx = fmaxf(mx, __shfl_xor(mx, 32));
        const float sc = 0.125f * 1.4426950408889634f;
        float l = 0.f;
        bf16x8 pf[5][2];
#pragma unroll
        for (int i = 0; i < 5; ++i) {
            float p[16];
#pragma unroll
            for (int e = 0; e < 16; ++e) { p[e] = (sacc[i][e] > -1.0e38f) ? __builtin_amdgcn_exp2f((sacc[i][e] - mx) * sc) : 0.f; l += p[e]; }
#pragma unroll
            for (int s2 = 0; s2 < 2; ++s2) { const u32x4 w = {pkbf(p[8 * s2 + 0], p[8 * s2 + 1]), pkbf(p[8 * s2 + 2], p[8 * s2 + 3]), pkbf(p[8 * s2 + 4], p[8 * s2 + 5]), pkbf(p[8 * s2 + 6], p[8 * s2 + 7])};
                pf[i][s2] = __builtin_bit_cast(bf16x8, w); }
        }
        l += __shfl_xor(l, 32);
        const float il = 1.0f / l;
        const int tq = (lane & 15) >> 2, tp = lane & 3, tblk = (lane >> 4) & 1;
        const unsigned vbase = (unsigned)(size_t)(sV) + (unsigned)((32 * wave + 4 * h + tq) * RST + (16 * tblk + 4 * tp) * 2);
#pragma unroll
        for (int dt = 0; dt < 2; ++dt) {
            f32x16 o;
#pragma unroll
            for (int e = 0; e < 16; ++e) o[e] = 0.f;
#pragma unroll
            for (int i = 0; i < 5; ++i) {
                s16x4 lo[2], hi[2];
#pragma unroll
                for (int s2 = 0; s2 < 2; ++s2) { const unsigned a = vbase + (unsigned)((32 * i + 16 * s2) * RST + 64 * dt);
                    asm volatile("ds_read_b64_tr_b16 %0, %1" : "=&v"(lo[s2]) : "v"(a) : "memory");
                    asm volatile("ds_read_b64_tr_b16 %0, %1 offset:1152" : "=&v"(hi[s2]) : "v"(a) : "memory"); }
                asm volatile("s_waitcnt lgkmcnt(0)" ::: "memory"); __builtin_amdgcn_sched_barrier(0);
#pragma unroll
                for (int s2 = 0; s2 < 2; ++s2) { const bf16x8 vf = {lo[s2][0], lo[s2][1], lo[s2][2], lo[s2][3], hi[s2][0], hi[s2][1], hi[s2][2], hi[s2][3]}; o = MFMA32(vf, pf[i][s2], o); }
            }
#pragma unroll
            for (int gq = 0; gq < 4; ++gq) { const u32x2 w = {pkbf(o[4 * gq] * il, o[4 * gq + 1] * il), pkbf(o[4 * gq + 2] * il, o[4 * gq + 3] * il)}; *(u32x2*)(qp + 32 * dt + 8 * gq + 4 * h) = w; }
        }
        if (h == 0) LSE[((size_t)half * HT + rq) * 12 + head] = mx * 0.125f + __logf(l);
    }
}

__device__ __forceinline__ void dilmerge_phase(Frame& F, int half) {
    const bf16* P = (const bf16*)(F.ws + WS_BIG);
    const float* LSE = (const float*)(F.ws + WS_LSE);
    bf16* Y = (bf16*)F.out;
    const size_t gtid = (size_t)F.bid * NTHR + F.tid, gth = (size_t)F.G * NTHR;
    for (size_t it = gtid; it < (size_t)HT * 32; it += gth) {
        const size_t r = it >> 5; const int hh = (int)(it >> 3) & 3, d0 = (int)(it & 7) * 8;
        const size_t tok = (size_t)half * HT + r;
        const float l0 = LSE[tok * 12 + hh], l1 = LSE[tok * 12 + 4 + hh], l2 = LSE[tok * 12 + 8 + hh];
        const float m = fmaxf(l0, fmaxf(l1, l2));
        float w0 = __expf(l0 - m), w1 = __expf(l1 - m), w2 = __expf(l2 - m); const float iw = 1.0f / (w0 + w1 + w2); w0 *= iw; w1 *= iw; w2 *= iw;
        const bf16* op = P + r * NPROJ + PC_DQ + hh * 64 + d0;
        const u32x4 a = *(const u32x4*)op, b = *(const u32x4*)(op + 256), c = *(const u32x4*)(op + 512);
        u32x4 o;
        o.x = pkbf(w0 * bflo(a.x) + w1 * bflo(b.x) + w2 * bflo(c.x), w0 * bfhi(a.x) + w1 * bfhi(b.x) + w2 * bfhi(c.x));
        o.y = pkbf(w0 * bflo(a.y) + w1 * bflo(b.y) + w2 * bflo(c.y), w0 * bfhi(a.y) + w1 * bfhi(b.y) + w2 * bfhi(c.y));
        o.z = pkbf(w0 * bflo(a.z) + w1 * bflo(b.z) + w2 * bflo(c.z), w0 * bfhi(a.z) + w1 * bfhi(b.z) + w2 * bfhi(c.z));
        o.w = pkbf(w0 * bflo(a.w) + w1 * bflo(b.w) + w2 * bflo(c.w), w0 * bfhi(a.w) + w1 * bfhi(b.w) + w2 * bfhi(c.w));
        *(u32x4*)(Y + tok * YC + 1024 + hh * 64 + d0) = o;
    }
}

__device__ __forceinline__ void hn_phase(Frame& F) {
    const int gw = F.bid * NWAVES + F.wave, NGW = F.G * NWAVES;
    for (int m = gw; m < T; m += NGW) { f32x4 v[4]; rms_row_to_bf16(F.out + (size_t)m * DM, F.in[I_NFFNW], (bf16*)(F.ws + WS_ACT1) + (size_t)m * DM, F.lane, v); }
}


__device__ __forceinline__ float gelu_erf(float x) { return 0.5f * x * (1.0f + erff(x * 0.70710678118654752f)); }
__device__ __forceinline__ unsigned f2ord(float f) { const unsigned u = __builtin_bit_cast(unsigned, f); return u ^ ((unsigned)((int)u >> 31) | 0x80000000u); }
__device__ __forceinline__ float ord2f(unsigned k) { const unsigned m = (unsigned)((int)k >> 31); return __builtin_bit_cast(float, k ^ (0x80000000u | ~m)); }
#define CMPX(a, b) do { const unsigned _mx = max((a), (b)), _mn = min((a), (b)); (a) = _mx; (b) = _mn; } while (0)
__device__ __forceinline__ void bitonic_sort16_desc(unsigned (&v)[16]) {
#pragma unroll
    for (int k = 2; k <= 16; k <<= 1)
#pragma unroll
        for (int j = k >> 1; j > 0; j >>= 1)
#pragma unroll
            for (int i = 0; i < 16; ++i) { const int l = i ^ j; if (l > i) { if ((i & k) == 0) CMPX(v[i], v[l]); else CMPX(v[l], v[i]); } }
}
__device__ __forceinline__ void bitonic_merge16_desc(unsigned (&v)[16]) {
#pragma unroll
    for (int j = 8; j > 0; j >>= 1)
#pragma unroll
        for (int i = 0; i < 16; ++i) { const int l = i ^ j; if (l > i) CMPX(v[i], v[l]); }
}
__device__ __forceinline__ void top16_merge(unsigned (&a)[16], const unsigned (&b)[16]) {
#pragma unroll
    for (int i = 0; i < 16; ++i) a[i] = max(a[i], b[15 - i]);
    bitonic_merge16_desc(a);
}
constexpr int PK_ST = 272;
__device__ __forceinline__ void peer_topk_tile(Frame& F, size_t tok0, const bf16* Q, int* IDX, float* GATE) {
    const bf16* SK = (const bf16*)(F.ws + WS_SUBK);
    LAS unsigned char* sK = F.lds;
    int tid = F.tid; asm volatile("" : "+v"(tid));
    const int lane = tid & 63, wave = F.wave, ql = lane & 31, hh = lane >> 5;
    const size_t tok = tok0 + wave * 32 + ql;
    const bf16* qrow = Q + tok * PEER_Q + 8 * hh;
    __syncthreads();
#pragma unroll
    for (int j = 0; j < 4; ++j) { const int cidx = tid + 512 * j, row = cidx >> 4, ch = cidx & 15; *(LAS u32x4*)(sK + row * PK_ST + ch * 16) = *(const u32x4*)(SK + (size_t)row * 128 + ch * 8); }
    __syncthreads();
    unsigned k1[16];
    bf16x8 qf[8];
#pragma unroll
    for (int ks = 0; ks < 8; ++ks) qf[ks] = *(const bf16x8*)(qrow + 16 * ks);
#pragma unroll 1
    for (int hc = 0; hc < 16; ++hc) {
        LAS unsigned char* cur = sK + (hc & 1) * (128 * PK_ST); LAS unsigned char* nxt = sK + ((hc + 1) & 1) * (128 * PK_ST);
        u32x4 stg[4];
        const int hcn = (hc + 1) & 15;
#pragma unroll
        for (int j = 0; j < 4; ++j) { const int cidx = tid + 512 * j, row = cidx >> 4, ch = cidx & 15; stg[j] = *(const u32x4*)(SK + ((size_t)hcn * 128 + row) * 128 + ch * 8); }
        unsigned pk[4][16];
#pragma unroll
        for (int mt = 0; mt < 4; ++mt) {
            f32x16 acc;
#pragma unroll
            for (int e = 0; e < 16; ++e) acc[e] = 0.f;
#pragma unroll
            for (int ks = 0; ks < 8; ++ks) { const bf16x8 kf = *(const LAS bf16x8*)(cur + (32 * mt + ql) * PK_ST + 32 * ks + 16 * hh); acc = MFMA32(kf, qf[ks], acc); }
#pragma unroll
            for (int e = 0; e < 16; ++e) pk[mt][e] = (f2ord(acc[e]) & 0xFFFFFF80u) | (unsigned)(32 * mt + (e & 3) + 8 * (e >> 2) + 4 * hh);
        }
#pragma unroll
        for (int j = 0; j < 4; ++j) { const int cidx = tid + 512 * j, row = cidx >> 4, ch = cidx & 15; *(LAS u32x4*)(nxt + row * PK_ST + ch * 16) = stg[j]; }
        __syncthreads();
        __builtin_amdgcn_sched_barrier(0);
#pragma unroll
        for (int ks = 0; ks < 8; ++ks) qf[ks] = *(const bf16x8*)(qrow + hcn * 128 + 16 * ks);
        __builtin_amdgcn_sched_barrier(0);
#pragma unroll
        for (int mt = 0; mt < 4; ++mt) bitonic_sort16_desc(pk[mt]);
        top16_merge(pk[0], pk[1]); top16_merge(pk[2], pk[3]); top16_merge(pk[0], pk[2]);
        unsigned other[16];
#pragma unroll
        for (int i = 0; i < 16; ++i) other[i] = (unsigned)__shfl_xor((int)pk[0][i], 32);
        top16_merge(pk[0], other);
        if ((hc & 1) == 0) {
#pragma unroll
            for (int i = 0; i < 16; ++i) k1[i] = pk[0][i];
        } else {
            float f1[16], f2[16];
#pragma unroll
            for (int i = 0; i < 16; ++i) { f1[i] = ord2f(k1[i] & 0xFFFFFF80u); f2[i] = ord2f(pk[0][i] & 0xFFFFFF80u); }
            unsigned cd[4][16];
#pragma unroll
            for (int i = 0; i < 64; ++i) cd[i >> 4][i & 15] = 0u;
            int n = 0;
#pragma unroll
            for (int a = 0; a < 16; ++a)
#pragma unroll
                for (int b = 0; b < 16; ++b)
                    if ((a + 1) * (b + 1) <= 16) { cd[n >> 4][n & 15] = (f2ord(f1[a] + f2[b]) & 0xFFFFC000u) | ((k1[a] & 127u) << 7) | (pk[0][b] & 127u); ++n; }
#pragma unroll
            for (int g4 = 0; g4 < 4; ++g4) bitonic_sort16_desc(cd[g4]);
            top16_merge(cd[0], cd[1]); top16_merge(cd[2], cd[3]); top16_merge(cd[0], cd[2]);
            const float vmax = ord2f(cd[0][0] & 0xFFFFC000u);
            float ex[16], den = 0.f;
#pragma unroll
            for (int i = 0; i < 16; ++i) { ex[i] = __expf(ord2f(cd[0][i] & 0xFFFFC000u) - vmax); den += ex[i]; }
            const float iden = 1.0f / den;
            const int h = hc >> 1;
            if (hh == 0) { int* ip = IDX + tok * 128 + h * 16;
#pragma unroll
                for (int i = 0; i < 4; ++i) { const u32x4 w = {cd[0][4 * i] & 0x3FFFu, cd[0][4 * i + 1] & 0x3FFFu, cd[0][4 * i + 2] & 0x3FFFu, cd[0][4 * i + 3] & 0x3FFFu}; *(u32x4*)(ip + 4 * i) = w; } }
            else { float* gp = GATE + tok * 128 + h * 16;
#pragma unroll
                for (int i = 0; i < 4; ++i) { const f32x4 w = {ex[4 * i] * iden, ex[4 * i + 1] * iden, ex[4 * i + 2] * iden, ex[4 * i + 3] * iden}; *(f32x4*)(gp + 4 * i) = w; } }
        }
    }
}

struct PeerDeal { size_t tokw; int ntok; size_t tok0; float* PART; const int* IDX; const float* GATE; float* COEF; };
__device__ __forceinline__ void peer_item(int n, const PeerDeal& D, int wave, int& slice, size_t& tok) { slice = n >> 5; tok = D.tokw + (n & 31); }
__device__ __forceinline__ void peer_down_rows(u32x4 (&R)[16], __amdgpu_buffer_rsrc_t tab, int slice, int id0, int id1, int lane) {
    const int soff = slice * (16384 * 128);
    const int r = lane & 15, g = lane >> 4, e8 = (r >> 2) + 4 * (g >> 1), q = 4 * (g & 1) + (r & 3);
    const int src0 = 16 * (e8 & 3);
#pragma unroll
    for (int k = 0; k < 16; ++k) { const int v0 = __shfl(id0, src0 + k), v1 = __shfl(id1, src0 + k); const int id = (e8 < 4) ? v0 : v1;
        R[k] = __builtin_amdgcn_raw_buffer_load_b128(tab, (id << 7) + 16 * q, soff, 0); }
}
__device__ __forceinline__ void peer_down_hn(u32x4 (&H)[2], const bf16* HN, int slice, size_t tok, int lane) {
    const bf16* hp = HN + tok * DM + slice * 128 + 16 * (4 * ((lane >> 4) & 1) + (lane & 3));
    H[0] = *(const u32x4*)hp; H[1] = *(const u32x4*)(hp + 8);
}
__device__ __forceinline__ void peer_down_bq(long (&bq)[2], const u32x4 (&H)[2], int lane) {
    const int c = lane & 15, g = lane >> 4; const bool on = (c < 8) && ((c >> 2) == (g >> 1));
    const u32x4 x0 = H[0], x1 = H[1];
    unsigned p0 = __builtin_amdgcn_cvt_pk_fp8_f32(bflo(x0.x), bfhi(x0.x), 0, false); p0 = __builtin_amdgcn_cvt_pk_fp8_f32(bflo(x0.y), bfhi(x0.y), p0, true);
    unsigned p1 = __builtin_amdgcn_cvt_pk_fp8_f32(bflo(x0.z), bfhi(x0.z), 0, false); p1 = __builtin_amdgcn_cvt_pk_fp8_f32(bflo(x0.w), bfhi(x0.w), p1, true);
    unsigned p2 = __builtin_amdgcn_cvt_pk_fp8_f32(bflo(x1.x), bfhi(x1.x), 0, false); p2 = __builtin_amdgcn_cvt_pk_fp8_f32(bflo(x1.y), bfhi(x1.y), p2, true);
    unsigned p3 = __builtin_amdgcn_cvt_pk_fp8_f32(bflo(x1.z), bfhi(x1.z), 0, false); p3 = __builtin_amdgcn_cvt_pk_fp8_f32(bflo(x1.w), bfhi(x1.w), p3, true);
    if (!on) { p0 = 0u; p1 = 0u; p2 = 0u; p3 = 0u; }
    bq[0] = (long)(((unsigned long long)p1 << 32) | p0); bq[1] = (long)(((unsigned long long)p3 << 32) | p2);
}
__device__ __forceinline__ void peer_down_mfma(const u32x4 (&R)[16], const long (&bq)[2], __amdgpu_buffer_rsrc_t prsrc, int slice, int tokl, int lane) {
    const int c = lane & 15, g = lane >> 4, cb = c & 3;
    float dv[16];
#pragma unroll
    for (int k = 0; k < 16; ++k) { f32x4 acc = {0.f, 0.f, 0.f, 0.f}; const u32x4 v = R[k];
        acc = __builtin_amdgcn_mfma_f32_16x16x32_fp8_fp8((long)(((unsigned long long)v.y << 32) | v.x), bq[0], acc, 0, 0, 0);
        acc = __builtin_amdgcn_mfma_f32_16x16x32_fp8_fp8((long)(((unsigned long long)v.w << 32) | v.z), bq[1], acc, 0, 0, 0);
        float t = (cb == 0) ? acc.x : (cb == 1) ? acc.y : (cb == 2) ? acc.z : acc.w;
        t += __shfl_xor(t, 1); t += __shfl_xor(t, 2); dv[k] = t; }
    const unsigned off = ((c & 3) == 0 && c < 8) ? (unsigned)(((tokl * 8 + slice) * 128 + 16 * (g + 4 * (c >> 2))) * 4) : 0xFFFFFF00u;
#pragma unroll
    for (int i = 0; i < 4; ++i) { const f32x4 w = {dv[4 * i], dv[4 * i + 1], dv[4 * i + 2], dv[4 * i + 3]}; __builtin_amdgcn_raw_buffer_store_b128(__builtin_bit_cast(u32x4, w), prsrc, off, 16 * i, 0); }
}
__device__ __forceinline__ void peer_down_phase(Frame& F, const PeerDeal& D) {
    const __amdgpu_buffer_rsrc_t PD = __builtin_amdgcn_make_buffer_rsrc((void*)(F.ws + WS_PD), 0, 16384 * 1024, 0x00020000); const bf16* HN = (const bf16*)(F.ws + WS_HB);
    const int* IDX = D.IDX;
    const __amdgpu_buffer_rsrc_t prsrc = __builtin_amdgcn_make_buffer_rsrc((void*)D.PART, 0, 256 * 8 * 128 * 4, 0x00020000);
    int lane = F.lane; asm volatile("" : "+v"(lane));
    const int wave = F.wave;
    const int ntok = D.ntok;
    u32x4 RA[16], RB[16], HA[2], HB[2]; int ia0, ia1, ib0, ib1; long bq[2];
#define PEER_TOK(k, sv, tv) int sv; size_t tv; peer_item((k) < ntok ? (k) : ntok - 2 + ((k) & 1), D, wave, sv, tv)
    { PEER_TOK(0, s0, t0); PEER_TOK(1, s1, t1); PEER_TOK(2, s2, t2); PEER_TOK(3, s3, t3);
      const int a0 = IDX[t0 * 128 + lane], a1 = IDX[t0 * 128 + 64 + lane], b0 = IDX[t1 * 128 + lane], b1 = IDX[t1 * 128 + 64 + lane];
      ia0 = IDX[t2 * 128 + lane]; ia1 = IDX[t2 * 128 + 64 + lane]; ib0 = IDX[t3 * 128 + lane]; ib1 = IDX[t3 * 128 + 64 + lane];
      __builtin_amdgcn_sched_barrier(0);
      peer_down_rows(RA, PD, s0, a0, a1, lane); peer_down_hn(HA, HN, s0, t0, lane);
      __builtin_amdgcn_sched_barrier(0);
      peer_down_rows(RB, PD, s1, b0, b1, lane); peer_down_hn(HB, HN, s1, t1, lane);
      __builtin_amdgcn_sched_barrier(0); }
#pragma unroll 1
    for (int n = 0; n < ntok; n += 2) {
        PEER_TOK(n, s0, t0); PEER_TOK(n + 1, s1, t1); PEER_TOK(n + 2, s2, t2); PEER_TOK(n + 3, s3, t3); PEER_TOK(n + 4, s4, t4); PEER_TOK(n + 5, s5, t5);
        peer_down_bq(bq, HA, lane);
        peer_down_mfma(RA, bq, prsrc, s0, (int)(t0 - D.tok0), lane);
        __builtin_amdgcn_sched_barrier(0);
        { const int j0 = IDX[t4 * 128 + lane], j1 = IDX[t4 * 128 + 64 + lane];
          peer_down_rows(RA, PD, s2, ia0, ia1, lane); peer_down_hn(HA, HN, s2, t2, lane); ia0 = j0; ia1 = j1; }
        __builtin_amdgcn_sched_barrier(0);
        peer_down_bq(bq, HB, lane);
        peer_down_mfma(RB, bq, prsrc, s1, (int)(t1 - D.tok0), lane);
        __builtin_amdgcn_sched_barrier(0);
        { const int j0 = IDX[t5 * 128 + lane], j1 = IDX[t5 * 128 + 64 + lane];
          peer_down_rows(RB, PD, s3, ib0, ib1, lane); peer_down_hn(HB, HN, s3, t3, lane); ib0 = j0; ib1 = j1; }
        __builtin_amdgcn_sched_barrier(0);
    }
#undef PEER_TOK
}
__device__ __forceinline__ void peer_coef_wave(Frame& F, const PeerDeal& D) {
    for (int k = F.lane; k < 32 * 32; k += 64) {
        const int tl = (int)(D.tokw - D.tok0) + (k >> 5), slot = 4 * (k & 31);
        const float* pp = D.PART + (size_t)tl * 1024 + slot;
        f32x4 sm = *(const f32x4*)pp;
#pragma unroll
        for (int x = 1; x < 8; ++x) sm += *(const f32x4*)(pp + 128 * x);
        const size_t i = (D.tok0 + tl) * 128 + slot;
        const f32x4 gt = *(const f32x4*)(D.GATE + i);
        const float dsc = (1.0f / PD_SCALE) / sqrtf(((const float*)(F.ws + WS_SSQ))[D.tok0 + tl] * (1.f / DM) + EPS);
        const f32x4 o = {gt.x * gelu_erf(sm.x * dsc) * (1.0f / PU_SCALE), gt.y * gelu_erf(sm.y * dsc) * (1.0f / PU_SCALE),
                         gt.z * gelu_erf(sm.z * dsc) * (1.0f / PU_SCALE), gt.w * gelu_erf(sm.w * dsc) * (1.0f / PU_SCALE)};
        *(f32x4*)(D.COEF + i) = o;
    }
}
__device__ __forceinline__ void peer_up_rows(u32x4 (&R)[16], __amdgpu_buffer_rsrc_t tab, int slice, int id0, int id1, int lane) {
    const int soff = slice * (16384 * 128);
#pragma unroll
    for (int s8 = 0; s8 < 8; ++s8) { const int id = __shfl(s8 < 4 ? id0 : id1, (16 * s8 + (lane >> 2)) & 63); const int vo = (id << 7) + 16 * (lane & 3);
        R[2 * s8] = __builtin_amdgcn_raw_buffer_load_b128(tab, vo, soff, 0); R[2 * s8 + 1] = __builtin_amdgcn_raw_buffer_load_b128(tab, vo, soff + 64, 0); }
}
__device__ __forceinline__ void peer_up_compute(const u32x4 (&R)[16], float c0, float c1, f32x2 h, float* out, int slice, size_t tok, int lane) {
    f32x2 acc[16];
#pragma unroll
    for (int k = 0; k < 16; ++k) acc[k] = (f32x2){0.f, 0.f};
#pragma unroll
    for (int s8 = 0; s8 < 8; ++s8) { const float c = __shfl(s8 < 4 ? c0 : c1, (16 * s8 + (lane >> 2)) & 63); f32x2 c2 = {c, c}; asm volatile("" : "+v"(c2));
#pragma unroll
        for (int hf = 0; hf < 2; ++hf) { const u32x4 r = R[2 * s8 + hf];
            acc[8 * hf + 0] = c2 * __builtin_amdgcn_cvt_pk_f32_fp8(r.x, false) + acc[8 * hf + 0]; acc[8 * hf + 1] = c2 * __builtin_amdgcn_cvt_pk_f32_fp8(r.x, true) + acc[8 * hf + 1];
            acc[8 * hf + 2] = c2 * __builtin_amdgcn_cvt_pk_f32_fp8(r.y, false) + acc[8 * hf + 2]; acc[8 * hf + 3] = c2 * __builtin_amdgcn_cvt_pk_f32_fp8(r.y, true) + acc[8 * hf + 3];
            acc[8 * hf + 4] = c2 * __builtin_amdgcn_cvt_pk_f32_fp8(r.z, false) + acc[8 * hf + 4]; acc[8 * hf + 5] = c2 * __builtin_amdgcn_cvt_pk_f32_fp8(r.z, true) + acc[8 * hf + 5];
            acc[8 * hf + 6] = c2 * __builtin_amdgcn_cvt_pk_f32_fp8(r.w, false) + acc[8 * hf + 6]; acc[8 * hf + 7] = c2 * __builtin_amdgcn_cvt_pk_f32_fp8(r.w, true) + acc[8 * hf + 7]; } }
    f32x2 r8[8], r4[4], r2[2], r1;
    { const bool up = (lane & 32) != 0;
#pragma unroll
      for (int k = 0; k < 8; ++k) { const f32x2 keep = up ? acc[k + 8] : acc[k], send = up ? acc[k] : acc[k + 8]; r8[k] = keep + (f32x2){__shfl_xor(send.x, 32), __shfl_xor(send.y, 32)}; } }
    { const bool up = (lane & 16) != 0;
#pragma unroll
      for (int k = 0; k < 4; ++k) { const f32x2 keep = up ? r8[k + 4] : r8[k], send = up ? r8[k] : r8[k + 4]; r4[k] = keep + (f32x2){__shfl_xor(send.x, 16), __shfl_xor(send.y, 16)}; } }
    { const bool up = (lane & 8) != 0;
#pragma unroll
      for (int k = 0; k < 2; ++k) { const f32x2 keep = up ? r4[k + 2] : r4[k], send = up ? r4[k] : r4[k + 2]; r2[k] = keep + (f32x2){__shfl_xor(send.x, 8), __shfl_xor(send.y, 8)}; } }
    { const bool up = (lane & 4) != 0; const f32x2 keep = up ? r2[1] : r2[0], send = up ? r2[0] : r2[1]; r1 = keep + (f32x2){__shfl_xor(send.x, 4), __shfl_xor(send.y, 4)}; }
    const int p = ((lane >> 5) & 1) * 8 + ((lane >> 4) & 1) * 4 + ((lane >> 3) & 1) * 2 + ((lane >> 2) & 1);
    *(f32x2*)(out + tok * DM + slice * 128 + 16 * (lane & 3) + 2 * (p & 7) + 64 * (p >> 3)) = h + r1;
}
__device__ __forceinline__ void peer_up_phase(Frame& F, const PeerDeal& D, float* outp) {
    const __amdgpu_buffer_rsrc_t PU = __builtin_amdgcn_make_buffer_rsrc((void*)(F.ws + WS_PU), 0, 16384 * 1024, 0x00020000);
    const int* IDX = D.IDX; const float* COEF = D.COEF;
    int lane = F.lane; asm volatile("" : "+v"(lane));
    const int wave = F.wave;
    const int ntok = D.ntok;
    const int p = ((lane >> 5) & 1) * 8 + ((lane >> 4) & 1) * 4 + ((lane >> 3) & 1) * 2 + ((lane >> 2) & 1);
    const int hoff = 16 * (lane & 3) + 2 * (p & 7) + 64 * (p >> 3);
    int sl; size_t tk;
    u32x4 R0[16], R1[16];
    float ca0, ca1, cb0, cb1; f32x2 ha, hb;
    int id0, id1, jd0, jd1;
    { int s1_; size_t t1_; peer_item(0, D, wave, sl, tk); peer_item(1, D, wave, s1_, t1_);
      jd0 = IDX[tk * 128 + lane]; jd1 = IDX[tk * 128 + 64 + lane]; id0 = IDX[t1_ * 128 + lane]; id1 = IDX[t1_ * 128 + 64 + lane];
      __builtin_amdgcn_sched_barrier(0);
      peer_up_rows(R0, PU, sl, jd0, jd1, lane);
      ca0 = COEF[tk * 128 + lane]; ca1 = COEF[tk * 128 + 64 + lane]; ha = *(const f32x2*)(F.out + tk * DM + sl * 128 + hoff);
      __builtin_amdgcn_sched_barrier(0); }
#pragma unroll 1
    for (int n = 0; n < ntok; n += 2) {
        int s0, s1, s2, s3; size_t t0, t1, t2, t3;
        peer_item(n, D, wave, s0, t0); peer_item(n + 1, D, wave, s1, t1);
        peer_item(n + 2 < ntok ? n + 2 : n, D, wave, s2, t2); peer_item(n + 3 < ntok ? n + 3 : n + 1, D, wave, s3, t3);
        jd0 = IDX[t2 * 128 + lane]; jd1 = IDX[t2 * 128 + 64 + lane];
        peer_up_rows(R1, PU, s1, id0, id1, lane);
        cb0 = COEF[t1 * 128 + lane]; cb1 = COEF[t1 * 128 + 64 + lane]; hb = *(const f32x2*)(F.out + t1 * DM + s1 * 128 + hoff);
        __builtin_amdgcn_sched_barrier(0);
        peer_up_compute(R0, ca0, ca1, ha, outp, s0, t0, lane);
        __builtin_amdgcn_sched_barrier(0);
        id0 = IDX[t3 * 128 + lane]; id1 = IDX[t3 * 128 + 64 + lane];
        peer_up_rows(R0, PU, s2, jd0, jd1, lane);
        ca0 = COEF[t2 * 128 + lane]; ca1 = COEF[t2 * 128 + 64 + lane]; ha = *(const f32x2*)(F.out + t2 * DM + s2 * 128 + hoff);
        __builtin_amdgcn_sched_barrier(0);
        peer_up_compute(R1, cb0, cb1, hb, outp, s1, t1, lane);
        __builtin_amdgcn_sched_barrier(0);
    }
}
__device__ __forceinline__ void peer_tile(Frame& F, int tile) {
    const size_t tok0 = (size_t)tile * 256;
    const bf16* Q = (const bf16*)(F.ws + WS_BIG);
    int* IDX = (int*)(F.ws + WS_BIG + 256 * MiB); float* GATE = (float*)(F.ws + WS_BIG + 288 * MiB); float* COEF = (float*)(F.ws + WS_BIG + 320 * MiB);
    peer_topk_tile(F, tok0, Q, IDX, GATE);
    VM_WAIT(); __syncthreads();
    PeerDeal D; D.tokw = tok0 + F.wave * 32; D.ntok = 256; D.tok0 = tok0; D.PART = (float*)(F.ws + WS_BIG + tok0 * (PEER_Q * 2)); D.IDX = IDX; D.GATE = GATE; D.COEF = COEF;
    peer_down_phase(F, D);
    VM_WAIT(); __syncthreads();
    peer_coef_wave(F, D);
    VM_WAIT(); __syncthreads();
    peer_up_phase(F, D, F.out);
}
__device__ __forceinline__ void peer_phase(Frame& F) { for (int tile = F.bid; tile < T / 256; tile += F.G) { peer_tile(F, tile); VM_WAIT(); __syncthreads(); } }

constexpr int N_PHASES = 14;
__global__ void __launch_bounds__(NTHR, 2) mega_fwd(Args args) {
    extern __shared__ __attribute__((aligned(16))) unsigned char lds_raw[];
    Frame F;
    F.lds = (LAS unsigned char*)lds_raw;
    F.tid = threadIdx.x; F.lane = F.tid & 63; F.wave = __builtin_amdgcn_readfirstlane(F.tid >> 6);
    F.G = gridDim.x; F.bid = blockIdx.x;
    F.in = args.in;
    F.positions = args.positions; F.out = args.out; F.ws = args.ws;
    unsigned char* ws = args.ws;
    volatile LAS unsigned* ctlw = (volatile LAS unsigned*)(F.lds + LDSCTL_OFF);
    if (F.tid < 64) ctlw[F.tid] = 0u;
    __syncthreads();
    const int lo = args.ph_lo, hi = args.ph_hi;
    XcdBarrier bar; bar.bar = (unsigned*)(ws + WS_CTL); bar.x = 0; bar.st = nullptr; bar.wave = F.wave;
    if (hi - lo > 1) bar = xcd_barrier_post((unsigned*)(ws + WS_CTL), ctlw + 8, F.wave);
#define IN(k) (lo <= (k) && (k) < hi)
#define SEAM(k) do { if (IN(k) && IN((k) + 1)) xcd_barrier(bar); } while (0)
    bf16* ACT1 = (bf16*)(ws + WS_ACT1); bf16* BIG = (bf16*)(ws + WS_BIG); bf16* WallT = (bf16*)(ws + WS_WALLT);

    if (IN(0)) { frame_refresh(F); p0_prologue(F); __syncthreads(); }
    SEAM(0);
    if (IN(1)) { frame_refresh(F);
        p1_wquant(F); xcd_barrier(bar); frame_refresh(F);
        { pg8::Gemm g{(const bf16*)(ws + WS_MEMN), (const bf16*)(ws + WS_WMKVT), NB * NMEM, 768, DM, DM, DM}; pg8::StaticOrder S; S.init(g.M, g.N, F.G, F.bid);
          pg8::EpiBf16<0> E{(bf16*)(ws + WS_MKV), 1536}; pg8::gemm_phase(F.lds, g, S, E, F.wave); }
        { pg8::Gemm g{(const bf16*)(ws + WS_WMKVT) + (size_t)768 * DM, (const bf16*)(ws + WS_MEMN), 768, NB * NMEM, DM, DM, DM}; pg8::StaticOrder S; S.init(g.M, g.N, F.G, F.G - 1 - F.bid);
          pg8::EpiBf16<0> E{(bf16*)(ws + WS_MVT), NB * NMEM}; pg8::gemm_phase(F.lds, g, S, E, F.wave); }
        { pg8::Gemm g{(const bf16*)(ws + WS_U8), (const bf16*)(ws + WS_W8), HT, NPROJ, DM / 2, DM / 2, DM / 2}; pg8::StaticOrder S; S.init(g.M, g.N, F.G, F.bid);
          pg8::EpiBf16Q<0> E{BIG, NPROJ, (const float*)(ws + WS_USC), (const float*)(ws + WS_WSC)}; pg8::gemm_phase<2>(F.lds, g, S, E, F.wave); }
    }
    SEAM(1);
    if (IN(2)) { frame_refresh(F); mknorm_phase(F); ssdC_phase(F, 0); }
    SEAM(2);
    if (IN(3)) { frame_refresh(F); ssdD_phase(F); dilattn_mfma_phase(F, 0); memattn_mfma_phase(F, 0); }
    SEAM(3);
    if (IN(4)) { frame_refresh(F); ssdE_phase(F, 0); dilmerge_phase(F, 0); }
    SEAM(4);
    if (IN(5)) { frame_refresh(F); pg8::Gemm g{(const bf16*)(ws + WS_U8 + (size_t)HT * DM), (const bf16*)(ws + WS_W8), HT, NPROJ, DM / 2, DM / 2, DM / 2}; pg8::StaticOrder S; S.init(g.M, g.N, F.G, F.bid);
        pg8::EpiBf16Q<0> E{BIG, NPROJ, (const float*)(ws + WS_USC) + HT, (const float*)(ws + WS_WSC)}; pg8::gemm_phase<2>(F.lds, g, S, E, F.wave); }
    SEAM(5);
    if (IN(6)) { frame_refresh(F); ssdC_phase(F, 1); }
    SEAM(6);
    if (IN(7)) { frame_refresh(F); ssdD_phase(F); dilattn_mfma_phase(F, 1); memattn_mfma_phase(F, 1); }
    SEAM(7);
    if (IN(8)) { frame_refresh(F); ssdE_phase(F, 1); dilmerge_phase(F, 1); }
    SEAM(8);
    if (IN(9)) { frame_refresh(F);
        { pg8::Gemm g{(const bf16*)(ws + WS_U8), (const bf16*)(ws + WS_W8 + (size_t)NPROJ * DM), T, NGATE, DM / 2, DM / 2, DM / 2}; pg8::GateOrder S; S.B.init(T, DM, F.G, F.bid);
          pg8::EpiBf16Q<1> E{BIG, NGATE, (const float*)(ws + WS_USC), (const float*)(ws + WS_WSC) + NPROJ}; pg8::gemm_phase<2>(F.lds, g, S, E, F.wave); }
        VM_WAIT(); __syncthreads();
    }
    if (IN(10)) { frame_refresh(F);
        pg8::Gemm g{(const bf16*)F.out, (const bf16*)(ws + WS_WCATT), T, DM, YC, YC, YC}; pg8::StaticOrder S; S.init(g.M, g.N, F.G, F.bid);
        pg8::EpiBranchFused E{ACT1, DM, __builtin_amdgcn_make_buffer_rsrc((void*)BIG, 0, T * NGATE * 2, 0x00020000), NGATE}; pg8::gemm_phase(F.lds, g, S, E, F.wave);
    }
    SEAM(10);
    if (IN(11)) { frame_refresh(F); pg8::Gemm g{ACT1, (const bf16*)(ws + WS_WOUTT), T, DM, DM, DM, DM}; pg8::StaticOrder S; S.init(g.M, g.N, F.G, F.bid);
        pg8::EpiResidNorm E{F.out, DM, F.in[I_X], (bf16*)(ws + WS_HB), F.in[I_NFFNW], (float*)(ws + WS_SSQ)}; pg8::gemm_phase(F.lds, g, S, E, F.wave); }
    SEAM(11);
    if (IN(12)) { frame_refresh(F); pg8::Gemm g{(const bf16*)(ws + WS_HB), (const bf16*)(ws + WS_WQT), T, PEER_Q, DM, DM, DM}; pg8::StaticOrder S; S.init(g.M, g.N, F.G, F.bid);
        pg8::EpiBf16RowScale E{BIG, PEER_Q, (const float*)(ws + WS_SSQ)}; pg8::gemm_phase(F.lds, g, S, E, F.wave); }
    SEAM(12);
    if (IN(13)) { frame_refresh(F); peer_phase(F); }
#undef IN
#undef SEAM
}

extern "C" void kernel_launch(void* const* d_in, const int* in_sizes, int n_in, void* d_out, int out_size, void* d_ws, size_t ws_size, hipStream_t stream) {
    static int grid = 0;
    if (grid == 0) {
        if (n_in != 26 || out_size != T * DM || ws_size < WS_END) { fprintf(stderr, "kernel_launch: unexpected shapes (n_in %d, out %d, ws %zu)\n", n_in, out_size, ws_size); grid = -1; return; }
        int dev = 0, cus = 0;
        if (hipGetDevice(&dev) != hipSuccess || hipDeviceGetAttribute(&cus, hipDeviceAttributeMultiprocessorCount, dev) != hipSuccess) { grid = -1; return; }
        if (hipFuncSetAttribute((const void*)mega_fwd, hipFuncAttributeMaxDynamicSharedMemorySize, LDS_BYTES) != hipSuccess) { grid = -1; return; }
        int per_cu = 0;
        (void)hipOccupancyMaxActiveBlocksPerMultiprocessor(&per_cu, (const void*)mega_fwd, NTHR, LDS_BYTES);
        (void)hipGetLastError();
        grid = cus;
    }
    if (grid < 0) return;
    (void)hipMemsetAsync((char*)d_ws + WS_CTL, 0, CTL_ZERO_BYTES, stream);
    Args a{};
    for (int i = 0; i < 26; ++i) a.in[i] = (const float*)d_in[i];
    a.positions = (const int*)d_in[2]; a.out = (float*)d_out; a.ws = (unsigned char*)d_ws;
#if MK_N_LAUNCHES == 1
    a.ph_lo = 0; a.ph_hi = N_PHASES;
    hipLaunchKernelGGL(mega_fwd, dim3(grid), dim3(NTHR), LDS_BYTES, stream, a);
#else
    for (int p = 0; p < N_PHASES; ++p) { a.ph_lo = p; a.ph_hi = p + 1; hipLaunchKernelGGL(mega_fwd, dim3(grid), dim3(NTHR), LDS_BYTES, stream, a); }
#endif
}
```

```cpp
#include <hip/hip_runtime.h>
#include <cstdio>
#include <cstdint>

#ifndef MK_N_LAUNCHES
#define MK_N_LAUNCHES 1
#endif

#define LAS __attribute__((address_space(3)))
#define GAS __attribute__((address_space(1)))
typedef unsigned short bf16;
typedef short bf16x8 __attribute__((ext_vector_type(8)));
typedef float f32x4 __attribute__((ext_vector_type(4)));
typedef float f32x2 __attribute__((ext_vector_type(2)));
typedef unsigned u32x4 __attribute__((ext_vector_type(4)));
typedef unsigned u32x2 __attribute__((ext_vector_type(2)));
typedef int i32x4 __attribute__((ext_vector_type(4)));
typedef int i32x8 __attribute__((ext_vector_type(8)));

constexpr int NB = 8, SEQ = 8192, DM = 1024, T = NB * SEQ;
constexpr int HB = 4, HT = HB * SEQ;
constexpr int NMEM = 256;
constexpr int NPROJ = 6144;
constexpr int PC_Z = 0, PC_X = 1024, PC_B = 2048, PC_C = 2560, PC_DQ = 3072, PC_DK = 3840, PC_DV = 4608, PC_MQ = 5376;
constexpr int W_IN_N = 9232, OFF_DT = 3072, OFF_AFTER_DT = 3088;
constexpr int NGATE = 3072;
constexpr int YC = 2048;
constexpr int PEER_H = 8, PEER_K = 16, PEER_NK = 128, PEER_Q = 2048;
constexpr float EPS = 1e-6f;

constexpr size_t MiB = 1u << 20;
constexpr size_t WS_CTL = 0, WS_WAMAX = 65536, CTL_ZERO_BYTES = 131072;
constexpr size_t WS_WALLT = 1 * MiB;
constexpr size_t WS_WMKVT = 19 * MiB;
constexpr size_t WS_WCATT = 22 * MiB;
constexpr size_t WS_WOUTT = 26 * MiB;
constexpr size_t WS_WQT = 28 * MiB;
constexpr size_t WS_SUBK = 32 * MiB;
constexpr size_t WS_PD = 33 * MiB;
constexpr size_t WS_PU = 65 * MiB;
constexpr size_t WS_DT = 97 * MiB;
constexpr size_t WS_MEMN = 101 * MiB;
constexpr size_t WS_MKV = 105 * MiB;
constexpr size_t WS_ACT1 = 112 * MiB;
constexpr size_t WS_BIG = 240 * MiB;
constexpr size_t WS_LSE = 624 * MiB;
constexpr size_t WS_MVT = 628 * MiB;
constexpr size_t WS_DEC = 631 * MiB;
constexpr size_t WS_SST = 632 * MiB;
constexpr size_t WS_SIN = 760 * MiB;
constexpr size_t WS_ROPE = 824 * MiB;
constexpr size_t WS_SSQ = 828 * MiB;
constexpr size_t WS_HB = 632 * MiB;
constexpr size_t WS_U8 = 832 * MiB;
constexpr size_t WS_W8 = WS_WALLT;
constexpr size_t WS_WSC = 896 * MiB;
constexpr size_t WS_USC = 897 * MiB;
constexpr size_t WS_HN8 = WS_U8;
constexpr size_t WS_HNSC = WS_USC;
constexpr size_t WS_H1B = WS_HB;
constexpr size_t WS_HN8F = WS_SIN;
constexpr size_t WS_END = 898 * MiB;

constexpr int RING_BYTES = 131072;
constexpr int LDSCTL_OFF = 143360;
constexpr int LDS_BYTES = 147456;
constexpr int NWAVES = 8, NTHR = 512;

__device__ __forceinline__ int lane_id() { return (int)__builtin_amdgcn_mbcnt_hi(~0u, __builtin_amdgcn_mbcnt_lo(~0u, 0u)); }
__device__ __forceinline__ float bf2f(unsigned short b) { return __builtin_bit_cast(float, (unsigned)b << 16); }
__device__ __forceinline__ float bflo(unsigned w) { return __builtin_bit_cast(float, w << 16); }
__device__ __forceinline__ float bfhi(unsigned w) { return __builtin_bit_cast(float, w & 0xffff0000u); }
__device__ __forceinline__ unsigned f2bf(float f) { unsigned u = __builtin_bit_cast(unsigned, f); return (u + 0x7fffu + ((u >> 16) & 1u)) >> 16; }
__device__ __forceinline__ unsigned pk2(float lo, float hi);
typedef float f32x16 __attribute__((ext_vector_type(16)));
typedef short s16x4 __attribute__((ext_vector_type(4)));
typedef __bf16 bf2_t __attribute__((ext_vector_type(2)));
__device__ __forceinline__ unsigned pkbf(float a, float b) { const f32x2 v = {a, b}; return __builtin_bit_cast(unsigned, __builtin_convertvector(v, bf2_t)); }
__device__ __forceinline__ unsigned pk2(float lo, float hi) { return pkbf(lo, hi); }
#define MFMA32(a, b, c) __builtin_amdgcn_mfma_f32_32x32x16_bf16((a), (b), (c), 0, 0, 0)
__device__ __forceinline__ float wave_sum(float v) {
#pragma unroll
    for (int o = 1; o < 64; o <<= 1) v += __shfl_xor(v, o);
    return v;
}
__device__ __forceinline__ float wave_max(float v) {
#pragma unroll
    for (int o = 1; o < 64; o <<= 1) v = fmaxf(v, __shfl_xor(v, o));
    return v;
}
__device__ __forceinline__ float sigmoidf_(float x) { return __builtin_amdgcn_rcpf(1.0f + __expf(-x)); }
#define LDS_WAIT() asm volatile("s_waitcnt lgkmcnt(0)" ::: "memory")
#define VM_WAIT() asm volatile("s_waitcnt vmcnt(0)" ::: "memory")

#define XB_TMO      128
#define XB_XCNT(j)  (256  + 64 * (j))
#define XB_XSUB(j)  (1280 + 64 * (j))
#define XB_XGEN(j)  (2304 + 64 * (j))
#define XB_TOP      3328
#define XB_TOPGEN   3392
#define XCD_BAR_WORDS 3456
#define XB_SPIN_CAP (1u << 18)
__device__ __forceinline__ unsigned xb_ld(unsigned* p)              { return __hip_atomic_load(p, __ATOMIC_RELAXED, __HIP_MEMORY_SCOPE_AGENT); }
__device__ __forceinline__ unsigned xb_add(unsigned* p, unsigned v) { return __hip_atomic_fetch_add(p, v, __ATOMIC_RELAXED, __HIP_MEMORY_SCOPE_AGENT); }
__device__ __forceinline__ unsigned xb_xcc_id() { return (unsigned)__builtin_amdgcn_s_getreg((3 << 11) | 20) & 0xFu; }
#define XB_SPIN(cond, bar) do { unsigned _sp = 0; while (cond) { __builtin_amdgcn_s_sleep(1); \
    if ((++_sp & 255u) == 0u) { if (xb_ld(&(bar)[XB_TMO])) break; if (_sp > XB_SPIN_CAP) { atomicAdd(&(bar)[XB_TMO], 1u); break; } } } } while (0)
struct XcdBarrier { unsigned* bar; unsigned x; volatile LAS unsigned* st; int wave; };
__device__ __forceinline__ XcdBarrier xcd_barrier_post(unsigned* bar, volatile LAS unsigned* st, int wave) {
    XcdBarrier b; b.bar = bar; b.x = xb_xcc_id(); b.st = st; b.wave = wave;
    if (wave == 0 && lane_id() == 0) (void)xb_add(&bar[XB_XCNT(b.x)], 1u);
    return b;
}
__device__ __forceinline__ void xcd_barrier_complete(unsigned* bar, unsigned x, unsigned& nloc, unsigned& nx) {
    const unsigned G = gridDim.x * gridDim.y * gridDim.z;
    unsigned sum, cnt, mine, sp = 0u;
    for (;;) {
        sum = 0u; cnt = 0u; mine = 0u;
#pragma unroll
        for (unsigned j = 0; j < 16; ++j) { const unsigned c = xb_ld(&bar[XB_XCNT(j)]); sum += c; cnt += (c > 0u) ? 1u : 0u; mine = (j == x) ? c : mine; }
        if (sum == G) break;
        __builtin_amdgcn_s_sleep(1);
        if ((++sp & 255u) == 0u) { if (xb_ld(&bar[XB_TMO])) break; if (sp > XB_SPIN_CAP) { atomicAdd(&bar[XB_TMO], 1u); break; } }
    }
    nloc = mine > 0u ? mine : 1u; nx = cnt > 0u ? cnt : 1u;
}
__device__ __forceinline__ void xcd_barrier(const XcdBarrier& b) {
    asm volatile("s_waitcnt vmcnt(0)" ::: "memory");
    __syncthreads();
    if (b.wave == 0 && lane_id() == 0) {
        unsigned* bar = b.bar;
        __builtin_amdgcn_s_waitcnt(0);
        unsigned nloc = b.st[0], nx = b.st[1];
        if (nloc == 0u) { xcd_barrier_complete(bar, b.x, nloc, nx); b.st[0] = nloc; b.st[1] = nx; }
        const unsigned old = xb_add(&bar[XB_XSUB(b.x)], 1u);
        const unsigned gen = old / nloc;
        if (old + 1u == (gen + 1u) * nloc) {
            __builtin_amdgcn_fence(__ATOMIC_RELEASE, "agent");
            asm volatile("s_waitcnt vmcnt(0)" ::: "memory");
            const unsigned og = xb_add(&bar[XB_TOP], 1u);
            const unsigned tg = og / nx;
            if (og + 1u == (tg + 1u) * nx) xb_add(&bar[XB_TOPGEN], 1u);
            else XB_SPIN(xb_ld(&bar[XB_TOPGEN]) == tg, bar);
            __builtin_amdgcn_fence(__ATOMIC_ACQUIRE, "agent");
            xb_add(&bar[XB_XGEN(b.x)], 1u);
            asm volatile("s_waitcnt vmcnt(0)" ::: "memory");
        } else {
            XB_SPIN(xb_ld(&bar[XB_XGEN(b.x)]) == gen, bar);
            __builtin_amdgcn_fence(__ATOMIC_ACQUIRE, "agent");
            asm volatile("s_waitcnt vmcnt(0)" ::: "memory");
        }
    }
    __syncthreads();
}

constexpr float WC_SCALE = 32.0f, YD_SCALE = 8.0f;
namespace pg8 {
constexpr int BM = 256, BK = 64, HALF = 128, HTB = HALF * BK * 2, STAGE_BYTES = 8 * HTB, NXCD = 8, WGM = 8;
__host__ __device__ __forceinline__ int lds_byte(int r, int c) { const int st = (r >> 4) * 2 + (c >> 5), rr = r & 15, cc = c & 31, ob = rr * 64 + cc * 2; return st * 1024 + (ob ^ (((ob >> 9) & 1) << 5)); }
__host__ __device__ __forceinline__ void stage_rc(int b, int& R, int& C) { const int st = b / 1024, sb = b % 1024, swz = sb ^ (((sb >> 9) & 1) << 5); R = (st >> 1) * 16 + swz / 64; C = (st & 1) * 32 + (swz % 64) / 2; }
__host__ __device__ __forceinline__ int perm32(int rho) { const int n = rho >> 4, i = rho & 15; return 8 * (i >> 2) + 4 * n + (i & 3); }
struct Unit { int pm, pn; };
struct Gemm { const bf16* A; const bf16* Bt; int M, N, K, lda, ldb; };
struct StaticOrder {
    int nM, nN, nwg, G, c;
    __host__ __device__ void init(int M, int N, int G_, int c_) { nM = M / BM; nN = N / BM; nwg = nM * nN; G = G_; c = c_; }
    __host__ __device__ bool next(int i, Unit& u) const {
        const long L = (long)i * G + c; if (L >= nwg) return false;
        int wgid = (int)L; { const int q = nwg / NXCD, r = nwg % NXCD, xcd = wgid % NXCD, off = wgid / NXCD; wgid = (xcd < r ? xcd * (q + 1) : r * (q + 1) + (xcd - r) * q) + off; }
        const int nig = WGM * nN, gid = wgid / nig, fm = gid * WGM, gsz = (nM - fm) < WGM ? (nM - fm) : WGM;
        u.pm = fm + ((wgid % nig) % gsz); u.pn = (wgid % nig) / gsz; return true;
    }
    __device__ __forceinline__ void a_ready(const Unit&) const {}
    __device__ __forceinline__ void done(const Unit&) const {}
};
struct PanelOrder {
    int nM, nN, G, c;
    __host__ __device__ void init(int M, int N, int G_, int c_) { nM = M / BM; nN = N / BM; G = G_; c = c_; }
    __device__ __forceinline__ bool next(int i, Unit& u) const { const int p = c + (i / nN) * G; if (p >= nM) return false; u.pm = p; u.pn = (i + (c >> 3)) % nN; return true; }
    __device__ __forceinline__ void a_ready(const Unit&) const {}
    __device__ __forceinline__ void done(const Unit&) const {}
};
struct GateOrder {
    StaticOrder B;
    __device__ __forceinline__ bool next(int i, Unit& u) const { Unit t; if (!B.next(i / 3, t)) return false; u.pm = t.pm; u.pn = t.pn + 4 * (i % 3); return true; }
    __device__ __forceinline__ void a_ready(const Unit&) const {}
    __device__ __forceinline__ void done(const Unit&) const {}
};
__device__ __forceinline__ unsigned cvt_pk_bf16(float lo, float hi) { return pkbf(lo, hi); }

constexpr float WG_SCALE = 32.0f;
template <int ACT> struct EpiBf16 {
    static constexpr bool PERM = true, AFTER_DRAIN = false, HAS_MID = false;
    bf16* O; int ldc;
    __device__ __forceinline__ void operator()(const f32x4 (&acc)[2][2][4][2], const Unit& u, int wr, int wc, int fr, int fq) const {
        const int row0 = u.pm * BM + wr * 64 + fr; const int col0 = u.pn * BM + wc * 32 + 8 * fq;
#pragma unroll
        for (int ai = 0; ai < 2; ++ai)
#pragma unroll
            for (int m = 0; m < 4; ++m) { bf16* rowp = O + (size_t)(row0 + ai * HALF + m * 16) * ldc + col0;
#pragma unroll
                for (int bj = 0; bj < 2; ++bj) { f32x4 v0 = acc[ai][bj][m][0], v1 = acc[ai][bj][m][1];
                    if (ACT == 1) {
#pragma unroll
                        for (int j = 0; j < 4; ++j) { v0[j] = sigmoidf_(v0[j]); v1[j] = sigmoidf_(v1[j]); } }
                    if (ACT == 2) {
#pragma unroll
                        for (int j = 0; j < 4; ++j) { v0[j] = sigmoidf_(v0[j] * (1.0f / WG_SCALE)); v1[j] = sigmoidf_(v1[j] * (1.0f / WG_SCALE)); } }
                    u32x4 w; w.x = cvt_pk_bf16(v0[0], v0[1]); w.y = cvt_pk_bf16(v0[2], v0[3]); w.z = cvt_pk_bf16(v1[0], v1[1]); w.w = cvt_pk_bf16(v1[2], v1[3]);
                    *(u32x4*)(rowp + bj * HALF) = w; } }
    }
};
__device__ __forceinline__ f32x4 i2f4(f32x4 a) { return __builtin_convertvector(__builtin_bit_cast(i32x4, a), f32x4); }
template <int ACT> struct EpiBf16Q {
    static constexpr bool PERM = true, AFTER_DRAIN = false, HAS_MID = false;
    bf16* O; int ldc; const float* sa; const float* sb;
    __device__ __forceinline__ void operator()(const f32x4 (&acc)[2][2][4][2], const Unit& u, int wr, int wc, int fr, int fq) const {
        const int row0 = u.pm * BM + wr * 64 + fr; const int col0 = u.pn * BM + wc * 32 + 8 * fq;
        f32x4 sbv[2][2];
#pragma unroll
        for (int bj = 0; bj < 2; ++bj)
#pragma unroll
            for (int n = 0; n < 2; ++n) sbv[bj][n] = *(const f32x4*)(sb + col0 + bj * HALF + 4 * n);
#pragma unroll
        for (int ai = 0; ai < 2; ++ai)
#pragma unroll
            for (int m = 0; m < 4; ++m) { const int row = row0 + ai * HALF + m * 16; const float sr = sa[row]; bf16* rowp = O + (size_t)row * ldc + col0;
#pragma unroll
                for (int bj = 0; bj < 2; ++bj) { f32x4 v0 = i2f4(acc[ai][bj][m][0]) * sr * sbv[bj][0], v1 = i2f4(acc[ai][bj][m][1]) * sr * sbv[bj][1];
                    if (ACT == 1) {
#pragma unroll
                        for (int j = 0; j < 4; ++j) { v0[j] = __builtin_amdgcn_rcpf(1.0f + __expf(-v0[j])); v1[j] = __builtin_amdgcn_rcpf(1.0f + __expf(-v1[j])); } }
                    u32x4 w; w.x = cvt_pk_bf16(v0[0], v0[1]); w.y = cvt_pk_bf16(v0[2], v0[3]); w.z = cvt_pk_bf16(v1[0], v1[1]); w.w = cvt_pk_bf16(v1[2], v1[3]);
                    *(u32x4*)(rowp + bj * HALF) = w; } }
    }
};
struct EpiGateU8 {
    static constexpr bool PERM = true, AFTER_DRAIN = false, HAS_MID = false;
    unsigned char* O; int ldc; const float* sa; const float* sb;
    __device__ __forceinline__ void operator()(const f32x4 (&acc)[2][2][4][2], const Unit& u, int wr, int wc, int fr, int fq) const {
        const int row0 = u.pm * BM + wr * 64 + fr; const int col0 = u.pn * BM + wc * 32 + 8 * fq;
        f32x4 sbv[2][2];
#pragma unroll
        for (int bj = 0; bj < 2; ++bj)
#pragma unroll
            for (int n = 0; n < 2; ++n) sbv[bj][n] = *(const f32x4*)(sb + col0 + bj * HALF + 4 * n) * -1.4426950408889634f;
#pragma unroll
        for (int ai = 0; ai < 2; ++ai)
#pragma unroll
            for (int m = 0; m < 4; ++m) { const int row = row0 + ai * HALF + m * 16; const float sr = sa[row]; unsigned char* rowp = O + (size_t)row * ldc + col0;
#pragma unroll
                for (int bj = 0; bj < 2; ++bj) { f32x4 v0 = i2f4(acc[ai][bj][m][0]) * (sr * sbv[bj][0]), v1 = i2f4(acc[ai][bj][m][1]) * (sr * sbv[bj][1]);
                    unsigned w0 = 0u, w1 = 0u;
#pragma unroll
                    for (int j = 0; j < 4; ++j) { constexpr float k = 1.0f / 255.0f;
                        const float g0 = fmaxf(__builtin_rintf(__builtin_amdgcn_rcpf(__builtin_fmaf(__builtin_amdgcn_exp2f(v0[j]), k, k))), 1.0f), g1 = fmaxf(__builtin_rintf(__builtin_amdgcn_rcpf(__builtin_fmaf(__builtin_amdgcn_exp2f(v1[j]), k, k))), 1.0f);
                        w0 = __builtin_amdgcn_cvt_pk_u8_f32(g0, j, w0); w1 = __builtin_amdgcn_cvt_pk_u8_f32(g1, j, w1); }
                    const u32x2 w = {w0, w1};
                    *(u32x2*)(rowp + bj * HALF) = w; } }
    }
};
struct EpiResid {
    static constexpr bool PERM = false, AFTER_DRAIN = false, HAS_MID = false;
    float* C; int ldc; const float* R;
    __device__ __forceinline__ void operator()(const f32x4 (&acc)[2][2][4][2], const Unit& u, int wr, int wc, int fr, int fq) const {
        const int row0 = u.pm * BM + wr * 64 + fr, col0 = u.pn * BM + wc * 32 + 4 * fq;
#pragma unroll
        for (int ai = 0; ai < 2; ++ai)
#pragma unroll
            for (int m = 0; m < 4; ++m) { const size_t off = (size_t)(row0 + ai * HALF + m * 16) * ldc + col0;
#pragma unroll
                for (int bj = 0; bj < 2; ++bj)
#pragma unroll
                    for (int n = 0; n < 2; ++n) { const f32x4 r = *(const f32x4*)(R + off + bj * HALF + n * 16); *(f32x4*)(C + off + bj * HALF + n * 16) = acc[ai][bj][m][n] + r; } }
    }
};

struct EpiResidNorm {
    static constexpr bool PERM = false, AFTER_DRAIN = false, HAS_MID = false;
    float* C; int ldc; const float* R; bf16* Hb; const float* w; float* SSQ;
    __device__ __forceinline__ void operator()(const f32x4 (&acc)[2][2][4][2], const Unit& u, int wr, int wc, int fr, int fq) const {
        const int row0 = u.pm * BM + wr * 64 + fr, col0 = u.pn * BM + wc * 32 + 4 * fq;
        f32x4 wv[2][2];
#pragma unroll
        for (int bj = 0; bj < 2; ++bj)
#pragma unroll
            for (int n = 0; n < 2; ++n) wv[bj][n] = *(const f32x4*)(w + col0 + bj * HALF + n * 16);
#pragma unroll
        for (int ai = 0; ai < 2; ++ai)
#pragma unroll
            for (int m = 0; m < 4; ++m) { const int row = row0 + ai * HALF + m * 16; const size_t off = (size_t)row * ldc + col0; float ss = 0.f;
#pragma unroll
                for (int bj = 0; bj < 2; ++bj)
#pragma unroll
                    for (int n = 0; n < 2; ++n) { const f32x4 h = acc[ai][bj][m][n] + *(const f32x4*)(R + off + bj * HALF + n * 16); *(f32x4*)(C + off + bj * HALF + n * 16) = h;
                        ss += (h.x * h.x + h.y * h.y) + (h.z * h.z + h.w * h.w);
                        const u32x2 hb2 = {cvt_pk_bf16(h.x * wv[bj][n].x, h.y * wv[bj][n].y), cvt_pk_bf16(h.z * wv[bj][n].z, h.w * wv[bj][n].w)}; *(u32x2*)(Hb + off + bj * HALF + n * 16) = hb2; }
                ss += __shfl_xor(ss, 16); ss += __shfl_xor(ss, 32);
                if (fq == 0) atomicAdd(SSQ + row, ss); }
    }
};
struct EpiBf16RowScale {
    static constexpr bool PERM = true, AFTER_DRAIN = false, HAS_MID = false;
    bf16* O; int ldc; const float* SSQ;
    __device__ __forceinline__ void operator()(const f32x4 (&acc)[2][2][4][2], const Unit& u, int wr, int wc, int fr, int fq) const {
        const int row0 = u.pm * BM + wr * 64 + fr; const int col0 = u.pn * BM + wc * 32 + 8 * fq;
#pragma unroll
        for (int ai = 0; ai < 2; ++ai)
#pragma unroll
            for (int m = 0; m < 4; ++m) { const int row = row0 + ai * HALF + m * 16; bf16* rowp = O + (size_t)row * ldc + col0; const float rs = __builtin_amdgcn_rsqf(SSQ[row] * (1.f / DM) + EPS);
#pragma unroll
                for (int bj = 0; bj < 2; ++bj) { const f32x4 v0 = acc[ai][bj][m][0] * rs, v1 = acc[ai][bj][m][1] * rs;
                    u32x4 w; w.x = cvt_pk_bf16(v0[0], v0[1]); w.y = cvt_pk_bf16(v0[2], v0[3]); w.z = cvt_pk_bf16(v1[0], v1[1]); w.w = cvt_pk_bf16(v1[2], v1[3]);
                    *(u32x4*)(rowp + bj * HALF) = w; } }
    }
};

struct EpiResidBf16 {
    static constexpr bool PERM = false, AFTER_DRAIN = false, HAS_MID = false;
    bf16* C; int ldc; const float* R;
    __device__ __forceinline__ void operator()(const f32x4 (&acc)[2][2][4][2], const Unit& u, int wr, int wc, int fr, int fq) const {
        const int row0 = u.pm * BM + wr * 64 + fr, col0 = u.pn * BM + wc * 32 + 4 * fq;
#pragma unroll
        for (int ai = 0; ai < 2; ++ai)
#pragma unroll
            for (int m = 0; m < 4; ++m) { const size_t off = (size_t)(row0 + ai * HALF + m * 16) * ldc + col0;
#pragma unroll
                for (int bj = 0; bj < 2; ++bj)
#pragma unroll
                    for (int n = 0; n < 2; ++n) { const f32x4 h = acc[ai][bj][m][n] + *(const f32x4*)(R + off + bj * HALF + n * 16);
                        const u32x2 w = {cvt_pk_bf16(h.x, h.y), cvt_pk_bf16(h.z, h.w)}; *(u32x2*)(C + off + bj * HALF + n * 16) = w; } }
    }
};
__device__ __forceinline__ float u8f(unsigned w, int j) { return (float)((w >> (8 * j)) & 255u); }
struct EpiBranchFused {
    static constexpr bool PERM = true, AFTER_DRAIN = false, HAS_MID = true;
    static constexpr int MID0 = 8, MID1 = 10;
    bf16* O; int ldc; __amdgpu_buffer_rsrc_t grs; int ldg;
    __device__ __forceinline__ void mid(f32x4 (&acc)[2][2][4][2], const Unit& u, int t, int wr, int wc, int fr, int fq) const {
        const unsigned voff = (unsigned)((u.pm * BM + wr * 64 + fr) * ldg + u.pn * BM + wc * 32 + 8 * fq);
        const int ca = (t == MID0) ? 0 : 1024;
        const float fs = (t == MID0) ? YD_SCALE : 1.0f;
#pragma unroll
        for (int ai = 0; ai < 2; ++ai)
#pragma unroll
            for (int m = 0; m < 4; ++m) {
#pragma unroll
                for (int bj = 0; bj < 2; ++bj) { const int so = (ai * HALF + m * 16) * ldg + bj * HALF + ca;
                    const u32x2 ga = __builtin_amdgcn_raw_buffer_load_b64(grs, voff, so, 0), gb = __builtin_amdgcn_raw_buffer_load_b64(grs, voff, so + 1024, 0);
                    f32x4& v0 = acc[ai][bj][m][0]; f32x4& v1 = acc[ai][bj][m][1];
#pragma unroll
                    for (int j = 0; j < 4; ++j) { v0[j] *= (fs * u8f(ga.x, j)) * __builtin_amdgcn_rcpf(u8f(gb.x, j)); v1[j] *= (fs * u8f(ga.y, j)) * __builtin_amdgcn_rcpf(u8f(gb.y, j)); } }
                __builtin_amdgcn_sched_barrier(0); }
    }
    __device__ __forceinline__ void operator()(const f32x4 (&acc)[2][2][4][2], const Unit& u, int wr, int wc, int fr, int fq) const {
        const int row0 = u.pm * BM + wr * 64 + fr; const int col0 = u.pn * BM + wc * 32 + 8 * fq;
        const unsigned voff = (unsigned)(row0 * ldg + col0);
#pragma unroll
        for (int ai = 0; ai < 2; ++ai)
#pragma unroll
            for (int m = 0; m < 4; ++m) { const size_t r = (size_t)(row0 + ai * HALF + m * 16); bf16* rowp = O + r * ldc + col0;
#pragma unroll
                for (int bj = 0; bj < 2; ++bj) { constexpr float q = 1.0f / (WC_SCALE * YD_SCALE * 255.0f); const f32x4 v0 = acc[ai][bj][m][0] * q, v1 = acc[ai][bj][m][1] * q;
                    const u32x2 g = __builtin_amdgcn_raw_buffer_load_b64(grs, voff, (ai * HALF + m * 16) * ldg + bj * HALF + 2048, 0);
                    u32x4 w; w.x = cvt_pk_bf16(v0[0] * u8f(g.x, 0), v0[1] * u8f(g.x, 1)); w.y = cvt_pk_bf16(v0[2] * u8f(g.x, 2), v0[3] * u8f(g.x, 3));
                    w.z = cvt_pk_bf16(v1[0] * u8f(g.y, 0), v1[1] * u8f(g.y, 1)); w.w = cvt_pk_bf16(v1[2] * u8f(g.y, 2), v1[3] * u8f(g.y, 3));
                    *(u32x4*)(rowp + bj * HALF) = w; } }
    }
};

template <int QM = 0, class Epi, class Sched>
__device__ __forceinline__ void gemm_phase(LAS unsigned char* lds, const Gemm g, const Sched& S, const Epi& E, int wid) {
    constexpr bool F8 = (QM == 1);
    int lane = lane_id(); asm volatile("" : "+v"(lane));
    const int tid = wid * 64 + lane, wr = wid >> 2, wc = wid & 3, fr = lane & 15, fq = lane >> 4;
    const int K = g.K, nt = K / BK;
    unsigned voffA[2], voffB[2];
#pragma unroll
    for (int i = 0; i < 2; ++i) { int R, C; stage_rc(tid * 16 + i * 8192, R, C); const int Rb = Epi::PERM ? ((R & ~31) + perm32(R & 31)) : R;
        voffA[i] = (unsigned)(R * g.lda + C) * 2u; voffB[i] = (unsigned)(Rb * g.ldb + C) * 2u; }
    const size_t kstep = (size_t)(BK * 2);
    const size_t hsA = (size_t)HALF * g.lda * 2, hsB = (size_t)HALF * g.ldb * 2;
    const size_t tsA = 2 * hsA, tsB = 2 * hsB;
    const unsigned ldsw = (unsigned)wid * 1024u;
    const int aoff = lds_byte(wr * 64 + fr, fq * 8), boff = lds_byte(wc * 32 + fr, fq * 8);
#define PG8_SA(b, h) (((b) * 2 + (h)) * HTB)
#define PG8_SB(b, h) ((4 + (b) * 2 + (h)) * HTB)
#define PG8_STAGE(bufoff, gbase, voff) do { _Pragma("unroll") for (int _i = 0; _i < 2; ++_i) \
        __builtin_amdgcn_global_load_lds((const unsigned*)((const char*)(gbase) + (voff)[_i]), (LAS unsigned*)(lds + (bufoff) + ldsw + _i * 8192), 16, 0, 0); } while (0)
#define PG8_LDA(dst, b, h) do { _Pragma("unroll") for (int m = 0; m < 4; ++m) _Pragma("unroll") for (int k = 0; k < 2; ++k) dst[m][k] = *(const LAS bf16x8*)(lds + PG8_SA(b, h) + aoff + m * 2048 + k * 1024); } while (0)
#define PG8_LDB(dst, b, h) do { _Pragma("unroll") for (int n = 0; n < 2; ++n) _Pragma("unroll") for (int k = 0; k < 2; ++k) dst[n][k] = *(const LAS bf16x8*)(lds + PG8_SB(b, h) + boff + n * 2048 + k * 1024); } while (0)
#define PG8_CAT(x, y) __builtin_shufflevector(__builtin_bit_cast(i32x4, x), __builtin_bit_cast(i32x4, y), 0, 1, 2, 3, 4, 5, 6, 7)
#define PG8_MMA(ai, bj, At, Bt) do { __builtin_amdgcn_s_setprio(1); _Pragma("unroll") for (int m = 0; m < 4; ++m) _Pragma("unroll") for (int n = 0; n < 2; ++n) { \
        if constexpr (F8) { asm volatile("v_mfma_f32_16x16x128_f8f6f4 %0, %1, %2, %0" : "+v"(acc[ai][bj][m][n]) : "v"(PG8_CAT(Bt[n][0], Bt[n][1])), "v"(PG8_CAT(At[m][0], At[m][1]))); } \
        else if constexpr (QM == 2) { _Pragma("unroll") for (int k = 0; k < 2; ++k) acc[ai][bj][m][n] = __builtin_bit_cast(f32x4, __builtin_amdgcn_mfma_i32_16x16x64_i8(__builtin_bit_cast(i32x4, Bt[n][k]), __builtin_bit_cast(i32x4, At[m][k]), __builtin_bit_cast(i32x4, acc[ai][bj][m][n]), 0, 0, 0)); } \
        else { _Pragma("unroll") for (int k = 0; k < 2; ++k) acc[ai][bj][m][n] = __builtin_amdgcn_mfma_f32_16x16x32_bf16(Bt[n][k], At[m][k], acc[ai][bj][m][n], 0, 0, 0); } } \
        __builtin_amdgcn_s_setprio(0); } while (0)
#define PG8_WAIT_V(n) asm volatile("s_waitcnt vmcnt(" #n ")" ::: "memory")
#define PG8_WAIT_L(n) asm volatile("s_waitcnt lgkmcnt(" #n ")" ::: "memory")
#define PG8_BAR __builtin_amdgcn_s_barrier()
#define PG8_SCHED __builtin_amdgcn_sched_barrier(0)
#define PG8_MFMA_SETTLE asm volatile("s_nop 15\n\ts_nop 15\n\ts_nop 7" ::: "memory")
    Unit cur, nxt; int ui = 0;
    if (!S.next(0, cur)) return;
    f32x4 acc[2][2][4][2];
#pragma unroll
    for (int a = 0; a < 2; ++a)
#pragma unroll
        for (int b = 0; b < 2; ++b)
#pragma unroll
            for (int m = 0; m < 4; ++m)
#pragma unroll
                for (int n = 0; n < 2; ++n) acc[a][b][m][n] = (f32x4){0.f, 0.f, 0.f, 0.f};
    bf16x8 At[4][2], B0[2][2], B1[2][2];
    const char* cA = (const char*)g.A + (size_t)cur.pm * tsA; const char* cB = (const char*)g.Bt + (size_t)cur.pn * tsB;
    S.a_ready(cur);
    PG8_STAGE(PG8_SB(0, 0), cB, voffB); PG8_STAGE(PG8_SB(0, 1), cB + hsB, voffB); PG8_STAGE(PG8_SA(0, 0), cA, voffA); PG8_STAGE(PG8_SA(0, 1), cA + hsA, voffA);
    if (wr == 1) PG8_BAR;
    PG8_WAIT_V(2); PG8_BAR;
    PG8_STAGE(PG8_SB(1, 0), cB + kstep, voffB); PG8_STAGE(PG8_SA(1, 0), cA + kstep, voffA); PG8_STAGE(PG8_SB(1, 1), cB + hsB + kstep, voffB);
    PG8_WAIT_V(6); PG8_BAR;
    for (;;) {
        const bool has_next = S.next(ui + 1, nxt);
        const char* nA = has_next ? (const char*)g.A + (size_t)nxt.pm * tsA : cA; const char* nB = has_next ? (const char*)g.Bt + (size_t)nxt.pn * tsB : cB;
#pragma clang loop unroll(disable)
        for (int t = 0; t < nt; t += 2) {
            const bool last = (t == nt - 2);
            const char* a1 = cA + (size_t)(t + 1) * kstep;
            const char* a2 = last ? nA : cA + (size_t)(t + 2) * kstep; const char* b2 = last ? nB : cB + (size_t)(t + 2) * kstep;
            const char* a3 = a2 + kstep; const char* b3 = b2 + kstep;
            if (last && has_next) S.a_ready(nxt);
            if constexpr (Epi::HAS_MID) { if (t == Epi::MID0 || t == Epi::MID1) { if constexpr (F8) PG8_MFMA_SETTLE; E.mid(acc, cur, t, wr, wc, fr, fq); } }
            PG8_LDB(B0, 0, 0); PG8_LDB(B1, 0, 1); PG8_SCHED; PG8_LDA(At, 0, 0); PG8_STAGE(PG8_SA(1, 1), a1 + hsA, voffA);
            PG8_WAIT_V(8); PG8_WAIT_L(0); PG8_BAR; PG8_MMA(0, 0, At, B0); PG8_MMA(0, 1, At, B1); PG8_BAR; PG8_SCHED;
            PG8_LDA(At, 0, 1); PG8_STAGE(PG8_SB(0, 0), b2, voffB); PG8_STAGE(PG8_SB(0, 1), b2 + hsB, voffB); PG8_STAGE(PG8_SA(0, 0), a2, voffA);
            PG8_WAIT_V(8); PG8_WAIT_L(0); PG8_BAR; PG8_MMA(1, 0, At, B0); PG8_MMA(1, 1, At, B1); PG8_BAR; PG8_SCHED;
            PG8_LDB(B0, 1, 0); PG8_LDB(B1, 1, 1); PG8_SCHED; PG8_LDA(At, 1, 0); PG8_STAGE(PG8_SA(0, 1), a2 + hsA, voffA);
            PG8_WAIT_V(8); PG8_WAIT_L(0); PG8_BAR; PG8_MMA(0, 0, At, B0); PG8_MMA(0, 1, At, B1); PG8_BAR; PG8_SCHED;
            PG8_LDA(At, 1, 1); PG8_STAGE(PG8_SB(1, 0), b3, voffB); PG8_STAGE(PG8_SB(1, 1), b3 + hsB, voffB); PG8_STAGE(PG8_SA(1, 0), a3, voffA);
            PG8_WAIT_V(8); PG8_WAIT_L(0); PG8_BAR; PG8_MMA(1, 0, At, B0); PG8_MMA(1, 1, At, B1); PG8_BAR; PG8_SCHED;
        }
        if constexpr (F8) PG8_MFMA_SETTLE;
        if (wr == 0) PG8_BAR;
        E(acc, cur, wr, wc, fr, fq); S.done(cur);
        if (!has_next) break;
#pragma unroll
        for (int a = 0; a < 2; ++a)
#pragma unroll
            for (int b = 0; b < 2; ++b)
#pragma unroll
                for (int m = 0; m < 4; ++m)
#pragma unroll
                    for (int n = 0; n < 2; ++n) acc[a][b][m][n] = (f32x4){0.f, 0.f, 0.f, 0.f};
        cur = nxt; cA = nA; cB = nB; ++ui;
        if (wr == 1) PG8_BAR;
    }
    PG8_WAIT_V(0);
    PG8_BAR;
#undef PG8_SA
#undef PG8_SB
#undef PG8_STAGE
#undef PG8_LDA
#undef PG8_LDB
#undef PG8_MMA
#undef PG8_CAT
#undef PG8_WAIT_V
#undef PG8_WAIT_L
#undef PG8_BAR
#undef PG8_SCHED
#undef PG8_MFMA_SETTLE
}
}

struct Args {
    const float* in[26]; const int* positions; float* out; unsigned char* ws; int ph_lo, ph_hi; int pad0, pad1;
};
struct Frame {
    LAS unsigned char* lds;
    int tid, lane, wave, G, bid;
    const float* const* in; const int* positions; float* out; unsigned char* ws;
};
__device__ __forceinline__ void frame_refresh(Frame& F) { int l = lane_id(); asm volatile("" : "+v"(l)); F.lane = l; F.tid = F.wave * 64 + l; }
enum { I_X = 0, I_MEM = 1, I_POS = 2, I_NMIXW = 3, I_WIN = 4, I_CONVW = 5, I_CONVB = 6, I_DTB = 7, I_ALOG = 8, I_SSDD = 9, I_SSDNW = 10, I_DQNW = 11, I_DKNW = 12, I_MEMNW = 13,
       I_WMKV = 14, I_MQNW = 15, I_MKNW = 16, I_WSSD = 17, I_WDIL = 18, I_WMEMBR = 19, I_WOUT = 20, I_NFFNW = 21, I_WQ = 22, I_SUBK = 23, I_PD = 24, I_PU = 25 };

constexpr float PD_SCALE = 64.0f, PU_SCALE = 8.0f;
__device__ __forceinline__ unsigned pk4f8(float a, float b, float c, float d) {
    a = fminf(fmaxf(a, -448.f), 448.f); b = fminf(fmaxf(b, -448.f), 448.f); c = fminf(fmaxf(c, -448.f), 448.f); d = fminf(fmaxf(d, -448.f), 448.f);
    unsigned p = __builtin_amdgcn_cvt_pk_fp8_f32(a, b, 0, false); return __builtin_amdgcn_cvt_pk_fp8_f32(c, d, p, true);
}
__device__ __forceinline__ unsigned pk4_fp8(f32x4 v, float sc) {
    const float a = fminf(fmaxf(v.x * sc, -448.f), 448.f), b = fminf(fmaxf(v.y * sc, -448.f), 448.f), c = fminf(fmaxf(v.z * sc, -448.f), 448.f), d = fminf(fmaxf(v.w * sc, -448.f), 448.f);
    unsigned p = __builtin_amdgcn_cvt_pk_fp8_f32(a, b, 0, false); return __builtin_amdgcn_cvt_pk_fp8_f32(c, d, p, true);
}
__device__ __forceinline__ void p0_transpose_item(const float* W, int ldw, int src_col0, bf16* WT, int ldt, int dst_row0, int dst_col0, int nblk, LAS float* scr, int item, int lane) {
    const int kb = item / nblk, nb = item % nblk, k0 = 64 * kb, n0 = 32 * nb;
#pragma unroll 8
    for (int i = 0; i < 32; ++i) { const int kk = 2 * i + (lane >> 5); scr[kk * 33 + (lane & 31)] = W[(size_t)(k0 + kk) * ldw + src_col0 + n0 + (lane & 31)]; }
    LDS_WAIT(); asm volatile("" ::: "memory");
    const int c = lane & 7;
#pragma unroll
    for (int j = 0; j < 4; ++j) { const int n = (lane >> 3) + 8 * j; const LAS float* s = scr + (8 * c) * 33 + n;
        u32x4 o; o.x = pk2(s[0 * 33], s[1 * 33]); o.y = pk2(s[2 * 33], s[3 * 33]); o.z = pk2(s[4 * 33], s[5 * 33]); o.w = pk2(s[6 * 33], s[7 * 33]);
        *(u32x4*)(WT + (size_t)(dst_row0 + n0 + n) * ldt + dst_col0 + k0 + 8 * c) = o; }
    LDS_WAIT(); asm volatile("" ::: "memory");
}
__device__ __forceinline__ void p0_transpose_item_fp8(const float* W, int ldw, int src_col0, unsigned char* WT8, int ldt, int dst_row0, int nblk, float sc, LAS float* scr, int item, int lane) {
    const int kb = item / nblk, nb = item % nblk, n0 = 32 * nb;
#pragma unroll 1
    for (int h = 0; h < 2; ++h) { const int k0 = 128 * kb + 64 * h;
#pragma unroll 8
        for (int i = 0; i < 32; ++i) { const int kk = 2 * i + (lane >> 5); scr[kk * 33 + (lane & 31)] = W[(size_t)(k0 + kk) * ldw + src_col0 + n0 + (lane & 31)]; }
        LDS_WAIT(); asm volatile("" ::: "memory");
        const int c = lane & 7;
#pragma unroll
        for (int j = 0; j < 4; ++j) { const int n = (lane >> 3) + 8 * j; const LAS float* s = scr + (8 * c) * 33 + n;
            const f32x4 a = {s[0 * 33], s[1 * 33], s[2 * 33], s[3 * 33]}, b = {s[4 * 33], s[5 * 33], s[6 * 33], s[7 * 33]};
            const u32x2 o = {pk4_fp8(a, sc), pk4_fp8(b, sc)};
            *(u32x2*)(WT8 + (size_t)(dst_row0 + n0 + n) * ldt + k0 + 8 * c) = o; }
        LDS_WAIT(); asm volatile("" ::: "memory"); }
}
__device__ __forceinline__ void p0_wamax_item(const float* W, int ldw, int src_col0, unsigned* AM, int dst_row0, int nblk, int item, int lane) {
    const int kb = item / nblk, nb = item % nblk, k0 = 64 * kb, n0 = 32 * nb;
    float am = 0.f;
#pragma unroll 8
    for (int i = 0; i < 32; ++i) { const int kk = 2 * i + (lane >> 5); am = fmaxf(am, fabsf(W[(size_t)(k0 + kk) * ldw + src_col0 + n0 + (lane & 31)])); }
    am = fmaxf(am, __shfl_xor(am, 32));
    if (lane < 32) atomicMax(AM + dst_row0 + n0 + lane, __float_as_uint(am));
}
__device__ __forceinline__ unsigned pk4_i8(float a, float b, float c, float d) {
    const int ia = (int)__builtin_rintf(a), ib = (int)__builtin_rintf(b), ic = (int)__builtin_rintf(c), id = (int)__builtin_rintf(d);
    return (unsigned)(ia & 255) | ((unsigned)(ib & 255) << 8) | ((unsigned)(ic & 255) << 16) | ((unsigned)id << 24);
}
__device__ __forceinline__ void p1_wquant_item(const float* W, int ldw, int src_col0, unsigned char* WT8, const unsigned* AM, float* SC, int dst_row0, int am_row0, int nblk, LAS float* scr, int item, int lane) {
    const int kb = item / nblk, nb = item % nblk, n0 = 32 * nb;
    const float am = __uint_as_float(AM[am_row0 + n0 + (lane & 31)]);
    const float inv = am > 0.f ? 127.0f / am : 0.f;
    if (kb == 0 && lane < 32) SC[am_row0 + n0 + lane] = am * (1.0f / 127.0f);
#pragma unroll 1
    for (int h = 0; h < 2; ++h) { const int k0 = 128 * kb + 64 * h;
#pragma unroll 8
        for (int i = 0; i < 32; ++i) { const int kk = 2 * i + (lane >> 5); scr[kk * 33 + (lane & 31)] = W[(size_t)(k0 + kk) * ldw + src_col0 + n0 + (lane & 31)] * inv; }
        LDS_WAIT(); asm volatile("" ::: "memory");
        const int c = lane & 7;
#pragma unroll
        for (int j = 0; j < 4; ++j) { const int n = (lane >> 3) + 8 * j; const LAS float* q = scr + (8 * c) * 33 + n;
            const u32x2 o = {pk4_i8(q[0 * 33], q[1 * 33], q[2 * 33], q[3 * 33]), pk4_i8(q[4 * 33], q[5 * 33], q[6 * 33], q[7 * 33])};
            *(u32x2*)(WT8 + (size_t)(dst_row0 + n0 + n) * 1024 + k0 + 8 * c) = o; }
        LDS_WAIT(); asm volatile("" ::: "memory"); }
}
__device__ __forceinline__ void rms_row_to_bf16(const float* xrow, const float* w, bf16* orow, int lane, f32x4 (&v)[4]) {
    const f32x4* xr = (const f32x4*)xrow + lane; const f32x4* wr = (const f32x4*)w + lane;
    float s = 0.f;
#pragma unroll
    for (int j = 0; j < 4; ++j) { v[j] = xr[64 * j]; s += (v[j].x * v[j].x + v[j].y * v[j].y) + (v[j].z * v[j].z + v[j].w * v[j].w); }
    const float rstd = __builtin_amdgcn_rsqf(wave_sum(s) * (1.f / DM) + EPS);
    unsigned long long* o8 = (unsigned long long*)orow + lane;
#pragma unroll
    for (int j = 0; j < 4; ++j) { const f32x4 ww = wr[64 * j]; v[j] = v[j] * rstd * ww;
        o8[64 * j] = (unsigned long long)pk2(v[j].x, v[j].y) | ((unsigned long long)pk2(v[j].z, v[j].w) << 32); }
}
__device__ __forceinline__ void rms_rows_finish(f32x4 (&v)[4], const float* w, unsigned char* orow8, float* osc, int lane) {
    const f32x4* wr = (const f32x4*)w + lane;
    float s = 0.f;
#pragma unroll
    for (int j = 0; j < 4; ++j) s += (v[j].x * v[j].x + v[j].y * v[j].y) + (v[j].z * v[j].z + v[j].w * v[j].w);
    const float rstd = __builtin_amdgcn_rsqf(wave_sum(s) * (1.f / DM) + EPS);
    float am = 0.f;
#pragma unroll
    for (int j = 0; j < 4; ++j) { const f32x4 ww = wr[64 * j]; v[j] = v[j] * rstd * ww; am = fmaxf(fmaxf(am, fmaxf(fabsf(v[j].x), fabsf(v[j].y))), fmaxf(fabsf(v[j].z), fabsf(v[j].w))); }
    am = wave_max(am);
    const float inv = am > 0.f ? 127.0f / am : 0.f;
    unsigned* o4 = (unsigned*)orow8 + lane;
#pragma unroll
    for (int j = 0; j < 4; ++j) o4[64 * j] = pk4_i8(v[j].x * inv, v[j].y * inv, v[j].z * inv, v[j].w * inv);
    if (lane == 0) *osc = am * (1.0f / 127.0f);
}
__device__ __forceinline__ void cvt_f32_bf16_stream(const float* src, bf16* dst, size_t n, size_t gtid, size_t gthreads) {
    for (size_t i = gtid * 8; i < n; i += gthreads * 8) { const f32x4 a = *(const f32x4*)(src + i), b = *(const f32x4*)(src + i + 4);
        u32x4 o; o.x = pk2(a.x, a.y); o.y = pk2(a.z, a.w); o.z = pk2(b.x, b.y); o.w = pk2(b.z, b.w); *(u32x4*)(dst + i) = o; }
}
__device__ __forceinline__ void cvt_f32_fp8_sliced(const float* src, unsigned char* dst, float sc, size_t gtid, size_t gthreads) {
    for (size_t i = gtid * 16; i < (size_t)16384 * 1024; i += gthreads * 16) { const f32x4 a = *(const f32x4*)(src + i), b = *(const f32x4*)(src + i + 4), c = *(const f32x4*)(src + i + 8), d = *(const f32x4*)(src + i + 12);
        const size_t e = i >> 10, dd = i & 1023;
        const u32x4 o = {pk4_fp8(a, sc), pk4_fp8(b, sc), pk4_fp8(c, sc), pk4_fp8(d, sc)}; *(u32x4*)(dst + ((((dd >> 7) * 16384 + e) << 7) + (dd & 127))) = o; }
}
__device__ __forceinline__ void p0_prologue(Frame& F) {
    LAS float* scr = (LAS float*)(F.lds + F.wave * 8448);
    LAS float* wdt = (LAS float*)(F.lds + 8 * 8448);
    const int gw = F.bid * NWAVES + F.wave, NGW = F.G * NWAVES;
    unsigned char* ws = F.ws;
    for (int i = F.tid; i < 1024 * 16; i += NTHR) { const int k = i >> 4, c = i & 15, l = (k & 255) >> 2, e = k & 3, j = k >> 8, q = c >> 2;
        wdt[((((j * 4 + e) * 4 + q) * 64 + l) << 2) + (c & 3)] = F.in[I_WIN][(size_t)k * W_IN_N + OFF_DT + c]; }
    __syncthreads();
    constexpr int IT_A = 16 * 96, IT_B = 16 * 192, IT_MKV = 16 * 48, IT_SSD = 8 * 32, IT_DIL = 2 * 32, IT_MBR = 6 * 32, IT_OUT = 16 * 32, IT_WQ = 16 * 64;
    constexpr int NITEMS = IT_A + IT_B + IT_MKV + IT_SSD + IT_DIL + IT_MBR + IT_OUT + IT_WQ;
    for (int it = gw; it < NITEMS; it += NGW) {
        int r = it;
        if (r < IT_A) { p0_wamax_item(F.in[I_WIN], W_IN_N, 0, (unsigned*)(ws + WS_WAMAX), 0, 96, r, F.lane); continue; } r -= IT_A;
        if (r < IT_B) { p0_wamax_item(F.in[I_WIN], W_IN_N, OFF_AFTER_DT, (unsigned*)(ws + WS_WAMAX), 3072, 192, r, F.lane); continue; } r -= IT_B;
        if (r < IT_MKV) { p0_transpose_item(F.in[I_WMKV], 1536, 0, (bf16*)(ws + WS_WMKVT), DM, 0, 0, 48, scr, r, F.lane); continue; } r -= IT_MKV;
        if (r < IT_SSD) { p0_transpose_item_fp8(F.in[I_WSSD], DM, 0, ws + WS_WCATT, YC, 0, 32, WC_SCALE, scr, r, F.lane); continue; } r -= IT_SSD;
        if (r < IT_DIL) { p0_transpose_item_fp8(F.in[I_WDIL], DM, 0, ws + WS_WCATT + 1024, YC, 0, 32, WC_SCALE, scr, r, F.lane); continue; } r -= IT_DIL;
        if (r < IT_MBR) { p0_transpose_item_fp8(F.in[I_WMEMBR], DM, 0, ws + WS_WCATT + 1280, YC, 0, 32, WC_SCALE, scr, r, F.lane); continue; } r -= IT_MBR;
        if (r < IT_OUT) { p0_transpose_item(F.in[I_WOUT], DM, 0, (bf16*)(ws + WS_WOUTT), DM, 0, 0, 32, scr, r, F.lane); continue; } r -= IT_OUT;
        p0_wamax_item(F.in[I_WQ], PEER_Q, 0, (unsigned*)(ws + WS_WAMAX), 9216, 64, r, F.lane);
    }
    const size_t gtid = (size_t)F.bid * NTHR + F.tid, gth = (size_t)F.G * NTHR;
    cvt_f32_bf16_stream(F.in[I_SUBK], (bf16*)(ws + WS_SUBK), (size_t)8 * 2 * 128 * 128, gtid, gth);
    cvt_f32_fp8_sliced(F.in[I_PD], ws + WS_PD, PD_SCALE, gtid, gth);
    cvt_f32_fp8_sliced(F.in[I_PU], ws + WS_PU, PU_SCALE, gtid, gth);
    for (int m = gw; m < NB * NMEM; m += NGW) { f32x4 v[4]; rms_row_to_bf16(F.in[I_MEM] + (size_t)m * DM, F.in[I_MEMNW], (bf16*)(ws + WS_MEMN) + (size_t)m * DM, F.lane, v); }
    { float* RT = (float*)(ws + WS_ROPE);
      for (size_t i = gtid; i < (size_t)T * 8; i += gth) { const int tok = (int)(i >> 3), a = (int)(i & 7);
          const float inv = __expf(-logf(500000.0f) * (2.0f / 16.0f) * (float)a);
          const double rev = (double)((float)F.positions[tok] * inv) * 0.15915494309189535; const float fr = (float)(rev - floor(rev));
          RT[(size_t)tok * 16 + a] = __builtin_amdgcn_cosf(fr); RT[(size_t)tok * 16 + 8 + a] = __builtin_amdgcn_sinf(fr); } }
    float* DTp = (float*)(ws + WS_DT);
    const int lane = F.lane;
    const int myj = ((lane >> 5) & 1) * 8 + ((lane >> 4) & 1) * 4 + ((lane >> 3) & 1) * 2 + ((lane >> 2) & 1);
    const float dtb = F.in[I_DTB][myj];
    f32x4 na[4], nb[4];
    { const int m0 = 2 * gw < T ? 2 * gw : 0; const f32x4* xa = (const f32x4*)(F.in[I_X] + (size_t)m0 * DM) + lane; const f32x4* xb = (const f32x4*)(F.in[I_X] + (size_t)(m0 + 1) * DM) + lane;
#pragma unroll
      for (int j = 0; j < 4; ++j) { na[j] = xa[64 * j]; nb[j] = xb[64 * j]; } }
    for (int m = 2 * gw; m < T; m += 2 * NGW) {
        f32x4 va[4], vb[4];
#pragma unroll
        for (int j = 0; j < 4; ++j) { va[j] = na[j]; vb[j] = nb[j]; }
        { const int mn = (m + 2 * NGW < T) ? m + 2 * NGW : m; const f32x4* xa = (const f32x4*)(F.in[I_X] + (size_t)mn * DM) + lane; const f32x4* xb = (const f32x4*)(F.in[I_X] + (size_t)(mn + 1) * DM) + lane;
#pragma unroll
          for (int j = 0; j < 4; ++j) { na[j] = xa[64 * j]; nb[j] = xb[64 * j]; } }
        rms_rows_finish(va, F.in[I_NMIXW], ws + WS_U8 + (size_t)m * DM, (float*)(ws + WS_USC) + m, lane);
        rms_rows_finish(vb, F.in[I_NMIXW], ws + WS_U8 + (size_t)(m + 1) * DM, (float*)(ws + WS_USC) + m + 1, lane);
        float da[16], db[16];
#pragma unroll
        for (int j = 0; j < 16; ++j) { da[j] = 0.f; db[j] = 0.f; }
#pragma unroll
        for (int j = 0; j < 4; ++j)
#pragma unroll
            for (int e = 0; e < 4; ++e) { const float ua = va[j][e], ub = vb[j][e];
#pragma unroll
                for (int q = 0; q < 4; ++q) { const f32x4 w4 = *(const LAS f32x4*)(wdt + ((((j * 4 + e) * 4 + q) * 64 + lane) << 2));
                    da[4 * q + 0] += ua * w4.x; da[4 * q + 1] += ua * w4.y; da[4 * q + 2] += ua * w4.z; da[4 * q + 3] += ua * w4.w;
                    db[4 * q + 0] += ub * w4.x; db[4 * q + 1] += ub * w4.y; db[4 * q + 2] += ub * w4.z; db[4 * q + 3] += ub * w4.w; }
                __builtin_amdgcn_sched_barrier(0); }
        float ra, rb;
        { float r8a[8], r8b[8], r4a[4], r4b[4], r2a[2], r2b[2];
          { const bool up = (lane & 32) != 0;
#pragma unroll
            for (int k = 0; k < 8; ++k) { r8a[k] = (up ? da[k + 8] : da[k]) + __shfl_xor(up ? da[k] : da[k + 8], 32); r8b[k] = (up ? db[k + 8] : db[k]) + __shfl_xor(up ? db[k] : db[k + 8], 32); } }
          { const bool up = (lane & 16) != 0;
#pragma unroll
            for (int k = 0; k < 4; ++k) { r4a[k] = (up ? r8a[k + 4] : r8a[k]) + __shfl_xor(up ? r8a[k] : r8a[k + 4], 16); r4b[k] = (up ? r8b[k + 4] : r8b[k]) + __shfl_xor(up ? r8b[k] : r8b[k + 4], 16); } }
          { const bool up = (lane & 8) != 0;
#pragma unroll
            for (int k = 0; k < 2; ++k) { r2a[k] = (up ? r4a[k + 2] : r4a[k]) + __shfl_xor(up ? r4a[k] : r4a[k + 2], 8); r2b[k] = (up ? r4b[k + 2] : r4b[k]) + __shfl_xor(up ? r4b[k] : r4b[k + 2], 8); } }
          { const bool up = (lane & 4) != 0; ra = (up ? r2a[1] : r2a[0]) + __shfl_xor(up ? r2a[0] : r2a[1], 4); rb = (up ? r2b[1] : r2b[0]) + __shfl_xor(up ? r2b[0] : r2b[1], 4); }
          ra += __shfl_xor(ra, 2); ra += __shfl_xor(ra, 1); rb += __shfl_xor(rb, 2); rb += __shfl_xor(rb, 1); }
        if ((lane & 3) == 0) { const float xa = ra + dtb, xb = rb + dtb;
            DTp[(size_t)m * 16 + myj] = (xa > 20.f) ? xa : log1pf(__expf(xa)); DTp[(size_t)(m + 1) * 16 + myj] = (xb > 20.f) ? xb : log1pf(__expf(xb)); }
    }
}

__device__ __forceinline__ void p1_wquant(Frame& F) {
    LAS float* scr = (LAS float*)(F.lds + F.wave * 8448);
    const int gw = F.bid * NWAVES + F.wave, NGW = F.G * NWAVES;
    unsigned char* ws = F.ws;
    constexpr int QA = 8 * 96, QB = 8 * 192, QQ = 8 * 64;
    for (int it = gw; it < QA + QB + QQ; it += NGW) {
        if (it < QA) p1_wquant_item(F.in[I_WIN], W_IN_N, 0, ws + WS_W8, (const unsigned*)(ws + WS_WAMAX), (float*)(ws + WS_WSC), 0, 0, 96, scr, it, F.lane);
        else if (it < QA + QB) p1_wquant_item(F.in[I_WIN], W_IN_N, OFF_AFTER_DT, ws + WS_W8, (const unsigned*)(ws + WS_WAMAX), (float*)(ws + WS_WSC), 3072, 3072, 192, scr, it - QA, F.lane);
        else p1_wquant_item(F.in[I_WQ], PEER_Q, 0, ws + WS_WQT, (const unsigned*)(ws + WS_WAMAX), (float*)(ws + WS_WSC), 0, 9216, 64, scr, it - QA - QB, F.lane);
    }
}

__device__ __forceinline__ void norm192_inplace(bf16* p, const float (&w)[4], int lane) {
    u32x2 v = {0u, 0u};
    if (lane < 48) v = *(const u32x2*)(p + 4 * lane);
    float x0 = bflo(v.x), x1 = bfhi(v.x), x2 = bflo(v.y), x3 = bfhi(v.y);
    const float ss = wave_sum((x0 * x0 + x1 * x1) + (x2 * x2 + x3 * x3));
    const float rs = __builtin_amdgcn_rsqf(ss * (1.f / 192.f) + EPS);
    if (lane < 48) { const u32x2 o = {pkbf(x0 * rs * w[0], x1 * rs * w[1]), pkbf(x2 * rs * w[2], x3 * rs * w[3])}; *(u32x2*)(p + 4 * lane) = o; }
}
__device__ __forceinline__ void mknorm_phase(Frame& F) {
    const int gw = F.bid * NWAVES + F.wave, NGW = F.G * NWAVES, lane = F.lane;
    float wmk[4];
#pragma unroll
    for (int j = 0; j < 4; ++j) wmk[j] = F.in[I_MKNW][(4 * lane + j) % 192];
    bf16* MK = (bf16*)(F.ws + WS_MKV);
    for (int r = gw; r < NB * NMEM * 4; r += NGW) norm192_inplace(MK + (size_t)(r >> 2) * 1536 + (r & 3) * 192, wmk, lane);
}

constexpr int SC_ST = 272, SX_ST = 528;
__device__ __forceinline__ float bfsel(const u32x4& v, int j) { const unsigned w = v[j >> 1]; return (j & 1) ? bfhi(w) : bflo(w); }
__device__ __forceinline__ void conv_task(const bf16* P, size_t rowb, int t0, int pcol, const float* cw, const float* cb, int ccol, LAS unsigned char* dst, int stride, const LAS float* scale) {
    float w[4][8], bs[8];
#pragma unroll
    for (int k = 0; k < 4; ++k) { const f32x4 a = *(const f32x4*)(cw + k * 2048 + ccol), b = *(const f32x4*)(cw + k * 2048 + ccol + 4);
        w[k][0] = a.x; w[k][1] = a.y; w[k][2] = a.z; w[k][3] = a.w; w[k][4] = b.x; w[k][5] = b.y; w[k][6] = b.z; w[k][7] = b.w; }
    { const f32x4 a = *(const f32x4*)(cb + ccol), b = *(const f32x4*)(cb + ccol + 4); bs[0] = a.x; bs[1] = a.y; bs[2] = a.z; bs[3] = a.w; bs[4] = b.x; bs[5] = b.y; bs[6] = b.z; bs[7] = b.w; }
    const bf16* src = P + (rowb + t0) * NPROJ + pcol;
    u32x4 rw[19];
#pragma unroll
    for (int i = 0; i < 3; ++i) rw[i] = (u32x4){0u, 0u, 0u, 0u};
    if (t0 > 0) {
#pragma unroll
        for (int i = 0; i < 3; ++i) rw[i] = *(const u32x4*)(src + (ptrdiff_t)(i - 3) * NPROJ); }
#pragma unroll
    for (int i = 0; i < 16; ++i) rw[3 + i] = *(const u32x4*)(src + (size_t)i * NPROJ);
#pragma unroll
    for (int i = 0; i < 16; ++i) {
        float o[8];
#pragma unroll
        for (int j = 0; j < 8; ++j) { float a = bs[j] + w[0][j] * bfsel(rw[i], j) + w[1][j] * bfsel(rw[i + 1], j) + w[2][j] * bfsel(rw[i + 2], j) + w[3][j] * bfsel(rw[i + 3], j); o[j] = a * sigmoidf_(a); }
        if (scale) { const float sv = scale[i];
#pragma unroll
            for (int j = 0; j < 8; ++j) o[j] *= sv; }
        const u32x4 r = {pkbf(o[0], o[1]), pkbf(o[2], o[3]), pkbf(o[4], o[5]), pkbf(o[6], o[7])};
        *(LAS u32x4*)(dst + i * stride) = r;
    }
}
__device__ __forceinline__ float ssd_scan(Frame& F, const float* DTp, size_t tok0, int g, LAS float* sAc, LAS float* sDt) {
    float total = 0.f;
    if (F.wave < 4) {
        const int head = 4 * g + F.wave, lane = F.lane;
        const float A = -__expf(F.in[I_ALOG][head]);
        const float d0 = DTp[(tok0 + 2 * lane) * 16 + head], d1 = DTp[(tok0 + 2 * lane + 1) * 16 + head];
        const float a0 = d0 * A, a1 = d1 * A;
        float sc = a0 + a1;
#pragma unroll
        for (int o = 1; o < 64; o <<= 1) { const float v = __shfl_up(sc, o); if (lane >= o) sc += v; }
        sAc[F.wave * 128 + 2 * lane] = sc - a1; sAc[F.wave * 128 + 2 * lane + 1] = sc;
        sDt[F.wave * 128 + 2 * lane] = d0; sDt[F.wave * 128 + 2 * lane + 1] = d1;
        total = __shfl(sc, 63);
    }
    return total;
}
__device__ __forceinline__ bf16x8 tr_pair(unsigned a_lo, unsigned a_hi) {
    s16x4 lo, hi;
    asm volatile("ds_read_b64_tr_b16 %0, %2\n\tds_read_b64_tr_b16 %1, %3\n\ts_waitcnt lgkmcnt(0)" : "=&v"(lo), "=&v"(hi) : "v"(a_lo), "v"(a_hi) : "memory");
    const bf16x8 r = {lo[0], lo[1], lo[2], lo[3], hi[0], hi[1], hi[2], hi[3]}; return r;
}

__device__ __forceinline__ void ssdC_phase(Frame& F, int half) {
    const bf16* P = (const bf16*)(F.ws + WS_BIG);
    const float* DTp = (const float*)(F.ws + WS_DT);
    bf16* SST = (bf16*)(F.ws + WS_SST); float* DEC = (float*)(F.ws + WS_DEC);
    LAS unsigned char* sX = F.lds; LAS unsigned char* sB = F.lds + 128 * SX_ST;
    LAS float* sAc = (LAS float*)(F.lds + 128 * SX_ST + 128 * SC_ST); LAS float* sDt = sAc + 512; LAS float* sW = sDt + 512;
    const int wave = F.wave;
    for (int unit = F.bid; unit < HB * 64 * 4; unit += F.G) {
        int tid = F.tid; asm volatile("" : "+v"(tid));
        const int lane = tid & 63, ql = lane & 31, h = lane >> 5, tq = (lane & 15) >> 2, tp = lane & 3, tblk = (lane >> 4) & 1;
        const int bl = unit >> 8, c = (unit >> 2) & 63, g = unit & 3;
        const size_t rowb = (size_t)bl * SEQ, tok0 = (size_t)half * HT + rowb + c * 128;
        __syncthreads();
        const float total = ssd_scan(F, DTp, tok0, g, sAc, sDt);
        if (wave < 4) { sW[wave * 128 + 2 * lane] = __expf(total - sAc[wave * 128 + 2 * lane]) * sDt[wave * 128 + 2 * lane];
            sW[wave * 128 + 2 * lane + 1] = __expf(total - sAc[wave * 128 + 2 * lane + 1]) * sDt[wave * 128 + 2 * lane + 1];
            if (lane == 0) DEC[((size_t)bl * 64 + c) * 16 + 4 * g + wave] = __expf(total); }
        __syncthreads();
        if (tid < 384) {
            int ch, strip, ccol, stride; LAS unsigned char* dst; const LAS float* scl = nullptr;
            if (tid < 256) { ch = tid & 31; strip = tid >> 5; ccol = g * 256 + 8 * ch; stride = SX_ST; dst = sX + (strip * 16) * SX_ST + ch * 16; scl = sW + (ch >> 3) * 128 + strip * 16; }
            else { const int u = tid - 256; ch = u & 15; strip = u >> 4; ccol = 1024 + g * 128 + 8 * ch; stride = SC_ST; dst = sB + (strip * 16) * SC_ST + ch * 16; }
            conv_task(P, rowb, c * 128 + strip * 16, PC_X + ccol, F.in[I_CONVW], F.in[I_CONVB], ccol, dst, stride, scl);
        }
        __syncthreads();
        const int r = wave >> 1, pt = wave & 1;
        f32x16 acc[4];
#pragma unroll
        for (int nt = 0; nt < 4; ++nt)
#pragma unroll
            for (int e = 0; e < 16; ++e) acc[nt][e] = 0.f;
        const unsigned xa = (unsigned)(size_t)sX + (unsigned)((8 * h + tq) * SX_ST + (r * 64 + 32 * pt + 16 * tblk + 4 * tp) * 2);
        const unsigned ba = (unsigned)(size_t)sB + (unsigned)((8 * h + tq) * SC_ST + (16 * tblk + 4 * tp) * 2);
#pragma unroll
        for (int ks = 0; ks < 8; ++ks) {
            const bf16x8 af = tr_pair(xa + ks * 16 * SX_ST, xa + ks * 16 * SX_ST + 4 * SX_ST);
            bf16x8 bfr[4];
#pragma unroll
            for (int nt = 0; nt < 4; ++nt) bfr[nt] = tr_pair(ba + ks * 16 * SC_ST + nt * 64, ba + ks * 16 * SC_ST + 4 * SC_ST + nt * 64);
            __builtin_amdgcn_sched_barrier(0);
#pragma unroll
            for (int nt = 0; nt < 4; ++nt) acc[nt] = MFMA32(af, bfr[nt], acc[nt]);
        }
        bf16* out = SST + (((size_t)bl * 64 + c) * 16 + 4 * g + r) * 8192;
#pragma unroll
        for (int nt = 0; nt < 4; ++nt)
#pragma unroll
            for (int e = 0; e < 16; ++e) out[(32 * pt + (e & 3) + 8 * (e >> 2) + 4 * h) * 128 + 32 * nt + ql] = (bf16)(pkbf(acc[nt][e], 0.f) & 0xffffu);
    }
}

__device__ __forceinline__ void ssdD_phase(Frame& F) {
    const bf16* SST = (const bf16*)(F.ws + WS_SST); const float* DEC = (const float*)(F.ws + WS_DEC);
    bf16* SIN = (bf16*)(F.ws + WS_SIN);
    const size_t gtid = (size_t)F.bid * NTHR + F.tid, gth = (size_t)F.G * NTHR;
    for (size_t it = gtid; it < (size_t)HB * 16 * 2048; it += gth) {
        const int bl = (int)(it >> 15), head = (int)(it >> 11) & 15, e4 = (int)(it & 2047) * 4;
        f32x4 st = {0.f, 0.f, 0.f, 0.f};
#pragma unroll 8
        for (int c = 0; c < 64; ++c) {
            const size_t idx = (((size_t)bl * 64 + c) * 16 + head);
            const u32x2 o = {pkbf(st.x, st.y), pkbf(st.z, st.w)};
            *(u32x2*)(SIN + idx * 8192 + e4) = o;
            const u32x2 sw = *(const u32x2*)(SST + idx * 8192 + e4); const f32x4 sl = {bflo(sw.x), bfhi(sw.x), bflo(sw.y), bfhi(sw.y)}; const float d = DEC[idx];
            st = st * d + sl;
        }
    }
}

__device__ __forceinline__ void ssdE_phase(Frame& F, int half) {
    const bf16* P = (const bf16*)(F.ws + WS_BIG);
    const float* DTp = (const float*)(F.ws + WS_DT);
    const bf16* SIN = (const bf16*)(F.ws + WS_SIN);
    bf16* Y = (bf16*)F.out;
    LAS unsigned char* sX = F.lds; LAS unsigned char* sB = F.lds + 128 * SX_ST; LAS unsigned char* sC = sB + 128 * SC_ST;
    LAS float* sAc = (LAS float*)(sC + 128 * SC_ST); LAS float* sDt = sAc + 512; LAS float* sSS = sDt + 512;
    const int wave = F.wave;
    const int st = wave & 3, hp = wave >> 2;
    for (int unit = F.bid; unit < HB * 64 * 4; unit += F.G) {
        int tid = F.tid; asm volatile("" : "+v"(tid));
        const int lane = tid & 63, ql = lane & 31, h = lane >> 5, tq = (lane & 15) >> 2, tp = lane & 3, tblk = (lane >> 4) & 1;
        const int bl = unit >> 8, c = (unit >> 2) & 63, g = unit & 3;
        const size_t rowb = (size_t)bl * SEQ, tok0 = (size_t)half * HT + rowb + c * 128;
        __syncthreads();
        (void)ssd_scan(F, DTp, tok0, g, sAc, sDt);
        if (tid < 128) sSS[tid] = 0.f;
        {
            int ch, strip, ccol, stride; LAS unsigned char* dst;
            if (tid < 256) { ch = tid & 31; strip = tid >> 5; ccol = g * 256 + 8 * ch; stride = SX_ST; dst = sX + (strip * 16) * SX_ST + ch * 16; }
            else if (tid < 384) { const int u = tid - 256; ch = u & 15; strip = u >> 4; ccol = 1024 + g * 128 + 8 * ch; stride = SC_ST; dst = sB + (strip * 16) * SC_ST + ch * 16; }
            else { const int u = tid - 384; ch = u & 15; strip = u >> 4; ccol = 1536 + g * 128 + 8 * ch; stride = SC_ST; dst = sC + (strip * 16) * SC_ST + ch * 16; }
            conv_task(P, rowb, c * 128 + strip * 16, PC_X + ccol, F.in[I_CONVW], F.in[I_CONVB], ccol, dst, stride, nullptr);
        }
        __syncthreads();
        const int s = 32 * st + ql;
        unsigned yk[2][2][8];
        float ssq = 0.f;
        const unsigned xa = (unsigned)(size_t)sX + (unsigned)((4 * h + tq) * SX_ST + (16 * tblk + 4 * tp) * 2);
#pragma unroll
        for (int hq = 0; hq < 2; ++hq) {
            const int r = 2 * hp + hq, head = 4 * g + r;
            const float acs = sAc[r * 128 + s];
            const bf16* stp = SIN + (((size_t)bl * 64 + c) * 16 + head) * 8192 + ql * 128 + 8 * h;
            bf16x8 sfr[2][8];
#pragma unroll
            for (int pt = 0; pt < 2; ++pt)
#pragma unroll
                for (int ks = 0; ks < 8; ++ks) sfr[pt][ks] = *(const bf16x8*)(stp + pt * 4096 + 16 * ks);
            bf16x8 pf[4][2];
#pragma unroll
            for (int i = 0; i < 4; ++i) {
                f32x16 Xi;
#pragma unroll
                for (int e = 0; e < 16; ++e) Xi[e] = 0.f;
#pragma unroll
                for (int ks = 0; ks < 8; ++ks) { const bf16x8 bf_ = *(const LAS bf16x8*)(sB + (32 * i + ql) * SC_ST + 32 * ks + 16 * h);
                    const bf16x8 cf = *(const LAS bf16x8*)(sC + s * SC_ST + 32 * ks + 16 * h); Xi = MFMA32(bf_, cf, Xi); }
                float p[16];
#pragma unroll
                for (int q4 = 0; q4 < 4; ++q4) { const int t0 = 32 * i + 8 * q4 + 4 * h;
                    const f32x4 at = *(const LAS f32x4*)(sAc + r * 128 + t0), dt4 = *(const LAS f32x4*)(sDt + r * 128 + t0);
#pragma unroll
                    for (int e = 0; e < 4; ++e) { const int t = t0 + e; p[4 * q4 + e] = (t <= s) ? Xi[4 * q4 + e] * __expf(acs - at[e]) * dt4[e] : 0.f; } }
#pragma unroll
                for (int s2 = 0; s2 < 2; ++s2) { const u32x4 w = {pkbf(p[8 * s2 + 0], p[8 * s2 + 1]), pkbf(p[8 * s2 + 2], p[8 * s2 + 3]), pkbf(p[8 * s2 + 4], p[8 * s2 + 5]), pkbf(p[8 * s2 + 6], p[8 * s2 + 7])};
                    pf[i][s2] = __builtin_bit_cast(bf16x8, w); }
            }
            const float eacs = __expf(acs), Dh = F.in[I_SSDD][head];
#pragma unroll
            for (int pt = 0; pt < 2; ++pt) {
                f32x16 yd, yo;
#pragma unroll
                for (int e = 0; e < 16; ++e) { yd[e] = 0.f; yo[e] = 0.f; }
#pragma unroll
                for (int i = 0; i < 4; ++i) {
#pragma unroll
                    for (int s2 = 0; s2 < 2; ++s2) { const unsigned a = xa + (unsigned)((32 * i + 16 * s2) * SX_ST + (r * 64 + 32 * pt) * 2);
                        const bf16x8 xf = tr_pair(a, a + 8 * SX_ST); __builtin_amdgcn_sched_barrier(0); yd = MFMA32(xf, pf[i][s2], yd); }
                }
#pragma unroll
                for (int ks = 0; ks < 8; ++ks) { const bf16x8 cf = *(const LAS bf16x8*)(sC + s * SC_ST + 32 * ks + 16 * h); yo = MFMA32(sfr[pt][ks], cf, yo); }
                const bf16* zp = P + (rowb + c * 128 + s) * NPROJ + PC_Z + g * 256 + r * 64 + 32 * pt + 4 * h;
                u32x2 zv[4];
#pragma unroll
                for (int q4 = 0; q4 < 4; ++q4) zv[q4] = *(const u32x2*)(zp + 8 * q4);
#pragma unroll
                for (int q4 = 0; q4 < 4; ++q4) {
                    const u32x2 xv = *(const LAS u32x2*)(sX + s * SX_ST + (r * 64 + 32 * pt + 8 * q4 + 4 * h) * 2);
                    const u32x2 zq = zv[q4];
                    const float xs_[4] = {bflo(xv.x), bfhi(xv.x), bflo(xv.y), bfhi(xv.y)}, zs_[4] = {bflo(zq.x), bfhi(zq.x), bflo(zq.y), bfhi(zq.y)};
                    float yv[4];
#pragma unroll
                    for (int e = 0; e < 4; ++e) { float y = yd[4 * q4 + e] + eacs * yo[4 * q4 + e] + Dh * xs_[e]; y = y * zs_[e] * sigmoidf_(zs_[e]); yv[e] = y; ssq += y * y; }
                    yk[hq][pt][2 * q4] = pkbf(yv[0], yv[1]); yk[hq][pt][2 * q4 + 1] = pkbf(yv[2], yv[3]);
                }
            }
        }
        ssq += __shfl_xor(ssq, 32);
        if (h == 0) __hip_atomic_fetch_add(sSS + s, ssq, __ATOMIC_RELAXED, __HIP_MEMORY_SCOPE_WORKGROUP);
        __syncthreads();
        const float rs = __builtin_amdgcn_rsqf(sSS[s] * (1.f / 256.f) + EPS);
        unsigned char* yp = (unsigned char*)F.out + (tok0 + s) * YC + g * 256 + 4 * h;
        const float* nw = F.in[I_SSDNW] + g * 256 + 4 * h;
#pragma unroll
        for (int hq = 0; hq < 2; ++hq)
#pragma unroll
            for (int pt = 0; pt < 2; ++pt)
#pragma unroll
                for (int q4 = 0; q4 < 4; ++q4) { const int cc = (2 * hp + hq) * 64 + 32 * pt + 8 * q4; const f32x4 w4 = *(const f32x4*)(nw + cc);
                    const unsigned ya = yk[hq][pt][2 * q4], yb = yk[hq][pt][2 * q4 + 1];
                    *(unsigned*)(yp + cc) = pk4f8(bflo(ya) * rs * w4.x, bfhi(ya) * rs * w4.y, bflo(yb) * rs * w4.z, bfhi(yb) * rs * w4.w); }
    }
}

__device__ __forceinline__ bf16x8 mk_bf16x8(u32x2 lo, u32x2 hi) { const u32x4 v = {lo.x, lo.y, hi.x, hi.y}; return __builtin_bit_cast(bf16x8, v); }

__device__ __forceinline__ void memattn_mfma_phase(Frame& F, int half) {
    const bf16* P = (const bf16*)(F.ws + WS_BIG);
    const bf16* MKV = (const bf16*)(F.ws + WS_MKV);
    const bf16* MVT = (const bf16*)(F.ws + WS_MVT);
    bf16* Y = (bf16*)F.out;
    LAS unsigned char* sm = F.lds;
    const int tid = F.tid, lane = F.lane, wave = F.wave, ql = lane & 31, h = lane >> 5;
    constexpr int KST = 400, VST = 528;
    for (int unit = F.bid; unit < HB * 4 * 32; unit += F.G) {
        const int bl = unit >> 7, head = (unit >> 5) & 3, qt = unit & 31, b = half * HB + bl;
        const int r = bl * SEQ + qt * 256 + wave * 32 + ql;
        __syncthreads();
        for (int c = tid; c < 256 * 24; c += NTHR) { const int row = c / 24, ch = c % 24;
            *(LAS u32x4*)(sm + row * KST + ch * 16) = *(const u32x4*)(MKV + (size_t)(b * NMEM + row) * 1536 + head * 192 + ch * 8); }
        bf16x8 qf[12];
        { const bf16* qp = P + (size_t)r * NPROJ + PC_MQ + head * 192 + 8 * h;
          u32x4 qr[12]; float ss = 0.f;
#pragma unroll
          for (int ks = 0; ks < 12; ++ks) { qr[ks] = *(const u32x4*)(qp + 16 * ks);
              ss += (bflo(qr[ks].x) * bflo(qr[ks].x) + bfhi(qr[ks].x) * bfhi(qr[ks].x)) + (bflo(qr[ks].y) * bflo(qr[ks].y) + bfhi(qr[ks].y) * bfhi(qr[ks].y))
                  + (bflo(qr[ks].z) * bflo(qr[ks].z) + bfhi(qr[ks].z) * bfhi(qr[ks].z)) + (bflo(qr[ks].w) * bflo(qr[ks].w) + bfhi(qr[ks].w) * bfhi(qr[ks].w)); }
          ss += __shfl_xor(ss, 32);
          const float rs = __builtin_amdgcn_rsqf(ss * (1.f / 192.f) + EPS);
#pragma unroll
          for (int ks = 0; ks < 12; ++ks) { const f32x4 wa = *(const f32x4*)(F.in[I_MQNW] + 16 * ks + 8 * h), wb = *(const f32x4*)(F.in[I_MQNW] + 16 * ks + 8 * h + 4);
              const u32x4 w = {pkbf(bflo(qr[ks].x) * rs * wa.x, bfhi(qr[ks].x) * rs * wa.y), pkbf(bflo(qr[ks].y) * rs * wa.z, bfhi(qr[ks].y) * rs * wa.w),
                               pkbf(bflo(qr[ks].z) * rs * wb.x, bfhi(qr[ks].z) * rs * wb.y), pkbf(bflo(qr[ks].w) * rs * wb.z, bfhi(qr[ks].w) * rs * wb.w)};
              qf[ks] = __builtin_bit_cast(bf16x8, w); } }
        __syncthreads();
        f32x16 sacc[8];
#pragma unroll
        for (int mt = 0; mt < 8; ++mt) {
#pragma unroll
            for (int i = 0; i < 16; ++i) sacc[mt][i] = 0.f;
#pragma unroll
            for (int ks = 0; ks < 12; ++ks) { const bf16x8 kf = *(const LAS bf16x8*)(sm + (32 * mt + ql) * KST + 32 * ks + 16 * h); sacc[mt] = MFMA32(kf, qf[ks], sacc[mt]); }
        }
        float mx = -3.0e38f;
#pragma unroll
        for (int mt = 0; mt < 8; ++mt)
#pragma unroll
            for (int i = 0; i < 16; ++i) mx = fmaxf(mx, sacc[mt][i]);
        mx = fmaxf(mx, __shfl_xor(mx, 32));
        const float sc = 0.07216878364870323f * 1.4426950408889634f;
        float l = 0.f;
        bf16x8 pf[8][2];
#pragma unroll
        for (int mt = 0; mt < 8; ++mt) {
            float p[16];
#pragma unroll
            for (int i = 0; i < 16; ++i) { p[i] = __builtin_amdgcn_exp2f((sacc[mt][i] - mx) * sc); l += p[i]; }
#pragma unroll
            for (int s2 = 0; s2 < 2; ++s2) { const u32x4 w = {pkbf(p[8 * s2 + 0], p[8 * s2 + 1]), pkbf(p[8 * s2 + 2], p[8 * s2 + 3]), pkbf(p[8 * s2 + 4], p[8 * s2 + 5]), pkbf(p[8 * s2 + 6], p[8 * s2 + 7])};
                pf[mt][s2] = __builtin_bit_cast(bf16x8, w); }
        }
        l += __shfl_xor(l, 32);
        __syncthreads();
        for (int c = tid; c < 192 * 32; c += NTHR) { const int row = c >> 5, ch = c & 31;
            *(LAS u32x4*)(sm + row * VST + ch * 16) = *(const u32x4*)(MVT + (size_t)(head * 192 + row) * 2048 + b * NMEM + ch * 8); }
        __syncthreads();
        const float il = __builtin_amdgcn_rcpf(l);
        unsigned char* yp = (unsigned char*)F.out + ((size_t)half * HT + r) * YC + 1280 + head * 192 + 4 * h;
#pragma unroll
        for (int dt = 0; dt < 6; ++dt) {
            f32x16 o;
#pragma unroll
            for (int i = 0; i < 16; ++i) o[i] = 0.f;
#pragma unroll
            for (int mt = 0; mt < 8; ++mt)
#pragma unroll
                for (int s2 = 0; s2 < 2; ++s2) { const LAS unsigned char* vp = sm + (32 * dt + ql) * VST + (32 * mt + 16 * s2 + 4 * h) * 2;
                    const bf16x8 vf = mk_bf16x8(*(const LAS u32x2*)vp, *(const LAS u32x2*)(vp + 16)); o = MFMA32(vf, pf[mt][s2], o); }
#pragma unroll
            for (int g = 0; g < 4; ++g) { const float is = il * YD_SCALE; *(unsigned*)(yp + 32 * dt + 8 * g) = pk4f8(o[4 * g] * is, o[4 * g + 1] * is, o[4 * g + 2] * is, o[4 * g + 3] * is); }
        }
    }
}

__device__ __forceinline__ void dilattn_mfma_phase(Frame& F, int half) {
    bf16* P = (bf16*)(F.ws + WS_BIG);
    float* LSE = (float*)(F.ws + WS_LSE);
    LAS unsigned char* sK = F.lds; LAS unsigned char* sV = F.lds + 384 * 144;
    const int tid = F.tid, lane = F.lane, wave = F.wave, ql = lane & 31, h = lane >> 5;
    constexpr int RST = 144;
    const float* RT = (const float*)(F.ws + WS_ROPE);
    float wk8[8];
#pragma unroll
    for (int j = 0; j < 8; ++j) wk8[j] = F.in[I_DKNW][8 * (tid & 7) + j];
    for (int unit = F.bid; unit < HB * 12 * 32; unit += F.G) {
        const int bl = unit / 384, rem = unit % 384, head = rem >> 5, blk = rem & 31;
        const int g = head >> 2, dil = (g == 0) ? 1 : (g == 1 ? 4 : 16), bpr = 32 / dil;
        const int res = blk / bpr, q0 = (blk % bpr) * 256;
        const size_t rowb = (size_t)bl * SEQ;
        __syncthreads();
        for (int c = tid; c < 384 * 8; c += NTHR) { const int row = c >> 3, ch = c & 7; const int ks = q0 - 128 + row;
            u32x4 kv = {0u, 0u, 0u, 0u}, vv = {0u, 0u, 0u, 0u}; f32x4 c0 = {1.f, 1.f, 1.f, 1.f}, c1 = c0, s0 = {0.f, 0.f, 0.f, 0.f}, s1 = s0;
            if (ks >= 0) { const size_t rr = rowb + (size_t)ks * dil + res; const bf16* src = P + rr * NPROJ + head * 64 + ch * 8; kv = *(const u32x4*)(src + PC_DK); vv = *(const u32x4*)(src + PC_DV);
                if (ch < 2) { const f32x4* rt = (const f32x4*)(RT + ((size_t)half * HT + rr) * 16); c0 = rt[0]; c1 = rt[1]; s0 = rt[2]; s1 = rt[3]; } }
            float x[8] = {bflo(kv.x), bfhi(kv.x), bflo(kv.y), bfhi(kv.y), bflo(kv.z), bfhi(kv.z), bflo(kv.w), bfhi(kv.w)};
            float ss = 0.f;
#pragma unroll
            for (int j = 0; j < 8; ++j) ss += x[j] * x[j];
            ss += __shfl_xor(ss, 1); ss += __shfl_xor(ss, 2); ss += __shfl_xor(ss, 4);
            const float rs = __builtin_amdgcn_rsqf(ss * (1.f / 64.f) + EPS);
            const float cs[8] = {c0.x, c0.y, c0.z, c0.w, c1.x, c1.y, c1.z, c1.w}, sn[8] = {s0.x, s0.y, s0.z, s0.w, s1.x, s1.y, s1.z, s1.w};
#pragma unroll
            for (int j = 0; j < 8; ++j) { x[j] = x[j] * rs * wk8[j]; const float o = __shfl_xor(x[j], 1); if (ch == 0) x[j] = x[j] * cs[j] - o * sn[j]; else if (ch == 1) x[j] = x[j] * cs[j] + o * sn[j]; }
            kv = (u32x4){pkbf(x[0], x[1]), pkbf(x[2], x[3]), pkbf(x[4], x[5]), pkbf(x[6], x[7])};
            *(LAS u32x4*)(sK + row * RST + ch * 16) = kv; *(LAS u32x4*)(sV + row * RST + ch * 16) = vv; }
        const int qs = q0 + wave * 32 + ql;
        const size_t rq = rowb + (size_t)qs * dil + res;
        bf16* qp = P + rq * NPROJ + PC_DQ + head * 64;
        bf16x8 qf[4];
        {
            u32x4 qr[4];
#pragma unroll
            for (int ks = 0; ks < 4; ++ks) qr[ks] = *(const u32x4*)(qp + 16 * ks + 8 * h);
            const f32x4* rt = (const f32x4*)(RT + ((size_t)half * HT + rq) * 16); const f32x4 c0 = rt[0], c1 = rt[1], s0 = rt[2], s1 = rt[3];
            float ss = 0.f;
#pragma unroll
            for (int ks = 0; ks < 4; ++ks) ss += (bflo(qr[ks].x) * bflo(qr[ks].x) + bfhi(qr[ks].x) * bfhi(qr[ks].x)) + (bflo(qr[ks].y) * bflo(qr[ks].y) + bfhi(qr[ks].y) * bfhi(qr[ks].y))
                                               + (bflo(qr[ks].z) * bflo(qr[ks].z) + bfhi(qr[ks].z) * bfhi(qr[ks].z)) + (bflo(qr[ks].w) * bflo(qr[ks].w) + bfhi(qr[ks].w) * bfhi(qr[ks].w));
            ss += __shfl_xor(ss, 32);
            const float rs = __builtin_amdgcn_rsqf(ss * (1.f / 64.f) + EPS);
#pragma unroll
            for (int ks = 0; ks < 4; ++ks) { const f32x4 wa = *(const f32x4*)(F.in[I_DQNW] + 16 * ks + 8 * h), wb = *(const f32x4*)(F.in[I_DQNW] + 16 * ks + 8 * h + 4);
                float x[8] = {bflo(qr[ks].x) * rs * wa.x, bfhi(qr[ks].x) * rs * wa.y, bflo(qr[ks].y) * rs * wa.z, bfhi(qr[ks].y) * rs * wa.w, bflo(qr[ks].z) * rs * wb.x, bfhi(qr[ks].z) * rs * wb.y, bflo(qr[ks].w) * rs * wb.z, bfhi(qr[ks].w) * rs * wb.w};
                if (ks == 0) { const float cs[8] = {c0.x, c0.y, c0.z, c0.w, c1.x, c1.y, c1.z, c1.w}, sn[8] = {s0.x, s0.y, s0.z, s0.w, s1.x, s1.y, s1.z, s1.w};
#pragma unroll
                    for (int j = 0; j < 8; ++j) { const float o = __shfl_xor(x[j], 32); x[j] = (h == 0) ? x[j] * cs[j] - o * sn[j] : x[j] * cs[j] + o * sn[j]; } }
                const u32x4 w = {pkbf(x[0], x[1]), pkbf(x[2], x[3]), pkbf(x[4], x[5]), pkbf(x[6], x[7])}; qf[ks] = __builtin_bit_cast(bf16x8, w); }
        }
        __syncthreads();
        f32x16 sacc[5];
        const int kfirst = q0 + wave * 32 - 128;
#pragma unroll
        for (int i = 0; i < 5; ++i) {
#pragma unroll
            for (int e = 0; e < 16; ++e) sacc[i][e] = 0.f;
#pragma unroll
            for (int ks = 0; ks < 4; ++ks) { const bf16x8 kf = *(const LAS bf16x8*)(sK + (32 * wave + 32 * i + ql) * RST + 32 * ks + 16 * h); sacc[i] = MFMA32(kf, qf[ks], sacc[i]); }
        }
        float mx = -3.0e38f;
#pragma unroll
        for (int i = 0; i < 5; ++i)
#pragma unroll
            for (int e = 0; e < 16; ++e) { const int kj = 32 * i + (e & 3) + 8 * (e >> 2) + 4 * h; const bool ok = (kj >= ql) && (kj <= ql + 128) && (kfirst + kj >= 0);
                sacc[i][e] = ok ? sacc[i][e] : -3.0e38f; mx = fmaxf(mx, sacc[i][e]); }
        mx = fmaxf(mx, __shfl_xor(mx, 32));
        const float sc = 0.125f * 1.4426950408889634f;
        float l = 0.f;
        bf16x8 pf[5][2];
#pragma unroll
        for (int i = 0; i < 5; ++i) {
            float p[16];
#pragma unroll
            for (int e = 0; e < 16; ++e) { p[e] = (sacc[i][e] > -1.0e38f) ? __builtin_amdgcn_exp2f((sacc[i][e] - mx) * sc) : 0.f; l += p[e]; }
#pragma unroll
            for (int s2 = 0; s2 < 2; ++s2) { const u32x4 w = {pkbf(p[8 * s2 + 0], p[8 * s2 + 1]), pkbf(p[8 * s2 + 2], p[8 * s2 + 3]), pkbf(p[8 * s2 + 4], p[8 * s2 + 5]), pkbf(p[8 * s2 + 6], p[8 * s2 + 7])};
                pf[i][s2] = __builtin_bit_cast(bf16x8, w); }
        }
        l += __shfl_xor(l, 32);
        const float il = __builtin_amdgcn_rcpf(l);
        const int tq = (lane & 15) >> 2, tp = lane & 3, tblk = (lane >> 4) & 1;
        const unsigned vbase = (unsigned)(size_t)(sV) + (unsigned)((32 * wave + 4 * h + tq) * RST + (16 * tblk + 4 * tp) * 2);
#pragma unroll
        for (int dt = 0; dt < 2; ++dt) {
            f32x16 o;
#pragma unroll
            for (int e = 0; e < 16; ++e) o[e] = 0.f;
#pragma unroll
            for (int i = 0; i < 5; ++i) {
                s16x4 lo[2], hi[2];
#pragma unroll
                for (int s2 = 0; s2 < 2; ++s2) { const unsigned a = vbase + (unsigned)((32 * i + 16 * s2) * RST + 64 * dt);
                    asm volatile("ds_read_b64_tr_b16 %0, %1" : "=&v"(lo[s2]) : "v"(a) : "memory");
                    asm volatile("ds_read_b64_tr_b16 %0, %1 offset:1152" : "=&v"(hi[s2]) : "v"(a) : "memory"); }
                asm volatile("s_waitcnt lgkmcnt(0)" ::: "memory"); __builtin_amdgcn_sched_barrier(0);
#pragma unroll
                for (int s2 = 0; s2 < 2; ++s2) { const bf16x8 vf = {lo[s2][0], lo[s2][1], lo[s2][2], lo[s2][3], hi[s2][0], hi[s2][1], hi[s2][2], hi[s2][3]}; o = MFMA32(vf, pf[i][s2], o); }
            }
#pragma unroll
            for (int gq = 0; gq < 4; ++gq) { const u32x2 w = {pkbf(o[4 * gq] * il, o[4 * gq + 1] * il), pkbf(o[4 * gq + 2] * il, o[4 * gq + 3] * il)}; *(u32x2*)(qp + 32 * dt + 8 * gq + 4 * h) = w; }
        }
        if (h == 0) LSE[((size_t)half * HT + rq) * 12 + head] = mx * 0.125f + __logf(l);
    }
}

__device__ __forceinline__ void dilmerge_phase(Frame& F, int half) {
    const bf16* P = (const bf16*)(F.ws + WS_BIG);
    const float* LSE = (const float*)(F.ws + WS_LSE);
    bf16* Y = (bf16*)F.out;
    const size_t gtid = (size_t)F.bid * NTHR + F.tid, gth = (size_t)F.G * NTHR;
    for (size_t it = gtid; it < (size_t)HT * 32; it += gth) {
        const size_t r = it >> 5; const int hh = (int)(it >> 3) & 3, d0 = (int)(it & 7) * 8;
        const size_t tok = (size_t)half * HT + r;
        const float l0 = LSE[tok * 12 + hh], l1 = LSE[tok * 12 + 4 + hh], l2 = LSE[tok * 12 + 8 + hh];
        const float m = fmaxf(l0, fmaxf(l1, l2));
        float w0 = __expf(l0 - m), w1 = __expf(l1 - m), w2 = __expf(l2 - m); const float iw = __builtin_amdgcn_rcpf(w0 + w1 + w2) * YD_SCALE; w0 *= iw; w1 *= iw; w2 *= iw;
        const bf16* op = P + r * NPROJ + PC_DQ + hh * 64 + d0;
        const u32x4 a = *(const u32x4*)op, b = *(const u32x4*)(op + 256), c = *(const u32x4*)(op + 512);
#define DM_(p, q) (w0 * p(a.q) + w1 * p(b.q) + w2 * p(c.q))
        const u32x2 o = {pk4f8(DM_(bflo, x), DM_(bfhi, x), DM_(bflo, y), DM_(bfhi, y)), pk4f8(DM_(bflo, z), DM_(bfhi, z), DM_(bflo, w), DM_(bfhi, w))};
#undef DM_
        *(u32x2*)((unsigned char*)F.out + tok * YC + 1024 + hh * 64 + d0) = o;
    }
}

__device__ __forceinline__ void hn_phase(Frame& F) {
    const int gw = F.bid * NWAVES + F.wave, NGW = F.G * NWAVES;
    for (int m = gw; m < T; m += NGW) { f32x4 v[4]; rms_row_to_bf16(F.out + (size_t)m * DM, F.in[I_NFFNW], (bf16*)(F.ws + WS_ACT1) + (size_t)m * DM, F.lane, v); }
}


__device__ __forceinline__ float gelu_erf(float x) { return 0.5f * x * (1.0f + erff(x * 0.70710678118654752f)); }
__device__ __forceinline__ unsigned f2ord(float f) { const unsigned u = __builtin_bit_cast(unsigned, f); return u ^ ((unsigned)((int)u >> 31) | 0x80000000u); }
__device__ __forceinline__ float ord2f(unsigned k) { const unsigned m = (unsigned)((int)k >> 31); return __builtin_bit_cast(float, k ^ (0x80000000u | ~m)); }
#define CMPX(a, b) do { const unsigned _mx = max((a), (b)), _mn = min((a), (b)); (a) = _mx; (b) = _mn; } while (0)
__device__ __forceinline__ void bitonic_sort16_desc(unsigned (&v)[16]) {
#pragma unroll
    for (int k = 2; k <= 16; k <<= 1)
#pragma unroll
        for (int j = k >> 1; j > 0; j >>= 1)
#pragma unroll
            for (int i = 0; i < 16; ++i) { const int l = i ^ j; if (l > i) { if ((i & k) == 0) CMPX(v[i], v[l]); else CMPX(v[l], v[i]); } }
}
__device__ __forceinline__ void bitonic_merge16_desc(unsigned (&v)[16]) {
#pragma unroll
    for (int j = 8; j > 0; j >>= 1)
#pragma unroll
        for (int i = 0; i < 16; ++i) { const int l = i ^ j; if (l > i) CMPX(v[i], v[l]); }
}
__device__ __forceinline__ void top16_merge(unsigned (&a)[16], const unsigned (&b)[16]) {
#pragma unroll
    for (int i = 0; i < 16; ++i) a[i] = max(a[i], b[15 - i]);
    bitonic_merge16_desc(a);
}
constexpr int PK_ST = 272;
__device__ __forceinline__ void peer_topk_tile(Frame& F, size_t tok0, const bf16* Q, int* IDX, float* GATE) {
    const bf16* SK = (const bf16*)(F.ws + WS_SUBK);
    LAS unsigned char* sK = F.lds;
    int tid = F.tid; asm volatile("" : "+v"(tid));
    const int lane = tid & 63, wave = F.wave, ql = lane & 31, hh = lane >> 5;
    const size_t tok = tok0 + wave * 32 + ql;
    const bf16* qrow = Q + tok * PEER_Q + 8 * hh;
    __syncthreads();
#pragma unroll
    for (int j = 0; j < 4; ++j) { const int cidx = tid + 512 * j, row = cidx >> 4, ch = cidx & 15; *(LAS u32x4*)(sK + row * PK_ST + ch * 16) = *(const u32x4*)(SK + (size_t)row * 128 + ch * 8); }
    __syncthreads();
    unsigned k1[16];
    bf16x8 qf[8];
#pragma unroll
    for (int ks = 0; ks < 8; ++ks) qf[ks] = *(const bf16x8*)(qrow + 16 * ks);
#pragma unroll 1
    for (int hc = 0; hc < 16; ++hc) {
        LAS unsigned char* cur = sK + (hc & 1) * (128 * PK_ST); LAS unsigned char* nxt = sK + ((hc + 1) & 1) * (128 * PK_ST);
        u32x4 stg[4];
        const int hcn = (hc + 1) & 15;
#pragma unroll
        for (int j = 0; j < 4; ++j) { const int cidx = tid + 512 * j, row = cidx >> 4, ch = cidx & 15; stg[j] = *(const u32x4*)(SK + ((size_t)hcn * 128 + row) * 128 + ch * 8); }
        unsigned pk[4][16];
#pragma unroll
        for (int mt = 0; mt < 4; ++mt) {
            f32x16 acc;
#pragma unroll
            for (int e = 0; e < 16; ++e) acc[e] = 0.f;
#pragma unroll
            for (int ks = 0; ks < 8; ++ks) { const bf16x8 kf = *(const LAS bf16x8*)(cur + (32 * mt + ql) * PK_ST + 32 * ks + 16 * hh); acc = MFMA32(kf, qf[ks], acc); }
#pragma unroll
            for (int e = 0; e < 16; ++e) pk[mt][e] = (f2ord(acc[e]) & 0xFFFFFF80u) | (unsigned)(32 * mt + (e & 3) + 8 * (e >> 2) + 4 * hh);
        }
#pragma unroll
        for (int j = 0; j < 4; ++j) { const int cidx = tid + 512 * j, row = cidx >> 4, ch = cidx & 15; *(LAS u32x4*)(nxt + row * PK_ST + ch * 16) = stg[j]; }
        __syncthreads();
        __builtin_amdgcn_sched_barrier(0);
#pragma unroll
        for (int ks = 0; ks < 8; ++ks) qf[ks] = *(const bf16x8*)(qrow + hcn * 128 + 16 * ks);
        __builtin_amdgcn_sched_barrier(0);
#pragma unroll
        for (int mt = 0; mt < 4; ++mt) bitonic_sort16_desc(pk[mt]);
        top16_merge(pk[0], pk[1]); top16_merge(pk[2], pk[3]); top16_merge(pk[0], pk[2]);
        unsigned other[16];
#pragma unroll
        for (int i = 0; i < 16; ++i) other[i] = (unsigned)__shfl_xor((int)pk[0][i], 32);
        top16_merge(pk[0], other);
        if ((hc & 1) == 0) {
#pragma unroll
            for (int i = 0; i < 16; ++i) k1[i] = pk[0][i];
        } else {
            float f1[16], f2[16];
#pragma unroll
            for (int i = 0; i < 16; ++i) { f1[i] = ord2f(k1[i] & 0xFFFFFF80u); f2[i] = ord2f(pk[0][i] & 0xFFFFFF80u); }
            unsigned cd[4][16];
#pragma unroll
            for (int i = 0; i < 64; ++i) cd[i >> 4][i & 15] = 0u;
            int n = 0;
#pragma unroll
            for (int a = 0; a < 16; ++a)
#pragma unroll
                for (int b = 0; b < 16; ++b)
                    if ((a + 1) * (b + 1) <= 16) { cd[n >> 4][n & 15] = (f2ord(f1[a] + f2[b]) & 0xFFFFC000u) | ((k1[a] & 127u) << 7) | (pk[0][b] & 127u); ++n; }
            {
#pragma unroll
                for (int i = 0; i < 16; ++i) { cd[0][i] = hh ? cd[2][i] : cd[0][i]; cd[1][i] = hh ? cd[3][i] : cd[1][i]; }
                bitonic_sort16_desc(cd[0]); bitonic_sort16_desc(cd[1]);
                top16_merge(cd[0], cd[1]);
                unsigned oth[16];
#pragma unroll
                for (int i = 0; i < 16; ++i) oth[i] = (unsigned)__shfl_xor((int)cd[0][i], 32);
                top16_merge(cd[0], oth);
            }
            const float vmax = ord2f(cd[0][0] & 0xFFFFC000u);
            float ex[16], den = 0.f;
#pragma unroll
            for (int i = 0; i < 16; ++i) { ex[i] = __expf(ord2f(cd[0][i] & 0xFFFFC000u) - vmax); den += ex[i]; }
            const float iden = __builtin_amdgcn_rcpf(den);
            const int h = hc >> 1;
            if (hh == 0) { int* ip = IDX + tok * 128 + h * 16;
#pragma unroll
                for (int i = 0; i < 4; ++i) { const u32x4 w = {cd[0][4 * i] & 0x3FFFu, cd[0][4 * i + 1] & 0x3FFFu, cd[0][4 * i + 2] & 0x3FFFu, cd[0][4 * i + 3] & 0x3FFFu}; *(u32x4*)(ip + 4 * i) = w; } }
            else { float* gp = GATE + tok * 128 + h * 16;
#pragma unroll
                for (int i = 0; i < 4; ++i) { const f32x4 w = {ex[4 * i] * iden, ex[4 * i + 1] * iden, ex[4 * i + 2] * iden, ex[4 * i + 3] * iden}; *(f32x4*)(gp + 4 * i) = w; } }
        }
    }
}

struct PeerDeal { size_t tokw; int ntok; size_t tok0; float* PART; const int* IDX; const float* GATE; float* COEF; };
__device__ __forceinline__ void peer_item(int n, const PeerDeal& D, int wave, int& slice, size_t& tok) { slice = n >> 5; tok = D.tokw + (n & 31); }
__device__ __forceinline__ void peer_down_rows(u32x4 (&R)[16], __amdgpu_buffer_rsrc_t tab, int slice, int id0, int id1, int lane) {
    const int soff = slice * (16384 * 128);
    const int r = lane & 15, g = lane >> 4, e8 = (r >> 2) + 4 * (g >> 1), q = 4 * (g & 1) + (r & 3);
    const int src0 = 16 * (e8 & 3);
#pragma unroll
    for (int k = 0; k < 16; ++k) { const int v0 = __shfl(id0, src0 + k), v1 = __shfl(id1, src0 + k); const int id = (e8 < 4) ? v0 : v1;
        R[k] = __builtin_amdgcn_raw_buffer_load_b128(tab, (id << 7) + 16 * q, soff, 0); }
}
__device__ __forceinline__ void peer_down_hn(u32x4 (&H)[2], const bf16* HN, int slice, size_t tok, int lane) {
    const unsigned char* hp = (const unsigned char*)HN + tok * DM + slice * 128 + 16 * (4 * ((lane >> 4) & 1) + (lane & 3));
    H[0] = *(const u32x4*)hp;
}
__device__ __forceinline__ void peer_down_bq(long (&bq)[2], const u32x4 (&H)[2], int lane) {
    const int c = lane & 15, g = lane >> 4; const bool on = (c < 8) && ((c >> 2) == (g >> 1));
    unsigned p0 = H[0].x, p1 = H[0].y, p2 = H[0].z, p3 = H[0].w;
    if (!on) { p0 = 0u; p1 = 0u; p2 = 0u; p3 = 0u; }
    bq[0] = (long)(((unsigned long long)p1 << 32) | p0); bq[1] = (long)(((unsigned long long)p3 << 32) | p2);
}
__device__ __forceinline__ void peer_down_mfma(const u32x4 (&R)[16], const long (&bq)[2], __amdgpu_buffer_rsrc_t prsrc, int slice, int tokl, int lane) {
    const int c = lane & 15, g = lane >> 4, cb = c & 3;
    float dv[16];
#pragma unroll
    for (int k = 0; k < 16; ++k) { f32x4 acc = {0.f, 0.f, 0.f, 0.f}; const u32x4 v = R[k];
        acc = __builtin_amdgcn_mfma_f32_16x16x32_fp8_fp8((long)(((unsigned long long)v.y << 32) | v.x), bq[0], acc, 0, 0, 0);
        acc = __builtin_amdgcn_mfma_f32_16x16x32_fp8_fp8((long)(((unsigned long long)v.w << 32) | v.z), bq[1], acc, 0, 0, 0);
        float t = (cb == 0) ? acc.x : (cb == 1) ? acc.y : (cb == 2) ? acc.z : acc.w;
        t += __shfl_xor(t, 1); t += __shfl_xor(t, 2); dv[k] = t; }
    const unsigned off = ((c & 3) == 0 && c < 8) ? (unsigned)(((tokl * 8 + slice) * 128 + 16 * (g + 4 * (c >> 2))) * 2) : 0xFFFFFF00u;
#pragma unroll
    for (int i = 0; i < 2; ++i) { const u32x4 w = {pkbf(dv[8 * i], dv[8 * i + 1]), pkbf(dv[8 * i + 2], dv[8 * i + 3]), pkbf(dv[8 * i + 4], dv[8 * i + 5]), pkbf(dv[8 * i + 6], dv[8 * i + 7])}; __builtin_amdgcn_raw_buffer_store_b128(w, prsrc, off, 16 * i, 0); }
}
__device__ __forceinline__ void peer_down_phase(Frame& F, const PeerDeal& D) {
    const __amdgpu_buffer_rsrc_t PD = __builtin_amdgcn_make_buffer_rsrc((void*)(F.ws + WS_PD), 0, 16384 * 1024, 0x00020000); const bf16* HN = (const bf16*)(F.ws + WS_HN8F);
    const int* IDX = D.IDX;
    const __amdgpu_buffer_rsrc_t prsrc = __builtin_amdgcn_make_buffer_rsrc((void*)D.PART, 0, 256 * 8 * 128 * 2, 0x00020000);
    int lane = F.lane; asm volatile("" : "+v"(lane));
    const int wave = F.wave;
    const int ntok = D.ntok;
    u32x4 RA[16], RB[16], HA[2], HB[2]; int ia0, ia1, ib0, ib1; long bq[2];
#define PEER_TOK(k, sv, tv) int sv; size_t tv; peer_item((k) < ntok ? (k) : ntok - 2 + ((k) & 1), D, wave, sv, tv)
    { PEER_TOK(0, s0, t0); PEER_TOK(1, s1, t1); PEER_TOK(2, s2, t2); PEER_TOK(3, s3, t3);
      const int a0 = IDX[t0 * 128 + lane], a1 = IDX[t0 * 128 + 64 + lane], b0 = IDX[t1 * 128 + lane], b1 = IDX[t1 * 128 + 64 + lane];
      ia0 = IDX[t2 * 128 + lane]; ia1 = IDX[t2 * 128 + 64 + lane]; ib0 = IDX[t3 * 128 + lane]; ib1 = IDX[t3 * 128 + 64 + lane];
      __builtin_amdgcn_sched_barrier(0);
      peer_down_rows(RA, PD, s0, a0, a1, lane); peer_down_hn(HA, HN, s0, t0, lane);
      __builtin_amdgcn_sched_barrier(0);
      peer_down_rows(RB, PD, s1, b0, b1, lane); peer_down_hn(HB, HN, s1, t1, lane);
      __builtin_amdgcn_sched_barrier(0); }
#pragma unroll 1
    for (int n = 0; n < ntok; n += 2) {
        PEER_TOK(n, s0, t0); PEER_TOK(n + 1, s1, t1); PEER_TOK(n + 2, s2, t2); PEER_TOK(n + 3, s3, t3); PEER_TOK(n + 4, s4, t4); PEER_TOK(n + 5, s5, t5);
        peer_down_bq(bq, HA, lane);
        peer_down_mfma(RA, bq, prsrc, s0, (int)(t0 - D.tok0), lane);
        __builtin_amdgcn_sched_barrier(0);
        { const int j0 = IDX[t4 * 128 + lane], j1 = IDX[t4 * 128 + 64 + lane];
          peer_down_rows(RA, PD, s2, ia0, ia1, lane); peer_down_hn(HA, HN, s2, t2, lane); ia0 = j0; ia1 = j1; }
        __builtin_amdgcn_sched_barrier(0);
        peer_down_bq(bq, HB, lane);
        peer_down_mfma(RB, bq, prsrc, s1, (int)(t1 - D.tok0), lane);
        __builtin_amdgcn_sched_barrier(0);
        { const int j0 = IDX[t5 * 128 + lane], j1 = IDX[t5 * 128 + 64 + lane];
          peer_down_rows(RB, PD, s3, ib0, ib1, lane); peer_down_hn(HB, HN, s3, t3, lane); ib0 = j0; ib1 = j1; }
        __builtin_amdgcn_sched_barrier(0);
    }
#undef PEER_TOK
}
__device__ __forceinline__ void peer_coef_wave(Frame& F, const PeerDeal& D) {
    for (int k = F.lane; k < 32 * 32; k += 64) {
        const int tl = (int)(D.tokw - D.tok0) + (k >> 5), slot = 4 * (k & 31);
        const bf16* pp = (const bf16*)D.PART + (size_t)tl * 1024 + slot;
        f32x4 sm = {0.f, 0.f, 0.f, 0.f};
#pragma unroll
        for (int x = 0; x < 8; ++x) { const u32x2 q = *(const u32x2*)(pp + 128 * x); sm += (f32x4){bflo(q.x), bfhi(q.x), bflo(q.y), bfhi(q.y)}; }
        const size_t i = (D.tok0 + tl) * 128 + slot;
        const f32x4 gt = *(const f32x4*)(D.GATE + i);
        const float dsc = 1.0f / PD_SCALE;
        const f32x4 o = {gt.x * gelu_erf(sm.x * dsc) * (1.0f / PU_SCALE), gt.y * gelu_erf(sm.y * dsc) * (1.0f / PU_SCALE),
                         gt.z * gelu_erf(sm.z * dsc) * (1.0f / PU_SCALE), gt.w * gelu_erf(sm.w * dsc) * (1.0f / PU_SCALE)};
        *(f32x4*)(D.COEF + i) = o;
    }
}
__device__ __forceinline__ void peer_up_rows(u32x4 (&R)[16], __amdgpu_buffer_rsrc_t tab, int slice, int id0, int id1, int lane) {
    const int soff = slice * (16384 * 128);
#pragma unroll
    for (int s8 = 0; s8 < 8; ++s8) { const int id = __shfl(s8 < 4 ? id0 : id1, (16 * s8 + (lane >> 2)) & 63); const int vo = (id << 7) + 16 * (lane & 3);
        R[2 * s8] = __builtin_amdgcn_raw_buffer_load_b128(tab, vo, soff, 0); R[2 * s8 + 1] = __builtin_amdgcn_raw_buffer_load_b128(tab, vo, soff + 64, 0); }
}
__device__ __forceinline__ void peer_up_compute(const u32x4 (&R)[16], float c0, float c1, f32x2 h, float* out, int slice, size_t tok, int lane) {
    f32x2 acc[16];
#pragma unroll
    for (int k = 0; k < 16; ++k) acc[k] = (f32x2){0.f, 0.f};
#pragma unroll
    for (int s8 = 0; s8 < 8; ++s8) { const float c = __shfl(s8 < 4 ? c0 : c1, (16 * s8 + (lane >> 2)) & 63); f32x2 c2 = {c, c}; asm volatile("" : "+v"(c2));
#pragma unroll
        for (int hf = 0; hf < 2; ++hf) { const u32x4 r = R[2 * s8 + hf];
            acc[8 * hf + 0] = c2 * __builtin_amdgcn_cvt_pk_f32_fp8(r.x, false) + acc[8 * hf + 0]; acc[8 * hf + 1] = c2 * __builtin_amdgcn_cvt_pk_f32_fp8(r.x, true) + acc[8 * hf + 1];
            acc[8 * hf + 2] = c2 * __builtin_amdgcn_cvt_pk_f32_fp8(r.y, false) + acc[8 * hf + 2]; acc[8 * hf + 3] = c2 * __builtin_amdgcn_cvt_pk_f32_fp8(r.y, true) + acc[8 * hf + 3];
            acc[8 * hf + 4] = c2 * __builtin_amdgcn_cvt_pk_f32_fp8(r.z, false) + acc[8 * hf + 4]; acc[8 * hf + 5] = c2 * __builtin_amdgcn_cvt_pk_f32_fp8(r.z, true) + acc[8 * hf + 5];
            acc[8 * hf + 6] = c2 * __builtin_amdgcn_cvt_pk_f32_fp8(r.w, false) + acc[8 * hf + 6]; acc[8 * hf + 7] = c2 * __builtin_amdgcn_cvt_pk_f32_fp8(r.w, true) + acc[8 * hf + 7]; } }
    f32x2 r8[8], r4[4], r2[2], r1;
    { const bool up = (lane & 32) != 0;
#pragma unroll
      for (int k = 0; k < 8; ++k) { const f32x2 keep = up ? acc[k + 8] : acc[k], send = up ? acc[k] : acc[k + 8]; r8[k] = keep + (f32x2){__shfl_xor(send.x, 32), __shfl_xor(send.y, 32)}; } }
    { const bool up = (lane & 16) != 0;
#pragma unroll
      for (int k = 0; k < 4; ++k) { const f32x2 keep = up ? r8[k + 4] : r8[k], send = up ? r8[k] : r8[k + 4]; r4[k] = keep + (f32x2){__shfl_xor(send.x, 16), __shfl_xor(send.y, 16)}; } }
    { const bool up = (lane & 8) != 0;
#pragma unroll
      for (int k = 0; k < 2; ++k) { const f32x2 keep = up ? r4[k + 2] : r4[k], send = up ? r4[k] : r4[k + 2]; r2[k] = keep + (f32x2){__shfl_xor(send.x, 8), __shfl_xor(send.y, 8)}; } }
    { const bool up = (lane & 4) != 0; const f32x2 keep = up ? r2[1] : r2[0], send = up ? r2[0] : r2[1]; r1 = keep + (f32x2){__shfl_xor(send.x, 4), __shfl_xor(send.y, 4)}; }
    const int p = ((lane >> 5) & 1) * 8 + ((lane >> 4) & 1) * 4 + ((lane >> 3) & 1) * 2 + ((lane >> 2) & 1);
    *(f32x2*)(out + tok * DM + slice * 128 + 16 * (lane & 3) + 2 * (p & 7) + 64 * (p >> 3)) = h + r1;
}
__device__ __forceinline__ void peer_up_phase(Frame& F, const PeerDeal& D, float* outp) {
    const __amdgpu_buffer_rsrc_t PU = __builtin_amdgcn_make_buffer_rsrc((void*)(F.ws + WS_PU), 0, 16384 * 1024, 0x00020000);
    const int* IDX = D.IDX; const float* COEF = D.COEF;
    int lane = F.lane; asm volatile("" : "+v"(lane));
    const int wave = F.wave;
    const int ntok = D.ntok;
    const int p = ((lane >> 5) & 1) * 8 + ((lane >> 4) & 1) * 4 + ((lane >> 3) & 1) * 2 + ((lane >> 2) & 1);
    const int hoff = 16 * (lane & 3) + 2 * (p & 7) + 64 * (p >> 3);
    int sl; size_t tk;
    u32x4 R0[16], R1[16];
    float ca0, ca1, cb0, cb1; f32x2 ha, hb;
    int id0, id1, jd0, jd1;
    { int s1_; size_t t1_; peer_item(0, D, wave, sl, tk); peer_item(1, D, wave, s1_, t1_);
      jd0 = IDX[tk * 128 + lane]; jd1 = IDX[tk * 128 + 64 + lane]; id0 = IDX[t1_ * 128 + lane]; id1 = IDX[t1_ * 128 + 64 + lane];
      __builtin_amdgcn_sched_barrier(0);
      peer_up_rows(R0, PU, sl, jd0, jd1, lane);
      ca0 = COEF[tk * 128 + lane]; ca1 = COEF[tk * 128 + 64 + lane]; { const unsigned hw_ = *(const unsigned*)((const bf16*)(F.ws + WS_H1B) + tk * DM + sl * 128 + hoff); ha = (f32x2){bflo(hw_), bfhi(hw_)}; }
      __builtin_amdgcn_sched_barrier(0); }
#pragma unroll 1
    for (int n = 0; n < ntok; n += 2) {
        int s0, s1, s2, s3; size_t t0, t1, t2, t3;
        peer_item(n, D, wave, s0, t0); peer_item(n + 1, D, wave, s1, t1);
        peer_item(n + 2 < ntok ? n + 2 : n, D, wave, s2, t2); peer_item(n + 3 < ntok ? n + 3 : n + 1, D, wave, s3, t3);
        jd0 = IDX[t2 * 128 + lane]; jd1 = IDX[t2 * 128 + 64 + lane];
        peer_up_rows(R1, PU, s1, id0, id1, lane);
        cb0 = COEF[t1 * 128 + lane]; cb1 = COEF[t1 * 128 + 64 + lane]; { const unsigned hw_ = *(const unsigned*)((const bf16*)(F.ws + WS_H1B) + t1 * DM + s1 * 128 + hoff); hb = (f32x2){bflo(hw_), bfhi(hw_)}; }
        __builtin_amdgcn_sched_barrier(0);
        peer_up_compute(R0, ca0, ca1, ha, outp, s0, t0, lane);
        __builtin_amdgcn_sched_barrier(0);
        id0 = IDX[t3 * 128 + lane]; id1 = IDX[t3 * 128 + 64 + lane];
        peer_up_rows(R0, PU, s2, jd0, jd1, lane);
        ca0 = COEF[t2 * 128 + lane]; ca1 = COEF[t2 * 128 + 64 + lane]; { const unsigned hw_ = *(const unsigned*)((const bf16*)(F.ws + WS_H1B) + t2 * DM + s2 * 128 + hoff); ha = (f32x2){bflo(hw_), bfhi(hw_)}; }
        __builtin_amdgcn_sched_barrier(0);
        peer_up_compute(R1, cb0, cb1, hb, outp, s1, t1, lane);
        __builtin_amdgcn_sched_barrier(0);
    }
}
__device__ __forceinline__ void peer_tile(Frame& F, int tile) {
    const size_t tok0 = (size_t)tile * 256;
    const bf16* Q = (const bf16*)(F.ws + WS_BIG);
    int* IDX = (int*)(F.ws + WS_BIG + 256 * MiB); float* GATE = (float*)(F.ws + WS_BIG + 288 * MiB); float* COEF = (float*)(F.ws + WS_BIG + 320 * MiB);
    peer_topk_tile(F, tok0, Q, IDX, GATE);
    VM_WAIT(); __syncthreads();
    PeerDeal D; D.tokw = tok0 + F.wave * 32; D.ntok = 256; D.tok0 = tok0; D.PART = (float*)(F.ws + WS_BIG + tok0 * (PEER_Q * 2)); D.IDX = IDX; D.GATE = GATE; D.COEF = COEF;
    peer_down_phase(F, D);
    VM_WAIT(); __syncthreads();
    peer_coef_wave(F, D);
    VM_WAIT(); __syncthreads();
    peer_up_phase(F, D, F.out);
}
__device__ __forceinline__ void peer_phase(Frame& F) { for (int tile = F.bid; tile < T / 256; tile += F.G) { peer_tile(F, tile); VM_WAIT(); __syncthreads(); } }

__device__ __forceinline__ void hn_panel_pass(Frame& F) {
    const f32x4* nwr = (const f32x4*)F.in[I_NFFNW] + F.lane;
    for (int p = F.bid; p < T / 256; p += F.G) {
#pragma unroll 1
        for (int r4 = 0; r4 < 8; ++r4) { const int row0 = p * 256 + F.wave * 32 + r4 * 4;
            f32x4 v[4][4];
#pragma unroll
            for (int r = 0; r < 4; ++r) { const u32x2* xr = (const u32x2*)((const bf16*)(F.ws + WS_H1B) + (size_t)(row0 + r) * DM) + F.lane;
#pragma unroll
                for (int j = 0; j < 4; ++j) { const u32x2 x = xr[64 * j]; v[r][j] = (f32x4){bflo(x.x), bfhi(x.x), bflo(x.y), bfhi(x.y)}; } }
#pragma unroll
            for (int r = 0; r < 4; ++r) { const int row = row0 + r; float s = 0.f;
#pragma unroll
                for (int j = 0; j < 4; ++j) s += (v[r][j].x * v[r][j].x + v[r][j].y * v[r][j].y) + (v[r][j].z * v[r][j].z + v[r][j].w * v[r][j].w);
                const float rstd = __builtin_amdgcn_rsqf(wave_sum(s) * (1.f / DM) + EPS);
                float am = 0.f;
#pragma unroll
                for (int j = 0; j < 4; ++j) { const f32x4 ww = nwr[64 * j]; v[r][j] = v[r][j] * rstd * ww;
                    am = fmaxf(fmaxf(am, fmaxf(fabsf(v[r][j].x), fabsf(v[r][j].y))), fmaxf(fabsf(v[r][j].z), fabsf(v[r][j].w))); }
                am = wave_max(am);
                const float inv = am > 0.f ? 127.0f / am : 0.f;
                unsigned* o8 = (unsigned*)(F.ws + WS_HN8F + (size_t)row * DM) + F.lane; unsigned* o4 = (unsigned*)(F.ws + WS_HN8 + (size_t)row * DM) + F.lane;
#pragma unroll
                for (int j = 0; j < 4; ++j) { o8[64 * j] = pk4f8(v[r][j].x, v[r][j].y, v[r][j].z, v[r][j].w);
                    o4[64 * j] = pk4_i8(v[r][j].x * inv, v[r][j].y * inv, v[r][j].z * inv, v[r][j].w * inv); }
                if (F.lane == 0) ((float*)(F.ws + WS_HNSC))[row] = am * (1.0f / 127.0f); } }
    }
}
constexpr int N_PHASES = 14;
__global__ void __launch_bounds__(NTHR, 2) mega_fwd(Args args) {
    extern __shared__ __attribute__((aligned(16))) unsigned char lds_raw[];
    Frame F;
    F.lds = (LAS unsigned char*)lds_raw;
    F.tid = threadIdx.x; F.lane = F.tid & 63; F.wave = __builtin_amdgcn_readfirstlane(F.tid >> 6);
    F.G = gridDim.x; F.bid = blockIdx.x;
    F.in = args.in;
    F.positions = args.positions; F.out = args.out; F.ws = args.ws;
    unsigned char* ws = args.ws;
    volatile LAS unsigned* ctlw = (volatile LAS unsigned*)(F.lds + LDSCTL_OFF);
    if (F.tid < 64) ctlw[F.tid] = 0u;
    __syncthreads();
    const int lo = args.ph_lo, hi = args.ph_hi;
    XcdBarrier bar; bar.bar = (unsigned*)(ws + WS_CTL); bar.x = 0; bar.st = nullptr; bar.wave = F.wave;
    if (hi - lo > 1) bar = xcd_barrier_post((unsigned*)(ws + WS_CTL), ctlw + 8, F.wave);
#define IN(k) (lo <= (k) && (k) < hi)
#define SEAM(k) do { if (IN(k) && IN((k) + 1)) xcd_barrier(bar); } while (0)
    bf16* ACT1 = (bf16*)(ws + WS_ACT1); bf16* BIG = (bf16*)(ws + WS_BIG); bf16* WallT = (bf16*)(ws + WS_WALLT);

    if (IN(0)) { frame_refresh(F); p0_prologue(F); __syncthreads(); }
    SEAM(0);
    if (IN(1)) { frame_refresh(F);
        p1_wquant(F); xcd_barrier(bar); frame_refresh(F);
        { pg8::Gemm g{(const bf16*)(ws + WS_MEMN), (const bf16*)(ws + WS_WMKVT), NB * NMEM, 768, DM, DM, DM}; pg8::StaticOrder S; S.init(g.M, g.N, F.G, F.bid);
          pg8::EpiBf16<0> E{(bf16*)(ws + WS_MKV), 1536}; pg8::gemm_phase(F.lds, g, S, E, F.wave); }
        { pg8::Gemm g{(const bf16*)(ws + WS_WMKVT) + (size_t)768 * DM, (const bf16*)(ws + WS_MEMN), 768, NB * NMEM, DM, DM, DM}; pg8::StaticOrder S; S.init(g.M, g.N, F.G, F.G - 1 - F.bid);
          pg8::EpiBf16<0> E{(bf16*)(ws + WS_MVT), NB * NMEM}; pg8::gemm_phase(F.lds, g, S, E, F.wave); }
        { pg8::Gemm g{(const bf16*)(ws + WS_U8), (const bf16*)(ws + WS_W8), HT, NPROJ, DM / 2, DM / 2, DM / 2}; pg8::StaticOrder S; S.init(g.M, g.N, F.G, F.bid);
          pg8::EpiBf16Q<0> E{BIG, NPROJ, (const float*)(ws + WS_USC), (const float*)(ws + WS_WSC)}; pg8::gemm_phase<2>(F.lds, g, S, E, F.wave); }
    }
    SEAM(1);
    if (IN(2)) { frame_refresh(F); mknorm_phase(F); ssdC_phase(F, 0); }
    SEAM(2);
    if (IN(3)) { frame_refresh(F); ssdD_phase(F); dilattn_mfma_phase(F, 0); memattn_mfma_phase(F, 0); }
    SEAM(3);
    if (IN(4)) { frame_refresh(F); ssdE_phase(F, 0); dilmerge_phase(F, 0); }
    SEAM(4);
    if (IN(5)) { frame_refresh(F); pg8::Gemm g{(const bf16*)(ws + WS_U8 + (size_t)HT * DM), (const bf16*)(ws + WS_W8), HT, NPROJ, DM / 2, DM / 2, DM / 2}; pg8::StaticOrder S; S.init(g.M, g.N, F.G, F.bid);
        pg8::EpiBf16Q<0> E{BIG, NPROJ, (const float*)(ws + WS_USC) + HT, (const float*)(ws + WS_WSC)}; pg8::gemm_phase<2>(F.lds, g, S, E, F.wave); }
    SEAM(5);
    if (IN(6)) { frame_refresh(F); ssdC_phase(F, 1); }
    SEAM(6);
    if (IN(7)) { frame_refresh(F); ssdD_phase(F); dilattn_mfma_phase(F, 1); memattn_mfma_phase(F, 1); }
    SEAM(7);
    if (IN(8)) { frame_refresh(F); ssdE_phase(F, 1); dilmerge_phase(F, 1); }
    SEAM(8);
    if (IN(9)) { frame_refresh(F);
        { pg8::Gemm g{(const bf16*)(ws + WS_U8), (const bf16*)(ws + WS_W8 + (size_t)NPROJ * DM), T, NGATE, DM / 2, DM / 2, DM / 2}; pg8::GateOrder S; S.B.init(T, DM, F.G, F.bid);
          pg8::EpiGateU8 E{ws + WS_BIG, NGATE, (const float*)(ws + WS_USC), (const float*)(ws + WS_WSC) + NPROJ}; pg8::gemm_phase<2>(F.lds, g, S, E, F.wave); }
        VM_WAIT(); __syncthreads();
    }
    if (IN(10)) { frame_refresh(F);
        pg8::Gemm g{(const bf16*)F.out, (const bf16*)(ws + WS_WCATT), T, DM, YC / 2, YC / 2, YC / 2}; pg8::StaticOrder S; S.init(g.M, g.N, F.G, F.bid);
        pg8::EpiBranchFused E{ACT1, DM, __builtin_amdgcn_make_buffer_rsrc((void*)BIG, 0, T * NGATE, 0x00020000), NGATE}; pg8::gemm_phase<1>(F.lds, g, S, E, F.wave);
    }
    SEAM(10);
    if (IN(11)) { frame_refresh(F); pg8::Gemm g{ACT1, (const bf16*)(ws + WS_WOUTT), T, DM, DM, DM, DM}; pg8::PanelOrder S; S.init(g.M, g.N, F.G, F.bid);
        pg8::EpiResidBf16 E{(bf16*)(ws + WS_H1B), DM, F.in[I_X]}; pg8::gemm_phase(F.lds, g, S, E, F.wave);
        frame_refresh(F); hn_panel_pass(F); }
    if (IN(11) && IN(12)) { VM_WAIT(); __syncthreads(); __builtin_amdgcn_fence(__ATOMIC_ACQUIRE, "agent"); }
    if (IN(12)) { frame_refresh(F); pg8::Gemm g{(const bf16*)(ws + WS_HN8), (const bf16*)(ws + WS_WQT), T, PEER_Q, DM / 2, DM / 2, DM / 2}; pg8::PanelOrder S; S.init(g.M, g.N, F.G, F.bid);
        pg8::EpiBf16Q<0> E{BIG, PEER_Q, (const float*)(ws + WS_HNSC), (const float*)(ws + WS_WSC) + 9216}; pg8::gemm_phase<2>(F.lds, g, S, E, F.wave); }
    SEAM(12);
    if (IN(13)) { frame_refresh(F); peer_phase(F); }
#undef IN
#undef SEAM
}

extern "C" void kernel_launch(void* const* d_in, const int* in_sizes, int n_in, void* d_out, int out_size, void* d_ws, size_t ws_size, hipStream_t stream) {
    static int grid = 0;
    if (grid == 0) {
        if (n_in != 26 || out_size != T * DM || ws_size < WS_END) { fprintf(stderr, "kernel_launch: unexpected shapes (n_in %d, out %d, ws %zu)\n", n_in, out_size, ws_size); grid = -1; return; }
        int dev = 0, cus = 0;
        if (hipGetDevice(&dev) != hipSuccess || hipDeviceGetAttribute(&cus, hipDeviceAttributeMultiprocessorCount, dev) != hipSuccess) { grid = -1; return; }
        if (hipFuncSetAttribute((const void*)mega_fwd, hipFuncAttributeMaxDynamicSharedMemorySize, LDS_BYTES) != hipSuccess) { grid = -1; return; }
        int per_cu = 0;
        (void)hipOccupancyMaxActiveBlocksPerMultiprocessor(&per_cu, (const void*)mega_fwd, NTHR, LDS_BYTES);
        (void)hipGetLastError();
        grid = cus;
    }
    if (grid < 0) return;
    (void)hipMemsetAsync((char*)d_ws + WS_CTL, 0, CTL_ZERO_BYTES, stream);
    Args a{};
    for (int i = 0; i < 26; ++i) a.in[i] = (const float*)d_in[i];
    a.positions = (const int*)d_in[2]; a.out = (float*)d_out; a.ws = (unsigned char*)d_ws;
#if MK_N_LAUNCHES == 1
    a.ph_lo = 0; a.ph_hi = N_PHASES;
    hipLaunchKernelGGL(mega_fwd, dim3(grid), dim3(NTHR), LDS_BYTES, stream, a);
#else
    for (int p = 0; p < N_PHASES; ++p) { a.ph_lo = p; a.ph_hi = p + 1; hipLaunchKernelGGL(mega_fwd, dim3(grid), dim3(NTHR), LDS_BYTES, stream, a); }
#endif
}
```

```cpp
#include <hip/hip_runtime.h>
#include <cstdio>
#include <cstdint>

#ifndef MK_N_LAUNCHES
#define MK_N_LAUNCHES 1
#endif

#define LAS __attribute__((address_space(3)))
#define GAS __attribute__((address_space(1)))
typedef unsigned short bf16;
typedef short bf16x8 __attribute__((ext_vector_type(8)));
typedef float f32x4 __attribute__((ext_vector_type(4)));
typedef float f32x2 __attribute__((ext_vector_type(2)));
typedef unsigned u32x4 __attribute__((ext_vector_type(4)));
typedef unsigned u32x2 __attribute__((ext_vector_type(2)));
typedef int i32x4 __attribute__((ext_vector_type(4)));
typedef int i32x8 __attribute__((ext_vector_type(8)));

constexpr int NB = 8, SEQ = 8192, DM = 1024, T = NB * SEQ;
constexpr int HB = 4, HT = HB * SEQ;
constexpr int NMEM = 256;
constexpr int NPROJ = 6144;
constexpr int PC_Z = 0, PC_X = 1024, PC_B = 2048, PC_C = 2560, PC_DQ = 3072, PC_DK = 3840, PC_DV = 4608, PC_MQ = 5376;
constexpr int W_IN_N = 9232, OFF_DT = 3072, OFF_AFTER_DT = 3088;
constexpr int NGATE = 3072;
constexpr int YC = 2048;
constexpr int PEER_H = 8, PEER_K = 16, PEER_NK = 128, PEER_Q = 2048;
constexpr float EPS = 1e-6f;

constexpr size_t MiB = 1u << 20;
constexpr size_t WS_CTL = 0, WS_WAMAX = 65536, CTL_ZERO_BYTES = 131072;
constexpr size_t WS_WALLT = 1 * MiB;
constexpr size_t WS_WMKVT = 19 * MiB;
constexpr size_t WS_WCATT = 22 * MiB;
constexpr size_t WS_WOUTT = 26 * MiB;
constexpr size_t WS_WQT = 28 * MiB;
constexpr size_t WS_SUBK = 32 * MiB;
constexpr size_t WS_PD = 33 * MiB;
constexpr size_t WS_PU = 65 * MiB;
constexpr size_t WS_DT = 97 * MiB;
constexpr size_t WS_MEMN = 101 * MiB;
constexpr size_t WS_MKV = 105 * MiB;
constexpr size_t WS_ACT1 = 112 * MiB;
constexpr size_t WS_BIG = 240 * MiB;
constexpr size_t WS_LSE = 624 * MiB;
constexpr size_t WS_MVT = 628 * MiB;
constexpr size_t WS_DEC = 631 * MiB;
constexpr size_t WS_SST = 632 * MiB;
constexpr size_t WS_SIN = 760 * MiB;
constexpr size_t WS_ROPE = 824 * MiB;
constexpr size_t WS_SSQ = 828 * MiB;
constexpr size_t WS_HB = 632 * MiB;
constexpr size_t WS_U8 = 832 * MiB;
constexpr size_t WS_W8 = WS_WALLT;
constexpr size_t WS_WSC = 896 * MiB;
constexpr size_t WS_USC = 897 * MiB;
constexpr size_t WS_HN8 = WS_U8;
constexpr size_t WS_HNSC = WS_USC;
constexpr size_t WS_H1B = WS_HB;
constexpr size_t WS_HN8F = WS_SIN;
constexpr size_t WS_END = 898 * MiB;

constexpr int RING_BYTES = 131072;
constexpr int LDSCTL_OFF = 143360;
constexpr int LDS_BYTES = 147456;
constexpr int NWAVES = 8, NTHR = 512;

__device__ __forceinline__ int lane_id() { return (int)__builtin_amdgcn_mbcnt_hi(~0u, __builtin_amdgcn_mbcnt_lo(~0u, 0u)); }
__device__ __forceinline__ float bf2f(unsigned short b) { return __builtin_bit_cast(float, (unsigned)b << 16); }
__device__ __forceinline__ float bflo(unsigned w) { return __builtin_bit_cast(float, w << 16); }
__device__ __forceinline__ float bfhi(unsigned w) { return __builtin_bit_cast(float, w & 0xffff0000u); }
__device__ __forceinline__ unsigned f2bf(float f) { unsigned u = __builtin_bit_cast(unsigned, f); return (u + 0x7fffu + ((u >> 16) & 1u)) >> 16; }
__device__ __forceinline__ unsigned pk2(float lo, float hi);
typedef float f32x16 __attribute__((ext_vector_type(16)));
typedef short s16x4 __attribute__((ext_vector_type(4)));
typedef __bf16 bf2_t __attribute__((ext_vector_type(2)));
__device__ __forceinline__ unsigned pkbf(float a, float b) { const f32x2 v = {a, b}; return __builtin_bit_cast(unsigned, __builtin_convertvector(v, bf2_t)); }
__device__ __forceinline__ unsigned pk2(float lo, float hi) { return pkbf(lo, hi); }
#define MFMA32(a, b, c) __builtin_amdgcn_mfma_f32_32x32x16_bf16((a), (b), (c), 0, 0, 0)
__device__ __forceinline__ float wave_sum(float v) {
#pragma unroll
    for (int o = 1; o < 64; o <<= 1) v += __shfl_xor(v, o);
    return v;
}
__device__ __forceinline__ float wave_max(float v) {
#pragma unroll
    for (int o = 1; o < 64; o <<= 1) v = fmaxf(v, __shfl_xor(v, o));
    return v;
}
__device__ __forceinline__ float sigmoidf_(float x) { return __builtin_amdgcn_rcpf(1.0f + __expf(-x)); }
#define LDS_WAIT() asm volatile("s_waitcnt lgkmcnt(0)" ::: "memory")
#define VM_WAIT() asm volatile("s_waitcnt vmcnt(0)" ::: "memory")

#define XB_TMO      128
#define XB_XCNT(j)  (256  + 64 * (j))
#define XB_XSUB(j)  (1280 + 64 * (j))
#define XB_XGEN(j)  (2304 + 64 * (j))
#define XB_TOP      3328
#define XB_TOPGEN   3392
#define XCD_BAR_WORDS 3456
#define XB_SPIN_CAP (1u << 18)
__device__ __forceinline__ unsigned xb_ld(unsigned* p)              { return __hip_atomic_load(p, __ATOMIC_RELAXED, __HIP_MEMORY_SCOPE_AGENT); }
__device__ __forceinline__ unsigned xb_add(unsigned* p, unsigned v) { return __hip_atomic_fetch_add(p, v, __ATOMIC_RELAXED, __HIP_MEMORY_SCOPE_AGENT); }
__device__ __forceinline__ unsigned xb_xcc_id() { return (unsigned)__builtin_amdgcn_s_getreg((3 << 11) | 20) & 0xFu; }
#define XB_SPIN(cond, bar) do { unsigned _sp = 0; while (cond) { __builtin_amdgcn_s_sleep(1); \
    if ((++_sp & 255u) == 0u) { if (xb_ld(&(bar)[XB_TMO])) break; if (_sp > XB_SPIN_CAP) { atomicAdd(&(bar)[XB_TMO], 1u); break; } } } } while (0)
struct XcdBarrier { unsigned* bar; unsigned x; volatile LAS unsigned* st; int wave; };
__device__ __forceinline__ XcdBarrier xcd_barrier_post(unsigned* bar, volatile LAS unsigned* st, int wave) {
    XcdBarrier b; b.bar = bar; b.x = xb_xcc_id(); b.st = st; b.wave = wave;
    if (wave == 0 && lane_id() == 0) (void)xb_add(&bar[XB_XCNT(b.x)], 1u);
    return b;
}
__device__ __forceinline__ void xcd_barrier_complete(unsigned* bar, unsigned x, unsigned& nloc, unsigned& nx) {
    const unsigned G = gridDim.x * gridDim.y * gridDim.z;
    unsigned sum, cnt, mine, sp = 0u;
    for (;;) {
        sum = 0u; cnt = 0u; mine = 0u;
#pragma unroll
        for (unsigned j = 0; j < 16; ++j) { const unsigned c = xb_ld(&bar[XB_XCNT(j)]); sum += c; cnt += (c > 0u) ? 1u : 0u; mine = (j == x) ? c : mine; }
        if (sum == G) break;
        __builtin_amdgcn_s_sleep(1);
        if ((++sp & 255u) == 0u) { if (xb_ld(&bar[XB_TMO])) break; if (sp > XB_SPIN_CAP) { atomicAdd(&bar[XB_TMO], 1u); break; } }
    }
    nloc = mine > 0u ? mine : 1u; nx = cnt > 0u ? cnt : 1u;
}
__device__ __forceinline__ void xcd_barrier(const XcdBarrier& b) {
    asm volatile("s_waitcnt vmcnt(0)" ::: "memory");
    __syncthreads();
    if (b.wave == 0 && lane_id() == 0) {
        unsigned* bar = b.bar;
        __builtin_amdgcn_s_waitcnt(0);
        unsigned nloc = b.st[0], nx = b.st[1];
        if (nloc == 0u) { xcd_barrier_complete(bar, b.x, nloc, nx); b.st[0] = nloc; b.st[1] = nx; }
        const unsigned old = xb_add(&bar[XB_XSUB(b.x)], 1u);
        const unsigned gen = old / nloc;
        if (old + 1u == (gen + 1u) * nloc) {
            __builtin_amdgcn_fence(__ATOMIC_RELEASE, "agent");
            asm volatile("s_waitcnt vmcnt(0)" ::: "memory");
            const unsigned og = xb_add(&bar[XB_TOP], 1u);
            const unsigned tg = og / nx;
            if (og + 1u == (tg + 1u) * nx) xb_add(&bar[XB_TOPGEN], 1u);
            else XB_SPIN(xb_ld(&bar[XB_TOPGEN]) == tg, bar);
            __builtin_amdgcn_fence(__ATOMIC_ACQUIRE, "agent");
            xb_add(&bar[XB_XGEN(b.x)], 1u);
            asm volatile("s_waitcnt vmcnt(0)" ::: "memory");
        } else {
            XB_SPIN(xb_ld(&bar[XB_XGEN(b.x)]) == gen, bar);
            __builtin_amdgcn_fence(__ATOMIC_ACQUIRE, "agent");
            asm volatile("s_waitcnt vmcnt(0)" ::: "memory");
        }
    }
    __syncthreads();
}

__device__ __forceinline__ unsigned pk4f8(float a, float b, float c, float d);
constexpr float WO_SCALE = 32.0f, M8_SCALE = 4.0f;
constexpr float WC_SCALE = 32.0f, YD_SCALE = 8.0f;
namespace pg8 {
constexpr int BM = 256, BK = 64, HALF = 128, HTB = HALF * BK * 2, STAGE_BYTES = 8 * HTB, NXCD = 8, WGM = 8;
__host__ __device__ __forceinline__ int lds_byte(int r, int c) { const int st = (r >> 4) * 2 + (c >> 5), rr = r & 15, cc = c & 31, ob = rr * 64 + cc * 2; return st * 1024 + (ob ^ (((ob >> 9) & 1) << 5)); }
__host__ __device__ __forceinline__ void stage_rc(int b, int& R, int& C) { const int st = b / 1024, sb = b % 1024, swz = sb ^ (((sb >> 9) & 1) << 5); R = (st >> 1) * 16 + swz / 64; C = (st & 1) * 32 + (swz % 64) / 2; }
__host__ __device__ __forceinline__ int perm32(int rho) { const int n = rho >> 4, i = rho & 15; return 8 * (i >> 2) + 4 * n + (i & 3); }
struct Unit { int pm, pn; };
struct Gemm { const bf16* A; const bf16* Bt; int M, N, K, lda, ldb; };
struct StaticOrder {
    int nM, nN, nwg, G, c;
    __host__ __device__ void init(int M, int N, int G_, int c_) { nM = M / BM; nN = N / BM; nwg = nM * nN; G = G_; c = c_; }
    __host__ __device__ bool next(int i, Unit& u) const {
        const long L = (long)i * G + c; if (L >= nwg) return false;
        int wgid = (int)L; { const int q = nwg / NXCD, r = nwg % NXCD, xcd = wgid % NXCD, off = wgid / NXCD; wgid = (xcd < r ? xcd * (q + 1) : r * (q + 1) + (xcd - r) * q) + off; }
        const int nig = WGM * nN, gid = wgid / nig, fm = gid * WGM, gsz = (nM - fm) < WGM ? (nM - fm) : WGM;
        u.pm = fm + ((wgid % nig) % gsz); u.pn = (wgid % nig) / gsz; return true;
    }
    __device__ __forceinline__ void a_ready(const Unit&) const {}
    __device__ __forceinline__ void done(const Unit&) const {}
};
struct PanelOrder {
    int nM, nN, G, c;
    __host__ __device__ void init(int M, int N, int G_, int c_) { nM = M / BM; nN = N / BM; G = G_; c = c_; }
    __device__ __forceinline__ bool next(int i, Unit& u) const { const int p = c + (i / nN) * G; if (p >= nM) return false; u.pm = p; u.pn = (i + (c >> 3)) % nN; return true; }
    __device__ __forceinline__ void a_ready(const Unit&) const {}
    __device__ __forceinline__ void done(const Unit&) const {}
};
struct GateOrder {
    StaticOrder B;
    __device__ __forceinline__ bool next(int i, Unit& u) const { Unit t; if (!B.next(i / 3, t)) return false; u.pm = t.pm; u.pn = t.pn + 4 * (i % 3); return true; }
    __device__ __forceinline__ void a_ready(const Unit&) const {}
    __device__ __forceinline__ void done(const Unit&) const {}
};
__device__ __forceinline__ unsigned cvt_pk_bf16(float lo, float hi) { return pkbf(lo, hi); }

constexpr float WG_SCALE = 32.0f;
template <int ACT> struct EpiBf16 {
    static constexpr bool PERM = true, AFTER_DRAIN = false, HAS_MID = false;
    bf16* O; int ldc;
    __device__ __forceinline__ void operator()(const f32x4 (&acc)[2][2][4][2], const Unit& u, int wr, int wc, int fr, int fq) const {
        const int row0 = u.pm * BM + wr * 64 + fr; const int col0 = u.pn * BM + wc * 32 + 8 * fq;
#pragma unroll
        for (int ai = 0; ai < 2; ++ai)
#pragma unroll
            for (int m = 0; m < 4; ++m) { bf16* rowp = O + (size_t)(row0 + ai * HALF + m * 16) * ldc + col0;
#pragma unroll
                for (int bj = 0; bj < 2; ++bj) { f32x4 v0 = acc[ai][bj][m][0], v1 = acc[ai][bj][m][1];
                    if (ACT == 1) {
#pragma unroll
                        for (int j = 0; j < 4; ++j) { v0[j] = sigmoidf_(v0[j]); v1[j] = sigmoidf_(v1[j]); } }
                    if (ACT == 2) {
#pragma unroll
                        for (int j = 0; j < 4; ++j) { v0[j] = sigmoidf_(v0[j] * (1.0f / WG_SCALE)); v1[j] = sigmoidf_(v1[j] * (1.0f / WG_SCALE)); } }
                    u32x4 w; w.x = cvt_pk_bf16(v0[0], v0[1]); w.y = cvt_pk_bf16(v0[2], v0[3]); w.z = cvt_pk_bf16(v1[0], v1[1]); w.w = cvt_pk_bf16(v1[2], v1[3]);
                    *(u32x4*)(rowp + bj * HALF) = w; } }
    }
};
__device__ __forceinline__ f32x4 i2f4(f32x4 a) { return __builtin_convertvector(__builtin_bit_cast(i32x4, a), f32x4); }
template <int ACT> struct EpiBf16Q {
    static constexpr bool PERM = true, AFTER_DRAIN = false, HAS_MID = false;
    bf16* O; int ldc; const float* sa; const float* sb;
    __device__ __forceinline__ void operator()(const f32x4 (&acc)[2][2][4][2], const Unit& u, int wr, int wc, int fr, int fq) const {
        const int row0 = u.pm * BM + wr * 64 + fr; const int col0 = u.pn * BM + wc * 32 + 8 * fq;
        f32x4 sbv[2][2];
#pragma unroll
        for (int bj = 0; bj < 2; ++bj)
#pragma unroll
            for (int n = 0; n < 2; ++n) sbv[bj][n] = *(const f32x4*)(sb + col0 + bj * HALF + 4 * n);
#pragma unroll
        for (int ai = 0; ai < 2; ++ai)
#pragma unroll
            for (int m = 0; m < 4; ++m) { const int row = row0 + ai * HALF + m * 16; const float sr = sa[row]; bf16* rowp = O + (size_t)row * ldc + col0;
#pragma unroll
                for (int bj = 0; bj < 2; ++bj) { f32x4 v0 = i2f4(acc[ai][bj][m][0]) * sr * sbv[bj][0], v1 = i2f4(acc[ai][bj][m][1]) * sr * sbv[bj][1];
                    if (ACT == 1) {
#pragma unroll
                        for (int j = 0; j < 4; ++j) { v0[j] = __builtin_amdgcn_rcpf(1.0f + __expf(-v0[j])); v1[j] = __builtin_amdgcn_rcpf(1.0f + __expf(-v1[j])); } }
                    u32x4 w; w.x = cvt_pk_bf16(v0[0], v0[1]); w.y = cvt_pk_bf16(v0[2], v0[3]); w.z = cvt_pk_bf16(v1[0], v1[1]); w.w = cvt_pk_bf16(v1[2], v1[3]);
                    *(u32x4*)(rowp + bj * HALF) = w; } }
    }
};
struct EpiGateU8 {
    static constexpr bool PERM = true, AFTER_DRAIN = false, HAS_MID = false;
    unsigned char* O; int ldc; const float* sa; const float* sb;
    __device__ __forceinline__ void operator()(const f32x4 (&acc)[2][2][4][2], const Unit& u, int wr, int wc, int fr, int fq) const {
        const int row0 = u.pm * BM + wr * 64 + fr; const int col0 = u.pn * BM + wc * 32 + 8 * fq;
        f32x4 sbv[2][2];
#pragma unroll
        for (int bj = 0; bj < 2; ++bj)
#pragma unroll
            for (int n = 0; n < 2; ++n) sbv[bj][n] = *(const f32x4*)(sb + col0 + bj * HALF + 4 * n);
#pragma unroll
        for (int ai = 0; ai < 2; ++ai)
#pragma unroll
            for (int m = 0; m < 4; ++m) { const int row = row0 + ai * HALF + m * 16; const float sr = sa[row]; unsigned char* rowp = O + (size_t)row * ldc + col0;
#pragma unroll
                for (int bj = 0; bj < 2; ++bj) { f32x4 v0 = i2f4(acc[ai][bj][m][0]) * sr * sbv[bj][0], v1 = i2f4(acc[ai][bj][m][1]) * sr * sbv[bj][1];
                    unsigned w0 = 0u, w1 = 0u;
#pragma unroll
                    for (int j = 0; j < 4; ++j) { const float g0 = fmaxf(__builtin_rintf(255.0f * __builtin_amdgcn_rcpf(1.0f + __expf(-v0[j]))), 1.0f), g1 = fmaxf(__builtin_rintf(255.0f * __builtin_amdgcn_rcpf(1.0f + __expf(-v1[j]))), 1.0f);
                        w0 = __builtin_amdgcn_cvt_pk_u8_f32(g0, j, w0); w1 = __builtin_amdgcn_cvt_pk_u8_f32(g1, j, w1); }
                    const u32x2 w = {w0, w1};
                    *(u32x2*)(rowp + bj * HALF) = w; } }
    }
};
struct EpiResid {
    static constexpr bool PERM = false, AFTER_DRAIN = false, HAS_MID = false;
    float* C; int ldc; const float* R;
    __device__ __forceinline__ void operator()(const f32x4 (&acc)[2][2][4][2], const Unit& u, int wr, int wc, int fr, int fq) const {
        const int row0 = u.pm * BM + wr * 64 + fr, col0 = u.pn * BM + wc * 32 + 4 * fq;
#pragma unroll
        for (int ai = 0; ai < 2; ++ai)
#pragma unroll
            for (int m = 0; m < 4; ++m) { const size_t off = (size_t)(row0 + ai * HALF + m * 16) * ldc + col0;
#pragma unroll
                for (int bj = 0; bj < 2; ++bj)
#pragma unroll
                    for (int n = 0; n < 2; ++n) { const f32x4 r = *(const f32x4*)(R + off + bj * HALF + n * 16); *(f32x4*)(C + off + bj * HALF + n * 16) = acc[ai][bj][m][n] + r; } }
    }
};

struct EpiResidNorm {
    static constexpr bool PERM = false, AFTER_DRAIN = false, HAS_MID = false;
    float* C; int ldc; const float* R; bf16* Hb; const float* w; float* SSQ;
    __device__ __forceinline__ void operator()(const f32x4 (&acc)[2][2][4][2], const Unit& u, int wr, int wc, int fr, int fq) const {
        const int row0 = u.pm * BM + wr * 64 + fr, col0 = u.pn * BM + wc * 32 + 4 * fq;
        f32x4 wv[2][2];
#pragma unroll
        for (int bj = 0; bj < 2; ++bj)
#pragma unroll
            for (int n = 0; n < 2; ++n) wv[bj][n] = *(const f32x4*)(w + col0 + bj * HALF + n * 16);
#pragma unroll
        for (int ai = 0; ai < 2; ++ai)
#pragma unroll
            for (int m = 0; m < 4; ++m) { const int row = row0 + ai * HALF + m * 16; const size_t off = (size_t)row * ldc + col0; float ss = 0.f;
#pragma unroll
                for (int bj = 0; bj < 2; ++bj)
#pragma unroll
                    for (int n = 0; n < 2; ++n) { const f32x4 h = acc[ai][bj][m][n] + *(const f32x4*)(R + off + bj * HALF + n * 16); *(f32x4*)(C + off + bj * HALF + n * 16) = h;
                        ss += (h.x * h.x + h.y * h.y) + (h.z * h.z + h.w * h.w);
                        const u32x2 hb2 = {cvt_pk_bf16(h.x * wv[bj][n].x, h.y * wv[bj][n].y), cvt_pk_bf16(h.z * wv[bj][n].z, h.w * wv[bj][n].w)}; *(u32x2*)(Hb + off + bj * HALF + n * 16) = hb2; }
                ss += __shfl_xor(ss, 16); ss += __shfl_xor(ss, 32);
                if (fq == 0) atomicAdd(SSQ + row, ss); }
    }
};
struct EpiBf16RowScale {
    static constexpr bool PERM = true, AFTER_DRAIN = false, HAS_MID = false;
    bf16* O; int ldc; const float* SSQ;
    __device__ __forceinline__ void operator()(const f32x4 (&acc)[2][2][4][2], const Unit& u, int wr, int wc, int fr, int fq) const {
        const int row0 = u.pm * BM + wr * 64 + fr; const int col0 = u.pn * BM + wc * 32 + 8 * fq;
#pragma unroll
        for (int ai = 0; ai < 2; ++ai)
#pragma unroll
            for (int m = 0; m < 4; ++m) { const int row = row0 + ai * HALF + m * 16; bf16* rowp = O + (size_t)row * ldc + col0; const float rs = __builtin_amdgcn_rsqf(SSQ[row] * (1.f / DM) + EPS);
#pragma unroll
                for (int bj = 0; bj < 2; ++bj) { const f32x4 v0 = acc[ai][bj][m][0] * rs, v1 = acc[ai][bj][m][1] * rs;
                    u32x4 w; w.x = cvt_pk_bf16(v0[0], v0[1]); w.y = cvt_pk_bf16(v0[2], v0[3]); w.z = cvt_pk_bf16(v1[0], v1[1]); w.w = cvt_pk_bf16(v1[2], v1[3]);
                    *(u32x4*)(rowp + bj * HALF) = w; } }
    }
};

struct EpiResidBf16 {
    static constexpr bool PERM = false, AFTER_DRAIN = false, HAS_MID = false;
    bf16* C; int ldc; const float* R; float sc;
    __device__ __forceinline__ void operator()(const f32x4 (&acc)[2][2][4][2], const Unit& u, int wr, int wc, int fr, int fq) const {
        const int row0 = u.pm * BM + wr * 64 + fr, col0 = u.pn * BM + wc * 32 + 4 * fq;
#pragma unroll
        for (int ai = 0; ai < 2; ++ai)
#pragma unroll
            for (int m = 0; m < 4; ++m) { const size_t off = (size_t)(row0 + ai * HALF + m * 16) * ldc + col0;
#pragma unroll
                for (int bj = 0; bj < 2; ++bj)
#pragma unroll
                    for (int n = 0; n < 2; ++n) { const f32x4 h = acc[ai][bj][m][n] * sc + *(const f32x4*)(R + off + bj * HALF + n * 16);
                        const u32x2 w = {cvt_pk_bf16(h.x, h.y), cvt_pk_bf16(h.z, h.w)}; *(u32x2*)(C + off + bj * HALF + n * 16) = w; } }
    }
};
__device__ __forceinline__ float u8f(unsigned w, int j) { return (float)((w >> (8 * j)) & 255u); }
struct EpiBranchFused {
    static constexpr bool PERM = true, AFTER_DRAIN = false, HAS_MID = true;
    static constexpr int MID0 = 8, MID1 = 10;
    unsigned char* O; int ldc; __amdgpu_buffer_rsrc_t grs; int ldg;
    __device__ __forceinline__ void mid(f32x4 (&acc)[2][2][4][2], const Unit& u, int t, int wr, int wc, int fr, int fq) const {
        const unsigned voff = (unsigned)((u.pm * BM + wr * 64 + fr) * ldg + u.pn * BM + wc * 32 + 8 * fq);
        const int ca = (t == MID0) ? 0 : 1024;
        const float fs = (t == MID0) ? YD_SCALE : 1.0f;
#pragma unroll
        for (int ai = 0; ai < 2; ++ai)
#pragma unroll
            for (int m = 0; m < 4; ++m) {
#pragma unroll
                for (int bj = 0; bj < 2; ++bj) { const int so = (ai * HALF + m * 16) * ldg + bj * HALF + ca;
                    const u32x2 ga = __builtin_amdgcn_raw_buffer_load_b64(grs, voff, so, 0), gb = __builtin_amdgcn_raw_buffer_load_b64(grs, voff, so + 1024, 0);
                    f32x4& v0 = acc[ai][bj][m][0]; f32x4& v1 = acc[ai][bj][m][1];
#pragma unroll
                    for (int j = 0; j < 4; ++j) { v0[j] *= (fs * u8f(ga.x, j)) * __builtin_amdgcn_rcpf(u8f(gb.x, j)); v1[j] *= (fs * u8f(ga.y, j)) * __builtin_amdgcn_rcpf(u8f(gb.y, j)); } }
                __builtin_amdgcn_sched_barrier(0); }
    }
    __device__ __forceinline__ void operator()(const f32x4 (&acc)[2][2][4][2], const Unit& u, int wr, int wc, int fr, int fq) const {
        const int row0 = u.pm * BM + wr * 64 + fr; const int col0 = u.pn * BM + wc * 32 + 8 * fq;
        const unsigned voff = (unsigned)(row0 * ldg + col0);
#pragma unroll
        for (int ai = 0; ai < 2; ++ai)
#pragma unroll
            for (int m = 0; m < 4; ++m) { const size_t r = (size_t)(row0 + ai * HALF + m * 16); unsigned char* rowp = O + r * ldc + col0;
#pragma unroll
                for (int bj = 0; bj < 2; ++bj) { constexpr float q = M8_SCALE / (WC_SCALE * YD_SCALE * 255.0f); const f32x4 v0 = acc[ai][bj][m][0] * q, v1 = acc[ai][bj][m][1] * q;
                    const u32x2 g = __builtin_amdgcn_raw_buffer_load_b64(grs, voff, (ai * HALF + m * 16) * ldg + bj * HALF + 2048, 0);
                    const u32x2 w = {pk4f8(v0[0] * u8f(g.x, 0), v0[1] * u8f(g.x, 1), v0[2] * u8f(g.x, 2), v0[3] * u8f(g.x, 3)), pk4f8(v1[0] * u8f(g.y, 0), v1[1] * u8f(g.y, 1), v1[2] * u8f(g.y, 2), v1[3] * u8f(g.y, 3))};
                    *(u32x2*)(rowp + bj * HALF) = w; } }
    }
};

template <int QM = 0, class Epi, class Sched>
__device__ __forceinline__ void gemm_phase(LAS unsigned char* lds, const Gemm g, const Sched& S, const Epi& E, int wid) {
    constexpr bool F8 = (QM == 1);
    int lane = lane_id(); asm volatile("" : "+v"(lane));
    const int tid = wid * 64 + lane, wr = wid >> 2, wc = wid & 3, fr = lane & 15, fq = lane >> 4;
    const int K = g.K, nt = K / BK;
    unsigned voffA[2], voffB[2];
#pragma unroll
    for (int i = 0; i < 2; ++i) { int R, C; stage_rc(tid * 16 + i * 8192, R, C); const int Rb = Epi::PERM ? ((R & ~31) + perm32(R & 31)) : R;
        voffA[i] = (unsigned)(R * g.lda + C) * 2u; voffB[i] = (unsigned)(Rb * g.ldb + C) * 2u; }
    const size_t kstep = (size_t)(BK * 2);
    const size_t hsA = (size_t)HALF * g.lda * 2, hsB = (size_t)HALF * g.ldb * 2;
    const size_t tsA = 2 * hsA, tsB = 2 * hsB;
    const unsigned ldsw = (unsigned)wid * 1024u;
    const int aoff = lds_byte(wr * 64 + fr, fq * 8), boff = lds_byte(wc * 32 + fr, fq * 8);
#define PG8_SA(b, h) (((b) * 2 + (h)) * HTB)
#define PG8_SB(b, h) ((4 + (b) * 2 + (h)) * HTB)
#define PG8_STAGE(bufoff, gbase, voff) do { _Pragma("unroll") for (int _i = 0; _i < 2; ++_i) \
        __builtin_amdgcn_global_load_lds((const unsigned*)((const char*)(gbase) + (voff)[_i]), (LAS unsigned*)(lds + (bufoff) + ldsw + _i * 8192), 16, 0, 0); } while (0)
#define PG8_LDA(dst, b, h) do { _Pragma("unroll") for (int m = 0; m < 4; ++m) _Pragma("unroll") for (int k = 0; k < 2; ++k) dst[m][k] = *(const LAS bf16x8*)(lds + PG8_SA(b, h) + aoff + m * 2048 + k * 1024); } while (0)
#define PG8_LDB(dst, b, h) do { _Pragma("unroll") for (int n = 0; n < 2; ++n) _Pragma("unroll") for (int k = 0; k < 2; ++k) dst[n][k] = *(const LAS bf16x8*)(lds + PG8_SB(b, h) + boff + n * 2048 + k * 1024); } while (0)
#define PG8_CAT(x, y) __builtin_shufflevector(__builtin_bit_cast(i32x4, x), __builtin_bit_cast(i32x4, y), 0, 1, 2, 3, 4, 5, 6, 7)
#define PG8_MMA(ai, bj, At, Bt) do { __builtin_amdgcn_s_setprio(1); _Pragma("unroll") for (int m = 0; m < 4; ++m) _Pragma("unroll") for (int n = 0; n < 2; ++n) { \
        if constexpr (F8) { asm volatile("v_mfma_f32_16x16x128_f8f6f4 %0, %1, %2, %0" : "+v"(acc[ai][bj][m][n]) : "v"(PG8_CAT(Bt[n][0], Bt[n][1])), "v"(PG8_CAT(At[m][0], At[m][1]))); } \
        else if constexpr (QM == 2) { _Pragma("unroll") for (int k = 0; k < 2; ++k) acc[ai][bj][m][n] = __builtin_bit_cast(f32x4, __builtin_amdgcn_mfma_i32_16x16x64_i8(__builtin_bit_cast(i32x4, Bt[n][k]), __builtin_bit_cast(i32x4, At[m][k]), __builtin_bit_cast(i32x4, acc[ai][bj][m][n]), 0, 0, 0)); } \
        else { _Pragma("unroll") for (int k = 0; k < 2; ++k) acc[ai][bj][m][n] = __builtin_amdgcn_mfma_f32_16x16x32_bf16(Bt[n][k], At[m][k], acc[ai][bj][m][n], 0, 0, 0); } } \
        __builtin_amdgcn_s_setprio(0); } while (0)
#define PG8_WAIT_V(n) asm volatile("s_waitcnt vmcnt(" #n ")" ::: "memory")
#define PG8_WAIT_L(n) asm volatile("s_waitcnt lgkmcnt(" #n ")" ::: "memory")
#define PG8_BAR __builtin_amdgcn_s_barrier()
#define PG8_SCHED __builtin_amdgcn_sched_barrier(0)
#define PG8_MFMA_SETTLE asm volatile("s_nop 15\n\ts_nop 15\n\ts_nop 7" ::: "memory")
    Unit cur, nxt; int ui = 0;
    if (!S.next(0, cur)) return;
    f32x4 acc[2][2][4][2];
#pragma unroll
    for (int a = 0; a < 2; ++a)
#pragma unroll
        for (int b = 0; b < 2; ++b)
#pragma unroll
            for (int m = 0; m < 4; ++m)
#pragma unroll
                for (int n = 0; n < 2; ++n) acc[a][b][m][n] = (f32x4){0.f, 0.f, 0.f, 0.f};
    bf16x8 At[4][2], B0[2][2], B1[2][2];
    const char* cA = (const char*)g.A + (size_t)cur.pm * tsA; const char* cB = (const char*)g.Bt + (size_t)cur.pn * tsB;
    S.a_ready(cur);
    PG8_STAGE(PG8_SB(0, 0), cB, voffB); PG8_STAGE(PG8_SB(0, 1), cB + hsB, voffB); PG8_STAGE(PG8_SA(0, 0), cA, voffA); PG8_STAGE(PG8_SA(0, 1), cA + hsA, voffA);
    if (wr == 1) PG8_BAR;
    PG8_WAIT_V(2); PG8_BAR;
    PG8_STAGE(PG8_SB(1, 0), cB + kstep, voffB); PG8_STAGE(PG8_SA(1, 0), cA + kstep, voffA); PG8_STAGE(PG8_SB(1, 1), cB + hsB + kstep, voffB);
    PG8_WAIT_V(6); PG8_BAR;
    for (;;) {
        const bool has_next = S.next(ui + 1, nxt);
        const char* nA = has_next ? (const char*)g.A + (size_t)nxt.pm * tsA : cA; const char* nB = has_next ? (const char*)g.Bt + (size_t)nxt.pn * tsB : cB;
#pragma clang loop unroll(disable)
        for (int t = 0; t < nt; t += 2) {
            const bool last = (t == nt - 2);
            const char* a1 = cA + (size_t)(t + 1) * kstep;
            const char* a2 = last ? nA : cA + (size_t)(t + 2) * kstep; const char* b2 = last ? nB : cB + (size_t)(t + 2) * kstep;
            const char* a3 = a2 + kstep; const char* b3 = b2 + kstep;
            if (last && has_next) S.a_ready(nxt);
            if constexpr (Epi::HAS_MID) { if (t == Epi::MID0 || t == Epi::MID1) { if constexpr (F8) PG8_MFMA_SETTLE; E.mid(acc, cur, t, wr, wc, fr, fq); } }
            PG8_LDB(B0, 0, 0); PG8_LDB(B1, 0, 1); PG8_SCHED; PG8_LDA(At, 0, 0); PG8_STAGE(PG8_SA(1, 1), a1 + hsA, voffA);
            PG8_WAIT_V(8); PG8_WAIT_L(0); PG8_BAR; PG8_MMA(0, 0, At, B0); PG8_MMA(0, 1, At, B1); PG8_BAR; PG8_SCHED;
            PG8_LDA(At, 0, 1); PG8_STAGE(PG8_SB(0, 0), b2, voffB); PG8_STAGE(PG8_SB(0, 1), b2 + hsB, voffB); PG8_STAGE(PG8_SA(0, 0), a2, voffA);
            PG8_WAIT_V(8); PG8_WAIT_L(0); PG8_BAR; PG8_MMA(1, 0, At, B0); PG8_MMA(1, 1, At, B1); PG8_BAR; PG8_SCHED;
            PG8_LDB(B0, 1, 0); PG8_LDB(B1, 1, 1); PG8_SCHED; PG8_LDA(At, 1, 0); PG8_STAGE(PG8_SA(0, 1), a2 + hsA, voffA);
            PG8_WAIT_V(8); PG8_WAIT_L(0); PG8_BAR; PG8_MMA(0, 0, At, B0); PG8_MMA(0, 1, At, B1); PG8_BAR; PG8_SCHED;
            PG8_LDA(At, 1, 1); PG8_STAGE(PG8_SB(1, 0), b3, voffB); PG8_STAGE(PG8_SB(1, 1), b3 + hsB, voffB); PG8_STAGE(PG8_SA(1, 0), a3, voffA);
            PG8_WAIT_V(8); PG8_WAIT_L(0); PG8_BAR; PG8_MMA(1, 0, At, B0); PG8_MMA(1, 1, At, B1); PG8_BAR; PG8_SCHED;
        }
        if constexpr (F8) PG8_MFMA_SETTLE;
        if (wr == 0) PG8_BAR;
        E(acc, cur, wr, wc, fr, fq); S.done(cur);
        if (!has_next) break;
#pragma unroll
        for (int a = 0; a < 2; ++a)
#pragma unroll
            for (int b = 0; b < 2; ++b)
#pragma unroll
                for (int m = 0; m < 4; ++m)
#pragma unroll
                    for (int n = 0; n < 2; ++n) acc[a][b][m][n] = (f32x4){0.f, 0.f, 0.f, 0.f};
        cur = nxt; cA = nA; cB = nB; ++ui;
        if (wr == 1) PG8_BAR;
    }
    PG8_WAIT_V(0);
    PG8_BAR;
#undef PG8_SA
#undef PG8_SB
#undef PG8_STAGE
#undef PG8_LDA
#undef PG8_LDB
#undef PG8_MMA
#undef PG8_CAT
#undef PG8_WAIT_V
#undef PG8_WAIT_L
#undef PG8_BAR
#undef PG8_SCHED
#undef PG8_MFMA_SETTLE
}
}

struct Args {
    const float* in[26]; const int* positions; float* out; unsigned char* ws; int ph_lo, ph_hi; int pad0, pad1;
};
struct Frame {
    LAS unsigned char* lds;
    int tid, lane, wave, G, bid;
    const float* const* in; const int* positions; float* out; unsigned char* ws;
};
__device__ __forceinline__ void frame_refresh(Frame& F) { int l = lane_id(); asm volatile("" : "+v"(l)); F.lane = l; F.tid = F.wave * 64 + l; }
enum { I_X = 0, I_MEM = 1, I_POS = 2, I_NMIXW = 3, I_WIN = 4, I_CONVW = 5, I_CONVB = 6, I_DTB = 7, I_ALOG = 8, I_SSDD = 9, I_SSDNW = 10, I_DQNW = 11, I_DKNW = 12, I_MEMNW = 13,
       I_WMKV = 14, I_MQNW = 15, I_MKNW = 16, I_WSSD = 17, I_WDIL = 18, I_WMEMBR = 19, I_WOUT = 20, I_NFFNW = 21, I_WQ = 22, I_SUBK = 23, I_PD = 24, I_PU = 25 };

constexpr float PD_SCALE = 64.0f, PU_SCALE = 8.0f;
__device__ __forceinline__ unsigned pk4f8(float a, float b, float c, float d) {
    a = fminf(fmaxf(a, -448.f), 448.f); b = fminf(fmaxf(b, -448.f), 448.f); c = fminf(fmaxf(c, -448.f), 448.f); d = fminf(fmaxf(d, -448.f), 448.f);
    unsigned p = __builtin_amdgcn_cvt_pk_fp8_f32(a, b, 0, false); return __builtin_amdgcn_cvt_pk_fp8_f32(c, d, p, true);
}
__device__ __forceinline__ unsigned pk4_fp8(f32x4 v, float sc) {
    const float a = fminf(fmaxf(v.x * sc, -448.f), 448.f), b = fminf(fmaxf(v.y * sc, -448.f), 448.f), c = fminf(fmaxf(v.z * sc, -448.f), 448.f), d = fminf(fmaxf(v.w * sc, -448.f), 448.f);
    unsigned p = __builtin_amdgcn_cvt_pk_fp8_f32(a, b, 0, false); return __builtin_amdgcn_cvt_pk_fp8_f32(c, d, p, true);
}
__device__ __forceinline__ void p0_transpose_item(const float* W, int ldw, int src_col0, bf16* WT, int ldt, int dst_row0, int dst_col0, int nblk, LAS float* scr, int item, int lane) {
    const int kb = item / nblk, nb = item % nblk, k0 = 64 * kb, n0 = 32 * nb;
#pragma unroll 8
    for (int i = 0; i < 32; ++i) { const int kk = 2 * i + (lane >> 5); scr[kk * 33 + (lane & 31)] = W[(size_t)(k0 + kk) * ldw + src_col0 + n0 + (lane & 31)]; }
    LDS_WAIT(); asm volatile("" ::: "memory");
    const int c = lane & 7;
#pragma unroll
    for (int j = 0; j < 4; ++j) { const int n = (lane >> 3) + 8 * j; const LAS float* s = scr + (8 * c) * 33 + n;
        u32x4 o; o.x = pk2(s[0 * 33], s[1 * 33]); o.y = pk2(s[2 * 33], s[3 * 33]); o.z = pk2(s[4 * 33], s[5 * 33]); o.w = pk2(s[6 * 33], s[7 * 33]);
        *(u32x4*)(WT + (size_t)(dst_row0 + n0 + n) * ldt + dst_col0 + k0 + 8 * c) = o; }
    LDS_WAIT(); asm volatile("" ::: "memory");
}
__device__ __forceinline__ void p0_transpose_item_fp8(const float* W, int ldw, int src_col0, unsigned char* WT8, int ldt, int dst_row0, int nblk, float sc, LAS float* scr, int item, int lane) {
    const int kb = item / nblk, nb = item % nblk, n0 = 32 * nb;
#pragma unroll 1
    for (int h = 0; h < 2; ++h) { const int k0 = 128 * kb + 64 * h;
#pragma unroll 8
        for (int i = 0; i < 32; ++i) { const int kk = 2 * i + (lane >> 5); scr[kk * 33 + (lane & 31)] = W[(size_t)(k0 + kk) * ldw + src_col0 + n0 + (lane & 31)]; }
        LDS_WAIT(); asm volatile("" ::: "memory");
        const int c = lane & 7;
#pragma unroll
        for (int j = 0; j < 4; ++j) { const int n = (lane >> 3) + 8 * j; const LAS float* s = scr + (8 * c) * 33 + n;
            const f32x4 a = {s[0 * 33], s[1 * 33], s[2 * 33], s[3 * 33]}, b = {s[4 * 33], s[5 * 33], s[6 * 33], s[7 * 33]};
            const u32x2 o = {pk4_fp8(a, sc), pk4_fp8(b, sc)};
            *(u32x2*)(WT8 + (size_t)(dst_row0 + n0 + n) * ldt + k0 + 8 * c) = o; }
        LDS_WAIT(); asm volatile("" ::: "memory"); }
}
__device__ __forceinline__ void p0_wamax_item(const float* W, int ldw, int src_col0, unsigned* AM, int dst_row0, int nblk, int item, int lane) {
    const int kb = item / nblk, nb = item % nblk, k0 = 64 * kb, n0 = 32 * nb;
    float am = 0.f;
#pragma unroll 8
    for (int i = 0; i < 32; ++i) { const int kk = 2 * i + (lane >> 5); am = fmaxf(am, fabsf(W[(size_t)(k0 + kk) * ldw + src_col0 + n0 + (lane & 31)])); }
    am = fmaxf(am, __shfl_xor(am, 32));
    if (lane < 32) atomicMax(AM + dst_row0 + n0 + lane, __float_as_uint(am));
}
__device__ __forceinline__ unsigned pk4_i8(float a, float b, float c, float d) {
    const int ia = (int)__builtin_rintf(a), ib = (int)__builtin_rintf(b), ic = (int)__builtin_rintf(c), id = (int)__builtin_rintf(d);
    return (unsigned)(ia & 255) | ((unsigned)(ib & 255) << 8) | ((unsigned)(ic & 255) << 16) | ((unsigned)id << 24);
}
__device__ __forceinline__ void p1_wquant_item(const float* W, int ldw, int src_col0, unsigned char* WT8, const unsigned* AM, float* SC, int dst_row0, int am_row0, int nblk, LAS float* scr, int item, int lane) {
    const int kb = item / nblk, nb = item % nblk, n0 = 32 * nb;
    const float am = __uint_as_float(AM[am_row0 + n0 + (lane & 31)]);
    const float inv = am > 0.f ? 127.0f / am : 0.f;
    if (kb == 0 && lane < 32) SC[am_row0 + n0 + lane] = am * (1.0f / 127.0f);
#pragma unroll 1
    for (int h = 0; h < 2; ++h) { const int k0 = 128 * kb + 64 * h;
#pragma unroll 8
        for (int i = 0; i < 32; ++i) { const int kk = 2 * i + (lane >> 5); scr[kk * 33 + (lane & 31)] = W[(size_t)(k0 + kk) * ldw + src_col0 + n0 + (lane & 31)] * inv; }
        LDS_WAIT(); asm volatile("" ::: "memory");
        const int c = lane & 7;
#pragma unroll
        for (int j = 0; j < 4; ++j) { const int n = (lane >> 3) + 8 * j; const LAS float* q = scr + (8 * c) * 33 + n;
            const u32x2 o = {pk4_i8(q[0 * 33], q[1 * 33], q[2 * 33], q[3 * 33]), pk4_i8(q[4 * 33], q[5 * 33], q[6 * 33], q[7 * 33])};
            *(u32x2*)(WT8 + (size_t)(dst_row0 + n0 + n) * 1024 + k0 + 8 * c) = o; }
        LDS_WAIT(); asm volatile("" ::: "memory"); }
}
__device__ __forceinline__ void rms_row_to_bf16(const float* xrow, const float* w, bf16* orow, int lane, f32x4 (&v)[4]) {
    const f32x4* xr = (const f32x4*)xrow + lane; const f32x4* wr = (const f32x4*)w + lane;
    float s = 0.f;
#pragma unroll
    for (int j = 0; j < 4; ++j) { v[j] = xr[64 * j]; s += (v[j].x * v[j].x + v[j].y * v[j].y) + (v[j].z * v[j].z + v[j].w * v[j].w); }
    const float rstd = __builtin_amdgcn_rsqf(wave_sum(s) * (1.f / DM) + EPS);
    unsigned long long* o8 = (unsigned long long*)orow + lane;
#pragma unroll
    for (int j = 0; j < 4; ++j) { const f32x4 ww = wr[64 * j]; v[j] = v[j] * rstd * ww;
        o8[64 * j] = (unsigned long long)pk2(v[j].x, v[j].y) | ((unsigned long long)pk2(v[j].z, v[j].w) << 32); }
}
__device__ __forceinline__ void rms_rows_finish(f32x4 (&v)[4], const float* w, unsigned char* orow8, float* osc, int lane) {
    const f32x4* wr = (const f32x4*)w + lane;
    float s = 0.f;
#pragma unroll
    for (int j = 0; j < 4; ++j) s += (v[j].x * v[j].x + v[j].y * v[j].y) + (v[j].z * v[j].z + v[j].w * v[j].w);
    const float rstd = __builtin_amdgcn_rsqf(wave_sum(s) * (1.f / DM) + EPS);
    float am = 0.f;
#pragma unroll
    for (int j = 0; j < 4; ++j) { const f32x4 ww = wr[64 * j]; v[j] = v[j] * rstd * ww; am = fmaxf(fmaxf(am, fmaxf(fabsf(v[j].x), fabsf(v[j].y))), fmaxf(fabsf(v[j].z), fabsf(v[j].w))); }
    am = wave_max(am);
    const float inv = am > 0.f ? 127.0f / am : 0.f;
    unsigned* o4 = (unsigned*)orow8 + lane;
#pragma unroll
    for (int j = 0; j < 4; ++j) o4[64 * j] = pk4_i8(v[j].x * inv, v[j].y * inv, v[j].z * inv, v[j].w * inv);
    if (lane == 0) *osc = am * (1.0f / 127.0f);
}
__device__ __forceinline__ void cvt_f32_bf16_stream(const float* src, bf16* dst, size_t n, size_t gtid, size_t gthreads) {
    for (size_t i = gtid * 8; i < n; i += gthreads * 8) { const f32x4 a = *(const f32x4*)(src + i), b = *(const f32x4*)(src + i + 4);
        u32x4 o; o.x = pk2(a.x, a.y); o.y = pk2(a.z, a.w); o.z = pk2(b.x, b.y); o.w = pk2(b.z, b.w); *(u32x4*)(dst + i) = o; }
}
__device__ __forceinline__ void cvt_f32_fp8_sliced(const float* src, unsigned char* dst, float sc, size_t gtid, size_t gthreads) {
    for (size_t i = gtid * 16; i < (size_t)16384 * 1024; i += gthreads * 16) { const f32x4 a = *(const f32x4*)(src + i), b = *(const f32x4*)(src + i + 4), c = *(const f32x4*)(src + i + 8), d = *(const f32x4*)(src + i + 12);
        const size_t e = i >> 10, dd = i & 1023;
        const u32x4 o = {pk4_fp8(a, sc), pk4_fp8(b, sc), pk4_fp8(c, sc), pk4_fp8(d, sc)}; *(u32x4*)(dst + ((((dd >> 7) * 16384 + e) << 7) + (dd & 127))) = o; }
}
__device__ __forceinline__ void p0_prologue(Frame& F) {
    LAS float* scr = (LAS float*)(F.lds + F.wave * 8448);
    LAS float* wdt = (LAS float*)(F.lds + 8 * 8448);
    const int gw = F.bid * NWAVES + F.wave, NGW = F.G * NWAVES;
    unsigned char* ws = F.ws;
    for (int i = F.tid; i < 1024 * 16; i += NTHR) { const int k = i >> 4, c = i & 15, l = (k & 255) >> 2, e = k & 3, j = k >> 8, q = c >> 2;
        wdt[((((j * 4 + e) * 4 + q) * 64 + l) << 2) + (c & 3)] = F.in[I_WIN][(size_t)k * W_IN_N + OFF_DT + c]; }
    __syncthreads();
    constexpr int IT_A = 16 * 96, IT_B = 16 * 192, IT_MKV = 16 * 48, IT_SSD = 8 * 32, IT_DIL = 2 * 32, IT_MBR = 6 * 32, IT_OUT = 8 * 32, IT_WQ = 16 * 64;
    constexpr int NITEMS = IT_A + IT_B + IT_MKV + IT_SSD + IT_DIL + IT_MBR + IT_OUT + IT_WQ;
    for (int it = gw; it < NITEMS; it += NGW) {
        int r = it;
        if (r < IT_A) { p0_wamax_item(F.in[I_WIN], W_IN_N, 0, (unsigned*)(ws + WS_WAMAX), 0, 96, r, F.lane); continue; } r -= IT_A;
        if (r < IT_B) { p0_wamax_item(F.in[I_WIN], W_IN_N, OFF_AFTER_DT, (unsigned*)(ws + WS_WAMAX), 3072, 192, r, F.lane); continue; } r -= IT_B;
        if (r < IT_MKV) { p0_transpose_item(F.in[I_WMKV], 1536, 0, (bf16*)(ws + WS_WMKVT), DM, 0, 0, 48, scr, r, F.lane); continue; } r -= IT_MKV;
        if (r < IT_SSD) { p0_transpose_item_fp8(F.in[I_WSSD], DM, 0, ws + WS_WCATT, YC, 0, 32, WC_SCALE, scr, r, F.lane); continue; } r -= IT_SSD;
        if (r < IT_DIL) { p0_transpose_item_fp8(F.in[I_WDIL], DM, 0, ws + WS_WCATT + 1024, YC, 0, 32, WC_SCALE, scr, r, F.lane); continue; } r -= IT_DIL;
        if (r < IT_MBR) { p0_transpose_item_fp8(F.in[I_WMEMBR], DM, 0, ws + WS_WCATT + 1280, YC, 0, 32, WC_SCALE, scr, r, F.lane); continue; } r -= IT_MBR;
        if (r < IT_OUT) { p0_transpose_item_fp8(F.in[I_WOUT], DM, 0, ws + WS_WOUTT, DM, 0, 32, WO_SCALE, scr, r, F.lane); continue; } r -= IT_OUT;
        p0_wamax_item(F.in[I_WQ], PEER_Q, 0, (unsigned*)(ws + WS_WAMAX), 9216, 64, r, F.lane);
    }
    const size_t gtid = (size_t)F.bid * NTHR + F.tid, gth = (size_t)F.G * NTHR;
    cvt_f32_bf16_stream(F.in[I_SUBK], (bf16*)(ws + WS_SUBK), (size_t)8 * 2 * 128 * 128, gtid, gth);
    cvt_f32_fp8_sliced(F.in[I_PD], ws + WS_PD, PD_SCALE, gtid, gth);
    cvt_f32_fp8_sliced(F.in[I_PU], ws + WS_PU, PU_SCALE, gtid, gth);
    for (int m = gw; m < NB * NMEM; m += NGW) { f32x4 v[4]; rms_row_to_bf16(F.in[I_MEM] + (size_t)m * DM, F.in[I_MEMNW], (bf16*)(ws + WS_MEMN) + (size_t)m * DM, F.lane, v); }
    { float* RT = (float*)(ws + WS_ROPE);
      for (size_t i = gtid; i < (size_t)T * 8; i += gth) { const int tok = (int)(i >> 3), a = (int)(i & 7);
          const float inv = __expf(-logf(500000.0f) * (2.0f / 16.0f) * (float)a);
          const double rev = (double)((float)F.positions[tok] * inv) * 0.15915494309189535; const float fr = (float)(rev - floor(rev));
          RT[(size_t)tok * 16 + a] = __builtin_amdgcn_cosf(fr); RT[(size_t)tok * 16 + 8 + a] = __builtin_amdgcn_sinf(fr); } }
    float* DTp = (float*)(ws + WS_DT);
    const int lane = F.lane;
    const int myj = ((lane >> 5) & 1) * 8 + ((lane >> 4) & 1) * 4 + ((lane >> 3) & 1) * 2 + ((lane >> 2) & 1);
    const float dtb = F.in[I_DTB][myj];
    f32x4 na[4], nb[4];
    { const int m0 = 2 * gw < T ? 2 * gw : 0; const f32x4* xa = (const f32x4*)(F.in[I_X] + (size_t)m0 * DM) + lane; const f32x4* xb = (const f32x4*)(F.in[I_X] + (size_t)(m0 + 1) * DM) + lane;
#pragma unroll
      for (int j = 0; j < 4; ++j) { na[j] = xa[64 * j]; nb[j] = xb[64 * j]; } }
    for (int m = 2 * gw; m < T; m += 2 * NGW) {
        f32x4 va[4], vb[4];
#pragma unroll
        for (int j = 0; j < 4; ++j) { va[j] = na[j]; vb[j] = nb[j]; }
        { const int mn = (m + 2 * NGW < T) ? m + 2 * NGW : m; const f32x4* xa = (const f32x4*)(F.in[I_X] + (size_t)mn * DM) + lane; const f32x4* xb = (const f32x4*)(F.in[I_X] + (size_t)(mn + 1) * DM) + lane;
#pragma unroll
          for (int j = 0; j < 4; ++j) { na[j] = xa[64 * j]; nb[j] = xb[64 * j]; } }
        rms_rows_finish(va, F.in[I_NMIXW], ws + WS_U8 + (size_t)m * DM, (float*)(ws + WS_USC) + m, lane);
        rms_rows_finish(vb, F.in[I_NMIXW], ws + WS_U8 + (size_t)(m + 1) * DM, (float*)(ws + WS_USC) + m + 1, lane);
        float da[16], db[16];
#pragma unroll
        for (int j = 0; j < 16; ++j) { da[j] = 0.f; db[j] = 0.f; }
#pragma unroll
        for (int j = 0; j < 4; ++j)
#pragma unroll
            for (int e = 0; e < 4; ++e) { const float ua = va[j][e], ub = vb[j][e];
#pragma unroll
                for (int q = 0; q < 4; ++q) { const f32x4 w4 = *(const LAS f32x4*)(wdt + ((((j * 4 + e) * 4 + q) * 64 + lane) << 2));
                    da[4 * q + 0] += ua * w4.x; da[4 * q + 1] += ua * w4.y; da[4 * q + 2] += ua * w4.z; da[4 * q + 3] += ua * w4.w;
                    db[4 * q + 0] += ub * w4.x; db[4 * q + 1] += ub * w4.y; db[4 * q + 2] += ub * w4.z; db[4 * q + 3] += ub * w4.w; }
                __builtin_amdgcn_sched_barrier(0); }
        float ra, rb;
        { float r8a[8], r8b[8], r4a[4], r4b[4], r2a[2], r2b[2];
          { const bool up = (lane & 32) != 0;
#pragma unroll
            for (int k = 0; k < 8; ++k) { r8a[k] = (up ? da[k + 8] : da[k]) + __shfl_xor(up ? da[k] : da[k + 8], 32); r8b[k] = (up ? db[k + 8] : db[k]) + __shfl_xor(up ? db[k] : db[k + 8], 32); } }
          { const bool up = (lane & 16) != 0;
#pragma unroll
            for (int k = 0; k < 4; ++k) { r4a[k] = (up ? r8a[k + 4] : r8a[k]) + __shfl_xor(up ? r8a[k] : r8a[k + 4], 16); r4b[k] = (up ? r8b[k + 4] : r8b[k]) + __shfl_xor(up ? r8b[k] : r8b[k + 4], 16); } }
          { const bool up = (lane & 8) != 0;
#pragma unroll
            for (int k = 0; k < 2; ++k) { r2a[k] = (up ? r4a[k + 2] : r4a[k]) + __shfl_xor(up ? r4a[k] : r4a[k + 2], 8); r2b[k] = (up ? r4b[k + 2] : r4b[k]) + __shfl_xor(up ? r4b[k] : r4b[k + 2], 8); } }
          { const bool up = (lane & 4) != 0; ra = (up ? r2a[1] : r2a[0]) + __shfl_xor(up ? r2a[0] : r2a[1], 4); rb = (up ? r2b[1] : r2b[0]) + __shfl_xor(up ? r2b[0] : r2b[1], 4); }
          ra += __shfl_xor(ra, 2); ra += __shfl_xor(ra, 1); rb += __shfl_xor(rb, 2); rb += __shfl_xor(rb, 1); }
        if ((lane & 3) == 0) { const float xa = ra + dtb, xb = rb + dtb;
            DTp[(size_t)m * 16 + myj] = (xa > 20.f) ? xa : log1pf(__expf(xa)); DTp[(size_t)(m + 1) * 16 + myj] = (xb > 20.f) ? xb : log1pf(__expf(xb)); }
    }
}

__device__ __forceinline__ void p1_wquant(Frame& F) {
    LAS float* scr = (LAS float*)(F.lds + F.wave * 8448);
    const int gw = F.bid * NWAVES + F.wave, NGW = F.G * NWAVES;
    unsigned char* ws = F.ws;
    constexpr int QA = 8 * 96, QB = 8 * 192, QQ = 8 * 64;
    for (int it = gw; it < QA + QB + QQ; it += NGW) {
        if (it < QA) p1_wquant_item(F.in[I_WIN], W_IN_N, 0, ws + WS_W8, (const unsigned*)(ws + WS_WAMAX), (float*)(ws + WS_WSC), 0, 0, 96, scr, it, F.lane);
        else if (it < QA + QB) p1_wquant_item(F.in[I_WIN], W_IN_N, OFF_AFTER_DT, ws + WS_W8, (const unsigned*)(ws + WS_WAMAX), (float*)(ws + WS_WSC), 3072, 3072, 192, scr, it - QA, F.lane);
        else p1_wquant_item(F.in[I_WQ], PEER_Q, 0, ws + WS_WQT, (const unsigned*)(ws + WS_WAMAX), (float*)(ws + WS_WSC), 0, 9216, 64, scr, it - QA - QB, F.lane);
    }
}

__device__ __forceinline__ void norm192_inplace(bf16* p, const float (&w)[4], int lane) {
    u32x2 v = {0u, 0u};
    if (lane < 48) v = *(const u32x2*)(p + 4 * lane);
    float x0 = bflo(v.x), x1 = bfhi(v.x), x2 = bflo(v.y), x3 = bfhi(v.y);
    const float ss = wave_sum((x0 * x0 + x1 * x1) + (x2 * x2 + x3 * x3));
    const float rs = __builtin_amdgcn_rsqf(ss * (1.f / 192.f) + EPS);
    if (lane < 48) { const u32x2 o = {pkbf(x0 * rs * w[0], x1 * rs * w[1]), pkbf(x2 * rs * w[2], x3 * rs * w[3])}; *(u32x2*)(p + 4 * lane) = o; }
}
__device__ __forceinline__ void mknorm_phase(Frame& F) {
    const int gw = F.bid * NWAVES + F.wave, NGW = F.G * NWAVES, lane = F.lane;
    float wmk[4];
#pragma unroll
    for (int j = 0; j < 4; ++j) wmk[j] = F.in[I_MKNW][(4 * lane + j) % 192];
    bf16* MK = (bf16*)(F.ws + WS_MKV);
    for (int r = gw; r < NB * NMEM * 4; r += NGW) norm192_inplace(MK + (size_t)(r >> 2) * 1536 + (r & 3) * 192, wmk, lane);
}

constexpr int SC_ST = 272, SX_ST = 528;
__device__ __forceinline__ float bfsel(const u32x4& v, int j) { const unsigned w = v[j >> 1]; return (j & 1) ? bfhi(w) : bflo(w); }
__device__ __forceinline__ void conv_task(const bf16* P, size_t rowb, int t0, int pcol, const float* cw, const float* cb, int ccol, LAS unsigned char* dst, int stride, const LAS float* scale) {
    float w[4][8], bs[8];
#pragma unroll
    for (int k = 0; k < 4; ++k) { const f32x4 a = *(const f32x4*)(cw + k * 2048 + ccol), b = *(const f32x4*)(cw + k * 2048 + ccol + 4);
        w[k][0] = a.x; w[k][1] = a.y; w[k][2] = a.z; w[k][3] = a.w; w[k][4] = b.x; w[k][5] = b.y; w[k][6] = b.z; w[k][7] = b.w; }
    { const f32x4 a = *(const f32x4*)(cb + ccol), b = *(const f32x4*)(cb + ccol + 4); bs[0] = a.x; bs[1] = a.y; bs[2] = a.z; bs[3] = a.w; bs[4] = b.x; bs[5] = b.y; bs[6] = b.z; bs[7] = b.w; }
    const bf16* src = P + (rowb + t0) * NPROJ + pcol;
    u32x4 rw[19];
#pragma unroll
    for (int i = 0; i < 3; ++i) rw[i] = (u32x4){0u, 0u, 0u, 0u};
    if (t0 > 0) {
#pragma unroll
        for (int i = 0; i < 3; ++i) rw[i] = *(const u32x4*)(src + (ptrdiff_t)(i - 3) * NPROJ); }
#pragma unroll
    for (int i = 0; i < 16; ++i) rw[3 + i] = *(const u32x4*)(src + (size_t)i * NPROJ);
#pragma unroll
    for (int i = 0; i < 16; ++i) {
        float o[8];
#pragma unroll
        for (int j = 0; j < 8; ++j) { float a = bs[j] + w[0][j] * bfsel(rw[i], j) + w[1][j] * bfsel(rw[i + 1], j) + w[2][j] * bfsel(rw[i + 2], j) + w[3][j] * bfsel(rw[i + 3], j); o[j] = a * sigmoidf_(a); }
        if (scale) { const float sv = scale[i];
#pragma unroll
            for (int j = 0; j < 8; ++j) o[j] *= sv; }
        const u32x4 r = {pkbf(o[0], o[1]), pkbf(o[2], o[3]), pkbf(o[4], o[5]), pkbf(o[6], o[7])};
        *(LAS u32x4*)(dst + i * stride) = r;
    }
}
__device__ __forceinline__ float ssd_scan(Frame& F, const float* DTp, size_t tok0, int g, LAS float* sAc, LAS float* sDt) {
    float total = 0.f;
    if (F.wave < 4) {
        const int head = 4 * g + F.wave, lane = F.lane;
        const float A = -__expf(F.in[I_ALOG][head]);
        const float d0 = DTp[(tok0 + 2 * lane) * 16 + head], d1 = DTp[(tok0 + 2 * lane + 1) * 16 + head];
        const float a0 = d0 * A, a1 = d1 * A;
        float sc = a0 + a1;
#pragma unroll
        for (int o = 1; o < 64; o <<= 1) { const float v = __shfl_up(sc, o); if (lane >= o) sc += v; }
        sAc[F.wave * 128 + 2 * lane] = sc - a1; sAc[F.wave * 128 + 2 * lane + 1] = sc;
        sDt[F.wave * 128 + 2 * lane] = d0; sDt[F.wave * 128 + 2 * lane + 1] = d1;
        total = __shfl(sc, 63);
    }
    return total;
}
__device__ __forceinline__ bf16x8 tr_pair(unsigned a_lo, unsigned a_hi) {
    s16x4 lo, hi;
    asm volatile("ds_read_b64_tr_b16 %0, %2\n\tds_read_b64_tr_b16 %1, %3\n\ts_waitcnt lgkmcnt(0)" : "=&v"(lo), "=&v"(hi) : "v"(a_lo), "v"(a_hi) : "memory");
    const bf16x8 r = {lo[0], lo[1], lo[2], lo[3], hi[0], hi[1], hi[2], hi[3]}; return r;
}

__device__ __forceinline__ void ssdC_phase(Frame& F, int half) {
    const bf16* P = (const bf16*)(F.ws + WS_BIG);
    const float* DTp = (const float*)(F.ws + WS_DT);
    bf16* SST = (bf16*)(F.ws + WS_SST); float* DEC = (float*)(F.ws + WS_DEC);
    LAS unsigned char* sX = F.lds; LAS unsigned char* sB = F.lds + 128 * SX_ST;
    LAS float* sAc = (LAS float*)(F.lds + 128 * SX_ST + 128 * SC_ST); LAS float* sDt = sAc + 512; LAS float* sW = sDt + 512;
    const int wave = F.wave;
    for (int unit = F.bid; unit < HB * 64 * 4; unit += F.G) {
        int tid = F.tid; asm volatile("" : "+v"(tid));
        const int lane = tid & 63, ql = lane & 31, h = lane >> 5, tq = (lane & 15) >> 2, tp = lane & 3, tblk = (lane >> 4) & 1;
        const int bl = unit >> 8, c = (unit >> 2) & 63, g = unit & 3;
        const size_t rowb = (size_t)bl * SEQ, tok0 = (size_t)half * HT + rowb + c * 128;
        __syncthreads();
        const float total = ssd_scan(F, DTp, tok0, g, sAc, sDt);
        if (wave < 4) { sW[wave * 128 + 2 * lane] = __expf(total - sAc[wave * 128 + 2 * lane]) * sDt[wave * 128 + 2 * lane];
            sW[wave * 128 + 2 * lane + 1] = __expf(total - sAc[wave * 128 + 2 * lane + 1]) * sDt[wave * 128 + 2 * lane + 1];
            if (lane == 0) DEC[((size_t)bl * 64 + c) * 16 + 4 * g + wave] = __expf(total); }
        __syncthreads();
        if (tid < 384) {
            int ch, strip, ccol, stride; LAS unsigned char* dst; const LAS float* scl = nullptr;
            if (tid < 256) { ch = tid & 31; strip = tid >> 5; ccol = g * 256 + 8 * ch; stride = SX_ST; dst = sX + (strip * 16) * SX_ST + ch * 16; scl = sW + (ch >> 3) * 128 + strip * 16; }
            else { const int u = tid - 256; ch = u & 15; strip = u >> 4; ccol = 1024 + g * 128 + 8 * ch; stride = SC_ST; dst = sB + (strip * 16) * SC_ST + ch * 16; }
            conv_task(P, rowb, c * 128 + strip * 16, PC_X + ccol, F.in[I_CONVW], F.in[I_CONVB], ccol, dst, stride, scl);
        }
        __syncthreads();
        const int r = wave >> 1, pt = wave & 1;
        f32x16 acc[4];
#pragma unroll
        for (int nt = 0; nt < 4; ++nt)
#pragma unroll
            for (int e = 0; e < 16; ++e) acc[nt][e] = 0.f;
        const unsigned xa = (unsigned)(size_t)sX + (unsigned)((8 * h + tq) * SX_ST + (r * 64 + 32 * pt + 16 * tblk + 4 * tp) * 2);
        const unsigned ba = (unsigned)(size_t)sB + (unsigned)((8 * h + tq) * SC_ST + (16 * tblk + 4 * tp) * 2);
#pragma unroll
        for (int ks = 0; ks < 8; ++ks) {
            const bf16x8 af = tr_pair(xa + ks * 16 * SX_ST, xa + ks * 16 * SX_ST + 4 * SX_ST);
            bf16x8 bfr[4];
#pragma unroll
            for (int nt = 0; nt < 4; ++nt) bfr[nt] = tr_pair(ba + ks * 16 * SC_ST + nt * 64, ba + ks * 16 * SC_ST + 4 * SC_ST + nt * 64);
            __builtin_amdgcn_sched_barrier(0);
#pragma unroll
            for (int nt = 0; nt < 4; ++nt) acc[nt] = MFMA32(af, bfr[nt], acc[nt]);
        }
        bf16* out = SST + (((size_t)bl * 64 + c) * 16 + 4 * g + r) * 8192;
#pragma unroll
        for (int nt = 0; nt < 4; ++nt)
#pragma unroll
            for (int e = 0; e < 16; ++e) out[(32 * pt + (e & 3) + 8 * (e >> 2) + 4 * h) * 128 + 32 * nt + ql] = (bf16)(pkbf(acc[nt][e], 0.f) & 0xffffu);
    }
}

__device__ __forceinline__ void ssdD_phase(Frame& F) {
    const bf16* SST = (const bf16*)(F.ws + WS_SST); const float* DEC = (const float*)(F.ws + WS_DEC);
    bf16* SIN = (bf16*)(F.ws + WS_SIN);
    const size_t gtid = (size_t)F.bid * NTHR + F.tid, gth = (size_t)F.G * NTHR;
    for (size_t it = gtid; it < (size_t)HB * 16 * 2048; it += gth) {
        const int bl = (int)(it >> 15), head = (int)(it >> 11) & 15, e4 = (int)(it & 2047) * 4;
        f32x4 st = {0.f, 0.f, 0.f, 0.f};
#pragma unroll 8
        for (int c = 0; c < 64; ++c) {
            const size_t idx = (((size_t)bl * 64 + c) * 16 + head);
            const u32x2 o = {pkbf(st.x, st.y), pkbf(st.z, st.w)};
            *(u32x2*)(SIN + idx * 8192 + e4) = o;
            const u32x2 sw = *(const u32x2*)(SST + idx * 8192 + e4); const f32x4 sl = {bflo(sw.x), bfhi(sw.x), bflo(sw.y), bfhi(sw.y)}; const float d = DEC[idx];
            st = st * d + sl;
        }
    }
}

__device__ __forceinline__ void ssdE_phase(Frame& F, int half) {
    const bf16* P = (const bf16*)(F.ws + WS_BIG);
    const float* DTp = (const float*)(F.ws + WS_DT);
    const bf16* SIN = (const bf16*)(F.ws + WS_SIN);
    bf16* Y = (bf16*)F.out;
    LAS unsigned char* sX = F.lds; LAS unsigned char* sB = F.lds + 128 * SX_ST; LAS unsigned char* sC = sB + 128 * SC_ST;
    LAS float* sAc = (LAS float*)(sC + 128 * SC_ST); LAS float* sDt = sAc + 512; LAS float* sSS = sDt + 512;
    const int wave = F.wave;
    const int st = wave & 3, hp = wave >> 2;
    for (int unit = F.bid; unit < HB * 64 * 4; unit += F.G) {
        int tid = F.tid; asm volatile("" : "+v"(tid));
        const int lane = tid & 63, ql = lane & 31, h = lane >> 5, tq = (lane & 15) >> 2, tp = lane & 3, tblk = (lane >> 4) & 1;
        const int bl = unit >> 8, c = (unit >> 2) & 63, g = unit & 3;
        const size_t rowb = (size_t)bl * SEQ, tok0 = (size_t)half * HT + rowb + c * 128;
        __syncthreads();
        (void)ssd_scan(F, DTp, tok0, g, sAc, sDt);
        if (tid < 128) sSS[tid] = 0.f;
        {
            int ch, strip, ccol, stride; LAS unsigned char* dst;
            if (tid < 256) { ch = tid & 31; strip = tid >> 5; ccol = g * 256 + 8 * ch; stride = SX_ST; dst = sX + (strip * 16) * SX_ST + ch * 16; }
            else if (tid < 384) { const int u = tid - 256; ch = u & 15; strip = u >> 4; ccol = 1024 + g * 128 + 8 * ch; stride = SC_ST; dst = sB + (strip * 16) * SC_ST + ch * 16; }
            else { const int u = tid - 384; ch = u & 15; strip = u >> 4; ccol = 1536 + g * 128 + 8 * ch; stride = SC_ST; dst = sC + (strip * 16) * SC_ST + ch * 16; }
            conv_task(P, rowb, c * 128 + strip * 16, PC_X + ccol, F.in[I_CONVW], F.in[I_CONVB], ccol, dst, stride, nullptr);
        }
        __syncthreads();
        const int s = 32 * st + ql;
        unsigned yk[2][2][8];
        float ssq = 0.f;
        const unsigned xa = (unsigned)(size_t)sX + (unsigned)((4 * h + tq) * SX_ST + (16 * tblk + 4 * tp) * 2);
#pragma unroll
        for (int hq = 0; hq < 2; ++hq) {
            const int r = 2 * hp + hq, head = 4 * g + r;
            const float acs = sAc[r * 128 + s];
            const bf16* stp = SIN + (((size_t)bl * 64 + c) * 16 + head) * 8192 + ql * 128 + 8 * h;
            bf16x8 sfr[2][8];
#pragma unroll
            for (int pt = 0; pt < 2; ++pt)
#pragma unroll
                for (int ks = 0; ks < 8; ++ks) sfr[pt][ks] = *(const bf16x8*)(stp + pt * 4096 + 16 * ks);
            bf16x8 pf[4][2];
#pragma unroll
            for (int i = 0; i < 4; ++i) {
                f32x16 Xi;
#pragma unroll
                for (int e = 0; e < 16; ++e) Xi[e] = 0.f;
#pragma unroll
                for (int ks = 0; ks < 8; ++ks) { const bf16x8 bf_ = *(const LAS bf16x8*)(sB + (32 * i + ql) * SC_ST + 32 * ks + 16 * h);
                    const bf16x8 cf = *(const LAS bf16x8*)(sC + s * SC_ST + 32 * ks + 16 * h); Xi = MFMA32(bf_, cf, Xi); }
                float p[16];
#pragma unroll
                for (int q4 = 0; q4 < 4; ++q4) { const int t0 = 32 * i + 8 * q4 + 4 * h;
                    const f32x4 at = *(const LAS f32x4*)(sAc + r * 128 + t0), dt4 = *(const LAS f32x4*)(sDt + r * 128 + t0);
#pragma unroll
                    for (int e = 0; e < 4; ++e) { const int t = t0 + e; p[4 * q4 + e] = (t <= s) ? Xi[4 * q4 + e] * __expf(acs - at[e]) * dt4[e] : 0.f; } }
#pragma unroll
                for (int s2 = 0; s2 < 2; ++s2) { const u32x4 w = {pkbf(p[8 * s2 + 0], p[8 * s2 + 1]), pkbf(p[8 * s2 + 2], p[8 * s2 + 3]), pkbf(p[8 * s2 + 4], p[8 * s2 + 5]), pkbf(p[8 * s2 + 6], p[8 * s2 + 7])};
                    pf[i][s2] = __builtin_bit_cast(bf16x8, w); }
            }
            const float eacs = __expf(acs), Dh = F.in[I_SSDD][head];
#pragma unroll
            for (int pt = 0; pt < 2; ++pt) {
                f32x16 yd, yo;
#pragma unroll
                for (int e = 0; e < 16; ++e) { yd[e] = 0.f; yo[e] = 0.f; }
#pragma unroll
                for (int i = 0; i < 4; ++i) {
#pragma unroll
                    for (int s2 = 0; s2 < 2; ++s2) { const unsigned a = xa + (unsigned)((32 * i + 16 * s2) * SX_ST + (r * 64 + 32 * pt) * 2);
                        const bf16x8 xf = tr_pair(a, a + 8 * SX_ST); __builtin_amdgcn_sched_barrier(0); yd = MFMA32(xf, pf[i][s2], yd); }
                }
#pragma unroll
                for (int ks = 0; ks < 8; ++ks) { const bf16x8 cf = *(const LAS bf16x8*)(sC + s * SC_ST + 32 * ks + 16 * h); yo = MFMA32(sfr[pt][ks], cf, yo); }
                const bf16* zp = P + (rowb + c * 128 + s) * NPROJ + PC_Z + g * 256 + r * 64 + 32 * pt + 4 * h;
                u32x2 zv[4];
#pragma unroll
                for (int q4 = 0; q4 < 4; ++q4) zv[q4] = *(const u32x2*)(zp + 8 * q4);
#pragma unroll
                for (int q4 = 0; q4 < 4; ++q4) {
                    const u32x2 xv = *(const LAS u32x2*)(sX + s * SX_ST + (r * 64 + 32 * pt + 8 * q4 + 4 * h) * 2);
                    const u32x2 zq = zv[q4];
                    const float xs_[4] = {bflo(xv.x), bfhi(xv.x), bflo(xv.y), bfhi(xv.y)}, zs_[4] = {bflo(zq.x), bfhi(zq.x), bflo(zq.y), bfhi(zq.y)};
                    float yv[4];
#pragma unroll
                    for (int e = 0; e < 4; ++e) { float y = yd[4 * q4 + e] + eacs * yo[4 * q4 + e] + Dh * xs_[e]; y = y * zs_[e] * sigmoidf_(zs_[e]); yv[e] = y; ssq += y * y; }
                    yk[hq][pt][2 * q4] = pkbf(yv[0], yv[1]); yk[hq][pt][2 * q4 + 1] = pkbf(yv[2], yv[3]);
                }
            }
        }
        ssq += __shfl_xor(ssq, 32);
        if (h == 0) __hip_atomic_fetch_add(sSS + s, ssq, __ATOMIC_RELAXED, __HIP_MEMORY_SCOPE_WORKGROUP);
        __syncthreads();
        const float rs = __builtin_amdgcn_rsqf(sSS[s] * (1.f / 256.f) + EPS);
        unsigned char* yp = (unsigned char*)F.out + (tok0 + s) * YC + g * 256 + 4 * h;
        const float* nw = F.in[I_SSDNW] + g * 256 + 4 * h;
#pragma unroll
        for (int hq = 0; hq < 2; ++hq)
#pragma unroll
            for (int pt = 0; pt < 2; ++pt)
#pragma unroll
                for (int q4 = 0; q4 < 4; ++q4) { const int cc = (2 * hp + hq) * 64 + 32 * pt + 8 * q4; const f32x4 w4 = *(const f32x4*)(nw + cc);
                    const unsigned ya = yk[hq][pt][2 * q4], yb = yk[hq][pt][2 * q4 + 1];
                    *(unsigned*)(yp + cc) = pk4f8(bflo(ya) * rs * w4.x, bfhi(ya) * rs * w4.y, bflo(yb) * rs * w4.z, bfhi(yb) * rs * w4.w); }
    }
}

__device__ __forceinline__ bf16x8 mk_bf16x8(u32x2 lo, u32x2 hi) { const u32x4 v = {lo.x, lo.y, hi.x, hi.y}; return __builtin_bit_cast(bf16x8, v); }

__device__ __forceinline__ void memattn_mfma_phase(Frame& F, int half) {
    const bf16* P = (const bf16*)(F.ws + WS_BIG);
    const bf16* MKV = (const bf16*)(F.ws + WS_MKV);
    const bf16* MVT = (const bf16*)(F.ws + WS_MVT);
    bf16* Y = (bf16*)F.out;
    LAS unsigned char* sm = F.lds;
    const int tid = F.tid, lane = F.lane, wave = F.wave, ql = lane & 31, h = lane >> 5;
    constexpr int KST = 400, VST = 528;
    for (int unit = F.bid; unit < HB * 4 * 32; unit += F.G) {
        const int bl = unit >> 7, head = (unit >> 5) & 3, qt = unit & 31, b = half * HB + bl;
        const int r = bl * SEQ + qt * 256 + wave * 32 + ql;
        __syncthreads();
        for (int c = tid; c < 256 * 24; c += NTHR) { const int row = c / 24, ch = c % 24;
            *(LAS u32x4*)(sm + row * KST + ch * 16) = *(const u32x4*)(MKV + (size_t)(b * NMEM + row) * 1536 + head * 192 + ch * 8); }
        bf16x8 qf[12];
        { const bf16* qp = P + (size_t)r * NPROJ + PC_MQ + head * 192 + 8 * h;
          u32x4 qr[12]; float ss = 0.f;
#pragma unroll
          for (int ks = 0; ks < 12; ++ks) { qr[ks] = *(const u32x4*)(qp + 16 * ks);
              ss += (bflo(qr[ks].x) * bflo(qr[ks].x) + bfhi(qr[ks].x) * bfhi(qr[ks].x)) + (bflo(qr[ks].y) * bflo(qr[ks].y) + bfhi(qr[ks].y) * bfhi(qr[ks].y))
                  + (bflo(qr[ks].z) * bflo(qr[ks].z) + bfhi(qr[ks].z) * bfhi(qr[ks].z)) + (bflo(qr[ks].w) * bflo(qr[ks].w) + bfhi(qr[ks].w) * bfhi(qr[ks].w)); }
          ss += __shfl_xor(ss, 32);
          const float rs = __builtin_amdgcn_rsqf(ss * (1.f / 192.f) + EPS);
#pragma unroll
          for (int ks = 0; ks < 12; ++ks) { const f32x4 wa = *(const f32x4*)(F.in[I_MQNW] + 16 * ks + 8 * h), wb = *(const f32x4*)(F.in[I_MQNW] + 16 * ks + 8 * h + 4);
              const u32x4 w = {pkbf(bflo(qr[ks].x) * rs * wa.x, bfhi(qr[ks].x) * rs * wa.y), pkbf(bflo(qr[ks].y) * rs * wa.z, bfhi(qr[ks].y) * rs * wa.w),
                               pkbf(bflo(qr[ks].z) * rs * wb.x, bfhi(qr[ks].z) * rs * wb.y), pkbf(bflo(qr[ks].w) * rs * wb.z, bfhi(qr[ks].w) * rs * wb.w)};
              qf[ks] = __builtin_bit_cast(bf16x8, w); } }
        __syncthreads();
        f32x16 sacc[8];
#pragma unroll
        for (int mt = 0; mt < 8; ++mt) {
#pragma unroll
            for (int i = 0; i < 16; ++i) sacc[mt][i] = 0.f;
#pragma unroll
            for (int ks = 0; ks < 12; ++ks) { const bf16x8 kf = *(const LAS bf16x8*)(sm + (32 * mt + ql) * KST + 32 * ks + 16 * h); sacc[mt] = MFMA32(kf, qf[ks], sacc[mt]); }
        }
        float mx = -3.0e38f;
#pragma unroll
        for (int mt = 0; mt < 8; ++mt)
#pragma unroll
            for (int i = 0; i < 16; ++i) mx = fmaxf(mx, sacc[mt][i]);
        mx = fmaxf(mx, __shfl_xor(mx, 32));
        const float sc = 0.07216878364870323f * 1.4426950408889634f;
        float l = 0.f;
        bf16x8 pf[8][2];
#pragma unroll
        for (int mt = 0; mt < 8; ++mt) {
            float p[16];
#pragma unroll
            for (int i = 0; i < 16; ++i) { p[i] = __builtin_amdgcn_exp2f((sacc[mt][i] - mx) * sc); l += p[i]; }
#pragma unroll
            for (int s2 = 0; s2 < 2; ++s2) { const u32x4 w = {pkbf(p[8 * s2 + 0], p[8 * s2 + 1]), pkbf(p[8 * s2 + 2], p[8 * s2 + 3]), pkbf(p[8 * s2 + 4], p[8 * s2 + 5]), pkbf(p[8 * s2 + 6], p[8 * s2 + 7])};
                pf[mt][s2] = __builtin_bit_cast(bf16x8, w); }
        }
        l += __shfl_xor(l, 32);
        __syncthreads();
        for (int c = tid; c < 192 * 32; c += NTHR) { const int row = c >> 5, ch = c & 31;
            *(LAS u32x4*)(sm + row * VST + ch * 16) = *(const u32x4*)(MVT + (size_t)(head * 192 + row) * 2048 + b * NMEM + ch * 8); }
        __syncthreads();
        const float il = __builtin_amdgcn_rcpf(l);
        unsigned char* yp = (unsigned char*)F.out + ((size_t)half * HT + r) * YC + 1280 + head * 192 + 4 * h;
#pragma unroll
        for (int dt = 0; dt < 6; ++dt) {
            f32x16 o;
#pragma unroll
            for (int i = 0; i < 16; ++i) o[i] = 0.f;
#pragma unroll
            for (int mt = 0; mt < 8; ++mt)
#pragma unroll
                for (int s2 = 0; s2 < 2; ++s2) { const LAS unsigned char* vp = sm + (32 * dt + ql) * VST + (32 * mt + 16 * s2 + 4 * h) * 2;
                    const bf16x8 vf = mk_bf16x8(*(const LAS u32x2*)vp, *(const LAS u32x2*)(vp + 16)); o = MFMA32(vf, pf[mt][s2], o); }
#pragma unroll
            for (int g = 0; g < 4; ++g) { const float is = il * YD_SCALE; *(unsigned*)(yp + 32 * dt + 8 * g) = pk4f8(o[4 * g] * is, o[4 * g + 1] * is, o[4 * g + 2] * is, o[4 * g + 3] * is); }
        }
    }
}

__device__ __forceinline__ void dilattn_mfma_phase(Frame& F, int half) {
    bf16* P = (bf16*)(F.ws + WS_BIG);
    float* LSE = (float*)(F.ws + WS_LSE);
    LAS unsigned char* sK = F.lds; LAS unsigned char* sV = F.lds + 384 * 144;
    const int tid = F.tid, lane = F.lane, wave = F.wave, ql = lane & 31, h = lane >> 5;
    constexpr int RST = 144;
    const float* RT = (const float*)(F.ws + WS_ROPE);
    float wk8[8];
#pragma unroll
    for (int j = 0; j < 8; ++j) wk8[j] = F.in[I_DKNW][8 * (tid & 7) + j];
    for (int unit = F.bid; unit < HB * 12 * 32; unit += F.G) {
        const int bl = unit / 384, rem = unit % 384, head = rem >> 5, blk = rem & 31;
        const int g = head >> 2, dil = (g == 0) ? 1 : (g == 1 ? 4 : 16), bpr = 32 / dil;
        const int res = blk / bpr, q0 = (blk % bpr) * 256;
        const size_t rowb = (size_t)bl * SEQ;
        __syncthreads();
        for (int c = tid; c < 384 * 8; c += NTHR) { const int row = c >> 3, ch = c & 7; const int ks = q0 - 128 + row;
            u32x4 kv = {0u, 0u, 0u, 0u}, vv = {0u, 0u, 0u, 0u}; f32x4 c0 = {1.f, 1.f, 1.f, 1.f}, c1 = c0, s0 = {0.f, 0.f, 0.f, 0.f}, s1 = s0;
            if (ks >= 0) { const size_t rr = rowb + (size_t)ks * dil + res; const bf16* src = P + rr * NPROJ + head * 64 + ch * 8; kv = *(const u32x4*)(src + PC_DK); vv = *(const u32x4*)(src + PC_DV);
                if (ch < 2) { const f32x4* rt = (const f32x4*)(RT + ((size_t)half * HT + rr) * 16); c0 = rt[0]; c1 = rt[1]; s0 = rt[2]; s1 = rt[3]; } }
            float x[8] = {bflo(kv.x), bfhi(kv.x), bflo(kv.y), bfhi(kv.y), bflo(kv.z), bfhi(kv.z), bflo(kv.w), bfhi(kv.w)};
            float ss = 0.f;
#pragma unroll
            for (int j = 0; j < 8; ++j) ss += x[j] * x[j];
            ss += __shfl_xor(ss, 1); ss += __shfl_xor(ss, 2); ss += __shfl_xor(ss, 4);
            const float rs = __builtin_amdgcn_rsqf(ss * (1.f / 64.f) + EPS);
            const float cs[8] = {c0.x, c0.y, c0.z, c0.w, c1.x, c1.y, c1.z, c1.w}, sn[8] = {s0.x, s0.y, s0.z, s0.w, s1.x, s1.y, s1.z, s1.w};
#pragma unroll
            for (int j = 0; j < 8; ++j) { x[j] = x[j] * rs * wk8[j]; const float o = __shfl_xor(x[j], 1); if (ch == 0) x[j] = x[j] * cs[j] - o * sn[j]; else if (ch == 1) x[j] = x[j] * cs[j] + o * sn[j]; }
            kv = (u32x4){pkbf(x[0], x[1]), pkbf(x[2], x[3]), pkbf(x[4], x[5]), pkbf(x[6], x[7])};
            *(LAS u32x4*)(sK + row * RST + ch * 16) = kv; *(LAS u32x4*)(sV + row * RST + ch * 16) = vv; }
        const int qs = q0 + wave * 32 + ql;
        const size_t rq = rowb + (size_t)qs * dil + res;
        bf16* qp = P + rq * NPROJ + PC_DQ + head * 64;
        bf16x8 qf[4];
        {
            u32x4 qr[4];
#pragma unroll
            for (int ks = 0; ks < 4; ++ks) qr[ks] = *(const u32x4*)(qp + 16 * ks + 8 * h);
            const f32x4* rt = (const f32x4*)(RT + ((size_t)half * HT + rq) * 16); const f32x4 c0 = rt[0], c1 = rt[1], s0 = rt[2], s1 = rt[3];
            float ss = 0.f;
#pragma unroll
            for (int ks = 0; ks < 4; ++ks) ss += (bflo(qr[ks].x) * bflo(qr[ks].x) + bfhi(qr[ks].x) * bfhi(qr[ks].x)) + (bflo(qr[ks].y) * bflo(qr[ks].y) + bfhi(qr[ks].y) * bfhi(qr[ks].y))
                                               + (bflo(qr[ks].z) * bflo(qr[ks].z) + bfhi(qr[ks].z) * bfhi(qr[ks].z)) + (bflo(qr[ks].w) * bflo(qr[ks].w) + bfhi(qr[ks].w) * bfhi(qr[ks].w));
            ss += __shfl_xor(ss, 32);
            const float rs = __builtin_amdgcn_rsqf(ss * (1.f / 64.f) + EPS);
#pragma unroll
            for (int ks = 0; ks < 4; ++ks) { const f32x4 wa = *(const f32x4*)(F.in[I_DQNW] + 16 * ks + 8 * h), wb = *(const f32x4*)(F.in[I_DQNW] + 16 * ks + 8 * h + 4);
                float x[8] = {bflo(qr[ks].x) * rs * wa.x, bfhi(qr[ks].x) * rs * wa.y, bflo(qr[ks].y) * rs * wa.z, bfhi(qr[ks].y) * rs * wa.w, bflo(qr[ks].z) * rs * wb.x, bfhi(qr[ks].z) * rs * wb.y, bflo(qr[ks].w) * rs * wb.z, bfhi(qr[ks].w) * rs * wb.w};
                if (ks == 0) { const float cs[8] = {c0.x, c0.y, c0.z, c0.w, c1.x, c1.y, c1.z, c1.w}, sn[8] = {s0.x, s0.y, s0.z, s0.w, s1.x, s1.y, s1.z, s1.w};
#pragma unroll
                    for (int j = 0; j < 8; ++j) { const float o = __shfl_xor(x[j], 32); x[j] = (h == 0) ? x[j] * cs[j] - o * sn[j] : x[j] * cs[j] + o * sn[j]; } }
                const u32x4 w = {pkbf(x[0], x[1]), pkbf(x[2], x[3]), pkbf(x[4], x[5]), pkbf(x[6], x[7])}; qf[ks] = __builtin_bit_cast(bf16x8, w); }
        }
        __syncthreads();
        f32x16 sacc[5];
        const int kfirst = q0 + wave * 32 - 128;
#pragma unroll
        for (int i = 0; i < 5; ++i) {
#pragma unroll
            for (int e = 0; e < 16; ++e) sacc[i][e] = 0.f;
#pragma unroll
            for (int ks = 0; ks < 4; ++ks) { const bf16x8 kf = *(const LAS bf16x8*)(sK + (32 * wave + 32 * i + ql) * RST + 32 * ks + 16 * h); sacc[i] = MFMA32(kf, qf[ks], sacc[i]); }
        }
        float mx = -3.0e38f;
#pragma unroll
        for (int i = 0; i < 5; ++i)
#pragma unroll
            for (int e = 0; e < 16; ++e) { const int kj = 32 * i + (e & 3) + 8 * (e >> 2) + 4 * h; const bool ok = (kj >= ql) && (kj <= ql + 128) && (kfirst + kj >= 0);
                sacc[i][e] = ok ? sacc[i][e] : -3.0e38f; mx = fmaxf(mx, sacc[i][e]); }
        mx = fmaxf(mx, __shfl_xor(mx, 32));
        const float sc = 0.125f * 1.4426950408889634f;
        float l = 0.f;
        bf16x8 pf[5][2];
#pragma unroll
        for (int i = 0; i < 5; ++i) {
            float p[16];
#pragma unroll
            for (int e = 0; e < 16; ++e) { p[e] = (sacc[i][e] > -1.0e38f) ? __builtin_amdgcn_exp2f((sacc[i][e] - mx) * sc) : 0.f; l += p[e]; }
#pragma unroll
            for (int s2 = 0; s2 < 2; ++s2) { const u32x4 w = {pkbf(p[8 * s2 + 0], p[8 * s2 + 1]), pkbf(p[8 * s2 + 2], p[8 * s2 + 3]), pkbf(p[8 * s2 + 4], p[8 * s2 + 5]), pkbf(p[8 * s2 + 6], p[8 * s2 + 7])};
                pf[i][s2] = __builtin_bit_cast(bf16x8, w); }
        }
        l += __shfl_xor(l, 32);
        const float il = __builtin_amdgcn_rcpf(l);
        const int tq = (lane & 15) >> 2, tp = lane & 3, tblk = (lane >> 4) & 1;
        const unsigned vbase = (unsigned)(size_t)(sV) + (unsigned)((32 * wave + 4 * h + tq) * RST + (16 * tblk + 4 * tp) * 2);
#pragma unroll
        for (int dt = 0; dt < 2; ++dt) {
            f32x16 o;
#pragma unroll
            for (int e = 0; e < 16; ++e) o[e] = 0.f;
#pragma unroll
            for (int i = 0; i < 5; ++i) {
                s16x4 lo[2], hi[2];
#pragma unroll
                for (int s2 = 0; s2 < 2; ++s2) { const unsigned a = vbase + (unsigned)((32 * i + 16 * s2) * RST + 64 * dt);
                    asm volatile("ds_read_b64_tr_b16 %0, %1" : "=&v"(lo[s2]) : "v"(a) : "memory");
                    asm volatile("ds_read_b64_tr_b16 %0, %1 offset:1152" : "=&v"(hi[s2]) : "v"(a) : "memory"); }
                asm volatile("s_waitcnt lgkmcnt(0)" ::: "memory"); __builtin_amdgcn_sched_barrier(0);
#pragma unroll
                for (int s2 = 0; s2 < 2; ++s2) { const bf16x8 vf = {lo[s2][0], lo[s2][1], lo[s2][2], lo[s2][3], hi[s2][0], hi[s2][1], hi[s2][2], hi[s2][3]}; o = MFMA32(vf, pf[i][s2], o); }
            }
#pragma unroll
            for (int gq = 0; gq < 4; ++gq) { const u32x2 w = {pkbf(o[4 * gq] * il, o[4 * gq + 1] * il), pkbf(o[4 * gq + 2] * il, o[4 * gq + 3] * il)}; *(u32x2*)(qp + 32 * dt + 8 * gq + 4 * h) = w; }
        }
        if (h == 0) LSE[((size_t)half * HT + rq) * 12 + head] = mx * 0.125f + __logf(l);
    }
}

__device__ __forceinline__ void dilmerge_phase(Frame& F, int half) {
    const bf16* P = (const bf16*)(F.ws + WS_BIG);
    const float* LSE = (const float*)(F.ws + WS_LSE);
    bf16* Y = (bf16*)F.out;
    const size_t gtid = (size_t)F.bid * NTHR + F.tid, gth = (size_t)F.G * NTHR;
    for (size_t it = gtid; it < (size_t)HT * 32; it += gth) {
        const size_t r = it >> 5; const int hh = (int)(it >> 3) & 3, d0 = (int)(it & 7) * 8;
        const size_t tok = (size_t)half * HT + r;
        const float l0 = LSE[tok * 12 + hh], l1 = LSE[tok * 12 + 4 + hh], l2 = LSE[tok * 12 + 8 + hh];
        const float m = fmaxf(l0, fmaxf(l1, l2));
        float w0 = __expf(l0 - m), w1 = __expf(l1 - m), w2 = __expf(l2 - m); const float iw = __builtin_amdgcn_rcpf(w0 + w1 + w2) * YD_SCALE; w0 *= iw; w1 *= iw; w2 *= iw;
        const bf16* op = P + r * NPROJ + PC_DQ + hh * 64 + d0;
        const u32x4 a = *(const u32x4*)op, b = *(const u32x4*)(op + 256), c = *(const u32x4*)(op + 512);
#define DM_(p, q) (w0 * p(a.q) + w1 * p(b.q) + w2 * p(c.q))
        const u32x2 o = {pk4f8(DM_(bflo, x), DM_(bfhi, x), DM_(bflo, y), DM_(bfhi, y)), pk4f8(DM_(bflo, z), DM_(bfhi, z), DM_(bflo, w), DM_(bfhi, w))};
#undef DM_
        *(u32x2*)((unsigned char*)F.out + tok * YC + 1024 + hh * 64 + d0) = o;
    }
}

__device__ __forceinline__ void hn_phase(Frame& F) {
    const int gw = F.bid * NWAVES + F.wave, NGW = F.G * NWAVES;
    for (int m = gw; m < T; m += NGW) { f32x4 v[4]; rms_row_to_bf16(F.out + (size_t)m * DM, F.in[I_NFFNW], (bf16*)(F.ws + WS_ACT1) + (size_t)m * DM, F.lane, v); }
}


__device__ __forceinline__ float gelu_erf(float x) { return 0.5f * x * (1.0f + erff(x * 0.70710678118654752f)); }
__device__ __forceinline__ unsigned f2ord(float f) { const unsigned u = __builtin_bit_cast(unsigned, f); return u ^ ((unsigned)((int)u >> 31) | 0x80000000u); }
__device__ __forceinline__ float ord2f(unsigned k) { const unsigned m = (unsigned)((int)k >> 31); return __builtin_bit_cast(float, k ^ (0x80000000u | ~m)); }
#define CMPX(a, b) do { const unsigned _mx = max((a), (b)), _mn = min((a), (b)); (a) = _mx; (b) = _mn; } while (0)
__device__ __forceinline__ void bitonic_sort16_desc(unsigned (&v)[16]) {
#pragma unroll
    for (int k = 2; k <= 16; k <<= 1)
#pragma unroll
        for (int j = k >> 1; j > 0; j >>= 1)
#pragma unroll
            for (int i = 0; i < 16; ++i) { const int l = i ^ j; if (l > i) { if ((i & k) == 0) CMPX(v[i], v[l]); else CMPX(v[l], v[i]); } }
}
__device__ __forceinline__ void bitonic_merge16_desc(unsigned (&v)[16]) {
#pragma unroll
    for (int j = 8; j > 0; j >>= 1)
#pragma unroll
        for (int i = 0; i < 16; ++i) { const int l = i ^ j; if (l > i) CMPX(v[i], v[l]); }
}
__device__ __forceinline__ void top16_merge(unsigned (&a)[16], const unsigned (&b)[16]) {
#pragma unroll
    for (int i = 0; i < 16; ++i) a[i] = max(a[i], b[15 - i]);
    bitonic_merge16_desc(a);
}
constexpr int PK_ST = 272;
__device__ __forceinline__ void peer_topk_tile(Frame& F, size_t tok0, const bf16* Q, int* IDX, float* GATE) {
    const bf16* SK = (const bf16*)(F.ws + WS_SUBK);
    LAS unsigned char* sK = F.lds;
    int tid = F.tid; asm volatile("" : "+v"(tid));
    const int lane = tid & 63, wave = F.wave, ql = lane & 31, hh = lane >> 5;
    const size_t tok = tok0 + wave * 32 + ql;
    const bf16* qrow = Q + tok * PEER_Q + 8 * hh;
    __syncthreads();
#pragma unroll
    for (int j = 0; j < 4; ++j) { const int cidx = tid + 512 * j, row = cidx >> 4, ch = cidx & 15; *(LAS u32x4*)(sK + row * PK_ST + ch * 16) = *(const u32x4*)(SK + (size_t)row * 128 + ch * 8); }
    __syncthreads();
    unsigned k1[16];
    bf16x8 qf[8];
#pragma unroll
    for (int ks = 0; ks < 8; ++ks) qf[ks] = *(const bf16x8*)(qrow + 16 * ks);
#pragma unroll 1
    for (int hc = 0; hc < 16; ++hc) {
        LAS unsigned char* cur = sK + (hc & 1) * (128 * PK_ST); LAS unsigned char* nxt = sK + ((hc + 1) & 1) * (128 * PK_ST);
        u32x4 stg[4];
        const int hcn = (hc + 1) & 15;
#pragma unroll
        for (int j = 0; j < 4; ++j) { const int cidx = tid + 512 * j, row = cidx >> 4, ch = cidx & 15; stg[j] = *(const u32x4*)(SK + ((size_t)hcn * 128 + row) * 128 + ch * 8); }
        unsigned pk[4][16];
#pragma unroll
        for (int mt = 0; mt < 4; ++mt) {
            f32x16 acc;
#pragma unroll
            for (int e = 0; e < 16; ++e) acc[e] = 0.f;
#pragma unroll
            for (int ks = 0; ks < 8; ++ks) { const bf16x8 kf = *(const LAS bf16x8*)(cur + (32 * mt + ql) * PK_ST + 32 * ks + 16 * hh); acc = MFMA32(kf, qf[ks], acc); }
#pragma unroll
            for (int e = 0; e < 16; ++e) pk[mt][e] = (f2ord(acc[e]) & 0xFFFFFF80u) | (unsigned)(32 * mt + (e & 3) + 8 * (e >> 2) + 4 * hh);
        }
#pragma unroll
        for (int j = 0; j < 4; ++j) { const int cidx = tid + 512 * j, row = cidx >> 4, ch = cidx & 15; *(LAS u32x4*)(nxt + row * PK_ST + ch * 16) = stg[j]; }
        __syncthreads();
        __builtin_amdgcn_sched_barrier(0);
#pragma unroll
        for (int ks = 0; ks < 8; ++ks) qf[ks] = *(const bf16x8*)(qrow + hcn * 128 + 16 * ks);
        __builtin_amdgcn_sched_barrier(0);
#pragma unroll
        for (int mt = 0; mt < 4; ++mt) bitonic_sort16_desc(pk[mt]);
        top16_merge(pk[0], pk[1]); top16_merge(pk[2], pk[3]); top16_merge(pk[0], pk[2]);
        unsigned other[16];
#pragma unroll
        for (int i = 0; i < 16; ++i) other[i] = (unsigned)__shfl_xor((int)pk[0][i], 32);
        top16_merge(pk[0], other);
        if ((hc & 1) == 0) {
#pragma unroll
            for (int i = 0; i < 16; ++i) k1[i] = pk[0][i];
        } else {
            float f1[16], f2[16];
#pragma unroll
            for (int i = 0; i < 16; ++i) { f1[i] = ord2f(k1[i] & 0xFFFFFF80u); f2[i] = ord2f(pk[0][i] & 0xFFFFFF80u); }
            unsigned cd[4][16];
#pragma unroll
            for (int i = 0; i < 64; ++i) cd[i >> 4][i & 15] = 0u;
            int n = 0;
#pragma unroll
            for (int a = 0; a < 16; ++a)
#pragma unroll
                for (int b = 0; b < 16; ++b)
                    if ((a + 1) * (b + 1) <= 16) { cd[n >> 4][n & 15] = (f2ord(f1[a] + f2[b]) & 0xFFFFC000u) | ((k1[a] & 127u) << 7) | (pk[0][b] & 127u); ++n; }
            {
#pragma unroll
                for (int i = 0; i < 16; ++i) { cd[0][i] = hh ? cd[2][i] : cd[0][i]; cd[1][i] = hh ? cd[3][i] : cd[1][i]; }
                bitonic_sort16_desc(cd[0]); bitonic_sort16_desc(cd[1]);
                top16_merge(cd[0], cd[1]);
                unsigned oth[16];
#pragma unroll
                for (int i = 0; i < 16; ++i) oth[i] = (unsigned)__shfl_xor((int)cd[0][i], 32);
                top16_merge(cd[0], oth);
            }
            const float vmax = ord2f(cd[0][0] & 0xFFFFC000u);
            float ex[16], den = 0.f;
#pragma unroll
            for (int i = 0; i < 16; ++i) { ex[i] = __expf(ord2f(cd[0][i] & 0xFFFFC000u) - vmax); den += ex[i]; }
            const float iden = __builtin_amdgcn_rcpf(den);
            const int h = hc >> 1;
            if (hh == 0) { int* ip = IDX + tok * 128 + h * 16;
#pragma unroll
                for (int i = 0; i < 4; ++i) { const u32x4 w = {cd[0][4 * i] & 0x3FFFu, cd[0][4 * i + 1] & 0x3FFFu, cd[0][4 * i + 2] & 0x3FFFu, cd[0][4 * i + 3] & 0x3FFFu}; *(u32x4*)(ip + 4 * i) = w; } }
            else { float* gp = GATE + tok * 128 + h * 16;
#pragma unroll
                for (int i = 0; i < 4; ++i) { const f32x4 w = {ex[4 * i] * iden, ex[4 * i + 1] * iden, ex[4 * i + 2] * iden, ex[4 * i + 3] * iden}; *(f32x4*)(gp + 4 * i) = w; } }
        }
    }
}

struct PeerDeal { size_t tokw; int ntok; size_t tok0; float* PART; const int* IDX; const float* GATE; float* COEF; };
__device__ __forceinline__ void peer_item(int n, const PeerDeal& D, int wave, int& slice, size_t& tok) { slice = n >> 5; tok = D.tokw + (n & 31); }
__device__ __forceinline__ void peer_down_rows(u32x4 (&R)[16], __amdgpu_buffer_rsrc_t tab, int slice, int id0, int id1, int lane) {
    const int soff = slice * (16384 * 128);
    const int r = lane & 15, g = lane >> 4, e8 = (r >> 2) + 4 * (g >> 1), q = 4 * (g & 1) + (r & 3);
    const int src0 = 16 * (e8 & 3);
#pragma unroll
    for (int k = 0; k < 16; ++k) { const int v0 = __shfl(id0, src0 + k), v1 = __shfl(id1, src0 + k); const int id = (e8 < 4) ? v0 : v1;
        R[k] = __builtin_amdgcn_raw_buffer_load_b128(tab, (id << 7) + 16 * q, soff, 0); }
}
__device__ __forceinline__ void peer_down_hn(u32x4 (&H)[2], const bf16* HN, int slice, size_t tok, int lane) {
    const unsigned char* hp = (const unsigned char*)HN + tok * DM + slice * 128 + 16 * (4 * ((lane >> 4) & 1) + (lane & 3));
    H[0] = *(const u32x4*)hp;
}
__device__ __forceinline__ void peer_down_bq(long (&bq)[2], const u32x4 (&H)[2], int lane) {
    const int c = lane & 15, g = lane >> 4; const bool on = (c < 8) && ((c >> 2) == (g >> 1));
    unsigned p0 = H[0].x, p1 = H[0].y, p2 = H[0].z, p3 = H[0].w;
    if (!on) { p0 = 0u; p1 = 0u; p2 = 0u; p3 = 0u; }
    bq[0] = (long)(((unsigned long long)p1 << 32) | p0); bq[1] = (long)(((unsigned long long)p3 << 32) | p2);
}
__device__ __forceinline__ void peer_down_mfma(const u32x4 (&R)[16], const long (&bq)[2], __amdgpu_buffer_rsrc_t prsrc, int slice, int tokl, int lane) {
    const int c = lane & 15, g = lane >> 4, cb = c & 3;
    float dv[16];
#pragma unroll
    for (int k = 0; k < 16; ++k) { f32x4 acc = {0.f, 0.f, 0.f, 0.f}; const u32x4 v = R[k];
        acc = __builtin_amdgcn_mfma_f32_16x16x32_fp8_fp8((long)(((unsigned long long)v.y << 32) | v.x), bq[0], acc, 0, 0, 0);
        acc = __builtin_amdgcn_mfma_f32_16x16x32_fp8_fp8((long)(((unsigned long long)v.w << 32) | v.z), bq[1], acc, 0, 0, 0);
        float t = (cb == 0) ? acc.x : (cb == 1) ? acc.y : (cb == 2) ? acc.z : acc.w;
        t += __shfl_xor(t, 1); t += __shfl_xor(t, 2); dv[k] = t; }
    const unsigned off = ((c & 3) == 0 && c < 8) ? (unsigned)(((tokl * 8 + slice) * 128 + 16 * (g + 4 * (c >> 2))) * 2) : 0xFFFFFF00u;
#pragma unroll
    for (int i = 0; i < 2; ++i) { const u32x4 w = {pkbf(dv[8 * i], dv[8 * i + 1]), pkbf(dv[8 * i + 2], dv[8 * i + 3]), pkbf(dv[8 * i + 4], dv[8 * i + 5]), pkbf(dv[8 * i + 6], dv[8 * i + 7])}; __builtin_amdgcn_raw_buffer_store_b128(w, prsrc, off, 16 * i, 0); }
}
__device__ __forceinline__ void peer_down_phase(Frame& F, const PeerDeal& D) {
    const __amdgpu_buffer_rsrc_t PD = __builtin_amdgcn_make_buffer_rsrc((void*)(F.ws + WS_PD), 0, 16384 * 1024, 0x00020000); const bf16* HN = (const bf16*)(F.ws + WS_HN8F);
    const int* IDX = D.IDX;
    const __amdgpu_buffer_rsrc_t prsrc = __builtin_amdgcn_make_buffer_rsrc((void*)D.PART, 0, 256 * 8 * 128 * 2, 0x00020000);
    int lane = F.lane; asm volatile("" : "+v"(lane));
    const int wave = F.wave;
    const int ntok = D.ntok;
    u32x4 RA[16], RB[16], HA[2], HB[2]; int ia0, ia1, ib0, ib1; long bq[2];
#define PEER_TOK(k, sv, tv) int sv; size_t tv; peer_item((k) < ntok ? (k) : ntok - 2 + ((k) & 1), D, wave, sv, tv)
    { PEER_TOK(0, s0, t0); PEER_TOK(1, s1, t1); PEER_TOK(2, s2, t2); PEER_TOK(3, s3, t3);
      const int a0 = IDX[t0 * 128 + lane], a1 = IDX[t0 * 128 + 64 + lane], b0 = IDX[t1 * 128 + lane], b1 = IDX[t1 * 128 + 64 + lane];
      ia0 = IDX[t2 * 128 + lane]; ia1 = IDX[t2 * 128 + 64 + lane]; ib0 = IDX[t3 * 128 + lane]; ib1 = IDX[t3 * 128 + 64 + lane];
      __builtin_amdgcn_sched_barrier(0);
      peer_down_rows(RA, PD, s0, a0, a1, lane); peer_down_hn(HA, HN, s0, t0, lane);
      __builtin_amdgcn_sched_barrier(0);
      peer_down_rows(RB, PD, s1, b0, b1, lane); peer_down_hn(HB, HN, s1, t1, lane);
      __builtin_amdgcn_sched_barrier(0); }
#pragma unroll 1
    for (int n = 0; n < ntok; n += 2) {
        PEER_TOK(n, s0, t0); PEER_TOK(n + 1, s1, t1); PEER_TOK(n + 2, s2, t2); PEER_TOK(n + 3, s3, t3); PEER_TOK(n + 4, s4, t4); PEER_TOK(n + 5, s5, t5);
        peer_down_bq(bq, HA, lane);
        peer_down_mfma(RA, bq, prsrc, s0, (int)(t0 - D.tok0), lane);
        __builtin_amdgcn_sched_barrier(0);
        { const int j0 = IDX[t4 * 128 + lane], j1 = IDX[t4 * 128 + 64 + lane];
          peer_down_rows(RA, PD, s2, ia0, ia1, lane); peer_down_hn(HA, HN, s2, t2, lane); ia0 = j0; ia1 = j1; }
        __builtin_amdgcn_sched_barrier(0);
        peer_down_bq(bq, HB, lane);
        peer_down_mfma(RB, bq, prsrc, s1, (int)(t1 - D.tok0), lane);
        __builtin_amdgcn_sched_barrier(0);
        { const int j0 = IDX[t5 * 128 + lane], j1 = IDX[t5 * 128 + 64 + lane];
          peer_down_rows(RB, PD, s3, ib0, ib1, lane); peer_down_hn(HB, HN, s3, t3, lane); ib0 = j0; ib1 = j1; }
        __builtin_amdgcn_sched_barrier(0);
    }
#undef PEER_TOK
}
__device__ __forceinline__ void peer_coef_wave(Frame& F, const PeerDeal& D) {
    for (int k = F.lane; k < 32 * 32; k += 64) {
        const int tl = (int)(D.tokw - D.tok0) + (k >> 5), slot = 4 * (k & 31);
        const bf16* pp = (const bf16*)D.PART + (size_t)tl * 1024 + slot;
        f32x4 sm = {0.f, 0.f, 0.f, 0.f};
#pragma unroll
        for (int x = 0; x < 8; ++x) { const u32x2 q = *(const u32x2*)(pp + 128 * x); sm += (f32x4){bflo(q.x), bfhi(q.x), bflo(q.y), bfhi(q.y)}; }
        const size_t i = (D.tok0 + tl) * 128 + slot;
        const f32x4 gt = *(const f32x4*)(D.GATE + i);
        const float dsc = 1.0f / PD_SCALE;
        const f32x4 o = {gt.x * gelu_erf(sm.x * dsc) * (1.0f / PU_SCALE), gt.y * gelu_erf(sm.y * dsc) * (1.0f / PU_SCALE),
                         gt.z * gelu_erf(sm.z * dsc) * (1.0f / PU_SCALE), gt.w * gelu_erf(sm.w * dsc) * (1.0f / PU_SCALE)};
        *(f32x4*)(D.COEF + i) = o;
    }
}
__device__ __forceinline__ void peer_up_rows(u32x4 (&R)[16], __amdgpu_buffer_rsrc_t tab, int slice, int id0, int id1, int lane) {
    const int soff = slice * (16384 * 128);
#pragma unroll
    for (int s8 = 0; s8 < 8; ++s8) { const int id = __shfl(s8 < 4 ? id0 : id1, (16 * s8 + (lane >> 2)) & 63); const int vo = (id << 7) + 16 * (lane & 3);
        R[2 * s8] = __builtin_amdgcn_raw_buffer_load_b128(tab, vo, soff, 0); R[2 * s8 + 1] = __builtin_amdgcn_raw_buffer_load_b128(tab, vo, soff + 64, 0); }
}
__device__ __forceinline__ void peer_up_compute(const u32x4 (&R)[16], float c0, float c1, f32x2 h, float* out, int slice, size_t tok, int lane) {
    f32x2 acc[16];
#pragma unroll
    for (int k = 0; k < 16; ++k) acc[k] = (f32x2){0.f, 0.f};
#pragma unroll
    for (int s8 = 0; s8 < 8; ++s8) { const float c = __shfl(s8 < 4 ? c0 : c1, (16 * s8 + (lane >> 2)) & 63); f32x2 c2 = {c, c}; asm volatile("" : "+v"(c2));
#pragma unroll
        for (int hf = 0; hf < 2; ++hf) { const u32x4 r = R[2 * s8 + hf];
            acc[8 * hf + 0] = c2 * __builtin_amdgcn_cvt_pk_f32_fp8(r.x, false) + acc[8 * hf + 0]; acc[8 * hf + 1] = c2 * __builtin_amdgcn_cvt_pk_f32_fp8(r.x, true) + acc[8 * hf + 1];
            acc[8 * hf + 2] = c2 * __builtin_amdgcn_cvt_pk_f32_fp8(r.y, false) + acc[8 * hf + 2]; acc[8 * hf + 3] = c2 * __builtin_amdgcn_cvt_pk_f32_fp8(r.y, true) + acc[8 * hf + 3];
            acc[8 * hf + 4] = c2 * __builtin_amdgcn_cvt_pk_f32_fp8(r.z, false) + acc[8 * hf + 4]; acc[8 * hf + 5] = c2 * __builtin_amdgcn_cvt_pk_f32_fp8(r.z, true) + acc[8 * hf + 5];
            acc[8 * hf + 6] = c2 * __builtin_amdgcn_cvt_pk_f32_fp8(r.w, false) + acc[8 * hf + 6]; acc[8 * hf + 7] = c2 * __builtin_amdgcn_cvt_pk_f32_fp8(r.w, true) + acc[8 * hf + 7]; } }
    f32x2 r8[8], r4[4], r2[2], r1;
    { const bool up = (lane & 32) != 0;
#pragma unroll
      for (int k = 0; k < 8; ++k) { const f32x2 keep = up ? acc[k + 8] : acc[k], send = up ? acc[k] : acc[k + 8]; r8[k] = keep + (f32x2){__shfl_xor(send.x, 32), __shfl_xor(send.y, 32)}; } }
    { const bool up = (lane & 16) != 0;
#pragma unroll
      for (int k = 0; k < 4; ++k) { const f32x2 keep = up ? r8[k + 4] : r8[k], send = up ? r8[k] : r8[k + 4]; r4[k] = keep + (f32x2){__shfl_xor(send.x, 16), __shfl_xor(send.y, 16)}; } }
    { const bool up = (lane & 8) != 0;
#pragma unroll
      for (int k = 0; k < 2; ++k) { const f32x2 keep = up ? r4[k + 2] : r4[k], send = up ? r4[k] : r4[k + 2]; r2[k] = keep + (f32x2){__shfl_xor(send.x, 8), __shfl_xor(send.y, 8)}; } }
    { const bool up = (lane & 4) != 0; const f32x2 keep = up ? r2[1] : r2[0], send = up ? r2[0] : r2[1]; r1 = keep + (f32x2){__shfl_xor(send.x, 4), __shfl_xor(send.y, 4)}; }
    const int p = ((lane >> 5) & 1) * 8 + ((lane >> 4) & 1) * 4 + ((lane >> 3) & 1) * 2 + ((lane >> 2) & 1);
    *(f32x2*)(out + tok * DM + slice * 128 + 16 * (lane & 3) + 2 * (p & 7) + 64 * (p >> 3)) = h + r1;
}
__device__ __forceinline__ void peer_up_phase(Frame& F, const PeerDeal& D, float* outp) {
    const __amdgpu_buffer_rsrc_t PU = __builtin_amdgcn_make_buffer_rsrc((void*)(F.ws + WS_PU), 0, 16384 * 1024, 0x00020000);
    const int* IDX = D.IDX; const float* COEF = D.COEF;
    int lane = F.lane; asm volatile("" : "+v"(lane));
    const int wave = F.wave;
    const int ntok = D.ntok;
    const int p = ((lane >> 5) & 1) * 8 + ((lane >> 4) & 1) * 4 + ((lane >> 3) & 1) * 2 + ((lane >> 2) & 1);
    const int hoff = 16 * (lane & 3) + 2 * (p & 7) + 64 * (p >> 3);
    int sl; size_t tk;
    u32x4 R0[16], R1[16];
    float ca0, ca1, cb0, cb1; f32x2 ha, hb;
    int id0, id1, jd0, jd1;
    { int s1_; size_t t1_; peer_item(0, D, wave, sl, tk); peer_item(1, D, wave, s1_, t1_);
      jd0 = IDX[tk * 128 + lane]; jd1 = IDX[tk * 128 + 64 + lane]; id0 = IDX[t1_ * 128 + lane]; id1 = IDX[t1_ * 128 + 64 + lane];
      __builtin_amdgcn_sched_barrier(0);
      peer_up_rows(R0, PU, sl, jd0, jd1, lane);
      ca0 = COEF[tk * 128 + lane]; ca1 = COEF[tk * 128 + 64 + lane]; { const unsigned hw_ = *(const unsigned*)((const bf16*)(F.ws + WS_H1B) + tk * DM + sl * 128 + hoff); ha = (f32x2){bflo(hw_), bfhi(hw_)}; }
      __builtin_amdgcn_sched_barrier(0); }
#pragma unroll 1
    for (int n = 0; n < ntok; n += 2) {
        int s0, s1, s2, s3; size_t t0, t1, t2, t3;
        peer_item(n, D, wave, s0, t0); peer_item(n + 1, D, wave, s1, t1);
        peer_item(n + 2 < ntok ? n + 2 : n, D, wave, s2, t2); peer_item(n + 3 < ntok ? n + 3 : n + 1, D, wave, s3, t3);
        jd0 = IDX[t2 * 128 + lane]; jd1 = IDX[t2 * 128 + 64 + lane];
        peer_up_rows(R1, PU, s1, id0, id1, lane);
        cb0 = COEF[t1 * 128 + lane]; cb1 = COEF[t1 * 128 + 64 + lane]; { const unsigned hw_ = *(const unsigned*)((const bf16*)(F.ws + WS_H1B) + t1 * DM + s1 * 128 + hoff); hb = (f32x2){bflo(hw_), bfhi(hw_)}; }
        __builtin_amdgcn_sched_barrier(0);
        peer_up_compute(R0, ca0, ca1, ha, outp, s0, t0, lane);
        __builtin_amdgcn_sched_barrier(0);
        id0 = IDX[t3 * 128 + lane]; id1 = IDX[t3 * 128 + 64 + lane];
        peer_up_rows(R0, PU, s2, jd0, jd1, lane);
        ca0 = COEF[t2 * 128 + lane]; ca1 = COEF[t2 * 128 + 64 + lane]; { const unsigned hw_ = *(const unsigned*)((const bf16*)(F.ws + WS_H1B) + t2 * DM + s2 * 128 + hoff); ha = (f32x2){bflo(hw_), bfhi(hw_)}; }
        __builtin_amdgcn_sched_barrier(0);
        peer_up_compute(R1, cb0, cb1, hb, outp, s1, t1, lane);
        __builtin_amdgcn_sched_barrier(0);
    }
}
__device__ __forceinline__ void peer_tile(Frame& F, int tile) {
    const size_t tok0 = (size_t)tile * 256;
    const bf16* Q = (const bf16*)(F.ws + WS_BIG);
    int* IDX = (int*)(F.ws + WS_BIG + 256 * MiB); float* GATE = (float*)(F.ws + WS_BIG + 288 * MiB); float* COEF = (float*)(F.ws + WS_BIG + 320 * MiB);
    peer_topk_tile(F, tok0, Q, IDX, GATE);
    VM_WAIT(); __syncthreads();
    PeerDeal D; D.tokw = tok0 + F.wave * 32; D.ntok = 256; D.tok0 = tok0; D.PART = (float*)(F.ws + WS_BIG + tok0 * (PEER_Q * 2)); D.IDX = IDX; D.GATE = GATE; D.COEF = COEF;
    peer_down_phase(F, D);
    VM_WAIT(); __syncthreads();
    peer_coef_wave(F, D);
    VM_WAIT(); __syncthreads();
    peer_up_phase(F, D, F.out);
}
__device__ __forceinline__ void peer_phase(Frame& F) { for (int tile = F.bid; tile < T / 256; tile += F.G) { peer_tile(F, tile); VM_WAIT(); __syncthreads(); } }

__device__ __forceinline__ void hn_panel_pass(Frame& F) {
    const f32x4* nwr = (const f32x4*)F.in[I_NFFNW] + F.lane;
    for (int p = F.bid; p < T / 256; p += F.G) {
#pragma unroll 1
        for (int r4 = 0; r4 < 8; ++r4) { const int row0 = p * 256 + F.wave * 32 + r4 * 4;
            f32x4 v[4][4];
#pragma unroll
            for (int r = 0; r < 4; ++r) { const u32x2* xr = (const u32x2*)((const bf16*)(F.ws + WS_H1B) + (size_t)(row0 + r) * DM) + F.lane;
#pragma unroll
                for (int j = 0; j < 4; ++j) { const u32x2 x = xr[64 * j]; v[r][j] = (f32x4){bflo(x.x), bfhi(x.x), bflo(x.y), bfhi(x.y)}; } }
#pragma unroll
            for (int r = 0; r < 4; ++r) { const int row = row0 + r; float s = 0.f;
#pragma unroll
                for (int j = 0; j < 4; ++j) s += (v[r][j].x * v[r][j].x + v[r][j].y * v[r][j].y) + (v[r][j].z * v[r][j].z + v[r][j].w * v[r][j].w);
                const float rstd = __builtin_amdgcn_rsqf(wave_sum(s) * (1.f / DM) + EPS);
                float am = 0.f;
#pragma unroll
                for (int j = 0; j < 4; ++j) { const f32x4 ww = nwr[64 * j]; v[r][j] = v[r][j] * rstd * ww;
                    am = fmaxf(fmaxf(am, fmaxf(fabsf(v[r][j].x), fabsf(v[r][j].y))), fmaxf(fabsf(v[r][j].z), fabsf(v[r][j].w))); }
                am = wave_max(am);
                const float inv = am > 0.f ? 127.0f / am : 0.f;
                unsigned* o8 = (unsigned*)(F.ws + WS_HN8F + (size_t)row * DM) + F.lane; unsigned* o4 = (unsigned*)(F.ws + WS_HN8 + (size_t)row * DM) + F.lane;
#pragma unroll
                for (int j = 0; j < 4; ++j) { o8[64 * j] = pk4f8(v[r][j].x, v[r][j].y, v[r][j].z, v[r][j].w);
                    o4[64 * j] = pk4_i8(v[r][j].x * inv, v[r][j].y * inv, v[r][j].z * inv, v[r][j].w * inv); }
                if (F.lane == 0) ((float*)(F.ws + WS_HNSC))[row] = am * (1.0f / 127.0f); } }
    }
}
constexpr int N_PHASES = 14;
__global__ void __launch_bounds__(NTHR, 2) mega_fwd(Args args) {
    extern __shared__ __attribute__((aligned(16))) unsigned char lds_raw[];
    Frame F;
    F.lds = (LAS unsigned char*)lds_raw;
    F.tid = threadIdx.x; F.lane = F.tid & 63; F.wave = __builtin_amdgcn_readfirstlane(F.tid >> 6);
    F.G = gridDim.x; F.bid = blockIdx.x;
    F.in = args.in;
    F.positions = args.positions; F.out = args.out; F.ws = args.ws;
    unsigned char* ws = args.ws;
    volatile LAS unsigned* ctlw = (volatile LAS unsigned*)(F.lds + LDSCTL_OFF);
    if (F.tid < 64) ctlw[F.tid] = 0u;
    __syncthreads();
    const int lo = args.ph_lo, hi = args.ph_hi;
    XcdBarrier bar; bar.bar = (unsigned*)(ws + WS_CTL); bar.x = 0; bar.st = nullptr; bar.wave = F.wave;
    if (hi - lo > 1) bar = xcd_barrier_post((unsigned*)(ws + WS_CTL), ctlw + 8, F.wave);
#define IN(k) (lo <= (k) && (k) < hi)
#define SEAM(k) do { if (IN(k) && IN((k) + 1)) xcd_barrier(bar); } while (0)
    bf16* ACT1 = (bf16*)(ws + WS_ACT1); bf16* BIG = (bf16*)(ws + WS_BIG); bf16* WallT = (bf16*)(ws + WS_WALLT);

    if (IN(0)) { frame_refresh(F); p0_prologue(F); __syncthreads(); }
    SEAM(0);
    if (IN(1)) { frame_refresh(F);
        p1_wquant(F); xcd_barrier(bar); frame_refresh(F);
        { pg8::Gemm g{(const bf16*)(ws + WS_MEMN), (const bf16*)(ws + WS_WMKVT), NB * NMEM, 768, DM, DM, DM}; pg8::StaticOrder S; S.init(g.M, g.N, F.G, F.bid);
          pg8::EpiBf16<0> E{(bf16*)(ws + WS_MKV), 1536}; pg8::gemm_phase(F.lds, g, S, E, F.wave); }
        { pg8::Gemm g{(const bf16*)(ws + WS_WMKVT) + (size_t)768 * DM, (const bf16*)(ws + WS_MEMN), 768, NB * NMEM, DM, DM, DM}; pg8::StaticOrder S; S.init(g.M, g.N, F.G, F.G - 1 - F.bid);
          pg8::EpiBf16<0> E{(bf16*)(ws + WS_MVT), NB * NMEM}; pg8::gemm_phase(F.lds, g, S, E, F.wave); }
        { pg8::Gemm g{(const bf16*)(ws + WS_U8), (const bf16*)(ws + WS_W8), HT, NPROJ, DM / 2, DM / 2, DM / 2}; pg8::StaticOrder S; S.init(g.M, g.N, F.G, F.bid);
          pg8::EpiBf16Q<0> E{BIG, NPROJ, (const float*)(ws + WS_USC), (const float*)(ws + WS_WSC)}; pg8::gemm_phase<2>(F.lds, g, S, E, F.wave); }
    }
    SEAM(1);
    if (IN(2)) { frame_refresh(F); mknorm_phase(F); ssdC_phase(F, 0); }
    SEAM(2);
    if (IN(3)) { frame_refresh(F); ssdD_phase(F); dilattn_mfma_phase(F, 0); memattn_mfma_phase(F, 0); }
    SEAM(3);
    if (IN(4)) { frame_refresh(F); ssdE_phase(F, 0); dilmerge_phase(F, 0); }
    SEAM(4);
    if (IN(5)) { frame_refresh(F); pg8::Gemm g{(const bf16*)(ws + WS_U8 + (size_t)HT * DM), (const bf16*)(ws + WS_W8), HT, NPROJ, DM / 2, DM / 2, DM / 2}; pg8::StaticOrder S; S.init(g.M, g.N, F.G, F.bid);
        pg8::EpiBf16Q<0> E{BIG, NPROJ, (const float*)(ws + WS_USC) + HT, (const float*)(ws + WS_WSC)}; pg8::gemm_phase<2>(F.lds, g, S, E, F.wave); }
    SEAM(5);
    if (IN(6)) { frame_refresh(F); ssdC_phase(F, 1); }
    SEAM(6);
    if (IN(7)) { frame_refresh(F); ssdD_phase(F); dilattn_mfma_phase(F, 1); memattn_mfma_phase(F, 1); }
    SEAM(7);
    if (IN(8)) { frame_refresh(F); ssdE_phase(F, 1); dilmerge_phase(F, 1); }
    SEAM(8);
    if (IN(9)) { frame_refresh(F);
        { pg8::Gemm g{(const bf16*)(ws + WS_U8), (const bf16*)(ws + WS_W8 + (size_t)NPROJ * DM), T, NGATE, DM / 2, DM / 2, DM / 2}; pg8::GateOrder S; S.B.init(T, DM, F.G, F.bid);
          pg8::EpiGateU8 E{ws + WS_BIG, NGATE, (const float*)(ws + WS_USC), (const float*)(ws + WS_WSC) + NPROJ}; pg8::gemm_phase<2>(F.lds, g, S, E, F.wave); }
        VM_WAIT(); __syncthreads();
    }
    if (IN(10)) { frame_refresh(F);
        pg8::Gemm g{(const bf16*)F.out, (const bf16*)(ws + WS_WCATT), T, DM, YC / 2, YC / 2, YC / 2}; pg8::StaticOrder S; S.init(g.M, g.N, F.G, F.bid);
        pg8::EpiBranchFused E{ws + WS_ACT1, DM, __builtin_amdgcn_make_buffer_rsrc((void*)BIG, 0, T * NGATE, 0x00020000), NGATE}; pg8::gemm_phase<1>(F.lds, g, S, E, F.wave);
    }
    SEAM(10);
    if (IN(11)) { frame_refresh(F); pg8::Gemm g{ACT1, (const bf16*)(ws + WS_WOUTT), T, DM, DM / 2, DM / 2, DM / 2}; pg8::PanelOrder S; S.init(g.M, g.N, F.G, F.bid);
        pg8::EpiResidBf16 E{(bf16*)(ws + WS_H1B), DM, F.in[I_X], 1.0f / (WO_SCALE * M8_SCALE)}; pg8::gemm_phase<1>(F.lds, g, S, E, F.wave);
        frame_refresh(F); hn_panel_pass(F); }
    if (IN(11) && IN(12)) { VM_WAIT(); __syncthreads(); __builtin_amdgcn_fence(__ATOMIC_ACQUIRE, "agent"); }
    if (IN(12)) { frame_refresh(F); pg8::Gemm g{(const bf16*)(ws + WS_HN8), (const bf16*)(ws + WS_WQT), T, PEER_Q, DM / 2, DM / 2, DM / 2}; pg8::PanelOrder S; S.init(g.M, g.N, F.G, F.bid);
        pg8::EpiBf16Q<0> E{BIG, PEER_Q, (const float*)(ws + WS_HNSC), (const float*)(ws + WS_WSC) + 9216}; pg8::gemm_phase<2>(F.lds, g, S, E, F.wave); }
    SEAM(12);
    if (IN(13)) { frame_refresh(F); peer_phase(F); }
#undef IN
#undef SEAM
}

extern "C" void kernel_launch(void* const* d_in, const int* in_sizes, int n_in, void* d_out, int out_size, void* d_ws, size_t ws_size, hipStream_t stream) {
    static int grid = 0;
    if (grid == 0) {
        if (n_in != 26 || out_size != T * DM || ws_size < WS_END) { fprintf(stderr, "kernel_launch: unexpected shapes (n_in %d, out %d, ws %zu)\n", n_in, out_size, ws_size); grid = -1; return; }
        int dev = 0, cus = 0;
        if (hipGetDevice(&dev) != hipSuccess || hipDeviceGetAttribute(&cus, hipDeviceAttributeMultiprocessorCount, dev) != hipSuccess) { grid = -1; return; }
        if (hipFuncSetAttribute((const void*)mega_fwd, hipFuncAttributeMaxDynamicSharedMemorySize, LDS_BYTES) != hipSuccess) { grid = -1; return; }
        int per_cu = 0;
        (void)hipOccupancyMaxActiveBlocksPerMultiprocessor(&per_cu, (const void*)mega_fwd, NTHR, LDS_BYTES);
        (void)hipGetLastError();
        grid = cus;
    }
    if (grid < 0) return;
    (void)hipMemsetAsync((char*)d_ws + WS_CTL, 0, CTL_ZERO_BYTES, stream);
    Args a{};
    for (int i = 0; i < 26; ++i) a.in[i] = (const float*)d_in[i];
    a.positions = (const int*)d_in[2]; a.out = (float*)d_out; a.ws = (unsigned char*)d_ws;
#if MK_N_LAUNCHES == 1
    a.ph_lo = 0; a.ph_hi = N_PHASES;
    hipLaunchKernelGGL(mega_fwd, dim3(grid), dim3(NTHR), LDS_BYTES, stream, a);
#else
    for (int p = 0; p < N_PHASES; ++p) { a.ph_lo = p; a.ph_hi = p + 1; hipLaunchKernelGGL(mega_fwd, dim3(grid), dim3(NTHR), LDS_BYTES, stream, a); }
#endif
}
```
